# Optimizing an MI355X kernel written in HIP

```python
import jax, jax.numpy as jnp
from jax import lax
import numpy as np

D_MODEL = 1024
BATCH = 8
SEQ = 2048
DEPTH = 1

SB_HEADS = 8
SB_HEAD_DIM = 64
SB_BLOCK = 128
DN_HEADS = 4
DN_KEY_DIM = 128
DN_VALUE_DIM = 128
DN_CONV = 4
DN_CHUNK = 64
D_FF = 2816
N_MOD = 9
EPS = 1e-6

SB_W = SB_HEADS * SB_HEAD_DIM
DN_QK_W = DN_HEADS * DN_KEY_DIM
DN_V_W = DN_HEADS * DN_VALUE_DIM
IN_SPLITS = (SB_W, SB_W, SB_W, DN_QK_W, DN_QK_W, DN_V_W, DN_V_W, DN_HEADS, DN_HEADS, D_MODEL, D_MODEL)
IN_WIDTH = 3 * SB_W + 2 * DN_QK_W + 2 * DN_V_W + 2 * DN_HEADS + 2 * D_MODEL

kernel_name = "hybrid_stickbreak_gdn_macaron_adaln"


def rms_norm(x, gain):
    xf = x.astype(jnp.float32)
    y = xf * lax.rsqrt(jnp.mean(xf * xf, axis=-1, keepdims=True) + EPS)
    return (y * gain.astype(jnp.float32)).astype(x.dtype)


def l2_norm(x):
    xf = x.astype(jnp.float32)
    return xf * lax.rsqrt(jnp.sum(xf * xf, axis=-1, keepdims=True) + EPS)


def modulate(x, shift, scale):
    return x * (1.0 + scale) + shift


def swiglu(u, w_in, w_out):
    a, b = jnp.split(u @ w_in, 2, axis=-1)
    return (jax.nn.silu(a) * b) @ w_out


def causal_depthwise_conv(x, w):
    k = w.shape[0]
    return lax.conv_general_dilated(
        x, w[:, None, :].astype(x.dtype), window_strides=(1,), padding=[(k - 1, 0)],
        dimension_numbers=("NWC", "WIO", "NWC"), feature_group_count=x.shape[-1])


def stick_breaking_attention(q, k, v):
    seq = q.shape[2]
    scale = SB_HEAD_DIM ** -0.5
    outs = []
    for blk in range(seq // SB_BLOCK):
        start = blk * SB_BLOCK
        end = start + SB_BLOCK
        qb = q[:, :, start:end]
        kb = k[:, :, :end]
        vb = v[:, :, :end]
        z = jnp.einsum("bhqd,bhkd->bhqk", qb, kb, preferred_element_type=jnp.float32) * scale
        t_pos = start + jnp.arange(SB_BLOCK)[:, None]
        s_pos = jnp.arange(end)[None, :]
        causal = s_pos < t_pos
        log_beta = jax.nn.log_sigmoid(z)
        log_keep = jnp.where(causal, jax.nn.log_sigmoid(-z), 0.0)
        later = lax.cumsum(log_keep, axis=3, reverse=True) - log_keep
        w = jnp.where(causal, jnp.exp(log_beta + later), 0.0)
        outs.append(jnp.einsum("bhqk,bhkd->bhqd", w.astype(v.dtype), vb))
    return jnp.concatenate(outs, axis=2)


def gated_delta_rule_chunked(q, k, v, g, beta):
    bsz, seq, nh, dk = q.shape
    dv = v.shape[-1]
    c = DN_CHUNK
    n = seq // c
    f32 = jnp.float32
    q = q.astype(f32) * (dk ** -0.5)
    chunk = lambda a: a.astype(f32).transpose(0, 2, 1, 3).reshape(bsz, nh, n, c, a.shape[-1])
    q, k, v = chunk(q), chunk(k), chunk(v)
    g = jnp.cumsum(g.astype(f32).transpose(0, 2, 1).reshape(bsz, nh, n, c), axis=-1)
    beta = beta.astype(f32).transpose(0, 2, 1).reshape(bsz, nh, n, c)
    kb = k * beta[..., None]
    vb = v * beta[..., None]
    incl = jnp.tril(jnp.ones((c, c), dtype=bool))
    strict = jnp.tril(jnp.ones((c, c), dtype=bool), -1)
    diff = g[..., :, None] - g[..., None, :]
    decay = jnp.where(incl, jnp.exp(jnp.where(incl, diff, 0.0)), 0.0)
    lower = jnp.where(strict, jnp.einsum("bhnid,bhnjd->bhnij", kb, k) * decay, 0.0)
    rhs = jnp.concatenate([vb, kb * jnp.exp(g)[..., None]], axis=-1)
    sol = lax.linalg.triangular_solve(lower, rhs, left_side=True, lower=True, unit_diagonal=True)
    u, w = sol[..., :dv], sol[..., dv:]
    a_qk = jnp.where(incl, jnp.einsum("bhnid,bhnjd->bhnij", q, k) * decay, 0.0)

    def step(state, inp):
        q_c, k_c, u_c, w_c, g_c, a_c = inp
        v_new = u_c - jnp.matmul(w_c, state)
        o = jnp.matmul(q_c * jnp.exp(g_c)[..., None], state) + jnp.matmul(a_c, v_new)
        g_last = g_c[..., -1]
        k_dec = k_c * jnp.exp(g_last[..., None] - g_c)[..., None]
        state = state * jnp.exp(g_last)[..., None, None] + jnp.einsum("bhcd,bhce->bhde", k_dec, v_new)
        return state, o

    xs = tuple(jnp.moveaxis(a, 2, 0) for a in (q, k, u, w, g, a_qk))
    state0 = jnp.zeros((bsz, nh, dk, dv), f32)
    _, o = lax.scan(step, state0, xs)
    o = jnp.moveaxis(o, 0, 2).reshape(bsz, nh, seq, dv)
    return o.transpose(0, 2, 1, 3)


def hybrid_mixer(u, w_in, g_q_sb, g_k_sb, w_conv, a_log, dt_bias, g_dn_out, w_up_sb, w_up_dn, w_out):
    bsz, seq, _ = u.shape
    offsets = [int(o) for o in np.cumsum(IN_SPLITS)[:-1]]
    (q_sb, k_sb, v_sb, q_dn, k_dn, v_dn, z_dn, b_dn, a_dn, r_sb, r_dn) = jnp.split(u @ w_in, offsets, axis=-1)

    to_heads = lambda t: t.reshape(bsz, seq, SB_HEADS, SB_HEAD_DIM)
    q_a = rms_norm(to_heads(q_sb), g_q_sb).transpose(0, 2, 1, 3)
    k_a = rms_norm(to_heads(k_sb), g_k_sb).transpose(0, 2, 1, 3)
    v_a = to_heads(v_sb).transpose(0, 2, 1, 3)
    y_sb = stick_breaking_attention(q_a, k_a, v_a)
    y_sb = y_sb.transpose(0, 2, 1, 3).reshape(bsz, seq, SB_W) @ w_up_sb

    qkv = jax.nn.silu(causal_depthwise_conv(jnp.concatenate([q_dn, k_dn, v_dn], axis=-1), w_conv))
    q_b, k_b, v_b = jnp.split(qkv, [DN_QK_W, 2 * DN_QK_W], axis=-1)
    q_b = l2_norm(q_b.reshape(bsz, seq, DN_HEADS, DN_KEY_DIM))
    k_b = l2_norm(k_b.reshape(bsz, seq, DN_HEADS, DN_KEY_DIM))
    v_b = v_b.reshape(bsz, seq, DN_HEADS, DN_VALUE_DIM)
    beta = jax.nn.sigmoid(b_dn.astype(jnp.float32))
    g = -jnp.exp(a_log.astype(jnp.float32)) * jax.nn.softplus(a_dn.astype(jnp.float32) + dt_bias.astype(jnp.float32))
    o = gated_delta_rule_chunked(q_b, k_b, v_b, g, beta)
    o = rms_norm(o, g_dn_out) * jax.nn.silu(z_dn.reshape(bsz, seq, DN_HEADS, DN_VALUE_DIM).astype(jnp.float32))
    y_dn = o.reshape(bsz, seq, DN_V_W).astype(u.dtype) @ w_up_dn

    merged = jax.nn.sigmoid(r_sb) * y_sb + jax.nn.sigmoid(r_dn) * y_dn
    return merged @ w_out


def setup_inputs(seed: int = 0) -> dict:
    key = jax.random.key(seed)
    ks = jax.random.split(key, 24)
    nrm = lambda k, shape, fan_in: jax.random.normal(k, shape, jnp.float32) * (fan_in ** -0.5)
    gain = lambda k, shape: 1.0 + 0.02 * jax.random.normal(k, shape, jnp.float32)
    dt = jnp.exp(jax.random.uniform(ks[14], (DEPTH, DN_HEADS), jnp.float32, np.log(1e-3), np.log(1e-1)))
    return {
        "x": jax.random.normal(ks[0], (BATCH, SEQ, D_MODEL), jnp.float32),
        "c": jax.random.normal(ks[1], (BATCH, D_MODEL), jnp.float32),
        "w_ada": nrm(ks[2], (DEPTH, D_MODEL, N_MOD * D_MODEL), D_MODEL),
        "b_ada": 0.02 * jax.random.normal(ks[3], (DEPTH, N_MOD * D_MODEL), jnp.float32),
        "g_ffn1": gain(ks[4], (DEPTH, D_MODEL)),
        "w_ffn1_in": nrm(ks[5], (DEPTH, D_MODEL, 2 * D_FF), D_MODEL),
        "w_ffn1_out": nrm(ks[6], (DEPTH, D_FF, D_MODEL), D_FF),
        "g_mix": gain(ks[7], (DEPTH, D_MODEL)),
        "w_in": nrm(ks[8], (DEPTH, D_MODEL, IN_WIDTH), D_MODEL),
        "g_q_sb": gain(ks[9], (DEPTH, SB_HEAD_DIM)),
        "g_k_sb": gain(ks[10], (DEPTH, SB_HEAD_DIM)),
        "w_conv": nrm(ks[11], (DEPTH, DN_CONV, 2 * DN_QK_W + DN_V_W), DN_CONV),
        "a_log": jnp.log(jax.random.uniform(ks[12], (DEPTH, DN_HEADS), jnp.float32, 1.0, 16.0)),
        "dt_bias": dt + jnp.log(-jnp.expm1(-dt)),
        "g_dn_out": gain(ks[13], (DEPTH, DN_VALUE_DIM)),
        "w_up_sb": nrm(ks[15], (DEPTH, SB_W, D_MODEL), SB_W),
        "w_up_dn": nrm(ks[16], (DEPTH, DN_V_W, D_MODEL), DN_V_W),
        "w_out": nrm(ks[17], (DEPTH, D_MODEL, D_MODEL), D_MODEL),
        "g_ffn2": gain(ks[18], (DEPTH, D_MODEL)),
        "w_ffn2_in": nrm(ks[19], (DEPTH, D_MODEL, 2 * D_FF), D_MODEL),
        "w_ffn2_out": nrm(ks[20], (DEPTH, D_FF, D_MODEL), D_FF),
    }


def reference(x, c, w_ada, b_ada, g_ffn1, w_ffn1_in, w_ffn1_out, g_mix, w_in, g_q_sb, g_k_sb, w_conv,
              a_log, dt_bias, g_dn_out, w_up_sb, w_up_dn, w_out, g_ffn2, w_ffn2_in, w_ffn2_out):
    h = x
    cond = jax.nn.silu(c)
    for l in range(DEPTH):
        mod = cond @ w_ada[l] + b_ada[l]
        sh1, sc1, gt1, sh2, sc2, gt2, sh3, sc3, gt3 = [m[:, None, :] for m in jnp.split(mod, N_MOD, axis=-1)]
        u = modulate(rms_norm(h, g_ffn1[l]), sh1, sc1)
        h = h + 0.5 * gt1 * swiglu(u, w_ffn1_in[l], w_ffn1_out[l])
        u = modulate(rms_norm(h, g_mix[l]), sh2, sc2)
        h = h + gt2 * hybrid_mixer(u, w_in[l], g_q_sb[l], g_k_sb[l], w_conv[l], a_log[l], dt_bias[l],
                                   g_dn_out[l], w_up_sb[l], w_up_dn[l], w_out[l])
        u = modulate(rms_norm(h, g_ffn2[l]), sh3, sc3)
        h = h + 0.5 * gt3 * swiglu(u, w_ffn2_in[l], w_ffn2_out[l])
    return h.astype(x.dtype)
```

```cpp
#include <hip/hip_runtime.h>
#include <hip/hip_cooperative_groups.h>
#include <cstdio>
namespace cg = cooperative_groups;

#define LAS __attribute__((address_space(3)))
typedef unsigned short bf16_t;
typedef short bf16x8 __attribute__((ext_vector_type(8)));
typedef float f32x4 __attribute__((ext_vector_type(4)));
typedef unsigned u32x4 __attribute__((ext_vector_type(4)));
typedef unsigned u32x2 __attribute__((ext_vector_type(2)));

constexpr int T = 16384, D = 1024, SEQ = 2048, NB = 8, FF = 2816, NIN = 5632, INW = 5640, NMOD = 9216;
constexpr int C_QSB = 0, C_KSB = 512, C_VSB = 1024, C_QDN = 1536, C_KDN = 2048, C_VDN = 2560, C_ZDN = 3072, C_RSB = 3584, C_RDN = 4608;
constexpr float EPS = 1e-6f;
constexpr int LDS_BYTES = 131072;
constexpr size_t MiB = 1024 * 1024;
constexpr size_t WS_MOD = 0, WS_BG = 512 * 1024, WS_SS = 242 * MiB, WS_W = 2 * MiB;
constexpr size_t W_FFIN = WS_W, W_FFOUT = W_FFIN + (size_t)2 * FF * D * 2, W_IN = W_FFOUT + (size_t)D * FF * 2, W_UPSB = W_IN + (size_t)NIN * D * 2,
                 W_UPDN = W_UPSB + (size_t)D * 512 * 2, W_OUT = W_UPDN + (size_t)D * 512 * 2, W_END = W_OUT + (size_t)D * D * 2;
constexpr size_t WS_U = 34 * MiB, WS_P = 66 * MiB;
static_assert(W_END <= WS_U, "weights overflow");

enum { I_X = 0, I_C, I_WADA, I_BADA, I_GFFN1, I_WFFN1IN, I_WFFN1OUT, I_GMIX, I_WIN, I_GQSB, I_GKSB, I_WCONV, I_ALOG, I_DTBIAS, I_GDNOUT, I_WUPSB, I_WUPDN, I_WOUT, I_GFFN2, I_WFFN2IN, I_WFFN2OUT, N_IN };
struct Params { const float* in[N_IN]; float* out; unsigned char* ws; };

__device__ __forceinline__ float bf_lo(unsigned w) { return __uint_as_float(w << 16); }
__device__ __forceinline__ float bf_hi(unsigned w) { return __uint_as_float(w & 0xffff0000u); }
__device__ __forceinline__ float bf2f(bf16_t b) { return __uint_as_float(((unsigned)b) << 16); }
__device__ __forceinline__ unsigned pk2(float lo, float hi) { unsigned r; asm("v_cvt_pk_bf16_f32 %0, %1, %2" : "=v"(r) : "v"(lo), "v"(hi)); return r; }
__device__ __forceinline__ bf16_t f2bf(float f) { return (bf16_t)(pk2(f, 0.f) & 0xffffu); }
__device__ __forceinline__ float fexp(float x) { return __builtin_amdgcn_exp2f(x * 1.4426950408889634f); }
__device__ __forceinline__ float flog(float x) { return __builtin_amdgcn_logf(x) * 0.6931471805599453f; }
__device__ __forceinline__ float fsigmoid(float x) { return __builtin_amdgcn_rcpf(1.f + fexp(-x)); }
__device__ __forceinline__ float fsilu(float x) { return x * fsigmoid(x); }
__device__ __forceinline__ float fsoftplus(float x) { return fmaxf(x, 0.f) + flog(1.f + fexp(-fabsf(x))); }
__device__ __forceinline__ float wave_sum(float v) {
#pragma unroll
    for (int o = 1; o < 64; o <<= 1) v += __shfl_xor(v, o);
    return v;
}
#define LDS_WAIT() asm volatile("s_waitcnt lgkmcnt(0)" ::: "memory")

namespace pg8 {
constexpr int BM = 256, BK = 64, HALF = 128, HTB = HALF * BK * 2, STAGE_BYTES = 8 * HTB, NXCD = 8, WGM = 8;
__host__ __device__ __forceinline__ int lds_byte(int r, int c) { const int st = (r >> 4) * 2 + (c >> 5), rr = r & 15, cc = c & 31, ob = rr * 64 + cc * 2; return st * 1024 + (ob ^ (((ob >> 9) & 1) << 5)); }
__host__ __device__ __forceinline__ void stage_rc(int b, int& R, int& C) { const int st = b / 1024, sb = b % 1024, swz = sb ^ (((sb >> 9) & 1) << 5); R = (st >> 1) * 16 + swz / 64; C = (st & 1) * 32 + (swz % 64) / 2; }
__host__ __device__ __forceinline__ int perm32(int rho) { const int n = rho >> 4, i = rho & 15; return 8 * (i >> 2) + 4 * n + (i & 3); }
struct Unit { int pm, pn; };
struct Gemm { const bf16_t* A; const bf16_t* Bt; int M, N, K, lda; };
struct StaticOrder {
    int nM, nN, nwg, G, c;
    __host__ __device__ void init(int M, int N, int G_, int c_) { nM = M / BM; nN = N / BM; nwg = nM * nN; G = G_; c = c_; }
    __host__ __device__ bool next(int i, Unit& u) const {
        const long L = (long)i * G + c; if (L >= nwg) return false;
        int wgid = (int)L; { const int q = nwg / NXCD, r = nwg % NXCD, xcd = wgid % NXCD, off = wgid / NXCD; wgid = (xcd < r ? xcd * (q + 1) : r * (q + 1) + (xcd - r) * q) + off; }
        const int nig = WGM * nN, gid = wgid / nig, fm = gid * WGM, gsz = (nM - fm) < WGM ? (nM - fm) : WGM;
        u.pm = fm + ((wgid % nig) % gsz); u.pn = (wgid % nig) / gsz; return true;
    }
};
template <class Epi>
__device__ __forceinline__ void gemm_phase(LAS unsigned char* lds, const Gemm g, const StaticOrder& S, const Epi& E) {
    const int tid = threadIdx.x, wid = __builtin_amdgcn_readfirstlane(tid >> 6), lane = tid & 63, wr = wid >> 2, wc = wid & 3, fr = lane & 15, fq = lane >> 4;
    const int K = g.K, nt = K / BK, lda = g.lda;
    unsigned voffA[2], voffB[2];
#pragma unroll
    for (int i = 0; i < 2; ++i) { int R, C; stage_rc(tid * 16 + i * 8192, R, C); const int Rb = Epi::PERM ? ((R & ~31) + perm32(R & 31)) : R;
        voffA[i] = (unsigned)(R * lda + C) * 2u; voffB[i] = (unsigned)(Rb * K + C) * 2u; }
    const size_t kstep = (size_t)(BK * 2);
    const size_t hstepA = (size_t)HALF * lda * 2, hstepB = (size_t)HALF * K * 2;
    const size_t tstepA = 2 * hstepA, tstepB = 2 * hstepB;
    const unsigned ldsw = (unsigned)wid * 1024u;
    const int aoff = lds_byte(wr * 64 + fr, fq * 8), boff = lds_byte(wc * 32 + fr, fq * 8);
#define PG8_SA(b, h) (((b) * 2 + (h)) * HTB)
#define PG8_SB(b, h) ((4 + (b) * 2 + (h)) * HTB)
#define PG8_STAGE(bufoff, gbase, voff) do { _Pragma("unroll") for (int _i = 0; _i < 2; ++_i) \
        __builtin_amdgcn_global_load_lds((const unsigned*)((const char*)(gbase) + (voff)[_i]), (LAS unsigned*)(lds + (bufoff) + ldsw + _i * 8192), 16, 0, 0); } while (0)
#define PG8_LDA(dst, b, h) do { _Pragma("unroll") for (int m = 0; m < 4; ++m) _Pragma("unroll") for (int k = 0; k < 2; ++k) dst[m][k] = *(const LAS bf16x8*)(lds + PG8_SA(b, h) + aoff + m * 2048 + k * 1024); } while (0)
#define PG8_LDB(dst, b, h) do { _Pragma("unroll") for (int n = 0; n < 2; ++n) _Pragma("unroll") for (int k = 0; k < 2; ++k) dst[n][k] = *(const LAS bf16x8*)(lds + PG8_SB(b, h) + boff + n * 2048 + k * 1024); } while (0)
#define PG8_MMA(ai, bj, At, Bt) do { __builtin_amdgcn_s_setprio(1); _Pragma("unroll") for (int m = 0; m < 4; ++m) _Pragma("unroll") for (int n = 0; n < 2; ++n) _Pragma("unroll") for (int k = 0; k < 2; ++k) \
        acc[ai][bj][m][n] = __builtin_amdgcn_mfma_f32_16x16x32_bf16(Bt[n][k], At[m][k], acc[ai][bj][m][n], 0, 0, 0); __builtin_amdgcn_s_setprio(0); } while (0)
#define PG8_WAIT_V(n) asm volatile("s_waitcnt vmcnt(" #n ")" ::: "memory")
#define PG8_WAIT_L(n) asm volatile("s_waitcnt lgkmcnt(" #n ")" ::: "memory")
#define PG8_BAR __builtin_amdgcn_s_barrier()
#define PG8_SCHED __builtin_amdgcn_sched_barrier(0)
    Unit cur, nxt; int ui = 0;
    if (!S.next(0, cur)) return;
    f32x4 acc[2][2][4][2];
#pragma unroll
    for (int a = 0; a < 2; ++a)
#pragma unroll
        for (int b = 0; b < 2; ++b)
#pragma unroll
            for (int m = 0; m < 4; ++m)
#pragma unroll
                for (int n = 0; n < 2; ++n) acc[a][b][m][n] = (f32x4){0.f, 0.f, 0.f, 0.f};
    bf16x8 At[4][2], B0[2][2], B1[2][2];
    const char* cA = (const char*)g.A + (size_t)cur.pm * tstepA; const char* cB = (const char*)g.Bt + (size_t)cur.pn * tstepB;
    PG8_STAGE(PG8_SB(0, 0), cB, voffB); PG8_STAGE(PG8_SA(0, 0), cA, voffA); PG8_STAGE(PG8_SB(0, 1), cB + hstepB, voffB); PG8_STAGE(PG8_SA(0, 1), cA + hstepA, voffA);
    if (wr == 1) PG8_BAR;
    PG8_WAIT_V(4); PG8_BAR;
    PG8_STAGE(PG8_SB(1, 0), cB + kstep, voffB); PG8_STAGE(PG8_SA(1, 0), cA + kstep, voffA); PG8_STAGE(PG8_SB(1, 1), cB + hstepB + kstep, voffB);
    PG8_WAIT_V(6); PG8_BAR;
    for (;;) {
        const bool has_next = S.next(ui + 1, nxt);
        const char* nA = has_next ? (const char*)g.A + (size_t)nxt.pm * tstepA : cA; const char* nB = has_next ? (const char*)g.Bt + (size_t)nxt.pn * tstepB : cB;
        for (int t = 0; t < nt; t += 2) {
            const bool last = (t == nt - 2);
            const char* a1 = cA + (size_t)(t + 1) * kstep;
            const char* a2 = last ? nA : cA + (size_t)(t + 2) * kstep; const char* b2 = last ? nB : cB + (size_t)(t + 2) * kstep;
            const char* a3 = a2 + kstep; const char* b3 = b2 + kstep;
            PG8_LDB(B0, 0, 0); PG8_SCHED; PG8_LDA(At, 0, 0); PG8_STAGE(PG8_SA(1, 1), a1 + hstepA, voffA);
            PG8_WAIT_L(8); PG8_BAR; PG8_WAIT_L(0); PG8_MMA(0, 0, At, B0); PG8_BAR; PG8_SCHED;
            PG8_LDB(B1, 0, 1); PG8_STAGE(PG8_SB(0, 0), b2, voffB);
            PG8_BAR; PG8_WAIT_L(0); PG8_MMA(0, 1, At, B1); PG8_BAR;
            PG8_LDA(At, 0, 1); PG8_STAGE(PG8_SA(0, 0), a2, voffA);
            PG8_BAR; PG8_WAIT_L(0); PG8_MMA(1, 0, At, B0); PG8_BAR; PG8_SCHED;
            PG8_STAGE(PG8_SB(0, 1), b2 + hstepB, voffB);
            PG8_WAIT_V(6); PG8_BAR; PG8_MMA(1, 1, At, B1); PG8_BAR;
            PG8_LDB(B0, 1, 0); PG8_SCHED; PG8_LDA(At, 1, 0); PG8_STAGE(PG8_SA(0, 1), a2 + hstepA, voffA);
            PG8_WAIT_L(8); PG8_BAR; PG8_WAIT_L(0); PG8_MMA(0, 0, At, B0); PG8_BAR; PG8_SCHED;
            PG8_LDB(B1, 1, 1); PG8_STAGE(PG8_SB(1, 0), b3, voffB);
            PG8_BAR; PG8_WAIT_L(0); PG8_MMA(0, 1, At, B1); PG8_BAR;
            PG8_LDA(At, 1, 1); PG8_STAGE(PG8_SA(1, 0), a3, voffA);
            PG8_BAR; PG8_WAIT_L(0); PG8_MMA(1, 0, At, B0); PG8_BAR; PG8_SCHED;
            PG8_STAGE(PG8_SB(1, 1), b3 + hstepB, voffB);
            PG8_WAIT_V(6); PG8_BAR; PG8_MMA(1, 1, At, B1); PG8_BAR;
        }
        E(acc, cur, wr, wc, fr, fq);
        if (!has_next) break;
#pragma unroll
        for (int a = 0; a < 2; ++a)
#pragma unroll
            for (int b = 0; b < 2; ++b)
#pragma unroll
                for (int m = 0; m < 4; ++m)
#pragma unroll
                    for (int n = 0; n < 2; ++n) acc[a][b][m][n] = (f32x4){0.f, 0.f, 0.f, 0.f};
        cur = nxt; cA = nA; cB = nB; ++ui;
    }
    PG8_WAIT_V(0);
    if (wr == 0) PG8_BAR;
    PG8_BAR;
#undef PG8_SA
#undef PG8_SB
#undef PG8_STAGE
#undef PG8_LDA
#undef PG8_LDB
#undef PG8_MMA
#undef PG8_WAIT_V
#undef PG8_WAIT_L
#undef PG8_BAR
#undef PG8_SCHED
}
}

typedef const f32x4 (&AccRef)[2][2][4][2];
struct EpiBf16 {
    static constexpr bool PERM = true;
    bf16_t* O; int ldc;
    __device__ __forceinline__ void operator()(AccRef acc, const pg8::Unit& u, int wr, int wc, int fr, int fq) const {
        const int row0 = u.pm * 256 + wr * 64 + fr, col0 = u.pn * 256 + wc * 32 + 8 * fq;
#pragma unroll
        for (int ai = 0; ai < 2; ++ai)
#pragma unroll
            for (int m = 0; m < 4; ++m) { bf16_t* rowp = O + (size_t)(row0 + ai * 128 + m * 16) * ldc + col0;
#pragma unroll
                for (int bj = 0; bj < 2; ++bj) { const f32x4 v0 = acc[ai][bj][m][0], v1 = acc[ai][bj][m][1];
                    u32x4 w; w.x = pk2(v0[0], v0[1]); w.y = pk2(v0[2], v0[3]); w.z = pk2(v1[0], v1[1]); w.w = pk2(v1[2], v1[3]);
                    *(u32x4*)(rowp + bj * 128) = w; } }
    }
};
struct EpiSwiGLU {
    static constexpr bool PERM = true;
    bf16_t* O; int ldc;
    __device__ __forceinline__ void operator()(AccRef acc, const pg8::Unit& u, int wr, int wc, int fr, int fq) const {
        const int row0 = u.pm * 256 + wr * 64 + fr, col0 = u.pn * 128 + wc * 32 + 8 * fq;
#pragma unroll
        for (int ai = 0; ai < 2; ++ai)
#pragma unroll
            for (int m = 0; m < 4; ++m) { bf16_t* rowp = O + (size_t)(row0 + ai * 128 + m * 16) * ldc + col0;
                float r[8];
#pragma unroll
                for (int n = 0; n < 2; ++n)
#pragma unroll
                    for (int j = 0; j < 4; ++j) { const float a = acc[ai][0][m][n][j], b = acc[ai][1][m][n][j]; r[n * 4 + j] = fsilu(a) * b; }
                u32x4 w; w.x = pk2(r[0], r[1]); w.y = pk2(r[2], r[3]); w.z = pk2(r[4], r[5]); w.w = pk2(r[6], r[7]);
                *(u32x4*)rowp = w; }
    }
};
struct EpiResid {
    static constexpr bool PERM = false;
    const float* base; float* out; const float* gate; float scale;
    __device__ __forceinline__ void operator()(AccRef acc, const pg8::Unit& u, int wr, int wc, int fr, int fq) const {
        const int row0 = u.pm * 256 + wr * 64 + fr, col0 = u.pn * 256 + wc * 32 + 4 * fq;
        const float* gp = gate + (size_t)(u.pm >> 3) * NMOD + col0;
        f32x4 gv[2][2];
#pragma unroll
        for (int bj = 0; bj < 2; ++bj)
#pragma unroll
            for (int n = 0; n < 2; ++n) gv[bj][n] = *(const f32x4*)(gp + bj * 128 + n * 16) * scale;
#pragma unroll
        for (int ai = 0; ai < 2; ++ai)
#pragma unroll
            for (int m = 0; m < 4; ++m) { const size_t off = (size_t)(row0 + ai * 128 + m * 16) * D + col0;
#pragma unroll
                for (int bj = 0; bj < 2; ++bj)
#pragma unroll
                    for (int n = 0; n < 2; ++n) { const f32x4 bs = *(const f32x4*)(base + off + bj * 128 + n * 16);
                        *(f32x4*)(out + off + bj * 128 + n * 16) = bs + gv[bj][n] * acc[ai][bj][m][n]; } }
    }
};
template <bool ACCUM> struct EpiGate {
    static constexpr bool PERM = true;
    const bf16_t* R; bf16_t* O;
    __device__ __forceinline__ void operator()(AccRef acc, const pg8::Unit& u, int wr, int wc, int fr, int fq) const {
        const int row0 = u.pm * 256 + wr * 64 + fr, col0 = u.pn * 256 + wc * 32 + 8 * fq;
#pragma unroll
        for (int ai = 0; ai < 2; ++ai)
#pragma unroll
            for (int m = 0; m < 4; ++m) { const size_t row = (size_t)(row0 + ai * 128 + m * 16);
#pragma unroll
                for (int bj = 0; bj < 2; ++bj) { const u32x4 rw = *(const u32x4*)(R + row * NIN + col0 + bj * 128);
                    bf16_t* op = O + row * D + col0 + bj * 128;
                    const f32x4 v0 = acc[ai][bj][m][0], v1 = acc[ai][bj][m][1];
                    float r[8] = {fsigmoid(bf_lo(rw.x)) * v0[0], fsigmoid(bf_hi(rw.x)) * v0[1], fsigmoid(bf_lo(rw.y)) * v0[2], fsigmoid(bf_hi(rw.y)) * v0[3],
                                  fsigmoid(bf_lo(rw.z)) * v1[0], fsigmoid(bf_hi(rw.z)) * v1[1], fsigmoid(bf_lo(rw.w)) * v1[2], fsigmoid(bf_hi(rw.w)) * v1[3]};
                    if (ACCUM) { const u32x4 pw = *(const u32x4*)op;
                        r[0] += bf_lo(pw.x); r[1] += bf_hi(pw.x); r[2] += bf_lo(pw.y); r[3] += bf_hi(pw.y); r[4] += bf_lo(pw.z); r[5] += bf_hi(pw.z); r[6] += bf_lo(pw.w); r[7] += bf_hi(pw.w); }
                    u32x4 w; w.x = pk2(r[0], r[1]); w.y = pk2(r[2], r[3]); w.z = pk2(r[4], r[5]); w.w = pk2(r[6], r[7]);
                    *(u32x4*)op = w; } }
    }
};
template <class Epi> __device__ __forceinline__ void run_gemm(LAS unsigned char* lds, const bf16_t* A, int lda, const bf16_t* Bt, int N, int K, const Epi& E) {
    pg8::Gemm g{A, Bt, T, N, K, lda}; pg8::StaticOrder S; S.init(T, N, (int)gridDim.x, (int)blockIdx.x);
    pg8::gemm_phase<Epi>(lds, g, S, E);
}

__device__ __forceinline__ void transpose_item(const float* W, int ldw, int s0, int k0, bf16_t* WT, int ldk, int d0, LAS float* scr, int lane) {
#pragma unroll 8
    for (int i = 0; i < 32; ++i) { const int kk = 2 * i + (lane >> 5); scr[kk * 33 + (lane & 31)] = W[(size_t)(k0 + kk) * ldw + s0 + (lane & 31)]; }
    LDS_WAIT();
    const int c = lane & 7;
#pragma unroll
    for (int j = 0; j < 4; ++j) { const int n = (lane >> 3) + 8 * j; const LAS float* s = scr + (8 * c) * 33 + n;
        u32x4 o; o.x = pk2(s[0 * 33], s[1 * 33]); o.y = pk2(s[2 * 33], s[3 * 33]); o.z = pk2(s[4 * 33], s[5 * 33]); o.w = pk2(s[6 * 33], s[7 * 33]);
        *(u32x4*)(WT + (size_t)(d0 + n) * ldk + k0 + 8 * c) = o; }
    LDS_WAIT();
}
__device__ __forceinline__ void ffn_weight_items(const float* w_in, const float* w_out, bf16_t* wt_in, bf16_t* wt_out, LAS float* scr, int gw, int ngw, int lane) {
    for (int it = gw; it < 2816 + 1408; it += ngw) {
        if (it < 2816) { const int kb = it / 176, nb = it % 176, d0 = nb * 32, pn = d0 >> 8, bj = (d0 >> 7) & 1, c = d0 & 127, s0 = bj * FF + pn * 128 + c;
            transpose_item(w_in, 2 * FF, s0, kb * 64, wt_in, D, d0, scr, lane); }
        else { const int r = it - 2816, kb = r / 32, nb = r % 32; transpose_item(w_out, D, nb * 32, kb * 64, wt_out, FF, nb * 32, scr, lane); }
    }
}
__device__ __forceinline__ void mixer_weight_items(const Params& p, LAS float* scr, int gw, int ngw, int lane) {
    unsigned char* ws = p.ws;
    for (int it = gw; it < 2816 + 256 + 256 + 512; it += ngw) {
        int r = it;
        if (r < 2816) { const int kb = r / 176, nb = r % 176, d0 = nb * 32, s0 = d0 < C_RSB ? d0 : d0 + 8; transpose_item(p.in[I_WIN], INW, s0, kb * 64, (bf16_t*)(ws + W_IN), D, d0, scr, lane); continue; } r -= 2816;
        if (r < 256) { const int kb = r / 32, nb = r % 32; transpose_item(p.in[I_WUPSB], D, nb * 32, kb * 64, (bf16_t*)(ws + W_UPSB), 512, nb * 32, scr, lane); continue; } r -= 256;
        if (r < 256) { const int kb = r / 32, nb = r % 32; transpose_item(p.in[I_WUPDN], D, nb * 32, kb * 64, (bf16_t*)(ws + W_UPDN), 512, nb * 32, scr, lane); continue; } r -= 256;
        { const int kb = r / 32, nb = r % 32; transpose_item(p.in[I_WOUT], D, nb * 32, kb * 64, (bf16_t*)(ws + W_OUT), D, nb * 32, scr, lane); }
    }
}
__device__ __forceinline__ void mod_item(const Params& p, LAS unsigned char* lds, int cb, int tid, int wave, int lane) {
    LAS float* sc = (LAS float*)lds; LAS float* red = (LAS float*)(lds + 32768);
    for (int i = tid; i < NB * D; i += 512) sc[i] = fsilu(p.in[I_C][i]);
    __syncthreads();
    const float* wa = p.in[I_WADA] + cb * 64 + lane;
    float acc[NB];
#pragma unroll
    for (int b = 0; b < NB; ++b) acc[b] = 0.f;
    for (int k = wave * 128; k < wave * 128 + 128; k += 4) {
        float w[4];
#pragma unroll
        for (int e = 0; e < 4; ++e) w[e] = wa[(size_t)(k + e) * NMOD];
#pragma unroll
        for (int b = 0; b < NB; ++b) { const f32x4 s = *(const LAS f32x4*)(sc + b * D + k); acc[b] += s[0] * w[0] + s[1] * w[1] + s[2] * w[2] + s[3] * w[3]; }
    }
#pragma unroll
    for (int b = 0; b < NB; ++b) red[(wave * NB + b) * 64 + lane] = acc[b];
    __syncthreads();
    { const int b = tid >> 6; float s = p.in[I_BADA][cb * 64 + lane];
#pragma unroll
        for (int w = 0; w < 8; ++w) s += red[(w * NB + b) * 64 + lane];
        ((float*)(p.ws + WS_MOD))[b * NMOD + cb * 64 + lane] = s; }
    __syncthreads();
}

template <bool DN>
__device__ __forceinline__ void norm_mod_phase(const Params& p, LAS unsigned char* lds, const float* src, const float* gain, int midx, bf16_t* dst, int tid, int wave, int lane) {
    const float* mod = (const float*)(p.ws + WS_MOD);
    LAS float* wl = (LAS float*)lds;
    if (DN) { for (int i = tid; i < D * 8; i += 512) { const int k = i >> 3, j = i & 7; wl[8 * k + 4 * (k >> 2) + j] = p.in[I_WIN][(size_t)k * INW + C_RSB + j]; } __syncthreads(); }
    f32x4 g4[4];
#pragma unroll
    for (int j = 0; j < 4; ++j) g4[j] = ((const f32x4*)gain)[lane + 64 * j];
    for (int row = blockIdx.x * 8 + wave; row < T; row += gridDim.x * 8) {
        const int b = row >> 11;
        const f32x4* xr = (const f32x4*)(src + (size_t)row * D) + lane;
        const f32x4* shp = (const f32x4*)(mod + (size_t)b * NMOD + midx * D) + lane; const f32x4* scp = shp + D / 4;
        f32x4 v[4]; float ss = 0.f;
#pragma unroll
        for (int j = 0; j < 4; ++j) { v[j] = xr[64 * j]; ss += (v[j][0] * v[j][0] + v[j][1] * v[j][1]) + (v[j][2] * v[j][2] + v[j][3] * v[j][3]); }
        const float rstd = 1.0f / sqrtf(wave_sum(ss) * (1.f / D) + EPS);
        u32x2* o8 = (u32x2*)(dst + (size_t)row * D) + lane;
        float dot[8];
        if (DN) {
#pragma unroll
            for (int e = 0; e < 8; ++e) dot[e] = 0.f; }
#pragma unroll
        for (int j = 0; j < 4; ++j) { const f32x4 sh = shp[64 * j], sc = scp[64 * j];
            const f32x4 uu = v[j] * rstd * g4[j] * (sc + 1.0f) + sh;
            u32x2 w; w.x = pk2(uu[0], uu[1]); w.y = pk2(uu[2], uu[3]); o8[64 * j] = w;
            if (DN) {
#pragma unroll
                for (int e = 0; e < 4; ++e) { const int k = 4 * lane + 256 * j + e; const LAS f32x4* wp = (const LAS f32x4*)(wl + 8 * k + 4 * (k >> 2)); const f32x4 w0 = wp[0], w1 = wp[1];
                    dot[0] += uu[e] * w0[0]; dot[1] += uu[e] * w0[1]; dot[2] += uu[e] * w0[2]; dot[3] += uu[e] * w0[3];
                    dot[4] += uu[e] * w1[0]; dot[5] += uu[e] * w1[1]; dot[6] += uu[e] * w1[2]; dot[7] += uu[e] * w1[3]; } } }
        if (DN) {
#pragma unroll
            for (int e = 0; e < 8; ++e) dot[e] = wave_sum(dot[e]);
            float mine = dot[0];
#pragma unroll
            for (int e = 1; e < 8; ++e) mine = (lane == e) ? dot[e] : mine;
            if (lane < 8) { float r;
                if (lane < 4) r = 1.0f / (1.0f + expf(-mine));
                else { const int hh = lane - 4; const float a = mine + p.in[I_DTBIAS][hh]; const float sp = a > 20.f ? a : log1pf(expf(a)); r = -expf(p.in[I_ALOG][hh]) * sp; }
                ((float*)(p.ws + WS_BG))[(size_t)row * 8 + lane] = r; } }
    }
    if (DN) __syncthreads();
}

__device__ __forceinline__ void unpack16(const bf16_t* p, float* f) {
    const u32x4 a = ((const u32x4*)p)[0], b = ((const u32x4*)p)[1];
    f[0] = bf_lo(a.x); f[1] = bf_hi(a.x); f[2] = bf_lo(a.y); f[3] = bf_hi(a.y); f[4] = bf_lo(a.z); f[5] = bf_hi(a.z); f[6] = bf_lo(a.w); f[7] = bf_hi(a.w);
    f[8] = bf_lo(b.x); f[9] = bf_hi(b.x); f[10] = bf_lo(b.y); f[11] = bf_hi(b.y); f[12] = bf_lo(b.z); f[13] = bf_hi(b.z); f[14] = bf_lo(b.w); f[15] = bf_hi(b.w);
}
__device__ __forceinline__ void pack16(bf16_t* p, const float* f) {
    u32x4 a, b; a.x = pk2(f[0], f[1]); a.y = pk2(f[2], f[3]); a.z = pk2(f[4], f[5]); a.w = pk2(f[6], f[7]); b.x = pk2(f[8], f[9]); b.y = pk2(f[10], f[11]); b.z = pk2(f[12], f[13]); b.w = pk2(f[14], f[15]);
    ((u32x4*)p)[0] = a; ((u32x4*)p)[1] = b;
}
__device__ __forceinline__ void prep_phase(const Params& p, int wave, int lane) {
    bf16_t* P = (bf16_t*)(p.ws + WS_P); bf16_t* U = (bf16_t*)(p.ws + WS_U);
    const int ch = 16 * lane;
    float gsb[16], wcv[4][16];
    { const float* gp = (ch < 512 ? p.in[I_GQSB] : p.in[I_GKSB]) + (ch & 63); const float sc = ch < 512 ? 0.125f : 1.0f;
#pragma unroll
        for (int e = 0; e < 16; ++e) gsb[e] = gp[e] * sc;
#pragma unroll
        for (int i = 0; i < 4; ++i)
#pragma unroll
            for (int e = 0; e < 16; ++e) wcv[i][e] = p.in[I_WCONV][i * 1536 + ch + e]; }
    for (int row = blockIdx.x * 8 + wave; row < T; row += gridDim.x * 8) {
        const int tl = row & (SEQ - 1);
        { bf16_t* qp = P + (size_t)row * NIN + ch; float f[16]; unpack16(qp, f); float ss = 0.f;
#pragma unroll
            for (int e = 0; e < 16; ++e) ss += f[e] * f[e];
            ss += __shfl_xor(ss, 1); ss += __shfl_xor(ss, 2);
            const float rstd = 1.0f / sqrtf(ss * (1.f / 64.f) + EPS);
#pragma unroll
            for (int e = 0; e < 16; ++e) f[e] = f[e] * rstd * gsb[e];
            pack16(qp, f); }
        { float y[16];
#pragma unroll
            for (int e = 0; e < 16; ++e) y[e] = 0.f;
#pragma unroll
            for (int i = 0; i < 4; ++i) { if (tl - 3 + i >= 0) { float f[16]; unpack16(P + (size_t)(row - 3 + i) * NIN + C_QDN + ch, f);
#pragma unroll
                    for (int e = 0; e < 16; ++e) y[e] += wcv[i][e] * f[e]; } }
            float ss = 0.f;
#pragma unroll
            for (int e = 0; e < 16; ++e) { y[e] = fsilu(y[e]); ss += y[e] * y[e]; }
            ss += __shfl_xor(ss, 1); ss += __shfl_xor(ss, 2); ss += __shfl_xor(ss, 4);
            const float sc = (1.0f / sqrtf(ss + EPS)) * (ch < 512 ? 0.08838834764831845f : 1.0f);
#pragma unroll
            for (int e = 0; e < 16; ++e) y[e] *= sc;
            pack16(U + (size_t)row * D + ch, y); }
    }
}

__device__ __forceinline__ void attn_item_naive(bf16_t* P, int bh, int qb, int lane) {
    const int b = bh >> 3, h = bh & 7, t0 = qb * 64, t = t0 + lane;
    bf16_t* qrow = P + (size_t)(b * SEQ + t) * NIN + C_QSB + h * 64;
    float q[64], o[64];
#pragma unroll
    for (int i = 0; i < 8; ++i) { const u32x4 w = ((const u32x4*)qrow)[i];
        q[8 * i + 0] = bf_lo(w.x); q[8 * i + 1] = bf_hi(w.x); q[8 * i + 2] = bf_lo(w.y); q[8 * i + 3] = bf_hi(w.y); q[8 * i + 4] = bf_lo(w.z); q[8 * i + 5] = bf_hi(w.z); q[8 * i + 6] = bf_lo(w.w); q[8 * i + 7] = bf_hi(w.w); }
#pragma unroll
    for (int e = 0; e < 64; ++e) o[e] = 0.f;
    float R = 0.f;
    const bf16_t* kbase = P + (size_t)(b * SEQ) * NIN + C_KSB + h * 64; const bf16_t* vbase = P + (size_t)(b * SEQ) * NIN + C_VSB + h * 64;
#pragma unroll 1
    for (int s = t0 + 62; s >= 0; --s) {
        const u32x4* kp = (const u32x4*)(kbase + (size_t)s * NIN); const u32x4* vp = (const u32x4*)(vbase + (size_t)s * NIN);
        float z = 0.f;
#pragma unroll
        for (int i = 0; i < 8; ++i) { const u32x4 w = kp[i];
            z += q[8 * i + 0] * bf_lo(w.x) + q[8 * i + 1] * bf_hi(w.x) + q[8 * i + 2] * bf_lo(w.y) + q[8 * i + 3] * bf_hi(w.y) + q[8 * i + 4] * bf_lo(w.z) + q[8 * i + 5] * bf_hi(w.z) + q[8 * i + 6] * bf_lo(w.w) + q[8 * i + 7] * bf_hi(w.w); }
        const float sp = fsoftplus(z); const bool act = s < t;
        const float wgt = act ? fexp(z - sp - R) : 0.f;
        R += act ? sp : 0.f;
#pragma unroll
        for (int i = 0; i < 8; ++i) { const u32x4 w = vp[i];
            o[8 * i + 0] += wgt * bf_lo(w.x); o[8 * i + 1] += wgt * bf_hi(w.x); o[8 * i + 2] += wgt * bf_lo(w.y); o[8 * i + 3] += wgt * bf_hi(w.y);
            o[8 * i + 4] += wgt * bf_lo(w.z); o[8 * i + 5] += wgt * bf_hi(w.z); o[8 * i + 6] += wgt * bf_lo(w.w); o[8 * i + 7] += wgt * bf_hi(w.w); }
    }
#pragma unroll
    for (int i = 0; i < 8; ++i) { u32x4 w; w.x = pk2(o[8 * i], o[8 * i + 1]); w.y = pk2(o[8 * i + 2], o[8 * i + 3]); w.z = pk2(o[8 * i + 4], o[8 * i + 5]); w.w = pk2(o[8 * i + 6], o[8 * i + 7]); ((u32x4*)qrow)[i] = w; }
}
__device__ __forceinline__ void gdn_item_naive(const Params& p, int bh, int part, int lane) {
    bf16_t* P = (bf16_t*)(p.ws + WS_P); const bf16_t* U = (const bf16_t*)(p.ws + WS_U); const float* BG = (const float*)(p.ws + WS_BG); float* SSb = (float*)(p.ws + WS_SS);
    const int b = bh >> 2, h = bh & 3, c = part * 16 + (lane & 15), dq = lane >> 4;
    float S[32];
#pragma unroll
    for (int d = 0; d < 32; ++d) S[d] = 0.f;
    float wc[4];
#pragma unroll
    for (int i = 0; i < 4; ++i) wc[i] = p.in[I_WCONV][i * 1536 + 1024 + h * 128 + c];
    float x1 = 0.f, x2 = 0.f, x3 = 0.f;
#pragma unroll 1
    for (int t = 0; t < SEQ; ++t) {
        const size_t row = (size_t)b * SEQ + t;
        bf16_t* vp = P + row * NIN + C_VDN + h * 128 + c;
        const float x0 = bf2f(*vp);
        const float vc = wc[3] * x0 + wc[2] * x1 + wc[1] * x2 + wc[0] * x3; x3 = x2; x2 = x1; x1 = x0;
        const float v = fsilu(vc);
        const float beta = BG[row * 8 + h], eg = fexp(BG[row * 8 + 4 + h]);
        const u32x4* qp = (const u32x4*)(U + row * D + h * 128 + dq * 32); const u32x4* kp = (const u32x4*)(U + row * D + 512 + h * 128 + dq * 32);
        float kk[32], qq[32];
#pragma unroll
        for (int i = 0; i < 4; ++i) { const u32x4 w = kp[i], qw = qp[i];
            kk[8 * i] = bf_lo(w.x); kk[8 * i + 1] = bf_hi(w.x); kk[8 * i + 2] = bf_lo(w.y); kk[8 * i + 3] = bf_hi(w.y); kk[8 * i + 4] = bf_lo(w.z); kk[8 * i + 5] = bf_hi(w.z); kk[8 * i + 6] = bf_lo(w.w); kk[8 * i + 7] = bf_hi(w.w);
            qq[8 * i] = bf_lo(qw.x); qq[8 * i + 1] = bf_hi(qw.x); qq[8 * i + 2] = bf_lo(qw.y); qq[8 * i + 3] = bf_hi(qw.y); qq[8 * i + 4] = bf_lo(qw.z); qq[8 * i + 5] = bf_hi(qw.z); qq[8 * i + 6] = bf_lo(qw.w); qq[8 * i + 7] = bf_hi(qw.w); }
        float kS = 0.f;
#pragma unroll
        for (int d = 0; d < 32; ++d) kS += kk[d] * S[d];
        kS += __shfl_xor(kS, 16); kS += __shfl_xor(kS, 32);
        const float vn = beta * (v - eg * kS);
        float o = 0.f;
#pragma unroll
        for (int d = 0; d < 32; ++d) { S[d] = eg * S[d] + kk[d] * vn; o += qq[d] * S[d]; }
        o += __shfl_xor(o, 16); o += __shfl_xor(o, 32);
        if (dq == 0) *vp = f2bf(o);
        const float ss = wave_sum(dq == 0 ? o * o : 0.f);
        if (lane == 0) SSb[row * 32 + h * 8 + part] = ss;
    }
}
__device__ __forceinline__ void gdn_finalize_phase(const Params& p, int wave, int lane) {
    bf16_t* P = (bf16_t*)(p.ws + WS_P); const float* SSb = (const float*)(p.ws + WS_SS);
    const int h = lane >> 4, c0 = (lane & 15) * 8;
    float gg[8];
#pragma unroll
    for (int e = 0; e < 8; ++e) gg[e] = p.in[I_GDNOUT][c0 + e];
    for (int row = blockIdx.x * 8 + wave; row < T; row += gridDim.x * 8) {
        bf16_t* op = P + (size_t)row * NIN + C_VDN + lane * 8; const bf16_t* zp = P + (size_t)row * NIN + C_ZDN + lane * 8;
        const f32x4 s4 = *(const f32x4*)(SSb + (size_t)row * 32 + h * 8), s5 = *(const f32x4*)(SSb + (size_t)row * 32 + h * 8 + 4); const float ss = ((s4[0] + s4[1]) + (s4[2] + s4[3])) + ((s5[0] + s5[1]) + (s5[2] + s5[3]));
        const float rstd = 1.0f / sqrtf(ss * (1.f / 128.f) + EPS);
        const u32x4 ow = *(const u32x4*)op, zw = *(const u32x4*)zp;
        const float o[8] = {bf_lo(ow.x), bf_hi(ow.x), bf_lo(ow.y), bf_hi(ow.y), bf_lo(ow.z), bf_hi(ow.z), bf_lo(ow.w), bf_hi(ow.w)};
        const float z[8] = {bf_lo(zw.x), bf_hi(zw.x), bf_lo(zw.y), bf_hi(zw.y), bf_lo(zw.z), bf_hi(zw.z), bf_lo(zw.w), bf_hi(zw.w)};
        float r[8];
#pragma unroll
        for (int e = 0; e < 8; ++e) r[e] = o[e] * rstd * gg[e] * fsilu(z[e]);
        u32x4 w; w.x = pk2(r[0], r[1]); w.y = pk2(r[2], r[3]); w.z = pk2(r[4], r[5]); w.w = pk2(r[6], r[7]);
        *(u32x4*)op = w;
    }
}

#ifndef PHMASK
#define PHMASK 0xFFFF
#endif
#define PH(n) ((PHMASK >> (n)) & 1)
__global__ void __launch_bounds__(512, 2) fwd_megakernel(Params p) {
    extern __shared__ __attribute__((aligned(16))) unsigned char lds_raw[];
    LAS unsigned char* lds = (LAS unsigned char*)lds_raw;
    cg::grid_group grid = cg::this_grid();
    const int tid = threadIdx.x, lane = tid & 63, wave = __builtin_amdgcn_readfirstlane(tid >> 6);
    const int G = gridDim.x, gw = wave * G + blockIdx.x, ngw = G * 8;
    unsigned char* ws = p.ws;
    bf16_t* U = (bf16_t*)(ws + WS_U); bf16_t* P = (bf16_t*)(ws + WS_P);
    const float* mod = (const float*)(ws + WS_MOD);
    LAS float* scr = (LAS float*)(lds + wave * 16384);

    if (PH(0)) for (int it = blockIdx.x; it < NMOD / 64; it += G) mod_item(p, lds, it, tid, wave, lane);
    if (PH(0)) ffn_weight_items(p.in[I_WFFN1IN], p.in[I_WFFN1OUT], (bf16_t*)(ws + W_FFIN), (bf16_t*)(ws + W_FFOUT), scr, gw, ngw, lane);
    if (PH(0)) mixer_weight_items(p, scr, gw, ngw, lane);
    grid.sync();
    if (PH(1)) norm_mod_phase<false>(p, lds, p.in[I_X], p.in[I_GFFN1], 0, U, tid, wave, lane);
    grid.sync();
    if (PH(2)) run_gemm(lds, U, D, (const bf16_t*)(ws + W_FFIN), 2 * FF, D, EpiSwiGLU{P, FF});
    grid.sync();
    if (PH(3)) run_gemm(lds, P, FF, (const bf16_t*)(ws + W_FFOUT), D, FF, EpiResid{p.in[I_X], p.out, mod + 2 * D, 0.5f});
    grid.sync();
    if (PH(4)) norm_mod_phase<true>(p, lds, p.out, p.in[I_GMIX], 3, U, tid, wave, lane);
    grid.sync();
    if (PH(5)) run_gemm(lds, U, D, (const bf16_t*)(ws + W_IN), NIN, D, EpiBf16{P, NIN});
    grid.sync();
    if (PH(6)) prep_phase(p, wave, lane);
    grid.sync();
    for (int it = gw; it < 256 + 2048; it += ngw) {
        if (it < 256) { if (PH(7)) gdn_item_naive(p, it >> 3, it & 7, lane); }
        else if (PH(8)) { const int a = it - 256; attn_item_naive(P, a & 63, 31 - (a >> 6), lane); }
    }
    grid.sync();
    if (PH(9)) gdn_finalize_phase(p, wave, lane);
    grid.sync();
    if (PH(10)) run_gemm(lds, P + C_QSB, NIN, (const bf16_t*)(ws + W_UPSB), D, 512, EpiGate<false>{P + C_RSB, U});
    if (PH(10)) run_gemm(lds, P + C_VDN, NIN, (const bf16_t*)(ws + W_UPDN), D, 512, EpiGate<true>{P + C_RDN, U});
    grid.sync();
    if (PH(11)) run_gemm(lds, U, D, (const bf16_t*)(ws + W_OUT), D, D, EpiResid{p.out, p.out, mod + 5 * D, 1.0f});
    grid.sync();
    if (PH(12)) norm_mod_phase<false>(p, lds, p.out, p.in[I_GFFN2], 6, U, tid, wave, lane);
    __syncthreads();
    if (PH(12)) ffn_weight_items(p.in[I_WFFN2IN], p.in[I_WFFN2OUT], (bf16_t*)(ws + W_FFIN), (bf16_t*)(ws + W_FFOUT), scr, gw, ngw, lane);
    grid.sync();
    if (PH(13)) run_gemm(lds, U, D, (const bf16_t*)(ws + W_FFIN), 2 * FF, D, EpiSwiGLU{P, FF});
    grid.sync();
    if (PH(14)) run_gemm(lds, P, FF, (const bf16_t*)(ws + W_FFOUT), D, FF, EpiResid{p.out, p.out, mod + 8 * D, 0.5f});
}

extern "C" void kernel_launch(void* const* d_in, const int* in_sizes, int n_in, void* d_out, int out_size, void* d_ws, size_t ws_size, hipStream_t stream) {
    static int grid_blocks = 0;
    if (!grid_blocks) {
        int dev = 0, cus = 0, per_cu = 0;
        (void)hipGetDevice(&dev);
        (void)hipDeviceGetAttribute(&cus, hipDeviceAttributeMultiprocessorCount, dev);
        (void)hipFuncSetAttribute((const void*)fwd_megakernel, hipFuncAttributeMaxDynamicSharedMemorySize, LDS_BYTES);
        (void)hipOccupancyMaxActiveBlocksPerMultiprocessor(&per_cu, (const void*)fwd_megakernel, 512, LDS_BYTES);
        if (per_cu < 1) { fprintf(stderr, "occupancy query says %d blocks/CU\n", per_cu); per_cu = 1; }
        grid_blocks = cus;
    }
    Params p{};
    for (int i = 0; i < N_IN; ++i) p.in[i] = (const float*)d_in[i];
    p.out = (float*)d_out; p.ws = (unsigned char*)d_ws;
    void* args[] = {&p};
    hipError_t e = hipLaunchCooperativeKernel((const void*)fwd_megakernel, dim3(grid_blocks), dim3(512), args, LDS_BYTES, stream);
    if (e != hipSuccess) fprintf(stderr, "cooperative launch failed: %s (grid %d)\n", hipGetErrorString(e), grid_blocks);
}
```

```cpp
#include <hip/hip_runtime.h>
#include <hip/hip_cooperative_groups.h>
#include <cstdio>
namespace cg = cooperative_groups;

#define LAS __attribute__((address_space(3)))
typedef unsigned short bf16_t;
typedef short bf16x8 __attribute__((ext_vector_type(8)));
typedef float f32x4 __attribute__((ext_vector_type(4)));
typedef unsigned u32x4 __attribute__((ext_vector_type(4)));
typedef unsigned u32x2 __attribute__((ext_vector_type(2)));
typedef float f32x16 __attribute__((ext_vector_type(16)));
typedef float f32x2 __attribute__((ext_vector_type(2)));
typedef __bf16 nbf16x2 __attribute__((ext_vector_type(2)));

constexpr int T = 16384, D = 1024, SEQ = 2048, NB = 8, FF = 2816, NIN = 5632, INW = 5640, NMOD = 9216;
constexpr int C_QSB = 0, C_KSB = 512, C_VSB = 1024, C_QDN = 1536, C_KDN = 2048, C_VDN = 2560, C_ZDN = 3072, C_RSB = 3584, C_RDN = 4608;
constexpr float EPS = 1e-6f;
constexpr int LDS_BYTES = 131072;
constexpr size_t MiB = 1024 * 1024;
constexpr size_t WS_MOD = 0, WS_BG = 512 * 1024, WS_SS = 242 * MiB, WS_W = 2 * MiB;
constexpr size_t W_FFIN = WS_W, W_FFOUT = W_FFIN + (size_t)2 * FF * D * 2, W_IN = W_FFOUT + (size_t)D * FF * 2, W_UPSB = W_IN + (size_t)NIN * D * 2,
                 W_UPDN = W_UPSB + (size_t)D * 512 * 2, W_OUT = W_UPDN + (size_t)D * 512 * 2, W_END = W_OUT + (size_t)D * D * 2;
constexpr size_t WS_U = 34 * MiB, WS_P = 66 * MiB;
static_assert(W_END <= WS_U, "weights overflow");
constexpr size_t WS_VT = W_FFIN;
static_assert((size_t)T * 512 * 2 <= W_IN - W_FFIN, "Vt overflow");

enum { I_X = 0, I_C, I_WADA, I_BADA, I_GFFN1, I_WFFN1IN, I_WFFN1OUT, I_GMIX, I_WIN, I_GQSB, I_GKSB, I_WCONV, I_ALOG, I_DTBIAS, I_GDNOUT, I_WUPSB, I_WUPDN, I_WOUT, I_GFFN2, I_WFFN2IN, I_WFFN2OUT, N_IN };
struct Params { const float* in[N_IN]; float* out; unsigned char* ws; };

__device__ __forceinline__ float bf_lo(unsigned w) { return __uint_as_float(w << 16); }
__device__ __forceinline__ float bf_hi(unsigned w) { return __uint_as_float(w & 0xffff0000u); }
__device__ __forceinline__ float bf2f(bf16_t b) { return __uint_as_float(((unsigned)b) << 16); }
__device__ __forceinline__ unsigned pk2(float lo, float hi) { unsigned r; asm("v_cvt_pk_bf16_f32 %0, %1, %2" : "=v"(r) : "v"(lo), "v"(hi)); return r; }
__device__ __forceinline__ unsigned cpk2(float lo, float hi) { const f32x2 v = {lo, hi}; return __builtin_bit_cast(unsigned, __builtin_convertvector(v, nbf16x2)); }
__device__ __forceinline__ bf16_t f2bf(float f) { return (bf16_t)(pk2(f, 0.f) & 0xffffu); }
__device__ __forceinline__ float fexp(float x) { return __builtin_amdgcn_exp2f(x * 1.4426950408889634f); }
__device__ __forceinline__ float flog(float x) { return __builtin_amdgcn_logf(x) * 0.6931471805599453f; }
__device__ __forceinline__ float fsigmoid(float x) { return __builtin_amdgcn_rcpf(1.f + fexp(-x)); }
__device__ __forceinline__ float fsilu(float x) { return x * fsigmoid(x); }
__device__ __forceinline__ float fsoftplus(float x) { return fmaxf(x, 0.f) + flog(1.f + fexp(-fabsf(x))); }
__device__ __forceinline__ float wave_sum(float v) {
#pragma unroll
    for (int o = 1; o < 64; o <<= 1) v += __shfl_xor(v, o);
    return v;
}
#define LDS_WAIT() asm volatile("s_waitcnt lgkmcnt(0)" ::: "memory")

namespace pg8 {
constexpr int BM = 256, BK = 64, HALF = 128, HTB = HALF * BK * 2, STAGE_BYTES = 8 * HTB, NXCD = 8, WGM = 8;
__host__ __device__ __forceinline__ int lds_byte(int r, int c) { const int st = (r >> 4) * 2 + (c >> 5), rr = r & 15, cc = c & 31, ob = rr * 64 + cc * 2; return st * 1024 + (ob ^ (((ob >> 9) & 1) << 5)); }
__host__ __device__ __forceinline__ void stage_rc(int b, int& R, int& C) { const int st = b / 1024, sb = b % 1024, swz = sb ^ (((sb >> 9) & 1) << 5); R = (st >> 1) * 16 + swz / 64; C = (st & 1) * 32 + (swz % 64) / 2; }
__host__ __device__ __forceinline__ int perm32(int rho) { const int n = rho >> 4, i = rho & 15; return 8 * (i >> 2) + 4 * n + (i & 3); }
struct Unit { int pm, pn; };
struct Gemm { const bf16_t* A; const bf16_t* Bt; int M, N, K, lda; };
struct StaticOrder {
    int nM, nN, nwg, G, c;
    __host__ __device__ void init(int M, int N, int G_, int c_) { nM = M / BM; nN = N / BM; nwg = nM * nN; G = G_; c = c_; }
    __host__ __device__ bool next(int i, Unit& u) const {
        const long L = (long)i * G + c; if (L >= nwg) return false;
        int wgid = (int)L; { const int q = nwg / NXCD, r = nwg % NXCD, xcd = wgid % NXCD, off = wgid / NXCD; wgid = (xcd < r ? xcd * (q + 1) : r * (q + 1) + (xcd - r) * q) + off; }
        const int nig = WGM * nN, gid = wgid / nig, fm = gid * WGM, gsz = (nM - fm) < WGM ? (nM - fm) : WGM;
        u.pm = fm + ((wgid % nig) % gsz); u.pn = (wgid % nig) / gsz; return true;
    }
};
template <class Epi>
__device__ __forceinline__ void gemm_phase(LAS unsigned char* lds, const Gemm g, const StaticOrder& S, const Epi& E) {
    const int tid = threadIdx.x, wid = __builtin_amdgcn_readfirstlane(tid >> 6), lane = tid & 63, wr = wid >> 2, wc = wid & 3, fr = lane & 15, fq = lane >> 4;
    const int K = g.K, nt = K / BK, lda = g.lda;
    unsigned voffA[2], voffB[2];
#pragma unroll
    for (int i = 0; i < 2; ++i) { int R, C; stage_rc(tid * 16 + i * 8192, R, C); const int Rb = Epi::PERM ? ((R & ~31) + perm32(R & 31)) : R;
        voffA[i] = (unsigned)(R * lda + C) * 2u; voffB[i] = (unsigned)(Rb * K + C) * 2u; }
    const size_t kstep = (size_t)(BK * 2);
    const size_t hstepA = (size_t)HALF * lda * 2, hstepB = (size_t)HALF * K * 2;
    const size_t tstepA = 2 * hstepA, tstepB = 2 * hstepB;
    const unsigned ldsw = (unsigned)wid * 1024u;
    const int aoff = lds_byte(wr * 64 + fr, fq * 8), boff = lds_byte(wc * 32 + fr, fq * 8);
#define PG8_SA(b, h) (((b) * 2 + (h)) * HTB)
#define PG8_SB(b, h) ((4 + (b) * 2 + (h)) * HTB)
#define PG8_STAGE(bufoff, gbase, voff) do { _Pragma("unroll") for (int _i = 0; _i < 2; ++_i) \
        __builtin_amdgcn_global_load_lds((const unsigned*)((const char*)(gbase) + (voff)[_i]), (LAS unsigned*)(lds + (bufoff) + ldsw + _i * 8192), 16, 0, 0); } while (0)
#define PG8_LDA(dst, b, h) do { _Pragma("unroll") for (int m = 0; m < 4; ++m) _Pragma("unroll") for (int k = 0; k < 2; ++k) dst[m][k] = *(const LAS bf16x8*)(lds + PG8_SA(b, h) + aoff + m * 2048 + k * 1024); } while (0)
#define PG8_LDB(dst, b, h) do { _Pragma("unroll") for (int n = 0; n < 2; ++n) _Pragma("unroll") for (int k = 0; k < 2; ++k) dst[n][k] = *(const LAS bf16x8*)(lds + PG8_SB(b, h) + boff + n * 2048 + k * 1024); } while (0)
#define PG8_MMA(ai, bj, At, Bt) do { __builtin_amdgcn_s_setprio(1); _Pragma("unroll") for (int m = 0; m < 4; ++m) _Pragma("unroll") for (int n = 0; n < 2; ++n) _Pragma("unroll") for (int k = 0; k < 2; ++k) \
        acc[ai][bj][m][n] = __builtin_amdgcn_mfma_f32_16x16x32_bf16(Bt[n][k], At[m][k], acc[ai][bj][m][n], 0, 0, 0); __builtin_amdgcn_s_setprio(0); } while (0)
#define PG8_WAIT_V(n) asm volatile("s_waitcnt vmcnt(" #n ")" ::: "memory")
#define PG8_WAIT_L(n) asm volatile("s_waitcnt lgkmcnt(" #n ")" ::: "memory")
#define PG8_BAR __builtin_amdgcn_s_barrier()
#define PG8_SCHED __builtin_amdgcn_sched_barrier(0)
    Unit cur, nxt; int ui = 0;
    if (!S.next(0, cur)) return;
    f32x4 acc[2][2][4][2];
#pragma unroll
    for (int a = 0; a < 2; ++a)
#pragma unroll
        for (int b = 0; b < 2; ++b)
#pragma unroll
            for (int m = 0; m < 4; ++m)
#pragma unroll
                for (int n = 0; n < 2; ++n) acc[a][b][m][n] = (f32x4){0.f, 0.f, 0.f, 0.f};
    bf16x8 At[4][2], B0[2][2], B1[2][2];
    const char* cA = (const char*)g.A + (size_t)cur.pm * tstepA; const char* cB = (const char*)g.Bt + (size_t)cur.pn * tstepB;
    PG8_STAGE(PG8_SB(0, 0), cB, voffB); PG8_STAGE(PG8_SA(0, 0), cA, voffA); PG8_STAGE(PG8_SB(0, 1), cB + hstepB, voffB); PG8_STAGE(PG8_SA(0, 1), cA + hstepA, voffA);
    if (wr == 1) PG8_BAR;
    PG8_WAIT_V(4); PG8_BAR;
    PG8_STAGE(PG8_SB(1, 0), cB + kstep, voffB); PG8_STAGE(PG8_SA(1, 0), cA + kstep, voffA); PG8_STAGE(PG8_SB(1, 1), cB + hstepB + kstep, voffB);
    PG8_WAIT_V(6); PG8_BAR;
    for (;;) {
        const bool has_next = S.next(ui + 1, nxt);
        const char* nA = has_next ? (const char*)g.A + (size_t)nxt.pm * tstepA : cA; const char* nB = has_next ? (const char*)g.Bt + (size_t)nxt.pn * tstepB : cB;
        for (int t = 0; t < nt; t += 2) {
            const bool last = (t == nt - 2);
            const char* a1 = cA + (size_t)(t + 1) * kstep;
            const char* a2 = last ? nA : cA + (size_t)(t + 2) * kstep; const char* b2 = last ? nB : cB + (size_t)(t + 2) * kstep;
            const char* a3 = a2 + kstep; const char* b3 = b2 + kstep;
            PG8_LDB(B0, 0, 0); PG8_SCHED; PG8_LDA(At, 0, 0); PG8_STAGE(PG8_SA(1, 1), a1 + hstepA, voffA);
            PG8_WAIT_L(8); PG8_BAR; PG8_WAIT_L(0); PG8_MMA(0, 0, At, B0); PG8_BAR; PG8_SCHED;
            PG8_LDB(B1, 0, 1); PG8_STAGE(PG8_SB(0, 0), b2, voffB);
            PG8_BAR; PG8_WAIT_L(0); PG8_MMA(0, 1, At, B1); PG8_BAR;
            PG8_LDA(At, 0, 1); PG8_STAGE(PG8_SA(0, 0), a2, voffA);
            PG8_BAR; PG8_WAIT_L(0); PG8_MMA(1, 0, At, B0); PG8_BAR; PG8_SCHED;
            PG8_STAGE(PG8_SB(0, 1), b2 + hstepB, voffB);
            PG8_WAIT_V(6); PG8_BAR; PG8_MMA(1, 1, At, B1); PG8_BAR;
            PG8_LDB(B0, 1, 0); PG8_SCHED; PG8_LDA(At, 1, 0); PG8_STAGE(PG8_SA(0, 1), a2 + hstepA, voffA);
            PG8_WAIT_L(8); PG8_BAR; PG8_WAIT_L(0); PG8_MMA(0, 0, At, B0); PG8_BAR; PG8_SCHED;
            PG8_LDB(B1, 1, 1); PG8_STAGE(PG8_SB(1, 0), b3, voffB);
            PG8_BAR; PG8_WAIT_L(0); PG8_MMA(0, 1, At, B1); PG8_BAR;
            PG8_LDA(At, 1, 1); PG8_STAGE(PG8_SA(1, 0), a3, voffA);
            PG8_BAR; PG8_WAIT_L(0); PG8_MMA(1, 0, At, B0); PG8_BAR; PG8_SCHED;
            PG8_STAGE(PG8_SB(1, 1), b3 + hstepB, voffB);
            PG8_WAIT_V(6); PG8_BAR; PG8_MMA(1, 1, At, B1); PG8_BAR;
        }
        E(acc, cur, wr, wc, fr, fq);
        if (!has_next) break;
#pragma unroll
        for (int a = 0; a < 2; ++a)
#pragma unroll
            for (int b = 0; b < 2; ++b)
#pragma unroll
                for (int m = 0; m < 4; ++m)
#pragma unroll
                    for (int n = 0; n < 2; ++n) acc[a][b][m][n] = (f32x4){0.f, 0.f, 0.f, 0.f};
        cur = nxt; cA = nA; cB = nB; ++ui;
    }
    PG8_WAIT_V(0);
    if (wr == 0) PG8_BAR;
    PG8_BAR;
#undef PG8_SA
#undef PG8_SB
#undef PG8_STAGE
#undef PG8_LDA
#undef PG8_LDB
#undef PG8_MMA
#undef PG8_WAIT_V
#undef PG8_WAIT_L
#undef PG8_BAR
#undef PG8_SCHED
}
}

typedef const f32x4 (&AccRef)[2][2][4][2];
struct EpiBf16 {
    static constexpr bool PERM = true;
    bf16_t* O; int ldc;
    __device__ __forceinline__ void operator()(AccRef acc, const pg8::Unit& u, int wr, int wc, int fr, int fq) const {
        const int row0 = u.pm * 256 + wr * 64 + fr, col0 = u.pn * 256 + wc * 32 + 8 * fq;
#pragma unroll
        for (int ai = 0; ai < 2; ++ai)
#pragma unroll
            for (int m = 0; m < 4; ++m) { bf16_t* rowp = O + (size_t)(row0 + ai * 128 + m * 16) * ldc + col0;
#pragma unroll
                for (int bj = 0; bj < 2; ++bj) { const f32x4 v0 = acc[ai][bj][m][0], v1 = acc[ai][bj][m][1];
                    u32x4 w; w.x = pk2(v0[0], v0[1]); w.y = pk2(v0[2], v0[3]); w.z = pk2(v1[0], v1[1]); w.w = pk2(v1[2], v1[3]);
                    *(u32x4*)(rowp + bj * 128) = w; } }
    }
};
struct EpiSwiGLU {
    static constexpr bool PERM = true;
    bf16_t* O; int ldc;
    __device__ __forceinline__ void operator()(AccRef acc, const pg8::Unit& u, int wr, int wc, int fr, int fq) const {
        const int row0 = u.pm * 256 + wr * 64 + fr, col0 = u.pn * 128 + wc * 32 + 8 * fq;
#pragma unroll
        for (int ai = 0; ai < 2; ++ai)
#pragma unroll
            for (int m = 0; m < 4; ++m) { bf16_t* rowp = O + (size_t)(row0 + ai * 128 + m * 16) * ldc + col0;
                float r[8];
#pragma unroll
                for (int n = 0; n < 2; ++n)
#pragma unroll
                    for (int j = 0; j < 4; ++j) { const float a = acc[ai][0][m][n][j], b = acc[ai][1][m][n][j]; r[n * 4 + j] = fsilu(a) * b; }
                u32x4 w; w.x = pk2(r[0], r[1]); w.y = pk2(r[2], r[3]); w.z = pk2(r[4], r[5]); w.w = pk2(r[6], r[7]);
                *(u32x4*)rowp = w; }
    }
};
struct EpiResid {
    static constexpr bool PERM = false;
    const float* base; float* out; const float* gate; float scale;
    __device__ __forceinline__ void operator()(AccRef acc, const pg8::Unit& u, int wr, int wc, int fr, int fq) const {
        const int row0 = u.pm * 256 + wr * 64 + fr, col0 = u.pn * 256 + wc * 32 + 4 * fq;
        const float* gp = gate + (size_t)(u.pm >> 3) * NMOD + col0;
        f32x4 gv[2][2];
#pragma unroll
        for (int bj = 0; bj < 2; ++bj)
#pragma unroll
            for (int n = 0; n < 2; ++n) gv[bj][n] = *(const f32x4*)(gp + bj * 128 + n * 16) * scale;
#pragma unroll
        for (int ai = 0; ai < 2; ++ai)
#pragma unroll
            for (int m = 0; m < 4; ++m) { const size_t off = (size_t)(row0 + ai * 128 + m * 16) * D + col0;
#pragma unroll
                for (int bj = 0; bj < 2; ++bj)
#pragma unroll
                    for (int n = 0; n < 2; ++n) { const f32x4 bs = *(const f32x4*)(base + off + bj * 128 + n * 16);
                        *(f32x4*)(out + off + bj * 128 + n * 16) = bs + gv[bj][n] * acc[ai][bj][m][n]; } }
    }
};
template <bool ACCUM> struct EpiGate {
    static constexpr bool PERM = true;
    const bf16_t* R; bf16_t* O;
    __device__ __forceinline__ void operator()(AccRef acc, const pg8::Unit& u, int wr, int wc, int fr, int fq) const {
        const int row0 = u.pm * 256 + wr * 64 + fr, col0 = u.pn * 256 + wc * 32 + 8 * fq;
#pragma unroll
        for (int ai = 0; ai < 2; ++ai)
#pragma unroll
            for (int m = 0; m < 4; ++m) { const size_t row = (size_t)(row0 + ai * 128 + m * 16);
#pragma unroll
                for (int bj = 0; bj < 2; ++bj) { const u32x4 rw = *(const u32x4*)(R + row * NIN + col0 + bj * 128);
                    bf16_t* op = O + row * D + col0 + bj * 128;
                    const f32x4 v0 = acc[ai][bj][m][0], v1 = acc[ai][bj][m][1];
                    float r[8] = {fsigmoid(bf_lo(rw.x)) * v0[0], fsigmoid(bf_hi(rw.x)) * v0[1], fsigmoid(bf_lo(rw.y)) * v0[2], fsigmoid(bf_hi(rw.y)) * v0[3],
                                  fsigmoid(bf_lo(rw.z)) * v1[0], fsigmoid(bf_hi(rw.z)) * v1[1], fsigmoid(bf_lo(rw.w)) * v1[2], fsigmoid(bf_hi(rw.w)) * v1[3]};
                    if (ACCUM) { const u32x4 pw = *(const u32x4*)op;
                        r[0] += bf_lo(pw.x); r[1] += bf_hi(pw.x); r[2] += bf_lo(pw.y); r[3] += bf_hi(pw.y); r[4] += bf_lo(pw.z); r[5] += bf_hi(pw.z); r[6] += bf_lo(pw.w); r[7] += bf_hi(pw.w); }
                    u32x4 w; w.x = pk2(r[0], r[1]); w.y = pk2(r[2], r[3]); w.z = pk2(r[4], r[5]); w.w = pk2(r[6], r[7]);
                    *(u32x4*)op = w; } }
    }
};
template <class Epi> __device__ __forceinline__ void run_gemm(LAS unsigned char* lds, const bf16_t* A, int lda, const bf16_t* Bt, int N, int K, const Epi& E) {
    pg8::Gemm g{A, Bt, T, N, K, lda}; pg8::StaticOrder S; S.init(T, N, (int)gridDim.x, (int)blockIdx.x);
    pg8::gemm_phase<Epi>(lds, g, S, E);
}

__device__ __forceinline__ void transpose_item(const float* W, int ldw, int s0, int k0, bf16_t* WT, int ldk, int d0, LAS float* scr, int lane) {
#pragma unroll 8
    for (int i = 0; i < 32; ++i) { const int kk = 2 * i + (lane >> 5); scr[kk * 33 + (lane & 31)] = W[(size_t)(k0 + kk) * ldw + s0 + (lane & 31)]; }
    LDS_WAIT();
    const int c = lane & 7;
#pragma unroll
    for (int j = 0; j < 4; ++j) { const int n = (lane >> 3) + 8 * j; const LAS float* s = scr + (8 * c) * 33 + n;
        u32x4 o; o.x = pk2(s[0 * 33], s[1 * 33]); o.y = pk2(s[2 * 33], s[3 * 33]); o.z = pk2(s[4 * 33], s[5 * 33]); o.w = pk2(s[6 * 33], s[7 * 33]);
        *(u32x4*)(WT + (size_t)(d0 + n) * ldk + k0 + 8 * c) = o; }
    LDS_WAIT();
}
__device__ __forceinline__ void ffn_weight_items(const float* w_in, const float* w_out, bf16_t* wt_in, bf16_t* wt_out, LAS float* scr, int gw, int ngw, int lane) {
    for (int it = gw; it < 2816 + 1408; it += ngw) {
        if (it < 2816) { const int kb = it / 176, nb = it % 176, d0 = nb * 32, pn = d0 >> 8, bj = (d0 >> 7) & 1, c = d0 & 127, s0 = bj * FF + pn * 128 + c;
            transpose_item(w_in, 2 * FF, s0, kb * 64, wt_in, D, d0, scr, lane); }
        else { const int r = it - 2816, kb = r / 32, nb = r % 32; transpose_item(w_out, D, nb * 32, kb * 64, wt_out, FF, nb * 32, scr, lane); }
    }
}
__device__ __forceinline__ void mixer_weight_items(const Params& p, LAS float* scr, int gw, int ngw, int lane) {
    unsigned char* ws = p.ws;
    for (int it = gw; it < 2816 + 256 + 256 + 512; it += ngw) {
        int r = it;
        if (r < 2816) { const int kb = r / 176, nb = r % 176, d0 = nb * 32, s0 = d0 < C_RSB ? d0 : d0 + 8; transpose_item(p.in[I_WIN], INW, s0, kb * 64, (bf16_t*)(ws + W_IN), D, d0, scr, lane); continue; } r -= 2816;
        if (r < 256) { const int kb = r / 32, nb = r % 32; transpose_item(p.in[I_WUPSB], D, nb * 32, kb * 64, (bf16_t*)(ws + W_UPSB), 512, nb * 32, scr, lane); continue; } r -= 256;
        if (r < 256) { const int kb = r / 32, nb = r % 32; transpose_item(p.in[I_WUPDN], D, nb * 32, kb * 64, (bf16_t*)(ws + W_UPDN), 512, nb * 32, scr, lane); continue; } r -= 256;
        { const int kb = r / 32, nb = r % 32; transpose_item(p.in[I_WOUT], D, nb * 32, kb * 64, (bf16_t*)(ws + W_OUT), D, nb * 32, scr, lane); }
    }
}
__device__ __forceinline__ void mod_item(const Params& p, LAS unsigned char* lds, int cb, int tid, int wave, int lane) {
    LAS float* sc = (LAS float*)lds; LAS float* red = (LAS float*)(lds + 32768);
    for (int i = tid; i < NB * D; i += 512) sc[i] = fsilu(p.in[I_C][i]);
    __syncthreads();
    const float* wa = p.in[I_WADA] + cb * 64 + lane;
    float acc[NB];
#pragma unroll
    for (int b = 0; b < NB; ++b) acc[b] = 0.f;
    for (int k = wave * 128; k < wave * 128 + 128; k += 4) {
        float w[4];
#pragma unroll
        for (int e = 0; e < 4; ++e) w[e] = wa[(size_t)(k + e) * NMOD];
#pragma unroll
        for (int b = 0; b < NB; ++b) { const f32x4 s = *(const LAS f32x4*)(sc + b * D + k); acc[b] += s[0] * w[0] + s[1] * w[1] + s[2] * w[2] + s[3] * w[3]; }
    }
#pragma unroll
    for (int b = 0; b < NB; ++b) red[(wave * NB + b) * 64 + lane] = acc[b];
    __syncthreads();
    { const int b = tid >> 6; float s = p.in[I_BADA][cb * 64 + lane];
#pragma unroll
        for (int w = 0; w < 8; ++w) s += red[(w * NB + b) * 64 + lane];
        ((float*)(p.ws + WS_MOD))[b * NMOD + cb * 64 + lane] = s; }
    __syncthreads();
}

template <bool DN>
__device__ __forceinline__ void norm_mod_phase(const Params& p, LAS unsigned char* lds, const float* src, const float* gain, int midx, bf16_t* dst, int tid, int wave, int lane) {
    const float* mod = (const float*)(p.ws + WS_MOD);
    LAS float* wl = (LAS float*)lds;
    if (DN) { for (int i = tid; i < D * 8; i += 512) { const int k = i >> 3, j = i & 7; wl[8 * k + 4 * (k >> 2) + j] = p.in[I_WIN][(size_t)k * INW + C_RSB + j]; } __syncthreads(); }
    f32x4 g4[4];
#pragma unroll
    for (int j = 0; j < 4; ++j) g4[j] = ((const f32x4*)gain)[lane + 64 * j];
    for (int row = blockIdx.x * 8 + wave; row < T; row += gridDim.x * 8) {
        const int b = row >> 11;
        const f32x4* xr = (const f32x4*)(src + (size_t)row * D) + lane;
        const f32x4* shp = (const f32x4*)(mod + (size_t)b * NMOD + midx * D) + lane; const f32x4* scp = shp + D / 4;
        f32x4 v[4]; float ss = 0.f;
#pragma unroll
        for (int j = 0; j < 4; ++j) { v[j] = xr[64 * j]; ss += (v[j][0] * v[j][0] + v[j][1] * v[j][1]) + (v[j][2] * v[j][2] + v[j][3] * v[j][3]); }
        const float rstd = 1.0f / sqrtf(wave_sum(ss) * (1.f / D) + EPS);
        u32x2* o8 = (u32x2*)(dst + (size_t)row * D) + lane;
        float dot[8];
        if (DN) {
#pragma unroll
            for (int e = 0; e < 8; ++e) dot[e] = 0.f; }
#pragma unroll
        for (int j = 0; j < 4; ++j) { const f32x4 sh = shp[64 * j], sc = scp[64 * j];
            const f32x4 uu = v[j] * rstd * g4[j] * (sc + 1.0f) + sh;
            u32x2 w; w.x = pk2(uu[0], uu[1]); w.y = pk2(uu[2], uu[3]); o8[64 * j] = w;
            if (DN) {
#pragma unroll
                for (int e = 0; e < 4; ++e) { const int k = 4 * lane + 256 * j + e; const LAS f32x4* wp = (const LAS f32x4*)(wl + 8 * k + 4 * (k >> 2)); const f32x4 w0 = wp[0], w1 = wp[1];
                    dot[0] += uu[e] * w0[0]; dot[1] += uu[e] * w0[1]; dot[2] += uu[e] * w0[2]; dot[3] += uu[e] * w0[3];
                    dot[4] += uu[e] * w1[0]; dot[5] += uu[e] * w1[1]; dot[6] += uu[e] * w1[2]; dot[7] += uu[e] * w1[3]; } } }
        if (DN) {
#pragma unroll
            for (int e = 0; e < 8; ++e) dot[e] = wave_sum(dot[e]);
            float mine = dot[0];
#pragma unroll
            for (int e = 1; e < 8; ++e) mine = (lane == e) ? dot[e] : mine;
            if (lane < 8) { float r;
                if (lane < 4) r = 1.0f / (1.0f + expf(-mine));
                else { const int hh = lane - 4; const float a = mine + p.in[I_DTBIAS][hh]; const float sp = a > 20.f ? a : log1pf(expf(a)); r = -expf(p.in[I_ALOG][hh]) * sp; }
                ((float*)(p.ws + WS_BG))[(size_t)row * 8 + lane] = r; } }
    }
    if (DN) __syncthreads();
}

__device__ __forceinline__ void unpack16(const bf16_t* p, float* f) {
    const u32x4 a = ((const u32x4*)p)[0], b = ((const u32x4*)p)[1];
    f[0] = bf_lo(a.x); f[1] = bf_hi(a.x); f[2] = bf_lo(a.y); f[3] = bf_hi(a.y); f[4] = bf_lo(a.z); f[5] = bf_hi(a.z); f[6] = bf_lo(a.w); f[7] = bf_hi(a.w);
    f[8] = bf_lo(b.x); f[9] = bf_hi(b.x); f[10] = bf_lo(b.y); f[11] = bf_hi(b.y); f[12] = bf_lo(b.z); f[13] = bf_hi(b.z); f[14] = bf_lo(b.w); f[15] = bf_hi(b.w);
}
__device__ __forceinline__ void pack16(bf16_t* p, const float* f) {
    u32x4 a, b; a.x = pk2(f[0], f[1]); a.y = pk2(f[2], f[3]); a.z = pk2(f[4], f[5]); a.w = pk2(f[6], f[7]); b.x = pk2(f[8], f[9]); b.y = pk2(f[10], f[11]); b.z = pk2(f[12], f[13]); b.w = pk2(f[14], f[15]);
    ((u32x4*)p)[0] = a; ((u32x4*)p)[1] = b;
}
__device__ __forceinline__ void prep_phase(const Params& p, int wave, int lane) {
    bf16_t* P = (bf16_t*)(p.ws + WS_P); bf16_t* U = (bf16_t*)(p.ws + WS_U);
    const int ch = 16 * lane;
    float gsb[16], wcv[4][16];
    { const float* gp = (ch < 512 ? p.in[I_GQSB] : p.in[I_GKSB]) + (ch & 63); const float sc = ch < 512 ? 0.125f : 1.0f;
#pragma unroll
        for (int e = 0; e < 16; ++e) gsb[e] = gp[e] * sc;
#pragma unroll
        for (int i = 0; i < 4; ++i)
#pragma unroll
            for (int e = 0; e < 16; ++e) wcv[i][e] = p.in[I_WCONV][i * 1536 + ch + e]; }
    for (int row = blockIdx.x * 8 + wave; row < T; row += gridDim.x * 8) {
        const int tl = row & (SEQ - 1);
        { bf16_t* qp = P + (size_t)row * NIN + ch; float f[16]; unpack16(qp, f); float ss = 0.f;
#pragma unroll
            for (int e = 0; e < 16; ++e) ss += f[e] * f[e];
            ss += __shfl_xor(ss, 1); ss += __shfl_xor(ss, 2);
            const float rstd = 1.0f / sqrtf(ss * (1.f / 64.f) + EPS);
#pragma unroll
            for (int e = 0; e < 16; ++e) f[e] = f[e] * rstd * gsb[e];
            pack16(qp, f); }
        { float y[16];
#pragma unroll
            for (int e = 0; e < 16; ++e) y[e] = 0.f;
#pragma unroll
            for (int i = 0; i < 4; ++i) { if (tl - 3 + i >= 0) { float f[16]; unpack16(P + (size_t)(row - 3 + i) * NIN + C_QDN + ch, f);
#pragma unroll
                    for (int e = 0; e < 16; ++e) y[e] += wcv[i][e] * f[e]; } }
            float ss = 0.f;
#pragma unroll
            for (int e = 0; e < 16; ++e) { y[e] = fsilu(y[e]); ss += y[e] * y[e]; }
            ss += __shfl_xor(ss, 1); ss += __shfl_xor(ss, 2); ss += __shfl_xor(ss, 4);
            const float sc = (1.0f / sqrtf(ss + EPS)) * (ch < 512 ? 0.08838834764831845f : 1.0f);
#pragma unroll
            for (int e = 0; e < 16; ++e) y[e] *= sc;
            pack16(U + (size_t)row * D + ch, y); }
    }
    bf16_t* Vt = (bf16_t*)(p.ws + WS_VT);
    for (int it = blockIdx.x * 8 + wave; it < T / 16; it += gridDim.x * 8) {
        const int row0 = it * 16, b = row0 >> 11, tl0 = row0 & (SEQ - 1), c8 = lane * 8, hd = c8 >> 6, d0 = c8 & 63;
        u32x4 w[16];
#pragma unroll
        for (int r = 0; r < 16; ++r) w[r] = *(const u32x4*)(P + (size_t)(row0 + r) * NIN + C_VSB + c8);
#pragma unroll
        for (int e = 0; e < 8; ++e) {
            unsigned o[8];
#pragma unroll
            for (int i = 0; i < 8; ++i) {
                const int p0 = 2 * i, p1 = 2 * i + 1;
                const int k0 = 8 * ((p0 >> 2) & 1) + 4 * (p0 >> 3) + (p0 & 3), k1 = 8 * ((p1 >> 2) & 1) + 4 * (p1 >> 3) + (p1 & 3);
                const unsigned a0 = w[k0][e >> 1], a1 = w[k1][e >> 1];
                const unsigned lo = (e & 1) ? (a0 >> 16) : (a0 & 0xffffu), hi = (e & 1) ? (a1 & 0xffff0000u) : (a1 << 16);
                o[i] = lo | hi; }
            bf16_t* dst = Vt + ((size_t)(b * 8 + hd) * 64 + d0 + e) * SEQ + tl0;
            ((u32x4*)dst)[0] = (u32x4){o[0], o[1], o[2], o[3]}; ((u32x4*)dst)[1] = (u32x4){o[4], o[5], o[6], o[7]}; }
    }
}

__device__ __forceinline__ void attn_item_mfma(bf16_t* P, const bf16_t* Vt, int bh, int qt, int lane) {
    const int b = bh >> 3, h = bh & 7, ql = lane & 31, hh = lane >> 5, q0 = qt * 32;
    bf16_t* qrow = P + (size_t)(b * SEQ + q0 + ql) * NIN + C_QSB + h * 64;
    bf16x8 qf[4];
#pragma unroll
    for (int s = 0; s < 4; ++s) qf[s] = *(const bf16x8*)(qrow + 16 * s + 8 * hh);
    f32x16 o0, o1;
#pragma unroll
    for (int i = 0; i < 16; ++i) { o0[i] = 0.f; o1[i] = 0.f; }
    float R = 1.0f;
    const bf16_t* kb = P + (size_t)(b * SEQ + ql) * NIN + C_KSB + h * 64 + 8 * hh;
    const bf16_t* vb = Vt + ((size_t)bh * 64 + ql) * SEQ + 8 * hh;
    bf16x8 kf[4], vf[4];
#pragma unroll
    for (int s = 0; s < 4; ++s) kf[s] = *(const bf16x8*)(kb + (size_t)q0 * NIN + 16 * s);
#pragma unroll
    for (int j = 0; j < 4; ++j) vf[j] = *(const bf16x8*)(vb + (size_t)(j >> 1) * 32 * SEQ + q0 + 16 * (j & 1));
#pragma unroll 1
    for (int kt = qt; kt >= 0; --kt) {
        f32x16 z;
#pragma unroll
        for (int i = 0; i < 16; ++i) z[i] = 0.f;
#pragma unroll
        for (int s = 0; s < 4; ++s) z = __builtin_amdgcn_mfma_f32_32x32x16_bf16(kf[s], qf[s], z, 0, 0, 0);
        bf16x8 vc[4];
#pragma unroll
        for (int j = 0; j < 4; ++j) vc[j] = vf[j];
        { const int kn = (kt > 0 ? kt - 1 : 0) * 32;
#pragma unroll
            for (int s = 0; s < 4; ++s) kf[s] = *(const bf16x8*)(kb + (size_t)kn * NIN + 16 * s);
#pragma unroll
            for (int j = 0; j < 4; ++j) vf[j] = *(const bf16x8*)(vb + (size_t)(j >> 1) * 32 * SEQ + kn + 16 * (j & 1)); }
        float sg[16], m[16];
        const bool diag = (kt == qt);
#pragma unroll
        for (int i = 0; i < 16; ++i) { const float zz = z[i]; const float e = __builtin_amdgcn_exp2f(-1.4426950408889634f * fabsf(zz)); const float r = __builtin_amdgcn_rcpf(1.0f + e); const float er = e * r;
            float sig = zz >= 0.f ? r : er, mm = zz >= 0.f ? er : r;
            if (diag) { const bool act = ((i & 3) + 8 * (i >> 2) + 4 * hh) < ql; sig = act ? sig : 0.f; mm = act ? mm : 1.0f; }
            sg[i] = sig; m[i] = mm; }
        float g[4], gp[4];
#pragma unroll
        for (int bq = 0; bq < 4; ++bq) { g[bq] = (m[4 * bq] * m[4 * bq + 1]) * (m[4 * bq + 2] * m[4 * bq + 3]); gp[bq] = __shfl_xor(g[bq], 32); }
        float outer[4]; float tb = R;
#pragma unroll
        for (int bq = 3; bq >= 0; --bq) { outer[bq] = tb * (hh == 0 ? gp[bq] : 1.0f); tb *= g[bq] * gp[bq]; }
        R = tb;
        float w[16];
#pragma unroll
        for (int bq = 0; bq < 4; ++bq) { const float s3 = outer[bq], s2 = s3 * m[4 * bq + 3], s1 = s2 * m[4 * bq + 2], s0 = s1 * m[4 * bq + 1];
            w[4 * bq + 3] = sg[4 * bq + 3] * s3; w[4 * bq + 2] = sg[4 * bq + 2] * s2; w[4 * bq + 1] = sg[4 * bq + 1] * s1; w[4 * bq] = sg[4 * bq] * s0; }
        bf16x8 wf[2];
#pragma unroll
        for (int s2 = 0; s2 < 2; ++s2) { const u32x4 pw = {cpk2(w[8 * s2], w[8 * s2 + 1]), cpk2(w[8 * s2 + 2], w[8 * s2 + 3]), cpk2(w[8 * s2 + 4], w[8 * s2 + 5]), cpk2(w[8 * s2 + 6], w[8 * s2 + 7])}; wf[s2] = __builtin_bit_cast(bf16x8, pw); }
        o0 = __builtin_amdgcn_mfma_f32_32x32x16_bf16(vc[0], wf[0], o0, 0, 0, 0); o0 = __builtin_amdgcn_mfma_f32_32x32x16_bf16(vc[1], wf[1], o0, 0, 0, 0);
        o1 = __builtin_amdgcn_mfma_f32_32x32x16_bf16(vc[2], wf[0], o1, 0, 0, 0); o1 = __builtin_amdgcn_mfma_f32_32x32x16_bf16(vc[3], wf[1], o1, 0, 0, 0);
    }
#pragma unroll
    for (int bq = 0; bq < 4; ++bq) {
        u32x2 w0 = {cpk2(o0[4 * bq], o0[4 * bq + 1]), cpk2(o0[4 * bq + 2], o0[4 * bq + 3])}, w1 = {cpk2(o1[4 * bq], o1[4 * bq + 1]), cpk2(o1[4 * bq + 2], o1[4 * bq + 3])};
        *(u32x2*)(qrow + 8 * bq + 4 * hh) = w0; *(u32x2*)(qrow + 32 + 8 * bq + 4 * hh) = w1; }
}
__device__ __forceinline__ void gdn_item_naive(const Params& p, int bh, int part, int lane) {
    bf16_t* P = (bf16_t*)(p.ws + WS_P); const bf16_t* U = (const bf16_t*)(p.ws + WS_U); const float* BG = (const float*)(p.ws + WS_BG);
    const int b = bh >> 2, h = bh & 3, c = part * 16 + (lane >> 2), dq = lane & 3;
    float S[32];
#pragma unroll
    for (int d = 0; d < 32; ++d) S[d] = 0.f;
    float wc[4];
#pragma unroll
    for (int i = 0; i < 4; ++i) wc[i] = p.in[I_WCONV][i * 1536 + 1024 + h * 128 + c];
    float x1 = 0.f, x2 = 0.f, x3 = 0.f;
    const size_t rowb = (size_t)b * SEQ;
    bf16_t* vbase = P + rowb * NIN + C_VDN + h * 128 + c;
    const bf16_t* qbase = U + rowb * D + h * 128 + dq * 32; const bf16_t* kbase = qbase + 512;
    u32x4 nk[4], nq[4]; float nx0 = bf2f(*vbase), nbeta = BG[rowb * 8 + h], ng = BG[rowb * 8 + 4 + h];
#pragma unroll
    for (int i = 0; i < 4; ++i) { nk[i] = ((const u32x4*)kbase)[i]; nq[i] = ((const u32x4*)qbase)[i]; }
#pragma unroll 1
    for (int t = 0; t < SEQ; ++t) {
        bf16_t* vp = vbase + (size_t)t * NIN;
        const float x0 = nx0, beta = nbeta, eg = fexp(ng);
        u32x4 ck[4], cq[4];
#pragma unroll
        for (int i = 0; i < 4; ++i) { ck[i] = nk[i]; cq[i] = nq[i]; }
        { const int tn = t + 1 < SEQ ? t + 1 : t; const size_t rn = rowb + tn;
            nx0 = bf2f(vbase[(size_t)tn * NIN]); nbeta = BG[rn * 8 + h]; ng = BG[rn * 8 + 4 + h];
#pragma unroll
            for (int i = 0; i < 4; ++i) { nk[i] = ((const u32x4*)(kbase + (size_t)tn * D))[i]; nq[i] = ((const u32x4*)(qbase + (size_t)tn * D))[i]; } }
        const float vc = wc[3] * x0 + wc[2] * x1 + wc[1] * x2 + wc[0] * x3; x3 = x2; x2 = x1; x1 = x0;
        const float v = fsilu(vc);
        float kk[32], qq[32];
#pragma unroll
        for (int i = 0; i < 4; ++i) { const u32x4 w = ck[i], qw = cq[i];
            kk[8 * i] = bf_lo(w.x); kk[8 * i + 1] = bf_hi(w.x); kk[8 * i + 2] = bf_lo(w.y); kk[8 * i + 3] = bf_hi(w.y); kk[8 * i + 4] = bf_lo(w.z); kk[8 * i + 5] = bf_hi(w.z); kk[8 * i + 6] = bf_lo(w.w); kk[8 * i + 7] = bf_hi(w.w);
            qq[8 * i] = bf_lo(qw.x); qq[8 * i + 1] = bf_hi(qw.x); qq[8 * i + 2] = bf_lo(qw.y); qq[8 * i + 3] = bf_hi(qw.y); qq[8 * i + 4] = bf_lo(qw.z); qq[8 * i + 5] = bf_hi(qw.z); qq[8 * i + 6] = bf_lo(qw.w); qq[8 * i + 7] = bf_hi(qw.w); }
        float kS = 0.f;
#pragma unroll
        for (int d = 0; d < 32; ++d) kS += kk[d] * S[d];
        kS += __builtin_bit_cast(float, __builtin_amdgcn_mov_dpp(__builtin_bit_cast(int, kS), 0xB1, 0xF, 0xF, true)); kS += __builtin_bit_cast(float, __builtin_amdgcn_mov_dpp(__builtin_bit_cast(int, kS), 0x4E, 0xF, 0xF, true));
        const float vn = beta * (v - eg * kS);
        float o = 0.f;
#pragma unroll
        for (int d = 0; d < 32; ++d) { S[d] = eg * S[d] + kk[d] * vn; o += qq[d] * S[d]; }
        o += __builtin_bit_cast(float, __builtin_amdgcn_mov_dpp(__builtin_bit_cast(int, o), 0xB1, 0xF, 0xF, true)); o += __builtin_bit_cast(float, __builtin_amdgcn_mov_dpp(__builtin_bit_cast(int, o), 0x4E, 0xF, 0xF, true));
        if (dq == 0) *vp = f2bf(o);
    }
}
__device__ __forceinline__ void gdn_finalize_phase(const Params& p, int wave, int lane) {
    bf16_t* P = (bf16_t*)(p.ws + WS_P);
    const int c0 = (lane & 15) * 8;
    float gg[8];
#pragma unroll
    for (int e = 0; e < 8; ++e) gg[e] = p.in[I_GDNOUT][c0 + e];
    for (int row = blockIdx.x * 8 + wave; row < T; row += gridDim.x * 8) {
        bf16_t* op = P + (size_t)row * NIN + C_VDN + lane * 8; const bf16_t* zp = P + (size_t)row * NIN + C_ZDN + lane * 8;
        const u32x4 ow = *(const u32x4*)op, zw = *(const u32x4*)zp;
        const float o[8] = {bf_lo(ow.x), bf_hi(ow.x), bf_lo(ow.y), bf_hi(ow.y), bf_lo(ow.z), bf_hi(ow.z), bf_lo(ow.w), bf_hi(ow.w)};
        const float z[8] = {bf_lo(zw.x), bf_hi(zw.x), bf_lo(zw.y), bf_hi(zw.y), bf_lo(zw.z), bf_hi(zw.z), bf_lo(zw.w), bf_hi(zw.w)};
        float ss = 0.f;
#pragma unroll
        for (int e = 0; e < 8; ++e) ss += o[e] * o[e];
        ss += __shfl_xor(ss, 1); ss += __shfl_xor(ss, 2); ss += __shfl_xor(ss, 4); ss += __shfl_xor(ss, 8);
        const float rstd = 1.0f / sqrtf(ss * (1.f / 128.f) + EPS);
        float r[8];
#pragma unroll
        for (int e = 0; e < 8; ++e) r[e] = o[e] * rstd * gg[e] * fsilu(z[e]);
        u32x4 w; w.x = pk2(r[0], r[1]); w.y = pk2(r[2], r[3]); w.z = pk2(r[4], r[5]); w.w = pk2(r[6], r[7]);
        *(u32x4*)op = w;
    }
}

#ifndef PHMASK
#define PHMASK 0xFFFF
#endif
#define PH(n) ((PHMASK >> (n)) & 1)
__global__ void __launch_bounds__(512, 2) fwd_megakernel(Params p) {
    extern __shared__ __attribute__((aligned(16))) unsigned char lds_raw[];
    LAS unsigned char* lds = (LAS unsigned char*)lds_raw;
    cg::grid_group grid = cg::this_grid();
    const int tid = threadIdx.x, lane = tid & 63, wave = __builtin_amdgcn_readfirstlane(tid >> 6);
    const int G = gridDim.x, gw = wave * G + blockIdx.x, ngw = G * 8;
    unsigned char* ws = p.ws;
    bf16_t* U = (bf16_t*)(ws + WS_U); bf16_t* P = (bf16_t*)(ws + WS_P);
    const float* mod = (const float*)(ws + WS_MOD);
    LAS float* scr = (LAS float*)(lds + wave * 16384);

    if (PH(0)) for (int it = blockIdx.x; it < NMOD / 64; it += G) mod_item(p, lds, it, tid, wave, lane);
    if (PH(0)) ffn_weight_items(p.in[I_WFFN1IN], p.in[I_WFFN1OUT], (bf16_t*)(ws + W_FFIN), (bf16_t*)(ws + W_FFOUT), scr, gw, ngw, lane);
    if (PH(0)) mixer_weight_items(p, scr, gw, ngw, lane);
    grid.sync();
    if (PH(1)) norm_mod_phase<false>(p, lds, p.in[I_X], p.in[I_GFFN1], 0, U, tid, wave, lane);
    grid.sync();
    if (PH(2)) run_gemm(lds, U, D, (const bf16_t*)(ws + W_FFIN), 2 * FF, D, EpiSwiGLU{P, FF});
    grid.sync();
    if (PH(3)) run_gemm(lds, P, FF, (const bf16_t*)(ws + W_FFOUT), D, FF, EpiResid{p.in[I_X], p.out, mod + 2 * D, 0.5f});
    grid.sync();
    if (PH(4)) norm_mod_phase<true>(p, lds, p.out, p.in[I_GMIX], 3, U, tid, wave, lane);
    grid.sync();
    if (PH(5)) run_gemm(lds, U, D, (const bf16_t*)(ws + W_IN), NIN, D, EpiBf16{P, NIN});
    grid.sync();
    if (PH(6)) prep_phase(p, wave, lane);
    grid.sync();
    for (int it = gw; it < 256 + 2048; it += ngw) {
        if (it < 256) { if (PH(7)) gdn_item_naive(p, it >> 3, it & 7, lane); }
        else if (PH(8)) { const int a = it - 256, abh = a >> 5, pr = a & 31; attn_item_mfma(P, (const bf16_t*)(ws + WS_VT), abh, 63 - pr, lane); attn_item_mfma(P, (const bf16_t*)(ws + WS_VT), abh, pr, lane); }
    }
    grid.sync();
    if (PH(9)) gdn_finalize_phase(p, wave, lane);
    grid.sync();
    if (PH(10)) run_gemm(lds, P + C_QSB, NIN, (const bf16_t*)(ws + W_UPSB), D, 512, EpiGate<false>{P + C_RSB, U});
    if (PH(10)) run_gemm(lds, P + C_VDN, NIN, (const bf16_t*)(ws + W_UPDN), D, 512, EpiGate<true>{P + C_RDN, U});
    grid.sync();
    if (PH(11)) run_gemm(lds, U, D, (const bf16_t*)(ws + W_OUT), D, D, EpiResid{p.out, p.out, mod + 5 * D, 1.0f});
    grid.sync();
    if (PH(12)) norm_mod_phase<false>(p, lds, p.out, p.in[I_GFFN2], 6, U, tid, wave, lane);
    __syncthreads();
    if (PH(12)) ffn_weight_items(p.in[I_WFFN2IN], p.in[I_WFFN2OUT], (bf16_t*)(ws + W_FFIN), (bf16_t*)(ws + W_FFOUT), scr, gw, ngw, lane);
    grid.sync();
    if (PH(13)) run_gemm(lds, U, D, (const bf16_t*)(ws + W_FFIN), 2 * FF, D, EpiSwiGLU{P, FF});
    grid.sync();
    if (PH(14)) run_gemm(lds, P, FF, (const bf16_t*)(ws + W_FFOUT), D, FF, EpiResid{p.out, p.out, mod + 8 * D, 0.5f});
}

extern "C" void kernel_launch(void* const* d_in, const int* in_sizes, int n_in, void* d_out, int out_size, void* d_ws, size_t ws_size, hipStream_t stream) {
    static int grid_blocks = 0;
    if (!grid_blocks) {
        int dev = 0, cus = 0, per_cu = 0;
        (void)hipGetDevice(&dev);
        (void)hipDeviceGetAttribute(&cus, hipDeviceAttributeMultiprocessorCount, dev);
        (void)hipFuncSetAttribute((const void*)fwd_megakernel, hipFuncAttributeMaxDynamicSharedMemorySize, LDS_BYTES);
        (void)hipOccupancyMaxActiveBlocksPerMultiprocessor(&per_cu, (const void*)fwd_megakernel, 512, LDS_BYTES);
        if (per_cu < 1) { fprintf(stderr, "occupancy query says %d blocks/CU\n", per_cu); per_cu = 1; }
        grid_blocks = cus;
    }
    Params p{};
    for (int i = 0; i < N_IN; ++i) p.in[i] = (const float*)d_in[i];
    p.out = (float*)d_out; p.ws = (unsigned char*)d_ws;
    void* args[] = {&p};
    hipError_t e = hipLaunchCooperativeKernel((const void*)fwd_megakernel, dim3(grid_blocks), dim3(512), args, LDS_BYTES, stream);
    if (e != hipSuccess) fprintf(stderr, "cooperative launch failed: %s (grid %d)\n", hipGetErrorString(e), grid_blocks);
}
```

```cpp
#include <hip/hip_runtime.h>
#include <hip/hip_cooperative_groups.h>
#include <cstdio>
namespace cg = cooperative_groups;

#define LAS __attribute__((address_space(3)))
typedef unsigned short bf16_t;
typedef short bf16x8 __attribute__((ext_vector_type(8)));
typedef float f32x4 __attribute__((ext_vector_type(4)));
typedef unsigned u32x4 __attribute__((ext_vector_type(4)));
typedef unsigned u32x2 __attribute__((ext_vector_type(2)));
typedef float f32x16 __attribute__((ext_vector_type(16)));
typedef float f32x2 __attribute__((ext_vector_type(2)));
typedef __bf16 nbf16x2 __attribute__((ext_vector_type(2)));

constexpr int T = 16384, D = 1024, SEQ = 2048, NB = 8, FF = 2816, NIN = 5632, INW = 5640, NMOD = 9216;
constexpr int C_QSB = 0, C_KSB = 512, C_VSB = 1024, C_QDN = 1536, C_KDN = 2048, C_VDN = 2560, C_ZDN = 3072, C_RSB = 3584, C_RDN = 4608;
constexpr float EPS = 1e-6f;
constexpr int LDS_BYTES = 131072;
constexpr size_t MiB = 1024 * 1024;
constexpr size_t WS_MOD = 0, WS_BG = 512 * 1024, WS_SS = 242 * MiB, WS_W = 2 * MiB;
constexpr size_t W_FFIN = WS_W, W_FFOUT = W_FFIN + (size_t)2 * FF * D * 2, W_IN = W_FFOUT + (size_t)D * FF * 2, W_UPSB = W_IN + (size_t)NIN * D * 2,
                 W_UPDN = W_UPSB + (size_t)D * 512 * 2, W_OUT = W_UPDN + (size_t)D * 512 * 2, W_END = W_OUT + (size_t)D * D * 2;
constexpr size_t WS_U = 34 * MiB, WS_P = 66 * MiB;
static_assert(W_END <= WS_U, "weights overflow");
constexpr size_t WS_EGL = 384 * 1024, WS_CTR = 400 * 1024;
constexpr size_t WS_VT = W_FFIN;
static_assert((size_t)T * 512 * 2 <= W_IN - W_FFIN, "Vt overflow");

enum { I_X = 0, I_C, I_WADA, I_BADA, I_GFFN1, I_WFFN1IN, I_WFFN1OUT, I_GMIX, I_WIN, I_GQSB, I_GKSB, I_WCONV, I_ALOG, I_DTBIAS, I_GDNOUT, I_WUPSB, I_WUPDN, I_WOUT, I_GFFN2, I_WFFN2IN, I_WFFN2OUT, N_IN };
struct Params { const float* in[N_IN]; float* out; unsigned char* ws; };

__device__ __forceinline__ float bf_lo(unsigned w) { return __uint_as_float(w << 16); }
__device__ __forceinline__ float bf_hi(unsigned w) { return __uint_as_float(w & 0xffff0000u); }
__device__ __forceinline__ float bf2f(bf16_t b) { return __uint_as_float(((unsigned)b) << 16); }
__device__ __forceinline__ unsigned pk2(float lo, float hi) { unsigned r; asm("v_cvt_pk_bf16_f32 %0, %1, %2" : "=v"(r) : "v"(lo), "v"(hi)); return r; }
__device__ __forceinline__ unsigned cpk2(float lo, float hi) { const f32x2 v = {lo, hi}; return __builtin_bit_cast(unsigned, __builtin_convertvector(v, nbf16x2)); }
__device__ __forceinline__ bf16_t f2bf(float f) { return (bf16_t)(pk2(f, 0.f) & 0xffffu); }
__device__ __forceinline__ float fexp(float x) { return __builtin_amdgcn_exp2f(x * 1.4426950408889634f); }
__device__ __forceinline__ float flog(float x) { return __builtin_amdgcn_logf(x) * 0.6931471805599453f; }
__device__ __forceinline__ float fsigmoid(float x) { return __builtin_amdgcn_rcpf(1.f + fexp(-x)); }
__device__ __forceinline__ float fsilu(float x) { return x * fsigmoid(x); }
__device__ __forceinline__ float fsoftplus(float x) { return fmaxf(x, 0.f) + flog(1.f + fexp(-fabsf(x))); }
__device__ __forceinline__ float wave_sum(float v) {
#pragma unroll
    for (int o = 1; o < 64; o <<= 1) v += __shfl_xor(v, o);
    return v;
}
#define LDS_WAIT() asm volatile("s_waitcnt lgkmcnt(0)" ::: "memory")

namespace pg8 {
constexpr int BM = 256, BK = 64, HALF = 128, HTB = HALF * BK * 2, STAGE_BYTES = 8 * HTB, NXCD = 8, WGM = 8;
__host__ __device__ __forceinline__ int lds_byte(int r, int c) { const int st = (r >> 4) * 2 + (c >> 5), rr = r & 15, cc = c & 31, ob = rr * 64 + cc * 2; return st * 1024 + (ob ^ (((ob >> 9) & 1) << 5)); }
__host__ __device__ __forceinline__ void stage_rc(int b, int& R, int& C) { const int st = b / 1024, sb = b % 1024, swz = sb ^ (((sb >> 9) & 1) << 5); R = (st >> 1) * 16 + swz / 64; C = (st & 1) * 32 + (swz % 64) / 2; }
__host__ __device__ __forceinline__ int perm32(int rho) { const int n = rho >> 4, i = rho & 15; return 8 * (i >> 2) + 4 * n + (i & 3); }
struct Unit { int pm, pn; };
struct Gemm { const bf16_t* A; const bf16_t* Bt; int M, N, K, lda; };
struct StaticOrder {
    int nM, nN, nwg, G, c;
    __host__ __device__ void init(int M, int N, int G_, int c_) { nM = M / BM; nN = N / BM; nwg = nM * nN; G = G_; c = c_; }
    __host__ __device__ bool next(int i, Unit& u) const {
        const long L = (long)i * G + c; if (L >= nwg) return false;
        int wgid = (int)L; { const int q = nwg / NXCD, r = nwg % NXCD, xcd = wgid % NXCD, off = wgid / NXCD; wgid = (xcd < r ? xcd * (q + 1) : r * (q + 1) + (xcd - r) * q) + off; }
        const int nig = WGM * nN, gid = wgid / nig, fm = gid * WGM, gsz = (nM - fm) < WGM ? (nM - fm) : WGM;
        u.pm = fm + ((wgid % nig) % gsz); u.pn = (wgid % nig) / gsz; return true;
    }
};
template <class Epi>
__device__ __forceinline__ void gemm_phase(LAS unsigned char* lds, const Gemm g, const StaticOrder& S, const Epi& E) {
    int tid = threadIdx.x; asm volatile("" : "+v"(tid));
    const int wid = __builtin_amdgcn_readfirstlane(tid >> 6), lane = tid & 63, wr = wid >> 2, wc = wid & 3, fr = lane & 15, fq = lane >> 4;
    const int K = g.K, nt = K / BK, lda = g.lda;
    unsigned voffA[2], voffB[2];
#pragma unroll
    for (int i = 0; i < 2; ++i) { int R, C; stage_rc(tid * 16 + i * 8192, R, C); const int Rb = Epi::PERM ? ((R & ~31) + perm32(R & 31)) : R;
        voffA[i] = (unsigned)(R * lda + C) * 2u; voffB[i] = (unsigned)(Rb * K + C) * 2u; }
    const size_t kstep = (size_t)(BK * 2);
    const size_t hstepA = (size_t)HALF * lda * 2, hstepB = (size_t)HALF * K * 2;
    const size_t tstepA = 2 * hstepA, tstepB = 2 * hstepB;
    const unsigned ldsw = (unsigned)wid * 1024u;
    const int aoff = lds_byte(wr * 64 + fr, fq * 8), boff = lds_byte(wc * 32 + fr, fq * 8);
#define PG8_SA(b, h) (((b) * 2 + (h)) * HTB)
#define PG8_SB(b, h) ((4 + (b) * 2 + (h)) * HTB)
#define PG8_STAGE(bufoff, gbase, voff) do { _Pragma("unroll") for (int _i = 0; _i < 2; ++_i) \
        __builtin_amdgcn_global_load_lds((const unsigned*)((const char*)(gbase) + (voff)[_i]), (LAS unsigned*)(lds + (bufoff) + ldsw + _i * 8192), 16, 0, 0); } while (0)
#define PG8_LDA(dst, b, h) do { _Pragma("unroll") for (int m = 0; m < 4; ++m) _Pragma("unroll") for (int k = 0; k < 2; ++k) dst[m][k] = *(const LAS bf16x8*)(lds + PG8_SA(b, h) + aoff + m * 2048 + k * 1024); } while (0)
#define PG8_LDB(dst, b, h) do { _Pragma("unroll") for (int n = 0; n < 2; ++n) _Pragma("unroll") for (int k = 0; k < 2; ++k) dst[n][k] = *(const LAS bf16x8*)(lds + PG8_SB(b, h) + boff + n * 2048 + k * 1024); } while (0)
#define PG8_MMA(ai, bj, At, Bt) do { __builtin_amdgcn_s_setprio(1); _Pragma("unroll") for (int m = 0; m < 4; ++m) _Pragma("unroll") for (int n = 0; n < 2; ++n) _Pragma("unroll") for (int k = 0; k < 2; ++k) \
        acc[ai][bj][m][n] = __builtin_amdgcn_mfma_f32_16x16x32_bf16(Bt[n][k], At[m][k], acc[ai][bj][m][n], 0, 0, 0); __builtin_amdgcn_s_setprio(0); } while (0)
#define PG8_WAIT_V(n) asm volatile("s_waitcnt vmcnt(" #n ")" ::: "memory")
#define PG8_WAIT_L(n) asm volatile("s_waitcnt lgkmcnt(" #n ")" ::: "memory")
#define PG8_BAR __builtin_amdgcn_s_barrier()
#define PG8_SCHED __builtin_amdgcn_sched_barrier(0)
    Unit cur, nxt; int ui = 0;
    if (!S.next(0, cur)) return;
    f32x4 acc[2][2][4][2];
#pragma unroll
    for (int a = 0; a < 2; ++a)
#pragma unroll
        for (int b = 0; b < 2; ++b)
#pragma unroll
            for (int m = 0; m < 4; ++m)
#pragma unroll
                for (int n = 0; n < 2; ++n) acc[a][b][m][n] = (f32x4){0.f, 0.f, 0.f, 0.f};
    bf16x8 At[4][2], B0[2][2], B1[2][2];
    const char* cA = (const char*)g.A + (size_t)cur.pm * tstepA; const char* cB = (const char*)g.Bt + (size_t)cur.pn * tstepB;
    PG8_STAGE(PG8_SB(0, 0), cB, voffB); PG8_STAGE(PG8_SA(0, 0), cA, voffA); PG8_STAGE(PG8_SB(0, 1), cB + hstepB, voffB); PG8_STAGE(PG8_SA(0, 1), cA + hstepA, voffA);
    if (wr == 1) PG8_BAR;
    PG8_WAIT_V(4); PG8_BAR;
    PG8_STAGE(PG8_SB(1, 0), cB + kstep, voffB); PG8_STAGE(PG8_SA(1, 0), cA + kstep, voffA); PG8_STAGE(PG8_SB(1, 1), cB + hstepB + kstep, voffB);
    PG8_WAIT_V(6); PG8_BAR;
    for (;;) {
        const bool has_next = S.next(ui + 1, nxt);
        const char* nA = has_next ? (const char*)g.A + (size_t)nxt.pm * tstepA : cA; const char* nB = has_next ? (const char*)g.Bt + (size_t)nxt.pn * tstepB : cB;
        for (int t = 0; t < nt; t += 2) {
            const bool last = (t == nt - 2);
            const char* a1 = cA + (size_t)(t + 1) * kstep;
            const char* a2 = last ? nA : cA + (size_t)(t + 2) * kstep; const char* b2 = last ? nB : cB + (size_t)(t + 2) * kstep;
            const char* a3 = a2 + kstep; const char* b3 = b2 + kstep;
            PG8_LDB(B0, 0, 0); PG8_SCHED; PG8_LDA(At, 0, 0); PG8_STAGE(PG8_SA(1, 1), a1 + hstepA, voffA);
            PG8_WAIT_L(8); PG8_BAR; PG8_WAIT_L(0); PG8_MMA(0, 0, At, B0); PG8_BAR; PG8_SCHED;
            PG8_LDB(B1, 0, 1); PG8_STAGE(PG8_SB(0, 0), b2, voffB);
            PG8_BAR; PG8_WAIT_L(0); PG8_MMA(0, 1, At, B1); PG8_BAR;
            PG8_LDA(At, 0, 1); PG8_STAGE(PG8_SA(0, 0), a2, voffA);
            PG8_BAR; PG8_WAIT_L(0); PG8_MMA(1, 0, At, B0); PG8_BAR; PG8_SCHED;
            PG8_STAGE(PG8_SB(0, 1), b2 + hstepB, voffB);
            PG8_WAIT_V(6); PG8_BAR; PG8_MMA(1, 1, At, B1); PG8_BAR;
            PG8_LDB(B0, 1, 0); PG8_SCHED; PG8_LDA(At, 1, 0); PG8_STAGE(PG8_SA(0, 1), a2 + hstepA, voffA);
            PG8_WAIT_L(8); PG8_BAR; PG8_WAIT_L(0); PG8_MMA(0, 0, At, B0); PG8_BAR; PG8_SCHED;
            PG8_LDB(B1, 1, 1); PG8_STAGE(PG8_SB(1, 0), b3, voffB);
            PG8_BAR; PG8_WAIT_L(0); PG8_MMA(0, 1, At, B1); PG8_BAR;
            PG8_LDA(At, 1, 1); PG8_STAGE(PG8_SA(1, 0), a3, voffA);
            PG8_BAR; PG8_WAIT_L(0); PG8_MMA(1, 0, At, B0); PG8_BAR; PG8_SCHED;
            PG8_STAGE(PG8_SB(1, 1), b3 + hstepB, voffB);
            PG8_WAIT_V(6); PG8_BAR; PG8_MMA(1, 1, At, B1); PG8_BAR;
        }
        E(acc, cur, wr, wc, fr, fq);
        if (!has_next) break;
#pragma unroll
        for (int a = 0; a < 2; ++a)
#pragma unroll
            for (int b = 0; b < 2; ++b)
#pragma unroll
                for (int m = 0; m < 4; ++m)
#pragma unroll
                    for (int n = 0; n < 2; ++n) acc[a][b][m][n] = (f32x4){0.f, 0.f, 0.f, 0.f};
        cur = nxt; cA = nA; cB = nB; ++ui;
    }
    PG8_WAIT_V(0);
    if (wr == 0) PG8_BAR;
    PG8_BAR;
#undef PG8_SA
#undef PG8_SB
#undef PG8_STAGE
#undef PG8_LDA
#undef PG8_LDB
#undef PG8_MMA
#undef PG8_WAIT_V
#undef PG8_WAIT_L
#undef PG8_BAR
#undef PG8_SCHED
}
}

typedef const f32x4 (&AccRef)[2][2][4][2];
struct EpiBf16 {
    static constexpr bool PERM = true;
    bf16_t* O; int ldc;
    __device__ __forceinline__ void operator()(AccRef acc, const pg8::Unit& u, int wr, int wc, int fr, int fq) const {
        const int row0 = u.pm * 256 + wr * 64 + fr, col0 = u.pn * 256 + wc * 32 + 8 * fq;
#pragma unroll
        for (int ai = 0; ai < 2; ++ai)
#pragma unroll
            for (int m = 0; m < 4; ++m) { bf16_t* rowp = O + (size_t)(row0 + ai * 128 + m * 16) * ldc + col0;
#pragma unroll
                for (int bj = 0; bj < 2; ++bj) { const f32x4 v0 = acc[ai][bj][m][0], v1 = acc[ai][bj][m][1];
                    u32x4 w; w.x = pk2(v0[0], v0[1]); w.y = pk2(v0[2], v0[3]); w.z = pk2(v1[0], v1[1]); w.w = pk2(v1[2], v1[3]);
                    *(u32x4*)(rowp + bj * 128) = w; } }
    }
};
struct EpiSwiGLU {
    static constexpr bool PERM = true;
    bf16_t* O; int ldc;
    __device__ __forceinline__ void operator()(AccRef acc, const pg8::Unit& u, int wr, int wc, int fr, int fq) const {
        const int row0 = u.pm * 256 + wr * 64 + fr, col0 = u.pn * 128 + wc * 32 + 8 * fq;
#pragma unroll
        for (int ai = 0; ai < 2; ++ai)
#pragma unroll
            for (int m = 0; m < 4; ++m) { bf16_t* rowp = O + (size_t)(row0 + ai * 128 + m * 16) * ldc + col0;
                float r[8];
#pragma unroll
                for (int n = 0; n < 2; ++n)
#pragma unroll
                    for (int j = 0; j < 4; ++j) { const float a = acc[ai][0][m][n][j], b = acc[ai][1][m][n][j]; r[n * 4 + j] = fsilu(a) * b; }
                u32x4 w; w.x = pk2(r[0], r[1]); w.y = pk2(r[2], r[3]); w.z = pk2(r[4], r[5]); w.w = pk2(r[6], r[7]);
                *(u32x4*)rowp = w; }
    }
};
struct EpiResid {
    static constexpr bool PERM = false;
    const float* base; float* out; const float* gate; float scale;
    __device__ __forceinline__ void operator()(AccRef acc, const pg8::Unit& u, int wr, int wc, int fr, int fq) const {
        const int row0 = u.pm * 256 + wr * 64 + fr, col0 = u.pn * 256 + wc * 32 + 4 * fq;
        const float* gp = gate + (size_t)(u.pm >> 3) * NMOD + col0;
        f32x4 gv[2][2];
#pragma unroll
        for (int bj = 0; bj < 2; ++bj)
#pragma unroll
            for (int n = 0; n < 2; ++n) gv[bj][n] = *(const f32x4*)(gp + bj * 128 + n * 16) * scale;
#pragma unroll
        for (int ai = 0; ai < 2; ++ai)
#pragma unroll
            for (int m = 0; m < 4; ++m) { const size_t off = (size_t)(row0 + ai * 128 + m * 16) * D + col0;
#pragma unroll
                for (int bj = 0; bj < 2; ++bj)
#pragma unroll
                    for (int n = 0; n < 2; ++n) { const f32x4 bs = *(const f32x4*)(base + off + bj * 128 + n * 16);
                        *(f32x4*)(out + off + bj * 128 + n * 16) = bs + gv[bj][n] * acc[ai][bj][m][n]; } }
    }
};
template <bool ACCUM> struct EpiGate {
    static constexpr bool PERM = true;
    const bf16_t* R; bf16_t* O;
    __device__ __forceinline__ void operator()(AccRef acc, const pg8::Unit& u, int wr, int wc, int fr, int fq) const {
        const int row0 = u.pm * 256 + wr * 64 + fr, col0 = u.pn * 256 + wc * 32 + 8 * fq;
#pragma unroll
        for (int ai = 0; ai < 2; ++ai)
#pragma unroll
            for (int m = 0; m < 4; ++m) { const size_t row = (size_t)(row0 + ai * 128 + m * 16);
#pragma unroll
                for (int bj = 0; bj < 2; ++bj) { const u32x4 rw = *(const u32x4*)(R + row * NIN + col0 + bj * 128);
                    bf16_t* op = O + row * D + col0 + bj * 128;
                    const f32x4 v0 = acc[ai][bj][m][0], v1 = acc[ai][bj][m][1];
                    float r[8] = {fsigmoid(bf_lo(rw.x)) * v0[0], fsigmoid(bf_hi(rw.x)) * v0[1], fsigmoid(bf_lo(rw.y)) * v0[2], fsigmoid(bf_hi(rw.y)) * v0[3],
                                  fsigmoid(bf_lo(rw.z)) * v1[0], fsigmoid(bf_hi(rw.z)) * v1[1], fsigmoid(bf_lo(rw.w)) * v1[2], fsigmoid(bf_hi(rw.w)) * v1[3]};
                    if (ACCUM) { const u32x4 pw = *(const u32x4*)op;
                        r[0] += bf_lo(pw.x); r[1] += bf_hi(pw.x); r[2] += bf_lo(pw.y); r[3] += bf_hi(pw.y); r[4] += bf_lo(pw.z); r[5] += bf_hi(pw.z); r[6] += bf_lo(pw.w); r[7] += bf_hi(pw.w); }
                    u32x4 w; w.x = pk2(r[0], r[1]); w.y = pk2(r[2], r[3]); w.z = pk2(r[4], r[5]); w.w = pk2(r[6], r[7]);
                    *(u32x4*)op = w; } }
    }
};
template <class Epi> __device__ __forceinline__ void run_gemm(LAS unsigned char* lds, const bf16_t* A, int lda, const bf16_t* Bt, int N, int K, const Epi& E) {
    pg8::Gemm g{A, Bt, T, N, K, lda}; pg8::StaticOrder S; S.init(T, N, (int)gridDim.x, (int)blockIdx.x);
    pg8::gemm_phase<Epi>(lds, g, S, E);
}

__device__ __forceinline__ void transpose_item(const float* W, int ldw, int s0, int k0, bf16_t* WT, int ldk, int d0, LAS float* scr, int lane) {
#pragma unroll 8
    for (int i = 0; i < 32; ++i) { const int kk = 2 * i + (lane >> 5); scr[kk * 33 + (lane & 31)] = W[(size_t)(k0 + kk) * ldw + s0 + (lane & 31)]; }
    LDS_WAIT();
    const int c = lane & 7;
#pragma unroll
    for (int j = 0; j < 4; ++j) { const int n = (lane >> 3) + 8 * j; const LAS float* s = scr + (8 * c) * 33 + n;
        u32x4 o; o.x = pk2(s[0 * 33], s[1 * 33]); o.y = pk2(s[2 * 33], s[3 * 33]); o.z = pk2(s[4 * 33], s[5 * 33]); o.w = pk2(s[6 * 33], s[7 * 33]);
        *(u32x4*)(WT + (size_t)(d0 + n) * ldk + k0 + 8 * c) = o; }
    LDS_WAIT();
}
__device__ __forceinline__ void ffn_weight_items(const float* w_in, const float* w_out, bf16_t* wt_in, bf16_t* wt_out, LAS float* scr, int gw, int ngw, int lane) {
    for (int it = gw; it < 2816 + 1408; it += ngw) {
        if (it < 2816) { const int kb = it / 176, nb = it % 176, d0 = nb * 32, pn = d0 >> 8, bj = (d0 >> 7) & 1, c = d0 & 127, s0 = bj * FF + pn * 128 + c;
            transpose_item(w_in, 2 * FF, s0, kb * 64, wt_in, D, d0, scr, lane); }
        else { const int r = it - 2816, kb = r / 32, nb = r % 32; transpose_item(w_out, D, nb * 32, kb * 64, wt_out, FF, nb * 32, scr, lane); }
    }
}
__device__ __forceinline__ void mixer_weight_items(const Params& p, LAS float* scr, int gw, int ngw, int lane) {
    unsigned char* ws = p.ws;
    for (int it = gw; it < 2816 + 256 + 256 + 512; it += ngw) {
        int r = it;
        if (r < 2816) { const int kb = r / 176, nb = r % 176, d0 = nb * 32, s0 = d0 < C_RSB ? d0 : d0 + 8; transpose_item(p.in[I_WIN], INW, s0, kb * 64, (bf16_t*)(ws + W_IN), D, d0, scr, lane); continue; } r -= 2816;
        if (r < 256) { const int kb = r / 32, nb = r % 32; transpose_item(p.in[I_WUPSB], D, nb * 32, kb * 64, (bf16_t*)(ws + W_UPSB), 512, nb * 32, scr, lane); continue; } r -= 256;
        if (r < 256) { const int kb = r / 32, nb = r % 32; transpose_item(p.in[I_WUPDN], D, nb * 32, kb * 64, (bf16_t*)(ws + W_UPDN), 512, nb * 32, scr, lane); continue; } r -= 256;
        { const int kb = r / 32, nb = r % 32; transpose_item(p.in[I_WOUT], D, nb * 32, kb * 64, (bf16_t*)(ws + W_OUT), D, nb * 32, scr, lane); }
    }
}
__device__ __forceinline__ void mod_item(const Params& p, LAS unsigned char* lds, int cb, int tid, int wave, int lane) {
    LAS float* sc = (LAS float*)lds; LAS float* red = (LAS float*)(lds + 32768);
    for (int i = tid; i < NB * D; i += 512) sc[i] = fsilu(p.in[I_C][i]);
    __syncthreads();
    const float* wa = p.in[I_WADA] + cb * 64 + lane;
    float acc[NB];
#pragma unroll
    for (int b = 0; b < NB; ++b) acc[b] = 0.f;
    for (int k = wave * 128; k < wave * 128 + 128; k += 4) {
        float w[4];
#pragma unroll
        for (int e = 0; e < 4; ++e) w[e] = wa[(size_t)(k + e) * NMOD];
#pragma unroll
        for (int b = 0; b < NB; ++b) { const f32x4 s = *(const LAS f32x4*)(sc + b * D + k); acc[b] += s[0] * w[0] + s[1] * w[1] + s[2] * w[2] + s[3] * w[3]; }
    }
#pragma unroll
    for (int b = 0; b < NB; ++b) red[(wave * NB + b) * 64 + lane] = acc[b];
    __syncthreads();
    { const int b = tid >> 6; float s = p.in[I_BADA][cb * 64 + lane];
#pragma unroll
        for (int w = 0; w < 8; ++w) s += red[(w * NB + b) * 64 + lane];
        ((float*)(p.ws + WS_MOD))[b * NMOD + cb * 64 + lane] = s; }
    __syncthreads();
}

template <bool DN>
__device__ __forceinline__ void norm_mod_phase(const Params& p, LAS unsigned char* lds, const float* src, const float* gain, int midx, bf16_t* dst, int tid, int wave, int lane) {
    const float* mod = (const float*)(p.ws + WS_MOD);
    LAS float* wl = (LAS float*)lds;
    if (DN) { for (int i = tid; i < D * 8; i += 512) { const int k = i >> 3, j = i & 7; wl[8 * k + 4 * (k >> 2) + j] = p.in[I_WIN][(size_t)k * INW + C_RSB + j]; } __syncthreads(); }
    f32x4 g4[4];
#pragma unroll
    for (int j = 0; j < 4; ++j) g4[j] = ((const f32x4*)gain)[lane + 64 * j];
    for (int row = blockIdx.x * 8 + wave; row < T; row += gridDim.x * 8) {
        const int b = row >> 11;
        const f32x4* xr = (const f32x4*)(src + (size_t)row * D) + lane;
        const f32x4* shp = (const f32x4*)(mod + (size_t)b * NMOD + midx * D) + lane; const f32x4* scp = shp + D / 4;
        f32x4 v[4]; float ss = 0.f;
#pragma unroll
        for (int j = 0; j < 4; ++j) { v[j] = xr[64 * j]; ss += (v[j][0] * v[j][0] + v[j][1] * v[j][1]) + (v[j][2] * v[j][2] + v[j][3] * v[j][3]); }
        const float rstd = 1.0f / sqrtf(wave_sum(ss) * (1.f / D) + EPS);
        u32x2* o8 = (u32x2*)(dst + (size_t)row * D) + lane;
        float dot[8];
        if (DN) {
#pragma unroll
            for (int e = 0; e < 8; ++e) dot[e] = 0.f; }
#pragma unroll
        for (int j = 0; j < 4; ++j) { const f32x4 sh = shp[64 * j], sc = scp[64 * j];
            const f32x4 uu = v[j] * rstd * g4[j] * (sc + 1.0f) + sh;
            u32x2 w; w.x = pk2(uu[0], uu[1]); w.y = pk2(uu[2], uu[3]); o8[64 * j] = w;
            if (DN) {
#pragma unroll
                for (int e = 0; e < 4; ++e) { const int k = 4 * lane + 256 * j + e; const LAS f32x4* wp = (const LAS f32x4*)(wl + 8 * k + 4 * (k >> 2)); const f32x4 w0 = wp[0], w1 = wp[1];
                    dot[0] += uu[e] * w0[0]; dot[1] += uu[e] * w0[1]; dot[2] += uu[e] * w0[2]; dot[3] += uu[e] * w0[3];
                    dot[4] += uu[e] * w1[0]; dot[5] += uu[e] * w1[1]; dot[6] += uu[e] * w1[2]; dot[7] += uu[e] * w1[3]; } } }
        if (DN) {
#pragma unroll
            for (int e = 0; e < 8; ++e) dot[e] = wave_sum(dot[e]);
            float mine = dot[0];
#pragma unroll
            for (int e = 1; e < 8; ++e) mine = (lane == e) ? dot[e] : mine;
            if (lane < 8) { float r;
                if (lane < 4) r = 1.0f / (1.0f + expf(-mine));
                else { const int hh = lane - 4; const float a = mine + p.in[I_DTBIAS][hh]; const float sp = a > 20.f ? a : log1pf(expf(a)); r = -expf(p.in[I_ALOG][hh]) * sp; }
                ((float*)(p.ws + WS_BG))[(size_t)row * 8 + lane] = r; } }
    }
    if (DN) __syncthreads();
}

__device__ __forceinline__ void unpack16(const bf16_t* p, float* f) {
    const u32x4 a = ((const u32x4*)p)[0], b = ((const u32x4*)p)[1];
    f[0] = bf_lo(a.x); f[1] = bf_hi(a.x); f[2] = bf_lo(a.y); f[3] = bf_hi(a.y); f[4] = bf_lo(a.z); f[5] = bf_hi(a.z); f[6] = bf_lo(a.w); f[7] = bf_hi(a.w);
    f[8] = bf_lo(b.x); f[9] = bf_hi(b.x); f[10] = bf_lo(b.y); f[11] = bf_hi(b.y); f[12] = bf_lo(b.z); f[13] = bf_hi(b.z); f[14] = bf_lo(b.w); f[15] = bf_hi(b.w);
}
__device__ __forceinline__ void pack16(bf16_t* p, const float* f) {
    u32x4 a, b; a.x = pk2(f[0], f[1]); a.y = pk2(f[2], f[3]); a.z = pk2(f[4], f[5]); a.w = pk2(f[6], f[7]); b.x = pk2(f[8], f[9]); b.y = pk2(f[10], f[11]); b.z = pk2(f[12], f[13]); b.w = pk2(f[14], f[15]);
    ((u32x4*)p)[0] = a; ((u32x4*)p)[1] = b;
}
__device__ __forceinline__ void prep_phase(const Params& p, int wave, int lane) {
    bf16_t* P = (bf16_t*)(p.ws + WS_P); bf16_t* U = (bf16_t*)(p.ws + WS_U);
    const int ch = 16 * lane;
    float gsb[16], wcv[4][16];
    { const float* gp = (ch < 512 ? p.in[I_GQSB] : p.in[I_GKSB]) + (ch & 63); const float sc = ch < 512 ? 0.125f : 1.0f;
#pragma unroll
        for (int e = 0; e < 16; ++e) gsb[e] = gp[e] * sc;
#pragma unroll
        for (int i = 0; i < 4; ++i)
#pragma unroll
            for (int e = 0; e < 16; ++e) wcv[i][e] = p.in[I_WCONV][i * 1536 + ch + e]; }
    for (int row = blockIdx.x * 8 + wave; row < T; row += gridDim.x * 8) {
        const int tl = row & (SEQ - 1);
        { bf16_t* qp = P + (size_t)row * NIN + ch; float f[16]; unpack16(qp, f); float ss = 0.f;
#pragma unroll
            for (int e = 0; e < 16; ++e) ss += f[e] * f[e];
            ss += __shfl_xor(ss, 1); ss += __shfl_xor(ss, 2);
            const float rstd = 1.0f / sqrtf(ss * (1.f / 64.f) + EPS);
#pragma unroll
            for (int e = 0; e < 16; ++e) f[e] = f[e] * rstd * gsb[e];
            pack16(qp, f); }
        { float y[16];
#pragma unroll
            for (int e = 0; e < 16; ++e) y[e] = 0.f;
#pragma unroll
            for (int i = 0; i < 4; ++i) { if (tl - 3 + i >= 0) { float f[16]; unpack16(P + (size_t)(row - 3 + i) * NIN + C_QDN + ch, f);
#pragma unroll
                    for (int e = 0; e < 16; ++e) y[e] += wcv[i][e] * f[e]; } }
            float ss = 0.f;
#pragma unroll
            for (int e = 0; e < 16; ++e) { y[e] = fsilu(y[e]); ss += y[e] * y[e]; }
            ss += __shfl_xor(ss, 1); ss += __shfl_xor(ss, 2); ss += __shfl_xor(ss, 4);
            const float sc = (1.0f / sqrtf(ss + EPS)) * (ch < 512 ? 0.08838834764831845f : 1.0f);
#pragma unroll
            for (int e = 0; e < 16; ++e) y[e] *= sc;
            pack16(U + (size_t)row * D + ch, y); }
    }
    bf16_t* Vt = (bf16_t*)(p.ws + WS_VT);
    for (int it = blockIdx.x * 8 + wave; it < T / 16; it += gridDim.x * 8) {
        const int row0 = it * 16, b = row0 >> 11, tl0 = row0 & (SEQ - 1), c8 = lane * 8, hd = c8 >> 6, d0 = c8 & 63;
        u32x4 w[16];
#pragma unroll
        for (int r = 0; r < 16; ++r) w[r] = *(const u32x4*)(P + (size_t)(row0 + r) * NIN + C_VSB + c8);
#pragma unroll
        for (int e = 0; e < 8; ++e) {
            unsigned o[8];
#pragma unroll
            for (int i = 0; i < 8; ++i) {
                const int p0 = 2 * i, p1 = 2 * i + 1;
                const int k0 = 8 * ((p0 >> 2) & 1) + 4 * (p0 >> 3) + (p0 & 3), k1 = 8 * ((p1 >> 2) & 1) + 4 * (p1 >> 3) + (p1 & 3);
                const unsigned a0 = w[k0][e >> 1], a1 = w[k1][e >> 1];
                const unsigned lo = (e & 1) ? (a0 >> 16) : (a0 & 0xffffu), hi = (e & 1) ? (a1 & 0xffff0000u) : (a1 << 16);
                o[i] = lo | hi; }
            bf16_t* dst = Vt + ((size_t)(b * 8 + hd) * 64 + d0 + e) * SEQ + tl0;
            ((u32x4*)dst)[0] = (u32x4){o[0], o[1], o[2], o[3]}; ((u32x4*)dst)[1] = (u32x4){o[4], o[5], o[6], o[7]}; }
    }
}

__device__ __forceinline__ void attn_item_mfma(bf16_t* P, const bf16_t* Vt, int bh, int qt, int lane) {
    const int b = bh >> 3, h = bh & 7, ql = lane & 31, hh = lane >> 5, q0 = qt * 32;
    bf16_t* qrow = P + (size_t)(b * SEQ + q0 + ql) * NIN + C_QSB + h * 64;
    bf16x8 qf[4];
#pragma unroll
    for (int s = 0; s < 4; ++s) qf[s] = *(const bf16x8*)(qrow + 16 * s + 8 * hh);
    f32x16 o0, o1;
#pragma unroll
    for (int i = 0; i < 16; ++i) { o0[i] = 0.f; o1[i] = 0.f; }
    float R = 1.0f;
    const bf16_t* kb = P + (size_t)(b * SEQ + ql) * NIN + C_KSB + h * 64 + 8 * hh;
    const bf16_t* vb = Vt + ((size_t)bh * 64 + ql) * SEQ + 8 * hh;
    bf16x8 kf[4], vf[4];
#pragma unroll
    for (int s = 0; s < 4; ++s) kf[s] = *(const bf16x8*)(kb + (size_t)q0 * NIN + 16 * s);
#pragma unroll
    for (int j = 0; j < 4; ++j) vf[j] = *(const bf16x8*)(vb + (size_t)(j >> 1) * 32 * SEQ + q0 + 16 * (j & 1));
#pragma unroll 1
    for (int kt = qt; kt >= 0; --kt) {
        f32x16 z;
#pragma unroll
        for (int i = 0; i < 16; ++i) z[i] = 0.f;
#pragma unroll
        for (int s = 0; s < 4; ++s) z = __builtin_amdgcn_mfma_f32_32x32x16_bf16(kf[s], qf[s], z, 0, 0, 0);
        bf16x8 vc[4];
#pragma unroll
        for (int j = 0; j < 4; ++j) vc[j] = vf[j];
        { const int kn = (kt > 0 ? kt - 1 : 0) * 32;
#pragma unroll
            for (int s = 0; s < 4; ++s) kf[s] = *(const bf16x8*)(kb + (size_t)kn * NIN + 16 * s);
#pragma unroll
            for (int j = 0; j < 4; ++j) vf[j] = *(const bf16x8*)(vb + (size_t)(j >> 1) * 32 * SEQ + kn + 16 * (j & 1)); }
        float sg[16], m[16];
        const bool diag = (kt == qt);
#pragma unroll
        for (int i = 0; i < 16; ++i) { const float zz = z[i]; const float e = __builtin_amdgcn_exp2f(-1.4426950408889634f * fabsf(zz)); const float r = __builtin_amdgcn_rcpf(1.0f + e); const float er = e * r;
            float sig = zz >= 0.f ? r : er, mm = zz >= 0.f ? er : r;
            if (diag) { const bool act = ((i & 3) + 8 * (i >> 2) + 4 * hh) < ql; sig = act ? sig : 0.f; mm = act ? mm : 1.0f; }
            sg[i] = sig; m[i] = mm; }
        float g[4], gp[4];
#pragma unroll
        for (int bq = 0; bq < 4; ++bq) { g[bq] = (m[4 * bq] * m[4 * bq + 1]) * (m[4 * bq + 2] * m[4 * bq + 3]); gp[bq] = __shfl_xor(g[bq], 32); }
        float outer[4]; float tb = R;
#pragma unroll
        for (int bq = 3; bq >= 0; --bq) { outer[bq] = tb * (hh == 0 ? gp[bq] : 1.0f); tb *= g[bq] * gp[bq]; }
        R = tb;
        float w[16];
#pragma unroll
        for (int bq = 0; bq < 4; ++bq) { const float s3 = outer[bq], s2 = s3 * m[4 * bq + 3], s1 = s2 * m[4 * bq + 2], s0 = s1 * m[4 * bq + 1];
            w[4 * bq + 3] = sg[4 * bq + 3] * s3; w[4 * bq + 2] = sg[4 * bq + 2] * s2; w[4 * bq + 1] = sg[4 * bq + 1] * s1; w[4 * bq] = sg[4 * bq] * s0; }
        bf16x8 wf[2];
#pragma unroll
        for (int s2 = 0; s2 < 2; ++s2) { const u32x4 pw = {cpk2(w[8 * s2], w[8 * s2 + 1]), cpk2(w[8 * s2 + 2], w[8 * s2 + 3]), cpk2(w[8 * s2 + 4], w[8 * s2 + 5]), cpk2(w[8 * s2 + 6], w[8 * s2 + 7])}; wf[s2] = __builtin_bit_cast(bf16x8, pw); }
        o0 = __builtin_amdgcn_mfma_f32_32x32x16_bf16(vc[0], wf[0], o0, 0, 0, 0); o0 = __builtin_amdgcn_mfma_f32_32x32x16_bf16(vc[1], wf[1], o0, 0, 0, 0);
        o1 = __builtin_amdgcn_mfma_f32_32x32x16_bf16(vc[2], wf[0], o1, 0, 0, 0); o1 = __builtin_amdgcn_mfma_f32_32x32x16_bf16(vc[3], wf[1], o1, 0, 0, 0);
    }
#pragma unroll
    for (int bq = 0; bq < 4; ++bq) {
        u32x2 w0 = {cpk2(o0[4 * bq], o0[4 * bq + 1]), cpk2(o0[4 * bq + 2], o0[4 * bq + 3])}, w1 = {cpk2(o1[4 * bq], o1[4 * bq + 1]), cpk2(o1[4 * bq + 2], o1[4 * bq + 3])};
        *(u32x2*)(qrow + 8 * bq + 4 * hh) = w0; *(u32x2*)(qrow + 32 + 8 * bq + 4 * hh) = w1; }
}
__device__ __forceinline__ size_t slotU(size_t t0, int h, int colbase, int f) { return (t0 + (size_t)(f >> 7)) * D + colbase + h * 128 + (f & 127); }
__device__ __forceinline__ size_t slotP(size_t t0, int h, int colbase, int f) { return (t0 + (size_t)(f >> 7)) * NIN + colbase + h * 128 + (f & 127); }
__device__ __forceinline__ int permpos(int x) { const int k = x & 15; return (x & ~15) + 8 * ((k >> 2) & 1) + 4 * (k >> 3) + (k & 3); }
__device__ __forceinline__ int crow(int r, int hh) { return (r & 3) + 8 * (r >> 2) + 4 * hh; }
__device__ __forceinline__ bf16x8 pack8(const f32x16& x, int s2) {
    const u32x4 pw = {cpk2(x[8 * s2], x[8 * s2 + 1]), cpk2(x[8 * s2 + 2], x[8 * s2 + 3]), cpk2(x[8 * s2 + 4], x[8 * s2 + 5]), cpk2(x[8 * s2 + 6], x[8 * s2 + 7])};
    return __builtin_bit_cast(bf16x8, pw);
}
#define MFMA32(a, b, c) __builtin_amdgcn_mfma_f32_32x32x16_bf16((a), (b), (c), 0, 0, 0)
constexpr int PT = 72, PQ = 136, PL = 68;
__device__ __forceinline__ void gdn_chunk_prep(const Params& p, LAS unsigned char* lds, int item, int tid, int wave, int lane) {
    asm volatile("" : "+v"(tid), "+v"(lane));
    const int bh = item >> 5, n = item & 31, b = bh >> 2, h = bh & 3, ql = lane & 31, hh = lane >> 5;
    const size_t t0 = (size_t)b * SEQ + n * 64;
    bf16_t* P = (bf16_t*)(p.ws + WS_P); bf16_t* U = (bf16_t*)(p.ws + WS_U); const float* BG = (const float*)(p.ws + WS_BG);
    LAS float* gcS = (LAS float*)lds; LAS float* btS = gcS + 64;
    LAS float* LS = (LAS float*)(lds + 1024);
    LAS bf16_t* TuS = (LAS bf16_t*)(lds + 1024 + 64 * PL * 4); LAS bf16_t* TwS = TuS + 64 * PT;
    LAS bf16_t* kT = TwS + 64 * PT; LAS bf16_t* vT = kT + 128 * PT; LAS bf16_t* qS = vT + 128 * PT;
    if (tid < 64) { float x = BG[(t0 + tid) * 8 + 4 + h];
#pragma unroll
        for (int o = 1; o < 64; o <<= 1) { const float y = __shfl_up(x, o); if (lane >= o) x += y; }
        gcS[tid] = x; btS[tid] = BG[(t0 + tid) * 8 + h]; }
    { const int tok = tid >> 3, c16 = (tid & 7) * 16; float f[16];
        unpack16(U + (t0 + tok) * D + 512 + h * 128 + c16, f);
#pragma unroll
        for (int e = 0; e < 16; ++e) kT[(c16 + e) * PT + tok] = f2bf(f[e]);
        const u32x4 qa = *(const u32x4*)(U + (t0 + tok) * D + h * 128 + c16), qb = *(const u32x4*)(U + (t0 + tok) * D + h * 128 + c16 + 8);
        *(LAS u32x4*)(qS + tok * PQ + c16) = qa; *(LAS u32x4*)(qS + tok * PQ + c16 + 8) = qb;
        float y[16];
#pragma unroll
        for (int e = 0; e < 16; ++e) y[e] = 0.f;
#pragma unroll
        for (int i = 0; i < 4; ++i) { if (n * 64 + tok - 3 + i >= 0) { float x[16]; unpack16(P + (t0 + tok - 3 + i) * NIN + C_VDN + h * 128 + c16, x);
                const float* wp = p.in[I_WCONV] + i * 1536 + 1024 + h * 128 + c16;
#pragma unroll
                for (int e = 0; e < 16; ++e) y[e] += wp[e] * x[e]; } }
#pragma unroll
        for (int e = 0; e < 16; ++e) vT[(c16 + e) * PT + tok] = f2bf(fsilu(y[e])); }
    __syncthreads();
    const bf16_t* kg = U + t0 * D + 512 + h * 128 + 8 * hh; const bf16_t* qg = U + t0 * D + h * 128 + 8 * hh;
    if (wave == 0) {
        bf16x8 kf[2][8];
#pragma unroll
        for (int t = 0; t < 2; ++t)
#pragma unroll
        for (int ks = 0; ks < 8; ++ks) kf[t][ks] = *(const bf16x8*)(kg + (size_t)(32 * t + ql) * D + 16 * ks);
#pragma unroll
        for (int tt = 0; tt < 3; ++tt) { const int it = tt == 0 ? 0 : 1, jt = tt == 2 ? 1 : 0;
            f32x16 acc;
#pragma unroll
            for (int r = 0; r < 16; ++r) acc[r] = 0.f;
#pragma unroll
            for (int ks = 0; ks < 8; ++ks) acc = MFMA32(kf[it][ks], kf[jt][ks], acc);
            const int j = 32 * jt + ql; const float gj = gcS[j];
#pragma unroll
            for (int r = 0; r < 16; ++r) { const int i = 32 * it + crow(r, hh); LS[i * PL + j] = (j < i) ? btS[i] * acc[r] * fexp(gcS[i] - gj) : 0.f; } }
    }
    __syncthreads();
    if (wave == 0) {
        float Tc[64];
#pragma unroll
        for (int i = 0; i < 64; ++i) {
            float acc = (lane == i) ? 1.0f : 0.f;
#pragma unroll
            for (int j4 = 0; j4 < i; j4 += 4) { const f32x4 l4 = *(const LAS f32x4*)(LS + i * PL + j4);
                acc -= l4[0] * Tc[j4]; if (j4 + 1 < i) acc -= l4[1] * Tc[j4 + 1]; if (j4 + 2 < i) acc -= l4[2] * Tc[j4 + 2]; if (j4 + 3 < i) acc -= l4[3] * Tc[j4 + 3]; }
            Tc[i] = acc; __builtin_amdgcn_sched_barrier(0); }
        const float bu = btS[lane], bw = bu * fexp(gcS[lane]);
#pragma unroll
        for (int i = 0; i < 64; ++i) { TuS[i * PT + lane] = f2bf(Tc[i] * bu); TwS[i * PT + lane] = f2bf(Tc[i] * bw); }
    }
    __syncthreads();
    bf16x8 aqf[2][4];
    {
        bf16x8 kf[2][8];
#pragma unroll
    for (int t = 0; t < 2; ++t)
#pragma unroll
        for (int ks = 0; ks < 8; ++ks) kf[t][ks] = *(const bf16x8*)(kg + (size_t)(32 * t + ql) * D + 16 * ks);
#pragma unroll
        for (int it = 0; it < 2; ++it) {
            bf16x8 qf[8];
#pragma unroll
            for (int ks = 0; ks < 8; ++ks) qf[ks] = *(const bf16x8*)(qg + (size_t)(32 * it + ql) * D + 16 * ks);
            const int i = 32 * it + ql; const float gi = gcS[i];
#pragma unroll
            for (int jt = 0; jt < 2; ++jt) {
                if (jt > it) { const u32x4 zz = {0u, 0u, 0u, 0u}; aqf[it][2 * jt] = __builtin_bit_cast(bf16x8, zz); aqf[it][2 * jt + 1] = __builtin_bit_cast(bf16x8, zz); continue; }
                f32x16 acc;
#pragma unroll
                for (int r = 0; r < 16; ++r) acc[r] = 0.f;
#pragma unroll
                for (int ks = 0; ks < 8; ++ks) acc = MFMA32(kf[jt][ks], qf[ks], acc);
#pragma unroll
                for (int r = 0; r < 16; ++r) { const int j = 32 * jt + crow(r, hh); acc[r] = (j <= i) ? acc[r] * fexp(gi - gcS[j]) : 0.f; }
                aqf[it][2 * jt] = pack8(acc, 0); aqf[it][2 * jt + 1] = pack8(acc, 1); } }
    }
    __syncthreads();
    {
        const int isW = wave >> 2, ct = wave & 3, col = 32 * ct + ql;
        const LAS bf16_t* Ta = (isW ? TwS : TuS) + 8 * hh; const LAS bf16_t* Bs = (isW ? kT : vT) + col * PT + 8 * hh;
        bf16x8 bf[4];
#pragma unroll
        for (int ks = 0; ks < 4; ++ks) bf[ks] = *(const LAS bf16x8*)(Bs + 16 * ks);
        f32x16 xa[2];
#pragma unroll
        for (int jt = 0; jt < 2; ++jt) {
#pragma unroll
            for (int r = 0; r < 16; ++r) xa[jt][r] = 0.f;
#pragma unroll
            for (int ks = 0; ks < 4; ++ks) xa[jt] = MFMA32(*(const LAS bf16x8*)(Ta + (32 * jt + ql) * PT + 16 * ks), bf[ks], xa[jt]); }
        bf16x8 xb[4] = {pack8(xa[0], 0), pack8(xa[0], 1), pack8(xa[1], 0), pack8(xa[1], 1)};
        f32x16 ra[2];
#pragma unroll
        for (int it = 0; it < 2; ++it) {
#pragma unroll
            for (int r = 0; r < 16; ++r) ra[it][r] = 0.f;
#pragma unroll
            for (int kk = 0; kk < 4; ++kk) ra[it] = MFMA32(aqf[it][kk], xb[kk], ra[it]); }
        if (!isW) {
#pragma unroll
            for (int jt = 0; jt < 2; ++jt)
#pragma unroll
                for (int bq = 0; bq < 4; ++bq) { const int f = col * 64 + 32 * jt + 8 * bq + 4 * hh;
                    *(u32x2*)(U + slotU(t0, h, 0, f)) = (u32x2){cpk2(xa[jt][4 * bq], xa[jt][4 * bq + 1]), cpk2(xa[jt][4 * bq + 2], xa[jt][4 * bq + 3])};
                    *(u32x2*)(U + slotU(t0, h, 512, f)) = (u32x2){cpk2(ra[jt][4 * bq], ra[jt][4 * bq + 1]), cpk2(ra[jt][4 * bq + 2], ra[jt][4 * bq + 3])}; }
        } else {
            const int pc = permpos(col);
#pragma unroll
            for (int jt = 0; jt < 2; ++jt)
#pragma unroll
                for (int r = 0; r < 16; ++r) { const int tok = 32 * jt + crow(r, hh);
                    P[(t0 + tok) * NIN + C_QDN + h * 128 + pc] = f2bf(-xa[jt][r]);
                    P[(t0 + tok) * NIN + C_KDN + h * 128 + pc] = f2bf(bf2f(qS[tok * PQ + col]) * fexp(gcS[tok]) - ra[jt][r]); }
        }
        { const int dk = tid >> 2, blk = tid & 3; const float gl = gcS[63];
            const u32x4 k0 = *(const LAS u32x4*)(kT + dk * PT + 16 * blk), k1 = *(const LAS u32x4*)(kT + dk * PT + 16 * blk + 8);
            float kv[16] = {bf_lo(k0.x), bf_hi(k0.x), bf_lo(k0.y), bf_hi(k0.y), bf_lo(k0.z), bf_hi(k0.z), bf_lo(k0.w), bf_hi(k0.w), bf_lo(k1.x), bf_hi(k1.x), bf_lo(k1.y), bf_hi(k1.y), bf_lo(k1.z), bf_hi(k1.z), bf_lo(k1.w), bf_hi(k1.w)};
#pragma unroll
            for (int e = 0; e < 16; ++e) kv[e] *= fexp(gl - gcS[16 * blk + e]);
            float pv[16];
#pragma unroll
            for (int e = 0; e < 16; ++e) pv[permpos(e)] = kv[e];
            pack16(P + slotP(t0, h, C_VSB, dk * 64 + 16 * blk), pv);
            if (tid == 0) ((float*)(p.ws + WS_EGL))[bh * 32 + n] = fexp(gl); }
    }
    __syncthreads();
}
__device__ __forceinline__ void gdn_scan_item(const Params& p, int bh, int ct, int lane) {
    bf16_t* P = (bf16_t*)(p.ws + WS_P); const bf16_t* U = (const bf16_t*)(p.ws + WS_U); const float* EGL = (const float*)(p.ws + WS_EGL);
    const int b = bh >> 2, h = bh & 3, ql = lane & 31, hh = lane >> 5, col = 32 * ct + ql;
    f32x16 S[4];
#pragma unroll
    for (int rt = 0; rt < 4; ++rt)
#pragma unroll
        for (int r = 0; r < 16; ++r) S[rt][r] = 0.f;
#pragma unroll 1
    for (int n = 0; n < 32; ++n) {
        const size_t t0 = (size_t)b * SEQ + n * 64;
        const float egl = EGL[bh * 32 + n];
        bf16x8 Sb[8];
#pragma unroll
        for (int rt = 0; rt < 4; ++rt) { Sb[2 * rt] = pack8(S[rt], 0); Sb[2 * rt + 1] = pack8(S[rt], 1); }
        f32x16 vn[2], oa[2];
#pragma unroll
        for (int jt = 0; jt < 2; ++jt)
#pragma unroll
            for (int bq = 0; bq < 4; ++bq) { const int f = col * 64 + 32 * jt + 8 * bq + 4 * hh;
                const u32x2 uw = *(const u32x2*)(U + slotU(t0, h, 0, f)), ow = *(const u32x2*)(U + slotU(t0, h, 512, f));
                vn[jt][4 * bq] = bf_lo(uw.x); vn[jt][4 * bq + 1] = bf_hi(uw.x); vn[jt][4 * bq + 2] = bf_lo(uw.y); vn[jt][4 * bq + 3] = bf_hi(uw.y);
                oa[jt][4 * bq] = bf_lo(ow.x); oa[jt][4 * bq + 1] = bf_hi(ow.x); oa[jt][4 * bq + 2] = bf_lo(ow.y); oa[jt][4 * bq + 3] = bf_hi(ow.y); }
#pragma unroll
        for (int jt = 0; jt < 2; ++jt) { const bf16_t* wrow = P + (t0 + 32 * jt + ql) * NIN + h * 128 + 8 * hh;
#pragma unroll
            for (int ks = 0; ks < 8; ++ks) { vn[jt] = MFMA32(*(const bf16x8*)(wrow + C_QDN + 16 * ks), Sb[ks], vn[jt]); oa[jt] = MFMA32(*(const bf16x8*)(wrow + C_KDN + 16 * ks), Sb[ks], oa[jt]); } }
        bf16x8 vb[4] = {pack8(vn[0], 0), pack8(vn[0], 1), pack8(vn[1], 0), pack8(vn[1], 1)};
#pragma unroll
        for (int rt = 0; rt < 4; ++rt) {
#pragma unroll
            for (int r = 0; r < 16; ++r) S[rt][r] *= egl;
            const int dk = 32 * rt + ql;
#pragma unroll
            for (int ks = 0; ks < 4; ++ks) S[rt] = MFMA32(*(const bf16x8*)(P + slotP(t0, h, C_VSB, dk * 64 + 16 * ks + 8 * hh)), vb[ks], S[rt]); }
#pragma unroll
        for (int jt = 0; jt < 2; ++jt)
#pragma unroll
            for (int r = 0; r < 16; ++r) P[(t0 + 32 * jt + crow(r, hh)) * NIN + C_VDN + h * 128 + col] = f2bf(oa[jt][r]);
    }
}
__device__ __forceinline__ void gdn_finalize_phase(const Params& p, int wave, int lane) {
    bf16_t* P = (bf16_t*)(p.ws + WS_P);
    const int c0 = (lane & 15) * 8;
    float gg[8];
#pragma unroll
    for (int e = 0; e < 8; ++e) gg[e] = p.in[I_GDNOUT][c0 + e];
    for (int row = blockIdx.x * 8 + wave; row < T; row += gridDim.x * 8) {
        bf16_t* op = P + (size_t)row * NIN + C_VDN + lane * 8; const bf16_t* zp = P + (size_t)row * NIN + C_ZDN + lane * 8;
        const u32x4 ow = *(const u32x4*)op, zw = *(const u32x4*)zp;
        const float o[8] = {bf_lo(ow.x), bf_hi(ow.x), bf_lo(ow.y), bf_hi(ow.y), bf_lo(ow.z), bf_hi(ow.z), bf_lo(ow.w), bf_hi(ow.w)};
        const float z[8] = {bf_lo(zw.x), bf_hi(zw.x), bf_lo(zw.y), bf_hi(zw.y), bf_lo(zw.z), bf_hi(zw.z), bf_lo(zw.w), bf_hi(zw.w)};
        float ss = 0.f;
#pragma unroll
        for (int e = 0; e < 8; ++e) ss += o[e] * o[e];
        ss += __shfl_xor(ss, 1); ss += __shfl_xor(ss, 2); ss += __shfl_xor(ss, 4); ss += __shfl_xor(ss, 8);
        const float rstd = 1.0f / sqrtf(ss * (1.f / 128.f) + EPS);
        float r[8];
#pragma unroll
        for (int e = 0; e < 8; ++e) r[e] = o[e] * rstd * gg[e] * fsilu(z[e]);
        u32x4 w; w.x = pk2(r[0], r[1]); w.y = pk2(r[2], r[3]); w.z = pk2(r[4], r[5]); w.w = pk2(r[6], r[7]);
        *(u32x4*)op = w;
    }
}

#ifndef PHMASK
#define PHMASK 0xFFFF
#endif
#define PH(n) ((PHMASK >> (n)) & 1)
__global__ void __launch_bounds__(512, 2) fwd_megakernel(Params p) {
    extern __shared__ __attribute__((aligned(16))) unsigned char lds_raw[];
    LAS unsigned char* lds = (LAS unsigned char*)lds_raw;
    cg::grid_group grid = cg::this_grid();
    const int tid = threadIdx.x, lane = tid & 63, wave = __builtin_amdgcn_readfirstlane(tid >> 6);
    const int G = gridDim.x, gw = wave * G + blockIdx.x, ngw = G * 8;
    unsigned char* ws = p.ws;
    bf16_t* U = (bf16_t*)(ws + WS_U); bf16_t* P = (bf16_t*)(ws + WS_P);
    const float* mod = (const float*)(ws + WS_MOD);
    LAS float* scr = (LAS float*)(lds + wave * 16384);

    if (blockIdx.x == 0 && tid == 0) *(unsigned*)(ws + WS_CTR) = 0u;
    if (PH(0)) for (int it = blockIdx.x; it < NMOD / 64; it += G) mod_item(p, lds, it, tid, wave, lane);
    if (PH(0)) ffn_weight_items(p.in[I_WFFN1IN], p.in[I_WFFN1OUT], (bf16_t*)(ws + W_FFIN), (bf16_t*)(ws + W_FFOUT), scr, gw, ngw, lane);
    if (PH(0)) mixer_weight_items(p, scr, gw, ngw, lane);
    grid.sync();
    if (PH(1)) norm_mod_phase<false>(p, lds, p.in[I_X], p.in[I_GFFN1], 0, U, tid, wave, lane);
    grid.sync();
    if (PH(2)) run_gemm(lds, U, D, (const bf16_t*)(ws + W_FFIN), 2 * FF, D, EpiSwiGLU{P, FF});
    grid.sync();
    if (PH(3)) run_gemm(lds, P, FF, (const bf16_t*)(ws + W_FFOUT), D, FF, EpiResid{p.in[I_X], p.out, mod + 2 * D, 0.5f});
    grid.sync();
    if (PH(4)) norm_mod_phase<true>(p, lds, p.out, p.in[I_GMIX], 3, U, tid, wave, lane);
    grid.sync();
    if (PH(5)) run_gemm(lds, U, D, (const bf16_t*)(ws + W_IN), NIN, D, EpiBf16{P, NIN});
    grid.sync();
    if (PH(6)) prep_phase(p, wave, lane);
    grid.sync();
    if (PH(7)) for (int it = blockIdx.x; it < 1024; it += G) gdn_chunk_prep(p, lds, it, tid, wave, lane);
    grid.sync();
    if (PH(15) && gw < 128) gdn_scan_item(p, gw >> 2, gw & 3, lane);
    if (PH(8)) { unsigned* ctr = (unsigned*)(ws + WS_CTR);
        for (;;) { unsigned idx = 0; if (lane == 0) idx = atomicAdd(ctr, 1u); idx = __builtin_amdgcn_readfirstlane(idx);
            if (idx >= 4096u) break;
            attn_item_mfma(P, (const bf16_t*)(ws + WS_VT), (int)(idx & 63u), 63 - (int)(idx >> 6), lane); } }
    grid.sync();
    if (PH(9)) gdn_finalize_phase(p, wave, lane);
    grid.sync();
    if (PH(10)) run_gemm(lds, P + C_QSB, NIN, (const bf16_t*)(ws + W_UPSB), D, 512, EpiGate<false>{P + C_RSB, U});
    if (PH(10)) run_gemm(lds, P + C_VDN, NIN, (const bf16_t*)(ws + W_UPDN), D, 512, EpiGate<true>{P + C_RDN, U});
    grid.sync();
    if (PH(11)) run_gemm(lds, U, D, (const bf16_t*)(ws + W_OUT), D, D, EpiResid{p.out, p.out, mod + 5 * D, 1.0f});
    grid.sync();
    if (PH(12)) norm_mod_phase<false>(p, lds, p.out, p.in[I_GFFN2], 6, U, tid, wave, lane);
    __syncthreads();
    if (PH(12)) ffn_weight_items(p.in[I_WFFN2IN], p.in[I_WFFN2OUT], (bf16_t*)(ws + W_FFIN), (bf16_t*)(ws + W_FFOUT), scr, gw, ngw, lane);
    grid.sync();
    if (PH(13)) run_gemm(lds, U, D, (const bf16_t*)(ws + W_FFIN), 2 * FF, D, EpiSwiGLU{P, FF});
    grid.sync();
    if (PH(14)) run_gemm(lds, P, FF, (const bf16_t*)(ws + W_FFOUT), D, FF, EpiResid{p.out, p.out, mod + 8 * D, 0.5f});
}

extern "C" void kernel_launch(void* const* d_in, const int* in_sizes, int n_in, void* d_out, int out_size, void* d_ws, size_t ws_size, hipStream_t stream) {
    static int grid_blocks = 0;
    if (!grid_blocks) {
        int dev = 0, cus = 0, per_cu = 0;
        (void)hipGetDevice(&dev);
        (void)hipDeviceGetAttribute(&cus, hipDeviceAttributeMultiprocessorCount, dev);
        (void)hipFuncSetAttribute((const void*)fwd_megakernel, hipFuncAttributeMaxDynamicSharedMemorySize, LDS_BYTES);
        (void)hipOccupancyMaxActiveBlocksPerMultiprocessor(&per_cu, (const void*)fwd_megakernel, 512, LDS_BYTES);
        if (per_cu < 1) { fprintf(stderr, "occupancy query says %d blocks/CU\n", per_cu); per_cu = 1; }
        grid_blocks = cus;
    }
    Params p{};
    for (int i = 0; i < N_IN; ++i) p.in[i] = (const float*)d_in[i];
    p.out = (float*)d_out; p.ws = (unsigned char*)d_ws;
    void* args[] = {&p};
    hipError_t e = hipLaunchCooperativeKernel((const void*)fwd_megakernel, dim3(grid_blocks), dim3(512), args, LDS_BYTES, stream);
    if (e != hipSuccess) fprintf(stderr, "cooperative launch failed: %s (grid %d)\n", hipGetErrorString(e), grid_blocks);
}
```

```cpp
#include <hip/hip_runtime.h>
#include <hip/hip_cooperative_groups.h>
#include <cstdio>
namespace cg = cooperative_groups;

#define LAS __attribute__((address_space(3)))
typedef unsigned short bf16_t;
typedef short bf16x8 __attribute__((ext_vector_type(8)));
typedef float f32x4 __attribute__((ext_vector_type(4)));
typedef unsigned u32x4 __attribute__((ext_vector_type(4)));
typedef unsigned u32x2 __attribute__((ext_vector_type(2)));
typedef float f32x16 __attribute__((ext_vector_type(16)));
typedef float f32x2 __attribute__((ext_vector_type(2)));
typedef __bf16 nbf16x2 __attribute__((ext_vector_type(2)));

constexpr int T = 16384, D = 1024, SEQ = 2048, NB = 8, FF = 2816, NIN = 5632, INW = 5640, NMOD = 9216;
constexpr int C_QSB = 0, C_KSB = 512, C_VSB = 1024, C_QDN = 1536, C_KDN = 2048, C_VDN = 2560, C_ZDN = 3072, C_RSB = 3584, C_RDN = 4608;
constexpr float EPS = 1e-6f;
constexpr int LDS_BYTES = 131072 + 64;
constexpr size_t MiB = 1024 * 1024;
constexpr size_t WS_MOD = 0, WS_BG = 512 * 1024, WS_SS = 242 * MiB, WS_W = 2 * MiB;
constexpr size_t W_FFIN = WS_W, W_FFOUT = W_FFIN + (size_t)2 * FF * D * 2, W_IN = W_FFOUT + (size_t)D * FF * 2, W_UPSB = W_IN + (size_t)NIN * D * 2,
                 W_UPDN = W_UPSB + (size_t)D * 512 * 2, W_OUT = W_UPDN + (size_t)D * 512 * 2, W_END = W_OUT + (size_t)D * D * 2;
constexpr size_t WS_U = 34 * MiB, WS_P = 66 * MiB;
static_assert(W_END <= WS_U, "weights overflow");
constexpr size_t WS_EGL = 384 * 1024, WS_CTR = 400 * 1024, WS_BAR = 416 * 1024;
constexpr size_t WS_VT = W_FFIN;
static_assert((size_t)T * 512 * 2 <= W_IN - W_FFIN, "Vt overflow");

enum { I_X = 0, I_C, I_WADA, I_BADA, I_GFFN1, I_WFFN1IN, I_WFFN1OUT, I_GMIX, I_WIN, I_GQSB, I_GKSB, I_WCONV, I_ALOG, I_DTBIAS, I_GDNOUT, I_WUPSB, I_WUPDN, I_WOUT, I_GFFN2, I_WFFN2IN, I_WFFN2OUT, N_IN };
struct Params { const float* in[N_IN]; float* out; unsigned char* ws; };

__device__ __forceinline__ float bf_lo(unsigned w) { return __uint_as_float(w << 16); }
__device__ __forceinline__ float bf_hi(unsigned w) { return __uint_as_float(w & 0xffff0000u); }
__device__ __forceinline__ float bf2f(bf16_t b) { return __uint_as_float(((unsigned)b) << 16); }
__device__ __forceinline__ unsigned pk2(float lo, float hi) { unsigned r; asm("v_cvt_pk_bf16_f32 %0, %1, %2" : "=v"(r) : "v"(lo), "v"(hi)); return r; }
__device__ __forceinline__ unsigned cpk2(float lo, float hi) { const f32x2 v = {lo, hi}; return __builtin_bit_cast(unsigned, __builtin_convertvector(v, nbf16x2)); }
__device__ __forceinline__ bf16_t f2bf(float f) { return (bf16_t)(pk2(f, 0.f) & 0xffffu); }
__device__ __forceinline__ float fexp(float x) { return __builtin_amdgcn_exp2f(x * 1.4426950408889634f); }
__device__ __forceinline__ float flog(float x) { return __builtin_amdgcn_logf(x) * 0.6931471805599453f; }
__device__ __forceinline__ float fsigmoid(float x) { return __builtin_amdgcn_rcpf(1.f + fexp(-x)); }
__device__ __forceinline__ float fsilu(float x) { return x * fsigmoid(x); }
__device__ __forceinline__ float fsoftplus(float x) { return fmaxf(x, 0.f) + flog(1.f + fexp(-fabsf(x))); }
__device__ __forceinline__ float wave_sum(float v) {
#pragma unroll
    for (int o = 1; o < 64; o <<= 1) v += __shfl_xor(v, o);
    return v;
}
#define LDS_WAIT() asm volatile("s_waitcnt lgkmcnt(0)" ::: "memory")

namespace pg8 {
constexpr int BM = 256, BK = 64, HALF = 128, HTB = HALF * BK * 2, STAGE_BYTES = 8 * HTB, NXCD = 8, WGM = 8;
__host__ __device__ __forceinline__ int lds_byte(int r, int c) { const int st = (r >> 4) * 2 + (c >> 5), rr = r & 15, cc = c & 31, ob = rr * 64 + cc * 2; return st * 1024 + (ob ^ (((ob >> 9) & 1) << 5)); }
__host__ __device__ __forceinline__ void stage_rc(int b, int& R, int& C) { const int st = b / 1024, sb = b % 1024, swz = sb ^ (((sb >> 9) & 1) << 5); R = (st >> 1) * 16 + swz / 64; C = (st & 1) * 32 + (swz % 64) / 2; }
__host__ __device__ __forceinline__ int perm32(int rho) { const int n = rho >> 4, i = rho & 15; return 8 * (i >> 2) + 4 * n + (i & 3); }
struct Unit { int pm, pn; };
struct Gemm { const bf16_t* A; const bf16_t* Bt; int M, N, K, lda; };
struct StaticOrder {
    int nM, nN, nwg, G, c;
    __host__ __device__ void init(int M, int N, int G_, int c_) { nM = M / BM; nN = N / BM; nwg = nM * nN; G = G_; c = c_; }
    __host__ __device__ bool next(int i, Unit& u) const {
        const long L = (long)i * G + c; if (L >= nwg) return false;
        int wgid = (int)L; { const int q = nwg / NXCD, r = nwg % NXCD, xcd = wgid % NXCD, off = wgid / NXCD; wgid = (xcd < r ? xcd * (q + 1) : r * (q + 1) + (xcd - r) * q) + off; }
        const int nig = WGM * nN, gid = wgid / nig, fm = gid * WGM, gsz = (nM - fm) < WGM ? (nM - fm) : WGM;
        u.pm = fm + ((wgid % nig) % gsz); u.pn = (wgid % nig) / gsz; return true;
    }
};
template <class Epi>
__device__ __forceinline__ void gemm_phase(LAS unsigned char* lds, const Gemm g, const StaticOrder& S, const Epi& E) {
    int tid = threadIdx.x; asm volatile("" : "+v"(tid));
    const int wid = __builtin_amdgcn_readfirstlane(tid >> 6), lane = tid & 63, wr = wid >> 2, wc = wid & 3, fr = lane & 15, fq = lane >> 4;
    const int K = g.K, nt = K / BK, lda = g.lda;
    unsigned voffA[2], voffB[2];
#pragma unroll
    for (int i = 0; i < 2; ++i) { int R, C; stage_rc(tid * 16 + i * 8192, R, C); const int Rb = Epi::PERM ? ((R & ~31) + perm32(R & 31)) : R;
        voffA[i] = (unsigned)(R * lda + C) * 2u; voffB[i] = (unsigned)(Rb * K + C) * 2u; }
    const size_t kstep = (size_t)(BK * 2);
    const size_t hstepA = (size_t)HALF * lda * 2, hstepB = (size_t)HALF * K * 2;
    const size_t tstepA = 2 * hstepA, tstepB = 2 * hstepB;
    const unsigned ldsw = (unsigned)wid * 1024u;
    const int aoff = lds_byte(wr * 64 + fr, fq * 8), boff = lds_byte(wc * 32 + fr, fq * 8);
#define PG8_SA(b, h) (((b) * 2 + (h)) * HTB)
#define PG8_SB(b, h) ((4 + (b) * 2 + (h)) * HTB)
#define PG8_STAGE(bufoff, gbase, voff) do { _Pragma("unroll") for (int _i = 0; _i < 2; ++_i) \
        __builtin_amdgcn_global_load_lds((const unsigned*)((const char*)(gbase) + (voff)[_i]), (LAS unsigned*)(lds + (bufoff) + ldsw + _i * 8192), 16, 0, 0); } while (0)
#define PG8_LDA(dst, b, h) do { _Pragma("unroll") for (int m = 0; m < 4; ++m) _Pragma("unroll") for (int k = 0; k < 2; ++k) dst[m][k] = *(const LAS bf16x8*)(lds + PG8_SA(b, h) + aoff + m * 2048 + k * 1024); } while (0)
#define PG8_LDB(dst, b, h) do { _Pragma("unroll") for (int n = 0; n < 2; ++n) _Pragma("unroll") for (int k = 0; k < 2; ++k) dst[n][k] = *(const LAS bf16x8*)(lds + PG8_SB(b, h) + boff + n * 2048 + k * 1024); } while (0)
#define PG8_MMA(ai, bj, At, Bt) do { __builtin_amdgcn_s_setprio(1); _Pragma("unroll") for (int m = 0; m < 4; ++m) _Pragma("unroll") for (int n = 0; n < 2; ++n) _Pragma("unroll") for (int k = 0; k < 2; ++k) \
        acc[ai][bj][m][n] = __builtin_amdgcn_mfma_f32_16x16x32_bf16(Bt[n][k], At[m][k], acc[ai][bj][m][n], 0, 0, 0); __builtin_amdgcn_s_setprio(0); } while (0)
#define PG8_WAIT_V(n) asm volatile("s_waitcnt vmcnt(" #n ")" ::: "memory")
#define PG8_WAIT_L(n) asm volatile("s_waitcnt lgkmcnt(" #n ")" ::: "memory")
#define PG8_BAR __builtin_amdgcn_s_barrier()
#define PG8_SCHED __builtin_amdgcn_sched_barrier(0)
    Unit cur, nxt; int ui = 0;
    if (!S.next(0, cur)) return;
    f32x4 acc[2][2][4][2];
#pragma unroll
    for (int a = 0; a < 2; ++a)
#pragma unroll
        for (int b = 0; b < 2; ++b)
#pragma unroll
            for (int m = 0; m < 4; ++m)
#pragma unroll
                for (int n = 0; n < 2; ++n) acc[a][b][m][n] = (f32x4){0.f, 0.f, 0.f, 0.f};
    bf16x8 At[4][2], B0[2][2], B1[2][2];
    const char* cA = (const char*)g.A + (size_t)cur.pm * tstepA; const char* cB = (const char*)g.Bt + (size_t)cur.pn * tstepB;
    PG8_STAGE(PG8_SB(0, 0), cB, voffB); PG8_STAGE(PG8_SA(0, 0), cA, voffA); PG8_STAGE(PG8_SB(0, 1), cB + hstepB, voffB); PG8_STAGE(PG8_SA(0, 1), cA + hstepA, voffA);
    if (wr == 1) PG8_BAR;
    PG8_WAIT_V(4); PG8_BAR;
    PG8_STAGE(PG8_SB(1, 0), cB + kstep, voffB); PG8_STAGE(PG8_SA(1, 0), cA + kstep, voffA); PG8_STAGE(PG8_SB(1, 1), cB + hstepB + kstep, voffB);
    PG8_WAIT_V(6); PG8_BAR;
    for (;;) {
        const bool has_next = S.next(ui + 1, nxt);
        const char* nA = has_next ? (const char*)g.A + (size_t)nxt.pm * tstepA : cA; const char* nB = has_next ? (const char*)g.Bt + (size_t)nxt.pn * tstepB : cB;
        for (int t = 0; t < nt; t += 2) {
            const bool last = (t == nt - 2);
            const char* a1 = cA + (size_t)(t + 1) * kstep;
            const char* a2 = last ? nA : cA + (size_t)(t + 2) * kstep; const char* b2 = last ? nB : cB + (size_t)(t + 2) * kstep;
            const char* a3 = a2 + kstep; const char* b3 = b2 + kstep;
            PG8_LDB(B0, 0, 0); PG8_SCHED; PG8_LDA(At, 0, 0); PG8_STAGE(PG8_SA(1, 1), a1 + hstepA, voffA);
            PG8_WAIT_L(8); PG8_BAR; PG8_WAIT_L(0); PG8_MMA(0, 0, At, B0); PG8_BAR; PG8_SCHED;
            PG8_LDB(B1, 0, 1); PG8_STAGE(PG8_SB(0, 0), b2, voffB);
            PG8_BAR; PG8_WAIT_L(0); PG8_MMA(0, 1, At, B1); PG8_BAR;
            PG8_LDA(At, 0, 1); PG8_STAGE(PG8_SA(0, 0), a2, voffA);
            PG8_BAR; PG8_WAIT_L(0); PG8_MMA(1, 0, At, B0); PG8_BAR; PG8_SCHED;
            PG8_STAGE(PG8_SB(0, 1), b2 + hstepB, voffB);
            PG8_WAIT_V(6); PG8_BAR; PG8_MMA(1, 1, At, B1); PG8_BAR;
            PG8_LDB(B0, 1, 0); PG8_SCHED; PG8_LDA(At, 1, 0); PG8_STAGE(PG8_SA(0, 1), a2 + hstepA, voffA);
            PG8_WAIT_L(8); PG8_BAR; PG8_WAIT_L(0); PG8_MMA(0, 0, At, B0); PG8_BAR; PG8_SCHED;
            PG8_LDB(B1, 1, 1); PG8_STAGE(PG8_SB(1, 0), b3, voffB);
            PG8_BAR; PG8_WAIT_L(0); PG8_MMA(0, 1, At, B1); PG8_BAR;
            PG8_LDA(At, 1, 1); PG8_STAGE(PG8_SA(1, 0), a3, voffA);
            PG8_BAR; PG8_WAIT_L(0); PG8_MMA(1, 0, At, B0); PG8_BAR; PG8_SCHED;
            PG8_STAGE(PG8_SB(1, 1), b3 + hstepB, voffB);
            PG8_WAIT_V(6); PG8_BAR; PG8_MMA(1, 1, At, B1); PG8_BAR;
        }
        E(acc, cur, wr, wc, fr, fq);
        if (!has_next) break;
#pragma unroll
        for (int a = 0; a < 2; ++a)
#pragma unroll
            for (int b = 0; b < 2; ++b)
#pragma unroll
                for (int m = 0; m < 4; ++m)
#pragma unroll
                    for (int n = 0; n < 2; ++n) acc[a][b][m][n] = (f32x4){0.f, 0.f, 0.f, 0.f};
        cur = nxt; cA = nA; cB = nB; ++ui;
    }
    PG8_WAIT_V(0);
    if (wr == 0) PG8_BAR;
    PG8_BAR;
#undef PG8_SA
#undef PG8_SB
#undef PG8_STAGE
#undef PG8_LDA
#undef PG8_LDB
#undef PG8_MMA
#undef PG8_WAIT_V
#undef PG8_WAIT_L
#undef PG8_BAR
#undef PG8_SCHED
}
}

typedef const f32x4 (&AccRef)[2][2][4][2];
struct EpiBf16 {
    static constexpr bool PERM = true;
    bf16_t* O; int ldc;
    __device__ __forceinline__ void operator()(AccRef acc, const pg8::Unit& u, int wr, int wc, int fr, int fq) const {
        const int row0 = u.pm * 256 + wr * 64 + fr, col0 = u.pn * 256 + wc * 32 + 8 * fq;
#pragma unroll
        for (int ai = 0; ai < 2; ++ai)
#pragma unroll
            for (int m = 0; m < 4; ++m) { bf16_t* rowp = O + (size_t)(row0 + ai * 128 + m * 16) * ldc + col0;
#pragma unroll
                for (int bj = 0; bj < 2; ++bj) { const f32x4 v0 = acc[ai][bj][m][0], v1 = acc[ai][bj][m][1];
                    u32x4 w; w.x = pk2(v0[0], v0[1]); w.y = pk2(v0[2], v0[3]); w.z = pk2(v1[0], v1[1]); w.w = pk2(v1[2], v1[3]);
                    *(u32x4*)(rowp + bj * 128) = w; } }
    }
};
struct EpiSwiGLU {
    static constexpr bool PERM = true;
    bf16_t* O; int ldc;
    __device__ __forceinline__ void operator()(AccRef acc, const pg8::Unit& u, int wr, int wc, int fr, int fq) const {
        const int row0 = u.pm * 256 + wr * 64 + fr, col0 = u.pn * 128 + wc * 32 + 8 * fq;
#pragma unroll
        for (int ai = 0; ai < 2; ++ai)
#pragma unroll
            for (int m = 0; m < 4; ++m) { bf16_t* rowp = O + (size_t)(row0 + ai * 128 + m * 16) * ldc + col0;
                float r[8];
#pragma unroll
                for (int n = 0; n < 2; ++n)
#pragma unroll
                    for (int j = 0; j < 4; ++j) { const float a = acc[ai][0][m][n][j], b = acc[ai][1][m][n][j]; r[n * 4 + j] = fsilu(a) * b; }
                u32x4 w; w.x = pk2(r[0], r[1]); w.y = pk2(r[2], r[3]); w.z = pk2(r[4], r[5]); w.w = pk2(r[6], r[7]);
                *(u32x4*)rowp = w; }
    }
};
struct EpiResid {
    static constexpr bool PERM = false;
    const float* base; float* out; const float* gate; float scale;
    __device__ __forceinline__ void operator()(AccRef acc, const pg8::Unit& u, int wr, int wc, int fr, int fq) const {
        const int row0 = u.pm * 256 + wr * 64 + fr, col0 = u.pn * 256 + wc * 32 + 4 * fq;
        const float* gp = gate + (size_t)(u.pm >> 3) * NMOD + col0;
        f32x4 gv[2][2];
#pragma unroll
        for (int bj = 0; bj < 2; ++bj)
#pragma unroll
            for (int n = 0; n < 2; ++n) gv[bj][n] = *(const f32x4*)(gp + bj * 128 + n * 16) * scale;
#pragma unroll
        for (int ai = 0; ai < 2; ++ai)
#pragma unroll
            for (int m = 0; m < 4; ++m) { const size_t off = (size_t)(row0 + ai * 128 + m * 16) * D + col0;
#pragma unroll
                for (int bj = 0; bj < 2; ++bj)
#pragma unroll
                    for (int n = 0; n < 2; ++n) { const f32x4 bs = *(const f32x4*)(base + off + bj * 128 + n * 16);
                        *(f32x4*)(out + off + bj * 128 + n * 16) = bs + gv[bj][n] * acc[ai][bj][m][n]; } }
    }
};
template <bool ACCUM> struct EpiGate {
    static constexpr bool PERM = true;
    const bf16_t* R; bf16_t* O;
    __device__ __forceinline__ void operator()(AccRef acc, const pg8::Unit& u, int wr, int wc, int fr, int fq) const {
        const int row0 = u.pm * 256 + wr * 64 + fr, col0 = u.pn * 256 + wc * 32 + 8 * fq;
#pragma unroll
        for (int ai = 0; ai < 2; ++ai)
#pragma unroll
            for (int m = 0; m < 4; ++m) { const size_t row = (size_t)(row0 + ai * 128 + m * 16);
#pragma unroll
                for (int bj = 0; bj < 2; ++bj) { const u32x4 rw = *(const u32x4*)(R + row * NIN + col0 + bj * 128);
                    bf16_t* op = O + row * D + col0 + bj * 128;
                    const f32x4 v0 = acc[ai][bj][m][0], v1 = acc[ai][bj][m][1];
                    float r[8] = {fsigmoid(bf_lo(rw.x)) * v0[0], fsigmoid(bf_hi(rw.x)) * v0[1], fsigmoid(bf_lo(rw.y)) * v0[2], fsigmoid(bf_hi(rw.y)) * v0[3],
                                  fsigmoid(bf_lo(rw.z)) * v1[0], fsigmoid(bf_hi(rw.z)) * v1[1], fsigmoid(bf_lo(rw.w)) * v1[2], fsigmoid(bf_hi(rw.w)) * v1[3]};
                    if (ACCUM) { const u32x4 pw = *(const u32x4*)op;
                        r[0] += bf_lo(pw.x); r[1] += bf_hi(pw.x); r[2] += bf_lo(pw.y); r[3] += bf_hi(pw.y); r[4] += bf_lo(pw.z); r[5] += bf_hi(pw.z); r[6] += bf_lo(pw.w); r[7] += bf_hi(pw.w); }
                    u32x4 w; w.x = pk2(r[0], r[1]); w.y = pk2(r[2], r[3]); w.z = pk2(r[4], r[5]); w.w = pk2(r[6], r[7]);
                    *(u32x4*)op = w; } }
    }
};
template <class Epi> __device__ __forceinline__ void run_gemm(LAS unsigned char* lds, const bf16_t* A, int lda, const bf16_t* Bt, int N, int K, const Epi& E) {
    pg8::Gemm g{A, Bt, T, N, K, lda}; pg8::StaticOrder S; S.init(T, N, (int)gridDim.x, (int)blockIdx.x);
    pg8::gemm_phase<Epi>(lds, g, S, E);
}

__device__ __forceinline__ void transpose_item(const float* W, int ldw, int s0, int k0, bf16_t* WT, int ldk, int d0, LAS float* scr, int lane) {
#pragma unroll 8
    for (int i = 0; i < 32; ++i) { const int kk = 2 * i + (lane >> 5); scr[kk * 33 + (lane & 31)] = W[(size_t)(k0 + kk) * ldw + s0 + (lane & 31)]; }
    LDS_WAIT();
    const int c = lane & 7;
#pragma unroll
    for (int j = 0; j < 4; ++j) { const int n = (lane >> 3) + 8 * j; const LAS float* s = scr + (8 * c) * 33 + n;
        u32x4 o; o.x = pk2(s[0 * 33], s[1 * 33]); o.y = pk2(s[2 * 33], s[3 * 33]); o.z = pk2(s[4 * 33], s[5 * 33]); o.w = pk2(s[6 * 33], s[7 * 33]);
        *(u32x4*)(WT + (size_t)(d0 + n) * ldk + k0 + 8 * c) = o; }
    LDS_WAIT();
}
__device__ __forceinline__ void ffn_weight_items(const float* w_in, const float* w_out, bf16_t* wt_in, bf16_t* wt_out, LAS float* scr, int gw, int ngw, int lane) {
    for (int it = gw; it < 2816 + 1408; it += ngw) {
        if (it < 2816) { const int kb = it / 176, nb = it % 176, d0 = nb * 32, pn = d0 >> 8, bj = (d0 >> 7) & 1, c = d0 & 127, s0 = bj * FF + pn * 128 + c;
            transpose_item(w_in, 2 * FF, s0, kb * 64, wt_in, D, d0, scr, lane); }
        else { const int r = it - 2816, kb = r / 32, nb = r % 32; transpose_item(w_out, D, nb * 32, kb * 64, wt_out, FF, nb * 32, scr, lane); }
    }
}
__device__ __forceinline__ void mixer_weight_items(const Params& p, LAS float* scr, int gw, int ngw, int lane) {
    unsigned char* ws = p.ws;
    for (int it = gw; it < 2816 + 256 + 256 + 512; it += ngw) {
        int r = it;
        if (r < 2816) { const int kb = r / 176, nb = r % 176, d0 = nb * 32, s0 = d0 < C_RSB ? d0 : d0 + 8; transpose_item(p.in[I_WIN], INW, s0, kb * 64, (bf16_t*)(ws + W_IN), D, d0, scr, lane); continue; } r -= 2816;
        if (r < 256) { const int kb = r / 32, nb = r % 32; transpose_item(p.in[I_WUPSB], D, nb * 32, kb * 64, (bf16_t*)(ws + W_UPSB), 512, nb * 32, scr, lane); continue; } r -= 256;
        if (r < 256) { const int kb = r / 32, nb = r % 32; transpose_item(p.in[I_WUPDN], D, nb * 32, kb * 64, (bf16_t*)(ws + W_UPDN), 512, nb * 32, scr, lane); continue; } r -= 256;
        { const int kb = r / 32, nb = r % 32; transpose_item(p.in[I_WOUT], D, nb * 32, kb * 64, (bf16_t*)(ws + W_OUT), D, nb * 32, scr, lane); }
    }
}
__device__ __forceinline__ void mod_item(const Params& p, LAS unsigned char* lds, int cb, int tid, int wave, int lane) {
    LAS float* sc = (LAS float*)lds; LAS float* red = (LAS float*)(lds + 32768);
    for (int i = tid; i < NB * D; i += 512) sc[i] = fsilu(p.in[I_C][i]);
    __syncthreads();
    const float* wa = p.in[I_WADA] + cb * 64 + lane;
    float acc[NB];
#pragma unroll
    for (int b = 0; b < NB; ++b) acc[b] = 0.f;
    for (int k = wave * 128; k < wave * 128 + 128; k += 4) {
        float w[4];
#pragma unroll
        for (int e = 0; e < 4; ++e) w[e] = wa[(size_t)(k + e) * NMOD];
#pragma unroll
        for (int b = 0; b < NB; ++b) { const f32x4 s = *(const LAS f32x4*)(sc + b * D + k); acc[b] += s[0] * w[0] + s[1] * w[1] + s[2] * w[2] + s[3] * w[3]; }
    }
#pragma unroll
    for (int b = 0; b < NB; ++b) red[(wave * NB + b) * 64 + lane] = acc[b];
    __syncthreads();
    { const int b = tid >> 6; float s = p.in[I_BADA][cb * 64 + lane];
#pragma unroll
        for (int w = 0; w < 8; ++w) s += red[(w * NB + b) * 64 + lane];
        ((float*)(p.ws + WS_MOD))[b * NMOD + cb * 64 + lane] = s; }
    __syncthreads();
}

template <bool DN>
__device__ __forceinline__ void norm_mod_phase(const Params& p, LAS unsigned char* lds, const float* src, const float* gain, int midx, bf16_t* dst, int tid, int wave, int lane) {
    const float* mod = (const float*)(p.ws + WS_MOD);
    LAS float* wl = (LAS float*)lds;
    if (DN) { for (int i = tid; i < D * 8; i += 512) { const int k = i >> 3, j = i & 7; wl[8 * k + 4 * (k >> 2) + j] = p.in[I_WIN][(size_t)k * INW + C_RSB + j]; } __syncthreads(); }
    f32x4 g4[4];
#pragma unroll
    for (int j = 0; j < 4; ++j) g4[j] = ((const f32x4*)gain)[lane + 64 * j];
    for (int row = blockIdx.x * 8 + wave; row < T; row += gridDim.x * 8) {
        const int b = row >> 11;
        const f32x4* xr = (const f32x4*)(src + (size_t)row * D) + lane;
        const f32x4* shp = (const f32x4*)(mod + (size_t)b * NMOD + midx * D) + lane; const f32x4* scp = shp + D / 4;
        f32x4 v[4]; float ss = 0.f;
#pragma unroll
        for (int j = 0; j < 4; ++j) { v[j] = xr[64 * j]; ss += (v[j][0] * v[j][0] + v[j][1] * v[j][1]) + (v[j][2] * v[j][2] + v[j][3] * v[j][3]); }
        const float rstd = 1.0f / sqrtf(wave_sum(ss) * (1.f / D) + EPS);
        u32x2* o8 = (u32x2*)(dst + (size_t)row * D) + lane;
        float dot[8];
        if (DN) {
#pragma unroll
            for (int e = 0; e < 8; ++e) dot[e] = 0.f; }
#pragma unroll
        for (int j = 0; j < 4; ++j) { const f32x4 sh = shp[64 * j], sc = scp[64 * j];
            const f32x4 uu = v[j] * rstd * g4[j] * (sc + 1.0f) + sh;
            u32x2 w; w.x = pk2(uu[0], uu[1]); w.y = pk2(uu[2], uu[3]); o8[64 * j] = w;
            if (DN) {
#pragma unroll
                for (int e = 0; e < 4; ++e) { const int k = 4 * lane + 256 * j + e; const LAS f32x4* wp = (const LAS f32x4*)(wl + 8 * k + 4 * (k >> 2)); const f32x4 w0 = wp[0], w1 = wp[1];
                    dot[0] += uu[e] * w0[0]; dot[1] += uu[e] * w0[1]; dot[2] += uu[e] * w0[2]; dot[3] += uu[e] * w0[3];
                    dot[4] += uu[e] * w1[0]; dot[5] += uu[e] * w1[1]; dot[6] += uu[e] * w1[2]; dot[7] += uu[e] * w1[3]; } } }
        if (DN) {
#pragma unroll
            for (int e = 0; e < 8; ++e) dot[e] = wave_sum(dot[e]);
            float mine = dot[0];
#pragma unroll
            for (int e = 1; e < 8; ++e) mine = (lane == e) ? dot[e] : mine;
            if (lane < 8) { float r;
                if (lane < 4) r = 1.0f / (1.0f + expf(-mine));
                else { const int hh = lane - 4; const float a = mine + p.in[I_DTBIAS][hh]; const float sp = a > 20.f ? a : log1pf(expf(a)); r = -expf(p.in[I_ALOG][hh]) * sp; }
                ((float*)(p.ws + WS_BG))[(size_t)row * 8 + lane] = r; } }
    }
    if (DN) __syncthreads();
}

__device__ __forceinline__ void unpack16(const bf16_t* p, float* f) {
    const u32x4 a = ((const u32x4*)p)[0], b = ((const u32x4*)p)[1];
    f[0] = bf_lo(a.x); f[1] = bf_hi(a.x); f[2] = bf_lo(a.y); f[3] = bf_hi(a.y); f[4] = bf_lo(a.z); f[5] = bf_hi(a.z); f[6] = bf_lo(a.w); f[7] = bf_hi(a.w);
    f[8] = bf_lo(b.x); f[9] = bf_hi(b.x); f[10] = bf_lo(b.y); f[11] = bf_hi(b.y); f[12] = bf_lo(b.z); f[13] = bf_hi(b.z); f[14] = bf_lo(b.w); f[15] = bf_hi(b.w);
}
__device__ __forceinline__ void pack16(bf16_t* p, const float* f) {
    u32x4 a, b; a.x = pk2(f[0], f[1]); a.y = pk2(f[2], f[3]); a.z = pk2(f[4], f[5]); a.w = pk2(f[6], f[7]); b.x = pk2(f[8], f[9]); b.y = pk2(f[10], f[11]); b.z = pk2(f[12], f[13]); b.w = pk2(f[14], f[15]);
    ((u32x4*)p)[0] = a; ((u32x4*)p)[1] = b;
}
__device__ __forceinline__ void prep_phase(const Params& p, int wave, int lane) {
    bf16_t* P = (bf16_t*)(p.ws + WS_P); bf16_t* U = (bf16_t*)(p.ws + WS_U);
    const int ch = 16 * lane;
    float gsb[16], wcv[4][16];
    { const float* gp = (ch < 512 ? p.in[I_GQSB] : p.in[I_GKSB]) + (ch & 63); const float sc = ch < 512 ? 0.125f : 1.0f;
#pragma unroll
        for (int e = 0; e < 16; ++e) gsb[e] = gp[e] * sc;
#pragma unroll
        for (int i = 0; i < 4; ++i)
#pragma unroll
            for (int e = 0; e < 16; ++e) wcv[i][e] = p.in[I_WCONV][i * 1536 + ch + e]; }
    for (int row = blockIdx.x * 8 + wave; row < T; row += gridDim.x * 8) {
        const int tl = row & (SEQ - 1);
        { bf16_t* qp = P + (size_t)row * NIN + ch; float f[16]; unpack16(qp, f); float ss = 0.f;
#pragma unroll
            for (int e = 0; e < 16; ++e) ss += f[e] * f[e];
            ss += __shfl_xor(ss, 1); ss += __shfl_xor(ss, 2);
            const float rstd = 1.0f / sqrtf(ss * (1.f / 64.f) + EPS);
#pragma unroll
            for (int e = 0; e < 16; ++e) f[e] = f[e] * rstd * gsb[e];
            pack16(qp, f); }
        { float y[16];
#pragma unroll
            for (int e = 0; e < 16; ++e) y[e] = 0.f;
#pragma unroll
            for (int i = 0; i < 4; ++i) { if (tl - 3 + i >= 0) { float f[16]; unpack16(P + (size_t)(row - 3 + i) * NIN + C_QDN + ch, f);
#pragma unroll
                    for (int e = 0; e < 16; ++e) y[e] += wcv[i][e] * f[e]; } }
            float ss = 0.f;
#pragma unroll
            for (int e = 0; e < 16; ++e) { y[e] = fsilu(y[e]); ss += y[e] * y[e]; }
            ss += __shfl_xor(ss, 1); ss += __shfl_xor(ss, 2); ss += __shfl_xor(ss, 4);
            const float sc = (1.0f / sqrtf(ss + EPS)) * (ch < 512 ? 0.08838834764831845f : 1.0f);
#pragma unroll
            for (int e = 0; e < 16; ++e) y[e] *= sc;
            pack16(U + (size_t)row * D + ch, y); }
    }
    bf16_t* Vt = (bf16_t*)(p.ws + WS_VT);
    for (int it = blockIdx.x * 8 + wave; it < T / 16; it += gridDim.x * 8) {
        const int row0 = it * 16, b = row0 >> 11, tl0 = row0 & (SEQ - 1), c8 = lane * 8, hd = c8 >> 6, d0 = c8 & 63;
        u32x4 w[16];
#pragma unroll
        for (int r = 0; r < 16; ++r) w[r] = *(const u32x4*)(P + (size_t)(row0 + r) * NIN + C_VSB + c8);
#pragma unroll
        for (int e = 0; e < 8; ++e) {
            unsigned o[8];
#pragma unroll
            for (int i = 0; i < 8; ++i) {
                const int p0 = 2 * i, p1 = 2 * i + 1;
                const int k0 = 8 * ((p0 >> 2) & 1) + 4 * (p0 >> 3) + (p0 & 3), k1 = 8 * ((p1 >> 2) & 1) + 4 * (p1 >> 3) + (p1 & 3);
                const unsigned a0 = w[k0][e >> 1], a1 = w[k1][e >> 1];
                const unsigned lo = (e & 1) ? (a0 >> 16) : (a0 & 0xffffu), hi = (e & 1) ? (a1 & 0xffff0000u) : (a1 << 16);
                o[i] = lo | hi; }
            bf16_t* dst = Vt + ((size_t)(b * 8 + hd) * 64 + d0 + e) * SEQ + tl0;
            ((u32x4*)dst)[0] = (u32x4){o[0], o[1], o[2], o[3]}; ((u32x4*)dst)[1] = (u32x4){o[4], o[5], o[6], o[7]}; }
    }
}

__device__ __forceinline__ void attn_item_mfma(bf16_t* P, const bf16_t* Vt, int bh, int qt, int lane) {
    const int b = bh >> 3, h = bh & 7, ql = lane & 31, hh = lane >> 5, q0 = qt * 32;
    bf16_t* qrow = P + (size_t)(b * SEQ + q0 + ql) * NIN + C_QSB + h * 64;
    bf16x8 qf[4];
#pragma unroll
    for (int s = 0; s < 4; ++s) qf[s] = *(const bf16x8*)(qrow + 16 * s + 8 * hh);
    f32x16 o0, o1;
#pragma unroll
    for (int i = 0; i < 16; ++i) { o0[i] = 0.f; o1[i] = 0.f; }
    float R = 1.0f;
    const bf16_t* kb = P + (size_t)(b * SEQ + ql) * NIN + C_KSB + h * 64 + 8 * hh;
    const bf16_t* vb = Vt + ((size_t)bh * 64 + ql) * SEQ + 8 * hh;
    bf16x8 kf[4], vf[4];
#pragma unroll
    for (int s = 0; s < 4; ++s) kf[s] = *(const bf16x8*)(kb + (size_t)q0 * NIN + 16 * s);
#pragma unroll
    for (int j = 0; j < 4; ++j) vf[j] = *(const bf16x8*)(vb + (size_t)(j >> 1) * 32 * SEQ + q0 + 16 * (j & 1));
#pragma unroll 1
    for (int kt = qt; kt >= 0; --kt) {
        f32x16 z;
#pragma unroll
        for (int i = 0; i < 16; ++i) z[i] = 0.f;
#pragma unroll
        for (int s = 0; s < 4; ++s) z = __builtin_amdgcn_mfma_f32_32x32x16_bf16(kf[s], qf[s], z, 0, 0, 0);
        bf16x8 vc[4];
#pragma unroll
        for (int j = 0; j < 4; ++j) vc[j] = vf[j];
        { const int kn = (kt > 0 ? kt - 1 : 0) * 32;
#pragma unroll
            for (int s = 0; s < 4; ++s) kf[s] = *(const bf16x8*)(kb + (size_t)kn * NIN + 16 * s);
#pragma unroll
            for (int j = 0; j < 4; ++j) vf[j] = *(const bf16x8*)(vb + (size_t)(j >> 1) * 32 * SEQ + kn + 16 * (j & 1)); }
        float sg[16], m[16];
        const bool diag = (kt == qt);
#pragma unroll
        for (int i = 0; i < 16; ++i) { const float zz = z[i]; const float e = __builtin_amdgcn_exp2f(-1.4426950408889634f * fabsf(zz)); const float r = __builtin_amdgcn_rcpf(1.0f + e); const float er = e * r;
            float sig = zz >= 0.f ? r : er, mm = zz >= 0.f ? er : r;
            if (diag) { const bool act = ((i & 3) + 8 * (i >> 2) + 4 * hh) < ql; sig = act ? sig : 0.f; mm = act ? mm : 1.0f; }
            sg[i] = sig; m[i] = mm; }
        float g[4], gp[4];
#pragma unroll
        for (int bq = 0; bq < 4; ++bq) { g[bq] = (m[4 * bq] * m[4 * bq + 1]) * (m[4 * bq + 2] * m[4 * bq + 3]); gp[bq] = __shfl_xor(g[bq], 32); }
        float outer[4]; float tb = R;
#pragma unroll
        for (int bq = 3; bq >= 0; --bq) { outer[bq] = tb * (hh == 0 ? gp[bq] : 1.0f); tb *= g[bq] * gp[bq]; }
        R = tb;
        float w[16];
#pragma unroll
        for (int bq = 0; bq < 4; ++bq) { const float s3 = outer[bq], s2 = s3 * m[4 * bq + 3], s1 = s2 * m[4 * bq + 2], s0 = s1 * m[4 * bq + 1];
            w[4 * bq + 3] = sg[4 * bq + 3] * s3; w[4 * bq + 2] = sg[4 * bq + 2] * s2; w[4 * bq + 1] = sg[4 * bq + 1] * s1; w[4 * bq] = sg[4 * bq] * s0; }
        bf16x8 wf[2];
#pragma unroll
        for (int s2 = 0; s2 < 2; ++s2) { const u32x4 pw = {cpk2(w[8 * s2], w[8 * s2 + 1]), cpk2(w[8 * s2 + 2], w[8 * s2 + 3]), cpk2(w[8 * s2 + 4], w[8 * s2 + 5]), cpk2(w[8 * s2 + 6], w[8 * s2 + 7])}; wf[s2] = __builtin_bit_cast(bf16x8, pw); }
        o0 = __builtin_amdgcn_mfma_f32_32x32x16_bf16(vc[0], wf[0], o0, 0, 0, 0); o0 = __builtin_amdgcn_mfma_f32_32x32x16_bf16(vc[1], wf[1], o0, 0, 0, 0);
        o1 = __builtin_amdgcn_mfma_f32_32x32x16_bf16(vc[2], wf[0], o1, 0, 0, 0); o1 = __builtin_amdgcn_mfma_f32_32x32x16_bf16(vc[3], wf[1], o1, 0, 0, 0);
    }
#pragma unroll
    for (int bq = 0; bq < 4; ++bq) {
        u32x2 w0 = {cpk2(o0[4 * bq], o0[4 * bq + 1]), cpk2(o0[4 * bq + 2], o0[4 * bq + 3])}, w1 = {cpk2(o1[4 * bq], o1[4 * bq + 1]), cpk2(o1[4 * bq + 2], o1[4 * bq + 3])};
        *(u32x2*)(qrow + 8 * bq + 4 * hh) = w0; *(u32x2*)(qrow + 32 + 8 * bq + 4 * hh) = w1; }
}
__device__ __forceinline__ size_t slotU(size_t t0, int h, int colbase, int f) { return (t0 + (size_t)(f >> 7)) * D + colbase + h * 128 + (f & 127); }
__device__ __forceinline__ size_t slotP(size_t t0, int h, int colbase, int f) { return (t0 + (size_t)(f >> 7)) * NIN + colbase + h * 128 + (f & 127); }
__device__ __forceinline__ int permpos(int x) { const int k = x & 15; return (x & ~15) + 8 * ((k >> 2) & 1) + 4 * (k >> 3) + (k & 3); }
__device__ __forceinline__ int crow(int r, int hh) { return (r & 3) + 8 * (r >> 2) + 4 * hh; }
__device__ __forceinline__ bf16x8 pack8(const f32x16& x, int s2) {
    const u32x4 pw = {cpk2(x[8 * s2], x[8 * s2 + 1]), cpk2(x[8 * s2 + 2], x[8 * s2 + 3]), cpk2(x[8 * s2 + 4], x[8 * s2 + 5]), cpk2(x[8 * s2 + 6], x[8 * s2 + 7])};
    return __builtin_bit_cast(bf16x8, pw);
}
#define MFMA32(a, b, c) __builtin_amdgcn_mfma_f32_32x32x16_bf16((a), (b), (c), 0, 0, 0)
constexpr int PT = 72, PQ = 136, PL = 68;
__device__ __forceinline__ void gdn_chunk_prep(const Params& p, LAS unsigned char* lds, int item, int tid, int wave, int lane) {
    asm volatile("" : "+v"(tid), "+v"(lane));
    const int bh = item >> 5, n = item & 31, b = bh >> 2, h = bh & 3, ql = lane & 31, hh = lane >> 5;
    const size_t t0 = (size_t)b * SEQ + n * 64;
    bf16_t* P = (bf16_t*)(p.ws + WS_P); bf16_t* U = (bf16_t*)(p.ws + WS_U); const float* BG = (const float*)(p.ws + WS_BG);
    LAS float* gcS = (LAS float*)lds; LAS float* btS = gcS + 64;
    LAS float* LS = (LAS float*)(lds + 1024);
    LAS bf16_t* TuS = (LAS bf16_t*)(lds + 1024 + 64 * PL * 4); LAS bf16_t* TwS = TuS + 64 * PT;
    LAS bf16_t* kT = TwS + 64 * PT; LAS bf16_t* vT = kT + 128 * PT; LAS bf16_t* qS = vT + 128 * PT;
    if (tid < 64) { float x = BG[(t0 + tid) * 8 + 4 + h];
#pragma unroll
        for (int o = 1; o < 64; o <<= 1) { const float y = __shfl_up(x, o); if (lane >= o) x += y; }
        gcS[tid] = x; btS[tid] = BG[(t0 + tid) * 8 + h]; }
    { const int tok = tid >> 3, c16 = (tid & 7) * 16; float f[16];
        unpack16(U + (t0 + tok) * D + 512 + h * 128 + c16, f);
#pragma unroll
        for (int e = 0; e < 16; ++e) kT[(c16 + e) * PT + tok] = f2bf(f[e]);
        const u32x4 qa = *(const u32x4*)(U + (t0 + tok) * D + h * 128 + c16), qb = *(const u32x4*)(U + (t0 + tok) * D + h * 128 + c16 + 8);
        *(LAS u32x4*)(qS + tok * PQ + c16) = qa; *(LAS u32x4*)(qS + tok * PQ + c16 + 8) = qb;
        float y[16];
#pragma unroll
        for (int e = 0; e < 16; ++e) y[e] = 0.f;
#pragma unroll
        for (int i = 0; i < 4; ++i) { if (n * 64 + tok - 3 + i >= 0) { float x[16]; unpack16(P + (t0 + tok - 3 + i) * NIN + C_VDN + h * 128 + c16, x);
                const float* wp = p.in[I_WCONV] + i * 1536 + 1024 + h * 128 + c16;
#pragma unroll
                for (int e = 0; e < 16; ++e) y[e] += wp[e] * x[e]; } }
#pragma unroll
        for (int e = 0; e < 16; ++e) vT[(c16 + e) * PT + tok] = f2bf(fsilu(y[e])); }
    __syncthreads();
    const bf16_t* kg = U + t0 * D + 512 + h * 128 + 8 * hh; const bf16_t* qg = U + t0 * D + h * 128 + 8 * hh;
    if (wave == 0) {
        bf16x8 kf[2][8];
#pragma unroll
        for (int t = 0; t < 2; ++t)
#pragma unroll
        for (int ks = 0; ks < 8; ++ks) kf[t][ks] = *(const bf16x8*)(kg + (size_t)(32 * t + ql) * D + 16 * ks);
#pragma unroll
        for (int tt = 0; tt < 3; ++tt) { const int it = tt == 0 ? 0 : 1, jt = tt == 2 ? 1 : 0;
            f32x16 acc;
#pragma unroll
            for (int r = 0; r < 16; ++r) acc[r] = 0.f;
#pragma unroll
            for (int ks = 0; ks < 8; ++ks) acc = MFMA32(kf[it][ks], kf[jt][ks], acc);
            const int j = 32 * jt + ql; const float gj = gcS[j];
#pragma unroll
            for (int r = 0; r < 16; ++r) { const int i = 32 * it + crow(r, hh); LS[i * PL + j] = (j < i) ? btS[i] * acc[r] * fexp(gcS[i] - gj) : 0.f; } }
    }
    __syncthreads();
    if (wave == 0) {
        float Tc[64];
#pragma unroll
        for (int i = 0; i < 64; ++i) {
            float acc = (lane == i) ? 1.0f : 0.f;
#pragma unroll
            for (int j4 = 0; j4 < i; j4 += 4) { const f32x4 l4 = *(const LAS f32x4*)(LS + i * PL + j4);
                acc -= l4[0] * Tc[j4]; if (j4 + 1 < i) acc -= l4[1] * Tc[j4 + 1]; if (j4 + 2 < i) acc -= l4[2] * Tc[j4 + 2]; if (j4 + 3 < i) acc -= l4[3] * Tc[j4 + 3]; }
            Tc[i] = acc; __builtin_amdgcn_sched_barrier(0); }
        const float bu = btS[lane], bw = bu * fexp(gcS[lane]);
#pragma unroll
        for (int i = 0; i < 64; ++i) { TuS[i * PT + lane] = f2bf(Tc[i] * bu); TwS[i * PT + lane] = f2bf(Tc[i] * bw); }
    }
    __syncthreads();
    bf16x8 aqf[2][4];
    {
        bf16x8 kf[2][8];
#pragma unroll
    for (int t = 0; t < 2; ++t)
#pragma unroll
        for (int ks = 0; ks < 8; ++ks) kf[t][ks] = *(const bf16x8*)(kg + (size_t)(32 * t + ql) * D + 16 * ks);
#pragma unroll
        for (int it = 0; it < 2; ++it) {
            bf16x8 qf[8];
#pragma unroll
            for (int ks = 0; ks < 8; ++ks) qf[ks] = *(const bf16x8*)(qg + (size_t)(32 * it + ql) * D + 16 * ks);
            const int i = 32 * it + ql; const float gi = gcS[i];
#pragma unroll
            for (int jt = 0; jt < 2; ++jt) {
                if (jt > it) { const u32x4 zz = {0u, 0u, 0u, 0u}; aqf[it][2 * jt] = __builtin_bit_cast(bf16x8, zz); aqf[it][2 * jt + 1] = __builtin_bit_cast(bf16x8, zz); continue; }
                f32x16 acc;
#pragma unroll
                for (int r = 0; r < 16; ++r) acc[r] = 0.f;
#pragma unroll
                for (int ks = 0; ks < 8; ++ks) acc = MFMA32(kf[jt][ks], qf[ks], acc);
#pragma unroll
                for (int r = 0; r < 16; ++r) { const int j = 32 * jt + crow(r, hh); acc[r] = (j <= i) ? acc[r] * fexp(gi - gcS[j]) : 0.f; }
                aqf[it][2 * jt] = pack8(acc, 0); aqf[it][2 * jt + 1] = pack8(acc, 1); } }
    }
    __syncthreads();
    {
        const int isW = wave >> 2, ct = wave & 3, col = 32 * ct + ql;
        const LAS bf16_t* Ta = (isW ? TwS : TuS) + 8 * hh; const LAS bf16_t* Bs = (isW ? kT : vT) + col * PT + 8 * hh;
        bf16x8 bf[4];
#pragma unroll
        for (int ks = 0; ks < 4; ++ks) bf[ks] = *(const LAS bf16x8*)(Bs + 16 * ks);
        f32x16 xa[2];
#pragma unroll
        for (int jt = 0; jt < 2; ++jt) {
#pragma unroll
            for (int r = 0; r < 16; ++r) xa[jt][r] = 0.f;
#pragma unroll
            for (int ks = 0; ks < 4; ++ks) xa[jt] = MFMA32(*(const LAS bf16x8*)(Ta + (32 * jt + ql) * PT + 16 * ks), bf[ks], xa[jt]); }
        bf16x8 xb[4] = {pack8(xa[0], 0), pack8(xa[0], 1), pack8(xa[1], 0), pack8(xa[1], 1)};
        f32x16 ra[2];
#pragma unroll
        for (int it = 0; it < 2; ++it) {
#pragma unroll
            for (int r = 0; r < 16; ++r) ra[it][r] = 0.f;
#pragma unroll
            for (int kk = 0; kk < 4; ++kk) ra[it] = MFMA32(aqf[it][kk], xb[kk], ra[it]); }
        if (!isW) {
#pragma unroll
            for (int jt = 0; jt < 2; ++jt)
#pragma unroll
                for (int bq = 0; bq < 4; ++bq) { const int f = col * 64 + 32 * jt + 8 * bq + 4 * hh;
                    *(u32x2*)(U + slotU(t0, h, 0, f)) = (u32x2){cpk2(xa[jt][4 * bq], xa[jt][4 * bq + 1]), cpk2(xa[jt][4 * bq + 2], xa[jt][4 * bq + 3])};
                    *(u32x2*)(U + slotU(t0, h, 512, f)) = (u32x2){cpk2(ra[jt][4 * bq], ra[jt][4 * bq + 1]), cpk2(ra[jt][4 * bq + 2], ra[jt][4 * bq + 3])}; }
        } else {
            const int pc = permpos(col);
#pragma unroll
            for (int jt = 0; jt < 2; ++jt)
#pragma unroll
                for (int r = 0; r < 16; ++r) { const int tok = 32 * jt + crow(r, hh);
                    P[(t0 + tok) * NIN + C_QDN + h * 128 + pc] = f2bf(-xa[jt][r]);
                    P[(t0 + tok) * NIN + C_KDN + h * 128 + pc] = f2bf(bf2f(qS[tok * PQ + col]) * fexp(gcS[tok]) - ra[jt][r]); }
        }
        { const int dk = tid >> 2, blk = tid & 3; const float gl = gcS[63];
            const u32x4 k0 = *(const LAS u32x4*)(kT + dk * PT + 16 * blk), k1 = *(const LAS u32x4*)(kT + dk * PT + 16 * blk + 8);
            float kv[16] = {bf_lo(k0.x), bf_hi(k0.x), bf_lo(k0.y), bf_hi(k0.y), bf_lo(k0.z), bf_hi(k0.z), bf_lo(k0.w), bf_hi(k0.w), bf_lo(k1.x), bf_hi(k1.x), bf_lo(k1.y), bf_hi(k1.y), bf_lo(k1.z), bf_hi(k1.z), bf_lo(k1.w), bf_hi(k1.w)};
#pragma unroll
            for (int e = 0; e < 16; ++e) kv[e] *= fexp(gl - gcS[16 * blk + e]);
            float pv[16];
#pragma unroll
            for (int e = 0; e < 16; ++e) pv[permpos(e)] = kv[e];
            pack16(P + slotP(t0, h, C_VSB, dk * 64 + 16 * blk), pv);
            if (tid == 0) ((float*)(p.ws + WS_EGL))[bh * 32 + n] = fexp(gl); }
    }
    __syncthreads();
}
__device__ __forceinline__ void gdn_scan_item(const Params& p, int bh, int ct, int lane) {
    bf16_t* P = (bf16_t*)(p.ws + WS_P); const bf16_t* U = (const bf16_t*)(p.ws + WS_U); const float* EGL = (const float*)(p.ws + WS_EGL);
    const int b = bh >> 2, h = bh & 3, ql = lane & 31, hh = lane >> 5, col = 32 * ct + ql;
    f32x16 S[4];
#pragma unroll
    for (int rt = 0; rt < 4; ++rt)
#pragma unroll
        for (int r = 0; r < 16; ++r) S[rt][r] = 0.f;
#pragma unroll 1
    for (int n = 0; n < 32; ++n) {
        const size_t t0 = (size_t)b * SEQ + n * 64;
        const float egl = EGL[bh * 32 + n];
        bf16x8 Sb[8];
#pragma unroll
        for (int rt = 0; rt < 4; ++rt) { Sb[2 * rt] = pack8(S[rt], 0); Sb[2 * rt + 1] = pack8(S[rt], 1); }
        f32x16 vn[2], oa[2];
#pragma unroll
        for (int jt = 0; jt < 2; ++jt)
#pragma unroll
            for (int bq = 0; bq < 4; ++bq) { const int f = col * 64 + 32 * jt + 8 * bq + 4 * hh;
                const u32x2 uw = *(const u32x2*)(U + slotU(t0, h, 0, f)), ow = *(const u32x2*)(U + slotU(t0, h, 512, f));
                vn[jt][4 * bq] = bf_lo(uw.x); vn[jt][4 * bq + 1] = bf_hi(uw.x); vn[jt][4 * bq + 2] = bf_lo(uw.y); vn[jt][4 * bq + 3] = bf_hi(uw.y);
                oa[jt][4 * bq] = bf_lo(ow.x); oa[jt][4 * bq + 1] = bf_hi(ow.x); oa[jt][4 * bq + 2] = bf_lo(ow.y); oa[jt][4 * bq + 3] = bf_hi(ow.y); }
#pragma unroll
        for (int jt = 0; jt < 2; ++jt) { const bf16_t* wrow = P + (t0 + 32 * jt + ql) * NIN + h * 128 + 8 * hh;
#pragma unroll
            for (int ks = 0; ks < 8; ++ks) { vn[jt] = MFMA32(*(const bf16x8*)(wrow + C_QDN + 16 * ks), Sb[ks], vn[jt]); oa[jt] = MFMA32(*(const bf16x8*)(wrow + C_KDN + 16 * ks), Sb[ks], oa[jt]); } }
        bf16x8 vb[4] = {pack8(vn[0], 0), pack8(vn[0], 1), pack8(vn[1], 0), pack8(vn[1], 1)};
#pragma unroll
        for (int rt = 0; rt < 4; ++rt) {
#pragma unroll
            for (int r = 0; r < 16; ++r) S[rt][r] *= egl;
            const int dk = 32 * rt + ql;
#pragma unroll
            for (int ks = 0; ks < 4; ++ks) S[rt] = MFMA32(*(const bf16x8*)(P + slotP(t0, h, C_VSB, dk * 64 + 16 * ks + 8 * hh)), vb[ks], S[rt]); }
#pragma unroll
        for (int jt = 0; jt < 2; ++jt)
#pragma unroll
            for (int r = 0; r < 16; ++r) P[(t0 + 32 * jt + crow(r, hh)) * NIN + C_VDN + h * 128 + col] = f2bf(oa[jt][r]);
    }
}
__device__ __forceinline__ void gdn_finalize_phase(const Params& p, int wave, int lane) {
    bf16_t* P = (bf16_t*)(p.ws + WS_P);
    const int c0 = (lane & 15) * 8;
    float gg[8];
#pragma unroll
    for (int e = 0; e < 8; ++e) gg[e] = p.in[I_GDNOUT][c0 + e];
    for (int row = blockIdx.x * 8 + wave; row < T; row += gridDim.x * 8) {
        bf16_t* op = P + (size_t)row * NIN + C_VDN + lane * 8; const bf16_t* zp = P + (size_t)row * NIN + C_ZDN + lane * 8;
        const u32x4 ow = *(const u32x4*)op, zw = *(const u32x4*)zp;
        const float o[8] = {bf_lo(ow.x), bf_hi(ow.x), bf_lo(ow.y), bf_hi(ow.y), bf_lo(ow.z), bf_hi(ow.z), bf_lo(ow.w), bf_hi(ow.w)};
        const float z[8] = {bf_lo(zw.x), bf_hi(zw.x), bf_lo(zw.y), bf_hi(zw.y), bf_lo(zw.z), bf_hi(zw.z), bf_lo(zw.w), bf_hi(zw.w)};
        float ss = 0.f;
#pragma unroll
        for (int e = 0; e < 8; ++e) ss += o[e] * o[e];
        ss += __shfl_xor(ss, 1); ss += __shfl_xor(ss, 2); ss += __shfl_xor(ss, 4); ss += __shfl_xor(ss, 8);
        const float rstd = 1.0f / sqrtf(ss * (1.f / 128.f) + EPS);
        float r[8];
#pragma unroll
        for (int e = 0; e < 8; ++e) r[e] = o[e] * rstd * gg[e] * fsilu(z[e]);
        u32x4 w; w.x = pk2(r[0], r[1]); w.y = pk2(r[2], r[3]); w.z = pk2(r[4], r[5]); w.w = pk2(r[6], r[7]);
        *(u32x4*)op = w;
    }
}

#define XB_TMO      128
#define XB_XCNT(j)  (256  + 64 * (j))
#define XB_XSUB(j)  (1280 + 64 * (j))
#define XB_XGEN(j)  (2304 + 64 * (j))
#define XB_TOP      3328
#define XB_TOPGEN   3392
#define XCD_BAR_WORDS 3456
#define XB_SPIN_CAP (1u << 18)
__device__ __forceinline__ unsigned xb_ld(unsigned* p)              { return __hip_atomic_load(p, __ATOMIC_RELAXED, __HIP_MEMORY_SCOPE_AGENT); }
__device__ __forceinline__ unsigned xb_add(unsigned* p, unsigned v) { return __hip_atomic_fetch_add(p, v, __ATOMIC_RELAXED, __HIP_MEMORY_SCOPE_AGENT); }
__device__ __forceinline__ unsigned xb_xcc_id() { return (unsigned)__builtin_amdgcn_s_getreg((3 << 11) | 20) & 0xFu; }
#define XB_SPIN(cond, bar) do { unsigned _sp = 0; while (cond) { __builtin_amdgcn_s_sleep(1); \
    if ((++_sp & 255u) == 0u) { if (xb_ld(&(bar)[XB_TMO])) break; if (_sp > XB_SPIN_CAP) { atomicAdd(&(bar)[XB_TMO], 1u); break; } } } } while (0)
struct XcdBarrier { unsigned* bar; unsigned x; volatile LAS unsigned* st; };
__device__ __forceinline__ XcdBarrier xcd_barrier_post(unsigned* bar, volatile LAS unsigned* st) {
    XcdBarrier b; b.bar = bar; b.x = xb_xcc_id(); b.st = st;
    if (threadIdx.x == 0) (void)xb_add(&bar[XB_XCNT(b.x)], 1u);
    return b;
}
__device__ __forceinline__ void xcd_barrier_complete(unsigned* bar, unsigned x, unsigned& nloc, unsigned& nx) {
    const unsigned G = gridDim.x * gridDim.y * gridDim.z;
    unsigned sum, cnt, mine, sp = 0u;
    for (;;) {
        sum = 0u; cnt = 0u; mine = 0u;
#pragma unroll
        for (unsigned j = 0; j < 16; ++j) { const unsigned c = xb_ld(&bar[XB_XCNT(j)]); sum += c; cnt += (c > 0u) ? 1u : 0u; mine = (j == x) ? c : mine; }
        if (sum == G) break;
        __builtin_amdgcn_s_sleep(1);
        if ((++sp & 255u) == 0u) { if (xb_ld(&bar[XB_TMO])) break; if (sp > XB_SPIN_CAP) { atomicAdd(&bar[XB_TMO], 1u); break; } }
    }
    nloc = mine > 0u ? mine : 1u; nx = cnt > 0u ? cnt : 1u;
}
__device__ __forceinline__ void xcd_barrier(const XcdBarrier& b) {
    asm volatile("s_waitcnt vmcnt(0)" ::: "memory");
    __syncthreads();
    if (threadIdx.x == 0) {
        unsigned* bar = b.bar;
        __builtin_amdgcn_s_waitcnt(0);
        unsigned nloc = b.st[0], nx = b.st[1];
        if (nloc == 0u) { xcd_barrier_complete(bar, b.x, nloc, nx); b.st[0] = nloc; b.st[1] = nx; }
        const unsigned old = xb_add(&bar[XB_XSUB(b.x)], 1u);
        const unsigned gen = old / nloc;
        if (old + 1u == (gen + 1u) * nloc) {
            __builtin_amdgcn_fence(__ATOMIC_RELEASE, "agent");
            asm volatile("s_waitcnt vmcnt(0)" ::: "memory");
            const unsigned og = xb_add(&bar[XB_TOP], 1u);
            const unsigned tg = og / nx;
            if (og + 1u == (tg + 1u) * nx) xb_add(&bar[XB_TOPGEN], 1u);
            else XB_SPIN(xb_ld(&bar[XB_TOPGEN]) == tg, bar);
            __builtin_amdgcn_fence(__ATOMIC_ACQUIRE, "agent");
            xb_add(&bar[XB_XGEN(b.x)], 1u);
            asm volatile("s_waitcnt vmcnt(0)" ::: "memory");
        } else {
            XB_SPIN(xb_ld(&bar[XB_XGEN(b.x)]) == gen, bar);
            __builtin_amdgcn_fence(__ATOMIC_ACQUIRE, "agent");
            asm volatile("s_waitcnt vmcnt(0)" ::: "memory");
        }
    }
    __syncthreads();
}

#ifndef PHMASK
#define PHMASK 0xFFFF
#endif
#define PH(n) ((PHMASK >> (n)) & 1)
#ifndef PROBE
#define PROBE 0
#endif
#define REP(g) for (int _rep = 0; _rep < ((PROBE == (g)) ? 2 : 1); ++_rep)
__global__ void __launch_bounds__(512, 2) fwd_megakernel(Params p) {
    extern __shared__ __attribute__((aligned(16))) unsigned char lds_raw[];
    LAS unsigned char* lds = (LAS unsigned char*)lds_raw;
    cg::grid_group grid = cg::this_grid();
    const int tid = threadIdx.x, lane = tid & 63, wave = __builtin_amdgcn_readfirstlane(tid >> 6);
    const int G = gridDim.x, gw = wave * G + blockIdx.x, ngw = G * 8;
    unsigned char* ws = p.ws;
    bf16_t* U = (bf16_t*)(ws + WS_U); bf16_t* P = (bf16_t*)(ws + WS_P);
    const float* mod = (const float*)(ws + WS_MOD);
    LAS float* scr = (LAS float*)(lds + wave * 16384);

    unsigned* barw = (unsigned*)(ws + WS_BAR);
    if (blockIdx.x == 0) {
        if (tid == 0) __hip_atomic_store((unsigned*)(ws + WS_CTR), 0u, __ATOMIC_RELAXED, __HIP_MEMORY_SCOPE_AGENT);
        if (tid == 1) __hip_atomic_store(&barw[XB_TMO], 0u, __ATOMIC_RELAXED, __HIP_MEMORY_SCOPE_AGENT);
        if (tid == 2) __hip_atomic_store(&barw[XB_TOP], 0u, __ATOMIC_RELAXED, __HIP_MEMORY_SCOPE_AGENT);
        if (tid == 3) __hip_atomic_store(&barw[XB_TOPGEN], 0u, __ATOMIC_RELAXED, __HIP_MEMORY_SCOPE_AGENT);
        if (tid >= 64 && tid < 80) { const int j = tid - 64; __hip_atomic_store(&barw[XB_XCNT(j)], 0u, __ATOMIC_RELAXED, __HIP_MEMORY_SCOPE_AGENT); __hip_atomic_store(&barw[XB_XSUB(j)], 0u, __ATOMIC_RELAXED, __HIP_MEMORY_SCOPE_AGENT); __hip_atomic_store(&barw[XB_XGEN(j)], 0u, __ATOMIC_RELAXED, __HIP_MEMORY_SCOPE_AGENT); }
    }
    volatile LAS unsigned* bst = (volatile LAS unsigned*)(lds + 131072);
    if (tid < 2) bst[tid] = 0u;
    __syncthreads();
    REP(1) { if (PH(0)) for (int it = blockIdx.x; it < NMOD / 64; it += G) mod_item(p, lds, it, tid, wave, lane);
    if (PH(0)) ffn_weight_items(p.in[I_WFFN1IN], p.in[I_WFFN1OUT], (bf16_t*)(ws + W_FFIN), (bf16_t*)(ws + W_FFOUT), scr, gw, ngw, lane);
    if (PH(0)) mixer_weight_items(p, scr, gw, ngw, lane); __syncthreads(); }
    grid.sync();
    const XcdBarrier xbar = xcd_barrier_post(barw, bst);
    if (PROBE == 3) for (int i = 0; i < 16; ++i) xcd_barrier(xbar);
    REP(1) if (PH(1)) norm_mod_phase<false>(p, lds, p.in[I_X], p.in[I_GFFN1], 0, U, tid, wave, lane);
    xcd_barrier(xbar);
    REP(2) if (PH(2)) run_gemm(lds, U, D, (const bf16_t*)(ws + W_FFIN), 2 * FF, D, EpiSwiGLU{P, FF});
    xcd_barrier(xbar);
    REP(2) if (PH(3)) run_gemm(lds, P, FF, (const bf16_t*)(ws + W_FFOUT), D, FF, EpiResid{p.in[I_X], p.out, mod + 2 * D, 0.5f});
    xcd_barrier(xbar);
    REP(1) if (PH(4)) norm_mod_phase<true>(p, lds, p.out, p.in[I_GMIX], 3, U, tid, wave, lane);
    xcd_barrier(xbar);
    REP(2) if (PH(5)) run_gemm(lds, U, D, (const bf16_t*)(ws + W_IN), NIN, D, EpiBf16{P, NIN});
    xcd_barrier(xbar);
    if (PH(6)) prep_phase(p, wave, lane);
    xcd_barrier(xbar);
    if (PH(7)) for (int it = blockIdx.x; it < 1024; it += G) gdn_chunk_prep(p, lds, it, tid, wave, lane);
    xcd_barrier(xbar);
    if (PH(15) && gw < 128) gdn_scan_item(p, gw >> 2, gw & 3, lane);
    if (PH(8)) { unsigned* ctr = (unsigned*)(ws + WS_CTR);
        for (;;) { unsigned idx = 0; if (lane == 0) idx = atomicAdd(ctr, 1u); idx = __builtin_amdgcn_readfirstlane(idx);
            if (idx >= 4096u) break;
            attn_item_mfma(P, (const bf16_t*)(ws + WS_VT), (int)(idx & 63u), 63 - (int)(idx >> 6), lane); } }
    xcd_barrier(xbar);
    if (PH(9)) gdn_finalize_phase(p, wave, lane);
    xcd_barrier(xbar);
    if (PH(10)) run_gemm(lds, P + C_QSB, NIN, (const bf16_t*)(ws + W_UPSB), D, 512, EpiGate<false>{P + C_RSB, U});
    if (PH(10)) run_gemm(lds, P + C_VDN, NIN, (const bf16_t*)(ws + W_UPDN), D, 512, EpiGate<true>{P + C_RDN, U});
    xcd_barrier(xbar);
    if (PH(11)) run_gemm(lds, U, D, (const bf16_t*)(ws + W_OUT), D, D, EpiResid{p.out, p.out, mod + 5 * D, 1.0f});
    xcd_barrier(xbar);
    REP(1) if (PH(12)) norm_mod_phase<false>(p, lds, p.out, p.in[I_GFFN2], 6, U, tid, wave, lane);
    __syncthreads();
    if (PH(12)) ffn_weight_items(p.in[I_WFFN2IN], p.in[I_WFFN2OUT], (bf16_t*)(ws + W_FFIN), (bf16_t*)(ws + W_FFOUT), scr, gw, ngw, lane);
    xcd_barrier(xbar);
    REP(2) if (PH(13)) run_gemm(lds, U, D, (const bf16_t*)(ws + W_FFIN), 2 * FF, D, EpiSwiGLU{P, FF});
    xcd_barrier(xbar);
    if (PH(14)) run_gemm(lds, P, FF, (const bf16_t*)(ws + W_FFOUT), D, FF, EpiResid{p.out, p.out, mod + 8 * D, 0.5f});
}

extern "C" void kernel_launch(void* const* d_in, const int* in_sizes, int n_in, void* d_out, int out_size, void* d_ws, size_t ws_size, hipStream_t stream) {
    static int grid_blocks = 0;
    if (!grid_blocks) {
        int dev = 0, cus = 0, per_cu = 0;
        (void)hipGetDevice(&dev);
        (void)hipDeviceGetAttribute(&cus, hipDeviceAttributeMultiprocessorCount, dev);
        (void)hipFuncSetAttribute((const void*)fwd_megakernel, hipFuncAttributeMaxDynamicSharedMemorySize, LDS_BYTES);
        (void)hipOccupancyMaxActiveBlocksPerMultiprocessor(&per_cu, (const void*)fwd_megakernel, 512, LDS_BYTES);
        if (per_cu < 1) { fprintf(stderr, "occupancy query says %d blocks/CU\n", per_cu); per_cu = 1; }
        grid_blocks = cus;
    }
    Params p{};
    for (int i = 0; i < N_IN; ++i) p.in[i] = (const float*)d_in[i];
    p.out = (float*)d_out; p.ws = (unsigned char*)d_ws;
    void* args[] = {&p};
    hipError_t e = hipLaunchCooperativeKernel((const void*)fwd_megakernel, dim3(grid_blocks), dim3(512), args, LDS_BYTES, stream);
    if (e != hipSuccess) fprintf(stderr, "cooperative launch failed: %s (grid %d)\n", hipGetErrorString(e), grid_blocks);
}
```

```cpp
#include <hip/hip_runtime.h>
#include <hip/hip_cooperative_groups.h>
#include <cstdio>
namespace cg = cooperative_groups;

#define LAS __attribute__((address_space(3)))
typedef unsigned short bf16_t;
typedef short bf16x8 __attribute__((ext_vector_type(8)));
typedef float f32x4 __attribute__((ext_vector_type(4)));
typedef unsigned u32x4 __attribute__((ext_vector_type(4)));
typedef unsigned u32x2 __attribute__((ext_vector_type(2)));
typedef float f32x16 __attribute__((ext_vector_type(16)));
typedef float f32x2 __attribute__((ext_vector_type(2)));
typedef __bf16 nbf16x2 __attribute__((ext_vector_type(2)));

constexpr int T = 16384, D = 1024, SEQ = 2048, NB = 8, FF = 2816, NIN = 5632, INW = 5640, NMOD = 9216;
constexpr int C_QSB = 0, C_KSB = 512, C_VSB = 1024, C_QDN = 1536, C_KDN = 2048, C_VDN = 2560, C_ZDN = 3072, C_RSB = 3584, C_RDN = 4608;
constexpr float EPS = 1e-6f;
constexpr int LDS_BYTES = 131072 + 64;
constexpr size_t MiB = 1024 * 1024;
constexpr size_t WS_MOD = 0, WS_BG = 512 * 1024, WS_SS = 242 * MiB, WS_W = 2 * MiB;
constexpr size_t W_FFIN = WS_W, W_FFOUT = W_FFIN + (size_t)2 * FF * D * 2, W_IN = W_FFOUT + (size_t)D * FF * 2, W_UPSB = W_IN + (size_t)NIN * D * 2,
                 W_UPDN = W_UPSB + (size_t)D * 512 * 2, W_OUT = W_UPDN + (size_t)D * 512 * 2, W_END = W_OUT + (size_t)D * D * 2;
constexpr size_t WS_U = 34 * MiB, WS_P = 66 * MiB;
static_assert(W_END <= WS_U, "weights overflow");
constexpr size_t WS_EGL = 384 * 1024, WS_CTR = 400 * 1024, WS_BAR = 416 * 1024;
constexpr size_t WS_VT = W_FFIN;
static_assert((size_t)T * 512 * 2 <= W_IN - W_FFIN, "Vt overflow");

enum { I_X = 0, I_C, I_WADA, I_BADA, I_GFFN1, I_WFFN1IN, I_WFFN1OUT, I_GMIX, I_WIN, I_GQSB, I_GKSB, I_WCONV, I_ALOG, I_DTBIAS, I_GDNOUT, I_WUPSB, I_WUPDN, I_WOUT, I_GFFN2, I_WFFN2IN, I_WFFN2OUT, N_IN };
struct Params { const float* in[N_IN]; float* out; unsigned char* ws; };

__device__ __forceinline__ float bf_lo(unsigned w) { return __uint_as_float(w << 16); }
__device__ __forceinline__ float bf_hi(unsigned w) { return __uint_as_float(w & 0xffff0000u); }
__device__ __forceinline__ float bf2f(bf16_t b) { return __uint_as_float(((unsigned)b) << 16); }
__device__ __forceinline__ unsigned pk2(float lo, float hi) { unsigned r; asm("v_cvt_pk_bf16_f32 %0, %1, %2" : "=v"(r) : "v"(lo), "v"(hi)); return r; }
__device__ __forceinline__ unsigned cpk2(float lo, float hi) { const f32x2 v = {lo, hi}; return __builtin_bit_cast(unsigned, __builtin_convertvector(v, nbf16x2)); }
__device__ __forceinline__ bf16_t f2bf(float f) { return (bf16_t)(pk2(f, 0.f) & 0xffffu); }
__device__ __forceinline__ float fexp(float x) { return __builtin_amdgcn_exp2f(x * 1.4426950408889634f); }
__device__ __forceinline__ float flog(float x) { return __builtin_amdgcn_logf(x) * 0.6931471805599453f; }
__device__ __forceinline__ float fsigmoid(float x) { return __builtin_amdgcn_rcpf(1.f + fexp(-x)); }
__device__ __forceinline__ float fsilu(float x) { return x * fsigmoid(x); }
__device__ __forceinline__ float fsoftplus(float x) { return fmaxf(x, 0.f) + flog(1.f + fexp(-fabsf(x))); }
__device__ __forceinline__ float wave_sum(float v) {
#pragma unroll
    for (int o = 1; o < 64; o <<= 1) v += __shfl_xor(v, o);
    return v;
}
#define LDS_WAIT() asm volatile("s_waitcnt lgkmcnt(0)" ::: "memory")

namespace pg8 {
constexpr int BM = 256, BK = 64, HALF = 128, HTB = HALF * BK * 2, STAGE_BYTES = 8 * HTB, NXCD = 8, WGM = 8;
__host__ __device__ __forceinline__ int lds_byte(int r, int c) { const int st = (r >> 4) * 2 + (c >> 5), rr = r & 15, cc = c & 31, ob = rr * 64 + cc * 2; return st * 1024 + (ob ^ (((ob >> 9) & 1) << 5)); }
__host__ __device__ __forceinline__ void stage_rc(int b, int& R, int& C) { const int st = b / 1024, sb = b % 1024, swz = sb ^ (((sb >> 9) & 1) << 5); R = (st >> 1) * 16 + swz / 64; C = (st & 1) * 32 + (swz % 64) / 2; }
__host__ __device__ __forceinline__ int perm32(int rho) { const int n = rho >> 4, i = rho & 15; return 8 * (i >> 2) + 4 * n + (i & 3); }
struct Unit { int pm, pn; };
struct Gemm { const bf16_t* A; const bf16_t* Bt; int M, N, K, lda; };
struct StaticOrder {
    int nM, nN, nwg, G, c;
    __host__ __device__ void init(int M, int N, int G_, int c_) { nM = M / BM; nN = N / BM; nwg = nM * nN; G = G_; c = c_; }
    __host__ __device__ bool next(int i, Unit& u) const {
        const long L = (long)i * G + c; if (L >= nwg) return false;
        int wgid = (int)L; { const int q = nwg / NXCD, r = nwg % NXCD, xcd = wgid % NXCD, off = wgid / NXCD; wgid = (xcd < r ? xcd * (q + 1) : r * (q + 1) + (xcd - r) * q) + off; }
        const int nig = WGM * nN, gid = wgid / nig, fm = gid * WGM, gsz = (nM - fm) < WGM ? (nM - fm) : WGM;
        u.pm = fm + ((wgid % nig) % gsz); u.pn = (wgid % nig) / gsz; return true;
    }
};
template <class Epi>
__device__ __forceinline__ void gemm_phase(LAS unsigned char* lds, const Gemm g, const StaticOrder& S, const Epi& E) {
    int tid = threadIdx.x; asm volatile("" : "+v"(tid));
    const int wid = __builtin_amdgcn_readfirstlane(tid >> 6), lane = tid & 63, wr = wid >> 2, wc = wid & 3, fr = lane & 15, fq = lane >> 4;
    const int K = g.K, nt = K / BK, lda = g.lda;
    unsigned voffA[2], voffB[2];
#pragma unroll
    for (int i = 0; i < 2; ++i) { int R, C; stage_rc(tid * 16 + i * 8192, R, C); const int Rb = Epi::PERM ? ((R & ~31) + perm32(R & 31)) : R;
        voffA[i] = (unsigned)(R * lda + C) * 2u; voffB[i] = (unsigned)(Rb * K + C) * 2u; }
    const size_t kstep = (size_t)(BK * 2);
    const size_t hstepA = (size_t)HALF * lda * 2, hstepB = (size_t)HALF * K * 2;
    const size_t tstepA = 2 * hstepA, tstepB = 2 * hstepB;
    const unsigned ldsw = (unsigned)wid * 1024u;
    const int aoff = lds_byte(wr * 64 + fr, fq * 8), boff = lds_byte(wc * 32 + fr, fq * 8);
#define PG8_SA(b, h) (((b) * 2 + (h)) * HTB)
#define PG8_SB(b, h) ((4 + (b) * 2 + (h)) * HTB)
#define PG8_STAGE(bufoff, gbase, voff) do { _Pragma("unroll") for (int _i = 0; _i < 2; ++_i) \
        __builtin_amdgcn_global_load_lds((const unsigned*)((const char*)(gbase) + (voff)[_i]), (LAS unsigned*)(lds + (bufoff) + ldsw + _i * 8192), 16, 0, 0); } while (0)
#define PG8_LDA(dst, b, h) do { _Pragma("unroll") for (int m = 0; m < 4; ++m) _Pragma("unroll") for (int k = 0; k < 2; ++k) dst[m][k] = *(const LAS bf16x8*)(lds + PG8_SA(b, h) + aoff + m * 2048 + k * 1024); } while (0)
#define PG8_LDB(dst, b, h) do { _Pragma("unroll") for (int n = 0; n < 2; ++n) _Pragma("unroll") for (int k = 0; k < 2; ++k) dst[n][k] = *(const LAS bf16x8*)(lds + PG8_SB(b, h) + boff + n * 2048 + k * 1024); } while (0)
#define PG8_MMA(ai, bj, At, Bt) do { __builtin_amdgcn_s_setprio(1); _Pragma("unroll") for (int m = 0; m < 4; ++m) _Pragma("unroll") for (int n = 0; n < 2; ++n) _Pragma("unroll") for (int k = 0; k < 2; ++k) \
        acc[ai][bj][m][n] = __builtin_amdgcn_mfma_f32_16x16x32_bf16(Bt[n][k], At[m][k], acc[ai][bj][m][n], 0, 0, 0); __builtin_amdgcn_s_setprio(0); } while (0)
#define PG8_WAIT_V(n) asm volatile("s_waitcnt vmcnt(" #n ")" ::: "memory")
#define PG8_WAIT_L(n) asm volatile("s_waitcnt lgkmcnt(" #n ")" ::: "memory")
#define PG8_BAR __builtin_amdgcn_s_barrier()
#define PG8_SCHED __builtin_amdgcn_sched_barrier(0)
    Unit cur, nxt; int ui = 0;
    if (!S.next(0, cur)) return;
    f32x4 acc[2][2][4][2];
#pragma unroll
    for (int a = 0; a < 2; ++a)
#pragma unroll
        for (int b = 0; b < 2; ++b)
#pragma unroll
            for (int m = 0; m < 4; ++m)
#pragma unroll
                for (int n = 0; n < 2; ++n) acc[a][b][m][n] = (f32x4){0.f, 0.f, 0.f, 0.f};
    bf16x8 At[4][2], B0[2][2], B1[2][2];
    const char* cA = (const char*)g.A + (size_t)cur.pm * tstepA; const char* cB = (const char*)g.Bt + (size_t)cur.pn * tstepB;
    PG8_STAGE(PG8_SB(0, 0), cB, voffB); PG8_STAGE(PG8_SA(0, 0), cA, voffA); PG8_STAGE(PG8_SB(0, 1), cB + hstepB, voffB); PG8_STAGE(PG8_SA(0, 1), cA + hstepA, voffA);
    if (wr == 1) PG8_BAR;
    PG8_WAIT_V(4); PG8_BAR;
    PG8_STAGE(PG8_SB(1, 0), cB + kstep, voffB); PG8_STAGE(PG8_SA(1, 0), cA + kstep, voffA); PG8_STAGE(PG8_SB(1, 1), cB + hstepB + kstep, voffB);
    PG8_WAIT_V(6); PG8_BAR;
    for (;;) {
        const bool has_next = S.next(ui + 1, nxt);
        const char* nA = has_next ? (const char*)g.A + (size_t)nxt.pm * tstepA : cA; const char* nB = has_next ? (const char*)g.Bt + (size_t)nxt.pn * tstepB : cB;
        for (int t = 0; t < nt; t += 2) {
            const bool last = (t == nt - 2);
            const char* a1 = cA + (size_t)(t + 1) * kstep;
            const char* a2 = last ? nA : cA + (size_t)(t + 2) * kstep; const char* b2 = last ? nB : cB + (size_t)(t + 2) * kstep;
            const char* a3 = a2 + kstep; const char* b3 = b2 + kstep;
            PG8_LDB(B0, 0, 0); PG8_SCHED; PG8_LDA(At, 0, 0); PG8_STAGE(PG8_SA(1, 1), a1 + hstepA, voffA);
            PG8_WAIT_L(8); PG8_BAR; PG8_WAIT_L(0); PG8_MMA(0, 0, At, B0); PG8_BAR; PG8_SCHED;
            PG8_LDB(B1, 0, 1); PG8_STAGE(PG8_SB(0, 0), b2, voffB);
            PG8_BAR; PG8_WAIT_L(0); PG8_MMA(0, 1, At, B1); PG8_BAR;
            PG8_LDA(At, 0, 1); PG8_STAGE(PG8_SA(0, 0), a2, voffA);
            PG8_BAR; PG8_WAIT_L(0); PG8_MMA(1, 0, At, B0); PG8_BAR; PG8_SCHED;
            PG8_STAGE(PG8_SB(0, 1), b2 + hstepB, voffB);
            PG8_WAIT_V(6); PG8_BAR; PG8_MMA(1, 1, At, B1); PG8_BAR;
            PG8_LDB(B0, 1, 0); PG8_SCHED; PG8_LDA(At, 1, 0); PG8_STAGE(PG8_SA(0, 1), a2 + hstepA, voffA);
            PG8_WAIT_L(8); PG8_BAR; PG8_WAIT_L(0); PG8_MMA(0, 0, At, B0); PG8_BAR; PG8_SCHED;
            PG8_LDB(B1, 1, 1); PG8_STAGE(PG8_SB(1, 0), b3, voffB);
            PG8_BAR; PG8_WAIT_L(0); PG8_MMA(0, 1, At, B1); PG8_BAR;
            PG8_LDA(At, 1, 1); PG8_STAGE(PG8_SA(1, 0), a3, voffA);
            PG8_BAR; PG8_WAIT_L(0); PG8_MMA(1, 0, At, B0); PG8_BAR; PG8_SCHED;
            PG8_STAGE(PG8_SB(1, 1), b3 + hstepB, voffB);
            PG8_WAIT_V(6); PG8_BAR; PG8_MMA(1, 1, At, B1); PG8_BAR;
        }
        E(acc, cur, wr, wc, fr, fq);
        if (!has_next) break;
#pragma unroll
        for (int a = 0; a < 2; ++a)
#pragma unroll
            for (int b = 0; b < 2; ++b)
#pragma unroll
                for (int m = 0; m < 4; ++m)
#pragma unroll
                    for (int n = 0; n < 2; ++n) acc[a][b][m][n] = (f32x4){0.f, 0.f, 0.f, 0.f};
        cur = nxt; cA = nA; cB = nB; ++ui;
    }
    PG8_WAIT_V(0);
    if (wr == 0) PG8_BAR;
    PG8_BAR;
#undef PG8_SA
#undef PG8_SB
#undef PG8_STAGE
#undef PG8_LDA
#undef PG8_LDB
#undef PG8_MMA
#undef PG8_WAIT_V
#undef PG8_WAIT_L
#undef PG8_BAR
#undef PG8_SCHED
}
}

typedef const f32x4 (&AccRef)[2][2][4][2];
struct EpiBf16 {
    static constexpr bool PERM = true;
    bf16_t* O; int ldc;
    __device__ __forceinline__ void operator()(AccRef acc, const pg8::Unit& u, int wr, int wc, int fr, int fq) const {
        const int row0 = u.pm * 256 + wr * 64 + fr, col0 = u.pn * 256 + wc * 32 + 8 * fq;
#pragma unroll
        for (int ai = 0; ai < 2; ++ai)
#pragma unroll
            for (int m = 0; m < 4; ++m) { bf16_t* rowp = O + (size_t)(row0 + ai * 128 + m * 16) * ldc + col0;
#pragma unroll
                for (int bj = 0; bj < 2; ++bj) { const f32x4 v0 = acc[ai][bj][m][0], v1 = acc[ai][bj][m][1];
                    u32x4 w; w.x = pk2(v0[0], v0[1]); w.y = pk2(v0[2], v0[3]); w.z = pk2(v1[0], v1[1]); w.w = pk2(v1[2], v1[3]);
                    *(u32x4*)(rowp + bj * 128) = w; } }
    }
};
struct EpiSwiGLU {
    static constexpr bool PERM = true;
    bf16_t* O; int ldc;
    __device__ __forceinline__ void operator()(AccRef acc, const pg8::Unit& u, int wr, int wc, int fr, int fq) const {
        const int row0 = u.pm * 256 + wr * 64 + fr, col0 = u.pn * 128 + wc * 32 + 8 * fq;
#pragma unroll
        for (int ai = 0; ai < 2; ++ai)
#pragma unroll
            for (int m = 0; m < 4; ++m) { bf16_t* rowp = O + (size_t)(row0 + ai * 128 + m * 16) * ldc + col0;
                float r[8];
#pragma unroll
                for (int n = 0; n < 2; ++n)
#pragma unroll
                    for (int j = 0; j < 4; ++j) { const float a = acc[ai][0][m][n][j], b = acc[ai][1][m][n][j]; r[n * 4 + j] = fsilu(a) * b; }
                u32x4 w; w.x = pk2(r[0], r[1]); w.y = pk2(r[2], r[3]); w.z = pk2(r[4], r[5]); w.w = pk2(r[6], r[7]);
                *(u32x4*)rowp = w; }
    }
};
struct EpiResid {
    static constexpr bool PERM = false;
    const float* base; float* out; const float* gate; float scale;
    __device__ __forceinline__ void operator()(AccRef acc, const pg8::Unit& u, int wr, int wc, int fr, int fq) const {
        const int row0 = u.pm * 256 + wr * 64 + fr, col0 = u.pn * 256 + wc * 32 + 4 * fq;
        const float* gp = gate + (size_t)(u.pm >> 3) * NMOD + col0;
        f32x4 gv[2][2];
#pragma unroll
        for (int bj = 0; bj < 2; ++bj)
#pragma unroll
            for (int n = 0; n < 2; ++n) gv[bj][n] = *(const f32x4*)(gp + bj * 128 + n * 16) * scale;
#pragma unroll
        for (int ai = 0; ai < 2; ++ai)
#pragma unroll
            for (int m = 0; m < 4; ++m) { const size_t off = (size_t)(row0 + ai * 128 + m * 16) * D + col0;
#pragma unroll
                for (int bj = 0; bj < 2; ++bj)
#pragma unroll
                    for (int n = 0; n < 2; ++n) { const f32x4 bs = *(const f32x4*)(base + off + bj * 128 + n * 16);
                        *(f32x4*)(out + off + bj * 128 + n * 16) = bs + gv[bj][n] * acc[ai][bj][m][n]; } }
    }
};
template <bool ACCUM> struct EpiGate {
    static constexpr bool PERM = true;
    const bf16_t* R; bf16_t* O;
    __device__ __forceinline__ void operator()(AccRef acc, const pg8::Unit& u, int wr, int wc, int fr, int fq) const {
        const int row0 = u.pm * 256 + wr * 64 + fr, col0 = u.pn * 256 + wc * 32 + 8 * fq;
#pragma unroll
        for (int ai = 0; ai < 2; ++ai)
#pragma unroll
            for (int m = 0; m < 4; ++m) { const size_t row = (size_t)(row0 + ai * 128 + m * 16);
#pragma unroll
                for (int bj = 0; bj < 2; ++bj) { const u32x4 rw = *(const u32x4*)(R + row * NIN + col0 + bj * 128);
                    bf16_t* op = O + row * D + col0 + bj * 128;
                    const f32x4 v0 = acc[ai][bj][m][0], v1 = acc[ai][bj][m][1];
                    float r[8] = {fsigmoid(bf_lo(rw.x)) * v0[0], fsigmoid(bf_hi(rw.x)) * v0[1], fsigmoid(bf_lo(rw.y)) * v0[2], fsigmoid(bf_hi(rw.y)) * v0[3],
                                  fsigmoid(bf_lo(rw.z)) * v1[0], fsigmoid(bf_hi(rw.z)) * v1[1], fsigmoid(bf_lo(rw.w)) * v1[2], fsigmoid(bf_hi(rw.w)) * v1[3]};
                    if (ACCUM) { const u32x4 pw = *(const u32x4*)op;
                        r[0] += bf_lo(pw.x); r[1] += bf_hi(pw.x); r[2] += bf_lo(pw.y); r[3] += bf_hi(pw.y); r[4] += bf_lo(pw.z); r[5] += bf_hi(pw.z); r[6] += bf_lo(pw.w); r[7] += bf_hi(pw.w); }
                    u32x4 w; w.x = pk2(r[0], r[1]); w.y = pk2(r[2], r[3]); w.z = pk2(r[4], r[5]); w.w = pk2(r[6], r[7]);
                    *(u32x4*)op = w; } }
    }
};
template <class Epi> __device__ __forceinline__ void run_gemm(LAS unsigned char* lds, const bf16_t* A, int lda, const bf16_t* Bt, int N, int K, const Epi& E) {
    pg8::Gemm g{A, Bt, T, N, K, lda}; pg8::StaticOrder S; S.init(T, N, (int)gridDim.x, (int)blockIdx.x);
    pg8::gemm_phase<Epi>(lds, g, S, E);
}

__device__ __forceinline__ void transpose_item(const float* W, int ldw, int s0, int k0, bf16_t* WT, int ldk, int d0, LAS float* scr, int lane) {
#pragma unroll 8
    for (int i = 0; i < 32; ++i) { const int kk = 2 * i + (lane >> 5); scr[kk * 33 + (lane & 31)] = W[(size_t)(k0 + kk) * ldw + s0 + (lane & 31)]; }
    LDS_WAIT();
    const int c = lane & 7;
#pragma unroll
    for (int j = 0; j < 4; ++j) { const int n = (lane >> 3) + 8 * j; const LAS float* s = scr + (8 * c) * 33 + n;
        u32x4 o; o.x = pk2(s[0 * 33], s[1 * 33]); o.y = pk2(s[2 * 33], s[3 * 33]); o.z = pk2(s[4 * 33], s[5 * 33]); o.w = pk2(s[6 * 33], s[7 * 33]);
        *(u32x4*)(WT + (size_t)(d0 + n) * ldk + k0 + 8 * c) = o; }
    LDS_WAIT();
}
__device__ __forceinline__ void ffn_weight_items(const float* w_in, const float* w_out, bf16_t* wt_in, bf16_t* wt_out, LAS float* scr, int gw, int ngw, int lane) {
    for (int it = gw; it < 2816 + 1408; it += ngw) {
        if (it < 2816) { const int kb = it / 176, nb = it % 176, d0 = nb * 32, pn = d0 >> 8, bj = (d0 >> 7) & 1, c = d0 & 127, s0 = bj * FF + pn * 128 + c;
            transpose_item(w_in, 2 * FF, s0, kb * 64, wt_in, D, d0, scr, lane); }
        else { const int r = it - 2816, kb = r / 32, nb = r % 32; transpose_item(w_out, D, nb * 32, kb * 64, wt_out, FF, nb * 32, scr, lane); }
    }
}
__device__ __forceinline__ void mixer_weight_items(const Params& p, LAS float* scr, int gw, int ngw, int lane) {
    unsigned char* ws = p.ws;
    for (int it = gw; it < 2816 + 256 + 256 + 512; it += ngw) {
        int r = it;
        if (r < 2816) { const int kb = r / 176, nb = r % 176, d0 = nb * 32, s0 = d0 < C_RSB ? d0 : d0 + 8; transpose_item(p.in[I_WIN], INW, s0, kb * 64, (bf16_t*)(ws + W_IN), D, d0, scr, lane); continue; } r -= 2816;
        if (r < 256) { const int kb = r / 32, nb = r % 32; transpose_item(p.in[I_WUPSB], D, nb * 32, kb * 64, (bf16_t*)(ws + W_UPSB), 512, nb * 32, scr, lane); continue; } r -= 256;
        if (r < 256) { const int kb = r / 32, nb = r % 32; transpose_item(p.in[I_WUPDN], D, nb * 32, kb * 64, (bf16_t*)(ws + W_UPDN), 512, nb * 32, scr, lane); continue; } r -= 256;
        { const int kb = r / 32, nb = r % 32; transpose_item(p.in[I_WOUT], D, nb * 32, kb * 64, (bf16_t*)(ws + W_OUT), D, nb * 32, scr, lane); }
    }
}
__device__ __forceinline__ void mod_item(const Params& p, LAS unsigned char* lds, int cb, int tid, int wave, int lane) {
    LAS float* sc = (LAS float*)lds; LAS float* red = (LAS float*)(lds + 32768);
    for (int i = tid; i < NB * D; i += 512) sc[i] = fsilu(p.in[I_C][i]);
    __syncthreads();
    const float* wa = p.in[I_WADA] + cb * 64 + lane;
    float acc[NB];
#pragma unroll
    for (int b = 0; b < NB; ++b) acc[b] = 0.f;
    for (int k = wave * 128; k < wave * 128 + 128; k += 4) {
        float w[4];
#pragma unroll
        for (int e = 0; e < 4; ++e) w[e] = wa[(size_t)(k + e) * NMOD];
#pragma unroll
        for (int b = 0; b < NB; ++b) { const f32x4 s = *(const LAS f32x4*)(sc + b * D + k); acc[b] += s[0] * w[0] + s[1] * w[1] + s[2] * w[2] + s[3] * w[3]; }
    }
#pragma unroll
    for (int b = 0; b < NB; ++b) red[(wave * NB + b) * 64 + lane] = acc[b];
    __syncthreads();
    { const int b = tid >> 6; float s = p.in[I_BADA][cb * 64 + lane];
#pragma unroll
        for (int w = 0; w < 8; ++w) s += red[(w * NB + b) * 64 + lane];
        ((float*)(p.ws + WS_MOD))[b * NMOD + cb * 64 + lane] = s; }
    __syncthreads();
}

template <bool DN>
__device__ __forceinline__ void norm_mod_phase(const Params& p, LAS unsigned char* lds, const float* src, const float* gain, int midx, bf16_t* dst, int tid, int wave, int lane) {
    const float* mod = (const float*)(p.ws + WS_MOD);
    LAS float* wl = (LAS float*)lds;
    if (DN) { for (int i = tid; i < D * 8; i += 512) { const int k = i >> 3, j = i & 7; wl[8 * k + 4 * (k >> 2) + j] = p.in[I_WIN][(size_t)k * INW + C_RSB + j]; } __syncthreads(); }
    f32x4 g4[4];
#pragma unroll
    for (int j = 0; j < 4; ++j) g4[j] = ((const f32x4*)gain)[lane + 64 * j];
    for (int row = blockIdx.x * 8 + wave; row < T; row += gridDim.x * 8) {
        const int b = row >> 11;
        const f32x4* xr = (const f32x4*)(src + (size_t)row * D) + lane;
        const f32x4* shp = (const f32x4*)(mod + (size_t)b * NMOD + midx * D) + lane; const f32x4* scp = shp + D / 4;
        f32x4 v[4]; float ss = 0.f;
#pragma unroll
        for (int j = 0; j < 4; ++j) { v[j] = xr[64 * j]; ss += (v[j][0] * v[j][0] + v[j][1] * v[j][1]) + (v[j][2] * v[j][2] + v[j][3] * v[j][3]); }
        const float rstd = 1.0f / sqrtf(wave_sum(ss) * (1.f / D) + EPS);
        u32x2* o8 = (u32x2*)(dst + (size_t)row * D) + lane;
        float dot[8];
        if (DN) {
#pragma unroll
            for (int e = 0; e < 8; ++e) dot[e] = 0.f; }
#pragma unroll
        for (int j = 0; j < 4; ++j) { const f32x4 sh = shp[64 * j], sc = scp[64 * j];
            const f32x4 uu = v[j] * rstd * g4[j] * (sc + 1.0f) + sh;
            u32x2 w; w.x = pk2(uu[0], uu[1]); w.y = pk2(uu[2], uu[3]); o8[64 * j] = w;
            if (DN) {
#pragma unroll
                for (int e = 0; e < 4; ++e) { const int k = 4 * lane + 256 * j + e; const LAS f32x4* wp = (const LAS f32x4*)(wl + 8 * k + 4 * (k >> 2)); const f32x4 w0 = wp[0], w1 = wp[1];
                    dot[0] += uu[e] * w0[0]; dot[1] += uu[e] * w0[1]; dot[2] += uu[e] * w0[2]; dot[3] += uu[e] * w0[3];
                    dot[4] += uu[e] * w1[0]; dot[5] += uu[e] * w1[1]; dot[6] += uu[e] * w1[2]; dot[7] += uu[e] * w1[3]; } } }
        if (DN) {
#pragma unroll
            for (int e = 0; e < 8; ++e) dot[e] = wave_sum(dot[e]);
            float mine = dot[0];
#pragma unroll
            for (int e = 1; e < 8; ++e) mine = (lane == e) ? dot[e] : mine;
            if (lane < 8) { float r;
                if (lane < 4) r = 1.0f / (1.0f + expf(-mine));
                else { const int hh = lane - 4; const float a = mine + p.in[I_DTBIAS][hh]; const float sp = a > 20.f ? a : log1pf(expf(a)); r = -expf(p.in[I_ALOG][hh]) * sp; }
                ((float*)(p.ws + WS_BG))[(size_t)row * 8 + lane] = r; } }
    }
    if (DN) __syncthreads();
}

__device__ __forceinline__ void unpack16(const bf16_t* p, float* f) {
    const u32x4 a = ((const u32x4*)p)[0], b = ((const u32x4*)p)[1];
    f[0] = bf_lo(a.x); f[1] = bf_hi(a.x); f[2] = bf_lo(a.y); f[3] = bf_hi(a.y); f[4] = bf_lo(a.z); f[5] = bf_hi(a.z); f[6] = bf_lo(a.w); f[7] = bf_hi(a.w);
    f[8] = bf_lo(b.x); f[9] = bf_hi(b.x); f[10] = bf_lo(b.y); f[11] = bf_hi(b.y); f[12] = bf_lo(b.z); f[13] = bf_hi(b.z); f[14] = bf_lo(b.w); f[15] = bf_hi(b.w);
}
__device__ __forceinline__ void pack16(bf16_t* p, const float* f) {
    u32x4 a, b; a.x = pk2(f[0], f[1]); a.y = pk2(f[2], f[3]); a.z = pk2(f[4], f[5]); a.w = pk2(f[6], f[7]); b.x = pk2(f[8], f[9]); b.y = pk2(f[10], f[11]); b.z = pk2(f[12], f[13]); b.w = pk2(f[14], f[15]);
    ((u32x4*)p)[0] = a; ((u32x4*)p)[1] = b;
}
__device__ __forceinline__ void prep_phase(const Params& p, int wave, int lane) {
    bf16_t* P = (bf16_t*)(p.ws + WS_P); bf16_t* U = (bf16_t*)(p.ws + WS_U);
    const int ch = 16 * lane;
    float gsb[16], wcv[4][16];
    { const float* gp = (ch < 512 ? p.in[I_GQSB] : p.in[I_GKSB]) + (ch & 63); const float sc = ch < 512 ? 0.125f : 1.0f;
#pragma unroll
        for (int e = 0; e < 16; ++e) gsb[e] = gp[e] * sc;
#pragma unroll
        for (int i = 0; i < 4; ++i)
#pragma unroll
            for (int e = 0; e < 16; ++e) wcv[i][e] = p.in[I_WCONV][i * 1536 + ch + e]; }
    for (int row = blockIdx.x * 8 + wave; row < T; row += gridDim.x * 8) {
        const int tl = row & (SEQ - 1);
        { bf16_t* qp = P + (size_t)row * NIN + ch; float f[16]; unpack16(qp, f); float ss = 0.f;
#pragma unroll
            for (int e = 0; e < 16; ++e) ss += f[e] * f[e];
            ss += __shfl_xor(ss, 1); ss += __shfl_xor(ss, 2);
            const float rstd = 1.0f / sqrtf(ss * (1.f / 64.f) + EPS);
#pragma unroll
            for (int e = 0; e < 16; ++e) f[e] = f[e] * rstd * gsb[e];
            pack16(qp, f); }
        { float y[16];
#pragma unroll
            for (int e = 0; e < 16; ++e) y[e] = 0.f;
#pragma unroll
            for (int i = 0; i < 4; ++i) { if (tl - 3 + i >= 0) { float f[16]; unpack16(P + (size_t)(row - 3 + i) * NIN + C_QDN + ch, f);
#pragma unroll
                    for (int e = 0; e < 16; ++e) y[e] += wcv[i][e] * f[e]; } }
            float ss = 0.f;
#pragma unroll
            for (int e = 0; e < 16; ++e) { y[e] = fsilu(y[e]); ss += y[e] * y[e]; }
            ss += __shfl_xor(ss, 1); ss += __shfl_xor(ss, 2); ss += __shfl_xor(ss, 4);
            const float sc = (1.0f / sqrtf(ss + EPS)) * (ch < 512 ? 0.08838834764831845f : 1.0f);
#pragma unroll
            for (int e = 0; e < 16; ++e) y[e] *= sc;
            pack16(U + (size_t)row * D + ch, y); }
    }
    bf16_t* Vt = (bf16_t*)(p.ws + WS_VT);
    for (int it = blockIdx.x * 8 + wave; it < T / 16; it += gridDim.x * 8) {
        const int row0 = it * 16, b = row0 >> 11, tl0 = row0 & (SEQ - 1), c8 = lane * 8, hd = c8 >> 6, d0 = c8 & 63;
        u32x4 w[16];
#pragma unroll
        for (int r = 0; r < 16; ++r) w[r] = *(const u32x4*)(P + (size_t)(row0 + r) * NIN + C_VSB + c8);
#pragma unroll
        for (int e = 0; e < 8; ++e) {
            unsigned o[8];
#pragma unroll
            for (int i = 0; i < 8; ++i) {
                const int p0 = 2 * i, p1 = 2 * i + 1;
                const int k0 = 8 * ((p0 >> 2) & 1) + 4 * (p0 >> 3) + (p0 & 3), k1 = 8 * ((p1 >> 2) & 1) + 4 * (p1 >> 3) + (p1 & 3);
                const unsigned a0 = w[k0][e >> 1], a1 = w[k1][e >> 1];
                const unsigned lo = (e & 1) ? (a0 >> 16) : (a0 & 0xffffu), hi = (e & 1) ? (a1 & 0xffff0000u) : (a1 << 16);
                o[i] = lo | hi; }
            bf16_t* dst = Vt + ((size_t)(b * 8 + hd) * 64 + d0 + e) * SEQ + tl0;
            ((u32x4*)dst)[0] = (u32x4){o[0], o[1], o[2], o[3]}; ((u32x4*)dst)[1] = (u32x4){o[4], o[5], o[6], o[7]}; }
    }
}

__device__ __forceinline__ void attn_item_mfma(bf16_t* P, const bf16_t* Vt, int bh, int qt, int lane) {
    asm volatile("" : "+v"(lane));
    const int b = bh >> 3, h = bh & 7, ql = lane & 31, hh = lane >> 5, q0 = qt * 32;
    bf16_t* qrow = P + (size_t)(b * SEQ + q0 + ql) * NIN + C_QSB + h * 64;
    bf16x8 qf[4];
#pragma unroll
    for (int s = 0; s < 4; ++s) qf[s] = *(const bf16x8*)(qrow + 16 * s + 8 * hh);
    f32x16 o0, o1;
#pragma unroll
    for (int i = 0; i < 16; ++i) { o0[i] = 0.f; o1[i] = 0.f; }
    float R = 1.0f;
    const bf16_t* kb = P + (size_t)(b * SEQ + ql) * NIN + C_KSB + h * 64 + 8 * hh;
    const bf16_t* vb = Vt + ((size_t)bh * 64 + ql) * SEQ + 8 * hh;
    bf16x8 kf[4], vf[4];
#pragma unroll
    for (int s = 0; s < 4; ++s) kf[s] = *(const bf16x8*)(kb + (size_t)q0 * NIN + 16 * s);
#pragma unroll
    for (int j = 0; j < 4; ++j) vf[j] = *(const bf16x8*)(vb + (size_t)(j >> 1) * 32 * SEQ + q0 + 16 * (j & 1));
#pragma unroll 1
    for (int kt = qt; kt >= 0; --kt) {
        f32x16 z;
#pragma unroll
        for (int i = 0; i < 16; ++i) z[i] = 0.f;
#pragma unroll
        for (int s = 0; s < 4; ++s) z = __builtin_amdgcn_mfma_f32_32x32x16_bf16(kf[s], qf[s], z, 0, 0, 0);
        bf16x8 vc[4];
#pragma unroll
        for (int j = 0; j < 4; ++j) vc[j] = vf[j];
        { const int kn = (kt > 0 ? kt - 1 : 0) * 32;
#pragma unroll
            for (int s = 0; s < 4; ++s) kf[s] = *(const bf16x8*)(kb + (size_t)kn * NIN + 16 * s);
#pragma unroll
            for (int j = 0; j < 4; ++j) vf[j] = *(const bf16x8*)(vb + (size_t)(j >> 1) * 32 * SEQ + kn + 16 * (j & 1)); }
        float sg[16], m[16];
        const bool diag = (kt == qt);
#pragma unroll
        for (int i = 0; i < 16; ++i) { const float zz = z[i]; const float e = __builtin_amdgcn_exp2f(-1.4426950408889634f * fabsf(zz)); const float r = __builtin_amdgcn_rcpf(1.0f + e); const float er = e * r;
            float sig = zz >= 0.f ? r : er, mm = zz >= 0.f ? er : r;
            if (diag) { const bool act = ((i & 3) + 8 * (i >> 2) + 4 * hh) < ql; sig = act ? sig : 0.f; mm = act ? mm : 1.0f; }
            sg[i] = sig; m[i] = mm; }
        float g[4], gp[4];
#pragma unroll
        for (int bq = 0; bq < 4; ++bq) { g[bq] = (m[4 * bq] * m[4 * bq + 1]) * (m[4 * bq + 2] * m[4 * bq + 3]); gp[bq] = __shfl_xor(g[bq], 32); }
        float outer[4]; float tb = R;
#pragma unroll
        for (int bq = 3; bq >= 0; --bq) { outer[bq] = tb * (hh == 0 ? gp[bq] : 1.0f); tb *= g[bq] * gp[bq]; }
        R = tb;
        float w[16];
#pragma unroll
        for (int bq = 0; bq < 4; ++bq) { const float s3 = outer[bq], s2 = s3 * m[4 * bq + 3], s1 = s2 * m[4 * bq + 2], s0 = s1 * m[4 * bq + 1];
            w[4 * bq + 3] = sg[4 * bq + 3] * s3; w[4 * bq + 2] = sg[4 * bq + 2] * s2; w[4 * bq + 1] = sg[4 * bq + 1] * s1; w[4 * bq] = sg[4 * bq] * s0; }
        bf16x8 wf[2];
#pragma unroll
        for (int s2 = 0; s2 < 2; ++s2) { const u32x4 pw = {cpk2(w[8 * s2], w[8 * s2 + 1]), cpk2(w[8 * s2 + 2], w[8 * s2 + 3]), cpk2(w[8 * s2 + 4], w[8 * s2 + 5]), cpk2(w[8 * s2 + 6], w[8 * s2 + 7])}; wf[s2] = __builtin_bit_cast(bf16x8, pw); }
        o0 = __builtin_amdgcn_mfma_f32_32x32x16_bf16(vc[0], wf[0], o0, 0, 0, 0); o0 = __builtin_amdgcn_mfma_f32_32x32x16_bf16(vc[1], wf[1], o0, 0, 0, 0);
        o1 = __builtin_amdgcn_mfma_f32_32x32x16_bf16(vc[2], wf[0], o1, 0, 0, 0); o1 = __builtin_amdgcn_mfma_f32_32x32x16_bf16(vc[3], wf[1], o1, 0, 0, 0);
    }
#pragma unroll
    for (int bq = 0; bq < 4; ++bq) {
        u32x2 w0 = {cpk2(o0[4 * bq], o0[4 * bq + 1]), cpk2(o0[4 * bq + 2], o0[4 * bq + 3])}, w1 = {cpk2(o1[4 * bq], o1[4 * bq + 1]), cpk2(o1[4 * bq + 2], o1[4 * bq + 3])};
        *(u32x2*)(qrow + 8 * bq + 4 * hh) = w0; *(u32x2*)(qrow + 32 + 8 * bq + 4 * hh) = w1; }
}
__device__ __forceinline__ size_t slotU(size_t t0, int h, int colbase, int f) { return (t0 + (size_t)(f >> 7)) * D + colbase + h * 128 + (f & 127); }
__device__ __forceinline__ size_t slotP(size_t t0, int h, int colbase, int f) { return (t0 + (size_t)(f >> 7)) * NIN + colbase + h * 128 + (f & 127); }
__device__ __forceinline__ int permpos(int x) { const int k = x & 15; return (x & ~15) + 8 * ((k >> 2) & 1) + 4 * (k >> 3) + (k & 3); }
__device__ __forceinline__ int crow(int r, int hh) { return (r & 3) + 8 * (r >> 2) + 4 * hh; }
__device__ __forceinline__ bf16x8 pack8(const f32x16& x, int s2) {
    const u32x4 pw = {cpk2(x[8 * s2], x[8 * s2 + 1]), cpk2(x[8 * s2 + 2], x[8 * s2 + 3]), cpk2(x[8 * s2 + 4], x[8 * s2 + 5]), cpk2(x[8 * s2 + 6], x[8 * s2 + 7])};
    return __builtin_bit_cast(bf16x8, pw);
}
#define MFMA32(a, b, c) __builtin_amdgcn_mfma_f32_32x32x16_bf16((a), (b), (c), 0, 0, 0)
constexpr int PT = 72, PQ = 136, PL = 68;
__device__ __forceinline__ void gdn_chunk_prep(const Params& p, LAS unsigned char* lds, int item, int tid, int wave, int lane) {
    asm volatile("" : "+v"(tid), "+v"(lane));
    const int bh = item >> 5, n = item & 31, b = bh >> 2, h = bh & 3, ql = lane & 31, hh = lane >> 5;
    const size_t t0 = (size_t)b * SEQ + n * 64;
    bf16_t* P = (bf16_t*)(p.ws + WS_P); bf16_t* U = (bf16_t*)(p.ws + WS_U); const float* BG = (const float*)(p.ws + WS_BG);
    LAS float* gcS = (LAS float*)lds; LAS float* btS = gcS + 64;
    LAS float* LS = (LAS float*)(lds + 1024);
    LAS bf16_t* TuS = (LAS bf16_t*)(lds + 1024 + 64 * PL * 4); LAS bf16_t* TwS = TuS + 64 * PT;
    LAS bf16_t* kT = TwS + 64 * PT; LAS bf16_t* vT = kT + 128 * PT; LAS bf16_t* qS = vT + 128 * PT;
    if (tid < 64) { float x = BG[(t0 + tid) * 8 + 4 + h];
#pragma unroll
        for (int o = 1; o < 64; o <<= 1) { const float y = __shfl_up(x, o); if (lane >= o) x += y; }
        gcS[tid] = x; btS[tid] = BG[(t0 + tid) * 8 + h]; }
    { const int tok = tid >> 3, c16 = (tid & 7) * 16; float f[16];
        unpack16(U + (t0 + tok) * D + 512 + h * 128 + c16, f);
#pragma unroll
        for (int e = 0; e < 16; ++e) kT[(c16 + e) * PT + tok] = f2bf(f[e]);
        const u32x4 qa = *(const u32x4*)(U + (t0 + tok) * D + h * 128 + c16), qb = *(const u32x4*)(U + (t0 + tok) * D + h * 128 + c16 + 8);
        *(LAS u32x4*)(qS + tok * PQ + c16) = qa; *(LAS u32x4*)(qS + tok * PQ + c16 + 8) = qb;
        float y[16];
#pragma unroll
        for (int e = 0; e < 16; ++e) y[e] = 0.f;
#pragma unroll
        for (int i = 0; i < 4; ++i) { if (n * 64 + tok - 3 + i >= 0) { float x[16]; unpack16(P + (t0 + tok - 3 + i) * NIN + C_VDN + h * 128 + c16, x);
                const float* wp = p.in[I_WCONV] + i * 1536 + 1024 + h * 128 + c16;
#pragma unroll
                for (int e = 0; e < 16; ++e) y[e] += wp[e] * x[e]; } }
#pragma unroll
        for (int e = 0; e < 16; ++e) vT[(c16 + e) * PT + tok] = f2bf(fsilu(y[e])); }
    __syncthreads();
    const bf16_t* kg = U + t0 * D + 512 + h * 128 + 8 * hh; const bf16_t* qg = U + t0 * D + h * 128 + 8 * hh;
    if (wave == 0) {
        bf16x8 kf[2][8];
#pragma unroll
        for (int t = 0; t < 2; ++t)
#pragma unroll
        for (int ks = 0; ks < 8; ++ks) kf[t][ks] = *(const bf16x8*)(kg + (size_t)(32 * t + ql) * D + 16 * ks);
#pragma unroll
        for (int tt = 0; tt < 3; ++tt) { const int it = tt == 0 ? 0 : 1, jt = tt == 2 ? 1 : 0;
            f32x16 acc;
#pragma unroll
            for (int r = 0; r < 16; ++r) acc[r] = 0.f;
#pragma unroll
            for (int ks = 0; ks < 8; ++ks) acc = MFMA32(kf[it][ks], kf[jt][ks], acc);
            const int j = 32 * jt + ql; const float gj = gcS[j];
#pragma unroll
            for (int r = 0; r < 16; ++r) { const int i = 32 * it + crow(r, hh); LS[i * PL + j] = (j < i) ? btS[i] * acc[r] * fexp(gcS[i] - gj) : 0.f; } }
    }
    __syncthreads();
    if (wave == 0) {
        float Tc[64];
#pragma unroll
        for (int i = 0; i < 64; ++i) {
            float acc = (lane == i) ? 1.0f : 0.f;
#pragma unroll
            for (int j4 = 0; j4 < i; j4 += 4) { const f32x4 l4 = *(const LAS f32x4*)(LS + i * PL + j4);
                acc -= l4[0] * Tc[j4]; if (j4 + 1 < i) acc -= l4[1] * Tc[j4 + 1]; if (j4 + 2 < i) acc -= l4[2] * Tc[j4 + 2]; if (j4 + 3 < i) acc -= l4[3] * Tc[j4 + 3]; }
            Tc[i] = acc; __builtin_amdgcn_sched_barrier(0); }
        const float bu = btS[lane], bw = bu * fexp(gcS[lane]);
#pragma unroll
        for (int i = 0; i < 64; ++i) { TuS[i * PT + lane] = f2bf(Tc[i] * bu); TwS[i * PT + lane] = f2bf(Tc[i] * bw); }
    }
    __syncthreads();
    bf16x8 aqf[2][4];
    {
        bf16x8 kf[2][8];
#pragma unroll
    for (int t = 0; t < 2; ++t)
#pragma unroll
        for (int ks = 0; ks < 8; ++ks) kf[t][ks] = *(const bf16x8*)(kg + (size_t)(32 * t + ql) * D + 16 * ks);
#pragma unroll
        for (int it = 0; it < 2; ++it) {
            bf16x8 qf[8];
#pragma unroll
            for (int ks = 0; ks < 8; ++ks) qf[ks] = *(const bf16x8*)(qg + (size_t)(32 * it + ql) * D + 16 * ks);
            const int i = 32 * it + ql; const float gi = gcS[i];
#pragma unroll
            for (int jt = 0; jt < 2; ++jt) {
                if (jt > it) { const u32x4 zz = {0u, 0u, 0u, 0u}; aqf[it][2 * jt] = __builtin_bit_cast(bf16x8, zz); aqf[it][2 * jt + 1] = __builtin_bit_cast(bf16x8, zz); continue; }
                f32x16 acc;
#pragma unroll
                for (int r = 0; r < 16; ++r) acc[r] = 0.f;
#pragma unroll
                for (int ks = 0; ks < 8; ++ks) acc = MFMA32(kf[jt][ks], qf[ks], acc);
#pragma unroll
                for (int r = 0; r < 16; ++r) { const int j = 32 * jt + crow(r, hh); acc[r] = (j <= i) ? acc[r] * fexp(gi - gcS[j]) : 0.f; }
                aqf[it][2 * jt] = pack8(acc, 0); aqf[it][2 * jt + 1] = pack8(acc, 1); } }
    }
    __syncthreads();
    {
        const int isW = wave >> 2, ct = wave & 3, col = 32 * ct + ql;
        const LAS bf16_t* Ta = (isW ? TwS : TuS) + 8 * hh; const LAS bf16_t* Bs = (isW ? kT : vT) + col * PT + 8 * hh;
        bf16x8 bf[4];
#pragma unroll
        for (int ks = 0; ks < 4; ++ks) bf[ks] = *(const LAS bf16x8*)(Bs + 16 * ks);
        f32x16 xa[2];
#pragma unroll
        for (int jt = 0; jt < 2; ++jt) {
#pragma unroll
            for (int r = 0; r < 16; ++r) xa[jt][r] = 0.f;
#pragma unroll
            for (int ks = 0; ks < 4; ++ks) xa[jt] = MFMA32(*(const LAS bf16x8*)(Ta + (32 * jt + ql) * PT + 16 * ks), bf[ks], xa[jt]); }
        bf16x8 xb[4] = {pack8(xa[0], 0), pack8(xa[0], 1), pack8(xa[1], 0), pack8(xa[1], 1)};
        f32x16 ra[2];
#pragma unroll
        for (int it = 0; it < 2; ++it) {
#pragma unroll
            for (int r = 0; r < 16; ++r) ra[it][r] = 0.f;
#pragma unroll
            for (int kk = 0; kk < 4; ++kk) ra[it] = MFMA32(aqf[it][kk], xb[kk], ra[it]); }
        if (!isW) {
#pragma unroll
            for (int jt = 0; jt < 2; ++jt)
#pragma unroll
                for (int bq = 0; bq < 4; ++bq) { const int f = col * 64 + 32 * jt + 8 * bq + 4 * hh;
                    *(u32x2*)(U + slotU(t0, h, 0, f)) = (u32x2){cpk2(xa[jt][4 * bq], xa[jt][4 * bq + 1]), cpk2(xa[jt][4 * bq + 2], xa[jt][4 * bq + 3])};
                    *(u32x2*)(U + slotU(t0, h, 512, f)) = (u32x2){cpk2(ra[jt][4 * bq], ra[jt][4 * bq + 1]), cpk2(ra[jt][4 * bq + 2], ra[jt][4 * bq + 3])}; }
        } else {
            const int pc = permpos(col);
#pragma unroll
            for (int jt = 0; jt < 2; ++jt)
#pragma unroll
                for (int r = 0; r < 16; ++r) { const int tok = 32 * jt + crow(r, hh);
                    P[(t0 + tok) * NIN + C_QDN + h * 128 + pc] = f2bf(-xa[jt][r]);
                    P[(t0 + tok) * NIN + C_KDN + h * 128 + pc] = f2bf(bf2f(qS[tok * PQ + col]) * fexp(gcS[tok]) - ra[jt][r]); }
        }
        { const int dk = tid >> 2, blk = tid & 3; const float gl = gcS[63];
            const u32x4 k0 = *(const LAS u32x4*)(kT + dk * PT + 16 * blk), k1 = *(const LAS u32x4*)(kT + dk * PT + 16 * blk + 8);
            float kv[16] = {bf_lo(k0.x), bf_hi(k0.x), bf_lo(k0.y), bf_hi(k0.y), bf_lo(k0.z), bf_hi(k0.z), bf_lo(k0.w), bf_hi(k0.w), bf_lo(k1.x), bf_hi(k1.x), bf_lo(k1.y), bf_hi(k1.y), bf_lo(k1.z), bf_hi(k1.z), bf_lo(k1.w), bf_hi(k1.w)};
#pragma unroll
            for (int e = 0; e < 16; ++e) kv[e] *= fexp(gl - gcS[16 * blk + e]);
            float pv[16];
#pragma unroll
            for (int e = 0; e < 16; ++e) pv[permpos(e)] = kv[e];
            pack16(P + slotP(t0, h, C_VSB, dk * 64 + 16 * blk), pv);
            if (tid == 0) ((float*)(p.ws + WS_EGL))[bh * 32 + n] = fexp(gl); }
    }
    __syncthreads();
}
constexpr int SC_PW = 136, SC_PK = 72, SC_NW = 0, SC_Q2 = 64 * SC_PW * 2, SC_KD = 2 * 64 * SC_PW * 2, SC_STAGE = 2 * 64 * SC_PW * 2 + 128 * SC_PK * 2;
static_assert(2 * SC_STAGE <= 131072, "scan LDS");
__device__ __forceinline__ void gdn_scan_block(const Params& p, LAS unsigned char* lds, int bh, int tid, int wave, int lane) {
    asm volatile("" : "+v"(tid), "+v"(lane));
    bf16_t* P = (bf16_t*)(p.ws + WS_P); const bf16_t* U = (const bf16_t*)(p.ws + WS_U); const float* EGL = (const float*)(p.ws + WS_EGL);
    const int b = bh >> 2, h = bh & 3, ql = lane & 31, hh = lane >> 5;
    const size_t tb = (size_t)b * SEQ;
    if (wave >= 4) {
        const int lt = tid - 256;
        u32x4 r[12];
#define SC_LOAD(n_) do { const size_t t0_ = tb + (size_t)(n_) * 64; _Pragma("unroll") for (int i = 0; i < 4; ++i) { const int c = lt + 256 * i, row = c >> 4, c8 = (c & 15) * 8; \
            const bf16_t* g_ = P + (t0_ + row) * NIN + h * 128 + c8; r[i] = *(const u32x4*)(g_ + C_QDN); r[4 + i] = *(const u32x4*)(g_ + C_KDN); r[8 + i] = *(const u32x4*)(g_ + C_VSB); } } while (0)
#define SC_STORE(st_) do { LAS unsigned char* s_ = lds + (st_) * SC_STAGE; _Pragma("unroll") for (int i = 0; i < 4; ++i) { const int c = lt + 256 * i, row = c >> 4, c8 = (c & 15) * 8; \
            *(LAS u32x4*)(s_ + SC_NW + (row * SC_PW + c8) * 2) = r[i]; *(LAS u32x4*)(s_ + SC_Q2 + (row * SC_PW + c8) * 2) = r[4 + i]; \
            *(LAS u32x4*)(s_ + SC_KD + ((2 * row + (c8 >> 6)) * SC_PK + (c8 & 63)) * 2) = r[8 + i]; } } while (0)
        SC_LOAD(0); SC_STORE(0);
        __syncthreads();
#pragma unroll 1
        for (int n = 0; n < 32; ++n) {
            if (n + 1 < 32) { SC_LOAD(n + 1); SC_STORE((n + 1) & 1); }
            __syncthreads();
        }
#undef SC_LOAD
#undef SC_STORE
    } else {
        const int col = 32 * wave + ql;
        f32x16 S[4];
#pragma unroll
        for (int rt = 0; rt < 4; ++rt)
#pragma unroll
            for (int r = 0; r < 16; ++r) S[rt][r] = 0.f;
        u32x2 pu[8], po[8];
#define SC_PRE(n_) do { const size_t t0_ = tb + (size_t)(n_) * 64; _Pragma("unroll") for (int jt = 0; jt < 2; ++jt) _Pragma("unroll") for (int bq = 0; bq < 4; ++bq) { const int f = col * 64 + 32 * jt + 8 * bq + 4 * hh; \
            pu[jt * 4 + bq] = *(const u32x2*)(U + slotU(t0_, h, 0, f)); po[jt * 4 + bq] = *(const u32x2*)(U + slotU(t0_, h, 512, f)); } } while (0)
        SC_PRE(0);
        __syncthreads();
#pragma unroll 1
        for (int n = 0; n < 32; ++n) {
            const size_t t0 = tb + (size_t)n * 64;
            const float egl = EGL[bh * 32 + n];
            const LAS unsigned char* st = lds + (n & 1) * SC_STAGE;
            bf16x8 Sb[8];
#pragma unroll
            for (int rt = 0; rt < 4; ++rt) { Sb[2 * rt] = pack8(S[rt], 0); Sb[2 * rt + 1] = pack8(S[rt], 1); }
            f32x16 vn[2], oa[2];
#pragma unroll
            for (int jt = 0; jt < 2; ++jt)
#pragma unroll
                for (int bq = 0; bq < 4; ++bq) { const u32x2 uw = pu[jt * 4 + bq], ow = po[jt * 4 + bq];
                    vn[jt][4 * bq] = bf_lo(uw.x); vn[jt][4 * bq + 1] = bf_hi(uw.x); vn[jt][4 * bq + 2] = bf_lo(uw.y); vn[jt][4 * bq + 3] = bf_hi(uw.y);
                    oa[jt][4 * bq] = bf_lo(ow.x); oa[jt][4 * bq + 1] = bf_hi(ow.x); oa[jt][4 * bq + 2] = bf_lo(ow.y); oa[jt][4 * bq + 3] = bf_hi(ow.y); }
            if (n + 1 < 32) SC_PRE(n + 1);
#pragma unroll
            for (int jt = 0; jt < 2; ++jt) { const LAS unsigned char* wr_ = st + ((32 * jt + ql) * SC_PW + 8 * hh) * 2;
#pragma unroll
                for (int ks = 0; ks < 8; ++ks) { vn[jt] = MFMA32(*(const LAS bf16x8*)(wr_ + SC_NW + 32 * ks), Sb[ks], vn[jt]); oa[jt] = MFMA32(*(const LAS bf16x8*)(wr_ + SC_Q2 + 32 * ks), Sb[ks], oa[jt]); } }
            bf16x8 vb[4] = {pack8(vn[0], 0), pack8(vn[0], 1), pack8(vn[1], 0), pack8(vn[1], 1)};
#pragma unroll
            for (int rt = 0; rt < 4; ++rt) {
#pragma unroll
                for (int r = 0; r < 16; ++r) S[rt][r] *= egl;
                const LAS unsigned char* kr_ = st + SC_KD + ((32 * rt + ql) * SC_PK + 8 * hh) * 2;
#pragma unroll
                for (int ks = 0; ks < 4; ++ks) S[rt] = MFMA32(*(const LAS bf16x8*)(kr_ + 32 * ks), vb[ks], S[rt]); }
#pragma unroll
            for (int jt = 0; jt < 2; ++jt)
#pragma unroll
                for (int r = 0; r < 16; ++r) P[(t0 + 32 * jt + crow(r, hh)) * NIN + C_VDN + h * 128 + col] = f2bf(oa[jt][r]);
            __syncthreads();
        }
#undef SC_PRE
    }
}
__device__ __forceinline__ void gdn_finalize_phase(const Params& p, int wave, int lane) {
    bf16_t* P = (bf16_t*)(p.ws + WS_P);
    const int c0 = (lane & 15) * 8;
    float gg[8];
#pragma unroll
    for (int e = 0; e < 8; ++e) gg[e] = p.in[I_GDNOUT][c0 + e];
    for (int row = blockIdx.x * 8 + wave; row < T; row += gridDim.x * 8) {
        bf16_t* op = P + (size_t)row * NIN + C_VDN + lane * 8; const bf16_t* zp = P + (size_t)row * NIN + C_ZDN + lane * 8;
        const u32x4 ow = *(const u32x4*)op, zw = *(const u32x4*)zp;
        const float o[8] = {bf_lo(ow.x), bf_hi(ow.x), bf_lo(ow.y), bf_hi(ow.y), bf_lo(ow.z), bf_hi(ow.z), bf_lo(ow.w), bf_hi(ow.w)};
        const float z[8] = {bf_lo(zw.x), bf_hi(zw.x), bf_lo(zw.y), bf_hi(zw.y), bf_lo(zw.z), bf_hi(zw.z), bf_lo(zw.w), bf_hi(zw.w)};
        float ss = 0.f;
#pragma unroll
        for (int e = 0; e < 8; ++e) ss += o[e] * o[e];
        ss += __shfl_xor(ss, 1); ss += __shfl_xor(ss, 2); ss += __shfl_xor(ss, 4); ss += __shfl_xor(ss, 8);
        const float rstd = 1.0f / sqrtf(ss * (1.f / 128.f) + EPS);
        float r[8];
#pragma unroll
        for (int e = 0; e < 8; ++e) r[e] = o[e] * rstd * gg[e] * fsilu(z[e]);
        u32x4 w; w.x = pk2(r[0], r[1]); w.y = pk2(r[2], r[3]); w.z = pk2(r[4], r[5]); w.w = pk2(r[6], r[7]);
        *(u32x4*)op = w;
    }
}

#define XB_TMO      128
#define XB_XCNT(j)  (256  + 64 * (j))
#define XB_XSUB(j)  (1280 + 64 * (j))
#define XB_XGEN(j)  (2304 + 64 * (j))
#define XB_TOP      3328
#define XB_TOPGEN   3392
#define XCD_BAR_WORDS 3456
#define XB_SPIN_CAP (1u << 18)
__device__ __forceinline__ unsigned xb_ld(unsigned* p)              { return __hip_atomic_load(p, __ATOMIC_RELAXED, __HIP_MEMORY_SCOPE_AGENT); }
__device__ __forceinline__ unsigned xb_add(unsigned* p, unsigned v) { return __hip_atomic_fetch_add(p, v, __ATOMIC_RELAXED, __HIP_MEMORY_SCOPE_AGENT); }
__device__ __forceinline__ unsigned xb_xcc_id() { return (unsigned)__builtin_amdgcn_s_getreg((3 << 11) | 20) & 0xFu; }
#define XB_SPIN(cond, bar) do { unsigned _sp = 0; while (cond) { __builtin_amdgcn_s_sleep(1); \
    if ((++_sp & 255u) == 0u) { if (xb_ld(&(bar)[XB_TMO])) break; if (_sp > XB_SPIN_CAP) { atomicAdd(&(bar)[XB_TMO], 1u); break; } } } } while (0)
struct XcdBarrier { unsigned* bar; unsigned x; volatile LAS unsigned* st; };
__device__ __forceinline__ XcdBarrier xcd_barrier_post(unsigned* bar, volatile LAS unsigned* st) {
    XcdBarrier b; b.bar = bar; b.x = xb_xcc_id(); b.st = st;
    if (threadIdx.x == 0) (void)xb_add(&bar[XB_XCNT(b.x)], 1u);
    return b;
}
__device__ __forceinline__ void xcd_barrier_complete(unsigned* bar, unsigned x, unsigned& nloc, unsigned& nx) {
    const unsigned G = gridDim.x * gridDim.y * gridDim.z;
    unsigned sum, cnt, mine, sp = 0u;
    for (;;) {
        sum = 0u; cnt = 0u; mine = 0u;
#pragma unroll
        for (unsigned j = 0; j < 16; ++j) { const unsigned c = xb_ld(&bar[XB_XCNT(j)]); sum += c; cnt += (c > 0u) ? 1u : 0u; mine = (j == x) ? c : mine; }
        if (sum == G) break;
        __builtin_amdgcn_s_sleep(1);
        if ((++sp & 255u) == 0u) { if (xb_ld(&bar[XB_TMO])) break; if (sp > XB_SPIN_CAP) { atomicAdd(&bar[XB_TMO], 1u); break; } }
    }
    nloc = mine > 0u ? mine : 1u; nx = cnt > 0u ? cnt : 1u;
}
__device__ __forceinline__ void xcd_barrier(const XcdBarrier& b) {
    asm volatile("s_waitcnt vmcnt(0)" ::: "memory");
    __syncthreads();
    if (threadIdx.x == 0) {
        unsigned* bar = b.bar;
        __builtin_amdgcn_s_waitcnt(0);
        unsigned nloc = b.st[0], nx = b.st[1];
        if (nloc == 0u) { xcd_barrier_complete(bar, b.x, nloc, nx); b.st[0] = nloc; b.st[1] = nx; }
        const unsigned old = xb_add(&bar[XB_XSUB(b.x)], 1u);
        const unsigned gen = old / nloc;
        if (old + 1u == (gen + 1u) * nloc) {
            __builtin_amdgcn_fence(__ATOMIC_RELEASE, "agent");
            asm volatile("s_waitcnt vmcnt(0)" ::: "memory");
            const unsigned og = xb_add(&bar[XB_TOP], 1u);
            const unsigned tg = og / nx;
            if (og + 1u == (tg + 1u) * nx) xb_add(&bar[XB_TOPGEN], 1u);
            else XB_SPIN(xb_ld(&bar[XB_TOPGEN]) == tg, bar);
            __builtin_amdgcn_fence(__ATOMIC_ACQUIRE, "agent");
            xb_add(&bar[XB_XGEN(b.x)], 1u);
            asm volatile("s_waitcnt vmcnt(0)" ::: "memory");
        } else {
            XB_SPIN(xb_ld(&bar[XB_XGEN(b.x)]) == gen, bar);
            __builtin_amdgcn_fence(__ATOMIC_ACQUIRE, "agent");
            asm volatile("s_waitcnt vmcnt(0)" ::: "memory");
        }
    }
    __syncthreads();
}

#ifndef PHMASK
#define PHMASK 0xFFFF
#endif
#define PH(n) ((PHMASK >> (n)) & 1)
#ifndef PROBE
#define PROBE 0
#endif
#define REP(g) for (int _rep = 0; _rep < ((PROBE == (g)) ? 2 : 1); ++_rep)
__global__ void __launch_bounds__(512, 2) fwd_megakernel(Params p) {
    extern __shared__ __attribute__((aligned(16))) unsigned char lds_raw[];
    LAS unsigned char* lds = (LAS unsigned char*)lds_raw;
    cg::grid_group grid = cg::this_grid();
    const int tid = threadIdx.x, lane = tid & 63, wave = __builtin_amdgcn_readfirstlane(tid >> 6);
    const int G = gridDim.x, gw = wave * G + blockIdx.x, ngw = G * 8;
    unsigned char* ws = p.ws;
    bf16_t* U = (bf16_t*)(ws + WS_U); bf16_t* P = (bf16_t*)(ws + WS_P);
    const float* mod = (const float*)(ws + WS_MOD);
    LAS float* scr = (LAS float*)(lds + wave * 16384);

    unsigned* barw = (unsigned*)(ws + WS_BAR);
    if (blockIdx.x == 0) {
        if (tid == 0) __hip_atomic_store((unsigned*)(ws + WS_CTR), 0u, __ATOMIC_RELAXED, __HIP_MEMORY_SCOPE_AGENT);
        if (tid == 1) __hip_atomic_store(&barw[XB_TMO], 0u, __ATOMIC_RELAXED, __HIP_MEMORY_SCOPE_AGENT);
        if (tid == 2) __hip_atomic_store(&barw[XB_TOP], 0u, __ATOMIC_RELAXED, __HIP_MEMORY_SCOPE_AGENT);
        if (tid == 3) __hip_atomic_store(&barw[XB_TOPGEN], 0u, __ATOMIC_RELAXED, __HIP_MEMORY_SCOPE_AGENT);
        if (tid >= 64 && tid < 80) { const int j = tid - 64; __hip_atomic_store(&barw[XB_XCNT(j)], 0u, __ATOMIC_RELAXED, __HIP_MEMORY_SCOPE_AGENT); __hip_atomic_store(&barw[XB_XSUB(j)], 0u, __ATOMIC_RELAXED, __HIP_MEMORY_SCOPE_AGENT); __hip_atomic_store(&barw[XB_XGEN(j)], 0u, __ATOMIC_RELAXED, __HIP_MEMORY_SCOPE_AGENT); }
    }
    volatile LAS unsigned* bst = (volatile LAS unsigned*)(lds + 131072);
    if (tid < 2) bst[tid] = 0u;
    __syncthreads();
    REP(1) { if (PH(0)) for (int it = blockIdx.x; it < NMOD / 64; it += G) mod_item(p, lds, it, tid, wave, lane);
    if (PH(0)) ffn_weight_items(p.in[I_WFFN1IN], p.in[I_WFFN1OUT], (bf16_t*)(ws + W_FFIN), (bf16_t*)(ws + W_FFOUT), scr, gw, ngw, lane);
    if (PH(0)) mixer_weight_items(p, scr, gw, ngw, lane); __syncthreads(); }
    grid.sync();
    const XcdBarrier xbar = xcd_barrier_post(barw, bst);
    if (PROBE == 3) for (int i = 0; i < 16; ++i) xcd_barrier(xbar);
    REP(1) if (PH(1)) norm_mod_phase<false>(p, lds, p.in[I_X], p.in[I_GFFN1], 0, U, tid, wave, lane);
    xcd_barrier(xbar);
    REP(2) if (PH(2)) run_gemm(lds, U, D, (const bf16_t*)(ws + W_FFIN), 2 * FF, D, EpiSwiGLU{P, FF});
    xcd_barrier(xbar);
    REP(2) if (PH(3)) run_gemm(lds, P, FF, (const bf16_t*)(ws + W_FFOUT), D, FF, EpiResid{p.in[I_X], p.out, mod + 2 * D, 0.5f});
    xcd_barrier(xbar);
    REP(1) if (PH(4)) norm_mod_phase<true>(p, lds, p.out, p.in[I_GMIX], 3, U, tid, wave, lane);
    xcd_barrier(xbar);
    REP(2) if (PH(5)) run_gemm(lds, U, D, (const bf16_t*)(ws + W_IN), NIN, D, EpiBf16{P, NIN});
    xcd_barrier(xbar);
    if (PH(6)) prep_phase(p, wave, lane);
    xcd_barrier(xbar);
    if (PH(7)) for (int it = blockIdx.x; it < 1024; it += G) gdn_chunk_prep(p, lds, it, tid, wave, lane);
    xcd_barrier(xbar);
    if (PH(15)) for (int it = blockIdx.x; it < 32; it += G) gdn_scan_block(p, lds, it, tid, wave, lane);
    if (PH(8)) { unsigned* ctr = (unsigned*)(ws + WS_CTR);
        for (;;) { unsigned idx = 0; if (lane == 0) idx = atomicAdd(ctr, 1u); idx = __builtin_amdgcn_readfirstlane(idx);
            if (idx >= 4096u) break;
            attn_item_mfma(P, (const bf16_t*)(ws + WS_VT), (int)(idx & 63u), 63 - (int)(idx >> 6), lane); } }
    xcd_barrier(xbar);
    if (PH(9)) gdn_finalize_phase(p, wave, lane);
    xcd_barrier(xbar);
    if (PH(10)) run_gemm(lds, P + C_QSB, NIN, (const bf16_t*)(ws + W_UPSB), D, 512, EpiGate<false>{P + C_RSB, U});
    if (PH(10)) run_gemm(lds, P + C_VDN, NIN, (const bf16_t*)(ws + W_UPDN), D, 512, EpiGate<true>{P + C_RDN, U});
    xcd_barrier(xbar);
    if (PH(11)) run_gemm(lds, U, D, (const bf16_t*)(ws + W_OUT), D, D, EpiResid{p.out, p.out, mod + 5 * D, 1.0f});
    xcd_barrier(xbar);
    REP(1) if (PH(12)) norm_mod_phase<false>(p, lds, p.out, p.in[I_GFFN2], 6, U, tid, wave, lane);
    __syncthreads();
    if (PH(12)) ffn_weight_items(p.in[I_WFFN2IN], p.in[I_WFFN2OUT], (bf16_t*)(ws + W_FFIN), (bf16_t*)(ws + W_FFOUT), scr, gw, ngw, lane);
    xcd_barrier(xbar);
    REP(2) if (PH(13)) run_gemm(lds, U, D, (const bf16_t*)(ws + W_FFIN), 2 * FF, D, EpiSwiGLU{P, FF});
    xcd_barrier(xbar);
    if (PH(14)) run_gemm(lds, P, FF, (const bf16_t*)(ws + W_FFOUT), D, FF, EpiResid{p.out, p.out, mod + 8 * D, 0.5f});
}

extern "C" void kernel_launch(void* const* d_in, const int* in_sizes, int n_in, void* d_out, int out_size, void* d_ws, size_t ws_size, hipStream_t stream) {
    static int grid_blocks = 0;
    if (!grid_blocks) {
        int dev = 0, cus = 0, per_cu = 0;
        (void)hipGetDevice(&dev);
        (void)hipDeviceGetAttribute(&cus, hipDeviceAttributeMultiprocessorCount, dev);
        (void)hipFuncSetAttribute((const void*)fwd_megakernel, hipFuncAttributeMaxDynamicSharedMemorySize, LDS_BYTES);
        (void)hipOccupancyMaxActiveBlocksPerMultiprocessor(&per_cu, (const void*)fwd_megakernel, 512, LDS_BYTES);
        if (per_cu < 1) { fprintf(stderr, "occupancy query says %d blocks/CU\n", per_cu); per_cu = 1; }
        grid_blocks = cus;
    }
    Params p{};
    for (int i = 0; i < N_IN; ++i) p.in[i] = (const float*)d_in[i];
    p.out = (float*)d_out; p.ws = (unsigned char*)d_ws;
    void* args[] = {&p};
    hipError_t e = hipLaunchCooperativeKernel((const void*)fwd_megakernel, dim3(grid_blocks), dim3(512), args, LDS_BYTES, stream);
    if (e != hipSuccess) fprintf(stderr, "cooperative launch failed: %s (grid %d)\n", hipGetErrorString(e), grid_blocks);
}
```

```cpp
#include <hip/hip_runtime.h>
#include <hip/hip_cooperative_groups.h>
#include <cstdio>
namespace cg = cooperative_groups;

#define LAS __attribute__((address_space(3)))
typedef unsigned short bf16_t;
typedef short bf16x8 __attribute__((ext_vector_type(8)));
typedef float f32x4 __attribute__((ext_vector_type(4)));
typedef unsigned u32x4 __attribute__((ext_vector_type(4)));
typedef unsigned u32x2 __attribute__((ext_vector_type(2)));
typedef float f32x16 __attribute__((ext_vector_type(16)));
typedef float f32x2 __attribute__((ext_vector_type(2)));
typedef __bf16 nbf16x2 __attribute__((ext_vector_type(2)));

constexpr int T = 16384, D = 1024, SEQ = 2048, NB = 8, FF = 2816, NIN = 5632, INW = 5640, NMOD = 9216;
constexpr int C_QSB = 0, C_KSB = 512, C_VSB = 1024, C_QDN = 1536, C_KDN = 2048, C_VDN = 2560, C_ZDN = 3072, C_RSB = 3584, C_RDN = 4608;
constexpr float EPS = 1e-6f;
constexpr int LDS_BYTES = 131072 + 64;
constexpr size_t MiB = 1024 * 1024;
constexpr size_t WS_MOD = 0, WS_BG = 512 * 1024, WS_SS = 242 * MiB, WS_W = 2 * MiB;
constexpr size_t W_FFIN = WS_W, W_FFOUT = W_FFIN + (size_t)2 * FF * D * 2, W_IN = W_FFOUT + (size_t)D * FF * 2, W_UPSB = W_IN + (size_t)NIN * D * 2,
                 W_UPDN = W_UPSB + (size_t)D * 512 * 2, W_OUT = W_UPDN + (size_t)D * 512 * 2, W_END = W_OUT + (size_t)D * D * 2;
constexpr size_t WS_U = 34 * MiB, WS_P = 66 * MiB;
static_assert(W_END <= WS_U, "weights overflow");
constexpr size_t WS_EGL = 384 * 1024, WS_CTR = 400 * 1024, WS_BAR = 416 * 1024;
constexpr size_t WS_VT = W_FFIN;
static_assert((size_t)T * 512 * 2 <= W_IN - W_FFIN, "Vt overflow");

enum { I_X = 0, I_C, I_WADA, I_BADA, I_GFFN1, I_WFFN1IN, I_WFFN1OUT, I_GMIX, I_WIN, I_GQSB, I_GKSB, I_WCONV, I_ALOG, I_DTBIAS, I_GDNOUT, I_WUPSB, I_WUPDN, I_WOUT, I_GFFN2, I_WFFN2IN, I_WFFN2OUT, N_IN };
struct Params { const float* in[N_IN]; float* out; unsigned char* ws; };

__device__ __forceinline__ float bf_lo(unsigned w) { return __uint_as_float(w << 16); }
__device__ __forceinline__ float bf_hi(unsigned w) { return __uint_as_float(w & 0xffff0000u); }
__device__ __forceinline__ float bf2f(bf16_t b) { return __uint_as_float(((unsigned)b) << 16); }
__device__ __forceinline__ unsigned pk2(float lo, float hi) { unsigned r; asm("v_cvt_pk_bf16_f32 %0, %1, %2" : "=v"(r) : "v"(lo), "v"(hi)); return r; }
__device__ __forceinline__ unsigned cpk2(float lo, float hi) { const f32x2 v = {lo, hi}; return __builtin_bit_cast(unsigned, __builtin_convertvector(v, nbf16x2)); }
__device__ __forceinline__ bf16_t f2bf(float f) { return (bf16_t)(pk2(f, 0.f) & 0xffffu); }
__device__ __forceinline__ float fexp(float x) { return __builtin_amdgcn_exp2f(x * 1.4426950408889634f); }
__device__ __forceinline__ float flog(float x) { return __builtin_amdgcn_logf(x) * 0.6931471805599453f; }
__device__ __forceinline__ float fsigmoid(float x) { return __builtin_amdgcn_rcpf(1.f + fexp(-x)); }
__device__ __forceinline__ float fsilu(float x) { return x * fsigmoid(x); }
__device__ __forceinline__ float fsoftplus(float x) { return fmaxf(x, 0.f) + flog(1.f + fexp(-fabsf(x))); }
__device__ __forceinline__ float wave_sum(float v) {
#pragma unroll
    for (int o = 1; o < 64; o <<= 1) v += __shfl_xor(v, o);
    return v;
}
#define LDS_WAIT() asm volatile("s_waitcnt lgkmcnt(0)" ::: "memory")

namespace pg8 {
constexpr int BM = 256, BK = 64, HALF = 128, HTB = HALF * BK * 2, STAGE_BYTES = 8 * HTB, NXCD = 8, WGM = 8;
__host__ __device__ __forceinline__ int lds_byte(int r, int c) { const int st = (r >> 4) * 2 + (c >> 5), rr = r & 15, cc = c & 31, ob = rr * 64 + cc * 2; return st * 1024 + (ob ^ (((ob >> 9) & 1) << 5)); }
__host__ __device__ __forceinline__ void stage_rc(int b, int& R, int& C) { const int st = b / 1024, sb = b % 1024, swz = sb ^ (((sb >> 9) & 1) << 5); R = (st >> 1) * 16 + swz / 64; C = (st & 1) * 32 + (swz % 64) / 2; }
__host__ __device__ __forceinline__ int perm32(int rho) { const int n = rho >> 4, i = rho & 15; return 8 * (i >> 2) + 4 * n + (i & 3); }
struct Unit { int pm, pn; };
struct Gemm { const bf16_t* A; const bf16_t* Bt; int M, N, K, lda; };
struct StaticOrder {
    int nM, nN, nwg, G, c;
    __host__ __device__ void init(int M, int N, int G_, int c_) { nM = M / BM; nN = N / BM; nwg = nM * nN; G = G_; c = c_; }
    __host__ __device__ bool next(int i, Unit& u) const {
        const long L = (long)i * G + c; if (L >= nwg) return false;
        int wgid = (int)L; { const int q = nwg / NXCD, r = nwg % NXCD, xcd = wgid % NXCD, off = wgid / NXCD; wgid = (xcd < r ? xcd * (q + 1) : r * (q + 1) + (xcd - r) * q) + off; }
        const int nig = WGM * nN, gid = wgid / nig, fm = gid * WGM, gsz = (nM - fm) < WGM ? (nM - fm) : WGM;
        u.pm = fm + ((wgid % nig) % gsz); u.pn = (wgid % nig) / gsz; return true;
    }
};
template <class Epi>
__device__ __forceinline__ void gemm_phase(LAS unsigned char* lds, const Gemm g, const StaticOrder& S, const Epi& E) {
    int tid = threadIdx.x; asm volatile("" : "+v"(tid));
    const int wid = __builtin_amdgcn_readfirstlane(tid >> 6), lane = tid & 63, wr = wid >> 2, wc = wid & 3, fr = lane & 15, fq = lane >> 4;
    const int K = g.K, nt = K / BK, lda = g.lda;
    unsigned voffA[2], voffB[2];
#pragma unroll
    for (int i = 0; i < 2; ++i) { int R, C; stage_rc(tid * 16 + i * 8192, R, C); const int Rb = Epi::PERM ? ((R & ~31) + perm32(R & 31)) : R;
        voffA[i] = (unsigned)(R * lda + C) * 2u; voffB[i] = (unsigned)(Rb * K + C) * 2u; }
    const size_t kstep = (size_t)(BK * 2);
    const size_t hstepA = (size_t)HALF * lda * 2, hstepB = (size_t)HALF * K * 2;
    const size_t tstepA = 2 * hstepA, tstepB = 2 * hstepB;
    const unsigned ldsw = (unsigned)wid * 1024u;
    const int aoff = lds_byte(wr * 64 + fr, fq * 8), boff = lds_byte(wc * 32 + fr, fq * 8);
#define PG8_SA(b, h) (((b) * 2 + (h)) * HTB)
#define PG8_SB(b, h) ((4 + (b) * 2 + (h)) * HTB)
#define PG8_STAGE(bufoff, gbase, voff) do { _Pragma("unroll") for (int _i = 0; _i < 2; ++_i) \
        __builtin_amdgcn_global_load_lds((const unsigned*)((const char*)(gbase) + (voff)[_i]), (LAS unsigned*)(lds + (bufoff) + ldsw + _i * 8192), 16, 0, 0); } while (0)
#define PG8_LDA(dst, b, h) do { _Pragma("unroll") for (int m = 0; m < 4; ++m) _Pragma("unroll") for (int k = 0; k < 2; ++k) dst[m][k] = *(const LAS bf16x8*)(lds + PG8_SA(b, h) + aoff + m * 2048 + k * 1024); } while (0)
#define PG8_LDB(dst, b, h) do { _Pragma("unroll") for (int n = 0; n < 2; ++n) _Pragma("unroll") for (int k = 0; k < 2; ++k) dst[n][k] = *(const LAS bf16x8*)(lds + PG8_SB(b, h) + boff + n * 2048 + k * 1024); } while (0)
#define PG8_MMA(ai, bj, At, Bt) do { __builtin_amdgcn_s_setprio(1); _Pragma("unroll") for (int m = 0; m < 4; ++m) _Pragma("unroll") for (int n = 0; n < 2; ++n) _Pragma("unroll") for (int k = 0; k < 2; ++k) \
        acc[ai][bj][m][n] = __builtin_amdgcn_mfma_f32_16x16x32_bf16(Bt[n][k], At[m][k], acc[ai][bj][m][n], 0, 0, 0); __builtin_amdgcn_s_setprio(0); } while (0)
#define PG8_WAIT_V(n) asm volatile("s_waitcnt vmcnt(" #n ")" ::: "memory")
#define PG8_WAIT_L(n) asm volatile("s_waitcnt lgkmcnt(" #n ")" ::: "memory")
#define PG8_BAR __builtin_amdgcn_s_barrier()
#define PG8_SCHED __builtin_amdgcn_sched_barrier(0)
    Unit cur, nxt; int ui = 0;
    if (!S.next(0, cur)) return;
    f32x4 acc[2][2][4][2];
#pragma unroll
    for (int a = 0; a < 2; ++a)
#pragma unroll
        for (int b = 0; b < 2; ++b)
#pragma unroll
            for (int m = 0; m < 4; ++m)
#pragma unroll
                for (int n = 0; n < 2; ++n) acc[a][b][m][n] = (f32x4){0.f, 0.f, 0.f, 0.f};
    bf16x8 At[4][2], B0[2][2], B1[2][2];
    const char* cA = (const char*)g.A + (size_t)cur.pm * tstepA; const char* cB = (const char*)g.Bt + (size_t)cur.pn * tstepB;
    PG8_STAGE(PG8_SB(0, 0), cB, voffB); PG8_STAGE(PG8_SA(0, 0), cA, voffA); PG8_STAGE(PG8_SB(0, 1), cB + hstepB, voffB); PG8_STAGE(PG8_SA(0, 1), cA + hstepA, voffA);
    if (wr == 1) PG8_BAR;
    PG8_WAIT_V(4); PG8_BAR;
    PG8_STAGE(PG8_SB(1, 0), cB + kstep, voffB); PG8_STAGE(PG8_SA(1, 0), cA + kstep, voffA); PG8_STAGE(PG8_SB(1, 1), cB + hstepB + kstep, voffB);
    PG8_WAIT_V(6); PG8_BAR;
    for (;;) {
        const bool has_next = S.next(ui + 1, nxt);
        const char* nA = has_next ? (const char*)g.A + (size_t)nxt.pm * tstepA : cA; const char* nB = has_next ? (const char*)g.Bt + (size_t)nxt.pn * tstepB : cB;
        for (int t = 0; t < nt; t += 2) {
            const bool last = (t == nt - 2);
            const char* a1 = cA + (size_t)(t + 1) * kstep;
            const char* a2 = last ? nA : cA + (size_t)(t + 2) * kstep; const char* b2 = last ? nB : cB + (size_t)(t + 2) * kstep;
            const char* a3 = a2 + kstep; const char* b3 = b2 + kstep;
            PG8_LDB(B0, 0, 0); PG8_SCHED; PG8_LDA(At, 0, 0); PG8_STAGE(PG8_SA(1, 1), a1 + hstepA, voffA);
            PG8_WAIT_L(8); PG8_BAR; PG8_WAIT_L(0); PG8_MMA(0, 0, At, B0); PG8_BAR; PG8_SCHED;
            PG8_LDB(B1, 0, 1); PG8_STAGE(PG8_SB(0, 0), b2, voffB);
            PG8_BAR; PG8_WAIT_L(0); PG8_MMA(0, 1, At, B1); PG8_BAR;
            PG8_LDA(At, 0, 1); PG8_STAGE(PG8_SA(0, 0), a2, voffA);
            PG8_BAR; PG8_WAIT_L(0); PG8_MMA(1, 0, At, B0); PG8_BAR; PG8_SCHED;
            PG8_STAGE(PG8_SB(0, 1), b2 + hstepB, voffB);
            PG8_WAIT_V(6); PG8_BAR; PG8_MMA(1, 1, At, B1); PG8_BAR;
            PG8_LDB(B0, 1, 0); PG8_SCHED; PG8_LDA(At, 1, 0); PG8_STAGE(PG8_SA(0, 1), a2 + hstepA, voffA);
            PG8_WAIT_L(8); PG8_BAR; PG8_WAIT_L(0); PG8_MMA(0, 0, At, B0); PG8_BAR; PG8_SCHED;
            PG8_LDB(B1, 1, 1); PG8_STAGE(PG8_SB(1, 0), b3, voffB);
            PG8_BAR; PG8_WAIT_L(0); PG8_MMA(0, 1, At, B1); PG8_BAR;
            PG8_LDA(At, 1, 1); PG8_STAGE(PG8_SA(1, 0), a3, voffA);
            PG8_BAR; PG8_WAIT_L(0); PG8_MMA(1, 0, At, B0); PG8_BAR; PG8_SCHED;
            PG8_STAGE(PG8_SB(1, 1), b3 + hstepB, voffB);
            PG8_WAIT_V(6); PG8_BAR; PG8_MMA(1, 1, At, B1); PG8_BAR;
        }
        E(acc, cur, wr, wc, fr, fq);
        if (!has_next) break;
#pragma unroll
        for (int a = 0; a < 2; ++a)
#pragma unroll
            for (int b = 0; b < 2; ++b)
#pragma unroll
                for (int m = 0; m < 4; ++m)
#pragma unroll
                    for (int n = 0; n < 2; ++n) acc[a][b][m][n] = (f32x4){0.f, 0.f, 0.f, 0.f};
        cur = nxt; cA = nA; cB = nB; ++ui;
    }
    PG8_WAIT_V(0);
    if (wr == 0) PG8_BAR;
    PG8_BAR;
#undef PG8_SA
#undef PG8_SB
#undef PG8_STAGE
#undef PG8_LDA
#undef PG8_LDB
#undef PG8_MMA
#undef PG8_WAIT_V
#undef PG8_WAIT_L
#undef PG8_BAR
#undef PG8_SCHED
}
}

typedef const f32x4 (&AccRef)[2][2][4][2];
struct EpiBf16 {
    static constexpr bool PERM = true;
    bf16_t* O; int ldc;
    __device__ __forceinline__ void operator()(AccRef acc, const pg8::Unit& u, int wr, int wc, int fr, int fq) const {
        const int row0 = u.pm * 256 + wr * 64 + fr, col0 = u.pn * 256 + wc * 32 + 8 * fq;
#pragma unroll
        for (int ai = 0; ai < 2; ++ai)
#pragma unroll
            for (int m = 0; m < 4; ++m) { bf16_t* rowp = O + (size_t)(row0 + ai * 128 + m * 16) * ldc + col0;
#pragma unroll
                for (int bj = 0; bj < 2; ++bj) { const f32x4 v0 = acc[ai][bj][m][0], v1 = acc[ai][bj][m][1];
                    u32x4 w; w.x = pk2(v0[0], v0[1]); w.y = pk2(v0[2], v0[3]); w.z = pk2(v1[0], v1[1]); w.w = pk2(v1[2], v1[3]);
                    *(u32x4*)(rowp + bj * 128) = w; } }
    }
};
struct EpiSwiGLU {
    static constexpr bool PERM = true;
    bf16_t* O; int ldc;
    __device__ __forceinline__ void operator()(AccRef acc, const pg8::Unit& u, int wr, int wc, int fr, int fq) const {
        const int row0 = u.pm * 256 + wr * 64 + fr, col0 = u.pn * 128 + wc * 32 + 8 * fq;
#pragma unroll
        for (int ai = 0; ai < 2; ++ai)
#pragma unroll
            for (int m = 0; m < 4; ++m) { bf16_t* rowp = O + (size_t)(row0 + ai * 128 + m * 16) * ldc + col0;
                float r[8];
#pragma unroll
                for (int n = 0; n < 2; ++n)
#pragma unroll
                    for (int j = 0; j < 4; ++j) { const float a = acc[ai][0][m][n][j], b = acc[ai][1][m][n][j]; r[n * 4 + j] = fsilu(a) * b; }
                u32x4 w; w.x = pk2(r[0], r[1]); w.y = pk2(r[2], r[3]); w.z = pk2(r[4], r[5]); w.w = pk2(r[6], r[7]);
                *(u32x4*)rowp = w; }
    }
};
struct EpiResid {
    static constexpr bool PERM = false;
    const float* base; float* out; const float* gate; float scale;
    __device__ __forceinline__ void operator()(AccRef acc, const pg8::Unit& u, int wr, int wc, int fr, int fq) const {
        const int row0 = u.pm * 256 + wr * 64 + fr, col0 = u.pn * 256 + wc * 32 + 4 * fq;
        const float* gp = gate + (size_t)(u.pm >> 3) * NMOD + col0;
        f32x4 gv[2][2];
#pragma unroll
        for (int bj = 0; bj < 2; ++bj)
#pragma unroll
            for (int n = 0; n < 2; ++n) gv[bj][n] = *(const f32x4*)(gp + bj * 128 + n * 16) * scale;
#pragma unroll
        for (int ai = 0; ai < 2; ++ai)
#pragma unroll
            for (int m = 0; m < 4; ++m) { const size_t off = (size_t)(row0 + ai * 128 + m * 16) * D + col0;
#pragma unroll
                for (int bj = 0; bj < 2; ++bj)
#pragma unroll
                    for (int n = 0; n < 2; ++n) { const f32x4 bs = *(const f32x4*)(base + off + bj * 128 + n * 16);
                        *(f32x4*)(out + off + bj * 128 + n * 16) = bs + gv[bj][n] * acc[ai][bj][m][n]; } }
    }
};
template <bool ACCUM> struct EpiGate {
    static constexpr bool PERM = true;
    const bf16_t* R; bf16_t* O;
    __device__ __forceinline__ void operator()(AccRef acc, const pg8::Unit& u, int wr, int wc, int fr, int fq) const {
        const int row0 = u.pm * 256 + wr * 64 + fr, col0 = u.pn * 256 + wc * 32 + 8 * fq;
#pragma unroll
        for (int ai = 0; ai < 2; ++ai)
#pragma unroll
            for (int m = 0; m < 4; ++m) { const size_t row = (size_t)(row0 + ai * 128 + m * 16);
#pragma unroll
                for (int bj = 0; bj < 2; ++bj) { const u32x4 rw = *(const u32x4*)(R + row * NIN + col0 + bj * 128);
                    bf16_t* op = O + row * D + col0 + bj * 128;
                    const f32x4 v0 = acc[ai][bj][m][0], v1 = acc[ai][bj][m][1];
                    float r[8] = {fsigmoid(bf_lo(rw.x)) * v0[0], fsigmoid(bf_hi(rw.x)) * v0[1], fsigmoid(bf_lo(rw.y)) * v0[2], fsigmoid(bf_hi(rw.y)) * v0[3],
                                  fsigmoid(bf_lo(rw.z)) * v1[0], fsigmoid(bf_hi(rw.z)) * v1[1], fsigmoid(bf_lo(rw.w)) * v1[2], fsigmoid(bf_hi(rw.w)) * v1[3]};
                    if (ACCUM) { const u32x4 pw = *(const u32x4*)op;
                        r[0] += bf_lo(pw.x); r[1] += bf_hi(pw.x); r[2] += bf_lo(pw.y); r[3] += bf_hi(pw.y); r[4] += bf_lo(pw.z); r[5] += bf_hi(pw.z); r[6] += bf_lo(pw.w); r[7] += bf_hi(pw.w); }
                    u32x4 w; w.x = pk2(r[0], r[1]); w.y = pk2(r[2], r[3]); w.z = pk2(r[4], r[5]); w.w = pk2(r[6], r[7]);
                    *(u32x4*)op = w; } }
    }
};
template <class Epi> __device__ __forceinline__ void run_gemm(LAS unsigned char* lds, const bf16_t* A, int lda, const bf16_t* Bt, int N, int K, const Epi& E) {
    pg8::Gemm g{A, Bt, T, N, K, lda}; pg8::StaticOrder S; S.init(T, N, (int)gridDim.x, (int)blockIdx.x);
    pg8::gemm_phase<Epi>(lds, g, S, E);
}

__device__ __forceinline__ void transpose_item(const float* W, int ldw, int s0, int k0, bf16_t* WT, int ldk, int d0, LAS float* scr, int lane) {
#pragma unroll 8
    for (int i = 0; i < 32; ++i) { const int kk = 2 * i + (lane >> 5); scr[kk * 33 + (lane & 31)] = W[(size_t)(k0 + kk) * ldw + s0 + (lane & 31)]; }
    LDS_WAIT();
    const int c = lane & 7;
#pragma unroll
    for (int j = 0; j < 4; ++j) { const int n = (lane >> 3) + 8 * j; const LAS float* s = scr + (8 * c) * 33 + n;
        u32x4 o; o.x = pk2(s[0 * 33], s[1 * 33]); o.y = pk2(s[2 * 33], s[3 * 33]); o.z = pk2(s[4 * 33], s[5 * 33]); o.w = pk2(s[6 * 33], s[7 * 33]);
        *(u32x4*)(WT + (size_t)(d0 + n) * ldk + k0 + 8 * c) = o; }
    LDS_WAIT();
}
__device__ __forceinline__ void ffn_weight_items(const float* w_in, const float* w_out, bf16_t* wt_in, bf16_t* wt_out, LAS float* scr, int gw, int ngw, int lane) {
    for (int it = gw; it < 2816 + 1408; it += ngw) {
        if (it < 2816) { const int kb = it / 176, nb = it % 176, d0 = nb * 32, pn = d0 >> 8, bj = (d0 >> 7) & 1, c = d0 & 127, s0 = bj * FF + pn * 128 + c;
            transpose_item(w_in, 2 * FF, s0, kb * 64, wt_in, D, d0, scr, lane); }
        else { const int r = it - 2816, kb = r / 32, nb = r % 32; transpose_item(w_out, D, nb * 32, kb * 64, wt_out, FF, nb * 32, scr, lane); }
    }
}
__device__ __forceinline__ void mixer_weight_items(const Params& p, LAS float* scr, int gw, int ngw, int lane) {
    unsigned char* ws = p.ws;
    for (int it = gw; it < 2816 + 256 + 256 + 512; it += ngw) {
        int r = it;
        if (r < 2816) { const int kb = r / 176, nb = r % 176, d0 = nb * 32, s0 = d0 < C_RSB ? d0 : d0 + 8; transpose_item(p.in[I_WIN], INW, s0, kb * 64, (bf16_t*)(ws + W_IN), D, d0, scr, lane); continue; } r -= 2816;
        if (r < 256) { const int kb = r / 32, nb = r % 32; transpose_item(p.in[I_WUPSB], D, nb * 32, kb * 64, (bf16_t*)(ws + W_UPSB), 512, nb * 32, scr, lane); continue; } r -= 256;
        if (r < 256) { const int kb = r / 32, nb = r % 32; transpose_item(p.in[I_WUPDN], D, nb * 32, kb * 64, (bf16_t*)(ws + W_UPDN), 512, nb * 32, scr, lane); continue; } r -= 256;
        { const int kb = r / 32, nb = r % 32; transpose_item(p.in[I_WOUT], D, nb * 32, kb * 64, (bf16_t*)(ws + W_OUT), D, nb * 32, scr, lane); }
    }
}
__device__ __forceinline__ void mod_item(const Params& p, LAS unsigned char* lds, int cb, int tid, int wave, int lane) {
    LAS float* sc = (LAS float*)lds; LAS float* red = (LAS float*)(lds + 32768);
    for (int i = tid; i < NB * D; i += 512) sc[i] = fsilu(p.in[I_C][i]);
    __syncthreads();
    const float* wa = p.in[I_WADA] + cb * 64 + lane;
    float acc[NB];
#pragma unroll
    for (int b = 0; b < NB; ++b) acc[b] = 0.f;
    for (int k = wave * 128; k < wave * 128 + 128; k += 4) {
        float w[4];
#pragma unroll
        for (int e = 0; e < 4; ++e) w[e] = wa[(size_t)(k + e) * NMOD];
#pragma unroll
        for (int b = 0; b < NB; ++b) { const f32x4 s = *(const LAS f32x4*)(sc + b * D + k); acc[b] += s[0] * w[0] + s[1] * w[1] + s[2] * w[2] + s[3] * w[3]; }
    }
#pragma unroll
    for (int b = 0; b < NB; ++b) red[(wave * NB + b) * 64 + lane] = acc[b];
    __syncthreads();
    { const int b = tid >> 6; float s = p.in[I_BADA][cb * 64 + lane];
#pragma unroll
        for (int w = 0; w < 8; ++w) s += red[(w * NB + b) * 64 + lane];
        ((float*)(p.ws + WS_MOD))[b * NMOD + cb * 64 + lane] = s; }
    __syncthreads();
}

template <bool DN>
__device__ __forceinline__ void norm_mod_phase(const Params& p, LAS unsigned char* lds, const float* src, const float* gain, int midx, bf16_t* dst, int tid, int wave, int lane) {
    const float* mod = (const float*)(p.ws + WS_MOD);
    LAS float* wl = (LAS float*)lds;
    if (DN) { for (int i = tid; i < D * 8; i += 512) { const int k = i >> 3, j = i & 7; wl[8 * k + 4 * (k >> 2) + j] = p.in[I_WIN][(size_t)k * INW + C_RSB + j]; } __syncthreads(); }
    f32x4 g4[4];
#pragma unroll
    for (int j = 0; j < 4; ++j) g4[j] = ((const f32x4*)gain)[lane + 64 * j];
    for (int row = blockIdx.x * 8 + wave; row < T; row += gridDim.x * 8) {
        const int b = row >> 11;
        const f32x4* xr = (const f32x4*)(src + (size_t)row * D) + lane;
        const f32x4* shp = (const f32x4*)(mod + (size_t)b * NMOD + midx * D) + lane; const f32x4* scp = shp + D / 4;
        f32x4 v[4]; float ss = 0.f;
#pragma unroll
        for (int j = 0; j < 4; ++j) { v[j] = xr[64 * j]; ss += (v[j][0] * v[j][0] + v[j][1] * v[j][1]) + (v[j][2] * v[j][2] + v[j][3] * v[j][3]); }
        const float rstd = 1.0f / sqrtf(wave_sum(ss) * (1.f / D) + EPS);
        u32x2* o8 = (u32x2*)(dst + (size_t)row * D) + lane;
        float dot[8];
        if (DN) {
#pragma unroll
            for (int e = 0; e < 8; ++e) dot[e] = 0.f; }
#pragma unroll
        for (int j = 0; j < 4; ++j) { const f32x4 sh = shp[64 * j], sc = scp[64 * j];
            const f32x4 uu = v[j] * rstd * g4[j] * (sc + 1.0f) + sh;
            u32x2 w; w.x = pk2(uu[0], uu[1]); w.y = pk2(uu[2], uu[3]); o8[64 * j] = w;
            if (DN) {
#pragma unroll
                for (int e = 0; e < 4; ++e) { const int k = 4 * lane + 256 * j + e; const LAS f32x4* wp = (const LAS f32x4*)(wl + 8 * k + 4 * (k >> 2)); const f32x4 w0 = wp[0], w1 = wp[1];
                    dot[0] += uu[e] * w0[0]; dot[1] += uu[e] * w0[1]; dot[2] += uu[e] * w0[2]; dot[3] += uu[e] * w0[3];
                    dot[4] += uu[e] * w1[0]; dot[5] += uu[e] * w1[1]; dot[6] += uu[e] * w1[2]; dot[7] += uu[e] * w1[3]; } } }
        if (DN) {
#pragma unroll
            for (int e = 0; e < 8; ++e) dot[e] = wave_sum(dot[e]);
            float mine = dot[0];
#pragma unroll
            for (int e = 1; e < 8; ++e) mine = (lane == e) ? dot[e] : mine;
            if (lane < 8) { float r;
                if (lane < 4) r = 1.0f / (1.0f + expf(-mine));
                else { const int hh = lane - 4; const float a = mine + p.in[I_DTBIAS][hh]; const float sp = a > 20.f ? a : log1pf(expf(a)); r = -expf(p.in[I_ALOG][hh]) * sp; }
                ((float*)(p.ws + WS_BG))[(size_t)row * 8 + lane] = r; } }
    }
    if (DN) __syncthreads();
}

__device__ __forceinline__ void unpack16(const bf16_t* p, float* f) {
    const u32x4 a = ((const u32x4*)p)[0], b = ((const u32x4*)p)[1];
    f[0] = bf_lo(a.x); f[1] = bf_hi(a.x); f[2] = bf_lo(a.y); f[3] = bf_hi(a.y); f[4] = bf_lo(a.z); f[5] = bf_hi(a.z); f[6] = bf_lo(a.w); f[7] = bf_hi(a.w);
    f[8] = bf_lo(b.x); f[9] = bf_hi(b.x); f[10] = bf_lo(b.y); f[11] = bf_hi(b.y); f[12] = bf_lo(b.z); f[13] = bf_hi(b.z); f[14] = bf_lo(b.w); f[15] = bf_hi(b.w);
}
__device__ __forceinline__ void pack16(bf16_t* p, const float* f) {
    u32x4 a, b; a.x = pk2(f[0], f[1]); a.y = pk2(f[2], f[3]); a.z = pk2(f[4], f[5]); a.w = pk2(f[6], f[7]); b.x = pk2(f[8], f[9]); b.y = pk2(f[10], f[11]); b.z = pk2(f[12], f[13]); b.w = pk2(f[14], f[15]);
    ((u32x4*)p)[0] = a; ((u32x4*)p)[1] = b;
}
__device__ __forceinline__ void prep_phase(const Params& p, int wave, int lane) {
    bf16_t* P = (bf16_t*)(p.ws + WS_P); bf16_t* U = (bf16_t*)(p.ws + WS_U);
    const int ch = 16 * lane;
    float gsb[16], wcv[4][16];
    { const float* gp = (ch < 512 ? p.in[I_GQSB] : p.in[I_GKSB]) + (ch & 63); const float sc = ch < 512 ? 0.125f : 1.0f;
#pragma unroll
        for (int e = 0; e < 16; ++e) gsb[e] = gp[e] * sc;
#pragma unroll
        for (int i = 0; i < 4; ++i)
#pragma unroll
            for (int e = 0; e < 16; ++e) wcv[i][e] = p.in[I_WCONV][i * 1536 + ch + e]; }
    for (int row = blockIdx.x * 8 + wave; row < T; row += gridDim.x * 8) {
        const int tl = row & (SEQ - 1);
        { bf16_t* qp = P + (size_t)row * NIN + ch; float f[16]; unpack16(qp, f); float ss = 0.f;
#pragma unroll
            for (int e = 0; e < 16; ++e) ss += f[e] * f[e];
            ss += __shfl_xor(ss, 1); ss += __shfl_xor(ss, 2);
            const float rstd = 1.0f / sqrtf(ss * (1.f / 64.f) + EPS);
#pragma unroll
            for (int e = 0; e < 16; ++e) f[e] = f[e] * rstd * gsb[e];
            pack16(qp, f); }
        { float y[16];
#pragma unroll
            for (int e = 0; e < 16; ++e) y[e] = 0.f;
#pragma unroll
            for (int i = 0; i < 4; ++i) { if (tl - 3 + i >= 0) { float f[16]; unpack16(P + (size_t)(row - 3 + i) * NIN + C_QDN + ch, f);
#pragma unroll
                    for (int e = 0; e < 16; ++e) y[e] += wcv[i][e] * f[e]; } }
            float ss = 0.f;
#pragma unroll
            for (int e = 0; e < 16; ++e) { y[e] = fsilu(y[e]); ss += y[e] * y[e]; }
            ss += __shfl_xor(ss, 1); ss += __shfl_xor(ss, 2); ss += __shfl_xor(ss, 4);
            const float sc = (1.0f / sqrtf(ss + EPS)) * (ch < 512 ? 0.08838834764831845f : 1.0f);
#pragma unroll
            for (int e = 0; e < 16; ++e) y[e] *= sc;
            pack16(U + (size_t)row * D + ch, y); }
    }
    bf16_t* Vt = (bf16_t*)(p.ws + WS_VT);
    for (int it = blockIdx.x * 8 + wave; it < T / 16; it += gridDim.x * 8) {
        const int row0 = it * 16, b = row0 >> 11, tl0 = row0 & (SEQ - 1), c8 = lane * 8, hd = c8 >> 6, d0 = c8 & 63;
        u32x4 w[16];
#pragma unroll
        for (int r = 0; r < 16; ++r) w[r] = *(const u32x4*)(P + (size_t)(row0 + r) * NIN + C_VSB + c8);
#pragma unroll
        for (int e = 0; e < 8; ++e) {
            unsigned o[8];
#pragma unroll
            for (int i = 0; i < 8; ++i) {
                const int p0 = 2 * i, p1 = 2 * i + 1;
                const int k0 = 8 * ((p0 >> 2) & 1) + 4 * (p0 >> 3) + (p0 & 3), k1 = 8 * ((p1 >> 2) & 1) + 4 * (p1 >> 3) + (p1 & 3);
                const unsigned a0 = w[k0][e >> 1], a1 = w[k1][e >> 1];
                const unsigned lo = (e & 1) ? (a0 >> 16) : (a0 & 0xffffu), hi = (e & 1) ? (a1 & 0xffff0000u) : (a1 << 16);
                o[i] = lo | hi; }
            bf16_t* dst = Vt + ((size_t)(b * 8 + hd) * 64 + d0 + e) * SEQ + tl0;
            ((u32x4*)dst)[0] = (u32x4){o[0], o[1], o[2], o[3]}; ((u32x4*)dst)[1] = (u32x4){o[4], o[5], o[6], o[7]}; }
    }
}

__device__ __forceinline__ void attn_item_mfma(bf16_t* P, const bf16_t* Vt, int bh, int qt, int lane) {
    asm volatile("" : "+v"(lane));
    const int b = bh >> 3, h = bh & 7, ql = lane & 31, hh = lane >> 5, q0 = qt * 32;
    bf16_t* qrow = P + (size_t)(b * SEQ + q0 + ql) * NIN + C_QSB + h * 64;
    bf16x8 qf[4];
#pragma unroll
    for (int s = 0; s < 4; ++s) qf[s] = *(const bf16x8*)(qrow + 16 * s + 8 * hh);
    f32x16 o0, o1;
#pragma unroll
    for (int i = 0; i < 16; ++i) { o0[i] = 0.f; o1[i] = 0.f; }
    float R = 1.0f;
    const bf16_t* kb = P + (size_t)(b * SEQ + ql) * NIN + C_KSB + h * 64 + 8 * hh;
    const bf16_t* vb = Vt + ((size_t)bh * 64 + ql) * SEQ + 8 * hh;
    bf16x8 kf[4], vf[4];
#pragma unroll
    for (int s = 0; s < 4; ++s) kf[s] = *(const bf16x8*)(kb + (size_t)q0 * NIN + 16 * s);
#pragma unroll
    for (int j = 0; j < 4; ++j) vf[j] = *(const bf16x8*)(vb + (size_t)(j >> 1) * 32 * SEQ + q0 + 16 * (j & 1));
#pragma unroll 1
    for (int kt = qt; kt >= 0; --kt) {
        f32x16 z;
#pragma unroll
        for (int i = 0; i < 16; ++i) z[i] = 0.f;
#pragma unroll
        for (int s = 0; s < 4; ++s) z = __builtin_amdgcn_mfma_f32_32x32x16_bf16(kf[s], qf[s], z, 0, 0, 0);
        bf16x8 vc[4];
#pragma unroll
        for (int j = 0; j < 4; ++j) vc[j] = vf[j];
        { const int kn = (kt > 0 ? kt - 1 : 0) * 32;
#pragma unroll
            for (int s = 0; s < 4; ++s) kf[s] = *(const bf16x8*)(kb + (size_t)kn * NIN + 16 * s);
#pragma unroll
            for (int j = 0; j < 4; ++j) vf[j] = *(const bf16x8*)(vb + (size_t)(j >> 1) * 32 * SEQ + kn + 16 * (j & 1)); }
        float sg[16], m[16];
        const bool diag = (kt == qt);
#pragma unroll
        for (int i = 0; i < 16; ++i) { const float zz = z[i]; const float e = __builtin_amdgcn_exp2f(-1.4426950408889634f * fabsf(zz)); const float r = __builtin_amdgcn_rcpf(1.0f + e); const float er = e * r;
            float sig = zz >= 0.f ? r : er, mm = zz >= 0.f ? er : r;
            if (diag) { const bool act = ((i & 3) + 8 * (i >> 2) + 4 * hh) < ql; sig = act ? sig : 0.f; mm = act ? mm : 1.0f; }
            sg[i] = sig; m[i] = mm; }
        float g[4], gp[4];
#pragma unroll
        for (int bq = 0; bq < 4; ++bq) { g[bq] = (m[4 * bq] * m[4 * bq + 1]) * (m[4 * bq + 2] * m[4 * bq + 3]); gp[bq] = __shfl_xor(g[bq], 32); }
        float outer[4]; float tb = R;
#pragma unroll
        for (int bq = 3; bq >= 0; --bq) { outer[bq] = tb * (hh == 0 ? gp[bq] : 1.0f); tb *= g[bq] * gp[bq]; }
        R = tb;
        float w[16];
#pragma unroll
        for (int bq = 0; bq < 4; ++bq) { const float s3 = outer[bq], s2 = s3 * m[4 * bq + 3], s1 = s2 * m[4 * bq + 2], s0 = s1 * m[4 * bq + 1];
            w[4 * bq + 3] = sg[4 * bq + 3] * s3; w[4 * bq + 2] = sg[4 * bq + 2] * s2; w[4 * bq + 1] = sg[4 * bq + 1] * s1; w[4 * bq] = sg[4 * bq] * s0; }
        bf16x8 wf[2];
#pragma unroll
        for (int s2 = 0; s2 < 2; ++s2) { const u32x4 pw = {cpk2(w[8 * s2], w[8 * s2 + 1]), cpk2(w[8 * s2 + 2], w[8 * s2 + 3]), cpk2(w[8 * s2 + 4], w[8 * s2 + 5]), cpk2(w[8 * s2 + 6], w[8 * s2 + 7])}; wf[s2] = __builtin_bit_cast(bf16x8, pw); }
        o0 = __builtin_amdgcn_mfma_f32_32x32x16_bf16(vc[0], wf[0], o0, 0, 0, 0); o0 = __builtin_amdgcn_mfma_f32_32x32x16_bf16(vc[1], wf[1], o0, 0, 0, 0);
        o1 = __builtin_amdgcn_mfma_f32_32x32x16_bf16(vc[2], wf[0], o1, 0, 0, 0); o1 = __builtin_amdgcn_mfma_f32_32x32x16_bf16(vc[3], wf[1], o1, 0, 0, 0);
    }
#pragma unroll
    for (int bq = 0; bq < 4; ++bq) {
        u32x2 w0 = {cpk2(o0[4 * bq], o0[4 * bq + 1]), cpk2(o0[4 * bq + 2], o0[4 * bq + 3])}, w1 = {cpk2(o1[4 * bq], o1[4 * bq + 1]), cpk2(o1[4 * bq + 2], o1[4 * bq + 3])};
        *(u32x2*)(qrow + 8 * bq + 4 * hh) = w0; *(u32x2*)(qrow + 32 + 8 * bq + 4 * hh) = w1; }
}
__device__ __forceinline__ size_t slotU(size_t t0, int h, int colbase, int f) { return (t0 + (size_t)(f >> 7)) * D + colbase + h * 128 + (f & 127); }
__device__ __forceinline__ size_t slotP(size_t t0, int h, int colbase, int f) { return (t0 + (size_t)(f >> 7)) * NIN + colbase + h * 128 + (f & 127); }
__device__ __forceinline__ int permpos(int x) { const int k = x & 15; return (x & ~15) + 8 * ((k >> 2) & 1) + 4 * (k >> 3) + (k & 3); }
__device__ __forceinline__ int crow(int r, int hh) { return (r & 3) + 8 * (r >> 2) + 4 * hh; }
__device__ __forceinline__ bf16x8 pack8(const f32x16& x, int s2) {
    const u32x4 pw = {cpk2(x[8 * s2], x[8 * s2 + 1]), cpk2(x[8 * s2 + 2], x[8 * s2 + 3]), cpk2(x[8 * s2 + 4], x[8 * s2 + 5]), cpk2(x[8 * s2 + 6], x[8 * s2 + 7])};
    return __builtin_bit_cast(bf16x8, pw);
}
#define MFMA32(a, b, c) __builtin_amdgcn_mfma_f32_32x32x16_bf16((a), (b), (c), 0, 0, 0)
constexpr int PT = 72, PQ = 136, PL = 68, PB = 40;
constexpr int CP_GC = 0, CP_BT = 256, CP_LS = 1024, CP_TU = CP_LS + 64 * PL * 4, CP_TW = CP_TU + 64 * PT * 2, CP_KT = CP_TW + 64 * PT * 2, CP_VT = CP_KT + 128 * PT * 2,
              CP_QS = CP_VT + 128 * PT * 2, CP_KS = CP_QS + 64 * PQ * 2, CP_AQ = CP_KS + 64 * PQ * 2, CP_L21 = CP_AQ + 64 * PT * 2, CP_TCM = CP_L21 + 32 * PB * 2, CP_T22 = CP_TCM + 32 * PB * 2, CP_END = CP_T22 + 32 * PB * 2;
static_assert(CP_END <= 131072, "chunk prep LDS");
__device__ __forceinline__ void gdn_chunk_prep(const Params& p, LAS unsigned char* lds, int item, int tid, int wave, int lane) {
    asm volatile("" : "+v"(tid), "+v"(lane));
    const int bh = item >> 5, n = item & 31, b = bh >> 2, h = bh & 3, ql = lane & 31, hh = lane >> 5;
    const size_t t0 = (size_t)b * SEQ + n * 64;
    bf16_t* P = (bf16_t*)(p.ws + WS_P); bf16_t* U = (bf16_t*)(p.ws + WS_U); const float* BG = (const float*)(p.ws + WS_BG);
    LAS float* gcS = (LAS float*)(lds + CP_GC); LAS float* btS = (LAS float*)(lds + CP_BT);
    LAS float* LS = (LAS float*)(lds + CP_LS);
    LAS bf16_t* TuS = (LAS bf16_t*)(lds + CP_TU); LAS bf16_t* TwS = (LAS bf16_t*)(lds + CP_TW);
    LAS bf16_t* kT = (LAS bf16_t*)(lds + CP_KT); LAS bf16_t* vT = (LAS bf16_t*)(lds + CP_VT); LAS bf16_t* qS = (LAS bf16_t*)(lds + CP_QS); LAS bf16_t* kS = (LAS bf16_t*)(lds + CP_KS);
    LAS bf16_t* AQ = (LAS bf16_t*)(lds + CP_AQ); LAS bf16_t* L21b = (LAS bf16_t*)(lds + CP_L21); LAS bf16_t* Tcm = (LAS bf16_t*)(lds + CP_TCM); LAS bf16_t* T22r = (LAS bf16_t*)(lds + CP_T22);
    if (tid < 64) { float x = BG[(t0 + tid) * 8 + 4 + h];
#pragma unroll
        for (int o = 1; o < 64; o <<= 1) { const float y = __shfl_up(x, o); if (lane >= o) x += y; }
        gcS[tid] = x; btS[tid] = BG[(t0 + tid) * 8 + h]; }
    { const int tok = tid >> 3, c16 = (tid & 7) * 16;
        const u32x4 ka = *(const u32x4*)(U + (t0 + tok) * D + 512 + h * 128 + c16), kb = *(const u32x4*)(U + (t0 + tok) * D + 512 + h * 128 + c16 + 8);
        const u32x4 qa = *(const u32x4*)(U + (t0 + tok) * D + h * 128 + c16), qb = *(const u32x4*)(U + (t0 + tok) * D + h * 128 + c16 + 8);
        u32x4 xv[4][2];
#pragma unroll
        for (int i = 0; i < 4; ++i) { const bool ok = n * 64 + tok - 3 + i >= 0; const bf16_t* vp = P + (t0 + tok - 3 + i) * NIN + C_VDN + h * 128 + c16;
            xv[i][0] = ok ? *(const u32x4*)vp : (u32x4){0u, 0u, 0u, 0u}; xv[i][1] = ok ? *(const u32x4*)(vp + 8) : (u32x4){0u, 0u, 0u, 0u}; }
        *(LAS u32x4*)(kS + tok * PQ + c16) = ka; *(LAS u32x4*)(kS + tok * PQ + c16 + 8) = kb;
        *(LAS u32x4*)(qS + tok * PQ + c16) = qa; *(LAS u32x4*)(qS + tok * PQ + c16 + 8) = qb;
        const unsigned kw[8] = {ka.x, ka.y, ka.z, ka.w, kb.x, kb.y, kb.z, kb.w};
#pragma unroll
        for (int e = 0; e < 8; ++e) { kT[(c16 + 2 * e) * PT + tok] = (bf16_t)(kw[e] & 0xffffu); kT[(c16 + 2 * e + 1) * PT + tok] = (bf16_t)(kw[e] >> 16); }
        float y[16];
#pragma unroll
        for (int e = 0; e < 16; ++e) y[e] = 0.f;
#pragma unroll
        for (int i = 0; i < 4; ++i) { const float* wp = p.in[I_WCONV] + i * 1536 + 1024 + h * 128 + c16;
            const unsigned xw[8] = {xv[i][0].x, xv[i][0].y, xv[i][0].z, xv[i][0].w, xv[i][1].x, xv[i][1].y, xv[i][1].z, xv[i][1].w};
#pragma unroll
            for (int e = 0; e < 8; ++e) { y[2 * e] += wp[2 * e] * bf_lo(xw[e]); y[2 * e + 1] += wp[2 * e + 1] * bf_hi(xw[e]); } }
#pragma unroll
        for (int e = 0; e < 16; ++e) vT[(c16 + e) * PT + tok] = f2bf(fsilu(y[e])); }
    __syncthreads();
    if (wave == 0) {
        bf16x8 kf[2][8];
#pragma unroll
        for (int t = 0; t < 2; ++t)
#pragma unroll
            for (int ks = 0; ks < 8; ++ks) kf[t][ks] = *(const LAS bf16x8*)(kS + (32 * t + ql) * PQ + 16 * ks + 8 * hh);
#pragma unroll
        for (int tt = 0; tt < 3; ++tt) { const int it = tt == 0 ? 0 : 1, jt = tt == 2 ? 1 : 0;
            f32x16 acc;
#pragma unroll
            for (int r = 0; r < 16; ++r) acc[r] = 0.f;
#pragma unroll
            for (int ks = 0; ks < 8; ++ks) acc = MFMA32(kf[it][ks], kf[jt][ks], acc);
            const int j = 32 * jt + ql; const float gj = gcS[j];
#pragma unroll
            for (int r = 0; r < 16; ++r) { const int i = 32 * it + crow(r, hh); const float l = (j < i) ? btS[i] * acc[r] * fexp(gcS[i] - gj) : 0.f;
                if (it != jt) L21b[(i - 32) * PB + j] = f2bf(l); else LS[i * PL + j] = l; } }
    } else if (wave < 4) {
        const int jt = wave == 3 ? 1 : 0, it = wave == 1 ? 0 : 1;
        f32x16 acc;
#pragma unroll
        for (int r = 0; r < 16; ++r) acc[r] = 0.f;
#pragma unroll
        for (int ks = 0; ks < 8; ++ks) acc = MFMA32(*(const LAS bf16x8*)(kS + (32 * jt + ql) * PQ + 16 * ks + 8 * hh), *(const LAS bf16x8*)(qS + (32 * it + ql) * PQ + 16 * ks + 8 * hh), acc);
        const int i = 32 * it + ql; const float gi = gcS[i];
#pragma unroll
        for (int r = 0; r < 16; ++r) { const int j = 32 * jt + crow(r, hh); acc[r] = (j <= i) ? acc[r] * fexp(gi - gcS[j]) : 0.f; }
#pragma unroll
        for (int bq = 0; bq < 4; ++bq) *(LAS u32x2*)(AQ + i * PT + 32 * jt + 8 * bq + 4 * hh) = (u32x2){cpk2(acc[4 * bq], acc[4 * bq + 1]), cpk2(acc[4 * bq + 2], acc[4 * bq + 3])};
    } else {
        const float gl = gcS[63];
#pragma unroll
        for (int uu = 0; uu < 2; ++uu) { const int unit = (tid - 256) + 256 * uu, dk = unit >> 2, blk = unit & 3;
            const u32x4 k0 = *(const LAS u32x4*)(kT + dk * PT + 16 * blk), k1 = *(const LAS u32x4*)(kT + dk * PT + 16 * blk + 8);
            float kv[16] = {bf_lo(k0.x), bf_hi(k0.x), bf_lo(k0.y), bf_hi(k0.y), bf_lo(k0.z), bf_hi(k0.z), bf_lo(k0.w), bf_hi(k0.w), bf_lo(k1.x), bf_hi(k1.x), bf_lo(k1.y), bf_hi(k1.y), bf_lo(k1.z), bf_hi(k1.z), bf_lo(k1.w), bf_hi(k1.w)};
#pragma unroll
            for (int e = 0; e < 16; ++e) kv[e] *= fexp(gl - gcS[16 * blk + e]);
            float pv[16];
#pragma unroll
            for (int e = 0; e < 16; ++e) pv[permpos(e)] = kv[e];
            pack16(P + slotP(t0, h, C_VSB, dk * 64 + 16 * blk), pv); }
        if (tid == 256) ((float*)(p.ws + WS_EGL))[bh * 32 + n] = fexp(gl);
    }
    __syncthreads();
    if (wave == 0) {
        const LAS float* LB = LS + (32 * hh) * PL + 32 * hh;
        float Tc[32];
#pragma unroll
        for (int i = 0; i < 32; ++i) {
            float a0 = (ql == i) ? 1.0f : 0.f, a1 = 0.f, a2 = 0.f, a3 = 0.f;
#pragma unroll
            for (int j4 = 0; j4 < i; j4 += 4) { const f32x4 l4 = *(const LAS f32x4*)(LB + i * PL + j4);
                a0 -= l4[0] * Tc[j4]; if (j4 + 1 < i) a1 -= l4[1] * Tc[j4 + 1]; if (j4 + 2 < i) a2 -= l4[2] * Tc[j4 + 2]; if (j4 + 3 < i) a3 -= l4[3] * Tc[j4 + 3]; }
            Tc[i] = (a0 + a1) + (a2 + a3); }
        const int cg_ = 32 * hh + ql; const float bu = btS[cg_], bw = bu * fexp(gcS[cg_]);
#pragma unroll
        for (int i = 0; i < 32; ++i) { TuS[(32 * hh + i) * PT + cg_] = f2bf(Tc[i] * bu); TwS[(32 * hh + i) * PT + cg_] = f2bf(Tc[i] * bw); }
        if (hh == 0) {
#pragma unroll
            for (int i8 = 0; i8 < 4; ++i8) *(LAS u32x4*)(Tcm + ql * PB + 8 * i8) = (u32x4){cpk2(Tc[8 * i8], Tc[8 * i8 + 1]), cpk2(Tc[8 * i8 + 2], Tc[8 * i8 + 3]), cpk2(Tc[8 * i8 + 4], Tc[8 * i8 + 5]), cpk2(Tc[8 * i8 + 6], Tc[8 * i8 + 7])};
        } else {
#pragma unroll
            for (int i = 0; i < 32; ++i) T22r[i * PB + ql] = f2bf(Tc[i]);
        }
        LDS_WAIT();
        f32x16 x1;
#pragma unroll
        for (int r = 0; r < 16; ++r) x1[r] = 0.f;
#pragma unroll
        for (int s2 = 0; s2 < 2; ++s2) x1 = MFMA32(*(const LAS bf16x8*)(L21b + ql * PB + 16 * s2 + 8 * hh), *(const LAS bf16x8*)(Tcm + ql * PB + 16 * s2 + 8 * hh), x1);
        f32x16 yy;
#pragma unroll
        for (int r = 0; r < 16; ++r) yy[r] = 0.f;
#pragma unroll
        for (int s2 = 0; s2 < 2; ++s2) { const u32x2 lo = *(const LAS u32x2*)(T22r + ql * PB + 16 * s2 + 4 * hh), hi = *(const LAS u32x2*)(T22r + ql * PB + 16 * s2 + 8 + 4 * hh);
            const u32x4 af = {lo.x, lo.y, hi.x, hi.y};
            yy = MFMA32(__builtin_bit_cast(bf16x8, af), pack8(x1, s2), yy); }
        { const float bu0 = btS[ql], bw0 = bu0 * fexp(gcS[ql]);
#pragma unroll
            for (int r = 0; r < 16; ++r) { const int i2 = 32 + crow(r, hh); TuS[i2 * PT + ql] = f2bf(-yy[r] * bu0); TwS[i2 * PT + ql] = f2bf(-yy[r] * bw0); } }
    }
    __syncthreads();
    {
        const int isW = wave >> 2, ct = wave & 3, col = 32 * ct + ql;
        const LAS bf16_t* Ta = (isW ? TwS : TuS) + 8 * hh; const LAS bf16_t* Bs = (isW ? kT : vT) + col * PT + 8 * hh;
        bf16x8 bf[4];
#pragma unroll
        for (int ks = 0; ks < 4; ++ks) bf[ks] = *(const LAS bf16x8*)(Bs + 16 * ks);
        f32x16 xa[2];
#pragma unroll
        for (int jt = 0; jt < 2; ++jt) {
#pragma unroll
            for (int r = 0; r < 16; ++r) xa[jt][r] = 0.f;
#pragma unroll
            for (int ks = 0; ks < 4; ++ks) if (jt == 1 || ks < 2) xa[jt] = MFMA32(*(const LAS bf16x8*)(Ta + (32 * jt + ql) * PT + 16 * ks), bf[ks], xa[jt]); }
        bf16x8 xb[4] = {pack8(xa[0], 0), pack8(xa[0], 1), pack8(xa[1], 0), pack8(xa[1], 1)};
        f32x16 ra[2];
#pragma unroll
        for (int it = 0; it < 2; ++it) {
#pragma unroll
            for (int r = 0; r < 16; ++r) ra[it][r] = 0.f;
#pragma unroll
            for (int kk = 0; kk < 4; ++kk) if (it == 1 || kk < 2) { const LAS bf16_t* ap = AQ + (32 * it + ql) * PT + 16 * kk + 4 * hh;
                const u32x2 lo = *(const LAS u32x2*)ap, hi = *(const LAS u32x2*)(ap + 8); const u32x4 af = {lo.x, lo.y, hi.x, hi.y};
                ra[it] = MFMA32(__builtin_bit_cast(bf16x8, af), xb[kk], ra[it]); } }
        if (!isW) {
#pragma unroll
            for (int jt = 0; jt < 2; ++jt)
#pragma unroll
                for (int bq = 0; bq < 4; ++bq) { const int f = col * 64 + 32 * jt + 8 * bq + 4 * hh;
                    *(u32x2*)(U + slotU(t0, h, 0, f)) = (u32x2){cpk2(xa[jt][4 * bq], xa[jt][4 * bq + 1]), cpk2(xa[jt][4 * bq + 2], xa[jt][4 * bq + 3])};
                    *(u32x2*)(U + slotU(t0, h, 512, f)) = (u32x2){cpk2(ra[jt][4 * bq], ra[jt][4 * bq + 1]), cpk2(ra[jt][4 * bq + 2], ra[jt][4 * bq + 3])}; }
        } else {
            const int pc = permpos(col);
#pragma unroll
            for (int jt = 0; jt < 2; ++jt)
#pragma unroll
                for (int r = 0; r < 16; ++r) { const int tok = 32 * jt + crow(r, hh);
                    P[(t0 + tok) * NIN + C_QDN + h * 128 + pc] = f2bf(-xa[jt][r]);
                    P[(t0 + tok) * NIN + C_KDN + h * 128 + pc] = f2bf(bf2f(qS[tok * PQ + col]) * fexp(gcS[tok]) - ra[jt][r]); }
        }
    }
    __syncthreads();
}
constexpr int SC_PW = 136, SC_PK = 72, SC_NW = 0, SC_Q2 = 64 * SC_PW * 2, SC_KD = 2 * 64 * SC_PW * 2, SC_STAGE = 2 * 64 * SC_PW * 2 + 128 * SC_PK * 2;
static_assert(2 * SC_STAGE <= 131072, "scan LDS");
__device__ __forceinline__ void gdn_scan_block(const Params& p, LAS unsigned char* lds, int bh, int tid, int wave, int lane) {
    asm volatile("" : "+v"(tid), "+v"(lane));
    bf16_t* P = (bf16_t*)(p.ws + WS_P); const bf16_t* U = (const bf16_t*)(p.ws + WS_U); const float* EGL = (const float*)(p.ws + WS_EGL);
    const int b = bh >> 2, h = bh & 3, ql = lane & 31, hh = lane >> 5;
    const size_t tb = (size_t)b * SEQ;
    if (wave >= 4) {
        const int lt = tid - 256;
        u32x4 r[12];
#define SC_LOAD(n_) do { const size_t t0_ = tb + (size_t)(n_) * 64; _Pragma("unroll") for (int i = 0; i < 4; ++i) { const int c = lt + 256 * i, row = c >> 4, c8 = (c & 15) * 8; \
            const bf16_t* g_ = P + (t0_ + row) * NIN + h * 128 + c8; r[i] = *(const u32x4*)(g_ + C_QDN); r[4 + i] = *(const u32x4*)(g_ + C_KDN); r[8 + i] = *(const u32x4*)(g_ + C_VSB); } } while (0)
#define SC_STORE(st_) do { LAS unsigned char* s_ = lds + (st_) * SC_STAGE; _Pragma("unroll") for (int i = 0; i < 4; ++i) { const int c = lt + 256 * i, row = c >> 4, c8 = (c & 15) * 8; \
            *(LAS u32x4*)(s_ + SC_NW + (row * SC_PW + c8) * 2) = r[i]; *(LAS u32x4*)(s_ + SC_Q2 + (row * SC_PW + c8) * 2) = r[4 + i]; \
            *(LAS u32x4*)(s_ + SC_KD + ((2 * row + (c8 >> 6)) * SC_PK + (c8 & 63)) * 2) = r[8 + i]; } } while (0)
        SC_LOAD(0); SC_STORE(0);
        __syncthreads();
#pragma unroll 1
        for (int n = 0; n < 32; ++n) {
            if (n + 1 < 32) { SC_LOAD(n + 1); SC_STORE((n + 1) & 1); }
            __syncthreads();
        }
#undef SC_LOAD
#undef SC_STORE
    } else {
        const int col = 32 * wave + ql;
        f32x16 S[4];
#pragma unroll
        for (int rt = 0; rt < 4; ++rt)
#pragma unroll
            for (int r = 0; r < 16; ++r) S[rt][r] = 0.f;
        u32x2 pu[8], po[8];
#define SC_PRE(n_) do { const size_t t0_ = tb + (size_t)(n_) * 64; _Pragma("unroll") for (int jt = 0; jt < 2; ++jt) _Pragma("unroll") for (int bq = 0; bq < 4; ++bq) { const int f = col * 64 + 32 * jt + 8 * bq + 4 * hh; \
            pu[jt * 4 + bq] = *(const u32x2*)(U + slotU(t0_, h, 0, f)); po[jt * 4 + bq] = *(const u32x2*)(U + slotU(t0_, h, 512, f)); } } while (0)
        SC_PRE(0);
        __syncthreads();
#pragma unroll 1
        for (int n = 0; n < 32; ++n) {
            const size_t t0 = tb + (size_t)n * 64;
            const float egl = EGL[bh * 32 + n];
            const LAS unsigned char* st = lds + (n & 1) * SC_STAGE;
            bf16x8 Sb[8];
#pragma unroll
            for (int rt = 0; rt < 4; ++rt) { Sb[2 * rt] = pack8(S[rt], 0); Sb[2 * rt + 1] = pack8(S[rt], 1); }
            f32x16 vn[2], oa[2];
#pragma unroll
            for (int jt = 0; jt < 2; ++jt)
#pragma unroll
                for (int bq = 0; bq < 4; ++bq) { const u32x2 uw = pu[jt * 4 + bq], ow = po[jt * 4 + bq];
                    vn[jt][4 * bq] = bf_lo(uw.x); vn[jt][4 * bq + 1] = bf_hi(uw.x); vn[jt][4 * bq + 2] = bf_lo(uw.y); vn[jt][4 * bq + 3] = bf_hi(uw.y);
                    oa[jt][4 * bq] = bf_lo(ow.x); oa[jt][4 * bq + 1] = bf_hi(ow.x); oa[jt][4 * bq + 2] = bf_lo(ow.y); oa[jt][4 * bq + 3] = bf_hi(ow.y); }
            if (n + 1 < 32) SC_PRE(n + 1);
#pragma unroll
            for (int jt = 0; jt < 2; ++jt) { const LAS unsigned char* wr_ = st + ((32 * jt + ql) * SC_PW + 8 * hh) * 2;
#pragma unroll
                for (int ks = 0; ks < 8; ++ks) { vn[jt] = MFMA32(*(const LAS bf16x8*)(wr_ + SC_NW + 32 * ks), Sb[ks], vn[jt]); oa[jt] = MFMA32(*(const LAS bf16x8*)(wr_ + SC_Q2 + 32 * ks), Sb[ks], oa[jt]); } }
            bf16x8 vb[4] = {pack8(vn[0], 0), pack8(vn[0], 1), pack8(vn[1], 0), pack8(vn[1], 1)};
#pragma unroll
            for (int rt = 0; rt < 4; ++rt) {
#pragma unroll
                for (int r = 0; r < 16; ++r) S[rt][r] *= egl;
                const LAS unsigned char* kr_ = st + SC_KD + ((32 * rt + ql) * SC_PK + 8 * hh) * 2;
#pragma unroll
                for (int ks = 0; ks < 4; ++ks) S[rt] = MFMA32(*(const LAS bf16x8*)(kr_ + 32 * ks), vb[ks], S[rt]); }
#pragma unroll
            for (int jt = 0; jt < 2; ++jt)
#pragma unroll
                for (int r = 0; r < 16; ++r) P[(t0 + 32 * jt + crow(r, hh)) * NIN + C_VDN + h * 128 + col] = f2bf(oa[jt][r]);
            __syncthreads();
        }
#undef SC_PRE
    }
}
__device__ __forceinline__ void gdn_finalize_phase(const Params& p, int wave, int lane) {
    bf16_t* P = (bf16_t*)(p.ws + WS_P);
    const int c0 = (lane & 15) * 8;
    float gg[8];
#pragma unroll
    for (int e = 0; e < 8; ++e) gg[e] = p.in[I_GDNOUT][c0 + e];
    for (int row = blockIdx.x * 8 + wave; row < T; row += gridDim.x * 8) {
        bf16_t* op = P + (size_t)row * NIN + C_VDN + lane * 8; const bf16_t* zp = P + (size_t)row * NIN + C_ZDN + lane * 8;
        const u32x4 ow = *(const u32x4*)op, zw = *(const u32x4*)zp;
        const float o[8] = {bf_lo(ow.x), bf_hi(ow.x), bf_lo(ow.y), bf_hi(ow.y), bf_lo(ow.z), bf_hi(ow.z), bf_lo(ow.w), bf_hi(ow.w)};
        const float z[8] = {bf_lo(zw.x), bf_hi(zw.x), bf_lo(zw.y), bf_hi(zw.y), bf_lo(zw.z), bf_hi(zw.z), bf_lo(zw.w), bf_hi(zw.w)};
        float ss = 0.f;
#pragma unroll
        for (int e = 0; e < 8; ++e) ss += o[e] * o[e];
        ss += __shfl_xor(ss, 1); ss += __shfl_xor(ss, 2); ss += __shfl_xor(ss, 4); ss += __shfl_xor(ss, 8);
        const float rstd = 1.0f / sqrtf(ss * (1.f / 128.f) + EPS);
        float r[8];
#pragma unroll
        for (int e = 0; e < 8; ++e) r[e] = o[e] * rstd * gg[e] * fsilu(z[e]);
        u32x4 w; w.x = pk2(r[0], r[1]); w.y = pk2(r[2], r[3]); w.z = pk2(r[4], r[5]); w.w = pk2(r[6], r[7]);
        *(u32x4*)op = w;
    }
}

#define XB_TMO      128
#define XB_XCNT(j)  (256  + 64 * (j))
#define XB_XSUB(j)  (1280 + 64 * (j))
#define XB_XGEN(j)  (2304 + 64 * (j))
#define XB_TOP      3328
#define XB_TOPGEN   3392
#define XCD_BAR_WORDS 3456
#define XB_SPIN_CAP (1u << 18)
__device__ __forceinline__ unsigned xb_ld(unsigned* p)              { return __hip_atomic_load(p, __ATOMIC_RELAXED, __HIP_MEMORY_SCOPE_AGENT); }
__device__ __forceinline__ unsigned xb_add(unsigned* p, unsigned v) { return __hip_atomic_fetch_add(p, v, __ATOMIC_RELAXED, __HIP_MEMORY_SCOPE_AGENT); }
__device__ __forceinline__ unsigned xb_xcc_id() { return (unsigned)__builtin_amdgcn_s_getreg((3 << 11) | 20) & 0xFu; }
#define XB_SPIN(cond, bar) do { unsigned _sp = 0; while (cond) { __builtin_amdgcn_s_sleep(1); \
    if ((++_sp & 255u) == 0u) { if (xb_ld(&(bar)[XB_TMO])) break; if (_sp > XB_SPIN_CAP) { atomicAdd(&(bar)[XB_TMO], 1u); break; } } } } while (0)
struct XcdBarrier { unsigned* bar; unsigned x; volatile LAS unsigned* st; };
__device__ __forceinline__ XcdBarrier xcd_barrier_post(unsigned* bar, volatile LAS unsigned* st) {
    XcdBarrier b; b.bar = bar; b.x = xb_xcc_id(); b.st = st;
    if (threadIdx.x == 0) (void)xb_add(&bar[XB_XCNT(b.x)], 1u);
    return b;
}
__device__ __forceinline__ void xcd_barrier_complete(unsigned* bar, unsigned x, unsigned& nloc, unsigned& nx) {
    const unsigned G = gridDim.x * gridDim.y * gridDim.z;
    unsigned sum, cnt, mine, sp = 0u;
    for (;;) {
        sum = 0u; cnt = 0u; mine = 0u;
#pragma unroll
        for (unsigned j = 0; j < 16; ++j) { const unsigned c = xb_ld(&bar[XB_XCNT(j)]); sum += c; cnt += (c > 0u) ? 1u : 0u; mine = (j == x) ? c : mine; }
        if (sum == G) break;
        __builtin_amdgcn_s_sleep(1);
        if ((++sp & 255u) == 0u) { if (xb_ld(&bar[XB_TMO])) break; if (sp > XB_SPIN_CAP) { atomicAdd(&bar[XB_TMO], 1u); break; } }
    }
    nloc = mine > 0u ? mine : 1u; nx = cnt > 0u ? cnt : 1u;
}
__device__ __forceinline__ void xcd_barrier(const XcdBarrier& b) {
    asm volatile("s_waitcnt vmcnt(0)" ::: "memory");
    __syncthreads();
    if (threadIdx.x == 0) {
        unsigned* bar = b.bar;
        __builtin_amdgcn_s_waitcnt(0);
        unsigned nloc = b.st[0], nx = b.st[1];
        if (nloc == 0u) { xcd_barrier_complete(bar, b.x, nloc, nx); b.st[0] = nloc; b.st[1] = nx; }
        const unsigned old = xb_add(&bar[XB_XSUB(b.x)], 1u);
        const unsigned gen = old / nloc;
        if (old + 1u == (gen + 1u) * nloc) {
            __builtin_amdgcn_fence(__ATOMIC_RELEASE, "agent");
            asm volatile("s_waitcnt vmcnt(0)" ::: "memory");
            const unsigned og = xb_add(&bar[XB_TOP], 1u);
            const unsigned tg = og / nx;
            if (og + 1u == (tg + 1u) * nx) xb_add(&bar[XB_TOPGEN], 1u);
            else XB_SPIN(xb_ld(&bar[XB_TOPGEN]) == tg, bar);
            __builtin_amdgcn_fence(__ATOMIC_ACQUIRE, "agent");
            xb_add(&bar[XB_XGEN(b.x)], 1u);
            asm volatile("s_waitcnt vmcnt(0)" ::: "memory");
        } else {
            XB_SPIN(xb_ld(&bar[XB_XGEN(b.x)]) == gen, bar);
            __builtin_amdgcn_fence(__ATOMIC_ACQUIRE, "agent");
            asm volatile("s_waitcnt vmcnt(0)" ::: "memory");
        }
    }
    __syncthreads();
}

#ifndef PHMASK
#define PHMASK 0xFFFF
#endif
#define PH(n) ((PHMASK >> (n)) & 1)
#ifndef PROBE
#define PROBE 0
#endif
#define REP(g) for (int _rep = 0; _rep < ((PROBE == (g)) ? 2 : 1); ++_rep)
__global__ void __launch_bounds__(512, 2) fwd_megakernel(Params p) {
    extern __shared__ __attribute__((aligned(16))) unsigned char lds_raw[];
    LAS unsigned char* lds = (LAS unsigned char*)lds_raw;
    cg::grid_group grid = cg::this_grid();
    const int tid = threadIdx.x, lane = tid & 63, wave = __builtin_amdgcn_readfirstlane(tid >> 6);
    const int G = gridDim.x, gw = wave * G + blockIdx.x, ngw = G * 8;
    unsigned char* ws = p.ws;
    bf16_t* U = (bf16_t*)(ws + WS_U); bf16_t* P = (bf16_t*)(ws + WS_P);
    const float* mod = (const float*)(ws + WS_MOD);
    LAS float* scr = (LAS float*)(lds + wave * 16384);

    unsigned* barw = (unsigned*)(ws + WS_BAR);
    if (blockIdx.x == 0) {
        if (tid == 0) __hip_atomic_store((unsigned*)(ws + WS_CTR), 0u, __ATOMIC_RELAXED, __HIP_MEMORY_SCOPE_AGENT);
        if (tid == 1) __hip_atomic_store(&barw[XB_TMO], 0u, __ATOMIC_RELAXED, __HIP_MEMORY_SCOPE_AGENT);
        if (tid == 2) __hip_atomic_store(&barw[XB_TOP], 0u, __ATOMIC_RELAXED, __HIP_MEMORY_SCOPE_AGENT);
        if (tid == 3) __hip_atomic_store(&barw[XB_TOPGEN], 0u, __ATOMIC_RELAXED, __HIP_MEMORY_SCOPE_AGENT);
        if (tid >= 64 && tid < 80) { const int j = tid - 64; __hip_atomic_store(&barw[XB_XCNT(j)], 0u, __ATOMIC_RELAXED, __HIP_MEMORY_SCOPE_AGENT); __hip_atomic_store(&barw[XB_XSUB(j)], 0u, __ATOMIC_RELAXED, __HIP_MEMORY_SCOPE_AGENT); __hip_atomic_store(&barw[XB_XGEN(j)], 0u, __ATOMIC_RELAXED, __HIP_MEMORY_SCOPE_AGENT); }
    }
    volatile LAS unsigned* bst = (volatile LAS unsigned*)(lds + 131072);
    if (tid < 2) bst[tid] = 0u;
    __syncthreads();
    REP(1) { if (PH(0)) for (int it = blockIdx.x; it < NMOD / 64; it += G) mod_item(p, lds, it, tid, wave, lane);
    if (PH(0)) ffn_weight_items(p.in[I_WFFN1IN], p.in[I_WFFN1OUT], (bf16_t*)(ws + W_FFIN), (bf16_t*)(ws + W_FFOUT), scr, gw, ngw, lane);
    if (PH(0)) mixer_weight_items(p, scr, gw, ngw, lane); __syncthreads(); }
    grid.sync();
    const XcdBarrier xbar = xcd_barrier_post(barw, bst);
    if (PROBE == 3) for (int i = 0; i < 16; ++i) xcd_barrier(xbar);
    REP(1) if (PH(1)) norm_mod_phase<false>(p, lds, p.in[I_X], p.in[I_GFFN1], 0, U, tid, wave, lane);
    xcd_barrier(xbar);
    REP(2) if (PH(2)) run_gemm(lds, U, D, (const bf16_t*)(ws + W_FFIN), 2 * FF, D, EpiSwiGLU{P, FF});
    xcd_barrier(xbar);
    REP(2) if (PH(3)) run_gemm(lds, P, FF, (const bf16_t*)(ws + W_FFOUT), D, FF, EpiResid{p.in[I_X], p.out, mod + 2 * D, 0.5f});
    xcd_barrier(xbar);
    REP(1) if (PH(4)) norm_mod_phase<true>(p, lds, p.out, p.in[I_GMIX], 3, U, tid, wave, lane);
    xcd_barrier(xbar);
    REP(2) if (PH(5)) run_gemm(lds, U, D, (const bf16_t*)(ws + W_IN), NIN, D, EpiBf16{P, NIN});
    xcd_barrier(xbar);
    if (PH(6)) prep_phase(p, wave, lane);
    xcd_barrier(xbar);
    if (PH(7)) for (int it = blockIdx.x; it < 1024; it += G) gdn_chunk_prep(p, lds, it, tid, wave, lane);
    xcd_barrier(xbar);
    if (PH(15)) for (int it = blockIdx.x; it < 32; it += G) gdn_scan_block(p, lds, it, tid, wave, lane);
    if (PH(8)) { unsigned* ctr = (unsigned*)(ws + WS_CTR);
        for (;;) { unsigned idx = 0; if (lane == 0) idx = atomicAdd(ctr, 1u); idx = __builtin_amdgcn_readfirstlane(idx);
            if (idx >= 4096u) break;
            attn_item_mfma(P, (const bf16_t*)(ws + WS_VT), (int)(idx & 63u), 63 - (int)(idx >> 6), lane); } }
    xcd_barrier(xbar);
    if (PH(9)) gdn_finalize_phase(p, wave, lane);
    xcd_barrier(xbar);
    if (PH(10)) run_gemm(lds, P + C_QSB, NIN, (const bf16_t*)(ws + W_UPSB), D, 512, EpiGate<false>{P + C_RSB, U});
    if (PH(10)) run_gemm(lds, P + C_VDN, NIN, (const bf16_t*)(ws + W_UPDN), D, 512, EpiGate<true>{P + C_RDN, U});
    xcd_barrier(xbar);
    if (PH(11)) run_gemm(lds, U, D, (const bf16_t*)(ws + W_OUT), D, D, EpiResid{p.out, p.out, mod + 5 * D, 1.0f});
    xcd_barrier(xbar);
    REP(1) if (PH(12)) norm_mod_phase<false>(p, lds, p.out, p.in[I_GFFN2], 6, U, tid, wave, lane);
    __syncthreads();
    if (PH(12)) ffn_weight_items(p.in[I_WFFN2IN], p.in[I_WFFN2OUT], (bf16_t*)(ws + W_FFIN), (bf16_t*)(ws + W_FFOUT), scr, gw, ngw, lane);
    xcd_barrier(xbar);
    REP(2) if (PH(13)) run_gemm(lds, U, D, (const bf16_t*)(ws + W_FFIN), 2 * FF, D, EpiSwiGLU{P, FF});
    xcd_barrier(xbar);
    if (PH(14)) run_gemm(lds, P, FF, (const bf16_t*)(ws + W_FFOUT), D, FF, EpiResid{p.out, p.out, mod + 8 * D, 0.5f});
}

extern "C" void kernel_launch(void* const* d_in, const int* in_sizes, int n_in, void* d_out, int out_size, void* d_ws, size_t ws_size, hipStream_t stream) {
    static int grid_blocks = 0;
    if (!grid_blocks) {
        int dev = 0, cus = 0, per_cu = 0;
        (void)hipGetDevice(&dev);
        (void)hipDeviceGetAttribute(&cus, hipDeviceAttributeMultiprocessorCount, dev);
        (void)hipFuncSetAttribute((const void*)fwd_megakernel, hipFuncAttributeMaxDynamicSharedMemorySize, LDS_BYTES);
        (void)hipOccupancyMaxActiveBlocksPerMultiprocessor(&per_cu, (const void*)fwd_megakernel, 512, LDS_BYTES);
        if (per_cu < 1) { fprintf(stderr, "occupancy query says %d blocks/CU\n", per_cu); per_cu = 1; }
        grid_blocks = cus;
    }
    Params p{};
    for (int i = 0; i < N_IN; ++i) p.in[i] = (const float*)d_in[i];
    p.out = (float*)d_out; p.ws = (unsigned char*)d_ws;
    void* args[] = {&p};
    hipError_t e = hipLaunchCooperativeKernel((const void*)fwd_megakernel, dim3(grid_blocks), dim3(512), args, LDS_BYTES, stream);
    if (e != hipSuccess) fprintf(stderr, "cooperative launch failed: %s (grid %d)\n", hipGetErrorString(e), grid_blocks);
}
```

```cpp
#include <hip/hip_runtime.h>
#include <hip/hip_cooperative_groups.h>
#include <cstdio>
namespace cg = cooperative_groups;

#define LAS __attribute__((address_space(3)))
typedef unsigned short bf16_t;
typedef short bf16x8 __attribute__((ext_vector_type(8)));
typedef float f32x4 __attribute__((ext_vector_type(4)));
typedef unsigned u32x4 __attribute__((ext_vector_type(4)));
typedef unsigned u32x2 __attribute__((ext_vector_type(2)));
typedef float f32x16 __attribute__((ext_vector_type(16)));
typedef float f32x2 __attribute__((ext_vector_type(2)));
typedef __bf16 nbf16x2 __attribute__((ext_vector_type(2)));

constexpr int T = 16384, D = 1024, SEQ = 2048, NB = 8, FF = 2816, NIN = 5632, INW = 5640, NMOD = 9216;
constexpr int C_QSB = 0, C_KSB = 512, C_VSB = 1024, C_QDN = 1536, C_KDN = 2048, C_VDN = 2560, C_ZDN = 3072, C_RSB = 3584, C_RDN = 4608;
constexpr float EPS = 1e-6f;
constexpr int LDS_BYTES = 131072 + 64;
constexpr size_t MiB = 1024 * 1024;
constexpr size_t WS_MOD = 0, WS_BG = 512 * 1024, WS_SS = 242 * MiB, WS_W = 2 * MiB;
constexpr size_t W_FFIN = WS_W, W_FFOUT = W_FFIN + (size_t)2 * FF * D * 2, W_IN = W_FFOUT + (size_t)D * FF * 2, W_UPSB = W_IN + (size_t)NIN * D * 2,
                 W_UPDN = W_UPSB + (size_t)D * 512 * 2, W_OUT = W_UPDN + (size_t)D * 512 * 2, W_END = W_OUT + (size_t)D * D * 2;
constexpr size_t WS_U = 34 * MiB, WS_P = 66 * MiB;
static_assert(W_END <= WS_U, "weights overflow");
constexpr size_t WS_EGL = 384 * 1024, WS_CTR = 400 * 1024, WS_BAR = 416 * 1024;
constexpr size_t WS_VT = W_FFIN;
static_assert((size_t)T * 512 * 2 <= W_IN - W_FFIN, "Vt overflow");

enum { I_X = 0, I_C, I_WADA, I_BADA, I_GFFN1, I_WFFN1IN, I_WFFN1OUT, I_GMIX, I_WIN, I_GQSB, I_GKSB, I_WCONV, I_ALOG, I_DTBIAS, I_GDNOUT, I_WUPSB, I_WUPDN, I_WOUT, I_GFFN2, I_WFFN2IN, I_WFFN2OUT, N_IN };
struct Params { const float* in[N_IN]; float* out; unsigned char* ws; };

__device__ __forceinline__ float bf_lo(unsigned w) { return __uint_as_float(w << 16); }
__device__ __forceinline__ float bf_hi(unsigned w) { return __uint_as_float(w & 0xffff0000u); }
__device__ __forceinline__ float bf2f(bf16_t b) { return __uint_as_float(((unsigned)b) << 16); }
__device__ __forceinline__ unsigned pk2(float lo, float hi) { unsigned r; asm("v_cvt_pk_bf16_f32 %0, %1, %2" : "=v"(r) : "v"(lo), "v"(hi)); return r; }
__device__ __forceinline__ unsigned cpk2(float lo, float hi) { const f32x2 v = {lo, hi}; return __builtin_bit_cast(unsigned, __builtin_convertvector(v, nbf16x2)); }
__device__ __forceinline__ bf16_t f2bf(float f) { return (bf16_t)(pk2(f, 0.f) & 0xffffu); }
__device__ __forceinline__ float fexp(float x) { return __builtin_amdgcn_exp2f(x * 1.4426950408889634f); }
__device__ __forceinline__ float flog(float x) { return __builtin_amdgcn_logf(x) * 0.6931471805599453f; }
__device__ __forceinline__ float fsigmoid(float x) { return __builtin_amdgcn_rcpf(1.f + fexp(-x)); }
__device__ __forceinline__ float fsilu(float x) { return x * fsigmoid(x); }
__device__ __forceinline__ float fsoftplus(float x) { return fmaxf(x, 0.f) + flog(1.f + fexp(-fabsf(x))); }
__device__ __forceinline__ float wave_sum(float v) {
#pragma unroll
    for (int o = 1; o < 64; o <<= 1) v += __shfl_xor(v, o);
    return v;
}
#define LDS_WAIT() asm volatile("s_waitcnt lgkmcnt(0)" ::: "memory")

namespace pg8 {
constexpr int BM = 256, BK = 64, HALF = 128, HTB = HALF * BK * 2, STAGE_BYTES = 8 * HTB, NXCD = 8, WGM = 8;
__host__ __device__ __forceinline__ int lds_byte(int r, int c) { const int st = (r >> 4) * 2 + (c >> 5), rr = r & 15, cc = c & 31, ob = rr * 64 + cc * 2; return st * 1024 + (ob ^ (((ob >> 9) & 1) << 5)); }
__host__ __device__ __forceinline__ void stage_rc(int b, int& R, int& C) { const int st = b / 1024, sb = b % 1024, swz = sb ^ (((sb >> 9) & 1) << 5); R = (st >> 1) * 16 + swz / 64; C = (st & 1) * 32 + (swz % 64) / 2; }
__host__ __device__ __forceinline__ int perm32(int rho) { const int n = rho >> 4, i = rho & 15; return 8 * (i >> 2) + 4 * n + (i & 3); }
struct Unit { int pm, pn; };
struct Gemm { const bf16_t* A; const bf16_t* Bt; int M, N, K, lda; int jt; int jbytes; };
struct StaticOrder {
    int nM, nN, nwg, G, c;
    __host__ __device__ void init(int M, int N, int G_, int c_) { nM = M / BM; nN = N / BM; nwg = nM * nN; G = G_; c = c_; }
    __host__ __device__ bool next(int i, Unit& u) const {
        const long L = (long)i * G + c; if (L >= nwg) return false;
        int wgid = (int)L; { const int q = nwg / NXCD, r = nwg % NXCD, xcd = wgid % NXCD, off = wgid / NXCD; wgid = (xcd < r ? xcd * (q + 1) : r * (q + 1) + (xcd - r) * q) + off; }
        const int nig = WGM * nN, gid = wgid / nig, fm = gid * WGM, gsz = (nM - fm) < WGM ? (nM - fm) : WGM;
        u.pm = fm + ((wgid % nig) % gsz); u.pn = (wgid % nig) / gsz; return true;
    }
};
template <class Epi>
__device__ __forceinline__ void gemm_phase(LAS unsigned char* lds, const Gemm g, const StaticOrder& S, const Epi& E) {
    int tid = threadIdx.x; asm volatile("" : "+v"(tid));
    const int wid = __builtin_amdgcn_readfirstlane(tid >> 6), lane = tid & 63, wr = wid >> 2, wc = wid & 3, fr = lane & 15, fq = lane >> 4;
    const int K = g.K, nt = K / BK, lda = g.lda;
    unsigned voffA[2], voffB[2];
#pragma unroll
    for (int i = 0; i < 2; ++i) { int R, C; stage_rc(tid * 16 + i * 8192, R, C); const int Rb = Epi::PERM ? ((R & ~31) + perm32(R & 31)) : R;
        voffA[i] = (unsigned)(R * lda + C) * 2u; voffB[i] = (unsigned)(Rb * K + C) * 2u; }
    const size_t kstep = (size_t)(BK * 2);
    const size_t hstepA = (size_t)HALF * lda * 2, hstepB = (size_t)HALF * K * 2;
    const size_t tstepA = 2 * hstepA, tstepB = 2 * hstepB;
    const unsigned ldsw = (unsigned)wid * 1024u;
    const int aoff = lds_byte(wr * 64 + fr, fq * 8), boff = lds_byte(wc * 32 + fr, fq * 8);
#define PG8_SA(b, h) (((b) * 2 + (h)) * HTB)
#define PG8_SB(b, h) ((4 + (b) * 2 + (h)) * HTB)
#define PG8_STAGE(bufoff, gbase, voff) do { _Pragma("unroll") for (int _i = 0; _i < 2; ++_i) \
        __builtin_amdgcn_global_load_lds((const unsigned*)((const char*)(gbase) + (voff)[_i]), (LAS unsigned*)(lds + (bufoff) + ldsw + _i * 8192), 16, 0, 0); } while (0)
#define PG8_LDA(dst, b, h) do { _Pragma("unroll") for (int m = 0; m < 4; ++m) _Pragma("unroll") for (int k = 0; k < 2; ++k) dst[m][k] = *(const LAS bf16x8*)(lds + PG8_SA(b, h) + aoff + m * 2048 + k * 1024); } while (0)
#define PG8_LDB(dst, b, h) do { _Pragma("unroll") for (int n = 0; n < 2; ++n) _Pragma("unroll") for (int k = 0; k < 2; ++k) dst[n][k] = *(const LAS bf16x8*)(lds + PG8_SB(b, h) + boff + n * 2048 + k * 1024); } while (0)
#define PG8_MMA(ai, bj, At, Bt) do { __builtin_amdgcn_s_setprio(1); _Pragma("unroll") for (int m = 0; m < 4; ++m) _Pragma("unroll") for (int n = 0; n < 2; ++n) _Pragma("unroll") for (int k = 0; k < 2; ++k) \
        acc[ai][bj][m][n] = __builtin_amdgcn_mfma_f32_16x16x32_bf16(Bt[n][k], At[m][k], acc[ai][bj][m][n], 0, 0, 0); __builtin_amdgcn_s_setprio(0); } while (0)
#define PG8_WAIT_V(n) asm volatile("s_waitcnt vmcnt(" #n ")" ::: "memory")
#define PG8_WAIT_L(n) asm volatile("s_waitcnt lgkmcnt(" #n ")" ::: "memory")
#define PG8_BAR __builtin_amdgcn_s_barrier()
#define PG8_SCHED __builtin_amdgcn_sched_barrier(0)
    Unit cur, nxt; int ui = 0;
    if (!S.next(0, cur)) return;
    f32x4 acc[2][2][4][2];
#pragma unroll
    for (int a = 0; a < 2; ++a)
#pragma unroll
        for (int b = 0; b < 2; ++b)
#pragma unroll
            for (int m = 0; m < 4; ++m)
#pragma unroll
                for (int n = 0; n < 2; ++n) acc[a][b][m][n] = (f32x4){0.f, 0.f, 0.f, 0.f};
    bf16x8 At[4][2], B0[2][2], B1[2][2];
    const char* cA = (const char*)g.A + (size_t)cur.pm * tstepA; const char* cB = (const char*)g.Bt + (size_t)cur.pn * tstepB;
    PG8_STAGE(PG8_SB(0, 0), cB, voffB); PG8_STAGE(PG8_SA(0, 0), cA, voffA); PG8_STAGE(PG8_SB(0, 1), cB + hstepB, voffB); PG8_STAGE(PG8_SA(0, 1), cA + hstepA, voffA);
    if (wr == 1) PG8_BAR;
    PG8_WAIT_V(4); PG8_BAR;
    PG8_STAGE(PG8_SB(1, 0), cB + kstep, voffB); PG8_STAGE(PG8_SA(1, 0), cA + kstep, voffA); PG8_STAGE(PG8_SB(1, 1), cB + hstepB + kstep, voffB);
    PG8_WAIT_V(6); PG8_BAR;
    for (;;) {
        const bool has_next = S.next(ui + 1, nxt);
        const char* nA = has_next ? (const char*)g.A + (size_t)nxt.pm * tstepA : cA; const char* nB = has_next ? (const char*)g.Bt + (size_t)nxt.pn * tstepB : cB;
        for (int t = 0; t < nt; t += 2) {
            const bool last = (t == nt - 2);
            const char* a1 = cA + (size_t)(t + 1) * kstep + (t + 1 >= g.jt ? g.jbytes : 0);
            const char* a2 = last ? nA : cA + (size_t)(t + 2) * kstep + (t + 2 >= g.jt ? g.jbytes : 0); const char* b2 = last ? nB : cB + (size_t)(t + 2) * kstep;
            const char* a3 = a2 + kstep; const char* b3 = b2 + kstep;
            if constexpr (Epi::HAS_MID) { if (t == g.jt) E.mid(acc, cur, wr, wc, fr, fq); }
            PG8_LDB(B0, 0, 0); PG8_SCHED; PG8_LDA(At, 0, 0); PG8_STAGE(PG8_SA(1, 1), a1 + hstepA, voffA);
            PG8_WAIT_L(8); PG8_BAR; PG8_WAIT_L(0); PG8_MMA(0, 0, At, B0); PG8_BAR; PG8_SCHED;
            PG8_LDB(B1, 0, 1); PG8_STAGE(PG8_SB(0, 0), b2, voffB);
            PG8_BAR; PG8_WAIT_L(0); PG8_MMA(0, 1, At, B1); PG8_BAR;
            PG8_LDA(At, 0, 1); PG8_STAGE(PG8_SA(0, 0), a2, voffA);
            PG8_BAR; PG8_WAIT_L(0); PG8_MMA(1, 0, At, B0); PG8_BAR; PG8_SCHED;
            PG8_STAGE(PG8_SB(0, 1), b2 + hstepB, voffB);
            PG8_WAIT_V(6); PG8_BAR; PG8_MMA(1, 1, At, B1); PG8_BAR;
            PG8_LDB(B0, 1, 0); PG8_SCHED; PG8_LDA(At, 1, 0); PG8_STAGE(PG8_SA(0, 1), a2 + hstepA, voffA);
            PG8_WAIT_L(8); PG8_BAR; PG8_WAIT_L(0); PG8_MMA(0, 0, At, B0); PG8_BAR; PG8_SCHED;
            PG8_LDB(B1, 1, 1); PG8_STAGE(PG8_SB(1, 0), b3, voffB);
            PG8_BAR; PG8_WAIT_L(0); PG8_MMA(0, 1, At, B1); PG8_BAR;
            PG8_LDA(At, 1, 1); PG8_STAGE(PG8_SA(1, 0), a3, voffA);
            PG8_BAR; PG8_WAIT_L(0); PG8_MMA(1, 0, At, B0); PG8_BAR; PG8_SCHED;
            PG8_STAGE(PG8_SB(1, 1), b3 + hstepB, voffB);
            PG8_WAIT_V(6); PG8_BAR; PG8_MMA(1, 1, At, B1); PG8_BAR;
        }
        E(acc, cur, wr, wc, fr, fq);
        if (!has_next) break;
#pragma unroll
        for (int a = 0; a < 2; ++a)
#pragma unroll
            for (int b = 0; b < 2; ++b)
#pragma unroll
                for (int m = 0; m < 4; ++m)
#pragma unroll
                    for (int n = 0; n < 2; ++n) acc[a][b][m][n] = (f32x4){0.f, 0.f, 0.f, 0.f};
        cur = nxt; cA = nA; cB = nB; ++ui;
    }
    PG8_WAIT_V(0);
    if (wr == 0) PG8_BAR;
    PG8_BAR;
#undef PG8_SA
#undef PG8_SB
#undef PG8_STAGE
#undef PG8_LDA
#undef PG8_LDB
#undef PG8_MMA
#undef PG8_WAIT_V
#undef PG8_WAIT_L
#undef PG8_BAR
#undef PG8_SCHED
}
}

typedef const f32x4 (&AccRef)[2][2][4][2];
struct EpiBf16 {
    static constexpr bool PERM = true, HAS_MID = false;
    bf16_t* O; int ldc;
    __device__ __forceinline__ void operator()(AccRef acc, const pg8::Unit& u, int wr, int wc, int fr, int fq) const {
        const int row0 = u.pm * 256 + wr * 64 + fr, col0 = u.pn * 256 + wc * 32 + 8 * fq;
#pragma unroll
        for (int ai = 0; ai < 2; ++ai)
#pragma unroll
            for (int m = 0; m < 4; ++m) { bf16_t* rowp = O + (size_t)(row0 + ai * 128 + m * 16) * ldc + col0;
#pragma unroll
                for (int bj = 0; bj < 2; ++bj) { const f32x4 v0 = acc[ai][bj][m][0], v1 = acc[ai][bj][m][1];
                    u32x4 w; w.x = pk2(v0[0], v0[1]); w.y = pk2(v0[2], v0[3]); w.z = pk2(v1[0], v1[1]); w.w = pk2(v1[2], v1[3]);
                    *(u32x4*)(rowp + bj * 128) = w; } }
    }
};
struct EpiSwiGLU {
    static constexpr bool PERM = true, HAS_MID = false;
    bf16_t* O; int ldc;
    __device__ __forceinline__ void operator()(AccRef acc, const pg8::Unit& u, int wr, int wc, int fr, int fq) const {
        const int row0 = u.pm * 256 + wr * 64 + fr, col0 = u.pn * 128 + wc * 32 + 8 * fq;
#pragma unroll
        for (int ai = 0; ai < 2; ++ai)
#pragma unroll
            for (int m = 0; m < 4; ++m) { bf16_t* rowp = O + (size_t)(row0 + ai * 128 + m * 16) * ldc + col0;
                float r[8];
#pragma unroll
                for (int n = 0; n < 2; ++n)
#pragma unroll
                    for (int j = 0; j < 4; ++j) { const float a = acc[ai][0][m][n][j], b = acc[ai][1][m][n][j]; r[n * 4 + j] = fsilu(a) * b; }
                u32x4 w; w.x = pk2(r[0], r[1]); w.y = pk2(r[2], r[3]); w.z = pk2(r[4], r[5]); w.w = pk2(r[6], r[7]);
                *(u32x4*)rowp = w; }
    }
};
struct EpiResid {
    static constexpr bool PERM = false, HAS_MID = false;
    const float* base; float* out; const float* gate; float scale;
    __device__ __forceinline__ void operator()(AccRef acc, const pg8::Unit& u, int wr, int wc, int fr, int fq) const {
        const int row0 = u.pm * 256 + wr * 64 + fr, col0 = u.pn * 256 + wc * 32 + 4 * fq;
        const float* gp = gate + (size_t)(u.pm >> 3) * NMOD + col0;
        f32x4 gv[2][2];
#pragma unroll
        for (int bj = 0; bj < 2; ++bj)
#pragma unroll
            for (int n = 0; n < 2; ++n) gv[bj][n] = *(const f32x4*)(gp + bj * 128 + n * 16) * scale;
#pragma unroll
        for (int ai = 0; ai < 2; ++ai)
#pragma unroll
            for (int m = 0; m < 4; ++m) { const size_t off = (size_t)(row0 + ai * 128 + m * 16) * D + col0;
#pragma unroll
                for (int bj = 0; bj < 2; ++bj)
#pragma unroll
                    for (int n = 0; n < 2; ++n) { const f32x4 bs = *(const f32x4*)(base + off + bj * 128 + n * 16);
                        *(f32x4*)(out + off + bj * 128 + n * 16) = bs + gv[bj][n] * acc[ai][bj][m][n]; } }
    }
};
struct EpiGateFused {
    static constexpr bool PERM = true, HAS_MID = true;
    const bf16_t* Rsb; const bf16_t* Rdn; bf16_t* O;
    __device__ __forceinline__ void mid(f32x4 (&acc)[2][2][4][2], const pg8::Unit& u, int wr, int wc, int fr, int fq) const {
        int row0 = u.pm * 256 + wr * 64 + fr, col0 = u.pn * 256 + wc * 32 + 8 * fq;
        asm volatile("" : "+v"(row0), "+v"(col0));
#pragma unroll
        for (int ai = 0; ai < 2; ++ai)
#pragma unroll
            for (int m = 0; m < 4; ++m) { const size_t row = (size_t)(row0 + ai * 128 + m * 16);
#pragma unroll
                for (int bj = 0; bj < 2; ++bj) { const u32x4 a = *(const u32x4*)(Rsb + row * NIN + col0 + bj * 128), d = *(const u32x4*)(Rdn + row * NIN + col0 + bj * 128);
                    const float ra[8] = {bf_lo(a.x), bf_hi(a.x), bf_lo(a.y), bf_hi(a.y), bf_lo(a.z), bf_hi(a.z), bf_lo(a.w), bf_hi(a.w)};
                    const float rd[8] = {bf_lo(d.x), bf_hi(d.x), bf_lo(d.y), bf_hi(d.y), bf_lo(d.z), bf_hi(d.z), bf_lo(d.w), bf_hi(d.w)};
#pragma unroll
                    for (int e = 0; e < 8; ++e) { const float q = (1.0f + fexp(-rd[e])) * __builtin_amdgcn_rcpf(1.0f + fexp(-ra[e])); acc[ai][bj][m][e >> 2][e & 3] *= q; }
                    asm volatile("" ::: "memory"); } }
    }
    __device__ __forceinline__ void operator()(AccRef acc, const pg8::Unit& u, int wr, int wc, int fr, int fq) const {
        const int row0 = u.pm * 256 + wr * 64 + fr, col0 = u.pn * 256 + wc * 32 + 8 * fq;
#pragma unroll
        for (int ai = 0; ai < 2; ++ai)
#pragma unroll
            for (int m = 0; m < 4; ++m) { const size_t row = (size_t)(row0 + ai * 128 + m * 16);
#pragma unroll
                for (int bj = 0; bj < 2; ++bj) { const u32x4 d = *(const u32x4*)(Rdn + row * NIN + col0 + bj * 128);
                    const f32x4 v0 = acc[ai][bj][m][0], v1 = acc[ai][bj][m][1];
                    const float r[8] = {fsigmoid(bf_lo(d.x)) * v0[0], fsigmoid(bf_hi(d.x)) * v0[1], fsigmoid(bf_lo(d.y)) * v0[2], fsigmoid(bf_hi(d.y)) * v0[3],
                                        fsigmoid(bf_lo(d.z)) * v1[0], fsigmoid(bf_hi(d.z)) * v1[1], fsigmoid(bf_lo(d.w)) * v1[2], fsigmoid(bf_hi(d.w)) * v1[3]};
                    u32x4 w; w.x = pk2(r[0], r[1]); w.y = pk2(r[2], r[3]); w.z = pk2(r[4], r[5]); w.w = pk2(r[6], r[7]);
                    *(u32x4*)(O + row * D + col0 + bj * 128) = w; } }
    }
};
template <class Epi> __device__ __forceinline__ void run_gemm(LAS unsigned char* lds, const bf16_t* A, int lda, const bf16_t* Bt, int N, int K, const Epi& E, int jt = 1 << 30, int jbytes = 0) {
    pg8::Gemm g{A, Bt, T, N, K, lda, jt, jbytes}; pg8::StaticOrder S; S.init(T, N, (int)gridDim.x, (int)blockIdx.x);
    pg8::gemm_phase<Epi>(lds, g, S, E);
}

__device__ __forceinline__ void transpose_item(const float* W, int ldw, int s0, int k0, bf16_t* WT, int ldk, int d0, LAS float* scr, int lane) {
    float tv[32];
#pragma unroll
    for (int i = 0; i < 32; ++i) tv[i] = W[(size_t)(k0 + 2 * i + (lane >> 5)) * ldw + s0 + (lane & 31)];
#pragma unroll
    for (int i = 0; i < 32; ++i) scr[(2 * i + (lane >> 5)) * 33 + (lane & 31)] = tv[i];
    LDS_WAIT();
    const int c = lane & 7;
#pragma unroll
    for (int j = 0; j < 4; ++j) { const int n = (lane >> 3) + 8 * j; const LAS float* s = scr + (8 * c) * 33 + n;
        u32x4 o; o.x = pk2(s[0 * 33], s[1 * 33]); o.y = pk2(s[2 * 33], s[3 * 33]); o.z = pk2(s[4 * 33], s[5 * 33]); o.w = pk2(s[6 * 33], s[7 * 33]);
        *(u32x4*)(WT + (size_t)(d0 + n) * ldk + k0 + 8 * c) = o; }
    LDS_WAIT();
}
__device__ __forceinline__ void ffn_weight_items(const float* w_in, const float* w_out, bf16_t* wt_in, bf16_t* wt_out, LAS float* scr, int gw, int ngw, int lane) {
    for (int it = gw; it < 2816 + 1408; it += ngw) {
        if (it < 2816) { const int kb = it / 176, nb = it % 176, d0 = nb * 32, pn = d0 >> 8, bj = (d0 >> 7) & 1, c = d0 & 127, s0 = bj * FF + pn * 128 + c;
            transpose_item(w_in, 2 * FF, s0, kb * 64, wt_in, D, d0, scr, lane); }
        else { const int r = it - 2816, kb = r / 32, nb = r % 32; transpose_item(w_out, D, nb * 32, kb * 64, wt_out, FF, nb * 32, scr, lane); }
    }
}
__device__ __forceinline__ void mixer_weight_items(const Params& p, LAS float* scr, int gw, int ngw, int lane) {
    unsigned char* ws = p.ws;
    for (int it = gw; it < 2816 + 256 + 256 + 512; it += ngw) {
        int r = it;
        if (r < 2816) { const int kb = r / 176, nb = r % 176, d0 = nb * 32, s0 = d0 < C_RSB ? d0 : d0 + 8; transpose_item(p.in[I_WIN], INW, s0, kb * 64, (bf16_t*)(ws + W_IN), D, d0, scr, lane); continue; } r -= 2816;
        if (r < 256) { const int kb = r / 32, nb = r % 32; transpose_item(p.in[I_WUPSB], D, nb * 32, kb * 64, (bf16_t*)(ws + W_UPSB), D, nb * 32, scr, lane); continue; } r -= 256;
        if (r < 256) { const int kb = r / 32, nb = r % 32; transpose_item(p.in[I_WUPDN], D, nb * 32, kb * 64, (bf16_t*)(ws + W_UPSB) + 512, D, nb * 32, scr, lane); continue; } r -= 256;
        { const int kb = r / 32, nb = r % 32; transpose_item(p.in[I_WOUT], D, nb * 32, kb * 64, (bf16_t*)(ws + W_OUT), D, nb * 32, scr, lane); }
    }
}
__device__ __forceinline__ void mod_item(const Params& p, LAS unsigned char* lds, int cb, int tid, int wave, int lane) {
    LAS float* sc = (LAS float*)lds; LAS float* red = (LAS float*)(lds + 32768);
    for (int i = tid; i < NB * D; i += 512) sc[i] = fsilu(p.in[I_C][i]);
    __syncthreads();
    const float* wa = p.in[I_WADA] + cb * 64 + lane;
    float acc[NB];
#pragma unroll
    for (int b = 0; b < NB; ++b) acc[b] = 0.f;
    for (int k = wave * 128; k < wave * 128 + 128; k += 16) {
        float w[16];
#pragma unroll
        for (int e = 0; e < 16; ++e) w[e] = wa[(size_t)(k + e) * NMOD];
#pragma unroll
        for (int b = 0; b < NB; ++b)
#pragma unroll
            for (int e4 = 0; e4 < 4; ++e4) { const f32x4 s = *(const LAS f32x4*)(sc + b * D + k + 4 * e4); acc[b] += s[0] * w[4 * e4] + s[1] * w[4 * e4 + 1] + s[2] * w[4 * e4 + 2] + s[3] * w[4 * e4 + 3]; }
    }
#pragma unroll
    for (int b = 0; b < NB; ++b) red[(wave * NB + b) * 64 + lane] = acc[b];
    __syncthreads();
    { const int b = tid >> 6; float s = p.in[I_BADA][cb * 64 + lane];
#pragma unroll
        for (int w = 0; w < 8; ++w) s += red[(w * NB + b) * 64 + lane];
        ((float*)(p.ws + WS_MOD))[b * NMOD + cb * 64 + lane] = s; }
    __syncthreads();
}

template <bool DN>
__device__ __forceinline__ void norm_mod_phase(const Params& p, LAS unsigned char* lds, const float* src, const float* gain, int midx, bf16_t* dst, int tid, int wave, int lane) {
    const float* mod = (const float*)(p.ws + WS_MOD);
    LAS float* wl = (LAS float*)lds;
    if (DN) { for (int i = tid; i < D * 8; i += 512) { const int k = i >> 3, j = i & 7; wl[8 * k + 4 * (k >> 2) + j] = p.in[I_WIN][(size_t)k * INW + C_RSB + j]; } __syncthreads(); }
    f32x4 g4[4];
#pragma unroll
    for (int j = 0; j < 4; ++j) g4[j] = ((const f32x4*)gain)[lane + 64 * j];
    for (int row = blockIdx.x * 8 + wave; row < T; row += gridDim.x * 8) {
        const int b = row >> 11;
        const f32x4* xr = (const f32x4*)(src + (size_t)row * D) + lane;
        const f32x4* shp = (const f32x4*)(mod + (size_t)b * NMOD + midx * D) + lane; const f32x4* scp = shp + D / 4;
        f32x4 v[4]; float ss = 0.f;
#pragma unroll
        for (int j = 0; j < 4; ++j) { v[j] = xr[64 * j]; ss += (v[j][0] * v[j][0] + v[j][1] * v[j][1]) + (v[j][2] * v[j][2] + v[j][3] * v[j][3]); }
        const float rstd = 1.0f / sqrtf(wave_sum(ss) * (1.f / D) + EPS);
        u32x2* o8 = (u32x2*)(dst + (size_t)row * D) + lane;
        float dot[8];
        if (DN) {
#pragma unroll
            for (int e = 0; e < 8; ++e) dot[e] = 0.f; }
#pragma unroll
        for (int j = 0; j < 4; ++j) { const f32x4 sh = shp[64 * j], sc = scp[64 * j];
            const f32x4 uu = v[j] * rstd * g4[j] * (sc + 1.0f) + sh;
            u32x2 w; w.x = pk2(uu[0], uu[1]); w.y = pk2(uu[2], uu[3]); o8[64 * j] = w;
            if (DN) {
#pragma unroll
                for (int e = 0; e < 4; ++e) { const int k = 4 * lane + 256 * j + e; const LAS f32x4* wp = (const LAS f32x4*)(wl + 8 * k + 4 * (k >> 2)); const f32x4 w0 = wp[0], w1 = wp[1];
                    dot[0] += uu[e] * w0[0]; dot[1] += uu[e] * w0[1]; dot[2] += uu[e] * w0[2]; dot[3] += uu[e] * w0[3];
                    dot[4] += uu[e] * w1[0]; dot[5] += uu[e] * w1[1]; dot[6] += uu[e] * w1[2]; dot[7] += uu[e] * w1[3]; } } }
        if (DN) {
#pragma unroll
            for (int e = 0; e < 8; ++e) dot[e] = wave_sum(dot[e]);
            float mine = dot[0];
#pragma unroll
            for (int e = 1; e < 8; ++e) mine = (lane == e) ? dot[e] : mine;
            if (lane < 8) { float r;
                if (lane < 4) r = 1.0f / (1.0f + expf(-mine));
                else { const int hh = lane - 4; const float a = mine + p.in[I_DTBIAS][hh]; const float sp = a > 20.f ? a : log1pf(expf(a)); r = -expf(p.in[I_ALOG][hh]) * sp; }
                ((float*)(p.ws + WS_BG))[(size_t)row * 8 + lane] = r; } }
    }
    if (DN) __syncthreads();
}

__device__ __forceinline__ void unpack16(const bf16_t* p, float* f) {
    const u32x4 a = ((const u32x4*)p)[0], b = ((const u32x4*)p)[1];
    f[0] = bf_lo(a.x); f[1] = bf_hi(a.x); f[2] = bf_lo(a.y); f[3] = bf_hi(a.y); f[4] = bf_lo(a.z); f[5] = bf_hi(a.z); f[6] = bf_lo(a.w); f[7] = bf_hi(a.w);
    f[8] = bf_lo(b.x); f[9] = bf_hi(b.x); f[10] = bf_lo(b.y); f[11] = bf_hi(b.y); f[12] = bf_lo(b.z); f[13] = bf_hi(b.z); f[14] = bf_lo(b.w); f[15] = bf_hi(b.w);
}
__device__ __forceinline__ void pack16(bf16_t* p, const float* f) {
    u32x4 a, b; a.x = pk2(f[0], f[1]); a.y = pk2(f[2], f[3]); a.z = pk2(f[4], f[5]); a.w = pk2(f[6], f[7]); b.x = pk2(f[8], f[9]); b.y = pk2(f[10], f[11]); b.z = pk2(f[12], f[13]); b.w = pk2(f[14], f[15]);
    ((u32x4*)p)[0] = a; ((u32x4*)p)[1] = b;
}
__device__ __forceinline__ void prep_phase(const Params& p, int wave, int lane) {
    bf16_t* P = (bf16_t*)(p.ws + WS_P); bf16_t* U = (bf16_t*)(p.ws + WS_U);
    const int ch = 16 * lane;
    float gsb[16], wcv[4][16];
    { const float* gp = (ch < 512 ? p.in[I_GQSB] : p.in[I_GKSB]) + (ch & 63); const float sc = ch < 512 ? 0.125f : 1.0f;
#pragma unroll
        for (int e = 0; e < 16; ++e) gsb[e] = gp[e] * sc;
#pragma unroll
        for (int i = 0; i < 4; ++i)
#pragma unroll
            for (int e = 0; e < 16; ++e) wcv[i][e] = p.in[I_WCONV][i * 1536 + ch + e]; }
    for (int row = blockIdx.x * 8 + wave; row < T; row += gridDim.x * 8) {
        const int tl = row & (SEQ - 1);
        { bf16_t* qp = P + (size_t)row * NIN + ch; float f[16]; unpack16(qp, f); float ss = 0.f;
#pragma unroll
            for (int e = 0; e < 16; ++e) ss += f[e] * f[e];
            ss += __shfl_xor(ss, 1); ss += __shfl_xor(ss, 2);
            const float rstd = 1.0f / sqrtf(ss * (1.f / 64.f) + EPS);
#pragma unroll
            for (int e = 0; e < 16; ++e) f[e] = f[e] * rstd * gsb[e];
            pack16(qp, f); }
        { float y[16];
#pragma unroll
            for (int e = 0; e < 16; ++e) y[e] = 0.f;
#pragma unroll
            for (int i = 0; i < 4; ++i) { if (tl - 3 + i >= 0) { float f[16]; unpack16(P + (size_t)(row - 3 + i) * NIN + C_QDN + ch, f);
#pragma unroll
                    for (int e = 0; e < 16; ++e) y[e] += wcv[i][e] * f[e]; } }
            float ss = 0.f;
#pragma unroll
            for (int e = 0; e < 16; ++e) { y[e] = fsilu(y[e]); ss += y[e] * y[e]; }
            ss += __shfl_xor(ss, 1); ss += __shfl_xor(ss, 2); ss += __shfl_xor(ss, 4);
            const float sc = (1.0f / sqrtf(ss + EPS)) * (ch < 512 ? 0.08838834764831845f : 1.0f);
#pragma unroll
            for (int e = 0; e < 16; ++e) y[e] *= sc;
            pack16(U + (size_t)row * D + ch, y); }
    }
    bf16_t* Vt = (bf16_t*)(p.ws + WS_VT);
    for (int it = blockIdx.x * 8 + wave; it < T / 16; it += gridDim.x * 8) {
        const int row0 = it * 16, b = row0 >> 11, tl0 = row0 & (SEQ - 1), c8 = lane * 8, hd = c8 >> 6, d0 = c8 & 63;
        u32x4 w[16];
#pragma unroll
        for (int r = 0; r < 16; ++r) w[r] = *(const u32x4*)(P + (size_t)(row0 + r) * NIN + C_VSB + c8);
#pragma unroll
        for (int e = 0; e < 8; ++e) {
            unsigned o[8];
#pragma unroll
            for (int i = 0; i < 8; ++i) {
                const int p0 = 2 * i, p1 = 2 * i + 1;
                const int k0 = 8 * ((p0 >> 2) & 1) + 4 * (p0 >> 3) + (p0 & 3), k1 = 8 * ((p1 >> 2) & 1) + 4 * (p1 >> 3) + (p1 & 3);
                const unsigned a0 = w[k0][e >> 1], a1 = w[k1][e >> 1];
                const unsigned lo = (e & 1) ? (a0 >> 16) : (a0 & 0xffffu), hi = (e & 1) ? (a1 & 0xffff0000u) : (a1 << 16);
                o[i] = lo | hi; }
            bf16_t* dst = Vt + ((size_t)(b * 8 + hd) * 64 + d0 + e) * SEQ + tl0;
            ((u32x4*)dst)[0] = (u32x4){o[0], o[1], o[2], o[3]}; ((u32x4*)dst)[1] = (u32x4){o[4], o[5], o[6], o[7]}; }
    }
}

__device__ __forceinline__ void attn_item_mfma(bf16_t* P, const bf16_t* Vt, int bh, int qt, int lane) {
    asm volatile("" : "+v"(lane));
    const int b = bh >> 3, h = bh & 7, ql = lane & 31, hh = lane >> 5, q0 = qt * 32;
    bf16_t* qrow = P + (size_t)(b * SEQ + q0 + ql) * NIN + C_QSB + h * 64;
    bf16x8 qf[4];
#pragma unroll
    for (int s = 0; s < 4; ++s) qf[s] = *(const bf16x8*)(qrow + 16 * s + 8 * hh);
    f32x16 o0, o1;
#pragma unroll
    for (int i = 0; i < 16; ++i) { o0[i] = 0.f; o1[i] = 0.f; }
    float R = 1.0f;
    const bf16_t* kb = P + (size_t)(b * SEQ + ql) * NIN + C_KSB + h * 64 + 8 * hh;
    const bf16_t* vb = Vt + ((size_t)bh * 64 + ql) * SEQ + 8 * hh;
    bf16x8 kf[4], vf[4];
#pragma unroll
    for (int s = 0; s < 4; ++s) kf[s] = *(const bf16x8*)(kb + (size_t)q0 * NIN + 16 * s);
#pragma unroll
    for (int j = 0; j < 4; ++j) vf[j] = *(const bf16x8*)(vb + (size_t)(j >> 1) * 32 * SEQ + q0 + 16 * (j & 1));
#pragma unroll 1
    for (int kt = qt; kt >= 0; --kt) {
        f32x16 z;
#pragma unroll
        for (int i = 0; i < 16; ++i) z[i] = 0.f;
#pragma unroll
        for (int s = 0; s < 4; ++s) z = __builtin_amdgcn_mfma_f32_32x32x16_bf16(kf[s], qf[s], z, 0, 0, 0);
        bf16x8 vc[4];
#pragma unroll
        for (int j = 0; j < 4; ++j) vc[j] = vf[j];
        { const int kn = (kt > 0 ? kt - 1 : 0) * 32;
#pragma unroll
            for (int s = 0; s < 4; ++s) kf[s] = *(const bf16x8*)(kb + (size_t)kn * NIN + 16 * s);
#pragma unroll
            for (int j = 0; j < 4; ++j) vf[j] = *(const bf16x8*)(vb + (size_t)(j >> 1) * 32 * SEQ + kn + 16 * (j & 1)); }
        float sg[16], m[16];
        const bool diag = (kt == qt);
#pragma unroll
        for (int i = 0; i < 16; ++i) { const float zz = z[i]; const float e = __builtin_amdgcn_exp2f(-1.4426950408889634f * fabsf(zz)); const float r = __builtin_amdgcn_rcpf(1.0f + e); const float er = e * r;
            float sig = zz >= 0.f ? r : er, mm = zz >= 0.f ? er : r;
            if (diag) { const bool act = ((i & 3) + 8 * (i >> 2) + 4 * hh) < ql; sig = act ? sig : 0.f; mm = act ? mm : 1.0f; }
            sg[i] = sig; m[i] = mm; }
        float g[4], gp[4];
#pragma unroll
        for (int bq = 0; bq < 4; ++bq) { g[bq] = (m[4 * bq] * m[4 * bq + 1]) * (m[4 * bq + 2] * m[4 * bq + 3]); gp[bq] = __shfl_xor(g[bq], 32); }
        float outer[4]; float tb = R;
#pragma unroll
        for (int bq = 3; bq >= 0; --bq) { outer[bq] = tb * (hh == 0 ? gp[bq] : 1.0f); tb *= g[bq] * gp[bq]; }
        R = tb;
        float w[16];
#pragma unroll
        for (int bq = 0; bq < 4; ++bq) { const float s3 = outer[bq], s2 = s3 * m[4 * bq + 3], s1 = s2 * m[4 * bq + 2], s0 = s1 * m[4 * bq + 1];
            w[4 * bq + 3] = sg[4 * bq + 3] * s3; w[4 * bq + 2] = sg[4 * bq + 2] * s2; w[4 * bq + 1] = sg[4 * bq + 1] * s1; w[4 * bq] = sg[4 * bq] * s0; }
        bf16x8 wf[2];
#pragma unroll
        for (int s2 = 0; s2 < 2; ++s2) { const u32x4 pw = {cpk2(w[8 * s2], w[8 * s2 + 1]), cpk2(w[8 * s2 + 2], w[8 * s2 + 3]), cpk2(w[8 * s2 + 4], w[8 * s2 + 5]), cpk2(w[8 * s2 + 6], w[8 * s2 + 7])}; wf[s2] = __builtin_bit_cast(bf16x8, pw); }
        o0 = __builtin_amdgcn_mfma_f32_32x32x16_bf16(vc[0], wf[0], o0, 0, 0, 0); o0 = __builtin_amdgcn_mfma_f32_32x32x16_bf16(vc[1], wf[1], o0, 0, 0, 0);
        o1 = __builtin_amdgcn_mfma_f32_32x32x16_bf16(vc[2], wf[0], o1, 0, 0, 0); o1 = __builtin_amdgcn_mfma_f32_32x32x16_bf16(vc[3], wf[1], o1, 0, 0, 0);
    }
#pragma unroll
    for (int bq = 0; bq < 4; ++bq) {
        u32x2 w0 = {cpk2(o0[4 * bq], o0[4 * bq + 1]), cpk2(o0[4 * bq + 2], o0[4 * bq + 3])}, w1 = {cpk2(o1[4 * bq], o1[4 * bq + 1]), cpk2(o1[4 * bq + 2], o1[4 * bq + 3])};
        *(u32x2*)(qrow + 8 * bq + 4 * hh) = w0; *(u32x2*)(qrow + 32 + 8 * bq + 4 * hh) = w1; }
}
__device__ __forceinline__ size_t slotU(size_t t0, int h, int colbase, int f) { return (t0 + (size_t)(f >> 7)) * D + colbase + h * 128 + (f & 127); }
__device__ __forceinline__ size_t slotP(size_t t0, int h, int colbase, int f) { return (t0 + (size_t)(f >> 7)) * NIN + colbase + h * 128 + (f & 127); }
__device__ __forceinline__ int permpos(int x) { const int k = x & 15; return (x & ~15) + 8 * ((k >> 2) & 1) + 4 * (k >> 3) + (k & 3); }
__device__ __forceinline__ int crow(int r, int hh) { return (r & 3) + 8 * (r >> 2) + 4 * hh; }
__device__ __forceinline__ bf16x8 pack8(const f32x16& x, int s2) {
    const u32x4 pw = {cpk2(x[8 * s2], x[8 * s2 + 1]), cpk2(x[8 * s2 + 2], x[8 * s2 + 3]), cpk2(x[8 * s2 + 4], x[8 * s2 + 5]), cpk2(x[8 * s2 + 6], x[8 * s2 + 7])};
    return __builtin_bit_cast(bf16x8, pw);
}
#define MFMA32(a, b, c) __builtin_amdgcn_mfma_f32_32x32x16_bf16((a), (b), (c), 0, 0, 0)
constexpr int PT = 72, PQ = 136, PL = 68, PB = 40;
constexpr int CP_GC = 0, CP_BT = 256, CP_LS = 1024, CP_TU = CP_LS + 64 * PL * 4, CP_TW = CP_TU + 64 * PT * 2, CP_KT = CP_TW + 64 * PT * 2, CP_VT = CP_KT + 128 * PT * 2,
              CP_QS = CP_VT + 128 * PT * 2, CP_KS = CP_QS + 64 * PQ * 2, CP_AQ = CP_KS + 64 * PQ * 2, CP_L21 = CP_AQ + 64 * PT * 2, CP_TCM = CP_L21 + 32 * PB * 2, CP_T22 = CP_TCM + 32 * PB * 2, CP_END = CP_T22 + 32 * PB * 2;
static_assert(CP_END <= 131072, "chunk prep LDS");
__device__ __forceinline__ void gdn_chunk_prep(const Params& p, LAS unsigned char* lds, int item, int tid, int wave, int lane) {
    asm volatile("" : "+v"(tid), "+v"(lane));
    const int bh = item >> 5, n = item & 31, b = bh >> 2, h = bh & 3, ql = lane & 31, hh = lane >> 5;
    const size_t t0 = (size_t)b * SEQ + n * 64;
    bf16_t* P = (bf16_t*)(p.ws + WS_P); bf16_t* U = (bf16_t*)(p.ws + WS_U); const float* BG = (const float*)(p.ws + WS_BG);
    LAS float* gcS = (LAS float*)(lds + CP_GC); LAS float* btS = (LAS float*)(lds + CP_BT);
    LAS float* LS = (LAS float*)(lds + CP_LS);
    LAS bf16_t* TuS = (LAS bf16_t*)(lds + CP_TU); LAS bf16_t* TwS = (LAS bf16_t*)(lds + CP_TW);
    LAS bf16_t* kT = (LAS bf16_t*)(lds + CP_KT); LAS bf16_t* vT = (LAS bf16_t*)(lds + CP_VT); LAS bf16_t* qS = (LAS bf16_t*)(lds + CP_QS); LAS bf16_t* kS = (LAS bf16_t*)(lds + CP_KS);
    LAS bf16_t* AQ = (LAS bf16_t*)(lds + CP_AQ); LAS bf16_t* L21b = (LAS bf16_t*)(lds + CP_L21); LAS bf16_t* Tcm = (LAS bf16_t*)(lds + CP_TCM); LAS bf16_t* T22r = (LAS bf16_t*)(lds + CP_T22);
    if (tid < 64) { float x = BG[(t0 + tid) * 8 + 4 + h];
#pragma unroll
        for (int o = 1; o < 64; o <<= 1) { const float y = __shfl_up(x, o); if (lane >= o) x += y; }
        gcS[tid] = x; btS[tid] = BG[(t0 + tid) * 8 + h]; }
    { const int tok = tid >> 3, c16 = (tid & 7) * 16;
        const u32x4 ka = *(const u32x4*)(U + (t0 + tok) * D + 512 + h * 128 + c16), kb = *(const u32x4*)(U + (t0 + tok) * D + 512 + h * 128 + c16 + 8);
        const u32x4 qa = *(const u32x4*)(U + (t0 + tok) * D + h * 128 + c16), qb = *(const u32x4*)(U + (t0 + tok) * D + h * 128 + c16 + 8);
        u32x4 xv[4][2];
#pragma unroll
        for (int i = 0; i < 4; ++i) { const bool ok = n * 64 + tok - 3 + i >= 0; const bf16_t* vp = P + (t0 + tok - 3 + i) * NIN + C_VDN + h * 128 + c16;
            xv[i][0] = ok ? *(const u32x4*)vp : (u32x4){0u, 0u, 0u, 0u}; xv[i][1] = ok ? *(const u32x4*)(vp + 8) : (u32x4){0u, 0u, 0u, 0u}; }
        *(LAS u32x4*)(kS + tok * PQ + c16) = ka; *(LAS u32x4*)(kS + tok * PQ + c16 + 8) = kb;
        *(LAS u32x4*)(qS + tok * PQ + c16) = qa; *(LAS u32x4*)(qS + tok * PQ + c16 + 8) = qb;
        const unsigned kw[8] = {ka.x, ka.y, ka.z, ka.w, kb.x, kb.y, kb.z, kb.w};
#pragma unroll
        for (int e = 0; e < 8; ++e) { kT[(c16 + 2 * e) * PT + tok] = (bf16_t)(kw[e] & 0xffffu); kT[(c16 + 2 * e + 1) * PT + tok] = (bf16_t)(kw[e] >> 16); }
        float y[16];
#pragma unroll
        for (int e = 0; e < 16; ++e) y[e] = 0.f;
#pragma unroll
        for (int i = 0; i < 4; ++i) { const float* wp = p.in[I_WCONV] + i * 1536 + 1024 + h * 128 + c16;
            const unsigned xw[8] = {xv[i][0].x, xv[i][0].y, xv[i][0].z, xv[i][0].w, xv[i][1].x, xv[i][1].y, xv[i][1].z, xv[i][1].w};
#pragma unroll
            for (int e = 0; e < 8; ++e) { y[2 * e] += wp[2 * e] * bf_lo(xw[e]); y[2 * e + 1] += wp[2 * e + 1] * bf_hi(xw[e]); } }
#pragma unroll
        for (int e = 0; e < 16; ++e) vT[(c16 + e) * PT + tok] = f2bf(fsilu(y[e])); }
    __syncthreads();
    if (wave == 0) {
        bf16x8 kf[2][8];
#pragma unroll
        for (int t = 0; t < 2; ++t)
#pragma unroll
            for (int ks = 0; ks < 8; ++ks) kf[t][ks] = *(const LAS bf16x8*)(kS + (32 * t + ql) * PQ + 16 * ks + 8 * hh);
#pragma unroll
        for (int tt = 0; tt < 3; ++tt) { const int it = tt == 0 ? 0 : 1, jt = tt == 2 ? 1 : 0;
            f32x16 acc;
#pragma unroll
            for (int r = 0; r < 16; ++r) acc[r] = 0.f;
#pragma unroll
            for (int ks = 0; ks < 8; ++ks) acc = MFMA32(kf[it][ks], kf[jt][ks], acc);
            const int j = 32 * jt + ql; const float gj = gcS[j];
#pragma unroll
            for (int r = 0; r < 16; ++r) { const int i = 32 * it + crow(r, hh); const float l = (j < i) ? btS[i] * acc[r] * fexp(gcS[i] - gj) : 0.f;
                if (it != jt) L21b[(i - 32) * PB + j] = f2bf(l); else LS[i * PL + j] = l; } }
    } else if (wave < 4) {
        const int jt = wave == 3 ? 1 : 0, it = wave == 1 ? 0 : 1;
        f32x16 acc;
#pragma unroll
        for (int r = 0; r < 16; ++r) acc[r] = 0.f;
#pragma unroll
        for (int ks = 0; ks < 8; ++ks) acc = MFMA32(*(const LAS bf16x8*)(kS + (32 * jt + ql) * PQ + 16 * ks + 8 * hh), *(const LAS bf16x8*)(qS + (32 * it + ql) * PQ + 16 * ks + 8 * hh), acc);
        const int i = 32 * it + ql; const float gi = gcS[i];
#pragma unroll
        for (int r = 0; r < 16; ++r) { const int j = 32 * jt + crow(r, hh); acc[r] = (j <= i) ? acc[r] * fexp(gi - gcS[j]) : 0.f; }
#pragma unroll
        for (int bq = 0; bq < 4; ++bq) *(LAS u32x2*)(AQ + i * PT + 32 * jt + 8 * bq + 4 * hh) = (u32x2){cpk2(acc[4 * bq], acc[4 * bq + 1]), cpk2(acc[4 * bq + 2], acc[4 * bq + 3])};
    } else {
        const float gl = gcS[63];
#pragma unroll
        for (int uu = 0; uu < 2; ++uu) { const int unit = (tid - 256) + 256 * uu, dk = unit >> 2, blk = unit & 3;
            const u32x4 k0 = *(const LAS u32x4*)(kT + dk * PT + 16 * blk), k1 = *(const LAS u32x4*)(kT + dk * PT + 16 * blk + 8);
            float kv[16] = {bf_lo(k0.x), bf_hi(k0.x), bf_lo(k0.y), bf_hi(k0.y), bf_lo(k0.z), bf_hi(k0.z), bf_lo(k0.w), bf_hi(k0.w), bf_lo(k1.x), bf_hi(k1.x), bf_lo(k1.y), bf_hi(k1.y), bf_lo(k1.z), bf_hi(k1.z), bf_lo(k1.w), bf_hi(k1.w)};
#pragma unroll
            for (int e = 0; e < 16; ++e) kv[e] *= fexp(gl - gcS[16 * blk + e]);
            float pv[16];
#pragma unroll
            for (int e = 0; e < 16; ++e) pv[permpos(e)] = kv[e];
            pack16(P + slotP(t0, h, C_VSB, dk * 64 + 16 * blk), pv); }
        if (tid == 256) ((float*)(p.ws + WS_EGL))[bh * 32 + n] = fexp(gl);
    }
    __syncthreads();
    if (wave == 0) {
        const LAS float* LB = LS + (32 * hh) * PL + 32 * hh;
        float Tc[32];
#pragma unroll
        for (int i = 0; i < 32; ++i) {
            float a0 = (ql == i) ? 1.0f : 0.f, a1 = 0.f, a2 = 0.f, a3 = 0.f;
#pragma unroll
            for (int j4 = 0; j4 < i; j4 += 4) { const f32x4 l4 = *(const LAS f32x4*)(LB + i * PL + j4);
                a0 -= l4[0] * Tc[j4]; if (j4 + 1 < i) a1 -= l4[1] * Tc[j4 + 1]; if (j4 + 2 < i) a2 -= l4[2] * Tc[j4 + 2]; if (j4 + 3 < i) a3 -= l4[3] * Tc[j4 + 3]; }
            Tc[i] = (a0 + a1) + (a2 + a3); }
        const int cg_ = 32 * hh + ql; const float bu = btS[cg_], bw = bu * fexp(gcS[cg_]);
#pragma unroll
        for (int i = 0; i < 32; ++i) { TuS[(32 * hh + i) * PT + cg_] = f2bf(Tc[i] * bu); TwS[(32 * hh + i) * PT + cg_] = f2bf(Tc[i] * bw); }
        if (hh == 0) {
#pragma unroll
            for (int i8 = 0; i8 < 4; ++i8) *(LAS u32x4*)(Tcm + ql * PB + 8 * i8) = (u32x4){cpk2(Tc[8 * i8], Tc[8 * i8 + 1]), cpk2(Tc[8 * i8 + 2], Tc[8 * i8 + 3]), cpk2(Tc[8 * i8 + 4], Tc[8 * i8 + 5]), cpk2(Tc[8 * i8 + 6], Tc[8 * i8 + 7])};
        } else {
#pragma unroll
            for (int i = 0; i < 32; ++i) T22r[i * PB + ql] = f2bf(Tc[i]);
        }
        LDS_WAIT();
        f32x16 x1;
#pragma unroll
        for (int r = 0; r < 16; ++r) x1[r] = 0.f;
#pragma unroll
        for (int s2 = 0; s2 < 2; ++s2) x1 = MFMA32(*(const LAS bf16x8*)(L21b + ql * PB + 16 * s2 + 8 * hh), *(const LAS bf16x8*)(Tcm + ql * PB + 16 * s2 + 8 * hh), x1);
        f32x16 yy;
#pragma unroll
        for (int r = 0; r < 16; ++r) yy[r] = 0.f;
#pragma unroll
        for (int s2 = 0; s2 < 2; ++s2) { const u32x2 lo = *(const LAS u32x2*)(T22r + ql * PB + 16 * s2 + 4 * hh), hi = *(const LAS u32x2*)(T22r + ql * PB + 16 * s2 + 8 + 4 * hh);
            const u32x4 af = {lo.x, lo.y, hi.x, hi.y};
            yy = MFMA32(__builtin_bit_cast(bf16x8, af), pack8(x1, s2), yy); }
        { const float bu0 = btS[ql], bw0 = bu0 * fexp(gcS[ql]);
#pragma unroll
            for (int r = 0; r < 16; ++r) { const int i2 = 32 + crow(r, hh); TuS[i2 * PT + ql] = f2bf(-yy[r] * bu0); TwS[i2 * PT + ql] = f2bf(-yy[r] * bw0); } }
    }
    __syncthreads();
    {
        const int isW = wave >> 2, ct = wave & 3, col = 32 * ct + ql;
        const LAS bf16_t* Ta = (isW ? TwS : TuS) + 8 * hh; const LAS bf16_t* Bs = (isW ? kT : vT) + col * PT + 8 * hh;
        bf16x8 bf[4];
#pragma unroll
        for (int ks = 0; ks < 4; ++ks) bf[ks] = *(const LAS bf16x8*)(Bs + 16 * ks);
        f32x16 xa[2];
#pragma unroll
        for (int jt = 0; jt < 2; ++jt) {
#pragma unroll
            for (int r = 0; r < 16; ++r) xa[jt][r] = 0.f;
#pragma unroll
            for (int ks = 0; ks < 4; ++ks) if (jt == 1 || ks < 2) xa[jt] = MFMA32(*(const LAS bf16x8*)(Ta + (32 * jt + ql) * PT + 16 * ks), bf[ks], xa[jt]); }
        bf16x8 xb[4] = {pack8(xa[0], 0), pack8(xa[0], 1), pack8(xa[1], 0), pack8(xa[1], 1)};
        f32x16 ra[2];
#pragma unroll
        for (int it = 0; it < 2; ++it) {
#pragma unroll
            for (int r = 0; r < 16; ++r) ra[it][r] = 0.f;
#pragma unroll
            for (int kk = 0; kk < 4; ++kk) if (it == 1 || kk < 2) { const LAS bf16_t* ap = AQ + (32 * it + ql) * PT + 16 * kk + 4 * hh;
                const u32x2 lo = *(const LAS u32x2*)ap, hi = *(const LAS u32x2*)(ap + 8); const u32x4 af = {lo.x, lo.y, hi.x, hi.y};
                ra[it] = MFMA32(__builtin_bit_cast(bf16x8, af), xb[kk], ra[it]); } }
        if (!isW) {
#pragma unroll
            for (int jt = 0; jt < 2; ++jt)
#pragma unroll
                for (int bq = 0; bq < 4; ++bq) { const int f = col * 64 + 32 * jt + 8 * bq + 4 * hh;
                    *(u32x2*)(U + slotU(t0, h, 0, f)) = (u32x2){cpk2(xa[jt][4 * bq], xa[jt][4 * bq + 1]), cpk2(xa[jt][4 * bq + 2], xa[jt][4 * bq + 3])};
                    *(u32x2*)(U + slotU(t0, h, 512, f)) = (u32x2){cpk2(ra[jt][4 * bq], ra[jt][4 * bq + 1]), cpk2(ra[jt][4 * bq + 2], ra[jt][4 * bq + 3])}; }
        } else {
            const int pc = permpos(col);
#pragma unroll
            for (int jt = 0; jt < 2; ++jt)
#pragma unroll
                for (int r = 0; r < 16; ++r) { const int tok = 32 * jt + crow(r, hh);
                    P[(t0 + tok) * NIN + C_QDN + h * 128 + pc] = f2bf(-xa[jt][r]);
                    P[(t0 + tok) * NIN + C_KDN + h * 128 + pc] = f2bf(bf2f(qS[tok * PQ + col]) * fexp(gcS[tok]) - ra[jt][r]); }
        }
    }
    __syncthreads();
}
constexpr int SC_PW = 136, SC_PK = 72, SC_NW = 0, SC_Q2 = 64 * SC_PW * 2, SC_KD = 2 * 64 * SC_PW * 2, SC_STAGE = 2 * 64 * SC_PW * 2 + 128 * SC_PK * 2;
static_assert(2 * SC_STAGE <= 131072, "scan LDS");
__device__ __forceinline__ void gdn_scan_block(const Params& p, LAS unsigned char* lds, int bh, int tid, int wave, int lane) {
    asm volatile("" : "+v"(tid), "+v"(lane));
    bf16_t* P = (bf16_t*)(p.ws + WS_P); const bf16_t* U = (const bf16_t*)(p.ws + WS_U); const float* EGL = (const float*)(p.ws + WS_EGL);
    const int b = bh >> 2, h = bh & 3, ql = lane & 31, hh = lane >> 5;
    const size_t tb = (size_t)b * SEQ;
    if (wave >= 4) {
        const int lt = tid - 256;
        u32x4 r[12];
#define SC_LOAD(n_) do { const size_t t0_ = tb + (size_t)(n_) * 64; _Pragma("unroll") for (int i = 0; i < 4; ++i) { const int c = lt + 256 * i, row = c >> 4, c8 = (c & 15) * 8; \
            const bf16_t* g_ = P + (t0_ + row) * NIN + h * 128 + c8; r[i] = *(const u32x4*)(g_ + C_QDN); r[4 + i] = *(const u32x4*)(g_ + C_KDN); r[8 + i] = *(const u32x4*)(g_ + C_VSB); } } while (0)
#define SC_STORE(st_) do { LAS unsigned char* s_ = lds + (st_) * SC_STAGE; _Pragma("unroll") for (int i = 0; i < 4; ++i) { const int c = lt + 256 * i, row = c >> 4, c8 = (c & 15) * 8; \
            *(LAS u32x4*)(s_ + SC_NW + (row * SC_PW + c8) * 2) = r[i]; *(LAS u32x4*)(s_ + SC_Q2 + (row * SC_PW + c8) * 2) = r[4 + i]; \
            *(LAS u32x4*)(s_ + SC_KD + ((2 * row + (c8 >> 6)) * SC_PK + (c8 & 63)) * 2) = r[8 + i]; } } while (0)
        SC_LOAD(0); SC_STORE(0);
        __syncthreads();
#pragma unroll 1
        for (int n = 0; n < 32; ++n) {
            if (n + 1 < 32) { SC_LOAD(n + 1); SC_STORE((n + 1) & 1); }
            __syncthreads();
        }
#undef SC_LOAD
#undef SC_STORE
    } else {
        const int col = 32 * wave + ql;
        f32x16 S[4];
#pragma unroll
        for (int rt = 0; rt < 4; ++rt)
#pragma unroll
            for (int r = 0; r < 16; ++r) S[rt][r] = 0.f;
        u32x2 pu[8], po[8];
#define SC_PRE(n_) do { const size_t t0_ = tb + (size_t)(n_) * 64; _Pragma("unroll") for (int jt = 0; jt < 2; ++jt) _Pragma("unroll") for (int bq = 0; bq < 4; ++bq) { const int f = col * 64 + 32 * jt + 8 * bq + 4 * hh; \
            pu[jt * 4 + bq] = *(const u32x2*)(U + slotU(t0_, h, 0, f)); po[jt * 4 + bq] = *(const u32x2*)(U + slotU(t0_, h, 512, f)); } } while (0)
        SC_PRE(0);
        __syncthreads();
#pragma unroll 1
        for (int n = 0; n < 32; ++n) {
            const size_t t0 = tb + (size_t)n * 64;
            const float egl = EGL[bh * 32 + n];
            const LAS unsigned char* st = lds + (n & 1) * SC_STAGE;
            bf16x8 Sb[8];
#pragma unroll
            for (int rt = 0; rt < 4; ++rt) { Sb[2 * rt] = pack8(S[rt], 0); Sb[2 * rt + 1] = pack8(S[rt], 1); }
            f32x16 vn[2], oa[2];
#pragma unroll
            for (int jt = 0; jt < 2; ++jt)
#pragma unroll
                for (int bq = 0; bq < 4; ++bq) { const u32x2 uw = pu[jt * 4 + bq], ow = po[jt * 4 + bq];
                    vn[jt][4 * bq] = bf_lo(uw.x); vn[jt][4 * bq + 1] = bf_hi(uw.x); vn[jt][4 * bq + 2] = bf_lo(uw.y); vn[jt][4 * bq + 3] = bf_hi(uw.y);
                    oa[jt][4 * bq] = bf_lo(ow.x); oa[jt][4 * bq + 1] = bf_hi(ow.x); oa[jt][4 * bq + 2] = bf_lo(ow.y); oa[jt][4 * bq + 3] = bf_hi(ow.y); }
            if (n + 1 < 32) SC_PRE(n + 1);
#pragma unroll
            for (int jt = 0; jt < 2; ++jt) { const LAS unsigned char* wr_ = st + ((32 * jt + ql) * SC_PW + 8 * hh) * 2;
#pragma unroll
                for (int ks = 0; ks < 8; ++ks) { vn[jt] = MFMA32(*(const LAS bf16x8*)(wr_ + SC_NW + 32 * ks), Sb[ks], vn[jt]); oa[jt] = MFMA32(*(const LAS bf16x8*)(wr_ + SC_Q2 + 32 * ks), Sb[ks], oa[jt]); } }
            bf16x8 vb[4] = {pack8(vn[0], 0), pack8(vn[0], 1), pack8(vn[1], 0), pack8(vn[1], 1)};
#pragma unroll
            for (int rt = 0; rt < 4; ++rt) {
#pragma unroll
                for (int r = 0; r < 16; ++r) S[rt][r] *= egl;
                const LAS unsigned char* kr_ = st + SC_KD + ((32 * rt + ql) * SC_PK + 8 * hh) * 2;
#pragma unroll
                for (int ks = 0; ks < 4; ++ks) S[rt] = MFMA32(*(const LAS bf16x8*)(kr_ + 32 * ks), vb[ks], S[rt]); }
#pragma unroll
            for (int jt = 0; jt < 2; ++jt)
#pragma unroll
                for (int r = 0; r < 16; ++r) P[(t0 + 32 * jt + crow(r, hh)) * NIN + C_VDN + h * 128 + col] = f2bf(oa[jt][r]);
            __syncthreads();
        }
#undef SC_PRE
    }
}
__device__ __forceinline__ void gdn_finalize_phase(const Params& p, int wave, int lane) {
    bf16_t* P = (bf16_t*)(p.ws + WS_P);
    const int c0 = (lane & 15) * 8;
    float gg[8];
#pragma unroll
    for (int e = 0; e < 8; ++e) gg[e] = p.in[I_GDNOUT][c0 + e];
    for (int row = blockIdx.x * 8 + wave; row < T; row += gridDim.x * 8) {
        bf16_t* op = P + (size_t)row * NIN + C_VDN + lane * 8; const bf16_t* zp = P + (size_t)row * NIN + C_ZDN + lane * 8;
        const u32x4 ow = *(const u32x4*)op, zw = *(const u32x4*)zp;
        const float o[8] = {bf_lo(ow.x), bf_hi(ow.x), bf_lo(ow.y), bf_hi(ow.y), bf_lo(ow.z), bf_hi(ow.z), bf_lo(ow.w), bf_hi(ow.w)};
        const float z[8] = {bf_lo(zw.x), bf_hi(zw.x), bf_lo(zw.y), bf_hi(zw.y), bf_lo(zw.z), bf_hi(zw.z), bf_lo(zw.w), bf_hi(zw.w)};
        float ss = 0.f;
#pragma unroll
        for (int e = 0; e < 8; ++e) ss += o[e] * o[e];
        ss += __shfl_xor(ss, 1); ss += __shfl_xor(ss, 2); ss += __shfl_xor(ss, 4); ss += __shfl_xor(ss, 8);
        const float rstd = 1.0f / sqrtf(ss * (1.f / 128.f) + EPS);
        float r[8];
#pragma unroll
        for (int e = 0; e < 8; ++e) r[e] = o[e] * rstd * gg[e] * fsilu(z[e]);
        u32x4 w; w.x = pk2(r[0], r[1]); w.y = pk2(r[2], r[3]); w.z = pk2(r[4], r[5]); w.w = pk2(r[6], r[7]);
        *(u32x4*)op = w;
    }
}

#define XB_TMO      128
#define XB_XCNT(j)  (256  + 64 * (j))
#define XB_XSUB(j)  (1280 + 64 * (j))
#define XB_XGEN(j)  (2304 + 64 * (j))
#define XB_TOP      3328
#define XB_TOPGEN   3392
#define XCD_BAR_WORDS 3456
#define XB_SPIN_CAP (1u << 18)
__device__ __forceinline__ unsigned xb_ld(unsigned* p)              { return __hip_atomic_load(p, __ATOMIC_RELAXED, __HIP_MEMORY_SCOPE_AGENT); }
__device__ __forceinline__ unsigned xb_add(unsigned* p, unsigned v) { return __hip_atomic_fetch_add(p, v, __ATOMIC_RELAXED, __HIP_MEMORY_SCOPE_AGENT); }
__device__ __forceinline__ unsigned xb_xcc_id() { return (unsigned)__builtin_amdgcn_s_getreg((3 << 11) | 20) & 0xFu; }
#define XB_SPIN(cond, bar) do { unsigned _sp = 0; while (cond) { __builtin_amdgcn_s_sleep(1); \
    if ((++_sp & 255u) == 0u) { if (xb_ld(&(bar)[XB_TMO])) break; if (_sp > XB_SPIN_CAP) { atomicAdd(&(bar)[XB_TMO], 1u); break; } } } } while (0)
struct XcdBarrier { unsigned* bar; unsigned x; volatile LAS unsigned* st; };
__device__ __forceinline__ XcdBarrier xcd_barrier_post(unsigned* bar, volatile LAS unsigned* st) {
    XcdBarrier b; b.bar = bar; b.x = xb_xcc_id(); b.st = st;
    if (threadIdx.x == 0) (void)xb_add(&bar[XB_XCNT(b.x)], 1u);
    return b;
}
__device__ __forceinline__ void xcd_barrier_complete(unsigned* bar, unsigned x, unsigned& nloc, unsigned& nx) {
    const unsigned G = gridDim.x * gridDim.y * gridDim.z;
    unsigned sum, cnt, mine, sp = 0u;
    for (;;) {
        sum = 0u; cnt = 0u; mine = 0u;
#pragma unroll
        for (unsigned j = 0; j < 16; ++j) { const unsigned c = xb_ld(&bar[XB_XCNT(j)]); sum += c; cnt += (c > 0u) ? 1u : 0u; mine = (j == x) ? c : mine; }
        if (sum == G) break;
        __builtin_amdgcn_s_sleep(1);
        if ((++sp & 255u) == 0u) { if (xb_ld(&bar[XB_TMO])) break; if (sp > XB_SPIN_CAP) { atomicAdd(&bar[XB_TMO], 1u); break; } }
    }
    nloc = mine > 0u ? mine : 1u; nx = cnt > 0u ? cnt : 1u;
}
__device__ __forceinline__ void xcd_barrier(const XcdBarrier& b) {
    asm volatile("s_waitcnt vmcnt(0)" ::: "memory");
    __syncthreads();
    if (threadIdx.x == 0) {
        unsigned* bar = b.bar;
        __builtin_amdgcn_s_waitcnt(0);
        unsigned nloc = b.st[0], nx = b.st[1];
        if (nloc == 0u) { xcd_barrier_complete(bar, b.x, nloc, nx); b.st[0] = nloc; b.st[1] = nx; }
        const unsigned old = xb_add(&bar[XB_XSUB(b.x)], 1u);
        const unsigned gen = old / nloc;
        if (old + 1u == (gen + 1u) * nloc) {
            __builtin_amdgcn_fence(__ATOMIC_RELEASE, "agent");
            asm volatile("s_waitcnt vmcnt(0)" ::: "memory");
            const unsigned og = xb_add(&bar[XB_TOP], 1u);
            const unsigned tg = og / nx;
            if (og + 1u == (tg + 1u) * nx) xb_add(&bar[XB_TOPGEN], 1u);
            else XB_SPIN(xb_ld(&bar[XB_TOPGEN]) == tg, bar);
            __builtin_amdgcn_fence(__ATOMIC_ACQUIRE, "agent");
            xb_add(&bar[XB_XGEN(b.x)], 1u);
            asm volatile("s_waitcnt vmcnt(0)" ::: "memory");
        } else {
            XB_SPIN(xb_ld(&bar[XB_XGEN(b.x)]) == gen, bar);
            __builtin_amdgcn_fence(__ATOMIC_ACQUIRE, "agent");
            asm volatile("s_waitcnt vmcnt(0)" ::: "memory");
        }
    }
    __syncthreads();
}

#ifndef PHMASK
#define PHMASK 0xFFFF
#endif
#define PH(n) ((PHMASK >> (n)) & 1)
#ifndef PROBE
#define PROBE 0
#endif
#define REP(g) for (int _rep = 0; _rep < ((PROBE == (g)) ? 2 : 1); ++_rep)
__global__ void __launch_bounds__(512, 2) fwd_megakernel(Params p) {
    extern __shared__ __attribute__((aligned(16))) unsigned char lds_raw[];
    LAS unsigned char* lds = (LAS unsigned char*)lds_raw;
    cg::grid_group grid = cg::this_grid();
    const int tid = threadIdx.x, lane = tid & 63, wave = __builtin_amdgcn_readfirstlane(tid >> 6);
    const int G = gridDim.x, gw = wave * G + blockIdx.x, ngw = G * 8;
    unsigned char* ws = p.ws;
    bf16_t* U = (bf16_t*)(ws + WS_U); bf16_t* P = (bf16_t*)(ws + WS_P);
    const float* mod = (const float*)(ws + WS_MOD);
    LAS float* scr = (LAS float*)(lds + wave * 16384);

    unsigned* barw = (unsigned*)(ws + WS_BAR);
    volatile LAS unsigned* bst = (volatile LAS unsigned*)(lds + 131072);
    if (tid < 2) bst[tid] = 0u;
    __syncthreads();
    if (p.ws == nullptr) grid.sync();
    const XcdBarrier xbar = xcd_barrier_post(barw, bst);
    REP(1) { if (PH(0)) for (int it = blockIdx.x; it < NMOD / 64; it += G) mod_item(p, lds, it, tid, wave, lane);
    if (PH(0)) ffn_weight_items(p.in[I_WFFN1IN], p.in[I_WFFN1OUT], (bf16_t*)(ws + W_FFIN), (bf16_t*)(ws + W_FFOUT), scr, gw, ngw, lane);
    if (PH(0)) mixer_weight_items(p, scr, gw, ngw, lane); __syncthreads(); }
    xcd_barrier(xbar);
    if (PROBE == 3) for (int i = 0; i < 16; ++i) xcd_barrier(xbar);
    REP(1) if (PH(1)) norm_mod_phase<false>(p, lds, p.in[I_X], p.in[I_GFFN1], 0, U, tid, wave, lane);
    xcd_barrier(xbar);
    REP(2) if (PH(2)) run_gemm(lds, U, D, (const bf16_t*)(ws + W_FFIN), 2 * FF, D, EpiSwiGLU{P, FF});
    xcd_barrier(xbar);
    REP(2) if (PH(3)) run_gemm(lds, P, FF, (const bf16_t*)(ws + W_FFOUT), D, FF, EpiResid{p.in[I_X], p.out, mod + 2 * D, 0.5f});
    xcd_barrier(xbar);
    REP(1) if (PH(4)) norm_mod_phase<true>(p, lds, p.out, p.in[I_GMIX], 3, U, tid, wave, lane);
    xcd_barrier(xbar);
    REP(2) if (PH(5)) run_gemm(lds, U, D, (const bf16_t*)(ws + W_IN), NIN, D, EpiBf16{P, NIN});
    xcd_barrier(xbar);
    if (PH(6)) prep_phase(p, wave, lane);
    xcd_barrier(xbar);
    if (PH(7)) for (int it = blockIdx.x; it < 1024; it += G) gdn_chunk_prep(p, lds, it, tid, wave, lane);
    xcd_barrier(xbar);
    if (PH(15)) for (int it = blockIdx.x; it < 32; it += G) gdn_scan_block(p, lds, it, tid, wave, lane);
    if (PH(8)) { unsigned* ctr = (unsigned*)(ws + WS_CTR);
        for (;;) { unsigned idx = 0; if (lane == 0) idx = atomicAdd(ctr, 1u); idx = __builtin_amdgcn_readfirstlane(idx);
            if (idx >= 4096u) break;
            attn_item_mfma(P, (const bf16_t*)(ws + WS_VT), (int)(idx & 63u), 63 - (int)(idx >> 6), lane); } }
    xcd_barrier(xbar);
    if (PH(9)) gdn_finalize_phase(p, wave, lane);
    xcd_barrier(xbar);
    if (PH(10)) run_gemm(lds, P + C_QSB, NIN, (const bf16_t*)(ws + W_UPSB), D, 1024, EpiGateFused{P + C_RSB, P + C_RDN, U}, 8, (C_VDN - C_QSB) * 2 - 8 * 128);
    xcd_barrier(xbar);
    if (PH(11)) run_gemm(lds, U, D, (const bf16_t*)(ws + W_OUT), D, D, EpiResid{p.out, p.out, mod + 5 * D, 1.0f});
    xcd_barrier(xbar);
    REP(1) if (PH(12)) norm_mod_phase<false>(p, lds, p.out, p.in[I_GFFN2], 6, U, tid, wave, lane);
    __syncthreads();
    if (PH(12)) ffn_weight_items(p.in[I_WFFN2IN], p.in[I_WFFN2OUT], (bf16_t*)(ws + W_FFIN), (bf16_t*)(ws + W_FFOUT), scr, gw, ngw, lane);
    xcd_barrier(xbar);
    REP(2) if (PH(13)) run_gemm(lds, U, D, (const bf16_t*)(ws + W_FFIN), 2 * FF, D, EpiSwiGLU{P, FF});
    xcd_barrier(xbar);
    if (PH(14)) run_gemm(lds, P, FF, (const bf16_t*)(ws + W_FFOUT), D, FF, EpiResid{p.out, p.out, mod + 8 * D, 0.5f});
}

extern "C" void kernel_launch(void* const* d_in, const int* in_sizes, int n_in, void* d_out, int out_size, void* d_ws, size_t ws_size, hipStream_t stream) {
    static int grid_blocks = 0;
    if (!grid_blocks) {
        int dev = 0, cus = 0, per_cu = 0;
        (void)hipGetDevice(&dev);
        (void)hipDeviceGetAttribute(&cus, hipDeviceAttributeMultiprocessorCount, dev);
        (void)hipFuncSetAttribute((const void*)fwd_megakernel, hipFuncAttributeMaxDynamicSharedMemorySize, LDS_BYTES);
        (void)hipOccupancyMaxActiveBlocksPerMultiprocessor(&per_cu, (const void*)fwd_megakernel, 512, LDS_BYTES);
        if (per_cu < 1) { fprintf(stderr, "occupancy query says %d blocks/CU\n", per_cu); per_cu = 1; }
        grid_blocks = cus;
    }
    Params p{};
    for (int i = 0; i < N_IN; ++i) p.in[i] = (const float*)d_in[i];
    p.out = (float*)d_out; p.ws = (unsigned char*)d_ws;
    (void)hipMemsetAsync((char*)d_ws + WS_CTR, 0, (WS_BAR - WS_CTR) + XCD_BAR_WORDS * 4, stream);
    void* args[] = {&p};
    hipError_t e = hipLaunchCooperativeKernel((const void*)fwd_megakernel, dim3(grid_blocks), dim3(512), args, LDS_BYTES, stream);
    if (e != hipSuccess) fprintf(stderr, "cooperative launch failed: %s (grid %d)\n", hipGetErrorString(e), grid_blocks);
}
```

```cpp
#include <hip/hip_runtime.h>
#include <hip/hip_cooperative_groups.h>
#include <cstdio>
namespace cg = cooperative_groups;

#define LAS __attribute__((address_space(3)))
typedef unsigned short bf16_t;
typedef short bf16x8 __attribute__((ext_vector_type(8)));
typedef float f32x4 __attribute__((ext_vector_type(4)));
typedef unsigned u32x4 __attribute__((ext_vector_type(4)));
typedef unsigned u32x2 __attribute__((ext_vector_type(2)));
typedef float f32x16 __attribute__((ext_vector_type(16)));
typedef float f32x2 __attribute__((ext_vector_type(2)));
typedef __bf16 nbf16x2 __attribute__((ext_vector_type(2)));

constexpr int T = 16384, D = 1024, SEQ = 2048, NB = 8, FF = 2816, NIN = 5632, INW = 5640, NMOD = 9216;
constexpr int C_QSB = 0, C_KSB = 512, C_VSB = 1024, C_QDN = 1536, C_KDN = 2048, C_VDN = 2560, C_ZDN = 3072, C_RSB = 3584, C_RDN = 4608;
constexpr float EPS = 1e-6f;
constexpr int LDS_BYTES = 131072 + 64;
constexpr size_t MiB = 1024 * 1024;
constexpr size_t WS_MOD = 0, WS_BG = 512 * 1024, WS_SS = 242 * MiB, WS_W = 2 * MiB;
constexpr size_t W_FFIN = WS_W, W_FFOUT = W_FFIN + (size_t)2 * FF * D * 2, W_IN = W_FFOUT + (size_t)D * FF * 2, W_UPSB = W_IN + (size_t)NIN * D * 2,
                 W_UPDN = W_UPSB + (size_t)D * 512 * 2, W_OUT = W_UPDN + (size_t)D * 512 * 2, W_END = W_OUT + (size_t)D * D * 2;
constexpr size_t WS_U = 34 * MiB, WS_P = 66 * MiB;
static_assert(W_END <= WS_U, "weights overflow");
constexpr size_t WS_EGL = 384 * 1024, WS_CTR = 400 * 1024, WS_BAR = 416 * 1024;
constexpr size_t WS_VT = W_FFIN;
static_assert((size_t)T * 512 * 2 <= W_IN - W_FFIN, "Vt overflow");

enum { I_X = 0, I_C, I_WADA, I_BADA, I_GFFN1, I_WFFN1IN, I_WFFN1OUT, I_GMIX, I_WIN, I_GQSB, I_GKSB, I_WCONV, I_ALOG, I_DTBIAS, I_GDNOUT, I_WUPSB, I_WUPDN, I_WOUT, I_GFFN2, I_WFFN2IN, I_WFFN2OUT, N_IN };
struct Params { const float* in[N_IN]; float* out; unsigned char* ws; };

__device__ __forceinline__ float bf_lo(unsigned w) { return __uint_as_float(w << 16); }
__device__ __forceinline__ float bf_hi(unsigned w) { return __uint_as_float(w & 0xffff0000u); }
__device__ __forceinline__ float bf2f(bf16_t b) { return __uint_as_float(((unsigned)b) << 16); }
__device__ __forceinline__ unsigned pk2(float lo, float hi) { unsigned r; asm("v_cvt_pk_bf16_f32 %0, %1, %2" : "=v"(r) : "v"(lo), "v"(hi)); return r; }
__device__ __forceinline__ unsigned cpk2(float lo, float hi) { const f32x2 v = {lo, hi}; return __builtin_bit_cast(unsigned, __builtin_convertvector(v, nbf16x2)); }
__device__ __forceinline__ bf16_t f2bf(float f) { return (bf16_t)(pk2(f, 0.f) & 0xffffu); }
__device__ __forceinline__ float fexp(float x) { return __builtin_amdgcn_exp2f(x * 1.4426950408889634f); }
__device__ __forceinline__ float flog(float x) { return __builtin_amdgcn_logf(x) * 0.6931471805599453f; }
__device__ __forceinline__ float fsigmoid(float x) { return __builtin_amdgcn_rcpf(1.f + fexp(-x)); }
__device__ __forceinline__ float fsilu(float x) { return x * fsigmoid(x); }
__device__ __forceinline__ float fsoftplus(float x) { return fmaxf(x, 0.f) + flog(1.f + fexp(-fabsf(x))); }
__device__ __forceinline__ float wave_sum(float v) {
#pragma unroll
    for (int o = 1; o < 64; o <<= 1) v += __shfl_xor(v, o);
    return v;
}
#define LDS_WAIT() asm volatile("s_waitcnt lgkmcnt(0)" ::: "memory")

namespace pg8 {
constexpr int BM = 256, BK = 64, HALF = 128, HTB = HALF * BK * 2, STAGE_BYTES = 8 * HTB, NXCD = 8, WGM = 8;
__host__ __device__ __forceinline__ int lds_byte(int r, int c) { const int st = (r >> 4) * 2 + (c >> 5), rr = r & 15, cc = c & 31, ob = rr * 64 + cc * 2; return st * 1024 + (ob ^ (((ob >> 9) & 1) << 5)); }
__host__ __device__ __forceinline__ void stage_rc(int b, int& R, int& C) { const int st = b / 1024, sb = b % 1024, swz = sb ^ (((sb >> 9) & 1) << 5); R = (st >> 1) * 16 + swz / 64; C = (st & 1) * 32 + (swz % 64) / 2; }
__host__ __device__ __forceinline__ int perm32(int rho) { const int n = rho >> 4, i = rho & 15; return 8 * (i >> 2) + 4 * n + (i & 3); }
struct Unit { int pm, pn; };
struct Gemm { const bf16_t* A; const bf16_t* Bt; int M, N, K, lda; int jt; int jbytes; };
struct StaticOrder {
    int nM, nN, nwg, G, c;
    __host__ __device__ void init(int M, int N, int G_, int c_) { nM = M / BM; nN = N / BM; nwg = nM * nN; G = G_; c = c_; }
    __host__ __device__ bool next(int i, Unit& u) const {
        const long L = (long)i * G + c; if (L >= nwg) return false;
        int wgid = (int)L; { const int q = nwg / NXCD, r = nwg % NXCD, xcd = wgid % NXCD, off = wgid / NXCD; wgid = (xcd < r ? xcd * (q + 1) : r * (q + 1) + (xcd - r) * q) + off; }
        const int nig = WGM * nN, gid = wgid / nig, fm = gid * WGM, gsz = (nM - fm) < WGM ? (nM - fm) : WGM;
        u.pm = fm + ((wgid % nig) % gsz); u.pn = (wgid % nig) / gsz; return true;
    }
};
template <class Epi>
__device__ __forceinline__ void gemm_phase(LAS unsigned char* lds, const Gemm g, const StaticOrder& S, const Epi& E) {
    int tid = threadIdx.x; asm volatile("" : "+v"(tid));
    const int wid = __builtin_amdgcn_readfirstlane(tid >> 6), lane = tid & 63, wr = wid >> 2, wc = wid & 3, fr = lane & 15, fq = lane >> 4;
    const int K = g.K, nt = K / BK, lda = g.lda;
    unsigned voffA[2], voffB[2];
#pragma unroll
    for (int i = 0; i < 2; ++i) { int R, C; stage_rc(tid * 16 + i * 8192, R, C); const int Rb = Epi::PERM ? ((R & ~31) + perm32(R & 31)) : R;
        voffA[i] = (unsigned)(R * lda + C) * 2u; voffB[i] = (unsigned)(Rb * K + C) * 2u; }
    const size_t kstep = (size_t)(BK * 2);
    const size_t hstepA = (size_t)HALF * lda * 2, hstepB = (size_t)HALF * K * 2;
    const size_t tstepA = 2 * hstepA, tstepB = 2 * hstepB;
    const unsigned ldsw = (unsigned)wid * 1024u;
    const int aoff = lds_byte(wr * 64 + fr, fq * 8), boff = lds_byte(wc * 32 + fr, fq * 8);
#define PG8_SA(b, h) (((b) * 2 + (h)) * HTB)
#define PG8_SB(b, h) ((4 + (b) * 2 + (h)) * HTB)
#define PG8_STAGE(bufoff, gbase, voff) do { _Pragma("unroll") for (int _i = 0; _i < 2; ++_i) \
        __builtin_amdgcn_global_load_lds((const unsigned*)((const char*)(gbase) + (voff)[_i]), (LAS unsigned*)(lds + (bufoff) + ldsw + _i * 8192), 16, 0, 0); } while (0)
#define PG8_LDA(dst, b, h) do { _Pragma("unroll") for (int m = 0; m < 4; ++m) _Pragma("unroll") for (int k = 0; k < 2; ++k) dst[m][k] = *(const LAS bf16x8*)(lds + PG8_SA(b, h) + aoff + m * 2048 + k * 1024); } while (0)
#define PG8_LDB(dst, b, h) do { _Pragma("unroll") for (int n = 0; n < 2; ++n) _Pragma("unroll") for (int k = 0; k < 2; ++k) dst[n][k] = *(const LAS bf16x8*)(lds + PG8_SB(b, h) + boff + n * 2048 + k * 1024); } while (0)
#define PG8_MMA(ai, bj, At, Bt) do { __builtin_amdgcn_s_setprio(1); _Pragma("unroll") for (int m = 0; m < 4; ++m) _Pragma("unroll") for (int n = 0; n < 2; ++n) _Pragma("unroll") for (int k = 0; k < 2; ++k) \
        acc[ai][bj][m][n] = __builtin_amdgcn_mfma_f32_16x16x32_bf16(Bt[n][k], At[m][k], acc[ai][bj][m][n], 0, 0, 0); __builtin_amdgcn_s_setprio(0); } while (0)
#define PG8_WAIT_V(n) asm volatile("s_waitcnt vmcnt(" #n ")" ::: "memory")
#define PG8_WAIT_L(n) asm volatile("s_waitcnt lgkmcnt(" #n ")" ::: "memory")
#define PG8_BAR __builtin_amdgcn_s_barrier()
#define PG8_SCHED __builtin_amdgcn_sched_barrier(0)
    Unit cur, nxt; int ui = 0;
    if (!S.next(0, cur)) return;
    f32x4 acc[2][2][4][2];
#pragma unroll
    for (int a = 0; a < 2; ++a)
#pragma unroll
        for (int b = 0; b < 2; ++b)
#pragma unroll
            for (int m = 0; m < 4; ++m)
#pragma unroll
                for (int n = 0; n < 2; ++n) acc[a][b][m][n] = (f32x4){0.f, 0.f, 0.f, 0.f};
    bf16x8 At[4][2], B0[2][2], B1[2][2];
    const char* cA = (const char*)g.A + (size_t)cur.pm * tstepA; const char* cB = (const char*)g.Bt + (size_t)cur.pn * tstepB;
    PG8_STAGE(PG8_SB(0, 0), cB, voffB); PG8_STAGE(PG8_SA(0, 0), cA, voffA); PG8_STAGE(PG8_SB(0, 1), cB + hstepB, voffB); PG8_STAGE(PG8_SA(0, 1), cA + hstepA, voffA);
    if (wr == 1) PG8_BAR;
    PG8_WAIT_V(4); PG8_BAR;
    PG8_STAGE(PG8_SB(1, 0), cB + kstep, voffB); PG8_STAGE(PG8_SA(1, 0), cA + kstep, voffA); PG8_STAGE(PG8_SB(1, 1), cB + hstepB + kstep, voffB);
    PG8_WAIT_V(6); PG8_BAR;
    for (;;) {
        const bool has_next = S.next(ui + 1, nxt);
        const char* nA = has_next ? (const char*)g.A + (size_t)nxt.pm * tstepA : cA; const char* nB = has_next ? (const char*)g.Bt + (size_t)nxt.pn * tstepB : cB;
        for (int t = 0; t < nt; t += 2) {
            const bool last = (t == nt - 2);
            const char* a1 = cA + (size_t)(t + 1) * kstep + (t + 1 >= g.jt ? g.jbytes : 0);
            const char* a2 = last ? nA : cA + (size_t)(t + 2) * kstep + (t + 2 >= g.jt ? g.jbytes : 0); const char* b2 = last ? nB : cB + (size_t)(t + 2) * kstep;
            const char* a3 = a2 + kstep; const char* b3 = b2 + kstep;
            if constexpr (Epi::HAS_MID) { if (t == g.jt) E.mid(acc, cur, wr, wc, fr, fq); }
            PG8_LDB(B0, 0, 0); PG8_SCHED; PG8_LDA(At, 0, 0); PG8_STAGE(PG8_SA(1, 1), a1 + hstepA, voffA);
            PG8_WAIT_L(8); PG8_BAR; PG8_WAIT_L(0); PG8_MMA(0, 0, At, B0); PG8_BAR; PG8_SCHED;
            PG8_LDB(B1, 0, 1); PG8_STAGE(PG8_SB(0, 0), b2, voffB);
            PG8_BAR; PG8_WAIT_L(0); PG8_MMA(0, 1, At, B1); PG8_BAR;
            PG8_LDA(At, 0, 1); PG8_STAGE(PG8_SA(0, 0), a2, voffA);
            PG8_BAR; PG8_WAIT_L(0); PG8_MMA(1, 0, At, B0); PG8_BAR; PG8_SCHED;
            PG8_STAGE(PG8_SB(0, 1), b2 + hstepB, voffB);
            PG8_WAIT_V(6); PG8_BAR; PG8_MMA(1, 1, At, B1); PG8_BAR;
            PG8_LDB(B0, 1, 0); PG8_SCHED; PG8_LDA(At, 1, 0); PG8_STAGE(PG8_SA(0, 1), a2 + hstepA, voffA);
            PG8_WAIT_L(8); PG8_BAR; PG8_WAIT_L(0); PG8_MMA(0, 0, At, B0); PG8_BAR; PG8_SCHED;
            PG8_LDB(B1, 1, 1); PG8_STAGE(PG8_SB(1, 0), b3, voffB);
            PG8_BAR; PG8_WAIT_L(0); PG8_MMA(0, 1, At, B1); PG8_BAR;
            PG8_LDA(At, 1, 1); PG8_STAGE(PG8_SA(1, 0), a3, voffA);
            PG8_BAR; PG8_WAIT_L(0); PG8_MMA(1, 0, At, B0); PG8_BAR; PG8_SCHED;
            PG8_STAGE(PG8_SB(1, 1), b3 + hstepB, voffB);
            PG8_WAIT_V(6); PG8_BAR; PG8_MMA(1, 1, At, B1); PG8_BAR;
        }
        E(acc, cur, wr, wc, fr, fq);
        if (!has_next) break;
#pragma unroll
        for (int a = 0; a < 2; ++a)
#pragma unroll
            for (int b = 0; b < 2; ++b)
#pragma unroll
                for (int m = 0; m < 4; ++m)
#pragma unroll
                    for (int n = 0; n < 2; ++n) acc[a][b][m][n] = (f32x4){0.f, 0.f, 0.f, 0.f};
        cur = nxt; cA = nA; cB = nB; ++ui;
    }
    PG8_WAIT_V(0);
    if (wr == 0) PG8_BAR;
    PG8_BAR;
#undef PG8_SA
#undef PG8_SB
#undef PG8_STAGE
#undef PG8_LDA
#undef PG8_LDB
#undef PG8_MMA
#undef PG8_WAIT_V
#undef PG8_WAIT_L
#undef PG8_BAR
#undef PG8_SCHED
}
}

typedef const f32x4 (&AccRef)[2][2][4][2];
struct EpiBf16 {
    static constexpr bool PERM = true, HAS_MID = false;
    bf16_t* O; int ldc;
    __device__ __forceinline__ void operator()(AccRef acc, const pg8::Unit& u, int wr, int wc, int fr, int fq) const {
        const int row0 = u.pm * 256 + wr * 64 + fr, col0 = u.pn * 256 + wc * 32 + 8 * fq;
#pragma unroll
        for (int ai = 0; ai < 2; ++ai)
#pragma unroll
            for (int m = 0; m < 4; ++m) { bf16_t* rowp = O + (size_t)(row0 + ai * 128 + m * 16) * ldc + col0;
#pragma unroll
                for (int bj = 0; bj < 2; ++bj) { const f32x4 v0 = acc[ai][bj][m][0], v1 = acc[ai][bj][m][1];
                    u32x4 w; w.x = pk2(v0[0], v0[1]); w.y = pk2(v0[2], v0[3]); w.z = pk2(v1[0], v1[1]); w.w = pk2(v1[2], v1[3]);
                    *(u32x4*)(rowp + bj * 128) = w; } }
    }
};
struct EpiSwiGLU {
    static constexpr bool PERM = true, HAS_MID = false;
    bf16_t* O; int ldc;
    __device__ __forceinline__ void operator()(AccRef acc, const pg8::Unit& u, int wr, int wc, int fr, int fq) const {
        const int row0 = u.pm * 256 + wr * 64 + fr, col0 = u.pn * 128 + wc * 32 + 8 * fq;
#pragma unroll
        for (int ai = 0; ai < 2; ++ai)
#pragma unroll
            for (int m = 0; m < 4; ++m) { bf16_t* rowp = O + (size_t)(row0 + ai * 128 + m * 16) * ldc + col0;
                float r[8];
#pragma unroll
                for (int n = 0; n < 2; ++n)
#pragma unroll
                    for (int j = 0; j < 4; ++j) { const float a = acc[ai][0][m][n][j], b = acc[ai][1][m][n][j]; r[n * 4 + j] = fsilu(a) * b; }
                u32x4 w; w.x = pk2(r[0], r[1]); w.y = pk2(r[2], r[3]); w.z = pk2(r[4], r[5]); w.w = pk2(r[6], r[7]);
                *(u32x4*)rowp = w; }
    }
};
struct EpiResid {
    static constexpr bool PERM = false, HAS_MID = false;
    const float* base; float* out; const float* gate; float scale;
    __device__ __forceinline__ void operator()(AccRef acc, const pg8::Unit& u, int wr, int wc, int fr, int fq) const {
        const int row0 = u.pm * 256 + wr * 64 + fr, col0 = u.pn * 256 + wc * 32 + 4 * fq;
        const float* gp = gate + (size_t)(u.pm >> 3) * NMOD + col0;
        f32x4 gv[2][2];
#pragma unroll
        for (int bj = 0; bj < 2; ++bj)
#pragma unroll
            for (int n = 0; n < 2; ++n) gv[bj][n] = *(const f32x4*)(gp + bj * 128 + n * 16) * scale;
#pragma unroll
        for (int ai = 0; ai < 2; ++ai)
#pragma unroll
            for (int m = 0; m < 4; ++m) { const size_t off = (size_t)(row0 + ai * 128 + m * 16) * D + col0;
#pragma unroll
                for (int bj = 0; bj < 2; ++bj)
#pragma unroll
                    for (int n = 0; n < 2; ++n) { const f32x4 bs = *(const f32x4*)(base + off + bj * 128 + n * 16);
                        *(f32x4*)(out + off + bj * 128 + n * 16) = bs + gv[bj][n] * acc[ai][bj][m][n]; } }
    }
};
struct EpiGateFused {
    static constexpr bool PERM = true, HAS_MID = true;
    const bf16_t* Rsb; const bf16_t* Rdn; bf16_t* O;
    __device__ __forceinline__ void mid(f32x4 (&acc)[2][2][4][2], const pg8::Unit& u, int wr, int wc, int fr, int fq) const {
        int row0 = u.pm * 256 + wr * 64 + fr, col0 = u.pn * 256 + wc * 32 + 8 * fq;
        asm volatile("" : "+v"(row0), "+v"(col0));
#pragma unroll
        for (int ai = 0; ai < 2; ++ai)
#pragma unroll
            for (int m = 0; m < 4; ++m) { const size_t row = (size_t)(row0 + ai * 128 + m * 16);
#pragma unroll
                for (int bj = 0; bj < 2; ++bj) { const u32x4 a = *(const u32x4*)(Rsb + row * NIN + col0 + bj * 128), d = *(const u32x4*)(Rdn + row * NIN + col0 + bj * 128);
                    const float ra[8] = {bf_lo(a.x), bf_hi(a.x), bf_lo(a.y), bf_hi(a.y), bf_lo(a.z), bf_hi(a.z), bf_lo(a.w), bf_hi(a.w)};
                    const float rd[8] = {bf_lo(d.x), bf_hi(d.x), bf_lo(d.y), bf_hi(d.y), bf_lo(d.z), bf_hi(d.z), bf_lo(d.w), bf_hi(d.w)};
#pragma unroll
                    for (int e = 0; e < 8; ++e) { const float q = (1.0f + fexp(-rd[e])) * __builtin_amdgcn_rcpf(1.0f + fexp(-ra[e])); acc[ai][bj][m][e >> 2][e & 3] *= q; }
                    asm volatile("" ::: "memory"); } }
    }
    __device__ __forceinline__ void operator()(AccRef acc, const pg8::Unit& u, int wr, int wc, int fr, int fq) const {
        const int row0 = u.pm * 256 + wr * 64 + fr, col0 = u.pn * 256 + wc * 32 + 8 * fq;
#pragma unroll
        for (int ai = 0; ai < 2; ++ai)
#pragma unroll
            for (int m = 0; m < 4; ++m) { const size_t row = (size_t)(row0 + ai * 128 + m * 16);
#pragma unroll
                for (int bj = 0; bj < 2; ++bj) { const u32x4 d = *(const u32x4*)(Rdn + row * NIN + col0 + bj * 128);
                    const f32x4 v0 = acc[ai][bj][m][0], v1 = acc[ai][bj][m][1];
                    const float r[8] = {fsigmoid(bf_lo(d.x)) * v0[0], fsigmoid(bf_hi(d.x)) * v0[1], fsigmoid(bf_lo(d.y)) * v0[2], fsigmoid(bf_hi(d.y)) * v0[3],
                                        fsigmoid(bf_lo(d.z)) * v1[0], fsigmoid(bf_hi(d.z)) * v1[1], fsigmoid(bf_lo(d.w)) * v1[2], fsigmoid(bf_hi(d.w)) * v1[3]};
                    u32x4 w; w.x = pk2(r[0], r[1]); w.y = pk2(r[2], r[3]); w.z = pk2(r[4], r[5]); w.w = pk2(r[6], r[7]);
                    *(u32x4*)(O + row * D + col0 + bj * 128) = w; } }
    }
};
template <class Epi> __device__ __forceinline__ void run_gemm(LAS unsigned char* lds, const bf16_t* A, int lda, const bf16_t* Bt, int N, int K, const Epi& E, int jt = 1 << 30, int jbytes = 0) {
    pg8::Gemm g{A, Bt, T, N, K, lda, jt, jbytes}; pg8::StaticOrder S; S.init(T, N, (int)gridDim.x, (int)blockIdx.x);
    pg8::gemm_phase<Epi>(lds, g, S, E);
}

__device__ __forceinline__ void transpose_item(const float* W, int ldw, int s0, int k0, bf16_t* WT, int ldk, int d0, LAS float* scr, int lane) {
    float tv[32];
#pragma unroll
    for (int i = 0; i < 32; ++i) tv[i] = W[(size_t)(k0 + 2 * i + (lane >> 5)) * ldw + s0 + (lane & 31)];
#pragma unroll
    for (int i = 0; i < 32; ++i) scr[(2 * i + (lane >> 5)) * 33 + (lane & 31)] = tv[i];
    LDS_WAIT();
    const int c = lane & 7;
#pragma unroll
    for (int j = 0; j < 4; ++j) { const int n = (lane >> 3) + 8 * j; const LAS float* s = scr + (8 * c) * 33 + n;
        u32x4 o; o.x = pk2(s[0 * 33], s[1 * 33]); o.y = pk2(s[2 * 33], s[3 * 33]); o.z = pk2(s[4 * 33], s[5 * 33]); o.w = pk2(s[6 * 33], s[7 * 33]);
        *(u32x4*)(WT + (size_t)(d0 + n) * ldk + k0 + 8 * c) = o; }
    LDS_WAIT();
}
__device__ __forceinline__ void ffn_weight_items(const float* w_in, const float* w_out, bf16_t* wt_in, bf16_t* wt_out, LAS float* scr, int gw, int ngw, int lane) {
    for (int it = gw; it < 2816 + 1408; it += ngw) {
        if (it < 2816) { const int kb = it / 176, nb = it % 176, d0 = nb * 32, pn = d0 >> 8, bj = (d0 >> 7) & 1, c = d0 & 127, s0 = bj * FF + pn * 128 + c;
            transpose_item(w_in, 2 * FF, s0, kb * 64, wt_in, D, d0, scr, lane); }
        else { const int r = it - 2816, kb = r / 32, nb = r % 32; transpose_item(w_out, D, nb * 32, kb * 64, wt_out, FF, nb * 32, scr, lane); }
    }
}
__device__ __forceinline__ void mixer_weight_items(const Params& p, LAS float* scr, int gw, int ngw, int lane) {
    unsigned char* ws = p.ws;
    for (int it = gw; it < 2816 + 256 + 256 + 512; it += ngw) {
        int r = it;
        if (r < 2816) { const int kb = r / 176, nb = r % 176, d0 = nb * 32, s0 = d0 < C_RSB ? d0 : d0 + 8; transpose_item(p.in[I_WIN], INW, s0, kb * 64, (bf16_t*)(ws + W_IN), D, d0, scr, lane); continue; } r -= 2816;
        if (r < 256) { const int kb = r / 32, nb = r % 32; transpose_item(p.in[I_WUPSB], D, nb * 32, kb * 64, (bf16_t*)(ws + W_UPSB), D, nb * 32, scr, lane); continue; } r -= 256;
        if (r < 256) { const int kb = r / 32, nb = r % 32; transpose_item(p.in[I_WUPDN], D, nb * 32, kb * 64, (bf16_t*)(ws + W_UPSB) + 512, D, nb * 32, scr, lane); continue; } r -= 256;
        { const int kb = r / 32, nb = r % 32; transpose_item(p.in[I_WOUT], D, nb * 32, kb * 64, (bf16_t*)(ws + W_OUT), D, nb * 32, scr, lane); }
    }
}
__device__ __forceinline__ void mod_item(const Params& p, LAS unsigned char* lds, int cb, int tid, int wave, int lane) {
    LAS float* sc = (LAS float*)lds; LAS float* red = (LAS float*)(lds + 32768);
    for (int i = tid; i < NB * D; i += 512) sc[i] = fsilu(p.in[I_C][i]);
    __syncthreads();
    const float* wa = p.in[I_WADA] + cb * 64 + lane;
    float acc[NB];
#pragma unroll
    for (int b = 0; b < NB; ++b) acc[b] = 0.f;
    for (int k = wave * 128; k < wave * 128 + 128; k += 16) {
        float w[16];
#pragma unroll
        for (int e = 0; e < 16; ++e) w[e] = wa[(size_t)(k + e) * NMOD];
#pragma unroll
        for (int b = 0; b < NB; ++b)
#pragma unroll
            for (int e4 = 0; e4 < 4; ++e4) { const f32x4 s = *(const LAS f32x4*)(sc + b * D + k + 4 * e4); acc[b] += s[0] * w[4 * e4] + s[1] * w[4 * e4 + 1] + s[2] * w[4 * e4 + 2] + s[3] * w[4 * e4 + 3]; }
    }
#pragma unroll
    for (int b = 0; b < NB; ++b) red[(wave * NB + b) * 64 + lane] = acc[b];
    __syncthreads();
    { const int b = tid >> 6; float s = p.in[I_BADA][cb * 64 + lane];
#pragma unroll
        for (int w = 0; w < 8; ++w) s += red[(w * NB + b) * 64 + lane];
        ((float*)(p.ws + WS_MOD))[b * NMOD + cb * 64 + lane] = s; }
    __syncthreads();
}

template <bool DN>
__device__ __forceinline__ void norm_mod_phase(const Params& p, LAS unsigned char* lds, const float* src, const float* gain, int midx, bf16_t* dst, int tid, int wave, int lane) {
    const float* mod = (const float*)(p.ws + WS_MOD);
    LAS float* wl = (LAS float*)lds;
    if (DN) { for (int i = tid; i < D * 8; i += 512) { const int k = i >> 3, j = i & 7; wl[8 * k + 4 * (k >> 2) + j] = p.in[I_WIN][(size_t)k * INW + C_RSB + j]; } __syncthreads(); }
    f32x4 g4[4];
#pragma unroll
    for (int j = 0; j < 4; ++j) g4[j] = ((const f32x4*)gain)[lane + 64 * j];
    for (int row = blockIdx.x * 8 + wave; row < T; row += gridDim.x * 8) {
        const int b = row >> 11;
        const f32x4* xr = (const f32x4*)(src + (size_t)row * D) + lane;
        const f32x4* shp = (const f32x4*)(mod + (size_t)b * NMOD + midx * D) + lane; const f32x4* scp = shp + D / 4;
        f32x4 v[4]; float ss = 0.f;
#pragma unroll
        for (int j = 0; j < 4; ++j) { v[j] = xr[64 * j]; ss += (v[j][0] * v[j][0] + v[j][1] * v[j][1]) + (v[j][2] * v[j][2] + v[j][3] * v[j][3]); }
        const float rstd = 1.0f / sqrtf(wave_sum(ss) * (1.f / D) + EPS);
        u32x2* o8 = (u32x2*)(dst + (size_t)row * D) + lane;
        float dot[8];
        if (DN) {
#pragma unroll
            for (int e = 0; e < 8; ++e) dot[e] = 0.f; }
#pragma unroll
        for (int j = 0; j < 4; ++j) { const f32x4 sh = shp[64 * j], sc = scp[64 * j];
            const f32x4 uu = v[j] * rstd * g4[j] * (sc + 1.0f) + sh;
            u32x2 w; w.x = pk2(uu[0], uu[1]); w.y = pk2(uu[2], uu[3]); o8[64 * j] = w;
            if (DN) {
#pragma unroll
                for (int e = 0; e < 4; ++e) { const int k = 4 * lane + 256 * j + e; const LAS f32x4* wp = (const LAS f32x4*)(wl + 8 * k + 4 * (k >> 2)); const f32x4 w0 = wp[0], w1 = wp[1];
                    dot[0] += uu[e] * w0[0]; dot[1] += uu[e] * w0[1]; dot[2] += uu[e] * w0[2]; dot[3] += uu[e] * w0[3];
                    dot[4] += uu[e] * w1[0]; dot[5] += uu[e] * w1[1]; dot[6] += uu[e] * w1[2]; dot[7] += uu[e] * w1[3]; } } }
        if (DN) {
#pragma unroll
            for (int e = 0; e < 8; ++e) dot[e] = wave_sum(dot[e]);
            float mine = dot[0];
#pragma unroll
            for (int e = 1; e < 8; ++e) mine = (lane == e) ? dot[e] : mine;
            if (lane < 8) { float r;
                if (lane < 4) r = 1.0f / (1.0f + expf(-mine));
                else { const int hh = lane - 4; const float a = mine + p.in[I_DTBIAS][hh]; const float sp = a > 20.f ? a : log1pf(expf(a)); r = -expf(p.in[I_ALOG][hh]) * sp; }
                ((float*)(p.ws + WS_BG))[(size_t)row * 8 + lane] = r; } }
    }
    if (DN) __syncthreads();
}

__device__ __forceinline__ void unpack16(const bf16_t* p, float* f) {
    const u32x4 a = ((const u32x4*)p)[0], b = ((const u32x4*)p)[1];
    f[0] = bf_lo(a.x); f[1] = bf_hi(a.x); f[2] = bf_lo(a.y); f[3] = bf_hi(a.y); f[4] = bf_lo(a.z); f[5] = bf_hi(a.z); f[6] = bf_lo(a.w); f[7] = bf_hi(a.w);
    f[8] = bf_lo(b.x); f[9] = bf_hi(b.x); f[10] = bf_lo(b.y); f[11] = bf_hi(b.y); f[12] = bf_lo(b.z); f[13] = bf_hi(b.z); f[14] = bf_lo(b.w); f[15] = bf_hi(b.w);
}
__device__ __forceinline__ void pack16(bf16_t* p, const float* f) {
    u32x4 a, b; a.x = pk2(f[0], f[1]); a.y = pk2(f[2], f[3]); a.z = pk2(f[4], f[5]); a.w = pk2(f[6], f[7]); b.x = pk2(f[8], f[9]); b.y = pk2(f[10], f[11]); b.z = pk2(f[12], f[13]); b.w = pk2(f[14], f[15]);
    ((u32x4*)p)[0] = a; ((u32x4*)p)[1] = b;
}
__device__ __forceinline__ void prep_phase(const Params& p, int wave, int lane) {
    bf16_t* P = (bf16_t*)(p.ws + WS_P); bf16_t* U = (bf16_t*)(p.ws + WS_U);
    const int ch = 16 * lane;
    float gsb[16], wcv[4][16];
    { const float* gp = (ch < 512 ? p.in[I_GQSB] : p.in[I_GKSB]) + (ch & 63); const float sc = ch < 512 ? 0.18033688011112042f : 1.0f;
#pragma unroll
        for (int e = 0; e < 16; ++e) gsb[e] = gp[e] * sc;
#pragma unroll
        for (int i = 0; i < 4; ++i)
#pragma unroll
            for (int e = 0; e < 16; ++e) wcv[i][e] = p.in[I_WCONV][i * 1536 + ch + e]; }
    for (int row = blockIdx.x * 8 + wave; row < T; row += gridDim.x * 8) {
        const int tl = row & (SEQ - 1);
        { bf16_t* qp = P + (size_t)row * NIN + ch; float f[16]; unpack16(qp, f); float ss = 0.f;
#pragma unroll
            for (int e = 0; e < 16; ++e) ss += f[e] * f[e];
            ss += __shfl_xor(ss, 1); ss += __shfl_xor(ss, 2);
            const float rstd = 1.0f / sqrtf(ss * (1.f / 64.f) + EPS);
#pragma unroll
            for (int e = 0; e < 16; ++e) f[e] = f[e] * rstd * gsb[e];
            pack16(qp, f); }
        { float y[16];
#pragma unroll
            for (int e = 0; e < 16; ++e) y[e] = 0.f;
#pragma unroll
            for (int i = 0; i < 4; ++i) { if (tl - 3 + i >= 0) { float f[16]; unpack16(P + (size_t)(row - 3 + i) * NIN + C_QDN + ch, f);
#pragma unroll
                    for (int e = 0; e < 16; ++e) y[e] += wcv[i][e] * f[e]; } }
            float ss = 0.f;
#pragma unroll
            for (int e = 0; e < 16; ++e) { y[e] = fsilu(y[e]); ss += y[e] * y[e]; }
            ss += __shfl_xor(ss, 1); ss += __shfl_xor(ss, 2); ss += __shfl_xor(ss, 4);
            const float sc = (1.0f / sqrtf(ss + EPS)) * (ch < 512 ? 0.08838834764831845f : 1.0f);
#pragma unroll
            for (int e = 0; e < 16; ++e) y[e] *= sc;
            pack16(U + (size_t)row * D + ch, y); }
    }
    bf16_t* Vt = (bf16_t*)(p.ws + WS_VT);
    for (int it = blockIdx.x * 8 + wave; it < T / 16; it += gridDim.x * 8) {
        const int row0 = it * 16, b = row0 >> 11, tl0 = row0 & (SEQ - 1), c8 = lane * 8, hd = c8 >> 6, d0 = c8 & 63;
        u32x4 w[16];
#pragma unroll
        for (int r = 0; r < 16; ++r) w[r] = *(const u32x4*)(P + (size_t)(row0 + r) * NIN + C_VSB + c8);
#pragma unroll
        for (int e = 0; e < 8; ++e) {
            unsigned o[8];
#pragma unroll
            for (int i = 0; i < 8; ++i) {
                const int p0 = 2 * i, p1 = 2 * i + 1;
                const int k0 = 8 * ((p0 >> 2) & 1) + 4 * (p0 >> 3) + (p0 & 3), k1 = 8 * ((p1 >> 2) & 1) + 4 * (p1 >> 3) + (p1 & 3);
                const unsigned a0 = w[k0][e >> 1], a1 = w[k1][e >> 1];
                const unsigned lo = (e & 1) ? (a0 >> 16) : (a0 & 0xffffu), hi = (e & 1) ? (a1 & 0xffff0000u) : (a1 << 16);
                o[i] = lo | hi; }
            bf16_t* dst = Vt + ((size_t)(b * 8 + hd) * 64 + d0 + e) * SEQ + tl0;
            ((u32x4*)dst)[0] = (u32x4){o[0], o[1], o[2], o[3]}; ((u32x4*)dst)[1] = (u32x4){o[4], o[5], o[6], o[7]}; }
    }
}

__device__ __forceinline__ float xlane32(float x, int hh) {
    const unsigned xi = __builtin_bit_cast(unsigned, x);
    const u32x2 r = __builtin_amdgcn_permlane32_swap(xi, xi, false, false);
    return __builtin_bit_cast(float, hh ? r.x : r.y);
}
template <bool DIAG>
__device__ __forceinline__ void attn_tile(const f32x16& z, const bf16x8 (&vc)[4], f32x16& o0, f32x16& o1, float& R, int ql, int hh) {
    float sg[16], m[16];
#pragma unroll
    for (int i = 0; i < 16; ++i) { const float e = __builtin_amdgcn_exp2f(-z[i]); float sig = __builtin_amdgcn_rcpf(1.0f + e); float mm = e * sig;
        if (DIAG) { const bool act = ((i & 3) + 8 * (i >> 2) + 4 * hh) < ql; sig = act ? sig : 0.f; mm = act ? mm : 1.0f; }
        sg[i] = sig; m[i] = mm; }
    float g[4], gp[4];
#pragma unroll
    for (int bq = 0; bq < 4; ++bq) { g[bq] = (m[4 * bq] * m[4 * bq + 1]) * (m[4 * bq + 2] * m[4 * bq + 3]); gp[bq] = xlane32(g[bq], hh); }
    float outer[4]; float tb = R;
#pragma unroll
    for (int bq = 3; bq >= 0; --bq) { outer[bq] = hh == 0 ? tb * gp[bq] : tb; tb *= g[bq] * gp[bq]; }
    R = tb;
    float w[16];
#pragma unroll
    for (int bq = 0; bq < 4; ++bq) { const float s3 = outer[bq], s2 = s3 * m[4 * bq + 3], s1 = s2 * m[4 * bq + 2], s0 = s1 * m[4 * bq + 1];
        w[4 * bq + 3] = sg[4 * bq + 3] * s3; w[4 * bq + 2] = sg[4 * bq + 2] * s2; w[4 * bq + 1] = sg[4 * bq + 1] * s1; w[4 * bq] = sg[4 * bq] * s0; }
    bf16x8 wf[2];
#pragma unroll
    for (int s2 = 0; s2 < 2; ++s2) { const u32x4 pw = {cpk2(w[8 * s2], w[8 * s2 + 1]), cpk2(w[8 * s2 + 2], w[8 * s2 + 3]), cpk2(w[8 * s2 + 4], w[8 * s2 + 5]), cpk2(w[8 * s2 + 6], w[8 * s2 + 7])}; wf[s2] = __builtin_bit_cast(bf16x8, pw); }
    o0 = __builtin_amdgcn_mfma_f32_32x32x16_bf16(vc[0], wf[0], o0, 0, 0, 0); o0 = __builtin_amdgcn_mfma_f32_32x32x16_bf16(vc[1], wf[1], o0, 0, 0, 0);
    o1 = __builtin_amdgcn_mfma_f32_32x32x16_bf16(vc[2], wf[0], o1, 0, 0, 0); o1 = __builtin_amdgcn_mfma_f32_32x32x16_bf16(vc[3], wf[1], o1, 0, 0, 0);
}
__device__ __forceinline__ void attn_item_mfma(bf16_t* P, const bf16_t* Vt, int bh, int qt, int lane) {
    asm volatile("" : "+v"(lane));
    const int b = bh >> 3, h = bh & 7, ql = lane & 31, hh = lane >> 5, q0 = qt * 32;
    bf16_t* qrow = P + (size_t)(b * SEQ + q0 + ql) * NIN + C_QSB + h * 64;
    bf16x8 qf[4];
#pragma unroll
    for (int s = 0; s < 4; ++s) qf[s] = *(const bf16x8*)(qrow + 16 * s + 8 * hh);
    f32x16 o0, o1;
#pragma unroll
    for (int i = 0; i < 16; ++i) { o0[i] = 0.f; o1[i] = 0.f; }
    float R = 1.0f;
    const bf16_t* kb = P + (size_t)(b * SEQ + ql) * NIN + C_KSB + h * 64 + 8 * hh;
    const bf16_t* vb = Vt + ((size_t)bh * 64 + ql) * SEQ + 8 * hh;
    bf16x8 kf[4], vf[4], vn[4];
#define AT_LOADK(k0_) do { _Pragma("unroll") for (int s = 0; s < 4; ++s) kf[s] = *(const bf16x8*)(kb + (size_t)(k0_) * NIN + 16 * s); } while (0)
#define AT_LOADV(dst, k0_) do { _Pragma("unroll") for (int j = 0; j < 4; ++j) dst[j] = *(const bf16x8*)(vb + (size_t)(j >> 1) * 32 * SEQ + (k0_) + 16 * (j & 1)); } while (0)
#define AT_QK(zz) do { _Pragma("unroll") for (int i = 0; i < 16; ++i) zz[i] = 0.f; _Pragma("unroll") for (int s = 0; s < 4; ++s) zz = __builtin_amdgcn_mfma_f32_32x32x16_bf16(kf[s], qf[s], zz, 0, 0, 0); } while (0)
    f32x16 zc, zn;
    AT_LOADK(q0); AT_LOADV(vf, q0);
    AT_QK(zc);
    { const int k1 = (qt > 0 ? qt - 1 : 0) * 32; AT_LOADK(k1); AT_LOADV(vn, k1); }
    { AT_QK(zn);
      const int k2 = (qt > 1 ? qt - 2 : 0) * 32; AT_LOADK(k2);
      attn_tile<true>(zc, vf, o0, o1, R, ql, hh);
      zc = zn;
#pragma unroll
      for (int j = 0; j < 4; ++j) vf[j] = vn[j];
      const int k1 = (qt > 1 ? qt - 2 : 0) * 32; AT_LOADV(vn, k1); }
#pragma unroll 1
    for (int kt = qt - 1; kt >= 0; --kt) {
        AT_QK(zn);
        const int k2 = (kt > 1 ? kt - 2 : 0) * 32; AT_LOADK(k2);
        attn_tile<false>(zc, vf, o0, o1, R, ql, hh);
        zc = zn;
#pragma unroll
        for (int j = 0; j < 4; ++j) vf[j] = vn[j];
        AT_LOADV(vn, k2);
    }
#undef AT_LOADK
#undef AT_LOADV
#undef AT_QK
#pragma unroll
    for (int bq = 0; bq < 4; ++bq) {
        u32x2 w0 = {cpk2(o0[4 * bq], o0[4 * bq + 1]), cpk2(o0[4 * bq + 2], o0[4 * bq + 3])}, w1 = {cpk2(o1[4 * bq], o1[4 * bq + 1]), cpk2(o1[4 * bq + 2], o1[4 * bq + 3])};
        *(u32x2*)(qrow + 8 * bq + 4 * hh) = w0; *(u32x2*)(qrow + 32 + 8 * bq + 4 * hh) = w1; }
}
__device__ __forceinline__ size_t slotU(size_t t0, int h, int colbase, int f) { return (t0 + (size_t)(f >> 7)) * D + colbase + h * 128 + (f & 127); }
__device__ __forceinline__ size_t slotP(size_t t0, int h, int colbase, int f) { return (t0 + (size_t)(f >> 7)) * NIN + colbase + h * 128 + (f & 127); }
__device__ __forceinline__ int permpos(int x) { const int k = x & 15; return (x & ~15) + 8 * ((k >> 2) & 1) + 4 * (k >> 3) + (k & 3); }
__device__ __forceinline__ int crow(int r, int hh) { return (r & 3) + 8 * (r >> 2) + 4 * hh; }
__device__ __forceinline__ bf16x8 pack8(const f32x16& x, int s2) {
    const u32x4 pw = {cpk2(x[8 * s2], x[8 * s2 + 1]), cpk2(x[8 * s2 + 2], x[8 * s2 + 3]), cpk2(x[8 * s2 + 4], x[8 * s2 + 5]), cpk2(x[8 * s2 + 6], x[8 * s2 + 7])};
    return __builtin_bit_cast(bf16x8, pw);
}
#define MFMA32(a, b, c) __builtin_amdgcn_mfma_f32_32x32x16_bf16((a), (b), (c), 0, 0, 0)
constexpr int PT = 72, PQ = 136, PL = 68, PB = 40;
constexpr int CP_GC = 0, CP_BT = 256, CP_LS = 1024, CP_TU = CP_LS + 64 * PL * 4, CP_TW = CP_TU + 64 * PT * 2, CP_KT = CP_TW + 64 * PT * 2, CP_VT = CP_KT + 128 * PT * 2,
              CP_QS = CP_VT + 128 * PT * 2, CP_KS = CP_QS + 64 * PQ * 2, CP_AQ = CP_KS + 64 * PQ * 2, CP_L21 = CP_AQ + 64 * PT * 2, CP_TCM = CP_L21 + 32 * PB * 2, CP_T22 = CP_TCM + 32 * PB * 2, CP_END = CP_T22 + 32 * PB * 2;
static_assert(CP_END <= 131072, "chunk prep LDS");
__device__ __forceinline__ void gdn_chunk_prep(const Params& p, LAS unsigned char* lds, int item, int tid, int wave, int lane) {
    asm volatile("" : "+v"(tid), "+v"(lane));
    const int bh = item >> 5, n = item & 31, b = bh >> 2, h = bh & 3, ql = lane & 31, hh = lane >> 5;
    const size_t t0 = (size_t)b * SEQ + n * 64;
    bf16_t* P = (bf16_t*)(p.ws + WS_P); bf16_t* U = (bf16_t*)(p.ws + WS_U); const float* BG = (const float*)(p.ws + WS_BG);
    LAS float* gcS = (LAS float*)(lds + CP_GC); LAS float* btS = (LAS float*)(lds + CP_BT);
    LAS float* LS = (LAS float*)(lds + CP_LS);
    LAS bf16_t* TuS = (LAS bf16_t*)(lds + CP_TU); LAS bf16_t* TwS = (LAS bf16_t*)(lds + CP_TW);
    LAS bf16_t* kT = (LAS bf16_t*)(lds + CP_KT); LAS bf16_t* vT = (LAS bf16_t*)(lds + CP_VT); LAS bf16_t* qS = (LAS bf16_t*)(lds + CP_QS); LAS bf16_t* kS = (LAS bf16_t*)(lds + CP_KS);
    LAS bf16_t* AQ = (LAS bf16_t*)(lds + CP_AQ); LAS bf16_t* L21b = (LAS bf16_t*)(lds + CP_L21); LAS bf16_t* Tcm = (LAS bf16_t*)(lds + CP_TCM); LAS bf16_t* T22r = (LAS bf16_t*)(lds + CP_T22);
    if (tid < 64) { float x = BG[(t0 + tid) * 8 + 4 + h];
#pragma unroll
        for (int o = 1; o < 64; o <<= 1) { const float y = __shfl_up(x, o); if (lane >= o) x += y; }
        gcS[tid] = x; btS[tid] = BG[(t0 + tid) * 8 + h]; }
    { const int tok = tid >> 3, c16 = (tid & 7) * 16;
        const u32x4 ka = *(const u32x4*)(U + (t0 + tok) * D + 512 + h * 128 + c16), kb = *(const u32x4*)(U + (t0 + tok) * D + 512 + h * 128 + c16 + 8);
        const u32x4 qa = *(const u32x4*)(U + (t0 + tok) * D + h * 128 + c16), qb = *(const u32x4*)(U + (t0 + tok) * D + h * 128 + c16 + 8);
        u32x4 xv[4][2];
#pragma unroll
        for (int i = 0; i < 4; ++i) { const bool ok = n * 64 + tok - 3 + i >= 0; const bf16_t* vp = P + (t0 + tok - 3 + i) * NIN + C_VDN + h * 128 + c16;
            xv[i][0] = ok ? *(const u32x4*)vp : (u32x4){0u, 0u, 0u, 0u}; xv[i][1] = ok ? *(const u32x4*)(vp + 8) : (u32x4){0u, 0u, 0u, 0u}; }
        *(LAS u32x4*)(kS + tok * PQ + c16) = ka; *(LAS u32x4*)(kS + tok * PQ + c16 + 8) = kb;
        *(LAS u32x4*)(qS + tok * PQ + c16) = qa; *(LAS u32x4*)(qS + tok * PQ + c16 + 8) = qb;
        const unsigned kw[8] = {ka.x, ka.y, ka.z, ka.w, kb.x, kb.y, kb.z, kb.w};
#pragma unroll
        for (int e = 0; e < 8; ++e) { kT[(c16 + 2 * e) * PT + tok] = (bf16_t)(kw[e] & 0xffffu); kT[(c16 + 2 * e + 1) * PT + tok] = (bf16_t)(kw[e] >> 16); }
        float y[16];
#pragma unroll
        for (int e = 0; e < 16; ++e) y[e] = 0.f;
#pragma unroll
        for (int i = 0; i < 4; ++i) { const float* wp = p.in[I_WCONV] + i * 1536 + 1024 + h * 128 + c16;
            const unsigned xw[8] = {xv[i][0].x, xv[i][0].y, xv[i][0].z, xv[i][0].w, xv[i][1].x, xv[i][1].y, xv[i][1].z, xv[i][1].w};
#pragma unroll
            for (int e = 0; e < 8; ++e) { y[2 * e] += wp[2 * e] * bf_lo(xw[e]); y[2 * e + 1] += wp[2 * e + 1] * bf_hi(xw[e]); } }
#pragma unroll
        for (int e = 0; e < 16; ++e) vT[(c16 + e) * PT + tok] = f2bf(fsilu(y[e])); }
    __syncthreads();
    if (wave == 0) {
        bf16x8 kf[2][8];
#pragma unroll
        for (int t = 0; t < 2; ++t)
#pragma unroll
            for (int ks = 0; ks < 8; ++ks) kf[t][ks] = *(const LAS bf16x8*)(kS + (32 * t + ql) * PQ + 16 * ks + 8 * hh);
#pragma unroll
        for (int tt = 0; tt < 3; ++tt) { const int it = tt == 0 ? 0 : 1, jt = tt == 2 ? 1 : 0;
            f32x16 acc;
#pragma unroll
            for (int r = 0; r < 16; ++r) acc[r] = 0.f;
#pragma unroll
            for (int ks = 0; ks < 8; ++ks) acc = MFMA32(kf[it][ks], kf[jt][ks], acc);
            const int j = 32 * jt + ql; const float gj = gcS[j];
#pragma unroll
            for (int r = 0; r < 16; ++r) { const int i = 32 * it + crow(r, hh); const float l = (j < i) ? btS[i] * acc[r] * fexp(gcS[i] - gj) : 0.f;
                if (it != jt) L21b[(i - 32) * PB + j] = f2bf(l); else LS[i * PL + j] = l; } }
    } else if (wave < 4) {
        const int jt = wave == 3 ? 1 : 0, it = wave == 1 ? 0 : 1;
        f32x16 acc;
#pragma unroll
        for (int r = 0; r < 16; ++r) acc[r] = 0.f;
#pragma unroll
        for (int ks = 0; ks < 8; ++ks) acc = MFMA32(*(const LAS bf16x8*)(kS + (32 * jt + ql) * PQ + 16 * ks + 8 * hh), *(const LAS bf16x8*)(qS + (32 * it + ql) * PQ + 16 * ks + 8 * hh), acc);
        const int i = 32 * it + ql; const float gi = gcS[i];
#pragma unroll
        for (int r = 0; r < 16; ++r) { const int j = 32 * jt + crow(r, hh); acc[r] = (j <= i) ? acc[r] * fexp(gi - gcS[j]) : 0.f; }
#pragma unroll
        for (int bq = 0; bq < 4; ++bq) *(LAS u32x2*)(AQ + i * PT + 32 * jt + 8 * bq + 4 * hh) = (u32x2){cpk2(acc[4 * bq], acc[4 * bq + 1]), cpk2(acc[4 * bq + 2], acc[4 * bq + 3])};
    } else {
        const float gl = gcS[63];
#pragma unroll
        for (int uu = 0; uu < 2; ++uu) { const int unit = (tid - 256) + 256 * uu, dk = unit >> 2, blk = unit & 3;
            const u32x4 k0 = *(const LAS u32x4*)(kT + dk * PT + 16 * blk), k1 = *(const LAS u32x4*)(kT + dk * PT + 16 * blk + 8);
            float kv[16] = {bf_lo(k0.x), bf_hi(k0.x), bf_lo(k0.y), bf_hi(k0.y), bf_lo(k0.z), bf_hi(k0.z), bf_lo(k0.w), bf_hi(k0.w), bf_lo(k1.x), bf_hi(k1.x), bf_lo(k1.y), bf_hi(k1.y), bf_lo(k1.z), bf_hi(k1.z), bf_lo(k1.w), bf_hi(k1.w)};
#pragma unroll
            for (int e = 0; e < 16; ++e) kv[e] *= fexp(gl - gcS[16 * blk + e]);
            float pv[16];
#pragma unroll
            for (int e = 0; e < 16; ++e) pv[permpos(e)] = kv[e];
            pack16(P + slotP(t0, h, C_VSB, dk * 64 + 16 * blk), pv); }
        if (tid == 256) ((float*)(p.ws + WS_EGL))[bh * 32 + n] = fexp(gl);
    }
    __syncthreads();
    if (wave == 0) {
        const LAS float* LB = LS + (32 * hh) * PL + 32 * hh;
        float Tc[32];
#pragma unroll
        for (int i = 0; i < 32; ++i) {
            float a0 = (ql == i) ? 1.0f : 0.f, a1 = 0.f, a2 = 0.f, a3 = 0.f;
#pragma unroll
            for (int j4 = 0; j4 < i; j4 += 4) { const f32x4 l4 = *(const LAS f32x4*)(LB + i * PL + j4);
                a0 -= l4[0] * Tc[j4]; if (j4 + 1 < i) a1 -= l4[1] * Tc[j4 + 1]; if (j4 + 2 < i) a2 -= l4[2] * Tc[j4 + 2]; if (j4 + 3 < i) a3 -= l4[3] * Tc[j4 + 3]; }
            Tc[i] = (a0 + a1) + (a2 + a3); }
        const int cg_ = 32 * hh + ql; const float bu = btS[cg_], bw = bu * fexp(gcS[cg_]);
#pragma unroll
        for (int i = 0; i < 32; ++i) { TuS[(32 * hh + i) * PT + cg_] = f2bf(Tc[i] * bu); TwS[(32 * hh + i) * PT + cg_] = f2bf(Tc[i] * bw); }
        if (hh == 0) {
#pragma unroll
            for (int i8 = 0; i8 < 4; ++i8) *(LAS u32x4*)(Tcm + ql * PB + 8 * i8) = (u32x4){cpk2(Tc[8 * i8], Tc[8 * i8 + 1]), cpk2(Tc[8 * i8 + 2], Tc[8 * i8 + 3]), cpk2(Tc[8 * i8 + 4], Tc[8 * i8 + 5]), cpk2(Tc[8 * i8 + 6], Tc[8 * i8 + 7])};
        } else {
#pragma unroll
            for (int i = 0; i < 32; ++i) T22r[i * PB + ql] = f2bf(Tc[i]);
        }
        LDS_WAIT();
        f32x16 x1;
#pragma unroll
        for (int r = 0; r < 16; ++r) x1[r] = 0.f;
#pragma unroll
        for (int s2 = 0; s2 < 2; ++s2) x1 = MFMA32(*(const LAS bf16x8*)(L21b + ql * PB + 16 * s2 + 8 * hh), *(const LAS bf16x8*)(Tcm + ql * PB + 16 * s2 + 8 * hh), x1);
        f32x16 yy;
#pragma unroll
        for (int r = 0; r < 16; ++r) yy[r] = 0.f;
#pragma unroll
        for (int s2 = 0; s2 < 2; ++s2) { const u32x2 lo = *(const LAS u32x2*)(T22r + ql * PB + 16 * s2 + 4 * hh), hi = *(const LAS u32x2*)(T22r + ql * PB + 16 * s2 + 8 + 4 * hh);
            const u32x4 af = {lo.x, lo.y, hi.x, hi.y};
            yy = MFMA32(__builtin_bit_cast(bf16x8, af), pack8(x1, s2), yy); }
        { const float bu0 = btS[ql], bw0 = bu0 * fexp(gcS[ql]);
#pragma unroll
            for (int r = 0; r < 16; ++r) { const int i2 = 32 + crow(r, hh); TuS[i2 * PT + ql] = f2bf(-yy[r] * bu0); TwS[i2 * PT + ql] = f2bf(-yy[r] * bw0); } }
    }
    __syncthreads();
    {
        const int isW = wave >> 2, ct = wave & 3, col = 32 * ct + ql;
        const LAS bf16_t* Ta = (isW ? TwS : TuS) + 8 * hh; const LAS bf16_t* Bs = (isW ? kT : vT) + col * PT + 8 * hh;
        bf16x8 bf[4];
#pragma unroll
        for (int ks = 0; ks < 4; ++ks) bf[ks] = *(const LAS bf16x8*)(Bs + 16 * ks);
        f32x16 xa[2];
#pragma unroll
        for (int jt = 0; jt < 2; ++jt) {
#pragma unroll
            for (int r = 0; r < 16; ++r) xa[jt][r] = 0.f;
#pragma unroll
            for (int ks = 0; ks < 4; ++ks) if (jt == 1 || ks < 2) xa[jt] = MFMA32(*(const LAS bf16x8*)(Ta + (32 * jt + ql) * PT + 16 * ks), bf[ks], xa[jt]); }
        bf16x8 xb[4] = {pack8(xa[0], 0), pack8(xa[0], 1), pack8(xa[1], 0), pack8(xa[1], 1)};
        f32x16 ra[2];
#pragma unroll
        for (int it = 0; it < 2; ++it) {
#pragma unroll
            for (int r = 0; r < 16; ++r) ra[it][r] = 0.f;
#pragma unroll
            for (int kk = 0; kk < 4; ++kk) if (it == 1 || kk < 2) { const LAS bf16_t* ap = AQ + (32 * it + ql) * PT + 16 * kk + 4 * hh;
                const u32x2 lo = *(const LAS u32x2*)ap, hi = *(const LAS u32x2*)(ap + 8); const u32x4 af = {lo.x, lo.y, hi.x, hi.y};
                ra[it] = MFMA32(__builtin_bit_cast(bf16x8, af), xb[kk], ra[it]); } }
        if (!isW) {
#pragma unroll
            for (int jt = 0; jt < 2; ++jt)
#pragma unroll
                for (int bq = 0; bq < 4; ++bq) { const int f = col * 64 + 32 * jt + 8 * bq + 4 * hh;
                    *(u32x2*)(U + slotU(t0, h, 0, f)) = (u32x2){cpk2(xa[jt][4 * bq], xa[jt][4 * bq + 1]), cpk2(xa[jt][4 * bq + 2], xa[jt][4 * bq + 3])};
                    *(u32x2*)(U + slotU(t0, h, 512, f)) = (u32x2){cpk2(ra[jt][4 * bq], ra[jt][4 * bq + 1]), cpk2(ra[jt][4 * bq + 2], ra[jt][4 * bq + 3])}; }
        } else {
            const int pc = permpos(col);
#pragma unroll
            for (int jt = 0; jt < 2; ++jt)
#pragma unroll
                for (int r = 0; r < 16; ++r) { const int tok = 32 * jt + crow(r, hh);
                    P[(t0 + tok) * NIN + C_QDN + h * 128 + pc] = f2bf(-xa[jt][r]);
                    P[(t0 + tok) * NIN + C_KDN + h * 128 + pc] = f2bf(bf2f(qS[tok * PQ + col]) * fexp(gcS[tok]) - ra[jt][r]); }
        }
    }
    __syncthreads();
}
constexpr int SC_PW = 136, SC_PK = 72, SC_NW = 0, SC_Q2 = 64 * SC_PW * 2, SC_KD = 2 * 64 * SC_PW * 2, SC_STAGE = 2 * 64 * SC_PW * 2 + 128 * SC_PK * 2;
static_assert(2 * SC_STAGE <= 131072, "scan LDS");
__device__ __forceinline__ void gdn_scan_block(const Params& p, LAS unsigned char* lds, int bh, int tid, int wave, int lane) {
    asm volatile("" : "+v"(tid), "+v"(lane));
    bf16_t* P = (bf16_t*)(p.ws + WS_P); const bf16_t* U = (const bf16_t*)(p.ws + WS_U); const float* EGL = (const float*)(p.ws + WS_EGL);
    const int b = bh >> 2, h = bh & 3, ql = lane & 31, hh = lane >> 5;
    const size_t tb = (size_t)b * SEQ;
    if (wave >= 4) {
        const int lt = tid - 256;
        u32x4 r[12];
#define SC_LOAD(n_) do { const size_t t0_ = tb + (size_t)(n_) * 64; _Pragma("unroll") for (int i = 0; i < 4; ++i) { const int c = lt + 256 * i, row = c >> 4, c8 = (c & 15) * 8; \
            const bf16_t* g_ = P + (t0_ + row) * NIN + h * 128 + c8; r[i] = *(const u32x4*)(g_ + C_QDN); r[4 + i] = *(const u32x4*)(g_ + C_KDN); r[8 + i] = *(const u32x4*)(g_ + C_VSB); } } while (0)
#define SC_STORE(st_) do { LAS unsigned char* s_ = lds + (st_) * SC_STAGE; _Pragma("unroll") for (int i = 0; i < 4; ++i) { const int c = lt + 256 * i, row = c >> 4, c8 = (c & 15) * 8; \
            *(LAS u32x4*)(s_ + SC_NW + (row * SC_PW + c8) * 2) = r[i]; *(LAS u32x4*)(s_ + SC_Q2 + (row * SC_PW + c8) * 2) = r[4 + i]; \
            *(LAS u32x4*)(s_ + SC_KD + ((2 * row + (c8 >> 6)) * SC_PK + (c8 & 63)) * 2) = r[8 + i]; } } while (0)
        SC_LOAD(0); SC_STORE(0);
        __syncthreads();
#pragma unroll 1
        for (int n = 0; n < 32; ++n) {
            if (n + 1 < 32) { SC_LOAD(n + 1); SC_STORE((n + 1) & 1); }
            __syncthreads();
        }
#undef SC_LOAD
#undef SC_STORE
    } else {
        const int col = 32 * wave + ql;
        f32x16 S[4];
#pragma unroll
        for (int rt = 0; rt < 4; ++rt)
#pragma unroll
            for (int r = 0; r < 16; ++r) S[rt][r] = 0.f;
        u32x2 pu[8], po[8];
#define SC_PRE(n_) do { const size_t t0_ = tb + (size_t)(n_) * 64; _Pragma("unroll") for (int jt = 0; jt < 2; ++jt) _Pragma("unroll") for (int bq = 0; bq < 4; ++bq) { const int f = col * 64 + 32 * jt + 8 * bq + 4 * hh; \
            pu[jt * 4 + bq] = *(const u32x2*)(U + slotU(t0_, h, 0, f)); po[jt * 4 + bq] = *(const u32x2*)(U + slotU(t0_, h, 512, f)); } } while (0)
        SC_PRE(0);
        __syncthreads();
#pragma unroll 1
        for (int n = 0; n < 32; ++n) {
            const size_t t0 = tb + (size_t)n * 64;
            const float egl = EGL[bh * 32 + n];
            const LAS unsigned char* st = lds + (n & 1) * SC_STAGE;
            bf16x8 Sb[8];
#pragma unroll
            for (int rt = 0; rt < 4; ++rt) { Sb[2 * rt] = pack8(S[rt], 0); Sb[2 * rt + 1] = pack8(S[rt], 1); }
            f32x16 vn[2], oa[2];
#pragma unroll
            for (int jt = 0; jt < 2; ++jt)
#pragma unroll
                for (int bq = 0; bq < 4; ++bq) { const u32x2 uw = pu[jt * 4 + bq], ow = po[jt * 4 + bq];
                    vn[jt][4 * bq] = bf_lo(uw.x); vn[jt][4 * bq + 1] = bf_hi(uw.x); vn[jt][4 * bq + 2] = bf_lo(uw.y); vn[jt][4 * bq + 3] = bf_hi(uw.y);
                    oa[jt][4 * bq] = bf_lo(ow.x); oa[jt][4 * bq + 1] = bf_hi(ow.x); oa[jt][4 * bq + 2] = bf_lo(ow.y); oa[jt][4 * bq + 3] = bf_hi(ow.y); }
            if (n + 1 < 32) SC_PRE(n + 1);
#pragma unroll
            for (int jt = 0; jt < 2; ++jt) { const LAS unsigned char* wr_ = st + ((32 * jt + ql) * SC_PW + 8 * hh) * 2;
#pragma unroll
                for (int ks = 0; ks < 8; ++ks) { vn[jt] = MFMA32(*(const LAS bf16x8*)(wr_ + SC_NW + 32 * ks), Sb[ks], vn[jt]); oa[jt] = MFMA32(*(const LAS bf16x8*)(wr_ + SC_Q2 + 32 * ks), Sb[ks], oa[jt]); } }
            bf16x8 vb[4] = {pack8(vn[0], 0), pack8(vn[0], 1), pack8(vn[1], 0), pack8(vn[1], 1)};
#pragma unroll
            for (int rt = 0; rt < 4; ++rt) {
#pragma unroll
                for (int r = 0; r < 16; ++r) S[rt][r] *= egl;
                const LAS unsigned char* kr_ = st + SC_KD + ((32 * rt + ql) * SC_PK + 8 * hh) * 2;
#pragma unroll
                for (int ks = 0; ks < 4; ++ks) S[rt] = MFMA32(*(const LAS bf16x8*)(kr_ + 32 * ks), vb[ks], S[rt]); }
#pragma unroll
            for (int jt = 0; jt < 2; ++jt)
#pragma unroll
                for (int r = 0; r < 16; ++r) P[(t0 + 32 * jt + crow(r, hh)) * NIN + C_VDN + h * 128 + col] = f2bf(oa[jt][r]);
            __syncthreads();
        }
#undef SC_PRE
    }
}
__device__ __forceinline__ void gdn_finalize_phase(const Params& p, int wave, int lane) {
    bf16_t* P = (bf16_t*)(p.ws + WS_P);
    const int c0 = (lane & 15) * 8;
    float gg[8];
#pragma unroll
    for (int e = 0; e < 8; ++e) gg[e] = p.in[I_GDNOUT][c0 + e];
    for (int row = blockIdx.x * 8 + wave; row < T; row += gridDim.x * 8) {
        bf16_t* op = P + (size_t)row * NIN + C_VDN + lane * 8; const bf16_t* zp = P + (size_t)row * NIN + C_ZDN + lane * 8;
        const u32x4 ow = *(const u32x4*)op, zw = *(const u32x4*)zp;
        const float o[8] = {bf_lo(ow.x), bf_hi(ow.x), bf_lo(ow.y), bf_hi(ow.y), bf_lo(ow.z), bf_hi(ow.z), bf_lo(ow.w), bf_hi(ow.w)};
        const float z[8] = {bf_lo(zw.x), bf_hi(zw.x), bf_lo(zw.y), bf_hi(zw.y), bf_lo(zw.z), bf_hi(zw.z), bf_lo(zw.w), bf_hi(zw.w)};
        float ss = 0.f;
#pragma unroll
        for (int e = 0; e < 8; ++e) ss += o[e] * o[e];
        ss += __shfl_xor(ss, 1); ss += __shfl_xor(ss, 2); ss += __shfl_xor(ss, 4); ss += __shfl_xor(ss, 8);
        const float rstd = 1.0f / sqrtf(ss * (1.f / 128.f) + EPS);
        float r[8];
#pragma unroll
        for (int e = 0; e < 8; ++e) r[e] = o[e] * rstd * gg[e] * fsilu(z[e]);
        u32x4 w; w.x = pk2(r[0], r[1]); w.y = pk2(r[2], r[3]); w.z = pk2(r[4], r[5]); w.w = pk2(r[6], r[7]);
        *(u32x4*)op = w;
    }
}

#define XB_TMO      128
#define XB_XCNT(j)  (256  + 64 * (j))
#define XB_XSUB(j)  (1280 + 64 * (j))
#define XB_XGEN(j)  (2304 + 64 * (j))
#define XB_TOP      3328
#define XB_TOPGEN   3392
#define XCD_BAR_WORDS 3456
#define XB_SPIN_CAP (1u << 18)
__device__ __forceinline__ unsigned xb_ld(unsigned* p)              { return __hip_atomic_load(p, __ATOMIC_RELAXED, __HIP_MEMORY_SCOPE_AGENT); }
__device__ __forceinline__ unsigned xb_add(unsigned* p, unsigned v) { return __hip_atomic_fetch_add(p, v, __ATOMIC_RELAXED, __HIP_MEMORY_SCOPE_AGENT); }
__device__ __forceinline__ unsigned xb_xcc_id() { return (unsigned)__builtin_amdgcn_s_getreg((3 << 11) | 20) & 0xFu; }
#define XB_SPIN(cond, bar) do { unsigned _sp = 0; while (cond) { __builtin_amdgcn_s_sleep(1); \
    if ((++_sp & 255u) == 0u) { if (xb_ld(&(bar)[XB_TMO])) break; if (_sp > XB_SPIN_CAP) { atomicAdd(&(bar)[XB_TMO], 1u); break; } } } } while (0)
struct XcdBarrier { unsigned* bar; unsigned x; volatile LAS unsigned* st; };
__device__ __forceinline__ XcdBarrier xcd_barrier_post(unsigned* bar, volatile LAS unsigned* st) {
    XcdBarrier b; b.bar = bar; b.x = xb_xcc_id(); b.st = st;
    if (threadIdx.x == 0) (void)xb_add(&bar[XB_XCNT(b.x)], 1u);
    return b;
}
__device__ __forceinline__ void xcd_barrier_complete(unsigned* bar, unsigned x, unsigned& nloc, unsigned& nx) {
    const unsigned G = gridDim.x * gridDim.y * gridDim.z;
    unsigned sum, cnt, mine, sp = 0u;
    for (;;) {
        sum = 0u; cnt = 0u; mine = 0u;
#pragma unroll
        for (unsigned j = 0; j < 16; ++j) { const unsigned c = xb_ld(&bar[XB_XCNT(j)]); sum += c; cnt += (c > 0u) ? 1u : 0u; mine = (j == x) ? c : mine; }
        if (sum == G) break;
        __builtin_amdgcn_s_sleep(1);
        if ((++sp & 255u) == 0u) { if (xb_ld(&bar[XB_TMO])) break; if (sp > XB_SPIN_CAP) { atomicAdd(&bar[XB_TMO], 1u); break; } }
    }
    nloc = mine > 0u ? mine : 1u; nx = cnt > 0u ? cnt : 1u;
}
__device__ __forceinline__ void xcd_barrier(const XcdBarrier& b) {
    asm volatile("s_waitcnt vmcnt(0)" ::: "memory");
    __syncthreads();
    if (threadIdx.x == 0) {
        unsigned* bar = b.bar;
        __builtin_amdgcn_s_waitcnt(0);
        unsigned nloc = b.st[0], nx = b.st[1];
        if (nloc == 0u) { xcd_barrier_complete(bar, b.x, nloc, nx); b.st[0] = nloc; b.st[1] = nx; }
        const unsigned old = xb_add(&bar[XB_XSUB(b.x)], 1u);
        const unsigned gen = old / nloc;
        if (old + 1u == (gen + 1u) * nloc) {
            __builtin_amdgcn_fence(__ATOMIC_RELEASE, "agent");
            asm volatile("s_waitcnt vmcnt(0)" ::: "memory");
            const unsigned og = xb_add(&bar[XB_TOP], 1u);
            const unsigned tg = og / nx;
            if (og + 1u == (tg + 1u) * nx) xb_add(&bar[XB_TOPGEN], 1u);
            else XB_SPIN(xb_ld(&bar[XB_TOPGEN]) == tg, bar);
            __builtin_amdgcn_fence(__ATOMIC_ACQUIRE, "agent");
            xb_add(&bar[XB_XGEN(b.x)], 1u);
            asm volatile("s_waitcnt vmcnt(0)" ::: "memory");
        } else {
            XB_SPIN(xb_ld(&bar[XB_XGEN(b.x)]) == gen, bar);
            __builtin_amdgcn_fence(__ATOMIC_ACQUIRE, "agent");
            asm volatile("s_waitcnt vmcnt(0)" ::: "memory");
        }
    }
    __syncthreads();
}

#ifndef PHMASK
#define PHMASK 0xFFFF
#endif
#define PH(n) ((PHMASK >> (n)) & 1)
#ifndef PROBE
#define PROBE 0
#endif
#define REP(g) for (int _rep = 0; _rep < ((PROBE == (g)) ? 2 : 1); ++_rep)
__global__ void __launch_bounds__(512, 2) fwd_megakernel(Params p) {
    extern __shared__ __attribute__((aligned(16))) unsigned char lds_raw[];
    LAS unsigned char* lds = (LAS unsigned char*)lds_raw;
    cg::grid_group grid = cg::this_grid();
    const int tid = threadIdx.x, lane = tid & 63, wave = __builtin_amdgcn_readfirstlane(tid >> 6);
    const int G = gridDim.x, gw = wave * G + blockIdx.x, ngw = G * 8;
    unsigned char* ws = p.ws;
    bf16_t* U = (bf16_t*)(ws + WS_U); bf16_t* P = (bf16_t*)(ws + WS_P);
    const float* mod = (const float*)(ws + WS_MOD);
    LAS float* scr = (LAS float*)(lds + wave * 16384);

    unsigned* barw = (unsigned*)(ws + WS_BAR);
    volatile LAS unsigned* bst = (volatile LAS unsigned*)(lds + 131072);
    if (tid < 2) bst[tid] = 0u;
    __syncthreads();
    if (p.ws == nullptr) grid.sync();
    const XcdBarrier xbar = xcd_barrier_post(barw, bst);
    REP(1) { if (PH(0)) for (int it = blockIdx.x; it < NMOD / 64; it += G) mod_item(p, lds, it, tid, wave, lane);
    if (PH(0)) ffn_weight_items(p.in[I_WFFN1IN], p.in[I_WFFN1OUT], (bf16_t*)(ws + W_FFIN), (bf16_t*)(ws + W_FFOUT), scr, gw, ngw, lane);
    if (PH(0)) mixer_weight_items(p, scr, gw, ngw, lane); __syncthreads(); }
    xcd_barrier(xbar);
    if (PROBE == 3) for (int i = 0; i < 16; ++i) xcd_barrier(xbar);
    REP(1) if (PH(1)) norm_mod_phase<false>(p, lds, p.in[I_X], p.in[I_GFFN1], 0, U, tid, wave, lane);
    xcd_barrier(xbar);
    REP(2) if (PH(2)) run_gemm(lds, U, D, (const bf16_t*)(ws + W_FFIN), 2 * FF, D, EpiSwiGLU{P, FF});
    xcd_barrier(xbar);
    REP(2) if (PH(3)) run_gemm(lds, P, FF, (const bf16_t*)(ws + W_FFOUT), D, FF, EpiResid{p.in[I_X], p.out, mod + 2 * D, 0.5f});
    xcd_barrier(xbar);
    REP(1) if (PH(4)) norm_mod_phase<true>(p, lds, p.out, p.in[I_GMIX], 3, U, tid, wave, lane);
    xcd_barrier(xbar);
    REP(2) if (PH(5)) run_gemm(lds, U, D, (const bf16_t*)(ws + W_IN), NIN, D, EpiBf16{P, NIN});
    xcd_barrier(xbar);
    if (PH(6)) prep_phase(p, wave, lane);
    xcd_barrier(xbar);
    if (PH(7)) for (int it = blockIdx.x; it < 1024; it += G) gdn_chunk_prep(p, lds, it, tid, wave, lane);
    xcd_barrier(xbar);
    if (PH(15)) for (int it = blockIdx.x; it < 32; it += G) gdn_scan_block(p, lds, it, tid, wave, lane);
    if (PH(8)) {
        const unsigned x0 = xb_xcc_id() & 7u;
        for (unsigned dx = 0; dx < 8u; ++dx) { const unsigned x = (x0 + dx) & 7u; unsigned* ctr = (unsigned*)(ws + WS_CTR) + 64 * x;
            for (;;) { unsigned idx = 0; if (lane == 0) idx = atomicAdd(ctr, 1u); idx = __builtin_amdgcn_readfirstlane(idx);
                if (idx >= 512u) break;
                attn_item_mfma(P, (const bf16_t*)(ws + WS_VT), (int)(8u * x + (idx & 7u)), 63 - (int)(idx >> 3), lane); } } }
    xcd_barrier(xbar);
    if (PH(9)) gdn_finalize_phase(p, wave, lane);
    xcd_barrier(xbar);
    if (PH(10)) run_gemm(lds, P + C_QSB, NIN, (const bf16_t*)(ws + W_UPSB), D, 1024, EpiGateFused{P + C_RSB, P + C_RDN, U}, 8, (C_VDN - C_QSB) * 2 - 8 * 128);
    xcd_barrier(xbar);
    if (PH(11)) run_gemm(lds, U, D, (const bf16_t*)(ws + W_OUT), D, D, EpiResid{p.out, p.out, mod + 5 * D, 1.0f});
    xcd_barrier(xbar);
    REP(1) if (PH(12)) norm_mod_phase<false>(p, lds, p.out, p.in[I_GFFN2], 6, U, tid, wave, lane);
    __syncthreads();
    if (PH(12)) ffn_weight_items(p.in[I_WFFN2IN], p.in[I_WFFN2OUT], (bf16_t*)(ws + W_FFIN), (bf16_t*)(ws + W_FFOUT), scr, gw, ngw, lane);
    xcd_barrier(xbar);
    REP(2) if (PH(13)) run_gemm(lds, U, D, (const bf16_t*)(ws + W_FFIN), 2 * FF, D, EpiSwiGLU{P, FF});
    xcd_barrier(xbar);
    if (PH(14)) run_gemm(lds, P, FF, (const bf16_t*)(ws + W_FFOUT), D, FF, EpiResid{p.out, p.out, mod + 8 * D, 0.5f});
}

extern "C" void kernel_launch(void* const* d_in, const int* in_sizes, int n_in, void* d_out, int out_size, void* d_ws, size_t ws_size, hipStream_t stream) {
    static int grid_blocks = 0;
    if (!grid_blocks) {
        int dev = 0, cus = 0, per_cu = 0;
        (void)hipGetDevice(&dev);
        (void)hipDeviceGetAttribute(&cus, hipDeviceAttributeMultiprocessorCount, dev);
        (void)hipFuncSetAttribute((const void*)fwd_megakernel, hipFuncAttributeMaxDynamicSharedMemorySize, LDS_BYTES);
        (void)hipOccupancyMaxActiveBlocksPerMultiprocessor(&per_cu, (const void*)fwd_megakernel, 512, LDS_BYTES);
        if (per_cu < 1) { fprintf(stderr, "occupancy query says %d blocks/CU\n", per_cu); per_cu = 1; }
        grid_blocks = cus;
    }
    Params p{};
    for (int i = 0; i < N_IN; ++i) p.in[i] = (const float*)d_in[i];
    p.out = (float*)d_out; p.ws = (unsigned char*)d_ws;
    (void)hipMemsetAsync((char*)d_ws + WS_CTR, 0, (WS_BAR - WS_CTR) + XCD_BAR_WORDS * 4, stream);
    void* args[] = {&p};
    hipError_t e = hipLaunchCooperativeKernel((const void*)fwd_megakernel, dim3(grid_blocks), dim3(512), args, LDS_BYTES, stream);
    if (e != hipSuccess) fprintf(stderr, "cooperative launch failed: %s (grid %d)\n", hipGetErrorString(e), grid_blocks);
}
```

```cpp
#include <hip/hip_runtime.h>
#include <hip/hip_cooperative_groups.h>
#include <cstdio>
namespace cg = cooperative_groups;

#define LAS __attribute__((address_space(3)))
typedef unsigned short bf16_t;
typedef short bf16x8 __attribute__((ext_vector_type(8)));
typedef float f32x4 __attribute__((ext_vector_type(4)));
typedef unsigned u32x4 __attribute__((ext_vector_type(4)));
typedef unsigned u32x2 __attribute__((ext_vector_type(2)));
typedef float f32x16 __attribute__((ext_vector_type(16)));
typedef float f32x2 __attribute__((ext_vector_type(2)));
typedef __bf16 nbf16x2 __attribute__((ext_vector_type(2)));

constexpr int T = 16384, D = 1024, SEQ = 2048, NB = 8, FF = 2816, NIN = 5632, INW = 5640, NMOD = 9216;
constexpr int C_QSB = 0, C_KSB = 512, C_VSB = 1024, C_QDN = 1536, C_KDN = 2048, C_VDN = 2560, C_ZDN = 3072, C_RSB = 3584, C_RDN = 4608;
constexpr float EPS = 1e-6f;
constexpr int LDS_BYTES = 163840, BST_OFF = LDS_BYTES - 64;
constexpr size_t MiB = 1024 * 1024;
constexpr size_t WS_MOD = 0, WS_BG = 512 * 1024, WS_SS = 242 * MiB, WS_W = 2 * MiB;
constexpr size_t W_FFIN = WS_W, W_FFOUT = W_FFIN + (size_t)2 * FF * D * 2, W_IN = W_FFOUT + (size_t)D * FF * 2, W_UPSB = W_IN + (size_t)NIN * D * 2,
                 W_UPDN = W_UPSB + (size_t)D * 512 * 2, W_OUT = W_UPDN + (size_t)D * 512 * 2, W_END = W_OUT + (size_t)D * D * 2;
constexpr size_t WS_U = 34 * MiB, WS_P = 66 * MiB;
static_assert(W_END <= WS_U, "weights overflow");
constexpr size_t WS_EGL = 384 * 1024, WS_CTR = 400 * 1024, WS_BAR = 416 * 1024;
constexpr size_t WS_VT = W_FFIN;
static_assert((size_t)T * 512 * 2 <= W_IN - W_FFIN, "Vt overflow");

enum { I_X = 0, I_C, I_WADA, I_BADA, I_GFFN1, I_WFFN1IN, I_WFFN1OUT, I_GMIX, I_WIN, I_GQSB, I_GKSB, I_WCONV, I_ALOG, I_DTBIAS, I_GDNOUT, I_WUPSB, I_WUPDN, I_WOUT, I_GFFN2, I_WFFN2IN, I_WFFN2OUT, N_IN };
struct Params { const float* in[N_IN]; float* out; unsigned char* ws; };

__device__ __forceinline__ float bf_lo(unsigned w) { return __uint_as_float(w << 16); }
__device__ __forceinline__ float bf_hi(unsigned w) { return __uint_as_float(w & 0xffff0000u); }
__device__ __forceinline__ float bf2f(bf16_t b) { return __uint_as_float(((unsigned)b) << 16); }
__device__ __forceinline__ unsigned pk2(float lo, float hi) { unsigned r; asm("v_cvt_pk_bf16_f32 %0, %1, %2" : "=v"(r) : "v"(lo), "v"(hi)); return r; }
__device__ __forceinline__ unsigned cpk2(float lo, float hi) { const f32x2 v = {lo, hi}; return __builtin_bit_cast(unsigned, __builtin_convertvector(v, nbf16x2)); }
__device__ __forceinline__ bf16_t f2bf(float f) { return (bf16_t)(pk2(f, 0.f) & 0xffffu); }
__device__ __forceinline__ float fexp(float x) { return __builtin_amdgcn_exp2f(x * 1.4426950408889634f); }
__device__ __forceinline__ float flog(float x) { return __builtin_amdgcn_logf(x) * 0.6931471805599453f; }
__device__ __forceinline__ float fsigmoid(float x) { return __builtin_amdgcn_rcpf(1.f + fexp(-x)); }
__device__ __forceinline__ float fsilu(float x) { return x * fsigmoid(x); }
__device__ __forceinline__ float fsoftplus(float x) { return fmaxf(x, 0.f) + flog(1.f + fexp(-fabsf(x))); }
__device__ __forceinline__ float wave_sum(float v) {
#pragma unroll
    for (int o = 1; o < 64; o <<= 1) v += __shfl_xor(v, o);
    return v;
}
#define LDS_WAIT() asm volatile("s_waitcnt lgkmcnt(0)" ::: "memory")

namespace pg8 {
constexpr int BM = 256, BK = 64, HALF = 128, HTB = HALF * BK * 2, STAGE_BYTES = 8 * HTB, NXCD = 8, WGM = 8;
__host__ __device__ __forceinline__ int lds_byte(int r, int c) { const int st = (r >> 4) * 2 + (c >> 5), rr = r & 15, cc = c & 31, ob = rr * 64 + cc * 2; return st * 1024 + (ob ^ (((ob >> 9) & 1) << 5)); }
__host__ __device__ __forceinline__ void stage_rc(int b, int& R, int& C) { const int st = b / 1024, sb = b % 1024, swz = sb ^ (((sb >> 9) & 1) << 5); R = (st >> 1) * 16 + swz / 64; C = (st & 1) * 32 + (swz % 64) / 2; }
__host__ __device__ __forceinline__ int perm32(int rho) { const int n = rho >> 4, i = rho & 15; return 8 * (i >> 2) + 4 * n + (i & 3); }
struct Unit { int pm, pn; };
struct Gemm { const bf16_t* A; const bf16_t* Bt; int M, N, K, lda; int jt; int jbytes; };
struct StaticOrder {
    int nM, nN, nwg, G, c;
    __host__ __device__ void init(int M, int N, int G_, int c_) { nM = M / BM; nN = N / BM; nwg = nM * nN; G = G_; c = c_; }
    __host__ __device__ bool next(int i, Unit& u) const {
        const long L = (long)i * G + c; if (L >= nwg) return false;
        int wgid = (int)L; { const int q = nwg / NXCD, r = nwg % NXCD, xcd = wgid % NXCD, off = wgid / NXCD; wgid = (xcd < r ? xcd * (q + 1) : r * (q + 1) + (xcd - r) * q) + off; }
        const int nig = WGM * nN, gid = wgid / nig, fm = gid * WGM, gsz = (nM - fm) < WGM ? (nM - fm) : WGM;
        u.pm = fm + ((wgid % nig) % gsz); u.pn = (wgid % nig) / gsz; return true;
    }
};
template <class Epi>
__device__ __forceinline__ void gemm_phase(LAS unsigned char* lds, const Gemm g, const StaticOrder& S, const Epi& E) {
    int tid = threadIdx.x; asm volatile("" : "+v"(tid));
    const int wid = __builtin_amdgcn_readfirstlane(tid >> 6), lane = tid & 63, wr = wid >> 2, wc = wid & 3, fr = lane & 15, fq = lane >> 4;
    const int K = g.K, nt = K / BK, lda = g.lda;
    unsigned voffA[2], voffB[2];
#pragma unroll
    for (int i = 0; i < 2; ++i) { int R, C; stage_rc(tid * 16 + i * 8192, R, C); const int Rb = Epi::PERM ? ((R & ~31) + perm32(R & 31)) : R;
        voffA[i] = (unsigned)(R * lda + C) * 2u; voffB[i] = (unsigned)(Rb * K + C) * 2u; }
    const size_t kstep = (size_t)(BK * 2);
    const size_t hstepA = (size_t)HALF * lda * 2, hstepB = (size_t)HALF * K * 2;
    const size_t tstepA = 2 * hstepA, tstepB = 2 * hstepB;
    const unsigned ldsw = (unsigned)wid * 1024u;
    const int aoff = lds_byte(wr * 64 + fr, fq * 8), boff = lds_byte(wc * 32 + fr, fq * 8);
#define PG8_SA(b, h) (((b) * 2 + (h)) * HTB)
#define PG8_SB(b, h) ((4 + (b) * 2 + (h)) * HTB)
#define PG8_STAGE(bufoff, gbase, voff) do { _Pragma("unroll") for (int _i = 0; _i < 2; ++_i) \
        __builtin_amdgcn_global_load_lds((const unsigned*)((const char*)(gbase) + (voff)[_i]), (LAS unsigned*)(lds + (bufoff) + ldsw + _i * 8192), 16, 0, 0); } while (0)
#define PG8_LDA(dst, b, h) do { _Pragma("unroll") for (int m = 0; m < 4; ++m) _Pragma("unroll") for (int k = 0; k < 2; ++k) dst[m][k] = *(const LAS bf16x8*)(lds + PG8_SA(b, h) + aoff + m * 2048 + k * 1024); } while (0)
#define PG8_LDB(dst, b, h) do { _Pragma("unroll") for (int n = 0; n < 2; ++n) _Pragma("unroll") for (int k = 0; k < 2; ++k) dst[n][k] = *(const LAS bf16x8*)(lds + PG8_SB(b, h) + boff + n * 2048 + k * 1024); } while (0)
#define PG8_MMA(ai, bj, At, Bt) do { __builtin_amdgcn_s_setprio(1); _Pragma("unroll") for (int m = 0; m < 4; ++m) _Pragma("unroll") for (int n = 0; n < 2; ++n) _Pragma("unroll") for (int k = 0; k < 2; ++k) \
        acc[ai][bj][m][n] = __builtin_amdgcn_mfma_f32_16x16x32_bf16(Bt[n][k], At[m][k], acc[ai][bj][m][n], 0, 0, 0); __builtin_amdgcn_s_setprio(0); } while (0)
#define PG8_WAIT_V(n) asm volatile("s_waitcnt vmcnt(" #n ")" ::: "memory")
#define PG8_WAIT_L(n) asm volatile("s_waitcnt lgkmcnt(" #n ")" ::: "memory")
#define PG8_BAR __builtin_amdgcn_s_barrier()
#define PG8_SCHED __builtin_amdgcn_sched_barrier(0)
    Unit cur, nxt; int ui = 0;
    if (!S.next(0, cur)) return;
    f32x4 acc[2][2][4][2];
#pragma unroll
    for (int a = 0; a < 2; ++a)
#pragma unroll
        for (int b = 0; b < 2; ++b)
#pragma unroll
            for (int m = 0; m < 4; ++m)
#pragma unroll
                for (int n = 0; n < 2; ++n) acc[a][b][m][n] = (f32x4){0.f, 0.f, 0.f, 0.f};
    bf16x8 At[4][2], B0[2][2], B1[2][2];
    const char* cA = (const char*)g.A + (size_t)cur.pm * tstepA; const char* cB = (const char*)g.Bt + (size_t)cur.pn * tstepB;
    PG8_STAGE(PG8_SB(0, 0), cB, voffB); PG8_STAGE(PG8_SA(0, 0), cA, voffA); PG8_STAGE(PG8_SB(0, 1), cB + hstepB, voffB); PG8_STAGE(PG8_SA(0, 1), cA + hstepA, voffA);
    if (wr == 1) PG8_BAR;
    PG8_WAIT_V(4); PG8_BAR;
    PG8_STAGE(PG8_SB(1, 0), cB + kstep, voffB); PG8_STAGE(PG8_SA(1, 0), cA + kstep, voffA); PG8_STAGE(PG8_SB(1, 1), cB + hstepB + kstep, voffB);
    PG8_WAIT_V(6); PG8_BAR;
    for (;;) {
        const bool has_next = S.next(ui + 1, nxt);
        const char* nA = has_next ? (const char*)g.A + (size_t)nxt.pm * tstepA : cA; const char* nB = has_next ? (const char*)g.Bt + (size_t)nxt.pn * tstepB : cB;
        for (int t = 0; t < nt; t += 2) {
            const bool last = (t == nt - 2);
            const char* a1 = cA + (size_t)(t + 1) * kstep + (t + 1 >= g.jt ? g.jbytes : 0);
            const char* a2 = last ? nA : cA + (size_t)(t + 2) * kstep + (t + 2 >= g.jt ? g.jbytes : 0); const char* b2 = last ? nB : cB + (size_t)(t + 2) * kstep;
            const char* a3 = a2 + kstep; const char* b3 = b2 + kstep;
            if constexpr (Epi::HAS_MID) { if (t == g.jt) E.mid(acc, cur, wr, wc, fr, fq); }
            PG8_LDB(B0, 0, 0); PG8_SCHED; PG8_LDA(At, 0, 0); PG8_STAGE(PG8_SA(1, 1), a1 + hstepA, voffA);
            PG8_WAIT_L(8); PG8_BAR; PG8_WAIT_L(0); PG8_MMA(0, 0, At, B0); PG8_BAR; PG8_SCHED;
            PG8_LDB(B1, 0, 1); PG8_STAGE(PG8_SB(0, 0), b2, voffB);
            PG8_BAR; PG8_WAIT_L(0); PG8_MMA(0, 1, At, B1); PG8_BAR;
            PG8_LDA(At, 0, 1); PG8_STAGE(PG8_SA(0, 0), a2, voffA);
            PG8_BAR; PG8_WAIT_L(0); PG8_MMA(1, 0, At, B0); PG8_BAR; PG8_SCHED;
            PG8_STAGE(PG8_SB(0, 1), b2 + hstepB, voffB);
            PG8_WAIT_V(6); PG8_BAR; PG8_MMA(1, 1, At, B1); PG8_BAR;
            PG8_LDB(B0, 1, 0); PG8_SCHED; PG8_LDA(At, 1, 0); PG8_STAGE(PG8_SA(0, 1), a2 + hstepA, voffA);
            PG8_WAIT_L(8); PG8_BAR; PG8_WAIT_L(0); PG8_MMA(0, 0, At, B0); PG8_BAR; PG8_SCHED;
            PG8_LDB(B1, 1, 1); PG8_STAGE(PG8_SB(1, 0), b3, voffB);
            PG8_BAR; PG8_WAIT_L(0); PG8_MMA(0, 1, At, B1); PG8_BAR;
            PG8_LDA(At, 1, 1); PG8_STAGE(PG8_SA(1, 0), a3, voffA);
            PG8_BAR; PG8_WAIT_L(0); PG8_MMA(1, 0, At, B0); PG8_BAR; PG8_SCHED;
            PG8_STAGE(PG8_SB(1, 1), b3 + hstepB, voffB);
            PG8_WAIT_V(6); PG8_BAR; PG8_MMA(1, 1, At, B1); PG8_BAR;
        }
        E(acc, cur, wr, wc, fr, fq);
        if (!has_next) break;
#pragma unroll
        for (int a = 0; a < 2; ++a)
#pragma unroll
            for (int b = 0; b < 2; ++b)
#pragma unroll
                for (int m = 0; m < 4; ++m)
#pragma unroll
                    for (int n = 0; n < 2; ++n) acc[a][b][m][n] = (f32x4){0.f, 0.f, 0.f, 0.f};
        cur = nxt; cA = nA; cB = nB; ++ui;
    }
    PG8_WAIT_V(0);
    if (wr == 0) PG8_BAR;
    PG8_BAR;
#undef PG8_SA
#undef PG8_SB
#undef PG8_STAGE
#undef PG8_LDA
#undef PG8_LDB
#undef PG8_MMA
#undef PG8_WAIT_V
#undef PG8_WAIT_L
#undef PG8_BAR
#undef PG8_SCHED
}
}

typedef const f32x4 (&AccRef)[2][2][4][2];
struct EpiBf16 {
    static constexpr bool PERM = true, HAS_MID = false;
    bf16_t* O; int ldc;
    __device__ __forceinline__ void operator()(AccRef acc, const pg8::Unit& u, int wr, int wc, int fr, int fq) const {
        const int row0 = u.pm * 256 + wr * 64 + fr, col0 = u.pn * 256 + wc * 32 + 8 * fq;
#pragma unroll
        for (int ai = 0; ai < 2; ++ai)
#pragma unroll
            for (int m = 0; m < 4; ++m) { bf16_t* rowp = O + (size_t)(row0 + ai * 128 + m * 16) * ldc + col0;
#pragma unroll
                for (int bj = 0; bj < 2; ++bj) { const f32x4 v0 = acc[ai][bj][m][0], v1 = acc[ai][bj][m][1];
                    u32x4 w; w.x = pk2(v0[0], v0[1]); w.y = pk2(v0[2], v0[3]); w.z = pk2(v1[0], v1[1]); w.w = pk2(v1[2], v1[3]);
                    *(u32x4*)(rowp + bj * 128) = w; } }
    }
};
struct EpiSwiGLU {
    static constexpr bool PERM = true, HAS_MID = false;
    bf16_t* O; int ldc;
    __device__ __forceinline__ void operator()(AccRef acc, const pg8::Unit& u, int wr, int wc, int fr, int fq) const {
        const int row0 = u.pm * 256 + wr * 64 + fr, col0 = u.pn * 128 + wc * 32 + 8 * fq;
#pragma unroll
        for (int ai = 0; ai < 2; ++ai)
#pragma unroll
            for (int m = 0; m < 4; ++m) { bf16_t* rowp = O + (size_t)(row0 + ai * 128 + m * 16) * ldc + col0;
                float r[8];
#pragma unroll
                for (int n = 0; n < 2; ++n)
#pragma unroll
                    for (int j = 0; j < 4; ++j) { const float a = acc[ai][0][m][n][j], b = acc[ai][1][m][n][j]; r[n * 4 + j] = fsilu(a) * b; }
                u32x4 w; w.x = pk2(r[0], r[1]); w.y = pk2(r[2], r[3]); w.z = pk2(r[4], r[5]); w.w = pk2(r[6], r[7]);
                *(u32x4*)rowp = w; }
    }
};
struct EpiResid {
    static constexpr bool PERM = false, HAS_MID = false;
    const float* base; float* out; const float* gate; float scale;
    __device__ __forceinline__ void operator()(AccRef acc, const pg8::Unit& u, int wr, int wc, int fr, int fq) const {
        const int row0 = u.pm * 256 + wr * 64 + fr, col0 = u.pn * 256 + wc * 32 + 4 * fq;
        const float* gp = gate + (size_t)(u.pm >> 3) * NMOD + col0;
        f32x4 gv[2][2];
#pragma unroll
        for (int bj = 0; bj < 2; ++bj)
#pragma unroll
            for (int n = 0; n < 2; ++n) gv[bj][n] = *(const f32x4*)(gp + bj * 128 + n * 16) * scale;
#pragma unroll
        for (int ai = 0; ai < 2; ++ai)
#pragma unroll
            for (int m = 0; m < 4; ++m) { const size_t off = (size_t)(row0 + ai * 128 + m * 16) * D + col0;
#pragma unroll
                for (int bj = 0; bj < 2; ++bj)
#pragma unroll
                    for (int n = 0; n < 2; ++n) { const f32x4 bs = *(const f32x4*)(base + off + bj * 128 + n * 16);
                        *(f32x4*)(out + off + bj * 128 + n * 16) = bs + gv[bj][n] * acc[ai][bj][m][n]; } }
    }
};
struct EpiGateFused {
    static constexpr bool PERM = true, HAS_MID = true;
    const bf16_t* Rsb; const bf16_t* Rdn; bf16_t* O;
    __device__ __forceinline__ void mid(f32x4 (&acc)[2][2][4][2], const pg8::Unit& u, int wr, int wc, int fr, int fq) const {
        int row0 = u.pm * 256 + wr * 64 + fr, col0 = u.pn * 256 + wc * 32 + 8 * fq;
        asm volatile("" : "+v"(row0), "+v"(col0));
#pragma unroll
        for (int ai = 0; ai < 2; ++ai)
#pragma unroll
            for (int m = 0; m < 4; ++m) { const size_t row = (size_t)(row0 + ai * 128 + m * 16);
#pragma unroll
                for (int bj = 0; bj < 2; ++bj) { const u32x4 a = *(const u32x4*)(Rsb + row * NIN + col0 + bj * 128), d = *(const u32x4*)(Rdn + row * NIN + col0 + bj * 128);
                    const float ra[8] = {bf_lo(a.x), bf_hi(a.x), bf_lo(a.y), bf_hi(a.y), bf_lo(a.z), bf_hi(a.z), bf_lo(a.w), bf_hi(a.w)};
                    const float rd[8] = {bf_lo(d.x), bf_hi(d.x), bf_lo(d.y), bf_hi(d.y), bf_lo(d.z), bf_hi(d.z), bf_lo(d.w), bf_hi(d.w)};
#pragma unroll
                    for (int e = 0; e < 8; ++e) { const float q = (1.0f + fexp(-rd[e])) * __builtin_amdgcn_rcpf(1.0f + fexp(-ra[e])); acc[ai][bj][m][e >> 2][e & 3] *= q; }
                    asm volatile("" ::: "memory"); } }
    }
    __device__ __forceinline__ void operator()(AccRef acc, const pg8::Unit& u, int wr, int wc, int fr, int fq) const {
        const int row0 = u.pm * 256 + wr * 64 + fr, col0 = u.pn * 256 + wc * 32 + 8 * fq;
#pragma unroll
        for (int ai = 0; ai < 2; ++ai)
#pragma unroll
            for (int m = 0; m < 4; ++m) { const size_t row = (size_t)(row0 + ai * 128 + m * 16);
#pragma unroll
                for (int bj = 0; bj < 2; ++bj) { const u32x4 d = *(const u32x4*)(Rdn + row * NIN + col0 + bj * 128);
                    const f32x4 v0 = acc[ai][bj][m][0], v1 = acc[ai][bj][m][1];
                    const float r[8] = {fsigmoid(bf_lo(d.x)) * v0[0], fsigmoid(bf_hi(d.x)) * v0[1], fsigmoid(bf_lo(d.y)) * v0[2], fsigmoid(bf_hi(d.y)) * v0[3],
                                        fsigmoid(bf_lo(d.z)) * v1[0], fsigmoid(bf_hi(d.z)) * v1[1], fsigmoid(bf_lo(d.w)) * v1[2], fsigmoid(bf_hi(d.w)) * v1[3]};
                    u32x4 w; w.x = pk2(r[0], r[1]); w.y = pk2(r[2], r[3]); w.z = pk2(r[4], r[5]); w.w = pk2(r[6], r[7]);
                    *(u32x4*)(O + row * D + col0 + bj * 128) = w; } }
    }
};
template <class Epi> __device__ __forceinline__ void run_gemm(LAS unsigned char* lds, const bf16_t* A, int lda, const bf16_t* Bt, int N, int K, const Epi& E, int jt = 1 << 30, int jbytes = 0) {
    pg8::Gemm g{A, Bt, T, N, K, lda, jt, jbytes}; pg8::StaticOrder S; S.init(T, N, (int)gridDim.x, (int)blockIdx.x);
    pg8::gemm_phase<Epi>(lds, g, S, E);
}

__device__ __forceinline__ void transpose_item(const float* W, int ldw, int s0, int k0, bf16_t* WT, int ldk, int d0, LAS float* scr, int lane) {
    float tv[32];
#pragma unroll
    for (int i = 0; i < 32; ++i) tv[i] = W[(size_t)(k0 + 2 * i + (lane >> 5)) * ldw + s0 + (lane & 31)];
#pragma unroll
    for (int i = 0; i < 32; ++i) scr[(2 * i + (lane >> 5)) * 33 + (lane & 31)] = tv[i];
    LDS_WAIT();
    const int c = lane & 7;
#pragma unroll
    for (int j = 0; j < 4; ++j) { const int n = (lane >> 3) + 8 * j; const LAS float* s = scr + (8 * c) * 33 + n;
        u32x4 o; o.x = pk2(s[0 * 33], s[1 * 33]); o.y = pk2(s[2 * 33], s[3 * 33]); o.z = pk2(s[4 * 33], s[5 * 33]); o.w = pk2(s[6 * 33], s[7 * 33]);
        *(u32x4*)(WT + (size_t)(d0 + n) * ldk + k0 + 8 * c) = o; }
    LDS_WAIT();
}
__device__ __forceinline__ void ffn_weight_items(const float* w_in, const float* w_out, bf16_t* wt_in, bf16_t* wt_out, LAS float* scr, int gw, int ngw, int lane) {
    for (int it = gw; it < 2816 + 1408; it += ngw) {
        if (it < 2816) { const int kb = it / 176, nb = it % 176, d0 = nb * 32, pn = d0 >> 8, bj = (d0 >> 7) & 1, c = d0 & 127, s0 = bj * FF + pn * 128 + c;
            transpose_item(w_in, 2 * FF, s0, kb * 64, wt_in, D, d0, scr, lane); }
        else { const int r = it - 2816, kb = r / 32, nb = r % 32; transpose_item(w_out, D, nb * 32, kb * 64, wt_out, FF, nb * 32, scr, lane); }
    }
}
__device__ __forceinline__ void mixer_weight_items(const Params& p, LAS float* scr, int gw, int ngw, int lane) {
    unsigned char* ws = p.ws;
    for (int it = gw; it < 2816 + 256 + 256 + 512; it += ngw) {
        int r = it;
        if (r < 2816) { const int kb = r / 176, nb = r % 176, d0 = nb * 32, s0 = d0 < C_RSB ? d0 : d0 + 8; transpose_item(p.in[I_WIN], INW, s0, kb * 64, (bf16_t*)(ws + W_IN), D, d0, scr, lane); continue; } r -= 2816;
        if (r < 256) { const int kb = r / 32, nb = r % 32; transpose_item(p.in[I_WUPSB], D, nb * 32, kb * 64, (bf16_t*)(ws + W_UPSB), D, nb * 32, scr, lane); continue; } r -= 256;
        if (r < 256) { const int kb = r / 32, nb = r % 32; transpose_item(p.in[I_WUPDN], D, nb * 32, kb * 64, (bf16_t*)(ws + W_UPSB) + 512, D, nb * 32, scr, lane); continue; } r -= 256;
        { const int kb = r / 32, nb = r % 32; transpose_item(p.in[I_WOUT], D, nb * 32, kb * 64, (bf16_t*)(ws + W_OUT), D, nb * 32, scr, lane); }
    }
}
__device__ __forceinline__ void mod_item(const Params& p, LAS unsigned char* lds, int cb, int tid, int wave, int lane) {
    asm volatile("" : "+v"(tid), "+v"(lane));
    LAS float* sc = (LAS float*)lds; LAS float* red = (LAS float*)(lds + 32768);
    for (int i = tid; i < NB * D; i += 512) sc[i] = fsilu(p.in[I_C][i]);
    __syncthreads();
    const float* wa = p.in[I_WADA] + cb * 64 + lane;
    float acc[NB];
#pragma unroll
    for (int b = 0; b < NB; ++b) acc[b] = 0.f;
    for (int k = wave * 128; k < wave * 128 + 128; k += 16) {
        float w[16];
#pragma unroll
        for (int e = 0; e < 16; ++e) w[e] = wa[(size_t)(k + e) * NMOD];
#pragma unroll
        for (int b = 0; b < NB; ++b)
#pragma unroll
            for (int e4 = 0; e4 < 4; ++e4) { const f32x4 s = *(const LAS f32x4*)(sc + b * D + k + 4 * e4); acc[b] += s[0] * w[4 * e4] + s[1] * w[4 * e4 + 1] + s[2] * w[4 * e4 + 2] + s[3] * w[4 * e4 + 3]; }
    }
#pragma unroll
    for (int b = 0; b < NB; ++b) red[(wave * NB + b) * 64 + lane] = acc[b];
    __syncthreads();
    { const int b = tid >> 6; float s = p.in[I_BADA][cb * 64 + lane];
#pragma unroll
        for (int w = 0; w < 8; ++w) s += red[(w * NB + b) * 64 + lane];
        ((float*)(p.ws + WS_MOD))[b * NMOD + cb * 64 + lane] = s; }
    __syncthreads();
}

template <bool DN>
__device__ __forceinline__ void norm_mod_phase(const Params& p, LAS unsigned char* lds, const float* src, const float* gain, int midx, bf16_t* dst, int tid, int wave, int lane) {
    asm volatile("" : "+v"(tid), "+v"(lane));
    const float* mod = (const float*)(p.ws + WS_MOD);
    LAS float* wl = (LAS float*)lds;
    if (DN) { for (int i = tid; i < D * 8; i += 512) { const int k = i >> 3, j = i & 7; wl[8 * k + 4 * (k >> 2) + j] = p.in[I_WIN][(size_t)k * INW + C_RSB + j]; } __syncthreads(); }
    f32x4 g4[4];
#pragma unroll
    for (int j = 0; j < 4; ++j) g4[j] = ((const f32x4*)gain)[lane + 64 * j];
    for (int row = blockIdx.x * 8 + wave; row < T; row += gridDim.x * 8) {
        const int b = row >> 11;
        const f32x4* xr = (const f32x4*)(src + (size_t)row * D) + lane;
        const f32x4* shp = (const f32x4*)(mod + (size_t)b * NMOD + midx * D) + lane; const f32x4* scp = shp + D / 4;
        f32x4 v[4]; float ss = 0.f;
#pragma unroll
        for (int j = 0; j < 4; ++j) { v[j] = xr[64 * j]; ss += (v[j][0] * v[j][0] + v[j][1] * v[j][1]) + (v[j][2] * v[j][2] + v[j][3] * v[j][3]); }
        const float rstd = 1.0f / sqrtf(wave_sum(ss) * (1.f / D) + EPS);
        u32x2* o8 = (u32x2*)(dst + (size_t)row * D) + lane;
        float dot[8];
        if (DN) {
#pragma unroll
            for (int e = 0; e < 8; ++e) dot[e] = 0.f; }
#pragma unroll
        for (int j = 0; j < 4; ++j) { const f32x4 sh = shp[64 * j], sc = scp[64 * j];
            const f32x4 uu = v[j] * rstd * g4[j] * (sc + 1.0f) + sh;
            u32x2 w; w.x = pk2(uu[0], uu[1]); w.y = pk2(uu[2], uu[3]); o8[64 * j] = w;
            if (DN) {
#pragma unroll
                for (int e = 0; e < 4; ++e) { const int k = 4 * lane + 256 * j + e; const LAS f32x4* wp = (const LAS f32x4*)(wl + 8 * k + 4 * (k >> 2)); const f32x4 w0 = wp[0], w1 = wp[1];
                    dot[0] += uu[e] * w0[0]; dot[1] += uu[e] * w0[1]; dot[2] += uu[e] * w0[2]; dot[3] += uu[e] * w0[3];
                    dot[4] += uu[e] * w1[0]; dot[5] += uu[e] * w1[1]; dot[6] += uu[e] * w1[2]; dot[7] += uu[e] * w1[3]; } } }
        if (DN) {
#pragma unroll
            for (int e = 0; e < 8; ++e) dot[e] = wave_sum(dot[e]);
            float mine = dot[0];
#pragma unroll
            for (int e = 1; e < 8; ++e) mine = (lane == e) ? dot[e] : mine;
            if (lane < 8) { float r;
                if (lane < 4) r = 1.0f / (1.0f + expf(-mine));
                else { const int hh = lane - 4; const float a = mine + p.in[I_DTBIAS][hh]; const float sp = a > 20.f ? a : log1pf(expf(a)); r = -expf(p.in[I_ALOG][hh]) * sp; }
                ((float*)(p.ws + WS_BG))[(size_t)row * 8 + lane] = r; } }
    }
    if (DN) __syncthreads();
}

__device__ __forceinline__ void unpack16(const bf16_t* p, float* f) {
    const u32x4 a = ((const u32x4*)p)[0], b = ((const u32x4*)p)[1];
    f[0] = bf_lo(a.x); f[1] = bf_hi(a.x); f[2] = bf_lo(a.y); f[3] = bf_hi(a.y); f[4] = bf_lo(a.z); f[5] = bf_hi(a.z); f[6] = bf_lo(a.w); f[7] = bf_hi(a.w);
    f[8] = bf_lo(b.x); f[9] = bf_hi(b.x); f[10] = bf_lo(b.y); f[11] = bf_hi(b.y); f[12] = bf_lo(b.z); f[13] = bf_hi(b.z); f[14] = bf_lo(b.w); f[15] = bf_hi(b.w);
}
__device__ __forceinline__ void pack16(bf16_t* p, const float* f) {
    u32x4 a, b; a.x = pk2(f[0], f[1]); a.y = pk2(f[2], f[3]); a.z = pk2(f[4], f[5]); a.w = pk2(f[6], f[7]); b.x = pk2(f[8], f[9]); b.y = pk2(f[10], f[11]); b.z = pk2(f[12], f[13]); b.w = pk2(f[14], f[15]);
    ((u32x4*)p)[0] = a; ((u32x4*)p)[1] = b;
}
__device__ __forceinline__ void prep_phase(const Params& p, int wave, int lane) {
    asm volatile("" : "+v"(lane));
    bf16_t* P = (bf16_t*)(p.ws + WS_P); bf16_t* U = (bf16_t*)(p.ws + WS_U);
    const int ch = 16 * lane;
    float gsb[16], wcv[4][16];
    { const float* gp = (ch < 512 ? p.in[I_GQSB] : p.in[I_GKSB]) + (ch & 63); const float sc = ch < 512 ? 0.18033688011112042f : 1.0f;
#pragma unroll
        for (int e = 0; e < 16; ++e) gsb[e] = gp[e] * sc;
#pragma unroll
        for (int i = 0; i < 4; ++i)
#pragma unroll
            for (int e = 0; e < 16; ++e) wcv[i][e] = p.in[I_WCONV][i * 1536 + ch + e]; }
    for (int row = blockIdx.x * 8 + wave; row < T; row += gridDim.x * 8) {
        const int tl = row & (SEQ - 1);
        { bf16_t* qp = P + (size_t)row * NIN + ch; float f[16]; unpack16(qp, f); float ss = 0.f;
#pragma unroll
            for (int e = 0; e < 16; ++e) ss += f[e] * f[e];
            ss += __shfl_xor(ss, 1); ss += __shfl_xor(ss, 2);
            const float rstd = 1.0f / sqrtf(ss * (1.f / 64.f) + EPS);
#pragma unroll
            for (int e = 0; e < 16; ++e) f[e] = f[e] * rstd * gsb[e];
            pack16(qp, f); }
        { float y[16];
#pragma unroll
            for (int e = 0; e < 16; ++e) y[e] = 0.f;
#pragma unroll
            for (int i = 0; i < 4; ++i) { if (tl - 3 + i >= 0) { float f[16]; unpack16(P + (size_t)(row - 3 + i) * NIN + C_QDN + ch, f);
#pragma unroll
                    for (int e = 0; e < 16; ++e) y[e] += wcv[i][e] * f[e]; } }
            float ss = 0.f;
#pragma unroll
            for (int e = 0; e < 16; ++e) { y[e] = fsilu(y[e]); ss += y[e] * y[e]; }
            ss += __shfl_xor(ss, 1); ss += __shfl_xor(ss, 2); ss += __shfl_xor(ss, 4);
            const float sc = (1.0f / sqrtf(ss + EPS)) * (ch < 512 ? 0.08838834764831845f : 1.0f);
#pragma unroll
            for (int e = 0; e < 16; ++e) y[e] *= sc;
            pack16(U + (size_t)row * D + ch, y); }
    }
    bf16_t* Vt = (bf16_t*)(p.ws + WS_VT);
    for (int it = blockIdx.x * 8 + wave; it < T / 16; it += gridDim.x * 8) {
        const int row0 = it * 16, b = row0 >> 11, tl0 = row0 & (SEQ - 1), c8 = lane * 8, hd = c8 >> 6, d0 = c8 & 63;
        u32x4 w[16];
#pragma unroll
        for (int r = 0; r < 16; ++r) w[r] = *(const u32x4*)(P + (size_t)(row0 + r) * NIN + C_VSB + c8);
#pragma unroll
        for (int e = 0; e < 8; ++e) {
            unsigned o[8];
#pragma unroll
            for (int i = 0; i < 8; ++i) {
                const int p0 = 2 * i, p1 = 2 * i + 1;
                const int k0 = 8 * ((p0 >> 2) & 1) + 4 * (p0 >> 3) + (p0 & 3), k1 = 8 * ((p1 >> 2) & 1) + 4 * (p1 >> 3) + (p1 & 3);
                const unsigned a0 = w[k0][e >> 1], a1 = w[k1][e >> 1];
                const unsigned lo = (e & 1) ? (a0 >> 16) : (a0 & 0xffffu), hi = (e & 1) ? (a1 & 0xffff0000u) : (a1 << 16);
                o[i] = lo | hi; }
            bf16_t* dst = Vt + ((size_t)(b * 8 + hd) * 64 + d0 + e) * SEQ + tl0;
            ((u32x4*)dst)[0] = (u32x4){o[0], o[1], o[2], o[3]}; ((u32x4*)dst)[1] = (u32x4){o[4], o[5], o[6], o[7]}; }
    }
}

__device__ __forceinline__ float xlane32(float x, int hh) {
    const unsigned xi = __builtin_bit_cast(unsigned, x);
    const u32x2 r = __builtin_amdgcn_permlane32_swap(xi, xi, false, false);
    return __builtin_bit_cast(float, hh ? r.x : r.y);
}
template <bool DIAG>
__device__ __forceinline__ void attn_tile(const f32x16& z, const bf16x8 (&vc)[4], f32x16& o0, f32x16& o1, float& R, int ql, int hh) {
    float sg[16], m[16];
#pragma unroll
    for (int i = 0; i < 16; ++i) { const float e = __builtin_amdgcn_exp2f(fminf(-z[i], 80.0f)); float sig = __builtin_amdgcn_rcpf(1.0f + e); float mm = e * sig;
        if (DIAG) { const bool act = ((i & 3) + 8 * (i >> 2) + 4 * hh) < ql; sig = act ? sig : 0.f; mm = act ? mm : 1.0f; }
        sg[i] = sig; m[i] = mm; }
    float g[4], gp[4];
#pragma unroll
    for (int bq = 0; bq < 4; ++bq) { g[bq] = (m[4 * bq] * m[4 * bq + 1]) * (m[4 * bq + 2] * m[4 * bq + 3]); gp[bq] = xlane32(g[bq], hh); }
    float outer[4]; float tb = R;
#pragma unroll
    for (int bq = 3; bq >= 0; --bq) { outer[bq] = hh == 0 ? tb * gp[bq] : tb; tb *= g[bq] * gp[bq]; }
    R = tb;
    float w[16];
#pragma unroll
    for (int bq = 0; bq < 4; ++bq) { const float s3 = outer[bq], s2 = s3 * m[4 * bq + 3], s1 = s2 * m[4 * bq + 2], s0 = s1 * m[4 * bq + 1];
        w[4 * bq + 3] = sg[4 * bq + 3] * s3; w[4 * bq + 2] = sg[4 * bq + 2] * s2; w[4 * bq + 1] = sg[4 * bq + 1] * s1; w[4 * bq] = sg[4 * bq] * s0; }
    bf16x8 wf[2];
#pragma unroll
    for (int s2 = 0; s2 < 2; ++s2) { const u32x4 pw = {cpk2(w[8 * s2], w[8 * s2 + 1]), cpk2(w[8 * s2 + 2], w[8 * s2 + 3]), cpk2(w[8 * s2 + 4], w[8 * s2 + 5]), cpk2(w[8 * s2 + 6], w[8 * s2 + 7])}; wf[s2] = __builtin_bit_cast(bf16x8, pw); }
    o0 = __builtin_amdgcn_mfma_f32_32x32x16_bf16(vc[0], wf[0], o0, 0, 0, 0); o0 = __builtin_amdgcn_mfma_f32_32x32x16_bf16(vc[1], wf[1], o0, 0, 0, 0);
    o1 = __builtin_amdgcn_mfma_f32_32x32x16_bf16(vc[2], wf[0], o1, 0, 0, 0); o1 = __builtin_amdgcn_mfma_f32_32x32x16_bf16(vc[3], wf[1], o1, 0, 0, 0);
}
__device__ __forceinline__ void attn_item_mfma(bf16_t* P, const bf16_t* Vt, int bh, int qt, int lane) {
    asm volatile("" : "+v"(lane));
    const int b = bh >> 3, h = bh & 7, ql = lane & 31, hh = lane >> 5, q0 = qt * 32;
    bf16_t* qrow = P + (size_t)(b * SEQ + q0 + ql) * NIN + C_QSB + h * 64;
    bf16x8 qf[4];
#pragma unroll
    for (int s = 0; s < 4; ++s) qf[s] = *(const bf16x8*)(qrow + 16 * s + 8 * hh);
    f32x16 o0, o1;
#pragma unroll
    for (int i = 0; i < 16; ++i) { o0[i] = 0.f; o1[i] = 0.f; }
    float R = 1.0f;
    const bf16_t* kb = P + (size_t)(b * SEQ + ql) * NIN + C_KSB + h * 64 + 8 * hh;
    const bf16_t* vb = Vt + ((size_t)bh * 64 + ql) * SEQ + 8 * hh;
    bf16x8 kf[4], vf[4], vn[4];
#define AT_LOADK(k0_) do { _Pragma("unroll") for (int s = 0; s < 4; ++s) kf[s] = *(const bf16x8*)(kb + (size_t)(k0_) * NIN + 16 * s); } while (0)
#define AT_LOADV(dst, k0_) do { _Pragma("unroll") for (int j = 0; j < 4; ++j) dst[j] = *(const bf16x8*)(vb + (size_t)(j >> 1) * 32 * SEQ + (k0_) + 16 * (j & 1)); } while (0)
#define AT_QK(zz) do { _Pragma("unroll") for (int i = 0; i < 16; ++i) zz[i] = 0.f; _Pragma("unroll") for (int s = 0; s < 4; ++s) zz = __builtin_amdgcn_mfma_f32_32x32x16_bf16(kf[s], qf[s], zz, 0, 0, 0); } while (0)
    f32x16 zc, zn;
    AT_LOADK(q0); AT_LOADV(vf, q0);
    AT_QK(zc);
    { const int k1 = (qt > 0 ? qt - 1 : 0) * 32; AT_LOADK(k1); AT_LOADV(vn, k1); }
    { AT_QK(zn);
      const int k2 = (qt > 1 ? qt - 2 : 0) * 32; AT_LOADK(k2);
      attn_tile<true>(zc, vf, o0, o1, R, ql, hh);
      zc = zn;
#pragma unroll
      for (int j = 0; j < 4; ++j) vf[j] = vn[j];
      const int k1 = (qt > 1 ? qt - 2 : 0) * 32; AT_LOADV(vn, k1); }
#pragma unroll 1
    for (int kt = qt - 1; kt >= 0; --kt) {
        AT_QK(zn);
        const int k2 = (kt > 1 ? kt - 2 : 0) * 32; AT_LOADK(k2);
        attn_tile<false>(zc, vf, o0, o1, R, ql, hh);
        if (__builtin_amdgcn_ballot_w64(R != 0.0f) == 0ull) break;
        zc = zn;
#pragma unroll
        for (int j = 0; j < 4; ++j) vf[j] = vn[j];
        AT_LOADV(vn, k2);
    }
#undef AT_LOADK
#undef AT_LOADV
#undef AT_QK
#pragma unroll
    for (int bq = 0; bq < 4; ++bq) {
        u32x2 w0 = {cpk2(o0[4 * bq], o0[4 * bq + 1]), cpk2(o0[4 * bq + 2], o0[4 * bq + 3])}, w1 = {cpk2(o1[4 * bq], o1[4 * bq + 1]), cpk2(o1[4 * bq + 2], o1[4 * bq + 3])};
        *(u32x2*)(qrow + 8 * bq + 4 * hh) = w0; *(u32x2*)(qrow + 32 + 8 * bq + 4 * hh) = w1; }
}
__device__ __forceinline__ size_t slotU(size_t t0, int h, int colbase, int f) { return (t0 + (size_t)(f >> 7)) * D + colbase + h * 128 + (f & 127); }
__device__ __forceinline__ size_t slotP(size_t t0, int h, int colbase, int f) { return (t0 + (size_t)(f >> 7)) * NIN + colbase + h * 128 + (f & 127); }
__device__ __forceinline__ int permpos(int x) { const int k = x & 15; return (x & ~15) + 8 * ((k >> 2) & 1) + 4 * (k >> 3) + (k & 3); }
__device__ __forceinline__ int crow(int r, int hh) { return (r & 3) + 8 * (r >> 2) + 4 * hh; }
__device__ __forceinline__ bf16x8 pack8(const f32x16& x, int s2) {
    const u32x4 pw = {cpk2(x[8 * s2], x[8 * s2 + 1]), cpk2(x[8 * s2 + 2], x[8 * s2 + 3]), cpk2(x[8 * s2 + 4], x[8 * s2 + 5]), cpk2(x[8 * s2 + 6], x[8 * s2 + 7])};
    return __builtin_bit_cast(bf16x8, pw);
}
#define MFMA32(a, b, c) __builtin_amdgcn_mfma_f32_32x32x16_bf16((a), (b), (c), 0, 0, 0)
constexpr int PT = 72, PQ = 136, PL = 68, PB = 40;
constexpr int CP_GC = 0, CP_BT = 256, CP_LS = 1024, CP_TU = CP_LS + 64 * PL * 4, CP_TW = CP_TU + 64 * PT * 2, CP_KT = CP_TW + 64 * PT * 2, CP_VT = CP_KT + 128 * PT * 2,
              CP_QS = CP_VT + 128 * PT * 2, CP_KS = CP_QS + 64 * PQ * 2, CP_AQ = CP_KS + 64 * PQ * 2, CP_L21 = CP_AQ + 64 * PT * 2, CP_TCM = CP_L21 + 32 * PB * 2, CP_T22 = CP_TCM + 32 * PB * 2, CP_END = CP_T22 + 32 * PB * 2;
static_assert(CP_END <= 131072, "chunk prep LDS");
__device__ __forceinline__ void gdn_chunk_prep(const Params& p, LAS unsigned char* lds, int item, int tid, int wave, int lane) {
    asm volatile("" : "+v"(tid), "+v"(lane));
    const int bh = item >> 5, n = item & 31, b = bh >> 2, h = bh & 3, ql = lane & 31, hh = lane >> 5;
    const size_t t0 = (size_t)b * SEQ + n * 64;
    bf16_t* P = (bf16_t*)(p.ws + WS_P); bf16_t* U = (bf16_t*)(p.ws + WS_U); const float* BG = (const float*)(p.ws + WS_BG);
    LAS float* gcS = (LAS float*)(lds + CP_GC); LAS float* btS = (LAS float*)(lds + CP_BT);
    LAS float* LS = (LAS float*)(lds + CP_LS);
    LAS bf16_t* TuS = (LAS bf16_t*)(lds + CP_TU); LAS bf16_t* TwS = (LAS bf16_t*)(lds + CP_TW);
    LAS bf16_t* kT = (LAS bf16_t*)(lds + CP_KT); LAS bf16_t* vT = (LAS bf16_t*)(lds + CP_VT); LAS bf16_t* qS = (LAS bf16_t*)(lds + CP_QS); LAS bf16_t* kS = (LAS bf16_t*)(lds + CP_KS);
    LAS bf16_t* AQ = (LAS bf16_t*)(lds + CP_AQ); LAS bf16_t* L21b = (LAS bf16_t*)(lds + CP_L21); LAS bf16_t* Tcm = (LAS bf16_t*)(lds + CP_TCM); LAS bf16_t* T22r = (LAS bf16_t*)(lds + CP_T22);
    if (tid < 64) { float x = BG[(t0 + tid) * 8 + 4 + h];
#pragma unroll
        for (int o = 1; o < 64; o <<= 1) { const float y = __shfl_up(x, o); if (lane >= o) x += y; }
        gcS[tid] = x; btS[tid] = BG[(t0 + tid) * 8 + h]; }
    { const int tok = tid >> 3, c16 = (tid & 7) * 16;
        const u32x4 ka = *(const u32x4*)(U + (t0 + tok) * D + 512 + h * 128 + c16), kb = *(const u32x4*)(U + (t0 + tok) * D + 512 + h * 128 + c16 + 8);
        const u32x4 qa = *(const u32x4*)(U + (t0 + tok) * D + h * 128 + c16), qb = *(const u32x4*)(U + (t0 + tok) * D + h * 128 + c16 + 8);
        u32x4 xv[4][2];
#pragma unroll
        for (int i = 0; i < 4; ++i) { const bool ok = n * 64 + tok - 3 + i >= 0; const bf16_t* vp = P + (t0 + tok - 3 + i) * NIN + C_VDN + h * 128 + c16;
            xv[i][0] = ok ? *(const u32x4*)vp : (u32x4){0u, 0u, 0u, 0u}; xv[i][1] = ok ? *(const u32x4*)(vp + 8) : (u32x4){0u, 0u, 0u, 0u}; }
        *(LAS u32x4*)(kS + tok * PQ + c16) = ka; *(LAS u32x4*)(kS + tok * PQ + c16 + 8) = kb;
        *(LAS u32x4*)(qS + tok * PQ + c16) = qa; *(LAS u32x4*)(qS + tok * PQ + c16 + 8) = qb;
        const unsigned kw[8] = {ka.x, ka.y, ka.z, ka.w, kb.x, kb.y, kb.z, kb.w};
#pragma unroll
        for (int e = 0; e < 8; ++e) { kT[(c16 + 2 * e) * PT + tok] = (bf16_t)(kw[e] & 0xffffu); kT[(c16 + 2 * e + 1) * PT + tok] = (bf16_t)(kw[e] >> 16); }
        float y[16];
#pragma unroll
        for (int e = 0; e < 16; ++e) y[e] = 0.f;
#pragma unroll
        for (int i = 0; i < 4; ++i) { const float* wp = p.in[I_WCONV] + i * 1536 + 1024 + h * 128 + c16;
            const unsigned xw[8] = {xv[i][0].x, xv[i][0].y, xv[i][0].z, xv[i][0].w, xv[i][1].x, xv[i][1].y, xv[i][1].z, xv[i][1].w};
#pragma unroll
            for (int e = 0; e < 8; ++e) { y[2 * e] += wp[2 * e] * bf_lo(xw[e]); y[2 * e + 1] += wp[2 * e + 1] * bf_hi(xw[e]); } }
#pragma unroll
        for (int e = 0; e < 16; ++e) vT[(c16 + e) * PT + tok] = f2bf(fsilu(y[e])); }
    __syncthreads();
    if (wave == 0) {
        bf16x8 kf[2][8];
#pragma unroll
        for (int t = 0; t < 2; ++t)
#pragma unroll
            for (int ks = 0; ks < 8; ++ks) kf[t][ks] = *(const LAS bf16x8*)(kS + (32 * t + ql) * PQ + 16 * ks + 8 * hh);
#pragma unroll
        for (int tt = 0; tt < 3; ++tt) { const int it = tt == 0 ? 0 : 1, jt = tt == 2 ? 1 : 0;
            f32x16 acc;
#pragma unroll
            for (int r = 0; r < 16; ++r) acc[r] = 0.f;
#pragma unroll
            for (int ks = 0; ks < 8; ++ks) acc = MFMA32(kf[it][ks], kf[jt][ks], acc);
            const int j = 32 * jt + ql; const float gj = gcS[j];
#pragma unroll
            for (int r = 0; r < 16; ++r) { const int i = 32 * it + crow(r, hh); const float l = (j < i) ? btS[i] * acc[r] * fexp(gcS[i] - gj) : 0.f;
                if (it != jt) L21b[(i - 32) * PB + j] = f2bf(l); else LS[i * PL + j] = l; } }
    } else if (wave < 4) {
        const int jt = wave == 3 ? 1 : 0, it = wave == 1 ? 0 : 1;
        f32x16 acc;
#pragma unroll
        for (int r = 0; r < 16; ++r) acc[r] = 0.f;
#pragma unroll
        for (int ks = 0; ks < 8; ++ks) acc = MFMA32(*(const LAS bf16x8*)(kS + (32 * jt + ql) * PQ + 16 * ks + 8 * hh), *(const LAS bf16x8*)(qS + (32 * it + ql) * PQ + 16 * ks + 8 * hh), acc);
        const int i = 32 * it + ql; const float gi = gcS[i];
#pragma unroll
        for (int r = 0; r < 16; ++r) { const int j = 32 * jt + crow(r, hh); acc[r] = (j <= i) ? acc[r] * fexp(gi - gcS[j]) : 0.f; }
#pragma unroll
        for (int bq = 0; bq < 4; ++bq) *(LAS u32x2*)(AQ + i * PT + 32 * jt + 8 * bq + 4 * hh) = (u32x2){cpk2(acc[4 * bq], acc[4 * bq + 1]), cpk2(acc[4 * bq + 2], acc[4 * bq + 3])};
    } else {
        const float gl = gcS[63];
#pragma unroll
        for (int uu = 0; uu < 2; ++uu) { const int unit = (tid - 256) + 256 * uu, dk = unit >> 2, blk = unit & 3;
            const u32x4 k0 = *(const LAS u32x4*)(kT + dk * PT + 16 * blk), k1 = *(const LAS u32x4*)(kT + dk * PT + 16 * blk + 8);
            float kv[16] = {bf_lo(k0.x), bf_hi(k0.x), bf_lo(k0.y), bf_hi(k0.y), bf_lo(k0.z), bf_hi(k0.z), bf_lo(k0.w), bf_hi(k0.w), bf_lo(k1.x), bf_hi(k1.x), bf_lo(k1.y), bf_hi(k1.y), bf_lo(k1.z), bf_hi(k1.z), bf_lo(k1.w), bf_hi(k1.w)};
#pragma unroll
            for (int e = 0; e < 16; ++e) kv[e] *= fexp(gl - gcS[16 * blk + e]);
            float pv[16];
#pragma unroll
            for (int e = 0; e < 16; ++e) pv[permpos(e)] = kv[e];
            pack16(P + slotP(t0, h, C_VSB, dk * 64 + 16 * blk), pv); }
        if (tid == 256) ((float*)(p.ws + WS_EGL))[bh * 32 + n] = fexp(gl);
    }
    __syncthreads();
    if (wave == 0) {
        const LAS float* LB = LS + (32 * hh) * PL + 32 * hh;
        float Tc[32];
#pragma unroll
        for (int i = 0; i < 32; ++i) {
            float a0 = (ql == i) ? 1.0f : 0.f, a1 = 0.f, a2 = 0.f, a3 = 0.f;
#pragma unroll
            for (int j4 = 0; j4 < i; j4 += 4) { const f32x4 l4 = *(const LAS f32x4*)(LB + i * PL + j4);
                a0 -= l4[0] * Tc[j4]; if (j4 + 1 < i) a1 -= l4[1] * Tc[j4 + 1]; if (j4 + 2 < i) a2 -= l4[2] * Tc[j4 + 2]; if (j4 + 3 < i) a3 -= l4[3] * Tc[j4 + 3]; }
            Tc[i] = (a0 + a1) + (a2 + a3); }
        const int cg_ = 32 * hh + ql; const float bu = btS[cg_], bw = bu * fexp(gcS[cg_]);
#pragma unroll
        for (int i = 0; i < 32; ++i) { TuS[(32 * hh + i) * PT + cg_] = f2bf(Tc[i] * bu); TwS[(32 * hh + i) * PT + cg_] = f2bf(Tc[i] * bw); }
        if (hh == 0) {
#pragma unroll
            for (int i8 = 0; i8 < 4; ++i8) *(LAS u32x4*)(Tcm + ql * PB + 8 * i8) = (u32x4){cpk2(Tc[8 * i8], Tc[8 * i8 + 1]), cpk2(Tc[8 * i8 + 2], Tc[8 * i8 + 3]), cpk2(Tc[8 * i8 + 4], Tc[8 * i8 + 5]), cpk2(Tc[8 * i8 + 6], Tc[8 * i8 + 7])};
        } else {
#pragma unroll
            for (int i = 0; i < 32; ++i) T22r[i * PB + ql] = f2bf(Tc[i]);
        }
        LDS_WAIT();
        f32x16 x1;
#pragma unroll
        for (int r = 0; r < 16; ++r) x1[r] = 0.f;
#pragma unroll
        for (int s2 = 0; s2 < 2; ++s2) x1 = MFMA32(*(const LAS bf16x8*)(L21b + ql * PB + 16 * s2 + 8 * hh), *(const LAS bf16x8*)(Tcm + ql * PB + 16 * s2 + 8 * hh), x1);
        f32x16 yy;
#pragma unroll
        for (int r = 0; r < 16; ++r) yy[r] = 0.f;
#pragma unroll
        for (int s2 = 0; s2 < 2; ++s2) { const u32x2 lo = *(const LAS u32x2*)(T22r + ql * PB + 16 * s2 + 4 * hh), hi = *(const LAS u32x2*)(T22r + ql * PB + 16 * s2 + 8 + 4 * hh);
            const u32x4 af = {lo.x, lo.y, hi.x, hi.y};
            yy = MFMA32(__builtin_bit_cast(bf16x8, af), pack8(x1, s2), yy); }
        { const float bu0 = btS[ql], bw0 = bu0 * fexp(gcS[ql]);
#pragma unroll
            for (int r = 0; r < 16; ++r) { const int i2 = 32 + crow(r, hh); TuS[i2 * PT + ql] = f2bf(-yy[r] * bu0); TwS[i2 * PT + ql] = f2bf(-yy[r] * bw0); } }
    }
    __syncthreads();
    {
        const int isW = wave >> 2, ct = wave & 3, col = 32 * ct + ql;
        const LAS bf16_t* Ta = (isW ? TwS : TuS) + 8 * hh; const LAS bf16_t* Bs = (isW ? kT : vT) + col * PT + 8 * hh;
        bf16x8 bf[4];
#pragma unroll
        for (int ks = 0; ks < 4; ++ks) bf[ks] = *(const LAS bf16x8*)(Bs + 16 * ks);
        f32x16 xa[2];
#pragma unroll
        for (int jt = 0; jt < 2; ++jt) {
#pragma unroll
            for (int r = 0; r < 16; ++r) xa[jt][r] = 0.f;
#pragma unroll
            for (int ks = 0; ks < 4; ++ks) if (jt == 1 || ks < 2) xa[jt] = MFMA32(*(const LAS bf16x8*)(Ta + (32 * jt + ql) * PT + 16 * ks), bf[ks], xa[jt]); }
        bf16x8 xb[4] = {pack8(xa[0], 0), pack8(xa[0], 1), pack8(xa[1], 0), pack8(xa[1], 1)};
        f32x16 ra[2];
#pragma unroll
        for (int it = 0; it < 2; ++it) {
#pragma unroll
            for (int r = 0; r < 16; ++r) ra[it][r] = 0.f;
#pragma unroll
            for (int kk = 0; kk < 4; ++kk) if (it == 1 || kk < 2) { const LAS bf16_t* ap = AQ + (32 * it + ql) * PT + 16 * kk + 4 * hh;
                const u32x2 lo = *(const LAS u32x2*)ap, hi = *(const LAS u32x2*)(ap + 8); const u32x4 af = {lo.x, lo.y, hi.x, hi.y};
                ra[it] = MFMA32(__builtin_bit_cast(bf16x8, af), xb[kk], ra[it]); } }
        if (!isW) {
#pragma unroll
            for (int jt = 0; jt < 2; ++jt)
#pragma unroll
                for (int bq = 0; bq < 4; ++bq) { const int f = col * 64 + 32 * jt + 8 * bq + 4 * hh;
                    *(u32x2*)(U + slotU(t0, h, 0, f)) = (u32x2){cpk2(xa[jt][4 * bq], xa[jt][4 * bq + 1]), cpk2(xa[jt][4 * bq + 2], xa[jt][4 * bq + 3])};
                    *(u32x2*)(U + slotU(t0, h, 512, f)) = (u32x2){cpk2(ra[jt][4 * bq], ra[jt][4 * bq + 1]), cpk2(ra[jt][4 * bq + 2], ra[jt][4 * bq + 3])}; }
        } else {
            const int pc = permpos(col);
#pragma unroll
            for (int jt = 0; jt < 2; ++jt)
#pragma unroll
                for (int r = 0; r < 16; ++r) { const int tok = 32 * jt + crow(r, hh);
                    P[(t0 + tok) * NIN + C_QDN + h * 128 + pc] = f2bf(-xa[jt][r]);
                    P[(t0 + tok) * NIN + C_KDN + h * 128 + pc] = f2bf(bf2f(qS[tok * PQ + col]) * fexp(gcS[tok]) - ra[jt][r]); }
        }
    }
    __syncthreads();
}
constexpr int SC_PW = 136, SC_PK = 72, SC_NW = 0, SC_Q2 = 64 * SC_PW * 2, SC_KD = 2 * 64 * SC_PW * 2, SC_STAGE = 2 * 64 * SC_PW * 2 + 128 * SC_PK * 2, SC_OS = 2 * SC_STAGE,
              SC_US = SC_OS + 64 * SC_PW * 2, SC_OI = SC_US + 128 * SC_PK * 2, SC_END = SC_OI + 128 * SC_PK * 2;
static_assert(SC_END <= BST_OFF, "scan LDS");
__device__ __forceinline__ void gdn_scan_block(const Params& p, LAS unsigned char* lds, int bh, int tid, int wave, int lane) {
    asm volatile("" : "+v"(tid), "+v"(lane));
    bf16_t* P = (bf16_t*)(p.ws + WS_P); const bf16_t* U = (const bf16_t*)(p.ws + WS_U); const float* EGL = (const float*)(p.ws + WS_EGL);
    const int b = bh >> 2, h = bh & 3, ql = lane & 31, hh = lane >> 5;
    const size_t tb = (size_t)b * SEQ;
    LAS bf16_t* oS = (LAS bf16_t*)(lds + SC_OS);
    if (wave >= 4) {
        int lt = tid - 256, ftok = lt >> 2, fseg = lt & 3;
        u32x4 ra[20], rb[20];
#define SC_LOAD(r, n_) do { const size_t t0_ = tb + (size_t)(n_) * 64; _Pragma("unroll") for (int i = 0; i < 4; ++i) { const int c = lt + 256 * i, row = c >> 4, c8 = (c & 15) * 8; \
            const bf16_t* g_ = P + (t0_ + row) * NIN + h * 128 + c8; const bf16_t* u_ = U + (t0_ + row) * D + h * 128 + c8; \
            r[i] = *(const u32x4*)(g_ + C_QDN); r[4 + i] = *(const u32x4*)(g_ + C_KDN); r[8 + i] = *(const u32x4*)(g_ + C_VSB); r[12 + i] = *(const u32x4*)u_; r[16 + i] = *(const u32x4*)(u_ + 512); } } while (0)
#define SC_STORE(r, st_) do { LAS unsigned char* s_ = lds + (st_) * SC_STAGE; _Pragma("unroll") for (int i = 0; i < 4; ++i) { const int c = lt + 256 * i, row = c >> 4, c8 = (c & 15) * 8; \
            *(LAS u32x4*)(s_ + SC_NW + (row * SC_PW + c8) * 2) = r[i]; *(LAS u32x4*)(s_ + SC_Q2 + (row * SC_PW + c8) * 2) = r[4 + i]; \
            *(LAS u32x4*)(s_ + SC_KD + ((2 * row + (c8 >> 6)) * SC_PK + (c8 & 63)) * 2) = r[8 + i]; } } while (0)
#define SC_STOREU(r) do { _Pragma("unroll") for (int i = 0; i < 4; ++i) { const int c = lt + 256 * i, row = c >> 4, c8 = (c & 15) * 8; const int o_ = ((2 * row + (c8 >> 6)) * SC_PK + (c8 & 63)) * 2; \
            *(LAS u32x4*)(lds + SC_US + o_) = r[12 + i]; *(LAS u32x4*)(lds + SC_OI + o_) = r[16 + i]; } } while (0)
#define SC_FIN(m_) do { bf16_t* orow = P + (tb + (size_t)(m_) * 64 + ftok) * NIN + h * 128 + fseg * 32 + C_VDN; \
            _Pragma("unroll") for (int i = 0; i < 4; ++i) *(u32x4*)(orow + 8 * i) = *(const LAS u32x4*)(oS + ftok * SC_PW + fseg * 32 + 8 * i); } while (0)
        SC_LOAD(ra, 0); SC_STORE(ra, 0); SC_STOREU(ra); SC_LOAD(ra, 1);
        __syncthreads();
#pragma unroll 1
        for (int n = 0; n < 32; n += 2) {
            asm volatile("" : "+v"(lt), "+v"(ftok), "+v"(fseg));
            if (n + 2 < 32) SC_LOAD(rb, n + 2);
            SC_STORE(ra, 1);
            if (n > 0) SC_FIN(n - 1);
            __syncthreads();
            SC_STOREU(ra);
            __syncthreads();
            if (n + 3 < 32) SC_LOAD(ra, n + 3);
            if (n + 2 < 32) SC_STORE(rb, 0);
            SC_FIN(n);
            __syncthreads();
            if (n + 2 < 32) SC_STOREU(rb);
            __syncthreads();
        }
        SC_FIN(31);
#undef SC_LOAD
#undef SC_STORE
#undef SC_STOREU
#undef SC_FIN
    } else {
        const int col = 32 * wave + ql;
        f32x16 S[4];
#pragma unroll
        for (int rt = 0; rt < 4; ++rt)
#pragma unroll
            for (int r = 0; r < 16; ++r) S[rt][r] = 0.f;
        const float eglv = EGL[bh * 32 + ql];
        __syncthreads();
#pragma unroll 1
        for (int n = 0; n < 32; ++n) {
            const float egl = __builtin_bit_cast(float, __builtin_amdgcn_readlane(__builtin_bit_cast(int, eglv), n));
            const LAS unsigned char* st = lds + (n & 1) * SC_STAGE;
            f32x16 vn[2], oa[2];
            { const LAS unsigned char* up_ = lds + SC_US + (col * SC_PK + 4 * hh) * 2; const LAS unsigned char* op_ = lds + SC_OI + (col * SC_PK + 4 * hh) * 2;
#pragma unroll
              for (int jt = 0; jt < 2; ++jt)
#pragma unroll
                for (int bq = 0; bq < 4; ++bq) { const u32x2 uw = *(const LAS u32x2*)(up_ + (32 * jt + 8 * bq) * 2), ow = *(const LAS u32x2*)(op_ + (32 * jt + 8 * bq) * 2);
                    vn[jt][4 * bq] = bf_lo(uw.x); vn[jt][4 * bq + 1] = bf_hi(uw.x); vn[jt][4 * bq + 2] = bf_lo(uw.y); vn[jt][4 * bq + 3] = bf_hi(uw.y);
                    oa[jt][4 * bq] = bf_lo(ow.x); oa[jt][4 * bq + 1] = bf_hi(ow.x); oa[jt][4 * bq + 2] = bf_lo(ow.y); oa[jt][4 * bq + 3] = bf_hi(ow.y); } }
            const LAS unsigned char* w0_ = st + (ql * SC_PW + 8 * hh) * 2; const LAS unsigned char* w1_ = w0_ + 32 * SC_PW * 2;
            const LAS unsigned char* kd_ = st + SC_KD + (ql * SC_PK + 8 * hh) * 2;
            bf16x8 fa[4], fb[4];
#define SC_RD4(dst, ptr) do { _Pragma("unroll") for (int i_ = 0; i_ < 4; ++i_) dst[i_] = *(const LAS bf16x8*)((ptr) + 32 * i_); } while (0)
#define SC_MM4(acc, fr, bb) do { _Pragma("unroll") for (int i_ = 0; i_ < 4; ++i_) acc = MFMA32(fr[i_], bb[i_], acc); __builtin_amdgcn_sched_barrier(0); } while (0)
            SC_RD4(fa, w0_ + SC_NW); SC_RD4(fb, w1_ + SC_NW);
            { bf16x8 sb[4] = {pack8(S[0], 0), pack8(S[0], 1), pack8(S[1], 0), pack8(S[1], 1)};
              SC_MM4(vn[0], fa, sb); SC_RD4(fa, w0_ + SC_Q2);
              SC_MM4(vn[1], fb, sb); SC_RD4(fb, w1_ + SC_Q2);
              SC_MM4(oa[0], fa, sb); SC_RD4(fa, w0_ + SC_NW + 128);
              SC_MM4(oa[1], fb, sb); SC_RD4(fb, w1_ + SC_NW + 128); }
            { bf16x8 sb[4] = {pack8(S[2], 0), pack8(S[2], 1), pack8(S[3], 0), pack8(S[3], 1)};
              SC_MM4(vn[0], fa, sb); SC_RD4(fa, w0_ + SC_Q2 + 128);
              SC_MM4(vn[1], fb, sb); SC_RD4(fb, w1_ + SC_Q2 + 128);
              bf16x8 vb[4] = {pack8(vn[0], 0), pack8(vn[0], 1), pack8(vn[1], 0), pack8(vn[1], 1)};
              SC_MM4(oa[0], fa, sb); SC_RD4(fa, kd_);
              SC_MM4(oa[1], fb, sb); SC_RD4(fb, kd_ + 32 * SC_PK * 2);
#pragma unroll
              for (int rt = 0; rt < 4; ++rt)
#pragma unroll
                  for (int r = 0; r < 16; ++r) S[rt][r] *= egl;
              SC_MM4(S[0], fa, vb); SC_RD4(fa, kd_ + 64 * SC_PK * 2);
              SC_MM4(S[1], fb, vb); SC_RD4(fb, kd_ + 96 * SC_PK * 2);
              SC_MM4(S[2], fa, vb);
              SC_MM4(S[3], fb, vb); }
#undef SC_RD4
#undef SC_MM4
            __syncthreads();
#pragma unroll
            for (int jt = 0; jt < 2; ++jt)
#pragma unroll
                for (int r = 0; r < 16; ++r) oS[(32 * jt + crow(r, hh)) * SC_PW + col] = f2bf(oa[jt][r]);
            __syncthreads();
        }
    }
}
__device__ __forceinline__ void gdn_finalize_phase(const Params& p, int wave, int lane) {
    asm volatile("" : "+v"(lane));
    bf16_t* P = (bf16_t*)(p.ws + WS_P);
    const int c0 = (lane & 15) * 8;
    float gg[8];
#pragma unroll
    for (int e = 0; e < 8; ++e) gg[e] = p.in[I_GDNOUT][c0 + e];
    for (int row = blockIdx.x * 8 + wave; row < T; row += gridDim.x * 8) {
        bf16_t* op = P + (size_t)row * NIN + C_VDN + lane * 8; const bf16_t* zp = P + (size_t)row * NIN + C_ZDN + lane * 8;
        const u32x4 ow = *(const u32x4*)op, zw = *(const u32x4*)zp;
        const float o[8] = {bf_lo(ow.x), bf_hi(ow.x), bf_lo(ow.y), bf_hi(ow.y), bf_lo(ow.z), bf_hi(ow.z), bf_lo(ow.w), bf_hi(ow.w)};
        const float z[8] = {bf_lo(zw.x), bf_hi(zw.x), bf_lo(zw.y), bf_hi(zw.y), bf_lo(zw.z), bf_hi(zw.z), bf_lo(zw.w), bf_hi(zw.w)};
        float ss = 0.f;
#pragma unroll
        for (int e = 0; e < 8; ++e) ss += o[e] * o[e];
        ss += __shfl_xor(ss, 1); ss += __shfl_xor(ss, 2); ss += __shfl_xor(ss, 4); ss += __shfl_xor(ss, 8);
        const float rstd = 1.0f / sqrtf(ss * (1.f / 128.f) + EPS);
        float r[8];
#pragma unroll
        for (int e = 0; e < 8; ++e) r[e] = o[e] * rstd * gg[e] * fsilu(z[e]);
        u32x4 w; w.x = pk2(r[0], r[1]); w.y = pk2(r[2], r[3]); w.z = pk2(r[4], r[5]); w.w = pk2(r[6], r[7]);
        *(u32x4*)op = w;
    }
}

#define XB_TMO      128
#define XB_XCNT(j)  (256  + 64 * (j))
#define XB_XSUB(j)  (1280 + 64 * (j))
#define XB_XGEN(j)  (2304 + 64 * (j))
#define XB_TOP      3328
#define XB_TOPGEN   3392
#define XCD_BAR_WORDS 3456
#define XB_SPIN_CAP (1u << 18)
__device__ __forceinline__ unsigned xb_ld(unsigned* p)              { return __hip_atomic_load(p, __ATOMIC_RELAXED, __HIP_MEMORY_SCOPE_AGENT); }
__device__ __forceinline__ unsigned xb_add(unsigned* p, unsigned v) { return __hip_atomic_fetch_add(p, v, __ATOMIC_RELAXED, __HIP_MEMORY_SCOPE_AGENT); }
__device__ __forceinline__ unsigned xb_xcc_id() { return (unsigned)__builtin_amdgcn_s_getreg((3 << 11) | 20) & 0xFu; }
#define XB_SPIN(cond, bar) do { unsigned _sp = 0; while (cond) { __builtin_amdgcn_s_sleep(1); \
    if ((++_sp & 255u) == 0u) { if (xb_ld(&(bar)[XB_TMO])) break; if (_sp > XB_SPIN_CAP) { atomicAdd(&(bar)[XB_TMO], 1u); break; } } } } while (0)
struct XcdBarrier { unsigned* bar; unsigned x; volatile LAS unsigned* st; };
__device__ __forceinline__ XcdBarrier xcd_barrier_post(unsigned* bar, volatile LAS unsigned* st) {
    XcdBarrier b; b.bar = bar; b.x = xb_xcc_id(); b.st = st;
    if (threadIdx.x == 0) (void)xb_add(&bar[XB_XCNT(b.x)], 1u);
    return b;
}
__device__ __forceinline__ void xcd_barrier_complete(unsigned* bar, unsigned x, unsigned& nloc, unsigned& nx) {
    const unsigned G = gridDim.x * gridDim.y * gridDim.z;
    unsigned sum, cnt, mine, sp = 0u;
    for (;;) {
        sum = 0u; cnt = 0u; mine = 0u;
#pragma unroll
        for (unsigned j = 0; j < 16; ++j) { const unsigned c = xb_ld(&bar[XB_XCNT(j)]); sum += c; cnt += (c > 0u) ? 1u : 0u; mine = (j == x) ? c : mine; }
        if (sum == G) break;
        __builtin_amdgcn_s_sleep(1);
        if ((++sp & 255u) == 0u) { if (xb_ld(&bar[XB_TMO])) break; if (sp > XB_SPIN_CAP) { atomicAdd(&bar[XB_TMO], 1u); break; } }
    }
    nloc = mine > 0u ? mine : 1u; nx = cnt > 0u ? cnt : 1u;
}
__device__ __forceinline__ void xcd_barrier(const XcdBarrier& b) {
    asm volatile("s_waitcnt vmcnt(0)" ::: "memory");
    __syncthreads();
    if (threadIdx.x == 0) {
        unsigned* bar = b.bar;
        __builtin_amdgcn_s_waitcnt(0);
        unsigned nloc = b.st[0], nx = b.st[1];
        if (nloc == 0u) { xcd_barrier_complete(bar, b.x, nloc, nx); b.st[0] = nloc; b.st[1] = nx; }
        const unsigned old = xb_add(&bar[XB_XSUB(b.x)], 1u);
        const unsigned gen = old / nloc;
        if (old + 1u == (gen + 1u) * nloc) {
            __builtin_amdgcn_fence(__ATOMIC_RELEASE, "agent");
            asm volatile("s_waitcnt vmcnt(0)" ::: "memory");
            const unsigned og = xb_add(&bar[XB_TOP], 1u);
            const unsigned tg = og / nx;
            if (og + 1u == (tg + 1u) * nx) xb_add(&bar[XB_TOPGEN], 1u);
            else XB_SPIN(xb_ld(&bar[XB_TOPGEN]) == tg, bar);
            __builtin_amdgcn_fence(__ATOMIC_ACQUIRE, "agent");
            xb_add(&bar[XB_XGEN(b.x)], 1u);
            asm volatile("s_waitcnt vmcnt(0)" ::: "memory");
        } else {
            XB_SPIN(xb_ld(&bar[XB_XGEN(b.x)]) == gen, bar);
            __builtin_amdgcn_fence(__ATOMIC_ACQUIRE, "agent");
            asm volatile("s_waitcnt vmcnt(0)" ::: "memory");
        }
    }
    __syncthreads();
}

#ifndef PHMASK
#define PHMASK 0xFFFF
#endif
#define PH(n) ((PHMASK >> (n)) & 1)
#ifndef PROBE
#define PROBE 0
#endif
#define REP(g) for (int _rep = 0; _rep < ((PROBE == (g)) ? 2 : 1); ++_rep)
__global__ void __launch_bounds__(512, 2) fwd_megakernel(Params p) {
    extern __shared__ __attribute__((aligned(16))) unsigned char lds_raw[];
    LAS unsigned char* lds = (LAS unsigned char*)lds_raw;
    cg::grid_group grid = cg::this_grid();
    const int tid = threadIdx.x, lane = tid & 63, wave = __builtin_amdgcn_readfirstlane(tid >> 6);
    const int G = gridDim.x, gw = wave * G + blockIdx.x, ngw = G * 8;
    unsigned char* ws = p.ws;
    bf16_t* U = (bf16_t*)(ws + WS_U); bf16_t* P = (bf16_t*)(ws + WS_P);
    const float* mod = (const float*)(ws + WS_MOD);
    LAS float* scr = (LAS float*)(lds + wave * 16384);

    unsigned* barw = (unsigned*)(ws + WS_BAR);
    volatile LAS unsigned* bst = (volatile LAS unsigned*)(lds + BST_OFF);
    if (tid < 2) bst[tid] = 0u;
    __syncthreads();
    if (p.ws == nullptr) grid.sync();
    const XcdBarrier xbar = xcd_barrier_post(barw, bst);
    REP(1) { if (PH(0)) for (int it = blockIdx.x; it < NMOD / 64; it += G) mod_item(p, lds, it, tid, wave, lane);
    if (PH(0)) ffn_weight_items(p.in[I_WFFN1IN], p.in[I_WFFN1OUT], (bf16_t*)(ws + W_FFIN), (bf16_t*)(ws + W_FFOUT), scr, gw, ngw, lane);
    if (PH(0)) mixer_weight_items(p, scr, gw, ngw, lane); __syncthreads(); }
    xcd_barrier(xbar);
    if (PROBE == 3) for (int i = 0; i < 16; ++i) xcd_barrier(xbar);
    REP(1) if (PH(1)) norm_mod_phase<false>(p, lds, p.in[I_X], p.in[I_GFFN1], 0, U, tid, wave, lane);
    xcd_barrier(xbar);
    REP(2) if (PH(2)) run_gemm(lds, U, D, (const bf16_t*)(ws + W_FFIN), 2 * FF, D, EpiSwiGLU{P, FF});
    xcd_barrier(xbar);
    REP(2) if (PH(3)) run_gemm(lds, P, FF, (const bf16_t*)(ws + W_FFOUT), D, FF, EpiResid{p.in[I_X], p.out, mod + 2 * D, 0.5f});
    xcd_barrier(xbar);
    REP(1) if (PH(4)) norm_mod_phase<true>(p, lds, p.out, p.in[I_GMIX], 3, U, tid, wave, lane);
    xcd_barrier(xbar);
    REP(2) if (PH(5)) run_gemm(lds, U, D, (const bf16_t*)(ws + W_IN), NIN, D, EpiBf16{P, NIN});
    xcd_barrier(xbar);
    if (PH(6)) prep_phase(p, wave, lane);
    xcd_barrier(xbar);
    if (PH(7)) for (int it = blockIdx.x; it < 1024; it += G) gdn_chunk_prep(p, lds, it, tid, wave, lane);
    xcd_barrier(xbar);
    if (PH(15)) for (int it = blockIdx.x; it < 32; it += G) gdn_scan_block(p, lds, it, tid, wave, lane);
    if (PH(8)) {
        const unsigned x0 = xb_xcc_id() & 7u;
        for (unsigned dx = 0; dx < 8u; ++dx) { const unsigned x = (x0 + dx) & 7u; unsigned* ctr = (unsigned*)(ws + WS_CTR) + 64 * x;
            for (;;) { unsigned idx = 0; if (lane == 0) idx = atomicAdd(ctr, 1u); idx = __builtin_amdgcn_readfirstlane(idx);
                if (idx >= 512u) break;
                attn_item_mfma(P, (const bf16_t*)(ws + WS_VT), (int)(8u * x + (idx & 7u)), 63 - (int)(idx >> 3), lane); } } }
    xcd_barrier(xbar);
    if (PH(9)) gdn_finalize_phase(p, wave, lane);
    xcd_barrier(xbar);
    if (PH(10)) run_gemm(lds, P + C_QSB, NIN, (const bf16_t*)(ws + W_UPSB), D, 1024, EpiGateFused{P + C_RSB, P + C_RDN, U}, 8, (C_VDN - C_QSB) * 2 - 8 * 128);
    xcd_barrier(xbar);
    if (PH(11)) run_gemm(lds, U, D, (const bf16_t*)(ws + W_OUT), D, D, EpiResid{p.out, p.out, mod + 5 * D, 1.0f});
    xcd_barrier(xbar);
    REP(1) if (PH(12)) norm_mod_phase<false>(p, lds, p.out, p.in[I_GFFN2], 6, U, tid, wave, lane);
    __syncthreads();
    if (PH(12)) ffn_weight_items(p.in[I_WFFN2IN], p.in[I_WFFN2OUT], (bf16_t*)(ws + W_FFIN), (bf16_t*)(ws + W_FFOUT), scr, gw, ngw, lane);
    xcd_barrier(xbar);
    REP(2) if (PH(13)) run_gemm(lds, U, D, (const bf16_t*)(ws + W_FFIN), 2 * FF, D, EpiSwiGLU{P, FF});
    xcd_barrier(xbar);
    if (PH(14)) run_gemm(lds, P, FF, (const bf16_t*)(ws + W_FFOUT), D, FF, EpiResid{p.out, p.out, mod + 8 * D, 0.5f});
}

extern "C" void kernel_launch(void* const* d_in, const int* in_sizes, int n_in, void* d_out, int out_size, void* d_ws, size_t ws_size, hipStream_t stream) {
    static int grid_blocks = 0;
    if (!grid_blocks) {
        int dev = 0, cus = 0, per_cu = 0;
        (void)hipGetDevice(&dev);
        (void)hipDeviceGetAttribute(&cus, hipDeviceAttributeMultiprocessorCount, dev);
        (void)hipFuncSetAttribute((const void*)fwd_megakernel, hipFuncAttributeMaxDynamicSharedMemorySize, LDS_BYTES);
        (void)hipOccupancyMaxActiveBlocksPerMultiprocessor(&per_cu, (const void*)fwd_megakernel, 512, LDS_BYTES);
        if (per_cu < 1) { fprintf(stderr, "occupancy query says %d blocks/CU\n", per_cu); per_cu = 1; }
        grid_blocks = cus;
    }
    Params p{};
    for (int i = 0; i < N_IN; ++i) p.in[i] = (const float*)d_in[i];
    p.out = (float*)d_out; p.ws = (unsigned char*)d_ws;
    (void)hipMemsetAsync((char*)d_ws + WS_CTR, 0, (WS_BAR - WS_CTR) + XCD_BAR_WORDS * 4, stream);
    void* args[] = {&p};
    hipError_t e = hipLaunchCooperativeKernel((const void*)fwd_megakernel, dim3(grid_blocks), dim3(512), args, LDS_BYTES, stream);
    if (e != hipSuccess) fprintf(stderr, "cooperative launch failed: %s (grid %d)\n", hipGetErrorString(e), grid_blocks);
}
```

```cpp
#include <hip/hip_runtime.h>
#include <hip/hip_cooperative_groups.h>
#include <cstdio>
namespace cg = cooperative_groups;

#define LAS __attribute__((address_space(3)))
typedef unsigned short bf16_t;
typedef short bf16x8 __attribute__((ext_vector_type(8)));
typedef float f32x4 __attribute__((ext_vector_type(4)));
typedef unsigned u32x4 __attribute__((ext_vector_type(4)));
typedef unsigned u32x2 __attribute__((ext_vector_type(2)));
typedef float f32x16 __attribute__((ext_vector_type(16)));
typedef float f32x2 __attribute__((ext_vector_type(2)));
typedef __bf16 nbf16x2 __attribute__((ext_vector_type(2)));

constexpr int T = 16384, D = 1024, SEQ = 2048, NB = 8, FF = 2816, NIN = 5632, INW = 5640, NMOD = 9216;
constexpr int C_QSB = 0, C_KSB = 512, C_VSB = 1024, C_QDN = 1536, C_KDN = 2048, C_VDN = 2560, C_ZDN = 3072, C_RSB = 3584, C_RDN = 4608;
constexpr float EPS = 1e-6f;
constexpr int LDS_BYTES = 163840, BST_OFF = LDS_BYTES - 64;
constexpr size_t MiB = 1024 * 1024;
constexpr size_t WS_MOD = 0, WS_BG = 512 * 1024, WS_SS = 242 * MiB, WS_W = 2 * MiB;
constexpr size_t W_FFIN = WS_W, W_FFOUT = W_FFIN + (size_t)2 * FF * D * 2, W_IN = W_FFOUT + (size_t)D * FF * 2, W_UPSB = W_IN + (size_t)NIN * D * 2,
                 W_UPDN = W_UPSB + (size_t)D * 512 * 2, W_OUT = W_UPDN + (size_t)D * 512 * 2, W_END = W_OUT + (size_t)D * D * 2;
constexpr size_t WS_U = 34 * MiB, WS_P = 66 * MiB;
static_assert(W_END <= WS_U, "weights overflow");
constexpr size_t WS_EGL = 384 * 1024, WS_CTR = 400 * 1024, WS_BAR = 416 * 1024;
constexpr size_t WS_VT = W_FFIN;
static_assert((size_t)T * 512 * 2 <= W_IN - W_FFIN, "Vt overflow");

enum { I_X = 0, I_C, I_WADA, I_BADA, I_GFFN1, I_WFFN1IN, I_WFFN1OUT, I_GMIX, I_WIN, I_GQSB, I_GKSB, I_WCONV, I_ALOG, I_DTBIAS, I_GDNOUT, I_WUPSB, I_WUPDN, I_WOUT, I_GFFN2, I_WFFN2IN, I_WFFN2OUT, N_IN };
struct Params { const float* in[N_IN]; float* out; unsigned char* ws; };

__device__ __forceinline__ float bf_lo(unsigned w) { return __uint_as_float(w << 16); }
__device__ __forceinline__ float bf_hi(unsigned w) { return __uint_as_float(w & 0xffff0000u); }
__device__ __forceinline__ float bf2f(bf16_t b) { return __uint_as_float(((unsigned)b) << 16); }
__device__ __forceinline__ unsigned pk2(float lo, float hi) { unsigned r; asm("v_cvt_pk_bf16_f32 %0, %1, %2" : "=v"(r) : "v"(lo), "v"(hi)); return r; }
__device__ __forceinline__ unsigned cpk2(float lo, float hi) { const f32x2 v = {lo, hi}; return __builtin_bit_cast(unsigned, __builtin_convertvector(v, nbf16x2)); }
__device__ __forceinline__ bf16_t f2bf(float f) { return (bf16_t)(pk2(f, 0.f) & 0xffffu); }
__device__ __forceinline__ float fexp(float x) { return __builtin_amdgcn_exp2f(x * 1.4426950408889634f); }
__device__ __forceinline__ float flog(float x) { return __builtin_amdgcn_logf(x) * 0.6931471805599453f; }
__device__ __forceinline__ float fsigmoid(float x) { return __builtin_amdgcn_rcpf(1.f + fexp(-x)); }
__device__ __forceinline__ float fsilu(float x) { return x * fsigmoid(x); }
__device__ __forceinline__ float fsoftplus(float x) { return fmaxf(x, 0.f) + flog(1.f + fexp(-fabsf(x))); }
__device__ __forceinline__ float wave_sum(float v) {
#pragma unroll
    for (int o = 1; o < 64; o <<= 1) v += __shfl_xor(v, o);
    return v;
}
#define LDS_WAIT() asm volatile("s_waitcnt lgkmcnt(0)" ::: "memory")

namespace pg8 {
constexpr int BM = 256, BK = 64, HALF = 128, HTB = HALF * BK * 2, STAGE_BYTES = 8 * HTB, NXCD = 8, WGM = 8;
__host__ __device__ __forceinline__ int lds_byte(int r, int c) { const int st = (r >> 4) * 2 + (c >> 5), rr = r & 15, cc = c & 31, ob = rr * 64 + cc * 2; return st * 1024 + (ob ^ (((ob >> 9) & 1) << 5)); }
__host__ __device__ __forceinline__ void stage_rc(int b, int& R, int& C) { const int st = b / 1024, sb = b % 1024, swz = sb ^ (((sb >> 9) & 1) << 5); R = (st >> 1) * 16 + swz / 64; C = (st & 1) * 32 + (swz % 64) / 2; }
__host__ __device__ __forceinline__ int perm32(int rho) { const int n = rho >> 4, i = rho & 15; return 8 * (i >> 2) + 4 * n + (i & 3); }
struct Unit { int pm, pn; };
struct Gemm { const bf16_t* A; const bf16_t* Bt; int M, N, K, lda; int jt; int jbytes; };
struct StaticOrder {
    int nM, nN, nwg, G, c;
    __host__ __device__ void init(int M, int N, int G_, int c_) { nM = M / BM; nN = N / BM; nwg = nM * nN; G = G_; c = c_; }
    __host__ __device__ bool next(int i, Unit& u) const {
        const long L = (long)i * G + c; if (L >= nwg) return false;
        int wgid = (int)L; { const int q = nwg / NXCD, r = nwg % NXCD, xcd = wgid % NXCD, off = wgid / NXCD; wgid = (xcd < r ? xcd * (q + 1) : r * (q + 1) + (xcd - r) * q) + off; }
        const int nig = WGM * nN, gid = wgid / nig, fm = gid * WGM, gsz = (nM - fm) < WGM ? (nM - fm) : WGM;
        u.pm = fm + ((wgid % nig) % gsz); u.pn = (wgid % nig) / gsz; return true;
    }
};
template <class Epi>
__device__ __forceinline__ void gemm_phase(LAS unsigned char* lds, const Gemm g, const StaticOrder& S, const Epi& E) {
    int tid = threadIdx.x; asm volatile("" : "+v"(tid));
    const int wid = __builtin_amdgcn_readfirstlane(tid >> 6), lane = tid & 63, wr = wid >> 2, wc = wid & 3, fr = lane & 15, fq = lane >> 4;
    const int K = g.K, nt = K / BK, lda = g.lda;
    unsigned voffA[2], voffB[2];
#pragma unroll
    for (int i = 0; i < 2; ++i) { int R, C; stage_rc(tid * 16 + i * 8192, R, C); const int Rb = Epi::PERM ? ((R & ~31) + perm32(R & 31)) : R;
        voffA[i] = (unsigned)(R * lda + C) * 2u; voffB[i] = (unsigned)(Rb * K + C) * 2u; }
    const size_t kstep = (size_t)(BK * 2);
    const size_t hstepA = (size_t)HALF * lda * 2, hstepB = (size_t)HALF * K * 2;
    const size_t tstepA = 2 * hstepA, tstepB = 2 * hstepB;
    const unsigned ldsw = (unsigned)wid * 1024u;
    const int aoff = lds_byte(wr * 64 + fr, fq * 8), boff = lds_byte(wc * 32 + fr, fq * 8);
#define PG8_SA(b, h) (((b) * 2 + (h)) * HTB)
#define PG8_SB(b, h) ((4 + (b) * 2 + (h)) * HTB)
#define PG8_STAGE(bufoff, gbase, voff) do { _Pragma("unroll") for (int _i = 0; _i < 2; ++_i) \
        __builtin_amdgcn_global_load_lds((const unsigned*)((const char*)(gbase) + (voff)[_i]), (LAS unsigned*)(lds + (bufoff) + ldsw + _i * 8192), 16, 0, 0); } while (0)
#define PG8_LDA(dst, b, h) do { _Pragma("unroll") for (int m = 0; m < 4; ++m) _Pragma("unroll") for (int k = 0; k < 2; ++k) dst[m][k] = *(const LAS bf16x8*)(lds + PG8_SA(b, h) + aoff + m * 2048 + k * 1024); } while (0)
#define PG8_LDB(dst, b, h) do { _Pragma("unroll") for (int n = 0; n < 2; ++n) _Pragma("unroll") for (int k = 0; k < 2; ++k) dst[n][k] = *(const LAS bf16x8*)(lds + PG8_SB(b, h) + boff + n * 2048 + k * 1024); } while (0)
#define PG8_MMA(ai, bj, At, Bt) do { __builtin_amdgcn_s_setprio(1); _Pragma("unroll") for (int m = 0; m < 4; ++m) _Pragma("unroll") for (int n = 0; n < 2; ++n) _Pragma("unroll") for (int k = 0; k < 2; ++k) \
        acc[ai][bj][m][n] = __builtin_amdgcn_mfma_f32_16x16x32_bf16(Bt[n][k], At[m][k], acc[ai][bj][m][n], 0, 0, 0); __builtin_amdgcn_s_setprio(0); } while (0)
#define PG8_WAIT_V(n) asm volatile("s_waitcnt vmcnt(" #n ")" ::: "memory")
#define PG8_WAIT_L(n) asm volatile("s_waitcnt lgkmcnt(" #n ")" ::: "memory")
#define PG8_BAR __builtin_amdgcn_s_barrier()
#define PG8_SCHED __builtin_amdgcn_sched_barrier(0)
    Unit cur, nxt; int ui = 0;
    if (!S.next(0, cur)) return;
    f32x4 acc[2][2][4][2];
#pragma unroll
    for (int a = 0; a < 2; ++a)
#pragma unroll
        for (int b = 0; b < 2; ++b)
#pragma unroll
            for (int m = 0; m < 4; ++m)
#pragma unroll
                for (int n = 0; n < 2; ++n) acc[a][b][m][n] = (f32x4){0.f, 0.f, 0.f, 0.f};
    bf16x8 At[4][2], B0[2][2], B1[2][2];
    const char* cA = (const char*)g.A + (size_t)cur.pm * tstepA; const char* cB = (const char*)g.Bt + (size_t)cur.pn * tstepB;
    PG8_STAGE(PG8_SB(0, 0), cB, voffB); PG8_STAGE(PG8_SA(0, 0), cA, voffA); PG8_STAGE(PG8_SB(0, 1), cB + hstepB, voffB); PG8_STAGE(PG8_SA(0, 1), cA + hstepA, voffA);
    if (wr == 1) PG8_BAR;
    PG8_WAIT_V(4); PG8_BAR;
    PG8_STAGE(PG8_SB(1, 0), cB + kstep, voffB); PG8_STAGE(PG8_SA(1, 0), cA + kstep, voffA); PG8_STAGE(PG8_SB(1, 1), cB + hstepB + kstep, voffB);
    PG8_WAIT_V(6); PG8_BAR;
    for (;;) {
        const bool has_next = S.next(ui + 1, nxt);
        const char* nA = has_next ? (const char*)g.A + (size_t)nxt.pm * tstepA : cA; const char* nB = has_next ? (const char*)g.Bt + (size_t)nxt.pn * tstepB : cB;
        for (int t = 0; t < nt; t += 2) {
            const bool last = (t == nt - 2);
            const char* a1 = cA + (size_t)(t + 1) * kstep + (t + 1 >= g.jt ? g.jbytes : 0);
            const char* a2 = last ? nA : cA + (size_t)(t + 2) * kstep + (t + 2 >= g.jt ? g.jbytes : 0); const char* b2 = last ? nB : cB + (size_t)(t + 2) * kstep;
            const char* a3 = a2 + kstep; const char* b3 = b2 + kstep;
            if constexpr (Epi::HAS_MID) { if (t == g.jt) E.mid(acc, cur, wr, wc, fr, fq); }
            PG8_LDB(B0, 0, 0); PG8_SCHED; PG8_LDA(At, 0, 0); PG8_STAGE(PG8_SA(1, 1), a1 + hstepA, voffA);
            PG8_WAIT_L(8); PG8_BAR; PG8_WAIT_L(0); PG8_MMA(0, 0, At, B0); PG8_BAR; PG8_SCHED;
            PG8_LDB(B1, 0, 1); PG8_STAGE(PG8_SB(0, 0), b2, voffB);
            PG8_BAR; PG8_WAIT_L(0); PG8_MMA(0, 1, At, B1); PG8_BAR;
            PG8_LDA(At, 0, 1); PG8_STAGE(PG8_SA(0, 0), a2, voffA);
            PG8_BAR; PG8_WAIT_L(0); PG8_MMA(1, 0, At, B0); PG8_BAR; PG8_SCHED;
            PG8_STAGE(PG8_SB(0, 1), b2 + hstepB, voffB);
            PG8_WAIT_V(6); PG8_BAR; PG8_MMA(1, 1, At, B1); PG8_BAR;
            PG8_LDB(B0, 1, 0); PG8_SCHED; PG8_LDA(At, 1, 0); PG8_STAGE(PG8_SA(0, 1), a2 + hstepA, voffA);
            PG8_WAIT_L(8); PG8_BAR; PG8_WAIT_L(0); PG8_MMA(0, 0, At, B0); PG8_BAR; PG8_SCHED;
            PG8_LDB(B1, 1, 1); PG8_STAGE(PG8_SB(1, 0), b3, voffB);
            PG8_BAR; PG8_WAIT_L(0); PG8_MMA(0, 1, At, B1); PG8_BAR;
            PG8_LDA(At, 1, 1); PG8_STAGE(PG8_SA(1, 0), a3, voffA);
            PG8_BAR; PG8_WAIT_L(0); PG8_MMA(1, 0, At, B0); PG8_BAR; PG8_SCHED;
            PG8_STAGE(PG8_SB(1, 1), b3 + hstepB, voffB);
            PG8_WAIT_V(6); PG8_BAR; PG8_MMA(1, 1, At, B1); PG8_BAR;
        }
        E(acc, cur, wr, wc, fr, fq);
        if (!has_next) break;
#pragma unroll
        for (int a = 0; a < 2; ++a)
#pragma unroll
            for (int b = 0; b < 2; ++b)
#pragma unroll
                for (int m = 0; m < 4; ++m)
#pragma unroll
                    for (int n = 0; n < 2; ++n) acc[a][b][m][n] = (f32x4){0.f, 0.f, 0.f, 0.f};
        cur = nxt; cA = nA; cB = nB; ++ui;
    }
    PG8_WAIT_V(0);
    if (wr == 0) PG8_BAR;
    PG8_BAR;
#undef PG8_SA
#undef PG8_SB
#undef PG8_STAGE
#undef PG8_LDA
#undef PG8_LDB
#undef PG8_MMA
#undef PG8_WAIT_V
#undef PG8_WAIT_L
#undef PG8_BAR
#undef PG8_SCHED
}
}

typedef const f32x4 (&AccRef)[2][2][4][2];
struct EpiBf16 {
    static constexpr bool PERM = true, HAS_MID = false;
    bf16_t* O; int ldc;
    __device__ __forceinline__ void operator()(AccRef acc, const pg8::Unit& u, int wr, int wc, int fr, int fq) const {
        const int row0 = u.pm * 256 + wr * 64 + fr, col0 = u.pn * 256 + wc * 32 + 8 * fq;
#pragma unroll
        for (int ai = 0; ai < 2; ++ai)
#pragma unroll
            for (int m = 0; m < 4; ++m) { bf16_t* rowp = O + (size_t)(row0 + ai * 128 + m * 16) * ldc + col0;
#pragma unroll
                for (int bj = 0; bj < 2; ++bj) { const f32x4 v0 = acc[ai][bj][m][0], v1 = acc[ai][bj][m][1];
                    u32x4 w; w.x = pk2(v0[0], v0[1]); w.y = pk2(v0[2], v0[3]); w.z = pk2(v1[0], v1[1]); w.w = pk2(v1[2], v1[3]);
                    *(u32x4*)(rowp + bj * 128) = w; } }
    }
};
struct EpiSwiGLU {
    static constexpr bool PERM = true, HAS_MID = false;
    bf16_t* O; int ldc;
    __device__ __forceinline__ void operator()(AccRef acc, const pg8::Unit& u, int wr, int wc, int fr, int fq) const {
        const int row0 = u.pm * 256 + wr * 64 + fr, col0 = u.pn * 128 + wc * 32 + 8 * fq;
#pragma unroll
        for (int ai = 0; ai < 2; ++ai)
#pragma unroll
            for (int m = 0; m < 4; ++m) { bf16_t* rowp = O + (size_t)(row0 + ai * 128 + m * 16) * ldc + col0;
                float r[8];
#pragma unroll
                for (int n = 0; n < 2; ++n)
#pragma unroll
                    for (int j = 0; j < 4; ++j) { const float a = acc[ai][0][m][n][j], b = acc[ai][1][m][n][j]; r[n * 4 + j] = fsilu(a) * b; }
                u32x4 w; w.x = pk2(r[0], r[1]); w.y = pk2(r[2], r[3]); w.z = pk2(r[4], r[5]); w.w = pk2(r[6], r[7]);
                *(u32x4*)rowp = w; }
    }
};
struct EpiResid {
    static constexpr bool PERM = false, HAS_MID = false;
    const float* base; float* out; const float* gate; float scale;
    __device__ __forceinline__ void operator()(AccRef acc, const pg8::Unit& u, int wr, int wc, int fr, int fq) const {
        const int row0 = u.pm * 256 + wr * 64 + fr, col0 = u.pn * 256 + wc * 32 + 4 * fq;
        const float* gp = gate + (size_t)(u.pm >> 3) * NMOD + col0;
        f32x4 gv[2][2];
#pragma unroll
        for (int bj = 0; bj < 2; ++bj)
#pragma unroll
            for (int n = 0; n < 2; ++n) gv[bj][n] = *(const f32x4*)(gp + bj * 128 + n * 16) * scale;
#pragma unroll
        for (int ai = 0; ai < 2; ++ai)
#pragma unroll
            for (int m = 0; m < 4; ++m) { const size_t off = (size_t)(row0 + ai * 128 + m * 16) * D + col0;
#pragma unroll
                for (int bj = 0; bj < 2; ++bj)
#pragma unroll
                    for (int n = 0; n < 2; ++n) { const f32x4 bs = *(const f32x4*)(base + off + bj * 128 + n * 16);
                        *(f32x4*)(out + off + bj * 128 + n * 16) = bs + gv[bj][n] * acc[ai][bj][m][n]; } }
    }
};
struct EpiGateFused {
    static constexpr bool PERM = true, HAS_MID = true;
    const bf16_t* Rsb; const bf16_t* Rdn; bf16_t* O;
    __device__ __forceinline__ void mid(f32x4 (&acc)[2][2][4][2], const pg8::Unit& u, int wr, int wc, int fr, int fq) const {
        int row0 = u.pm * 256 + wr * 64 + fr, col0 = u.pn * 256 + wc * 32 + 8 * fq;
        asm volatile("" : "+v"(row0), "+v"(col0));
#pragma unroll
        for (int ai = 0; ai < 2; ++ai)
#pragma unroll
            for (int m = 0; m < 4; ++m) { const size_t row = (size_t)(row0 + ai * 128 + m * 16);
#pragma unroll
                for (int bj = 0; bj < 2; ++bj) { const u32x4 a = *(const u32x4*)(Rsb + row * NIN + col0 + bj * 128), d = *(const u32x4*)(Rdn + row * NIN + col0 + bj * 128);
                    const float ra[8] = {bf_lo(a.x), bf_hi(a.x), bf_lo(a.y), bf_hi(a.y), bf_lo(a.z), bf_hi(a.z), bf_lo(a.w), bf_hi(a.w)};
                    const float rd[8] = {bf_lo(d.x), bf_hi(d.x), bf_lo(d.y), bf_hi(d.y), bf_lo(d.z), bf_hi(d.z), bf_lo(d.w), bf_hi(d.w)};
#pragma unroll
                    for (int e = 0; e < 8; ++e) { const float q = (1.0f + fexp(fminf(-rd[e], 30.0f))) * __builtin_amdgcn_rcpf(1.0f + fexp(-ra[e])); acc[ai][bj][m][e >> 2][e & 3] *= q; }
                    asm volatile("" ::: "memory"); } }
    }
    __device__ __forceinline__ void operator()(AccRef acc, const pg8::Unit& u, int wr, int wc, int fr, int fq) const {
        const int row0 = u.pm * 256 + wr * 64 + fr, col0 = u.pn * 256 + wc * 32 + 8 * fq;
#pragma unroll
        for (int ai = 0; ai < 2; ++ai)
#pragma unroll
            for (int m = 0; m < 4; ++m) { const size_t row = (size_t)(row0 + ai * 128 + m * 16);
#pragma unroll
                for (int bj = 0; bj < 2; ++bj) { const u32x4 d = *(const u32x4*)(Rdn + row * NIN + col0 + bj * 128);
                    const f32x4 v0 = acc[ai][bj][m][0], v1 = acc[ai][bj][m][1];
#define SGC(x) __builtin_amdgcn_rcpf(1.0f + fexp(fminf(-(x), 30.0f)))
                    const float r[8] = {SGC(bf_lo(d.x)) * v0[0], SGC(bf_hi(d.x)) * v0[1], SGC(bf_lo(d.y)) * v0[2], SGC(bf_hi(d.y)) * v0[3],
                                        SGC(bf_lo(d.z)) * v1[0], SGC(bf_hi(d.z)) * v1[1], SGC(bf_lo(d.w)) * v1[2], SGC(bf_hi(d.w)) * v1[3]};
#undef SGC
                    u32x4 w; w.x = pk2(r[0], r[1]); w.y = pk2(r[2], r[3]); w.z = pk2(r[4], r[5]); w.w = pk2(r[6], r[7]);
                    *(u32x4*)(O + row * D + col0 + bj * 128) = w; } }
    }
};
template <class Epi> __device__ __forceinline__ void run_gemm(LAS unsigned char* lds, const bf16_t* A, int lda, const bf16_t* Bt, int N, int K, const Epi& E, int jt = 1 << 30, int jbytes = 0) {
    pg8::Gemm g{A, Bt, T, N, K, lda, jt, jbytes}; pg8::StaticOrder S; S.init(T, N, (int)gridDim.x, (int)blockIdx.x);
    pg8::gemm_phase<Epi>(lds, g, S, E);
}

__device__ __forceinline__ void transpose_item(const float* W, int ldw, int s0, int k0, bf16_t* WT, int ldk, int d0, LAS float* scr, int lane) {
    float tv[32];
#pragma unroll
    for (int i = 0; i < 32; ++i) tv[i] = W[(size_t)(k0 + 2 * i + (lane >> 5)) * ldw + s0 + (lane & 31)];
#pragma unroll
    for (int i = 0; i < 32; ++i) scr[(2 * i + (lane >> 5)) * 33 + (lane & 31)] = tv[i];
    LDS_WAIT();
    const int c = lane & 7;
#pragma unroll
    for (int j = 0; j < 4; ++j) { const int n = (lane >> 3) + 8 * j; const LAS float* s = scr + (8 * c) * 33 + n;
        u32x4 o; o.x = pk2(s[0 * 33], s[1 * 33]); o.y = pk2(s[2 * 33], s[3 * 33]); o.z = pk2(s[4 * 33], s[5 * 33]); o.w = pk2(s[6 * 33], s[7 * 33]);
        *(u32x4*)(WT + (size_t)(d0 + n) * ldk + k0 + 8 * c) = o; }
    LDS_WAIT();
}
__device__ __forceinline__ void ffn_weight_items(const float* w_in, const float* w_out, bf16_t* wt_in, bf16_t* wt_out, LAS float* scr, int gw, int ngw, int lane) {
    for (int it = gw; it < 2816 + 1408; it += ngw) {
        if (it < 2816) { const int kb = it / 176, nb = it % 176, d0 = nb * 32, pn = d0 >> 8, bj = (d0 >> 7) & 1, c = d0 & 127, s0 = bj * FF + pn * 128 + c;
            transpose_item(w_in, 2 * FF, s0, kb * 64, wt_in, D, d0, scr, lane); }
        else { const int r = it - 2816, kb = r / 32, nb = r % 32; transpose_item(w_out, D, nb * 32, kb * 64, wt_out, FF, nb * 32, scr, lane); }
    }
}
__device__ __forceinline__ void mixer_weight_items(const Params& p, LAS float* scr, int gw, int ngw, int lane) {
    unsigned char* ws = p.ws;
    for (int it = gw; it < 2816 + 256 + 256 + 512; it += ngw) {
        int r = it;
        if (r < 2816) { const int kb = r / 176, nb = r % 176, d0 = nb * 32, s0 = d0 < C_RSB ? d0 : d0 + 8; transpose_item(p.in[I_WIN], INW, s0, kb * 64, (bf16_t*)(ws + W_IN), D, d0, scr, lane); continue; } r -= 2816;
        if (r < 256) { const int kb = r / 32, nb = r % 32; transpose_item(p.in[I_WUPSB], D, nb * 32, kb * 64, (bf16_t*)(ws + W_UPSB), D, nb * 32, scr, lane); continue; } r -= 256;
        if (r < 256) { const int kb = r / 32, nb = r % 32; transpose_item(p.in[I_WUPDN], D, nb * 32, kb * 64, (bf16_t*)(ws + W_UPSB) + 512, D, nb * 32, scr, lane); continue; } r -= 256;
        { const int kb = r / 32, nb = r % 32; transpose_item(p.in[I_WOUT], D, nb * 32, kb * 64, (bf16_t*)(ws + W_OUT), D, nb * 32, scr, lane); }
    }
}
__device__ __forceinline__ void mod_item(const Params& p, LAS unsigned char* lds, int cb, int tid, int wave, int lane) {
    asm volatile("" : "+v"(tid), "+v"(lane));
    LAS float* sc = (LAS float*)lds; LAS float* red = (LAS float*)(lds + 32768);
    for (int i = tid; i < NB * D; i += 512) sc[i] = fsilu(p.in[I_C][i]);
    __syncthreads();
    const float* wa = p.in[I_WADA] + cb * 64 + lane;
    float acc[NB];
#pragma unroll
    for (int b = 0; b < NB; ++b) acc[b] = 0.f;
    for (int k = wave * 128; k < wave * 128 + 128; k += 16) {
        float w[16];
#pragma unroll
        for (int e = 0; e < 16; ++e) w[e] = wa[(size_t)(k + e) * NMOD];
#pragma unroll
        for (int b = 0; b < NB; ++b)
#pragma unroll
            for (int e4 = 0; e4 < 4; ++e4) { const f32x4 s = *(const LAS f32x4*)(sc + b * D + k + 4 * e4); acc[b] += s[0] * w[4 * e4] + s[1] * w[4 * e4 + 1] + s[2] * w[4 * e4 + 2] + s[3] * w[4 * e4 + 3]; }
    }
#pragma unroll
    for (int b = 0; b < NB; ++b) red[(wave * NB + b) * 64 + lane] = acc[b];
    __syncthreads();
    { const int b = tid >> 6; float s = p.in[I_BADA][cb * 64 + lane];
#pragma unroll
        for (int w = 0; w < 8; ++w) s += red[(w * NB + b) * 64 + lane];
        ((float*)(p.ws + WS_MOD))[b * NMOD + cb * 64 + lane] = s; }
    __syncthreads();
}

template <bool DN>
__device__ __forceinline__ void norm_mod_phase(const Params& p, LAS unsigned char* lds, const float* src, const float* gain, int midx, bf16_t* dst, int tid, int wave, int lane) {
    asm volatile("" : "+v"(tid), "+v"(lane));
    const float* mod = (const float*)(p.ws + WS_MOD);
    LAS float* wl = (LAS float*)lds;
    if (DN) { for (int i = tid; i < D * 8; i += 512) { const int k = i >> 3, j = i & 7; wl[8 * k + 4 * (k >> 2) + j] = p.in[I_WIN][(size_t)k * INW + C_RSB + j]; } __syncthreads(); }
    f32x4 g4[4];
#pragma unroll
    for (int j = 0; j < 4; ++j) g4[j] = ((const f32x4*)gain)[lane + 64 * j];
    for (int row = blockIdx.x * 8 + wave; row < T; row += gridDim.x * 8) {
        const int b = row >> 11;
        const f32x4* xr = (const f32x4*)(src + (size_t)row * D) + lane;
        const f32x4* shp = (const f32x4*)(mod + (size_t)b * NMOD + midx * D) + lane; const f32x4* scp = shp + D / 4;
        f32x4 v[4]; float ss = 0.f;
#pragma unroll
        for (int j = 0; j < 4; ++j) { v[j] = xr[64 * j]; ss += (v[j][0] * v[j][0] + v[j][1] * v[j][1]) + (v[j][2] * v[j][2] + v[j][3] * v[j][3]); }
        const float rstd = 1.0f / sqrtf(wave_sum(ss) * (1.f / D) + EPS);
        u32x2* o8 = (u32x2*)(dst + (size_t)row * D) + lane;
        float dot[8];
        if (DN) {
#pragma unroll
            for (int e = 0; e < 8; ++e) dot[e] = 0.f; }
#pragma unroll
        for (int j = 0; j < 4; ++j) { const f32x4 sh = shp[64 * j], sc = scp[64 * j];
            const f32x4 uu = v[j] * rstd * g4[j] * (sc + 1.0f) + sh;
            u32x2 w; w.x = pk2(uu[0], uu[1]); w.y = pk2(uu[2], uu[3]); o8[64 * j] = w;
            if (DN) {
#pragma unroll
                for (int e = 0; e < 4; ++e) { const int k = 4 * lane + 256 * j + e; const LAS f32x4* wp = (const LAS f32x4*)(wl + 8 * k + 4 * (k >> 2)); const f32x4 w0 = wp[0], w1 = wp[1];
                    dot[0] += uu[e] * w0[0]; dot[1] += uu[e] * w0[1]; dot[2] += uu[e] * w0[2]; dot[3] += uu[e] * w0[3];
                    dot[4] += uu[e] * w1[0]; dot[5] += uu[e] * w1[1]; dot[6] += uu[e] * w1[2]; dot[7] += uu[e] * w1[3]; } } }
        if (DN) {
#pragma unroll
            for (int e = 0; e < 8; ++e) dot[e] = wave_sum(dot[e]);
            float mine = dot[0];
#pragma unroll
            for (int e = 1; e < 8; ++e) mine = (lane == e) ? dot[e] : mine;
            if (lane < 8) { float r;
                if (lane < 4) r = 1.0f / (1.0f + expf(-mine));
                else { const int hh = lane - 4; const float a = mine + p.in[I_DTBIAS][hh]; const float sp = a > 20.f ? a : log1pf(expf(a)); r = -expf(p.in[I_ALOG][hh]) * sp; }
                ((float*)(p.ws + WS_BG))[(size_t)row * 8 + lane] = r; } }
    }
    if (DN) __syncthreads();
}

__device__ __forceinline__ void unpack16(const bf16_t* p, float* f) {
    const u32x4 a = ((const u32x4*)p)[0], b = ((const u32x4*)p)[1];
    f[0] = bf_lo(a.x); f[1] = bf_hi(a.x); f[2] = bf_lo(a.y); f[3] = bf_hi(a.y); f[4] = bf_lo(a.z); f[5] = bf_hi(a.z); f[6] = bf_lo(a.w); f[7] = bf_hi(a.w);
    f[8] = bf_lo(b.x); f[9] = bf_hi(b.x); f[10] = bf_lo(b.y); f[11] = bf_hi(b.y); f[12] = bf_lo(b.z); f[13] = bf_hi(b.z); f[14] = bf_lo(b.w); f[15] = bf_hi(b.w);
}
__device__ __forceinline__ void pack16(bf16_t* p, const float* f) {
    u32x4 a, b; a.x = pk2(f[0], f[1]); a.y = pk2(f[2], f[3]); a.z = pk2(f[4], f[5]); a.w = pk2(f[6], f[7]); b.x = pk2(f[8], f[9]); b.y = pk2(f[10], f[11]); b.z = pk2(f[12], f[13]); b.w = pk2(f[14], f[15]);
    ((u32x4*)p)[0] = a; ((u32x4*)p)[1] = b;
}
__device__ __forceinline__ void prep_phase(const Params& p, int wave, int lane) {
    asm volatile("" : "+v"(lane));
    bf16_t* P = (bf16_t*)(p.ws + WS_P); bf16_t* U = (bf16_t*)(p.ws + WS_U);
    const int ch = 16 * lane;
    float gsb[16], wcv[4][16];
    { const float* gp = (ch < 512 ? p.in[I_GQSB] : p.in[I_GKSB]) + (ch & 63); const float sc = ch < 512 ? 0.18033688011112042f : 1.0f;
#pragma unroll
        for (int e = 0; e < 16; ++e) gsb[e] = gp[e] * sc;
#pragma unroll
        for (int i = 0; i < 4; ++i)
#pragma unroll
            for (int e = 0; e < 16; ++e) wcv[i][e] = p.in[I_WCONV][i * 1536 + ch + e]; }
    for (int row = blockIdx.x * 8 + wave; row < T; row += gridDim.x * 8) {
        const int tl = row & (SEQ - 1);
        { bf16_t* qp = P + (size_t)row * NIN + ch; float f[16]; unpack16(qp, f); float ss = 0.f;
#pragma unroll
            for (int e = 0; e < 16; ++e) ss += f[e] * f[e];
            ss += __shfl_xor(ss, 1); ss += __shfl_xor(ss, 2);
            const float rstd = 1.0f / sqrtf(ss * (1.f / 64.f) + EPS);
#pragma unroll
            for (int e = 0; e < 16; ++e) f[e] = f[e] * rstd * gsb[e];
            pack16(qp, f); }
        { float y[16];
#pragma unroll
            for (int e = 0; e < 16; ++e) y[e] = 0.f;
#pragma unroll
            for (int i = 0; i < 4; ++i) { if (tl - 3 + i >= 0) { float f[16]; unpack16(P + (size_t)(row - 3 + i) * NIN + C_QDN + ch, f);
#pragma unroll
                    for (int e = 0; e < 16; ++e) y[e] += wcv[i][e] * f[e]; } }
            float ss = 0.f;
#pragma unroll
            for (int e = 0; e < 16; ++e) { y[e] = fsilu(y[e]); ss += y[e] * y[e]; }
            ss += __shfl_xor(ss, 1); ss += __shfl_xor(ss, 2); ss += __shfl_xor(ss, 4);
            const float sc = (1.0f / sqrtf(ss + EPS)) * (ch < 512 ? 0.08838834764831845f : 1.0f);
#pragma unroll
            for (int e = 0; e < 16; ++e) y[e] *= sc;
            pack16(U + (size_t)row * D + ch, y); }
    }
    bf16_t* Vt = (bf16_t*)(p.ws + WS_VT);
    for (int it = blockIdx.x * 8 + wave; it < T / 16; it += gridDim.x * 8) {
        const int row0 = it * 16, b = row0 >> 11, tl0 = row0 & (SEQ - 1), c8 = lane * 8, hd = c8 >> 6, d0 = c8 & 63;
        u32x4 w[16];
#pragma unroll
        for (int r = 0; r < 16; ++r) w[r] = *(const u32x4*)(P + (size_t)(row0 + r) * NIN + C_VSB + c8);
#pragma unroll
        for (int e = 0; e < 8; ++e) {
            unsigned o[8];
#pragma unroll
            for (int i = 0; i < 8; ++i) {
                const int p0 = 2 * i, p1 = 2 * i + 1;
                const int k0 = 8 * ((p0 >> 2) & 1) + 4 * (p0 >> 3) + (p0 & 3), k1 = 8 * ((p1 >> 2) & 1) + 4 * (p1 >> 3) + (p1 & 3);
                const unsigned a0 = w[k0][e >> 1], a1 = w[k1][e >> 1];
                const unsigned lo = (e & 1) ? (a0 >> 16) : (a0 & 0xffffu), hi = (e & 1) ? (a1 & 0xffff0000u) : (a1 << 16);
                o[i] = lo | hi; }
            bf16_t* dst = Vt + ((size_t)(b * 8 + hd) * 64 + d0 + e) * SEQ + tl0;
            ((u32x4*)dst)[0] = (u32x4){o[0], o[1], o[2], o[3]}; ((u32x4*)dst)[1] = (u32x4){o[4], o[5], o[6], o[7]}; }
    }
}

__device__ __forceinline__ float xlane32(float x, int hh) {
    const unsigned xi = __builtin_bit_cast(unsigned, x);
    const u32x2 r = __builtin_amdgcn_permlane32_swap(xi, xi, false, false);
    return __builtin_bit_cast(float, hh ? r.x : r.y);
}
template <bool DIAG>
__device__ __forceinline__ void attn_tile(const f32x16& z, const bf16x8 (&vc)[4], f32x16& o0, f32x16& o1, float& R, int ql, int hh) {
    float sg[16], m[16];
#pragma unroll
    for (int i = 0; i < 16; ++i) { const float e = __builtin_amdgcn_exp2f(fminf(-z[i], 80.0f)); float sig = __builtin_amdgcn_rcpf(1.0f + e); float mm = e * sig;
        if (DIAG) { const bool act = ((i & 3) + 8 * (i >> 2) + 4 * hh) < ql; sig = act ? sig : 0.f; mm = act ? mm : 1.0f; }
        sg[i] = sig; m[i] = mm; }
    float g[4], gp[4];
#pragma unroll
    for (int bq = 0; bq < 4; ++bq) { g[bq] = (m[4 * bq] * m[4 * bq + 1]) * (m[4 * bq + 2] * m[4 * bq + 3]); gp[bq] = xlane32(g[bq], hh); }
    float outer[4]; float tb = R;
#pragma unroll
    for (int bq = 3; bq >= 0; --bq) { outer[bq] = hh == 0 ? tb * gp[bq] : tb; tb *= g[bq] * gp[bq]; }
    R = tb;
    float w[16];
#pragma unroll
    for (int bq = 0; bq < 4; ++bq) { const float s3 = outer[bq], s2 = s3 * m[4 * bq + 3], s1 = s2 * m[4 * bq + 2], s0 = s1 * m[4 * bq + 1];
        w[4 * bq + 3] = sg[4 * bq + 3] * s3; w[4 * bq + 2] = sg[4 * bq + 2] * s2; w[4 * bq + 1] = sg[4 * bq + 1] * s1; w[4 * bq] = sg[4 * bq] * s0; }
    bf16x8 wf[2];
#pragma unroll
    for (int s2 = 0; s2 < 2; ++s2) { const u32x4 pw = {cpk2(w[8 * s2], w[8 * s2 + 1]), cpk2(w[8 * s2 + 2], w[8 * s2 + 3]), cpk2(w[8 * s2 + 4], w[8 * s2 + 5]), cpk2(w[8 * s2 + 6], w[8 * s2 + 7])}; wf[s2] = __builtin_bit_cast(bf16x8, pw); }
    o0 = __builtin_amdgcn_mfma_f32_32x32x16_bf16(vc[0], wf[0], o0, 0, 0, 0); o0 = __builtin_amdgcn_mfma_f32_32x32x16_bf16(vc[1], wf[1], o0, 0, 0, 0);
    o1 = __builtin_amdgcn_mfma_f32_32x32x16_bf16(vc[2], wf[0], o1, 0, 0, 0); o1 = __builtin_amdgcn_mfma_f32_32x32x16_bf16(vc[3], wf[1], o1, 0, 0, 0);
}
__device__ __forceinline__ void attn_item_mfma(bf16_t* P, const bf16_t* Vt, int bh, int qt, int lane) {
    asm volatile("" : "+v"(lane));
    const int b = bh >> 3, h = bh & 7, ql = lane & 31, hh = lane >> 5, q0 = qt * 32;
    bf16_t* qrow = P + (size_t)(b * SEQ + q0 + ql) * NIN + C_QSB + h * 64;
    bf16x8 qf[4];
#pragma unroll
    for (int s = 0; s < 4; ++s) qf[s] = *(const bf16x8*)(qrow + 16 * s + 8 * hh);
    f32x16 o0, o1;
#pragma unroll
    for (int i = 0; i < 16; ++i) { o0[i] = 0.f; o1[i] = 0.f; }
    float R = 1.0f;
    const bf16_t* kb = P + (size_t)(b * SEQ + ql) * NIN + C_KSB + h * 64 + 8 * hh;
    const bf16_t* vb = Vt + ((size_t)bh * 64 + ql) * SEQ + 8 * hh;
    bf16x8 kf[4], vf[4], vn[4];
#define AT_LOADK(k0_) do { _Pragma("unroll") for (int s = 0; s < 4; ++s) kf[s] = *(const bf16x8*)(kb + (size_t)(k0_) * NIN + 16 * s); } while (0)
#define AT_LOADV(dst, k0_) do { _Pragma("unroll") for (int j = 0; j < 4; ++j) dst[j] = *(const bf16x8*)(vb + (size_t)(j >> 1) * 32 * SEQ + (k0_) + 16 * (j & 1)); } while (0)
#define AT_QK(zz) do { _Pragma("unroll") for (int i = 0; i < 16; ++i) zz[i] = 0.f; _Pragma("unroll") for (int s = 0; s < 4; ++s) zz = __builtin_amdgcn_mfma_f32_32x32x16_bf16(kf[s], qf[s], zz, 0, 0, 0); } while (0)
    f32x16 zc, zn;
    AT_LOADK(q0); AT_LOADV(vf, q0);
    AT_QK(zc);
    { const int k1 = (qt > 0 ? qt - 1 : 0) * 32; AT_LOADK(k1); AT_LOADV(vn, k1); }
    { AT_QK(zn);
      const int k2 = (qt > 1 ? qt - 2 : 0) * 32; AT_LOADK(k2);
      attn_tile<true>(zc, vf, o0, o1, R, ql, hh);
      zc = zn;
#pragma unroll
      for (int j = 0; j < 4; ++j) vf[j] = vn[j];
      const int k1 = (qt > 1 ? qt - 2 : 0) * 32; AT_LOADV(vn, k1); }
#pragma unroll 1
    for (int kt = qt - 1; kt >= 0; --kt) {
        AT_QK(zn);
        const int k2 = (kt > 1 ? kt - 2 : 0) * 32; AT_LOADK(k2);
        attn_tile<false>(zc, vf, o0, o1, R, ql, hh);
        if (__builtin_amdgcn_ballot_w64(R != 0.0f) == 0ull) break;
        zc = zn;
#pragma unroll
        for (int j = 0; j < 4; ++j) vf[j] = vn[j];
        AT_LOADV(vn, k2);
    }
#undef AT_LOADK
#undef AT_LOADV
#undef AT_QK
#pragma unroll
    for (int bq = 0; bq < 4; ++bq) {
        u32x2 w0 = {cpk2(o0[4 * bq], o0[4 * bq + 1]), cpk2(o0[4 * bq + 2], o0[4 * bq + 3])}, w1 = {cpk2(o1[4 * bq], o1[4 * bq + 1]), cpk2(o1[4 * bq + 2], o1[4 * bq + 3])};
        *(u32x2*)(qrow + 8 * bq + 4 * hh) = w0; *(u32x2*)(qrow + 32 + 8 * bq + 4 * hh) = w1; }
}
__device__ __forceinline__ size_t slotU(size_t t0, int h, int colbase, int f) { return (t0 + (size_t)(f >> 7)) * D + colbase + h * 128 + (f & 127); }
__device__ __forceinline__ size_t slotP(size_t t0, int h, int colbase, int f) { return (t0 + (size_t)(f >> 7)) * NIN + colbase + h * 128 + (f & 127); }
__device__ __forceinline__ int permpos(int x) { const int k = x & 15; return (x & ~15) + 8 * ((k >> 2) & 1) + 4 * (k >> 3) + (k & 3); }
__device__ __forceinline__ int crow(int r, int hh) { return (r & 3) + 8 * (r >> 2) + 4 * hh; }
__device__ __forceinline__ bf16x8 pack8(const f32x16& x, int s2) {
    const u32x4 pw = {cpk2(x[8 * s2], x[8 * s2 + 1]), cpk2(x[8 * s2 + 2], x[8 * s2 + 3]), cpk2(x[8 * s2 + 4], x[8 * s2 + 5]), cpk2(x[8 * s2 + 6], x[8 * s2 + 7])};
    return __builtin_bit_cast(bf16x8, pw);
}
#define MFMA32(a, b, c) __builtin_amdgcn_mfma_f32_32x32x16_bf16((a), (b), (c), 0, 0, 0)
constexpr int PT = 72, PQ = 136, PL = 68, PB = 40;
constexpr int CP_GC = 0, CP_BT = 256, CP_LS = 1024, CP_TU = CP_LS + 64 * PL * 4, CP_TW = CP_TU + 64 * PT * 2, CP_KT = CP_TW + 64 * PT * 2, CP_VT = CP_KT + 128 * PT * 2,
              CP_QS = CP_VT + 128 * PT * 2, CP_KS = CP_QS + 64 * PQ * 2, CP_AQ = CP_KS + 64 * PQ * 2, CP_L21 = CP_AQ + 64 * PT * 2, CP_TCM = CP_L21 + 32 * PB * 2, CP_T22 = CP_TCM + 32 * PB * 2, CP_END = CP_T22 + 32 * PB * 2;
static_assert(CP_END <= 131072, "chunk prep LDS");
__device__ __forceinline__ void gdn_chunk_prep_phase(const Params& p, LAS unsigned char* lds, int tid, int wave, int lane) {
    bf16_t* P = (bf16_t*)(p.ws + WS_P); bf16_t* U = (bf16_t*)(p.ws + WS_U); const float* BG = (const float*)(p.ws + WS_BG);
    u32x4 ka, kb, qa, qb, xv[4][2]; float gx = 0.f, gbt = 0.f;
#define CP_LOAD(item_) do { const int bh_ = (item_) >> 5, n_ = (item_) & 31, b_ = bh_ >> 2, h_ = bh_ & 3; const size_t t0_ = (size_t)b_ * SEQ + n_ * 64; const int tok_ = tid >> 3, c16_ = (tid & 7) * 16; \
        ka = *(const u32x4*)(U + (t0_ + tok_) * D + 512 + h_ * 128 + c16_); kb = *(const u32x4*)(U + (t0_ + tok_) * D + 512 + h_ * 128 + c16_ + 8); \
        qa = *(const u32x4*)(U + (t0_ + tok_) * D + h_ * 128 + c16_); qb = *(const u32x4*)(U + (t0_ + tok_) * D + h_ * 128 + c16_ + 8); \
        _Pragma("unroll") for (int i = 0; i < 4; ++i) { const bool ok = n_ * 64 + tok_ - 3 + i >= 0; const bf16_t* vp = P + (t0_ + tok_ - 3 + i) * NIN + C_VDN + h_ * 128 + c16_; \
            xv[i][0] = ok ? *(const u32x4*)vp : (u32x4){0u, 0u, 0u, 0u}; xv[i][1] = ok ? *(const u32x4*)(vp + 8) : (u32x4){0u, 0u, 0u, 0u}; } \
        if (tid < 64) { gx = BG[(t0_ + tid) * 8 + 4 + h_]; gbt = BG[(t0_ + tid) * 8 + h_]; } } while (0)
    if ((int)blockIdx.x < 1024) CP_LOAD((int)blockIdx.x);
  for (int item = blockIdx.x; item < 1024; item += gridDim.x) {
    asm volatile("" : "+v"(tid), "+v"(lane));
    const int bh = item >> 5, n = item & 31, b = bh >> 2, h = bh & 3, ql = lane & 31, hh = lane >> 5;
    const size_t t0 = (size_t)b * SEQ + n * 64;
    LAS float* gcS = (LAS float*)(lds + CP_GC); LAS float* btS = (LAS float*)(lds + CP_BT);
    LAS float* LS = (LAS float*)(lds + CP_LS);
    LAS bf16_t* TuS = (LAS bf16_t*)(lds + CP_TU); LAS bf16_t* TwS = (LAS bf16_t*)(lds + CP_TW);
    LAS bf16_t* kT = (LAS bf16_t*)(lds + CP_KT); LAS bf16_t* vT = (LAS bf16_t*)(lds + CP_VT); LAS bf16_t* qS = (LAS bf16_t*)(lds + CP_QS); LAS bf16_t* kS = (LAS bf16_t*)(lds + CP_KS);
    LAS bf16_t* AQ = (LAS bf16_t*)(lds + CP_AQ); LAS bf16_t* L21b = (LAS bf16_t*)(lds + CP_L21); LAS bf16_t* Tcm = (LAS bf16_t*)(lds + CP_TCM); LAS bf16_t* T22r = (LAS bf16_t*)(lds + CP_T22);
    if (tid < 64) { float x = gx;
#pragma unroll
        for (int o = 1; o < 64; o <<= 1) { const float y = __shfl_up(x, o); if (lane >= o) x += y; }
        gcS[tid] = x; btS[tid] = gbt; }
    { const int tok = tid >> 3, c16 = (tid & 7) * 16;
        *(LAS u32x4*)(kS + tok * PQ + c16) = ka; *(LAS u32x4*)(kS + tok * PQ + c16 + 8) = kb;
        *(LAS u32x4*)(qS + tok * PQ + c16) = qa; *(LAS u32x4*)(qS + tok * PQ + c16 + 8) = qb;
        const unsigned kw[8] = {ka.x, ka.y, ka.z, ka.w, kb.x, kb.y, kb.z, kb.w};
#pragma unroll
        for (int e = 0; e < 8; ++e) { kT[(c16 + 2 * e) * PT + tok] = (bf16_t)(kw[e] & 0xffffu); kT[(c16 + 2 * e + 1) * PT + tok] = (bf16_t)(kw[e] >> 16); }
        float y[16];
#pragma unroll
        for (int e = 0; e < 16; ++e) y[e] = 0.f;
#pragma unroll
        for (int i = 0; i < 4; ++i) { const float* wp = p.in[I_WCONV] + i * 1536 + 1024 + h * 128 + c16;
            const unsigned xw[8] = {xv[i][0].x, xv[i][0].y, xv[i][0].z, xv[i][0].w, xv[i][1].x, xv[i][1].y, xv[i][1].z, xv[i][1].w};
#pragma unroll
            for (int e = 0; e < 8; ++e) { y[2 * e] += wp[2 * e] * bf_lo(xw[e]); y[2 * e + 1] += wp[2 * e + 1] * bf_hi(xw[e]); } }
#pragma unroll
        for (int e = 0; e < 16; ++e) vT[(c16 + e) * PT + tok] = f2bf(fsilu(y[e])); }
    __syncthreads();
    if (item + (int)gridDim.x < 1024) CP_LOAD(item + (int)gridDim.x);
    if (wave == 0) {
        bf16x8 kf[2][8];
#pragma unroll
        for (int t = 0; t < 2; ++t)
#pragma unroll
            for (int ks = 0; ks < 8; ++ks) kf[t][ks] = *(const LAS bf16x8*)(kS + (32 * t + ql) * PQ + 16 * ks + 8 * hh);
#pragma unroll
        for (int tt = 0; tt < 3; ++tt) { const int it = tt == 0 ? 0 : 1, jt = tt == 2 ? 1 : 0;
            f32x16 acc;
#pragma unroll
            for (int r = 0; r < 16; ++r) acc[r] = 0.f;
#pragma unroll
            for (int ks = 0; ks < 8; ++ks) acc = MFMA32(kf[it][ks], kf[jt][ks], acc);
            const int j = 32 * jt + ql; const float gj = gcS[j];
#pragma unroll
            for (int r = 0; r < 16; ++r) { const int i = 32 * it + crow(r, hh); const float l = (j < i) ? btS[i] * acc[r] * fexp(gcS[i] - gj) : 0.f;
                if (it != jt) L21b[(i - 32) * PB + j] = f2bf(l); else LS[i * PL + j] = l; } }
    } else if (wave < 4) {
        const int jt = wave == 3 ? 1 : 0, it = wave == 1 ? 0 : 1;
        f32x16 acc;
#pragma unroll
        for (int r = 0; r < 16; ++r) acc[r] = 0.f;
#pragma unroll
        for (int ks = 0; ks < 8; ++ks) acc = MFMA32(*(const LAS bf16x8*)(kS + (32 * jt + ql) * PQ + 16 * ks + 8 * hh), *(const LAS bf16x8*)(qS + (32 * it + ql) * PQ + 16 * ks + 8 * hh), acc);
        const int i = 32 * it + ql; const float gi = gcS[i];
#pragma unroll
        for (int r = 0; r < 16; ++r) { const int j = 32 * jt + crow(r, hh); acc[r] = (j <= i) ? acc[r] * fexp(gi - gcS[j]) : 0.f; }
#pragma unroll
        for (int bq = 0; bq < 4; ++bq) *(LAS u32x2*)(AQ + i * PT + 32 * jt + 8 * bq + 4 * hh) = (u32x2){cpk2(acc[4 * bq], acc[4 * bq + 1]), cpk2(acc[4 * bq + 2], acc[4 * bq + 3])};
    } else {
        const float gl = gcS[63];
#pragma unroll
        for (int uu = 0; uu < 2; ++uu) { const int unit = (tid - 256) + 256 * uu, dk = unit >> 2, blk = unit & 3;
            const u32x4 k0 = *(const LAS u32x4*)(kT + dk * PT + 16 * blk), k1 = *(const LAS u32x4*)(kT + dk * PT + 16 * blk + 8);
            float kv[16] = {bf_lo(k0.x), bf_hi(k0.x), bf_lo(k0.y), bf_hi(k0.y), bf_lo(k0.z), bf_hi(k0.z), bf_lo(k0.w), bf_hi(k0.w), bf_lo(k1.x), bf_hi(k1.x), bf_lo(k1.y), bf_hi(k1.y), bf_lo(k1.z), bf_hi(k1.z), bf_lo(k1.w), bf_hi(k1.w)};
#pragma unroll
            for (int e = 0; e < 16; ++e) kv[e] *= fexp(gl - gcS[16 * blk + e]);
            float pv[16];
#pragma unroll
            for (int e = 0; e < 16; ++e) pv[permpos(e)] = kv[e];
            pack16(P + slotP(t0, h, C_VSB, dk * 64 + 16 * blk), pv); }
        if (tid == 256) ((float*)(p.ws + WS_EGL))[bh * 32 + n] = fexp(gl);
    }
    __syncthreads();
    if (wave == 0) {
        const LAS float* LB = LS + (32 * hh) * PL + 32 * hh;
        float Tc[32];
#pragma unroll
        for (int i = 0; i < 32; ++i) {
            float a0 = (ql == i) ? 1.0f : 0.f, a1 = 0.f, a2 = 0.f, a3 = 0.f;
#pragma unroll
            for (int j4 = 0; j4 < i; j4 += 4) { const f32x4 l4 = *(const LAS f32x4*)(LB + i * PL + j4);
                a0 -= l4[0] * Tc[j4]; if (j4 + 1 < i) a1 -= l4[1] * Tc[j4 + 1]; if (j4 + 2 < i) a2 -= l4[2] * Tc[j4 + 2]; if (j4 + 3 < i) a3 -= l4[3] * Tc[j4 + 3]; }
            Tc[i] = (a0 + a1) + (a2 + a3); }
        const int cg_ = 32 * hh + ql; const float bu = btS[cg_], bw = bu * fexp(gcS[cg_]);
#pragma unroll
        for (int i = 0; i < 32; ++i) { TuS[(32 * hh + i) * PT + cg_] = f2bf(Tc[i] * bu); TwS[(32 * hh + i) * PT + cg_] = f2bf(Tc[i] * bw); }
        if (hh == 0) {
#pragma unroll
            for (int i8 = 0; i8 < 4; ++i8) *(LAS u32x4*)(Tcm + ql * PB + 8 * i8) = (u32x4){cpk2(Tc[8 * i8], Tc[8 * i8 + 1]), cpk2(Tc[8 * i8 + 2], Tc[8 * i8 + 3]), cpk2(Tc[8 * i8 + 4], Tc[8 * i8 + 5]), cpk2(Tc[8 * i8 + 6], Tc[8 * i8 + 7])};
        } else {
#pragma unroll
            for (int i = 0; i < 32; ++i) T22r[i * PB + ql] = f2bf(Tc[i]);
        }
        LDS_WAIT();
        f32x16 x1;
#pragma unroll
        for (int r = 0; r < 16; ++r) x1[r] = 0.f;
#pragma unroll
        for (int s2 = 0; s2 < 2; ++s2) x1 = MFMA32(*(const LAS bf16x8*)(L21b + ql * PB + 16 * s2 + 8 * hh), *(const LAS bf16x8*)(Tcm + ql * PB + 16 * s2 + 8 * hh), x1);
        f32x16 yy;
#pragma unroll
        for (int r = 0; r < 16; ++r) yy[r] = 0.f;
#pragma unroll
        for (int s2 = 0; s2 < 2; ++s2) { const u32x2 lo = *(const LAS u32x2*)(T22r + ql * PB + 16 * s2 + 4 * hh), hi = *(const LAS u32x2*)(T22r + ql * PB + 16 * s2 + 8 + 4 * hh);
            const u32x4 af = {lo.x, lo.y, hi.x, hi.y};
            yy = MFMA32(__builtin_bit_cast(bf16x8, af), pack8(x1, s2), yy); }
        { const float bu0 = btS[ql], bw0 = bu0 * fexp(gcS[ql]);
#pragma unroll
            for (int r = 0; r < 16; ++r) { const int i2 = 32 + crow(r, hh); TuS[i2 * PT + ql] = f2bf(-yy[r] * bu0); TwS[i2 * PT + ql] = f2bf(-yy[r] * bw0); } }
    }
    __syncthreads();
    {
        const int isW = wave >> 2, ct = wave & 3, col = 32 * ct + ql;
        const LAS bf16_t* Ta = (isW ? TwS : TuS) + 8 * hh; const LAS bf16_t* Bs = (isW ? kT : vT) + col * PT + 8 * hh;
        bf16x8 bf[4];
#pragma unroll
        for (int ks = 0; ks < 4; ++ks) bf[ks] = *(const LAS bf16x8*)(Bs + 16 * ks);
        f32x16 xa[2];
#pragma unroll
        for (int jt = 0; jt < 2; ++jt) {
#pragma unroll
            for (int r = 0; r < 16; ++r) xa[jt][r] = 0.f;
#pragma unroll
            for (int ks = 0; ks < 4; ++ks) if (jt == 1 || ks < 2) xa[jt] = MFMA32(*(const LAS bf16x8*)(Ta + (32 * jt + ql) * PT + 16 * ks), bf[ks], xa[jt]); }
        bf16x8 xb[4] = {pack8(xa[0], 0), pack8(xa[0], 1), pack8(xa[1], 0), pack8(xa[1], 1)};
        f32x16 ra[2];
#pragma unroll
        for (int it = 0; it < 2; ++it) {
#pragma unroll
            for (int r = 0; r < 16; ++r) ra[it][r] = 0.f;
#pragma unroll
            for (int kk = 0; kk < 4; ++kk) if (it == 1 || kk < 2) { const LAS bf16_t* ap = AQ + (32 * it + ql) * PT + 16 * kk + 4 * hh;
                const u32x2 lo = *(const LAS u32x2*)ap, hi = *(const LAS u32x2*)(ap + 8); const u32x4 af = {lo.x, lo.y, hi.x, hi.y};
                ra[it] = MFMA32(__builtin_bit_cast(bf16x8, af), xb[kk], ra[it]); } }
        if (!isW) {
#pragma unroll
            for (int jt = 0; jt < 2; ++jt)
#pragma unroll
                for (int bq = 0; bq < 4; ++bq) { const int f = col * 64 + 32 * jt + 8 * bq + 4 * hh;
                    *(u32x2*)(U + slotU(t0, h, 0, f)) = (u32x2){cpk2(xa[jt][4 * bq], xa[jt][4 * bq + 1]), cpk2(xa[jt][4 * bq + 2], xa[jt][4 * bq + 3])};
                    *(u32x2*)(U + slotU(t0, h, 512, f)) = (u32x2){cpk2(ra[jt][4 * bq], ra[jt][4 * bq + 1]), cpk2(ra[jt][4 * bq + 2], ra[jt][4 * bq + 3])}; }
        } else {
            const int pc = permpos(col);
#pragma unroll
            for (int jt = 0; jt < 2; ++jt)
#pragma unroll
                for (int r = 0; r < 16; ++r) { const int tok = 32 * jt + crow(r, hh);
                    P[(t0 + tok) * NIN + C_QDN + h * 128 + pc] = f2bf(-xa[jt][r]);
                    P[(t0 + tok) * NIN + C_KDN + h * 128 + pc] = f2bf(bf2f(qS[tok * PQ + col]) * fexp(gcS[tok]) - ra[jt][r]); }
        }
    }
    __syncthreads();
  }
#undef CP_LOAD
}
constexpr int SC_PW = 136, SC_PK = 72, SC_NW = 0, SC_Q2 = 64 * SC_PW * 2, SC_KD = 2 * 64 * SC_PW * 2, SC_STAGE = 2 * 64 * SC_PW * 2 + 128 * SC_PK * 2, SC_OS = 2 * SC_STAGE,
              SC_US = SC_OS + 64 * SC_PW * 2, SC_OI = SC_US + 128 * SC_PK * 2, SC_END = SC_OI + 128 * SC_PK * 2;
static_assert(SC_END <= BST_OFF, "scan LDS");
__device__ __forceinline__ void gdn_scan_block(const Params& p, LAS unsigned char* lds, int bh, int tid, int wave, int lane) {
    asm volatile("" : "+v"(tid), "+v"(lane));
    bf16_t* P = (bf16_t*)(p.ws + WS_P); const bf16_t* U = (const bf16_t*)(p.ws + WS_U); const float* EGL = (const float*)(p.ws + WS_EGL);
    const int b = bh >> 2, h = bh & 3, ql = lane & 31, hh = lane >> 5;
    const size_t tb = (size_t)b * SEQ;
    LAS bf16_t* oS = (LAS bf16_t*)(lds + SC_OS);
    if (wave >= 4) {
        int lt = tid - 256, ftok = lt >> 2, fseg = lt & 3;
        u32x4 ra[20], rb[20];
#define SC_LOAD(r, n_) do { const size_t t0_ = tb + (size_t)(n_) * 64; _Pragma("unroll") for (int i = 0; i < 4; ++i) { const int c = lt + 256 * i, row = c >> 4, c8 = (c & 15) * 8; \
            const bf16_t* g_ = P + (t0_ + row) * NIN + h * 128 + c8; const bf16_t* u_ = U + (t0_ + row) * D + h * 128 + c8; \
            r[i] = *(const u32x4*)(g_ + C_QDN); r[4 + i] = *(const u32x4*)(g_ + C_KDN); r[8 + i] = *(const u32x4*)(g_ + C_VSB); r[12 + i] = *(const u32x4*)u_; r[16 + i] = *(const u32x4*)(u_ + 512); } } while (0)
#define SC_STORE(r, st_) do { LAS unsigned char* s_ = lds + (st_) * SC_STAGE; _Pragma("unroll") for (int i = 0; i < 4; ++i) { const int c = lt + 256 * i, row = c >> 4, c8 = (c & 15) * 8; \
            *(LAS u32x4*)(s_ + SC_NW + (row * SC_PW + c8) * 2) = r[i]; *(LAS u32x4*)(s_ + SC_Q2 + (row * SC_PW + c8) * 2) = r[4 + i]; \
            *(LAS u32x4*)(s_ + SC_KD + ((2 * row + (c8 >> 6)) * SC_PK + (c8 & 63)) * 2) = r[8 + i]; } } while (0)
#define SC_STOREU(r) do { _Pragma("unroll") for (int i = 0; i < 4; ++i) { const int c = lt + 256 * i, row = c >> 4, c8 = (c & 15) * 8; const int o_ = ((2 * row + (c8 >> 6)) * SC_PK + (c8 & 63)) * 2; \
            *(LAS u32x4*)(lds + SC_US + o_) = r[12 + i]; *(LAS u32x4*)(lds + SC_OI + o_) = r[16 + i]; } } while (0)
#define SC_FIN(m_) do { bf16_t* orow = P + (tb + (size_t)(m_) * 64 + ftok) * NIN + h * 128 + fseg * 32 + C_VDN; \
            _Pragma("unroll") for (int i = 0; i < 4; ++i) *(u32x4*)(orow + 8 * i) = *(const LAS u32x4*)(oS + ftok * SC_PW + fseg * 32 + 8 * i); } while (0)
        SC_LOAD(ra, 0); SC_STORE(ra, 0); SC_STOREU(ra); SC_LOAD(ra, 1);
        __syncthreads();
#pragma unroll 1
        for (int n = 0; n < 32; n += 2) {
            asm volatile("" : "+v"(lt), "+v"(ftok), "+v"(fseg));
            if (n + 2 < 32) SC_LOAD(rb, n + 2);
            SC_STORE(ra, 1);
            if (n > 0) SC_FIN(n - 1);
            __syncthreads();
            SC_STOREU(ra);
            __syncthreads();
            if (n + 3 < 32) SC_LOAD(ra, n + 3);
            if (n + 2 < 32) SC_STORE(rb, 0);
            SC_FIN(n);
            __syncthreads();
            if (n + 2 < 32) SC_STOREU(rb);
            __syncthreads();
        }
        SC_FIN(31);
#undef SC_LOAD
#undef SC_STORE
#undef SC_STOREU
#undef SC_FIN
    } else {
        const int col = 32 * wave + ql;
        f32x16 S[4];
#pragma unroll
        for (int rt = 0; rt < 4; ++rt)
#pragma unroll
            for (int r = 0; r < 16; ++r) S[rt][r] = 0.f;
        const float eglv = EGL[bh * 32 + ql];
        __syncthreads();
#pragma unroll 1
        for (int n = 0; n < 32; ++n) {
            const float egl = __builtin_bit_cast(float, __builtin_amdgcn_readlane(__builtin_bit_cast(int, eglv), n));
            const LAS unsigned char* st = lds + (n & 1) * SC_STAGE;
            f32x16 vn[2], oa[2];
            { const LAS unsigned char* up_ = lds + SC_US + (col * SC_PK + 4 * hh) * 2; const LAS unsigned char* op_ = lds + SC_OI + (col * SC_PK + 4 * hh) * 2;
#pragma unroll
              for (int jt = 0; jt < 2; ++jt)
#pragma unroll
                for (int bq = 0; bq < 4; ++bq) { const u32x2 uw = *(const LAS u32x2*)(up_ + (32 * jt + 8 * bq) * 2), ow = *(const LAS u32x2*)(op_ + (32 * jt + 8 * bq) * 2);
                    vn[jt][4 * bq] = bf_lo(uw.x); vn[jt][4 * bq + 1] = bf_hi(uw.x); vn[jt][4 * bq + 2] = bf_lo(uw.y); vn[jt][4 * bq + 3] = bf_hi(uw.y);
                    oa[jt][4 * bq] = bf_lo(ow.x); oa[jt][4 * bq + 1] = bf_hi(ow.x); oa[jt][4 * bq + 2] = bf_lo(ow.y); oa[jt][4 * bq + 3] = bf_hi(ow.y); } }
            const LAS unsigned char* w0_ = st + (ql * SC_PW + 8 * hh) * 2; const LAS unsigned char* w1_ = w0_ + 32 * SC_PW * 2;
            const LAS unsigned char* kd_ = st + SC_KD + (ql * SC_PK + 8 * hh) * 2;
            bf16x8 fa[4], fb[4];
#define SC_RD4(dst, ptr) do { _Pragma("unroll") for (int i_ = 0; i_ < 4; ++i_) dst[i_] = *(const LAS bf16x8*)((ptr) + 32 * i_); } while (0)
#define SC_MM4(acc, fr, bb) do { _Pragma("unroll") for (int i_ = 0; i_ < 4; ++i_) acc = MFMA32(fr[i_], bb[i_], acc); __builtin_amdgcn_sched_barrier(0); } while (0)
            SC_RD4(fa, w0_ + SC_NW); SC_RD4(fb, w1_ + SC_NW);
            { bf16x8 sb[4] = {pack8(S[0], 0), pack8(S[0], 1), pack8(S[1], 0), pack8(S[1], 1)};
              SC_MM4(vn[0], fa, sb); SC_RD4(fa, w0_ + SC_Q2);
              SC_MM4(vn[1], fb, sb); SC_RD4(fb, w1_ + SC_Q2);
              SC_MM4(oa[0], fa, sb); SC_RD4(fa, w0_ + SC_NW + 128);
              SC_MM4(oa[1], fb, sb); SC_RD4(fb, w1_ + SC_NW + 128); }
            { bf16x8 sb[4] = {pack8(S[2], 0), pack8(S[2], 1), pack8(S[3], 0), pack8(S[3], 1)};
              SC_MM4(vn[0], fa, sb); SC_RD4(fa, w0_ + SC_Q2 + 128);
              SC_MM4(vn[1], fb, sb); SC_RD4(fb, w1_ + SC_Q2 + 128);
              bf16x8 vb[4] = {pack8(vn[0], 0), pack8(vn[0], 1), pack8(vn[1], 0), pack8(vn[1], 1)};
              SC_MM4(oa[0], fa, sb); SC_RD4(fa, kd_);
              SC_MM4(oa[1], fb, sb); SC_RD4(fb, kd_ + 32 * SC_PK * 2);
#pragma unroll
              for (int rt = 0; rt < 4; ++rt)
#pragma unroll
                  for (int r = 0; r < 16; ++r) S[rt][r] *= egl;
              SC_MM4(S[0], fa, vb); SC_RD4(fa, kd_ + 64 * SC_PK * 2);
              SC_MM4(S[1], fb, vb); SC_RD4(fb, kd_ + 96 * SC_PK * 2);
              SC_MM4(S[2], fa, vb);
              SC_MM4(S[3], fb, vb); }
#undef SC_RD4
#undef SC_MM4
            __syncthreads();
#pragma unroll
            for (int jt = 0; jt < 2; ++jt)
#pragma unroll
                for (int r = 0; r < 16; ++r) oS[(32 * jt + crow(r, hh)) * SC_PW + col] = f2bf(oa[jt][r]);
            __syncthreads();
        }
    }
}
__device__ __forceinline__ void gdn_finalize_phase(const Params& p, int wave, int lane) {
    asm volatile("" : "+v"(lane));
    bf16_t* P = (bf16_t*)(p.ws + WS_P);
    const int c0 = (lane & 15) * 8;
    float gg[8];
#pragma unroll
    for (int e = 0; e < 8; ++e) gg[e] = p.in[I_GDNOUT][c0 + e];
    for (int row = blockIdx.x * 8 + wave; row < T; row += gridDim.x * 8) {
        bf16_t* op = P + (size_t)row * NIN + C_VDN + lane * 8; const bf16_t* zp = P + (size_t)row * NIN + C_ZDN + lane * 8;
        const u32x4 ow = *(const u32x4*)op, zw = *(const u32x4*)zp;
        const float o[8] = {bf_lo(ow.x), bf_hi(ow.x), bf_lo(ow.y), bf_hi(ow.y), bf_lo(ow.z), bf_hi(ow.z), bf_lo(ow.w), bf_hi(ow.w)};
        const float z[8] = {bf_lo(zw.x), bf_hi(zw.x), bf_lo(zw.y), bf_hi(zw.y), bf_lo(zw.z), bf_hi(zw.z), bf_lo(zw.w), bf_hi(zw.w)};
        float ss = 0.f;
#pragma unroll
        for (int e = 0; e < 8; ++e) ss += o[e] * o[e];
        ss += __shfl_xor(ss, 1); ss += __shfl_xor(ss, 2); ss += __shfl_xor(ss, 4); ss += __shfl_xor(ss, 8);
        const float rstd = 1.0f / sqrtf(ss * (1.f / 128.f) + EPS);
        float r[8];
#pragma unroll
        for (int e = 0; e < 8; ++e) r[e] = o[e] * rstd * gg[e] * fsilu(z[e]);
        u32x4 w; w.x = pk2(r[0], r[1]); w.y = pk2(r[2], r[3]); w.z = pk2(r[4], r[5]); w.w = pk2(r[6], r[7]);
        *(u32x4*)op = w;
    }
}

#define XB_TMO      128
#define XB_XCNT(j)  (256  + 64 * (j))
#define XB_XSUB(j)  (1280 + 64 * (j))
#define XB_XGEN(j)  (2304 + 64 * (j))
#define XB_TOP      3328
#define XB_TOPGEN   3392
#define XCD_BAR_WORDS 3456
#define XB_SPIN_CAP (1u << 18)
__device__ __forceinline__ unsigned xb_ld(unsigned* p)              { return __hip_atomic_load(p, __ATOMIC_RELAXED, __HIP_MEMORY_SCOPE_AGENT); }
__device__ __forceinline__ unsigned xb_add(unsigned* p, unsigned v) { return __hip_atomic_fetch_add(p, v, __ATOMIC_RELAXED, __HIP_MEMORY_SCOPE_AGENT); }
__device__ __forceinline__ unsigned xb_xcc_id() { return (unsigned)__builtin_amdgcn_s_getreg((3 << 11) | 20) & 0xFu; }
#define XB_SPIN(cond, bar) do { unsigned _sp = 0; while (cond) { __builtin_amdgcn_s_sleep(1); \
    if ((++_sp & 255u) == 0u) { if (xb_ld(&(bar)[XB_TMO])) break; if (_sp > XB_SPIN_CAP) { atomicAdd(&(bar)[XB_TMO], 1u); break; } } } } while (0)
struct XcdBarrier { unsigned* bar; unsigned x; volatile LAS unsigned* st; };
__device__ __forceinline__ XcdBarrier xcd_barrier_post(unsigned* bar, volatile LAS unsigned* st) {
    XcdBarrier b; b.bar = bar; b.x = xb_xcc_id(); b.st = st;
    if (threadIdx.x == 0) (void)xb_add(&bar[XB_XCNT(b.x)], 1u);
    return b;
}
__device__ __forceinline__ void xcd_barrier_complete(unsigned* bar, unsigned x, unsigned& nloc, unsigned& nx) {
    const unsigned G = gridDim.x * gridDim.y * gridDim.z;
    unsigned sum, cnt, mine, sp = 0u;
    for (;;) {
        sum = 0u; cnt = 0u; mine = 0u;
#pragma unroll
        for (unsigned j = 0; j < 16; ++j) { const unsigned c = xb_ld(&bar[XB_XCNT(j)]); sum += c; cnt += (c > 0u) ? 1u : 0u; mine = (j == x) ? c : mine; }
        if (sum == G) break;
        __builtin_amdgcn_s_sleep(1);
        if ((++sp & 255u) == 0u) { if (xb_ld(&bar[XB_TMO])) break; if (sp > XB_SPIN_CAP) { atomicAdd(&bar[XB_TMO], 1u); break; } }
    }
    nloc = mine > 0u ? mine : 1u; nx = cnt > 0u ? cnt : 1u;
}
__device__ __forceinline__ void xcd_barrier(const XcdBarrier& b) {
    asm volatile("s_waitcnt vmcnt(0)" ::: "memory");
    __syncthreads();
    if (threadIdx.x == 0) {
        unsigned* bar = b.bar;
        __builtin_amdgcn_s_waitcnt(0);
        unsigned nloc = b.st[0], nx = b.st[1];
        if (nloc == 0u) { xcd_barrier_complete(bar, b.x, nloc, nx); b.st[0] = nloc; b.st[1] = nx; }
        const unsigned old = xb_add(&bar[XB_XSUB(b.x)], 1u);
        const unsigned gen = old / nloc;
        if (old + 1u == (gen + 1u) * nloc) {
            __builtin_amdgcn_fence(__ATOMIC_RELEASE, "agent");
            asm volatile("s_waitcnt vmcnt(0)" ::: "memory");
            const unsigned og = xb_add(&bar[XB_TOP], 1u);
            const unsigned tg = og / nx;
            if (og + 1u == (tg + 1u) * nx) xb_add(&bar[XB_TOPGEN], 1u);
            else XB_SPIN(xb_ld(&bar[XB_TOPGEN]) == tg, bar);
            __builtin_amdgcn_fence(__ATOMIC_ACQUIRE, "agent");
            xb_add(&bar[XB_XGEN(b.x)], 1u);
            asm volatile("s_waitcnt vmcnt(0)" ::: "memory");
        } else {
            XB_SPIN(xb_ld(&bar[XB_XGEN(b.x)]) == gen, bar);
            __builtin_amdgcn_fence(__ATOMIC_ACQUIRE, "agent");
            asm volatile("s_waitcnt vmcnt(0)" ::: "memory");
        }
    }
    __syncthreads();
}

#ifndef PHMASK
#define PHMASK 0xFFFF
#endif
#define PH(n) ((PHMASK >> (n)) & 1)
#ifndef PROBE
#define PROBE 0
#endif
#define REP(g) for (int _rep = 0; _rep < ((PROBE == (g)) ? 2 : 1); ++_rep)
__global__ void __launch_bounds__(512, 2) fwd_megakernel(Params p) {
    extern __shared__ __attribute__((aligned(16))) unsigned char lds_raw[];
    LAS unsigned char* lds = (LAS unsigned char*)lds_raw;
    cg::grid_group grid = cg::this_grid();
    const int tid = threadIdx.x, lane = tid & 63, wave = __builtin_amdgcn_readfirstlane(tid >> 6);
    const int G = gridDim.x, gw = wave * G + blockIdx.x, ngw = G * 8;
    unsigned char* ws = p.ws;
    bf16_t* U = (bf16_t*)(ws + WS_U); bf16_t* P = (bf16_t*)(ws + WS_P);
    const float* mod = (const float*)(ws + WS_MOD);
    LAS float* scr = (LAS float*)(lds + wave * 16384);

    unsigned* barw = (unsigned*)(ws + WS_BAR);
    volatile LAS unsigned* bst = (volatile LAS unsigned*)(lds + BST_OFF);
    if (tid < 2) bst[tid] = 0u;
    __syncthreads();
    if (p.ws == nullptr) grid.sync();
    const XcdBarrier xbar = xcd_barrier_post(barw, bst);
    REP(1) { if (PH(0)) for (int it = blockIdx.x; it < NMOD / 64; it += G) mod_item(p, lds, it, tid, wave, lane);
    if (PH(0)) ffn_weight_items(p.in[I_WFFN1IN], p.in[I_WFFN1OUT], (bf16_t*)(ws + W_FFIN), (bf16_t*)(ws + W_FFOUT), scr, gw, ngw, lane);
    __syncthreads(); }
    xcd_barrier(xbar);
    if (PROBE == 3) for (int i = 0; i < 16; ++i) xcd_barrier(xbar);
    REP(1) if (PH(1)) norm_mod_phase<false>(p, lds, p.in[I_X], p.in[I_GFFN1], 0, U, tid, wave, lane);
    xcd_barrier(xbar);
    REP(2) if (PH(2)) run_gemm(lds, U, D, (const bf16_t*)(ws + W_FFIN), 2 * FF, D, EpiSwiGLU{P, FF});
    { const int nfull = (64 * 22) % G, nidle = nfull ? G - nfull : G;
      const int ib = nfull ? (int)blockIdx.x - nfull : (int)blockIdx.x;
      if (PH(0) && ib >= 0) mixer_weight_items(p, scr, wave * nidle + ib, nidle * 8, lane); }
    xcd_barrier(xbar);
    REP(2) if (PH(3)) run_gemm(lds, P, FF, (const bf16_t*)(ws + W_FFOUT), D, FF, EpiResid{p.in[I_X], p.out, mod + 2 * D, 0.5f});
    xcd_barrier(xbar);
    REP(1) if (PH(4)) norm_mod_phase<true>(p, lds, p.out, p.in[I_GMIX], 3, U, tid, wave, lane);
    xcd_barrier(xbar);
    REP(2) if (PH(5)) run_gemm(lds, U, D, (const bf16_t*)(ws + W_IN), NIN, D, EpiBf16{P, NIN});
    xcd_barrier(xbar);
    if (PH(6)) prep_phase(p, wave, lane);
    xcd_barrier(xbar);
    if (PH(7)) gdn_chunk_prep_phase(p, lds, tid, wave, lane);
    xcd_barrier(xbar);
    if (PH(15)) for (int it = blockIdx.x; it < 32; it += G) gdn_scan_block(p, lds, it, tid, wave, lane);
    if (PH(8)) {
        const unsigned x0 = xb_xcc_id() & 7u;
        for (unsigned dx = 0; dx < 8u; ++dx) { const unsigned x = (x0 + dx) & 7u; unsigned* ctr = (unsigned*)(ws + WS_CTR) + 64 * x;
            for (;;) { unsigned idx = 0; if (lane == 0) idx = atomicAdd(ctr, 1u); idx = __builtin_amdgcn_readfirstlane(idx);
                if (idx >= 512u) break;
                attn_item_mfma(P, (const bf16_t*)(ws + WS_VT), (int)(8u * x + (idx & 7u)), 63 - (int)(idx >> 3), lane); } } }
    xcd_barrier(xbar);
    if (PH(9)) gdn_finalize_phase(p, wave, lane);
    xcd_barrier(xbar);
    if (PH(10)) run_gemm(lds, P + C_QSB, NIN, (const bf16_t*)(ws + W_UPSB), D, 1024, EpiGateFused{P + C_RSB, P + C_RDN, U}, 8, (C_VDN - C_QSB) * 2 - 8 * 128);
    xcd_barrier(xbar);
    if (PH(11)) run_gemm(lds, U, D, (const bf16_t*)(ws + W_OUT), D, D, EpiResid{p.out, p.out, mod + 5 * D, 1.0f});
    xcd_barrier(xbar);
    REP(1) if (PH(12)) norm_mod_phase<false>(p, lds, p.out, p.in[I_GFFN2], 6, U, tid, wave, lane);
    __syncthreads();
    if (PH(12)) ffn_weight_items(p.in[I_WFFN2IN], p.in[I_WFFN2OUT], (bf16_t*)(ws + W_FFIN), (bf16_t*)(ws + W_FFOUT), scr, gw, ngw, lane);
    xcd_barrier(xbar);
    REP(2) if (PH(13)) run_gemm(lds, U, D, (const bf16_t*)(ws + W_FFIN), 2 * FF, D, EpiSwiGLU{P, FF});
    xcd_barrier(xbar);
    if (PH(14)) run_gemm(lds, P, FF, (const bf16_t*)(ws + W_FFOUT), D, FF, EpiResid{p.out, p.out, mod + 8 * D, 0.5f});
}

extern "C" void kernel_launch(void* const* d_in, const int* in_sizes, int n_in, void* d_out, int out_size, void* d_ws, size_t ws_size, hipStream_t stream) {
    static int grid_blocks = 0;
    if (!grid_blocks) {
        int dev = 0, cus = 0, per_cu = 0;
        (void)hipGetDevice(&dev);
        (void)hipDeviceGetAttribute(&cus, hipDeviceAttributeMultiprocessorCount, dev);
        (void)hipFuncSetAttribute((const void*)fwd_megakernel, hipFuncAttributeMaxDynamicSharedMemorySize, LDS_BYTES);
        (void)hipOccupancyMaxActiveBlocksPerMultiprocessor(&per_cu, (const void*)fwd_megakernel, 512, LDS_BYTES);
        if (per_cu < 1) { fprintf(stderr, "occupancy query says %d blocks/CU\n", per_cu); per_cu = 1; }
        grid_blocks = cus;
    }
    Params p{};
    for (int i = 0; i < N_IN; ++i) p.in[i] = (const float*)d_in[i];
    p.out = (float*)d_out; p.ws = (unsigned char*)d_ws;
    (void)hipMemsetAsync((char*)d_ws + WS_CTR, 0, (WS_BAR - WS_CTR) + XCD_BAR_WORDS * 4, stream);
    void* args[] = {&p};
    hipError_t e = hipLaunchCooperativeKernel((const void*)fwd_megakernel, dim3(grid_blocks), dim3(512), args, LDS_BYTES, stream);
    if (e != hipSuccess) fprintf(stderr, "cooperative launch failed: %s (grid %d)\n", hipGetErrorString(e), grid_blocks);
}
```

```cpp
#include <hip/hip_runtime.h>
#include <hip/hip_cooperative_groups.h>
#include <cstdio>
namespace cg = cooperative_groups;

#define LAS __attribute__((address_space(3)))
typedef unsigned short bf16_t;
typedef short bf16x8 __attribute__((ext_vector_type(8)));
typedef float f32x4 __attribute__((ext_vector_type(4)));
typedef unsigned u32x4 __attribute__((ext_vector_type(4)));
typedef unsigned u32x2 __attribute__((ext_vector_type(2)));
typedef float f32x16 __attribute__((ext_vector_type(16)));
typedef float f32x2 __attribute__((ext_vector_type(2)));
typedef __bf16 nbf16x2 __attribute__((ext_vector_type(2)));

constexpr int T = 16384, D = 1024, SEQ = 2048, NB = 8, FF = 2816, NIN = 5632, INW = 5640, NMOD = 9216;
constexpr int C_QSB = 0, C_KSB = 512, C_VSB = 1024, C_QDN = 1536, C_KDN = 2048, C_VDN = 2560, C_ZDN = 3072, C_RSB = 3584, C_RDN = 4608;
constexpr float EPS = 1e-6f;
constexpr int LDS_BYTES = 163840, BST_OFF = LDS_BYTES - 64;
constexpr size_t MiB = 1024 * 1024;
constexpr size_t WS_MOD = 0, WS_BG = 512 * 1024, WS_SS = 242 * MiB, WS_W = 2 * MiB;
constexpr size_t W_FFIN = WS_W, W_FFOUT = W_FFIN + (size_t)2 * FF * D * 2, W_IN = W_FFOUT + (size_t)D * FF * 2, W_UPSB = W_IN + (size_t)NIN * D * 2,
                 W_UPDN = W_UPSB + (size_t)D * 512 * 2, W_OUT = W_UPDN + (size_t)D * 512 * 2, W_END = W_OUT + (size_t)D * D * 2;
constexpr size_t WS_U = 34 * MiB, WS_P = 66 * MiB;
static_assert(W_END <= WS_U, "weights overflow");
constexpr size_t WS_EGL = 384 * 1024, WS_CTR = 400 * 1024, WS_BAR = 416 * 1024;
constexpr size_t WS_VT = W_FFIN;
static_assert((size_t)T * 512 * 2 <= W_IN - W_FFIN, "Vt overflow");

enum { I_X = 0, I_C, I_WADA, I_BADA, I_GFFN1, I_WFFN1IN, I_WFFN1OUT, I_GMIX, I_WIN, I_GQSB, I_GKSB, I_WCONV, I_ALOG, I_DTBIAS, I_GDNOUT, I_WUPSB, I_WUPDN, I_WOUT, I_GFFN2, I_WFFN2IN, I_WFFN2OUT, N_IN };
struct Params { const float* in[N_IN]; float* out; unsigned char* ws; };

__device__ __forceinline__ float bf_lo(unsigned w) { return __uint_as_float(w << 16); }
__device__ __forceinline__ float bf_hi(unsigned w) { return __uint_as_float(w & 0xffff0000u); }
__device__ __forceinline__ float bf2f(bf16_t b) { return __uint_as_float(((unsigned)b) << 16); }
__device__ __forceinline__ unsigned pk2(float lo, float hi) { unsigned r; asm("v_cvt_pk_bf16_f32 %0, %1, %2" : "=v"(r) : "v"(lo), "v"(hi)); return r; }
__device__ __forceinline__ unsigned cpk2(float lo, float hi) { const f32x2 v = {lo, hi}; return __builtin_bit_cast(unsigned, __builtin_convertvector(v, nbf16x2)); }
__device__ __forceinline__ bf16_t f2bf(float f) { return (bf16_t)(pk2(f, 0.f) & 0xffffu); }
__device__ __forceinline__ float fexp(float x) { return __builtin_amdgcn_exp2f(x * 1.4426950408889634f); }
__device__ __forceinline__ float flog(float x) { return __builtin_amdgcn_logf(x) * 0.6931471805599453f; }
__device__ __forceinline__ float fsigmoid(float x) { return __builtin_amdgcn_rcpf(1.f + fexp(-x)); }
__device__ __forceinline__ float fsilu(float x) { return x * fsigmoid(x); }
__device__ __forceinline__ float fsoftplus(float x) { return fmaxf(x, 0.f) + flog(1.f + fexp(-fabsf(x))); }
__device__ __forceinline__ float wave_sum(float v) {
#pragma unroll
    for (int o = 1; o < 64; o <<= 1) v += __shfl_xor(v, o);
    return v;
}
#define LDS_WAIT() asm volatile("s_waitcnt lgkmcnt(0)" ::: "memory")

namespace pg8 {
constexpr int BM = 256, BK = 64, HALF = 128, HTB = HALF * BK * 2, STAGE_BYTES = 8 * HTB, NXCD = 8, WGM = 8;
__host__ __device__ __forceinline__ int lds_byte(int r, int c) { const int st = (r >> 4) * 2 + (c >> 5), rr = r & 15, cc = c & 31, ob = rr * 64 + cc * 2; return st * 1024 + (ob ^ (((ob >> 9) & 1) << 5)); }
__host__ __device__ __forceinline__ void stage_rc(int b, int& R, int& C) { const int st = b / 1024, sb = b % 1024, swz = sb ^ (((sb >> 9) & 1) << 5); R = (st >> 1) * 16 + swz / 64; C = (st & 1) * 32 + (swz % 64) / 2; }
__host__ __device__ __forceinline__ int perm32(int rho) { const int n = rho >> 4, i = rho & 15; return 8 * (i >> 2) + 4 * n + (i & 3); }
struct Unit { int pm, pn; };
struct Gemm { const bf16_t* A; const bf16_t* Bt; int M, N, K, lda; int jt; int jbytes; };
struct StaticOrder {
    int nM, nN, nwg, G, c;
    __host__ __device__ void init(int M, int N, int G_, int c_) { nM = M / BM; nN = N / BM; nwg = nM * nN; G = G_; c = c_; }
    __host__ __device__ bool next(int i, Unit& u) const {
        const long L = (long)i * G + c; if (L >= nwg) return false;
        int wgid = (int)L; { const int q = nwg / NXCD, r = nwg % NXCD, xcd = wgid % NXCD, off = wgid / NXCD; wgid = (xcd < r ? xcd * (q + 1) : r * (q + 1) + (xcd - r) * q) + off; }
        const int nig = WGM * nN, gid = wgid / nig, fm = gid * WGM, gsz = (nM - fm) < WGM ? (nM - fm) : WGM;
        u.pm = fm + ((wgid % nig) % gsz); u.pn = (wgid % nig) / gsz; return true;
    }
};
template <class Epi>
__device__ __forceinline__ void gemm_phase(LAS unsigned char* lds, const Gemm g, const StaticOrder& S, const Epi& E) {
    int tid = threadIdx.x; asm volatile("" : "+v"(tid));
    const int wid = __builtin_amdgcn_readfirstlane(tid >> 6), lane = tid & 63, wr = wid >> 2, wc = wid & 3, fr = lane & 15, fq = lane >> 4;
    const int K = g.K, nt = K / BK, lda = g.lda;
    unsigned voffA[2], voffB[2];
#pragma unroll
    for (int i = 0; i < 2; ++i) { int R, C; stage_rc(tid * 16 + i * 8192, R, C); const int Rb = Epi::PERM ? ((R & ~31) + perm32(R & 31)) : R;
        voffA[i] = (unsigned)(R * lda + C) * 2u; voffB[i] = (unsigned)(Rb * K + C) * 2u; }
    const size_t kstep = (size_t)(BK * 2);
    const size_t hstepA = (size_t)HALF * lda * 2, hstepB = (size_t)HALF * K * 2;
    const size_t tstepA = 2 * hstepA, tstepB = 2 * hstepB;
    const unsigned ldsw = (unsigned)wid * 1024u;
    const int aoff = lds_byte(wr * 64 + fr, fq * 8), boff = lds_byte(wc * 32 + fr, fq * 8);
#define PG8_SA(b, h) (((b) * 2 + (h)) * HTB)
#define PG8_SB(b, h) ((4 + (b) * 2 + (h)) * HTB)
#define PG8_STAGE(bufoff, gbase, voff) do { _Pragma("unroll") for (int _i = 0; _i < 2; ++_i) \
        __builtin_amdgcn_global_load_lds((const unsigned*)((const char*)(gbase) + (voff)[_i]), (LAS unsigned*)(lds + (bufoff) + ldsw + _i * 8192), 16, 0, 0); } while (0)
#define PG8_LDA(dst, b, h) do { _Pragma("unroll") for (int m = 0; m < 4; ++m) _Pragma("unroll") for (int k = 0; k < 2; ++k) dst[m][k] = *(const LAS bf16x8*)(lds + PG8_SA(b, h) + aoff + m * 2048 + k * 1024); } while (0)
#define PG8_LDB(dst, b, h) do { _Pragma("unroll") for (int n = 0; n < 2; ++n) _Pragma("unroll") for (int k = 0; k < 2; ++k) dst[n][k] = *(const LAS bf16x8*)(lds + PG8_SB(b, h) + boff + n * 2048 + k * 1024); } while (0)
#define PG8_MMA(ai, bj, At, Bt) do { __builtin_amdgcn_s_setprio(1); _Pragma("unroll") for (int m = 0; m < 4; ++m) _Pragma("unroll") for (int n = 0; n < 2; ++n) _Pragma("unroll") for (int k = 0; k < 2; ++k) \
        acc[ai][bj][m][n] = __builtin_amdgcn_mfma_f32_16x16x32_bf16(Bt[n][k], At[m][k], acc[ai][bj][m][n], 0, 0, 0); __builtin_amdgcn_s_setprio(0); } while (0)
#define PG8_WAIT_V(n) asm volatile("s_waitcnt vmcnt(" #n ")" ::: "memory")
#define PG8_WAIT_L(n) asm volatile("s_waitcnt lgkmcnt(" #n ")" ::: "memory")
#define PG8_BAR __builtin_amdgcn_s_barrier()
#define PG8_SCHED __builtin_amdgcn_sched_barrier(0)
    Unit cur, nxt; int ui = 0;
    if (!S.next(0, cur)) return;
    f32x4 acc[2][2][4][2];
#pragma unroll
    for (int a = 0; a < 2; ++a)
#pragma unroll
        for (int b = 0; b < 2; ++b)
#pragma unroll
            for (int m = 0; m < 4; ++m)
#pragma unroll
                for (int n = 0; n < 2; ++n) acc[a][b][m][n] = (f32x4){0.f, 0.f, 0.f, 0.f};
    bf16x8 At[4][2], B0[2][2], B1[2][2];
    const char* cA = (const char*)g.A + (size_t)cur.pm * tstepA; const char* cB = (const char*)g.Bt + (size_t)cur.pn * tstepB;
    PG8_STAGE(PG8_SB(0, 0), cB, voffB); PG8_STAGE(PG8_SA(0, 0), cA, voffA); PG8_STAGE(PG8_SB(0, 1), cB + hstepB, voffB); PG8_STAGE(PG8_SA(0, 1), cA + hstepA, voffA);
    if (wr == 1) PG8_BAR;
    PG8_WAIT_V(4); PG8_BAR;
    PG8_STAGE(PG8_SB(1, 0), cB + kstep, voffB); PG8_STAGE(PG8_SA(1, 0), cA + kstep, voffA); PG8_STAGE(PG8_SB(1, 1), cB + hstepB + kstep, voffB);
    PG8_WAIT_V(6); PG8_BAR;
    for (;;) {
        const bool has_next = S.next(ui + 1, nxt);
        const char* nA = has_next ? (const char*)g.A + (size_t)nxt.pm * tstepA : cA; const char* nB = has_next ? (const char*)g.Bt + (size_t)nxt.pn * tstepB : cB;
        for (int t = 0; t < nt; t += 2) {
            const bool last = (t == nt - 2);
            const char* a1 = cA + (size_t)(t + 1) * kstep + (t + 1 >= g.jt ? g.jbytes : 0);
            const char* a2 = last ? nA : cA + (size_t)(t + 2) * kstep + (t + 2 >= g.jt ? g.jbytes : 0); const char* b2 = last ? nB : cB + (size_t)(t + 2) * kstep;
            const char* a3 = a2 + kstep; const char* b3 = b2 + kstep;
            if constexpr (Epi::HAS_MID) { if (t == g.jt) E.mid(acc, cur, wr, wc, fr, fq); }
            PG8_LDB(B0, 0, 0); PG8_SCHED; PG8_LDA(At, 0, 0); PG8_STAGE(PG8_SA(1, 1), a1 + hstepA, voffA);
            PG8_WAIT_L(8); PG8_BAR; PG8_WAIT_L(0); PG8_MMA(0, 0, At, B0); PG8_BAR; PG8_SCHED;
            PG8_LDB(B1, 0, 1); PG8_STAGE(PG8_SB(0, 0), b2, voffB);
            PG8_BAR; PG8_WAIT_L(0); PG8_MMA(0, 1, At, B1); PG8_BAR;
            PG8_LDA(At, 0, 1); PG8_STAGE(PG8_SA(0, 0), a2, voffA);
            PG8_BAR; PG8_WAIT_L(0); PG8_MMA(1, 0, At, B0); PG8_BAR; PG8_SCHED;
            PG8_STAGE(PG8_SB(0, 1), b2 + hstepB, voffB);
            PG8_WAIT_V(6); PG8_BAR; PG8_MMA(1, 1, At, B1); PG8_BAR;
            PG8_LDB(B0, 1, 0); PG8_SCHED; PG8_LDA(At, 1, 0); PG8_STAGE(PG8_SA(0, 1), a2 + hstepA, voffA);
            PG8_WAIT_L(8); PG8_BAR; PG8_WAIT_L(0); PG8_MMA(0, 0, At, B0); PG8_BAR; PG8_SCHED;
            PG8_LDB(B1, 1, 1); PG8_STAGE(PG8_SB(1, 0), b3, voffB);
            PG8_BAR; PG8_WAIT_L(0); PG8_MMA(0, 1, At, B1); PG8_BAR;
            PG8_LDA(At, 1, 1); PG8_STAGE(PG8_SA(1, 0), a3, voffA);
            PG8_BAR; PG8_WAIT_L(0); PG8_MMA(1, 0, At, B0); PG8_BAR; PG8_SCHED;
            PG8_STAGE(PG8_SB(1, 1), b3 + hstepB, voffB);
            PG8_WAIT_V(6); PG8_BAR; PG8_MMA(1, 1, At, B1); PG8_BAR;
        }
        E(acc, cur, wr, wc, fr, fq);
        if (!has_next) break;
#pragma unroll
        for (int a = 0; a < 2; ++a)
#pragma unroll
            for (int b = 0; b < 2; ++b)
#pragma unroll
                for (int m = 0; m < 4; ++m)
#pragma unroll
                    for (int n = 0; n < 2; ++n) acc[a][b][m][n] = (f32x4){0.f, 0.f, 0.f, 0.f};
        cur = nxt; cA = nA; cB = nB; ++ui;
    }
    PG8_WAIT_V(0);
    if (wr == 0) PG8_BAR;
    PG8_BAR;
#undef PG8_SA
#undef PG8_SB
#undef PG8_STAGE
#undef PG8_LDA
#undef PG8_LDB
#undef PG8_MMA
#undef PG8_WAIT_V
#undef PG8_WAIT_L
#undef PG8_BAR
#undef PG8_SCHED
}
}

typedef const f32x4 (&AccRef)[2][2][4][2];
struct EpiBf16 {
    static constexpr bool PERM = true, HAS_MID = false;
    bf16_t* O; int ldc;
    __device__ __forceinline__ void operator()(AccRef acc, const pg8::Unit& u, int wr, int wc, int fr, int fq) const {
        const int row0 = u.pm * 256 + wr * 64 + fr, col0 = u.pn * 256 + wc * 32 + 8 * fq;
#pragma unroll
        for (int ai = 0; ai < 2; ++ai)
#pragma unroll
            for (int m = 0; m < 4; ++m) { bf16_t* rowp = O + (size_t)(row0 + ai * 128 + m * 16) * ldc + col0;
#pragma unroll
                for (int bj = 0; bj < 2; ++bj) { const f32x4 v0 = acc[ai][bj][m][0], v1 = acc[ai][bj][m][1];
                    u32x4 w; w.x = pk2(v0[0], v0[1]); w.y = pk2(v0[2], v0[3]); w.z = pk2(v1[0], v1[1]); w.w = pk2(v1[2], v1[3]);
                    *(u32x4*)(rowp + bj * 128) = w; } }
    }
};
struct EpiSwiGLU {
    static constexpr bool PERM = true, HAS_MID = false;
    bf16_t* O; int ldc;
    __device__ __forceinline__ void operator()(AccRef acc, const pg8::Unit& u, int wr, int wc, int fr, int fq) const {
        const int row0 = u.pm * 256 + wr * 64 + fr, col0 = u.pn * 128 + wc * 32 + 8 * fq;
#pragma unroll
        for (int ai = 0; ai < 2; ++ai)
#pragma unroll
            for (int m = 0; m < 4; ++m) { bf16_t* rowp = O + (size_t)(row0 + ai * 128 + m * 16) * ldc + col0;
                float r[8];
#pragma unroll
                for (int n = 0; n < 2; ++n)
#pragma unroll
                    for (int j = 0; j < 4; ++j) { const float a = acc[ai][0][m][n][j], b = acc[ai][1][m][n][j]; r[n * 4 + j] = fsilu(a) * b; }
                u32x4 w; w.x = pk2(r[0], r[1]); w.y = pk2(r[2], r[3]); w.z = pk2(r[4], r[5]); w.w = pk2(r[6], r[7]);
                *(u32x4*)rowp = w; }
    }
};
struct EpiResid {
    static constexpr bool PERM = false, HAS_MID = false;
    const float* base; float* out; const float* gate; float scale;
    __device__ __forceinline__ void operator()(AccRef acc, const pg8::Unit& u, int wr, int wc, int fr, int fq) const {
        const int row0 = u.pm * 256 + wr * 64 + fr, col0 = u.pn * 256 + wc * 32 + 4 * fq;
        const float* gp = gate + (size_t)(u.pm >> 3) * NMOD + col0;
        f32x4 gv[2][2];
#pragma unroll
        for (int bj = 0; bj < 2; ++bj)
#pragma unroll
            for (int n = 0; n < 2; ++n) gv[bj][n] = *(const f32x4*)(gp + bj * 128 + n * 16) * scale;
#pragma unroll
        for (int ai = 0; ai < 2; ++ai)
#pragma unroll
            for (int m = 0; m < 4; ++m) { const size_t off = (size_t)(row0 + ai * 128 + m * 16) * D + col0;
#pragma unroll
                for (int bj = 0; bj < 2; ++bj)
#pragma unroll
                    for (int n = 0; n < 2; ++n) { const f32x4 bs = *(const f32x4*)(base + off + bj * 128 + n * 16);
                        *(f32x4*)(out + off + bj * 128 + n * 16) = bs + gv[bj][n] * acc[ai][bj][m][n]; } }
    }
};
struct EpiGateFused {
    static constexpr bool PERM = true, HAS_MID = true;
    const bf16_t* Rsb; const bf16_t* Rdn; bf16_t* O;
    __device__ __forceinline__ void mid(f32x4 (&acc)[2][2][4][2], const pg8::Unit& u, int wr, int wc, int fr, int fq) const {
        int row0 = u.pm * 256 + wr * 64 + fr, col0 = u.pn * 256 + wc * 32 + 8 * fq;
        asm volatile("" : "+v"(row0), "+v"(col0));
#pragma unroll
        for (int ai = 0; ai < 2; ++ai)
#pragma unroll
            for (int m = 0; m < 4; ++m) { const size_t row = (size_t)(row0 + ai * 128 + m * 16);
#pragma unroll
                for (int bj = 0; bj < 2; ++bj) { const u32x4 a = *(const u32x4*)(Rsb + row * NIN + col0 + bj * 128), d = *(const u32x4*)(Rdn + row * NIN + col0 + bj * 128);
                    const float ra[8] = {bf_lo(a.x), bf_hi(a.x), bf_lo(a.y), bf_hi(a.y), bf_lo(a.z), bf_hi(a.z), bf_lo(a.w), bf_hi(a.w)};
                    const float rd[8] = {bf_lo(d.x), bf_hi(d.x), bf_lo(d.y), bf_hi(d.y), bf_lo(d.z), bf_hi(d.z), bf_lo(d.w), bf_hi(d.w)};
#pragma unroll
                    for (int e = 0; e < 8; ++e) { const float q = (1.0f + fexp(fminf(-rd[e], 30.0f))) * __builtin_amdgcn_rcpf(1.0f + fexp(-ra[e])); acc[ai][bj][m][e >> 2][e & 3] *= q; }
                    asm volatile("" ::: "memory"); } }
    }
    __device__ __forceinline__ void operator()(AccRef acc, const pg8::Unit& u, int wr, int wc, int fr, int fq) const {
        const int row0 = u.pm * 256 + wr * 64 + fr, col0 = u.pn * 256 + wc * 32 + 8 * fq;
#pragma unroll
        for (int ai = 0; ai < 2; ++ai)
#pragma unroll
            for (int m = 0; m < 4; ++m) { const size_t row = (size_t)(row0 + ai * 128 + m * 16);
#pragma unroll
                for (int bj = 0; bj < 2; ++bj) { const u32x4 d = *(const u32x4*)(Rdn + row * NIN + col0 + bj * 128);
                    const f32x4 v0 = acc[ai][bj][m][0], v1 = acc[ai][bj][m][1];
#define SGC(x) __builtin_amdgcn_rcpf(1.0f + fexp(fminf(-(x), 30.0f)))
                    const float r[8] = {SGC(bf_lo(d.x)) * v0[0], SGC(bf_hi(d.x)) * v0[1], SGC(bf_lo(d.y)) * v0[2], SGC(bf_hi(d.y)) * v0[3],
                                        SGC(bf_lo(d.z)) * v1[0], SGC(bf_hi(d.z)) * v1[1], SGC(bf_lo(d.w)) * v1[2], SGC(bf_hi(d.w)) * v1[3]};
#undef SGC
                    u32x4 w; w.x = pk2(r[0], r[1]); w.y = pk2(r[2], r[3]); w.z = pk2(r[4], r[5]); w.w = pk2(r[6], r[7]);
                    *(u32x4*)(O + row * D + col0 + bj * 128) = w; } }
    }
};
template <class Epi> __device__ __forceinline__ void run_gemm(LAS unsigned char* lds, const bf16_t* A, int lda, const bf16_t* Bt, int N, int K, const Epi& E, int jt = 1 << 30, int jbytes = 0) {
    pg8::Gemm g{A, Bt, T, N, K, lda, jt, jbytes}; pg8::StaticOrder S; S.init(T, N, (int)gridDim.x, (int)blockIdx.x);
    pg8::gemm_phase<Epi>(lds, g, S, E);
}

__device__ __forceinline__ void transpose_item(const float* W, int ldw, int s0, int k0, bf16_t* WT, int ldk, int d0, LAS float* scr, int lane) {
    float tv[32];
#pragma unroll
    for (int i = 0; i < 32; ++i) tv[i] = W[(size_t)(k0 + 2 * i + (lane >> 5)) * ldw + s0 + (lane & 31)];
#pragma unroll
    for (int i = 0; i < 32; ++i) scr[(2 * i + (lane >> 5)) * 33 + (lane & 31)] = tv[i];
    LDS_WAIT();
    const int c = lane & 7;
#pragma unroll
    for (int j = 0; j < 4; ++j) { const int n = (lane >> 3) + 8 * j; const LAS float* s = scr + (8 * c) * 33 + n;
        u32x4 o; o.x = pk2(s[0 * 33], s[1 * 33]); o.y = pk2(s[2 * 33], s[3 * 33]); o.z = pk2(s[4 * 33], s[5 * 33]); o.w = pk2(s[6 * 33], s[7 * 33]);
        *(u32x4*)(WT + (size_t)(d0 + n) * ldk + k0 + 8 * c) = o; }
    LDS_WAIT();
}
__device__ __forceinline__ void ffn_weight_items(const float* w_in, const float* w_out, bf16_t* wt_in, bf16_t* wt_out, LAS float* scr, int gw, int ngw, int lane) {
    for (int it = gw; it < 2816 + 1408; it += ngw) {
        if (it < 2816) { const int kb = it / 176, nb = it % 176, d0 = nb * 32, pn = d0 >> 8, bj = (d0 >> 7) & 1, c = d0 & 127, s0 = bj * FF + pn * 128 + c;
            transpose_item(w_in, 2 * FF, s0, kb * 64, wt_in, D, d0, scr, lane); }
        else { const int r = it - 2816, kb = r / 32, nb = r % 32; transpose_item(w_out, D, nb * 32, kb * 64, wt_out, FF, nb * 32, scr, lane); }
    }
}
__device__ __forceinline__ void mixer_weight_items(const Params& p, LAS float* scr, int gw, int ngw, int lane) {
    unsigned char* ws = p.ws;
    for (int it = gw; it < 2816 + 256 + 256 + 512; it += ngw) {
        int r = it;
        if (r < 2816) { const int kb = r / 176, nb = r % 176, d0 = nb * 32, s0 = d0 < C_RSB ? d0 : d0 + 8; transpose_item(p.in[I_WIN], INW, s0, kb * 64, (bf16_t*)(ws + W_IN), D, d0, scr, lane); continue; } r -= 2816;
        if (r < 256) { const int kb = r / 32, nb = r % 32; transpose_item(p.in[I_WUPSB], D, nb * 32, kb * 64, (bf16_t*)(ws + W_UPSB), D, nb * 32, scr, lane); continue; } r -= 256;
        if (r < 256) { const int kb = r / 32, nb = r % 32; transpose_item(p.in[I_WUPDN], D, nb * 32, kb * 64, (bf16_t*)(ws + W_UPSB) + 512, D, nb * 32, scr, lane); continue; } r -= 256;
        { const int kb = r / 32, nb = r % 32; transpose_item(p.in[I_WOUT], D, nb * 32, kb * 64, (bf16_t*)(ws + W_OUT), D, nb * 32, scr, lane); }
    }
}
__device__ __forceinline__ void mod_item(const Params& p, LAS unsigned char* lds, int cb, int tid, int wave, int lane) {
    asm volatile("" : "+v"(tid), "+v"(lane));
    LAS float* sc = (LAS float*)lds; LAS float* red = (LAS float*)(lds + 32768);
    for (int i = tid; i < NB * D; i += 512) sc[i] = fsilu(p.in[I_C][i]);
    __syncthreads();
    const float* wa = p.in[I_WADA] + cb * 64 + lane;
    float acc[NB];
#pragma unroll
    for (int b = 0; b < NB; ++b) acc[b] = 0.f;
    for (int k = wave * 128; k < wave * 128 + 128; k += 16) {
        float w[16];
#pragma unroll
        for (int e = 0; e < 16; ++e) w[e] = wa[(size_t)(k + e) * NMOD];
#pragma unroll
        for (int b = 0; b < NB; ++b)
#pragma unroll
            for (int e4 = 0; e4 < 4; ++e4) { const f32x4 s = *(const LAS f32x4*)(sc + b * D + k + 4 * e4); acc[b] += s[0] * w[4 * e4] + s[1] * w[4 * e4 + 1] + s[2] * w[4 * e4 + 2] + s[3] * w[4 * e4 + 3]; }
    }
#pragma unroll
    for (int b = 0; b < NB; ++b) red[(wave * NB + b) * 64 + lane] = acc[b];
    __syncthreads();
    { const int b = tid >> 6; float s = p.in[I_BADA][cb * 64 + lane];
#pragma unroll
        for (int w = 0; w < 8; ++w) s += red[(w * NB + b) * 64 + lane];
        ((float*)(p.ws + WS_MOD))[b * NMOD + cb * 64 + lane] = s; }
    __syncthreads();
}

template <bool DN>
__device__ __forceinline__ void norm_mod_phase(const Params& p, LAS unsigned char* lds, const float* src, const float* gain, int midx, bf16_t* dst, int tid, int wave, int lane) {
    asm volatile("" : "+v"(tid), "+v"(lane));
    const float* mod = (const float*)(p.ws + WS_MOD);
    LAS float* wl = (LAS float*)lds;
    if (DN) { for (int i = tid; i < D * 8; i += 512) { const int k = i >> 3, j = i & 7; wl[8 * k + 4 * (k >> 2) + j] = p.in[I_WIN][(size_t)k * INW + C_RSB + j]; } __syncthreads(); }
    f32x4 g4[4];
#pragma unroll
    for (int j = 0; j < 4; ++j) g4[j] = ((const f32x4*)gain)[lane + 64 * j];
    for (int row = blockIdx.x * 8 + wave; row < T; row += gridDim.x * 8) {
        const int b = row >> 11;
        const f32x4* xr = (const f32x4*)(src + (size_t)row * D) + lane;
        const f32x4* shp = (const f32x4*)(mod + (size_t)b * NMOD + midx * D) + lane; const f32x4* scp = shp + D / 4;
        f32x4 v[4]; float ss = 0.f;
#pragma unroll
        for (int j = 0; j < 4; ++j) { v[j] = xr[64 * j]; ss += (v[j][0] * v[j][0] + v[j][1] * v[j][1]) + (v[j][2] * v[j][2] + v[j][3] * v[j][3]); }
        const float rstd = 1.0f / sqrtf(wave_sum(ss) * (1.f / D) + EPS);
        u32x2* o8 = (u32x2*)(dst + (size_t)row * D) + lane;
        float dot[8];
        if (DN) {
#pragma unroll
            for (int e = 0; e < 8; ++e) dot[e] = 0.f; }
#pragma unroll
        for (int j = 0; j < 4; ++j) { const f32x4 sh = shp[64 * j], sc = scp[64 * j];
            const f32x4 uu = v[j] * rstd * g4[j] * (sc + 1.0f) + sh;
            u32x2 w; w.x = pk2(uu[0], uu[1]); w.y = pk2(uu[2], uu[3]); o8[64 * j] = w;
            if (DN) {
#pragma unroll
                for (int e = 0; e < 4; ++e) { const int k = 4 * lane + 256 * j + e; const LAS f32x4* wp = (const LAS f32x4*)(wl + 8 * k + 4 * (k >> 2)); const f32x4 w0 = wp[0], w1 = wp[1];
                    dot[0] += uu[e] * w0[0]; dot[1] += uu[e] * w0[1]; dot[2] += uu[e] * w0[2]; dot[3] += uu[e] * w0[3];
                    dot[4] += uu[e] * w1[0]; dot[5] += uu[e] * w1[1]; dot[6] += uu[e] * w1[2]; dot[7] += uu[e] * w1[3]; } } }
        if (DN) {
#pragma unroll
            for (int e = 0; e < 8; ++e) dot[e] = wave_sum(dot[e]);
            float mine = dot[0];
#pragma unroll
            for (int e = 1; e < 8; ++e) mine = (lane == e) ? dot[e] : mine;
            if (lane < 8) { float r;
                if (lane < 4) r = 1.0f / (1.0f + expf(-mine));
                else { const int hh = lane - 4; const float a = mine + p.in[I_DTBIAS][hh]; const float sp = a > 20.f ? a : log1pf(expf(a)); r = -expf(p.in[I_ALOG][hh]) * sp; }
                ((float*)(p.ws + WS_BG))[(size_t)row * 8 + lane] = r; } }
    }
    if (DN) __syncthreads();
}

__device__ __forceinline__ void unpack16(const bf16_t* p, float* f) {
    const u32x4 a = ((const u32x4*)p)[0], b = ((const u32x4*)p)[1];
    f[0] = bf_lo(a.x); f[1] = bf_hi(a.x); f[2] = bf_lo(a.y); f[3] = bf_hi(a.y); f[4] = bf_lo(a.z); f[5] = bf_hi(a.z); f[6] = bf_lo(a.w); f[7] = bf_hi(a.w);
    f[8] = bf_lo(b.x); f[9] = bf_hi(b.x); f[10] = bf_lo(b.y); f[11] = bf_hi(b.y); f[12] = bf_lo(b.z); f[13] = bf_hi(b.z); f[14] = bf_lo(b.w); f[15] = bf_hi(b.w);
}
__device__ __forceinline__ void pack16(bf16_t* p, const float* f) {
    u32x4 a, b; a.x = pk2(f[0], f[1]); a.y = pk2(f[2], f[3]); a.z = pk2(f[4], f[5]); a.w = pk2(f[6], f[7]); b.x = pk2(f[8], f[9]); b.y = pk2(f[10], f[11]); b.z = pk2(f[12], f[13]); b.w = pk2(f[14], f[15]);
    ((u32x4*)p)[0] = a; ((u32x4*)p)[1] = b;
}
__device__ __forceinline__ void prep_phase(const Params& p, int wave, int lane) {
    asm volatile("" : "+v"(lane));
    bf16_t* P = (bf16_t*)(p.ws + WS_P); bf16_t* U = (bf16_t*)(p.ws + WS_U);
    const int ch = 16 * lane;
    float gsb[16], wcv[4][16];
    { const float* gp = (ch < 512 ? p.in[I_GQSB] : p.in[I_GKSB]) + (ch & 63); const float sc = ch < 512 ? 0.18033688011112042f : 1.0f;
#pragma unroll
        for (int e = 0; e < 16; ++e) gsb[e] = gp[e] * sc;
#pragma unroll
        for (int i = 0; i < 4; ++i)
#pragma unroll
            for (int e = 0; e < 16; ++e) wcv[i][e] = p.in[I_WCONV][i * 1536 + ch + e]; }
    for (int row = blockIdx.x * 8 + wave; row < T; row += gridDim.x * 8) {
        const int tl = row & (SEQ - 1);
        { bf16_t* qp = P + (size_t)row * NIN + ch; float f[16]; unpack16(qp, f); float ss = 0.f;
#pragma unroll
            for (int e = 0; e < 16; ++e) ss += f[e] * f[e];
            ss += __shfl_xor(ss, 1); ss += __shfl_xor(ss, 2);
            const float rstd = 1.0f / sqrtf(ss * (1.f / 64.f) + EPS);
#pragma unroll
            for (int e = 0; e < 16; ++e) f[e] = f[e] * rstd * gsb[e];
            pack16(qp, f); }
        { float y[16];
#pragma unroll
            for (int e = 0; e < 16; ++e) y[e] = 0.f;
#pragma unroll
            for (int i = 0; i < 4; ++i) { if (tl - 3 + i >= 0) { float f[16]; unpack16(P + (size_t)(row - 3 + i) * NIN + C_QDN + ch, f);
#pragma unroll
                    for (int e = 0; e < 16; ++e) y[e] += wcv[i][e] * f[e]; } }
            float ss = 0.f;
#pragma unroll
            for (int e = 0; e < 16; ++e) { y[e] = fsilu(y[e]); ss += y[e] * y[e]; }
            ss += __shfl_xor(ss, 1); ss += __shfl_xor(ss, 2); ss += __shfl_xor(ss, 4);
            const float sc = (1.0f / sqrtf(ss + EPS)) * (ch < 512 ? 0.08838834764831845f : 1.0f);
#pragma unroll
            for (int e = 0; e < 16; ++e) y[e] *= sc;
            pack16(U + (size_t)row * D + ch, y); }
    }
    bf16_t* Vt = (bf16_t*)(p.ws + WS_VT);
    for (int it = blockIdx.x * 8 + wave; it < T / 16; it += gridDim.x * 8) {
        const int row0 = it * 16, b = row0 >> 11, tl0 = row0 & (SEQ - 1), c8 = lane * 8, hd = c8 >> 6, d0 = c8 & 63;
        u32x4 w[16];
#pragma unroll
        for (int r = 0; r < 16; ++r) w[r] = *(const u32x4*)(P + (size_t)(row0 + r) * NIN + C_VSB + c8);
#pragma unroll
        for (int e = 0; e < 8; ++e) {
            unsigned o[8];
#pragma unroll
            for (int i = 0; i < 8; ++i) {
                const int p0 = 2 * i, p1 = 2 * i + 1;
                const int k0 = 8 * ((p0 >> 2) & 1) + 4 * (p0 >> 3) + (p0 & 3), k1 = 8 * ((p1 >> 2) & 1) + 4 * (p1 >> 3) + (p1 & 3);
                const unsigned a0 = w[k0][e >> 1], a1 = w[k1][e >> 1];
                const unsigned lo = (e & 1) ? (a0 >> 16) : (a0 & 0xffffu), hi = (e & 1) ? (a1 & 0xffff0000u) : (a1 << 16);
                o[i] = lo | hi; }
            bf16_t* dst = Vt + ((size_t)(b * 8 + hd) * 64 + d0 + e) * SEQ + tl0;
            ((u32x4*)dst)[0] = (u32x4){o[0], o[1], o[2], o[3]}; ((u32x4*)dst)[1] = (u32x4){o[4], o[5], o[6], o[7]}; }
    }
}

__device__ __forceinline__ float xlane32(float x, int hh) {
    const unsigned xi = __builtin_bit_cast(unsigned, x);
    const u32x2 r = __builtin_amdgcn_permlane32_swap(xi, xi, false, false);
    return __builtin_bit_cast(float, hh ? r.x : r.y);
}
template <bool DIAG>
__device__ __forceinline__ void attn_tile(const f32x16& z, const bf16x8 (&vc)[4], f32x16& o0, f32x16& o1, float& R, int ql, int hh) {
    float sg[16], m[16];
#pragma unroll
    for (int i = 0; i < 16; ++i) { const float e = __builtin_amdgcn_exp2f(fminf(-z[i], 80.0f)); float sig = __builtin_amdgcn_rcpf(1.0f + e); float mm = e * sig;
        if (DIAG) { const bool act = ((i & 3) + 8 * (i >> 2) + 4 * hh) < ql; sig = act ? sig : 0.f; mm = act ? mm : 1.0f; }
        sg[i] = sig; m[i] = mm; }
    float g[4], gp[4];
#pragma unroll
    for (int bq = 0; bq < 4; ++bq) { g[bq] = (m[4 * bq] * m[4 * bq + 1]) * (m[4 * bq + 2] * m[4 * bq + 3]); gp[bq] = xlane32(g[bq], hh); }
    float outer[4]; float tb = R;
#pragma unroll
    for (int bq = 3; bq >= 0; --bq) { outer[bq] = hh == 0 ? tb * gp[bq] : tb; tb *= g[bq] * gp[bq]; }
    R = tb;
    float w[16];
#pragma unroll
    for (int bq = 0; bq < 4; ++bq) { const float s3 = outer[bq], s2 = s3 * m[4 * bq + 3], s1 = s2 * m[4 * bq + 2], s0 = s1 * m[4 * bq + 1];
        w[4 * bq + 3] = sg[4 * bq + 3] * s3; w[4 * bq + 2] = sg[4 * bq + 2] * s2; w[4 * bq + 1] = sg[4 * bq + 1] * s1; w[4 * bq] = sg[4 * bq] * s0; }
    bf16x8 wf[2];
#pragma unroll
    for (int s2 = 0; s2 < 2; ++s2) { const u32x4 pw = {cpk2(w[8 * s2], w[8 * s2 + 1]), cpk2(w[8 * s2 + 2], w[8 * s2 + 3]), cpk2(w[8 * s2 + 4], w[8 * s2 + 5]), cpk2(w[8 * s2 + 6], w[8 * s2 + 7])}; wf[s2] = __builtin_bit_cast(bf16x8, pw); }
    o0 = __builtin_amdgcn_mfma_f32_32x32x16_bf16(vc[0], wf[0], o0, 0, 0, 0); o0 = __builtin_amdgcn_mfma_f32_32x32x16_bf16(vc[1], wf[1], o0, 0, 0, 0);
    o1 = __builtin_amdgcn_mfma_f32_32x32x16_bf16(vc[2], wf[0], o1, 0, 0, 0); o1 = __builtin_amdgcn_mfma_f32_32x32x16_bf16(vc[3], wf[1], o1, 0, 0, 0);
}
__device__ __forceinline__ void attn_item_mfma(bf16_t* P, const bf16_t* Vt, int bh, int qt, int lane) {
    asm volatile("" : "+v"(lane));
    const int b = bh >> 3, h = bh & 7, ql = lane & 31, hh = lane >> 5, q0 = qt * 32;
    bf16_t* qrow = P + (size_t)(b * SEQ + q0 + ql) * NIN + C_QSB + h * 64;
    bf16x8 qf[4];
#pragma unroll
    for (int s = 0; s < 4; ++s) qf[s] = *(const bf16x8*)(qrow + 16 * s + 8 * hh);
    f32x16 o0, o1;
#pragma unroll
    for (int i = 0; i < 16; ++i) { o0[i] = 0.f; o1[i] = 0.f; }
    float R = 1.0f;
    const bf16_t* kb = P + (size_t)(b * SEQ + ql) * NIN + C_KSB + h * 64 + 8 * hh;
    const bf16_t* vb = Vt + ((size_t)bh * 64 + ql) * SEQ + 8 * hh;
    bf16x8 kf[4], vf[4], vn[4];
#define AT_LOADK(k0_) do { _Pragma("unroll") for (int s = 0; s < 4; ++s) kf[s] = *(const bf16x8*)(kb + (size_t)(k0_) * NIN + 16 * s); } while (0)
#define AT_LOADV(dst, k0_) do { _Pragma("unroll") for (int j = 0; j < 4; ++j) dst[j] = *(const bf16x8*)(vb + (size_t)(j >> 1) * 32 * SEQ + (k0_) + 16 * (j & 1)); } while (0)
#define AT_QK(zz) do { _Pragma("unroll") for (int i = 0; i < 16; ++i) zz[i] = 0.f; _Pragma("unroll") for (int s = 0; s < 4; ++s) zz = __builtin_amdgcn_mfma_f32_32x32x16_bf16(kf[s], qf[s], zz, 0, 0, 0); } while (0)
    f32x16 zc, zn;
    AT_LOADK(q0); AT_LOADV(vf, q0);
    AT_QK(zc);
    { const int k1 = (qt > 0 ? qt - 1 : 0) * 32; AT_LOADK(k1); AT_LOADV(vn, k1); }
    { AT_QK(zn);
      const int k2 = (qt > 1 ? qt - 2 : 0) * 32; AT_LOADK(k2);
      attn_tile<true>(zc, vf, o0, o1, R, ql, hh);
      zc = zn;
#pragma unroll
      for (int j = 0; j < 4; ++j) vf[j] = vn[j];
      const int k1 = (qt > 1 ? qt - 2 : 0) * 32; AT_LOADV(vn, k1); }
#pragma unroll 1
    for (int kt = qt - 1; kt >= 0; --kt) {
        AT_QK(zn);
        const int k2 = (kt > 1 ? kt - 2 : 0) * 32; AT_LOADK(k2);
        attn_tile<false>(zc, vf, o0, o1, R, ql, hh);
        if (__builtin_amdgcn_ballot_w64(R != 0.0f) == 0ull) break;
        zc = zn;
#pragma unroll
        for (int j = 0; j < 4; ++j) vf[j] = vn[j];
        AT_LOADV(vn, k2);
    }
#undef AT_LOADK
#undef AT_LOADV
#undef AT_QK
#pragma unroll
    for (int bq = 0; bq < 4; ++bq) {
        u32x2 w0 = {cpk2(o0[4 * bq], o0[4 * bq + 1]), cpk2(o0[4 * bq + 2], o0[4 * bq + 3])}, w1 = {cpk2(o1[4 * bq], o1[4 * bq + 1]), cpk2(o1[4 * bq + 2], o1[4 * bq + 3])};
        *(u32x2*)(qrow + 8 * bq + 4 * hh) = w0; *(u32x2*)(qrow + 32 + 8 * bq + 4 * hh) = w1; }
}
__device__ __forceinline__ size_t slotU(size_t t0, int h, int colbase, int f) { return (t0 + (size_t)(f >> 7)) * D + colbase + h * 128 + (f & 127); }
__device__ __forceinline__ size_t slotP(size_t t0, int h, int colbase, int f) { return (t0 + (size_t)(f >> 7)) * NIN + colbase + h * 128 + (f & 127); }
__device__ __forceinline__ int permpos(int x) { const int k = x & 15; return (x & ~15) + 8 * ((k >> 2) & 1) + 4 * (k >> 3) + (k & 3); }
__device__ __forceinline__ int crow(int r, int hh) { return (r & 3) + 8 * (r >> 2) + 4 * hh; }
__device__ __forceinline__ bf16x8 pack8(const f32x16& x, int s2) {
    const u32x4 pw = {cpk2(x[8 * s2], x[8 * s2 + 1]), cpk2(x[8 * s2 + 2], x[8 * s2 + 3]), cpk2(x[8 * s2 + 4], x[8 * s2 + 5]), cpk2(x[8 * s2 + 6], x[8 * s2 + 7])};
    return __builtin_bit_cast(bf16x8, pw);
}
#define MFMA32(a, b, c) __builtin_amdgcn_mfma_f32_32x32x16_bf16((a), (b), (c), 0, 0, 0)
constexpr int PT = 72, PQ = 136, PL = 68, PB = 40;
constexpr int CP_GC = 0, CP_BT = 256, CP_LS = 1024, CP_TU = CP_LS + 64 * PL * 4, CP_TW = CP_TU + 64 * PT * 2, CP_KT = CP_TW + 64 * PT * 2, CP_VT = CP_KT + 128 * PT * 2,
              CP_QS = CP_VT + 128 * PT * 2, CP_KS = CP_QS + 64 * PQ * 2, CP_AQ = CP_KS + 64 * PQ * 2, CP_L21 = CP_AQ + 64 * PT * 2, CP_TCM = CP_L21 + 32 * PB * 2, CP_T22 = CP_TCM + 32 * PB * 2, CP_END = CP_T22 + 32 * PB * 2;
static_assert(CP_END <= 131072, "chunk prep LDS");
__device__ __forceinline__ void gdn_chunk_prep_phase(const Params& p, LAS unsigned char* lds, int tid, int wave, int lane) {
    bf16_t* P = (bf16_t*)(p.ws + WS_P); bf16_t* U = (bf16_t*)(p.ws + WS_U); const float* BG = (const float*)(p.ws + WS_BG);
    u32x4 ka, kb, qa, qb, xv[4][2]; float gx = 0.f, gbt = 0.f;
#define CP_LOAD(item_) do { const int bh_ = (item_) >> 5, n_ = (item_) & 31, b_ = bh_ >> 2, h_ = bh_ & 3; const size_t t0_ = (size_t)b_ * SEQ + n_ * 64; const int tok_ = tid >> 3, c16_ = (tid & 7) * 16; \
        ka = *(const u32x4*)(U + (t0_ + tok_) * D + 512 + h_ * 128 + c16_); kb = *(const u32x4*)(U + (t0_ + tok_) * D + 512 + h_ * 128 + c16_ + 8); \
        qa = *(const u32x4*)(U + (t0_ + tok_) * D + h_ * 128 + c16_); qb = *(const u32x4*)(U + (t0_ + tok_) * D + h_ * 128 + c16_ + 8); \
        _Pragma("unroll") for (int i = 0; i < 4; ++i) { const bool ok = n_ * 64 + tok_ - 3 + i >= 0; const bf16_t* vp = P + (t0_ + tok_ - 3 + i) * NIN + C_VDN + h_ * 128 + c16_; \
            xv[i][0] = ok ? *(const u32x4*)vp : (u32x4){0u, 0u, 0u, 0u}; xv[i][1] = ok ? *(const u32x4*)(vp + 8) : (u32x4){0u, 0u, 0u, 0u}; } \
        if (tid < 64) { gx = BG[(t0_ + tid) * 8 + 4 + h_]; gbt = BG[(t0_ + tid) * 8 + h_]; } } while (0)
    if ((int)blockIdx.x < 1024) CP_LOAD((int)blockIdx.x);
  for (int item = blockIdx.x; item < 1024; item += gridDim.x) {
    asm volatile("" : "+v"(tid), "+v"(lane));
    const int bh = item >> 5, n = item & 31, b = bh >> 2, h = bh & 3, ql = lane & 31, hh = lane >> 5;
    const size_t t0 = (size_t)b * SEQ + n * 64;
    LAS float* gcS = (LAS float*)(lds + CP_GC); LAS float* btS = (LAS float*)(lds + CP_BT);
    LAS float* LS = (LAS float*)(lds + CP_LS);
    LAS bf16_t* TuS = (LAS bf16_t*)(lds + CP_TU); LAS bf16_t* TwS = (LAS bf16_t*)(lds + CP_TW);
    LAS bf16_t* kT = (LAS bf16_t*)(lds + CP_KT); LAS bf16_t* vT = (LAS bf16_t*)(lds + CP_VT); LAS bf16_t* qS = (LAS bf16_t*)(lds + CP_QS); LAS bf16_t* kS = (LAS bf16_t*)(lds + CP_KS);
    LAS bf16_t* AQ = (LAS bf16_t*)(lds + CP_AQ); LAS bf16_t* L21b = (LAS bf16_t*)(lds + CP_L21); LAS bf16_t* Tcm = (LAS bf16_t*)(lds + CP_TCM); LAS bf16_t* T22r = (LAS bf16_t*)(lds + CP_T22);
    if (tid < 64) { float x = gx;
#pragma unroll
        for (int o = 1; o < 64; o <<= 1) { const float y = __shfl_up(x, o); if (lane >= o) x += y; }
        gcS[tid] = x; btS[tid] = gbt; }
    { const int tok = tid >> 3, c16 = (tid & 7) * 16;
        *(LAS u32x4*)(kS + tok * PQ + c16) = ka; *(LAS u32x4*)(kS + tok * PQ + c16 + 8) = kb;
        *(LAS u32x4*)(qS + tok * PQ + c16) = qa; *(LAS u32x4*)(qS + tok * PQ + c16 + 8) = qb;
        const unsigned kw[8] = {ka.x, ka.y, ka.z, ka.w, kb.x, kb.y, kb.z, kb.w};
#pragma unroll
        for (int e = 0; e < 8; ++e) { kT[(c16 + 2 * e) * PT + tok] = (bf16_t)(kw[e] & 0xffffu); kT[(c16 + 2 * e + 1) * PT + tok] = (bf16_t)(kw[e] >> 16); }
        float y[16];
#pragma unroll
        for (int e = 0; e < 16; ++e) y[e] = 0.f;
#pragma unroll
        for (int i = 0; i < 4; ++i) { const float* wp = p.in[I_WCONV] + i * 1536 + 1024 + h * 128 + c16;
            const unsigned xw[8] = {xv[i][0].x, xv[i][0].y, xv[i][0].z, xv[i][0].w, xv[i][1].x, xv[i][1].y, xv[i][1].z, xv[i][1].w};
#pragma unroll
            for (int e = 0; e < 8; ++e) { y[2 * e] += wp[2 * e] * bf_lo(xw[e]); y[2 * e + 1] += wp[2 * e + 1] * bf_hi(xw[e]); } }
#pragma unroll
        for (int e = 0; e < 16; ++e) vT[(c16 + e) * PT + tok] = f2bf(fsilu(y[e])); }
    __syncthreads();
    if (item + (int)gridDim.x < 1024) CP_LOAD(item + (int)gridDim.x);
    if (wave == 0 || wave == 4 || wave == 5) {
        const int it = wave == 0 ? 0 : 1, jt = wave == 4 ? 1 : 0;
        f32x16 acc;
#pragma unroll
        for (int r = 0; r < 16; ++r) acc[r] = 0.f;
#pragma unroll
        for (int ks = 0; ks < 8; ++ks) acc = MFMA32(*(const LAS bf16x8*)(kS + (32 * it + ql) * PQ + 16 * ks + 8 * hh), *(const LAS bf16x8*)(kS + (32 * jt + ql) * PQ + 16 * ks + 8 * hh), acc);
        const int j = 32 * jt + ql; const float gj = gcS[j];
#pragma unroll
        for (int r = 0; r < 16; ++r) { const int i = 32 * it + crow(r, hh); const float l = (j < i) ? btS[i] * acc[r] * fexp(gcS[i] - gj) : 0.f;
            if (it != jt) L21b[(i - 32) * PB + j] = f2bf(l); else LS[i * PL + j] = l; }
    } else if (wave < 4) {
        const int jt = wave == 3 ? 1 : 0, it = wave == 1 ? 0 : 1;
        f32x16 acc;
#pragma unroll
        for (int r = 0; r < 16; ++r) acc[r] = 0.f;
#pragma unroll
        for (int ks = 0; ks < 8; ++ks) acc = MFMA32(*(const LAS bf16x8*)(kS + (32 * jt + ql) * PQ + 16 * ks + 8 * hh), *(const LAS bf16x8*)(qS + (32 * it + ql) * PQ + 16 * ks + 8 * hh), acc);
        const int i = 32 * it + ql; const float gi = gcS[i];
#pragma unroll
        for (int r = 0; r < 16; ++r) { const int j = 32 * jt + crow(r, hh); acc[r] = (j <= i) ? acc[r] * fexp(gi - gcS[j]) : 0.f; }
#pragma unroll
        for (int bq = 0; bq < 4; ++bq) *(LAS u32x2*)(AQ + i * PT + 32 * jt + 8 * bq + 4 * hh) = (u32x2){cpk2(acc[4 * bq], acc[4 * bq + 1]), cpk2(acc[4 * bq + 2], acc[4 * bq + 3])};
    } else {
        const float gl = gcS[63];
#pragma unroll
        for (int uu = 0; uu < 4; ++uu) { const int unit = (tid - 384) + 128 * uu, dk = unit >> 2, blk = unit & 3;
            const u32x4 k0 = *(const LAS u32x4*)(kT + dk * PT + 16 * blk), k1 = *(const LAS u32x4*)(kT + dk * PT + 16 * blk + 8);
            float kv[16] = {bf_lo(k0.x), bf_hi(k0.x), bf_lo(k0.y), bf_hi(k0.y), bf_lo(k0.z), bf_hi(k0.z), bf_lo(k0.w), bf_hi(k0.w), bf_lo(k1.x), bf_hi(k1.x), bf_lo(k1.y), bf_hi(k1.y), bf_lo(k1.z), bf_hi(k1.z), bf_lo(k1.w), bf_hi(k1.w)};
#pragma unroll
            for (int e = 0; e < 16; ++e) kv[e] *= fexp(gl - gcS[16 * blk + e]);
            float pv[16];
#pragma unroll
            for (int e = 0; e < 16; ++e) pv[permpos(e)] = kv[e];
            pack16(P + slotP(t0, h, C_VSB, dk * 64 + 16 * blk), pv); }
        if (tid == 384) ((float*)(p.ws + WS_EGL))[bh * 32 + n] = fexp(gl);
    }
    __syncthreads();
    if (wave == 0) {
        const LAS float* LB = LS + (32 * hh) * PL + 32 * hh;
        float Tc[32];
#pragma unroll
        for (int i = 0; i < 32; ++i) {
            float a0 = (ql == i) ? 1.0f : 0.f, a1 = 0.f, a2 = 0.f, a3 = 0.f;
#pragma unroll
            for (int j4 = 0; j4 < i; j4 += 4) { const f32x4 l4 = *(const LAS f32x4*)(LB + i * PL + j4);
                a0 -= l4[0] * Tc[j4]; if (j4 + 1 < i) a1 -= l4[1] * Tc[j4 + 1]; if (j4 + 2 < i) a2 -= l4[2] * Tc[j4 + 2]; if (j4 + 3 < i) a3 -= l4[3] * Tc[j4 + 3]; }
            Tc[i] = (a0 + a1) + (a2 + a3); }
        const int cg_ = 32 * hh + ql; const float bu = btS[cg_], bw = bu * fexp(gcS[cg_]);
#pragma unroll
        for (int i = 0; i < 32; ++i) { TuS[(32 * hh + i) * PT + cg_] = f2bf(Tc[i] * bu); TwS[(32 * hh + i) * PT + cg_] = f2bf(Tc[i] * bw); }
        if (hh == 0) {
#pragma unroll
            for (int i8 = 0; i8 < 4; ++i8) *(LAS u32x4*)(Tcm + ql * PB + 8 * i8) = (u32x4){cpk2(Tc[8 * i8], Tc[8 * i8 + 1]), cpk2(Tc[8 * i8 + 2], Tc[8 * i8 + 3]), cpk2(Tc[8 * i8 + 4], Tc[8 * i8 + 5]), cpk2(Tc[8 * i8 + 6], Tc[8 * i8 + 7])};
        } else {
#pragma unroll
            for (int i = 0; i < 32; ++i) T22r[i * PB + ql] = f2bf(Tc[i]);
        }
        LDS_WAIT();
        f32x16 x1;
#pragma unroll
        for (int r = 0; r < 16; ++r) x1[r] = 0.f;
#pragma unroll
        for (int s2 = 0; s2 < 2; ++s2) x1 = MFMA32(*(const LAS bf16x8*)(L21b + ql * PB + 16 * s2 + 8 * hh), *(const LAS bf16x8*)(Tcm + ql * PB + 16 * s2 + 8 * hh), x1);
        f32x16 yy;
#pragma unroll
        for (int r = 0; r < 16; ++r) yy[r] = 0.f;
#pragma unroll
        for (int s2 = 0; s2 < 2; ++s2) { const u32x2 lo = *(const LAS u32x2*)(T22r + ql * PB + 16 * s2 + 4 * hh), hi = *(const LAS u32x2*)(T22r + ql * PB + 16 * s2 + 8 + 4 * hh);
            const u32x4 af = {lo.x, lo.y, hi.x, hi.y};
            yy = MFMA32(__builtin_bit_cast(bf16x8, af), pack8(x1, s2), yy); }
        { const float bu0 = btS[ql], bw0 = bu0 * fexp(gcS[ql]);
#pragma unroll
            for (int r = 0; r < 16; ++r) { const int i2 = 32 + crow(r, hh); TuS[i2 * PT + ql] = f2bf(-yy[r] * bu0); TwS[i2 * PT + ql] = f2bf(-yy[r] * bw0); } }
    }
    __syncthreads();
    {
        const int isW = wave >> 2, ct = wave & 3, col = 32 * ct + ql;
        const LAS bf16_t* Ta = (isW ? TwS : TuS) + 8 * hh; const LAS bf16_t* Bs = (isW ? kT : vT) + col * PT + 8 * hh;
        bf16x8 bf[4];
#pragma unroll
        for (int ks = 0; ks < 4; ++ks) bf[ks] = *(const LAS bf16x8*)(Bs + 16 * ks);
        f32x16 xa[2];
#pragma unroll
        for (int jt = 0; jt < 2; ++jt) {
#pragma unroll
            for (int r = 0; r < 16; ++r) xa[jt][r] = 0.f;
#pragma unroll
            for (int ks = 0; ks < 4; ++ks) if (jt == 1 || ks < 2) xa[jt] = MFMA32(*(const LAS bf16x8*)(Ta + (32 * jt + ql) * PT + 16 * ks), bf[ks], xa[jt]); }
        bf16x8 xb[4] = {pack8(xa[0], 0), pack8(xa[0], 1), pack8(xa[1], 0), pack8(xa[1], 1)};
        f32x16 ra[2];
#pragma unroll
        for (int it = 0; it < 2; ++it) {
#pragma unroll
            for (int r = 0; r < 16; ++r) ra[it][r] = 0.f;
#pragma unroll
            for (int kk = 0; kk < 4; ++kk) if (it == 1 || kk < 2) { const LAS bf16_t* ap = AQ + (32 * it + ql) * PT + 16 * kk + 4 * hh;
                const u32x2 lo = *(const LAS u32x2*)ap, hi = *(const LAS u32x2*)(ap + 8); const u32x4 af = {lo.x, lo.y, hi.x, hi.y};
                ra[it] = MFMA32(__builtin_bit_cast(bf16x8, af), xb[kk], ra[it]); } }
        if (!isW) {
#pragma unroll
            for (int jt = 0; jt < 2; ++jt)
#pragma unroll
                for (int bq = 0; bq < 4; ++bq) { const int f = col * 64 + 32 * jt + 8 * bq + 4 * hh;
                    *(u32x2*)(U + slotU(t0, h, 0, f)) = (u32x2){cpk2(xa[jt][4 * bq], xa[jt][4 * bq + 1]), cpk2(xa[jt][4 * bq + 2], xa[jt][4 * bq + 3])};
                    *(u32x2*)(U + slotU(t0, h, 512, f)) = (u32x2){cpk2(ra[jt][4 * bq], ra[jt][4 * bq + 1]), cpk2(ra[jt][4 * bq + 2], ra[jt][4 * bq + 3])}; }
        } else {
            const int pc = permpos(col);
#pragma unroll
            for (int jt = 0; jt < 2; ++jt)
#pragma unroll
                for (int r = 0; r < 16; ++r) { const int tok = 32 * jt + crow(r, hh);
                    P[(t0 + tok) * NIN + C_QDN + h * 128 + pc] = f2bf(-xa[jt][r]);
                    P[(t0 + tok) * NIN + C_KDN + h * 128 + pc] = f2bf(bf2f(qS[tok * PQ + col]) * fexp(gcS[tok]) - ra[jt][r]); }
        }
    }
    __syncthreads();
  }
#undef CP_LOAD
}
constexpr int SC_PW = 136, SC_PK = 72, SC_NW = 0, SC_Q2 = 64 * SC_PW * 2, SC_KD = 2 * 64 * SC_PW * 2, SC_STAGE = 2 * 64 * SC_PW * 2 + 128 * SC_PK * 2, SC_OS = 2 * SC_STAGE,
              SC_US = SC_OS + 64 * SC_PW * 2, SC_OI = SC_US + 128 * SC_PK * 2, SC_END = SC_OI + 128 * SC_PK * 2;
static_assert(SC_END <= BST_OFF, "scan LDS");
__device__ __forceinline__ void gdn_scan_block(const Params& p, LAS unsigned char* lds, int bh, int tid, int wave, int lane) {
    asm volatile("" : "+v"(tid), "+v"(lane));
    bf16_t* P = (bf16_t*)(p.ws + WS_P); const bf16_t* U = (const bf16_t*)(p.ws + WS_U); const float* EGL = (const float*)(p.ws + WS_EGL);
    const int b = bh >> 2, h = bh & 3, ql = lane & 31, hh = lane >> 5;
    const size_t tb = (size_t)b * SEQ;
    LAS bf16_t* oS = (LAS bf16_t*)(lds + SC_OS);
    if (wave >= 4) {
        int lt = tid - 256, ftok = lt >> 2, fseg = lt & 3;
        u32x4 ra[20], rb[20];
#define SC_LOAD(r, n_) do { const size_t t0_ = tb + (size_t)(n_) * 64; _Pragma("unroll") for (int i = 0; i < 4; ++i) { const int c = lt + 256 * i, row = c >> 4, c8 = (c & 15) * 8; \
            const bf16_t* g_ = P + (t0_ + row) * NIN + h * 128 + c8; const bf16_t* u_ = U + (t0_ + row) * D + h * 128 + c8; \
            r[i] = *(const u32x4*)(g_ + C_QDN); r[4 + i] = *(const u32x4*)(g_ + C_KDN); r[8 + i] = *(const u32x4*)(g_ + C_VSB); r[12 + i] = *(const u32x4*)u_; r[16 + i] = *(const u32x4*)(u_ + 512); } } while (0)
#define SC_STORE(r, st_) do { LAS unsigned char* s_ = lds + (st_) * SC_STAGE; _Pragma("unroll") for (int i = 0; i < 4; ++i) { const int c = lt + 256 * i, row = c >> 4, c8 = (c & 15) * 8; \
            *(LAS u32x4*)(s_ + SC_NW + (row * SC_PW + c8) * 2) = r[i]; *(LAS u32x4*)(s_ + SC_Q2 + (row * SC_PW + c8) * 2) = r[4 + i]; \
            *(LAS u32x4*)(s_ + SC_KD + ((2 * row + (c8 >> 6)) * SC_PK + (c8 & 63)) * 2) = r[8 + i]; } } while (0)
#define SC_STOREU(r) do { _Pragma("unroll") for (int i = 0; i < 4; ++i) { const int c = lt + 256 * i, row = c >> 4, c8 = (c & 15) * 8; const int o_ = ((2 * row + (c8 >> 6)) * SC_PK + (c8 & 63)) * 2; \
            *(LAS u32x4*)(lds + SC_US + o_) = r[12 + i]; *(LAS u32x4*)(lds + SC_OI + o_) = r[16 + i]; } } while (0)
#define SC_FIN(m_) do { bf16_t* orow = P + (tb + (size_t)(m_) * 64 + ftok) * NIN + h * 128 + fseg * 32 + C_VDN; \
            _Pragma("unroll") for (int i = 0; i < 4; ++i) *(u32x4*)(orow + 8 * i) = *(const LAS u32x4*)(oS + ftok * SC_PW + fseg * 32 + 8 * i); } while (0)
        SC_LOAD(ra, 0); SC_STORE(ra, 0); SC_STOREU(ra); SC_LOAD(ra, 1);
        __syncthreads();
#pragma unroll 1
        for (int n = 0; n < 32; n += 2) {
            asm volatile("" : "+v"(lt), "+v"(ftok), "+v"(fseg));
            if (n + 2 < 32) SC_LOAD(rb, n + 2);
            SC_STORE(ra, 1);
            if (n > 0) SC_FIN(n - 1);
            __syncthreads();
            SC_STOREU(ra);
            __syncthreads();
            if (n + 3 < 32) SC_LOAD(ra, n + 3);
            if (n + 2 < 32) SC_STORE(rb, 0);
            SC_FIN(n);
            __syncthreads();
            if (n + 2 < 32) SC_STOREU(rb);
            __syncthreads();
        }
        SC_FIN(31);
#undef SC_LOAD
#undef SC_STORE
#undef SC_STOREU
#undef SC_FIN
    } else {
        const int col = 32 * wave + ql;
        f32x16 S[4];
#pragma unroll
        for (int rt = 0; rt < 4; ++rt)
#pragma unroll
            for (int r = 0; r < 16; ++r) S[rt][r] = 0.f;
        const float eglv = EGL[bh * 32 + ql];
        __syncthreads();
#pragma unroll 1
        for (int n = 0; n < 32; ++n) {
            const float egl = __builtin_bit_cast(float, __builtin_amdgcn_readlane(__builtin_bit_cast(int, eglv), n));
            const LAS unsigned char* st = lds + (n & 1) * SC_STAGE;
            f32x16 vn[2], oa[2];
            { const LAS unsigned char* up_ = lds + SC_US + (col * SC_PK + 4 * hh) * 2; const LAS unsigned char* op_ = lds + SC_OI + (col * SC_PK + 4 * hh) * 2;
#pragma unroll
              for (int jt = 0; jt < 2; ++jt)
#pragma unroll
                for (int bq = 0; bq < 4; ++bq) { const u32x2 uw = *(const LAS u32x2*)(up_ + (32 * jt + 8 * bq) * 2), ow = *(const LAS u32x2*)(op_ + (32 * jt + 8 * bq) * 2);
                    vn[jt][4 * bq] = bf_lo(uw.x); vn[jt][4 * bq + 1] = bf_hi(uw.x); vn[jt][4 * bq + 2] = bf_lo(uw.y); vn[jt][4 * bq + 3] = bf_hi(uw.y);
                    oa[jt][4 * bq] = bf_lo(ow.x); oa[jt][4 * bq + 1] = bf_hi(ow.x); oa[jt][4 * bq + 2] = bf_lo(ow.y); oa[jt][4 * bq + 3] = bf_hi(ow.y); } }
            const LAS unsigned char* w0_ = st + (ql * SC_PW + 8 * hh) * 2; const LAS unsigned char* w1_ = w0_ + 32 * SC_PW * 2;
            const LAS unsigned char* kd_ = st + SC_KD + (ql * SC_PK + 8 * hh) * 2;
            bf16x8 fa[4], fb[4];
#define SC_RD4(dst, ptr) do { _Pragma("unroll") for (int i_ = 0; i_ < 4; ++i_) dst[i_] = *(const LAS bf16x8*)((ptr) + 32 * i_); } while (0)
#define SC_MM4(acc, fr, bb) do { _Pragma("unroll") for (int i_ = 0; i_ < 4; ++i_) acc = MFMA32(fr[i_], bb[i_], acc); __builtin_amdgcn_sched_barrier(0); } while (0)
            SC_RD4(fa, w0_ + SC_NW); SC_RD4(fb, w1_ + SC_NW);
            { bf16x8 sb[4] = {pack8(S[0], 0), pack8(S[0], 1), pack8(S[1], 0), pack8(S[1], 1)};
              SC_MM4(vn[0], fa, sb); SC_RD4(fa, w0_ + SC_Q2);
              SC_MM4(vn[1], fb, sb); SC_RD4(fb, w1_ + SC_Q2);
              SC_MM4(oa[0], fa, sb); SC_RD4(fa, w0_ + SC_NW + 128);
              SC_MM4(oa[1], fb, sb); SC_RD4(fb, w1_ + SC_NW + 128); }
            { bf16x8 sb[4] = {pack8(S[2], 0), pack8(S[2], 1), pack8(S[3], 0), pack8(S[3], 1)};
              SC_MM4(vn[0], fa, sb); SC_RD4(fa, w0_ + SC_Q2 + 128);
              SC_MM4(vn[1], fb, sb); SC_RD4(fb, w1_ + SC_Q2 + 128);
              bf16x8 vb[4] = {pack8(vn[0], 0), pack8(vn[0], 1), pack8(vn[1], 0), pack8(vn[1], 1)};
              SC_MM4(oa[0], fa, sb); SC_RD4(fa, kd_);
              SC_MM4(oa[1], fb, sb); SC_RD4(fb, kd_ + 32 * SC_PK * 2);
#pragma unroll
              for (int rt = 0; rt < 4; ++rt)
#pragma unroll
                  for (int r = 0; r < 16; ++r) S[rt][r] *= egl;
              SC_MM4(S[0], fa, vb); SC_RD4(fa, kd_ + 64 * SC_PK * 2);
              SC_MM4(S[1], fb, vb); SC_RD4(fb, kd_ + 96 * SC_PK * 2);
              SC_MM4(S[2], fa, vb);
              SC_MM4(S[3], fb, vb); }
#undef SC_RD4
#undef SC_MM4
            __syncthreads();
#pragma unroll
            for (int jt = 0; jt < 2; ++jt)
#pragma unroll
                for (int r = 0; r < 16; ++r) oS[(32 * jt + crow(r, hh)) * SC_PW + col] = f2bf(oa[jt][r]);
            __syncthreads();
        }
    }
}
__device__ __forceinline__ void gdn_finalize_phase(const Params& p, int wave, int lane) {
    asm volatile("" : "+v"(lane));
    bf16_t* P = (bf16_t*)(p.ws + WS_P);
    const int c0 = (lane & 15) * 8;
    float gg[8];
#pragma unroll
    for (int e = 0; e < 8; ++e) gg[e] = p.in[I_GDNOUT][c0 + e];
    for (int row = blockIdx.x * 8 + wave; row < T; row += gridDim.x * 8) {
        bf16_t* op = P + (size_t)row * NIN + C_VDN + lane * 8; const bf16_t* zp = P + (size_t)row * NIN + C_ZDN + lane * 8;
        const u32x4 ow = *(const u32x4*)op, zw = *(const u32x4*)zp;
        const float o[8] = {bf_lo(ow.x), bf_hi(ow.x), bf_lo(ow.y), bf_hi(ow.y), bf_lo(ow.z), bf_hi(ow.z), bf_lo(ow.w), bf_hi(ow.w)};
        const float z[8] = {bf_lo(zw.x), bf_hi(zw.x), bf_lo(zw.y), bf_hi(zw.y), bf_lo(zw.z), bf_hi(zw.z), bf_lo(zw.w), bf_hi(zw.w)};
        float ss = 0.f;
#pragma unroll
        for (int e = 0; e < 8; ++e) ss += o[e] * o[e];
        ss += __shfl_xor(ss, 1); ss += __shfl_xor(ss, 2); ss += __shfl_xor(ss, 4); ss += __shfl_xor(ss, 8);
        const float rstd = 1.0f / sqrtf(ss * (1.f / 128.f) + EPS);
        float r[8];
#pragma unroll
        for (int e = 0; e < 8; ++e) r[e] = o[e] * rstd * gg[e] * fsilu(z[e]);
        u32x4 w; w.x = pk2(r[0], r[1]); w.y = pk2(r[2], r[3]); w.z = pk2(r[4], r[5]); w.w = pk2(r[6], r[7]);
        *(u32x4*)op = w;
    }
}

#define XB_TMO      128
#define XB_XCNT(j)  (256  + 64 * (j))
#define XB_XSUB(j)  (1280 + 64 * (j))
#define XB_XGEN(j)  (2304 + 64 * (j))
#define XB_TOP      3328
#define XB_TOPGEN   3392
#define XCD_BAR_WORDS 3456
#define XB_SPIN_CAP (1u << 18)
__device__ __forceinline__ unsigned xb_ld(unsigned* p)              { return __hip_atomic_load(p, __ATOMIC_RELAXED, __HIP_MEMORY_SCOPE_AGENT); }
__device__ __forceinline__ unsigned xb_add(unsigned* p, unsigned v) { return __hip_atomic_fetch_add(p, v, __ATOMIC_RELAXED, __HIP_MEMORY_SCOPE_AGENT); }
__device__ __forceinline__ unsigned xb_xcc_id() { return (unsigned)__builtin_amdgcn_s_getreg((3 << 11) | 20) & 0xFu; }
#define XB_SPIN(cond, bar) do { unsigned _sp = 0; while (cond) { __builtin_amdgcn_s_sleep(1); \
    if ((++_sp & 255u) == 0u) { if (xb_ld(&(bar)[XB_TMO])) break; if (_sp > XB_SPIN_CAP) { atomicAdd(&(bar)[XB_TMO], 1u); break; } } } } while (0)
struct XcdBarrier { unsigned* bar; unsigned x; volatile LAS unsigned* st; };
__device__ __forceinline__ XcdBarrier xcd_barrier_post(unsigned* bar, volatile LAS unsigned* st) {
    XcdBarrier b; b.bar = bar; b.x = xb_xcc_id(); b.st = st;
    if (threadIdx.x == 0) (void)xb_add(&bar[XB_XCNT(b.x)], 1u);
    return b;
}
__device__ __forceinline__ void xcd_barrier_complete(unsigned* bar, unsigned x, unsigned& nloc, unsigned& nx) {
    const unsigned G = gridDim.x * gridDim.y * gridDim.z;
    unsigned sum, cnt, mine, sp = 0u;
    for (;;) {
        sum = 0u; cnt = 0u; mine = 0u;
#pragma unroll
        for (unsigned j = 0; j < 16; ++j) { const unsigned c = xb_ld(&bar[XB_XCNT(j)]); sum += c; cnt += (c > 0u) ? 1u : 0u; mine = (j == x) ? c : mine; }
        if (sum == G) break;
        __builtin_amdgcn_s_sleep(1);
        if ((++sp & 255u) == 0u) { if (xb_ld(&bar[XB_TMO])) break; if (sp > XB_SPIN_CAP) { atomicAdd(&bar[XB_TMO], 1u); break; } }
    }
    nloc = mine > 0u ? mine : 1u; nx = cnt > 0u ? cnt : 1u;
}
__device__ __forceinline__ void xcd_barrier(const XcdBarrier& b) {
    asm volatile("s_waitcnt vmcnt(0)" ::: "memory");
    __syncthreads();
    if (threadIdx.x == 0) {
        unsigned* bar = b.bar;
        __builtin_amdgcn_s_waitcnt(0);
        unsigned nloc = b.st[0], nx = b.st[1];
        if (nloc == 0u) { xcd_barrier_complete(bar, b.x, nloc, nx); b.st[0] = nloc; b.st[1] = nx; }
        const unsigned old = xb_add(&bar[XB_XSUB(b.x)], 1u);
        const unsigned gen = old / nloc;
        if (old + 1u == (gen + 1u) * nloc) {
            __builtin_amdgcn_fence(__ATOMIC_RELEASE, "agent");
            asm volatile("s_waitcnt vmcnt(0)" ::: "memory");
            const unsigned og = xb_add(&bar[XB_TOP], 1u);
            const unsigned tg = og / nx;
            if (og + 1u == (tg + 1u) * nx) xb_add(&bar[XB_TOPGEN], 1u);
            else XB_SPIN(xb_ld(&bar[XB_TOPGEN]) == tg, bar);
            __builtin_amdgcn_fence(__ATOMIC_ACQUIRE, "agent");
            xb_add(&bar[XB_XGEN(b.x)], 1u);
            asm volatile("s_waitcnt vmcnt(0)" ::: "memory");
        } else {
            XB_SPIN(xb_ld(&bar[XB_XGEN(b.x)]) == gen, bar);
            __builtin_amdgcn_fence(__ATOMIC_ACQUIRE, "agent");
            asm volatile("s_waitcnt vmcnt(0)" ::: "memory");
        }
    }
    __syncthreads();
}

#ifndef PHMASK
#define PHMASK 0xFFFF
#endif
#define PH(n) ((PHMASK >> (n)) & 1)
#ifndef PROBE
#define PROBE 0
#endif
#define REP(g) for (int _rep = 0; _rep < ((PROBE == (g)) ? 2 : 1); ++_rep)
__global__ void __launch_bounds__(512, 2) fwd_megakernel(Params p) {
    extern __shared__ __attribute__((aligned(16))) unsigned char lds_raw[];
    LAS unsigned char* lds = (LAS unsigned char*)lds_raw;
    cg::grid_group grid = cg::this_grid();
    const int tid = threadIdx.x, lane = tid & 63, wave = __builtin_amdgcn_readfirstlane(tid >> 6);
    const int G = gridDim.x, gw = wave * G + blockIdx.x, ngw = G * 8;
    unsigned char* ws = p.ws;
    bf16_t* U = (bf16_t*)(ws + WS_U); bf16_t* P = (bf16_t*)(ws + WS_P);
    const float* mod = (const float*)(ws + WS_MOD);
    LAS float* scr = (LAS float*)(lds + wave * 16384);

    unsigned* barw = (unsigned*)(ws + WS_BAR);
    volatile LAS unsigned* bst = (volatile LAS unsigned*)(lds + BST_OFF);
    if (tid < 2) bst[tid] = 0u;
    __syncthreads();
    if (p.ws == nullptr) grid.sync();
    const XcdBarrier xbar = xcd_barrier_post(barw, bst);
    REP(1) { if (PH(0)) for (int it = blockIdx.x; it < NMOD / 64; it += G) mod_item(p, lds, it, tid, wave, lane);
    if (PH(0)) ffn_weight_items(p.in[I_WFFN1IN], p.in[I_WFFN1OUT], (bf16_t*)(ws + W_FFIN), (bf16_t*)(ws + W_FFOUT), scr, gw, ngw, lane);
    __syncthreads(); }
    xcd_barrier(xbar);
    if (PROBE == 3) for (int i = 0; i < 16; ++i) xcd_barrier(xbar);
    REP(1) if (PH(1)) norm_mod_phase<false>(p, lds, p.in[I_X], p.in[I_GFFN1], 0, U, tid, wave, lane);
    xcd_barrier(xbar);
    REP(2) if (PH(2)) run_gemm(lds, U, D, (const bf16_t*)(ws + W_FFIN), 2 * FF, D, EpiSwiGLU{P, FF});
    { const int nfull = (64 * 22) % G, nidle = nfull ? G - nfull : G;
      const int ib = nfull ? (int)blockIdx.x - nfull : (int)blockIdx.x;
      if (PH(0) && ib >= 0) mixer_weight_items(p, scr, wave * nidle + ib, nidle * 8, lane); }
    xcd_barrier(xbar);
    REP(2) if (PH(3)) run_gemm(lds, P, FF, (const bf16_t*)(ws + W_FFOUT), D, FF, EpiResid{p.in[I_X], p.out, mod + 2 * D, 0.5f});
    xcd_barrier(xbar);
    REP(1) if (PH(4)) norm_mod_phase<true>(p, lds, p.out, p.in[I_GMIX], 3, U, tid, wave, lane);
    xcd_barrier(xbar);
    REP(2) if (PH(5)) run_gemm(lds, U, D, (const bf16_t*)(ws + W_IN), NIN, D, EpiBf16{P, NIN});
    xcd_barrier(xbar);
    if (PH(6)) prep_phase(p, wave, lane);
    xcd_barrier(xbar);
    if (PH(7)) gdn_chunk_prep_phase(p, lds, tid, wave, lane);
    xcd_barrier(xbar);
    if (PH(15)) for (int it = blockIdx.x; it < 32; it += G) gdn_scan_block(p, lds, it, tid, wave, lane);
    if (PH(8)) {
        const unsigned x0 = xb_xcc_id() & 7u;
        for (unsigned dx = 0; dx < 8u; ++dx) { const unsigned x = (x0 + dx) & 7u; unsigned* ctr = (unsigned*)(ws + WS_CTR) + 64 * x;
            for (;;) { unsigned idx = 0; if (lane == 0) idx = atomicAdd(ctr, 1u); idx = __builtin_amdgcn_readfirstlane(idx);
                if (idx >= 512u) break;
                attn_item_mfma(P, (const bf16_t*)(ws + WS_VT), (int)(8u * x + (idx & 7u)), 63 - (int)(idx >> 3), lane); } } }
    xcd_barrier(xbar);
    if (PH(9)) gdn_finalize_phase(p, wave, lane);
    xcd_barrier(xbar);
    if (PH(10)) run_gemm(lds, P + C_QSB, NIN, (const bf16_t*)(ws + W_UPSB), D, 1024, EpiGateFused{P + C_RSB, P + C_RDN, U}, 8, (C_VDN - C_QSB) * 2 - 8 * 128);
    xcd_barrier(xbar);
    if (PH(11)) run_gemm(lds, U, D, (const bf16_t*)(ws + W_OUT), D, D, EpiResid{p.out, p.out, mod + 5 * D, 1.0f});
    xcd_barrier(xbar);
    REP(1) if (PH(12)) norm_mod_phase<false>(p, lds, p.out, p.in[I_GFFN2], 6, U, tid, wave, lane);
    __syncthreads();
    if (PH(12)) ffn_weight_items(p.in[I_WFFN2IN], p.in[I_WFFN2OUT], (bf16_t*)(ws + W_FFIN), (bf16_t*)(ws + W_FFOUT), scr, gw, ngw, lane);
    xcd_barrier(xbar);
    REP(2) if (PH(13)) run_gemm(lds, U, D, (const bf16_t*)(ws + W_FFIN), 2 * FF, D, EpiSwiGLU{P, FF});
    xcd_barrier(xbar);
    if (PH(14)) run_gemm(lds, P, FF, (const bf16_t*)(ws + W_FFOUT), D, FF, EpiResid{p.out, p.out, mod + 8 * D, 0.5f});
}

extern "C" void kernel_launch(void* const* d_in, const int* in_sizes, int n_in, void* d_out, int out_size, void* d_ws, size_t ws_size, hipStream_t stream) {
    static int grid_blocks = 0;
    if (!grid_blocks) {
        int dev = 0, cus = 0, per_cu = 0;
        (void)hipGetDevice(&dev);
        (void)hipDeviceGetAttribute(&cus, hipDeviceAttributeMultiprocessorCount, dev);
        (void)hipFuncSetAttribute((const void*)fwd_megakernel, hipFuncAttributeMaxDynamicSharedMemorySize, LDS_BYTES);
        (void)hipOccupancyMaxActiveBlocksPerMultiprocessor(&per_cu, (const void*)fwd_megakernel, 512, LDS_BYTES);
        if (per_cu < 1) { fprintf(stderr, "occupancy query says %d blocks/CU\n", per_cu); per_cu = 1; }
        grid_blocks = cus;
    }
    Params p{};
    for (int i = 0; i < N_IN; ++i) p.in[i] = (const float*)d_in[i];
    p.out = (float*)d_out; p.ws = (unsigned char*)d_ws;
    (void)hipMemsetAsync((char*)d_ws + WS_CTR, 0, (WS_BAR - WS_CTR) + XCD_BAR_WORDS * 4, stream);
    void* args[] = {&p};
    hipError_t e = hipLaunchCooperativeKernel((const void*)fwd_megakernel, dim3(grid_blocks), dim3(512), args, LDS_BYTES, stream);
    if (e != hipSuccess) fprintf(stderr, "cooperative launch failed: %s (grid %d)\n", hipGetErrorString(e), grid_blocks);
}
```

```cpp
#include <hip/hip_runtime.h>
#include <hip/hip_cooperative_groups.h>
#include <cstdio>
namespace cg = cooperative_groups;

#define LAS __attribute__((address_space(3)))
typedef unsigned short bf16_t;
typedef short bf16x8 __attribute__((ext_vector_type(8)));
typedef float f32x4 __attribute__((ext_vector_type(4)));
typedef unsigned u32x4 __attribute__((ext_vector_type(4)));
typedef unsigned u32x2 __attribute__((ext_vector_type(2)));
typedef float f32x16 __attribute__((ext_vector_type(16)));
typedef float f32x2 __attribute__((ext_vector_type(2)));
typedef __bf16 nbf16x2 __attribute__((ext_vector_type(2)));

constexpr int T = 16384, D = 1024, SEQ = 2048, NB = 8, FF = 2816, NIN = 5632, INW = 5640, NMOD = 9216;
constexpr int C_QSB = 0, C_KSB = 512, C_VSB = 1024, C_QDN = 1536, C_KDN = 2048, C_VDN = 2560, C_ZDN = 3072, C_RSB = 3584, C_RDN = 4608;
constexpr float EPS = 1e-6f;
constexpr int LDS_BYTES = 163840, BST_OFF = LDS_BYTES - 64;
constexpr size_t MiB = 1024 * 1024;
constexpr size_t WS_MOD = 0, WS_BG = 512 * 1024, WS_SS = 242 * MiB, WS_W = 2 * MiB;
constexpr size_t W_FFIN = WS_W, W_FFOUT = W_FFIN + (size_t)2 * FF * D * 2, W_IN = W_FFOUT + (size_t)D * FF * 2, W_UPSB = W_IN + (size_t)NIN * D * 2,
                 W_UPDN = W_UPSB + (size_t)D * 512 * 2, W_OUT = W_UPDN + (size_t)D * 512 * 2, W_END = W_OUT + (size_t)D * D * 2;
constexpr size_t WS_U = 34 * MiB, WS_P = 66 * MiB;
static_assert(W_END <= WS_U, "weights overflow");
constexpr size_t WS_EGL = 384 * 1024, WS_CTR = 400 * 1024, WS_BAR = 416 * 1024;
constexpr size_t WS_VT = W_FFIN;
static_assert((size_t)T * 512 * 2 <= W_IN - W_FFIN, "Vt overflow");

enum { I_X = 0, I_C, I_WADA, I_BADA, I_GFFN1, I_WFFN1IN, I_WFFN1OUT, I_GMIX, I_WIN, I_GQSB, I_GKSB, I_WCONV, I_ALOG, I_DTBIAS, I_GDNOUT, I_WUPSB, I_WUPDN, I_WOUT, I_GFFN2, I_WFFN2IN, I_WFFN2OUT, N_IN };
struct Params { const float* in[N_IN]; float* out; unsigned char* ws; };

__device__ __forceinline__ float bf_lo(unsigned w) { return __uint_as_float(w << 16); }
__device__ __forceinline__ float bf_hi(unsigned w) { return __uint_as_float(w & 0xffff0000u); }
__device__ __forceinline__ float bf2f(bf16_t b) { return __uint_as_float(((unsigned)b) << 16); }
__device__ __forceinline__ unsigned pk2(float lo, float hi) { unsigned r; asm("v_cvt_pk_bf16_f32 %0, %1, %2" : "=v"(r) : "v"(lo), "v"(hi)); return r; }
__device__ __forceinline__ unsigned cpk2(float lo, float hi) { const f32x2 v = {lo, hi}; return __builtin_bit_cast(unsigned, __builtin_convertvector(v, nbf16x2)); }
__device__ __forceinline__ bf16_t f2bf(float f) { return (bf16_t)(pk2(f, 0.f) & 0xffffu); }
__device__ __forceinline__ float fexp(float x) { return __builtin_amdgcn_exp2f(x * 1.4426950408889634f); }
__device__ __forceinline__ float flog(float x) { return __builtin_amdgcn_logf(x) * 0.6931471805599453f; }
__device__ __forceinline__ float fsigmoid(float x) { return __builtin_amdgcn_rcpf(1.f + fexp(-x)); }
__device__ __forceinline__ float fsilu(float x) { return x * fsigmoid(x); }
__device__ __forceinline__ float fsoftplus(float x) { return fmaxf(x, 0.f) + flog(1.f + fexp(-fabsf(x))); }
__device__ __forceinline__ float wave_sum(float v) {
#pragma unroll
    for (int o = 1; o < 64; o <<= 1) v += __shfl_xor(v, o);
    return v;
}
#define LDS_WAIT() asm volatile("s_waitcnt lgkmcnt(0)" ::: "memory")

namespace pg8 {
constexpr int BM = 256, BK = 64, HALF = 128, HTB = HALF * BK * 2, STAGE_BYTES = 8 * HTB, NXCD = 8, WGM = 8;
__host__ __device__ __forceinline__ int lds_byte(int r, int c) { const int st = (r >> 4) * 2 + (c >> 5), rr = r & 15, cc = c & 31, ob = rr * 64 + cc * 2; return st * 1024 + (ob ^ (((ob >> 9) & 1) << 5)); }
__host__ __device__ __forceinline__ void stage_rc(int b, int& R, int& C) { const int st = b / 1024, sb = b % 1024, swz = sb ^ (((sb >> 9) & 1) << 5); R = (st >> 1) * 16 + swz / 64; C = (st & 1) * 32 + (swz % 64) / 2; }
__host__ __device__ __forceinline__ int perm32(int rho) { const int n = rho >> 4, i = rho & 15; return 8 * (i >> 2) + 4 * n + (i & 3); }
struct Unit { int pm, pn; };
struct Gemm { const bf16_t* A; const bf16_t* Bt; int M, N, K, lda; int jt; int jbytes; };
struct StaticOrder {
    int nM, nN, nwg, G, c;
    __host__ __device__ void init(int M, int N, int G_, int c_) { nM = M / BM; nN = N / BM; nwg = nM * nN; G = G_; c = c_; }
    __host__ __device__ bool next(int i, Unit& u) const {
        const long L = (long)i * G + c; if (L >= nwg) return false;
        int wgid = (int)L; { const int q = nwg / NXCD, r = nwg % NXCD, xcd = wgid % NXCD, off = wgid / NXCD; wgid = (xcd < r ? xcd * (q + 1) : r * (q + 1) + (xcd - r) * q) + off; }
        const int nig = WGM * nN, gid = wgid / nig, fm = gid * WGM, gsz = (nM - fm) < WGM ? (nM - fm) : WGM;
        u.pm = fm + ((wgid % nig) % gsz); u.pn = (wgid % nig) / gsz; return true;
    }
};
template <class Epi>
__device__ __forceinline__ void gemm_phase(LAS unsigned char* lds, const Gemm g, const StaticOrder& S, const Epi& E) {
    int tid = threadIdx.x; asm volatile("" : "+v"(tid));
    const int wid = __builtin_amdgcn_readfirstlane(tid >> 6), lane = tid & 63, wr = wid >> 2, wc = wid & 3, fr = lane & 15, fq = lane >> 4;
    const int K = g.K, nt = K / BK, lda = g.lda;
    unsigned voffA[2], voffB[2];
#pragma unroll
    for (int i = 0; i < 2; ++i) { int R, C; stage_rc(tid * 16 + i * 8192, R, C); const int Rb = Epi::PERM ? ((R & ~31) + perm32(R & 31)) : R;
        voffA[i] = (unsigned)(R * lda + C) * 2u; voffB[i] = (unsigned)(Rb * K + C) * 2u; }
    const size_t kstep = (size_t)(BK * 2);
    const size_t hstepA = (size_t)HALF * lda * 2, hstepB = (size_t)HALF * K * 2;
    const size_t tstepA = 2 * hstepA, tstepB = 2 * hstepB;
    const unsigned ldsw = (unsigned)wid * 1024u;
    const int aoff = lds_byte(wr * 64 + fr, fq * 8), boff = lds_byte(wc * 32 + fr, fq * 8);
#define PG8_SA(b, h) (((b) * 2 + (h)) * HTB)
#define PG8_SB(b, h) ((4 + (b) * 2 + (h)) * HTB)
#define PG8_STAGE(bufoff, gbase, voff) do { _Pragma("unroll") for (int _i = 0; _i < 2; ++_i) \
        __builtin_amdgcn_global_load_lds((const unsigned*)((const char*)(gbase) + (voff)[_i]), (LAS unsigned*)(lds + (bufoff) + ldsw + _i * 8192), 16, 0, 0); } while (0)
#define PG8_LDA(dst, b, h) do { _Pragma("unroll") for (int m = 0; m < 4; ++m) _Pragma("unroll") for (int k = 0; k < 2; ++k) dst[m][k] = *(const LAS bf16x8*)(lds + PG8_SA(b, h) + aoff + m * 2048 + k * 1024); } while (0)
#define PG8_LDB(dst, b, h) do { _Pragma("unroll") for (int n = 0; n < 2; ++n) _Pragma("unroll") for (int k = 0; k < 2; ++k) dst[n][k] = *(const LAS bf16x8*)(lds + PG8_SB(b, h) + boff + n * 2048 + k * 1024); } while (0)
#define PG8_MMA(ai, bj, At, Bt) do { __builtin_amdgcn_s_setprio(1); _Pragma("unroll") for (int m = 0; m < 4; ++m) _Pragma("unroll") for (int n = 0; n < 2; ++n) _Pragma("unroll") for (int k = 0; k < 2; ++k) \
        acc[ai][bj][m][n] = __builtin_amdgcn_mfma_f32_16x16x32_bf16(Bt[n][k], At[m][k], acc[ai][bj][m][n], 0, 0, 0); __builtin_amdgcn_s_setprio(0); } while (0)
#define PG8_WAIT_V(n) asm volatile("s_waitcnt vmcnt(" #n ")" ::: "memory")
#define PG8_WAIT_L(n) asm volatile("s_waitcnt lgkmcnt(" #n ")" ::: "memory")
#define PG8_BAR __builtin_amdgcn_s_barrier()
#define PG8_SCHED __builtin_amdgcn_sched_barrier(0)
    Unit cur, nxt; int ui = 0;
    if (!S.next(0, cur)) return;
    f32x4 acc[2][2][4][2];
#pragma unroll
    for (int a = 0; a < 2; ++a)
#pragma unroll
        for (int b = 0; b < 2; ++b)
#pragma unroll
            for (int m = 0; m < 4; ++m)
#pragma unroll
                for (int n = 0; n < 2; ++n) acc[a][b][m][n] = (f32x4){0.f, 0.f, 0.f, 0.f};
    bf16x8 At[4][2], B0[2][2], B1[2][2];
    const char* cA = (const char*)g.A + (size_t)cur.pm * tstepA; const char* cB = (const char*)g.Bt + (size_t)cur.pn * tstepB;
    PG8_STAGE(PG8_SB(0, 0), cB, voffB); PG8_STAGE(PG8_SA(0, 0), cA, voffA); PG8_STAGE(PG8_SB(0, 1), cB + hstepB, voffB); PG8_STAGE(PG8_SA(0, 1), cA + hstepA, voffA);
    if (wr == 1) PG8_BAR;
    PG8_WAIT_V(4); PG8_BAR;
    PG8_STAGE(PG8_SB(1, 0), cB + kstep, voffB); PG8_STAGE(PG8_SA(1, 0), cA + kstep, voffA); PG8_STAGE(PG8_SB(1, 1), cB + hstepB + kstep, voffB);
    PG8_WAIT_V(6); PG8_BAR;
    for (;;) {
        const bool has_next = S.next(ui + 1, nxt);
        const char* nA = has_next ? (const char*)g.A + (size_t)nxt.pm * tstepA : cA; const char* nB = has_next ? (const char*)g.Bt + (size_t)nxt.pn * tstepB : cB;
        for (int t = 0; t < nt; t += 2) {
            const bool last = (t == nt - 2);
            const char* a1 = cA + (size_t)(t + 1) * kstep + (t + 1 >= g.jt ? g.jbytes : 0);
            const char* a2 = last ? nA : cA + (size_t)(t + 2) * kstep + (t + 2 >= g.jt ? g.jbytes : 0); const char* b2 = last ? nB : cB + (size_t)(t + 2) * kstep;
            const char* a3 = a2 + kstep; const char* b3 = b2 + kstep;
            if constexpr (Epi::HAS_MID) { if (t == g.jt) E.mid(acc, cur, wr, wc, fr, fq); }
            PG8_LDB(B0, 0, 0); PG8_SCHED; PG8_LDA(At, 0, 0); PG8_STAGE(PG8_SA(1, 1), a1 + hstepA, voffA);
            PG8_WAIT_L(8); PG8_BAR; PG8_WAIT_L(0); PG8_MMA(0, 0, At, B0); PG8_BAR; PG8_SCHED;
            PG8_LDB(B1, 0, 1); PG8_STAGE(PG8_SB(0, 0), b2, voffB);
            PG8_BAR; PG8_WAIT_L(0); PG8_MMA(0, 1, At, B1); PG8_BAR;
            PG8_LDA(At, 0, 1); PG8_STAGE(PG8_SA(0, 0), a2, voffA);
            PG8_BAR; PG8_WAIT_L(0); PG8_MMA(1, 0, At, B0); PG8_BAR; PG8_SCHED;
            PG8_STAGE(PG8_SB(0, 1), b2 + hstepB, voffB);
            PG8_WAIT_V(6); PG8_BAR; PG8_MMA(1, 1, At, B1); PG8_BAR;
            PG8_LDB(B0, 1, 0); PG8_SCHED; PG8_LDA(At, 1, 0); PG8_STAGE(PG8_SA(0, 1), a2 + hstepA, voffA);
            PG8_WAIT_L(8); PG8_BAR; PG8_WAIT_L(0); PG8_MMA(0, 0, At, B0); PG8_BAR; PG8_SCHED;
            PG8_LDB(B1, 1, 1); PG8_STAGE(PG8_SB(1, 0), b3, voffB);
            PG8_BAR; PG8_WAIT_L(0); PG8_MMA(0, 1, At, B1); PG8_BAR;
            PG8_LDA(At, 1, 1); PG8_STAGE(PG8_SA(1, 0), a3, voffA);
            PG8_BAR; PG8_WAIT_L(0); PG8_MMA(1, 0, At, B0); PG8_BAR; PG8_SCHED;
            PG8_STAGE(PG8_SB(1, 1), b3 + hstepB, voffB);
            PG8_WAIT_V(6); PG8_BAR; PG8_MMA(1, 1, At, B1); PG8_BAR;
        }
        E(acc, cur, wr, wc, fr, fq);
        if (!has_next) break;
#pragma unroll
        for (int a = 0; a < 2; ++a)
#pragma unroll
            for (int b = 0; b < 2; ++b)
#pragma unroll
                for (int m = 0; m < 4; ++m)
#pragma unroll
                    for (int n = 0; n < 2; ++n) acc[a][b][m][n] = (f32x4){0.f, 0.f, 0.f, 0.f};
        cur = nxt; cA = nA; cB = nB; ++ui;
    }
    PG8_WAIT_V(0);
    if (wr == 0) PG8_BAR;
    PG8_BAR;
#undef PG8_SA
#undef PG8_SB
#undef PG8_STAGE
#undef PG8_LDA
#undef PG8_LDB
#undef PG8_MMA
#undef PG8_WAIT_V
#undef PG8_WAIT_L
#undef PG8_BAR
#undef PG8_SCHED
}
}

typedef const f32x4 (&AccRef)[2][2][4][2];
struct EpiBf16 {
    static constexpr bool PERM = true, HAS_MID = false;
    bf16_t* O; int ldc;
    __device__ __forceinline__ void operator()(AccRef acc, const pg8::Unit& u, int wr, int wc, int fr, int fq) const {
        const int row0 = u.pm * 256 + wr * 64 + fr, col0 = u.pn * 256 + wc * 32 + 8 * fq;
#pragma unroll
        for (int ai = 0; ai < 2; ++ai)
#pragma unroll
            for (int m = 0; m < 4; ++m) { bf16_t* rowp = O + (size_t)(row0 + ai * 128 + m * 16) * ldc + col0;
#pragma unroll
                for (int bj = 0; bj < 2; ++bj) { const f32x4 v0 = acc[ai][bj][m][0], v1 = acc[ai][bj][m][1];
                    u32x4 w; w.x = pk2(v0[0], v0[1]); w.y = pk2(v0[2], v0[3]); w.z = pk2(v1[0], v1[1]); w.w = pk2(v1[2], v1[3]);
                    *(u32x4*)(rowp + bj * 128) = w; } }
    }
};
struct EpiSwiGLU {
    static constexpr bool PERM = true, HAS_MID = false;
    bf16_t* O; int ldc;
    __device__ __forceinline__ void operator()(AccRef acc, const pg8::Unit& u, int wr, int wc, int fr, int fq) const {
        const int row0 = u.pm * 256 + wr * 64 + fr, col0 = u.pn * 128 + wc * 32 + 8 * fq;
#pragma unroll
        for (int ai = 0; ai < 2; ++ai)
#pragma unroll
            for (int m = 0; m < 4; ++m) { bf16_t* rowp = O + (size_t)(row0 + ai * 128 + m * 16) * ldc + col0;
                float r[8];
#pragma unroll
                for (int n = 0; n < 2; ++n)
#pragma unroll
                    for (int j = 0; j < 4; ++j) { const float a = acc[ai][0][m][n][j], b = acc[ai][1][m][n][j]; r[n * 4 + j] = fsilu(a) * b; }
                u32x4 w; w.x = pk2(r[0], r[1]); w.y = pk2(r[2], r[3]); w.z = pk2(r[4], r[5]); w.w = pk2(r[6], r[7]);
                *(u32x4*)rowp = w; }
    }
};
struct EpiResid {
    static constexpr bool PERM = false, HAS_MID = false;
    const float* base; float* out; const float* gate; float scale;
    __device__ __forceinline__ void operator()(AccRef acc, const pg8::Unit& u, int wr, int wc, int fr, int fq) const {
        const int row0 = u.pm * 256 + wr * 64 + fr, col0 = u.pn * 256 + wc * 32 + 4 * fq;
        const float* gp = gate + (size_t)(u.pm >> 3) * NMOD + col0;
        f32x4 gv[2][2];
#pragma unroll
        for (int bj = 0; bj < 2; ++bj)
#pragma unroll
            for (int n = 0; n < 2; ++n) gv[bj][n] = *(const f32x4*)(gp + bj * 128 + n * 16) * scale;
#pragma unroll
        for (int ai = 0; ai < 2; ++ai)
#pragma unroll
            for (int m = 0; m < 4; ++m) { const size_t off = (size_t)(row0 + ai * 128 + m * 16) * D + col0;
#pragma unroll
                for (int bj = 0; bj < 2; ++bj)
#pragma unroll
                    for (int n = 0; n < 2; ++n) { const f32x4 bs = *(const f32x4*)(base + off + bj * 128 + n * 16);
                        *(f32x4*)(out + off + bj * 128 + n * 16) = bs + gv[bj][n] * acc[ai][bj][m][n]; } }
    }
};
struct EpiGateFused {
    static constexpr bool PERM = true, HAS_MID = true;
    const bf16_t* Rsb; const bf16_t* Rdn; bf16_t* O;
    __device__ __forceinline__ void mid(f32x4 (&acc)[2][2][4][2], const pg8::Unit& u, int wr, int wc, int fr, int fq) const {
        int row0 = u.pm * 256 + wr * 64 + fr, col0 = u.pn * 256 + wc * 32 + 8 * fq;
        asm volatile("" : "+v"(row0), "+v"(col0));
#pragma unroll
        for (int ai = 0; ai < 2; ++ai)
#pragma unroll
            for (int m = 0; m < 4; ++m) { const size_t row = (size_t)(row0 + ai * 128 + m * 16);
#pragma unroll
                for (int bj = 0; bj < 2; ++bj) { const u32x4 a = *(const u32x4*)(Rsb + row * NIN + col0 + bj * 128), d = *(const u32x4*)(Rdn + row * NIN + col0 + bj * 128);
                    const float ra[8] = {bf_lo(a.x), bf_hi(a.x), bf_lo(a.y), bf_hi(a.y), bf_lo(a.z), bf_hi(a.z), bf_lo(a.w), bf_hi(a.w)};
                    const float rd[8] = {bf_lo(d.x), bf_hi(d.x), bf_lo(d.y), bf_hi(d.y), bf_lo(d.z), bf_hi(d.z), bf_lo(d.w), bf_hi(d.w)};
#pragma unroll
                    for (int e = 0; e < 8; ++e) { const float q = (1.0f + fexp(fminf(-rd[e], 30.0f))) * __builtin_amdgcn_rcpf(1.0f + fexp(-ra[e])); acc[ai][bj][m][e >> 2][e & 3] *= q; }
                    asm volatile("" ::: "memory"); } }
    }
    __device__ __forceinline__ void operator()(AccRef acc, const pg8::Unit& u, int wr, int wc, int fr, int fq) const {
        const int row0 = u.pm * 256 + wr * 64 + fr, col0 = u.pn * 256 + wc * 32 + 8 * fq;
#pragma unroll
        for (int ai = 0; ai < 2; ++ai)
#pragma unroll
            for (int m = 0; m < 4; ++m) { const size_t row = (size_t)(row0 + ai * 128 + m * 16);
#pragma unroll
                for (int bj = 0; bj < 2; ++bj) { const u32x4 d = *(const u32x4*)(Rdn + row * NIN + col0 + bj * 128);
                    const f32x4 v0 = acc[ai][bj][m][0], v1 = acc[ai][bj][m][1];
#define SGC(x) __builtin_amdgcn_rcpf(1.0f + fexp(fminf(-(x), 30.0f)))
                    const float r[8] = {SGC(bf_lo(d.x)) * v0[0], SGC(bf_hi(d.x)) * v0[1], SGC(bf_lo(d.y)) * v0[2], SGC(bf_hi(d.y)) * v0[3],
                                        SGC(bf_lo(d.z)) * v1[0], SGC(bf_hi(d.z)) * v1[1], SGC(bf_lo(d.w)) * v1[2], SGC(bf_hi(d.w)) * v1[3]};
#undef SGC
                    u32x4 w; w.x = pk2(r[0], r[1]); w.y = pk2(r[2], r[3]); w.z = pk2(r[4], r[5]); w.w = pk2(r[6], r[7]);
                    *(u32x4*)(O + row * D + col0 + bj * 128) = w; } }
    }
};
template <class Epi> __device__ __forceinline__ void run_gemm(LAS unsigned char* lds, const bf16_t* A, int lda, const bf16_t* Bt, int N, int K, const Epi& E, int jt = 1 << 30, int jbytes = 0) {
    pg8::Gemm g{A, Bt, T, N, K, lda, jt, jbytes}; pg8::StaticOrder S; S.init(T, N, (int)gridDim.x, (int)blockIdx.x);
    pg8::gemm_phase<Epi>(lds, g, S, E);
}

__device__ __forceinline__ void transpose_item(const float* W, int ldw, int s0, int k0, bf16_t* WT, int ldk, int d0, LAS float* scr, int lane) {
    float tv[32];
#pragma unroll
    for (int i = 0; i < 32; ++i) tv[i] = W[(size_t)(k0 + 2 * i + (lane >> 5)) * ldw + s0 + (lane & 31)];
#pragma unroll
    for (int i = 0; i < 32; ++i) scr[(2 * i + (lane >> 5)) * 33 + (lane & 31)] = tv[i];
    LDS_WAIT();
    const int c = lane & 7;
#pragma unroll
    for (int j = 0; j < 4; ++j) { const int n = (lane >> 3) + 8 * j; const LAS float* s = scr + (8 * c) * 33 + n;
        u32x4 o; o.x = pk2(s[0 * 33], s[1 * 33]); o.y = pk2(s[2 * 33], s[3 * 33]); o.z = pk2(s[4 * 33], s[5 * 33]); o.w = pk2(s[6 * 33], s[7 * 33]);
        *(u32x4*)(WT + (size_t)(d0 + n) * ldk + k0 + 8 * c) = o; }
    LDS_WAIT();
}
__device__ __forceinline__ void ffn_weight_items(const float* w_in, const float* w_out, bf16_t* wt_in, bf16_t* wt_out, LAS float* scr, int gw, int ngw, int lane) {
    for (int it = gw; it < 2816 + 1408; it += ngw) {
        if (it < 2816) { const int kb = it / 176, nb = it % 176, d0 = nb * 32, pn = d0 >> 8, bj = (d0 >> 7) & 1, c = d0 & 127, s0 = bj * FF + pn * 128 + c;
            transpose_item(w_in, 2 * FF, s0, kb * 64, wt_in, D, d0, scr, lane); }
        else { const int r = it - 2816, kb = r / 32, nb = r % 32; transpose_item(w_out, D, nb * 32, kb * 64, wt_out, FF, nb * 32, scr, lane); }
    }
}
__device__ __forceinline__ void mixer_weight_items(const Params& p, LAS float* scr, int gw, int ngw, int lane) {
    unsigned char* ws = p.ws;
    for (int it = gw; it < 2816 + 256 + 256 + 512; it += ngw) {
        int r = it;
        if (r < 2816) { const int kb = r / 176, nb = r % 176, d0 = nb * 32, s0 = d0 < C_RSB ? d0 : d0 + 8; transpose_item(p.in[I_WIN], INW, s0, kb * 64, (bf16_t*)(ws + W_IN), D, d0, scr, lane); continue; } r -= 2816;
        if (r < 256) { const int kb = r / 32, nb = r % 32; transpose_item(p.in[I_WUPSB], D, nb * 32, kb * 64, (bf16_t*)(ws + W_UPSB), D, nb * 32, scr, lane); continue; } r -= 256;
        if (r < 256) { const int kb = r / 32, nb = r % 32; transpose_item(p.in[I_WUPDN], D, nb * 32, kb * 64, (bf16_t*)(ws + W_UPSB) + 512, D, nb * 32, scr, lane); continue; } r -= 256;
        { const int kb = r / 32, nb = r % 32; transpose_item(p.in[I_WOUT], D, nb * 32, kb * 64, (bf16_t*)(ws + W_OUT), D, nb * 32, scr, lane); }
    }
}
__device__ __forceinline__ void mod_item(const Params& p, LAS unsigned char* lds, int cb, int tid, int wave, int lane) {
    asm volatile("" : "+v"(tid), "+v"(lane));
    LAS float* sc = (LAS float*)lds; LAS float* red = (LAS float*)(lds + 32768);
    for (int i = tid; i < NB * D; i += 512) sc[i] = fsilu(p.in[I_C][i]);
    __syncthreads();
    const float* wa = p.in[I_WADA] + cb * 64 + lane;
    float acc[NB];
#pragma unroll
    for (int b = 0; b < NB; ++b) acc[b] = 0.f;
    for (int k = wave * 128; k < wave * 128 + 128; k += 16) {
        float w[16];
#pragma unroll
        for (int e = 0; e < 16; ++e) w[e] = wa[(size_t)(k + e) * NMOD];
#pragma unroll
        for (int b = 0; b < NB; ++b)
#pragma unroll
            for (int e4 = 0; e4 < 4; ++e4) { const f32x4 s = *(const LAS f32x4*)(sc + b * D + k + 4 * e4); acc[b] += s[0] * w[4 * e4] + s[1] * w[4 * e4 + 1] + s[2] * w[4 * e4 + 2] + s[3] * w[4 * e4 + 3]; }
    }
#pragma unroll
    for (int b = 0; b < NB; ++b) red[(wave * NB + b) * 64 + lane] = acc[b];
    __syncthreads();
    { const int b = tid >> 6; float s = p.in[I_BADA][cb * 64 + lane];
#pragma unroll
        for (int w = 0; w < 8; ++w) s += red[(w * NB + b) * 64 + lane];
        ((float*)(p.ws + WS_MOD))[b * NMOD + cb * 64 + lane] = s; }
    __syncthreads();
}

template <bool DN>
__device__ __forceinline__ void norm_mod_phase(const Params& p, LAS unsigned char* lds, const float* src, const float* gain, int midx, bf16_t* dst, int tid, int wave, int lane) {
    asm volatile("" : "+v"(tid), "+v"(lane));
    const float* mod = (const float*)(p.ws + WS_MOD);
    LAS float* wl = (LAS float*)lds;
    if (DN) { for (int i = tid; i < D * 8; i += 512) { const int k = i >> 3, j = i & 7; wl[8 * k + 4 * (k >> 2) + j] = p.in[I_WIN][(size_t)k * INW + C_RSB + j]; } __syncthreads(); }
    f32x4 g4[4];
#pragma unroll
    for (int j = 0; j < 4; ++j) g4[j] = ((const f32x4*)gain)[lane + 64 * j];
    const int rstep = gridDim.x * 8;
    f32x4 nv[4];
    { const int r0 = blockIdx.x * 8 + wave; const f32x4* xr = (const f32x4*)(src + (size_t)(r0 < T ? r0 : 0) * D) + lane;
#pragma unroll
      for (int j = 0; j < 4; ++j) nv[j] = xr[64 * j]; }
    for (int row = blockIdx.x * 8 + wave; row < T; row += rstep) {
        const int b = row >> 11;
        const f32x4* shp = (const f32x4*)(mod + (size_t)b * NMOD + midx * D) + lane; const f32x4* scp = shp + D / 4;
        f32x4 v[4], shv[4], scv[4]; float ss = 0.f;
#pragma unroll
        for (int j = 0; j < 4; ++j) { v[j] = nv[j]; shv[j] = shp[64 * j]; scv[j] = scp[64 * j]; }
        { const int rn = row + rstep < T ? row + rstep : row; const f32x4* xr = (const f32x4*)(src + (size_t)rn * D) + lane;
#pragma unroll
          for (int j = 0; j < 4; ++j) nv[j] = xr[64 * j]; }
#pragma unroll
        for (int j = 0; j < 4; ++j) ss += (v[j][0] * v[j][0] + v[j][1] * v[j][1]) + (v[j][2] * v[j][2] + v[j][3] * v[j][3]);
        const float rstd = 1.0f / sqrtf(wave_sum(ss) * (1.f / D) + EPS);
        u32x2* o8 = (u32x2*)(dst + (size_t)row * D) + lane;
        float dot[8];
        if (DN) {
#pragma unroll
            for (int e = 0; e < 8; ++e) dot[e] = 0.f; }
#pragma unroll
        for (int j = 0; j < 4; ++j) { const f32x4 sh = shv[j], sc = scv[j];
            const f32x4 uu = v[j] * rstd * g4[j] * (sc + 1.0f) + sh;
            u32x2 w; w.x = pk2(uu[0], uu[1]); w.y = pk2(uu[2], uu[3]); o8[64 * j] = w;
            if (DN) {
#pragma unroll
                for (int e = 0; e < 4; ++e) { const int k = 4 * lane + 256 * j + e; const LAS f32x4* wp = (const LAS f32x4*)(wl + 8 * k + 4 * (k >> 2)); const f32x4 w0 = wp[0], w1 = wp[1];
                    dot[0] += uu[e] * w0[0]; dot[1] += uu[e] * w0[1]; dot[2] += uu[e] * w0[2]; dot[3] += uu[e] * w0[3];
                    dot[4] += uu[e] * w1[0]; dot[5] += uu[e] * w1[1]; dot[6] += uu[e] * w1[2]; dot[7] += uu[e] * w1[3]; } } }
        if (DN) {
#pragma unroll
            for (int e = 0; e < 8; ++e) dot[e] = wave_sum(dot[e]);
            float mine = dot[0];
#pragma unroll
            for (int e = 1; e < 8; ++e) mine = (lane == e) ? dot[e] : mine;
            if (lane < 8) { float r;
                if (lane < 4) r = 1.0f / (1.0f + expf(-mine));
                else { const int hh = lane - 4; const float a = mine + p.in[I_DTBIAS][hh]; const float sp = a > 20.f ? a : log1pf(expf(a)); r = -expf(p.in[I_ALOG][hh]) * sp; }
                ((float*)(p.ws + WS_BG))[(size_t)row * 8 + lane] = r; } }
    }
    if (DN) __syncthreads();
}

__device__ __forceinline__ void unpack16(const bf16_t* p, float* f) {
    const u32x4 a = ((const u32x4*)p)[0], b = ((const u32x4*)p)[1];
    f[0] = bf_lo(a.x); f[1] = bf_hi(a.x); f[2] = bf_lo(a.y); f[3] = bf_hi(a.y); f[4] = bf_lo(a.z); f[5] = bf_hi(a.z); f[6] = bf_lo(a.w); f[7] = bf_hi(a.w);
    f[8] = bf_lo(b.x); f[9] = bf_hi(b.x); f[10] = bf_lo(b.y); f[11] = bf_hi(b.y); f[12] = bf_lo(b.z); f[13] = bf_hi(b.z); f[14] = bf_lo(b.w); f[15] = bf_hi(b.w);
}
__device__ __forceinline__ void pack16(bf16_t* p, const float* f) {
    u32x4 a, b; a.x = pk2(f[0], f[1]); a.y = pk2(f[2], f[3]); a.z = pk2(f[4], f[5]); a.w = pk2(f[6], f[7]); b.x = pk2(f[8], f[9]); b.y = pk2(f[10], f[11]); b.z = pk2(f[12], f[13]); b.w = pk2(f[14], f[15]);
    ((u32x4*)p)[0] = a; ((u32x4*)p)[1] = b;
}
__device__ __forceinline__ void prep_phase(const Params& p, int wave, int lane) {
    asm volatile("" : "+v"(lane));
    bf16_t* P = (bf16_t*)(p.ws + WS_P); bf16_t* U = (bf16_t*)(p.ws + WS_U);
    const int ch = 16 * lane;
    float gsb[16], wcv[4][16];
    { const float* gp = (ch < 512 ? p.in[I_GQSB] : p.in[I_GKSB]) + (ch & 63); const float sc = ch < 512 ? 0.18033688011112042f : 1.0f;
#pragma unroll
        for (int e = 0; e < 16; ++e) gsb[e] = gp[e] * sc;
#pragma unroll
        for (int i = 0; i < 4; ++i)
#pragma unroll
            for (int e = 0; e < 16; ++e) wcv[i][e] = p.in[I_WCONV][i * 1536 + ch + e]; }
    for (int row = blockIdx.x * 8 + wave; row < T; row += gridDim.x * 8) {
        const int tl = row & (SEQ - 1);
        { bf16_t* qp = P + (size_t)row * NIN + ch; float f[16]; unpack16(qp, f); float ss = 0.f;
#pragma unroll
            for (int e = 0; e < 16; ++e) ss += f[e] * f[e];
            ss += __shfl_xor(ss, 1); ss += __shfl_xor(ss, 2);
            const float rstd = 1.0f / sqrtf(ss * (1.f / 64.f) + EPS);
#pragma unroll
            for (int e = 0; e < 16; ++e) f[e] = f[e] * rstd * gsb[e];
            pack16(qp, f); }
        { float y[16];
#pragma unroll
            for (int e = 0; e < 16; ++e) y[e] = 0.f;
#pragma unroll
            for (int i = 0; i < 4; ++i) { if (tl - 3 + i >= 0) { float f[16]; unpack16(P + (size_t)(row - 3 + i) * NIN + C_QDN + ch, f);
#pragma unroll
                    for (int e = 0; e < 16; ++e) y[e] += wcv[i][e] * f[e]; } }
            float ss = 0.f;
#pragma unroll
            for (int e = 0; e < 16; ++e) { y[e] = fsilu(y[e]); ss += y[e] * y[e]; }
            ss += __shfl_xor(ss, 1); ss += __shfl_xor(ss, 2); ss += __shfl_xor(ss, 4);
            const float sc = (1.0f / sqrtf(ss + EPS)) * (ch < 512 ? 0.08838834764831845f : 1.0f);
#pragma unroll
            for (int e = 0; e < 16; ++e) y[e] *= sc;
            pack16(U + (size_t)row * D + ch, y); }
    }
    bf16_t* Vt = (bf16_t*)(p.ws + WS_VT);
    for (int it = blockIdx.x * 8 + wave; it < T / 16; it += gridDim.x * 8) {
        const int row0 = it * 16, b = row0 >> 11, tl0 = row0 & (SEQ - 1), c8 = lane * 8, hd = c8 >> 6, d0 = c8 & 63;
        u32x4 w[16];
#pragma unroll
        for (int r = 0; r < 16; ++r) w[r] = *(const u32x4*)(P + (size_t)(row0 + r) * NIN + C_VSB + c8);
#pragma unroll
        for (int e = 0; e < 8; ++e) {
            unsigned o[8];
#pragma unroll
            for (int i = 0; i < 8; ++i) {
                const int p0 = 2 * i, p1 = 2 * i + 1;
                const int k0 = 8 * ((p0 >> 2) & 1) + 4 * (p0 >> 3) + (p0 & 3), k1 = 8 * ((p1 >> 2) & 1) + 4 * (p1 >> 3) + (p1 & 3);
                const unsigned a0 = w[k0][e >> 1], a1 = w[k1][e >> 1];
                const unsigned lo = (e & 1) ? (a0 >> 16) : (a0 & 0xffffu), hi = (e & 1) ? (a1 & 0xffff0000u) : (a1 << 16);
                o[i] = lo | hi; }
            bf16_t* dst = Vt + ((size_t)(b * 8 + hd) * 64 + d0 + e) * SEQ + tl0;
            ((u32x4*)dst)[0] = (u32x4){o[0], o[1], o[2], o[3]}; ((u32x4*)dst)[1] = (u32x4){o[4], o[5], o[6], o[7]}; }
    }
}

__device__ __forceinline__ float xlane32(float x, int hh) {
    const unsigned xi = __builtin_bit_cast(unsigned, x);
    const u32x2 r = __builtin_amdgcn_permlane32_swap(xi, xi, false, false);
    return __builtin_bit_cast(float, hh ? r.x : r.y);
}
template <bool DIAG>
__device__ __forceinline__ void attn_tile(const f32x16& z, const bf16x8 (&vc)[4], f32x16& o0, f32x16& o1, float& R, int ql, int hh) {
    float sg[16], m[16];
#pragma unroll
    for (int i = 0; i < 16; ++i) { const float e = __builtin_amdgcn_exp2f(fminf(-z[i], 80.0f)); float sig = __builtin_amdgcn_rcpf(1.0f + e); float mm = e * sig;
        if (DIAG) { const bool act = ((i & 3) + 8 * (i >> 2) + 4 * hh) < ql; sig = act ? sig : 0.f; mm = act ? mm : 1.0f; }
        sg[i] = sig; m[i] = mm; }
    float g[4], gp[4];
#pragma unroll
    for (int bq = 0; bq < 4; ++bq) { g[bq] = (m[4 * bq] * m[4 * bq + 1]) * (m[4 * bq + 2] * m[4 * bq + 3]); gp[bq] = xlane32(g[bq], hh); }
    float outer[4]; float tb = R;
#pragma unroll
    for (int bq = 3; bq >= 0; --bq) { outer[bq] = hh == 0 ? tb * gp[bq] : tb; tb *= g[bq] * gp[bq]; }
    R = tb;
    float w[16];
#pragma unroll
    for (int bq = 0; bq < 4; ++bq) { const float s3 = outer[bq], s2 = s3 * m[4 * bq + 3], s1 = s2 * m[4 * bq + 2], s0 = s1 * m[4 * bq + 1];
        w[4 * bq + 3] = sg[4 * bq + 3] * s3; w[4 * bq + 2] = sg[4 * bq + 2] * s2; w[4 * bq + 1] = sg[4 * bq + 1] * s1; w[4 * bq] = sg[4 * bq] * s0; }
    bf16x8 wf[2];
#pragma unroll
    for (int s2 = 0; s2 < 2; ++s2) { const u32x4 pw = {cpk2(w[8 * s2], w[8 * s2 + 1]), cpk2(w[8 * s2 + 2], w[8 * s2 + 3]), cpk2(w[8 * s2 + 4], w[8 * s2 + 5]), cpk2(w[8 * s2 + 6], w[8 * s2 + 7])}; wf[s2] = __builtin_bit_cast(bf16x8, pw); }
    o0 = __builtin_amdgcn_mfma_f32_32x32x16_bf16(vc[0], wf[0], o0, 0, 0, 0); o0 = __builtin_amdgcn_mfma_f32_32x32x16_bf16(vc[1], wf[1], o0, 0, 0, 0);
    o1 = __builtin_amdgcn_mfma_f32_32x32x16_bf16(vc[2], wf[0], o1, 0, 0, 0); o1 = __builtin_amdgcn_mfma_f32_32x32x16_bf16(vc[3], wf[1], o1, 0, 0, 0);
}
__device__ __forceinline__ void attn_item_mfma(bf16_t* P, const bf16_t* Vt, int bh, int qt, int lane) {
    asm volatile("" : "+v"(lane));
    const int b = bh >> 3, h = bh & 7, ql = lane & 31, hh = lane >> 5, q0 = qt * 32;
    bf16_t* qrow = P + (size_t)(b * SEQ + q0 + ql) * NIN + C_QSB + h * 64;
    bf16x8 qf[4];
#pragma unroll
    for (int s = 0; s < 4; ++s) qf[s] = *(const bf16x8*)(qrow + 16 * s + 8 * hh);
    f32x16 o0, o1;
#pragma unroll
    for (int i = 0; i < 16; ++i) { o0[i] = 0.f; o1[i] = 0.f; }
    float R = 1.0f;
    const bf16_t* kb = P + (size_t)(b * SEQ + ql) * NIN + C_KSB + h * 64 + 8 * hh;
    const bf16_t* vb = Vt + ((size_t)bh * 64 + ql) * SEQ + 8 * hh;
    bf16x8 kf[4], vf[4], vn[4];
#define AT_LOADK(k0_) do { _Pragma("unroll") for (int s = 0; s < 4; ++s) kf[s] = *(const bf16x8*)(kb + (size_t)(k0_) * NIN + 16 * s); } while (0)
#define AT_LOADV(dst, k0_) do { _Pragma("unroll") for (int j = 0; j < 4; ++j) dst[j] = *(const bf16x8*)(vb + (size_t)(j >> 1) * 32 * SEQ + (k0_) + 16 * (j & 1)); } while (0)
#define AT_QK(zz) do { _Pragma("unroll") for (int i = 0; i < 16; ++i) zz[i] = 0.f; _Pragma("unroll") for (int s = 0; s < 4; ++s) zz = __builtin_amdgcn_mfma_f32_32x32x16_bf16(kf[s], qf[s], zz, 0, 0, 0); } while (0)
    f32x16 zc, zn;
    AT_LOADK(q0); AT_LOADV(vf, q0);
    AT_QK(zc);
    { const int k1 = (qt > 0 ? qt - 1 : 0) * 32; AT_LOADK(k1); AT_LOADV(vn, k1); }
    { AT_QK(zn);
      const int k2 = (qt > 1 ? qt - 2 : 0) * 32; AT_LOADK(k2);
      attn_tile<true>(zc, vf, o0, o1, R, ql, hh);
      zc = zn;
#pragma unroll
      for (int j = 0; j < 4; ++j) vf[j] = vn[j];
      const int k1 = (qt > 1 ? qt - 2 : 0) * 32; AT_LOADV(vn, k1); }
#pragma unroll 1
    for (int kt = qt - 1; kt >= 0; --kt) {
        AT_QK(zn);
        const int k2 = (kt > 1 ? kt - 2 : 0) * 32; AT_LOADK(k2);
        attn_tile<false>(zc, vf, o0, o1, R, ql, hh);
        if (__builtin_amdgcn_ballot_w64(R != 0.0f) == 0ull) break;
        zc = zn;
#pragma unroll
        for (int j = 0; j < 4; ++j) vf[j] = vn[j];
        AT_LOADV(vn, k2);
    }
#undef AT_LOADK
#undef AT_LOADV
#undef AT_QK
#pragma unroll
    for (int bq = 0; bq < 4; ++bq) {
        u32x2 w0 = {cpk2(o0[4 * bq], o0[4 * bq + 1]), cpk2(o0[4 * bq + 2], o0[4 * bq + 3])}, w1 = {cpk2(o1[4 * bq], o1[4 * bq + 1]), cpk2(o1[4 * bq + 2], o1[4 * bq + 3])};
        *(u32x2*)(qrow + 8 * bq + 4 * hh) = w0; *(u32x2*)(qrow + 32 + 8 * bq + 4 * hh) = w1; }
}
__device__ __forceinline__ size_t slotU(size_t t0, int h, int colbase, int f) { return (t0 + (size_t)(f >> 7)) * D + colbase + h * 128 + (f & 127); }
__device__ __forceinline__ size_t slotP(size_t t0, int h, int colbase, int f) { return (t0 + (size_t)(f >> 7)) * NIN + colbase + h * 128 + (f & 127); }
__device__ __forceinline__ int permpos(int x) { const int k = x & 15; return (x & ~15) + 8 * ((k >> 2) & 1) + 4 * (k >> 3) + (k & 3); }
__device__ __forceinline__ int crow(int r, int hh) { return (r & 3) + 8 * (r >> 2) + 4 * hh; }
__device__ __forceinline__ bf16x8 pack8(const f32x16& x, int s2) {
    const u32x4 pw = {cpk2(x[8 * s2], x[8 * s2 + 1]), cpk2(x[8 * s2 + 2], x[8 * s2 + 3]), cpk2(x[8 * s2 + 4], x[8 * s2 + 5]), cpk2(x[8 * s2 + 6], x[8 * s2 + 7])};
    return __builtin_bit_cast(bf16x8, pw);
}
#define MFMA32(a, b, c) __builtin_amdgcn_mfma_f32_32x32x16_bf16((a), (b), (c), 0, 0, 0)
constexpr int PT = 72, PQ = 136, PL = 68, PB = 40;
constexpr int CP_GC = 0, CP_BT = 256, CP_LS = 1024, CP_TU = CP_LS + 64 * PL * 4, CP_TW = CP_TU + 64 * PT * 2, CP_KT = CP_TW + 64 * PT * 2, CP_VT = CP_KT + 128 * PT * 2,
              CP_QS = CP_VT + 128 * PT * 2, CP_KS = CP_QS + 64 * PQ * 2, CP_AQ = CP_KS + 64 * PQ * 2, CP_L21 = CP_AQ + 64 * PT * 2, CP_TCM = CP_L21 + 32 * PB * 2, CP_T22 = CP_TCM + 32 * PB * 2, CP_END = CP_T22 + 32 * PB * 2;
static_assert(CP_END <= 131072, "chunk prep LDS");
__device__ __forceinline__ void gdn_chunk_prep_phase(const Params& p, LAS unsigned char* lds, int tid, int wave, int lane) {
    bf16_t* P = (bf16_t*)(p.ws + WS_P); bf16_t* U = (bf16_t*)(p.ws + WS_U); const float* BG = (const float*)(p.ws + WS_BG);
    u32x4 ka, kb, qa, qb, xv[4][2]; float gx = 0.f, gbt = 0.f;
#define CP_LOAD(item_) do { const int bh_ = (item_) >> 5, n_ = (item_) & 31, b_ = bh_ >> 2, h_ = bh_ & 3; const size_t t0_ = (size_t)b_ * SEQ + n_ * 64; const int tok_ = tid >> 3, c16_ = (tid & 7) * 16; \
        ka = *(const u32x4*)(U + (t0_ + tok_) * D + 512 + h_ * 128 + c16_); kb = *(const u32x4*)(U + (t0_ + tok_) * D + 512 + h_ * 128 + c16_ + 8); \
        qa = *(const u32x4*)(U + (t0_ + tok_) * D + h_ * 128 + c16_); qb = *(const u32x4*)(U + (t0_ + tok_) * D + h_ * 128 + c16_ + 8); \
        _Pragma("unroll") for (int i = 0; i < 4; ++i) { const bool ok = n_ * 64 + tok_ - 3 + i >= 0; const bf16_t* vp = P + (t0_ + tok_ - 3 + i) * NIN + C_VDN + h_ * 128 + c16_; \
            xv[i][0] = ok ? *(const u32x4*)vp : (u32x4){0u, 0u, 0u, 0u}; xv[i][1] = ok ? *(const u32x4*)(vp + 8) : (u32x4){0u, 0u, 0u, 0u}; } \
        if (tid < 64) { gx = BG[(t0_ + tid) * 8 + 4 + h_]; gbt = BG[(t0_ + tid) * 8 + h_]; } } while (0)
    if ((int)blockIdx.x < 1024) CP_LOAD((int)blockIdx.x);
  for (int item = blockIdx.x; item < 1024; item += gridDim.x) {
    asm volatile("" : "+v"(tid), "+v"(lane));
    const int bh = item >> 5, n = item & 31, b = bh >> 2, h = bh & 3, ql = lane & 31, hh = lane >> 5;
    const size_t t0 = (size_t)b * SEQ + n * 64;
    LAS float* gcS = (LAS float*)(lds + CP_GC); LAS float* btS = (LAS float*)(lds + CP_BT);
    LAS float* LS = (LAS float*)(lds + CP_LS);
    LAS bf16_t* TuS = (LAS bf16_t*)(lds + CP_TU); LAS bf16_t* TwS = (LAS bf16_t*)(lds + CP_TW);
    LAS bf16_t* kT = (LAS bf16_t*)(lds + CP_KT); LAS bf16_t* vT = (LAS bf16_t*)(lds + CP_VT); LAS bf16_t* qS = (LAS bf16_t*)(lds + CP_QS); LAS bf16_t* kS = (LAS bf16_t*)(lds + CP_KS);
    LAS bf16_t* AQ = (LAS bf16_t*)(lds + CP_AQ); LAS bf16_t* L21b = (LAS bf16_t*)(lds + CP_L21); LAS bf16_t* Tcm = (LAS bf16_t*)(lds + CP_TCM); LAS bf16_t* T22r = (LAS bf16_t*)(lds + CP_T22);
    if (tid < 64) { float x = gx;
#pragma unroll
        for (int o = 1; o < 64; o <<= 1) { const float y = __shfl_up(x, o); if (lane >= o) x += y; }
        gcS[tid] = x; btS[tid] = gbt; }
    { const int tok = tid >> 3, c16 = (tid & 7) * 16;
        *(LAS u32x4*)(kS + tok * PQ + c16) = ka; *(LAS u32x4*)(kS + tok * PQ + c16 + 8) = kb;
        *(LAS u32x4*)(qS + tok * PQ + c16) = qa; *(LAS u32x4*)(qS + tok * PQ + c16 + 8) = qb;
        const unsigned kw[8] = {ka.x, ka.y, ka.z, ka.w, kb.x, kb.y, kb.z, kb.w};
#pragma unroll
        for (int e = 0; e < 8; ++e) { kT[(c16 + 2 * e) * PT + tok] = (bf16_t)(kw[e] & 0xffffu); kT[(c16 + 2 * e + 1) * PT + tok] = (bf16_t)(kw[e] >> 16); }
        float y[16];
#pragma unroll
        for (int e = 0; e < 16; ++e) y[e] = 0.f;
#pragma unroll
        for (int i = 0; i < 4; ++i) { const float* wp = p.in[I_WCONV] + i * 1536 + 1024 + h * 128 + c16;
            const unsigned xw[8] = {xv[i][0].x, xv[i][0].y, xv[i][0].z, xv[i][0].w, xv[i][1].x, xv[i][1].y, xv[i][1].z, xv[i][1].w};
#pragma unroll
            for (int e = 0; e < 8; ++e) { y[2 * e] += wp[2 * e] * bf_lo(xw[e]); y[2 * e + 1] += wp[2 * e + 1] * bf_hi(xw[e]); } }
#pragma unroll
        for (int e = 0; e < 16; ++e) vT[(c16 + e) * PT + tok] = f2bf(fsilu(y[e])); }
    __syncthreads();
    if (item + (int)gridDim.x < 1024) CP_LOAD(item + (int)gridDim.x);
    if (wave == 0 || wave == 4 || wave == 5) {
        const int it = wave == 0 ? 0 : 1, jt = wave == 4 ? 1 : 0;
        f32x16 acc;
#pragma unroll
        for (int r = 0; r < 16; ++r) acc[r] = 0.f;
#pragma unroll
        for (int ks = 0; ks < 8; ++ks) acc = MFMA32(*(const LAS bf16x8*)(kS + (32 * it + ql) * PQ + 16 * ks + 8 * hh), *(const LAS bf16x8*)(kS + (32 * jt + ql) * PQ + 16 * ks + 8 * hh), acc);
        const int j = 32 * jt + ql; const float gj = gcS[j];
#pragma unroll
        for (int r = 0; r < 16; ++r) { const int i = 32 * it + crow(r, hh); const float l = (j < i) ? btS[i] * acc[r] * fexp(gcS[i] - gj) : 0.f;
            if (it != jt) L21b[(i - 32) * PB + j] = f2bf(l); else LS[i * PL + j] = l; }
    } else if (wave < 4) {
        const int jt = wave == 3 ? 1 : 0, it = wave == 1 ? 0 : 1;
        f32x16 acc;
#pragma unroll
        for (int r = 0; r < 16; ++r) acc[r] = 0.f;
#pragma unroll
        for (int ks = 0; ks < 8; ++ks) acc = MFMA32(*(const LAS bf16x8*)(kS + (32 * jt + ql) * PQ + 16 * ks + 8 * hh), *(const LAS bf16x8*)(qS + (32 * it + ql) * PQ + 16 * ks + 8 * hh), acc);
        const int i = 32 * it + ql; const float gi = gcS[i];
#pragma unroll
        for (int r = 0; r < 16; ++r) { const int j = 32 * jt + crow(r, hh); acc[r] = (j <= i) ? acc[r] * fexp(gi - gcS[j]) : 0.f; }
#pragma unroll
        for (int bq = 0; bq < 4; ++bq) *(LAS u32x2*)(AQ + i * PT + 32 * jt + 8 * bq + 4 * hh) = (u32x2){cpk2(acc[4 * bq], acc[4 * bq + 1]), cpk2(acc[4 * bq + 2], acc[4 * bq + 3])};
    } else {
        const float gl = gcS[63];
#pragma unroll
        for (int uu = 0; uu < 4; ++uu) { const int unit = (tid - 384) + 128 * uu, dk = unit >> 2, blk = unit & 3;
            const u32x4 k0 = *(const LAS u32x4*)(kT + dk * PT + 16 * blk), k1 = *(const LAS u32x4*)(kT + dk * PT + 16 * blk + 8);
            float kv[16] = {bf_lo(k0.x), bf_hi(k0.x), bf_lo(k0.y), bf_hi(k0.y), bf_lo(k0.z), bf_hi(k0.z), bf_lo(k0.w), bf_hi(k0.w), bf_lo(k1.x), bf_hi(k1.x), bf_lo(k1.y), bf_hi(k1.y), bf_lo(k1.z), bf_hi(k1.z), bf_lo(k1.w), bf_hi(k1.w)};
#pragma unroll
            for (int e = 0; e < 16; ++e) kv[e] *= fexp(gl - gcS[16 * blk + e]);
            float pv[16];
#pragma unroll
            for (int e = 0; e < 16; ++e) pv[permpos(e)] = kv[e];
            pack16(P + slotP(t0, h, C_VSB, dk * 64 + 16 * blk), pv); }
        if (tid == 384) ((float*)(p.ws + WS_EGL))[bh * 32 + n] = fexp(gl);
    }
    __syncthreads();
    if (wave == 0) {
        const LAS float* LB = LS + (32 * hh) * PL + 32 * hh;
        float Tc[32];
#pragma unroll
        for (int i = 0; i < 32; ++i) {
            float a0 = (ql == i) ? 1.0f : 0.f, a1 = 0.f, a2 = 0.f, a3 = 0.f;
#pragma unroll
            for (int j4 = 0; j4 < i; j4 += 4) { const f32x4 l4 = *(const LAS f32x4*)(LB + i * PL + j4);
                a0 -= l4[0] * Tc[j4]; if (j4 + 1 < i) a1 -= l4[1] * Tc[j4 + 1]; if (j4 + 2 < i) a2 -= l4[2] * Tc[j4 + 2]; if (j4 + 3 < i) a3 -= l4[3] * Tc[j4 + 3]; }
            Tc[i] = (a0 + a1) + (a2 + a3); }
        const int cg_ = 32 * hh + ql; const float bu = btS[cg_], bw = bu * fexp(gcS[cg_]);
#pragma unroll
        for (int i = 0; i < 32; ++i) { TuS[(32 * hh + i) * PT + cg_] = f2bf(Tc[i] * bu); TwS[(32 * hh + i) * PT + cg_] = f2bf(Tc[i] * bw); }
        if (hh == 0) {
#pragma unroll
            for (int i8 = 0; i8 < 4; ++i8) *(LAS u32x4*)(Tcm + ql * PB + 8 * i8) = (u32x4){cpk2(Tc[8 * i8], Tc[8 * i8 + 1]), cpk2(Tc[8 * i8 + 2], Tc[8 * i8 + 3]), cpk2(Tc[8 * i8 + 4], Tc[8 * i8 + 5]), cpk2(Tc[8 * i8 + 6], Tc[8 * i8 + 7])};
        } else {
#pragma unroll
            for (int i = 0; i < 32; ++i) T22r[i * PB + ql] = f2bf(Tc[i]);
        }
        LDS_WAIT();
        f32x16 x1;
#pragma unroll
        for (int r = 0; r < 16; ++r) x1[r] = 0.f;
#pragma unroll
        for (int s2 = 0; s2 < 2; ++s2) x1 = MFMA32(*(const LAS bf16x8*)(L21b + ql * PB + 16 * s2 + 8 * hh), *(const LAS bf16x8*)(Tcm + ql * PB + 16 * s2 + 8 * hh), x1);
        f32x16 yy;
#pragma unroll
        for (int r = 0; r < 16; ++r) yy[r] = 0.f;
#pragma unroll
        for (int s2 = 0; s2 < 2; ++s2) { const u32x2 lo = *(const LAS u32x2*)(T22r + ql * PB + 16 * s2 + 4 * hh), hi = *(const LAS u32x2*)(T22r + ql * PB + 16 * s2 + 8 + 4 * hh);
            const u32x4 af = {lo.x, lo.y, hi.x, hi.y};
            yy = MFMA32(__builtin_bit_cast(bf16x8, af), pack8(x1, s2), yy); }
        { const float bu0 = btS[ql], bw0 = bu0 * fexp(gcS[ql]);
#pragma unroll
            for (int r = 0; r < 16; ++r) { const int i2 = 32 + crow(r, hh); TuS[i2 * PT + ql] = f2bf(-yy[r] * bu0); TwS[i2 * PT + ql] = f2bf(-yy[r] * bw0); } }
    }
    __syncthreads();
    {
        const int isW = wave >> 2, ct = wave & 3, col = 32 * ct + ql;
        const LAS bf16_t* Ta = (isW ? TwS : TuS) + 8 * hh; const LAS bf16_t* Bs = (isW ? kT : vT) + col * PT + 8 * hh;
        bf16x8 bf[4];
#pragma unroll
        for (int ks = 0; ks < 4; ++ks) bf[ks] = *(const LAS bf16x8*)(Bs + 16 * ks);
        f32x16 xa[2];
#pragma unroll
        for (int jt = 0; jt < 2; ++jt) {
#pragma unroll
            for (int r = 0; r < 16; ++r) xa[jt][r] = 0.f;
#pragma unroll
            for (int ks = 0; ks < 4; ++ks) if (jt == 1 || ks < 2) xa[jt] = MFMA32(*(const LAS bf16x8*)(Ta + (32 * jt + ql) * PT + 16 * ks), bf[ks], xa[jt]); }
        bf16x8 xb[4] = {pack8(xa[0], 0), pack8(xa[0], 1), pack8(xa[1], 0), pack8(xa[1], 1)};
        f32x16 ra[2];
#pragma unroll
        for (int it = 0; it < 2; ++it) {
#pragma unroll
            for (int r = 0; r < 16; ++r) ra[it][r] = 0.f;
#pragma unroll
            for (int kk = 0; kk < 4; ++kk) if (it == 1 || kk < 2) { const LAS bf16_t* ap = AQ + (32 * it + ql) * PT + 16 * kk + 4 * hh;
                const u32x2 lo = *(const LAS u32x2*)ap, hi = *(const LAS u32x2*)(ap + 8); const u32x4 af = {lo.x, lo.y, hi.x, hi.y};
                ra[it] = MFMA32(__builtin_bit_cast(bf16x8, af), xb[kk], ra[it]); } }
        if (!isW) {
#pragma unroll
            for (int jt = 0; jt < 2; ++jt)
#pragma unroll
                for (int bq = 0; bq < 4; ++bq) { const int f = col * 64 + 32 * jt + 8 * bq + 4 * hh;
                    *(u32x2*)(U + slotU(t0, h, 0, f)) = (u32x2){cpk2(xa[jt][4 * bq], xa[jt][4 * bq + 1]), cpk2(xa[jt][4 * bq + 2], xa[jt][4 * bq + 3])};
                    *(u32x2*)(U + slotU(t0, h, 512, f)) = (u32x2){cpk2(ra[jt][4 * bq], ra[jt][4 * bq + 1]), cpk2(ra[jt][4 * bq + 2], ra[jt][4 * bq + 3])}; }
        } else {
            const int pc = permpos(col);
#pragma unroll
            for (int jt = 0; jt < 2; ++jt)
#pragma unroll
                for (int r = 0; r < 16; ++r) { const int tok = 32 * jt + crow(r, hh);
                    P[(t0 + tok) * NIN + C_QDN + h * 128 + pc] = f2bf(-xa[jt][r]);
                    P[(t0 + tok) * NIN + C_KDN + h * 128 + pc] = f2bf(bf2f(qS[tok * PQ + col]) * fexp(gcS[tok]) - ra[jt][r]); }
        }
    }
    __syncthreads();
  }
#undef CP_LOAD
}
constexpr int SC_PW = 136, SC_PK = 72, SC_NW = 0, SC_Q2 = 64 * SC_PW * 2, SC_KD = 2 * 64 * SC_PW * 2, SC_STAGE = 2 * 64 * SC_PW * 2 + 128 * SC_PK * 2, SC_OS = 2 * SC_STAGE,
              SC_US = SC_OS + 64 * SC_PW * 2, SC_OI = SC_US + 128 * SC_PK * 2, SC_END = SC_OI + 128 * SC_PK * 2;
static_assert(SC_END <= BST_OFF, "scan LDS");
__device__ __forceinline__ void gdn_scan_block(const Params& p, LAS unsigned char* lds, int bh, int tid, int wave, int lane) {
    asm volatile("" : "+v"(tid), "+v"(lane));
    bf16_t* P = (bf16_t*)(p.ws + WS_P); const bf16_t* U = (const bf16_t*)(p.ws + WS_U); const float* EGL = (const float*)(p.ws + WS_EGL);
    const int b = bh >> 2, h = bh & 3, ql = lane & 31, hh = lane >> 5;
    const size_t tb = (size_t)b * SEQ;
    LAS bf16_t* oS = (LAS bf16_t*)(lds + SC_OS);
    if (wave >= 4) {
        int lt = tid - 256, ftok = lt >> 2, fseg = lt & 3;
        u32x4 ra[20], rb[20];
#define SC_LOAD(r, n_) do { const size_t t0_ = tb + (size_t)(n_) * 64; _Pragma("unroll") for (int i = 0; i < 4; ++i) { const int c = lt + 256 * i, row = c >> 4, c8 = (c & 15) * 8; \
            const bf16_t* g_ = P + (t0_ + row) * NIN + h * 128 + c8; const bf16_t* u_ = U + (t0_ + row) * D + h * 128 + c8; \
            r[i] = *(const u32x4*)(g_ + C_QDN); r[4 + i] = *(const u32x4*)(g_ + C_KDN); r[8 + i] = *(const u32x4*)(g_ + C_VSB); r[12 + i] = *(const u32x4*)u_; r[16 + i] = *(const u32x4*)(u_ + 512); } } while (0)
#define SC_STORE(r, st_) do { LAS unsigned char* s_ = lds + (st_) * SC_STAGE; _Pragma("unroll") for (int i = 0; i < 4; ++i) { const int c = lt + 256 * i, row = c >> 4, c8 = (c & 15) * 8; \
            *(LAS u32x4*)(s_ + SC_NW + (row * SC_PW + c8) * 2) = r[i]; *(LAS u32x4*)(s_ + SC_Q2 + (row * SC_PW + c8) * 2) = r[4 + i]; \
            *(LAS u32x4*)(s_ + SC_KD + ((2 * row + (c8 >> 6)) * SC_PK + (c8 & 63)) * 2) = r[8 + i]; } } while (0)
#define SC_STOREU(r) do { _Pragma("unroll") for (int i = 0; i < 4; ++i) { const int c = lt + 256 * i, row = c >> 4, c8 = (c & 15) * 8; const int o_ = ((2 * row + (c8 >> 6)) * SC_PK + (c8 & 63)) * 2; \
            *(LAS u32x4*)(lds + SC_US + o_) = r[12 + i]; *(LAS u32x4*)(lds + SC_OI + o_) = r[16 + i]; } } while (0)
#define SC_FIN(m_) do { bf16_t* orow = P + (tb + (size_t)(m_) * 64 + ftok) * NIN + h * 128 + fseg * 32 + C_VDN; \
            _Pragma("unroll") for (int i = 0; i < 4; ++i) *(u32x4*)(orow + 8 * i) = *(const LAS u32x4*)(oS + ftok * SC_PW + fseg * 32 + 8 * i); } while (0)
        SC_LOAD(ra, 0); SC_STORE(ra, 0); SC_STOREU(ra); SC_LOAD(ra, 1);
        __syncthreads();
#pragma unroll 1
        for (int n = 0; n < 32; n += 2) {
            asm volatile("" : "+v"(lt), "+v"(ftok), "+v"(fseg));
            if (n + 2 < 32) SC_LOAD(rb, n + 2);
            SC_STORE(ra, 1);
            if (n > 0) SC_FIN(n - 1);
            __syncthreads();
            SC_STOREU(ra);
            __syncthreads();
            if (n + 3 < 32) SC_LOAD(ra, n + 3);
            if (n + 2 < 32) SC_STORE(rb, 0);
            SC_FIN(n);
            __syncthreads();
            if (n + 2 < 32) SC_STOREU(rb);
            __syncthreads();
        }
        SC_FIN(31);
#undef SC_LOAD
#undef SC_STORE
#undef SC_STOREU
#undef SC_FIN
    } else {
        const int col = 32 * wave + ql;
        f32x16 S[4];
#pragma unroll
        for (int rt = 0; rt < 4; ++rt)
#pragma unroll
            for (int r = 0; r < 16; ++r) S[rt][r] = 0.f;
        const float eglv = EGL[bh * 32 + ql];
        __syncthreads();
#pragma unroll 1
        for (int n = 0; n < 32; ++n) {
            const float egl = __builtin_bit_cast(float, __builtin_amdgcn_readlane(__builtin_bit_cast(int, eglv), n));
            const LAS unsigned char* st = lds + (n & 1) * SC_STAGE;
            f32x16 vn[2], oa[2];
            { const LAS unsigned char* up_ = lds + SC_US + (col * SC_PK + 4 * hh) * 2; const LAS unsigned char* op_ = lds + SC_OI + (col * SC_PK + 4 * hh) * 2;
#pragma unroll
              for (int jt = 0; jt < 2; ++jt)
#pragma unroll
                for (int bq = 0; bq < 4; ++bq) { const u32x2 uw = *(const LAS u32x2*)(up_ + (32 * jt + 8 * bq) * 2), ow = *(const LAS u32x2*)(op_ + (32 * jt + 8 * bq) * 2);
                    vn[jt][4 * bq] = bf_lo(uw.x); vn[jt][4 * bq + 1] = bf_hi(uw.x); vn[jt][4 * bq + 2] = bf_lo(uw.y); vn[jt][4 * bq + 3] = bf_hi(uw.y);
                    oa[jt][4 * bq] = bf_lo(ow.x); oa[jt][4 * bq + 1] = bf_hi(ow.x); oa[jt][4 * bq + 2] = bf_lo(ow.y); oa[jt][4 * bq + 3] = bf_hi(ow.y); } }
            const LAS unsigned char* w0_ = st + (ql * SC_PW + 8 * hh) * 2; const LAS unsigned char* w1_ = w0_ + 32 * SC_PW * 2;
            const LAS unsigned char* kd_ = st + SC_KD + (ql * SC_PK + 8 * hh) * 2;
            bf16x8 fa[4], fb[4];
#define SC_RD4(dst, ptr) do { _Pragma("unroll") for (int i_ = 0; i_ < 4; ++i_) dst[i_] = *(const LAS bf16x8*)((ptr) + 32 * i_); } while (0)
#define SC_MM4(acc, fr, bb) do { _Pragma("unroll") for (int i_ = 0; i_ < 4; ++i_) acc = MFMA32(fr[i_], bb[i_], acc); __builtin_amdgcn_sched_barrier(0); } while (0)
            SC_RD4(fa, w0_ + SC_NW); SC_RD4(fb, w1_ + SC_NW);
            { bf16x8 sb[4] = {pack8(S[0], 0), pack8(S[0], 1), pack8(S[1], 0), pack8(S[1], 1)};
              SC_MM4(vn[0], fa, sb); SC_RD4(fa, w0_ + SC_Q2);
              SC_MM4(vn[1], fb, sb); SC_RD4(fb, w1_ + SC_Q2);
              SC_MM4(oa[0], fa, sb); SC_RD4(fa, w0_ + SC_NW + 128);
              SC_MM4(oa[1], fb, sb); SC_RD4(fb, w1_ + SC_NW + 128); }
            { bf16x8 sb[4] = {pack8(S[2], 0), pack8(S[2], 1), pack8(S[3], 0), pack8(S[3], 1)};
              SC_MM4(vn[0], fa, sb); SC_RD4(fa, w0_ + SC_Q2 + 128);
              SC_MM4(vn[1], fb, sb); SC_RD4(fb, w1_ + SC_Q2 + 128);
              bf16x8 vb[4] = {pack8(vn[0], 0), pack8(vn[0], 1), pack8(vn[1], 0), pack8(vn[1], 1)};
              SC_MM4(oa[0], fa, sb); SC_RD4(fa, kd_);
              SC_MM4(oa[1], fb, sb); SC_RD4(fb, kd_ + 32 * SC_PK * 2);
#pragma unroll
              for (int rt = 0; rt < 4; ++rt)
#pragma unroll
                  for (int r = 0; r < 16; ++r) S[rt][r] *= egl;
              SC_MM4(S[0], fa, vb); SC_RD4(fa, kd_ + 64 * SC_PK * 2);
              SC_MM4(S[1], fb, vb); SC_RD4(fb, kd_ + 96 * SC_PK * 2);
              SC_MM4(S[2], fa, vb);
              SC_MM4(S[3], fb, vb); }
#undef SC_RD4
#undef SC_MM4
            __syncthreads();
#pragma unroll
            for (int jt = 0; jt < 2; ++jt)
#pragma unroll
                for (int r = 0; r < 16; ++r) oS[(32 * jt + crow(r, hh)) * SC_PW + col] = f2bf(oa[jt][r]);
            __syncthreads();
        }
    }
}
__device__ __forceinline__ void gdn_finalize_phase(const Params& p, int wave, int lane) {
    asm volatile("" : "+v"(lane));
    bf16_t* P = (bf16_t*)(p.ws + WS_P);
    const int c0 = (lane & 15) * 8;
    float gg[8];
#pragma unroll
    for (int e = 0; e < 8; ++e) gg[e] = p.in[I_GDNOUT][c0 + e];
    for (int row = blockIdx.x * 8 + wave; row < T; row += gridDim.x * 8) {
        bf16_t* op = P + (size_t)row * NIN + C_VDN + lane * 8; const bf16_t* zp = P + (size_t)row * NIN + C_ZDN + lane * 8;
        const u32x4 ow = *(const u32x4*)op, zw = *(const u32x4*)zp;
        const float o[8] = {bf_lo(ow.x), bf_hi(ow.x), bf_lo(ow.y), bf_hi(ow.y), bf_lo(ow.z), bf_hi(ow.z), bf_lo(ow.w), bf_hi(ow.w)};
        const float z[8] = {bf_lo(zw.x), bf_hi(zw.x), bf_lo(zw.y), bf_hi(zw.y), bf_lo(zw.z), bf_hi(zw.z), bf_lo(zw.w), bf_hi(zw.w)};
        float ss = 0.f;
#pragma unroll
        for (int e = 0; e < 8; ++e) ss += o[e] * o[e];
        ss += __shfl_xor(ss, 1); ss += __shfl_xor(ss, 2); ss += __shfl_xor(ss, 4); ss += __shfl_xor(ss, 8);
        const float rstd = 1.0f / sqrtf(ss * (1.f / 128.f) + EPS);
        float r[8];
#pragma unroll
        for (int e = 0; e < 8; ++e) r[e] = o[e] * rstd * gg[e] * fsilu(z[e]);
        u32x4 w; w.x = pk2(r[0], r[1]); w.y = pk2(r[2], r[3]); w.z = pk2(r[4], r[5]); w.w = pk2(r[6], r[7]);
        *(u32x4*)op = w;
    }
}

#define XB_TMO      128
#define XB_XCNT(j)  (256  + 64 * (j))
#define XB_XSUB(j)  (1280 + 64 * (j))
#define XB_XGEN(j)  (2304 + 64 * (j))
#define XB_TOP      3328
#define XB_TOPGEN   3392
#define XCD_BAR_WORDS 3456
#define XB_SPIN_CAP (1u << 18)
__device__ __forceinline__ unsigned xb_ld(unsigned* p)              { return __hip_atomic_load(p, __ATOMIC_RELAXED, __HIP_MEMORY_SCOPE_AGENT); }
__device__ __forceinline__ unsigned xb_add(unsigned* p, unsigned v) { return __hip_atomic_fetch_add(p, v, __ATOMIC_RELAXED, __HIP_MEMORY_SCOPE_AGENT); }
__device__ __forceinline__ unsigned xb_xcc_id() { return (unsigned)__builtin_amdgcn_s_getreg((3 << 11) | 20) & 0xFu; }
#define XB_SPIN(cond, bar) do { unsigned _sp = 0; while (cond) { __builtin_amdgcn_s_sleep(1); \
    if ((++_sp & 255u) == 0u) { if (xb_ld(&(bar)[XB_TMO])) break; if (_sp > XB_SPIN_CAP) { atomicAdd(&(bar)[XB_TMO], 1u); break; } } } } while (0)
struct XcdBarrier { unsigned* bar; unsigned x; volatile LAS unsigned* st; };
__device__ __forceinline__ XcdBarrier xcd_barrier_post(unsigned* bar, volatile LAS unsigned* st) {
    XcdBarrier b; b.bar = bar; b.x = xb_xcc_id(); b.st = st;
    if (threadIdx.x == 0) (void)xb_add(&bar[XB_XCNT(b.x)], 1u);
    return b;
}
__device__ __forceinline__ void xcd_barrier_complete(unsigned* bar, unsigned x, unsigned& nloc, unsigned& nx) {
    const unsigned G = gridDim.x * gridDim.y * gridDim.z;
    unsigned sum, cnt, mine, sp = 0u;
    for (;;) {
        sum = 0u; cnt = 0u; mine = 0u;
#pragma unroll
        for (unsigned j = 0; j < 16; ++j) { const unsigned c = xb_ld(&bar[XB_XCNT(j)]); sum += c; cnt += (c > 0u) ? 1u : 0u; mine = (j == x) ? c : mine; }
        if (sum == G) break;
        __builtin_amdgcn_s_sleep(1);
        if ((++sp & 255u) == 0u) { if (xb_ld(&bar[XB_TMO])) break; if (sp > XB_SPIN_CAP) { atomicAdd(&bar[XB_TMO], 1u); break; } }
    }
    nloc = mine > 0u ? mine : 1u; nx = cnt > 0u ? cnt : 1u;
}
__device__ __forceinline__ void xcd_barrier(const XcdBarrier& b) {
    asm volatile("s_waitcnt vmcnt(0)" ::: "memory");
    __syncthreads();
    if (threadIdx.x == 0) {
        unsigned* bar = b.bar;
        __builtin_amdgcn_s_waitcnt(0);
        unsigned nloc = b.st[0], nx = b.st[1];
        if (nloc == 0u) { xcd_barrier_complete(bar, b.x, nloc, nx); b.st[0] = nloc; b.st[1] = nx; }
        const unsigned old = xb_add(&bar[XB_XSUB(b.x)], 1u);
        const unsigned gen = old / nloc;
        if (old + 1u == (gen + 1u) * nloc) {
            __builtin_amdgcn_fence(__ATOMIC_RELEASE, "agent");
            asm volatile("s_waitcnt vmcnt(0)" ::: "memory");
            const unsigned og = xb_add(&bar[XB_TOP], 1u);
            const unsigned tg = og / nx;
            if (og + 1u == (tg + 1u) * nx) xb_add(&bar[XB_TOPGEN], 1u);
            else XB_SPIN(xb_ld(&bar[XB_TOPGEN]) == tg, bar);
            __builtin_amdgcn_fence(__ATOMIC_ACQUIRE, "agent");
            xb_add(&bar[XB_XGEN(b.x)], 1u);
            asm volatile("s_waitcnt vmcnt(0)" ::: "memory");
        } else {
            XB_SPIN(xb_ld(&bar[XB_XGEN(b.x)]) == gen, bar);
            __builtin_amdgcn_fence(__ATOMIC_ACQUIRE, "agent");
            asm volatile("s_waitcnt vmcnt(0)" ::: "memory");
        }
    }
    __syncthreads();
}

#ifndef PHMASK
#define PHMASK 0xFFFF
#endif
#define PH(n) ((PHMASK >> (n)) & 1)
#ifndef PROBE
#define PROBE 0
#endif
#define REP(g) for (int _rep = 0; _rep < ((PROBE == (g)) ? 2 : 1); ++_rep)
__global__ void __launch_bounds__(512, 2) fwd_megakernel(Params p) {
    extern __shared__ __attribute__((aligned(16))) unsigned char lds_raw[];
    LAS unsigned char* lds = (LAS unsigned char*)lds_raw;
    cg::grid_group grid = cg::this_grid();
    const int tid = threadIdx.x, lane = tid & 63, wave = __builtin_amdgcn_readfirstlane(tid >> 6);
    const int G = gridDim.x, gw = wave * G + blockIdx.x, ngw = G * 8;
    unsigned char* ws = p.ws;
    bf16_t* U = (bf16_t*)(ws + WS_U); bf16_t* P = (bf16_t*)(ws + WS_P);
    const float* mod = (const float*)(ws + WS_MOD);
    LAS float* scr = (LAS float*)(lds + wave * 16384);

    unsigned* barw = (unsigned*)(ws + WS_BAR);
    volatile LAS unsigned* bst = (volatile LAS unsigned*)(lds + BST_OFF);
    if (tid < 2) bst[tid] = 0u;
    __syncthreads();
    if (p.ws == nullptr) grid.sync();
    const XcdBarrier xbar = xcd_barrier_post(barw, bst);
    REP(1) { if (PH(0)) for (int it = blockIdx.x; it < NMOD / 64; it += G) mod_item(p, lds, it, tid, wave, lane);
    if (PH(0)) ffn_weight_items(p.in[I_WFFN1IN], p.in[I_WFFN1OUT], (bf16_t*)(ws + W_FFIN), (bf16_t*)(ws + W_FFOUT), scr, gw, ngw, lane);
    __syncthreads(); }
    xcd_barrier(xbar);
    if (PROBE == 3) for (int i = 0; i < 16; ++i) xcd_barrier(xbar);
    REP(1) if (PH(1)) norm_mod_phase<false>(p, lds, p.in[I_X], p.in[I_GFFN1], 0, U, tid, wave, lane);
    xcd_barrier(xbar);
    REP(2) if (PH(2)) run_gemm(lds, U, D, (const bf16_t*)(ws + W_FFIN), 2 * FF, D, EpiSwiGLU{P, FF});
    { const int nfull = (64 * 22) % G, nidle = nfull ? G - nfull : G;
      const int ib = nfull ? (int)blockIdx.x - nfull : (int)blockIdx.x;
      if (PH(0) && ib >= 0) mixer_weight_items(p, scr, wave * nidle + ib, nidle * 8, lane); }
    xcd_barrier(xbar);
    REP(2) if (PH(3)) run_gemm(lds, P, FF, (const bf16_t*)(ws + W_FFOUT), D, FF, EpiResid{p.in[I_X], p.out, mod + 2 * D, 0.5f});
    xcd_barrier(xbar);
    REP(1) if (PH(4)) norm_mod_phase<true>(p, lds, p.out, p.in[I_GMIX], 3, U, tid, wave, lane);
    xcd_barrier(xbar);
    REP(2) if (PH(5)) run_gemm(lds, U, D, (const bf16_t*)(ws + W_IN), NIN, D, EpiBf16{P, NIN});
    xcd_barrier(xbar);
    if (PH(6)) prep_phase(p, wave, lane);
    xcd_barrier(xbar);
    if (PH(7)) gdn_chunk_prep_phase(p, lds, tid, wave, lane);
    xcd_barrier(xbar);
    if (PH(15)) for (int it = blockIdx.x; it < 32; it += G) gdn_scan_block(p, lds, it, tid, wave, lane);
    if (PH(8)) {
        const unsigned x0 = xb_xcc_id() & 7u;
        for (unsigned dx = 0; dx < 8u; ++dx) { const unsigned x = (x0 + dx) & 7u; unsigned* ctr = (unsigned*)(ws + WS_CTR) + 64 * x;
            for (;;) { unsigned idx = 0; if (lane == 0) idx = atomicAdd(ctr, 1u); idx = __builtin_amdgcn_readfirstlane(idx);
                if (idx >= 512u) break;
                attn_item_mfma(P, (const bf16_t*)(ws + WS_VT), (int)(8u * x + (idx & 7u)), 63 - (int)(idx >> 3), lane); } } }
    xcd_barrier(xbar);
    if (PH(9)) gdn_finalize_phase(p, wave, lane);
    xcd_barrier(xbar);
    if (PH(10)) run_gemm(lds, P + C_QSB, NIN, (const bf16_t*)(ws + W_UPSB), D, 1024, EpiGateFused{P + C_RSB, P + C_RDN, U}, 8, (C_VDN - C_QSB) * 2 - 8 * 128);
    xcd_barrier(xbar);
    if (PH(11)) run_gemm(lds, U, D, (const bf16_t*)(ws + W_OUT), D, D, EpiResid{p.out, p.out, mod + 5 * D, 1.0f});
    xcd_barrier(xbar);
    REP(1) if (PH(12)) norm_mod_phase<false>(p, lds, p.out, p.in[I_GFFN2], 6, U, tid, wave, lane);
    __syncthreads();
    if (PH(12)) ffn_weight_items(p.in[I_WFFN2IN], p.in[I_WFFN2OUT], (bf16_t*)(ws + W_FFIN), (bf16_t*)(ws + W_FFOUT), scr, gw, ngw, lane);
    xcd_barrier(xbar);
    REP(2) if (PH(13)) run_gemm(lds, U, D, (const bf16_t*)(ws + W_FFIN), 2 * FF, D, EpiSwiGLU{P, FF});
    xcd_barrier(xbar);
    if (PH(14)) run_gemm(lds, P, FF, (const bf16_t*)(ws + W_FFOUT), D, FF, EpiResid{p.out, p.out, mod + 8 * D, 0.5f});
}

extern "C" void kernel_launch(void* const* d_in, const int* in_sizes, int n_in, void* d_out, int out_size, void* d_ws, size_t ws_size, hipStream_t stream) {
    static int grid_blocks = 0;
    if (!grid_blocks) {
        int dev = 0, cus = 0, per_cu = 0;
        (void)hipGetDevice(&dev);
        (void)hipDeviceGetAttribute(&cus, hipDeviceAttributeMultiprocessorCount, dev);
        (void)hipFuncSetAttribute((const void*)fwd_megakernel, hipFuncAttributeMaxDynamicSharedMemorySize, LDS_BYTES);
        (void)hipOccupancyMaxActiveBlocksPerMultiprocessor(&per_cu, (const void*)fwd_megakernel, 512, LDS_BYTES);
        if (per_cu < 1) { fprintf(stderr, "occupancy query says %d blocks/CU\n", per_cu); per_cu = 1; }
        grid_blocks = cus;
    }
    Params p{};
    for (int i = 0; i < N_IN; ++i) p.in[i] = (const float*)d_in[i];
    p.out = (float*)d_out; p.ws = (unsigned char*)d_ws;
    (void)hipMemsetAsync((char*)d_ws + WS_CTR, 0, (WS_BAR - WS_CTR) + XCD_BAR_WORDS * 4, stream);
    void* args[] = {&p};
    hipError_t e = hipLaunchCooperativeKernel((const void*)fwd_megakernel, dim3(grid_blocks), dim3(512), args, LDS_BYTES, stream);
    if (e != hipSuccess) fprintf(stderr, "cooperative launch failed: %s (grid %d)\n", hipGetErrorString(e), grid_blocks);
}
```

```cpp
#include <hip/hip_runtime.h>
#include <hip/hip_cooperative_groups.h>
#include <cstdio>
namespace cg = cooperative_groups;

#define LAS __attribute__((address_space(3)))
typedef unsigned short bf16_t;
typedef short bf16x8 __attribute__((ext_vector_type(8)));
typedef float f32x4 __attribute__((ext_vector_type(4)));
typedef unsigned u32x4 __attribute__((ext_vector_type(4)));
typedef unsigned u32x2 __attribute__((ext_vector_type(2)));
typedef float f32x16 __attribute__((ext_vector_type(16)));
typedef float f32x2 __attribute__((ext_vector_type(2)));
typedef __bf16 nbf16x2 __attribute__((ext_vector_type(2)));

constexpr int T = 16384, D = 1024, SEQ = 2048, NB = 8, FF = 2816, NIN = 5632, INW = 5640, NMOD = 9216;
constexpr int C_QSB = 0, C_KSB = 512, C_VSB = 1024, C_QDN = 1536, C_KDN = 2048, C_VDN = 2560, C_ZDN = 3072, C_RSB = 3584, C_RDN = 4608;
constexpr float EPS = 1e-6f;
constexpr int LDS_BYTES = 163840, BST_OFF = LDS_BYTES - 64;
constexpr size_t MiB = 1024 * 1024;
constexpr size_t WS_MOD = 0, WS_BG = 512 * 1024, WS_SS = 242 * MiB, WS_W = 2 * MiB;
constexpr size_t W_FFIN = WS_W, W_FFOUT = W_FFIN + (size_t)2 * FF * D * 2, W_IN = W_FFOUT + (size_t)D * FF * 2, W_UPSB = W_IN + (size_t)NIN * D * 2,
                 W_UPDN = W_UPSB + (size_t)D * 512 * 2, W_OUT = W_UPDN + (size_t)D * 512 * 2, W_END = W_OUT + (size_t)D * D * 2;
constexpr size_t WS_U = 34 * MiB, WS_P = 66 * MiB;
static_assert(W_END <= WS_U, "weights overflow");
constexpr size_t WS_EGL = 384 * 1024, WS_CTR = 400 * 1024, WS_BAR = 416 * 1024;
constexpr size_t WS_VT = W_FFIN;
static_assert((size_t)T * 512 * 2 <= W_IN - W_FFIN, "Vt overflow");

enum { I_X = 0, I_C, I_WADA, I_BADA, I_GFFN1, I_WFFN1IN, I_WFFN1OUT, I_GMIX, I_WIN, I_GQSB, I_GKSB, I_WCONV, I_ALOG, I_DTBIAS, I_GDNOUT, I_WUPSB, I_WUPDN, I_WOUT, I_GFFN2, I_WFFN2IN, I_WFFN2OUT, N_IN };
struct Params { const float* in[N_IN]; float* out; unsigned char* ws; };

__device__ __forceinline__ float bf_lo(unsigned w) { return __uint_as_float(w << 16); }
__device__ __forceinline__ float bf_hi(unsigned w) { return __uint_as_float(w & 0xffff0000u); }
__device__ __forceinline__ float bf2f(bf16_t b) { return __uint_as_float(((unsigned)b) << 16); }
__device__ __forceinline__ unsigned pk2(float lo, float hi) { unsigned r; asm("v_cvt_pk_bf16_f32 %0, %1, %2" : "=v"(r) : "v"(lo), "v"(hi)); return r; }
__device__ __forceinline__ unsigned cpk2(float lo, float hi) { const f32x2 v = {lo, hi}; return __builtin_bit_cast(unsigned, __builtin_convertvector(v, nbf16x2)); }
__device__ __forceinline__ bf16_t f2bf(float f) { return (bf16_t)(pk2(f, 0.f) & 0xffffu); }
__device__ __forceinline__ float fexp(float x) { return __builtin_amdgcn_exp2f(x * 1.4426950408889634f); }
__device__ __forceinline__ float flog(float x) { return __builtin_amdgcn_logf(x) * 0.6931471805599453f; }
__device__ __forceinline__ float fsigmoid(float x) { return __builtin_amdgcn_rcpf(1.f + fexp(-x)); }
__device__ __forceinline__ float fsilu(float x) { return x * fsigmoid(x); }
__device__ __forceinline__ float fsoftplus(float x) { return fmaxf(x, 0.f) + flog(1.f + fexp(-fabsf(x))); }
__device__ __forceinline__ float wave_sum(float v) {
#pragma unroll
    for (int o = 1; o < 64; o <<= 1) v += __shfl_xor(v, o);
    return v;
}
#define LDS_WAIT() asm volatile("s_waitcnt lgkmcnt(0)" ::: "memory")

namespace pg8 {
constexpr int BM = 256, BK = 64, HALF = 128, HTB = HALF * BK * 2, STAGE_BYTES = 8 * HTB, NXCD = 8, WGM = 8;
__host__ __device__ __forceinline__ int lds_byte(int r, int c) { const int st = (r >> 4) * 2 + (c >> 5), rr = r & 15, cc = c & 31, ob = rr * 64 + cc * 2; return st * 1024 + (ob ^ (((ob >> 9) & 1) << 5)); }
__host__ __device__ __forceinline__ void stage_rc(int b, int& R, int& C) { const int st = b / 1024, sb = b % 1024, swz = sb ^ (((sb >> 9) & 1) << 5); R = (st >> 1) * 16 + swz / 64; C = (st & 1) * 32 + (swz % 64) / 2; }
__host__ __device__ __forceinline__ int perm32(int rho) { const int n = rho >> 4, i = rho & 15; return 8 * (i >> 2) + 4 * n + (i & 3); }
struct Unit { int pm, pn; };
struct Gemm { const bf16_t* A; const bf16_t* Bt; int M, N, K, lda; int jt; int jbytes; };
struct StaticOrder {
    int nM, nN, nwg, G, c;
    __host__ __device__ void init(int M, int N, int G_, int c_) { nM = M / BM; nN = N / BM; nwg = nM * nN; G = G_; c = c_; }
    __host__ __device__ bool next(int i, Unit& u) const {
        const long L = (long)i * G + c; if (L >= nwg) return false;
        int wgid = (int)L; { const int q = nwg / NXCD, r = nwg % NXCD, xcd = wgid % NXCD, off = wgid / NXCD; wgid = (xcd < r ? xcd * (q + 1) : r * (q + 1) + (xcd - r) * q) + off; }
        const int nig = WGM * nN, gid = wgid / nig, fm = gid * WGM, gsz = (nM - fm) < WGM ? (nM - fm) : WGM;
        u.pm = fm + ((wgid % nig) % gsz); u.pn = (wgid % nig) / gsz; return true;
    }
};
template <class Epi>
__device__ __forceinline__ void gemm_phase(LAS unsigned char* lds, const Gemm g, const StaticOrder& S, const Epi& E) {
    int tid = threadIdx.x; asm volatile("" : "+v"(tid));
    const int wid = __builtin_amdgcn_readfirstlane(tid >> 6), lane = tid & 63, wr = wid >> 2, wc = wid & 3, fr = lane & 15, fq = lane >> 4;
    const int K = g.K, nt = K / BK, lda = g.lda;
    unsigned voffA[2], voffB[2];
#pragma unroll
    for (int i = 0; i < 2; ++i) { int R, C; stage_rc(tid * 16 + i * 8192, R, C); const int Rb = Epi::PERM ? ((R & ~31) + perm32(R & 31)) : R;
        voffA[i] = (unsigned)(R * lda + C) * 2u; voffB[i] = (unsigned)(Rb * K + C) * 2u; }
    const size_t kstep = (size_t)(BK * 2);
    const size_t hstepA = (size_t)HALF * lda * 2, hstepB = (size_t)HALF * K * 2;
    const size_t tstepA = 2 * hstepA, tstepB = 2 * hstepB;
    const unsigned ldsw = (unsigned)wid * 1024u;
    const int aoff = lds_byte(wr * 64 + fr, fq * 8), boff = lds_byte(wc * 32 + fr, fq * 8);
#define PG8_SA(b, h) (((b) * 2 + (h)) * HTB)
#define PG8_SB(b, h) ((4 + (b) * 2 + (h)) * HTB)
#define PG8_STAGE(bufoff, gbase, voff) do { _Pragma("unroll") for (int _i = 0; _i < 2; ++_i) \
        __builtin_amdgcn_global_load_lds((const unsigned*)((const char*)(gbase) + (voff)[_i]), (LAS unsigned*)(lds + (bufoff) + ldsw + _i * 8192), 16, 0, 0); } while (0)
#define PG8_LDA(dst, b, h) do { _Pragma("unroll") for (int m = 0; m < 4; ++m) _Pragma("unroll") for (int k = 0; k < 2; ++k) dst[m][k] = *(const LAS bf16x8*)(lds + PG8_SA(b, h) + aoff + m * 2048 + k * 1024); } while (0)
#define PG8_LDB(dst, b, h) do { _Pragma("unroll") for (int n = 0; n < 2; ++n) _Pragma("unroll") for (int k = 0; k < 2; ++k) dst[n][k] = *(const LAS bf16x8*)(lds + PG8_SB(b, h) + boff + n * 2048 + k * 1024); } while (0)
#define PG8_MMA(ai, bj, At, Bt) do { __builtin_amdgcn_s_setprio(1); _Pragma("unroll") for (int m = 0; m < 4; ++m) _Pragma("unroll") for (int n = 0; n < 2; ++n) _Pragma("unroll") for (int k = 0; k < 2; ++k) \
        acc[ai][bj][m][n] = __builtin_amdgcn_mfma_f32_16x16x32_bf16(Bt[n][k], At[m][k], acc[ai][bj][m][n], 0, 0, 0); __builtin_amdgcn_s_setprio(0); } while (0)
#define PG8_WAIT_V(n) asm volatile("s_waitcnt vmcnt(" #n ")" ::: "memory")
#define PG8_WAIT_L(n) asm volatile("s_waitcnt lgkmcnt(" #n ")" ::: "memory")
#define PG8_BAR __builtin_amdgcn_s_barrier()
#define PG8_SCHED __builtin_amdgcn_sched_barrier(0)
    Unit cur, nxt; int ui = 0;
    if (!S.next(0, cur)) return;
    f32x4 acc[2][2][4][2];
#pragma unroll
    for (int a = 0; a < 2; ++a)
#pragma unroll
        for (int b = 0; b < 2; ++b)
#pragma unroll
            for (int m = 0; m < 4; ++m)
#pragma unroll
                for (int n = 0; n < 2; ++n) acc[a][b][m][n] = (f32x4){0.f, 0.f, 0.f, 0.f};
    bf16x8 At[4][2], B0[2][2], B1[2][2];
    const char* cA = (const char*)g.A + (size_t)cur.pm * tstepA; const char* cB = (const char*)g.Bt + (size_t)cur.pn * tstepB;
    PG8_STAGE(PG8_SB(0, 0), cB, voffB); PG8_STAGE(PG8_SA(0, 0), cA, voffA); PG8_STAGE(PG8_SB(0, 1), cB + hstepB, voffB); PG8_STAGE(PG8_SA(0, 1), cA + hstepA, voffA);
    if (wr == 1) PG8_BAR;
    PG8_WAIT_V(4); PG8_BAR;
    PG8_STAGE(PG8_SB(1, 0), cB + kstep, voffB); PG8_STAGE(PG8_SA(1, 0), cA + kstep, voffA); PG8_STAGE(PG8_SB(1, 1), cB + hstepB + kstep, voffB);
    PG8_WAIT_V(6); PG8_BAR;
    for (;;) {
        const bool has_next = S.next(ui + 1, nxt);
        const char* nA = has_next ? (const char*)g.A + (size_t)nxt.pm * tstepA : cA; const char* nB = has_next ? (const char*)g.Bt + (size_t)nxt.pn * tstepB : cB;
        for (int t = 0; t < nt; t += 2) {
            const bool last = (t == nt - 2);
            const char* a1 = cA + (size_t)(t + 1) * kstep + (t + 1 >= g.jt ? g.jbytes : 0);
            const char* a2 = last ? nA : cA + (size_t)(t + 2) * kstep + (t + 2 >= g.jt ? g.jbytes : 0); const char* b2 = last ? nB : cB + (size_t)(t + 2) * kstep;
            const char* a3 = a2 + kstep; const char* b3 = b2 + kstep;
            if constexpr (Epi::HAS_MID) { if (t == g.jt) E.mid(acc, cur, wr, wc, fr, fq); }
            PG8_LDB(B0, 0, 0); PG8_SCHED; PG8_LDA(At, 0, 0); PG8_STAGE(PG8_SA(1, 1), a1 + hstepA, voffA);
            PG8_WAIT_L(8); PG8_BAR; PG8_WAIT_L(0); PG8_MMA(0, 0, At, B0); PG8_BAR; PG8_SCHED;
            PG8_LDB(B1, 0, 1); PG8_STAGE(PG8_SB(0, 0), b2, voffB);
            PG8_BAR; PG8_WAIT_L(0); PG8_MMA(0, 1, At, B1); PG8_BAR;
            PG8_LDA(At, 0, 1); PG8_STAGE(PG8_SA(0, 0), a2, voffA);
            PG8_BAR; PG8_WAIT_L(0); PG8_MMA(1, 0, At, B0); PG8_BAR; PG8_SCHED;
            PG8_STAGE(PG8_SB(0, 1), b2 + hstepB, voffB);
            PG8_WAIT_V(6); PG8_BAR; PG8_MMA(1, 1, At, B1); PG8_BAR;
            PG8_LDB(B0, 1, 0); PG8_SCHED; PG8_LDA(At, 1, 0); PG8_STAGE(PG8_SA(0, 1), a2 + hstepA, voffA);
            PG8_WAIT_L(8); PG8_BAR; PG8_WAIT_L(0); PG8_MMA(0, 0, At, B0); PG8_BAR; PG8_SCHED;
            PG8_LDB(B1, 1, 1); PG8_STAGE(PG8_SB(1, 0), b3, voffB);
            PG8_BAR; PG8_WAIT_L(0); PG8_MMA(0, 1, At, B1); PG8_BAR;
            PG8_LDA(At, 1, 1); PG8_STAGE(PG8_SA(1, 0), a3, voffA);
            PG8_BAR; PG8_WAIT_L(0); PG8_MMA(1, 0, At, B0); PG8_BAR; PG8_SCHED;
            PG8_STAGE(PG8_SB(1, 1), b3 + hstepB, voffB);
            PG8_WAIT_V(6); PG8_BAR; PG8_MMA(1, 1, At, B1); PG8_BAR;
        }
        E(acc, cur, wr, wc, fr, fq);
        if (!has_next) break;
#pragma unroll
        for (int a = 0; a < 2; ++a)
#pragma unroll
            for (int b = 0; b < 2; ++b)
#pragma unroll
                for (int m = 0; m < 4; ++m)
#pragma unroll
                    for (int n = 0; n < 2; ++n) acc[a][b][m][n] = (f32x4){0.f, 0.f, 0.f, 0.f};
        cur = nxt; cA = nA; cB = nB; ++ui;
    }
    PG8_WAIT_V(0);
    if (wr == 0) PG8_BAR;
    PG8_BAR;
#undef PG8_SA
#undef PG8_SB
#undef PG8_STAGE
#undef PG8_LDA
#undef PG8_LDB
#undef PG8_MMA
#undef PG8_WAIT_V
#undef PG8_WAIT_L
#undef PG8_BAR
#undef PG8_SCHED
}
}

typedef const f32x4 (&AccRef)[2][2][4][2];
struct EpiBf16 {
    static constexpr bool PERM = true, HAS_MID = false;
    bf16_t* O; int ldc;
    __device__ __forceinline__ void operator()(AccRef acc, const pg8::Unit& u, int wr, int wc, int fr, int fq) const {
        const int row0 = u.pm * 256 + wr * 64 + fr, col0 = u.pn * 256 + wc * 32 + 8 * fq;
#pragma unroll
        for (int ai = 0; ai < 2; ++ai)
#pragma unroll
            for (int m = 0; m < 4; ++m) { bf16_t* rowp = O + (size_t)(row0 + ai * 128 + m * 16) * ldc + col0;
#pragma unroll
                for (int bj = 0; bj < 2; ++bj) { const f32x4 v0 = acc[ai][bj][m][0], v1 = acc[ai][bj][m][1];
                    u32x4 w; w.x = pk2(v0[0], v0[1]); w.y = pk2(v0[2], v0[3]); w.z = pk2(v1[0], v1[1]); w.w = pk2(v1[2], v1[3]);
                    *(u32x4*)(rowp + bj * 128) = w; } }
    }
};
struct EpiSwiGLU {
    static constexpr bool PERM = true, HAS_MID = false;
    bf16_t* O; int ldc;
    __device__ __forceinline__ void operator()(AccRef acc, const pg8::Unit& u, int wr, int wc, int fr, int fq) const {
        const int row0 = u.pm * 256 + wr * 64 + fr, col0 = u.pn * 128 + wc * 32 + 8 * fq;
#pragma unroll
        for (int ai = 0; ai < 2; ++ai)
#pragma unroll
            for (int m = 0; m < 4; ++m) { bf16_t* rowp = O + (size_t)(row0 + ai * 128 + m * 16) * ldc + col0;
                float r[8];
#pragma unroll
                for (int n = 0; n < 2; ++n)
#pragma unroll
                    for (int j = 0; j < 4; ++j) { const float a = acc[ai][0][m][n][j], b = acc[ai][1][m][n][j]; r[n * 4 + j] = fsilu(a) * b; }
                u32x4 w; w.x = pk2(r[0], r[1]); w.y = pk2(r[2], r[3]); w.z = pk2(r[4], r[5]); w.w = pk2(r[6], r[7]);
                *(u32x4*)rowp = w; }
    }
};
struct EpiResid {
    static constexpr bool PERM = false, HAS_MID = false;
    const float* base; float* out; const float* gate; float scale;
    __device__ __forceinline__ void operator()(AccRef acc, const pg8::Unit& u, int wr, int wc, int fr, int fq) const {
        const int row0 = u.pm * 256 + wr * 64 + fr, col0 = u.pn * 256 + wc * 32 + 4 * fq;
        const float* gp = gate + (size_t)(u.pm >> 3) * NMOD + col0;
        f32x4 gv[2][2];
#pragma unroll
        for (int bj = 0; bj < 2; ++bj)
#pragma unroll
            for (int n = 0; n < 2; ++n) gv[bj][n] = *(const f32x4*)(gp + bj * 128 + n * 16) * scale;
#pragma unroll
        for (int ai = 0; ai < 2; ++ai) {
            f32x4 bs[4][2][2];
#pragma unroll
            for (int m = 0; m < 4; ++m) { const size_t off = (size_t)(row0 + ai * 128 + m * 16) * D + col0;
#pragma unroll
                for (int bj = 0; bj < 2; ++bj)
#pragma unroll
                    for (int n = 0; n < 2; ++n) bs[m][bj][n] = *(const f32x4*)(base + off + bj * 128 + n * 16); }
#pragma unroll
            for (int m = 0; m < 4; ++m) { const size_t off = (size_t)(row0 + ai * 128 + m * 16) * D + col0;
#pragma unroll
                for (int bj = 0; bj < 2; ++bj)
#pragma unroll
                    for (int n = 0; n < 2; ++n) *(f32x4*)(out + off + bj * 128 + n * 16) = bs[m][bj][n] + gv[bj][n] * acc[ai][bj][m][n]; }
            asm volatile("" ::: "memory"); }
    }
};
struct EpiGateFused {
    static constexpr bool PERM = true, HAS_MID = true;
    const bf16_t* Rsb; const bf16_t* Rdn; bf16_t* O;
    __device__ __forceinline__ void mid(f32x4 (&acc)[2][2][4][2], const pg8::Unit& u, int wr, int wc, int fr, int fq) const {
        int row0 = u.pm * 256 + wr * 64 + fr, col0 = u.pn * 256 + wc * 32 + 8 * fq;
        asm volatile("" : "+v"(row0), "+v"(col0));
#pragma unroll
        for (int ai = 0; ai < 2; ++ai)
#pragma unroll
            for (int mp = 0; mp < 2; ++mp) {
                u32x4 av[2][2], dv[2][2];
#pragma unroll
                for (int mm = 0; mm < 2; ++mm)
#pragma unroll
                    for (int bj = 0; bj < 2; ++bj) { const size_t row = (size_t)(row0 + ai * 128 + (2 * mp + mm) * 16);
                        av[mm][bj] = *(const u32x4*)(Rsb + row * NIN + col0 + bj * 128); dv[mm][bj] = *(const u32x4*)(Rdn + row * NIN + col0 + bj * 128); }
#pragma unroll
                for (int mm = 0; mm < 2; ++mm)
#pragma unroll
                    for (int bj = 0; bj < 2; ++bj) { const int m = 2 * mp + mm; const u32x4 a = av[mm][bj], d = dv[mm][bj];
                        const float ra[8] = {bf_lo(a.x), bf_hi(a.x), bf_lo(a.y), bf_hi(a.y), bf_lo(a.z), bf_hi(a.z), bf_lo(a.w), bf_hi(a.w)};
                        const float rd[8] = {bf_lo(d.x), bf_hi(d.x), bf_lo(d.y), bf_hi(d.y), bf_lo(d.z), bf_hi(d.z), bf_lo(d.w), bf_hi(d.w)};
#pragma unroll
                        for (int e = 0; e < 8; ++e) { const float q = (1.0f + fexp(fminf(-rd[e], 30.0f))) * __builtin_amdgcn_rcpf(1.0f + fexp(-ra[e])); acc[ai][bj][m][e >> 2][e & 3] *= q; } }
                asm volatile("" ::: "memory"); }
    }
    __device__ __forceinline__ void operator()(AccRef acc, const pg8::Unit& u, int wr, int wc, int fr, int fq) const {
        const int row0 = u.pm * 256 + wr * 64 + fr, col0 = u.pn * 256 + wc * 32 + 8 * fq;
#pragma unroll
        for (int ai = 0; ai < 2; ++ai) {
            u32x4 dv[4][2];
#pragma unroll
            for (int m = 0; m < 4; ++m)
#pragma unroll
                for (int bj = 0; bj < 2; ++bj) dv[m][bj] = *(const u32x4*)(Rdn + (size_t)(row0 + ai * 128 + m * 16) * NIN + col0 + bj * 128);
#pragma unroll
            for (int m = 0; m < 4; ++m) { const size_t row = (size_t)(row0 + ai * 128 + m * 16);
#pragma unroll
                for (int bj = 0; bj < 2; ++bj) { const u32x4 d = dv[m][bj];
                    const f32x4 v0 = acc[ai][bj][m][0], v1 = acc[ai][bj][m][1];
#define SGC(x) __builtin_amdgcn_rcpf(1.0f + fexp(fminf(-(x), 30.0f)))
                    const float r[8] = {SGC(bf_lo(d.x)) * v0[0], SGC(bf_hi(d.x)) * v0[1], SGC(bf_lo(d.y)) * v0[2], SGC(bf_hi(d.y)) * v0[3],
                                        SGC(bf_lo(d.z)) * v1[0], SGC(bf_hi(d.z)) * v1[1], SGC(bf_lo(d.w)) * v1[2], SGC(bf_hi(d.w)) * v1[3]};
#undef SGC
                    u32x4 w; w.x = pk2(r[0], r[1]); w.y = pk2(r[2], r[3]); w.z = pk2(r[4], r[5]); w.w = pk2(r[6], r[7]);
                    *(u32x4*)(O + row * D + col0 + bj * 128) = w; } } }
    }
};
template <class Epi> __device__ __forceinline__ void run_gemm(LAS unsigned char* lds, const bf16_t* A, int lda, const bf16_t* Bt, int N, int K, const Epi& E, int jt = 1 << 30, int jbytes = 0) {
    pg8::Gemm g{A, Bt, T, N, K, lda, jt, jbytes}; pg8::StaticOrder S; S.init(T, N, (int)gridDim.x, (int)blockIdx.x);
    pg8::gemm_phase<Epi>(lds, g, S, E);
}

__device__ __forceinline__ void transpose_item(const float* W, int ldw, int s0, int k0, bf16_t* WT, int ldk, int d0, LAS float* scr, int lane) {
    float tv[32];
#pragma unroll
    for (int i = 0; i < 32; ++i) tv[i] = W[(size_t)(k0 + 2 * i + (lane >> 5)) * ldw + s0 + (lane & 31)];
#pragma unroll
    for (int i = 0; i < 32; ++i) scr[(2 * i + (lane >> 5)) * 33 + (lane & 31)] = tv[i];
    LDS_WAIT();
    const int c = lane & 7;
#pragma unroll
    for (int j = 0; j < 4; ++j) { const int n = (lane >> 3) + 8 * j; const LAS float* s = scr + (8 * c) * 33 + n;
        u32x4 o; o.x = pk2(s[0 * 33], s[1 * 33]); o.y = pk2(s[2 * 33], s[3 * 33]); o.z = pk2(s[4 * 33], s[5 * 33]); o.w = pk2(s[6 * 33], s[7 * 33]);
        *(u32x4*)(WT + (size_t)(d0 + n) * ldk + k0 + 8 * c) = o; }
    LDS_WAIT();
}
struct TrD { const float* W; int ldw, s0, k0; bf16_t* WT; int ldk, d0; };
__device__ __forceinline__ TrD ffn_item_desc(const float* w_in, const float* w_out, bf16_t* wt_in, bf16_t* wt_out, int it) {
    if (it < 2816) { const int kb = it / 176, nb = it % 176, d0 = nb * 32, pn = d0 >> 8, bj = (d0 >> 7) & 1, c = d0 & 127, s0 = bj * FF + pn * 128 + c; return TrD{w_in, 2 * FF, s0, kb * 64, wt_in, D, d0}; }
    const int r = it - 2816, kb = r / 32, nb = r % 32; return TrD{w_out, D, nb * 32, kb * 64, wt_out, FF, nb * 32};
}
__device__ __forceinline__ void ffn_weight_items(const float* w_in, const float* w_out, bf16_t* wt_in, bf16_t* wt_out, LAS float* scr, int gw, int ngw, int lane) {
    constexpr int NIT = 2816 + 1408;
    float tv[32];
#define TR_LOAD(d_) do { _Pragma("unroll") for (int i = 0; i < 32; ++i) tv[i] = (d_).W[(size_t)((d_).k0 + 2 * i + (lane >> 5)) * (d_).ldw + (d_).s0 + (lane & 31)]; } while (0)
    if (gw < NIT) { const TrD d0_ = ffn_item_desc(w_in, w_out, wt_in, wt_out, gw); TR_LOAD(d0_); }
    for (int it = gw; it < NIT; it += ngw) {
        const TrD d = ffn_item_desc(w_in, w_out, wt_in, wt_out, it);
#pragma unroll
        for (int i = 0; i < 32; ++i) scr[(2 * i + (lane >> 5)) * 33 + (lane & 31)] = tv[i];
        LDS_WAIT();
        if (it + ngw < NIT) { const TrD dn = ffn_item_desc(w_in, w_out, wt_in, wt_out, it + ngw); TR_LOAD(dn); }
        const int c = lane & 7;
#pragma unroll
        for (int j = 0; j < 4; ++j) { const int n = (lane >> 3) + 8 * j; const LAS float* s_ = scr + (8 * c) * 33 + n;
            u32x4 o; o.x = pk2(s_[0 * 33], s_[1 * 33]); o.y = pk2(s_[2 * 33], s_[3 * 33]); o.z = pk2(s_[4 * 33], s_[5 * 33]); o.w = pk2(s_[6 * 33], s_[7 * 33]);
            *(u32x4*)(d.WT + (size_t)(d.d0 + n) * d.ldk + d.k0 + 8 * c) = o; }
        LDS_WAIT();
    }
#undef TR_LOAD
}
__device__ __forceinline__ void mixer_weight_items(const Params& p, LAS float* scr, int gw, int ngw, int lane) {
    unsigned char* ws = p.ws;
    for (int it = gw; it < 2816 + 256 + 256 + 512; it += ngw) {
        int r = it;
        if (r < 2816) { const int kb = r / 176, nb = r % 176, d0 = nb * 32, s0 = d0 < C_RSB ? d0 : d0 + 8; transpose_item(p.in[I_WIN], INW, s0, kb * 64, (bf16_t*)(ws + W_IN), D, d0, scr, lane); continue; } r -= 2816;
        if (r < 256) { const int kb = r / 32, nb = r % 32; transpose_item(p.in[I_WUPSB], D, nb * 32, kb * 64, (bf16_t*)(ws + W_UPSB), D, nb * 32, scr, lane); continue; } r -= 256;
        if (r < 256) { const int kb = r / 32, nb = r % 32; transpose_item(p.in[I_WUPDN], D, nb * 32, kb * 64, (bf16_t*)(ws + W_UPSB) + 512, D, nb * 32, scr, lane); continue; } r -= 256;
        { const int kb = r / 32, nb = r % 32; transpose_item(p.in[I_WOUT], D, nb * 32, kb * 64, (bf16_t*)(ws + W_OUT), D, nb * 32, scr, lane); }
    }
}
__device__ __forceinline__ void mod_item(const Params& p, LAS unsigned char* lds, int cb, int tid, int wave, int lane) {
    asm volatile("" : "+v"(tid), "+v"(lane));
    LAS float* sc = (LAS float*)lds; LAS float* red = (LAS float*)(lds + 32768);
    for (int i = tid; i < NB * D; i += 512) sc[i] = fsilu(p.in[I_C][i]);
    __syncthreads();
    const float* wa = p.in[I_WADA] + cb * 64 + lane;
    float acc[NB];
#pragma unroll
    for (int b = 0; b < NB; ++b) acc[b] = 0.f;
    for (int k = wave * 128; k < wave * 128 + 128; k += 16) {
        float w[16];
#pragma unroll
        for (int e = 0; e < 16; ++e) w[e] = wa[(size_t)(k + e) * NMOD];
#pragma unroll
        for (int b = 0; b < NB; ++b)
#pragma unroll
            for (int e4 = 0; e4 < 4; ++e4) { const f32x4 s = *(const LAS f32x4*)(sc + b * D + k + 4 * e4); acc[b] += s[0] * w[4 * e4] + s[1] * w[4 * e4 + 1] + s[2] * w[4 * e4 + 2] + s[3] * w[4 * e4 + 3]; }
    }
#pragma unroll
    for (int b = 0; b < NB; ++b) red[(wave * NB + b) * 64 + lane] = acc[b];
    __syncthreads();
    { const int b = tid >> 6; float s = p.in[I_BADA][cb * 64 + lane];
#pragma unroll
        for (int w = 0; w < 8; ++w) s += red[(w * NB + b) * 64 + lane];
        ((float*)(p.ws + WS_MOD))[b * NMOD + cb * 64 + lane] = s; }
    __syncthreads();
}

template <bool DN>
__device__ __forceinline__ void norm_mod_phase(const Params& p, LAS unsigned char* lds, const float* src, const float* gain, int midx, bf16_t* dst, int tid, int wave, int lane) {
    asm volatile("" : "+v"(tid), "+v"(lane));
    const float* mod = (const float*)(p.ws + WS_MOD);
    LAS float* wl = (LAS float*)lds;
    if (DN) { for (int i = tid; i < D * 8; i += 512) { const int k = i >> 3, j = i & 7; wl[8 * k + 4 * (k >> 2) + j] = p.in[I_WIN][(size_t)k * INW + C_RSB + j]; } __syncthreads(); }
    f32x4 g4[4];
#pragma unroll
    for (int j = 0; j < 4; ++j) g4[j] = ((const f32x4*)gain)[lane + 64 * j];
    const int rstep = gridDim.x * 8;
    f32x4 nv[4];
    { const int r0 = blockIdx.x * 8 + wave; const f32x4* xr = (const f32x4*)(src + (size_t)(r0 < T ? r0 : 0) * D) + lane;
#pragma unroll
      for (int j = 0; j < 4; ++j) nv[j] = xr[64 * j]; }
    for (int row = blockIdx.x * 8 + wave; row < T; row += rstep) {
        const int b = row >> 11;
        const f32x4* shp = (const f32x4*)(mod + (size_t)b * NMOD + midx * D) + lane; const f32x4* scp = shp + D / 4;
        f32x4 v[4], shv[4], scv[4]; float ss = 0.f;
#pragma unroll
        for (int j = 0; j < 4; ++j) { v[j] = nv[j]; shv[j] = shp[64 * j]; scv[j] = scp[64 * j]; }
        { const int rn = row + rstep < T ? row + rstep : row; const f32x4* xr = (const f32x4*)(src + (size_t)rn * D) + lane;
#pragma unroll
          for (int j = 0; j < 4; ++j) nv[j] = xr[64 * j]; }
#pragma unroll
        for (int j = 0; j < 4; ++j) ss += (v[j][0] * v[j][0] + v[j][1] * v[j][1]) + (v[j][2] * v[j][2] + v[j][3] * v[j][3]);
        const float rstd = 1.0f / sqrtf(wave_sum(ss) * (1.f / D) + EPS);
        u32x2* o8 = (u32x2*)(dst + (size_t)row * D) + lane;
        float dot[8];
        if (DN) {
#pragma unroll
            for (int e = 0; e < 8; ++e) dot[e] = 0.f; }
#pragma unroll
        for (int j = 0; j < 4; ++j) { const f32x4 sh = shv[j], sc = scv[j];
            const f32x4 uu = v[j] * rstd * g4[j] * (sc + 1.0f) + sh;
            u32x2 w; w.x = pk2(uu[0], uu[1]); w.y = pk2(uu[2], uu[3]); o8[64 * j] = w;
            if (DN) {
#pragma unroll
                for (int e = 0; e < 4; ++e) { const int k = 4 * lane + 256 * j + e; const LAS f32x4* wp = (const LAS f32x4*)(wl + 8 * k + 4 * (k >> 2)); const f32x4 w0 = wp[0], w1 = wp[1];
                    dot[0] += uu[e] * w0[0]; dot[1] += uu[e] * w0[1]; dot[2] += uu[e] * w0[2]; dot[3] += uu[e] * w0[3];
                    dot[4] += uu[e] * w1[0]; dot[5] += uu[e] * w1[1]; dot[6] += uu[e] * w1[2]; dot[7] += uu[e] * w1[3]; } } }
        if (DN) {
#pragma unroll
            for (int e = 0; e < 8; ++e) dot[e] = wave_sum(dot[e]);
            float mine = dot[0];
#pragma unroll
            for (int e = 1; e < 8; ++e) mine = (lane == e) ? dot[e] : mine;
            if (lane < 8) { float r;
                if (lane < 4) r = 1.0f / (1.0f + expf(-mine));
                else { const int hh = lane - 4; const float a = mine + p.in[I_DTBIAS][hh]; const float sp = a > 20.f ? a : log1pf(expf(a)); r = -expf(p.in[I_ALOG][hh]) * sp; }
                ((float*)(p.ws + WS_BG))[(size_t)row * 8 + lane] = r; } }
    }
    if (DN) __syncthreads();
}

__device__ __forceinline__ void unpack16(const bf16_t* p, float* f) {
    const u32x4 a = ((const u32x4*)p)[0], b = ((const u32x4*)p)[1];
    f[0] = bf_lo(a.x); f[1] = bf_hi(a.x); f[2] = bf_lo(a.y); f[3] = bf_hi(a.y); f[4] = bf_lo(a.z); f[5] = bf_hi(a.z); f[6] = bf_lo(a.w); f[7] = bf_hi(a.w);
    f[8] = bf_lo(b.x); f[9] = bf_hi(b.x); f[10] = bf_lo(b.y); f[11] = bf_hi(b.y); f[12] = bf_lo(b.z); f[13] = bf_hi(b.z); f[14] = bf_lo(b.w); f[15] = bf_hi(b.w);
}
__device__ __forceinline__ void pack16(bf16_t* p, const float* f) {
    u32x4 a, b; a.x = pk2(f[0], f[1]); a.y = pk2(f[2], f[3]); a.z = pk2(f[4], f[5]); a.w = pk2(f[6], f[7]); b.x = pk2(f[8], f[9]); b.y = pk2(f[10], f[11]); b.z = pk2(f[12], f[13]); b.w = pk2(f[14], f[15]);
    ((u32x4*)p)[0] = a; ((u32x4*)p)[1] = b;
}
__device__ __forceinline__ void prep_phase(const Params& p, int wave, int lane) {
    asm volatile("" : "+v"(lane));
    bf16_t* P = (bf16_t*)(p.ws + WS_P); bf16_t* U = (bf16_t*)(p.ws + WS_U);
    const int ch = 16 * lane;
    float gsb[16], wcv[4][16];
    { const float* gp = (ch < 512 ? p.in[I_GQSB] : p.in[I_GKSB]) + (ch & 63); const float sc = ch < 512 ? 0.18033688011112042f : 1.0f;
#pragma unroll
        for (int e = 0; e < 16; ++e) gsb[e] = gp[e] * sc;
#pragma unroll
        for (int i = 0; i < 4; ++i)
#pragma unroll
            for (int e = 0; e < 16; ++e) wcv[i][e] = p.in[I_WCONV][i * 1536 + ch + e]; }
    for (int row = blockIdx.x * 8 + wave; row < T; row += gridDim.x * 8) {
        const int tl = row & (SEQ - 1);
        { bf16_t* qp = P + (size_t)row * NIN + ch; float f[16]; unpack16(qp, f); float ss = 0.f;
#pragma unroll
            for (int e = 0; e < 16; ++e) ss += f[e] * f[e];
            ss += __shfl_xor(ss, 1); ss += __shfl_xor(ss, 2);
            const float rstd = 1.0f / sqrtf(ss * (1.f / 64.f) + EPS);
#pragma unroll
            for (int e = 0; e < 16; ++e) f[e] = f[e] * rstd * gsb[e];
            pack16(qp, f); }
        { float y[16];
#pragma unroll
            for (int e = 0; e < 16; ++e) y[e] = 0.f;
#pragma unroll
            for (int i = 0; i < 4; ++i) { if (tl - 3 + i >= 0) { float f[16]; unpack16(P + (size_t)(row - 3 + i) * NIN + C_QDN + ch, f);
#pragma unroll
                    for (int e = 0; e < 16; ++e) y[e] += wcv[i][e] * f[e]; } }
            float ss = 0.f;
#pragma unroll
            for (int e = 0; e < 16; ++e) { y[e] = fsilu(y[e]); ss += y[e] * y[e]; }
            ss += __shfl_xor(ss, 1); ss += __shfl_xor(ss, 2); ss += __shfl_xor(ss, 4);
            const float sc = (1.0f / sqrtf(ss + EPS)) * (ch < 512 ? 0.08838834764831845f : 1.0f);
#pragma unroll
            for (int e = 0; e < 16; ++e) y[e] *= sc;
            pack16(U + (size_t)row * D + ch, y); }
    }
    bf16_t* Vt = (bf16_t*)(p.ws + WS_VT);
    for (int it = blockIdx.x * 8 + wave; it < T / 16; it += gridDim.x * 8) {
        const int row0 = it * 16, b = row0 >> 11, tl0 = row0 & (SEQ - 1), c8 = lane * 8, hd = c8 >> 6, d0 = c8 & 63;
        u32x4 w[16];
#pragma unroll
        for (int r = 0; r < 16; ++r) w[r] = *(const u32x4*)(P + (size_t)(row0 + r) * NIN + C_VSB + c8);
#pragma unroll
        for (int e = 0; e < 8; ++e) {
            unsigned o[8];
#pragma unroll
            for (int i = 0; i < 8; ++i) {
                const int p0 = 2 * i, p1 = 2 * i + 1;
                const int k0 = 8 * ((p0 >> 2) & 1) + 4 * (p0 >> 3) + (p0 & 3), k1 = 8 * ((p1 >> 2) & 1) + 4 * (p1 >> 3) + (p1 & 3);
                const unsigned a0 = w[k0][e >> 1], a1 = w[k1][e >> 1];
                const unsigned lo = (e & 1) ? (a0 >> 16) : (a0 & 0xffffu), hi = (e & 1) ? (a1 & 0xffff0000u) : (a1 << 16);
                o[i] = lo | hi; }
            bf16_t* dst = Vt + ((size_t)(b * 8 + hd) * 64 + d0 + e) * SEQ + tl0;
            ((u32x4*)dst)[0] = (u32x4){o[0], o[1], o[2], o[3]}; ((u32x4*)dst)[1] = (u32x4){o[4], o[5], o[6], o[7]}; }
    }
}

__device__ __forceinline__ float xlane32(float x, int hh) {
    const unsigned xi = __builtin_bit_cast(unsigned, x);
    const u32x2 r = __builtin_amdgcn_permlane32_swap(xi, xi, false, false);
    return __builtin_bit_cast(float, hh ? r.x : r.y);
}
template <bool DIAG>
__device__ __forceinline__ void attn_tile(const f32x16& z, const bf16x8 (&vc)[4], f32x16& o0, f32x16& o1, float& R, int ql, int hh) {
    float sg[16], m[16];
#pragma unroll
    for (int i = 0; i < 16; ++i) { const float e = __builtin_amdgcn_exp2f(fminf(-z[i], 80.0f)); float sig = __builtin_amdgcn_rcpf(1.0f + e); float mm = e * sig;
        if (DIAG) { const bool act = ((i & 3) + 8 * (i >> 2) + 4 * hh) < ql; sig = act ? sig : 0.f; mm = act ? mm : 1.0f; }
        sg[i] = sig; m[i] = mm; }
    float g[4], gp[4];
#pragma unroll
    for (int bq = 0; bq < 4; ++bq) { g[bq] = (m[4 * bq] * m[4 * bq + 1]) * (m[4 * bq + 2] * m[4 * bq + 3]); gp[bq] = xlane32(g[bq], hh); }
    float outer[4]; float tb = R;
#pragma unroll
    for (int bq = 3; bq >= 0; --bq) { outer[bq] = hh == 0 ? tb * gp[bq] : tb; tb *= g[bq] * gp[bq]; }
    R = tb;
    float w[16];
#pragma unroll
    for (int bq = 0; bq < 4; ++bq) { const float s3 = outer[bq], s2 = s3 * m[4 * bq + 3], s1 = s2 * m[4 * bq + 2], s0 = s1 * m[4 * bq + 1];
        w[4 * bq + 3] = sg[4 * bq + 3] * s3; w[4 * bq + 2] = sg[4 * bq + 2] * s2; w[4 * bq + 1] = sg[4 * bq + 1] * s1; w[4 * bq] = sg[4 * bq] * s0; }
    bf16x8 wf[2];
#pragma unroll
    for (int s2 = 0; s2 < 2; ++s2) { const u32x4 pw = {cpk2(w[8 * s2], w[8 * s2 + 1]), cpk2(w[8 * s2 + 2], w[8 * s2 + 3]), cpk2(w[8 * s2 + 4], w[8 * s2 + 5]), cpk2(w[8 * s2 + 6], w[8 * s2 + 7])}; wf[s2] = __builtin_bit_cast(bf16x8, pw); }
    o0 = __builtin_amdgcn_mfma_f32_32x32x16_bf16(vc[0], wf[0], o0, 0, 0, 0); o0 = __builtin_amdgcn_mfma_f32_32x32x16_bf16(vc[1], wf[1], o0, 0, 0, 0);
    o1 = __builtin_amdgcn_mfma_f32_32x32x16_bf16(vc[2], wf[0], o1, 0, 0, 0); o1 = __builtin_amdgcn_mfma_f32_32x32x16_bf16(vc[3], wf[1], o1, 0, 0, 0);
}
__device__ __forceinline__ void attn_item_mfma(bf16_t* P, const bf16_t* Vt, int bh, int qt, int lane) {
    asm volatile("" : "+v"(lane));
    const int b = bh >> 3, h = bh & 7, ql = lane & 31, hh = lane >> 5, q0 = qt * 32;
    bf16_t* qrow = P + (size_t)(b * SEQ + q0 + ql) * NIN + C_QSB + h * 64;
    bf16x8 qf[4];
#pragma unroll
    for (int s = 0; s < 4; ++s) qf[s] = *(const bf16x8*)(qrow + 16 * s + 8 * hh);
    f32x16 o0, o1;
#pragma unroll
    for (int i = 0; i < 16; ++i) { o0[i] = 0.f; o1[i] = 0.f; }
    float R = 1.0f;
    const bf16_t* kb = P + (size_t)(b * SEQ + ql) * NIN + C_KSB + h * 64 + 8 * hh;
    const bf16_t* vb = Vt + ((size_t)bh * 64 + ql) * SEQ + 8 * hh;
    bf16x8 kf[4], vf[4], vn[4];
#define AT_LOADK(k0_) do { _Pragma("unroll") for (int s = 0; s < 4; ++s) kf[s] = *(const bf16x8*)(kb + (size_t)(k0_) * NIN + 16 * s); } while (0)
#define AT_LOADV(dst, k0_) do { _Pragma("unroll") for (int j = 0; j < 4; ++j) dst[j] = *(const bf16x8*)(vb + (size_t)(j >> 1) * 32 * SEQ + (k0_) + 16 * (j & 1)); } while (0)
#define AT_QK(zz) do { _Pragma("unroll") for (int i = 0; i < 16; ++i) zz[i] = 0.f; _Pragma("unroll") for (int s = 0; s < 4; ++s) zz = __builtin_amdgcn_mfma_f32_32x32x16_bf16(kf[s], qf[s], zz, 0, 0, 0); } while (0)
    f32x16 zc, zn;
    AT_LOADK(q0); AT_LOADV(vf, q0);
    AT_QK(zc);
    { const int k1 = (qt > 0 ? qt - 1 : 0) * 32; AT_LOADK(k1); AT_LOADV(vn, k1); }
    { AT_QK(zn);
      const int k2 = (qt > 1 ? qt - 2 : 0) * 32; AT_LOADK(k2);
      attn_tile<true>(zc, vf, o0, o1, R, ql, hh);
      zc = zn;
#pragma unroll
      for (int j = 0; j < 4; ++j) vf[j] = vn[j];
      const int k1 = (qt > 1 ? qt - 2 : 0) * 32; AT_LOADV(vn, k1); }
#pragma unroll 1
    for (int kt = qt - 1; kt >= 0; --kt) {
        AT_QK(zn);
        const int k2 = (kt > 1 ? kt - 2 : 0) * 32; AT_LOADK(k2);
        attn_tile<false>(zc, vf, o0, o1, R, ql, hh);
        if (__builtin_amdgcn_ballot_w64(R != 0.0f) == 0ull) break;
        zc = zn;
#pragma unroll
        for (int j = 0; j < 4; ++j) vf[j] = vn[j];
        AT_LOADV(vn, k2);
    }
#undef AT_LOADK
#undef AT_LOADV
#undef AT_QK
#pragma unroll
    for (int bq = 0; bq < 4; ++bq) {
        u32x2 w0 = {cpk2(o0[4 * bq], o0[4 * bq + 1]), cpk2(o0[4 * bq + 2], o0[4 * bq + 3])}, w1 = {cpk2(o1[4 * bq], o1[4 * bq + 1]), cpk2(o1[4 * bq + 2], o1[4 * bq + 3])};
        *(u32x2*)(qrow + 8 * bq + 4 * hh) = w0; *(u32x2*)(qrow + 32 + 8 * bq + 4 * hh) = w1; }
}
__device__ __forceinline__ size_t slotU(size_t t0, int h, int colbase, int f) { return (t0 + (size_t)(f >> 7)) * D + colbase + h * 128 + (f & 127); }
__device__ __forceinline__ size_t slotP(size_t t0, int h, int colbase, int f) { return (t0 + (size_t)(f >> 7)) * NIN + colbase + h * 128 + (f & 127); }
__device__ __forceinline__ int permpos(int x) { const int k = x & 15; return (x & ~15) + 8 * ((k >> 2) & 1) + 4 * (k >> 3) + (k & 3); }
__device__ __forceinline__ int crow(int r, int hh) { return (r & 3) + 8 * (r >> 2) + 4 * hh; }
__device__ __forceinline__ bf16x8 pack8(const f32x16& x, int s2) {
    const u32x4 pw = {cpk2(x[8 * s2], x[8 * s2 + 1]), cpk2(x[8 * s2 + 2], x[8 * s2 + 3]), cpk2(x[8 * s2 + 4], x[8 * s2 + 5]), cpk2(x[8 * s2 + 6], x[8 * s2 + 7])};
    return __builtin_bit_cast(bf16x8, pw);
}
#define MFMA32(a, b, c) __builtin_amdgcn_mfma_f32_32x32x16_bf16((a), (b), (c), 0, 0, 0)
constexpr int PT = 72, PQ = 136, PL = 68, PB = 40;
constexpr int CP_GC = 0, CP_BT = 256, CP_LS = 1024, CP_TU = CP_LS + 64 * PL * 4, CP_TW = CP_TU + 64 * PT * 2, CP_KT = CP_TW + 64 * PT * 2, CP_VT = CP_KT + 128 * PT * 2,
              CP_QS = CP_VT + 128 * PT * 2, CP_KS = CP_QS + 64 * PQ * 2, CP_AQ = CP_KS + 64 * PQ * 2, CP_L21 = CP_AQ + 64 * PT * 2, CP_TCM = CP_L21 + 32 * PB * 2, CP_T22 = CP_TCM + 32 * PB * 2, CP_END = CP_T22 + 32 * PB * 2;
static_assert(CP_END <= 131072, "chunk prep LDS");
__device__ __forceinline__ void gdn_chunk_prep_phase(const Params& p, LAS unsigned char* lds, int tid, int wave, int lane) {
    bf16_t* P = (bf16_t*)(p.ws + WS_P); bf16_t* U = (bf16_t*)(p.ws + WS_U); const float* BG = (const float*)(p.ws + WS_BG);
    u32x4 ka, kb, qa, qb, xv[4][2]; float gx = 0.f, gbt = 0.f;
#define CP_LOAD(item_) do { const int bh_ = (item_) >> 5, n_ = (item_) & 31, b_ = bh_ >> 2, h_ = bh_ & 3; const size_t t0_ = (size_t)b_ * SEQ + n_ * 64; const int tok_ = tid >> 3, c16_ = (tid & 7) * 16; \
        ka = *(const u32x4*)(U + (t0_ + tok_) * D + 512 + h_ * 128 + c16_); kb = *(const u32x4*)(U + (t0_ + tok_) * D + 512 + h_ * 128 + c16_ + 8); \
        qa = *(const u32x4*)(U + (t0_ + tok_) * D + h_ * 128 + c16_); qb = *(const u32x4*)(U + (t0_ + tok_) * D + h_ * 128 + c16_ + 8); \
        _Pragma("unroll") for (int i = 0; i < 4; ++i) { const bool ok = n_ * 64 + tok_ - 3 + i >= 0; const bf16_t* vp = P + (t0_ + tok_ - 3 + i) * NIN + C_VDN + h_ * 128 + c16_; \
            xv[i][0] = ok ? *(const u32x4*)vp : (u32x4){0u, 0u, 0u, 0u}; xv[i][1] = ok ? *(const u32x4*)(vp + 8) : (u32x4){0u, 0u, 0u, 0u}; } \
        if (tid < 64) { gx = BG[(t0_ + tid) * 8 + 4 + h_]; gbt = BG[(t0_ + tid) * 8 + h_]; } } while (0)
    if ((int)blockIdx.x < 1024) CP_LOAD((int)blockIdx.x);
  for (int item = blockIdx.x; item < 1024; item += gridDim.x) {
    asm volatile("" : "+v"(tid), "+v"(lane));
    const int bh = item >> 5, n = item & 31, b = bh >> 2, h = bh & 3, ql = lane & 31, hh = lane >> 5;
    const size_t t0 = (size_t)b * SEQ + n * 64;
    LAS float* gcS = (LAS float*)(lds + CP_GC); LAS float* btS = (LAS float*)(lds + CP_BT);
    LAS float* LS = (LAS float*)(lds + CP_LS);
    LAS bf16_t* TuS = (LAS bf16_t*)(lds + CP_TU); LAS bf16_t* TwS = (LAS bf16_t*)(lds + CP_TW);
    LAS bf16_t* kT = (LAS bf16_t*)(lds + CP_KT); LAS bf16_t* vT = (LAS bf16_t*)(lds + CP_VT); LAS bf16_t* qS = (LAS bf16_t*)(lds + CP_QS); LAS bf16_t* kS = (LAS bf16_t*)(lds + CP_KS);
    LAS bf16_t* AQ = (LAS bf16_t*)(lds + CP_AQ); LAS bf16_t* L21b = (LAS bf16_t*)(lds + CP_L21); LAS bf16_t* Tcm = (LAS bf16_t*)(lds + CP_TCM); LAS bf16_t* T22r = (LAS bf16_t*)(lds + CP_T22);
    if (tid < 64) { float x = gx;
#pragma unroll
        for (int o = 1; o < 64; o <<= 1) { const float y = __shfl_up(x, o); if (lane >= o) x += y; }
        gcS[tid] = x; btS[tid] = gbt; }
    { const int tok = tid >> 3, c16 = (tid & 7) * 16;
        *(LAS u32x4*)(kS + tok * PQ + c16) = ka; *(LAS u32x4*)(kS + tok * PQ + c16 + 8) = kb;
        *(LAS u32x4*)(qS + tok * PQ + c16) = qa; *(LAS u32x4*)(qS + tok * PQ + c16 + 8) = qb;
        const unsigned kw[8] = {ka.x, ka.y, ka.z, ka.w, kb.x, kb.y, kb.z, kb.w};
#pragma unroll
        for (int e = 0; e < 8; ++e) { kT[(c16 + 2 * e) * PT + tok] = (bf16_t)(kw[e] & 0xffffu); kT[(c16 + 2 * e + 1) * PT + tok] = (bf16_t)(kw[e] >> 16); }
        float y[16];
#pragma unroll
        for (int e = 0; e < 16; ++e) y[e] = 0.f;
#pragma unroll
        for (int i = 0; i < 4; ++i) { const float* wp = p.in[I_WCONV] + i * 1536 + 1024 + h * 128 + c16;
            const unsigned xw[8] = {xv[i][0].x, xv[i][0].y, xv[i][0].z, xv[i][0].w, xv[i][1].x, xv[i][1].y, xv[i][1].z, xv[i][1].w};
#pragma unroll
            for (int e = 0; e < 8; ++e) { y[2 * e] += wp[2 * e] * bf_lo(xw[e]); y[2 * e + 1] += wp[2 * e + 1] * bf_hi(xw[e]); } }
#pragma unroll
        for (int e = 0; e < 16; ++e) vT[(c16 + e) * PT + tok] = f2bf(fsilu(y[e])); }
    __syncthreads();
    if (item + (int)gridDim.x < 1024) CP_LOAD(item + (int)gridDim.x);
    if (wave == 0 || wave == 4 || wave == 5) {
        const int it = wave == 0 ? 0 : 1, jt = wave == 4 ? 1 : 0;
        f32x16 acc;
#pragma unroll
        for (int r = 0; r < 16; ++r) acc[r] = 0.f;
#pragma unroll
        for (int ks = 0; ks < 8; ++ks) acc = MFMA32(*(const LAS bf16x8*)(kS + (32 * it + ql) * PQ + 16 * ks + 8 * hh), *(const LAS bf16x8*)(kS + (32 * jt + ql) * PQ + 16 * ks + 8 * hh), acc);
        const int j = 32 * jt + ql; const float gj = gcS[j];
#pragma unroll
        for (int r = 0; r < 16; ++r) { const int i = 32 * it + crow(r, hh); const float l = (j < i) ? btS[i] * acc[r] * fexp(gcS[i] - gj) : 0.f;
            if (it != jt) L21b[(i - 32) * PB + j] = f2bf(l); else LS[i * PL + j] = l; }
    } else if (wave < 4) {
        const int jt = wave == 3 ? 1 : 0, it = wave == 1 ? 0 : 1;
        f32x16 acc;
#pragma unroll
        for (int r = 0; r < 16; ++r) acc[r] = 0.f;
#pragma unroll
        for (int ks = 0; ks < 8; ++ks) acc = MFMA32(*(const LAS bf16x8*)(kS + (32 * jt + ql) * PQ + 16 * ks + 8 * hh), *(const LAS bf16x8*)(qS + (32 * it + ql) * PQ + 16 * ks + 8 * hh), acc);
        const int i = 32 * it + ql; const float gi = gcS[i];
#pragma unroll
        for (int r = 0; r < 16; ++r) { const int j = 32 * jt + crow(r, hh); acc[r] = (j <= i) ? acc[r] * fexp(gi - gcS[j]) : 0.f; }
#pragma unroll
        for (int bq = 0; bq < 4; ++bq) *(LAS u32x2*)(AQ + i * PT + 32 * jt + 8 * bq + 4 * hh) = (u32x2){cpk2(acc[4 * bq], acc[4 * bq + 1]), cpk2(acc[4 * bq + 2], acc[4 * bq + 3])};
    } else {
        const float gl = gcS[63];
#pragma unroll
        for (int uu = 0; uu < 4; ++uu) { const int unit = (tid - 384) + 128 * uu, dk = unit >> 2, blk = unit & 3;
            const u32x4 k0 = *(const LAS u32x4*)(kT + dk * PT + 16 * blk), k1 = *(const LAS u32x4*)(kT + dk * PT + 16 * blk + 8);
            float kv[16] = {bf_lo(k0.x), bf_hi(k0.x), bf_lo(k0.y), bf_hi(k0.y), bf_lo(k0.z), bf_hi(k0.z), bf_lo(k0.w), bf_hi(k0.w), bf_lo(k1.x), bf_hi(k1.x), bf_lo(k1.y), bf_hi(k1.y), bf_lo(k1.z), bf_hi(k1.z), bf_lo(k1.w), bf_hi(k1.w)};
#pragma unroll
            for (int e = 0; e < 16; ++e) kv[e] *= fexp(gl - gcS[16 * blk + e]);
            float pv[16];
#pragma unroll
            for (int e = 0; e < 16; ++e) pv[permpos(e)] = kv[e];
            pack16(P + slotP(t0, h, C_VSB, dk * 64 + 16 * blk), pv); }
        if (tid == 384) ((float*)(p.ws + WS_EGL))[bh * 32 + n] = fexp(gl);
    }
    __syncthreads();
    if (wave == 0) {
        const LAS float* LB = LS + (32 * hh) * PL + 32 * hh;
        float Tc[32];
#pragma unroll
        for (int i = 0; i < 32; ++i) {
            float a0 = (ql == i) ? 1.0f : 0.f, a1 = 0.f, a2 = 0.f, a3 = 0.f;
#pragma unroll
            for (int j4 = 0; j4 < i; j4 += 4) { const f32x4 l4 = *(const LAS f32x4*)(LB + i * PL + j4);
                a0 -= l4[0] * Tc[j4]; if (j4 + 1 < i) a1 -= l4[1] * Tc[j4 + 1]; if (j4 + 2 < i) a2 -= l4[2] * Tc[j4 + 2]; if (j4 + 3 < i) a3 -= l4[3] * Tc[j4 + 3]; }
            Tc[i] = (a0 + a1) + (a2 + a3); }
        const int cg_ = 32 * hh + ql; const float bu = btS[cg_], bw = bu * fexp(gcS[cg_]);
#pragma unroll
        for (int i = 0; i < 32; ++i) { TuS[(32 * hh + i) * PT + cg_] = f2bf(Tc[i] * bu); TwS[(32 * hh + i) * PT + cg_] = f2bf(Tc[i] * bw); }
        if (hh == 0) {
#pragma unroll
            for (int i8 = 0; i8 < 4; ++i8) *(LAS u32x4*)(Tcm + ql * PB + 8 * i8) = (u32x4){cpk2(Tc[8 * i8], Tc[8 * i8 + 1]), cpk2(Tc[8 * i8 + 2], Tc[8 * i8 + 3]), cpk2(Tc[8 * i8 + 4], Tc[8 * i8 + 5]), cpk2(Tc[8 * i8 + 6], Tc[8 * i8 + 7])};
        } else {
#pragma unroll
            for (int i = 0; i < 32; ++i) T22r[i * PB + ql] = f2bf(Tc[i]);
        }
        LDS_WAIT();
        f32x16 x1;
#pragma unroll
        for (int r = 0; r < 16; ++r) x1[r] = 0.f;
#pragma unroll
        for (int s2 = 0; s2 < 2; ++s2) x1 = MFMA32(*(const LAS bf16x8*)(L21b + ql * PB + 16 * s2 + 8 * hh), *(const LAS bf16x8*)(Tcm + ql * PB + 16 * s2 + 8 * hh), x1);
        f32x16 yy;
#pragma unroll
        for (int r = 0; r < 16; ++r) yy[r] = 0.f;
#pragma unroll
        for (int s2 = 0; s2 < 2; ++s2) { const u32x2 lo = *(const LAS u32x2*)(T22r + ql * PB + 16 * s2 + 4 * hh), hi = *(const LAS u32x2*)(T22r + ql * PB + 16 * s2 + 8 + 4 * hh);
            const u32x4 af = {lo.x, lo.y, hi.x, hi.y};
            yy = MFMA32(__builtin_bit_cast(bf16x8, af), pack8(x1, s2), yy); }
        { const float bu0 = btS[ql], bw0 = bu0 * fexp(gcS[ql]);
#pragma unroll
            for (int r = 0; r < 16; ++r) { const int i2 = 32 + crow(r, hh); TuS[i2 * PT + ql] = f2bf(-yy[r] * bu0); TwS[i2 * PT + ql] = f2bf(-yy[r] * bw0); } }
    }
    __syncthreads();
    {
        const int isW = wave >> 2, ct = wave & 3, col = 32 * ct + ql;
        const LAS bf16_t* Ta = (isW ? TwS : TuS) + 8 * hh; const LAS bf16_t* Bs = (isW ? kT : vT) + col * PT + 8 * hh;
        bf16x8 bf[4];
#pragma unroll
        for (int ks = 0; ks < 4; ++ks) bf[ks] = *(const LAS bf16x8*)(Bs + 16 * ks);
        f32x16 xa[2];
#pragma unroll
        for (int jt = 0; jt < 2; ++jt) {
#pragma unroll
            for (int r = 0; r < 16; ++r) xa[jt][r] = 0.f;
#pragma unroll
            for (int ks = 0; ks < 4; ++ks) if (jt == 1 || ks < 2) xa[jt] = MFMA32(*(const LAS bf16x8*)(Ta + (32 * jt + ql) * PT + 16 * ks), bf[ks], xa[jt]); }
        bf16x8 xb[4] = {pack8(xa[0], 0), pack8(xa[0], 1), pack8(xa[1], 0), pack8(xa[1], 1)};
        f32x16 ra[2];
#pragma unroll
        for (int it = 0; it < 2; ++it) {
#pragma unroll
            for (int r = 0; r < 16; ++r) ra[it][r] = 0.f;
#pragma unroll
            for (int kk = 0; kk < 4; ++kk) if (it == 1 || kk < 2) { const LAS bf16_t* ap = AQ + (32 * it + ql) * PT + 16 * kk + 4 * hh;
                const u32x2 lo = *(const LAS u32x2*)ap, hi = *(const LAS u32x2*)(ap + 8); const u32x4 af = {lo.x, lo.y, hi.x, hi.y};
                ra[it] = MFMA32(__builtin_bit_cast(bf16x8, af), xb[kk], ra[it]); } }
        if (!isW) {
#pragma unroll
            for (int jt = 0; jt < 2; ++jt)
#pragma unroll
                for (int bq = 0; bq < 4; ++bq) { const int f = col * 64 + 32 * jt + 8 * bq + 4 * hh;
                    *(u32x2*)(U + slotU(t0, h, 0, f)) = (u32x2){cpk2(xa[jt][4 * bq], xa[jt][4 * bq + 1]), cpk2(xa[jt][4 * bq + 2], xa[jt][4 * bq + 3])};
                    *(u32x2*)(U + slotU(t0, h, 512, f)) = (u32x2){cpk2(ra[jt][4 * bq], ra[jt][4 * bq + 1]), cpk2(ra[jt][4 * bq + 2], ra[jt][4 * bq + 3])}; }
        } else {
            const int pc = permpos(col);
#pragma unroll
            for (int jt = 0; jt < 2; ++jt)
#pragma unroll
                for (int r = 0; r < 16; ++r) { const int tok = 32 * jt + crow(r, hh);
                    P[(t0 + tok) * NIN + C_QDN + h * 128 + pc] = f2bf(-xa[jt][r]);
                    P[(t0 + tok) * NIN + C_KDN + h * 128 + pc] = f2bf(bf2f(qS[tok * PQ + col]) * fexp(gcS[tok]) - ra[jt][r]); }
        }
    }
    __syncthreads();
  }
#undef CP_LOAD
}
constexpr int SC_PW = 136, SC_PK = 72, SC_NW = 0, SC_Q2 = 64 * SC_PW * 2, SC_KD = 2 * 64 * SC_PW * 2, SC_STAGE = 2 * 64 * SC_PW * 2 + 128 * SC_PK * 2, SC_OS = 2 * SC_STAGE,
              SC_US = SC_OS + 64 * SC_PW * 2, SC_OI = SC_US + 128 * SC_PK * 2, SC_END = SC_OI + 128 * SC_PK * 2;
static_assert(SC_END <= BST_OFF, "scan LDS");
__device__ __forceinline__ void gdn_scan_block(const Params& p, LAS unsigned char* lds, int bh, int tid, int wave, int lane) {
    asm volatile("" : "+v"(tid), "+v"(lane));
    bf16_t* P = (bf16_t*)(p.ws + WS_P); const bf16_t* U = (const bf16_t*)(p.ws + WS_U); const float* EGL = (const float*)(p.ws + WS_EGL);
    const int b = bh >> 2, h = bh & 3, ql = lane & 31, hh = lane >> 5;
    const size_t tb = (size_t)b * SEQ;
    LAS bf16_t* oS = (LAS bf16_t*)(lds + SC_OS);
    if (wave >= 4) {
        int lt = tid - 256, ftok = lt >> 2, fseg = lt & 3;
        u32x4 ra[20], rb[20];
#define SC_LOAD(r, n_) do { const size_t t0_ = tb + (size_t)(n_) * 64; _Pragma("unroll") for (int i = 0; i < 4; ++i) { const int c = lt + 256 * i, row = c >> 4, c8 = (c & 15) * 8; \
            const bf16_t* g_ = P + (t0_ + row) * NIN + h * 128 + c8; const bf16_t* u_ = U + (t0_ + row) * D + h * 128 + c8; \
            r[i] = *(const u32x4*)(g_ + C_QDN); r[4 + i] = *(const u32x4*)(g_ + C_KDN); r[8 + i] = *(const u32x4*)(g_ + C_VSB); r[12 + i] = *(const u32x4*)u_; r[16 + i] = *(const u32x4*)(u_ + 512); } } while (0)
#define SC_STORE(r, st_) do { LAS unsigned char* s_ = lds + (st_) * SC_STAGE; _Pragma("unroll") for (int i = 0; i < 4; ++i) { const int c = lt + 256 * i, row = c >> 4, c8 = (c & 15) * 8; \
            *(LAS u32x4*)(s_ + SC_NW + (row * SC_PW + c8) * 2) = r[i]; *(LAS u32x4*)(s_ + SC_Q2 + (row * SC_PW + c8) * 2) = r[4 + i]; \
            *(LAS u32x4*)(s_ + SC_KD + ((2 * row + (c8 >> 6)) * SC_PK + (c8 & 63)) * 2) = r[8 + i]; } } while (0)
#define SC_STOREU(r) do { _Pragma("unroll") for (int i = 0; i < 4; ++i) { const int c = lt + 256 * i, row = c >> 4, c8 = (c & 15) * 8; const int o_ = ((2 * row + (c8 >> 6)) * SC_PK + (c8 & 63)) * 2; \
            *(LAS u32x4*)(lds + SC_US + o_) = r[12 + i]; *(LAS u32x4*)(lds + SC_OI + o_) = r[16 + i]; } } while (0)
#define SC_FIN(m_) do { bf16_t* orow = P + (tb + (size_t)(m_) * 64 + ftok) * NIN + h * 128 + fseg * 32 + C_VDN; \
            _Pragma("unroll") for (int i = 0; i < 4; ++i) *(u32x4*)(orow + 8 * i) = *(const LAS u32x4*)(oS + ftok * SC_PW + fseg * 32 + 8 * i); } while (0)
        SC_LOAD(ra, 0); SC_STORE(ra, 0); SC_STOREU(ra); SC_LOAD(ra, 1);
        __syncthreads();
#pragma unroll 1
        for (int n = 0; n < 32; n += 2) {
            asm volatile("" : "+v"(lt), "+v"(ftok), "+v"(fseg));
            if (n + 2 < 32) SC_LOAD(rb, n + 2);
            SC_STORE(ra, 1);
            if (n > 0) SC_FIN(n - 1);
            __syncthreads();
            SC_STOREU(ra);
            __syncthreads();
            if (n + 3 < 32) SC_LOAD(ra, n + 3);
            if (n + 2 < 32) SC_STORE(rb, 0);
            SC_FIN(n);
            __syncthreads();
            if (n + 2 < 32) SC_STOREU(rb);
            __syncthreads();
        }
        SC_FIN(31);
#undef SC_LOAD
#undef SC_STORE
#undef SC_STOREU
#undef SC_FIN
    } else {
        const int col = 32 * wave + ql;
        f32x16 S[4];
#pragma unroll
        for (int rt = 0; rt < 4; ++rt)
#pragma unroll
            for (int r = 0; r < 16; ++r) S[rt][r] = 0.f;
        const float eglv = EGL[bh * 32 + ql];
        __syncthreads();
#pragma unroll 1
        for (int n = 0; n < 32; ++n) {
            const float egl = __builtin_bit_cast(float, __builtin_amdgcn_readlane(__builtin_bit_cast(int, eglv), n));
            const LAS unsigned char* st = lds + (n & 1) * SC_STAGE;
            f32x16 vn[2], oa[2];
            { const LAS unsigned char* up_ = lds + SC_US + (col * SC_PK + 4 * hh) * 2; const LAS unsigned char* op_ = lds + SC_OI + (col * SC_PK + 4 * hh) * 2;
#pragma unroll
              for (int jt = 0; jt < 2; ++jt)
#pragma unroll
                for (int bq = 0; bq < 4; ++bq) { const u32x2 uw = *(const LAS u32x2*)(up_ + (32 * jt + 8 * bq) * 2), ow = *(const LAS u32x2*)(op_ + (32 * jt + 8 * bq) * 2);
                    vn[jt][4 * bq] = bf_lo(uw.x); vn[jt][4 * bq + 1] = bf_hi(uw.x); vn[jt][4 * bq + 2] = bf_lo(uw.y); vn[jt][4 * bq + 3] = bf_hi(uw.y);
                    oa[jt][4 * bq] = bf_lo(ow.x); oa[jt][4 * bq + 1] = bf_hi(ow.x); oa[jt][4 * bq + 2] = bf_lo(ow.y); oa[jt][4 * bq + 3] = bf_hi(ow.y); } }
            const LAS unsigned char* w0_ = st + (ql * SC_PW + 8 * hh) * 2; const LAS unsigned char* w1_ = w0_ + 32 * SC_PW * 2;
            const LAS unsigned char* kd_ = st + SC_KD + (ql * SC_PK + 8 * hh) * 2;
            bf16x8 fa[4], fb[4];
#define SC_RD4(dst, ptr) do { _Pragma("unroll") for (int i_ = 0; i_ < 4; ++i_) dst[i_] = *(const LAS bf16x8*)((ptr) + 32 * i_); } while (0)
#define SC_MM4(acc, fr, bb) do { _Pragma("unroll") for (int i_ = 0; i_ < 4; ++i_) acc = MFMA32(fr[i_], bb[i_], acc); __builtin_amdgcn_sched_barrier(0); } while (0)
            SC_RD4(fa, w0_ + SC_NW); SC_RD4(fb, w1_ + SC_NW);
            { bf16x8 sb[4] = {pack8(S[0], 0), pack8(S[0], 1), pack8(S[1], 0), pack8(S[1], 1)};
              SC_MM4(vn[0], fa, sb); SC_RD4(fa, w0_ + SC_Q2);
              SC_MM4(vn[1], fb, sb); SC_RD4(fb, w1_ + SC_Q2);
              SC_MM4(oa[0], fa, sb); SC_RD4(fa, w0_ + SC_NW + 128);
              SC_MM4(oa[1], fb, sb); SC_RD4(fb, w1_ + SC_NW + 128); }
            { bf16x8 sb[4] = {pack8(S[2], 0), pack8(S[2], 1), pack8(S[3], 0), pack8(S[3], 1)};
              SC_MM4(vn[0], fa, sb); SC_RD4(fa, w0_ + SC_Q2 + 128);
              SC_MM4(vn[1], fb, sb); SC_RD4(fb, w1_ + SC_Q2 + 128);
              bf16x8 vb[4] = {pack8(vn[0], 0), pack8(vn[0], 1), pack8(vn[1], 0), pack8(vn[1], 1)};
              SC_MM4(oa[0], fa, sb); SC_RD4(fa, kd_);
              SC_MM4(oa[1], fb, sb); SC_RD4(fb, kd_ + 32 * SC_PK * 2);
#pragma unroll
              for (int rt = 0; rt < 4; ++rt)
#pragma unroll
                  for (int r = 0; r < 16; ++r) S[rt][r] *= egl;
              SC_MM4(S[0], fa, vb); SC_RD4(fa, kd_ + 64 * SC_PK * 2);
              SC_MM4(S[1], fb, vb); SC_RD4(fb, kd_ + 96 * SC_PK * 2);
              SC_MM4(S[2], fa, vb);
              SC_MM4(S[3], fb, vb); }
#undef SC_RD4
#undef SC_MM4
            __syncthreads();
#pragma unroll
            for (int jt = 0; jt < 2; ++jt)
#pragma unroll
                for (int r = 0; r < 16; ++r) oS[(32 * jt + crow(r, hh)) * SC_PW + col] = f2bf(oa[jt][r]);
            __syncthreads();
        }
    }
}
__device__ __forceinline__ void gdn_finalize_phase(const Params& p, int wave, int lane) {
    asm volatile("" : "+v"(lane));
    bf16_t* P = (bf16_t*)(p.ws + WS_P);
    const int c0 = (lane & 15) * 8;
    float gg[8];
#pragma unroll
    for (int e = 0; e < 8; ++e) gg[e] = p.in[I_GDNOUT][c0 + e];
    for (int row = blockIdx.x * 8 + wave; row < T; row += gridDim.x * 8) {
        bf16_t* op = P + (size_t)row * NIN + C_VDN + lane * 8; const bf16_t* zp = P + (size_t)row * NIN + C_ZDN + lane * 8;
        const u32x4 ow = *(const u32x4*)op, zw = *(const u32x4*)zp;
        const float o[8] = {bf_lo(ow.x), bf_hi(ow.x), bf_lo(ow.y), bf_hi(ow.y), bf_lo(ow.z), bf_hi(ow.z), bf_lo(ow.w), bf_hi(ow.w)};
        const float z[8] = {bf_lo(zw.x), bf_hi(zw.x), bf_lo(zw.y), bf_hi(zw.y), bf_lo(zw.z), bf_hi(zw.z), bf_lo(zw.w), bf_hi(zw.w)};
        float ss = 0.f;
#pragma unroll
        for (int e = 0; e < 8; ++e) ss += o[e] * o[e];
        ss += __shfl_xor(ss, 1); ss += __shfl_xor(ss, 2); ss += __shfl_xor(ss, 4); ss += __shfl_xor(ss, 8);
        const float rstd = 1.0f / sqrtf(ss * (1.f / 128.f) + EPS);
        float r[8];
#pragma unroll
        for (int e = 0; e < 8; ++e) r[e] = o[e] * rstd * gg[e] * fsilu(z[e]);
        u32x4 w; w.x = pk2(r[0], r[1]); w.y = pk2(r[2], r[3]); w.z = pk2(r[4], r[5]); w.w = pk2(r[6], r[7]);
        *(u32x4*)op = w;
    }
}

#define XB_TMO      128
#define XB_XCNT(j)  (256  + 64 * (j))
#define XB_XSUB(j)  (1280 + 64 * (j))
#define XB_XGEN(j)  (2304 + 64 * (j))
#define XB_TOP      3328
#define XB_TOPGEN   3392
#define XCD_BAR_WORDS 3456
#define XB_SPIN_CAP (1u << 18)
__device__ __forceinline__ unsigned xb_ld(unsigned* p)              { return __hip_atomic_load(p, __ATOMIC_RELAXED, __HIP_MEMORY_SCOPE_AGENT); }
__device__ __forceinline__ unsigned xb_add(unsigned* p, unsigned v) { return __hip_atomic_fetch_add(p, v, __ATOMIC_RELAXED, __HIP_MEMORY_SCOPE_AGENT); }
__device__ __forceinline__ unsigned xb_xcc_id() { return (unsigned)__builtin_amdgcn_s_getreg((3 << 11) | 20) & 0xFu; }
#define XB_SPIN(cond, bar) do { unsigned _sp = 0; while (cond) { __builtin_amdgcn_s_sleep(1); \
    if ((++_sp & 255u) == 0u) { if (xb_ld(&(bar)[XB_TMO])) break; if (_sp > XB_SPIN_CAP) { atomicAdd(&(bar)[XB_TMO], 1u); break; } } } } while (0)
struct XcdBarrier { unsigned* bar; unsigned x; volatile LAS unsigned* st; };
__device__ __forceinline__ XcdBarrier xcd_barrier_post(unsigned* bar, volatile LAS unsigned* st) {
    XcdBarrier b; b.bar = bar; b.x = xb_xcc_id(); b.st = st;
    if (threadIdx.x == 0) (void)xb_add(&bar[XB_XCNT(b.x)], 1u);
    return b;
}
__device__ __forceinline__ void xcd_barrier_complete(unsigned* bar, unsigned x, unsigned& nloc, unsigned& nx) {
    const unsigned G = gridDim.x * gridDim.y * gridDim.z;
    unsigned sum, cnt, mine, sp = 0u;
    for (;;) {
        sum = 0u; cnt = 0u; mine = 0u;
#pragma unroll
        for (unsigned j = 0; j < 16; ++j) { const unsigned c = xb_ld(&bar[XB_XCNT(j)]); sum += c; cnt += (c > 0u) ? 1u : 0u; mine = (j == x) ? c : mine; }
        if (sum == G) break;
        __builtin_amdgcn_s_sleep(1);
        if ((++sp & 255u) == 0u) { if (xb_ld(&bar[XB_TMO])) break; if (sp > XB_SPIN_CAP) { atomicAdd(&bar[XB_TMO], 1u); break; } }
    }
    nloc = mine > 0u ? mine : 1u; nx = cnt > 0u ? cnt : 1u;
}
__device__ __forceinline__ void xcd_barrier(const XcdBarrier& b) {
    asm volatile("s_waitcnt vmcnt(0)" ::: "memory");
    __syncthreads();
    if (threadIdx.x == 0) {
        unsigned* bar = b.bar;
        __builtin_amdgcn_s_waitcnt(0);
        unsigned nloc = b.st[0], nx = b.st[1];
        if (nloc == 0u) { xcd_barrier_complete(bar, b.x, nloc, nx); b.st[0] = nloc; b.st[1] = nx; }
        const unsigned old = xb_add(&bar[XB_XSUB(b.x)], 1u);
        const unsigned gen = old / nloc;
        if (old + 1u == (gen + 1u) * nloc) {
            __builtin_amdgcn_fence(__ATOMIC_RELEASE, "agent");
            asm volatile("s_waitcnt vmcnt(0)" ::: "memory");
            const unsigned og = xb_add(&bar[XB_TOP], 1u);
            const unsigned tg = og / nx;
            if (og + 1u == (tg + 1u) * nx) xb_add(&bar[XB_TOPGEN], 1u);
            else XB_SPIN(xb_ld(&bar[XB_TOPGEN]) == tg, bar);
            __builtin_amdgcn_fence(__ATOMIC_ACQUIRE, "agent");
            xb_add(&bar[XB_XGEN(b.x)], 1u);
            asm volatile("s_waitcnt vmcnt(0)" ::: "memory");
        } else {
            XB_SPIN(xb_ld(&bar[XB_XGEN(b.x)]) == gen, bar);
            __builtin_amdgcn_fence(__ATOMIC_ACQUIRE, "agent");
            asm volatile("s_waitcnt vmcnt(0)" ::: "memory");
        }
    }
    __syncthreads();
}

#ifndef PHMASK
#define PHMASK 0xFFFF
#endif
#define PH(n) ((PHMASK >> (n)) & 1)
#ifndef PROBE
#define PROBE 0
#endif
#define REP(g) for (int _rep = 0; _rep < ((PROBE == (g)) ? 2 : 1); ++_rep)
__global__ void __launch_bounds__(512, 2) fwd_megakernel(Params p) {
    extern __shared__ __attribute__((aligned(16))) unsigned char lds_raw[];
    LAS unsigned char* lds = (LAS unsigned char*)lds_raw;
    cg::grid_group grid = cg::this_grid();
    const int tid = threadIdx.x, lane = tid & 63, wave = __builtin_amdgcn_readfirstlane(tid >> 6);
    const int G = gridDim.x, gw = wave * G + blockIdx.x, ngw = G * 8;
    unsigned char* ws = p.ws;
    bf16_t* U = (bf16_t*)(ws + WS_U); bf16_t* P = (bf16_t*)(ws + WS_P);
    const float* mod = (const float*)(ws + WS_MOD);
    LAS float* scr = (LAS float*)(lds + wave * 16384);

    unsigned* barw = (unsigned*)(ws + WS_BAR);
    volatile LAS unsigned* bst = (volatile LAS unsigned*)(lds + BST_OFF);
    if (tid < 2) bst[tid] = 0u;
    __syncthreads();
    if (p.ws == nullptr) grid.sync();
    const XcdBarrier xbar = xcd_barrier_post(barw, bst);
    REP(1) { if (PH(0)) for (int it = blockIdx.x; it < NMOD / 64; it += G) mod_item(p, lds, it, tid, wave, lane);
    if (PH(0)) ffn_weight_items(p.in[I_WFFN1IN], p.in[I_WFFN1OUT], (bf16_t*)(ws + W_FFIN), (bf16_t*)(ws + W_FFOUT), scr, gw, ngw, lane);
    __syncthreads(); }
    xcd_barrier(xbar);
    if (PROBE == 3) for (int i = 0; i < 16; ++i) xcd_barrier(xbar);
    REP(1) if (PH(1)) norm_mod_phase<false>(p, lds, p.in[I_X], p.in[I_GFFN1], 0, U, tid, wave, lane);
    xcd_barrier(xbar);
    REP(2) if (PH(2)) run_gemm(lds, U, D, (const bf16_t*)(ws + W_FFIN), 2 * FF, D, EpiSwiGLU{P, FF});
    { const int nfull = (64 * 22) % G, nidle = nfull ? G - nfull : G;
      const int ib = nfull ? (int)blockIdx.x - nfull : (int)blockIdx.x;
      if (PH(0) && ib >= 0) mixer_weight_items(p, scr, wave * nidle + ib, nidle * 8, lane); }
    xcd_barrier(xbar);
    REP(2) if (PH(3)) run_gemm(lds, P, FF, (const bf16_t*)(ws + W_FFOUT), D, FF, EpiResid{p.in[I_X], p.out, mod + 2 * D, 0.5f});
    xcd_barrier(xbar);
    REP(1) if (PH(4)) norm_mod_phase<true>(p, lds, p.out, p.in[I_GMIX], 3, U, tid, wave, lane);
    xcd_barrier(xbar);
    REP(2) if (PH(5)) run_gemm(lds, U, D, (const bf16_t*)(ws + W_IN), NIN, D, EpiBf16{P, NIN});
    xcd_barrier(xbar);
    if (PH(6)) prep_phase(p, wave, lane);
    xcd_barrier(xbar);
    if (PH(7)) gdn_chunk_prep_phase(p, lds, tid, wave, lane);
    xcd_barrier(xbar);
    if (PH(15)) for (int it = blockIdx.x; it < 32; it += G) gdn_scan_block(p, lds, it, tid, wave, lane);
    if (PH(8)) {
        const unsigned x0 = xb_xcc_id() & 7u;
        for (unsigned dx = 0; dx < 8u; ++dx) { const unsigned x = (x0 + dx) & 7u; unsigned* ctr = (unsigned*)(ws + WS_CTR) + 64 * x;
            for (;;) { unsigned idx = 0; if (lane == 0) idx = atomicAdd(ctr, 1u); idx = __builtin_amdgcn_readfirstlane(idx);
                if (idx >= 512u) break;
                attn_item_mfma(P, (const bf16_t*)(ws + WS_VT), (int)(8u * x + (idx & 7u)), 63 - (int)(idx >> 3), lane); } } }
    xcd_barrier(xbar);
    if (PH(9)) gdn_finalize_phase(p, wave, lane);
    xcd_barrier(xbar);
    if (PH(10)) run_gemm(lds, P + C_QSB, NIN, (const bf16_t*)(ws + W_UPSB), D, 1024, EpiGateFused{P + C_RSB, P + C_RDN, U}, 8, (C_VDN - C_QSB) * 2 - 8 * 128);
    xcd_barrier(xbar);
    if (PH(11)) run_gemm(lds, U, D, (const bf16_t*)(ws + W_OUT), D, D, EpiResid{p.out, p.out, mod + 5 * D, 1.0f});
    xcd_barrier(xbar);
    REP(1) if (PH(12)) norm_mod_phase<false>(p, lds, p.out, p.in[I_GFFN2], 6, U, tid, wave, lane);
    __syncthreads();
    if (PH(12)) ffn_weight_items(p.in[I_WFFN2IN], p.in[I_WFFN2OUT], (bf16_t*)(ws + W_FFIN), (bf16_t*)(ws + W_FFOUT), scr, gw, ngw, lane);
    xcd_barrier(xbar);
    REP(2) if (PH(13)) run_gemm(lds, U, D, (const bf16_t*)(ws + W_FFIN), 2 * FF, D, EpiSwiGLU{P, FF});
    xcd_barrier(xbar);
    if (PH(14)) run_gemm(lds, P, FF, (const bf16_t*)(ws + W_FFOUT), D, FF, EpiResid{p.out, p.out, mod + 8 * D, 0.5f});
}

extern "C" void kernel_launch(void* const* d_in, const int* in_sizes, int n_in, void* d_out, int out_size, void* d_ws, size_t ws_size, hipStream_t stream) {
    static int grid_blocks = 0;
    if (!grid_blocks) {
        int dev = 0, cus = 0, per_cu = 0;
        (void)hipGetDevice(&dev);
        (void)hipDeviceGetAttribute(&cus, hipDeviceAttributeMultiprocessorCount, dev);
        (void)hipFuncSetAttribute((const void*)fwd_megakernel, hipFuncAttributeMaxDynamicSharedMemorySize, LDS_BYTES);
        (void)hipOccupancyMaxActiveBlocksPerMultiprocessor(&per_cu, (const void*)fwd_megakernel, 512, LDS_BYTES);
        if (per_cu < 1) { fprintf(stderr, "occupancy query says %d blocks/CU\n", per_cu); per_cu = 1; }
        grid_blocks = cus;
    }
    Params p{};
    for (int i = 0; i < N_IN; ++i) p.in[i] = (const float*)d_in[i];
    p.out = (float*)d_out; p.ws = (unsigned char*)d_ws;
    (void)hipMemsetAsync((char*)d_ws + WS_CTR, 0, (WS_BAR - WS_CTR) + XCD_BAR_WORDS * 4, stream);
    void* args[] = {&p};
    hipError_t e = hipLaunchCooperativeKernel((const void*)fwd_megakernel, dim3(grid_blocks), dim3(512), args, LDS_BYTES, stream);
    if (e != hipSuccess) fprintf(stderr, "cooperative launch failed: %s (grid %d)\n", hipGetErrorString(e), grid_blocks);
}
```

```cpp
#include <hip/hip_runtime.h>
#include <hip/hip_cooperative_groups.h>
#include <cstdio>
namespace cg = cooperative_groups;

#define LAS __attribute__((address_space(3)))
typedef unsigned short bf16_t;
typedef short bf16x8 __attribute__((ext_vector_type(8)));
typedef float f32x4 __attribute__((ext_vector_type(4)));
typedef unsigned u32x4 __attribute__((ext_vector_type(4)));
typedef unsigned u32x2 __attribute__((ext_vector_type(2)));
typedef float f32x16 __attribute__((ext_vector_type(16)));
typedef float f32x2 __attribute__((ext_vector_type(2)));
typedef __bf16 nbf16x2 __attribute__((ext_vector_type(2)));

constexpr int T = 16384, D = 1024, SEQ = 2048, NB = 8, FF = 2816, NIN = 5632, INW = 5640, NMOD = 9216;
constexpr int C_QSB = 0, C_KSB = 512, C_VSB = 1024, C_QDN = 1536, C_KDN = 2048, C_VDN = 2560, C_ZDN = 3072, C_RSB = 3584, C_RDN = 4608;
constexpr float EPS = 1e-6f;
constexpr int LDS_BYTES = 163840, BST_OFF = LDS_BYTES - 64;
constexpr size_t MiB = 1024 * 1024;
constexpr size_t WS_MOD = 0, WS_BG = 512 * 1024, WS_SS = 242 * MiB, WS_W = 2 * MiB;
constexpr size_t W_FFIN = WS_W, W_FFOUT = W_FFIN + (size_t)2 * FF * D * 2, W_IN = W_FFOUT + (size_t)D * FF * 2, W_UPSB = W_IN + (size_t)NIN * D * 2,
                 W_UPDN = W_UPSB + (size_t)D * 512 * 2, W_OUT = W_UPDN + (size_t)D * 512 * 2, W_END = W_OUT + (size_t)D * D * 2;
constexpr size_t WS_U = 34 * MiB, WS_P = 66 * MiB;
static_assert(W_END <= WS_U, "weights overflow");
constexpr size_t WS_EGL = 384 * 1024, WS_CTR = 400 * 1024, WS_BAR = 416 * 1024;
constexpr size_t WS_VT = W_FFIN;
static_assert((size_t)T * 512 * 2 <= W_IN - W_FFIN, "Vt overflow");

enum { I_X = 0, I_C, I_WADA, I_BADA, I_GFFN1, I_WFFN1IN, I_WFFN1OUT, I_GMIX, I_WIN, I_GQSB, I_GKSB, I_WCONV, I_ALOG, I_DTBIAS, I_GDNOUT, I_WUPSB, I_WUPDN, I_WOUT, I_GFFN2, I_WFFN2IN, I_WFFN2OUT, N_IN };
struct Params { const float* in[N_IN]; float* out; unsigned char* ws; };

__device__ __forceinline__ float bf_lo(unsigned w) { return __uint_as_float(w << 16); }
__device__ __forceinline__ float bf_hi(unsigned w) { return __uint_as_float(w & 0xffff0000u); }
__device__ __forceinline__ float bf2f(bf16_t b) { return __uint_as_float(((unsigned)b) << 16); }
__device__ __forceinline__ unsigned pk2(float lo, float hi) { unsigned r; asm("v_cvt_pk_bf16_f32 %0, %1, %2" : "=v"(r) : "v"(lo), "v"(hi)); return r; }
__device__ __forceinline__ unsigned cpk2(float lo, float hi) { const f32x2 v = {lo, hi}; return __builtin_bit_cast(unsigned, __builtin_convertvector(v, nbf16x2)); }
__device__ __forceinline__ bf16_t f2bf(float f) { return (bf16_t)(pk2(f, 0.f) & 0xffffu); }
__device__ __forceinline__ float fexp(float x) { return __builtin_amdgcn_exp2f(x * 1.4426950408889634f); }
__device__ __forceinline__ float flog(float x) { return __builtin_amdgcn_logf(x) * 0.6931471805599453f; }
__device__ __forceinline__ float fsigmoid(float x) { return __builtin_amdgcn_rcpf(1.f + fexp(-x)); }
__device__ __forceinline__ float fsilu(float x) { return x * fsigmoid(x); }
__device__ __forceinline__ float fsoftplus(float x) { return fmaxf(x, 0.f) + flog(1.f + fexp(-fabsf(x))); }
__device__ __forceinline__ float wave_sum(float v) {
#pragma unroll
    for (int o = 1; o < 64; o <<= 1) v += __shfl_xor(v, o);
    return v;
}
#define LDS_WAIT() asm volatile("s_waitcnt lgkmcnt(0)" ::: "memory")

namespace pg8 {
constexpr int BM = 256, BK = 64, HALF = 128, HTB = HALF * BK * 2, STAGE_BYTES = 8 * HTB, NXCD = 8, WGM = 8;
__host__ __device__ __forceinline__ int lds_byte(int r, int c) { const int st = (r >> 4) * 2 + (c >> 5), rr = r & 15, cc = c & 31, ob = rr * 64 + cc * 2; return st * 1024 + (ob ^ (((ob >> 9) & 1) << 5)); }
__host__ __device__ __forceinline__ void stage_rc(int b, int& R, int& C) { const int st = b / 1024, sb = b % 1024, swz = sb ^ (((sb >> 9) & 1) << 5); R = (st >> 1) * 16 + swz / 64; C = (st & 1) * 32 + (swz % 64) / 2; }
__host__ __device__ __forceinline__ int perm32(int rho) { const int n = rho >> 4, i = rho & 15; return 8 * (i >> 2) + 4 * n + (i & 3); }
struct Unit { int pm, pn; };
struct Gemm { const bf16_t* A; const bf16_t* Bt; int M, N, K, lda; int jt; int jbytes; };
struct StaticOrder {
    int nM, nN, nwg, G, c;
    __host__ __device__ void init(int M, int N, int G_, int c_) { nM = M / BM; nN = N / BM; nwg = nM * nN; G = G_; c = c_; }
    __host__ __device__ bool next(int i, Unit& u) const {
        const long L = (long)i * G + c; if (L >= nwg) return false;
        int wgid = (int)L; { const int q = nwg / NXCD, r = nwg % NXCD, xcd = wgid % NXCD, off = wgid / NXCD; wgid = (xcd < r ? xcd * (q + 1) : r * (q + 1) + (xcd - r) * q) + off; }
        const int nig = WGM * nN, gid = wgid / nig, fm = gid * WGM, gsz = (nM - fm) < WGM ? (nM - fm) : WGM;
        u.pm = fm + ((wgid % nig) % gsz); u.pn = (wgid % nig) / gsz; return true;
    }
};
template <class Epi>
__device__ __forceinline__ void gemm_phase(LAS unsigned char* lds, const Gemm g, const StaticOrder& S, const Epi& E) {
    int tid = threadIdx.x; asm volatile("" : "+v"(tid));
    const int wid = __builtin_amdgcn_readfirstlane(tid >> 6), lane = tid & 63, wr = wid >> 2, wc = wid & 3, fr = lane & 15, fq = lane >> 4;
    const int K = g.K, nt = K / BK, lda = g.lda;
    unsigned voffA[2], voffB[2];
#pragma unroll
    for (int i = 0; i < 2; ++i) { int R, C; stage_rc(tid * 16 + i * 8192, R, C); const int Rb = Epi::PERM ? ((R & ~31) + perm32(R & 31)) : R;
        voffA[i] = (unsigned)(R * lda + C) * 2u; voffB[i] = (unsigned)(Rb * K + C) * 2u; }
    const size_t kstep = (size_t)(BK * 2);
    const size_t hstepA = (size_t)HALF * lda * 2, hstepB = (size_t)HALF * K * 2;
    const size_t tstepA = 2 * hstepA, tstepB = 2 * hstepB;
    const unsigned ldsw = (unsigned)wid * 1024u;
    const int aoff = lds_byte(wr * 64 + fr, fq * 8), boff = lds_byte(wc * 32 + fr, fq * 8);
#define PG8_SA(b, h) (((b) * 2 + (h)) * HTB)
#define PG8_SB(b, h) ((4 + (b) * 2 + (h)) * HTB)
#define PG8_STAGE(bufoff, gbase, voff) do { _Pragma("unroll") for (int _i = 0; _i < 2; ++_i) \
        __builtin_amdgcn_global_load_lds((const unsigned*)((const char*)(gbase) + (voff)[_i]), (LAS unsigned*)(lds + (bufoff) + ldsw + _i * 8192), 16, 0, 0); } while (0)
#define PG8_LDA(dst, b, h) do { _Pragma("unroll") for (int m = 0; m < 4; ++m) _Pragma("unroll") for (int k = 0; k < 2; ++k) dst[m][k] = *(const LAS bf16x8*)(lds + PG8_SA(b, h) + aoff + m * 2048 + k * 1024); } while (0)
#define PG8_LDB(dst, b, h) do { _Pragma("unroll") for (int n = 0; n < 2; ++n) _Pragma("unroll") for (int k = 0; k < 2; ++k) dst[n][k] = *(const LAS bf16x8*)(lds + PG8_SB(b, h) + boff + n * 2048 + k * 1024); } while (0)
#define PG8_MMA(ai, bj, At, Bt) do { __builtin_amdgcn_s_setprio(1); _Pragma("unroll") for (int m = 0; m < 4; ++m) _Pragma("unroll") for (int n = 0; n < 2; ++n) _Pragma("unroll") for (int k = 0; k < 2; ++k) \
        acc[ai][bj][m][n] = __builtin_amdgcn_mfma_f32_16x16x32_bf16(Bt[n][k], At[m][k], acc[ai][bj][m][n], 0, 0, 0); __builtin_amdgcn_s_setprio(0); } while (0)
#define PG8_WAIT_V(n) asm volatile("s_waitcnt vmcnt(" #n ")" ::: "memory")
#define PG8_WAIT_L(n) asm volatile("s_waitcnt lgkmcnt(" #n ")" ::: "memory")
#define PG8_BAR __builtin_amdgcn_s_barrier()
#define PG8_SCHED __builtin_amdgcn_sched_barrier(0)
    Unit cur, nxt; int ui = 0;
    if (!S.next(0, cur)) return;
    f32x4 acc[2][2][4][2];
#pragma unroll
    for (int a = 0; a < 2; ++a)
#pragma unroll
        for (int b = 0; b < 2; ++b)
#pragma unroll
            for (int m = 0; m < 4; ++m)
#pragma unroll
                for (int n = 0; n < 2; ++n) acc[a][b][m][n] = (f32x4){0.f, 0.f, 0.f, 0.f};
    bf16x8 At[4][2], B0[2][2], B1[2][2];
    const char* cA = (const char*)g.A + (size_t)cur.pm * tstepA; const char* cB = (const char*)g.Bt + (size_t)cur.pn * tstepB;
    PG8_STAGE(PG8_SB(0, 0), cB, voffB); PG8_STAGE(PG8_SA(0, 0), cA, voffA); PG8_STAGE(PG8_SB(0, 1), cB + hstepB, voffB); PG8_STAGE(PG8_SA(0, 1), cA + hstepA, voffA);
    if (wr == 1) PG8_BAR;
    PG8_WAIT_V(4); PG8_BAR;
    PG8_STAGE(PG8_SB(1, 0), cB + kstep, voffB); PG8_STAGE(PG8_SA(1, 0), cA + kstep, voffA); PG8_STAGE(PG8_SB(1, 1), cB + hstepB + kstep, voffB);
    PG8_WAIT_V(6); PG8_BAR;
    for (;;) {
        const bool has_next = S.next(ui + 1, nxt);
        const char* nA = has_next ? (const char*)g.A + (size_t)nxt.pm * tstepA : cA; const char* nB = has_next ? (const char*)g.Bt + (size_t)nxt.pn * tstepB : cB;
        for (int t = 0; t < nt; t += 2) {
            const bool last = (t == nt - 2);
            const char* a1 = cA + (size_t)(t + 1) * kstep + (t + 1 >= g.jt ? g.jbytes : 0);
            const char* a2 = last ? nA : cA + (size_t)(t + 2) * kstep + (t + 2 >= g.jt ? g.jbytes : 0); const char* b2 = last ? nB : cB + (size_t)(t + 2) * kstep;
            const char* a3 = a2 + kstep; const char* b3 = b2 + kstep;
            if constexpr (Epi::HAS_MID) { if (t == g.jt) E.mid(acc, cur, wr, wc, fr, fq); }
            PG8_LDB(B0, 0, 0); PG8_SCHED; PG8_LDA(At, 0, 0); PG8_STAGE(PG8_SA(1, 1), a1 + hstepA, voffA);
            PG8_WAIT_L(8); PG8_BAR; PG8_WAIT_L(0); PG8_MMA(0, 0, At, B0); PG8_BAR; PG8_SCHED;
            PG8_LDB(B1, 0, 1); PG8_STAGE(PG8_SB(0, 0), b2, voffB);
            PG8_BAR; PG8_WAIT_L(0); PG8_MMA(0, 1, At, B1); PG8_BAR;
            PG8_LDA(At, 0, 1); PG8_STAGE(PG8_SA(0, 0), a2, voffA);
            PG8_BAR; PG8_WAIT_L(0); PG8_MMA(1, 0, At, B0); PG8_BAR; PG8_SCHED;
            PG8_STAGE(PG8_SB(0, 1), b2 + hstepB, voffB);
            PG8_WAIT_V(6); PG8_BAR; PG8_MMA(1, 1, At, B1); PG8_BAR;
            PG8_LDB(B0, 1, 0); PG8_SCHED; PG8_LDA(At, 1, 0); PG8_STAGE(PG8_SA(0, 1), a2 + hstepA, voffA);
            PG8_WAIT_L(8); PG8_BAR; PG8_WAIT_L(0); PG8_MMA(0, 0, At, B0); PG8_BAR; PG8_SCHED;
            PG8_LDB(B1, 1, 1); PG8_STAGE(PG8_SB(1, 0), b3, voffB);
            PG8_BAR; PG8_WAIT_L(0); PG8_MMA(0, 1, At, B1); PG8_BAR;
            PG8_LDA(At, 1, 1); PG8_STAGE(PG8_SA(1, 0), a3, voffA);
            PG8_BAR; PG8_WAIT_L(0); PG8_MMA(1, 0, At, B0); PG8_BAR; PG8_SCHED;
            PG8_STAGE(PG8_SB(1, 1), b3 + hstepB, voffB);
            PG8_WAIT_V(6); PG8_BAR; PG8_MMA(1, 1, At, B1); PG8_BAR;
        }
        E(acc, cur, wr, wc, fr, fq);
        if (!has_next) break;
#pragma unroll
        for (int a = 0; a < 2; ++a)
#pragma unroll
            for (int b = 0; b < 2; ++b)
#pragma unroll
                for (int m = 0; m < 4; ++m)
#pragma unroll
                    for (int n = 0; n < 2; ++n) acc[a][b][m][n] = (f32x4){0.f, 0.f, 0.f, 0.f};
        cur = nxt; cA = nA; cB = nB; ++ui;
    }
    PG8_WAIT_V(0);
    if (wr == 0) PG8_BAR;
    PG8_BAR;
#undef PG8_SA
#undef PG8_SB
#undef PG8_STAGE
#undef PG8_LDA
#undef PG8_LDB
#undef PG8_MMA
#undef PG8_WAIT_V
#undef PG8_WAIT_L
#undef PG8_BAR
#undef PG8_SCHED
}
}

typedef const f32x4 (&AccRef)[2][2][4][2];
struct EpiBf16 {
    static constexpr bool PERM = true, HAS_MID = false;
    bf16_t* O; int ldc;
    __device__ __forceinline__ void operator()(AccRef acc, const pg8::Unit& u, int wr, int wc, int fr, int fq) const {
        const int row0 = u.pm * 256 + wr * 64 + fr, col0 = u.pn * 256 + wc * 32 + 8 * fq;
#pragma unroll
        for (int ai = 0; ai < 2; ++ai)
#pragma unroll
            for (int m = 0; m < 4; ++m) { bf16_t* rowp = O + (size_t)(row0 + ai * 128 + m * 16) * ldc + col0;
#pragma unroll
                for (int bj = 0; bj < 2; ++bj) { const f32x4 v0 = acc[ai][bj][m][0], v1 = acc[ai][bj][m][1];
                    u32x4 w; w.x = pk2(v0[0], v0[1]); w.y = pk2(v0[2], v0[3]); w.z = pk2(v1[0], v1[1]); w.w = pk2(v1[2], v1[3]);
                    *(u32x4*)(rowp + bj * 128) = w; } }
    }
};
struct EpiSwiGLU {
    static constexpr bool PERM = true, HAS_MID = false;
    bf16_t* O; int ldc;
    __device__ __forceinline__ void operator()(AccRef acc, const pg8::Unit& u, int wr, int wc, int fr, int fq) const {
        const int row0 = u.pm * 256 + wr * 64 + fr, col0 = u.pn * 128 + wc * 32 + 8 * fq;
#pragma unroll
        for (int ai = 0; ai < 2; ++ai)
#pragma unroll
            for (int m = 0; m < 4; ++m) { bf16_t* rowp = O + (size_t)(row0 + ai * 128 + m * 16) * ldc + col0;
                float r[8];
#pragma unroll
                for (int n = 0; n < 2; ++n)
#pragma unroll
                    for (int j = 0; j < 4; ++j) { const float a = acc[ai][0][m][n][j], b = acc[ai][1][m][n][j]; r[n * 4 + j] = fsilu(a) * b; }
                u32x4 w; w.x = pk2(r[0], r[1]); w.y = pk2(r[2], r[3]); w.z = pk2(r[4], r[5]); w.w = pk2(r[6], r[7]);
                *(u32x4*)rowp = w; }
    }
};
struct EpiResid {
    static constexpr bool PERM = false, HAS_MID = false;
    const float* base; float* out; const float* gate; float scale;
    __device__ __forceinline__ void operator()(AccRef acc, const pg8::Unit& u, int wr, int wc, int fr, int fq) const {
        const int row0 = u.pm * 256 + wr * 64 + fr, col0 = u.pn * 256 + wc * 32 + 4 * fq;
        const float* gp = gate + (size_t)(u.pm >> 3) * NMOD + col0;
        f32x4 gv[2][2];
#pragma unroll
        for (int bj = 0; bj < 2; ++bj)
#pragma unroll
            for (int n = 0; n < 2; ++n) gv[bj][n] = *(const f32x4*)(gp + bj * 128 + n * 16) * scale;
#pragma unroll
        for (int ai = 0; ai < 2; ++ai) {
            f32x4 bs[4][2][2];
#pragma unroll
            for (int m = 0; m < 4; ++m) { const size_t off = (size_t)(row0 + ai * 128 + m * 16) * D + col0;
#pragma unroll
                for (int bj = 0; bj < 2; ++bj)
#pragma unroll
                    for (int n = 0; n < 2; ++n) bs[m][bj][n] = *(const f32x4*)(base + off + bj * 128 + n * 16); }
#pragma unroll
            for (int m = 0; m < 4; ++m) { const size_t off = (size_t)(row0 + ai * 128 + m * 16) * D + col0;
#pragma unroll
                for (int bj = 0; bj < 2; ++bj)
#pragma unroll
                    for (int n = 0; n < 2; ++n) *(f32x4*)(out + off + bj * 128 + n * 16) = bs[m][bj][n] + gv[bj][n] * acc[ai][bj][m][n]; }
            asm volatile("" ::: "memory"); }
    }
};
struct EpiGateFused {
    static constexpr bool PERM = true, HAS_MID = true;
    const bf16_t* Rsb; const bf16_t* Rdn; bf16_t* O;
    __device__ __forceinline__ void mid(f32x4 (&acc)[2][2][4][2], const pg8::Unit& u, int wr, int wc, int fr, int fq) const {
        int row0 = u.pm * 256 + wr * 64 + fr, col0 = u.pn * 256 + wc * 32 + 8 * fq;
        asm volatile("" : "+v"(row0), "+v"(col0));
#pragma unroll
        for (int ai = 0; ai < 2; ++ai)
#pragma unroll
            for (int mp = 0; mp < 2; ++mp) {
                u32x4 av[2][2], dv[2][2];
#pragma unroll
                for (int mm = 0; mm < 2; ++mm)
#pragma unroll
                    for (int bj = 0; bj < 2; ++bj) { const size_t row = (size_t)(row0 + ai * 128 + (2 * mp + mm) * 16);
                        av[mm][bj] = *(const u32x4*)(Rsb + row * NIN + col0 + bj * 128); dv[mm][bj] = *(const u32x4*)(Rdn + row * NIN + col0 + bj * 128); }
#pragma unroll
                for (int mm = 0; mm < 2; ++mm)
#pragma unroll
                    for (int bj = 0; bj < 2; ++bj) { const int m = 2 * mp + mm; const u32x4 a = av[mm][bj], d = dv[mm][bj];
                        const float ra[8] = {bf_lo(a.x), bf_hi(a.x), bf_lo(a.y), bf_hi(a.y), bf_lo(a.z), bf_hi(a.z), bf_lo(a.w), bf_hi(a.w)};
                        const float rd[8] = {bf_lo(d.x), bf_hi(d.x), bf_lo(d.y), bf_hi(d.y), bf_lo(d.z), bf_hi(d.z), bf_lo(d.w), bf_hi(d.w)};
#pragma unroll
                        for (int e = 0; e < 8; ++e) { const float q = (1.0f + fexp(fminf(-rd[e], 30.0f))) * __builtin_amdgcn_rcpf(1.0f + fexp(-ra[e])); acc[ai][bj][m][e >> 2][e & 3] *= q; } }
                asm volatile("" ::: "memory"); }
    }
    __device__ __forceinline__ void operator()(AccRef acc, const pg8::Unit& u, int wr, int wc, int fr, int fq) const {
        const int row0 = u.pm * 256 + wr * 64 + fr, col0 = u.pn * 256 + wc * 32 + 8 * fq;
#pragma unroll
        for (int ai = 0; ai < 2; ++ai) {
            u32x4 dv[4][2];
#pragma unroll
            for (int m = 0; m < 4; ++m)
#pragma unroll
                for (int bj = 0; bj < 2; ++bj) dv[m][bj] = *(const u32x4*)(Rdn + (size_t)(row0 + ai * 128 + m * 16) * NIN + col0 + bj * 128);
#pragma unroll
            for (int m = 0; m < 4; ++m) { const size_t row = (size_t)(row0 + ai * 128 + m * 16);
#pragma unroll
                for (int bj = 0; bj < 2; ++bj) { const u32x4 d = dv[m][bj];
                    const f32x4 v0 = acc[ai][bj][m][0], v1 = acc[ai][bj][m][1];
#define SGC(x) __builtin_amdgcn_rcpf(1.0f + fexp(fminf(-(x), 30.0f)))
                    const float r[8] = {SGC(bf_lo(d.x)) * v0[0], SGC(bf_hi(d.x)) * v0[1], SGC(bf_lo(d.y)) * v0[2], SGC(bf_hi(d.y)) * v0[3],
                                        SGC(bf_lo(d.z)) * v1[0], SGC(bf_hi(d.z)) * v1[1], SGC(bf_lo(d.w)) * v1[2], SGC(bf_hi(d.w)) * v1[3]};
#undef SGC
                    u32x4 w; w.x = pk2(r[0], r[1]); w.y = pk2(r[2], r[3]); w.z = pk2(r[4], r[5]); w.w = pk2(r[6], r[7]);
                    *(u32x4*)(O + row * D + col0 + bj * 128) = w; } } }
    }
};
template <class Epi> __device__ __forceinline__ void run_gemm(LAS unsigned char* lds, const bf16_t* A, int lda, const bf16_t* Bt, int N, int K, const Epi& E, int jt = 1 << 30, int jbytes = 0) {
    pg8::Gemm g{A, Bt, T, N, K, lda, jt, jbytes}; pg8::StaticOrder S; S.init(T, N, (int)gridDim.x, (int)blockIdx.x);
    pg8::gemm_phase<Epi>(lds, g, S, E);
}

__device__ __forceinline__ void transpose_item(const float* W, int ldw, int s0, int k0, bf16_t* WT, int ldk, int d0, LAS float* scr, int lane) {
    float tv[32];
#pragma unroll
    for (int i = 0; i < 32; ++i) tv[i] = W[(size_t)(k0 + 2 * i + (lane >> 5)) * ldw + s0 + (lane & 31)];
#pragma unroll
    for (int i = 0; i < 32; ++i) scr[(2 * i + (lane >> 5)) * 33 + (lane & 31)] = tv[i];
    LDS_WAIT();
    const int c = lane & 7;
#pragma unroll
    for (int j = 0; j < 4; ++j) { const int n = (lane >> 3) + 8 * j; const LAS float* s = scr + (8 * c) * 33 + n;
        u32x4 o; o.x = pk2(s[0 * 33], s[1 * 33]); o.y = pk2(s[2 * 33], s[3 * 33]); o.z = pk2(s[4 * 33], s[5 * 33]); o.w = pk2(s[6 * 33], s[7 * 33]);
        *(u32x4*)(WT + (size_t)(d0 + n) * ldk + k0 + 8 * c) = o; }
    LDS_WAIT();
}
struct TrD { const float* W; int ldw, s0, k0; bf16_t* WT; int ldk, d0; };
__device__ __forceinline__ TrD ffn_item_desc(const float* w_in, const float* w_out, bf16_t* wt_in, bf16_t* wt_out, int it) {
    if (it < 2816) { const int kb = it / 176, nb = it % 176, d0 = nb * 32, pn = d0 >> 8, bj = (d0 >> 7) & 1, c = d0 & 127, s0 = bj * FF + pn * 128 + c; return TrD{w_in, 2 * FF, s0, kb * 64, wt_in, D, d0}; }
    const int r = it - 2816, kb = r / 32, nb = r % 32; return TrD{w_out, D, nb * 32, kb * 64, wt_out, FF, nb * 32};
}
__device__ __forceinline__ void ffn_weight_items(const float* w_in, const float* w_out, bf16_t* wt_in, bf16_t* wt_out, LAS float* scr, int gw, int ngw, int lane) {
    constexpr int NIT = 2816 + 1408;
    float tv[32];
#define TR_LOAD(d_) do { _Pragma("unroll") for (int i = 0; i < 32; ++i) tv[i] = (d_).W[(size_t)((d_).k0 + 2 * i + (lane >> 5)) * (d_).ldw + (d_).s0 + (lane & 31)]; } while (0)
    if (gw < NIT) { const TrD d0_ = ffn_item_desc(w_in, w_out, wt_in, wt_out, gw); TR_LOAD(d0_); }
    for (int it = gw; it < NIT; it += ngw) {
        const TrD d = ffn_item_desc(w_in, w_out, wt_in, wt_out, it);
#pragma unroll
        for (int i = 0; i < 32; ++i) scr[(2 * i + (lane >> 5)) * 33 + (lane & 31)] = tv[i];
        LDS_WAIT();
        if (it + ngw < NIT) { const TrD dn = ffn_item_desc(w_in, w_out, wt_in, wt_out, it + ngw); TR_LOAD(dn); }
        const int c = lane & 7;
#pragma unroll
        for (int j = 0; j < 4; ++j) { const int n = (lane >> 3) + 8 * j; const LAS float* s_ = scr + (8 * c) * 33 + n;
            u32x4 o; o.x = pk2(s_[0 * 33], s_[1 * 33]); o.y = pk2(s_[2 * 33], s_[3 * 33]); o.z = pk2(s_[4 * 33], s_[5 * 33]); o.w = pk2(s_[6 * 33], s_[7 * 33]);
            *(u32x4*)(d.WT + (size_t)(d.d0 + n) * d.ldk + d.k0 + 8 * c) = o; }
        LDS_WAIT();
    }
#undef TR_LOAD
}
__device__ __forceinline__ void mixer_weight_items(const Params& p, LAS float* scr, int gw, int ngw, int lane) {
    unsigned char* ws = p.ws;
    for (int it = gw; it < 2816 + 256 + 256 + 512; it += ngw) {
        int r = it;
        if (r < 2816) { const int kb = r / 176, nb = r % 176, d0 = nb * 32, s0 = d0 < C_RSB ? d0 : d0 + 8; transpose_item(p.in[I_WIN], INW, s0, kb * 64, (bf16_t*)(ws + W_IN), D, d0, scr, lane); continue; } r -= 2816;
        if (r < 256) { const int kb = r / 32, nb = r % 32; transpose_item(p.in[I_WUPSB], D, nb * 32, kb * 64, (bf16_t*)(ws + W_UPSB), D, nb * 32, scr, lane); continue; } r -= 256;
        if (r < 256) { const int kb = r / 32, nb = r % 32; transpose_item(p.in[I_WUPDN], D, nb * 32, kb * 64, (bf16_t*)(ws + W_UPSB) + 512, D, nb * 32, scr, lane); continue; } r -= 256;
        { const int kb = r / 32, nb = r % 32; transpose_item(p.in[I_WOUT], D, nb * 32, kb * 64, (bf16_t*)(ws + W_OUT), D, nb * 32, scr, lane); }
    }
}
__device__ __forceinline__ void mod_item(const Params& p, LAS unsigned char* lds, int cb, int tid, int wave, int lane) {
    asm volatile("" : "+v"(tid), "+v"(lane));
    LAS float* sc = (LAS float*)lds; LAS float* red = (LAS float*)(lds + 32768);
    for (int i = tid; i < NB * D; i += 512) sc[i] = fsilu(p.in[I_C][i]);
    __syncthreads();
    const float* wa = p.in[I_WADA] + cb * 64 + lane;
    float acc[NB];
#pragma unroll
    for (int b = 0; b < NB; ++b) acc[b] = 0.f;
    for (int k = wave * 128; k < wave * 128 + 128; k += 32) {
        float w[32];
#pragma unroll
        for (int e = 0; e < 32; ++e) w[e] = wa[(size_t)(k + e) * NMOD];
#pragma unroll
        for (int b = 0; b < NB; ++b)
#pragma unroll
            for (int e4 = 0; e4 < 8; ++e4) { const f32x4 s = *(const LAS f32x4*)(sc + b * D + k + 4 * e4); acc[b] += s[0] * w[4 * e4] + s[1] * w[4 * e4 + 1] + s[2] * w[4 * e4 + 2] + s[3] * w[4 * e4 + 3]; }
    }
#pragma unroll
    for (int b = 0; b < NB; ++b) red[(wave * NB + b) * 64 + lane] = acc[b];
    __syncthreads();
    { const int b = tid >> 6; float s = p.in[I_BADA][cb * 64 + lane];
#pragma unroll
        for (int w = 0; w < 8; ++w) s += red[(w * NB + b) * 64 + lane];
        ((float*)(p.ws + WS_MOD))[b * NMOD + cb * 64 + lane] = s; }
    __syncthreads();
}

template <bool DN>
__device__ __forceinline__ void norm_mod_phase(const Params& p, LAS unsigned char* lds, const float* src, const float* gain, int midx, bf16_t* dst, int tid, int wave, int lane) {
    asm volatile("" : "+v"(tid), "+v"(lane));
    const float* mod = (const float*)(p.ws + WS_MOD);
    LAS float* wl = (LAS float*)lds;
    if (DN) { for (int i = tid; i < D * 8; i += 512) { const int k = i >> 3, j = i & 7; wl[8 * k + 4 * (k >> 2) + j] = p.in[I_WIN][(size_t)k * INW + C_RSB + j]; } __syncthreads(); }
    f32x4 g4[4];
#pragma unroll
    for (int j = 0; j < 4; ++j) g4[j] = ((const f32x4*)gain)[lane + 64 * j];
    const int rstep = gridDim.x * 8;
    f32x4 nv[4];
    { const int r0 = blockIdx.x * 8 + wave; const f32x4* xr = (const f32x4*)(src + (size_t)(r0 < T ? r0 : 0) * D) + lane;
#pragma unroll
      for (int j = 0; j < 4; ++j) nv[j] = xr[64 * j]; }
    for (int row = blockIdx.x * 8 + wave; row < T; row += rstep) {
        const int b = row >> 11;
        const f32x4* shp = (const f32x4*)(mod + (size_t)b * NMOD + midx * D) + lane; const f32x4* scp = shp + D / 4;
        f32x4 v[4], shv[4], scv[4]; float ss = 0.f;
#pragma unroll
        for (int j = 0; j < 4; ++j) { v[j] = nv[j]; shv[j] = shp[64 * j]; scv[j] = scp[64 * j]; }
        { const int rn = row + rstep < T ? row + rstep : row; const f32x4* xr = (const f32x4*)(src + (size_t)rn * D) + lane;
#pragma unroll
          for (int j = 0; j < 4; ++j) nv[j] = xr[64 * j]; }
#pragma unroll
        for (int j = 0; j < 4; ++j) ss += (v[j][0] * v[j][0] + v[j][1] * v[j][1]) + (v[j][2] * v[j][2] + v[j][3] * v[j][3]);
        const float rstd = 1.0f / sqrtf(wave_sum(ss) * (1.f / D) + EPS);
        u32x2* o8 = (u32x2*)(dst + (size_t)row * D) + lane;
        float dot[8];
        if (DN) {
#pragma unroll
            for (int e = 0; e < 8; ++e) dot[e] = 0.f; }
#pragma unroll
        for (int j = 0; j < 4; ++j) { const f32x4 sh = shv[j], sc = scv[j];
            const f32x4 uu = v[j] * rstd * g4[j] * (sc + 1.0f) + sh;
            u32x2 w; w.x = pk2(uu[0], uu[1]); w.y = pk2(uu[2], uu[3]); o8[64 * j] = w;
            if (DN) {
#pragma unroll
                for (int e = 0; e < 4; ++e) { const int k = 4 * lane + 256 * j + e; const LAS f32x4* wp = (const LAS f32x4*)(wl + 8 * k + 4 * (k >> 2)); const f32x4 w0 = wp[0], w1 = wp[1];
                    dot[0] += uu[e] * w0[0]; dot[1] += uu[e] * w0[1]; dot[2] += uu[e] * w0[2]; dot[3] += uu[e] * w0[3];
                    dot[4] += uu[e] * w1[0]; dot[5] += uu[e] * w1[1]; dot[6] += uu[e] * w1[2]; dot[7] += uu[e] * w1[3]; } } }
        if (DN) {
#pragma unroll
            for (int e = 0; e < 8; ++e) dot[e] = wave_sum(dot[e]);
            float mine = dot[0];
#pragma unroll
            for (int e = 1; e < 8; ++e) mine = (lane == e) ? dot[e] : mine;
            if (lane < 8) { float r;
                if (lane < 4) r = 1.0f / (1.0f + expf(-mine));
                else { const int hh = lane - 4; const float a = mine + p.in[I_DTBIAS][hh]; const float sp = a > 20.f ? a : log1pf(expf(a)); r = -expf(p.in[I_ALOG][hh]) * sp; }
                ((float*)(p.ws + WS_BG))[(size_t)row * 8 + lane] = r; } }
    }
    if (DN) __syncthreads();
}

__device__ __forceinline__ void unpack16(const bf16_t* p, float* f) {
    const u32x4 a = ((const u32x4*)p)[0], b = ((const u32x4*)p)[1];
    f[0] = bf_lo(a.x); f[1] = bf_hi(a.x); f[2] = bf_lo(a.y); f[3] = bf_hi(a.y); f[4] = bf_lo(a.z); f[5] = bf_hi(a.z); f[6] = bf_lo(a.w); f[7] = bf_hi(a.w);
    f[8] = bf_lo(b.x); f[9] = bf_hi(b.x); f[10] = bf_lo(b.y); f[11] = bf_hi(b.y); f[12] = bf_lo(b.z); f[13] = bf_hi(b.z); f[14] = bf_lo(b.w); f[15] = bf_hi(b.w);
}
__device__ __forceinline__ void pack16(bf16_t* p, const float* f) {
    u32x4 a, b; a.x = pk2(f[0], f[1]); a.y = pk2(f[2], f[3]); a.z = pk2(f[4], f[5]); a.w = pk2(f[6], f[7]); b.x = pk2(f[8], f[9]); b.y = pk2(f[10], f[11]); b.z = pk2(f[12], f[13]); b.w = pk2(f[14], f[15]);
    ((u32x4*)p)[0] = a; ((u32x4*)p)[1] = b;
}
__device__ __forceinline__ void prep_phase(const Params& p, int wave, int lane) {
    asm volatile("" : "+v"(lane));
    bf16_t* P = (bf16_t*)(p.ws + WS_P); bf16_t* U = (bf16_t*)(p.ws + WS_U);
    const int ch = 16 * lane;
    float gsb[16], wcv[4][16];
    { const float* gp = (ch < 512 ? p.in[I_GQSB] : p.in[I_GKSB]) + (ch & 63); const float sc = ch < 512 ? 0.18033688011112042f : 1.0f;
#pragma unroll
        for (int e = 0; e < 16; ++e) gsb[e] = gp[e] * sc;
#pragma unroll
        for (int i = 0; i < 4; ++i)
#pragma unroll
            for (int e = 0; e < 16; ++e) wcv[i][e] = p.in[I_WCONV][i * 1536 + ch + e]; }
    for (int row = blockIdx.x * 8 + wave; row < T; row += gridDim.x * 8) {
        const int tl = row & (SEQ - 1);
        { bf16_t* qp = P + (size_t)row * NIN + ch; float f[16]; unpack16(qp, f); float ss = 0.f;
#pragma unroll
            for (int e = 0; e < 16; ++e) ss += f[e] * f[e];
            ss += __shfl_xor(ss, 1); ss += __shfl_xor(ss, 2);
            const float rstd = 1.0f / sqrtf(ss * (1.f / 64.f) + EPS);
#pragma unroll
            for (int e = 0; e < 16; ++e) f[e] = f[e] * rstd * gsb[e];
            pack16(qp, f); }
        { float y[16];
#pragma unroll
            for (int e = 0; e < 16; ++e) y[e] = 0.f;
#pragma unroll
            for (int i = 0; i < 4; ++i) { if (tl - 3 + i >= 0) { float f[16]; unpack16(P + (size_t)(row - 3 + i) * NIN + C_QDN + ch, f);
#pragma unroll
                    for (int e = 0; e < 16; ++e) y[e] += wcv[i][e] * f[e]; } }
            float ss = 0.f;
#pragma unroll
            for (int e = 0; e < 16; ++e) { y[e] = fsilu(y[e]); ss += y[e] * y[e]; }
            ss += __shfl_xor(ss, 1); ss += __shfl_xor(ss, 2); ss += __shfl_xor(ss, 4);
            const float sc = (1.0f / sqrtf(ss + EPS)) * (ch < 512 ? 0.08838834764831845f : 1.0f);
#pragma unroll
            for (int e = 0; e < 16; ++e) y[e] *= sc;
            pack16(U + (size_t)row * D + ch, y); }
    }
    bf16_t* Vt = (bf16_t*)(p.ws + WS_VT);
    for (int it = blockIdx.x * 8 + wave; it < T / 16; it += gridDim.x * 8) {
        const int row0 = it * 16, b = row0 >> 11, tl0 = row0 & (SEQ - 1), c8 = lane * 8, hd = c8 >> 6, d0 = c8 & 63;
        u32x4 w[16];
#pragma unroll
        for (int r = 0; r < 16; ++r) w[r] = *(const u32x4*)(P + (size_t)(row0 + r) * NIN + C_VSB + c8);
#pragma unroll
        for (int e = 0; e < 8; ++e) {
            unsigned o[8];
#pragma unroll
            for (int i = 0; i < 8; ++i) {
                const int p0 = 2 * i, p1 = 2 * i + 1;
                const int k0 = 8 * ((p0 >> 2) & 1) + 4 * (p0 >> 3) + (p0 & 3), k1 = 8 * ((p1 >> 2) & 1) + 4 * (p1 >> 3) + (p1 & 3);
                const unsigned a0 = w[k0][e >> 1], a1 = w[k1][e >> 1];
                const unsigned lo = (e & 1) ? (a0 >> 16) : (a0 & 0xffffu), hi = (e & 1) ? (a1 & 0xffff0000u) : (a1 << 16);
                o[i] = lo | hi; }
            bf16_t* dst = Vt + ((size_t)(b * 8 + hd) * 64 + d0 + e) * SEQ + tl0;
            ((u32x4*)dst)[0] = (u32x4){o[0], o[1], o[2], o[3]}; ((u32x4*)dst)[1] = (u32x4){o[4], o[5], o[6], o[7]}; }
    }
}

__device__ __forceinline__ float xlane32(float x, int hh) {
    const unsigned xi = __builtin_bit_cast(unsigned, x);
    const u32x2 r = __builtin_amdgcn_permlane32_swap(xi, xi, false, false);
    return __builtin_bit_cast(float, hh ? r.x : r.y);
}
template <bool DIAG>
__device__ __forceinline__ void attn_tile(const f32x16& z, const bf16x8 (&vc)[4], f32x16& o0, f32x16& o1, float& R, int ql, int hh) {
    float sg[16], m[16];
#pragma unroll
    for (int i = 0; i < 16; ++i) { const float e = __builtin_amdgcn_exp2f(fminf(-z[i], 80.0f)); float sig = __builtin_amdgcn_rcpf(1.0f + e); float mm = e * sig;
        if (DIAG) { const bool act = ((i & 3) + 8 * (i >> 2) + 4 * hh) < ql; sig = act ? sig : 0.f; mm = act ? mm : 1.0f; }
        sg[i] = sig; m[i] = mm; }
    float g[4], gp[4];
#pragma unroll
    for (int bq = 0; bq < 4; ++bq) { g[bq] = (m[4 * bq] * m[4 * bq + 1]) * (m[4 * bq + 2] * m[4 * bq + 3]); gp[bq] = xlane32(g[bq], hh); }
    float outer[4]; float tb = R;
#pragma unroll
    for (int bq = 3; bq >= 0; --bq) { outer[bq] = hh == 0 ? tb * gp[bq] : tb; tb *= g[bq] * gp[bq]; }
    R = tb;
    float w[16];
#pragma unroll
    for (int bq = 0; bq < 4; ++bq) { const float s3 = outer[bq], s2 = s3 * m[4 * bq + 3], s1 = s2 * m[4 * bq + 2], s0 = s1 * m[4 * bq + 1];
        w[4 * bq + 3] = sg[4 * bq + 3] * s3; w[4 * bq + 2] = sg[4 * bq + 2] * s2; w[4 * bq + 1] = sg[4 * bq + 1] * s1; w[4 * bq] = sg[4 * bq] * s0; }
    bf16x8 wf[2];
#pragma unroll
    for (int s2 = 0; s2 < 2; ++s2) { const u32x4 pw = {cpk2(w[8 * s2], w[8 * s2 + 1]), cpk2(w[8 * s2 + 2], w[8 * s2 + 3]), cpk2(w[8 * s2 + 4], w[8 * s2 + 5]), cpk2(w[8 * s2 + 6], w[8 * s2 + 7])}; wf[s2] = __builtin_bit_cast(bf16x8, pw); }
    o0 = __builtin_amdgcn_mfma_f32_32x32x16_bf16(vc[0], wf[0], o0, 0, 0, 0); o0 = __builtin_amdgcn_mfma_f32_32x32x16_bf16(vc[1], wf[1], o0, 0, 0, 0);
    o1 = __builtin_amdgcn_mfma_f32_32x32x16_bf16(vc[2], wf[0], o1, 0, 0, 0); o1 = __builtin_amdgcn_mfma_f32_32x32x16_bf16(vc[3], wf[1], o1, 0, 0, 0);
}
__device__ __forceinline__ void attn_item_mfma(bf16_t* P, const bf16_t* Vt, int bh, int qt, int lane) {
    asm volatile("" : "+v"(lane));
    const int b = bh >> 3, h = bh & 7, ql = lane & 31, hh = lane >> 5, q0 = qt * 32;
    bf16_t* qrow = P + (size_t)(b * SEQ + q0 + ql) * NIN + C_QSB + h * 64;
    bf16x8 qf[4];
#pragma unroll
    for (int s = 0; s < 4; ++s) qf[s] = *(const bf16x8*)(qrow + 16 * s + 8 * hh);
    f32x16 o0, o1;
#pragma unroll
    for (int i = 0; i < 16; ++i) { o0[i] = 0.f; o1[i] = 0.f; }
    float R = 1.0f;
    const bf16_t* kb = P + (size_t)(b * SEQ + ql) * NIN + C_KSB + h * 64 + 8 * hh;
    const bf16_t* vb = Vt + ((size_t)bh * 64 + ql) * SEQ + 8 * hh;
    bf16x8 kf[4], vf[4], vn[4];
#define AT_LOADK(k0_) do { _Pragma("unroll") for (int s = 0; s < 4; ++s) kf[s] = *(const bf16x8*)(kb + (size_t)(k0_) * NIN + 16 * s); } while (0)
#define AT_LOADV(dst, k0_) do { _Pragma("unroll") for (int j = 0; j < 4; ++j) dst[j] = *(const bf16x8*)(vb + (size_t)(j >> 1) * 32 * SEQ + (k0_) + 16 * (j & 1)); } while (0)
#define AT_QK(zz) do { _Pragma("unroll") for (int i = 0; i < 16; ++i) zz[i] = 0.f; _Pragma("unroll") for (int s = 0; s < 4; ++s) zz = __builtin_amdgcn_mfma_f32_32x32x16_bf16(kf[s], qf[s], zz, 0, 0, 0); } while (0)
    f32x16 zc, zn;
    AT_LOADK(q0); AT_LOADV(vf, q0);
    AT_QK(zc);
    { const int k1 = (qt > 0 ? qt - 1 : 0) * 32; AT_LOADK(k1); AT_LOADV(vn, k1); }
    { AT_QK(zn);
      const int k2 = (qt > 1 ? qt - 2 : 0) * 32; AT_LOADK(k2);
      attn_tile<true>(zc, vf, o0, o1, R, ql, hh);
      zc = zn;
#pragma unroll
      for (int j = 0; j < 4; ++j) vf[j] = vn[j];
      const int k1 = (qt > 1 ? qt - 2 : 0) * 32; AT_LOADV(vn, k1); }
#pragma unroll 1
    for (int kt = qt - 1; kt >= 0; --kt) {
        AT_QK(zn);
        const int k2 = (kt > 1 ? kt - 2 : 0) * 32; AT_LOADK(k2);
        attn_tile<false>(zc, vf, o0, o1, R, ql, hh);
        if (__builtin_amdgcn_ballot_w64(R != 0.0f) == 0ull) break;
        zc = zn;
#pragma unroll
        for (int j = 0; j < 4; ++j) vf[j] = vn[j];
        AT_LOADV(vn, k2);
    }
#undef AT_LOADK
#undef AT_LOADV
#undef AT_QK
#pragma unroll
    for (int bq = 0; bq < 4; ++bq) {
        u32x2 w0 = {cpk2(o0[4 * bq], o0[4 * bq + 1]), cpk2(o0[4 * bq + 2], o0[4 * bq + 3])}, w1 = {cpk2(o1[4 * bq], o1[4 * bq + 1]), cpk2(o1[4 * bq + 2], o1[4 * bq + 3])};
        *(u32x2*)(qrow + 8 * bq + 4 * hh) = w0; *(u32x2*)(qrow + 32 + 8 * bq + 4 * hh) = w1; }
}
__device__ __forceinline__ size_t slotU(size_t t0, int h, int colbase, int f) { return (t0 + (size_t)(f >> 7)) * D + colbase + h * 128 + (f & 127); }
__device__ __forceinline__ size_t slotP(size_t t0, int h, int colbase, int f) { return (t0 + (size_t)(f >> 7)) * NIN + colbase + h * 128 + (f & 127); }
__device__ __forceinline__ int permpos(int x) { const int k = x & 15; return (x & ~15) + 8 * ((k >> 2) & 1) + 4 * (k >> 3) + (k & 3); }
__device__ __forceinline__ int crow(int r, int hh) { return (r & 3) + 8 * (r >> 2) + 4 * hh; }
__device__ __forceinline__ bf16x8 pack8(const f32x16& x, int s2) {
    const u32x4 pw = {cpk2(x[8 * s2], x[8 * s2 + 1]), cpk2(x[8 * s2 + 2], x[8 * s2 + 3]), cpk2(x[8 * s2 + 4], x[8 * s2 + 5]), cpk2(x[8 * s2 + 6], x[8 * s2 + 7])};
    return __builtin_bit_cast(bf16x8, pw);
}
#define MFMA32(a, b, c) __builtin_amdgcn_mfma_f32_32x32x16_bf16((a), (b), (c), 0, 0, 0)
constexpr int PT = 72, PQ = 136, PL = 68, PB = 40;
constexpr int CP_GC = 0, CP_BT = 256, CP_LS = 1024, CP_TU = CP_LS + 64 * PL * 4, CP_TW = CP_TU + 64 * PT * 2, CP_KT = CP_TW + 64 * PT * 2, CP_VT = CP_KT + 128 * PT * 2,
              CP_QS = CP_VT + 128 * PT * 2, CP_KS = CP_QS + 64 * PQ * 2, CP_AQ = CP_KS + 64 * PQ * 2, CP_L21 = CP_AQ + 64 * PT * 2, CP_TCM = CP_L21 + 32 * PB * 2, CP_T22 = CP_TCM + 32 * PB * 2, CP_END = CP_T22 + 32 * PB * 2;
static_assert(CP_END <= 131072, "chunk prep LDS");
__device__ __forceinline__ void gdn_chunk_prep_phase(const Params& p, LAS unsigned char* lds, int tid, int wave, int lane) {
    bf16_t* P = (bf16_t*)(p.ws + WS_P); bf16_t* U = (bf16_t*)(p.ws + WS_U); const float* BG = (const float*)(p.ws + WS_BG);
    u32x4 ka, kb, qa, qb, xv[4][2]; float gx = 0.f, gbt = 0.f;
#define CP_LOAD(item_) do { const int bh_ = (item_) >> 5, n_ = (item_) & 31, b_ = bh_ >> 2, h_ = bh_ & 3; const size_t t0_ = (size_t)b_ * SEQ + n_ * 64; const int tok_ = tid >> 3, c16_ = (tid & 7) * 16; \
        ka = *(const u32x4*)(U + (t0_ + tok_) * D + 512 + h_ * 128 + c16_); kb = *(const u32x4*)(U + (t0_ + tok_) * D + 512 + h_ * 128 + c16_ + 8); \
        qa = *(const u32x4*)(U + (t0_ + tok_) * D + h_ * 128 + c16_); qb = *(const u32x4*)(U + (t0_ + tok_) * D + h_ * 128 + c16_ + 8); \
        _Pragma("unroll") for (int i = 0; i < 4; ++i) { const bool ok = n_ * 64 + tok_ - 3 + i >= 0; const bf16_t* vp = P + (t0_ + tok_ - 3 + i) * NIN + C_VDN + h_ * 128 + c16_; \
            xv[i][0] = ok ? *(const u32x4*)vp : (u32x4){0u, 0u, 0u, 0u}; xv[i][1] = ok ? *(const u32x4*)(vp + 8) : (u32x4){0u, 0u, 0u, 0u}; } \
        if (tid < 64) { gx = BG[(t0_ + tid) * 8 + 4 + h_]; gbt = BG[(t0_ + tid) * 8 + h_]; } } while (0)
    if ((int)blockIdx.x < 1024) CP_LOAD((int)blockIdx.x);
  for (int item = blockIdx.x; item < 1024; item += gridDim.x) {
    asm volatile("" : "+v"(tid), "+v"(lane));
    const int bh = item >> 5, n = item & 31, b = bh >> 2, h = bh & 3, ql = lane & 31, hh = lane >> 5;
    const size_t t0 = (size_t)b * SEQ + n * 64;
    LAS float* gcS = (LAS float*)(lds + CP_GC); LAS float* btS = (LAS float*)(lds + CP_BT);
    LAS float* LS = (LAS float*)(lds + CP_LS);
    LAS bf16_t* TuS = (LAS bf16_t*)(lds + CP_TU); LAS bf16_t* TwS = (LAS bf16_t*)(lds + CP_TW);
    LAS bf16_t* kT = (LAS bf16_t*)(lds + CP_KT); LAS bf16_t* vT = (LAS bf16_t*)(lds + CP_VT); LAS bf16_t* qS = (LAS bf16_t*)(lds + CP_QS); LAS bf16_t* kS = (LAS bf16_t*)(lds + CP_KS);
    LAS bf16_t* AQ = (LAS bf16_t*)(lds + CP_AQ); LAS bf16_t* L21b = (LAS bf16_t*)(lds + CP_L21); LAS bf16_t* Tcm = (LAS bf16_t*)(lds + CP_TCM); LAS bf16_t* T22r = (LAS bf16_t*)(lds + CP_T22);
    if (tid < 64) { float x = gx;
#pragma unroll
        for (int o = 1; o < 64; o <<= 1) { const float y = __shfl_up(x, o); if (lane >= o) x += y; }
        gcS[tid] = x; btS[tid] = gbt; }
    { const int tok = tid >> 3, c16 = (tid & 7) * 16;
        *(LAS u32x4*)(kS + tok * PQ + c16) = ka; *(LAS u32x4*)(kS + tok * PQ + c16 + 8) = kb;
        *(LAS u32x4*)(qS + tok * PQ + c16) = qa; *(LAS u32x4*)(qS + tok * PQ + c16 + 8) = qb;
        const unsigned kw[8] = {ka.x, ka.y, ka.z, ka.w, kb.x, kb.y, kb.z, kb.w};
#pragma unroll
        for (int e = 0; e < 8; ++e) { kT[(c16 + 2 * e) * PT + tok] = (bf16_t)(kw[e] & 0xffffu); kT[(c16 + 2 * e + 1) * PT + tok] = (bf16_t)(kw[e] >> 16); }
        float y[16];
#pragma unroll
        for (int e = 0; e < 16; ++e) y[e] = 0.f;
#pragma unroll
        for (int i = 0; i < 4; ++i) { const float* wp = p.in[I_WCONV] + i * 1536 + 1024 + h * 128 + c16;
            const unsigned xw[8] = {xv[i][0].x, xv[i][0].y, xv[i][0].z, xv[i][0].w, xv[i][1].x, xv[i][1].y, xv[i][1].z, xv[i][1].w};
#pragma unroll
            for (int e = 0; e < 8; ++e) { y[2 * e] += wp[2 * e] * bf_lo(xw[e]); y[2 * e + 1] += wp[2 * e + 1] * bf_hi(xw[e]); } }
#pragma unroll
        for (int e = 0; e < 16; ++e) vT[(c16 + e) * PT + tok] = f2bf(fsilu(y[e])); }
    __syncthreads();
    if (item + (int)gridDim.x < 1024) CP_LOAD(item + (int)gridDim.x);
    if (wave == 0 || wave == 4 || wave == 5) {
        const int it = wave == 0 ? 0 : 1, jt = wave == 4 ? 1 : 0;
        f32x16 acc;
#pragma unroll
        for (int r = 0; r < 16; ++r) acc[r] = 0.f;
#pragma unroll
        for (int ks = 0; ks < 8; ++ks) acc = MFMA32(*(const LAS bf16x8*)(kS + (32 * it + ql) * PQ + 16 * ks + 8 * hh), *(const LAS bf16x8*)(kS + (32 * jt + ql) * PQ + 16 * ks + 8 * hh), acc);
        const int j = 32 * jt + ql; const float gj = gcS[j];
#pragma unroll
        for (int r = 0; r < 16; ++r) { const int i = 32 * it + crow(r, hh); const float l = (j < i) ? btS[i] * acc[r] * fexp(gcS[i] - gj) : 0.f;
            if (it != jt) L21b[(i - 32) * PB + j] = f2bf(l); else LS[i * PL + j] = l; }
    } else if (wave < 4) {
        const int jt = wave == 3 ? 1 : 0, it = wave == 1 ? 0 : 1;
        f32x16 acc;
#pragma unroll
        for (int r = 0; r < 16; ++r) acc[r] = 0.f;
#pragma unroll
        for (int ks = 0; ks < 8; ++ks) acc = MFMA32(*(const LAS bf16x8*)(kS + (32 * jt + ql) * PQ + 16 * ks + 8 * hh), *(const LAS bf16x8*)(qS + (32 * it + ql) * PQ + 16 * ks + 8 * hh), acc);
        const int i = 32 * it + ql; const float gi = gcS[i];
#pragma unroll
        for (int r = 0; r < 16; ++r) { const int j = 32 * jt + crow(r, hh); acc[r] = (j <= i) ? acc[r] * fexp(gi - gcS[j]) : 0.f; }
#pragma unroll
        for (int bq = 0; bq < 4; ++bq) *(LAS u32x2*)(AQ + i * PT + 32 * jt + 8 * bq + 4 * hh) = (u32x2){cpk2(acc[4 * bq], acc[4 * bq + 1]), cpk2(acc[4 * bq + 2], acc[4 * bq + 3])};
    } else {
        const float gl = gcS[63];
#pragma unroll
        for (int uu = 0; uu < 4; ++uu) { const int unit = (tid - 384) + 128 * uu, dk = unit >> 2, blk = unit & 3;
            const u32x4 k0 = *(const LAS u32x4*)(kT + dk * PT + 16 * blk), k1 = *(const LAS u32x4*)(kT + dk * PT + 16 * blk + 8);
            float kv[16] = {bf_lo(k0.x), bf_hi(k0.x), bf_lo(k0.y), bf_hi(k0.y), bf_lo(k0.z), bf_hi(k0.z), bf_lo(k0.w), bf_hi(k0.w), bf_lo(k1.x), bf_hi(k1.x), bf_lo(k1.y), bf_hi(k1.y), bf_lo(k1.z), bf_hi(k1.z), bf_lo(k1.w), bf_hi(k1.w)};
#pragma unroll
            for (int e = 0; e < 16; ++e) kv[e] *= fexp(gl - gcS[16 * blk + e]);
            float pv[16];
#pragma unroll
            for (int e = 0; e < 16; ++e) pv[permpos(e)] = kv[e];
            pack16(P + slotP(t0, h, C_VSB, dk * 64 + 16 * blk), pv); }
        if (tid == 384) ((float*)(p.ws + WS_EGL))[bh * 32 + n] = fexp(gl);
    }
    __syncthreads();
    if (wave == 0) {
        const LAS float* LB = LS + (32 * hh) * PL + 32 * hh;
        float Tc[32];
#pragma unroll
        for (int i = 0; i < 32; ++i) {
            float a0 = (ql == i) ? 1.0f : 0.f, a1 = 0.f, a2 = 0.f, a3 = 0.f;
#pragma unroll
            for (int j4 = 0; j4 < i; j4 += 4) { const f32x4 l4 = *(const LAS f32x4*)(LB + i * PL + j4);
                a0 -= l4[0] * Tc[j4]; if (j4 + 1 < i) a1 -= l4[1] * Tc[j4 + 1]; if (j4 + 2 < i) a2 -= l4[2] * Tc[j4 + 2]; if (j4 + 3 < i) a3 -= l4[3] * Tc[j4 + 3]; }
            Tc[i] = (a0 + a1) + (a2 + a3); }
        const int cg_ = 32 * hh + ql; const float bu = btS[cg_], bw = bu * fexp(gcS[cg_]);
#pragma unroll
        for (int i = 0; i < 32; ++i) { TuS[(32 * hh + i) * PT + cg_] = f2bf(Tc[i] * bu); TwS[(32 * hh + i) * PT + cg_] = f2bf(Tc[i] * bw); }
        if (hh == 0) {
#pragma unroll
            for (int i8 = 0; i8 < 4; ++i8) *(LAS u32x4*)(Tcm + ql * PB + 8 * i8) = (u32x4){cpk2(Tc[8 * i8], Tc[8 * i8 + 1]), cpk2(Tc[8 * i8 + 2], Tc[8 * i8 + 3]), cpk2(Tc[8 * i8 + 4], Tc[8 * i8 + 5]), cpk2(Tc[8 * i8 + 6], Tc[8 * i8 + 7])};
        } else {
#pragma unroll
            for (int i = 0; i < 32; ++i) T22r[i * PB + ql] = f2bf(Tc[i]);
        }
        LDS_WAIT();
        f32x16 x1;
#pragma unroll
        for (int r = 0; r < 16; ++r) x1[r] = 0.f;
#pragma unroll
        for (int s2 = 0; s2 < 2; ++s2) x1 = MFMA32(*(const LAS bf16x8*)(L21b + ql * PB + 16 * s2 + 8 * hh), *(const LAS bf16x8*)(Tcm + ql * PB + 16 * s2 + 8 * hh), x1);
        f32x16 yy;
#pragma unroll
        for (int r = 0; r < 16; ++r) yy[r] = 0.f;
#pragma unroll
        for (int s2 = 0; s2 < 2; ++s2) { const u32x2 lo = *(const LAS u32x2*)(T22r + ql * PB + 16 * s2 + 4 * hh), hi = *(const LAS u32x2*)(T22r + ql * PB + 16 * s2 + 8 + 4 * hh);
            const u32x4 af = {lo.x, lo.y, hi.x, hi.y};
            yy = MFMA32(__builtin_bit_cast(bf16x8, af), pack8(x1, s2), yy); }
        { const float bu0 = btS[ql], bw0 = bu0 * fexp(gcS[ql]);
#pragma unroll
            for (int r = 0; r < 16; ++r) { const int i2 = 32 + crow(r, hh); TuS[i2 * PT + ql] = f2bf(-yy[r] * bu0); TwS[i2 * PT + ql] = f2bf(-yy[r] * bw0); } }
    }
    __syncthreads();
    {
        const int isW = wave >> 2, ct = wave & 3, col = 32 * ct + ql;
        const LAS bf16_t* Ta = (isW ? TwS : TuS) + 8 * hh; const LAS bf16_t* Bs = (isW ? kT : vT) + col * PT + 8 * hh;
        bf16x8 bf[4];
#pragma unroll
        for (int ks = 0; ks < 4; ++ks) bf[ks] = *(const LAS bf16x8*)(Bs + 16 * ks);
        f32x16 xa[2];
#pragma unroll
        for (int jt = 0; jt < 2; ++jt) {
#pragma unroll
            for (int r = 0; r < 16; ++r) xa[jt][r] = 0.f;
#pragma unroll
            for (int ks = 0; ks < 4; ++ks) if (jt == 1 || ks < 2) xa[jt] = MFMA32(*(const LAS bf16x8*)(Ta + (32 * jt + ql) * PT + 16 * ks), bf[ks], xa[jt]); }
        bf16x8 xb[4] = {pack8(xa[0], 0), pack8(xa[0], 1), pack8(xa[1], 0), pack8(xa[1], 1)};
        f32x16 ra[2];
#pragma unroll
        for (int it = 0; it < 2; ++it) {
#pragma unroll
            for (int r = 0; r < 16; ++r) ra[it][r] = 0.f;
#pragma unroll
            for (int kk = 0; kk < 4; ++kk) if (it == 1 || kk < 2) { const LAS bf16_t* ap = AQ + (32 * it + ql) * PT + 16 * kk + 4 * hh;
                const u32x2 lo = *(const LAS u32x2*)ap, hi = *(const LAS u32x2*)(ap + 8); const u32x4 af = {lo.x, lo.y, hi.x, hi.y};
                ra[it] = MFMA32(__builtin_bit_cast(bf16x8, af), xb[kk], ra[it]); } }
        if (!isW) {
#pragma unroll
            for (int jt = 0; jt < 2; ++jt)
#pragma unroll
                for (int bq = 0; bq < 4; ++bq) { const int f = col * 64 + 32 * jt + 8 * bq + 4 * hh;
                    *(u32x2*)(U + slotU(t0, h, 0, f)) = (u32x2){cpk2(xa[jt][4 * bq], xa[jt][4 * bq + 1]), cpk2(xa[jt][4 * bq + 2], xa[jt][4 * bq + 3])};
                    *(u32x2*)(U + slotU(t0, h, 512, f)) = (u32x2){cpk2(ra[jt][4 * bq], ra[jt][4 * bq + 1]), cpk2(ra[jt][4 * bq + 2], ra[jt][4 * bq + 3])}; }
        } else {
            const int pc = permpos(col);
#pragma unroll
            for (int jt = 0; jt < 2; ++jt)
#pragma unroll
                for (int r = 0; r < 16; ++r) { const int tok = 32 * jt + crow(r, hh);
                    P[(t0 + tok) * NIN + C_QDN + h * 128 + pc] = f2bf(-xa[jt][r]);
                    P[(t0 + tok) * NIN + C_KDN + h * 128 + pc] = f2bf(bf2f(qS[tok * PQ + col]) * fexp(gcS[tok]) - ra[jt][r]); }
        }
    }
    __syncthreads();
  }
#undef CP_LOAD
}
constexpr int SC_PW = 136, SC_PK = 72, SC_NW = 0, SC_Q2 = 64 * SC_PW * 2, SC_KD = 2 * 64 * SC_PW * 2, SC_STAGE = 2 * 64 * SC_PW * 2 + 128 * SC_PK * 2, SC_OS = 2 * SC_STAGE,
              SC_US = SC_OS + 64 * SC_PW * 2, SC_OI = SC_US + 128 * SC_PK * 2, SC_END = SC_OI + 128 * SC_PK * 2;
static_assert(SC_END <= BST_OFF, "scan LDS");
__device__ __forceinline__ void gdn_scan_block(const Params& p, LAS unsigned char* lds, int bh, int tid, int wave, int lane) {
    asm volatile("" : "+v"(tid), "+v"(lane));
    bf16_t* P = (bf16_t*)(p.ws + WS_P); const bf16_t* U = (const bf16_t*)(p.ws + WS_U); const float* EGL = (const float*)(p.ws + WS_EGL);
    const int b = bh >> 2, h = bh & 3, ql = lane & 31, hh = lane >> 5;
    const size_t tb = (size_t)b * SEQ;
    LAS bf16_t* oS = (LAS bf16_t*)(lds + SC_OS);
    if (wave >= 4) {
        int lt = tid - 256, ftok = lt >> 2, fseg = lt & 3;
        u32x4 ra[20], rb[20];
#define SC_LOAD(r, n_) do { const size_t t0_ = tb + (size_t)(n_) * 64; _Pragma("unroll") for (int i = 0; i < 4; ++i) { const int c = lt + 256 * i, row = c >> 4, c8 = (c & 15) * 8; \
            const bf16_t* g_ = P + (t0_ + row) * NIN + h * 128 + c8; const bf16_t* u_ = U + (t0_ + row) * D + h * 128 + c8; \
            r[i] = *(const u32x4*)(g_ + C_QDN); r[4 + i] = *(const u32x4*)(g_ + C_KDN); r[8 + i] = *(const u32x4*)(g_ + C_VSB); r[12 + i] = *(const u32x4*)u_; r[16 + i] = *(const u32x4*)(u_ + 512); } } while (0)
#define SC_STORE(r, st_) do { LAS unsigned char* s_ = lds + (st_) * SC_STAGE; _Pragma("unroll") for (int i = 0; i < 4; ++i) { const int c = lt + 256 * i, row = c >> 4, c8 = (c & 15) * 8; \
            *(LAS u32x4*)(s_ + SC_NW + (row * SC_PW + c8) * 2) = r[i]; *(LAS u32x4*)(s_ + SC_Q2 + (row * SC_PW + c8) * 2) = r[4 + i]; \
            *(LAS u32x4*)(s_ + SC_KD + ((2 * row + (c8 >> 6)) * SC_PK + (c8 & 63)) * 2) = r[8 + i]; } } while (0)
#define SC_STOREU(r) do { _Pragma("unroll") for (int i = 0; i < 4; ++i) { const int c = lt + 256 * i, row = c >> 4, c8 = (c & 15) * 8; const int o_ = ((2 * row + (c8 >> 6)) * SC_PK + (c8 & 63)) * 2; \
            *(LAS u32x4*)(lds + SC_US + o_) = r[12 + i]; *(LAS u32x4*)(lds + SC_OI + o_) = r[16 + i]; } } while (0)
#define SC_FIN(m_) do { bf16_t* orow = P + (tb + (size_t)(m_) * 64 + ftok) * NIN + h * 128 + fseg * 32 + C_VDN; \
            _Pragma("unroll") for (int i = 0; i < 4; ++i) *(u32x4*)(orow + 8 * i) = *(const LAS u32x4*)(oS + ftok * SC_PW + fseg * 32 + 8 * i); } while (0)
        SC_LOAD(ra, 0); SC_STORE(ra, 0); SC_STOREU(ra); SC_LOAD(ra, 1);
        __syncthreads();
#pragma unroll 1
        for (int n = 0; n < 32; n += 2) {
            asm volatile("" : "+v"(lt), "+v"(ftok), "+v"(fseg));
            if (n + 2 < 32) SC_LOAD(rb, n + 2);
            SC_STORE(ra, 1);
            if (n > 0) SC_FIN(n - 1);
            __syncthreads();
            SC_STOREU(ra);
            __syncthreads();
            if (n + 3 < 32) SC_LOAD(ra, n + 3);
            if (n + 2 < 32) SC_STORE(rb, 0);
            SC_FIN(n);
            __syncthreads();
            if (n + 2 < 32) SC_STOREU(rb);
            __syncthreads();
        }
        SC_FIN(31);
#undef SC_LOAD
#undef SC_STORE
#undef SC_STOREU
#undef SC_FIN
    } else {
        const int col = 32 * wave + ql;
        f32x16 S[4];
#pragma unroll
        for (int rt = 0; rt < 4; ++rt)
#pragma unroll
            for (int r = 0; r < 16; ++r) S[rt][r] = 0.f;
        const float eglv = EGL[bh * 32 + ql];
        __syncthreads();
#pragma unroll 1
        for (int n = 0; n < 32; ++n) {
            const float egl = __builtin_bit_cast(float, __builtin_amdgcn_readlane(__builtin_bit_cast(int, eglv), n));
            const LAS unsigned char* st = lds + (n & 1) * SC_STAGE;
            f32x16 vn[2], oa[2];
            { const LAS unsigned char* up_ = lds + SC_US + (col * SC_PK + 4 * hh) * 2; const LAS unsigned char* op_ = lds + SC_OI + (col * SC_PK + 4 * hh) * 2;
#pragma unroll
              for (int jt = 0; jt < 2; ++jt)
#pragma unroll
                for (int bq = 0; bq < 4; ++bq) { const u32x2 uw = *(const LAS u32x2*)(up_ + (32 * jt + 8 * bq) * 2), ow = *(const LAS u32x2*)(op_ + (32 * jt + 8 * bq) * 2);
                    vn[jt][4 * bq] = bf_lo(uw.x); vn[jt][4 * bq + 1] = bf_hi(uw.x); vn[jt][4 * bq + 2] = bf_lo(uw.y); vn[jt][4 * bq + 3] = bf_hi(uw.y);
                    oa[jt][4 * bq] = bf_lo(ow.x); oa[jt][4 * bq + 1] = bf_hi(ow.x); oa[jt][4 * bq + 2] = bf_lo(ow.y); oa[jt][4 * bq + 3] = bf_hi(ow.y); } }
            const LAS unsigned char* w0_ = st + (ql * SC_PW + 8 * hh) * 2; const LAS unsigned char* w1_ = w0_ + 32 * SC_PW * 2;
            const LAS unsigned char* kd_ = st + SC_KD + (ql * SC_PK + 8 * hh) * 2;
            bf16x8 fa[4], fb[4];
#define SC_RD4(dst, ptr) do { _Pragma("unroll") for (int i_ = 0; i_ < 4; ++i_) dst[i_] = *(const LAS bf16x8*)((ptr) + 32 * i_); } while (0)
#define SC_MM4(acc, fr, bb) do { _Pragma("unroll") for (int i_ = 0; i_ < 4; ++i_) acc = MFMA32(fr[i_], bb[i_], acc); __builtin_amdgcn_sched_barrier(0); } while (0)
            SC_RD4(fa, w0_ + SC_NW); SC_RD4(fb, w1_ + SC_NW);
            { bf16x8 sb[4] = {pack8(S[0], 0), pack8(S[0], 1), pack8(S[1], 0), pack8(S[1], 1)};
              SC_MM4(vn[0], fa, sb); SC_RD4(fa, w0_ + SC_Q2);
              SC_MM4(vn[1], fb, sb); SC_RD4(fb, w1_ + SC_Q2);
              SC_MM4(oa[0], fa, sb); SC_RD4(fa, w0_ + SC_NW + 128);
              SC_MM4(oa[1], fb, sb); SC_RD4(fb, w1_ + SC_NW + 128); }
            { bf16x8 sb[4] = {pack8(S[2], 0), pack8(S[2], 1), pack8(S[3], 0), pack8(S[3], 1)};
              SC_MM4(vn[0], fa, sb); SC_RD4(fa, w0_ + SC_Q2 + 128);
              SC_MM4(vn[1], fb, sb); SC_RD4(fb, w1_ + SC_Q2 + 128);
              bf16x8 vb[4] = {pack8(vn[0], 0), pack8(vn[0], 1), pack8(vn[1], 0), pack8(vn[1], 1)};
              SC_MM4(oa[0], fa, sb); SC_RD4(fa, kd_);
              SC_MM4(oa[1], fb, sb); SC_RD4(fb, kd_ + 32 * SC_PK * 2);
#pragma unroll
              for (int rt = 0; rt < 4; ++rt)
#pragma unroll
                  for (int r = 0; r < 16; ++r) S[rt][r] *= egl;
              SC_MM4(S[0], fa, vb); SC_RD4(fa, kd_ + 64 * SC_PK * 2);
              SC_MM4(S[1], fb, vb); SC_RD4(fb, kd_ + 96 * SC_PK * 2);
              SC_MM4(S[2], fa, vb);
              SC_MM4(S[3], fb, vb); }
#undef SC_RD4
#undef SC_MM4
            __syncthreads();
#pragma unroll
            for (int jt = 0; jt < 2; ++jt)
#pragma unroll
                for (int r = 0; r < 16; ++r) oS[(32 * jt + crow(r, hh)) * SC_PW + col] = f2bf(oa[jt][r]);
            __syncthreads();
        }
    }
}
__device__ __forceinline__ void gdn_finalize_phase(const Params& p, int wave, int lane) {
    asm volatile("" : "+v"(lane));
    bf16_t* P = (bf16_t*)(p.ws + WS_P);
    const int c0 = (lane & 15) * 8;
    float gg[8];
#pragma unroll
    for (int e = 0; e < 8; ++e) gg[e] = p.in[I_GDNOUT][c0 + e];
    for (int row = blockIdx.x * 8 + wave; row < T; row += gridDim.x * 8) {
        bf16_t* op = P + (size_t)row * NIN + C_VDN + lane * 8; const bf16_t* zp = P + (size_t)row * NIN + C_ZDN + lane * 8;
        const u32x4 ow = *(const u32x4*)op, zw = *(const u32x4*)zp;
        const float o[8] = {bf_lo(ow.x), bf_hi(ow.x), bf_lo(ow.y), bf_hi(ow.y), bf_lo(ow.z), bf_hi(ow.z), bf_lo(ow.w), bf_hi(ow.w)};
        const float z[8] = {bf_lo(zw.x), bf_hi(zw.x), bf_lo(zw.y), bf_hi(zw.y), bf_lo(zw.z), bf_hi(zw.z), bf_lo(zw.w), bf_hi(zw.w)};
        float ss = 0.f;
#pragma unroll
        for (int e = 0; e < 8; ++e) ss += o[e] * o[e];
        ss += __shfl_xor(ss, 1); ss += __shfl_xor(ss, 2); ss += __shfl_xor(ss, 4); ss += __shfl_xor(ss, 8);
        const float rstd = 1.0f / sqrtf(ss * (1.f / 128.f) + EPS);
        float r[8];
#pragma unroll
        for (int e = 0; e < 8; ++e) r[e] = o[e] * rstd * gg[e] * fsilu(z[e]);
        u32x4 w; w.x = pk2(r[0], r[1]); w.y = pk2(r[2], r[3]); w.z = pk2(r[4], r[5]); w.w = pk2(r[6], r[7]);
        *(u32x4*)op = w;
    }
}

#define XB_TMO      128
#define XB_XCNT(j)  (256  + 64 * (j))
#define XB_XSUB(j)  (1280 + 64 * (j))
#define XB_XGEN(j)  (2304 + 64 * (j))
#define XB_TOP      3328
#define XB_TOPGEN   3392
#define XCD_BAR_WORDS 3456
#define XB_SPIN_CAP (1u << 18)
__device__ __forceinline__ unsigned xb_ld(unsigned* p)              { return __hip_atomic_load(p, __ATOMIC_RELAXED, __HIP_MEMORY_SCOPE_AGENT); }
__device__ __forceinline__ unsigned xb_add(unsigned* p, unsigned v) { return __hip_atomic_fetch_add(p, v, __ATOMIC_RELAXED, __HIP_MEMORY_SCOPE_AGENT); }
__device__ __forceinline__ unsigned xb_xcc_id() { return (unsigned)__builtin_amdgcn_s_getreg((3 << 11) | 20) & 0xFu; }
#define XB_SPIN(cond, bar) do { unsigned _sp = 0; while (cond) { __builtin_amdgcn_s_sleep(1); \
    if ((++_sp & 255u) == 0u) { if (xb_ld(&(bar)[XB_TMO])) break; if (_sp > XB_SPIN_CAP) { atomicAdd(&(bar)[XB_TMO], 1u); break; } } } } while (0)
struct XcdBarrier { unsigned* bar; unsigned x; volatile LAS unsigned* st; };
__device__ __forceinline__ XcdBarrier xcd_barrier_post(unsigned* bar, volatile LAS unsigned* st) {
    XcdBarrier b; b.bar = bar; b.x = xb_xcc_id(); b.st = st;
    if (threadIdx.x == 0) (void)xb_add(&bar[XB_XCNT(b.x)], 1u);
    return b;
}
__device__ __forceinline__ void xcd_barrier_complete(unsigned* bar, unsigned x, unsigned& nloc, unsigned& nx) {
    const unsigned G = gridDim.x * gridDim.y * gridDim.z;
    unsigned sum, cnt, mine, sp = 0u;
    for (;;) {
        sum = 0u; cnt = 0u; mine = 0u;
#pragma unroll
        for (unsigned j = 0; j < 16; ++j) { const unsigned c = xb_ld(&bar[XB_XCNT(j)]); sum += c; cnt += (c > 0u) ? 1u : 0u; mine = (j == x) ? c : mine; }
        if (sum == G) break;
        __builtin_amdgcn_s_sleep(1);
        if ((++sp & 255u) == 0u) { if (xb_ld(&bar[XB_TMO])) break; if (sp > XB_SPIN_CAP) { atomicAdd(&bar[XB_TMO], 1u); break; } }
    }
    nloc = mine > 0u ? mine : 1u; nx = cnt > 0u ? cnt : 1u;
}
__device__ __forceinline__ void xcd_barrier(const XcdBarrier& b) {
    asm volatile("s_waitcnt vmcnt(0)" ::: "memory");
    __syncthreads();
    if (threadIdx.x == 0) {
        unsigned* bar = b.bar;
        __builtin_amdgcn_s_waitcnt(0);
        unsigned nloc = b.st[0], nx = b.st[1];
        if (nloc == 0u) { xcd_barrier_complete(bar, b.x, nloc, nx); b.st[0] = nloc; b.st[1] = nx; }
        const unsigned old = xb_add(&bar[XB_XSUB(b.x)], 1u);
        const unsigned gen = old / nloc;
        if (old + 1u == (gen + 1u) * nloc) {
            __builtin_amdgcn_fence(__ATOMIC_RELEASE, "agent");
            asm volatile("s_waitcnt vmcnt(0)" ::: "memory");
            const unsigned og = xb_add(&bar[XB_TOP], 1u);
            const unsigned tg = og / nx;
            if (og + 1u == (tg + 1u) * nx) xb_add(&bar[XB_TOPGEN], 1u);
            else XB_SPIN(xb_ld(&bar[XB_TOPGEN]) == tg, bar);
            __builtin_amdgcn_fence(__ATOMIC_ACQUIRE, "agent");
            xb_add(&bar[XB_XGEN(b.x)], 1u);
            asm volatile("s_waitcnt vmcnt(0)" ::: "memory");
        } else {
            XB_SPIN(xb_ld(&bar[XB_XGEN(b.x)]) == gen, bar);
            __builtin_amdgcn_fence(__ATOMIC_ACQUIRE, "agent");
            asm volatile("s_waitcnt vmcnt(0)" ::: "memory");
        }
    }
    __syncthreads();
}

#ifndef PHMASK
#define PHMASK 0xFFFF
#endif
#define PH(n) ((PHMASK >> (n)) & 1)
#ifndef PROBE
#define PROBE 0
#endif
#define REP(g) for (int _rep = 0; _rep < ((PROBE == (g)) ? 2 : 1); ++_rep)
__global__ void __launch_bounds__(512, 2) fwd_megakernel(Params p) {
    extern __shared__ __attribute__((aligned(16))) unsigned char lds_raw[];
    LAS unsigned char* lds = (LAS unsigned char*)lds_raw;
    cg::grid_group grid = cg::this_grid();
    const int tid = threadIdx.x, lane = tid & 63, wave = __builtin_amdgcn_readfirstlane(tid >> 6);
    const int G = gridDim.x, gw = wave * G + blockIdx.x, ngw = G * 8;
    unsigned char* ws = p.ws;
    bf16_t* U = (bf16_t*)(ws + WS_U); bf16_t* P = (bf16_t*)(ws + WS_P);
    const float* mod = (const float*)(ws + WS_MOD);
    LAS float* scr = (LAS float*)(lds + wave * 16384);

    unsigned* barw = (unsigned*)(ws + WS_BAR);
    volatile LAS unsigned* bst = (volatile LAS unsigned*)(lds + BST_OFF);
    if (tid < 2) bst[tid] = 0u;
    __syncthreads();
    if (p.ws == nullptr) grid.sync();
    const XcdBarrier xbar = xcd_barrier_post(barw, bst);
    REP(1) { if (PH(0)) for (int it = blockIdx.x; it < NMOD / 64; it += G) mod_item(p, lds, it, tid, wave, lane);
    { const int nmod = NMOD / 64;
      if (PH(0)) { if (G >= nmod + 64) { if ((int)blockIdx.x >= nmod) ffn_weight_items(p.in[I_WFFN1IN], p.in[I_WFFN1OUT], (bf16_t*)(ws + W_FFIN), (bf16_t*)(ws + W_FFOUT), scr, wave * (G - nmod) + ((int)blockIdx.x - nmod), (G - nmod) * 8, lane); }
                   else ffn_weight_items(p.in[I_WFFN1IN], p.in[I_WFFN1OUT], (bf16_t*)(ws + W_FFIN), (bf16_t*)(ws + W_FFOUT), scr, gw, ngw, lane); } }
    __syncthreads(); }
    xcd_barrier(xbar);
    if (PROBE == 3) for (int i = 0; i < 16; ++i) xcd_barrier(xbar);
    REP(1) if (PH(1)) norm_mod_phase<false>(p, lds, p.in[I_X], p.in[I_GFFN1], 0, U, tid, wave, lane);
    xcd_barrier(xbar);
    REP(2) if (PH(2)) run_gemm(lds, U, D, (const bf16_t*)(ws + W_FFIN), 2 * FF, D, EpiSwiGLU{P, FF});
    { const int nfull = (64 * 22) % G, nidle = nfull ? G - nfull : G;
      const int ib = nfull ? (int)blockIdx.x - nfull : (int)blockIdx.x;
      if (PH(0) && ib >= 0) mixer_weight_items(p, scr, wave * nidle + ib, nidle * 8, lane); }
    xcd_barrier(xbar);
    REP(2) if (PH(3)) run_gemm(lds, P, FF, (const bf16_t*)(ws + W_FFOUT), D, FF, EpiResid{p.in[I_X], p.out, mod + 2 * D, 0.5f});
    xcd_barrier(xbar);
    REP(1) if (PH(4)) norm_mod_phase<true>(p, lds, p.out, p.in[I_GMIX], 3, U, tid, wave, lane);
    xcd_barrier(xbar);
    REP(2) if (PH(5)) run_gemm(lds, U, D, (const bf16_t*)(ws + W_IN), NIN, D, EpiBf16{P, NIN});
    xcd_barrier(xbar);
    if (PH(6)) prep_phase(p, wave, lane);
    xcd_barrier(xbar);
    if (PH(7)) gdn_chunk_prep_phase(p, lds, tid, wave, lane);
    xcd_barrier(xbar);
    if (PH(15)) for (int it = blockIdx.x; it < 32; it += G) gdn_scan_block(p, lds, it, tid, wave, lane);
    if (PH(8)) {
        const unsigned x0 = xb_xcc_id() & 7u;
        for (unsigned dx = 0; dx < 8u; ++dx) { const unsigned x = (x0 + dx) & 7u; unsigned* ctr = (unsigned*)(ws + WS_CTR) + 64 * x;
            for (;;) { unsigned idx = 0; if (lane == 0) idx = atomicAdd(ctr, 1u); idx = __builtin_amdgcn_readfirstlane(idx);
                if (idx >= 512u) break;
                attn_item_mfma(P, (const bf16_t*)(ws + WS_VT), (int)(8u * x + (idx & 7u)), 63 - (int)(idx >> 3), lane); } } }
    xcd_barrier(xbar);
    if (PH(9)) gdn_finalize_phase(p, wave, lane);
    xcd_barrier(xbar);
    if (PH(10)) run_gemm(lds, P + C_QSB, NIN, (const bf16_t*)(ws + W_UPSB), D, 1024, EpiGateFused{P + C_RSB, P + C_RDN, U}, 8, (C_VDN - C_QSB) * 2 - 8 * 128);
    xcd_barrier(xbar);
    if (PH(11)) run_gemm(lds, U, D, (const bf16_t*)(ws + W_OUT), D, D, EpiResid{p.out, p.out, mod + 5 * D, 1.0f});
    xcd_barrier(xbar);
    REP(1) if (PH(12)) norm_mod_phase<false>(p, lds, p.out, p.in[I_GFFN2], 6, U, tid, wave, lane);
    __syncthreads();
    if (PH(12)) ffn_weight_items(p.in[I_WFFN2IN], p.in[I_WFFN2OUT], (bf16_t*)(ws + W_FFIN), (bf16_t*)(ws + W_FFOUT), scr, gw, ngw, lane);
    xcd_barrier(xbar);
    REP(2) if (PH(13)) run_gemm(lds, U, D, (const bf16_t*)(ws + W_FFIN), 2 * FF, D, EpiSwiGLU{P, FF});
    xcd_barrier(xbar);
    if (PH(14)) run_gemm(lds, P, FF, (const bf16_t*)(ws + W_FFOUT), D, FF, EpiResid{p.out, p.out, mod + 8 * D, 0.5f});
}

extern "C" void kernel_launch(void* const* d_in, const int* in_sizes, int n_in, void* d_out, int out_size, void* d_ws, size_t ws_size, hipStream_t stream) {
    static int grid_blocks = 0;
    if (!grid_blocks) {
        int dev = 0, cus = 0, per_cu = 0;
        (void)hipGetDevice(&dev);
        (void)hipDeviceGetAttribute(&cus, hipDeviceAttributeMultiprocessorCount, dev);
        (void)hipFuncSetAttribute((const void*)fwd_megakernel, hipFuncAttributeMaxDynamicSharedMemorySize, LDS_BYTES);
        (void)hipOccupancyMaxActiveBlocksPerMultiprocessor(&per_cu, (const void*)fwd_megakernel, 512, LDS_BYTES);
        if (per_cu < 1) { fprintf(stderr, "occupancy query says %d blocks/CU\n", per_cu); per_cu = 1; }
        grid_blocks = cus;
    }
    Params p{};
    for (int i = 0; i < N_IN; ++i) p.in[i] = (const float*)d_in[i];
    p.out = (float*)d_out; p.ws = (unsigned char*)d_ws;
    (void)hipMemsetAsync((char*)d_ws + WS_CTR, 0, (WS_BAR - WS_CTR) + XCD_BAR_WORDS * 4, stream);
    void* args[] = {&p};
    hipError_t e = hipLaunchCooperativeKernel((const void*)fwd_megakernel, dim3(grid_blocks), dim3(512), args, LDS_BYTES, stream);
    if (e != hipSuccess) fprintf(stderr, "cooperative launch failed: %s (grid %d)\n", hipGetErrorString(e), grid_blocks);
}
```

```cpp
#include <hip/hip_runtime.h>
#include <hip/hip_cooperative_groups.h>
#include <cstdio>
namespace cg = cooperative_groups;

#define LAS __attribute__((address_space(3)))
typedef unsigned short bf16_t;
typedef short bf16x8 __attribute__((ext_vector_type(8)));
typedef float f32x4 __attribute__((ext_vector_type(4)));
typedef unsigned u32x4 __attribute__((ext_vector_type(4)));
typedef unsigned u32x2 __attribute__((ext_vector_type(2)));
typedef float f32x16 __attribute__((ext_vector_type(16)));
typedef float f32x2 __attribute__((ext_vector_type(2)));
typedef __bf16 nbf16x2 __attribute__((ext_vector_type(2)));

constexpr int T = 16384, D = 1024, SEQ = 2048, NB = 8, FF = 2816, NIN = 5632, INW = 5640, NMOD = 9216;
constexpr int C_QSB = 0, C_KSB = 512, C_VSB = 1024, C_QDN = 1536, C_KDN = 2048, C_VDN = 2560, C_ZDN = 3072, C_RSB = 3584, C_RDN = 4608;
constexpr float EPS = 1e-6f;
constexpr int LDS_BYTES = 163840, BST_OFF = LDS_BYTES - 64;
constexpr size_t MiB = 1024 * 1024;
constexpr size_t WS_MOD = 0, WS_BG = 512 * 1024, WS_SS = 242 * MiB, WS_W = 2 * MiB;
constexpr size_t W_FFIN = WS_W, W_FFOUT = W_FFIN + (size_t)2 * FF * D * 2, W_IN = W_FFOUT + (size_t)D * FF * 2, W_UPSB = W_IN + (size_t)NIN * D * 2,
                 W_UPDN = W_UPSB + (size_t)D * 512 * 2, W_OUT = W_UPDN + (size_t)D * 512 * 2, W_END = W_OUT + (size_t)D * D * 2;
constexpr size_t WS_U = 34 * MiB, WS_P = 66 * MiB, WS_F2IN = 242 * MiB;
static_assert(W_END <= WS_U, "weights overflow");
constexpr size_t WS_EGL = 384 * 1024, WS_CTR = 400 * 1024, WS_BAR = 416 * 1024, WS_XCNT = 432 * 1024, WS_ZEND = 464 * 1024;
constexpr size_t WS_XSLOT = 1 * MiB;
constexpr size_t WS_VT = W_FFIN;
static_assert((size_t)T * 512 * 2 <= W_IN - W_FFIN, "Vt overflow");

enum { I_X = 0, I_C, I_WADA, I_BADA, I_GFFN1, I_WFFN1IN, I_WFFN1OUT, I_GMIX, I_WIN, I_GQSB, I_GKSB, I_WCONV, I_ALOG, I_DTBIAS, I_GDNOUT, I_WUPSB, I_WUPDN, I_WOUT, I_GFFN2, I_WFFN2IN, I_WFFN2OUT, N_IN };
struct Params { const float* in[N_IN]; float* out; unsigned char* ws; };

__device__ __forceinline__ float bf_lo(unsigned w) { return __uint_as_float(w << 16); }
__device__ __forceinline__ float bf_hi(unsigned w) { return __uint_as_float(w & 0xffff0000u); }
__device__ __forceinline__ float bf2f(bf16_t b) { return __uint_as_float(((unsigned)b) << 16); }
__device__ __forceinline__ unsigned pk2(float lo, float hi) { unsigned r; asm("v_cvt_pk_bf16_f32 %0, %1, %2" : "=v"(r) : "v"(lo), "v"(hi)); return r; }
__device__ __forceinline__ unsigned cpk2(float lo, float hi) { const f32x2 v = {lo, hi}; return __builtin_bit_cast(unsigned, __builtin_convertvector(v, nbf16x2)); }
__device__ __forceinline__ bf16_t f2bf(float f) { return (bf16_t)(pk2(f, 0.f) & 0xffffu); }
__device__ __forceinline__ float fexp(float x) { return __builtin_amdgcn_exp2f(x * 1.4426950408889634f); }
__device__ __forceinline__ float flog(float x) { return __builtin_amdgcn_logf(x) * 0.6931471805599453f; }
__device__ __forceinline__ float fsigmoid(float x) { return __builtin_amdgcn_rcpf(1.f + fexp(-x)); }
__device__ __forceinline__ float fsilu(float x) { return x * fsigmoid(x); }
__device__ __forceinline__ float fsoftplus(float x) { return fmaxf(x, 0.f) + flog(1.f + fexp(-fabsf(x))); }
__device__ __forceinline__ float wave_sum(float v) {
#pragma unroll
    for (int o = 1; o < 64; o <<= 1) v += __shfl_xor(v, o);
    return v;
}
#define LDS_WAIT() asm volatile("s_waitcnt lgkmcnt(0)" ::: "memory")

namespace pg8 {
constexpr int BM = 256, BK = 64, HALF = 128, HTB = HALF * BK * 2, STAGE_BYTES = 8 * HTB, NXCD = 8, WGM = 8;
__host__ __device__ __forceinline__ int lds_byte(int r, int c) { const int st = (r >> 4) * 2 + (c >> 5), rr = r & 15, cc = c & 31, ob = rr * 64 + cc * 2; return st * 1024 + (ob ^ (((ob >> 9) & 1) << 5)); }
__host__ __device__ __forceinline__ void stage_rc(int b, int& R, int& C) { const int st = b / 1024, sb = b % 1024, swz = sb ^ (((sb >> 9) & 1) << 5); R = (st >> 1) * 16 + swz / 64; C = (st & 1) * 32 + (swz % 64) / 2; }
__host__ __device__ __forceinline__ int perm32(int rho) { const int n = rho >> 4, i = rho & 15; return 8 * (i >> 2) + 4 * n + (i & 3); }
struct Unit { int pm, pn; };
struct Gemm { const bf16_t* A; const bf16_t* Bt; int M, N, K, lda; int jt; int jbytes; };
struct StaticOrder {
    int nM, nN, nwg, G, c;
    __host__ __device__ void init(int M, int N, int G_, int c_) { nM = M / BM; nN = N / BM; nwg = nM * nN; G = G_; c = c_; }
    __host__ __device__ bool next(int i, Unit& u) const {
        const long L = (long)i * G + c; if (L >= nwg) return false;
        int wgid = (int)L; { const int q = nwg / NXCD, r = nwg % NXCD, xcd = wgid % NXCD, off = wgid / NXCD; wgid = (xcd < r ? xcd * (q + 1) : r * (q + 1) + (xcd - r) * q) + off; }
        const int nig = WGM * nN, gid = wgid / nig, fm = gid * WGM, gsz = (nM - fm) < WGM ? (nM - fm) : WGM;
        u.pm = fm + ((wgid % nig) % gsz); u.pn = (wgid % nig) / gsz; return true;
    }
};
template <class Epi>
__device__ __forceinline__ void gemm_phase(LAS unsigned char* lds, const Gemm g, const StaticOrder& S, const Epi E) {
    int tid = threadIdx.x; asm volatile("" : "+v"(tid));
    const int wid = __builtin_amdgcn_readfirstlane(tid >> 6), lane = tid & 63, wr = wid >> 2, wc = wid & 3, fr = lane & 15, fq = lane >> 4;
    const int K = g.K, nt = K / BK, lda = g.lda;
    unsigned voffA[2], voffB[2];
#pragma unroll
    for (int i = 0; i < 2; ++i) { int R, C; stage_rc(tid * 16 + i * 8192, R, C); const int Rb = Epi::PERM ? ((R & ~31) + perm32(R & 31)) : R;
        voffA[i] = (unsigned)(R * lda + C) * 2u; voffB[i] = (unsigned)(Rb * K + C) * 2u; }
    const size_t kstep = (size_t)(BK * 2);
    const size_t hstepA = (size_t)HALF * lda * 2, hstepB = (size_t)HALF * K * 2;
    const size_t tstepA = 2 * hstepA, tstepB = 2 * hstepB;
    const unsigned ldsw = (unsigned)wid * 1024u;
    const int aoff = lds_byte(wr * 64 + fr, fq * 8), boff = lds_byte(wc * 32 + fr, fq * 8);
#define PG8_SA(b, h) (((b) * 2 + (h)) * HTB)
#define PG8_SB(b, h) ((4 + (b) * 2 + (h)) * HTB)
#define PG8_STAGE(bufoff, gbase, voff) do { _Pragma("unroll") for (int _i = 0; _i < 2; ++_i) \
        __builtin_amdgcn_global_load_lds((const unsigned*)((const char*)(gbase) + (voff)[_i]), (LAS unsigned*)(lds + (bufoff) + ldsw + _i * 8192), 16, 0, 0); } while (0)
#define PG8_LDA(dst, b, h) do { _Pragma("unroll") for (int m = 0; m < 4; ++m) _Pragma("unroll") for (int k = 0; k < 2; ++k) dst[m][k] = *(const LAS bf16x8*)(lds + PG8_SA(b, h) + aoff + m * 2048 + k * 1024); } while (0)
#define PG8_LDB(dst, b, h) do { _Pragma("unroll") for (int n = 0; n < 2; ++n) _Pragma("unroll") for (int k = 0; k < 2; ++k) dst[n][k] = *(const LAS bf16x8*)(lds + PG8_SB(b, h) + boff + n * 2048 + k * 1024); } while (0)
#define PG8_MMA(ai, bj, At, Bt) do { __builtin_amdgcn_s_setprio(1); _Pragma("unroll") for (int m = 0; m < 4; ++m) _Pragma("unroll") for (int n = 0; n < 2; ++n) _Pragma("unroll") for (int k = 0; k < 2; ++k) \
        acc[ai][bj][m][n] = __builtin_amdgcn_mfma_f32_16x16x32_bf16(Bt[n][k], At[m][k], acc[ai][bj][m][n], 0, 0, 0); __builtin_amdgcn_s_setprio(0); } while (0)
#define PG8_WAIT_V(n) asm volatile("s_waitcnt vmcnt(" #n ")" ::: "memory")
#define PG8_WAIT_L(n) asm volatile("s_waitcnt lgkmcnt(" #n ")" ::: "memory")
#define PG8_BAR __builtin_amdgcn_s_barrier()
#define PG8_SCHED __builtin_amdgcn_sched_barrier(0)
    Unit cur, nxt; int ui = 0;
    if (!S.next(0, cur)) return;
    f32x4 acc[2][2][4][2];
#pragma unroll
    for (int a = 0; a < 2; ++a)
#pragma unroll
        for (int b = 0; b < 2; ++b)
#pragma unroll
            for (int m = 0; m < 4; ++m)
#pragma unroll
                for (int n = 0; n < 2; ++n) acc[a][b][m][n] = (f32x4){0.f, 0.f, 0.f, 0.f};
    bf16x8 At[4][2], B0[2][2], B1[2][2];
    const char* cA = (const char*)g.A + (size_t)cur.pm * tstepA; const char* cB = (const char*)g.Bt + (size_t)cur.pn * tstepB;
    PG8_STAGE(PG8_SB(0, 0), cB, voffB); PG8_STAGE(PG8_SA(0, 0), cA, voffA); PG8_STAGE(PG8_SB(0, 1), cB + hstepB, voffB); PG8_STAGE(PG8_SA(0, 1), cA + hstepA, voffA);
    if (wr == 1) PG8_BAR;
    PG8_WAIT_V(4); PG8_BAR;
    PG8_STAGE(PG8_SB(1, 0), cB + kstep, voffB); PG8_STAGE(PG8_SA(1, 0), cA + kstep, voffA); PG8_STAGE(PG8_SB(1, 1), cB + hstepB + kstep, voffB);
    PG8_WAIT_V(6); PG8_BAR;
    for (;;) {
        const bool has_next = S.next(ui + 1, nxt);
        const char* nA = has_next ? (const char*)g.A + (size_t)nxt.pm * tstepA : cA; const char* nB = has_next ? (const char*)g.Bt + (size_t)nxt.pn * tstepB : cB;
        for (int t = 0; t < nt; t += 2) {
            const bool last = (t == nt - 2);
            const char* a1 = cA + (size_t)(t + 1) * kstep + (t + 1 >= g.jt ? g.jbytes : 0);
            const char* a2 = last ? nA : cA + (size_t)(t + 2) * kstep + (t + 2 >= g.jt ? g.jbytes : 0); const char* b2 = last ? nB : cB + (size_t)(t + 2) * kstep;
            const char* a3 = a2 + kstep; const char* b3 = b2 + kstep;
            if constexpr (Epi::HAS_MID) { if (t == g.jt) E.mid(acc, cur, wr, wc, fr, fq); }
            PG8_LDB(B0, 0, 0); PG8_SCHED; PG8_LDA(At, 0, 0); PG8_STAGE(PG8_SA(1, 1), a1 + hstepA, voffA);
            PG8_WAIT_L(8); PG8_BAR; PG8_WAIT_L(0); PG8_MMA(0, 0, At, B0); PG8_BAR; PG8_SCHED;
            PG8_LDB(B1, 0, 1); PG8_STAGE(PG8_SB(0, 0), b2, voffB);
            PG8_BAR; PG8_WAIT_L(0); PG8_MMA(0, 1, At, B1); PG8_BAR;
            PG8_LDA(At, 0, 1); PG8_STAGE(PG8_SA(0, 0), a2, voffA);
            PG8_BAR; PG8_WAIT_L(0); PG8_MMA(1, 0, At, B0); PG8_BAR; PG8_SCHED;
            PG8_STAGE(PG8_SB(0, 1), b2 + hstepB, voffB);
            PG8_WAIT_V(6); PG8_BAR; PG8_MMA(1, 1, At, B1); PG8_BAR;
            PG8_LDB(B0, 1, 0); PG8_SCHED; PG8_LDA(At, 1, 0); PG8_STAGE(PG8_SA(0, 1), a2 + hstepA, voffA);
            PG8_WAIT_L(8); PG8_BAR; PG8_WAIT_L(0); PG8_MMA(0, 0, At, B0); PG8_BAR; PG8_SCHED;
            PG8_LDB(B1, 1, 1); PG8_STAGE(PG8_SB(1, 0), b3, voffB);
            PG8_BAR; PG8_WAIT_L(0); PG8_MMA(0, 1, At, B1); PG8_BAR;
            PG8_LDA(At, 1, 1); PG8_STAGE(PG8_SA(1, 0), a3, voffA);
            PG8_BAR; PG8_WAIT_L(0); PG8_MMA(1, 0, At, B0); PG8_BAR; PG8_SCHED;
            PG8_STAGE(PG8_SB(1, 1), b3 + hstepB, voffB);
            PG8_WAIT_V(6); PG8_BAR; PG8_MMA(1, 1, At, B1); PG8_BAR;
        }
        if constexpr (!Epi::AFTER) E(acc, cur, wr, wc, fr, fq);
        if (!has_next) break;
#pragma unroll
        for (int a = 0; a < 2; ++a)
#pragma unroll
            for (int b = 0; b < 2; ++b)
#pragma unroll
                for (int m = 0; m < 4; ++m)
#pragma unroll
                    for (int n = 0; n < 2; ++n) acc[a][b][m][n] = (f32x4){0.f, 0.f, 0.f, 0.f};
        cur = nxt; cA = nA; cB = nB; ++ui;
    }
    PG8_WAIT_V(0);
    if (wr == 0) PG8_BAR;
    PG8_BAR;
    if constexpr (Epi::AFTER) E.fused(acc, cur, wr, wc, fr, fq, lds, wid, lane);
#undef PG8_SA
#undef PG8_SB
#undef PG8_STAGE
#undef PG8_LDA
#undef PG8_LDB
#undef PG8_MMA
#undef PG8_WAIT_V
#undef PG8_WAIT_L
#undef PG8_BAR
#undef PG8_SCHED
}
}

typedef const f32x4 (&AccRef)[2][2][4][2];
struct EpiBf16 {
    static constexpr bool PERM = true, HAS_MID = false, AFTER = false;
    bf16_t* O; int ldc;
    __device__ __forceinline__ void operator()(AccRef acc, const pg8::Unit& u, int wr, int wc, int fr, int fq) const {
        const int row0 = u.pm * 256 + wr * 64 + fr, col0 = u.pn * 256 + wc * 32 + 8 * fq;
#pragma unroll
        for (int ai = 0; ai < 2; ++ai)
#pragma unroll
            for (int m = 0; m < 4; ++m) { bf16_t* rowp = O + (size_t)(row0 + ai * 128 + m * 16) * ldc + col0;
#pragma unroll
                for (int bj = 0; bj < 2; ++bj) { const f32x4 v0 = acc[ai][bj][m][0], v1 = acc[ai][bj][m][1];
                    u32x4 w; w.x = pk2(v0[0], v0[1]); w.y = pk2(v0[2], v0[3]); w.z = pk2(v1[0], v1[1]); w.w = pk2(v1[2], v1[3]);
                    *(u32x4*)(rowp + bj * 128) = w; } }
    }
};
struct EpiSwiGLU {
    static constexpr bool PERM = true, HAS_MID = false, AFTER = false;
    bf16_t* O; int ldc;
    __device__ __forceinline__ void operator()(AccRef acc, const pg8::Unit& u, int wr, int wc, int fr, int fq) const {
        const int row0 = u.pm * 256 + wr * 64 + fr, col0 = u.pn * 128 + wc * 32 + 8 * fq;
#pragma unroll
        for (int ai = 0; ai < 2; ++ai)
#pragma unroll
            for (int m = 0; m < 4; ++m) { bf16_t* rowp = O + (size_t)(row0 + ai * 128 + m * 16) * ldc + col0;
                float r[8];
#pragma unroll
                for (int n = 0; n < 2; ++n)
#pragma unroll
                    for (int j = 0; j < 4; ++j) { const float a = acc[ai][0][m][n][j], b = acc[ai][1][m][n][j]; r[n * 4 + j] = fsilu(a) * b; }
                u32x4 w; w.x = pk2(r[0], r[1]); w.y = pk2(r[2], r[3]); w.z = pk2(r[4], r[5]); w.w = pk2(r[6], r[7]);
                *(u32x4*)rowp = w; }
    }
};
struct EpiResid {
    static constexpr bool PERM = false, HAS_MID = false, AFTER = false;
    const float* base; float* out; const float* gate; float scale;
    __device__ __forceinline__ void operator()(AccRef acc, const pg8::Unit& u, int wr, int wc, int fr, int fq) const {
        const int row0 = u.pm * 256 + wr * 64 + fr, col0 = u.pn * 256 + wc * 32 + 4 * fq;
        const float* gp = gate + (size_t)(u.pm >> 3) * NMOD + col0;
        f32x4 gv[2][2];
#pragma unroll
        for (int bj = 0; bj < 2; ++bj)
#pragma unroll
            for (int n = 0; n < 2; ++n) gv[bj][n] = *(const f32x4*)(gp + bj * 128 + n * 16) * scale;
#pragma unroll
        for (int ai = 0; ai < 2; ++ai) {
            f32x4 bs[4][2][2];
#pragma unroll
            for (int m = 0; m < 4; ++m) { const size_t off = (size_t)(row0 + ai * 128 + m * 16) * D + col0;
#pragma unroll
                for (int bj = 0; bj < 2; ++bj)
#pragma unroll
                    for (int n = 0; n < 2; ++n) bs[m][bj][n] = *(const f32x4*)(base + off + bj * 128 + n * 16); }
#pragma unroll
            for (int m = 0; m < 4; ++m) { const size_t off = (size_t)(row0 + ai * 128 + m * 16) * D + col0;
#pragma unroll
                for (int bj = 0; bj < 2; ++bj)
#pragma unroll
                    for (int n = 0; n < 2; ++n) *(f32x4*)(out + off + bj * 128 + n * 16) = bs[m][bj][n] + gv[bj][n] * acc[ai][bj][m][n]; }
            asm volatile("" ::: "memory"); }
    }
};
struct EpiResidNorm {
    static constexpr bool PERM = false, HAS_MID = false, AFTER = true;
    const float* base; float* out; const float* gate;
    const float* gain; const float* modsh; bf16_t* un;
    unsigned* xslot; unsigned* cnt; float scale; int pad_;
    __device__ __forceinline__ void fused(f32x4 (&acc)[2][2][4][2], const pg8::Unit& u, int wr, int wc, int fr, int fq, LAS unsigned char* lds, int wid, int lane) const {
        const int row0 = u.pm * 256 + wr * 64 + fr, col0 = u.pn * 256 + wc * 32 + 4 * fq, tid = wid * 64 + lane;
        LAS float* Pt = (LAS float*)lds; LAS float* St = (LAS float*)(lds + 4096);
        const float* gp = gate + (size_t)(u.pm >> 3) * NMOD + col0;
        f32x4 gv[2][2];
#pragma unroll
        for (int bj = 0; bj < 2; ++bj)
#pragma unroll
            for (int n = 0; n < 2; ++n) gv[bj][n] = *(const f32x4*)(gp + bj * 128 + n * 16) * scale;
#pragma unroll
        for (int ai = 0; ai < 2; ++ai) {
            f32x4 bs[4][2][2];
#pragma unroll
            for (int m = 0; m < 4; ++m) { const size_t off = (size_t)(row0 + ai * 128 + m * 16) * D + col0;
#pragma unroll
                for (int bj = 0; bj < 2; ++bj)
#pragma unroll
                    for (int n = 0; n < 2; ++n) bs[m][bj][n] = *(const f32x4*)(base + off + bj * 128 + n * 16); }
#pragma unroll
            for (int m = 0; m < 4; ++m) { const size_t off = (size_t)(row0 + ai * 128 + m * 16) * D + col0; float sq = 0.f;
#pragma unroll
                for (int bj = 0; bj < 2; ++bj)
#pragma unroll
                    for (int n = 0; n < 2; ++n) { const f32x4 hv = bs[m][bj][n] + gv[bj][n] * acc[ai][bj][m][n]; acc[ai][bj][m][n] = hv; *(f32x4*)(out + off + bj * 128 + n * 16) = hv;
                        sq += (hv[0] * hv[0] + hv[1] * hv[1]) + (hv[2] * hv[2] + hv[3] * hv[3]); }
                sq += __shfl_xor(sq, 16); sq += __shfl_xor(sq, 32);
                if (fq == 0) Pt[(ai * 128 + wr * 64 + m * 16 + fr) * 4 + wc] = sq; }
            asm volatile("" ::: "memory"); }
        LDS_WAIT(); __syncthreads();
        if (tid < 256) { const f32x4 t4 = *(const LAS f32x4*)(Pt + tid * 4); const float sq = (t4[0] + t4[1]) + (t4[2] + t4[3]);
            __hip_atomic_store(xslot + ((size_t)(u.pm * 256 + tid) * 4 + u.pn), __float_as_uint(sq), __ATOMIC_RELAXED, __HIP_MEMORY_SCOPE_AGENT);
            asm volatile("s_waitcnt vmcnt(0)" ::: "memory");
            if (lane == 0) __hip_atomic_fetch_add(cnt + 64 * u.pm, 1u, __ATOMIC_RELAXED, __HIP_MEMORY_SCOPE_AGENT); }
        if (wid == 0) { unsigned spins = 0;
            while ((unsigned)__builtin_amdgcn_readfirstlane(__hip_atomic_load(cnt + 64 * u.pm, __ATOMIC_RELAXED, __HIP_MEMORY_SCOPE_AGENT)) < 16u) { __builtin_amdgcn_s_sleep(2); if (++spins > (1u << 22)) break; }
            __builtin_amdgcn_fence(__ATOMIC_ACQUIRE, "agent"); asm volatile("s_waitcnt vmcnt(0)" ::: "memory"); }
        __syncthreads();
        if (tid < 256) { const unsigned* sl = xslot + (size_t)(u.pm * 256 + tid) * 4; float sq = 0.f;
#pragma unroll
            for (int t = 0; t < 4; ++t) sq += __uint_as_float(__hip_atomic_load(sl + t, __ATOMIC_RELAXED, __HIP_MEMORY_SCOPE_AGENT));
            St[tid] = 1.0f / sqrtf(sq * (1.f / D) + EPS); }
        LDS_WAIT(); __syncthreads();
        const float* shp = modsh + (size_t)(u.pm >> 3) * NMOD + col0;
        f32x4 gs[2][2], sh[2][2];
#pragma unroll
        for (int bj = 0; bj < 2; ++bj)
#pragma unroll
            for (int n = 0; n < 2; ++n) { gs[bj][n] = *(const f32x4*)(gain + col0 + bj * 128 + n * 16) * (*(const f32x4*)(shp + D + bj * 128 + n * 16) + 1.0f); sh[bj][n] = *(const f32x4*)(shp + bj * 128 + n * 16); }
#pragma unroll
        for (int ai = 0; ai < 2; ++ai)
#pragma unroll
            for (int m = 0; m < 4; ++m) { const int r = ai * 128 + wr * 64 + m * 16 + fr; const float rstd = St[r]; bf16_t* up = un + (size_t)(u.pm * 256 + r) * D + col0;
#pragma unroll
                for (int bj = 0; bj < 2; ++bj)
#pragma unroll
                    for (int n = 0; n < 2; ++n) { const f32x4 uu = acc[ai][bj][m][n] * rstd * gs[bj][n] + sh[bj][n];
                        *(u32x2*)(up + bj * 128 + n * 16) = (u32x2){pk2(uu[0], uu[1]), pk2(uu[2], uu[3])}; } }
        __syncthreads();
    }
};
struct EpiGateFused {
    static constexpr bool PERM = true, HAS_MID = true, AFTER = false;
    const bf16_t* Rsb; const bf16_t* Rdn; bf16_t* O;
    __device__ __forceinline__ void mid(f32x4 (&acc)[2][2][4][2], const pg8::Unit& u, int wr, int wc, int fr, int fq) const {
        int row0 = u.pm * 256 + wr * 64 + fr, col0 = u.pn * 256 + wc * 32 + 8 * fq;
        asm volatile("" : "+v"(row0), "+v"(col0));
#pragma unroll
        for (int ai = 0; ai < 2; ++ai)
#pragma unroll
            for (int mp = 0; mp < 2; ++mp) {
                u32x4 av[2][2], dv[2][2];
#pragma unroll
                for (int mm = 0; mm < 2; ++mm)
#pragma unroll
                    for (int bj = 0; bj < 2; ++bj) { const size_t row = (size_t)(row0 + ai * 128 + (2 * mp + mm) * 16);
                        av[mm][bj] = *(const u32x4*)(Rsb + row * NIN + col0 + bj * 128); dv[mm][bj] = *(const u32x4*)(Rdn + row * NIN + col0 + bj * 128); }
#pragma unroll
                for (int mm = 0; mm < 2; ++mm)
#pragma unroll
                    for (int bj = 0; bj < 2; ++bj) { const int m = 2 * mp + mm; const u32x4 a = av[mm][bj], d = dv[mm][bj];
                        const float ra[8] = {bf_lo(a.x), bf_hi(a.x), bf_lo(a.y), bf_hi(a.y), bf_lo(a.z), bf_hi(a.z), bf_lo(a.w), bf_hi(a.w)};
                        const float rd[8] = {bf_lo(d.x), bf_hi(d.x), bf_lo(d.y), bf_hi(d.y), bf_lo(d.z), bf_hi(d.z), bf_lo(d.w), bf_hi(d.w)};
#pragma unroll
                        for (int e = 0; e < 8; ++e) { const float q = (1.0f + fexp(fminf(-rd[e], 30.0f))) * __builtin_amdgcn_rcpf(1.0f + fexp(-ra[e])); acc[ai][bj][m][e >> 2][e & 3] *= q; } }
                asm volatile("" ::: "memory"); }
    }
    __device__ __forceinline__ void operator()(AccRef acc, const pg8::Unit& u, int wr, int wc, int fr, int fq) const {
        const int row0 = u.pm * 256 + wr * 64 + fr, col0 = u.pn * 256 + wc * 32 + 8 * fq;
#pragma unroll
        for (int ai = 0; ai < 2; ++ai) {
            u32x4 dv[4][2];
#pragma unroll
            for (int m = 0; m < 4; ++m)
#pragma unroll
                for (int bj = 0; bj < 2; ++bj) dv[m][bj] = *(const u32x4*)(Rdn + (size_t)(row0 + ai * 128 + m * 16) * NIN + col0 + bj * 128);
#pragma unroll
            for (int m = 0; m < 4; ++m) { const size_t row = (size_t)(row0 + ai * 128 + m * 16);
#pragma unroll
                for (int bj = 0; bj < 2; ++bj) { const u32x4 d = dv[m][bj];
                    const f32x4 v0 = acc[ai][bj][m][0], v1 = acc[ai][bj][m][1];
#define SGC(x) __builtin_amdgcn_rcpf(1.0f + fexp(fminf(-(x), 30.0f)))
                    const float r[8] = {SGC(bf_lo(d.x)) * v0[0], SGC(bf_hi(d.x)) * v0[1], SGC(bf_lo(d.y)) * v0[2], SGC(bf_hi(d.y)) * v0[3],
                                        SGC(bf_lo(d.z)) * v1[0], SGC(bf_hi(d.z)) * v1[1], SGC(bf_lo(d.w)) * v1[2], SGC(bf_hi(d.w)) * v1[3]};
#undef SGC
                    u32x4 w; w.x = pk2(r[0], r[1]); w.y = pk2(r[2], r[3]); w.z = pk2(r[4], r[5]); w.w = pk2(r[6], r[7]);
                    *(u32x4*)(O + row * D + col0 + bj * 128) = w; } } }
    }
};
template <class Epi> __device__ __forceinline__ void run_gemm(LAS unsigned char* lds, const bf16_t* A, int lda, const bf16_t* Bt, int N, int K, const Epi E, int jt = 1 << 30, int jbytes = 0) {
    pg8::Gemm g{A, Bt, T, N, K, lda, jt, jbytes}; pg8::StaticOrder S; S.init(T, N, (int)gridDim.x, (int)blockIdx.x);
    pg8::gemm_phase<Epi>(lds, g, S, E);
}

__device__ __forceinline__ void transpose_item(const float* W, int ldw, int s0, int k0, bf16_t* WT, int ldk, int d0, LAS float* scr, int lane) {
    float tv[32];
#pragma unroll
    for (int i = 0; i < 32; ++i) tv[i] = W[(size_t)(k0 + 2 * i + (lane >> 5)) * ldw + s0 + (lane & 31)];
#pragma unroll
    for (int i = 0; i < 32; ++i) scr[(2 * i + (lane >> 5)) * 33 + (lane & 31)] = tv[i];
    LDS_WAIT();
    const int c = lane & 7;
#pragma unroll
    for (int j = 0; j < 4; ++j) { const int n = (lane >> 3) + 8 * j; const LAS float* s = scr + (8 * c) * 33 + n;
        u32x4 o; o.x = pk2(s[0 * 33], s[1 * 33]); o.y = pk2(s[2 * 33], s[3 * 33]); o.z = pk2(s[4 * 33], s[5 * 33]); o.w = pk2(s[6 * 33], s[7 * 33]);
        *(u32x4*)(WT + (size_t)(d0 + n) * ldk + k0 + 8 * c) = o; }
    LDS_WAIT();
}
struct TrD { const float* W; int ldw, s0, k0; bf16_t* WT; int ldk, d0; };
__device__ __forceinline__ TrD ffn_item_desc(const float* w_in, const float* w_out, bf16_t* wt_in, bf16_t* wt_out, int it) {
    if (it < 2816) { const int kb = it / 176, nb = it % 176, d0 = nb * 32, pn = d0 >> 8, bj = (d0 >> 7) & 1, c = d0 & 127, s0 = bj * FF + pn * 128 + c; return TrD{w_in, 2 * FF, s0, kb * 64, wt_in, D, d0}; }
    const int r = it - 2816, kb = r / 32, nb = r % 32; return TrD{w_out, D, nb * 32, kb * 64, wt_out, FF, nb * 32};
}
__device__ __forceinline__ void ffn_weight_items(const float* w_in, const float* w_out, bf16_t* wt_in, bf16_t* wt_out, LAS float* scr, int gw, int ngw, int lane, int lo = 0, int NIT = 2816 + 1408) {
    gw += lo;
    float tv[32];
#define TR_LOAD(d_) do { _Pragma("unroll") for (int i = 0; i < 32; ++i) tv[i] = (d_).W[(size_t)((d_).k0 + 2 * i + (lane >> 5)) * (d_).ldw + (d_).s0 + (lane & 31)]; } while (0)
    if (gw < NIT) { const TrD d0_ = ffn_item_desc(w_in, w_out, wt_in, wt_out, gw); TR_LOAD(d0_); }
    for (int it = gw; it < NIT; it += ngw) {
        const TrD d = ffn_item_desc(w_in, w_out, wt_in, wt_out, it);
#pragma unroll
        for (int i = 0; i < 32; ++i) scr[(2 * i + (lane >> 5)) * 33 + (lane & 31)] = tv[i];
        LDS_WAIT();
        if (it + ngw < NIT) { const TrD dn = ffn_item_desc(w_in, w_out, wt_in, wt_out, it + ngw); TR_LOAD(dn); }
        const int c = lane & 7;
#pragma unroll
        for (int j = 0; j < 4; ++j) { const int n = (lane >> 3) + 8 * j; const LAS float* s_ = scr + (8 * c) * 33 + n;
            u32x4 o; o.x = pk2(s_[0 * 33], s_[1 * 33]); o.y = pk2(s_[2 * 33], s_[3 * 33]); o.z = pk2(s_[4 * 33], s_[5 * 33]); o.w = pk2(s_[6 * 33], s_[7 * 33]);
            *(u32x4*)(d.WT + (size_t)(d.d0 + n) * d.ldk + d.k0 + 8 * c) = o; }
        LDS_WAIT();
    }
#undef TR_LOAD
}
__device__ __forceinline__ void mixer_weight_items(const Params& p, LAS float* scr, int gw, int ngw, int lane) {
    unsigned char* ws = p.ws;
    for (int it = gw; it < 2816 + 256 + 256 + 512; it += ngw) {
        int r = it;
        if (r < 2816) { const int kb = r / 176, nb = r % 176, d0 = nb * 32, s0 = d0 < C_RSB ? d0 : d0 + 8; transpose_item(p.in[I_WIN], INW, s0, kb * 64, (bf16_t*)(ws + W_IN), D, d0, scr, lane); continue; } r -= 2816;
        if (r < 256) { const int kb = r / 32, nb = r % 32; transpose_item(p.in[I_WUPSB], D, nb * 32, kb * 64, (bf16_t*)(ws + W_UPSB), D, nb * 32, scr, lane); continue; } r -= 256;
        if (r < 256) { const int kb = r / 32, nb = r % 32; transpose_item(p.in[I_WUPDN], D, nb * 32, kb * 64, (bf16_t*)(ws + W_UPSB) + 512, D, nb * 32, scr, lane); continue; } r -= 256;
        { const int kb = r / 32, nb = r % 32; transpose_item(p.in[I_WOUT], D, nb * 32, kb * 64, (bf16_t*)(ws + W_OUT), D, nb * 32, scr, lane); }
    }
}
__device__ __forceinline__ void mod_item(const Params& p, LAS unsigned char* lds, int cb, int tid, int wave, int lane) {
    asm volatile("" : "+v"(tid), "+v"(lane));
    LAS float* sc = (LAS float*)lds; LAS float* red = (LAS float*)(lds + 32768);
    for (int i = tid; i < NB * D; i += 512) sc[i] = fsilu(p.in[I_C][i]);
    __syncthreads();
    const float* wa = p.in[I_WADA] + cb * 64 + lane;
    float acc[NB];
#pragma unroll
    for (int b = 0; b < NB; ++b) acc[b] = 0.f;
    for (int k = wave * 128; k < wave * 128 + 128; k += 32) {
        float w[32];
#pragma unroll
        for (int e = 0; e < 32; ++e) w[e] = wa[(size_t)(k + e) * NMOD];
#pragma unroll
        for (int b = 0; b < NB; ++b)
#pragma unroll
            for (int e4 = 0; e4 < 8; ++e4) { const f32x4 s = *(const LAS f32x4*)(sc + b * D + k + 4 * e4); acc[b] += s[0] * w[4 * e4] + s[1] * w[4 * e4 + 1] + s[2] * w[4 * e4 + 2] + s[3] * w[4 * e4 + 3]; }
    }
#pragma unroll
    for (int b = 0; b < NB; ++b) red[(wave * NB + b) * 64 + lane] = acc[b];
    __syncthreads();
    { const int b = tid >> 6; float s = p.in[I_BADA][cb * 64 + lane];
#pragma unroll
        for (int w = 0; w < 8; ++w) s += red[(w * NB + b) * 64 + lane];
        ((float*)(p.ws + WS_MOD))[b * NMOD + cb * 64 + lane] = s; }
    __syncthreads();
}

template <bool DN>
__device__ __forceinline__ void norm_mod_phase(const Params& p, LAS unsigned char* lds, const float* src, const float* gain, int midx, bf16_t* dst, int tid, int wave, int lane) {
    asm volatile("" : "+v"(tid), "+v"(lane));
    const float* mod = (const float*)(p.ws + WS_MOD);
    LAS float* wl = (LAS float*)lds;
    if (DN) { for (int i = tid; i < D * 8; i += 512) { const int k = i >> 3, j = i & 7; wl[8 * k + 4 * (k >> 2) + j] = p.in[I_WIN][(size_t)k * INW + C_RSB + j]; } __syncthreads(); }
    f32x4 g4[4];
#pragma unroll
    for (int j = 0; j < 4; ++j) g4[j] = ((const f32x4*)gain)[lane + 64 * j];
    const int rstep = gridDim.x * 8;
    f32x4 nv[4];
    { const int r0 = blockIdx.x * 8 + wave; const f32x4* xr = (const f32x4*)(src + (size_t)(r0 < T ? r0 : 0) * D) + lane;
#pragma unroll
      for (int j = 0; j < 4; ++j) nv[j] = xr[64 * j]; }
    for (int row = blockIdx.x * 8 + wave; row < T; row += rstep) {
        const int b = row >> 11;
        const f32x4* shp = (const f32x4*)(mod + (size_t)b * NMOD + midx * D) + lane; const f32x4* scp = shp + D / 4;
        f32x4 v[4], shv[4], scv[4]; float ss = 0.f;
#pragma unroll
        for (int j = 0; j < 4; ++j) { v[j] = nv[j]; shv[j] = shp[64 * j]; scv[j] = scp[64 * j]; }
        { const int rn = row + rstep < T ? row + rstep : row; const f32x4* xr = (const f32x4*)(src + (size_t)rn * D) + lane;
#pragma unroll
          for (int j = 0; j < 4; ++j) nv[j] = xr[64 * j]; }
#pragma unroll
        for (int j = 0; j < 4; ++j) ss += (v[j][0] * v[j][0] + v[j][1] * v[j][1]) + (v[j][2] * v[j][2] + v[j][3] * v[j][3]);
        const float rstd = 1.0f / sqrtf(wave_sum(ss) * (1.f / D) + EPS);
        u32x2* o8 = (u32x2*)(dst + (size_t)row * D) + lane;
        float dot[8];
        if (DN) {
#pragma unroll
            for (int e = 0; e < 8; ++e) dot[e] = 0.f; }
#pragma unroll
        for (int j = 0; j < 4; ++j) { const f32x4 sh = shv[j], sc = scv[j];
            const f32x4 uu = v[j] * rstd * g4[j] * (sc + 1.0f) + sh;
            u32x2 w; w.x = pk2(uu[0], uu[1]); w.y = pk2(uu[2], uu[3]); o8[64 * j] = w;
            if (DN) {
#pragma unroll
                for (int e = 0; e < 4; ++e) { const int k = 4 * lane + 256 * j + e; const LAS f32x4* wp = (const LAS f32x4*)(wl + 8 * k + 4 * (k >> 2)); const f32x4 w0 = wp[0], w1 = wp[1];
                    dot[0] += uu[e] * w0[0]; dot[1] += uu[e] * w0[1]; dot[2] += uu[e] * w0[2]; dot[3] += uu[e] * w0[3];
                    dot[4] += uu[e] * w1[0]; dot[5] += uu[e] * w1[1]; dot[6] += uu[e] * w1[2]; dot[7] += uu[e] * w1[3]; } } }
        if (DN) {
#pragma unroll
            for (int e = 0; e < 8; ++e) dot[e] = wave_sum(dot[e]);
            float mine = dot[0];
#pragma unroll
            for (int e = 1; e < 8; ++e) mine = (lane == e) ? dot[e] : mine;
            if (lane < 8) { float r;
                if (lane < 4) r = 1.0f / (1.0f + expf(-mine));
                else { const int hh = lane - 4; const float a = mine + p.in[I_DTBIAS][hh]; const float sp = a > 20.f ? a : log1pf(expf(a)); r = -expf(p.in[I_ALOG][hh]) * sp; }
                ((float*)(p.ws + WS_BG))[(size_t)row * 8 + lane] = r; } }
    }
    if (DN) __syncthreads();
}

__device__ __forceinline__ void dn_gate_phase(const Params& p, LAS unsigned char* lds, const bf16_t* u2, int tid, int wave, int lane) {
    asm volatile("" : "+v"(tid), "+v"(lane));
    LAS float* wl = (LAS float*)lds;
    for (int i = tid; i < D * 8; i += 512) { const int k = i >> 3, j = i & 7; wl[8 * k + 4 * (k >> 2) + j] = p.in[I_WIN][(size_t)k * INW + C_RSB + j]; }
    __syncthreads();
    const int rstep = gridDim.x * 8;
    u32x4 na, nb;
    { const int r0 = blockIdx.x * 8 + wave; const bf16_t* up = u2 + (size_t)(r0 < T ? r0 : 0) * D + 16 * lane; na = ((const u32x4*)up)[0]; nb = ((const u32x4*)up)[1]; }
    for (int row = blockIdx.x * 8 + wave; row < T; row += rstep) {
        const u32x4 ca = na, cb = nb;
        { const int rn = row + rstep < T ? row + rstep : row; const bf16_t* up = u2 + (size_t)rn * D + 16 * lane; na = ((const u32x4*)up)[0]; nb = ((const u32x4*)up)[1]; }
        const unsigned w8[8] = {ca.x, ca.y, ca.z, ca.w, cb.x, cb.y, cb.z, cb.w};
        float dot[8];
#pragma unroll
        for (int e = 0; e < 8; ++e) dot[e] = 0.f;
#pragma unroll
        for (int e = 0; e < 16; ++e) { const int k = 16 * lane + e; const LAS f32x4* wp = (const LAS f32x4*)(wl + 8 * k + 4 * (k >> 2)); const f32x4 w0 = wp[0], w1 = wp[1];
            const float uv = (e & 1) ? bf_hi(w8[e >> 1]) : bf_lo(w8[e >> 1]);
            dot[0] += uv * w0[0]; dot[1] += uv * w0[1]; dot[2] += uv * w0[2]; dot[3] += uv * w0[3]; dot[4] += uv * w1[0]; dot[5] += uv * w1[1]; dot[6] += uv * w1[2]; dot[7] += uv * w1[3]; }
#pragma unroll
        for (int e = 0; e < 8; ++e) dot[e] = wave_sum(dot[e]);
        float mine = dot[0];
#pragma unroll
        for (int e = 1; e < 8; ++e) mine = (lane == e) ? dot[e] : mine;
        if (lane < 8) { float r;
            if (lane < 4) r = 1.0f / (1.0f + expf(-mine));
            else { const int hh = lane - 4; const float a = mine + p.in[I_DTBIAS][hh]; const float sp = a > 20.f ? a : log1pf(expf(a)); r = -expf(p.in[I_ALOG][hh]) * sp; }
            ((float*)(p.ws + WS_BG))[(size_t)row * 8 + lane] = r; }
    }
    __syncthreads();
}
__device__ __forceinline__ void unpack16(const bf16_t* p, float* f) {
    const u32x4 a = ((const u32x4*)p)[0], b = ((const u32x4*)p)[1];
    f[0] = bf_lo(a.x); f[1] = bf_hi(a.x); f[2] = bf_lo(a.y); f[3] = bf_hi(a.y); f[4] = bf_lo(a.z); f[5] = bf_hi(a.z); f[6] = bf_lo(a.w); f[7] = bf_hi(a.w);
    f[8] = bf_lo(b.x); f[9] = bf_hi(b.x); f[10] = bf_lo(b.y); f[11] = bf_hi(b.y); f[12] = bf_lo(b.z); f[13] = bf_hi(b.z); f[14] = bf_lo(b.w); f[15] = bf_hi(b.w);
}
__device__ __forceinline__ void pack16(bf16_t* p, const float* f) {
    u32x4 a, b; a.x = pk2(f[0], f[1]); a.y = pk2(f[2], f[3]); a.z = pk2(f[4], f[5]); a.w = pk2(f[6], f[7]); b.x = pk2(f[8], f[9]); b.y = pk2(f[10], f[11]); b.z = pk2(f[12], f[13]); b.w = pk2(f[14], f[15]);
    ((u32x4*)p)[0] = a; ((u32x4*)p)[1] = b;
}
__device__ __forceinline__ void prep_phase(const Params& p, int wave, int lane) {
    asm volatile("" : "+v"(lane));
    bf16_t* P = (bf16_t*)(p.ws + WS_P); bf16_t* U = (bf16_t*)(p.ws + WS_U);
    const int ch = 16 * lane;
    float gsb[16], wcv[4][16];
    { const float* gp = (ch < 512 ? p.in[I_GQSB] : p.in[I_GKSB]) + (ch & 63); const float sc = ch < 512 ? 0.18033688011112042f : 1.0f;
#pragma unroll
        for (int e = 0; e < 16; ++e) gsb[e] = gp[e] * sc;
#pragma unroll
        for (int i = 0; i < 4; ++i)
#pragma unroll
            for (int e = 0; e < 16; ++e) wcv[i][e] = p.in[I_WCONV][i * 1536 + ch + e]; }
    for (int row = blockIdx.x * 8 + wave; row < T; row += gridDim.x * 8) {
        const int tl = row & (SEQ - 1);
        { bf16_t* qp = P + (size_t)row * NIN + ch; float f[16]; unpack16(qp, f); float ss = 0.f;
#pragma unroll
            for (int e = 0; e < 16; ++e) ss += f[e] * f[e];
            ss += __shfl_xor(ss, 1); ss += __shfl_xor(ss, 2);
            const float rstd = 1.0f / sqrtf(ss * (1.f / 64.f) + EPS);
#pragma unroll
            for (int e = 0; e < 16; ++e) f[e] = f[e] * rstd * gsb[e];
            pack16(qp, f); }
        { float y[16];
#pragma unroll
            for (int e = 0; e < 16; ++e) y[e] = 0.f;
#pragma unroll
            for (int i = 0; i < 4; ++i) { if (tl - 3 + i >= 0) { float f[16]; unpack16(P + (size_t)(row - 3 + i) * NIN + C_QDN + ch, f);
#pragma unroll
                    for (int e = 0; e < 16; ++e) y[e] += wcv[i][e] * f[e]; } }
            float ss = 0.f;
#pragma unroll
            for (int e = 0; e < 16; ++e) { y[e] = fsilu(y[e]); ss += y[e] * y[e]; }
            ss += __shfl_xor(ss, 1); ss += __shfl_xor(ss, 2); ss += __shfl_xor(ss, 4);
            const float sc = (1.0f / sqrtf(ss + EPS)) * (ch < 512 ? 0.08838834764831845f : 1.0f);
#pragma unroll
            for (int e = 0; e < 16; ++e) y[e] *= sc;
            pack16(U + (size_t)row * D + ch, y); }
    }
    bf16_t* Vt = (bf16_t*)(p.ws + WS_VT);
    for (int it = blockIdx.x * 8 + wave; it < T / 16; it += gridDim.x * 8) {
        const int row0 = it * 16, b = row0 >> 11, tl0 = row0 & (SEQ - 1), c8 = lane * 8, hd = c8 >> 6, d0 = c8 & 63;
        u32x4 w[16];
#pragma unroll
        for (int r = 0; r < 16; ++r) w[r] = *(const u32x4*)(P + (size_t)(row0 + r) * NIN + C_VSB + c8);
#pragma unroll
        for (int e = 0; e < 8; ++e) {
            unsigned o[8];
#pragma unroll
            for (int i = 0; i < 8; ++i) {
                const int p0 = 2 * i, p1 = 2 * i + 1;
                const int k0 = 8 * ((p0 >> 2) & 1) + 4 * (p0 >> 3) + (p0 & 3), k1 = 8 * ((p1 >> 2) & 1) + 4 * (p1 >> 3) + (p1 & 3);
                const unsigned a0 = w[k0][e >> 1], a1 = w[k1][e >> 1];
                const unsigned lo = (e & 1) ? (a0 >> 16) : (a0 & 0xffffu), hi = (e & 1) ? (a1 & 0xffff0000u) : (a1 << 16);
                o[i] = lo | hi; }
            bf16_t* dst = Vt + ((size_t)(b * 8 + hd) * 64 + d0 + e) * SEQ + tl0;
            ((u32x4*)dst)[0] = (u32x4){o[0], o[1], o[2], o[3]}; ((u32x4*)dst)[1] = (u32x4){o[4], o[5], o[6], o[7]}; }
    }
}

__device__ __forceinline__ float xlane32(float x, int hh) {
    const unsigned xi = __builtin_bit_cast(unsigned, x);
    const u32x2 r = __builtin_amdgcn_permlane32_swap(xi, xi, false, false);
    return __builtin_bit_cast(float, hh ? r.x : r.y);
}
template <bool DIAG>
__device__ __forceinline__ void attn_tile(const f32x16& z, const bf16x8 (&vc)[4], f32x16& o0, f32x16& o1, float& R, int ql, int hh) {
    float sg[16], m[16];
#pragma unroll
    for (int i = 0; i < 16; ++i) { const float e = __builtin_amdgcn_exp2f(fminf(-z[i], 80.0f)); float sig = __builtin_amdgcn_rcpf(1.0f + e); float mm = e * sig;
        if (DIAG) { const bool act = ((i & 3) + 8 * (i >> 2) + 4 * hh) < ql; sig = act ? sig : 0.f; mm = act ? mm : 1.0f; }
        sg[i] = sig; m[i] = mm; }
    float g[4], gp[4];
#pragma unroll
    for (int bq = 0; bq < 4; ++bq) { g[bq] = (m[4 * bq] * m[4 * bq + 1]) * (m[4 * bq + 2] * m[4 * bq + 3]); gp[bq] = xlane32(g[bq], hh); }
    float outer[4]; float tb = R;
#pragma unroll
    for (int bq = 3; bq >= 0; --bq) { outer[bq] = hh == 0 ? tb * gp[bq] : tb; tb *= g[bq] * gp[bq]; }
    R = tb;
    float w[16];
#pragma unroll
    for (int bq = 0; bq < 4; ++bq) { const float s3 = outer[bq], s2 = s3 * m[4 * bq + 3], s1 = s2 * m[4 * bq + 2], s0 = s1 * m[4 * bq + 1];
        w[4 * bq + 3] = sg[4 * bq + 3] * s3; w[4 * bq + 2] = sg[4 * bq + 2] * s2; w[4 * bq + 1] = sg[4 * bq + 1] * s1; w[4 * bq] = sg[4 * bq] * s0; }
    bf16x8 wf[2];
#pragma unroll
    for (int s2 = 0; s2 < 2; ++s2) { const u32x4 pw = {cpk2(w[8 * s2], w[8 * s2 + 1]), cpk2(w[8 * s2 + 2], w[8 * s2 + 3]), cpk2(w[8 * s2 + 4], w[8 * s2 + 5]), cpk2(w[8 * s2 + 6], w[8 * s2 + 7])}; wf[s2] = __builtin_bit_cast(bf16x8, pw); }
    o0 = __builtin_amdgcn_mfma_f32_32x32x16_bf16(vc[0], wf[0], o0, 0, 0, 0); o0 = __builtin_amdgcn_mfma_f32_32x32x16_bf16(vc[1], wf[1], o0, 0, 0, 0);
    o1 = __builtin_amdgcn_mfma_f32_32x32x16_bf16(vc[2], wf[0], o1, 0, 0, 0); o1 = __builtin_amdgcn_mfma_f32_32x32x16_bf16(vc[3], wf[1], o1, 0, 0, 0);
}
__device__ __forceinline__ void attn_item_mfma(bf16_t* P, const bf16_t* Vt, int bh, int qt, int lane) {
    asm volatile("" : "+v"(lane));
    const int b = bh >> 3, h = bh & 7, ql = lane & 31, hh = lane >> 5, q0 = qt * 32;
    bf16_t* qrow = P + (size_t)(b * SEQ + q0 + ql) * NIN + C_QSB + h * 64;
    bf16x8 qf[4];
#pragma unroll
    for (int s = 0; s < 4; ++s) qf[s] = *(const bf16x8*)(qrow + 16 * s + 8 * hh);
    f32x16 o0, o1;
#pragma unroll
    for (int i = 0; i < 16; ++i) { o0[i] = 0.f; o1[i] = 0.f; }
    float R = 1.0f;
    const bf16_t* kb = P + (size_t)(b * SEQ + ql) * NIN + C_KSB + h * 64 + 8 * hh;
    const bf16_t* vb = Vt + ((size_t)bh * 64 + ql) * SEQ + 8 * hh;
    bf16x8 kf[4], vf[4], vn[4];
#define AT_LOADK(k0_) do { _Pragma("unroll") for (int s = 0; s < 4; ++s) kf[s] = *(const bf16x8*)(kb + (size_t)(k0_) * NIN + 16 * s); } while (0)
#define AT_LOADV(dst, k0_) do { _Pragma("unroll") for (int j = 0; j < 4; ++j) dst[j] = *(const bf16x8*)(vb + (size_t)(j >> 1) * 32 * SEQ + (k0_) + 16 * (j & 1)); } while (0)
#define AT_QK(zz) do { _Pragma("unroll") for (int i = 0; i < 16; ++i) zz[i] = 0.f; _Pragma("unroll") for (int s = 0; s < 4; ++s) zz = __builtin_amdgcn_mfma_f32_32x32x16_bf16(kf[s], qf[s], zz, 0, 0, 0); } while (0)
    f32x16 zc, zn;
    AT_LOADK(q0); AT_LOADV(vf, q0);
    AT_QK(zc);
    { const int k1 = (qt > 0 ? qt - 1 : 0) * 32; AT_LOADK(k1); AT_LOADV(vn, k1); }
    { AT_QK(zn);
      const int k2 = (qt > 1 ? qt - 2 : 0) * 32; AT_LOADK(k2);
      attn_tile<true>(zc, vf, o0, o1, R, ql, hh);
      zc = zn;
#pragma unroll
      for (int j = 0; j < 4; ++j) vf[j] = vn[j];
      const int k1 = (qt > 1 ? qt - 2 : 0) * 32; AT_LOADV(vn, k1); }
#pragma unroll 1
    for (int kt = qt - 1; kt >= 0; --kt) {
        AT_QK(zn);
        const int k2 = (kt > 1 ? kt - 2 : 0) * 32; AT_LOADK(k2);
        attn_tile<false>(zc, vf, o0, o1, R, ql, hh);
        if (__builtin_amdgcn_ballot_w64(R != 0.0f) == 0ull) break;
        zc = zn;
#pragma unroll
        for (int j = 0; j < 4; ++j) vf[j] = vn[j];
        AT_LOADV(vn, k2);
    }
#undef AT_LOADK
#undef AT_LOADV
#undef AT_QK
#pragma unroll
    for (int bq = 0; bq < 4; ++bq) {
        u32x2 w0 = {cpk2(o0[4 * bq], o0[4 * bq + 1]), cpk2(o0[4 * bq + 2], o0[4 * bq + 3])}, w1 = {cpk2(o1[4 * bq], o1[4 * bq + 1]), cpk2(o1[4 * bq + 2], o1[4 * bq + 3])};
        *(u32x2*)(qrow + 8 * bq + 4 * hh) = w0; *(u32x2*)(qrow + 32 + 8 * bq + 4 * hh) = w1; }
}
__device__ __forceinline__ size_t slotU(size_t t0, int h, int colbase, int f) { return (t0 + (size_t)(f >> 7)) * D + colbase + h * 128 + (f & 127); }
__device__ __forceinline__ size_t slotP(size_t t0, int h, int colbase, int f) { return (t0 + (size_t)(f >> 7)) * NIN + colbase + h * 128 + (f & 127); }
__device__ __forceinline__ int permpos(int x) { const int k = x & 15; return (x & ~15) + 8 * ((k >> 2) & 1) + 4 * (k >> 3) + (k & 3); }
__device__ __forceinline__ int crow(int r, int hh) { return (r & 3) + 8 * (r >> 2) + 4 * hh; }
__device__ __forceinline__ bf16x8 pack8(const f32x16& x, int s2) {
    const u32x4 pw = {cpk2(x[8 * s2], x[8 * s2 + 1]), cpk2(x[8 * s2 + 2], x[8 * s2 + 3]), cpk2(x[8 * s2 + 4], x[8 * s2 + 5]), cpk2(x[8 * s2 + 6], x[8 * s2 + 7])};
    return __builtin_bit_cast(bf16x8, pw);
}
#define MFMA32(a, b, c) __builtin_amdgcn_mfma_f32_32x32x16_bf16((a), (b), (c), 0, 0, 0)
constexpr int PT = 72, PQ = 136, PL = 68, PB = 40;
constexpr int CP_GC = 0, CP_BT = 256, CP_LS = 1024, CP_TU = CP_LS + 64 * PL * 4, CP_TW = CP_TU + 64 * PT * 2, CP_KT = CP_TW + 64 * PT * 2, CP_VT = CP_KT + 128 * PT * 2,
              CP_QS = CP_VT + 128 * PT * 2, CP_KS = CP_QS + 64 * PQ * 2, CP_AQ = CP_KS + 64 * PQ * 2, CP_L21 = CP_AQ + 64 * PT * 2, CP_TCM = CP_L21 + 32 * PB * 2, CP_T22 = CP_TCM + 32 * PB * 2, CP_END = CP_T22 + 32 * PB * 2;
static_assert(CP_END <= 131072, "chunk prep LDS");
__device__ __forceinline__ void gdn_chunk_prep_phase(const Params& p, LAS unsigned char* lds, int tid, int wave, int lane) {
    bf16_t* P = (bf16_t*)(p.ws + WS_P); bf16_t* U = (bf16_t*)(p.ws + WS_U); const float* BG = (const float*)(p.ws + WS_BG);
    u32x4 ka, kb, qa, qb, xv[4][2]; float gx = 0.f, gbt = 0.f;
#define CP_LOAD(item_) do { const int bh_ = (item_) >> 5, n_ = (item_) & 31, b_ = bh_ >> 2, h_ = bh_ & 3; const size_t t0_ = (size_t)b_ * SEQ + n_ * 64; const int tok_ = tid >> 3, c16_ = (tid & 7) * 16; \
        ka = *(const u32x4*)(U + (t0_ + tok_) * D + 512 + h_ * 128 + c16_); kb = *(const u32x4*)(U + (t0_ + tok_) * D + 512 + h_ * 128 + c16_ + 8); \
        qa = *(const u32x4*)(U + (t0_ + tok_) * D + h_ * 128 + c16_); qb = *(const u32x4*)(U + (t0_ + tok_) * D + h_ * 128 + c16_ + 8); \
        _Pragma("unroll") for (int i = 0; i < 4; ++i) { const bool ok = n_ * 64 + tok_ - 3 + i >= 0; const bf16_t* vp = P + (t0_ + tok_ - 3 + i) * NIN + C_VDN + h_ * 128 + c16_; \
            xv[i][0] = ok ? *(const u32x4*)vp : (u32x4){0u, 0u, 0u, 0u}; xv[i][1] = ok ? *(const u32x4*)(vp + 8) : (u32x4){0u, 0u, 0u, 0u}; } \
        if (tid < 64) { gx = BG[(t0_ + tid) * 8 + 4 + h_]; gbt = BG[(t0_ + tid) * 8 + h_]; } } while (0)
    if ((int)blockIdx.x < 1024) CP_LOAD((int)blockIdx.x);
  for (int item = blockIdx.x; item < 1024; item += gridDim.x) {
    asm volatile("" : "+v"(tid), "+v"(lane));
    const int bh = item >> 5, n = item & 31, b = bh >> 2, h = bh & 3, ql = lane & 31, hh = lane >> 5;
    const size_t t0 = (size_t)b * SEQ + n * 64;
    LAS float* gcS = (LAS float*)(lds + CP_GC); LAS float* btS = (LAS float*)(lds + CP_BT);
    LAS float* LS = (LAS float*)(lds + CP_LS);
    LAS bf16_t* TuS = (LAS bf16_t*)(lds + CP_TU); LAS bf16_t* TwS = (LAS bf16_t*)(lds + CP_TW);
    LAS bf16_t* kT = (LAS bf16_t*)(lds + CP_KT); LAS bf16_t* vT = (LAS bf16_t*)(lds + CP_VT); LAS bf16_t* qS = (LAS bf16_t*)(lds + CP_QS); LAS bf16_t* kS = (LAS bf16_t*)(lds + CP_KS);
    LAS bf16_t* AQ = (LAS bf16_t*)(lds + CP_AQ); LAS bf16_t* L21b = (LAS bf16_t*)(lds + CP_L21); LAS bf16_t* Tcm = (LAS bf16_t*)(lds + CP_TCM); LAS bf16_t* T22r = (LAS bf16_t*)(lds + CP_T22);
    if (tid < 64) { float x = gx;
#pragma unroll
        for (int o = 1; o < 64; o <<= 1) { const float y = __shfl_up(x, o); if (lane >= o) x += y; }
        gcS[tid] = x; btS[tid] = gbt; }
    { const int tok = tid >> 3, c16 = (tid & 7) * 16;
        *(LAS u32x4*)(kS + tok * PQ + c16) = ka; *(LAS u32x4*)(kS + tok * PQ + c16 + 8) = kb;
        *(LAS u32x4*)(qS + tok * PQ + c16) = qa; *(LAS u32x4*)(qS + tok * PQ + c16 + 8) = qb;
        const unsigned kw[8] = {ka.x, ka.y, ka.z, ka.w, kb.x, kb.y, kb.z, kb.w};
#pragma unroll
        for (int e = 0; e < 8; ++e) { kT[(c16 + 2 * e) * PT + tok] = (bf16_t)(kw[e] & 0xffffu); kT[(c16 + 2 * e + 1) * PT + tok] = (bf16_t)(kw[e] >> 16); }
        float y[16];
#pragma unroll
        for (int e = 0; e < 16; ++e) y[e] = 0.f;
#pragma unroll
        for (int i = 0; i < 4; ++i) { const float* wp = p.in[I_WCONV] + i * 1536 + 1024 + h * 128 + c16;
            const unsigned xw[8] = {xv[i][0].x, xv[i][0].y, xv[i][0].z, xv[i][0].w, xv[i][1].x, xv[i][1].y, xv[i][1].z, xv[i][1].w};
#pragma unroll
            for (int e = 0; e < 8; ++e) { y[2 * e] += wp[2 * e] * bf_lo(xw[e]); y[2 * e + 1] += wp[2 * e + 1] * bf_hi(xw[e]); } }
#pragma unroll
        for (int e = 0; e < 16; ++e) vT[(c16 + e) * PT + tok] = f2bf(fsilu(y[e])); }
    __syncthreads();
    if (item + (int)gridDim.x < 1024) CP_LOAD(item + (int)gridDim.x);
    if (wave == 0 || wave == 4 || wave == 5) {
        const int it = wave == 0 ? 0 : 1, jt = wave == 4 ? 1 : 0;
        f32x16 acc;
#pragma unroll
        for (int r = 0; r < 16; ++r) acc[r] = 0.f;
#pragma unroll
        for (int ks = 0; ks < 8; ++ks) acc = MFMA32(*(const LAS bf16x8*)(kS + (32 * it + ql) * PQ + 16 * ks + 8 * hh), *(const LAS bf16x8*)(kS + (32 * jt + ql) * PQ + 16 * ks + 8 * hh), acc);
        const int j = 32 * jt + ql; const float gj = gcS[j];
#pragma unroll
        for (int r = 0; r < 16; ++r) { const int i = 32 * it + crow(r, hh); const float l = (j < i) ? btS[i] * acc[r] * fexp(gcS[i] - gj) : 0.f;
            if (it != jt) L21b[(i - 32) * PB + j] = f2bf(l); else LS[i * PL + j] = l; }
    } else if (wave < 4) {
        const int jt = wave == 3 ? 1 : 0, it = wave == 1 ? 0 : 1;
        f32x16 acc;
#pragma unroll
        for (int r = 0; r < 16; ++r) acc[r] = 0.f;
#pragma unroll
        for (int ks = 0; ks < 8; ++ks) acc = MFMA32(*(const LAS bf16x8*)(kS + (32 * jt + ql) * PQ + 16 * ks + 8 * hh), *(const LAS bf16x8*)(qS + (32 * it + ql) * PQ + 16 * ks + 8 * hh), acc);
        const int i = 32 * it + ql; const float gi = gcS[i];
#pragma unroll
        for (int r = 0; r < 16; ++r) { const int j = 32 * jt + crow(r, hh); acc[r] = (j <= i) ? acc[r] * fexp(gi - gcS[j]) : 0.f; }
#pragma unroll
        for (int bq = 0; bq < 4; ++bq) *(LAS u32x2*)(AQ + i * PT + 32 * jt + 8 * bq + 4 * hh) = (u32x2){cpk2(acc[4 * bq], acc[4 * bq + 1]), cpk2(acc[4 * bq + 2], acc[4 * bq + 3])};
    } else {
        const float gl = gcS[63];
#pragma unroll
        for (int uu = 0; uu < 4; ++uu) { const int unit = (tid - 384) + 128 * uu, dk = unit >> 2, blk = unit & 3;
            const u32x4 k0 = *(const LAS u32x4*)(kT + dk * PT + 16 * blk), k1 = *(const LAS u32x4*)(kT + dk * PT + 16 * blk + 8);
            float kv[16] = {bf_lo(k0.x), bf_hi(k0.x), bf_lo(k0.y), bf_hi(k0.y), bf_lo(k0.z), bf_hi(k0.z), bf_lo(k0.w), bf_hi(k0.w), bf_lo(k1.x), bf_hi(k1.x), bf_lo(k1.y), bf_hi(k1.y), bf_lo(k1.z), bf_hi(k1.z), bf_lo(k1.w), bf_hi(k1.w)};
#pragma unroll
            for (int e = 0; e < 16; ++e) kv[e] *= fexp(gl - gcS[16 * blk + e]);
            float pv[16];
#pragma unroll
            for (int e = 0; e < 16; ++e) pv[permpos(e)] = kv[e];
            pack16(P + slotP(t0, h, C_VSB, dk * 64 + 16 * blk), pv); }
        if (tid == 384) ((float*)(p.ws + WS_EGL))[bh * 32 + n] = fexp(gl);
    }
    __syncthreads();
    if (wave == 0) {
        const LAS float* LB = LS + (32 * hh) * PL + 32 * hh;
        float Tc[32];
#pragma unroll
        for (int i = 0; i < 32; ++i) {
            float a0 = (ql == i) ? 1.0f : 0.f, a1 = 0.f, a2 = 0.f, a3 = 0.f;
#pragma unroll
            for (int j4 = 0; j4 < i; j4 += 4) { const f32x4 l4 = *(const LAS f32x4*)(LB + i * PL + j4);
                a0 -= l4[0] * Tc[j4]; if (j4 + 1 < i) a1 -= l4[1] * Tc[j4 + 1]; if (j4 + 2 < i) a2 -= l4[2] * Tc[j4 + 2]; if (j4 + 3 < i) a3 -= l4[3] * Tc[j4 + 3]; }
            Tc[i] = (a0 + a1) + (a2 + a3); }
        const int cg_ = 32 * hh + ql; const float bu = btS[cg_], bw = bu * fexp(gcS[cg_]);
#pragma unroll
        for (int i = 0; i < 32; ++i) { TuS[(32 * hh + i) * PT + cg_] = f2bf(Tc[i] * bu); TwS[(32 * hh + i) * PT + cg_] = f2bf(Tc[i] * bw); }
        if (hh == 0) {
#pragma unroll
            for (int i8 = 0; i8 < 4; ++i8) *(LAS u32x4*)(Tcm + ql * PB + 8 * i8) = (u32x4){cpk2(Tc[8 * i8], Tc[8 * i8 + 1]), cpk2(Tc[8 * i8 + 2], Tc[8 * i8 + 3]), cpk2(Tc[8 * i8 + 4], Tc[8 * i8 + 5]), cpk2(Tc[8 * i8 + 6], Tc[8 * i8 + 7])};
        } else {
#pragma unroll
            for (int i = 0; i < 32; ++i) T22r[i * PB + ql] = f2bf(Tc[i]);
        }
        LDS_WAIT();
        f32x16 x1;
#pragma unroll
        for (int r = 0; r < 16; ++r) x1[r] = 0.f;
#pragma unroll
        for (int s2 = 0; s2 < 2; ++s2) x1 = MFMA32(*(const LAS bf16x8*)(L21b + ql * PB + 16 * s2 + 8 * hh), *(const LAS bf16x8*)(Tcm + ql * PB + 16 * s2 + 8 * hh), x1);
        f32x16 yy;
#pragma unroll
        for (int r = 0; r < 16; ++r) yy[r] = 0.f;
#pragma unroll
        for (int s2 = 0; s2 < 2; ++s2) { const u32x2 lo = *(const LAS u32x2*)(T22r + ql * PB + 16 * s2 + 4 * hh), hi = *(const LAS u32x2*)(T22r + ql * PB + 16 * s2 + 8 + 4 * hh);
            const u32x4 af = {lo.x, lo.y, hi.x, hi.y};
            yy = MFMA32(__builtin_bit_cast(bf16x8, af), pack8(x1, s2), yy); }
        { const float bu0 = btS[ql], bw0 = bu0 * fexp(gcS[ql]);
#pragma unroll
            for (int r = 0; r < 16; ++r) { const int i2 = 32 + crow(r, hh); TuS[i2 * PT + ql] = f2bf(-yy[r] * bu0); TwS[i2 * PT + ql] = f2bf(-yy[r] * bw0); } }
    }
    __syncthreads();
    {
        const int isW = wave >> 2, ct = wave & 3, col = 32 * ct + ql;
        const LAS bf16_t* Ta = (isW ? TwS : TuS) + 8 * hh; const LAS bf16_t* Bs = (isW ? kT : vT) + col * PT + 8 * hh;
        bf16x8 bf[4];
#pragma unroll
        for (int ks = 0; ks < 4; ++ks) bf[ks] = *(const LAS bf16x8*)(Bs + 16 * ks);
        f32x16 xa[2];
#pragma unroll
        for (int jt = 0; jt < 2; ++jt) {
#pragma unroll
            for (int r = 0; r < 16; ++r) xa[jt][r] = 0.f;
#pragma unroll
            for (int ks = 0; ks < 4; ++ks) if (jt == 1 || ks < 2) xa[jt] = MFMA32(*(const LAS bf16x8*)(Ta + (32 * jt + ql) * PT + 16 * ks), bf[ks], xa[jt]); }
        bf16x8 xb[4] = {pack8(xa[0], 0), pack8(xa[0], 1), pack8(xa[1], 0), pack8(xa[1], 1)};
        f32x16 ra[2];
#pragma unroll
        for (int it = 0; it < 2; ++it) {
#pragma unroll
            for (int r = 0; r < 16; ++r) ra[it][r] = 0.f;
#pragma unroll
            for (int kk = 0; kk < 4; ++kk) if (it == 1 || kk < 2) { const LAS bf16_t* ap = AQ + (32 * it + ql) * PT + 16 * kk + 4 * hh;
                const u32x2 lo = *(const LAS u32x2*)ap, hi = *(const LAS u32x2*)(ap + 8); const u32x4 af = {lo.x, lo.y, hi.x, hi.y};
                ra[it] = MFMA32(__builtin_bit_cast(bf16x8, af), xb[kk], ra[it]); } }
        if (!isW) {
#pragma unroll
            for (int jt = 0; jt < 2; ++jt)
#pragma unroll
                for (int bq = 0; bq < 4; ++bq) { const int f = col * 64 + 32 * jt + 8 * bq + 4 * hh;
                    *(u32x2*)(U + slotU(t0, h, 0, f)) = (u32x2){cpk2(xa[jt][4 * bq], xa[jt][4 * bq + 1]), cpk2(xa[jt][4 * bq + 2], xa[jt][4 * bq + 3])};
                    *(u32x2*)(U + slotU(t0, h, 512, f)) = (u32x2){cpk2(ra[jt][4 * bq], ra[jt][4 * bq + 1]), cpk2(ra[jt][4 * bq + 2], ra[jt][4 * bq + 3])}; }
        } else {
            const int pc = permpos(col);
#pragma unroll
            for (int jt = 0; jt < 2; ++jt)
#pragma unroll
                for (int r = 0; r < 16; ++r) { const int tok = 32 * jt + crow(r, hh);
                    P[(t0 + tok) * NIN + C_QDN + h * 128 + pc] = f2bf(-xa[jt][r]);
                    P[(t0 + tok) * NIN + C_KDN + h * 128 + pc] = f2bf(bf2f(qS[tok * PQ + col]) * fexp(gcS[tok]) - ra[jt][r]); }
        }
    }
    __syncthreads();
  }
#undef CP_LOAD
}
constexpr int SC_PW = 136, SC_PK = 72, SC_NW = 0, SC_Q2 = 64 * SC_PW * 2, SC_KD = 2 * 64 * SC_PW * 2, SC_STAGE = 2 * 64 * SC_PW * 2 + 128 * SC_PK * 2, SC_OS = 2 * SC_STAGE,
              SC_US = SC_OS + 64 * SC_PW * 2, SC_OI = SC_US + 128 * SC_PK * 2, SC_END = SC_OI + 128 * SC_PK * 2;
static_assert(SC_END <= BST_OFF, "scan LDS");
__device__ __forceinline__ void gdn_scan_block(const Params& p, LAS unsigned char* lds, int bh, int tid, int wave, int lane) {
    asm volatile("" : "+v"(tid), "+v"(lane));
    bf16_t* P = (bf16_t*)(p.ws + WS_P); const bf16_t* U = (const bf16_t*)(p.ws + WS_U); const float* EGL = (const float*)(p.ws + WS_EGL);
    const int b = bh >> 2, h = bh & 3, ql = lane & 31, hh = lane >> 5;
    const size_t tb = (size_t)b * SEQ;
    LAS bf16_t* oS = (LAS bf16_t*)(lds + SC_OS);
    if (wave >= 4) {
        int lt = tid - 256, ftok = lt >> 2, fseg = lt & 3;
        u32x4 ra[20], rb[20];
#define SC_LOAD(r, n_) do { const size_t t0_ = tb + (size_t)(n_) * 64; _Pragma("unroll") for (int i = 0; i < 4; ++i) { const int c = lt + 256 * i, row = c >> 4, c8 = (c & 15) * 8; \
            const bf16_t* g_ = P + (t0_ + row) * NIN + h * 128 + c8; const bf16_t* u_ = U + (t0_ + row) * D + h * 128 + c8; \
            r[i] = *(const u32x4*)(g_ + C_QDN); r[4 + i] = *(const u32x4*)(g_ + C_KDN); r[8 + i] = *(const u32x4*)(g_ + C_VSB); r[12 + i] = *(const u32x4*)u_; r[16 + i] = *(const u32x4*)(u_ + 512); } } while (0)
#define SC_STORE(r, st_) do { LAS unsigned char* s_ = lds + (st_) * SC_STAGE; _Pragma("unroll") for (int i = 0; i < 4; ++i) { const int c = lt + 256 * i, row = c >> 4, c8 = (c & 15) * 8; \
            *(LAS u32x4*)(s_ + SC_NW + (row * SC_PW + c8) * 2) = r[i]; *(LAS u32x4*)(s_ + SC_Q2 + (row * SC_PW + c8) * 2) = r[4 + i]; \
            *(LAS u32x4*)(s_ + SC_KD + ((2 * row + (c8 >> 6)) * SC_PK + (c8 & 63)) * 2) = r[8 + i]; } } while (0)
#define SC_STOREU(r) do { _Pragma("unroll") for (int i = 0; i < 4; ++i) { const int c = lt + 256 * i, row = c >> 4, c8 = (c & 15) * 8; const int o_ = ((2 * row + (c8 >> 6)) * SC_PK + (c8 & 63)) * 2; \
            *(LAS u32x4*)(lds + SC_US + o_) = r[12 + i]; *(LAS u32x4*)(lds + SC_OI + o_) = r[16 + i]; } } while (0)
#define SC_FIN(m_) do { bf16_t* orow = P + (tb + (size_t)(m_) * 64 + ftok) * NIN + h * 128 + fseg * 32 + C_VDN; \
            _Pragma("unroll") for (int i = 0; i < 4; ++i) *(u32x4*)(orow + 8 * i) = *(const LAS u32x4*)(oS + ftok * SC_PW + fseg * 32 + 8 * i); } while (0)
        SC_LOAD(ra, 0); SC_STORE(ra, 0); SC_STOREU(ra); SC_LOAD(ra, 1);
        __syncthreads();
#pragma unroll 1
        for (int n = 0; n < 32; n += 2) {
            asm volatile("" : "+v"(lt), "+v"(ftok), "+v"(fseg));
            if (n + 2 < 32) SC_LOAD(rb, n + 2);
            SC_STORE(ra, 1);
            if (n > 0) SC_FIN(n - 1);
            __syncthreads();
            SC_STOREU(ra);
            __syncthreads();
            if (n + 3 < 32) SC_LOAD(ra, n + 3);
            if (n + 2 < 32) SC_STORE(rb, 0);
            SC_FIN(n);
            __syncthreads();
            if (n + 2 < 32) SC_STOREU(rb);
            __syncthreads();
        }
        SC_FIN(31);
#undef SC_LOAD
#undef SC_STORE
#undef SC_STOREU
#undef SC_FIN
    } else {
        const int col = 32 * wave + ql;
        f32x16 S[4];
#pragma unroll
        for (int rt = 0; rt < 4; ++rt)
#pragma unroll
            for (int r = 0; r < 16; ++r) S[rt][r] = 0.f;
        const float eglv = EGL[bh * 32 + ql];
        __syncthreads();
#pragma unroll 1
        for (int n = 0; n < 32; ++n) {
            const float egl = __builtin_bit_cast(float, __builtin_amdgcn_readlane(__builtin_bit_cast(int, eglv), n));
            const LAS unsigned char* st = lds + (n & 1) * SC_STAGE;
            f32x16 vn[2], oa[2];
            { const LAS unsigned char* up_ = lds + SC_US + (col * SC_PK + 4 * hh) * 2; const LAS unsigned char* op_ = lds + SC_OI + (col * SC_PK + 4 * hh) * 2;
#pragma unroll
              for (int jt = 0; jt < 2; ++jt)
#pragma unroll
                for (int bq = 0; bq < 4; ++bq) { const u32x2 uw = *(const LAS u32x2*)(up_ + (32 * jt + 8 * bq) * 2), ow = *(const LAS u32x2*)(op_ + (32 * jt + 8 * bq) * 2);
                    vn[jt][4 * bq] = bf_lo(uw.x); vn[jt][4 * bq + 1] = bf_hi(uw.x); vn[jt][4 * bq + 2] = bf_lo(uw.y); vn[jt][4 * bq + 3] = bf_hi(uw.y);
                    oa[jt][4 * bq] = bf_lo(ow.x); oa[jt][4 * bq + 1] = bf_hi(ow.x); oa[jt][4 * bq + 2] = bf_lo(ow.y); oa[jt][4 * bq + 3] = bf_hi(ow.y); } }
            const LAS unsigned char* w0_ = st + (ql * SC_PW + 8 * hh) * 2; const LAS unsigned char* w1_ = w0_ + 32 * SC_PW * 2;
            const LAS unsigned char* kd_ = st + SC_KD + (ql * SC_PK + 8 * hh) * 2;
            bf16x8 fa[4], fb[4];
#define SC_RD4(dst, ptr) do { _Pragma("unroll") for (int i_ = 0; i_ < 4; ++i_) dst[i_] = *(const LAS bf16x8*)((ptr) + 32 * i_); } while (0)
#define SC_MM4(acc, fr, bb) do { _Pragma("unroll") for (int i_ = 0; i_ < 4; ++i_) acc = MFMA32(fr[i_], bb[i_], acc); __builtin_amdgcn_sched_barrier(0); } while (0)
            SC_RD4(fa, w0_ + SC_NW); SC_RD4(fb, w1_ + SC_NW);
            { bf16x8 sb[4] = {pack8(S[0], 0), pack8(S[0], 1), pack8(S[1], 0), pack8(S[1], 1)};
              SC_MM4(vn[0], fa, sb); SC_RD4(fa, w0_ + SC_Q2);
              SC_MM4(vn[1], fb, sb); SC_RD4(fb, w1_ + SC_Q2);
              SC_MM4(oa[0], fa, sb); SC_RD4(fa, w0_ + SC_NW + 128);
              SC_MM4(oa[1], fb, sb); SC_RD4(fb, w1_ + SC_NW + 128); }
            { bf16x8 sb[4] = {pack8(S[2], 0), pack8(S[2], 1), pack8(S[3], 0), pack8(S[3], 1)};
              SC_MM4(vn[0], fa, sb); SC_RD4(fa, w0_ + SC_Q2 + 128);
              SC_MM4(vn[1], fb, sb); SC_RD4(fb, w1_ + SC_Q2 + 128);
              bf16x8 vb[4] = {pack8(vn[0], 0), pack8(vn[0], 1), pack8(vn[1], 0), pack8(vn[1], 1)};
              SC_MM4(oa[0], fa, sb); SC_RD4(fa, kd_);
              SC_MM4(oa[1], fb, sb); SC_RD4(fb, kd_ + 32 * SC_PK * 2);
#pragma unroll
              for (int rt = 0; rt < 4; ++rt)
#pragma unroll
                  for (int r = 0; r < 16; ++r) S[rt][r] *= egl;
              SC_MM4(S[0], fa, vb); SC_RD4(fa, kd_ + 64 * SC_PK * 2);
              SC_MM4(S[1], fb, vb); SC_RD4(fb, kd_ + 96 * SC_PK * 2);
              SC_MM4(S[2], fa, vb);
              SC_MM4(S[3], fb, vb); }
#undef SC_RD4
#undef SC_MM4
            __syncthreads();
#pragma unroll
            for (int jt = 0; jt < 2; ++jt)
#pragma unroll
                for (int r = 0; r < 16; ++r) oS[(32 * jt + crow(r, hh)) * SC_PW + col] = f2bf(oa[jt][r]);
            __syncthreads();
        }
    }
}
__device__ __forceinline__ void gdn_finalize_phase(const Params& p, int wave, int lane) {
    asm volatile("" : "+v"(lane));
    bf16_t* P = (bf16_t*)(p.ws + WS_P);
    const int c0 = (lane & 15) * 8;
    float gg[8];
#pragma unroll
    for (int e = 0; e < 8; ++e) gg[e] = p.in[I_GDNOUT][c0 + e];
    for (int row = blockIdx.x * 8 + wave; row < T; row += gridDim.x * 8) {
        bf16_t* op = P + (size_t)row * NIN + C_VDN + lane * 8; const bf16_t* zp = P + (size_t)row * NIN + C_ZDN + lane * 8;
        const u32x4 ow = *(const u32x4*)op, zw = *(const u32x4*)zp;
        const float o[8] = {bf_lo(ow.x), bf_hi(ow.x), bf_lo(ow.y), bf_hi(ow.y), bf_lo(ow.z), bf_hi(ow.z), bf_lo(ow.w), bf_hi(ow.w)};
        const float z[8] = {bf_lo(zw.x), bf_hi(zw.x), bf_lo(zw.y), bf_hi(zw.y), bf_lo(zw.z), bf_hi(zw.z), bf_lo(zw.w), bf_hi(zw.w)};
        float ss = 0.f;
#pragma unroll
        for (int e = 0; e < 8; ++e) ss += o[e] * o[e];
        ss += __shfl_xor(ss, 1); ss += __shfl_xor(ss, 2); ss += __shfl_xor(ss, 4); ss += __shfl_xor(ss, 8);
        const float rstd = 1.0f / sqrtf(ss * (1.f / 128.f) + EPS);
        float r[8];
#pragma unroll
        for (int e = 0; e < 8; ++e) r[e] = o[e] * rstd * gg[e] * fsilu(z[e]);
        u32x4 w; w.x = pk2(r[0], r[1]); w.y = pk2(r[2], r[3]); w.z = pk2(r[4], r[5]); w.w = pk2(r[6], r[7]);
        *(u32x4*)op = w;
    }
}

#define XB_TMO      128
#define XB_XCNT(j)  (256  + 64 * (j))
#define XB_XSUB(j)  (1280 + 64 * (j))
#define XB_XGEN(j)  (2304 + 64 * (j))
#define XB_TOP      3328
#define XB_TOPGEN   3392
#define XCD_BAR_WORDS 3456
#define XB_SPIN_CAP (1u << 18)
__device__ __forceinline__ unsigned xb_ld(unsigned* p)              { return __hip_atomic_load(p, __ATOMIC_RELAXED, __HIP_MEMORY_SCOPE_AGENT); }
__device__ __forceinline__ unsigned xb_add(unsigned* p, unsigned v) { return __hip_atomic_fetch_add(p, v, __ATOMIC_RELAXED, __HIP_MEMORY_SCOPE_AGENT); }
__device__ __forceinline__ unsigned xb_xcc_id() { return (unsigned)__builtin_amdgcn_s_getreg((3 << 11) | 20) & 0xFu; }
#define XB_SPIN(cond, bar) do { unsigned _sp = 0; while (cond) { __builtin_amdgcn_s_sleep(1); \
    if ((++_sp & 255u) == 0u) { if (xb_ld(&(bar)[XB_TMO])) break; if (_sp > XB_SPIN_CAP) { atomicAdd(&(bar)[XB_TMO], 1u); break; } } } } while (0)
struct XcdBarrier { unsigned* bar; unsigned x; volatile LAS unsigned* st; };
__device__ __forceinline__ XcdBarrier xcd_barrier_post(unsigned* bar, volatile LAS unsigned* st) {
    XcdBarrier b; b.bar = bar; b.x = xb_xcc_id(); b.st = st;
    if (threadIdx.x == 0) (void)xb_add(&bar[XB_XCNT(b.x)], 1u);
    return b;
}
__device__ __forceinline__ void xcd_barrier_complete(unsigned* bar, unsigned x, unsigned& nloc, unsigned& nx) {
    const unsigned G = gridDim.x * gridDim.y * gridDim.z;
    unsigned sum, cnt, mine, sp = 0u;
    for (;;) {
        sum = 0u; cnt = 0u; mine = 0u;
#pragma unroll
        for (unsigned j = 0; j < 16; ++j) { const unsigned c = xb_ld(&bar[XB_XCNT(j)]); sum += c; cnt += (c > 0u) ? 1u : 0u; mine = (j == x) ? c : mine; }
        if (sum == G) break;
        __builtin_amdgcn_s_sleep(1);
        if ((++sp & 255u) == 0u) { if (xb_ld(&bar[XB_TMO])) break; if (sp > XB_SPIN_CAP) { atomicAdd(&bar[XB_TMO], 1u); break; } }
    }
    nloc = mine > 0u ? mine : 1u; nx = cnt > 0u ? cnt : 1u;
}
__device__ __forceinline__ void xcd_barrier(const XcdBarrier& b) {
    asm volatile("s_waitcnt vmcnt(0)" ::: "memory");
    __syncthreads();
    if (threadIdx.x == 0) {
        unsigned* bar = b.bar;
        __builtin_amdgcn_s_waitcnt(0);
        unsigned nloc = b.st[0], nx = b.st[1];
        if (nloc == 0u) { xcd_barrier_complete(bar, b.x, nloc, nx); b.st[0] = nloc; b.st[1] = nx; }
        const unsigned old = xb_add(&bar[XB_XSUB(b.x)], 1u);
        const unsigned gen = old / nloc;
        if (old + 1u == (gen + 1u) * nloc) {
            __builtin_amdgcn_fence(__ATOMIC_RELEASE, "agent");
            asm volatile("s_waitcnt vmcnt(0)" ::: "memory");
            const unsigned og = xb_add(&bar[XB_TOP], 1u);
            const unsigned tg = og / nx;
            if (og + 1u == (tg + 1u) * nx) xb_add(&bar[XB_TOPGEN], 1u);
            else XB_SPIN(xb_ld(&bar[XB_TOPGEN]) == tg, bar);
            __builtin_amdgcn_fence(__ATOMIC_ACQUIRE, "agent");
            xb_add(&bar[XB_XGEN(b.x)], 1u);
            asm volatile("s_waitcnt vmcnt(0)" ::: "memory");
        } else {
            XB_SPIN(xb_ld(&bar[XB_XGEN(b.x)]) == gen, bar);
            __builtin_amdgcn_fence(__ATOMIC_ACQUIRE, "agent");
            asm volatile("s_waitcnt vmcnt(0)" ::: "memory");
        }
    }
    __syncthreads();
}

#ifndef PHMASK
#define PHMASK 0xFFFF
#endif
#define PH(n) ((PHMASK >> (n)) & 1)
#ifndef PROBE
#define PROBE 0
#endif
#define REP(g) for (int _rep = 0; _rep < ((PROBE == (g)) ? 2 : 1); ++_rep)
__global__ void __launch_bounds__(512, 2) fwd_megakernel(Params p) {
    extern __shared__ __attribute__((aligned(16))) unsigned char lds_raw[];
    LAS unsigned char* lds = (LAS unsigned char*)lds_raw;
    cg::grid_group grid = cg::this_grid();
    const int tid = threadIdx.x, lane = tid & 63, wave = __builtin_amdgcn_readfirstlane(tid >> 6);
    const int G = gridDim.x, gw = wave * G + blockIdx.x, ngw = G * 8;
    unsigned char* ws = p.ws;
    bf16_t* U = (bf16_t*)(ws + WS_U); bf16_t* P = (bf16_t*)(ws + WS_P);
    const float* mod = (const float*)(ws + WS_MOD);
    LAS float* scr = (LAS float*)(lds + wave * 16384);

    unsigned* barw = (unsigned*)(ws + WS_BAR);
    volatile LAS unsigned* bst = (volatile LAS unsigned*)(lds + BST_OFF);
    if (tid < 2) bst[tid] = 0u;
    __syncthreads();
    if (p.ws == nullptr) grid.sync();
    const XcdBarrier xbar = xcd_barrier_post(barw, bst);
    REP(1) { if (PH(0)) for (int it = blockIdx.x; it < NMOD / 64; it += G) mod_item(p, lds, it, tid, wave, lane);
    { const int nmod = NMOD / 64;
      if (PH(0)) { if (G >= nmod + 64) { if ((int)blockIdx.x >= nmod) ffn_weight_items(p.in[I_WFFN1IN], p.in[I_WFFN1OUT], (bf16_t*)(ws + W_FFIN), (bf16_t*)(ws + W_FFOUT), scr, wave * (G - nmod) + ((int)blockIdx.x - nmod), (G - nmod) * 8, lane); }
                   else ffn_weight_items(p.in[I_WFFN1IN], p.in[I_WFFN1OUT], (bf16_t*)(ws + W_FFIN), (bf16_t*)(ws + W_FFOUT), scr, gw, ngw, lane); } }
    __syncthreads(); }
    xcd_barrier(xbar);
    if (PROBE == 3) for (int i = 0; i < 16; ++i) xcd_barrier(xbar);
    REP(1) if (PH(1)) norm_mod_phase<false>(p, lds, p.in[I_X], p.in[I_GFFN1], 0, U, tid, wave, lane);
    xcd_barrier(xbar);
    REP(2) if (PH(2)) run_gemm(lds, U, D, (const bf16_t*)(ws + W_FFIN), 2 * FF, D, EpiSwiGLU{P, FF});
    { const int nfull = (64 * 22) % G, nidle = nfull ? G - nfull : G;
      const int ib = nfull ? (int)blockIdx.x - nfull : (int)blockIdx.x;
      if (PH(0) && ib >= 0) mixer_weight_items(p, scr, wave * nidle + ib, nidle * 8, lane); }
    xcd_barrier(xbar);
    const bool fusedn = (G == 256);
    unsigned* xslot = (unsigned*)(ws + WS_XSLOT); unsigned* xcnt = (unsigned*)(ws + WS_XCNT);
    if (fusedn) { if (PH(3)) run_gemm(lds, P, FF, (const bf16_t*)(ws + W_FFOUT), D, FF, EpiResidNorm{p.in[I_X], p.out, mod + 2 * D, p.in[I_GMIX], mod + 3 * D, U, xslot, xcnt, 0.5f, 0}); }
    else { REP(2) if (PH(3)) run_gemm(lds, P, FF, (const bf16_t*)(ws + W_FFOUT), D, FF, EpiResid{p.in[I_X], p.out, mod + 2 * D, 0.5f}); }
    xcd_barrier(xbar);
    if (fusedn) { if (PH(4)) dn_gate_phase(p, lds, U, tid, wave, lane); }
    else { REP(1) if (PH(4)) norm_mod_phase<true>(p, lds, p.out, p.in[I_GMIX], 3, U, tid, wave, lane); }
    xcd_barrier(xbar);
    REP(2) if (PH(5)) run_gemm(lds, U, D, (const bf16_t*)(ws + W_IN), NIN, D, EpiBf16{P, NIN});
    { const int nfull = (64 * 22) % G, nidle = nfull ? G - nfull : G; const int ib = nfull ? (int)blockIdx.x - nfull : (int)blockIdx.x;
      if (PH(12) && ib >= 0) ffn_weight_items(p.in[I_WFFN2IN], p.in[I_WFFN2OUT], (bf16_t*)(ws + WS_F2IN), (bf16_t*)(ws + W_FFOUT), scr, wave * nidle + ib, nidle * 8, lane, 0, 2816); }
    xcd_barrier(xbar);
    if (PH(6)) prep_phase(p, wave, lane);
    xcd_barrier(xbar);
    if (PH(7)) gdn_chunk_prep_phase(p, lds, tid, wave, lane);
    xcd_barrier(xbar);
    if (PH(15)) for (int it = blockIdx.x; it < 32; it += G) gdn_scan_block(p, lds, it, tid, wave, lane);
    if (PH(8)) {
        const unsigned x0 = xb_xcc_id() & 7u;
        for (unsigned dx = 0; dx < 8u; ++dx) { const unsigned x = (x0 + dx) & 7u; unsigned* ctr = (unsigned*)(ws + WS_CTR) + 64 * x;
            for (;;) { unsigned idx = 0; if (lane == 0) idx = atomicAdd(ctr, 1u); idx = __builtin_amdgcn_readfirstlane(idx);
                if (idx >= 512u) break;
                attn_item_mfma(P, (const bf16_t*)(ws + WS_VT), (int)(8u * x + (idx & 7u)), 63 - (int)(idx >> 3), lane); } } }
    xcd_barrier(xbar);
    if (PH(9)) gdn_finalize_phase(p, wave, lane);
    xcd_barrier(xbar);
    if (PH(10)) run_gemm(lds, P + C_QSB, NIN, (const bf16_t*)(ws + W_UPSB), D, 1024, EpiGateFused{P + C_RSB, P + C_RDN, U}, 8, (C_VDN - C_QSB) * 2 - 8 * 128);
    xcd_barrier(xbar);
    if (fusedn) { if (PH(11)) run_gemm(lds, U, D, (const bf16_t*)(ws + W_OUT), D, D, EpiResidNorm{p.out, p.out, mod + 5 * D, p.in[I_GFFN2], mod + 6 * D, U, xslot + 64 * 256 * 4, xcnt + 64 * 64, 1.0f, 0}); }
    else { if (PH(11)) run_gemm(lds, U, D, (const bf16_t*)(ws + W_OUT), D, D, EpiResid{p.out, p.out, mod + 5 * D, 1.0f}); }
    xcd_barrier(xbar);
    if (!fusedn) { REP(1) if (PH(12)) norm_mod_phase<false>(p, lds, p.out, p.in[I_GFFN2], 6, U, tid, wave, lane); }
    __syncthreads();
    if (PH(12)) ffn_weight_items(p.in[I_WFFN2IN], p.in[I_WFFN2OUT], (bf16_t*)(ws + WS_F2IN), (bf16_t*)(ws + W_FFOUT), scr, gw, ngw, lane, 2816, 2816 + 1408);
    xcd_barrier(xbar);
    REP(2) if (PH(13)) run_gemm(lds, U, D, (const bf16_t*)(ws + WS_F2IN), 2 * FF, D, EpiSwiGLU{P, FF});
    xcd_barrier(xbar);
    if (PH(14)) run_gemm(lds, P, FF, (const bf16_t*)(ws + W_FFOUT), D, FF, EpiResid{p.out, p.out, mod + 8 * D, 0.5f});
}

extern "C" void kernel_launch(void* const* d_in, const int* in_sizes, int n_in, void* d_out, int out_size, void* d_ws, size_t ws_size, hipStream_t stream) {
    static int grid_blocks = 0;
    if (!grid_blocks) {
        int dev = 0, cus = 0, per_cu = 0;
        (void)hipGetDevice(&dev);
        (void)hipDeviceGetAttribute(&cus, hipDeviceAttributeMultiprocessorCount, dev);
        (void)hipFuncSetAttribute((const void*)fwd_megakernel, hipFuncAttributeMaxDynamicSharedMemorySize, LDS_BYTES);
        (void)hipOccupancyMaxActiveBlocksPerMultiprocessor(&per_cu, (const void*)fwd_megakernel, 512, LDS_BYTES);
        if (per_cu < 1) { fprintf(stderr, "occupancy query says %d blocks/CU\n", per_cu); per_cu = 1; }
        grid_blocks = cus;
    }
    Params p{};
    for (int i = 0; i < N_IN; ++i) p.in[i] = (const float*)d_in[i];
    p.out = (float*)d_out; p.ws = (unsigned char*)d_ws;
    static_assert(WS_BAR + XCD_BAR_WORDS * 4 <= WS_XCNT, "control words");
    (void)hipMemsetAsync((char*)d_ws + WS_CTR, 0, WS_ZEND - WS_CTR, stream);
    void* args[] = {&p};
    hipError_t e = hipLaunchCooperativeKernel((const void*)fwd_megakernel, dim3(grid_blocks), dim3(512), args, LDS_BYTES, stream);
    if (e != hipSuccess) fprintf(stderr, "cooperative launch failed: %s (grid %d)\n", hipGetErrorString(e), grid_blocks);
}
```

```cpp
#include <hip/hip_runtime.h>
#include <hip/hip_cooperative_groups.h>
#include <cstdio>
namespace cg = cooperative_groups;

#define LAS __attribute__((address_space(3)))
typedef unsigned short bf16_t;
typedef short bf16x8 __attribute__((ext_vector_type(8)));
typedef float f32x4 __attribute__((ext_vector_type(4)));
typedef unsigned u32x4 __attribute__((ext_vector_type(4)));
typedef unsigned u32x2 __attribute__((ext_vector_type(2)));
typedef float f32x16 __attribute__((ext_vector_type(16)));
typedef float f32x2 __attribute__((ext_vector_type(2)));
typedef __bf16 nbf16x2 __attribute__((ext_vector_type(2)));

constexpr int T = 16384, D = 1024, SEQ = 2048, NB = 8, FF = 2816, NIN = 5632, INW = 5640, NMOD = 9216;
constexpr int C_QSB = 0, C_KSB = 512, C_VSB = 1024, C_QDN = 1536, C_KDN = 2048, C_VDN = 2560, C_ZDN = 3072, C_RSB = 3584, C_RDN = 4608;
constexpr float EPS = 1e-6f;
constexpr int LDS_BYTES = 163840, BST_OFF = LDS_BYTES - 64;
constexpr size_t MiB = 1024 * 1024;
constexpr size_t WS_MOD = 0, WS_BG = 512 * 1024, WS_SS = 242 * MiB, WS_W = 2 * MiB;
constexpr size_t W_FFIN = WS_W, W_FFOUT = W_FFIN + (size_t)2 * FF * D * 2, W_IN = W_FFOUT + (size_t)D * FF * 2, W_UPSB = W_IN + (size_t)NIN * D * 2,
                 W_UPDN = W_UPSB + (size_t)D * 512 * 2, W_OUT = W_UPDN + (size_t)D * 512 * 2, W_END = W_OUT + (size_t)D * D * 2;
constexpr size_t WS_U = 34 * MiB, WS_P = 66 * MiB, WS_F2IN = 242 * MiB;
static_assert(W_END <= WS_U, "weights overflow");
constexpr size_t WS_EGL = 384 * 1024, WS_CTR = 400 * 1024, WS_BAR = 416 * 1024, WS_XCNT = 432 * 1024, WS_ZEND = 464 * 1024;
constexpr size_t WS_XSLOT = 1 * MiB;
constexpr size_t WS_VT = W_FFIN;
static_assert((size_t)T * 512 * 2 <= W_IN - W_FFIN, "Vt overflow");

enum { I_X = 0, I_C, I_WADA, I_BADA, I_GFFN1, I_WFFN1IN, I_WFFN1OUT, I_GMIX, I_WIN, I_GQSB, I_GKSB, I_WCONV, I_ALOG, I_DTBIAS, I_GDNOUT, I_WUPSB, I_WUPDN, I_WOUT, I_GFFN2, I_WFFN2IN, I_WFFN2OUT, N_IN };
struct Params { const float* in[N_IN]; float* out; unsigned char* ws; };

__device__ __forceinline__ float bf_lo(unsigned w) { return __uint_as_float(w << 16); }
__device__ __forceinline__ float bf_hi(unsigned w) { return __uint_as_float(w & 0xffff0000u); }
__device__ __forceinline__ float bf2f(bf16_t b) { return __uint_as_float(((unsigned)b) << 16); }
__device__ __forceinline__ unsigned pk2(float lo, float hi) { unsigned r; asm("v_cvt_pk_bf16_f32 %0, %1, %2" : "=v"(r) : "v"(lo), "v"(hi)); return r; }
__device__ __forceinline__ unsigned cpk2(float lo, float hi) { const f32x2 v = {lo, hi}; return __builtin_bit_cast(unsigned, __builtin_convertvector(v, nbf16x2)); }
__device__ __forceinline__ bf16_t f2bf(float f) { return (bf16_t)(pk2(f, 0.f) & 0xffffu); }
__device__ __forceinline__ float fexp(float x) { return __builtin_amdgcn_exp2f(x * 1.4426950408889634f); }
__device__ __forceinline__ float flog(float x) { return __builtin_amdgcn_logf(x) * 0.6931471805599453f; }
__device__ __forceinline__ float fsigmoid(float x) { return __builtin_amdgcn_rcpf(1.f + fexp(-x)); }
__device__ __forceinline__ float fsilu(float x) { return x * fsigmoid(x); }
__device__ __forceinline__ float fsoftplus(float x) { return fmaxf(x, 0.f) + flog(1.f + fexp(-fabsf(x))); }
__device__ __forceinline__ float wave_sum(float v) {
#pragma unroll
    for (int o = 1; o < 64; o <<= 1) v += __shfl_xor(v, o);
    return v;
}
#define LDS_WAIT() asm volatile("s_waitcnt lgkmcnt(0)" ::: "memory")

namespace pg8 {
constexpr int BM = 256, BK = 64, HALF = 128, HTB = HALF * BK * 2, STAGE_BYTES = 8 * HTB, NXCD = 8, WGM = 8;
__host__ __device__ __forceinline__ int lds_byte(int r, int c) { const int st = (r >> 4) * 2 + (c >> 5), rr = r & 15, cc = c & 31, ob = rr * 64 + cc * 2; return st * 1024 + (ob ^ (((ob >> 9) & 1) << 5)); }
__host__ __device__ __forceinline__ void stage_rc(int b, int& R, int& C) { const int st = b / 1024, sb = b % 1024, swz = sb ^ (((sb >> 9) & 1) << 5); R = (st >> 1) * 16 + swz / 64; C = (st & 1) * 32 + (swz % 64) / 2; }
__host__ __device__ __forceinline__ int perm32(int rho) { const int n = rho >> 4, i = rho & 15; return 8 * (i >> 2) + 4 * n + (i & 3); }
struct Unit { int pm, pn; };
struct Gemm { const bf16_t* A; const bf16_t* Bt; int M, N, K, lda; int jt; int jbytes; };
struct StaticOrder {
    int nM, nN, nwg, G, c;
    __host__ __device__ void init(int M, int N, int G_, int c_) { nM = M / BM; nN = N / BM; nwg = nM * nN; G = G_; c = c_; }
    __host__ __device__ bool next(int i, Unit& u) const {
        const long L = (long)i * G + c; if (L >= nwg) return false;
        int wgid = (int)L; { const int q = nwg / NXCD, r = nwg % NXCD, xcd = wgid % NXCD, off = wgid / NXCD; wgid = (xcd < r ? xcd * (q + 1) : r * (q + 1) + (xcd - r) * q) + off; }
        const int nig = WGM * nN, gid = wgid / nig, fm = gid * WGM, gsz = (nM - fm) < WGM ? (nM - fm) : WGM;
        u.pm = fm + ((wgid % nig) % gsz); u.pn = (wgid % nig) / gsz; return true;
    }
};
template <class Epi>
__device__ __forceinline__ void gemm_phase(LAS unsigned char* lds, const Gemm g, const StaticOrder& S, const Epi E) {
    int tid = threadIdx.x; asm volatile("" : "+v"(tid));
    const int wid = __builtin_amdgcn_readfirstlane(tid >> 6), lane = tid & 63, wr = wid >> 2, wc = wid & 3, fr = lane & 15, fq = lane >> 4;
    const int K = g.K, nt = K / BK, lda = g.lda;
    unsigned voffA[2], voffB[2];
#pragma unroll
    for (int i = 0; i < 2; ++i) { int R, C; stage_rc(tid * 16 + i * 8192, R, C); const int Rb = Epi::PERM ? ((R & ~31) + perm32(R & 31)) : R;
        voffA[i] = (unsigned)(R * lda + C) * 2u; voffB[i] = (unsigned)(Rb * K + C) * 2u; }
    const size_t kstep = (size_t)(BK * 2);
    const size_t hstepA = (size_t)HALF * lda * 2, hstepB = (size_t)HALF * K * 2;
    const size_t tstepA = 2 * hstepA, tstepB = 2 * hstepB;
    const unsigned ldsw = (unsigned)wid * 1024u;
    const int aoff = lds_byte(wr * 64 + fr, fq * 8), boff = lds_byte(wc * 32 + fr, fq * 8);
#define PG8_SA(b, h) (((b) * 2 + (h)) * HTB)
#define PG8_SB(b, h) ((4 + (b) * 2 + (h)) * HTB)
#define PG8_STAGE(bufoff, gbase, voff) do { _Pragma("unroll") for (int _i = 0; _i < 2; ++_i) \
        __builtin_amdgcn_global_load_lds((const unsigned*)((const char*)(gbase) + (voff)[_i]), (LAS unsigned*)(lds + (bufoff) + ldsw + _i * 8192), 16, 0, 0); } while (0)
#define PG8_LDA(dst, b, h) do { _Pragma("unroll") for (int m = 0; m < 4; ++m) _Pragma("unroll") for (int k = 0; k < 2; ++k) dst[m][k] = *(const LAS bf16x8*)(lds + PG8_SA(b, h) + aoff + m * 2048 + k * 1024); } while (0)
#define PG8_LDB(dst, b, h) do { _Pragma("unroll") for (int n = 0; n < 2; ++n) _Pragma("unroll") for (int k = 0; k < 2; ++k) dst[n][k] = *(const LAS bf16x8*)(lds + PG8_SB(b, h) + boff + n * 2048 + k * 1024); } while (0)
#define PG8_MMA(ai, bj, At, Bt) do { __builtin_amdgcn_s_setprio(1); _Pragma("unroll") for (int m = 0; m < 4; ++m) _Pragma("unroll") for (int n = 0; n < 2; ++n) _Pragma("unroll") for (int k = 0; k < 2; ++k) \
        acc[ai][bj][m][n] = __builtin_amdgcn_mfma_f32_16x16x32_bf16(Bt[n][k], At[m][k], acc[ai][bj][m][n], 0, 0, 0); __builtin_amdgcn_s_setprio(0); } while (0)
#define PG8_WAIT_V(n) asm volatile("s_waitcnt vmcnt(" #n ")" ::: "memory")
#define PG8_WAIT_L(n) asm volatile("s_waitcnt lgkmcnt(" #n ")" ::: "memory")
#define PG8_BAR __builtin_amdgcn_s_barrier()
#define PG8_SCHED __builtin_amdgcn_sched_barrier(0)
    Unit cur, nxt; int ui = 0;
    if (!S.next(0, cur)) return;
    f32x4 acc[2][2][4][2];
#pragma unroll
    for (int a = 0; a < 2; ++a)
#pragma unroll
        for (int b = 0; b < 2; ++b)
#pragma unroll
            for (int m = 0; m < 4; ++m)
#pragma unroll
                for (int n = 0; n < 2; ++n) acc[a][b][m][n] = (f32x4){0.f, 0.f, 0.f, 0.f};
    bf16x8 At[4][2], B0[2][2], B1[2][2];
    const char* cA = (const char*)g.A + (size_t)cur.pm * tstepA; const char* cB = (const char*)g.Bt + (size_t)cur.pn * tstepB;
    PG8_STAGE(PG8_SB(0, 0), cB, voffB); PG8_STAGE(PG8_SA(0, 0), cA, voffA); PG8_STAGE(PG8_SB(0, 1), cB + hstepB, voffB); PG8_STAGE(PG8_SA(0, 1), cA + hstepA, voffA);
    if (wr == 1) PG8_BAR;
    PG8_WAIT_V(4); PG8_BAR;
    PG8_STAGE(PG8_SB(1, 0), cB + kstep, voffB); PG8_STAGE(PG8_SA(1, 0), cA + kstep, voffA); PG8_STAGE(PG8_SB(1, 1), cB + hstepB + kstep, voffB);
    PG8_WAIT_V(6); PG8_BAR;
    for (;;) {
        const bool has_next = S.next(ui + 1, nxt);
        const char* nA = has_next ? (const char*)g.A + (size_t)nxt.pm * tstepA : cA; const char* nB = has_next ? (const char*)g.Bt + (size_t)nxt.pn * tstepB : cB;
        for (int t = 0; t < nt; t += 2) {
            const bool last = (t == nt - 2);
            const char* a1 = cA + (size_t)(t + 1) * kstep + (t + 1 >= g.jt ? g.jbytes : 0);
            const char* a2 = last ? nA : cA + (size_t)(t + 2) * kstep + (t + 2 >= g.jt ? g.jbytes : 0); const char* b2 = last ? nB : cB + (size_t)(t + 2) * kstep;
            const char* a3 = a2 + kstep; const char* b3 = b2 + kstep;
            if constexpr (Epi::HAS_MID) { if (t == g.jt) E.mid(acc, cur, wr, wc, fr, fq); }
            PG8_LDB(B0, 0, 0); PG8_SCHED; PG8_LDA(At, 0, 0); PG8_STAGE(PG8_SA(1, 1), a1 + hstepA, voffA);
            PG8_WAIT_L(8); PG8_BAR; PG8_WAIT_L(0); PG8_MMA(0, 0, At, B0); PG8_BAR; PG8_SCHED;
            PG8_LDB(B1, 0, 1); PG8_STAGE(PG8_SB(0, 0), b2, voffB);
            PG8_BAR; PG8_WAIT_L(0); PG8_MMA(0, 1, At, B1); PG8_BAR;
            PG8_LDA(At, 0, 1); PG8_STAGE(PG8_SA(0, 0), a2, voffA);
            PG8_BAR; PG8_WAIT_L(0); PG8_MMA(1, 0, At, B0); PG8_BAR; PG8_SCHED;
            PG8_STAGE(PG8_SB(0, 1), b2 + hstepB, voffB);
            PG8_WAIT_V(6); PG8_BAR; PG8_MMA(1, 1, At, B1); PG8_BAR;
            PG8_LDB(B0, 1, 0); PG8_SCHED; PG8_LDA(At, 1, 0); PG8_STAGE(PG8_SA(0, 1), a2 + hstepA, voffA);
            PG8_WAIT_L(8); PG8_BAR; PG8_WAIT_L(0); PG8_MMA(0, 0, At, B0); PG8_BAR; PG8_SCHED;
            PG8_LDB(B1, 1, 1); PG8_STAGE(PG8_SB(1, 0), b3, voffB);
            PG8_BAR; PG8_WAIT_L(0); PG8_MMA(0, 1, At, B1); PG8_BAR;
            PG8_LDA(At, 1, 1); PG8_STAGE(PG8_SA(1, 0), a3, voffA);
            PG8_BAR; PG8_WAIT_L(0); PG8_MMA(1, 0, At, B0); PG8_BAR; PG8_SCHED;
            PG8_STAGE(PG8_SB(1, 1), b3 + hstepB, voffB);
            PG8_WAIT_V(6); PG8_BAR; PG8_MMA(1, 1, At, B1); PG8_BAR;
        }
        if constexpr (!Epi::AFTER) E(acc, cur, wr, wc, fr, fq);
        if (!has_next) break;
#pragma unroll
        for (int a = 0; a < 2; ++a)
#pragma unroll
            for (int b = 0; b < 2; ++b)
#pragma unroll
                for (int m = 0; m < 4; ++m)
#pragma unroll
                    for (int n = 0; n < 2; ++n) acc[a][b][m][n] = (f32x4){0.f, 0.f, 0.f, 0.f};
        cur = nxt; cA = nA; cB = nB; ++ui;
    }
    PG8_WAIT_V(0);
    if (wr == 0) PG8_BAR;
    PG8_BAR;
    if constexpr (Epi::AFTER) E.fused(acc, cur, wr, wc, fr, fq, lds, wid, lane);
#undef PG8_SA
#undef PG8_SB
#undef PG8_STAGE
#undef PG8_LDA
#undef PG8_LDB
#undef PG8_MMA
#undef PG8_WAIT_V
#undef PG8_WAIT_L
#undef PG8_BAR
#undef PG8_SCHED
}
}

typedef const f32x4 (&AccRef)[2][2][4][2];
struct EpiBf16 {
    static constexpr bool PERM = true, HAS_MID = false, AFTER = false;
    bf16_t* O; int ldc;
    __device__ __forceinline__ void operator()(AccRef acc, const pg8::Unit& u, int wr, int wc, int fr, int fq) const {
        const int row0 = u.pm * 256 + wr * 64 + fr, col0 = u.pn * 256 + wc * 32 + 8 * fq;
#pragma unroll
        for (int ai = 0; ai < 2; ++ai)
#pragma unroll
            for (int m = 0; m < 4; ++m) { bf16_t* rowp = O + (size_t)(row0 + ai * 128 + m * 16) * ldc + col0;
#pragma unroll
                for (int bj = 0; bj < 2; ++bj) { const f32x4 v0 = acc[ai][bj][m][0], v1 = acc[ai][bj][m][1];
                    u32x4 w; w.x = pk2(v0[0], v0[1]); w.y = pk2(v0[2], v0[3]); w.z = pk2(v1[0], v1[1]); w.w = pk2(v1[2], v1[3]);
                    *(u32x4*)(rowp + bj * 128) = w; } }
    }
};
struct EpiSwiGLU {
    static constexpr bool PERM = true, HAS_MID = false, AFTER = false;
    bf16_t* O; int ldc;
    __device__ __forceinline__ void operator()(AccRef acc, const pg8::Unit& u, int wr, int wc, int fr, int fq) const {
        const int row0 = u.pm * 256 + wr * 64 + fr, col0 = u.pn * 128 + wc * 32 + 8 * fq;
#pragma unroll
        for (int ai = 0; ai < 2; ++ai)
#pragma unroll
            for (int m = 0; m < 4; ++m) { bf16_t* rowp = O + (size_t)(row0 + ai * 128 + m * 16) * ldc + col0;
                float r[8];
#pragma unroll
                for (int n = 0; n < 2; ++n)
#pragma unroll
                    for (int j = 0; j < 4; ++j) { const float a = acc[ai][0][m][n][j], b = acc[ai][1][m][n][j]; r[n * 4 + j] = fsilu(a) * b; }
                u32x4 w; w.x = pk2(r[0], r[1]); w.y = pk2(r[2], r[3]); w.z = pk2(r[4], r[5]); w.w = pk2(r[6], r[7]);
                *(u32x4*)rowp = w; }
    }
};
struct EpiResid {
    static constexpr bool PERM = false, HAS_MID = false, AFTER = false;
    const float* base; float* out; const float* gate; float scale;
    __device__ __forceinline__ void operator()(AccRef acc, const pg8::Unit& u, int wr, int wc, int fr, int fq) const {
        const int row0 = u.pm * 256 + wr * 64 + fr, col0 = u.pn * 256 + wc * 32 + 4 * fq;
        const float* gp = gate + (size_t)(u.pm >> 3) * NMOD + col0;
        f32x4 gv[2][2];
#pragma unroll
        for (int bj = 0; bj < 2; ++bj)
#pragma unroll
            for (int n = 0; n < 2; ++n) gv[bj][n] = *(const f32x4*)(gp + bj * 128 + n * 16) * scale;
#pragma unroll
        for (int ai = 0; ai < 2; ++ai) {
            f32x4 bs[4][2][2];
#pragma unroll
            for (int m = 0; m < 4; ++m) { const size_t off = (size_t)(row0 + ai * 128 + m * 16) * D + col0;
#pragma unroll
                for (int bj = 0; bj < 2; ++bj)
#pragma unroll
                    for (int n = 0; n < 2; ++n) bs[m][bj][n] = *(const f32x4*)(base + off + bj * 128 + n * 16); }
#pragma unroll
            for (int m = 0; m < 4; ++m) { const size_t off = (size_t)(row0 + ai * 128 + m * 16) * D + col0;
#pragma unroll
                for (int bj = 0; bj < 2; ++bj)
#pragma unroll
                    for (int n = 0; n < 2; ++n) *(f32x4*)(out + off + bj * 128 + n * 16) = bs[m][bj][n] + gv[bj][n] * acc[ai][bj][m][n]; }
            asm volatile("" ::: "memory"); }
    }
};
struct EpiResidNorm {
    static constexpr bool PERM = false, HAS_MID = false, AFTER = true;
    const float* base; float* out; const float* gate;
    const float* gain; const float* modsh; bf16_t* un;
    unsigned* xslot; unsigned* cnt; float scale; int pad_;
    __device__ __forceinline__ void fused(f32x4 (&acc)[2][2][4][2], const pg8::Unit& u, int wr, int wc, int fr, int fq, LAS unsigned char* lds, int wid, int lane) const {
        const int row0 = u.pm * 256 + wr * 64 + fr, col0 = u.pn * 256 + wc * 32 + 4 * fq, tid = wid * 64 + lane;
        LAS float* Pt = (LAS float*)lds; LAS float* St = (LAS float*)(lds + 4096);
        const float* gp = gate + (size_t)(u.pm >> 3) * NMOD + col0;
        f32x4 gv[2][2];
#pragma unroll
        for (int bj = 0; bj < 2; ++bj)
#pragma unroll
            for (int n = 0; n < 2; ++n) gv[bj][n] = *(const f32x4*)(gp + bj * 128 + n * 16) * scale;
#pragma unroll
        for (int ai = 0; ai < 2; ++ai) {
            f32x4 bs[4][2][2];
#pragma unroll
            for (int m = 0; m < 4; ++m) { const size_t off = (size_t)(row0 + ai * 128 + m * 16) * D + col0;
#pragma unroll
                for (int bj = 0; bj < 2; ++bj)
#pragma unroll
                    for (int n = 0; n < 2; ++n) bs[m][bj][n] = *(const f32x4*)(base + off + bj * 128 + n * 16); }
#pragma unroll
            for (int m = 0; m < 4; ++m) { const size_t off = (size_t)(row0 + ai * 128 + m * 16) * D + col0; float sq = 0.f;
#pragma unroll
                for (int bj = 0; bj < 2; ++bj)
#pragma unroll
                    for (int n = 0; n < 2; ++n) { const f32x4 hv = bs[m][bj][n] + gv[bj][n] * acc[ai][bj][m][n]; acc[ai][bj][m][n] = hv; *(f32x4*)(out + off + bj * 128 + n * 16) = hv;
                        sq += (hv[0] * hv[0] + hv[1] * hv[1]) + (hv[2] * hv[2] + hv[3] * hv[3]); }
                sq += __shfl_xor(sq, 16); sq += __shfl_xor(sq, 32);
                if (fq == 0) Pt[(ai * 128 + wr * 64 + m * 16 + fr) * 4 + wc] = sq; }
            asm volatile("" ::: "memory"); }
        LDS_WAIT(); __syncthreads();
        if (tid < 256) { const f32x4 t4 = *(const LAS f32x4*)(Pt + tid * 4); const float sq = (t4[0] + t4[1]) + (t4[2] + t4[3]);
            __hip_atomic_store(xslot + ((size_t)(u.pm * 256 + tid) * 4 + u.pn), __float_as_uint(sq), __ATOMIC_RELAXED, __HIP_MEMORY_SCOPE_AGENT);
            asm volatile("s_waitcnt vmcnt(0)" ::: "memory");
            if (lane == 0) __hip_atomic_fetch_add(cnt + 64 * u.pm, 1u, __ATOMIC_RELAXED, __HIP_MEMORY_SCOPE_AGENT); }
        if (wid == 0) { unsigned spins = 0;
            while ((unsigned)__builtin_amdgcn_readfirstlane(__hip_atomic_load(cnt + 64 * u.pm, __ATOMIC_RELAXED, __HIP_MEMORY_SCOPE_AGENT)) < 16u) { __builtin_amdgcn_s_sleep(2); if (++spins > (1u << 22)) break; }
            __builtin_amdgcn_fence(__ATOMIC_ACQUIRE, "agent"); asm volatile("s_waitcnt vmcnt(0)" ::: "memory"); }
        __syncthreads();
        if (tid < 256) { const unsigned* sl = xslot + (size_t)(u.pm * 256 + tid) * 4; float sq = 0.f;
#pragma unroll
            for (int t = 0; t < 4; ++t) sq += __uint_as_float(__hip_atomic_load(sl + t, __ATOMIC_RELAXED, __HIP_MEMORY_SCOPE_AGENT));
            St[tid] = 1.0f / sqrtf(sq * (1.f / D) + EPS); }
        LDS_WAIT(); __syncthreads();
        const float* shp = modsh + (size_t)(u.pm >> 3) * NMOD + col0;
        f32x4 gs[2][2], sh[2][2];
#pragma unroll
        for (int bj = 0; bj < 2; ++bj)
#pragma unroll
            for (int n = 0; n < 2; ++n) { gs[bj][n] = *(const f32x4*)(gain + col0 + bj * 128 + n * 16) * (*(const f32x4*)(shp + D + bj * 128 + n * 16) + 1.0f); sh[bj][n] = *(const f32x4*)(shp + bj * 128 + n * 16); }
#pragma unroll
        for (int ai = 0; ai < 2; ++ai)
#pragma unroll
            for (int m = 0; m < 4; ++m) { const int r = ai * 128 + wr * 64 + m * 16 + fr; const float rstd = St[r]; bf16_t* up = un + (size_t)(u.pm * 256 + r) * D + col0;
#pragma unroll
                for (int bj = 0; bj < 2; ++bj)
#pragma unroll
                    for (int n = 0; n < 2; ++n) { const f32x4 uu = acc[ai][bj][m][n] * rstd * gs[bj][n] + sh[bj][n];
                        *(u32x2*)(up + bj * 128 + n * 16) = (u32x2){pk2(uu[0], uu[1]), pk2(uu[2], uu[3])}; } }
        __syncthreads();
    }
};
struct EpiGateFused {
    static constexpr bool PERM = true, HAS_MID = true, AFTER = false;
    const bf16_t* Rsb; const bf16_t* Rdn; bf16_t* O;
    __device__ __forceinline__ void mid(f32x4 (&acc)[2][2][4][2], const pg8::Unit& u, int wr, int wc, int fr, int fq) const {
        int row0 = u.pm * 256 + wr * 64 + fr, col0 = u.pn * 256 + wc * 32 + 8 * fq;
        asm volatile("" : "+v"(row0), "+v"(col0));
#pragma unroll
        for (int ai = 0; ai < 2; ++ai)
#pragma unroll
            for (int mp = 0; mp < 2; ++mp) {
                u32x4 av[2][2], dv[2][2];
#pragma unroll
                for (int mm = 0; mm < 2; ++mm)
#pragma unroll
                    for (int bj = 0; bj < 2; ++bj) { const size_t row = (size_t)(row0 + ai * 128 + (2 * mp + mm) * 16);
                        av[mm][bj] = *(const u32x4*)(Rsb + row * NIN + col0 + bj * 128); dv[mm][bj] = *(const u32x4*)(Rdn + row * NIN + col0 + bj * 128); }
#pragma unroll
                for (int mm = 0; mm < 2; ++mm)
#pragma unroll
                    for (int bj = 0; bj < 2; ++bj) { const int m = 2 * mp + mm; const u32x4 a = av[mm][bj], d = dv[mm][bj];
                        const float ra[8] = {bf_lo(a.x), bf_hi(a.x), bf_lo(a.y), bf_hi(a.y), bf_lo(a.z), bf_hi(a.z), bf_lo(a.w), bf_hi(a.w)};
                        const float rd[8] = {bf_lo(d.x), bf_hi(d.x), bf_lo(d.y), bf_hi(d.y), bf_lo(d.z), bf_hi(d.z), bf_lo(d.w), bf_hi(d.w)};
#pragma unroll
                        for (int e = 0; e < 8; ++e) { const float q = (1.0f + fexp(fminf(-rd[e], 30.0f))) * __builtin_amdgcn_rcpf(1.0f + fexp(-ra[e])); acc[ai][bj][m][e >> 2][e & 3] *= q; } }
                asm volatile("" ::: "memory"); }
    }
    __device__ __forceinline__ void operator()(AccRef acc, const pg8::Unit& u, int wr, int wc, int fr, int fq) const {
        const int row0 = u.pm * 256 + wr * 64 + fr, col0 = u.pn * 256 + wc * 32 + 8 * fq;
#pragma unroll
        for (int ai = 0; ai < 2; ++ai) {
            u32x4 dv[4][2];
#pragma unroll
            for (int m = 0; m < 4; ++m)
#pragma unroll
                for (int bj = 0; bj < 2; ++bj) dv[m][bj] = *(const u32x4*)(Rdn + (size_t)(row0 + ai * 128 + m * 16) * NIN + col0 + bj * 128);
#pragma unroll
            for (int m = 0; m < 4; ++m) { const size_t row = (size_t)(row0 + ai * 128 + m * 16);
#pragma unroll
                for (int bj = 0; bj < 2; ++bj) { const u32x4 d = dv[m][bj];
                    const f32x4 v0 = acc[ai][bj][m][0], v1 = acc[ai][bj][m][1];
#define SGC(x) __builtin_amdgcn_rcpf(1.0f + fexp(fminf(-(x), 30.0f)))
                    const float r[8] = {SGC(bf_lo(d.x)) * v0[0], SGC(bf_hi(d.x)) * v0[1], SGC(bf_lo(d.y)) * v0[2], SGC(bf_hi(d.y)) * v0[3],
                                        SGC(bf_lo(d.z)) * v1[0], SGC(bf_hi(d.z)) * v1[1], SGC(bf_lo(d.w)) * v1[2], SGC(bf_hi(d.w)) * v1[3]};
#undef SGC
                    u32x4 w; w.x = pk2(r[0], r[1]); w.y = pk2(r[2], r[3]); w.z = pk2(r[4], r[5]); w.w = pk2(r[6], r[7]);
                    *(u32x4*)(O + row * D + col0 + bj * 128) = w; } } }
    }
};
template <class Epi> __device__ __forceinline__ void run_gemm(LAS unsigned char* lds, const bf16_t* A, int lda, const bf16_t* Bt, int N, int K, const Epi E, int jt = 1 << 30, int jbytes = 0) {
    pg8::Gemm g{A, Bt, T, N, K, lda, jt, jbytes}; pg8::StaticOrder S; S.init(T, N, (int)gridDim.x, (int)blockIdx.x);
    pg8::gemm_phase<Epi>(lds, g, S, E);
}

__device__ __forceinline__ void transpose_item(const float* W, int ldw, int s0, int k0, bf16_t* WT, int ldk, int d0, LAS float* scr, int lane) {
    float tv[32];
#pragma unroll
    for (int i = 0; i < 32; ++i) tv[i] = W[(size_t)(k0 + 2 * i + (lane >> 5)) * ldw + s0 + (lane & 31)];
#pragma unroll
    for (int i = 0; i < 32; ++i) scr[(2 * i + (lane >> 5)) * 33 + (lane & 31)] = tv[i];
    LDS_WAIT();
    const int c = lane & 7;
#pragma unroll
    for (int j = 0; j < 4; ++j) { const int n = (lane >> 3) + 8 * j; const LAS float* s = scr + (8 * c) * 33 + n;
        u32x4 o; o.x = pk2(s[0 * 33], s[1 * 33]); o.y = pk2(s[2 * 33], s[3 * 33]); o.z = pk2(s[4 * 33], s[5 * 33]); o.w = pk2(s[6 * 33], s[7 * 33]);
        *(u32x4*)(WT + (size_t)(d0 + n) * ldk + k0 + 8 * c) = o; }
    LDS_WAIT();
}
struct TrD { const float* W; int ldw, s0, k0; bf16_t* WT; int ldk, d0; };
__device__ __forceinline__ TrD ffn_item_desc(const float* w_in, const float* w_out, bf16_t* wt_in, bf16_t* wt_out, int it) {
    if (it < 2816) { const int kb = it / 176, nb = it % 176, d0 = nb * 32, pn = d0 >> 8, bj = (d0 >> 7) & 1, c = d0 & 127, s0 = bj * FF + pn * 128 + c; return TrD{w_in, 2 * FF, s0, kb * 64, wt_in, D, d0}; }
    const int r = it - 2816, kb = r / 32, nb = r % 32; return TrD{w_out, D, nb * 32, kb * 64, wt_out, FF, nb * 32};
}
__device__ __forceinline__ void ffn_weight_items(const float* w_in, const float* w_out, bf16_t* wt_in, bf16_t* wt_out, LAS float* scr, int gw, int ngw, int lane, int lo = 0, int NIT = 2816 + 1408) {
    gw += lo;
    float tv[32];
#define TR_LOAD(d_) do { _Pragma("unroll") for (int i = 0; i < 32; ++i) tv[i] = (d_).W[(size_t)((d_).k0 + 2 * i + (lane >> 5)) * (d_).ldw + (d_).s0 + (lane & 31)]; } while (0)
    if (gw < NIT) { const TrD d0_ = ffn_item_desc(w_in, w_out, wt_in, wt_out, gw); TR_LOAD(d0_); }
    for (int it = gw; it < NIT; it += ngw) {
        const TrD d = ffn_item_desc(w_in, w_out, wt_in, wt_out, it);
#pragma unroll
        for (int i = 0; i < 32; ++i) scr[(2 * i + (lane >> 5)) * 33 + (lane & 31)] = tv[i];
        LDS_WAIT();
        if (it + ngw < NIT) { const TrD dn = ffn_item_desc(w_in, w_out, wt_in, wt_out, it + ngw); TR_LOAD(dn); }
        const int c = lane & 7;
#pragma unroll
        for (int j = 0; j < 4; ++j) { const int n = (lane >> 3) + 8 * j; const LAS float* s_ = scr + (8 * c) * 33 + n;
            u32x4 o; o.x = pk2(s_[0 * 33], s_[1 * 33]); o.y = pk2(s_[2 * 33], s_[3 * 33]); o.z = pk2(s_[4 * 33], s_[5 * 33]); o.w = pk2(s_[6 * 33], s_[7 * 33]);
            *(u32x4*)(d.WT + (size_t)(d.d0 + n) * d.ldk + d.k0 + 8 * c) = o; }
        LDS_WAIT();
    }
#undef TR_LOAD
}
__device__ __forceinline__ void mixer_weight_items(const Params& p, LAS float* scr, int gw, int ngw, int lane) {
    unsigned char* ws = p.ws;
    for (int it = gw; it < 2816 + 256 + 256 + 512; it += ngw) {
        int r = it;
        if (r < 2816) { const int kb = r / 176, nb = r % 176, d0 = nb * 32, s0 = d0 < C_RSB ? d0 : d0 + 8; transpose_item(p.in[I_WIN], INW, s0, kb * 64, (bf16_t*)(ws + W_IN), D, d0, scr, lane); continue; } r -= 2816;
        if (r < 256) { const int kb = r / 32, nb = r % 32; transpose_item(p.in[I_WUPSB], D, nb * 32, kb * 64, (bf16_t*)(ws + W_UPSB), D, nb * 32, scr, lane); continue; } r -= 256;
        if (r < 256) { const int kb = r / 32, nb = r % 32; transpose_item(p.in[I_WUPDN], D, nb * 32, kb * 64, (bf16_t*)(ws + W_UPSB) + 512, D, nb * 32, scr, lane); continue; } r -= 256;
        { const int kb = r / 32, nb = r % 32; transpose_item(p.in[I_WOUT], D, nb * 32, kb * 64, (bf16_t*)(ws + W_OUT), D, nb * 32, scr, lane); }
    }
}
__device__ __forceinline__ void mod_item(const Params& p, LAS unsigned char* lds, int cb, int tid, int wave, int lane) {
    asm volatile("" : "+v"(tid), "+v"(lane));
    LAS float* sc = (LAS float*)lds; LAS float* red = (LAS float*)(lds + 32768);
    for (int i = tid; i < NB * D; i += 512) sc[i] = fsilu(p.in[I_C][i]);
    __syncthreads();
    const float* wa = p.in[I_WADA] + cb * 64 + lane;
    float acc[NB];
#pragma unroll
    for (int b = 0; b < NB; ++b) acc[b] = 0.f;
    for (int k = wave * 128; k < wave * 128 + 128; k += 32) {
        float w[32];
#pragma unroll
        for (int e = 0; e < 32; ++e) w[e] = wa[(size_t)(k + e) * NMOD];
#pragma unroll
        for (int b = 0; b < NB; ++b)
#pragma unroll
            for (int e4 = 0; e4 < 8; ++e4) { const f32x4 s = *(const LAS f32x4*)(sc + b * D + k + 4 * e4); acc[b] += s[0] * w[4 * e4] + s[1] * w[4 * e4 + 1] + s[2] * w[4 * e4 + 2] + s[3] * w[4 * e4 + 3]; }
    }
#pragma unroll
    for (int b = 0; b < NB; ++b) red[(wave * NB + b) * 64 + lane] = acc[b];
    __syncthreads();
    { const int b = tid >> 6; float s = p.in[I_BADA][cb * 64 + lane];
#pragma unroll
        for (int w = 0; w < 8; ++w) s += red[(w * NB + b) * 64 + lane];
        ((float*)(p.ws + WS_MOD))[b * NMOD + cb * 64 + lane] = s; }
    __syncthreads();
}

template <bool DN>
__device__ __forceinline__ void norm_mod_phase(const Params& p, LAS unsigned char* lds, const float* src, const float* gain, int midx, bf16_t* dst, int tid, int wave, int lane) {
    asm volatile("" : "+v"(tid), "+v"(lane));
    const float* mod = (const float*)(p.ws + WS_MOD);
    LAS float* wl = (LAS float*)lds;
    if (DN) { for (int i = tid; i < D * 8; i += 512) { const int k = i >> 3, j = i & 7; wl[8 * k + 4 * (k >> 2) + j] = p.in[I_WIN][(size_t)k * INW + C_RSB + j]; } __syncthreads(); }
    f32x4 g4[4];
#pragma unroll
    for (int j = 0; j < 4; ++j) g4[j] = ((const f32x4*)gain)[lane + 64 * j];
    const int rstep = gridDim.x * 8;
    f32x4 nv[4];
    { const int r0 = blockIdx.x * 8 + wave; const f32x4* xr = (const f32x4*)(src + (size_t)(r0 < T ? r0 : 0) * D) + lane;
#pragma unroll
      for (int j = 0; j < 4; ++j) nv[j] = xr[64 * j]; }
    for (int row = blockIdx.x * 8 + wave; row < T; row += rstep) {
        const int b = row >> 11;
        const f32x4* shp = (const f32x4*)(mod + (size_t)b * NMOD + midx * D) + lane; const f32x4* scp = shp + D / 4;
        f32x4 v[4], shv[4], scv[4]; float ss = 0.f;
#pragma unroll
        for (int j = 0; j < 4; ++j) { v[j] = nv[j]; shv[j] = shp[64 * j]; scv[j] = scp[64 * j]; }
        { const int rn = row + rstep < T ? row + rstep : row; const f32x4* xr = (const f32x4*)(src + (size_t)rn * D) + lane;
#pragma unroll
          for (int j = 0; j < 4; ++j) nv[j] = xr[64 * j]; }
#pragma unroll
        for (int j = 0; j < 4; ++j) ss += (v[j][0] * v[j][0] + v[j][1] * v[j][1]) + (v[j][2] * v[j][2] + v[j][3] * v[j][3]);
        const float rstd = 1.0f / sqrtf(wave_sum(ss) * (1.f / D) + EPS);
        u32x2* o8 = (u32x2*)(dst + (size_t)row * D) + lane;
        float dot[8];
        if (DN) {
#pragma unroll
            for (int e = 0; e < 8; ++e) dot[e] = 0.f; }
#pragma unroll
        for (int j = 0; j < 4; ++j) { const f32x4 sh = shv[j], sc = scv[j];
            const f32x4 uu = v[j] * rstd * g4[j] * (sc + 1.0f) + sh;
            u32x2 w; w.x = pk2(uu[0], uu[1]); w.y = pk2(uu[2], uu[3]); o8[64 * j] = w;
            if (DN) {
#pragma unroll
                for (int e = 0; e < 4; ++e) { const int k = 4 * lane + 256 * j + e; const LAS f32x4* wp = (const LAS f32x4*)(wl + 8 * k + 4 * (k >> 2)); const f32x4 w0 = wp[0], w1 = wp[1];
                    dot[0] += uu[e] * w0[0]; dot[1] += uu[e] * w0[1]; dot[2] += uu[e] * w0[2]; dot[3] += uu[e] * w0[3];
                    dot[4] += uu[e] * w1[0]; dot[5] += uu[e] * w1[1]; dot[6] += uu[e] * w1[2]; dot[7] += uu[e] * w1[3]; } } }
        if (DN) {
#pragma unroll
            for (int e = 0; e < 8; ++e) dot[e] = wave_sum(dot[e]);
            float mine = dot[0];
#pragma unroll
            for (int e = 1; e < 8; ++e) mine = (lane == e) ? dot[e] : mine;
            if (lane < 8) { float r;
                if (lane < 4) r = 1.0f / (1.0f + expf(-mine));
                else { const int hh = lane - 4; const float a = mine + p.in[I_DTBIAS][hh]; const float sp = a > 20.f ? a : log1pf(expf(a)); r = -expf(p.in[I_ALOG][hh]) * sp; }
                ((float*)(p.ws + WS_BG))[(size_t)row * 8 + lane] = r; } }
    }
    if (DN) __syncthreads();
}

__device__ __forceinline__ void dn_gate_phase(const Params& p, LAS unsigned char* lds, const bf16_t* u2, int tid, int wave, int lane) {
    asm volatile("" : "+v"(tid), "+v"(lane));
    LAS float* wl = (LAS float*)lds;
    for (int i = tid; i < D * 8; i += 512) { const int k = i >> 3, j = i & 7; wl[8 * k + 4 * (k >> 2) + j] = p.in[I_WIN][(size_t)k * INW + C_RSB + j]; }
    __syncthreads();
    const int rstep = gridDim.x * 8;
    u32x4 na, nb;
    { const int r0 = blockIdx.x * 8 + wave; const bf16_t* up = u2 + (size_t)(r0 < T ? r0 : 0) * D + 16 * lane; na = ((const u32x4*)up)[0]; nb = ((const u32x4*)up)[1]; }
    for (int row = blockIdx.x * 8 + wave; row < T; row += rstep) {
        const u32x4 ca = na, cb = nb;
        { const int rn = row + rstep < T ? row + rstep : row; const bf16_t* up = u2 + (size_t)rn * D + 16 * lane; na = ((const u32x4*)up)[0]; nb = ((const u32x4*)up)[1]; }
        const unsigned w8[8] = {ca.x, ca.y, ca.z, ca.w, cb.x, cb.y, cb.z, cb.w};
        float dot[8];
#pragma unroll
        for (int e = 0; e < 8; ++e) dot[e] = 0.f;
#pragma unroll
        for (int e = 0; e < 16; ++e) { const int k = 16 * lane + e; const LAS f32x4* wp = (const LAS f32x4*)(wl + 8 * k + 4 * (k >> 2)); const f32x4 w0 = wp[0], w1 = wp[1];
            const float uv = (e & 1) ? bf_hi(w8[e >> 1]) : bf_lo(w8[e >> 1]);
            dot[0] += uv * w0[0]; dot[1] += uv * w0[1]; dot[2] += uv * w0[2]; dot[3] += uv * w0[3]; dot[4] += uv * w1[0]; dot[5] += uv * w1[1]; dot[6] += uv * w1[2]; dot[7] += uv * w1[3]; }
#pragma unroll
        for (int e = 0; e < 8; ++e) dot[e] = wave_sum(dot[e]);
        float mine = dot[0];
#pragma unroll
        for (int e = 1; e < 8; ++e) mine = (lane == e) ? dot[e] : mine;
        if (lane < 8) { float r;
            if (lane < 4) r = 1.0f / (1.0f + expf(-mine));
            else { const int hh = lane - 4; const float a = mine + p.in[I_DTBIAS][hh]; const float sp = a > 20.f ? a : log1pf(expf(a)); r = -expf(p.in[I_ALOG][hh]) * sp; }
            ((float*)(p.ws + WS_BG))[(size_t)row * 8 + lane] = r; }
    }
    __syncthreads();
}
__device__ __forceinline__ void unpack16(const bf16_t* p, float* f) {
    const u32x4 a = ((const u32x4*)p)[0], b = ((const u32x4*)p)[1];
    f[0] = bf_lo(a.x); f[1] = bf_hi(a.x); f[2] = bf_lo(a.y); f[3] = bf_hi(a.y); f[4] = bf_lo(a.z); f[5] = bf_hi(a.z); f[6] = bf_lo(a.w); f[7] = bf_hi(a.w);
    f[8] = bf_lo(b.x); f[9] = bf_hi(b.x); f[10] = bf_lo(b.y); f[11] = bf_hi(b.y); f[12] = bf_lo(b.z); f[13] = bf_hi(b.z); f[14] = bf_lo(b.w); f[15] = bf_hi(b.w);
}
__device__ __forceinline__ void pack16(bf16_t* p, const float* f) {
    u32x4 a, b; a.x = pk2(f[0], f[1]); a.y = pk2(f[2], f[3]); a.z = pk2(f[4], f[5]); a.w = pk2(f[6], f[7]); b.x = pk2(f[8], f[9]); b.y = pk2(f[10], f[11]); b.z = pk2(f[12], f[13]); b.w = pk2(f[14], f[15]);
    ((u32x4*)p)[0] = a; ((u32x4*)p)[1] = b;
}
__device__ __forceinline__ void prep_phase(const Params& p, LAS unsigned char* lds, bool dn, int tid, int wave, int lane) {
    asm volatile("" : "+v"(lane), "+v"(tid));
    bf16_t* P = (bf16_t*)(p.ws + WS_P); bf16_t* U = (bf16_t*)(p.ws + WS_U);
    LAS float* wl = (LAS float*)lds;
    if (dn) { for (int i = tid; i < D * 8; i += 512) { const int k = i >> 3, j = i & 7; wl[8 * k + 4 * (k >> 2) + j] = p.in[I_WIN][(size_t)k * INW + C_RSB + j]; } __syncthreads(); }
    const int ch = 16 * lane;
    float gsb[16], wcv[4][16];
    { const float* gp = (ch < 512 ? p.in[I_GQSB] : p.in[I_GKSB]) + (ch & 63); const float sc = ch < 512 ? 0.18033688011112042f : 1.0f;
#pragma unroll
        for (int e = 0; e < 16; ++e) gsb[e] = gp[e] * sc;
#pragma unroll
        for (int i = 0; i < 4; ++i)
#pragma unroll
            for (int e = 0; e < 16; ++e) wcv[i][e] = p.in[I_WCONV][i * 1536 + ch + e]; }
    for (int row = blockIdx.x * 8 + wave; row < T; row += gridDim.x * 8) {
        const int tl = row & (SEQ - 1);
        if (dn) {
            const u32x4 ca = *(const u32x4*)(U + (size_t)row * D + ch), cb = *(const u32x4*)(U + (size_t)row * D + ch + 8);
            const unsigned w8[8] = {ca.x, ca.y, ca.z, ca.w, cb.x, cb.y, cb.z, cb.w};
            float dot[8];
#pragma unroll
            for (int e = 0; e < 8; ++e) dot[e] = 0.f;
#pragma unroll
            for (int e = 0; e < 16; ++e) { const int k = ch + e; const LAS f32x4* wp = (const LAS f32x4*)(wl + 8 * k + 4 * (k >> 2)); const f32x4 w0 = wp[0], w1 = wp[1];
                const float uv = (e & 1) ? bf_hi(w8[e >> 1]) : bf_lo(w8[e >> 1]);
                dot[0] += uv * w0[0]; dot[1] += uv * w0[1]; dot[2] += uv * w0[2]; dot[3] += uv * w0[3]; dot[4] += uv * w1[0]; dot[5] += uv * w1[1]; dot[6] += uv * w1[2]; dot[7] += uv * w1[3]; }
#pragma unroll
            for (int e = 0; e < 8; ++e) dot[e] = wave_sum(dot[e]);
            float mine = dot[0];
#pragma unroll
            for (int e = 1; e < 8; ++e) mine = (lane == e) ? dot[e] : mine;
            if (lane < 8) { float r;
                if (lane < 4) r = 1.0f / (1.0f + expf(-mine));
                else { const int hh = lane - 4; const float a = mine + p.in[I_DTBIAS][hh]; const float sp = a > 20.f ? a : log1pf(expf(a)); r = -expf(p.in[I_ALOG][hh]) * sp; }
                ((float*)(p.ws + WS_BG))[(size_t)row * 8 + lane] = r; } }
        { bf16_t* qp = P + (size_t)row * NIN + ch; float f[16]; unpack16(qp, f); float ss = 0.f;
#pragma unroll
            for (int e = 0; e < 16; ++e) ss += f[e] * f[e];
            ss += __shfl_xor(ss, 1); ss += __shfl_xor(ss, 2);
            const float rstd = 1.0f / sqrtf(ss * (1.f / 64.f) + EPS);
#pragma unroll
            for (int e = 0; e < 16; ++e) f[e] = f[e] * rstd * gsb[e];
            pack16(qp, f); }
        { float y[16];
#pragma unroll
            for (int e = 0; e < 16; ++e) y[e] = 0.f;
#pragma unroll
            for (int i = 0; i < 4; ++i) { if (tl - 3 + i >= 0) { float f[16]; unpack16(P + (size_t)(row - 3 + i) * NIN + C_QDN + ch, f);
#pragma unroll
                    for (int e = 0; e < 16; ++e) y[e] += wcv[i][e] * f[e]; } }
            float ss = 0.f;
#pragma unroll
            for (int e = 0; e < 16; ++e) { y[e] = fsilu(y[e]); ss += y[e] * y[e]; }
            ss += __shfl_xor(ss, 1); ss += __shfl_xor(ss, 2); ss += __shfl_xor(ss, 4);
            const float sc = (1.0f / sqrtf(ss + EPS)) * (ch < 512 ? 0.08838834764831845f : 1.0f);
#pragma unroll
            for (int e = 0; e < 16; ++e) y[e] *= sc;
            pack16(U + (size_t)row * D + ch, y); }
    }
    bf16_t* Vt = (bf16_t*)(p.ws + WS_VT);
    for (int it = blockIdx.x * 8 + wave; it < T / 16; it += gridDim.x * 8) {
        const int row0 = it * 16, b = row0 >> 11, tl0 = row0 & (SEQ - 1), c8 = lane * 8, hd = c8 >> 6, d0 = c8 & 63;
        u32x4 w[16];
#pragma unroll
        for (int r = 0; r < 16; ++r) w[r] = *(const u32x4*)(P + (size_t)(row0 + r) * NIN + C_VSB + c8);
#pragma unroll
        for (int e = 0; e < 8; ++e) {
            unsigned o[8];
#pragma unroll
            for (int i = 0; i < 8; ++i) {
                const int p0 = 2 * i, p1 = 2 * i + 1;
                const int k0 = 8 * ((p0 >> 2) & 1) + 4 * (p0 >> 3) + (p0 & 3), k1 = 8 * ((p1 >> 2) & 1) + 4 * (p1 >> 3) + (p1 & 3);
                const unsigned a0 = w[k0][e >> 1], a1 = w[k1][e >> 1];
                const unsigned lo = (e & 1) ? (a0 >> 16) : (a0 & 0xffffu), hi = (e & 1) ? (a1 & 0xffff0000u) : (a1 << 16);
                o[i] = lo | hi; }
            bf16_t* dst = Vt + ((size_t)(b * 8 + hd) * 64 + d0 + e) * SEQ + tl0;
            ((u32x4*)dst)[0] = (u32x4){o[0], o[1], o[2], o[3]}; ((u32x4*)dst)[1] = (u32x4){o[4], o[5], o[6], o[7]}; }
    }
}

__device__ __forceinline__ float xlane32(float x, int hh) {
    const unsigned xi = __builtin_bit_cast(unsigned, x);
    const u32x2 r = __builtin_amdgcn_permlane32_swap(xi, xi, false, false);
    return __builtin_bit_cast(float, hh ? r.x : r.y);
}
template <bool DIAG>
__device__ __forceinline__ void attn_tile(const f32x16& z, const bf16x8 (&vc)[4], f32x16& o0, f32x16& o1, float& R, int ql, int hh) {
    float sg[16], m[16];
#pragma unroll
    for (int i = 0; i < 16; ++i) { const float e = __builtin_amdgcn_exp2f(fminf(-z[i], 80.0f)); float sig = __builtin_amdgcn_rcpf(1.0f + e); float mm = e * sig;
        if (DIAG) { const bool act = ((i & 3) + 8 * (i >> 2) + 4 * hh) < ql; sig = act ? sig : 0.f; mm = act ? mm : 1.0f; }
        sg[i] = sig; m[i] = mm; }
    float g[4], gp[4];
#pragma unroll
    for (int bq = 0; bq < 4; ++bq) { g[bq] = (m[4 * bq] * m[4 * bq + 1]) * (m[4 * bq + 2] * m[4 * bq + 3]); gp[bq] = xlane32(g[bq], hh); }
    float outer[4]; float tb = R;
#pragma unroll
    for (int bq = 3; bq >= 0; --bq) { outer[bq] = hh == 0 ? tb * gp[bq] : tb; tb *= g[bq] * gp[bq]; }
    R = tb;
    float w[16];
#pragma unroll
    for (int bq = 0; bq < 4; ++bq) { const float s3 = outer[bq], s2 = s3 * m[4 * bq + 3], s1 = s2 * m[4 * bq + 2], s0 = s1 * m[4 * bq + 1];
        w[4 * bq + 3] = sg[4 * bq + 3] * s3; w[4 * bq + 2] = sg[4 * bq + 2] * s2; w[4 * bq + 1] = sg[4 * bq + 1] * s1; w[4 * bq] = sg[4 * bq] * s0; }
    bf16x8 wf[2];
#pragma unroll
    for (int s2 = 0; s2 < 2; ++s2) { const u32x4 pw = {cpk2(w[8 * s2], w[8 * s2 + 1]), cpk2(w[8 * s2 + 2], w[8 * s2 + 3]), cpk2(w[8 * s2 + 4], w[8 * s2 + 5]), cpk2(w[8 * s2 + 6], w[8 * s2 + 7])}; wf[s2] = __builtin_bit_cast(bf16x8, pw); }
    o0 = __builtin_amdgcn_mfma_f32_32x32x16_bf16(vc[0], wf[0], o0, 0, 0, 0); o0 = __builtin_amdgcn_mfma_f32_32x32x16_bf16(vc[1], wf[1], o0, 0, 0, 0);
    o1 = __builtin_amdgcn_mfma_f32_32x32x16_bf16(vc[2], wf[0], o1, 0, 0, 0); o1 = __builtin_amdgcn_mfma_f32_32x32x16_bf16(vc[3], wf[1], o1, 0, 0, 0);
}
__device__ __forceinline__ void attn_item_mfma(bf16_t* P, const bf16_t* Vt, int bh, int qt, int lane) {
    asm volatile("" : "+v"(lane));
    const int b = bh >> 3, h = bh & 7, ql = lane & 31, hh = lane >> 5, q0 = qt * 32;
    bf16_t* qrow = P + (size_t)(b * SEQ + q0 + ql) * NIN + C_QSB + h * 64;
    bf16x8 qf[4];
#pragma unroll
    for (int s = 0; s < 4; ++s) qf[s] = *(const bf16x8*)(qrow + 16 * s + 8 * hh);
    f32x16 o0, o1;
#pragma unroll
    for (int i = 0; i < 16; ++i) { o0[i] = 0.f; o1[i] = 0.f; }
    float R = 1.0f;
    const bf16_t* kb = P + (size_t)(b * SEQ + ql) * NIN + C_KSB + h * 64 + 8 * hh;
    const bf16_t* vb = Vt + ((size_t)bh * 64 + ql) * SEQ + 8 * hh;
    bf16x8 kf[4], vf[4], vn[4];
#define AT_LOADK(k0_) do { _Pragma("unroll") for (int s = 0; s < 4; ++s) kf[s] = *(const bf16x8*)(kb + (size_t)(k0_) * NIN + 16 * s); } while (0)
#define AT_LOADV(dst, k0_) do { _Pragma("unroll") for (int j = 0; j < 4; ++j) dst[j] = *(const bf16x8*)(vb + (size_t)(j >> 1) * 32 * SEQ + (k0_) + 16 * (j & 1)); } while (0)
#define AT_QK(zz) do { _Pragma("unroll") for (int i = 0; i < 16; ++i) zz[i] = 0.f; _Pragma("unroll") for (int s = 0; s < 4; ++s) zz = __builtin_amdgcn_mfma_f32_32x32x16_bf16(kf[s], qf[s], zz, 0, 0, 0); } while (0)
    f32x16 zc, zn;
    AT_LOADK(q0); AT_LOADV(vf, q0);
    AT_QK(zc);
    { const int k1 = (qt > 0 ? qt - 1 : 0) * 32; AT_LOADK(k1); AT_LOADV(vn, k1); }
    { AT_QK(zn);
      const int k2 = (qt > 1 ? qt - 2 : 0) * 32; AT_LOADK(k2);
      attn_tile<true>(zc, vf, o0, o1, R, ql, hh);
      zc = zn;
#pragma unroll
      for (int j = 0; j < 4; ++j) vf[j] = vn[j];
      const int k1 = (qt > 1 ? qt - 2 : 0) * 32; AT_LOADV(vn, k1); }
#pragma unroll 1
    for (int kt = qt - 1; kt >= 0; --kt) {
        AT_QK(zn);
        const int k2 = (kt > 1 ? kt - 2 : 0) * 32; AT_LOADK(k2);
        attn_tile<false>(zc, vf, o0, o1, R, ql, hh);
        if (__builtin_amdgcn_ballot_w64(R != 0.0f) == 0ull) break;
        zc = zn;
#pragma unroll
        for (int j = 0; j < 4; ++j) vf[j] = vn[j];
        AT_LOADV(vn, k2);
    }
#undef AT_LOADK
#undef AT_LOADV
#undef AT_QK
#pragma unroll
    for (int bq = 0; bq < 4; ++bq) {
        u32x2 w0 = {cpk2(o0[4 * bq], o0[4 * bq + 1]), cpk2(o0[4 * bq + 2], o0[4 * bq + 3])}, w1 = {cpk2(o1[4 * bq], o1[4 * bq + 1]), cpk2(o1[4 * bq + 2], o1[4 * bq + 3])};
        *(u32x2*)(qrow + 8 * bq + 4 * hh) = w0; *(u32x2*)(qrow + 32 + 8 * bq + 4 * hh) = w1; }
}
__device__ __forceinline__ size_t slotU(size_t t0, int h, int colbase, int f) { return (t0 + (size_t)(f >> 7)) * D + colbase + h * 128 + (f & 127); }
__device__ __forceinline__ size_t slotP(size_t t0, int h, int colbase, int f) { return (t0 + (size_t)(f >> 7)) * NIN + colbase + h * 128 + (f & 127); }
__device__ __forceinline__ int permpos(int x) { const int k = x & 15; return (x & ~15) + 8 * ((k >> 2) & 1) + 4 * (k >> 3) + (k & 3); }
__device__ __forceinline__ int crow(int r, int hh) { return (r & 3) + 8 * (r >> 2) + 4 * hh; }
__device__ __forceinline__ bf16x8 pack8(const f32x16& x, int s2) {
    const u32x4 pw = {cpk2(x[8 * s2], x[8 * s2 + 1]), cpk2(x[8 * s2 + 2], x[8 * s2 + 3]), cpk2(x[8 * s2 + 4], x[8 * s2 + 5]), cpk2(x[8 * s2 + 6], x[8 * s2 + 7])};
    return __builtin_bit_cast(bf16x8, pw);
}
#define MFMA32(a, b, c) __builtin_amdgcn_mfma_f32_32x32x16_bf16((a), (b), (c), 0, 0, 0)
constexpr int PT = 72, PQ = 136, PL = 68, PB = 40;
constexpr int CP_GC = 0, CP_BT = 256, CP_LS = 1024, CP_TU = CP_LS + 64 * PL * 4, CP_TW = CP_TU + 64 * PT * 2, CP_KT = CP_TW + 64 * PT * 2, CP_VT = CP_KT + 128 * PT * 2,
              CP_QS = CP_VT + 128 * PT * 2, CP_KS = CP_QS + 64 * PQ * 2, CP_AQ = CP_KS + 64 * PQ * 2, CP_L21 = CP_AQ + 64 * PT * 2, CP_TCM = CP_L21 + 32 * PB * 2, CP_T22 = CP_TCM + 32 * PB * 2, CP_END = CP_T22 + 32 * PB * 2;
static_assert(CP_END <= 131072, "chunk prep LDS");
__device__ __forceinline__ void gdn_chunk_prep_phase(const Params& p, LAS unsigned char* lds, int tid, int wave, int lane) {
    bf16_t* P = (bf16_t*)(p.ws + WS_P); bf16_t* U = (bf16_t*)(p.ws + WS_U); const float* BG = (const float*)(p.ws + WS_BG);
    u32x4 ka, kb, qa, qb, xv[4][2]; float gx = 0.f, gbt = 0.f;
#define CP_LOAD(item_) do { const int bh_ = (item_) >> 5, n_ = (item_) & 31, b_ = bh_ >> 2, h_ = bh_ & 3; const size_t t0_ = (size_t)b_ * SEQ + n_ * 64; const int tok_ = tid >> 3, c16_ = (tid & 7) * 16; \
        ka = *(const u32x4*)(U + (t0_ + tok_) * D + 512 + h_ * 128 + c16_); kb = *(const u32x4*)(U + (t0_ + tok_) * D + 512 + h_ * 128 + c16_ + 8); \
        qa = *(const u32x4*)(U + (t0_ + tok_) * D + h_ * 128 + c16_); qb = *(const u32x4*)(U + (t0_ + tok_) * D + h_ * 128 + c16_ + 8); \
        _Pragma("unroll") for (int i = 0; i < 4; ++i) { const bool ok = n_ * 64 + tok_ - 3 + i >= 0; const bf16_t* vp = P + (t0_ + tok_ - 3 + i) * NIN + C_VDN + h_ * 128 + c16_; \
            xv[i][0] = ok ? *(const u32x4*)vp : (u32x4){0u, 0u, 0u, 0u}; xv[i][1] = ok ? *(const u32x4*)(vp + 8) : (u32x4){0u, 0u, 0u, 0u}; } \
        if (tid < 64) { gx = BG[(t0_ + tid) * 8 + 4 + h_]; gbt = BG[(t0_ + tid) * 8 + h_]; } } while (0)
    if ((int)blockIdx.x < 1024) CP_LOAD((int)blockIdx.x);
  for (int item = blockIdx.x; item < 1024; item += gridDim.x) {
    asm volatile("" : "+v"(tid), "+v"(lane));
    const int bh = item >> 5, n = item & 31, b = bh >> 2, h = bh & 3, ql = lane & 31, hh = lane >> 5;
    const size_t t0 = (size_t)b * SEQ + n * 64;
    LAS float* gcS = (LAS float*)(lds + CP_GC); LAS float* btS = (LAS float*)(lds + CP_BT);
    LAS float* LS = (LAS float*)(lds + CP_LS);
    LAS bf16_t* TuS = (LAS bf16_t*)(lds + CP_TU); LAS bf16_t* TwS = (LAS bf16_t*)(lds + CP_TW);
    LAS bf16_t* kT = (LAS bf16_t*)(lds + CP_KT); LAS bf16_t* vT = (LAS bf16_t*)(lds + CP_VT); LAS bf16_t* qS = (LAS bf16_t*)(lds + CP_QS); LAS bf16_t* kS = (LAS bf16_t*)(lds + CP_KS);
    LAS bf16_t* AQ = (LAS bf16_t*)(lds + CP_AQ); LAS bf16_t* L21b = (LAS bf16_t*)(lds + CP_L21); LAS bf16_t* Tcm = (LAS bf16_t*)(lds + CP_TCM); LAS bf16_t* T22r = (LAS bf16_t*)(lds + CP_T22);
    if (tid < 64) { float x = gx;
#pragma unroll
        for (int o = 1; o < 64; o <<= 1) { const float y = __shfl_up(x, o); if (lane >= o) x += y; }
        gcS[tid] = x; btS[tid] = gbt; }
    { const int tok = tid >> 3, c16 = (tid & 7) * 16;
        *(LAS u32x4*)(kS + tok * PQ + c16) = ka; *(LAS u32x4*)(kS + tok * PQ + c16 + 8) = kb;
        *(LAS u32x4*)(qS + tok * PQ + c16) = qa; *(LAS u32x4*)(qS + tok * PQ + c16 + 8) = qb;
        const unsigned kw[8] = {ka.x, ka.y, ka.z, ka.w, kb.x, kb.y, kb.z, kb.w};
#pragma unroll
        for (int e = 0; e < 8; ++e) { kT[(c16 + 2 * e) * PT + tok] = (bf16_t)(kw[e] & 0xffffu); kT[(c16 + 2 * e + 1) * PT + tok] = (bf16_t)(kw[e] >> 16); }
        float y[16];
#pragma unroll
        for (int e = 0; e < 16; ++e) y[e] = 0.f;
#pragma unroll
        for (int i = 0; i < 4; ++i) { const float* wp = p.in[I_WCONV] + i * 1536 + 1024 + h * 128 + c16;
            const unsigned xw[8] = {xv[i][0].x, xv[i][0].y, xv[i][0].z, xv[i][0].w, xv[i][1].x, xv[i][1].y, xv[i][1].z, xv[i][1].w};
#pragma unroll
            for (int e = 0; e < 8; ++e) { y[2 * e] += wp[2 * e] * bf_lo(xw[e]); y[2 * e + 1] += wp[2 * e + 1] * bf_hi(xw[e]); } }
#pragma unroll
        for (int e = 0; e < 16; ++e) vT[(c16 + e) * PT + tok] = f2bf(fsilu(y[e])); }
    __syncthreads();
    if (item + (int)gridDim.x < 1024) CP_LOAD(item + (int)gridDim.x);
    if (wave == 0 || wave == 4 || wave == 5) {
        const int it = wave == 0 ? 0 : 1, jt = wave == 4 ? 1 : 0;
        f32x16 acc;
#pragma unroll
        for (int r = 0; r < 16; ++r) acc[r] = 0.f;
#pragma unroll
        for (int ks = 0; ks < 8; ++ks) acc = MFMA32(*(const LAS bf16x8*)(kS + (32 * it + ql) * PQ + 16 * ks + 8 * hh), *(const LAS bf16x8*)(kS + (32 * jt + ql) * PQ + 16 * ks + 8 * hh), acc);
        const int j = 32 * jt + ql; const float gj = gcS[j];
#pragma unroll
        for (int r = 0; r < 16; ++r) { const int i = 32 * it + crow(r, hh); const float l = (j < i) ? btS[i] * acc[r] * fexp(gcS[i] - gj) : 0.f;
            if (it != jt) L21b[(i - 32) * PB + j] = f2bf(l); else LS[i * PL + j] = l; }
    } else if (wave < 4) {
        const int jt = wave == 3 ? 1 : 0, it = wave == 1 ? 0 : 1;
        f32x16 acc;
#pragma unroll
        for (int r = 0; r < 16; ++r) acc[r] = 0.f;
#pragma unroll
        for (int ks = 0; ks < 8; ++ks) acc = MFMA32(*(const LAS bf16x8*)(kS + (32 * jt + ql) * PQ + 16 * ks + 8 * hh), *(const LAS bf16x8*)(qS + (32 * it + ql) * PQ + 16 * ks + 8 * hh), acc);
        const int i = 32 * it + ql; const float gi = gcS[i];
#pragma unroll
        for (int r = 0; r < 16; ++r) { const int j = 32 * jt + crow(r, hh); acc[r] = (j <= i) ? acc[r] * fexp(gi - gcS[j]) : 0.f; }
#pragma unroll
        for (int bq = 0; bq < 4; ++bq) *(LAS u32x2*)(AQ + i * PT + 32 * jt + 8 * bq + 4 * hh) = (u32x2){cpk2(acc[4 * bq], acc[4 * bq + 1]), cpk2(acc[4 * bq + 2], acc[4 * bq + 3])};
    } else {
        const float gl = gcS[63];
#pragma unroll
        for (int uu = 0; uu < 4; ++uu) { const int unit = (tid - 384) + 128 * uu, dk = unit >> 2, blk = unit & 3;
            const u32x4 k0 = *(const LAS u32x4*)(kT + dk * PT + 16 * blk), k1 = *(const LAS u32x4*)(kT + dk * PT + 16 * blk + 8);
            float kv[16] = {bf_lo(k0.x), bf_hi(k0.x), bf_lo(k0.y), bf_hi(k0.y), bf_lo(k0.z), bf_hi(k0.z), bf_lo(k0.w), bf_hi(k0.w), bf_lo(k1.x), bf_hi(k1.x), bf_lo(k1.y), bf_hi(k1.y), bf_lo(k1.z), bf_hi(k1.z), bf_lo(k1.w), bf_hi(k1.w)};
#pragma unroll
            for (int e = 0; e < 16; ++e) kv[e] *= fexp(gl - gcS[16 * blk + e]);
            float pv[16];
#pragma unroll
            for (int e = 0; e < 16; ++e) pv[permpos(e)] = kv[e];
            pack16(P + slotP(t0, h, C_VSB, dk * 64 + 16 * blk), pv); }
        if (tid == 384) ((float*)(p.ws + WS_EGL))[bh * 32 + n] = fexp(gl);
    }
    __syncthreads();
    if (wave == 0) {
        const LAS float* LB = LS + (32 * hh) * PL + 32 * hh;
        float Tc[32];
#pragma unroll
        for (int i = 0; i < 32; ++i) {
            float a0 = (ql == i) ? 1.0f : 0.f, a1 = 0.f, a2 = 0.f, a3 = 0.f;
#pragma unroll
            for (int j4 = 0; j4 < i; j4 += 4) { const f32x4 l4 = *(const LAS f32x4*)(LB + i * PL + j4);
                a0 -= l4[0] * Tc[j4]; if (j4 + 1 < i) a1 -= l4[1] * Tc[j4 + 1]; if (j4 + 2 < i) a2 -= l4[2] * Tc[j4 + 2]; if (j4 + 3 < i) a3 -= l4[3] * Tc[j4 + 3]; }
            Tc[i] = (a0 + a1) + (a2 + a3); }
        const int cg_ = 32 * hh + ql; const float bu = btS[cg_], bw = bu * fexp(gcS[cg_]);
#pragma unroll
        for (int i = 0; i < 32; ++i) { TuS[(32 * hh + i) * PT + cg_] = f2bf(Tc[i] * bu); TwS[(32 * hh + i) * PT + cg_] = f2bf(Tc[i] * bw); }
        if (hh == 0) {
#pragma unroll
            for (int i8 = 0; i8 < 4; ++i8) *(LAS u32x4*)(Tcm + ql * PB + 8 * i8) = (u32x4){cpk2(Tc[8 * i8], Tc[8 * i8 + 1]), cpk2(Tc[8 * i8 + 2], Tc[8 * i8 + 3]), cpk2(Tc[8 * i8 + 4], Tc[8 * i8 + 5]), cpk2(Tc[8 * i8 + 6], Tc[8 * i8 + 7])};
        } else {
#pragma unroll
            for (int i = 0; i < 32; ++i) T22r[i * PB + ql] = f2bf(Tc[i]);
        }
        LDS_WAIT();
        f32x16 x1;
#pragma unroll
        for (int r = 0; r < 16; ++r) x1[r] = 0.f;
#pragma unroll
        for (int s2 = 0; s2 < 2; ++s2) x1 = MFMA32(*(const LAS bf16x8*)(L21b + ql * PB + 16 * s2 + 8 * hh), *(const LAS bf16x8*)(Tcm + ql * PB + 16 * s2 + 8 * hh), x1);
        f32x16 yy;
#pragma unroll
        for (int r = 0; r < 16; ++r) yy[r] = 0.f;
#pragma unroll
        for (int s2 = 0; s2 < 2; ++s2) { const u32x2 lo = *(const LAS u32x2*)(T22r + ql * PB + 16 * s2 + 4 * hh), hi = *(const LAS u32x2*)(T22r + ql * PB + 16 * s2 + 8 + 4 * hh);
            const u32x4 af = {lo.x, lo.y, hi.x, hi.y};
            yy = MFMA32(__builtin_bit_cast(bf16x8, af), pack8(x1, s2), yy); }
        { const float bu0 = btS[ql], bw0 = bu0 * fexp(gcS[ql]);
#pragma unroll
            for (int r = 0; r < 16; ++r) { const int i2 = 32 + crow(r, hh); TuS[i2 * PT + ql] = f2bf(-yy[r] * bu0); TwS[i2 * PT + ql] = f2bf(-yy[r] * bw0); } }
    }
    __syncthreads();
    {
        const int isW = wave >> 2, ct = wave & 3, col = 32 * ct + ql;
        const LAS bf16_t* Ta = (isW ? TwS : TuS) + 8 * hh; const LAS bf16_t* Bs = (isW ? kT : vT) + col * PT + 8 * hh;
        bf16x8 bf[4];
#pragma unroll
        for (int ks = 0; ks < 4; ++ks) bf[ks] = *(const LAS bf16x8*)(Bs + 16 * ks);
        f32x16 xa[2];
#pragma unroll
        for (int jt = 0; jt < 2; ++jt) {
#pragma unroll
            for (int r = 0; r < 16; ++r) xa[jt][r] = 0.f;
#pragma unroll
            for (int ks = 0; ks < 4; ++ks) if (jt == 1 || ks < 2) xa[jt] = MFMA32(*(const LAS bf16x8*)(Ta + (32 * jt + ql) * PT + 16 * ks), bf[ks], xa[jt]); }
        bf16x8 xb[4] = {pack8(xa[0], 0), pack8(xa[0], 1), pack8(xa[1], 0), pack8(xa[1], 1)};
        f32x16 ra[2];
#pragma unroll
        for (int it = 0; it < 2; ++it) {
#pragma unroll
            for (int r = 0; r < 16; ++r) ra[it][r] = 0.f;
#pragma unroll
            for (int kk = 0; kk < 4; ++kk) if (it == 1 || kk < 2) { const LAS bf16_t* ap = AQ + (32 * it + ql) * PT + 16 * kk + 4 * hh;
                const u32x2 lo = *(const LAS u32x2*)ap, hi = *(const LAS u32x2*)(ap + 8); const u32x4 af = {lo.x, lo.y, hi.x, hi.y};
                ra[it] = MFMA32(__builtin_bit_cast(bf16x8, af), xb[kk], ra[it]); } }
        if (!isW) {
#pragma unroll
            for (int jt = 0; jt < 2; ++jt)
#pragma unroll
                for (int bq = 0; bq < 4; ++bq) { const int f = col * 64 + 32 * jt + 8 * bq + 4 * hh;
                    *(u32x2*)(U + slotU(t0, h, 0, f)) = (u32x2){cpk2(xa[jt][4 * bq], xa[jt][4 * bq + 1]), cpk2(xa[jt][4 * bq + 2], xa[jt][4 * bq + 3])};
                    *(u32x2*)(U + slotU(t0, h, 512, f)) = (u32x2){cpk2(ra[jt][4 * bq], ra[jt][4 * bq + 1]), cpk2(ra[jt][4 * bq + 2], ra[jt][4 * bq + 3])}; }
        } else {
            const int pc = permpos(col);
#pragma unroll
            for (int jt = 0; jt < 2; ++jt)
#pragma unroll
                for (int r = 0; r < 16; ++r) { const int tok = 32 * jt + crow(r, hh);
                    P[(t0 + tok) * NIN + C_QDN + h * 128 + pc] = f2bf(-xa[jt][r]);
                    P[(t0 + tok) * NIN + C_KDN + h * 128 + pc] = f2bf(bf2f(qS[tok * PQ + col]) * fexp(gcS[tok]) - ra[jt][r]); }
        }
    }
    __syncthreads();
  }
#undef CP_LOAD
}
constexpr int SC_PW = 136, SC_PK = 72, SC_NW = 0, SC_Q2 = 64 * SC_PW * 2, SC_KD = 2 * 64 * SC_PW * 2, SC_STAGE = 2 * 64 * SC_PW * 2 + 128 * SC_PK * 2, SC_OS = 2 * SC_STAGE,
              SC_US = SC_OS + 64 * SC_PW * 2, SC_OI = SC_US + 128 * SC_PK * 2, SC_END = SC_OI + 128 * SC_PK * 2;
static_assert(SC_END <= BST_OFF, "scan LDS");
__device__ __forceinline__ void gdn_scan_block(const Params& p, LAS unsigned char* lds, int bh, int tid, int wave, int lane) {
    asm volatile("" : "+v"(tid), "+v"(lane));
    bf16_t* P = (bf16_t*)(p.ws + WS_P); const bf16_t* U = (const bf16_t*)(p.ws + WS_U); const float* EGL = (const float*)(p.ws + WS_EGL);
    const int b = bh >> 2, h = bh & 3, ql = lane & 31, hh = lane >> 5;
    const size_t tb = (size_t)b * SEQ;
    LAS bf16_t* oS = (LAS bf16_t*)(lds + SC_OS);
    if (wave >= 4) {
        int lt = tid - 256, ftok = lt >> 2, fseg = lt & 3;
        u32x4 ra[20], rb[20];
#define SC_LOAD(r, n_) do { const size_t t0_ = tb + (size_t)(n_) * 64; _Pragma("unroll") for (int i = 0; i < 4; ++i) { const int c = lt + 256 * i, row = c >> 4, c8 = (c & 15) * 8; \
            const bf16_t* g_ = P + (t0_ + row) * NIN + h * 128 + c8; const bf16_t* u_ = U + (t0_ + row) * D + h * 128 + c8; \
            r[i] = *(const u32x4*)(g_ + C_QDN); r[4 + i] = *(const u32x4*)(g_ + C_KDN); r[8 + i] = *(const u32x4*)(g_ + C_VSB); r[12 + i] = *(const u32x4*)u_; r[16 + i] = *(const u32x4*)(u_ + 512); } } while (0)
#define SC_STORE(r, st_) do { LAS unsigned char* s_ = lds + (st_) * SC_STAGE; _Pragma("unroll") for (int i = 0; i < 4; ++i) { const int c = lt + 256 * i, row = c >> 4, c8 = (c & 15) * 8; \
            *(LAS u32x4*)(s_ + SC_NW + (row * SC_PW + c8) * 2) = r[i]; *(LAS u32x4*)(s_ + SC_Q2 + (row * SC_PW + c8) * 2) = r[4 + i]; \
            *(LAS u32x4*)(s_ + SC_KD + ((2 * row + (c8 >> 6)) * SC_PK + (c8 & 63)) * 2) = r[8 + i]; } } while (0)
#define SC_STOREU(r) do { _Pragma("unroll") for (int i = 0; i < 4; ++i) { const int c = lt + 256 * i, row = c >> 4, c8 = (c & 15) * 8; const int o_ = ((2 * row + (c8 >> 6)) * SC_PK + (c8 & 63)) * 2; \
            *(LAS u32x4*)(lds + SC_US + o_) = r[12 + i]; *(LAS u32x4*)(lds + SC_OI + o_) = r[16 + i]; } } while (0)
#define SC_FIN(m_) do { bf16_t* orow = P + (tb + (size_t)(m_) * 64 + ftok) * NIN + h * 128 + fseg * 32 + C_VDN; \
            _Pragma("unroll") for (int i = 0; i < 4; ++i) *(u32x4*)(orow + 8 * i) = *(const LAS u32x4*)(oS + ftok * SC_PW + fseg * 32 + 8 * i); } while (0)
        SC_LOAD(ra, 0); SC_STORE(ra, 0); SC_STOREU(ra); SC_LOAD(ra, 1);
        __syncthreads();
#pragma unroll 1
        for (int n = 0; n < 32; n += 2) {
            asm volatile("" : "+v"(lt), "+v"(ftok), "+v"(fseg));
            if (n + 2 < 32) SC_LOAD(rb, n + 2);
            SC_STORE(ra, 1);
            if (n > 0) SC_FIN(n - 1);
            __syncthreads();
            SC_STOREU(ra);
            __syncthreads();
            if (n + 3 < 32) SC_LOAD(ra, n + 3);
            if (n + 2 < 32) SC_STORE(rb, 0);
            SC_FIN(n);
            __syncthreads();
            if (n + 2 < 32) SC_STOREU(rb);
            __syncthreads();
        }
        SC_FIN(31);
#undef SC_LOAD
#undef SC_STORE
#undef SC_STOREU
#undef SC_FIN
    } else {
        const int col = 32 * wave + ql;
        f32x16 S[4];
#pragma unroll
        for (int rt = 0; rt < 4; ++rt)
#pragma unroll
            for (int r = 0; r < 16; ++r) S[rt][r] = 0.f;
        const float eglv = EGL[bh * 32 + ql];
        __syncthreads();
#pragma unroll 1
        for (int n = 0; n < 32; ++n) {
            const float egl = __builtin_bit_cast(float, __builtin_amdgcn_readlane(__builtin_bit_cast(int, eglv), n));
            const LAS unsigned char* st = lds + (n & 1) * SC_STAGE;
            f32x16 vn[2], oa[2];
            { const LAS unsigned char* up_ = lds + SC_US + (col * SC_PK + 4 * hh) * 2; const LAS unsigned char* op_ = lds + SC_OI + (col * SC_PK + 4 * hh) * 2;
#pragma unroll
              for (int jt = 0; jt < 2; ++jt)
#pragma unroll
                for (int bq = 0; bq < 4; ++bq) { const u32x2 uw = *(const LAS u32x2*)(up_ + (32 * jt + 8 * bq) * 2), ow = *(const LAS u32x2*)(op_ + (32 * jt + 8 * bq) * 2);
                    vn[jt][4 * bq] = bf_lo(uw.x); vn[jt][4 * bq + 1] = bf_hi(uw.x); vn[jt][4 * bq + 2] = bf_lo(uw.y); vn[jt][4 * bq + 3] = bf_hi(uw.y);
                    oa[jt][4 * bq] = bf_lo(ow.x); oa[jt][4 * bq + 1] = bf_hi(ow.x); oa[jt][4 * bq + 2] = bf_lo(ow.y); oa[jt][4 * bq + 3] = bf_hi(ow.y); } }
            const LAS unsigned char* w0_ = st + (ql * SC_PW + 8 * hh) * 2; const LAS unsigned char* w1_ = w0_ + 32 * SC_PW * 2;
            const LAS unsigned char* kd_ = st + SC_KD + (ql * SC_PK + 8 * hh) * 2;
            bf16x8 fa[4], fb[4];
#define SC_RD4(dst, ptr) do { _Pragma("unroll") for (int i_ = 0; i_ < 4; ++i_) dst[i_] = *(const LAS bf16x8*)((ptr) + 32 * i_); } while (0)
#define SC_MM4(acc, fr, bb) do { _Pragma("unroll") for (int i_ = 0; i_ < 4; ++i_) acc = MFMA32(fr[i_], bb[i_], acc); __builtin_amdgcn_sched_barrier(0); } while (0)
            SC_RD4(fa, w0_ + SC_NW); SC_RD4(fb, w1_ + SC_NW);
            { bf16x8 sb[4] = {pack8(S[0], 0), pack8(S[0], 1), pack8(S[1], 0), pack8(S[1], 1)};
              SC_MM4(vn[0], fa, sb); SC_RD4(fa, w0_ + SC_Q2);
              SC_MM4(vn[1], fb, sb); SC_RD4(fb, w1_ + SC_Q2);
              SC_MM4(oa[0], fa, sb); SC_RD4(fa, w0_ + SC_NW + 128);
              SC_MM4(oa[1], fb, sb); SC_RD4(fb, w1_ + SC_NW + 128); }
            { bf16x8 sb[4] = {pack8(S[2], 0), pack8(S[2], 1), pack8(S[3], 0), pack8(S[3], 1)};
              SC_MM4(vn[0], fa, sb); SC_RD4(fa, w0_ + SC_Q2 + 128);
              SC_MM4(vn[1], fb, sb); SC_RD4(fb, w1_ + SC_Q2 + 128);
              bf16x8 vb[4] = {pack8(vn[0], 0), pack8(vn[0], 1), pack8(vn[1], 0), pack8(vn[1], 1)};
              SC_MM4(oa[0], fa, sb); SC_RD4(fa, kd_);
              SC_MM4(oa[1], fb, sb); SC_RD4(fb, kd_ + 32 * SC_PK * 2);
#pragma unroll
              for (int rt = 0; rt < 4; ++rt)
#pragma unroll
                  for (int r = 0; r < 16; ++r) S[rt][r] *= egl;
              SC_MM4(S[0], fa, vb); SC_RD4(fa, kd_ + 64 * SC_PK * 2);
              SC_MM4(S[1], fb, vb); SC_RD4(fb, kd_ + 96 * SC_PK * 2);
              SC_MM4(S[2], fa, vb);
              SC_MM4(S[3], fb, vb); }
#undef SC_RD4
#undef SC_MM4
            __syncthreads();
#pragma unroll
            for (int jt = 0; jt < 2; ++jt)
#pragma unroll
                for (int r = 0; r < 16; ++r) oS[(32 * jt + crow(r, hh)) * SC_PW + col] = f2bf(oa[jt][r]);
            __syncthreads();
        }
    }
}
__device__ __forceinline__ void gdn_finalize_phase(const Params& p, int wave, int lane) {
    asm volatile("" : "+v"(lane));
    bf16_t* P = (bf16_t*)(p.ws + WS_P);
    const int c0 = (lane & 15) * 8;
    float gg[8];
#pragma unroll
    for (int e = 0; e < 8; ++e) gg[e] = p.in[I_GDNOUT][c0 + e];
    for (int row = blockIdx.x * 8 + wave; row < T; row += gridDim.x * 8) {
        bf16_t* op = P + (size_t)row * NIN + C_VDN + lane * 8; const bf16_t* zp = P + (size_t)row * NIN + C_ZDN + lane * 8;
        const u32x4 ow = *(const u32x4*)op, zw = *(const u32x4*)zp;
        const float o[8] = {bf_lo(ow.x), bf_hi(ow.x), bf_lo(ow.y), bf_hi(ow.y), bf_lo(ow.z), bf_hi(ow.z), bf_lo(ow.w), bf_hi(ow.w)};
        const float z[8] = {bf_lo(zw.x), bf_hi(zw.x), bf_lo(zw.y), bf_hi(zw.y), bf_lo(zw.z), bf_hi(zw.z), bf_lo(zw.w), bf_hi(zw.w)};
        float ss = 0.f;
#pragma unroll
        for (int e = 0; e < 8; ++e) ss += o[e] * o[e];
        ss += __shfl_xor(ss, 1); ss += __shfl_xor(ss, 2); ss += __shfl_xor(ss, 4); ss += __shfl_xor(ss, 8);
        const float rstd = 1.0f / sqrtf(ss * (1.f / 128.f) + EPS);
        float r[8];
#pragma unroll
        for (int e = 0; e < 8; ++e) r[e] = o[e] * rstd * gg[e] * fsilu(z[e]);
        u32x4 w; w.x = pk2(r[0], r[1]); w.y = pk2(r[2], r[3]); w.z = pk2(r[4], r[5]); w.w = pk2(r[6], r[7]);
        *(u32x4*)op = w;
    }
}

#define XB_TMO      128
#define XB_XCNT(j)  (256  + 64 * (j))
#define XB_XSUB(j)  (1280 + 64 * (j))
#define XB_XGEN(j)  (2304 + 64 * (j))
#define XB_TOP      3328
#define XB_TOPGEN   3392
#define XCD_BAR_WORDS 3456
#define XB_SPIN_CAP (1u << 18)
__device__ __forceinline__ unsigned xb_ld(unsigned* p)              { return __hip_atomic_load(p, __ATOMIC_RELAXED, __HIP_MEMORY_SCOPE_AGENT); }
__device__ __forceinline__ unsigned xb_add(unsigned* p, unsigned v) { return __hip_atomic_fetch_add(p, v, __ATOMIC_RELAXED, __HIP_MEMORY_SCOPE_AGENT); }
__device__ __forceinline__ unsigned xb_xcc_id() { return (unsigned)__builtin_amdgcn_s_getreg((3 << 11) | 20) & 0xFu; }
#define XB_SPIN(cond, bar) do { unsigned _sp = 0; while (cond) { __builtin_amdgcn_s_sleep(1); \
    if ((++_sp & 255u) == 0u) { if (xb_ld(&(bar)[XB_TMO])) break; if (_sp > XB_SPIN_CAP) { atomicAdd(&(bar)[XB_TMO], 1u); break; } } } } while (0)
struct XcdBarrier { unsigned* bar; unsigned x; volatile LAS unsigned* st; };
__device__ __forceinline__ XcdBarrier xcd_barrier_post(unsigned* bar, volatile LAS unsigned* st) {
    XcdBarrier b; b.bar = bar; b.x = xb_xcc_id(); b.st = st;
    if (threadIdx.x == 0) (void)xb_add(&bar[XB_XCNT(b.x)], 1u);
    return b;
}
__device__ __forceinline__ void xcd_barrier_complete(unsigned* bar, unsigned x, unsigned& nloc, unsigned& nx) {
    const unsigned G = gridDim.x * gridDim.y * gridDim.z;
    unsigned sum, cnt, mine, sp = 0u;
    for (;;) {
        sum = 0u; cnt = 0u; mine = 0u;
#pragma unroll
        for (unsigned j = 0; j < 16; ++j) { const unsigned c = xb_ld(&bar[XB_XCNT(j)]); sum += c; cnt += (c > 0u) ? 1u : 0u; mine = (j == x) ? c : mine; }
        if (sum == G) break;
        __builtin_amdgcn_s_sleep(1);
        if ((++sp & 255u) == 0u) { if (xb_ld(&bar[XB_TMO])) break; if (sp > XB_SPIN_CAP) { atomicAdd(&bar[XB_TMO], 1u); break; } }
    }
    nloc = mine > 0u ? mine : 1u; nx = cnt > 0u ? cnt : 1u;
}
__device__ __forceinline__ void xcd_barrier(const XcdBarrier& b) {
    asm volatile("s_waitcnt vmcnt(0)" ::: "memory");
    __syncthreads();
    if (threadIdx.x == 0) {
        unsigned* bar = b.bar;
        __builtin_amdgcn_s_waitcnt(0);
        unsigned nloc = b.st[0], nx = b.st[1];
        if (nloc == 0u) { xcd_barrier_complete(bar, b.x, nloc, nx); b.st[0] = nloc; b.st[1] = nx; }
        const unsigned old = xb_add(&bar[XB_XSUB(b.x)], 1u);
        const unsigned gen = old / nloc;
        if (old + 1u == (gen + 1u) * nloc) {
            __builtin_amdgcn_fence(__ATOMIC_RELEASE, "agent");
            asm volatile("s_waitcnt vmcnt(0)" ::: "memory");
            const unsigned og = xb_add(&bar[XB_TOP], 1u);
            const unsigned tg = og / nx;
            if (og + 1u == (tg + 1u) * nx) xb_add(&bar[XB_TOPGEN], 1u);
            else XB_SPIN(xb_ld(&bar[XB_TOPGEN]) == tg, bar);
            __builtin_amdgcn_fence(__ATOMIC_ACQUIRE, "agent");
            xb_add(&bar[XB_XGEN(b.x)], 1u);
            asm volatile("s_waitcnt vmcnt(0)" ::: "memory");
        } else {
            XB_SPIN(xb_ld(&bar[XB_XGEN(b.x)]) == gen, bar);
            __builtin_amdgcn_fence(__ATOMIC_ACQUIRE, "agent");
            asm volatile("s_waitcnt vmcnt(0)" ::: "memory");
        }
    }
    __syncthreads();
}

#ifndef PHMASK
#define PHMASK 0xFFFF
#endif
#define PH(n) ((PHMASK >> (n)) & 1)
#ifndef PROBE
#define PROBE 0
#endif
#define REP(g) for (int _rep = 0; _rep < ((PROBE == (g)) ? 2 : 1); ++_rep)
__global__ void __launch_bounds__(512, 2) fwd_megakernel(Params p) {
    extern __shared__ __attribute__((aligned(16))) unsigned char lds_raw[];
    LAS unsigned char* lds = (LAS unsigned char*)lds_raw;
    cg::grid_group grid = cg::this_grid();
    const int tid = threadIdx.x, lane = tid & 63, wave = __builtin_amdgcn_readfirstlane(tid >> 6);
    const int G = gridDim.x, gw = wave * G + blockIdx.x, ngw = G * 8;
    unsigned char* ws = p.ws;
    bf16_t* U = (bf16_t*)(ws + WS_U); bf16_t* P = (bf16_t*)(ws + WS_P);
    const float* mod = (const float*)(ws + WS_MOD);
    LAS float* scr = (LAS float*)(lds + wave * 16384);

    unsigned* barw = (unsigned*)(ws + WS_BAR);
    volatile LAS unsigned* bst = (volatile LAS unsigned*)(lds + BST_OFF);
    if (tid < 2) bst[tid] = 0u;
    __syncthreads();
    if (p.ws == nullptr) grid.sync();
    const XcdBarrier xbar = xcd_barrier_post(barw, bst);
    REP(1) { if (PH(0)) for (int it = blockIdx.x; it < NMOD / 64; it += G) mod_item(p, lds, it, tid, wave, lane);
    { const int nmod = NMOD / 64;
      if (PH(0)) { if (G >= nmod + 64) { if ((int)blockIdx.x >= nmod) ffn_weight_items(p.in[I_WFFN1IN], p.in[I_WFFN1OUT], (bf16_t*)(ws + W_FFIN), (bf16_t*)(ws + W_FFOUT), scr, wave * (G - nmod) + ((int)blockIdx.x - nmod), (G - nmod) * 8, lane); }
                   else ffn_weight_items(p.in[I_WFFN1IN], p.in[I_WFFN1OUT], (bf16_t*)(ws + W_FFIN), (bf16_t*)(ws + W_FFOUT), scr, gw, ngw, lane); } }
    __syncthreads(); }
    xcd_barrier(xbar);
    if (PROBE == 3) for (int i = 0; i < 16; ++i) xcd_barrier(xbar);
    REP(1) if (PH(1)) norm_mod_phase<false>(p, lds, p.in[I_X], p.in[I_GFFN1], 0, U, tid, wave, lane);
    xcd_barrier(xbar);
    REP(2) if (PH(2)) run_gemm(lds, U, D, (const bf16_t*)(ws + W_FFIN), 2 * FF, D, EpiSwiGLU{P, FF});
    { const int nfull = (64 * 22) % G, nidle = nfull ? G - nfull : G;
      const int ib = nfull ? (int)blockIdx.x - nfull : (int)blockIdx.x;
      if (PH(0) && ib >= 0) mixer_weight_items(p, scr, wave * nidle + ib, nidle * 8, lane); }
    xcd_barrier(xbar);
    const bool fusedn = (G == 256);
    unsigned* xslot = (unsigned*)(ws + WS_XSLOT); unsigned* xcnt = (unsigned*)(ws + WS_XCNT);
    if (fusedn) { if (PH(3)) run_gemm(lds, P, FF, (const bf16_t*)(ws + W_FFOUT), D, FF, EpiResidNorm{p.in[I_X], p.out, mod + 2 * D, p.in[I_GMIX], mod + 3 * D, U, xslot, xcnt, 0.5f, 0}); }
    else { REP(2) if (PH(3)) run_gemm(lds, P, FF, (const bf16_t*)(ws + W_FFOUT), D, FF, EpiResid{p.in[I_X], p.out, mod + 2 * D, 0.5f}); }
    xcd_barrier(xbar);
    if (!fusedn) { REP(1) if (PH(4)) norm_mod_phase<true>(p, lds, p.out, p.in[I_GMIX], 3, U, tid, wave, lane); xcd_barrier(xbar); }
    REP(2) if (PH(5)) run_gemm(lds, U, D, (const bf16_t*)(ws + W_IN), NIN, D, EpiBf16{P, NIN});
    { const int nfull = (64 * 22) % G, nidle = nfull ? G - nfull : G; const int ib = nfull ? (int)blockIdx.x - nfull : (int)blockIdx.x;
      if (PH(12) && ib >= 0) ffn_weight_items(p.in[I_WFFN2IN], p.in[I_WFFN2OUT], (bf16_t*)(ws + WS_F2IN), (bf16_t*)(ws + W_FFOUT), scr, wave * nidle + ib, nidle * 8, lane, 0, 2816); }
    xcd_barrier(xbar);
    if (PH(6)) prep_phase(p, lds, fusedn, tid, wave, lane);
    xcd_barrier(xbar);
    if (PH(7)) gdn_chunk_prep_phase(p, lds, tid, wave, lane);
    xcd_barrier(xbar);
    if (PH(15)) for (int it = blockIdx.x; it < 32; it += G) gdn_scan_block(p, lds, it, tid, wave, lane);
    if (PH(8)) {
        const unsigned x0 = xb_xcc_id() & 7u;
        for (unsigned dx = 0; dx < 8u; ++dx) { const unsigned x = (x0 + dx) & 7u; unsigned* ctr = (unsigned*)(ws + WS_CTR) + 64 * x;
            for (;;) { unsigned idx = 0; if (lane == 0) idx = atomicAdd(ctr, 1u); idx = __builtin_amdgcn_readfirstlane(idx);
                if (idx >= 512u) break;
                attn_item_mfma(P, (const bf16_t*)(ws + WS_VT), (int)(8u * x + (idx & 7u)), 63 - (int)(idx >> 3), lane); } } }
    xcd_barrier(xbar);
    if (PH(9)) gdn_finalize_phase(p, wave, lane);
    xcd_barrier(xbar);
    if (PH(10)) run_gemm(lds, P + C_QSB, NIN, (const bf16_t*)(ws + W_UPSB), D, 1024, EpiGateFused{P + C_RSB, P + C_RDN, U}, 8, (C_VDN - C_QSB) * 2 - 8 * 128);
    if (fusedn && PH(12)) ffn_weight_items(p.in[I_WFFN2IN], p.in[I_WFFN2OUT], (bf16_t*)(ws + WS_F2IN), (bf16_t*)(ws + W_FFOUT), scr, gw, ngw, lane, 2816, 2816 + 1408);
    xcd_barrier(xbar);
    if (fusedn) { if (PH(11)) run_gemm(lds, U, D, (const bf16_t*)(ws + W_OUT), D, D, EpiResidNorm{p.out, p.out, mod + 5 * D, p.in[I_GFFN2], mod + 6 * D, U, xslot + 64 * 256 * 4, xcnt + 64 * 64, 1.0f, 0}); }
    else { if (PH(11)) run_gemm(lds, U, D, (const bf16_t*)(ws + W_OUT), D, D, EpiResid{p.out, p.out, mod + 5 * D, 1.0f}); }
    xcd_barrier(xbar);
    if (!fusedn) { REP(1) if (PH(12)) norm_mod_phase<false>(p, lds, p.out, p.in[I_GFFN2], 6, U, tid, wave, lane);
        __syncthreads();
        if (PH(12)) ffn_weight_items(p.in[I_WFFN2IN], p.in[I_WFFN2OUT], (bf16_t*)(ws + WS_F2IN), (bf16_t*)(ws + W_FFOUT), scr, gw, ngw, lane, 2816, 2816 + 1408);
        xcd_barrier(xbar); }
    REP(2) if (PH(13)) run_gemm(lds, U, D, (const bf16_t*)(ws + WS_F2IN), 2 * FF, D, EpiSwiGLU{P, FF});
    xcd_barrier(xbar);
    if (PH(14)) run_gemm(lds, P, FF, (const bf16_t*)(ws + W_FFOUT), D, FF, EpiResid{p.out, p.out, mod + 8 * D, 0.5f});
}

extern "C" void kernel_launch(void* const* d_in, const int* in_sizes, int n_in, void* d_out, int out_size, void* d_ws, size_t ws_size, hipStream_t stream) {
    static int grid_blocks = 0;
    if (!grid_blocks) {
        int dev = 0, cus = 0, per_cu = 0;
        (void)hipGetDevice(&dev);
        (void)hipDeviceGetAttribute(&cus, hipDeviceAttributeMultiprocessorCount, dev);
        (void)hipFuncSetAttribute((const void*)fwd_megakernel, hipFuncAttributeMaxDynamicSharedMemorySize, LDS_BYTES);
        (void)hipOccupancyMaxActiveBlocksPerMultiprocessor(&per_cu, (const void*)fwd_megakernel, 512, LDS_BYTES);
        if (per_cu < 1) { fprintf(stderr, "occupancy query says %d blocks/CU\n", per_cu); per_cu = 1; }
        grid_blocks = cus;
    }
    Params p{};
    for (int i = 0; i < N_IN; ++i) p.in[i] = (const float*)d_in[i];
    p.out = (float*)d_out; p.ws = (unsigned char*)d_ws;
    static_assert(WS_BAR + XCD_BAR_WORDS * 4 <= WS_XCNT, "control words");
    (void)hipMemsetAsync((char*)d_ws + WS_CTR, 0, WS_ZEND - WS_CTR, stream);
    void* args[] = {&p};
    hipError_t e = hipLaunchCooperativeKernel((const void*)fwd_megakernel, dim3(grid_blocks), dim3(512), args, LDS_BYTES, stream);
    if (e != hipSuccess) fprintf(stderr, "cooperative launch failed: %s (grid %d)\n", hipGetErrorString(e), grid_blocks);
}
```

```cpp
#include <hip/hip_runtime.h>
#include <hip/hip_cooperative_groups.h>
#include <cstdio>
namespace cg = cooperative_groups;

#define LAS __attribute__((address_space(3)))
typedef unsigned short bf16_t;
typedef short bf16x8 __attribute__((ext_vector_type(8)));
typedef float f32x4 __attribute__((ext_vector_type(4)));
typedef unsigned u32x4 __attribute__((ext_vector_type(4)));
typedef unsigned u32x2 __attribute__((ext_vector_type(2)));
typedef float f32x16 __attribute__((ext_vector_type(16)));
typedef float f32x2 __attribute__((ext_vector_type(2)));
typedef __bf16 nbf16x2 __attribute__((ext_vector_type(2)));

constexpr int T = 16384, D = 1024, SEQ = 2048, NB = 8, FF = 2816, NIN = 5632, INW = 5640, NMOD = 9216;
constexpr int C_QSB = 0, C_KSB = 512, C_VSB = 1024, C_QDN = 1536, C_KDN = 2048, C_VDN = 2560, C_ZDN = 3072, C_RSB = 3584, C_RDN = 4608;
constexpr float EPS = 1e-6f;
constexpr int LDS_BYTES = 163840, BST_OFF = LDS_BYTES - 64;
constexpr size_t MiB = 1024 * 1024;
constexpr size_t WS_MOD = 0, WS_BG = 512 * 1024, WS_SS = 242 * MiB, WS_W = 2 * MiB;
constexpr size_t W_FFIN = WS_W, W_FFOUT = W_FFIN + (size_t)2 * FF * D * 2, W_IN = W_FFOUT + (size_t)D * FF * 2, W_UPSB = W_IN + (size_t)NIN * D * 2,
                 W_UPDN = W_UPSB + (size_t)D * 512 * 2, W_OUT = W_UPDN + (size_t)D * 512 * 2, W_END = W_OUT + (size_t)D * D * 2;
constexpr size_t WS_U = 34 * MiB, WS_P = 66 * MiB, WS_F2IN = 242 * MiB;
static_assert(W_END <= WS_U, "weights overflow");
constexpr size_t WS_EGL = 384 * 1024, WS_CTR = 400 * 1024, WS_BAR = 416 * 1024, WS_XCNT = 432 * 1024, WS_ZEND = 464 * 1024;
constexpr size_t WS_XSLOT = 1 * MiB;
constexpr size_t WS_VT = W_FFIN;
static_assert((size_t)T * 512 * 2 <= W_IN - W_FFIN, "Vt overflow");

enum { I_X = 0, I_C, I_WADA, I_BADA, I_GFFN1, I_WFFN1IN, I_WFFN1OUT, I_GMIX, I_WIN, I_GQSB, I_GKSB, I_WCONV, I_ALOG, I_DTBIAS, I_GDNOUT, I_WUPSB, I_WUPDN, I_WOUT, I_GFFN2, I_WFFN2IN, I_WFFN2OUT, N_IN };
struct Params { const float* in[N_IN]; float* out; unsigned char* ws; };

__device__ __forceinline__ float bf_lo(unsigned w) { return __uint_as_float(w << 16); }
__device__ __forceinline__ float bf_hi(unsigned w) { return __uint_as_float(w & 0xffff0000u); }
__device__ __forceinline__ float bf2f(bf16_t b) { return __uint_as_float(((unsigned)b) << 16); }
__device__ __forceinline__ unsigned pk2(float lo, float hi) { unsigned r; asm("v_cvt_pk_bf16_f32 %0, %1, %2" : "=v"(r) : "v"(lo), "v"(hi)); return r; }
__device__ __forceinline__ unsigned cpk2(float lo, float hi) { const f32x2 v = {lo, hi}; return __builtin_bit_cast(unsigned, __builtin_convertvector(v, nbf16x2)); }
__device__ __forceinline__ bf16_t f2bf(float f) { return (bf16_t)(pk2(f, 0.f) & 0xffffu); }
__device__ __forceinline__ float fexp(float x) { return __builtin_amdgcn_exp2f(x * 1.4426950408889634f); }
__device__ __forceinline__ float flog(float x) { return __builtin_amdgcn_logf(x) * 0.6931471805599453f; }
__device__ __forceinline__ float fsigmoid(float x) { return __builtin_amdgcn_rcpf(1.f + fexp(-x)); }
__device__ __forceinline__ float fsilu(float x) { return x * fsigmoid(x); }
__device__ __forceinline__ float fsoftplus(float x) { return fmaxf(x, 0.f) + flog(1.f + fexp(-fabsf(x))); }
__device__ __forceinline__ float wave_sum(float v) {
#pragma unroll
    for (int o = 1; o < 64; o <<= 1) v += __shfl_xor(v, o);
    return v;
}
#define LDS_WAIT() asm volatile("s_waitcnt lgkmcnt(0)" ::: "memory")

namespace pg8 {
constexpr int BM = 256, BK = 64, HALF = 128, HTB = HALF * BK * 2, STAGE_BYTES = 8 * HTB, NXCD = 8, WGM = 8;
__host__ __device__ __forceinline__ int lds_byte(int r, int c) { const int st = (r >> 4) * 2 + (c >> 5), rr = r & 15, cc = c & 31, ob = rr * 64 + cc * 2; return st * 1024 + (ob ^ (((ob >> 9) & 1) << 5)); }
__host__ __device__ __forceinline__ void stage_rc(int b, int& R, int& C) { const int st = b / 1024, sb = b % 1024, swz = sb ^ (((sb >> 9) & 1) << 5); R = (st >> 1) * 16 + swz / 64; C = (st & 1) * 32 + (swz % 64) / 2; }
__host__ __device__ __forceinline__ int perm32(int rho) { const int n = rho >> 4, i = rho & 15; return 8 * (i >> 2) + 4 * n + (i & 3); }
struct Unit { int pm, pn; };
struct Gemm { const bf16_t* A; const bf16_t* Bt; int M, N, K, lda; int jt; int jbytes; };
struct StaticOrder {
    int nM, nN, nwg, G, c;
    __host__ __device__ void init(int M, int N, int G_, int c_) { nM = M / BM; nN = N / BM; nwg = nM * nN; G = G_; c = c_; }
    __host__ __device__ bool next(int i, Unit& u) const {
        const long L = (long)i * G + c; if (L >= nwg) return false;
        int wgid = (int)L; { const int q = nwg / NXCD, r = nwg % NXCD, xcd = wgid % NXCD, off = wgid / NXCD; wgid = (xcd < r ? xcd * (q + 1) : r * (q + 1) + (xcd - r) * q) + off; }
        const int nig = WGM * nN, gid = wgid / nig, fm = gid * WGM, gsz = (nM - fm) < WGM ? (nM - fm) : WGM;
        u.pm = fm + ((wgid % nig) % gsz); u.pn = (wgid % nig) / gsz; return true;
    }
};
template <class Epi>
__device__ __forceinline__ void gemm_phase(LAS unsigned char* lds, const Gemm g, const StaticOrder& S, const Epi E) {
    int tid = threadIdx.x; asm volatile("" : "+v"(tid));
    const int wid = __builtin_amdgcn_readfirstlane(tid >> 6), lane = tid & 63, wr = wid >> 2, wc = wid & 3, fr = lane & 15, fq = lane >> 4;
    const int K = g.K, nt = K / BK, lda = g.lda;
    unsigned voffA[2], voffB[2];
#pragma unroll
    for (int i = 0; i < 2; ++i) { int R, C; stage_rc(tid * 16 + i * 8192, R, C); const int Rb = Epi::PERM ? ((R & ~31) + perm32(R & 31)) : R;
        voffA[i] = (unsigned)(R * lda + C) * 2u; voffB[i] = (unsigned)(Rb * K + C) * 2u; }
    const size_t kstep = (size_t)(BK * 2);
    const size_t hstepA = (size_t)HALF * lda * 2, hstepB = (size_t)HALF * K * 2;
    const size_t tstepA = 2 * hstepA, tstepB = 2 * hstepB;
    const unsigned ldsw = (unsigned)wid * 1024u;
    const int aoff = lds_byte(wr * 64 + fr, fq * 8), boff = lds_byte(wc * 32 + fr, fq * 8);
#define PG8_SA(b, h) (((b) * 2 + (h)) * HTB)
#define PG8_SB(b, h) ((4 + (b) * 2 + (h)) * HTB)
#define PG8_STAGE(bufoff, gbase, voff) do { _Pragma("unroll") for (int _i = 0; _i < 2; ++_i) \
        __builtin_amdgcn_global_load_lds((const unsigned*)((const char*)(gbase) + (voff)[_i]), (LAS unsigned*)(lds + (bufoff) + ldsw + _i * 8192), 16, 0, 0); } while (0)
#define PG8_LDA(dst, b, h) do { _Pragma("unroll") for (int m = 0; m < 4; ++m) _Pragma("unroll") for (int k = 0; k < 2; ++k) dst[m][k] = *(const LAS bf16x8*)(lds + PG8_SA(b, h) + aoff + m * 2048 + k * 1024); } while (0)
#define PG8_LDB(dst, b, h) do { _Pragma("unroll") for (int n = 0; n < 2; ++n) _Pragma("unroll") for (int k = 0; k < 2; ++k) dst[n][k] = *(const LAS bf16x8*)(lds + PG8_SB(b, h) + boff + n * 2048 + k * 1024); } while (0)
#define PG8_MMA(ai, bj, At, Bt) do { __builtin_amdgcn_s_setprio(1); _Pragma("unroll") for (int m = 0; m < 4; ++m) _Pragma("unroll") for (int n = 0; n < 2; ++n) _Pragma("unroll") for (int k = 0; k < 2; ++k) \
        acc[ai][bj][m][n] = __builtin_amdgcn_mfma_f32_16x16x32_bf16(Bt[n][k], At[m][k], acc[ai][bj][m][n], 0, 0, 0); __builtin_amdgcn_s_setprio(0); } while (0)
#define PG8_WAIT_V(n) asm volatile("s_waitcnt vmcnt(" #n ")" ::: "memory")
#define PG8_WAIT_L(n) asm volatile("s_waitcnt lgkmcnt(" #n ")" ::: "memory")
#define PG8_BAR __builtin_amdgcn_s_barrier()
#define PG8_SCHED __builtin_amdgcn_sched_barrier(0)
    Unit cur, nxt; int ui = 0;
    if (!S.next(0, cur)) return;
    f32x4 acc[2][2][4][2];
#pragma unroll
    for (int a = 0; a < 2; ++a)
#pragma unroll
        for (int b = 0; b < 2; ++b)
#pragma unroll
            for (int m = 0; m < 4; ++m)
#pragma unroll
                for (int n = 0; n < 2; ++n) acc[a][b][m][n] = (f32x4){0.f, 0.f, 0.f, 0.f};
    bf16x8 At[4][2], B0[2][2], B1[2][2];
    const char* cA = (const char*)g.A + (size_t)cur.pm * tstepA; const char* cB = (const char*)g.Bt + (size_t)cur.pn * tstepB;
    PG8_STAGE(PG8_SB(0, 0), cB, voffB); PG8_STAGE(PG8_SA(0, 0), cA, voffA); PG8_STAGE(PG8_SB(0, 1), cB + hstepB, voffB); PG8_STAGE(PG8_SA(0, 1), cA + hstepA, voffA);
    if (wr == 1) PG8_BAR;
    PG8_WAIT_V(4); PG8_BAR;
    PG8_STAGE(PG8_SB(1, 0), cB + kstep, voffB); PG8_STAGE(PG8_SA(1, 0), cA + kstep, voffA); PG8_STAGE(PG8_SB(1, 1), cB + hstepB + kstep, voffB);
    PG8_WAIT_V(6); PG8_BAR;
    for (;;) {
        const bool has_next = S.next(ui + 1, nxt);
        const char* nA = has_next ? (const char*)g.A + (size_t)nxt.pm * tstepA : cA; const char* nB = has_next ? (const char*)g.Bt + (size_t)nxt.pn * tstepB : cB;
        for (int t = 0; t < nt; t += 2) {
            const bool last = (t == nt - 2);
            const char* a1 = cA + (size_t)(t + 1) * kstep + (t + 1 >= g.jt ? g.jbytes : 0);
            const char* a2 = last ? nA : cA + (size_t)(t + 2) * kstep + (t + 2 >= g.jt ? g.jbytes : 0); const char* b2 = last ? nB : cB + (size_t)(t + 2) * kstep;
            const char* a3 = a2 + kstep; const char* b3 = b2 + kstep;
            if constexpr (Epi::HAS_MID) { if (t == g.jt) E.mid(acc, cur, wr, wc, fr, fq); }
            PG8_LDB(B0, 0, 0); PG8_SCHED; PG8_LDA(At, 0, 0); PG8_STAGE(PG8_SA(1, 1), a1 + hstepA, voffA);
            PG8_WAIT_L(8); PG8_BAR; PG8_WAIT_L(0); PG8_MMA(0, 0, At, B0); PG8_BAR; PG8_SCHED;
            PG8_LDB(B1, 0, 1); PG8_STAGE(PG8_SB(0, 0), b2, voffB);
            PG8_BAR; PG8_WAIT_L(0); PG8_MMA(0, 1, At, B1); PG8_BAR;
            PG8_LDA(At, 0, 1); PG8_STAGE(PG8_SA(0, 0), a2, voffA);
            PG8_BAR; PG8_WAIT_L(0); PG8_MMA(1, 0, At, B0); PG8_BAR; PG8_SCHED;
            PG8_STAGE(PG8_SB(0, 1), b2 + hstepB, voffB);
            PG8_WAIT_V(6); PG8_BAR; PG8_MMA(1, 1, At, B1); PG8_BAR;
            PG8_LDB(B0, 1, 0); PG8_SCHED; PG8_LDA(At, 1, 0); PG8_STAGE(PG8_SA(0, 1), a2 + hstepA, voffA);
            PG8_WAIT_L(8); PG8_BAR; PG8_WAIT_L(0); PG8_MMA(0, 0, At, B0); PG8_BAR; PG8_SCHED;
            PG8_LDB(B1, 1, 1); PG8_STAGE(PG8_SB(1, 0), b3, voffB);
            PG8_BAR; PG8_WAIT_L(0); PG8_MMA(0, 1, At, B1); PG8_BAR;
            PG8_LDA(At, 1, 1); PG8_STAGE(PG8_SA(1, 0), a3, voffA);
            PG8_BAR; PG8_WAIT_L(0); PG8_MMA(1, 0, At, B0); PG8_BAR; PG8_SCHED;
            PG8_STAGE(PG8_SB(1, 1), b3 + hstepB, voffB);
            PG8_WAIT_V(6); PG8_BAR; PG8_MMA(1, 1, At, B1); PG8_BAR;
        }
        if constexpr (!Epi::AFTER) E(acc, cur, wr, wc, fr, fq);
        if (!has_next) break;
#pragma unroll
        for (int a = 0; a < 2; ++a)
#pragma unroll
            for (int b = 0; b < 2; ++b)
#pragma unroll
                for (int m = 0; m < 4; ++m)
#pragma unroll
                    for (int n = 0; n < 2; ++n) acc[a][b][m][n] = (f32x4){0.f, 0.f, 0.f, 0.f};
        cur = nxt; cA = nA; cB = nB; ++ui;
    }
    PG8_WAIT_V(0);
    if (wr == 0) PG8_BAR;
    PG8_BAR;
    if constexpr (Epi::AFTER) E.fused(acc, cur, wr, wc, fr, fq, lds, wid, lane);
#undef PG8_SA
#undef PG8_SB
#undef PG8_STAGE
#undef PG8_LDA
#undef PG8_LDB
#undef PG8_MMA
#undef PG8_WAIT_V
#undef PG8_WAIT_L
#undef PG8_BAR
#undef PG8_SCHED
}
}

typedef const f32x4 (&AccRef)[2][2][4][2];
struct EpiBf16 {
    static constexpr bool PERM = true, HAS_MID = false, AFTER = false;
    bf16_t* O; int ldc;
    __device__ __forceinline__ void operator()(AccRef acc, const pg8::Unit& u, int wr, int wc, int fr, int fq) const {
        const int row0 = u.pm * 256 + wr * 64 + fr, col0 = u.pn * 256 + wc * 32 + 8 * fq;
#pragma unroll
        for (int ai = 0; ai < 2; ++ai)
#pragma unroll
            for (int m = 0; m < 4; ++m) { bf16_t* rowp = O + (size_t)(row0 + ai * 128 + m * 16) * ldc + col0;
#pragma unroll
                for (int bj = 0; bj < 2; ++bj) { const f32x4 v0 = acc[ai][bj][m][0], v1 = acc[ai][bj][m][1];
                    u32x4 w; w.x = pk2(v0[0], v0[1]); w.y = pk2(v0[2], v0[3]); w.z = pk2(v1[0], v1[1]); w.w = pk2(v1[2], v1[3]);
                    *(u32x4*)(rowp + bj * 128) = w; } }
    }
};
struct EpiSwiGLU {
    static constexpr bool PERM = true, HAS_MID = false, AFTER = false;
    bf16_t* O; int ldc;
    __device__ __forceinline__ void operator()(AccRef acc, const pg8::Unit& u, int wr, int wc, int fr, int fq) const {
        const int row0 = u.pm * 256 + wr * 64 + fr, col0 = u.pn * 128 + wc * 32 + 8 * fq;
#pragma unroll
        for (int ai = 0; ai < 2; ++ai)
#pragma unroll
            for (int m = 0; m < 4; ++m) { bf16_t* rowp = O + (size_t)(row0 + ai * 128 + m * 16) * ldc + col0;
                float r[8];
#pragma unroll
                for (int n = 0; n < 2; ++n)
#pragma unroll
                    for (int j = 0; j < 4; ++j) { const float a = acc[ai][0][m][n][j], b = acc[ai][1][m][n][j]; r[n * 4 + j] = fsilu(a) * b; }
                u32x4 w; w.x = pk2(r[0], r[1]); w.y = pk2(r[2], r[3]); w.z = pk2(r[4], r[5]); w.w = pk2(r[6], r[7]);
                *(u32x4*)rowp = w; }
    }
};
struct EpiResid {
    static constexpr bool PERM = false, HAS_MID = false, AFTER = false;
    const float* base; float* out; const float* gate; float scale;
    __device__ __forceinline__ void operator()(AccRef acc, const pg8::Unit& u, int wr, int wc, int fr, int fq) const {
        const int row0 = u.pm * 256 + wr * 64 + fr, col0 = u.pn * 256 + wc * 32 + 4 * fq;
        const float* gp = gate + (size_t)(u.pm >> 3) * NMOD + col0;
        f32x4 gv[2][2];
#pragma unroll
        for (int bj = 0; bj < 2; ++bj)
#pragma unroll
            for (int n = 0; n < 2; ++n) gv[bj][n] = *(const f32x4*)(gp + bj * 128 + n * 16) * scale;
#pragma unroll
        for (int ai = 0; ai < 2; ++ai) {
            f32x4 bs[4][2][2];
#pragma unroll
            for (int m = 0; m < 4; ++m) { const size_t off = (size_t)(row0 + ai * 128 + m * 16) * D + col0;
#pragma unroll
                for (int bj = 0; bj < 2; ++bj)
#pragma unroll
                    for (int n = 0; n < 2; ++n) bs[m][bj][n] = *(const f32x4*)(base + off + bj * 128 + n * 16); }
#pragma unroll
            for (int m = 0; m < 4; ++m) { const size_t off = (size_t)(row0 + ai * 128 + m * 16) * D + col0;
#pragma unroll
                for (int bj = 0; bj < 2; ++bj)
#pragma unroll
                    for (int n = 0; n < 2; ++n) *(f32x4*)(out + off + bj * 128 + n * 16) = bs[m][bj][n] + gv[bj][n] * acc[ai][bj][m][n]; }
            asm volatile("" ::: "memory"); }
    }
};
struct EpiResidNorm {
    static constexpr bool PERM = false, HAS_MID = false, AFTER = true;
    const float* base; float* out; const float* gate;
    const float* gain; const float* modsh; bf16_t* un;
    unsigned* xslot; unsigned* cnt; float scale; int pad_;
    __device__ __forceinline__ void fused(f32x4 (&acc)[2][2][4][2], const pg8::Unit& u, int wr, int wc, int fr, int fq, LAS unsigned char* lds, int wid, int lane) const {
        const int row0 = u.pm * 256 + wr * 64 + fr, col0 = u.pn * 256 + wc * 32 + 4 * fq, tid = wid * 64 + lane;
        LAS float* Pt = (LAS float*)lds; LAS float* St = (LAS float*)(lds + 4096);
        const float* gp = gate + (size_t)(u.pm >> 3) * NMOD + col0;
        f32x4 gv[2][2];
#pragma unroll
        for (int bj = 0; bj < 2; ++bj)
#pragma unroll
            for (int n = 0; n < 2; ++n) gv[bj][n] = *(const f32x4*)(gp + bj * 128 + n * 16) * scale;
#pragma unroll
        for (int ai = 0; ai < 2; ++ai) {
            f32x4 bs[4][2][2];
#pragma unroll
            for (int m = 0; m < 4; ++m) { const size_t off = (size_t)(row0 + ai * 128 + m * 16) * D + col0;
#pragma unroll
                for (int bj = 0; bj < 2; ++bj)
#pragma unroll
                    for (int n = 0; n < 2; ++n) bs[m][bj][n] = *(const f32x4*)(base + off + bj * 128 + n * 16); }
#pragma unroll
            for (int m = 0; m < 4; ++m) { const size_t off = (size_t)(row0 + ai * 128 + m * 16) * D + col0; float sq = 0.f;
#pragma unroll
                for (int bj = 0; bj < 2; ++bj)
#pragma unroll
                    for (int n = 0; n < 2; ++n) { const f32x4 hv = bs[m][bj][n] + gv[bj][n] * acc[ai][bj][m][n]; acc[ai][bj][m][n] = hv; *(f32x4*)(out + off + bj * 128 + n * 16) = hv;
                        sq += (hv[0] * hv[0] + hv[1] * hv[1]) + (hv[2] * hv[2] + hv[3] * hv[3]); }
                sq += __shfl_xor(sq, 16); sq += __shfl_xor(sq, 32);
                if (fq == 0) Pt[(ai * 128 + wr * 64 + m * 16 + fr) * 4 + wc] = sq; }
            asm volatile("" ::: "memory"); }
        LDS_WAIT(); __syncthreads();
        if (tid < 256) { const f32x4 t4 = *(const LAS f32x4*)(Pt + tid * 4); const float sq = (t4[0] + t4[1]) + (t4[2] + t4[3]);
            __hip_atomic_store(xslot + ((size_t)(u.pm * 256 + tid) * 4 + u.pn), __float_as_uint(sq), __ATOMIC_RELAXED, __HIP_MEMORY_SCOPE_AGENT);
            asm volatile("s_waitcnt vmcnt(0)" ::: "memory");
            if (lane == 0) __hip_atomic_fetch_add(cnt + 64 * u.pm, 1u, __ATOMIC_RELAXED, __HIP_MEMORY_SCOPE_AGENT); }
        if (wid == 0) { unsigned spins = 0;
            while ((unsigned)__builtin_amdgcn_readfirstlane(__hip_atomic_load(cnt + 64 * u.pm, __ATOMIC_RELAXED, __HIP_MEMORY_SCOPE_AGENT)) < 16u) { __builtin_amdgcn_s_sleep(2); if (++spins > (1u << 22)) break; }
            __builtin_amdgcn_fence(__ATOMIC_ACQUIRE, "agent"); asm volatile("s_waitcnt vmcnt(0)" ::: "memory"); }
        __syncthreads();
        if (tid < 256) { const unsigned* sl = xslot + (size_t)(u.pm * 256 + tid) * 4; float sq = 0.f;
#pragma unroll
            for (int t = 0; t < 4; ++t) sq += __uint_as_float(__hip_atomic_load(sl + t, __ATOMIC_RELAXED, __HIP_MEMORY_SCOPE_AGENT));
            St[tid] = 1.0f / sqrtf(sq * (1.f / D) + EPS); }
        LDS_WAIT(); __syncthreads();
        const float* shp = modsh + (size_t)(u.pm >> 3) * NMOD + col0;
        f32x4 gs[2][2], sh[2][2];
#pragma unroll
        for (int bj = 0; bj < 2; ++bj)
#pragma unroll
            for (int n = 0; n < 2; ++n) { gs[bj][n] = *(const f32x4*)(gain + col0 + bj * 128 + n * 16) * (*(const f32x4*)(shp + D + bj * 128 + n * 16) + 1.0f); sh[bj][n] = *(const f32x4*)(shp + bj * 128 + n * 16); }
#pragma unroll
        for (int ai = 0; ai < 2; ++ai)
#pragma unroll
            for (int m = 0; m < 4; ++m) { const int r = ai * 128 + wr * 64 + m * 16 + fr; const float rstd = St[r]; bf16_t* up = un + (size_t)(u.pm * 256 + r) * D + col0;
#pragma unroll
                for (int bj = 0; bj < 2; ++bj)
#pragma unroll
                    for (int n = 0; n < 2; ++n) { const f32x4 uu = acc[ai][bj][m][n] * rstd * gs[bj][n] + sh[bj][n];
                        *(u32x2*)(up + bj * 128 + n * 16) = (u32x2){pk2(uu[0], uu[1]), pk2(uu[2], uu[3])}; } }
        __syncthreads();
    }
};
struct EpiGateFused {
    static constexpr bool PERM = true, HAS_MID = true, AFTER = false;
    const bf16_t* Rsb; const bf16_t* Rdn; bf16_t* O;
    __device__ __forceinline__ void mid(f32x4 (&acc)[2][2][4][2], const pg8::Unit& u, int wr, int wc, int fr, int fq) const {
        int row0 = u.pm * 256 + wr * 64 + fr, col0 = u.pn * 256 + wc * 32 + 8 * fq;
        asm volatile("" : "+v"(row0), "+v"(col0));
#pragma unroll
        for (int ai = 0; ai < 2; ++ai)
#pragma unroll
            for (int mp = 0; mp < 2; ++mp) {
                u32x4 av[2][2], dv[2][2];
#pragma unroll
                for (int mm = 0; mm < 2; ++mm)
#pragma unroll
                    for (int bj = 0; bj < 2; ++bj) { const size_t row = (size_t)(row0 + ai * 128 + (2 * mp + mm) * 16);
                        av[mm][bj] = *(const u32x4*)(Rsb + row * NIN + col0 + bj * 128); dv[mm][bj] = *(const u32x4*)(Rdn + row * NIN + col0 + bj * 128); }
#pragma unroll
                for (int mm = 0; mm < 2; ++mm)
#pragma unroll
                    for (int bj = 0; bj < 2; ++bj) { const int m = 2 * mp + mm; const u32x4 a = av[mm][bj], d = dv[mm][bj];
                        const float ra[8] = {bf_lo(a.x), bf_hi(a.x), bf_lo(a.y), bf_hi(a.y), bf_lo(a.z), bf_hi(a.z), bf_lo(a.w), bf_hi(a.w)};
                        const float rd[8] = {bf_lo(d.x), bf_hi(d.x), bf_lo(d.y), bf_hi(d.y), bf_lo(d.z), bf_hi(d.z), bf_lo(d.w), bf_hi(d.w)};
#pragma unroll
                        for (int e = 0; e < 8; ++e) { const float q = (1.0f + fexp(fminf(-rd[e], 30.0f))) * __builtin_amdgcn_rcpf(1.0f + fexp(-ra[e])); acc[ai][bj][m][e >> 2][e & 3] *= q; } }
                asm volatile("" ::: "memory"); }
    }
    __device__ __forceinline__ void operator()(AccRef acc, const pg8::Unit& u, int wr, int wc, int fr, int fq) const {
        const int row0 = u.pm * 256 + wr * 64 + fr, col0 = u.pn * 256 + wc * 32 + 8 * fq;
#pragma unroll
        for (int ai = 0; ai < 2; ++ai) {
            u32x4 dv[4][2];
#pragma unroll
            for (int m = 0; m < 4; ++m)
#pragma unroll
                for (int bj = 0; bj < 2; ++bj) dv[m][bj] = *(const u32x4*)(Rdn + (size_t)(row0 + ai * 128 + m * 16) * NIN + col0 + bj * 128);
#pragma unroll
            for (int m = 0; m < 4; ++m) { const size_t row = (size_t)(row0 + ai * 128 + m * 16);
#pragma unroll
                for (int bj = 0; bj < 2; ++bj) { const u32x4 d = dv[m][bj];
                    const f32x4 v0 = acc[ai][bj][m][0], v1 = acc[ai][bj][m][1];
#define SGC(x) __builtin_amdgcn_rcpf(1.0f + fexp(fminf(-(x), 30.0f)))
                    const float r[8] = {SGC(bf_lo(d.x)) * v0[0], SGC(bf_hi(d.x)) * v0[1], SGC(bf_lo(d.y)) * v0[2], SGC(bf_hi(d.y)) * v0[3],
                                        SGC(bf_lo(d.z)) * v1[0], SGC(bf_hi(d.z)) * v1[1], SGC(bf_lo(d.w)) * v1[2], SGC(bf_hi(d.w)) * v1[3]};
#undef SGC
                    u32x4 w; w.x = pk2(r[0], r[1]); w.y = pk2(r[2], r[3]); w.z = pk2(r[4], r[5]); w.w = pk2(r[6], r[7]);
                    *(u32x4*)(O + row * D + col0 + bj * 128) = w; } } }
    }
};
template <class Epi> __device__ __forceinline__ void run_gemm(LAS unsigned char* lds, const bf16_t* A, int lda, const bf16_t* Bt, int N, int K, const Epi E, int jt = 1 << 30, int jbytes = 0) {
    pg8::Gemm g{A, Bt, T, N, K, lda, jt, jbytes}; pg8::StaticOrder S; S.init(T, N, (int)gridDim.x, (int)blockIdx.x);
    pg8::gemm_phase<Epi>(lds, g, S, E);
}

__device__ __forceinline__ void transpose_item(const float* W, int ldw, int s0, int k0, bf16_t* WT, int ldk, int d0, LAS float* scr, int lane) {
    float tv[32];
#pragma unroll
    for (int i = 0; i < 32; ++i) tv[i] = W[(size_t)(k0 + 2 * i + (lane >> 5)) * ldw + s0 + (lane & 31)];
#pragma unroll
    for (int i = 0; i < 32; ++i) scr[(2 * i + (lane >> 5)) * 33 + (lane & 31)] = tv[i];
    LDS_WAIT();
    const int c = lane & 7;
#pragma unroll
    for (int j = 0; j < 4; ++j) { const int n = (lane >> 3) + 8 * j; const LAS float* s = scr + (8 * c) * 33 + n;
        u32x4 o; o.x = pk2(s[0 * 33], s[1 * 33]); o.y = pk2(s[2 * 33], s[3 * 33]); o.z = pk2(s[4 * 33], s[5 * 33]); o.w = pk2(s[6 * 33], s[7 * 33]);
        *(u32x4*)(WT + (size_t)(d0 + n) * ldk + k0 + 8 * c) = o; }
    LDS_WAIT();
}
struct TrD { const float* W; int ldw, s0, k0; bf16_t* WT; int ldk, d0; };
__device__ __forceinline__ TrD ffn_item_desc(const float* w_in, const float* w_out, bf16_t* wt_in, bf16_t* wt_out, int it) {
    if (it < 2816) { const int kb = it / 176, nb = it % 176, d0 = nb * 32, pn = d0 >> 8, bj = (d0 >> 7) & 1, c = d0 & 127, s0 = bj * FF + pn * 128 + c; return TrD{w_in, 2 * FF, s0, kb * 64, wt_in, D, d0}; }
    const int r = it - 2816, kb = r / 32, nb = r % 32; return TrD{w_out, D, nb * 32, kb * 64, wt_out, FF, nb * 32};
}
__device__ __forceinline__ void ffn_weight_items(const float* w_in, const float* w_out, bf16_t* wt_in, bf16_t* wt_out, LAS float* scr, int gw, int ngw, int lane, int lo = 0, int NIT = 2816 + 1408) {
    gw += lo;
    float tv[32];
#define TR_LOAD(d_) do { _Pragma("unroll") for (int i = 0; i < 32; ++i) tv[i] = (d_).W[(size_t)((d_).k0 + 2 * i + (lane >> 5)) * (d_).ldw + (d_).s0 + (lane & 31)]; } while (0)
    if (gw < NIT) { const TrD d0_ = ffn_item_desc(w_in, w_out, wt_in, wt_out, gw); TR_LOAD(d0_); }
    for (int it = gw; it < NIT; it += ngw) {
        const TrD d = ffn_item_desc(w_in, w_out, wt_in, wt_out, it);
#pragma unroll
        for (int i = 0; i < 32; ++i) scr[(2 * i + (lane >> 5)) * 33 + (lane & 31)] = tv[i];
        LDS_WAIT();
        if (it + ngw < NIT) { const TrD dn = ffn_item_desc(w_in, w_out, wt_in, wt_out, it + ngw); TR_LOAD(dn); }
        const int c = lane & 7;
#pragma unroll
        for (int j = 0; j < 4; ++j) { const int n = (lane >> 3) + 8 * j; const LAS float* s_ = scr + (8 * c) * 33 + n;
            u32x4 o; o.x = pk2(s_[0 * 33], s_[1 * 33]); o.y = pk2(s_[2 * 33], s_[3 * 33]); o.z = pk2(s_[4 * 33], s_[5 * 33]); o.w = pk2(s_[6 * 33], s_[7 * 33]);
            *(u32x4*)(d.WT + (size_t)(d.d0 + n) * d.ldk + d.k0 + 8 * c) = o; }
        LDS_WAIT();
    }
#undef TR_LOAD
}
__device__ __forceinline__ void mixer_weight_items(const Params& p, LAS float* scr, int gw, int ngw, int lane) {
    unsigned char* ws = p.ws;
    for (int it = gw; it < 2816 + 256 + 256 + 512; it += ngw) {
        int r = it;
        if (r < 2816) { const int kb = r / 176, nb = r % 176, d0 = nb * 32, s0 = d0 < C_RSB ? d0 : d0 + 8; transpose_item(p.in[I_WIN], INW, s0, kb * 64, (bf16_t*)(ws + W_IN), D, d0, scr, lane); continue; } r -= 2816;
        if (r < 256) { const int kb = r / 32, nb = r % 32; transpose_item(p.in[I_WUPSB], D, nb * 32, kb * 64, (bf16_t*)(ws + W_UPSB), D, nb * 32, scr, lane); continue; } r -= 256;
        if (r < 256) { const int kb = r / 32, nb = r % 32; transpose_item(p.in[I_WUPDN], D, nb * 32, kb * 64, (bf16_t*)(ws + W_UPSB) + 512, D, nb * 32, scr, lane); continue; } r -= 256;
        { const int kb = r / 32, nb = r % 32; transpose_item(p.in[I_WOUT], D, nb * 32, kb * 64, (bf16_t*)(ws + W_OUT), D, nb * 32, scr, lane); }
    }
}
__device__ __forceinline__ void mod_item(const Params& p, LAS unsigned char* lds, int cb, int tid, int wave, int lane) {
    asm volatile("" : "+v"(tid), "+v"(lane));
    LAS float* sc = (LAS float*)lds; LAS float* red = (LAS float*)(lds + 32768);
    for (int i = tid; i < NB * D; i += 512) sc[i] = fsilu(p.in[I_C][i]);
    __syncthreads();
    const float* wa = p.in[I_WADA] + cb * 64 + lane;
    float acc[NB];
#pragma unroll
    for (int b = 0; b < NB; ++b) acc[b] = 0.f;
    for (int k = wave * 128; k < wave * 128 + 128; k += 32) {
        float w[32];
#pragma unroll
        for (int e = 0; e < 32; ++e) w[e] = wa[(size_t)(k + e) * NMOD];
#pragma unroll
        for (int b = 0; b < NB; ++b)
#pragma unroll
            for (int e4 = 0; e4 < 8; ++e4) { const f32x4 s = *(const LAS f32x4*)(sc + b * D + k + 4 * e4); acc[b] += s[0] * w[4 * e4] + s[1] * w[4 * e4 + 1] + s[2] * w[4 * e4 + 2] + s[3] * w[4 * e4 + 3]; }
    }
#pragma unroll
    for (int b = 0; b < NB; ++b) red[(wave * NB + b) * 64 + lane] = acc[b];
    __syncthreads();
    { const int b = tid >> 6; float s = p.in[I_BADA][cb * 64 + lane];
#pragma unroll
        for (int w = 0; w < 8; ++w) s += red[(w * NB + b) * 64 + lane];
        ((float*)(p.ws + WS_MOD))[b * NMOD + cb * 64 + lane] = s; }
    __syncthreads();
}

template <bool DN>
__device__ __forceinline__ void norm_mod_phase(const Params& p, LAS unsigned char* lds, const float* src, const float* gain, int midx, bf16_t* dst, int tid, int wave, int lane) {
    asm volatile("" : "+v"(tid), "+v"(lane));
    const float* mod = (const float*)(p.ws + WS_MOD);
    LAS float* wl = (LAS float*)lds;
    if (DN) { for (int i = tid; i < D * 8; i += 512) { const int k = i >> 3, j = i & 7; wl[8 * k + 4 * (k >> 2) + j] = p.in[I_WIN][(size_t)k * INW + C_RSB + j]; } __syncthreads(); }
    f32x4 g4[4];
#pragma unroll
    for (int j = 0; j < 4; ++j) g4[j] = ((const f32x4*)gain)[lane + 64 * j];
    const int rstep = gridDim.x * 8;
    f32x4 nv[4];
    { const int r0 = blockIdx.x * 8 + wave; const f32x4* xr = (const f32x4*)(src + (size_t)(r0 < T ? r0 : 0) * D) + lane;
#pragma unroll
      for (int j = 0; j < 4; ++j) nv[j] = xr[64 * j]; }
    for (int row = blockIdx.x * 8 + wave; row < T; row += rstep) {
        const int b = row >> 11;
        const f32x4* shp = (const f32x4*)(mod + (size_t)b * NMOD + midx * D) + lane; const f32x4* scp = shp + D / 4;
        f32x4 v[4], shv[4], scv[4]; float ss = 0.f;
#pragma unroll
        for (int j = 0; j < 4; ++j) { v[j] = nv[j]; shv[j] = shp[64 * j]; scv[j] = scp[64 * j]; }
        { const int rn = row + rstep < T ? row + rstep : row; const f32x4* xr = (const f32x4*)(src + (size_t)rn * D) + lane;
#pragma unroll
          for (int j = 0; j < 4; ++j) nv[j] = xr[64 * j]; }
#pragma unroll
        for (int j = 0; j < 4; ++j) ss += (v[j][0] * v[j][0] + v[j][1] * v[j][1]) + (v[j][2] * v[j][2] + v[j][3] * v[j][3]);
        const float rstd = 1.0f / sqrtf(wave_sum(ss) * (1.f / D) + EPS);
        u32x2* o8 = (u32x2*)(dst + (size_t)row * D) + lane;
        float dot[8];
        if (DN) {
#pragma unroll
            for (int e = 0; e < 8; ++e) dot[e] = 0.f; }
#pragma unroll
        for (int j = 0; j < 4; ++j) { const f32x4 sh = shv[j], sc = scv[j];
            const f32x4 uu = v[j] * rstd * g4[j] * (sc + 1.0f) + sh;
            u32x2 w; w.x = pk2(uu[0], uu[1]); w.y = pk2(uu[2], uu[3]); o8[64 * j] = w;
            if (DN) {
#pragma unroll
                for (int e = 0; e < 4; ++e) { const int k = 4 * lane + 256 * j + e; const LAS f32x4* wp = (const LAS f32x4*)(wl + 8 * k + 4 * (k >> 2)); const f32x4 w0 = wp[0], w1 = wp[1];
                    dot[0] += uu[e] * w0[0]; dot[1] += uu[e] * w0[1]; dot[2] += uu[e] * w0[2]; dot[3] += uu[e] * w0[3];
                    dot[4] += uu[e] * w1[0]; dot[5] += uu[e] * w1[1]; dot[6] += uu[e] * w1[2]; dot[7] += uu[e] * w1[3]; } } }
        if (DN) {
#pragma unroll
            for (int e = 0; e < 8; ++e) dot[e] = wave_sum(dot[e]);
            float mine = dot[0];
#pragma unroll
            for (int e = 1; e < 8; ++e) mine = (lane == e) ? dot[e] : mine;
            if (lane < 8) { float r;
                if (lane < 4) r = 1.0f / (1.0f + expf(-mine));
                else { const int hh = lane - 4; const float a = mine + p.in[I_DTBIAS][hh]; const float sp = a > 20.f ? a : log1pf(expf(a)); r = -expf(p.in[I_ALOG][hh]) * sp; }
                ((float*)(p.ws + WS_BG))[(size_t)row * 8 + lane] = r; } }
    }
    if (DN) __syncthreads();
}

__device__ __forceinline__ void dn_gate_phase(const Params& p, LAS unsigned char* lds, const bf16_t* u2, int tid, int wave, int lane) {
    asm volatile("" : "+v"(tid), "+v"(lane));
    LAS float* wl = (LAS float*)lds;
    for (int i = tid; i < D * 8; i += 512) { const int k = i >> 3, j = i & 7; wl[8 * k + 4 * (k >> 2) + j] = p.in[I_WIN][(size_t)k * INW + C_RSB + j]; }
    __syncthreads();
    const int rstep = gridDim.x * 8;
    u32x4 na, nb;
    { const int r0 = blockIdx.x * 8 + wave; const bf16_t* up = u2 + (size_t)(r0 < T ? r0 : 0) * D + 16 * lane; na = ((const u32x4*)up)[0]; nb = ((const u32x4*)up)[1]; }
    for (int row = blockIdx.x * 8 + wave; row < T; row += rstep) {
        const u32x4 ca = na, cb = nb;
        { const int rn = row + rstep < T ? row + rstep : row; const bf16_t* up = u2 + (size_t)rn * D + 16 * lane; na = ((const u32x4*)up)[0]; nb = ((const u32x4*)up)[1]; }
        const unsigned w8[8] = {ca.x, ca.y, ca.z, ca.w, cb.x, cb.y, cb.z, cb.w};
        float dot[8];
#pragma unroll
        for (int e = 0; e < 8; ++e) dot[e] = 0.f;
#pragma unroll
        for (int e = 0; e < 16; ++e) { const int k = 16 * lane + e; const LAS f32x4* wp = (const LAS f32x4*)(wl + 8 * k + 4 * (k >> 2)); const f32x4 w0 = wp[0], w1 = wp[1];
            const float uv = (e & 1) ? bf_hi(w8[e >> 1]) : bf_lo(w8[e >> 1]);
            dot[0] += uv * w0[0]; dot[1] += uv * w0[1]; dot[2] += uv * w0[2]; dot[3] += uv * w0[3]; dot[4] += uv * w1[0]; dot[5] += uv * w1[1]; dot[6] += uv * w1[2]; dot[7] += uv * w1[3]; }
#pragma unroll
        for (int e = 0; e < 8; ++e) dot[e] = wave_sum(dot[e]);
        float mine = dot[0];
#pragma unroll
        for (int e = 1; e < 8; ++e) mine = (lane == e) ? dot[e] : mine;
        if (lane < 8) { float r;
            if (lane < 4) r = 1.0f / (1.0f + expf(-mine));
            else { const int hh = lane - 4; const float a = mine + p.in[I_DTBIAS][hh]; const float sp = a > 20.f ? a : log1pf(expf(a)); r = -expf(p.in[I_ALOG][hh]) * sp; }
            ((float*)(p.ws + WS_BG))[(size_t)row * 8 + lane] = r; }
    }
    __syncthreads();
}
__device__ __forceinline__ void unpack16(const bf16_t* p, float* f) {
    const u32x4 a = ((const u32x4*)p)[0], b = ((const u32x4*)p)[1];
    f[0] = bf_lo(a.x); f[1] = bf_hi(a.x); f[2] = bf_lo(a.y); f[3] = bf_hi(a.y); f[4] = bf_lo(a.z); f[5] = bf_hi(a.z); f[6] = bf_lo(a.w); f[7] = bf_hi(a.w);
    f[8] = bf_lo(b.x); f[9] = bf_hi(b.x); f[10] = bf_lo(b.y); f[11] = bf_hi(b.y); f[12] = bf_lo(b.z); f[13] = bf_hi(b.z); f[14] = bf_lo(b.w); f[15] = bf_hi(b.w);
}
__device__ __forceinline__ void pack16(bf16_t* p, const float* f) {
    u32x4 a, b; a.x = pk2(f[0], f[1]); a.y = pk2(f[2], f[3]); a.z = pk2(f[4], f[5]); a.w = pk2(f[6], f[7]); b.x = pk2(f[8], f[9]); b.y = pk2(f[10], f[11]); b.z = pk2(f[12], f[13]); b.w = pk2(f[14], f[15]);
    ((u32x4*)p)[0] = a; ((u32x4*)p)[1] = b;
}
__device__ __forceinline__ void prep_phase(const Params& p, LAS unsigned char* lds, bool dn, int tid, int wave, int lane) {
    asm volatile("" : "+v"(lane), "+v"(tid));
    bf16_t* P = (bf16_t*)(p.ws + WS_P); bf16_t* U = (bf16_t*)(p.ws + WS_U);
    LAS float* wl = (LAS float*)lds;
    if (dn) { for (int i = tid; i < D * 8; i += 512) { const int k = i >> 3, j = i & 7; wl[8 * k + 4 * (k >> 2) + j] = p.in[I_WIN][(size_t)k * INW + C_RSB + j]; } __syncthreads(); }
    const int ch = 16 * lane;
    float gsb[16], wcv[4][16];
    { const float* gp = (ch < 512 ? p.in[I_GQSB] : p.in[I_GKSB]) + (ch & 63); const float sc = ch < 512 ? 0.18033688011112042f : 1.0f;
#pragma unroll
        for (int e = 0; e < 16; ++e) gsb[e] = gp[e] * sc;
#pragma unroll
        for (int i = 0; i < 4; ++i)
#pragma unroll
            for (int e = 0; e < 16; ++e) wcv[i][e] = p.in[I_WCONV][i * 1536 + ch + e]; }
    for (int row = blockIdx.x * 8 + wave; row < T; row += gridDim.x * 8) {
        const int tl = row & (SEQ - 1);
        if (dn) {
            const u32x4 ca = *(const u32x4*)(U + (size_t)row * D + ch), cb = *(const u32x4*)(U + (size_t)row * D + ch + 8);
            const unsigned w8[8] = {ca.x, ca.y, ca.z, ca.w, cb.x, cb.y, cb.z, cb.w};
            float dot[8];
#pragma unroll
            for (int e = 0; e < 8; ++e) dot[e] = 0.f;
#pragma unroll
            for (int e = 0; e < 16; ++e) { const int k = ch + e; const LAS f32x4* wp = (const LAS f32x4*)(wl + 8 * k + 4 * (k >> 2)); const f32x4 w0 = wp[0], w1 = wp[1];
                const float uv = (e & 1) ? bf_hi(w8[e >> 1]) : bf_lo(w8[e >> 1]);
                dot[0] += uv * w0[0]; dot[1] += uv * w0[1]; dot[2] += uv * w0[2]; dot[3] += uv * w0[3]; dot[4] += uv * w1[0]; dot[5] += uv * w1[1]; dot[6] += uv * w1[2]; dot[7] += uv * w1[3]; }
#pragma unroll
            for (int e = 0; e < 8; ++e) dot[e] = wave_sum(dot[e]);
            float mine = dot[0];
#pragma unroll
            for (int e = 1; e < 8; ++e) mine = (lane == e) ? dot[e] : mine;
            if (lane < 8) { float r;
                if (lane < 4) r = 1.0f / (1.0f + expf(-mine));
                else { const int hh = lane - 4; const float a = mine + p.in[I_DTBIAS][hh]; const float sp = a > 20.f ? a : log1pf(expf(a)); r = -expf(p.in[I_ALOG][hh]) * sp; }
                ((float*)(p.ws + WS_BG))[(size_t)row * 8 + lane] = r; } }
        { bf16_t* qp = P + (size_t)row * NIN + ch; float f[16]; unpack16(qp, f); float ss = 0.f;
#pragma unroll
            for (int e = 0; e < 16; ++e) ss += f[e] * f[e];
            ss += __shfl_xor(ss, 1); ss += __shfl_xor(ss, 2);
            const float rstd = 1.0f / sqrtf(ss * (1.f / 64.f) + EPS);
#pragma unroll
            for (int e = 0; e < 16; ++e) f[e] = f[e] * rstd * gsb[e];
            pack16(qp, f); }
        { float y[16];
#pragma unroll
            for (int e = 0; e < 16; ++e) y[e] = 0.f;
#pragma unroll
            for (int i = 0; i < 4; ++i) { if (tl - 3 + i >= 0) { float f[16]; unpack16(P + (size_t)(row - 3 + i) * NIN + C_QDN + ch, f);
#pragma unroll
                    for (int e = 0; e < 16; ++e) y[e] += wcv[i][e] * f[e]; } }
            float ss = 0.f;
#pragma unroll
            for (int e = 0; e < 16; ++e) { y[e] = fsilu(y[e]); ss += y[e] * y[e]; }
            ss += __shfl_xor(ss, 1); ss += __shfl_xor(ss, 2); ss += __shfl_xor(ss, 4);
            const float sc = (1.0f / sqrtf(ss + EPS)) * (ch < 512 ? 0.08838834764831845f : 1.0f);
#pragma unroll
            for (int e = 0; e < 16; ++e) y[e] *= sc;
            pack16(U + (size_t)row * D + ch, y); }
    }
    bf16_t* Vt = (bf16_t*)(p.ws + WS_VT);
    for (int it = blockIdx.x * 8 + wave; it < T / 16; it += gridDim.x * 8) {
        const int row0 = it * 16, b = row0 >> 11, tl0 = row0 & (SEQ - 1), c8 = lane * 8, hd = c8 >> 6, d0 = c8 & 63;
        u32x4 w[16];
#pragma unroll
        for (int r = 0; r < 16; ++r) w[r] = *(const u32x4*)(P + (size_t)(row0 + r) * NIN + C_VSB + c8);
#pragma unroll
        for (int e = 0; e < 8; ++e) {
            unsigned o[8];
#pragma unroll
            for (int i = 0; i < 8; ++i) {
                const int p0 = 2 * i, p1 = 2 * i + 1;
                const int k0 = 8 * ((p0 >> 2) & 1) + 4 * (p0 >> 3) + (p0 & 3), k1 = 8 * ((p1 >> 2) & 1) + 4 * (p1 >> 3) + (p1 & 3);
                const unsigned a0 = w[k0][e >> 1], a1 = w[k1][e >> 1];
                const unsigned lo = (e & 1) ? (a0 >> 16) : (a0 & 0xffffu), hi = (e & 1) ? (a1 & 0xffff0000u) : (a1 << 16);
                o[i] = lo | hi; }
            bf16_t* dst = Vt + ((size_t)(b * 8 + hd) * 64 + d0 + e) * SEQ + tl0;
            ((u32x4*)dst)[0] = (u32x4){o[0], o[1], o[2], o[3]}; ((u32x4*)dst)[1] = (u32x4){o[4], o[5], o[6], o[7]}; }
    }
}

__device__ __forceinline__ float xlane32(float x, int hh) {
    const unsigned xi = __builtin_bit_cast(unsigned, x);
    const u32x2 r = __builtin_amdgcn_permlane32_swap(xi, xi, false, false);
    return __builtin_bit_cast(float, hh ? r.x : r.y);
}
template <bool DIAG>
__device__ __forceinline__ void attn_tile(const f32x16& z, const bf16x8 (&vc)[4], f32x16& o0, f32x16& o1, float& R, int ql, int hh) {
    float sg[16], m[16];
#pragma unroll
    for (int i = 0; i < 16; ++i) { const float e = __builtin_amdgcn_exp2f(fminf(-z[i], 80.0f)); float sig = __builtin_amdgcn_rcpf(1.0f + e); float mm = e * sig;
        if (DIAG) { const bool act = ((i & 3) + 8 * (i >> 2) + 4 * hh) < ql; sig = act ? sig : 0.f; mm = act ? mm : 1.0f; }
        sg[i] = sig; m[i] = mm; }
    float g[4], gp[4];
#pragma unroll
    for (int bq = 0; bq < 4; ++bq) { g[bq] = (m[4 * bq] * m[4 * bq + 1]) * (m[4 * bq + 2] * m[4 * bq + 3]); gp[bq] = xlane32(g[bq], hh); }
    float outer[4]; float tb = R;
#pragma unroll
    for (int bq = 3; bq >= 0; --bq) { outer[bq] = hh == 0 ? tb * gp[bq] : tb; tb *= g[bq] * gp[bq]; }
    R = tb;
    float w[16];
#pragma unroll
    for (int bq = 0; bq < 4; ++bq) { const float s3 = outer[bq], s2 = s3 * m[4 * bq + 3], s1 = s2 * m[4 * bq + 2], s0 = s1 * m[4 * bq + 1];
        w[4 * bq + 3] = sg[4 * bq + 3] * s3; w[4 * bq + 2] = sg[4 * bq + 2] * s2; w[4 * bq + 1] = sg[4 * bq + 1] * s1; w[4 * bq] = sg[4 * bq] * s0; }
    bf16x8 wf[2];
#pragma unroll
    for (int s2 = 0; s2 < 2; ++s2) { const u32x4 pw = {cpk2(w[8 * s2], w[8 * s2 + 1]), cpk2(w[8 * s2 + 2], w[8 * s2 + 3]), cpk2(w[8 * s2 + 4], w[8 * s2 + 5]), cpk2(w[8 * s2 + 6], w[8 * s2 + 7])}; wf[s2] = __builtin_bit_cast(bf16x8, pw); }
    o0 = __builtin_amdgcn_mfma_f32_32x32x16_bf16(vc[0], wf[0], o0, 0, 0, 0); o0 = __builtin_amdgcn_mfma_f32_32x32x16_bf16(vc[1], wf[1], o0, 0, 0, 0);
    o1 = __builtin_amdgcn_mfma_f32_32x32x16_bf16(vc[2], wf[0], o1, 0, 0, 0); o1 = __builtin_amdgcn_mfma_f32_32x32x16_bf16(vc[3], wf[1], o1, 0, 0, 0);
}
__device__ __forceinline__ void attn_item_mfma(bf16_t* P, const bf16_t* Vt, int bh, int qt, int lane) {
    asm volatile("" : "+v"(lane));
    const int b = bh >> 3, h = bh & 7, ql = lane & 31, hh = lane >> 5, q0 = qt * 32;
    bf16_t* qrow = P + (size_t)(b * SEQ + q0 + ql) * NIN + C_QSB + h * 64;
    bf16x8 qf[4];
#pragma unroll
    for (int s = 0; s < 4; ++s) qf[s] = *(const bf16x8*)(qrow + 16 * s + 8 * hh);
    f32x16 o0, o1;
#pragma unroll
    for (int i = 0; i < 16; ++i) { o0[i] = 0.f; o1[i] = 0.f; }
    float R = 1.0f;
    const bf16_t* kb = P + (size_t)(b * SEQ + ql) * NIN + C_KSB + h * 64 + 8 * hh;
    const bf16_t* vb = Vt + ((size_t)bh * 64 + ql) * SEQ + 8 * hh;
    bf16x8 kf[4], vf[4], vn[4];
#define AT_LOADK(k0_) do { _Pragma("unroll") for (int s = 0; s < 4; ++s) kf[s] = *(const bf16x8*)(kb + (size_t)(k0_) * NIN + 16 * s); } while (0)
#define AT_LOADV(dst, k0_) do { _Pragma("unroll") for (int j = 0; j < 4; ++j) dst[j] = *(const bf16x8*)(vb + (size_t)(j >> 1) * 32 * SEQ + (k0_) + 16 * (j & 1)); } while (0)
#define AT_QK(zz) do { _Pragma("unroll") for (int i = 0; i < 16; ++i) zz[i] = 0.f; _Pragma("unroll") for (int s = 0; s < 4; ++s) zz = __builtin_amdgcn_mfma_f32_32x32x16_bf16(kf[s], qf[s], zz, 0, 0, 0); } while (0)
    f32x16 zc, zn;
    AT_LOADK(q0); AT_LOADV(vf, q0);
    AT_QK(zc);
    { const int k1 = (qt > 0 ? qt - 1 : 0) * 32; AT_LOADK(k1); AT_LOADV(vn, k1); }
    { AT_QK(zn);
      const int k2 = (qt > 1 ? qt - 2 : 0) * 32; AT_LOADK(k2);
      attn_tile<true>(zc, vf, o0, o1, R, ql, hh);
      zc = zn;
#pragma unroll
      for (int j = 0; j < 4; ++j) vf[j] = vn[j];
      const int k1 = (qt > 1 ? qt - 2 : 0) * 32; AT_LOADV(vn, k1); }
#pragma unroll 1
    for (int kt = qt - 1; kt >= 0; --kt) {
        AT_QK(zn);
        const int k2 = (kt > 1 ? kt - 2 : 0) * 32; AT_LOADK(k2);
        attn_tile<false>(zc, vf, o0, o1, R, ql, hh);
        if (__builtin_amdgcn_ballot_w64(R != 0.0f) == 0ull) break;
        zc = zn;
#pragma unroll
        for (int j = 0; j < 4; ++j) vf[j] = vn[j];
        AT_LOADV(vn, k2);
    }
#undef AT_LOADK
#undef AT_LOADV
#undef AT_QK
#pragma unroll
    for (int bq = 0; bq < 4; ++bq) {
        u32x2 w0 = {cpk2(o0[4 * bq], o0[4 * bq + 1]), cpk2(o0[4 * bq + 2], o0[4 * bq + 3])}, w1 = {cpk2(o1[4 * bq], o1[4 * bq + 1]), cpk2(o1[4 * bq + 2], o1[4 * bq + 3])};
        *(u32x2*)(qrow + 8 * bq + 4 * hh) = w0; *(u32x2*)(qrow + 32 + 8 * bq + 4 * hh) = w1; }
}
__device__ __forceinline__ size_t slotU(size_t t0, int h, int colbase, int f) { return (t0 + (size_t)(f >> 7)) * D + colbase + h * 128 + (f & 127); }
__device__ __forceinline__ size_t slotP(size_t t0, int h, int colbase, int f) { return (t0 + (size_t)(f >> 7)) * NIN + colbase + h * 128 + (f & 127); }
__device__ __forceinline__ int permpos(int x) { const int k = x & 15; return (x & ~15) + 8 * ((k >> 2) & 1) + 4 * (k >> 3) + (k & 3); }
__device__ __forceinline__ int crow(int r, int hh) { return (r & 3) + 8 * (r >> 2) + 4 * hh; }
__device__ __forceinline__ bf16x8 pack8(const f32x16& x, int s2) {
    const u32x4 pw = {cpk2(x[8 * s2], x[8 * s2 + 1]), cpk2(x[8 * s2 + 2], x[8 * s2 + 3]), cpk2(x[8 * s2 + 4], x[8 * s2 + 5]), cpk2(x[8 * s2 + 6], x[8 * s2 + 7])};
    return __builtin_bit_cast(bf16x8, pw);
}
#define MFMA32(a, b, c) __builtin_amdgcn_mfma_f32_32x32x16_bf16((a), (b), (c), 0, 0, 0)
constexpr int PT = 72, PQ = 136, PL = 68, PB = 40;
constexpr int CP_GC = 0, CP_BT = 256, CP_LS = 1024, CP_TU = CP_LS + 64 * PL * 4, CP_TW = CP_TU + 64 * PT * 2, CP_KT = CP_TW + 64 * PT * 2, CP_VT = CP_KT + 128 * PT * 2,
              CP_QS = CP_VT + 128 * PT * 2, CP_KS = CP_QS + 64 * PQ * 2, CP_AQ = CP_KS + 64 * PQ * 2, CP_L21 = CP_AQ + 64 * PT * 2, CP_TCM = CP_L21 + 32 * PB * 2, CP_T22 = CP_TCM + 32 * PB * 2, CP_END = CP_T22 + 32 * PB * 2;
static_assert(CP_END <= 131072, "chunk prep LDS");
__device__ __forceinline__ void gdn_chunk_prep_phase(const Params& p, LAS unsigned char* lds, int tid, int wave, int lane) {
    bf16_t* P = (bf16_t*)(p.ws + WS_P); bf16_t* U = (bf16_t*)(p.ws + WS_U); const float* BG = (const float*)(p.ws + WS_BG);
    u32x4 ka, kb, qa, qb, xv[4][2]; float gx = 0.f, gbt = 0.f;
#define CP_LOAD(item_) do { const int bh_ = (item_) >> 5, n_ = (item_) & 31, b_ = bh_ >> 2, h_ = bh_ & 3; const size_t t0_ = (size_t)b_ * SEQ + n_ * 64; const int tok_ = tid & 63, c16_ = (tid >> 6) * 16; \
        ka = *(const u32x4*)(U + (t0_ + tok_) * D + 512 + h_ * 128 + c16_); kb = *(const u32x4*)(U + (t0_ + tok_) * D + 512 + h_ * 128 + c16_ + 8); \
        qa = *(const u32x4*)(U + (t0_ + tok_) * D + h_ * 128 + c16_); qb = *(const u32x4*)(U + (t0_ + tok_) * D + h_ * 128 + c16_ + 8); \
        _Pragma("unroll") for (int i = 0; i < 4; ++i) { const bool ok = n_ * 64 + tok_ - 3 + i >= 0; const bf16_t* vp = P + (t0_ + tok_ - 3 + i) * NIN + C_VDN + h_ * 128 + c16_; \
            xv[i][0] = ok ? *(const u32x4*)vp : (u32x4){0u, 0u, 0u, 0u}; xv[i][1] = ok ? *(const u32x4*)(vp + 8) : (u32x4){0u, 0u, 0u, 0u}; } \
        if (tid < 64) { gx = BG[(t0_ + tid) * 8 + 4 + h_]; gbt = BG[(t0_ + tid) * 8 + h_]; } } while (0)
    if ((int)blockIdx.x < 1024) CP_LOAD((int)blockIdx.x);
  for (int item = blockIdx.x; item < 1024; item += gridDim.x) {
    asm volatile("" : "+v"(tid), "+v"(lane));
    const int bh = item >> 5, n = item & 31, b = bh >> 2, h = bh & 3, ql = lane & 31, hh = lane >> 5;
    const size_t t0 = (size_t)b * SEQ + n * 64;
    LAS float* gcS = (LAS float*)(lds + CP_GC); LAS float* btS = (LAS float*)(lds + CP_BT);
    LAS float* LS = (LAS float*)(lds + CP_LS);
    LAS bf16_t* TuS = (LAS bf16_t*)(lds + CP_TU); LAS bf16_t* TwS = (LAS bf16_t*)(lds + CP_TW);
    LAS bf16_t* kT = (LAS bf16_t*)(lds + CP_KT); LAS bf16_t* vT = (LAS bf16_t*)(lds + CP_VT); LAS bf16_t* qS = (LAS bf16_t*)(lds + CP_QS); LAS bf16_t* kS = (LAS bf16_t*)(lds + CP_KS);
    LAS bf16_t* AQ = (LAS bf16_t*)(lds + CP_AQ); LAS bf16_t* L21b = (LAS bf16_t*)(lds + CP_L21); LAS bf16_t* Tcm = (LAS bf16_t*)(lds + CP_TCM); LAS bf16_t* T22r = (LAS bf16_t*)(lds + CP_T22);
    if (tid < 64) { float x = gx;
#pragma unroll
        for (int o = 1; o < 64; o <<= 1) { const float y = __shfl_up(x, o); if (lane >= o) x += y; }
        gcS[tid] = x; btS[tid] = gbt; }
    { const int tok = tid & 63, c16 = (tid >> 6) * 16;
        *(LAS u32x4*)(kS + tok * PQ + c16) = ka; *(LAS u32x4*)(kS + tok * PQ + c16 + 8) = kb;
        *(LAS u32x4*)(qS + tok * PQ + c16) = qa; *(LAS u32x4*)(qS + tok * PQ + c16 + 8) = qb;
        const unsigned kw[8] = {ka.x, ka.y, ka.z, ka.w, kb.x, kb.y, kb.z, kb.w};
#pragma unroll
        for (int e = 0; e < 8; ++e) { kT[(c16 + 2 * e) * PT + tok] = (bf16_t)(kw[e] & 0xffffu); kT[(c16 + 2 * e + 1) * PT + tok] = (bf16_t)(kw[e] >> 16); }
        float y[16];
#pragma unroll
        for (int e = 0; e < 16; ++e) y[e] = 0.f;
#pragma unroll
        for (int i = 0; i < 4; ++i) { const float* wp = p.in[I_WCONV] + i * 1536 + 1024 + h * 128 + c16;
            const unsigned xw[8] = {xv[i][0].x, xv[i][0].y, xv[i][0].z, xv[i][0].w, xv[i][1].x, xv[i][1].y, xv[i][1].z, xv[i][1].w};
#pragma unroll
            for (int e = 0; e < 8; ++e) { y[2 * e] += wp[2 * e] * bf_lo(xw[e]); y[2 * e + 1] += wp[2 * e + 1] * bf_hi(xw[e]); } }
#pragma unroll
        for (int e = 0; e < 16; ++e) vT[(c16 + e) * PT + tok] = f2bf(fsilu(y[e])); }
    __syncthreads();
    if (item + (int)gridDim.x < 1024) CP_LOAD(item + (int)gridDim.x);
    if (wave == 0 || wave == 4 || wave == 5) {
        const int it = wave == 0 ? 0 : 1, jt = wave == 4 ? 1 : 0;
        f32x16 acc;
#pragma unroll
        for (int r = 0; r < 16; ++r) acc[r] = 0.f;
#pragma unroll
        for (int ks = 0; ks < 8; ++ks) acc = MFMA32(*(const LAS bf16x8*)(kS + (32 * it + ql) * PQ + 16 * ks + 8 * hh), *(const LAS bf16x8*)(kS + (32 * jt + ql) * PQ + 16 * ks + 8 * hh), acc);
        const int j = 32 * jt + ql; const float gj = gcS[j];
#pragma unroll
        for (int r = 0; r < 16; ++r) { const int i = 32 * it + crow(r, hh); const float l = (j < i) ? btS[i] * acc[r] * fexp(gcS[i] - gj) : 0.f;
            if (it != jt) L21b[(i - 32) * PB + j] = f2bf(l); else LS[i * PL + j] = l; }
    } else if (wave < 4) {
        const int jt = wave == 3 ? 1 : 0, it = wave == 1 ? 0 : 1;
        f32x16 acc;
#pragma unroll
        for (int r = 0; r < 16; ++r) acc[r] = 0.f;
#pragma unroll
        for (int ks = 0; ks < 8; ++ks) acc = MFMA32(*(const LAS bf16x8*)(kS + (32 * jt + ql) * PQ + 16 * ks + 8 * hh), *(const LAS bf16x8*)(qS + (32 * it + ql) * PQ + 16 * ks + 8 * hh), acc);
        const int i = 32 * it + ql; const float gi = gcS[i];
#pragma unroll
        for (int r = 0; r < 16; ++r) { const int j = 32 * jt + crow(r, hh); acc[r] = (j <= i) ? acc[r] * fexp(gi - gcS[j]) : 0.f; }
#pragma unroll
        for (int bq = 0; bq < 4; ++bq) *(LAS u32x2*)(AQ + i * PT + 32 * jt + 8 * bq + 4 * hh) = (u32x2){cpk2(acc[4 * bq], acc[4 * bq + 1]), cpk2(acc[4 * bq + 2], acc[4 * bq + 3])};
    } else {
        const float gl = gcS[63];
#pragma unroll
        for (int uu = 0; uu < 4; ++uu) { const int unit = (tid - 384) + 128 * uu, dk = unit >> 2, blk = unit & 3;
            const u32x4 k0 = *(const LAS u32x4*)(kT + dk * PT + 16 * blk), k1 = *(const LAS u32x4*)(kT + dk * PT + 16 * blk + 8);
            float kv[16] = {bf_lo(k0.x), bf_hi(k0.x), bf_lo(k0.y), bf_hi(k0.y), bf_lo(k0.z), bf_hi(k0.z), bf_lo(k0.w), bf_hi(k0.w), bf_lo(k1.x), bf_hi(k1.x), bf_lo(k1.y), bf_hi(k1.y), bf_lo(k1.z), bf_hi(k1.z), bf_lo(k1.w), bf_hi(k1.w)};
#pragma unroll
            for (int e = 0; e < 16; ++e) kv[e] *= fexp(gl - gcS[16 * blk + e]);
            float pv[16];
#pragma unroll
            for (int e = 0; e < 16; ++e) pv[permpos(e)] = kv[e];
            pack16(P + slotP(t0, h, C_VSB, dk * 64 + 16 * blk), pv); }
        if (tid == 384) ((float*)(p.ws + WS_EGL))[bh * 32 + n] = fexp(gl);
    }
    __syncthreads();
    if (wave == 0) {
        const LAS float* LB = LS + (32 * hh) * PL + 32 * hh;
        float Tc[32];
        f32x4 lc[8], ln[8];
        Tc[0] = (ql == 0) ? 1.0f : 0.f;
        lc[0] = *(const LAS f32x4*)(LB + 1 * PL);
#pragma unroll
        for (int i = 1; i < 32; ++i) {
            if (i + 1 < 32) {
#pragma unroll
                for (int j4 = 0; j4 < i + 1; j4 += 4) ln[j4 >> 2] = *(const LAS f32x4*)(LB + (i + 1) * PL + j4); }
            float a0 = (ql == i) ? 1.0f : 0.f, a1 = 0.f, a2 = 0.f, a3 = 0.f;
#pragma unroll
            for (int j4 = 0; j4 < i; j4 += 4) { const f32x4 l4 = lc[j4 >> 2];
                a0 -= l4[0] * Tc[j4]; if (j4 + 1 < i) a1 -= l4[1] * Tc[j4 + 1]; if (j4 + 2 < i) a2 -= l4[2] * Tc[j4 + 2]; if (j4 + 3 < i) a3 -= l4[3] * Tc[j4 + 3]; }
            Tc[i] = (a0 + a1) + (a2 + a3);
#pragma unroll
            for (int q = 0; q < 8; ++q) lc[q] = ln[q]; }
        const int cg_ = 32 * hh + ql; const float bu = btS[cg_], bw = bu * fexp(gcS[cg_]);
#pragma unroll
        for (int i = 0; i < 32; ++i) { TuS[(32 * hh + i) * PT + cg_] = f2bf(Tc[i] * bu); TwS[(32 * hh + i) * PT + cg_] = f2bf(Tc[i] * bw); }
        if (hh == 0) {
#pragma unroll
            for (int i8 = 0; i8 < 4; ++i8) *(LAS u32x4*)(Tcm + ql * PB + 8 * i8) = (u32x4){cpk2(Tc[8 * i8], Tc[8 * i8 + 1]), cpk2(Tc[8 * i8 + 2], Tc[8 * i8 + 3]), cpk2(Tc[8 * i8 + 4], Tc[8 * i8 + 5]), cpk2(Tc[8 * i8 + 6], Tc[8 * i8 + 7])};
        } else {
#pragma unroll
            for (int i = 0; i < 32; ++i) T22r[i * PB + ql] = f2bf(Tc[i]);
        }
        LDS_WAIT();
        f32x16 x1;
#pragma unroll
        for (int r = 0; r < 16; ++r) x1[r] = 0.f;
#pragma unroll
        for (int s2 = 0; s2 < 2; ++s2) x1 = MFMA32(*(const LAS bf16x8*)(L21b + ql * PB + 16 * s2 + 8 * hh), *(const LAS bf16x8*)(Tcm + ql * PB + 16 * s2 + 8 * hh), x1);
        f32x16 yy;
#pragma unroll
        for (int r = 0; r < 16; ++r) yy[r] = 0.f;
#pragma unroll
        for (int s2 = 0; s2 < 2; ++s2) { const u32x2 lo = *(const LAS u32x2*)(T22r + ql * PB + 16 * s2 + 4 * hh), hi = *(const LAS u32x2*)(T22r + ql * PB + 16 * s2 + 8 + 4 * hh);
            const u32x4 af = {lo.x, lo.y, hi.x, hi.y};
            yy = MFMA32(__builtin_bit_cast(bf16x8, af), pack8(x1, s2), yy); }
        { const float bu0 = btS[ql], bw0 = bu0 * fexp(gcS[ql]);
#pragma unroll
            for (int r = 0; r < 16; ++r) { const int i2 = 32 + crow(r, hh); TuS[i2 * PT + ql] = f2bf(-yy[r] * bu0); TwS[i2 * PT + ql] = f2bf(-yy[r] * bw0); } }
    }
    __syncthreads();
    {
        const int isW = wave >> 2, ct = wave & 3, col = 32 * ct + ql;
        const LAS bf16_t* Ta = (isW ? TwS : TuS) + 8 * hh; const LAS bf16_t* Bs = (isW ? kT : vT) + col * PT + 8 * hh;
        bf16x8 bf[4];
#pragma unroll
        for (int ks = 0; ks < 4; ++ks) bf[ks] = *(const LAS bf16x8*)(Bs + 16 * ks);
        f32x16 xa[2];
#pragma unroll
        for (int jt = 0; jt < 2; ++jt) {
#pragma unroll
            for (int r = 0; r < 16; ++r) xa[jt][r] = 0.f;
#pragma unroll
            for (int ks = 0; ks < 4; ++ks) if (jt == 1 || ks < 2) xa[jt] = MFMA32(*(const LAS bf16x8*)(Ta + (32 * jt + ql) * PT + 16 * ks), bf[ks], xa[jt]); }
        bf16x8 xb[4] = {pack8(xa[0], 0), pack8(xa[0], 1), pack8(xa[1], 0), pack8(xa[1], 1)};
        f32x16 ra[2];
#pragma unroll
        for (int it = 0; it < 2; ++it) {
#pragma unroll
            for (int r = 0; r < 16; ++r) ra[it][r] = 0.f;
#pragma unroll
            for (int kk = 0; kk < 4; ++kk) if (it == 1 || kk < 2) { const LAS bf16_t* ap = AQ + (32 * it + ql) * PT + 16 * kk + 4 * hh;
                const u32x2 lo = *(const LAS u32x2*)ap, hi = *(const LAS u32x2*)(ap + 8); const u32x4 af = {lo.x, lo.y, hi.x, hi.y};
                ra[it] = MFMA32(__builtin_bit_cast(bf16x8, af), xb[kk], ra[it]); } }
        if (!isW) {
#pragma unroll
            for (int jt = 0; jt < 2; ++jt)
#pragma unroll
                for (int bq = 0; bq < 4; ++bq) { const int f = col * 64 + 32 * jt + 8 * bq + 4 * hh;
                    *(u32x2*)(U + slotU(t0, h, 0, f)) = (u32x2){cpk2(xa[jt][4 * bq], xa[jt][4 * bq + 1]), cpk2(xa[jt][4 * bq + 2], xa[jt][4 * bq + 3])};
                    *(u32x2*)(U + slotU(t0, h, 512, f)) = (u32x2){cpk2(ra[jt][4 * bq], ra[jt][4 * bq + 1]), cpk2(ra[jt][4 * bq + 2], ra[jt][4 * bq + 3])}; }
        } else {
            const int pc = permpos(col);
#pragma unroll
            for (int jt = 0; jt < 2; ++jt)
#pragma unroll
                for (int r = 0; r < 16; ++r) { const int tok = 32 * jt + crow(r, hh);
                    P[(t0 + tok) * NIN + C_QDN + h * 128 + pc] = f2bf(-xa[jt][r]);
                    P[(t0 + tok) * NIN + C_KDN + h * 128 + pc] = f2bf(bf2f(qS[tok * PQ + col]) * fexp(gcS[tok]) - ra[jt][r]); }
        }
    }
    __syncthreads();
  }
#undef CP_LOAD
}
constexpr int SC_PW = 136, SC_PK = 72, SC_NW = 0, SC_Q2 = 64 * SC_PW * 2, SC_KD = 2 * 64 * SC_PW * 2, SC_STAGE = 2 * 64 * SC_PW * 2 + 128 * SC_PK * 2, SC_OS = 2 * SC_STAGE,
              SC_US = SC_OS + 64 * SC_PW * 2, SC_OI = SC_US + 128 * SC_PK * 2, SC_END = SC_OI + 128 * SC_PK * 2;
static_assert(SC_END <= BST_OFF, "scan LDS");
__device__ __forceinline__ void gdn_scan_block(const Params& p, LAS unsigned char* lds, int bh, int tid, int wave, int lane) {
    asm volatile("" : "+v"(tid), "+v"(lane));
    bf16_t* P = (bf16_t*)(p.ws + WS_P); const bf16_t* U = (const bf16_t*)(p.ws + WS_U); const float* EGL = (const float*)(p.ws + WS_EGL);
    const int b = bh >> 2, h = bh & 3, ql = lane & 31, hh = lane >> 5;
    const size_t tb = (size_t)b * SEQ;
    LAS bf16_t* oS = (LAS bf16_t*)(lds + SC_OS);
    if (wave >= 4) {
        int lt = tid - 256, ftok = lt >> 2, fseg = lt & 3;
        u32x4 ra[20], rb[20];
#define SC_LOAD(r, n_) do { const size_t t0_ = tb + (size_t)(n_) * 64; _Pragma("unroll") for (int i = 0; i < 4; ++i) { const int c = lt + 256 * i, row = c >> 4, c8 = (c & 15) * 8; \
            const bf16_t* g_ = P + (t0_ + row) * NIN + h * 128 + c8; const bf16_t* u_ = U + (t0_ + row) * D + h * 128 + c8; \
            r[i] = *(const u32x4*)(g_ + C_QDN); r[4 + i] = *(const u32x4*)(g_ + C_KDN); r[8 + i] = *(const u32x4*)(g_ + C_VSB); r[12 + i] = *(const u32x4*)u_; r[16 + i] = *(const u32x4*)(u_ + 512); } } while (0)
#define SC_STORE(r, st_) do { LAS unsigned char* s_ = lds + (st_) * SC_STAGE; _Pragma("unroll") for (int i = 0; i < 4; ++i) { const int c = lt + 256 * i, row = c >> 4, c8 = (c & 15) * 8; \
            *(LAS u32x4*)(s_ + SC_NW + (row * SC_PW + c8) * 2) = r[i]; *(LAS u32x4*)(s_ + SC_Q2 + (row * SC_PW + c8) * 2) = r[4 + i]; \
            *(LAS u32x4*)(s_ + SC_KD + ((2 * row + (c8 >> 6)) * SC_PK + (c8 & 63)) * 2) = r[8 + i]; } } while (0)
#define SC_STOREU(r) do { _Pragma("unroll") for (int i = 0; i < 4; ++i) { const int c = lt + 256 * i, row = c >> 4, c8 = (c & 15) * 8; const int o_ = ((2 * row + (c8 >> 6)) * SC_PK + (c8 & 63)) * 2; \
            *(LAS u32x4*)(lds + SC_US + o_) = r[12 + i]; *(LAS u32x4*)(lds + SC_OI + o_) = r[16 + i]; } } while (0)
#define SC_FIN(m_) do { bf16_t* orow = P + (tb + (size_t)(m_) * 64 + ftok) * NIN + h * 128 + fseg * 32 + C_VDN; \
            _Pragma("unroll") for (int i = 0; i < 4; ++i) *(u32x4*)(orow + 8 * i) = *(const LAS u32x4*)(oS + ftok * SC_PW + fseg * 32 + 8 * i); } while (0)
        SC_LOAD(ra, 0); SC_STORE(ra, 0); SC_STOREU(ra); SC_LOAD(ra, 1);
        __syncthreads();
#pragma unroll 1
        for (int n = 0; n < 32; n += 2) {
            asm volatile("" : "+v"(lt), "+v"(ftok), "+v"(fseg));
            if (n + 2 < 32) SC_LOAD(rb, n + 2);
            SC_STORE(ra, 1);
            if (n > 0) SC_FIN(n - 1);
            __syncthreads();
            SC_STOREU(ra);
            __syncthreads();
            if (n + 3 < 32) SC_LOAD(ra, n + 3);
            if (n + 2 < 32) SC_STORE(rb, 0);
            SC_FIN(n);
            __syncthreads();
            if (n + 2 < 32) SC_STOREU(rb);
            __syncthreads();
        }
        SC_FIN(31);
#undef SC_LOAD
#undef SC_STORE
#undef SC_STOREU
#undef SC_FIN
    } else {
        const int col = 32 * wave + ql;
        f32x16 S[4];
#pragma unroll
        for (int rt = 0; rt < 4; ++rt)
#pragma unroll
            for (int r = 0; r < 16; ++r) S[rt][r] = 0.f;
        const float eglv = EGL[bh * 32 + ql];
        __syncthreads();
#pragma unroll 1
        for (int n = 0; n < 32; ++n) {
            const float egl = __builtin_bit_cast(float, __builtin_amdgcn_readlane(__builtin_bit_cast(int, eglv), n));
            const LAS unsigned char* st = lds + (n & 1) * SC_STAGE;
            f32x16 vn[2], oa[2];
            { const LAS unsigned char* up_ = lds + SC_US + (col * SC_PK + 4 * hh) * 2; const LAS unsigned char* op_ = lds + SC_OI + (col * SC_PK + 4 * hh) * 2;
#pragma unroll
              for (int jt = 0; jt < 2; ++jt)
#pragma unroll
                for (int bq = 0; bq < 4; ++bq) { const u32x2 uw = *(const LAS u32x2*)(up_ + (32 * jt + 8 * bq) * 2), ow = *(const LAS u32x2*)(op_ + (32 * jt + 8 * bq) * 2);
                    vn[jt][4 * bq] = bf_lo(uw.x); vn[jt][4 * bq + 1] = bf_hi(uw.x); vn[jt][4 * bq + 2] = bf_lo(uw.y); vn[jt][4 * bq + 3] = bf_hi(uw.y);
                    oa[jt][4 * bq] = bf_lo(ow.x); oa[jt][4 * bq + 1] = bf_hi(ow.x); oa[jt][4 * bq + 2] = bf_lo(ow.y); oa[jt][4 * bq + 3] = bf_hi(ow.y); } }
            const LAS unsigned char* w0_ = st + (ql * SC_PW + 8 * hh) * 2; const LAS unsigned char* w1_ = w0_ + 32 * SC_PW * 2;
            const LAS unsigned char* kd_ = st + SC_KD + (ql * SC_PK + 8 * hh) * 2;
            bf16x8 fa[4], fb[4];
#define SC_RD4(dst, ptr) do { _Pragma("unroll") for (int i_ = 0; i_ < 4; ++i_) dst[i_] = *(const LAS bf16x8*)((ptr) + 32 * i_); } while (0)
#define SC_MM4(acc, fr, bb) do { _Pragma("unroll") for (int i_ = 0; i_ < 4; ++i_) acc = MFMA32(fr[i_], bb[i_], acc); __builtin_amdgcn_sched_barrier(0); } while (0)
            SC_RD4(fa, w0_ + SC_NW); SC_RD4(fb, w1_ + SC_NW);
            { bf16x8 sb[4] = {pack8(S[0], 0), pack8(S[0], 1), pack8(S[1], 0), pack8(S[1], 1)};
              SC_MM4(vn[0], fa, sb); SC_RD4(fa, w0_ + SC_Q2);
              SC_MM4(vn[1], fb, sb); SC_RD4(fb, w1_ + SC_Q2);
              SC_MM4(oa[0], fa, sb); SC_RD4(fa, w0_ + SC_NW + 128);
              SC_MM4(oa[1], fb, sb); SC_RD4(fb, w1_ + SC_NW + 128); }
            { bf16x8 sb[4] = {pack8(S[2], 0), pack8(S[2], 1), pack8(S[3], 0), pack8(S[3], 1)};
              SC_MM4(vn[0], fa, sb); SC_RD4(fa, w0_ + SC_Q2 + 128);
              SC_MM4(vn[1], fb, sb); SC_RD4(fb, w1_ + SC_Q2 + 128);
              bf16x8 vb[4] = {pack8(vn[0], 0), pack8(vn[0], 1), pack8(vn[1], 0), pack8(vn[1], 1)};
              SC_MM4(oa[0], fa, sb); SC_RD4(fa, kd_);
              SC_MM4(oa[1], fb, sb); SC_RD4(fb, kd_ + 32 * SC_PK * 2);
#pragma unroll
              for (int rt = 0; rt < 4; ++rt)
#pragma unroll
                  for (int r = 0; r < 16; ++r) S[rt][r] *= egl;
              SC_MM4(S[0], fa, vb); SC_RD4(fa, kd_ + 64 * SC_PK * 2);
              SC_MM4(S[1], fb, vb); SC_RD4(fb, kd_ + 96 * SC_PK * 2);
              SC_MM4(S[2], fa, vb);
              SC_MM4(S[3], fb, vb); }
#undef SC_RD4
#undef SC_MM4
            __syncthreads();
#pragma unroll
            for (int jt = 0; jt < 2; ++jt)
#pragma unroll
                for (int r = 0; r < 16; ++r) oS[(32 * jt + crow(r, hh)) * SC_PW + col] = f2bf(oa[jt][r]);
            __syncthreads();
        }
    }
}
__device__ __forceinline__ void gdn_finalize_phase(const Params& p, int wave, int lane) {
    asm volatile("" : "+v"(lane));
    bf16_t* P = (bf16_t*)(p.ws + WS_P);
    const int c0 = (lane & 15) * 8;
    float gg[8];
#pragma unroll
    for (int e = 0; e < 8; ++e) gg[e] = p.in[I_GDNOUT][c0 + e];
    for (int row = blockIdx.x * 8 + wave; row < T; row += gridDim.x * 8) {
        bf16_t* op = P + (size_t)row * NIN + C_VDN + lane * 8; const bf16_t* zp = P + (size_t)row * NIN + C_ZDN + lane * 8;
        const u32x4 ow = *(const u32x4*)op, zw = *(const u32x4*)zp;
        const float o[8] = {bf_lo(ow.x), bf_hi(ow.x), bf_lo(ow.y), bf_hi(ow.y), bf_lo(ow.z), bf_hi(ow.z), bf_lo(ow.w), bf_hi(ow.w)};
        const float z[8] = {bf_lo(zw.x), bf_hi(zw.x), bf_lo(zw.y), bf_hi(zw.y), bf_lo(zw.z), bf_hi(zw.z), bf_lo(zw.w), bf_hi(zw.w)};
        float ss = 0.f;
#pragma unroll
        for (int e = 0; e < 8; ++e) ss += o[e] * o[e];
        ss += __shfl_xor(ss, 1); ss += __shfl_xor(ss, 2); ss += __shfl_xor(ss, 4); ss += __shfl_xor(ss, 8);
        const float rstd = 1.0f / sqrtf(ss * (1.f / 128.f) + EPS);
        float r[8];
#pragma unroll
        for (int e = 0; e < 8; ++e) r[e] = o[e] * rstd * gg[e] * fsilu(z[e]);
        u32x4 w; w.x = pk2(r[0], r[1]); w.y = pk2(r[2], r[3]); w.z = pk2(r[4], r[5]); w.w = pk2(r[6], r[7]);
        *(u32x4*)op = w;
    }
}

#define XB_TMO      128
#define XB_XCNT(j)  (256  + 64 * (j))
#define XB_XSUB(j)  (1280 + 64 * (j))
#define XB_XGEN(j)  (2304 + 64 * (j))
#define XB_TOP      3328
#define XB_TOPGEN   3392
#define XCD_BAR_WORDS 3456
#define XB_SPIN_CAP (1u << 18)
__device__ __forceinline__ unsigned xb_ld(unsigned* p)              { return __hip_atomic_load(p, __ATOMIC_RELAXED, __HIP_MEMORY_SCOPE_AGENT); }
__device__ __forceinline__ unsigned xb_add(unsigned* p, unsigned v) { return __hip_atomic_fetch_add(p, v, __ATOMIC_RELAXED, __HIP_MEMORY_SCOPE_AGENT); }
__device__ __forceinline__ unsigned xb_xcc_id() { return (unsigned)__builtin_amdgcn_s_getreg((3 << 11) | 20) & 0xFu; }
#define XB_SPIN(cond, bar) do { unsigned _sp = 0; while (cond) { __builtin_amdgcn_s_sleep(1); \
    if ((++_sp & 255u) == 0u) { if (xb_ld(&(bar)[XB_TMO])) break; if (_sp > XB_SPIN_CAP) { atomicAdd(&(bar)[XB_TMO], 1u); break; } } } } while (0)
struct XcdBarrier { unsigned* bar; unsigned x; volatile LAS unsigned* st; };
__device__ __forceinline__ XcdBarrier xcd_barrier_post(unsigned* bar, volatile LAS unsigned* st) {
    XcdBarrier b; b.bar = bar; b.x = xb_xcc_id(); b.st = st;
    if (threadIdx.x == 0) (void)xb_add(&bar[XB_XCNT(b.x)], 1u);
    return b;
}
__device__ __forceinline__ void xcd_barrier_complete(unsigned* bar, unsigned x, unsigned& nloc, unsigned& nx) {
    const unsigned G = gridDim.x * gridDim.y * gridDim.z;
    unsigned sum, cnt, mine, sp = 0u;
    for (;;) {
        sum = 0u; cnt = 0u; mine = 0u;
#pragma unroll
        for (unsigned j = 0; j < 16; ++j) { const unsigned c = xb_ld(&bar[XB_XCNT(j)]); sum += c; cnt += (c > 0u) ? 1u : 0u; mine = (j == x) ? c : mine; }
        if (sum == G) break;
        __builtin_amdgcn_s_sleep(1);
        if ((++sp & 255u) == 0u) { if (xb_ld(&bar[XB_TMO])) break; if (sp > XB_SPIN_CAP) { atomicAdd(&bar[XB_TMO], 1u); break; } }
    }
    nloc = mine > 0u ? mine : 1u; nx = cnt > 0u ? cnt : 1u;
}
__device__ __forceinline__ void xcd_barrier(const XcdBarrier& b) {
    asm volatile("s_waitcnt vmcnt(0)" ::: "memory");
    __syncthreads();
    if (threadIdx.x == 0) {
        unsigned* bar = b.bar;
        __builtin_amdgcn_s_waitcnt(0);
        unsigned nloc = b.st[0], nx = b.st[1];
        if (nloc == 0u) { xcd_barrier_complete(bar, b.x, nloc, nx); b.st[0] = nloc; b.st[1] = nx; }
        const unsigned old = xb_add(&bar[XB_XSUB(b.x)], 1u);
        const unsigned gen = old / nloc;
        if (old + 1u == (gen + 1u) * nloc) {
            __builtin_amdgcn_fence(__ATOMIC_RELEASE, "agent");
            asm volatile("s_waitcnt vmcnt(0)" ::: "memory");
            const unsigned og = xb_add(&bar[XB_TOP], 1u);
            const unsigned tg = og / nx;
            if (og + 1u == (tg + 1u) * nx) xb_add(&bar[XB_TOPGEN], 1u);
            else XB_SPIN(xb_ld(&bar[XB_TOPGEN]) == tg, bar);
            __builtin_amdgcn_fence(__ATOMIC_ACQUIRE, "agent");
            xb_add(&bar[XB_XGEN(b.x)], 1u);
            asm volatile("s_waitcnt vmcnt(0)" ::: "memory");
        } else {
            XB_SPIN(xb_ld(&bar[XB_XGEN(b.x)]) == gen, bar);
            __builtin_amdgcn_fence(__ATOMIC_ACQUIRE, "agent");
            asm volatile("s_waitcnt vmcnt(0)" ::: "memory");
        }
    }
    __syncthreads();
}

#ifndef PHMASK
#define PHMASK 0xFFFF
#endif
#define PH(n) ((PHMASK >> (n)) & 1)
#ifndef PROBE
#define PROBE 0
#endif
#define REP(g) for (int _rep = 0; _rep < ((PROBE == (g)) ? 2 : 1); ++_rep)
__global__ void __launch_bounds__(512, 2) fwd_megakernel(Params p) {
    extern __shared__ __attribute__((aligned(16))) unsigned char lds_raw[];
    LAS unsigned char* lds = (LAS unsigned char*)lds_raw;
    cg::grid_group grid = cg::this_grid();
    const int tid = threadIdx.x, lane = tid & 63, wave = __builtin_amdgcn_readfirstlane(tid >> 6);
    const int G = gridDim.x, gw = wave * G + blockIdx.x, ngw = G * 8;
    unsigned char* ws = p.ws;
    bf16_t* U = (bf16_t*)(ws + WS_U); bf16_t* P = (bf16_t*)(ws + WS_P);
    const float* mod = (const float*)(ws + WS_MOD);
    LAS float* scr = (LAS float*)(lds + wave * 16384);

    unsigned* barw = (unsigned*)(ws + WS_BAR);
    volatile LAS unsigned* bst = (volatile LAS unsigned*)(lds + BST_OFF);
    if (tid < 2) bst[tid] = 0u;
    __syncthreads();
    if (p.ws == nullptr) grid.sync();
    const XcdBarrier xbar = xcd_barrier_post(barw, bst);
    REP(1) { if (PH(0)) for (int it = blockIdx.x; it < NMOD / 64; it += G) mod_item(p, lds, it, tid, wave, lane);
    { const int nmod = NMOD / 64;
      if (PH(0)) { if (G >= nmod + 64) { if ((int)blockIdx.x >= nmod) ffn_weight_items(p.in[I_WFFN1IN], p.in[I_WFFN1OUT], (bf16_t*)(ws + W_FFIN), (bf16_t*)(ws + W_FFOUT), scr, wave * (G - nmod) + ((int)blockIdx.x - nmod), (G - nmod) * 8, lane); }
                   else ffn_weight_items(p.in[I_WFFN1IN], p.in[I_WFFN1OUT], (bf16_t*)(ws + W_FFIN), (bf16_t*)(ws + W_FFOUT), scr, gw, ngw, lane); } }
    __syncthreads(); }
    xcd_barrier(xbar);
    if (PROBE == 3) for (int i = 0; i < 16; ++i) xcd_barrier(xbar);
    REP(1) if (PH(1)) norm_mod_phase<false>(p, lds, p.in[I_X], p.in[I_GFFN1], 0, U, tid, wave, lane);
    xcd_barrier(xbar);
    REP(2) if (PH(2)) run_gemm(lds, U, D, (const bf16_t*)(ws + W_FFIN), 2 * FF, D, EpiSwiGLU{P, FF});
    { const int nfull = (64 * 22) % G, nidle = nfull ? G - nfull : G;
      const int ib = nfull ? (int)blockIdx.x - nfull : (int)blockIdx.x;
      if (PH(0) && ib >= 0) mixer_weight_items(p, scr, wave * nidle + ib, nidle * 8, lane); }
    xcd_barrier(xbar);
    const bool fusedn = (G == 256);
    unsigned* xslot = (unsigned*)(ws + WS_XSLOT); unsigned* xcnt = (unsigned*)(ws + WS_XCNT);
    if (fusedn) { if (PH(3)) run_gemm(lds, P, FF, (const bf16_t*)(ws + W_FFOUT), D, FF, EpiResidNorm{p.in[I_X], p.out, mod + 2 * D, p.in[I_GMIX], mod + 3 * D, U, xslot, xcnt, 0.5f, 0}); }
    else { REP(2) if (PH(3)) run_gemm(lds, P, FF, (const bf16_t*)(ws + W_FFOUT), D, FF, EpiResid{p.in[I_X], p.out, mod + 2 * D, 0.5f}); }
    xcd_barrier(xbar);
    if (!fusedn) { REP(1) if (PH(4)) norm_mod_phase<true>(p, lds, p.out, p.in[I_GMIX], 3, U, tid, wave, lane); xcd_barrier(xbar); }
    REP(2) if (PH(5)) run_gemm(lds, U, D, (const bf16_t*)(ws + W_IN), NIN, D, EpiBf16{P, NIN});
    { const int nfull = (64 * 22) % G, nidle = nfull ? G - nfull : G; const int ib = nfull ? (int)blockIdx.x - nfull : (int)blockIdx.x;
      if (PH(12) && ib >= 0) ffn_weight_items(p.in[I_WFFN2IN], p.in[I_WFFN2OUT], (bf16_t*)(ws + WS_F2IN), (bf16_t*)(ws + W_FFOUT), scr, wave * nidle + ib, nidle * 8, lane, 0, 2816); }
    xcd_barrier(xbar);
    if (PH(6)) prep_phase(p, lds, fusedn, tid, wave, lane);
    xcd_barrier(xbar);
    if (PH(7)) gdn_chunk_prep_phase(p, lds, tid, wave, lane);
    xcd_barrier(xbar);
    if (PH(15)) for (int it = blockIdx.x; it < 32; it += G) gdn_scan_block(p, lds, it, tid, wave, lane);
    if (PH(8)) {
        const unsigned x0 = xb_xcc_id() & 7u;
        for (unsigned dx = 0; dx < 8u; ++dx) { const unsigned x = (x0 + dx) & 7u; unsigned* ctr = (unsigned*)(ws + WS_CTR) + 64 * x;
            for (;;) { unsigned idx = 0; if (lane == 0) idx = atomicAdd(ctr, 1u); idx = __builtin_amdgcn_readfirstlane(idx);
                if (idx >= 512u) break;
                attn_item_mfma(P, (const bf16_t*)(ws + WS_VT), (int)(8u * x + (idx & 7u)), 63 - (int)(idx >> 3), lane); } } }
    xcd_barrier(xbar);
    if (PH(9)) gdn_finalize_phase(p, wave, lane);
    xcd_barrier(xbar);
    if (PH(10)) run_gemm(lds, P + C_QSB, NIN, (const bf16_t*)(ws + W_UPSB), D, 1024, EpiGateFused{P + C_RSB, P + C_RDN, U}, 8, (C_VDN - C_QSB) * 2 - 8 * 128);
    if (fusedn && PH(12)) ffn_weight_items(p.in[I_WFFN2IN], p.in[I_WFFN2OUT], (bf16_t*)(ws + WS_F2IN), (bf16_t*)(ws + W_FFOUT), scr, gw, ngw, lane, 2816, 2816 + 1408);
    xcd_barrier(xbar);
    if (fusedn) { if (PH(11)) run_gemm(lds, U, D, (const bf16_t*)(ws + W_OUT), D, D, EpiResidNorm{p.out, p.out, mod + 5 * D, p.in[I_GFFN2], mod + 6 * D, U, xslot + 64 * 256 * 4, xcnt + 64 * 64, 1.0f, 0}); }
    else { if (PH(11)) run_gemm(lds, U, D, (const bf16_t*)(ws + W_OUT), D, D, EpiResid{p.out, p.out, mod + 5 * D, 1.0f}); }
    xcd_barrier(xbar);
    if (!fusedn) { REP(1) if (PH(12)) norm_mod_phase<false>(p, lds, p.out, p.in[I_GFFN2], 6, U, tid, wave, lane);
        __syncthreads();
        if (PH(12)) ffn_weight_items(p.in[I_WFFN2IN], p.in[I_WFFN2OUT], (bf16_t*)(ws + WS_F2IN), (bf16_t*)(ws + W_FFOUT), scr, gw, ngw, lane, 2816, 2816 + 1408);
        xcd_barrier(xbar); }
    REP(2) if (PH(13)) run_gemm(lds, U, D, (const bf16_t*)(ws + WS_F2IN), 2 * FF, D, EpiSwiGLU{P, FF});
    xcd_barrier(xbar);
    if (PH(14)) run_gemm(lds, P, FF, (const bf16_t*)(ws + W_FFOUT), D, FF, EpiResid{p.out, p.out, mod + 8 * D, 0.5f});
}

extern "C" void kernel_launch(void* const* d_in, const int* in_sizes, int n_in, void* d_out, int out_size, void* d_ws, size_t ws_size, hipStream_t stream) {
    static int grid_blocks = 0;
    if (!grid_blocks) {
        int dev = 0, cus = 0, per_cu = 0;
        (void)hipGetDevice(&dev);
        (void)hipDeviceGetAttribute(&cus, hipDeviceAttributeMultiprocessorCount, dev);
        (void)hipFuncSetAttribute((const void*)fwd_megakernel, hipFuncAttributeMaxDynamicSharedMemorySize, LDS_BYTES);
        (void)hipOccupancyMaxActiveBlocksPerMultiprocessor(&per_cu, (const void*)fwd_megakernel, 512, LDS_BYTES);
        if (per_cu < 1) { fprintf(stderr, "occupancy query says %d blocks/CU\n", per_cu); per_cu = 1; }
        grid_blocks = cus;
    }
    Params p{};
    for (int i = 0; i < N_IN; ++i) p.in[i] = (const float*)d_in[i];
    p.out = (float*)d_out; p.ws = (unsigned char*)d_ws;
    static_assert(WS_BAR + XCD_BAR_WORDS * 4 <= WS_XCNT, "control words");
    (void)hipMemsetAsync((char*)d_ws + WS_CTR, 0, WS_ZEND - WS_CTR, stream);
    void* args[] = {&p};
    hipError_t e = hipLaunchCooperativeKernel((const void*)fwd_megakernel, dim3(grid_blocks), dim3(512), args, LDS_BYTES, stream);
    if (e != hipSuccess) fprintf(stderr, "cooperative launch failed: %s (grid %d)\n", hipGetErrorString(e), grid_blocks);
}
```

```cpp
#include <hip/hip_runtime.h>
#include <hip/hip_cooperative_groups.h>
#include <cstdio>
namespace cg = cooperative_groups;

#define LAS __attribute__((address_space(3)))
typedef unsigned short bf16_t;
typedef short bf16x8 __attribute__((ext_vector_type(8)));
typedef float f32x4 __attribute__((ext_vector_type(4)));
typedef unsigned u32x4 __attribute__((ext_vector_type(4)));
typedef unsigned u32x2 __attribute__((ext_vector_type(2)));
typedef float f32x16 __attribute__((ext_vector_type(16)));
typedef float f32x2 __attribute__((ext_vector_type(2)));
typedef __bf16 nbf16x2 __attribute__((ext_vector_type(2)));

constexpr int T = 16384, D = 1024, SEQ = 2048, NB = 8, FF = 2816, NIN = 5632, INW = 5640, NMOD = 9216;
constexpr int C_QSB = 0, C_KSB = 512, C_VSB = 1024, C_QDN = 1536, C_KDN = 2048, C_VDN = 2560, C_ZDN = 3072, C_RSB = 3584, C_RDN = 4608;
constexpr float EPS = 1e-6f;
constexpr int LDS_BYTES = 163840, BST_OFF = LDS_BYTES - 64;
constexpr size_t MiB = 1024 * 1024;
constexpr size_t WS_MOD = 0, WS_BG = 512 * 1024, WS_SS = 242 * MiB, WS_W = 2 * MiB;
constexpr size_t W_FFIN = WS_W, W_FFOUT = W_FFIN + (size_t)2 * FF * D * 2, W_IN = W_FFOUT + (size_t)D * FF * 2, W_UPSB = W_IN + (size_t)NIN * D * 2,
                 W_UPDN = W_UPSB + (size_t)D * 512 * 2, W_OUT = W_UPDN + (size_t)D * 512 * 2, W_END = W_OUT + (size_t)D * D * 2;
constexpr size_t WS_U = 34 * MiB, WS_P = 66 * MiB, WS_F2IN = 242 * MiB;
static_assert(W_END <= WS_U, "weights overflow");
constexpr size_t WS_EGL = 384 * 1024, WS_CTR = 400 * 1024, WS_BAR = 416 * 1024, WS_XCNT = 432 * 1024, WS_ZEND = 464 * 1024;
constexpr size_t WS_XSLOT = 1 * MiB;
constexpr size_t WS_VT = W_FFIN;
static_assert((size_t)T * 512 * 2 <= W_IN - W_FFIN, "Vt overflow");

enum { I_X = 0, I_C, I_WADA, I_BADA, I_GFFN1, I_WFFN1IN, I_WFFN1OUT, I_GMIX, I_WIN, I_GQSB, I_GKSB, I_WCONV, I_ALOG, I_DTBIAS, I_GDNOUT, I_WUPSB, I_WUPDN, I_WOUT, I_GFFN2, I_WFFN2IN, I_WFFN2OUT, N_IN };
struct Params { const float* in[N_IN]; float* out; unsigned char* ws; };

__device__ __forceinline__ float bf_lo(unsigned w) { return __uint_as_float(w << 16); }
__device__ __forceinline__ float bf_hi(unsigned w) { return __uint_as_float(w & 0xffff0000u); }
__device__ __forceinline__ float bf2f(bf16_t b) { return __uint_as_float(((unsigned)b) << 16); }
__device__ __forceinline__ unsigned pk2(float lo, float hi) { unsigned r; asm("v_cvt_pk_bf16_f32 %0, %1, %2" : "=v"(r) : "v"(lo), "v"(hi)); return r; }
__device__ __forceinline__ unsigned cpk2(float lo, float hi) { const f32x2 v = {lo, hi}; return __builtin_bit_cast(unsigned, __builtin_convertvector(v, nbf16x2)); }
__device__ __forceinline__ bf16_t f2bf(float f) { return (bf16_t)(pk2(f, 0.f) & 0xffffu); }
__device__ __forceinline__ float fexp(float x) { return __builtin_amdgcn_exp2f(x * 1.4426950408889634f); }
__device__ __forceinline__ float flog(float x) { return __builtin_amdgcn_logf(x) * 0.6931471805599453f; }
__device__ __forceinline__ float fsigmoid(float x) { return __builtin_amdgcn_rcpf(1.f + fexp(-x)); }
__device__ __forceinline__ float fsilu(float x) { return x * fsigmoid(x); }
__device__ __forceinline__ float fsoftplus(float x) { return fmaxf(x, 0.f) + flog(1.f + fexp(-fabsf(x))); }
__device__ __forceinline__ float wave_sum(float v) {
#pragma unroll
    for (int o = 1; o < 64; o <<= 1) v += __shfl_xor(v, o);
    return v;
}
#define LDS_WAIT() asm volatile("s_waitcnt lgkmcnt(0)" ::: "memory")

namespace pg8 {
constexpr int BM = 256, BK = 64, HALF = 128, HTB = HALF * BK * 2, STAGE_BYTES = 8 * HTB, NXCD = 8, WGM = 8;
__host__ __device__ __forceinline__ int lds_byte(int r, int c) { const int st = (r >> 4) * 2 + (c >> 5), rr = r & 15, cc = c & 31, ob = rr * 64 + cc * 2; return st * 1024 + (ob ^ (((ob >> 9) & 1) << 5)); }
__host__ __device__ __forceinline__ void stage_rc(int b, int& R, int& C) { const int st = b / 1024, sb = b % 1024, swz = sb ^ (((sb >> 9) & 1) << 5); R = (st >> 1) * 16 + swz / 64; C = (st & 1) * 32 + (swz % 64) / 2; }
__host__ __device__ __forceinline__ int perm32(int rho) { const int n = rho >> 4, i = rho & 15; return 8 * (i >> 2) + 4 * n + (i & 3); }
struct Unit { int pm, pn; };
struct Gemm { const bf16_t* A; const bf16_t* Bt; int M, N, K, lda; int jt; int jbytes; };
struct StaticOrder {
    int nM, nN, nwg, G, c;
    __host__ __device__ void init(int M, int N, int G_, int c_) { nM = M / BM; nN = N / BM; nwg = nM * nN; G = G_; c = c_; }
    __host__ __device__ bool next(int i, Unit& u) const {
        const long L = (long)i * G + c; if (L >= nwg) return false;
        int wgid = (int)L; { const int q = nwg / NXCD, r = nwg % NXCD, xcd = wgid % NXCD, off = wgid / NXCD; wgid = (xcd < r ? xcd * (q + 1) : r * (q + 1) + (xcd - r) * q) + off; }
        const int nig = WGM * nN, gid = wgid / nig, fm = gid * WGM, gsz = (nM - fm) < WGM ? (nM - fm) : WGM;
        u.pm = fm + ((wgid % nig) % gsz); u.pn = (wgid % nig) / gsz; return true;
    }
};
template <class Epi>
__device__ __forceinline__ void gemm_phase(LAS unsigned char* lds, const Gemm g, const StaticOrder& S, const Epi E) {
    int tid = threadIdx.x; asm volatile("" : "+v"(tid));
    const int wid = __builtin_amdgcn_readfirstlane(tid >> 6), lane = tid & 63, wr = wid >> 2, wc = wid & 3, fr = lane & 15, fq = lane >> 4;
    const int K = g.K, nt = K / BK, lda = g.lda;
    unsigned voffA[2], voffB[2];
#pragma unroll
    for (int i = 0; i < 2; ++i) { int R, C; stage_rc(tid * 16 + i * 8192, R, C); const int Rb = Epi::PERM ? ((R & ~31) + perm32(R & 31)) : R;
        voffA[i] = (unsigned)(R * lda + C) * 2u; voffB[i] = (unsigned)(Rb * K + C) * 2u; }
    const size_t kstep = (size_t)(BK * 2);
    const size_t hstepA = (size_t)HALF * lda * 2, hstepB = (size_t)HALF * K * 2;
    const size_t tstepA = 2 * hstepA, tstepB = 2 * hstepB;
    const unsigned ldsw = (unsigned)wid * 1024u;
    const int aoff = lds_byte(wr * 64 + fr, fq * 8), boff = lds_byte(wc * 32 + fr, fq * 8);
#define PG8_SA(b, h) (((b) * 2 + (h)) * HTB)
#define PG8_SB(b, h) ((4 + (b) * 2 + (h)) * HTB)
#define PG8_STAGE(bufoff, gbase, voff) do { _Pragma("unroll") for (int _i = 0; _i < 2; ++_i) \
        __builtin_amdgcn_global_load_lds((const unsigned*)((const char*)(gbase) + (voff)[_i]), (LAS unsigned*)(lds + (bufoff) + ldsw + _i * 8192), 16, 0, 0); } while (0)
#define PG8_LDA(dst, b, h) do { _Pragma("unroll") for (int m = 0; m < 4; ++m) _Pragma("unroll") for (int k = 0; k < 2; ++k) dst[m][k] = *(const LAS bf16x8*)(lds + PG8_SA(b, h) + aoff + m * 2048 + k * 1024); } while (0)
#define PG8_LDB(dst, b, h) do { _Pragma("unroll") for (int n = 0; n < 2; ++n) _Pragma("unroll") for (int k = 0; k < 2; ++k) dst[n][k] = *(const LAS bf16x8*)(lds + PG8_SB(b, h) + boff + n * 2048 + k * 1024); } while (0)
#define PG8_MMA(ai, bj, At, Bt) do { __builtin_amdgcn_s_setprio(1); _Pragma("unroll") for (int m = 0; m < 4; ++m) _Pragma("unroll") for (int n = 0; n < 2; ++n) _Pragma("unroll") for (int k = 0; k < 2; ++k) \
        acc[ai][bj][m][n] = __builtin_amdgcn_mfma_f32_16x16x32_bf16(Bt[n][k], At[m][k], acc[ai][bj][m][n], 0, 0, 0); __builtin_amdgcn_s_setprio(0); } while (0)
#define PG8_WAIT_V(n) asm volatile("s_waitcnt vmcnt(" #n ")" ::: "memory")
#define PG8_WAIT_L(n) asm volatile("s_waitcnt lgkmcnt(" #n ")" ::: "memory")
#define PG8_BAR __builtin_amdgcn_s_barrier()
#define PG8_SCHED __builtin_amdgcn_sched_barrier(0)
    Unit cur, nxt; int ui = 0;
    if (!S.next(0, cur)) return;
    f32x4 acc[2][2][4][2];
#pragma unroll
    for (int a = 0; a < 2; ++a)
#pragma unroll
        for (int b = 0; b < 2; ++b)
#pragma unroll
            for (int m = 0; m < 4; ++m)
#pragma unroll
                for (int n = 0; n < 2; ++n) acc[a][b][m][n] = (f32x4){0.f, 0.f, 0.f, 0.f};
    bf16x8 At[4][2], B0[2][2], B1[2][2];
    const char* cA = (const char*)g.A + (size_t)cur.pm * tstepA; const char* cB = (const char*)g.Bt + (size_t)cur.pn * tstepB;
    PG8_STAGE(PG8_SB(0, 0), cB, voffB); PG8_STAGE(PG8_SA(0, 0), cA, voffA); PG8_STAGE(PG8_SB(0, 1), cB + hstepB, voffB); PG8_STAGE(PG8_SA(0, 1), cA + hstepA, voffA);
    if (wr == 1) PG8_BAR;
    PG8_WAIT_V(4); PG8_BAR;
    PG8_STAGE(PG8_SB(1, 0), cB + kstep, voffB); PG8_STAGE(PG8_SA(1, 0), cA + kstep, voffA); PG8_STAGE(PG8_SB(1, 1), cB + hstepB + kstep, voffB);
    PG8_WAIT_V(6); PG8_BAR;
    for (;;) {
        const bool has_next = S.next(ui + 1, nxt);
        const char* nA = has_next ? (const char*)g.A + (size_t)nxt.pm * tstepA : cA; const char* nB = has_next ? (const char*)g.Bt + (size_t)nxt.pn * tstepB : cB;
        for (int t = 0; t < nt; t += 2) {
            const bool last = (t == nt - 2);
            const char* a1 = cA + (size_t)(t + 1) * kstep + (t + 1 >= g.jt ? g.jbytes : 0);
            const char* a2 = last ? nA : cA + (size_t)(t + 2) * kstep + (t + 2 >= g.jt ? g.jbytes : 0); const char* b2 = last ? nB : cB + (size_t)(t + 2) * kstep;
            const char* a3 = a2 + kstep; const char* b3 = b2 + kstep;
            if constexpr (Epi::HAS_MID) { if (t == g.jt) E.mid(acc, cur, wr, wc, fr, fq); }
            PG8_LDB(B0, 0, 0); PG8_SCHED; PG8_LDA(At, 0, 0); PG8_STAGE(PG8_SA(1, 1), a1 + hstepA, voffA);
            PG8_WAIT_L(8); PG8_BAR; PG8_WAIT_L(0); PG8_MMA(0, 0, At, B0); PG8_BAR; PG8_SCHED;
            PG8_LDB(B1, 0, 1); PG8_STAGE(PG8_SB(0, 0), b2, voffB);
            PG8_BAR; PG8_WAIT_L(0); PG8_MMA(0, 1, At, B1); PG8_BAR;
            PG8_LDA(At, 0, 1); PG8_STAGE(PG8_SA(0, 0), a2, voffA);
            PG8_BAR; PG8_WAIT_L(0); PG8_MMA(1, 0, At, B0); PG8_BAR; PG8_SCHED;
            PG8_STAGE(PG8_SB(0, 1), b2 + hstepB, voffB);
            PG8_WAIT_V(6); PG8_BAR; PG8_MMA(1, 1, At, B1); PG8_BAR;
            PG8_LDB(B0, 1, 0); PG8_SCHED; PG8_LDA(At, 1, 0); PG8_STAGE(PG8_SA(0, 1), a2 + hstepA, voffA);
            PG8_WAIT_L(8); PG8_BAR; PG8_WAIT_L(0); PG8_MMA(0, 0, At, B0); PG8_BAR; PG8_SCHED;
            PG8_LDB(B1, 1, 1); PG8_STAGE(PG8_SB(1, 0), b3, voffB);
            PG8_BAR; PG8_WAIT_L(0); PG8_MMA(0, 1, At, B1); PG8_BAR;
            PG8_LDA(At, 1, 1); PG8_STAGE(PG8_SA(1, 0), a3, voffA);
            PG8_BAR; PG8_WAIT_L(0); PG8_MMA(1, 0, At, B0); PG8_BAR; PG8_SCHED;
            PG8_STAGE(PG8_SB(1, 1), b3 + hstepB, voffB);
            PG8_WAIT_V(6); PG8_BAR; PG8_MMA(1, 1, At, B1); PG8_BAR;
        }
        if constexpr (!Epi::AFTER) E(acc, cur, wr, wc, fr, fq);
        if (!has_next) break;
#pragma unroll
        for (int a = 0; a < 2; ++a)
#pragma unroll
            for (int b = 0; b < 2; ++b)
#pragma unroll
                for (int m = 0; m < 4; ++m)
#pragma unroll
                    for (int n = 0; n < 2; ++n) acc[a][b][m][n] = (f32x4){0.f, 0.f, 0.f, 0.f};
        cur = nxt; cA = nA; cB = nB; ++ui;
    }
    PG8_WAIT_V(0);
    if (wr == 0) PG8_BAR;
    PG8_BAR;
    if constexpr (Epi::AFTER) E.fused(acc, cur, wr, wc, fr, fq, lds, wid, lane);
#undef PG8_SA
#undef PG8_SB
#undef PG8_STAGE
#undef PG8_LDA
#undef PG8_LDB
#undef PG8_MMA
#undef PG8_WAIT_V
#undef PG8_WAIT_L
#undef PG8_BAR
#undef PG8_SCHED
}
}

typedef const f32x4 (&AccRef)[2][2][4][2];
struct EpiBf16 {
    static constexpr bool PERM = true, HAS_MID = false, AFTER = false;
    bf16_t* O; int ldc;
    __device__ __forceinline__ void operator()(AccRef acc, const pg8::Unit& u, int wr, int wc, int fr, int fq) const {
        const int row0 = u.pm * 256 + wr * 64 + fr, col0 = u.pn * 256 + wc * 32 + 8 * fq;
#pragma unroll
        for (int ai = 0; ai < 2; ++ai)
#pragma unroll
            for (int m = 0; m < 4; ++m) { bf16_t* rowp = O + (size_t)(row0 + ai * 128 + m * 16) * ldc + col0;
#pragma unroll
                for (int bj = 0; bj < 2; ++bj) { const f32x4 v0 = acc[ai][bj][m][0], v1 = acc[ai][bj][m][1];
                    u32x4 w; w.x = pk2(v0[0], v0[1]); w.y = pk2(v0[2], v0[3]); w.z = pk2(v1[0], v1[1]); w.w = pk2(v1[2], v1[3]);
                    *(u32x4*)(rowp + bj * 128) = w; } }
    }
};
struct EpiSwiGLU {
    static constexpr bool PERM = true, HAS_MID = false, AFTER = false;
    bf16_t* O; int ldc;
    __device__ __forceinline__ void operator()(AccRef acc, const pg8::Unit& u, int wr, int wc, int fr, int fq) const {
        const int row0 = u.pm * 256 + wr * 64 + fr, col0 = u.pn * 128 + wc * 32 + 8 * fq;
#pragma unroll
        for (int ai = 0; ai < 2; ++ai)
#pragma unroll
            for (int m = 0; m < 4; ++m) { bf16_t* rowp = O + (size_t)(row0 + ai * 128 + m * 16) * ldc + col0;
                float r[8];
#pragma unroll
                for (int n = 0; n < 2; ++n)
#pragma unroll
                    for (int j = 0; j < 4; ++j) { const float a = acc[ai][0][m][n][j], b = acc[ai][1][m][n][j]; r[n * 4 + j] = fsilu(a) * b; }
                u32x4 w; w.x = pk2(r[0], r[1]); w.y = pk2(r[2], r[3]); w.z = pk2(r[4], r[5]); w.w = pk2(r[6], r[7]);
                *(u32x4*)rowp = w; }
    }
};
struct EpiResid {
    static constexpr bool PERM = false, HAS_MID = false, AFTER = false;
    const float* base; float* out; const float* gate; float scale;
    __device__ __forceinline__ void operator()(AccRef acc, const pg8::Unit& u, int wr, int wc, int fr, int fq) const {
        const int row0 = u.pm * 256 + wr * 64 + fr, col0 = u.pn * 256 + wc * 32 + 4 * fq;
        const float* gp = gate + (size_t)(u.pm >> 3) * NMOD + col0;
        f32x4 gv[2][2];
#pragma unroll
        for (int bj = 0; bj < 2; ++bj)
#pragma unroll
            for (int n = 0; n < 2; ++n) gv[bj][n] = *(const f32x4*)(gp + bj * 128 + n * 16) * scale;
#pragma unroll
        for (int ai = 0; ai < 2; ++ai) {
            f32x4 bs[4][2][2];
#pragma unroll
            for (int m = 0; m < 4; ++m) { const size_t off = (size_t)(row0 + ai * 128 + m * 16) * D + col0;
#pragma unroll
                for (int bj = 0; bj < 2; ++bj)
#pragma unroll
                    for (int n = 0; n < 2; ++n) bs[m][bj][n] = *(const f32x4*)(base + off + bj * 128 + n * 16); }
#pragma unroll
            for (int m = 0; m < 4; ++m) { const size_t off = (size_t)(row0 + ai * 128 + m * 16) * D + col0;
#pragma unroll
                for (int bj = 0; bj < 2; ++bj)
#pragma unroll
                    for (int n = 0; n < 2; ++n) *(f32x4*)(out + off + bj * 128 + n * 16) = bs[m][bj][n] + gv[bj][n] * acc[ai][bj][m][n]; }
            asm volatile("" ::: "memory"); }
    }
};
struct EpiResidNorm {
    static constexpr bool PERM = false, HAS_MID = false, AFTER = true;
    const float* base; float* out; const float* gate;
    const float* gain; const float* modsh; bf16_t* un;
    unsigned* xslot; unsigned* cnt; float scale; int pad_;
    __device__ __forceinline__ void fused(f32x4 (&acc)[2][2][4][2], const pg8::Unit& u, int wr, int wc, int fr, int fq, LAS unsigned char* lds, int wid, int lane) const {
        const int row0 = u.pm * 256 + wr * 64 + fr, col0 = u.pn * 256 + wc * 32 + 4 * fq, tid = wid * 64 + lane;
        LAS float* Pt = (LAS float*)lds; LAS float* St = (LAS float*)(lds + 4096);
        const float* gp = gate + (size_t)(u.pm >> 3) * NMOD + col0;
        f32x4 gv[2][2];
#pragma unroll
        for (int bj = 0; bj < 2; ++bj)
#pragma unroll
            for (int n = 0; n < 2; ++n) gv[bj][n] = *(const f32x4*)(gp + bj * 128 + n * 16) * scale;
#pragma unroll
        for (int ai = 0; ai < 2; ++ai) {
            f32x4 bs[4][2][2];
#pragma unroll
            for (int m = 0; m < 4; ++m) { const size_t off = (size_t)(row0 + ai * 128 + m * 16) * D + col0;
#pragma unroll
                for (int bj = 0; bj < 2; ++bj)
#pragma unroll
                    for (int n = 0; n < 2; ++n) bs[m][bj][n] = *(const f32x4*)(base + off + bj * 128 + n * 16); }
#pragma unroll
            for (int m = 0; m < 4; ++m) { const size_t off = (size_t)(row0 + ai * 128 + m * 16) * D + col0; float sq = 0.f;
#pragma unroll
                for (int bj = 0; bj < 2; ++bj)
#pragma unroll
                    for (int n = 0; n < 2; ++n) { const f32x4 hv = bs[m][bj][n] + gv[bj][n] * acc[ai][bj][m][n]; acc[ai][bj][m][n] = hv; *(f32x4*)(out + off + bj * 128 + n * 16) = hv;
                        sq += (hv[0] * hv[0] + hv[1] * hv[1]) + (hv[2] * hv[2] + hv[3] * hv[3]); }
                sq += __shfl_xor(sq, 16); sq += __shfl_xor(sq, 32);
                if (fq == 0) Pt[(ai * 128 + wr * 64 + m * 16 + fr) * 4 + wc] = sq; }
            asm volatile("" ::: "memory"); }
        LDS_WAIT(); __syncthreads();
        if (tid < 256) { const f32x4 t4 = *(const LAS f32x4*)(Pt + tid * 4); const float sq = (t4[0] + t4[1]) + (t4[2] + t4[3]);
            __hip_atomic_store(xslot + ((size_t)(u.pm * 256 + tid) * 4 + u.pn), __float_as_uint(sq), __ATOMIC_RELAXED, __HIP_MEMORY_SCOPE_AGENT);
            asm volatile("s_waitcnt vmcnt(0)" ::: "memory");
            if (lane == 0) __hip_atomic_fetch_add(cnt + 64 * u.pm, 1u, __ATOMIC_RELAXED, __HIP_MEMORY_SCOPE_AGENT); }
        if (wid == 0) { unsigned spins = 0;
            while ((unsigned)__builtin_amdgcn_readfirstlane(__hip_atomic_load(cnt + 64 * u.pm, __ATOMIC_RELAXED, __HIP_MEMORY_SCOPE_AGENT)) < 16u) { __builtin_amdgcn_s_sleep(2); if (++spins > (1u << 22)) break; }
            __builtin_amdgcn_fence(__ATOMIC_ACQUIRE, "agent"); asm volatile("s_waitcnt vmcnt(0)" ::: "memory"); }
        __syncthreads();
        if (tid < 256) { const unsigned* sl = xslot + (size_t)(u.pm * 256 + tid) * 4; float sq = 0.f;
#pragma unroll
            for (int t = 0; t < 4; ++t) sq += __uint_as_float(__hip_atomic_load(sl + t, __ATOMIC_RELAXED, __HIP_MEMORY_SCOPE_AGENT));
            St[tid] = 1.0f / sqrtf(sq * (1.f / D) + EPS); }
        LDS_WAIT(); __syncthreads();
        const float* shp = modsh + (size_t)(u.pm >> 3) * NMOD + col0;
        f32x4 gs[2][2], sh[2][2];
#pragma unroll
        for (int bj = 0; bj < 2; ++bj)
#pragma unroll
            for (int n = 0; n < 2; ++n) { gs[bj][n] = *(const f32x4*)(gain + col0 + bj * 128 + n * 16) * (*(const f32x4*)(shp + D + bj * 128 + n * 16) + 1.0f); sh[bj][n] = *(const f32x4*)(shp + bj * 128 + n * 16); }
#pragma unroll
        for (int ai = 0; ai < 2; ++ai)
#pragma unroll
            for (int m = 0; m < 4; ++m) { const int r = ai * 128 + wr * 64 + m * 16 + fr; const float rstd = St[r]; bf16_t* up = un + (size_t)(u.pm * 256 + r) * D + col0;
#pragma unroll
                for (int bj = 0; bj < 2; ++bj)
#pragma unroll
                    for (int n = 0; n < 2; ++n) { const f32x4 uu = acc[ai][bj][m][n] * rstd * gs[bj][n] + sh[bj][n];
                        *(u32x2*)(up + bj * 128 + n * 16) = (u32x2){pk2(uu[0], uu[1]), pk2(uu[2], uu[3])}; } }
        __syncthreads();
    }
};
struct EpiGateFused {
    static constexpr bool PERM = true, HAS_MID = true, AFTER = false;
    const bf16_t* Rsb; const bf16_t* Rdn; bf16_t* O;
    __device__ __forceinline__ void mid(f32x4 (&acc)[2][2][4][2], const pg8::Unit& u, int wr, int wc, int fr, int fq) const {
        int row0 = u.pm * 256 + wr * 64 + fr, col0 = u.pn * 256 + wc * 32 + 8 * fq;
        asm volatile("" : "+v"(row0), "+v"(col0));
#pragma unroll
        for (int ai = 0; ai < 2; ++ai)
#pragma unroll
            for (int mp = 0; mp < 2; ++mp) {
                u32x4 av[2][2], dv[2][2];
#pragma unroll
                for (int mm = 0; mm < 2; ++mm)
#pragma unroll
                    for (int bj = 0; bj < 2; ++bj) { const size_t row = (size_t)(row0 + ai * 128 + (2 * mp + mm) * 16);
                        av[mm][bj] = *(const u32x4*)(Rsb + row * NIN + col0 + bj * 128); dv[mm][bj] = *(const u32x4*)(Rdn + row * NIN + col0 + bj * 128); }
#pragma unroll
                for (int mm = 0; mm < 2; ++mm)
#pragma unroll
                    for (int bj = 0; bj < 2; ++bj) { const int m = 2 * mp + mm; const u32x4 a = av[mm][bj], d = dv[mm][bj];
                        const float ra[8] = {bf_lo(a.x), bf_hi(a.x), bf_lo(a.y), bf_hi(a.y), bf_lo(a.z), bf_hi(a.z), bf_lo(a.w), bf_hi(a.w)};
                        const float rd[8] = {bf_lo(d.x), bf_hi(d.x), bf_lo(d.y), bf_hi(d.y), bf_lo(d.z), bf_hi(d.z), bf_lo(d.w), bf_hi(d.w)};
#pragma unroll
                        for (int e = 0; e < 8; ++e) { const float q = (1.0f + fexp(fminf(-rd[e], 30.0f))) * __builtin_amdgcn_rcpf(1.0f + fexp(-ra[e])); acc[ai][bj][m][e >> 2][e & 3] *= q; } }
                asm volatile("" ::: "memory"); }
    }
    __device__ __forceinline__ void operator()(AccRef acc, const pg8::Unit& u, int wr, int wc, int fr, int fq) const {
        const int row0 = u.pm * 256 + wr * 64 + fr, col0 = u.pn * 256 + wc * 32 + 8 * fq;
#pragma unroll
        for (int ai = 0; ai < 2; ++ai) {
            u32x4 dv[4][2];
#pragma unroll
            for (int m = 0; m < 4; ++m)
#pragma unroll
                for (int bj = 0; bj < 2; ++bj) dv[m][bj] = *(const u32x4*)(Rdn + (size_t)(row0 + ai * 128 + m * 16) * NIN + col0 + bj * 128);
#pragma unroll
            for (int m = 0; m < 4; ++m) { const size_t row = (size_t)(row0 + ai * 128 + m * 16);
#pragma unroll
                for (int bj = 0; bj < 2; ++bj) { const u32x4 d = dv[m][bj];
                    const f32x4 v0 = acc[ai][bj][m][0], v1 = acc[ai][bj][m][1];
#define SGC(x) __builtin_amdgcn_rcpf(1.0f + fexp(fminf(-(x), 30.0f)))
                    const float r[8] = {SGC(bf_lo(d.x)) * v0[0], SGC(bf_hi(d.x)) * v0[1], SGC(bf_lo(d.y)) * v0[2], SGC(bf_hi(d.y)) * v0[3],
                                        SGC(bf_lo(d.z)) * v1[0], SGC(bf_hi(d.z)) * v1[1], SGC(bf_lo(d.w)) * v1[2], SGC(bf_hi(d.w)) * v1[3]};
#undef SGC
                    u32x4 w; w.x = pk2(r[0], r[1]); w.y = pk2(r[2], r[3]); w.z = pk2(r[4], r[5]); w.w = pk2(r[6], r[7]);
                    *(u32x4*)(O + row * D + col0 + bj * 128) = w; } } }
    }
};
template <class Epi> __device__ __forceinline__ void run_gemm(LAS unsigned char* lds, const bf16_t* A, int lda, const bf16_t* Bt, int N, int K, const Epi E, int jt = 1 << 30, int jbytes = 0) {
    pg8::Gemm g{A, Bt, T, N, K, lda, jt, jbytes}; pg8::StaticOrder S; S.init(T, N, (int)gridDim.x, (int)blockIdx.x);
    pg8::gemm_phase<Epi>(lds, g, S, E);
}

__device__ __forceinline__ void transpose_item(const float* W, int ldw, int s0, int k0, bf16_t* WT, int ldk, int d0, LAS float* scr, int lane) {
    float tv[32];
#pragma unroll
    for (int i = 0; i < 32; ++i) tv[i] = W[(size_t)(k0 + 2 * i + (lane >> 5)) * ldw + s0 + (lane & 31)];
#pragma unroll
    for (int i = 0; i < 32; ++i) scr[(2 * i + (lane >> 5)) * 33 + (lane & 31)] = tv[i];
    LDS_WAIT();
    const int c = lane & 7;
#pragma unroll
    for (int j = 0; j < 4; ++j) { const int n = (lane >> 3) + 8 * j; const LAS float* s = scr + (8 * c) * 33 + n;
        u32x4 o; o.x = pk2(s[0 * 33], s[1 * 33]); o.y = pk2(s[2 * 33], s[3 * 33]); o.z = pk2(s[4 * 33], s[5 * 33]); o.w = pk2(s[6 * 33], s[7 * 33]);
        *(u32x4*)(WT + (size_t)(d0 + n) * ldk + k0 + 8 * c) = o; }
    LDS_WAIT();
}
struct TrD { const float* W; int ldw, s0, k0; bf16_t* WT; int ldk, d0; };
__device__ __forceinline__ TrD ffn_item_desc(const float* w_in, const float* w_out, bf16_t* wt_in, bf16_t* wt_out, int it) {
    if (it < 2816) { const int kb = it / 176, nb = it % 176, d0 = nb * 32, pn = d0 >> 8, bj = (d0 >> 7) & 1, c = d0 & 127, s0 = bj * FF + pn * 128 + c; return TrD{w_in, 2 * FF, s0, kb * 64, wt_in, D, d0}; }
    const int r = it - 2816, kb = r / 32, nb = r % 32; return TrD{w_out, D, nb * 32, kb * 64, wt_out, FF, nb * 32};
}
__device__ __forceinline__ void ffn_weight_items(const float* w_in, const float* w_out, bf16_t* wt_in, bf16_t* wt_out, LAS float* scr, int gw, int ngw, int lane, int lo = 0, int NIT = 2816 + 1408) {
    gw += lo;
    float tv[32];
#define TR_LOAD(d_) do { _Pragma("unroll") for (int i = 0; i < 32; ++i) tv[i] = (d_).W[(size_t)((d_).k0 + 2 * i + (lane >> 5)) * (d_).ldw + (d_).s0 + (lane & 31)]; } while (0)
    if (gw < NIT) { const TrD d0_ = ffn_item_desc(w_in, w_out, wt_in, wt_out, gw); TR_LOAD(d0_); }
    for (int it = gw; it < NIT; it += ngw) {
        const TrD d = ffn_item_desc(w_in, w_out, wt_in, wt_out, it);
#pragma unroll
        for (int i = 0; i < 32; ++i) scr[(2 * i + (lane >> 5)) * 33 + (lane & 31)] = tv[i];
        LDS_WAIT();
        if (it + ngw < NIT) { const TrD dn = ffn_item_desc(w_in, w_out, wt_in, wt_out, it + ngw); TR_LOAD(dn); }
        const int c = lane & 7;
#pragma unroll
        for (int j = 0; j < 4; ++j) { const int n = (lane >> 3) + 8 * j; const LAS float* s_ = scr + (8 * c) * 33 + n;
            u32x4 o; o.x = pk2(s_[0 * 33], s_[1 * 33]); o.y = pk2(s_[2 * 33], s_[3 * 33]); o.z = pk2(s_[4 * 33], s_[5 * 33]); o.w = pk2(s_[6 * 33], s_[7 * 33]);
            *(u32x4*)(d.WT + (size_t)(d.d0 + n) * d.ldk + d.k0 + 8 * c) = o; }
        LDS_WAIT();
    }
#undef TR_LOAD
}
__device__ __forceinline__ void mixer_weight_items(const Params& p, LAS float* scr, int gw, int ngw, int lane) {
    unsigned char* ws = p.ws;
    for (int it = gw; it < 2816 + 256 + 256 + 512; it += ngw) {
        int r = it;
        if (r < 2816) { const int kb = r / 176, nb = r % 176, d0 = nb * 32, s0 = d0 < C_RSB ? d0 : d0 + 8; transpose_item(p.in[I_WIN], INW, s0, kb * 64, (bf16_t*)(ws + W_IN), D, d0, scr, lane); continue; } r -= 2816;
        if (r < 256) { const int kb = r / 32, nb = r % 32; transpose_item(p.in[I_WUPSB], D, nb * 32, kb * 64, (bf16_t*)(ws + W_UPSB), D, nb * 32, scr, lane); continue; } r -= 256;
        if (r < 256) { const int kb = r / 32, nb = r % 32; transpose_item(p.in[I_WUPDN], D, nb * 32, kb * 64, (bf16_t*)(ws + W_UPSB) + 512, D, nb * 32, scr, lane); continue; } r -= 256;
        { const int kb = r / 32, nb = r % 32; transpose_item(p.in[I_WOUT], D, nb * 32, kb * 64, (bf16_t*)(ws + W_OUT), D, nb * 32, scr, lane); }
    }
}
__device__ __forceinline__ void mod_item(const Params& p, LAS unsigned char* lds, int cb, int tid, int wave, int lane) {
    asm volatile("" : "+v"(tid), "+v"(lane));
    LAS float* sc = (LAS float*)lds; LAS float* red = (LAS float*)(lds + 32768);
    for (int i = tid; i < NB * D; i += 512) sc[i] = fsilu(p.in[I_C][i]);
    __syncthreads();
    const float* wa = p.in[I_WADA] + cb * 64 + lane;
    float acc[NB];
#pragma unroll
    for (int b = 0; b < NB; ++b) acc[b] = 0.f;
    for (int k = wave * 128; k < wave * 128 + 128; k += 32) {
        float w[32];
#pragma unroll
        for (int e = 0; e < 32; ++e) w[e] = wa[(size_t)(k + e) * NMOD];
#pragma unroll
        for (int b = 0; b < NB; ++b)
#pragma unroll
            for (int e4 = 0; e4 < 8; ++e4) { const f32x4 s = *(const LAS f32x4*)(sc + b * D + k + 4 * e4); acc[b] += s[0] * w[4 * e4] + s[1] * w[4 * e4 + 1] + s[2] * w[4 * e4 + 2] + s[3] * w[4 * e4 + 3]; }
    }
#pragma unroll
    for (int b = 0; b < NB; ++b) red[(wave * NB + b) * 64 + lane] = acc[b];
    __syncthreads();
    { const int b = tid >> 6; float s = p.in[I_BADA][cb * 64 + lane];
#pragma unroll
        for (int w = 0; w < 8; ++w) s += red[(w * NB + b) * 64 + lane];
        ((float*)(p.ws + WS_MOD))[b * NMOD + cb * 64 + lane] = s; }
    __syncthreads();
}

template <bool DN>
__device__ __forceinline__ void norm_mod_phase(const Params& p, LAS unsigned char* lds, const float* src, const float* gain, int midx, bf16_t* dst, int tid, int wave, int lane) {
    asm volatile("" : "+v"(tid), "+v"(lane));
    const float* mod = (const float*)(p.ws + WS_MOD);
    LAS float* wl = (LAS float*)lds;
    if (DN) { for (int i = tid; i < D * 8; i += 512) { const int k = i >> 3, j = i & 7; wl[8 * k + 4 * (k >> 2) + j] = p.in[I_WIN][(size_t)k * INW + C_RSB + j]; } __syncthreads(); }
    f32x4 g4[4];
#pragma unroll
    for (int j = 0; j < 4; ++j) g4[j] = ((const f32x4*)gain)[lane + 64 * j];
    const int rstep = gridDim.x * 8;
    f32x4 nv[4];
    { const int r0 = blockIdx.x * 8 + wave; const f32x4* xr = (const f32x4*)(src + (size_t)(r0 < T ? r0 : 0) * D) + lane;
#pragma unroll
      for (int j = 0; j < 4; ++j) nv[j] = xr[64 * j]; }
    for (int row = blockIdx.x * 8 + wave; row < T; row += rstep) {
        const int b = row >> 11;
        const f32x4* shp = (const f32x4*)(mod + (size_t)b * NMOD + midx * D) + lane; const f32x4* scp = shp + D / 4;
        f32x4 v[4], shv[4], scv[4]; float ss = 0.f;
#pragma unroll
        for (int j = 0; j < 4; ++j) { v[j] = nv[j]; shv[j] = shp[64 * j]; scv[j] = scp[64 * j]; }
        { const int rn = row + rstep < T ? row + rstep : row; const f32x4* xr = (const f32x4*)(src + (size_t)rn * D) + lane;
#pragma unroll
          for (int j = 0; j < 4; ++j) nv[j] = xr[64 * j]; }
#pragma unroll
        for (int j = 0; j < 4; ++j) ss += (v[j][0] * v[j][0] + v[j][1] * v[j][1]) + (v[j][2] * v[j][2] + v[j][3] * v[j][3]);
        const float rstd = 1.0f / sqrtf(wave_sum(ss) * (1.f / D) + EPS);
        u32x2* o8 = (u32x2*)(dst + (size_t)row * D) + lane;
        float dot[8];
        if (DN) {
#pragma unroll
            for (int e = 0; e < 8; ++e) dot[e] = 0.f; }
#pragma unroll
        for (int j = 0; j < 4; ++j) { const f32x4 sh = shv[j], sc = scv[j];
            const f32x4 uu = v[j] * rstd * g4[j] * (sc + 1.0f) + sh;
            u32x2 w; w.x = pk2(uu[0], uu[1]); w.y = pk2(uu[2], uu[3]); o8[64 * j] = w;
            if (DN) {
#pragma unroll
                for (int e = 0; e < 4; ++e) { const int k = 4 * lane + 256 * j + e; const LAS f32x4* wp = (const LAS f32x4*)(wl + 8 * k + 4 * (k >> 2)); const f32x4 w0 = wp[0], w1 = wp[1];
                    dot[0] += uu[e] * w0[0]; dot[1] += uu[e] * w0[1]; dot[2] += uu[e] * w0[2]; dot[3] += uu[e] * w0[3];
                    dot[4] += uu[e] * w1[0]; dot[5] += uu[e] * w1[1]; dot[6] += uu[e] * w1[2]; dot[7] += uu[e] * w1[3]; } } }
        if (DN) {
#pragma unroll
            for (int e = 0; e < 8; ++e) dot[e] = wave_sum(dot[e]);
            float mine = dot[0];
#pragma unroll
            for (int e = 1; e < 8; ++e) mine = (lane == e) ? dot[e] : mine;
            if (lane < 8) { float r;
                if (lane < 4) r = 1.0f / (1.0f + expf(-mine));
                else { const int hh = lane - 4; const float a = mine + p.in[I_DTBIAS][hh]; const float sp = a > 20.f ? a : log1pf(expf(a)); r = -expf(p.in[I_ALOG][hh]) * sp; }
                ((float*)(p.ws + WS_BG))[(size_t)row * 8 + lane] = r; } }
    }
    if (DN) __syncthreads();
}

__device__ __forceinline__ void dn_gate_phase(const Params& p, LAS unsigned char* lds, const bf16_t* u2, int tid, int wave, int lane) {
    asm volatile("" : "+v"(tid), "+v"(lane));
    LAS float* wl = (LAS float*)lds;
    for (int i = tid; i < D * 8; i += 512) { const int k = i >> 3, j = i & 7; wl[8 * k + 4 * (k >> 2) + j] = p.in[I_WIN][(size_t)k * INW + C_RSB + j]; }
    __syncthreads();
    const int rstep = gridDim.x * 8;
    u32x4 na, nb;
    { const int r0 = blockIdx.x * 8 + wave; const bf16_t* up = u2 + (size_t)(r0 < T ? r0 : 0) * D + 16 * lane; na = ((const u32x4*)up)[0]; nb = ((const u32x4*)up)[1]; }
    for (int row = blockIdx.x * 8 + wave; row < T; row += rstep) {
        const u32x4 ca = na, cb = nb;
        { const int rn = row + rstep < T ? row + rstep : row; const bf16_t* up = u2 + (size_t)rn * D + 16 * lane; na = ((const u32x4*)up)[0]; nb = ((const u32x4*)up)[1]; }
        const unsigned w8[8] = {ca.x, ca.y, ca.z, ca.w, cb.x, cb.y, cb.z, cb.w};
        float dot[8];
#pragma unroll
        for (int e = 0; e < 8; ++e) dot[e] = 0.f;
#pragma unroll
        for (int e = 0; e < 16; ++e) { const int k = 16 * lane + e; const LAS f32x4* wp = (const LAS f32x4*)(wl + 8 * k + 4 * (k >> 2)); const f32x4 w0 = wp[0], w1 = wp[1];
            const float uv = (e & 1) ? bf_hi(w8[e >> 1]) : bf_lo(w8[e >> 1]);
            dot[0] += uv * w0[0]; dot[1] += uv * w0[1]; dot[2] += uv * w0[2]; dot[3] += uv * w0[3]; dot[4] += uv * w1[0]; dot[5] += uv * w1[1]; dot[6] += uv * w1[2]; dot[7] += uv * w1[3]; }
#pragma unroll
        for (int e = 0; e < 8; ++e) dot[e] = wave_sum(dot[e]);
        float mine = dot[0];
#pragma unroll
        for (int e = 1; e < 8; ++e) mine = (lane == e) ? dot[e] : mine;
        if (lane < 8) { float r;
            if (lane < 4) r = 1.0f / (1.0f + expf(-mine));
            else { const int hh = lane - 4; const float a = mine + p.in[I_DTBIAS][hh]; const float sp = a > 20.f ? a : log1pf(expf(a)); r = -expf(p.in[I_ALOG][hh]) * sp; }
            ((float*)(p.ws + WS_BG))[(size_t)row * 8 + lane] = r; }
    }
    __syncthreads();
}
__device__ __forceinline__ void unpack16(const bf16_t* p, float* f) {
    const u32x4 a = ((const u32x4*)p)[0], b = ((const u32x4*)p)[1];
    f[0] = bf_lo(a.x); f[1] = bf_hi(a.x); f[2] = bf_lo(a.y); f[3] = bf_hi(a.y); f[4] = bf_lo(a.z); f[5] = bf_hi(a.z); f[6] = bf_lo(a.w); f[7] = bf_hi(a.w);
    f[8] = bf_lo(b.x); f[9] = bf_hi(b.x); f[10] = bf_lo(b.y); f[11] = bf_hi(b.y); f[12] = bf_lo(b.z); f[13] = bf_hi(b.z); f[14] = bf_lo(b.w); f[15] = bf_hi(b.w);
}
__device__ __forceinline__ void pack16(bf16_t* p, const float* f) {
    u32x4 a, b; a.x = pk2(f[0], f[1]); a.y = pk2(f[2], f[3]); a.z = pk2(f[4], f[5]); a.w = pk2(f[6], f[7]); b.x = pk2(f[8], f[9]); b.y = pk2(f[10], f[11]); b.z = pk2(f[12], f[13]); b.w = pk2(f[14], f[15]);
    ((u32x4*)p)[0] = a; ((u32x4*)p)[1] = b;
}
__device__ __forceinline__ void prep_phase(const Params& p, LAS unsigned char* lds, bool dn, int tid, int wave, int lane) {
    asm volatile("" : "+v"(lane), "+v"(tid));
    bf16_t* P = (bf16_t*)(p.ws + WS_P); bf16_t* U = (bf16_t*)(p.ws + WS_U);
    LAS float* wl = (LAS float*)lds;
    if (dn) { for (int i = tid; i < D * 8; i += 512) { const int k = i >> 3, j = i & 7; wl[(k & 15) * 520 + (k >> 4) * 8 + j] = p.in[I_WIN][(size_t)k * INW + C_RSB + j]; } __syncthreads(); }
    const int ch = 16 * lane;
    float gsb[16], wcv[4][16];
    { const float* gp = (ch < 512 ? p.in[I_GQSB] : p.in[I_GKSB]) + (ch & 63); const float sc = ch < 512 ? 0.18033688011112042f : 1.0f;
#pragma unroll
        for (int e = 0; e < 16; ++e) gsb[e] = gp[e] * sc;
#pragma unroll
        for (int i = 0; i < 4; ++i)
#pragma unroll
            for (int e = 0; e < 16; ++e) wcv[i][e] = p.in[I_WCONV][i * 1536 + ch + e]; }
    for (int row = blockIdx.x * 8 + wave; row < T; row += gridDim.x * 8) {
        const int tl = row & (SEQ - 1);
        if (dn) {
            const u32x4 ca = *(const u32x4*)(U + (size_t)row * D + ch), cb = *(const u32x4*)(U + (size_t)row * D + ch + 8);
            const unsigned w8[8] = {ca.x, ca.y, ca.z, ca.w, cb.x, cb.y, cb.z, cb.w};
            float dot[8];
#pragma unroll
            for (int e = 0; e < 8; ++e) dot[e] = 0.f;
#pragma unroll
            for (int e = 0; e < 16; ++e) { const LAS f32x4* wp = (const LAS f32x4*)(wl + e * 520 + lane * 8); const f32x4 w0 = wp[0], w1 = wp[1];
                const float uv = (e & 1) ? bf_hi(w8[e >> 1]) : bf_lo(w8[e >> 1]);
                dot[0] += uv * w0[0]; dot[1] += uv * w0[1]; dot[2] += uv * w0[2]; dot[3] += uv * w0[3]; dot[4] += uv * w1[0]; dot[5] += uv * w1[1]; dot[6] += uv * w1[2]; dot[7] += uv * w1[3]; }
#pragma unroll
            for (int e = 0; e < 8; ++e) dot[e] = wave_sum(dot[e]);
            float mine = dot[0];
#pragma unroll
            for (int e = 1; e < 8; ++e) mine = (lane == e) ? dot[e] : mine;
            if (lane < 8) { float r;
                if (lane < 4) r = 1.0f / (1.0f + expf(-mine));
                else { const int hh = lane - 4; const float a = mine + p.in[I_DTBIAS][hh]; const float sp = a > 20.f ? a : log1pf(expf(a)); r = -expf(p.in[I_ALOG][hh]) * sp; }
                ((float*)(p.ws + WS_BG))[(size_t)row * 8 + lane] = r; } }
        { bf16_t* qp = P + (size_t)row * NIN + ch; float f[16]; unpack16(qp, f); float ss = 0.f;
#pragma unroll
            for (int e = 0; e < 16; ++e) ss += f[e] * f[e];
            ss += __shfl_xor(ss, 1); ss += __shfl_xor(ss, 2);
            const float rstd = 1.0f / sqrtf(ss * (1.f / 64.f) + EPS);
#pragma unroll
            for (int e = 0; e < 16; ++e) f[e] = f[e] * rstd * gsb[e];
            pack16(qp, f); }
        { float y[16];
#pragma unroll
            for (int e = 0; e < 16; ++e) y[e] = 0.f;
#pragma unroll
            for (int i = 0; i < 4; ++i) { if (tl - 3 + i >= 0) { float f[16]; unpack16(P + (size_t)(row - 3 + i) * NIN + C_QDN + ch, f);
#pragma unroll
                    for (int e = 0; e < 16; ++e) y[e] += wcv[i][e] * f[e]; } }
            float ss = 0.f;
#pragma unroll
            for (int e = 0; e < 16; ++e) { y[e] = fsilu(y[e]); ss += y[e] * y[e]; }
            ss += __shfl_xor(ss, 1); ss += __shfl_xor(ss, 2); ss += __shfl_xor(ss, 4);
            const float sc = (1.0f / sqrtf(ss + EPS)) * (ch < 512 ? 0.08838834764831845f : 1.0f);
#pragma unroll
            for (int e = 0; e < 16; ++e) y[e] *= sc;
            pack16(U + (size_t)row * D + ch, y); }
    }
    bf16_t* Vt = (bf16_t*)(p.ws + WS_VT);
    for (int it = blockIdx.x * 8 + wave; it < T / 16; it += gridDim.x * 8) {
        const int row0 = it * 16, b = row0 >> 11, tl0 = row0 & (SEQ - 1), c8 = lane * 8, hd = c8 >> 6, d0 = c8 & 63;
        u32x4 w[16];
#pragma unroll
        for (int r = 0; r < 16; ++r) w[r] = *(const u32x4*)(P + (size_t)(row0 + r) * NIN + C_VSB + c8);
#pragma unroll
        for (int e = 0; e < 8; ++e) {
            unsigned o[8];
#pragma unroll
            for (int i = 0; i < 8; ++i) {
                const int p0 = 2 * i, p1 = 2 * i + 1;
                const int k0 = 8 * ((p0 >> 2) & 1) + 4 * (p0 >> 3) + (p0 & 3), k1 = 8 * ((p1 >> 2) & 1) + 4 * (p1 >> 3) + (p1 & 3);
                const unsigned a0 = w[k0][e >> 1], a1 = w[k1][e >> 1];
                const unsigned lo = (e & 1) ? (a0 >> 16) : (a0 & 0xffffu), hi = (e & 1) ? (a1 & 0xffff0000u) : (a1 << 16);
                o[i] = lo | hi; }
            bf16_t* dst = Vt + ((size_t)(b * 8 + hd) * 64 + d0 + e) * SEQ + tl0;
            ((u32x4*)dst)[0] = (u32x4){o[0], o[1], o[2], o[3]}; ((u32x4*)dst)[1] = (u32x4){o[4], o[5], o[6], o[7]}; }
    }
}

__device__ __forceinline__ float xlane32(float x, int hh) {
    const unsigned xi = __builtin_bit_cast(unsigned, x);
    const u32x2 r = __builtin_amdgcn_permlane32_swap(xi, xi, false, false);
    return __builtin_bit_cast(float, hh ? r.x : r.y);
}
template <bool DIAG>
__device__ __forceinline__ void attn_tile(const f32x16& z, const bf16x8 (&vc)[4], f32x16& o0, f32x16& o1, float& R, int ql, int hh) {
    float sg[16], m[16];
#pragma unroll
    for (int i = 0; i < 16; ++i) { const float e = __builtin_amdgcn_exp2f(fminf(-z[i], 80.0f)); float sig = __builtin_amdgcn_rcpf(1.0f + e); float mm = e * sig;
        if (DIAG) { const bool act = ((i & 3) + 8 * (i >> 2) + 4 * hh) < ql; sig = act ? sig : 0.f; mm = act ? mm : 1.0f; }
        sg[i] = sig; m[i] = mm; }
    float g[4], gp[4];
#pragma unroll
    for (int bq = 0; bq < 4; ++bq) { g[bq] = (m[4 * bq] * m[4 * bq + 1]) * (m[4 * bq + 2] * m[4 * bq + 3]); gp[bq] = xlane32(g[bq], hh); }
    float outer[4]; float tb = R;
#pragma unroll
    for (int bq = 3; bq >= 0; --bq) { outer[bq] = hh == 0 ? tb * gp[bq] : tb; tb *= g[bq] * gp[bq]; }
    R = tb;
    float w[16];
#pragma unroll
    for (int bq = 0; bq < 4; ++bq) { const float s3 = outer[bq], s2 = s3 * m[4 * bq + 3], s1 = s2 * m[4 * bq + 2], s0 = s1 * m[4 * bq + 1];
        w[4 * bq + 3] = sg[4 * bq + 3] * s3; w[4 * bq + 2] = sg[4 * bq + 2] * s2; w[4 * bq + 1] = sg[4 * bq + 1] * s1; w[4 * bq] = sg[4 * bq] * s0; }
    bf16x8 wf[2];
#pragma unroll
    for (int s2 = 0; s2 < 2; ++s2) { const u32x4 pw = {cpk2(w[8 * s2], w[8 * s2 + 1]), cpk2(w[8 * s2 + 2], w[8 * s2 + 3]), cpk2(w[8 * s2 + 4], w[8 * s2 + 5]), cpk2(w[8 * s2 + 6], w[8 * s2 + 7])}; wf[s2] = __builtin_bit_cast(bf16x8, pw); }
    o0 = __builtin_amdgcn_mfma_f32_32x32x16_bf16(vc[0], wf[0], o0, 0, 0, 0); o0 = __builtin_amdgcn_mfma_f32_32x32x16_bf16(vc[1], wf[1], o0, 0, 0, 0);
    o1 = __builtin_amdgcn_mfma_f32_32x32x16_bf16(vc[2], wf[0], o1, 0, 0, 0); o1 = __builtin_amdgcn_mfma_f32_32x32x16_bf16(vc[3], wf[1], o1, 0, 0, 0);
}
__device__ __forceinline__ void attn_item_mfma(bf16_t* P, const bf16_t* Vt, int bh, int qt, int lane) {
    asm volatile("" : "+v"(lane));
    const int b = bh >> 3, h = bh & 7, ql = lane & 31, hh = lane >> 5, q0 = qt * 32;
    bf16_t* qrow = P + (size_t)(b * SEQ + q0 + ql) * NIN + C_QSB + h * 64;
    bf16x8 qf[4];
#pragma unroll
    for (int s = 0; s < 4; ++s) qf[s] = *(const bf16x8*)(qrow + 16 * s + 8 * hh);
    f32x16 o0, o1;
#pragma unroll
    for (int i = 0; i < 16; ++i) { o0[i] = 0.f; o1[i] = 0.f; }
    float R = 1.0f;
    const bf16_t* kb = P + (size_t)(b * SEQ + ql) * NIN + C_KSB + h * 64 + 8 * hh;
    const bf16_t* vb = Vt + ((size_t)bh * 64 + ql) * SEQ + 8 * hh;
    bf16x8 kf[4], vf[4], vn[4];
#define AT_LOADK(k0_) do { _Pragma("unroll") for (int s = 0; s < 4; ++s) kf[s] = *(const bf16x8*)(kb + (size_t)(k0_) * NIN + 16 * s); } while (0)
#define AT_LOADV(dst, k0_) do { _Pragma("unroll") for (int j = 0; j < 4; ++j) dst[j] = *(const bf16x8*)(vb + (size_t)(j >> 1) * 32 * SEQ + (k0_) + 16 * (j & 1)); } while (0)
#define AT_QK(zz) do { _Pragma("unroll") for (int i = 0; i < 16; ++i) zz[i] = 0.f; _Pragma("unroll") for (int s = 0; s < 4; ++s) zz = __builtin_amdgcn_mfma_f32_32x32x16_bf16(kf[s], qf[s], zz, 0, 0, 0); } while (0)
    f32x16 zc, zn;
    AT_LOADK(q0); AT_LOADV(vf, q0);
    AT_QK(zc);
    { const int k1 = (qt > 0 ? qt - 1 : 0) * 32; AT_LOADK(k1); AT_LOADV(vn, k1); }
    { AT_QK(zn);
      const int k2 = (qt > 1 ? qt - 2 : 0) * 32; AT_LOADK(k2);
      attn_tile<true>(zc, vf, o0, o1, R, ql, hh);
      zc = zn;
#pragma unroll
      for (int j = 0; j < 4; ++j) vf[j] = vn[j];
      const int k1 = (qt > 1 ? qt - 2 : 0) * 32; AT_LOADV(vn, k1); }
#pragma unroll 1
    for (int kt = qt - 1; kt >= 0; --kt) {
        AT_QK(zn);
        const int k2 = (kt > 1 ? kt - 2 : 0) * 32; AT_LOADK(k2);
        attn_tile<false>(zc, vf, o0, o1, R, ql, hh);
        if (__builtin_amdgcn_ballot_w64(R != 0.0f) == 0ull) break;
        zc = zn;
#pragma unroll
        for (int j = 0; j < 4; ++j) vf[j] = vn[j];
        AT_LOADV(vn, k2);
    }
#undef AT_LOADK
#undef AT_LOADV
#undef AT_QK
#pragma unroll
    for (int bq = 0; bq < 4; ++bq) {
        u32x2 w0 = {cpk2(o0[4 * bq], o0[4 * bq + 1]), cpk2(o0[4 * bq + 2], o0[4 * bq + 3])}, w1 = {cpk2(o1[4 * bq], o1[4 * bq + 1]), cpk2(o1[4 * bq + 2], o1[4 * bq + 3])};
        *(u32x2*)(qrow + 8 * bq + 4 * hh) = w0; *(u32x2*)(qrow + 32 + 8 * bq + 4 * hh) = w1; }
}
__device__ __forceinline__ size_t slotU(size_t t0, int h, int colbase, int f) { return (t0 + (size_t)(f >> 7)) * D + colbase + h * 128 + (f & 127); }
__device__ __forceinline__ size_t slotP(size_t t0, int h, int colbase, int f) { return (t0 + (size_t)(f >> 7)) * NIN + colbase + h * 128 + (f & 127); }
__device__ __forceinline__ int permpos(int x) { const int k = x & 15; return (x & ~15) + 8 * ((k >> 2) & 1) + 4 * (k >> 3) + (k & 3); }
__device__ __forceinline__ int crow(int r, int hh) { return (r & 3) + 8 * (r >> 2) + 4 * hh; }
__device__ __forceinline__ bf16x8 pack8(const f32x16& x, int s2) {
    const u32x4 pw = {cpk2(x[8 * s2], x[8 * s2 + 1]), cpk2(x[8 * s2 + 2], x[8 * s2 + 3]), cpk2(x[8 * s2 + 4], x[8 * s2 + 5]), cpk2(x[8 * s2 + 6], x[8 * s2 + 7])};
    return __builtin_bit_cast(bf16x8, pw);
}
#define MFMA32(a, b, c) __builtin_amdgcn_mfma_f32_32x32x16_bf16((a), (b), (c), 0, 0, 0)
constexpr int PT = 72, PQ = 136, PL = 68, PB = 40;
constexpr int CP_GC = 0, CP_BT = 256, CP_LS = 1024, CP_TU = CP_LS + 64 * PL * 4, CP_TW = CP_TU + 64 * PT * 2, CP_KT = CP_TW + 64 * PT * 2, CP_VT = CP_KT + 128 * PT * 2,
              CP_QS = CP_VT + 128 * PT * 2, CP_KS = CP_QS + 64 * PQ * 2, CP_AQ = CP_KS + 64 * PQ * 2, CP_L21 = CP_AQ + 64 * PT * 2, CP_TCM = CP_L21 + 32 * PB * 2, CP_T22 = CP_TCM + 32 * PB * 2, CP_END = CP_T22 + 32 * PB * 2;
static_assert(CP_END <= 131072, "chunk prep LDS");
__device__ __forceinline__ void gdn_chunk_prep_phase(const Params& p, LAS unsigned char* lds, int tid, int wave, int lane) {
    bf16_t* P = (bf16_t*)(p.ws + WS_P); bf16_t* U = (bf16_t*)(p.ws + WS_U); const float* BG = (const float*)(p.ws + WS_BG);
    u32x4 ka, kb, qa, qb, xv[4][2]; float gx = 0.f, gbt = 0.f;
#define CP_LOAD(item_) do { const int bh_ = (item_) >> 5, n_ = (item_) & 31, b_ = bh_ >> 2, h_ = bh_ & 3; const size_t t0_ = (size_t)b_ * SEQ + n_ * 64; const int tok_ = tid & 63, c16_ = (tid >> 6) * 16; \
        ka = *(const u32x4*)(U + (t0_ + tok_) * D + 512 + h_ * 128 + c16_); kb = *(const u32x4*)(U + (t0_ + tok_) * D + 512 + h_ * 128 + c16_ + 8); \
        qa = *(const u32x4*)(U + (t0_ + tok_) * D + h_ * 128 + c16_); qb = *(const u32x4*)(U + (t0_ + tok_) * D + h_ * 128 + c16_ + 8); \
        _Pragma("unroll") for (int i = 0; i < 4; ++i) { const bool ok = n_ * 64 + tok_ - 3 + i >= 0; const bf16_t* vp = P + (t0_ + tok_ - 3 + i) * NIN + C_VDN + h_ * 128 + c16_; \
            xv[i][0] = ok ? *(const u32x4*)vp : (u32x4){0u, 0u, 0u, 0u}; xv[i][1] = ok ? *(const u32x4*)(vp + 8) : (u32x4){0u, 0u, 0u, 0u}; } \
        if (tid < 64) { gx = BG[(t0_ + tid) * 8 + 4 + h_]; gbt = BG[(t0_ + tid) * 8 + h_]; } } while (0)
    if ((int)blockIdx.x < 1024) CP_LOAD((int)blockIdx.x);
  for (int item = blockIdx.x; item < 1024; item += gridDim.x) {
    asm volatile("" : "+v"(tid), "+v"(lane));
    const int bh = item >> 5, n = item & 31, b = bh >> 2, h = bh & 3, ql = lane & 31, hh = lane >> 5;
    const size_t t0 = (size_t)b * SEQ + n * 64;
    LAS float* gcS = (LAS float*)(lds + CP_GC); LAS float* btS = (LAS float*)(lds + CP_BT);
    LAS float* LS = (LAS float*)(lds + CP_LS);
    LAS bf16_t* TuS = (LAS bf16_t*)(lds + CP_TU); LAS bf16_t* TwS = (LAS bf16_t*)(lds + CP_TW);
    LAS bf16_t* kT = (LAS bf16_t*)(lds + CP_KT); LAS bf16_t* vT = (LAS bf16_t*)(lds + CP_VT); LAS bf16_t* qS = (LAS bf16_t*)(lds + CP_QS); LAS bf16_t* kS = (LAS bf16_t*)(lds + CP_KS);
    LAS bf16_t* AQ = (LAS bf16_t*)(lds + CP_AQ); LAS bf16_t* L21b = (LAS bf16_t*)(lds + CP_L21); LAS bf16_t* Tcm = (LAS bf16_t*)(lds + CP_TCM); LAS bf16_t* T22r = (LAS bf16_t*)(lds + CP_T22);
    if (tid < 64) { float x = gx;
#pragma unroll
        for (int o = 1; o < 64; o <<= 1) { const float y = __shfl_up(x, o); if (lane >= o) x += y; }
        gcS[tid] = x; btS[tid] = gbt; }
    { const int tok = tid & 63, c16 = (tid >> 6) * 16;
        *(LAS u32x4*)(kS + tok * PQ + c16) = ka; *(LAS u32x4*)(kS + tok * PQ + c16 + 8) = kb;
        *(LAS u32x4*)(qS + tok * PQ + c16) = qa; *(LAS u32x4*)(qS + tok * PQ + c16 + 8) = qb;
        const unsigned kw[8] = {ka.x, ka.y, ka.z, ka.w, kb.x, kb.y, kb.z, kb.w};
#pragma unroll
        for (int e = 0; e < 8; ++e) { kT[(c16 + 2 * e) * PT + tok] = (bf16_t)(kw[e] & 0xffffu); kT[(c16 + 2 * e + 1) * PT + tok] = (bf16_t)(kw[e] >> 16); }
        float y[16];
#pragma unroll
        for (int e = 0; e < 16; ++e) y[e] = 0.f;
#pragma unroll
        for (int i = 0; i < 4; ++i) { const float* wp = p.in[I_WCONV] + i * 1536 + 1024 + h * 128 + c16;
            const unsigned xw[8] = {xv[i][0].x, xv[i][0].y, xv[i][0].z, xv[i][0].w, xv[i][1].x, xv[i][1].y, xv[i][1].z, xv[i][1].w};
#pragma unroll
            for (int e = 0; e < 8; ++e) { y[2 * e] += wp[2 * e] * bf_lo(xw[e]); y[2 * e + 1] += wp[2 * e + 1] * bf_hi(xw[e]); } }
#pragma unroll
        for (int e = 0; e < 16; ++e) vT[(c16 + e) * PT + tok] = f2bf(fsilu(y[e])); }
    __syncthreads();
    if (item + (int)gridDim.x < 1024) CP_LOAD(item + (int)gridDim.x);
    if (wave == 0 || wave == 4 || wave == 5) {
        const int it = wave == 0 ? 0 : 1, jt = wave == 4 ? 1 : 0;
        f32x16 acc;
#pragma unroll
        for (int r = 0; r < 16; ++r) acc[r] = 0.f;
#pragma unroll
        for (int ks = 0; ks < 8; ++ks) acc = MFMA32(*(const LAS bf16x8*)(kS + (32 * it + ql) * PQ + 16 * ks + 8 * hh), *(const LAS bf16x8*)(kS + (32 * jt + ql) * PQ + 16 * ks + 8 * hh), acc);
        const int j = 32 * jt + ql; const float gj = gcS[j];
#pragma unroll
        for (int r = 0; r < 16; ++r) { const int i = 32 * it + crow(r, hh); const float l = (j < i) ? btS[i] * acc[r] * fexp(gcS[i] - gj) : 0.f;
            if (it != jt) L21b[(i - 32) * PB + j] = f2bf(l); else LS[i * PL + j] = l; }
    } else if (wave < 4) {
        const int jt = wave == 3 ? 1 : 0, it = wave == 1 ? 0 : 1;
        f32x16 acc;
#pragma unroll
        for (int r = 0; r < 16; ++r) acc[r] = 0.f;
#pragma unroll
        for (int ks = 0; ks < 8; ++ks) acc = MFMA32(*(const LAS bf16x8*)(kS + (32 * jt + ql) * PQ + 16 * ks + 8 * hh), *(const LAS bf16x8*)(qS + (32 * it + ql) * PQ + 16 * ks + 8 * hh), acc);
        const int i = 32 * it + ql; const float gi = gcS[i];
#pragma unroll
        for (int r = 0; r < 16; ++r) { const int j = 32 * jt + crow(r, hh); acc[r] = (j <= i) ? acc[r] * fexp(gi - gcS[j]) : 0.f; }
#pragma unroll
        for (int bq = 0; bq < 4; ++bq) *(LAS u32x2*)(AQ + i * PT + 32 * jt + 8 * bq + 4 * hh) = (u32x2){cpk2(acc[4 * bq], acc[4 * bq + 1]), cpk2(acc[4 * bq + 2], acc[4 * bq + 3])};
    } else {
        const float gl = gcS[63];
#pragma unroll
        for (int uu = 0; uu < 4; ++uu) { const int unit = (tid - 384) + 128 * uu, dk = unit >> 2, blk = unit & 3;
            const u32x4 k0 = *(const LAS u32x4*)(kT + dk * PT + 16 * blk), k1 = *(const LAS u32x4*)(kT + dk * PT + 16 * blk + 8);
            float kv[16] = {bf_lo(k0.x), bf_hi(k0.x), bf_lo(k0.y), bf_hi(k0.y), bf_lo(k0.z), bf_hi(k0.z), bf_lo(k0.w), bf_hi(k0.w), bf_lo(k1.x), bf_hi(k1.x), bf_lo(k1.y), bf_hi(k1.y), bf_lo(k1.z), bf_hi(k1.z), bf_lo(k1.w), bf_hi(k1.w)};
#pragma unroll
            for (int e = 0; e < 16; ++e) kv[e] *= fexp(gl - gcS[16 * blk + e]);
            float pv[16];
#pragma unroll
            for (int e = 0; e < 16; ++e) pv[permpos(e)] = kv[e];
            pack16(P + slotP(t0, h, C_VSB, dk * 64 + 16 * blk), pv); }
        if (tid == 384) ((float*)(p.ws + WS_EGL))[bh * 32 + n] = fexp(gl);
    }
    __syncthreads();
    if (wave == 0) {
        const LAS float* LB = LS + (32 * hh) * PL + 32 * hh;
        float Tc[32];
        f32x4 lc[8], ln[8];
        Tc[0] = (ql == 0) ? 1.0f : 0.f;
        lc[0] = *(const LAS f32x4*)(LB + 1 * PL);
#pragma unroll
        for (int i = 1; i < 32; ++i) {
            if (i + 1 < 32) {
#pragma unroll
                for (int j4 = 0; j4 < i + 1; j4 += 4) ln[j4 >> 2] = *(const LAS f32x4*)(LB + (i + 1) * PL + j4); }
            float a0 = (ql == i) ? 1.0f : 0.f, a1 = 0.f, a2 = 0.f, a3 = 0.f;
#pragma unroll
            for (int j4 = 0; j4 < i; j4 += 4) { const f32x4 l4 = lc[j4 >> 2];
                a0 -= l4[0] * Tc[j4]; if (j4 + 1 < i) a1 -= l4[1] * Tc[j4 + 1]; if (j4 + 2 < i) a2 -= l4[2] * Tc[j4 + 2]; if (j4 + 3 < i) a3 -= l4[3] * Tc[j4 + 3]; }
            Tc[i] = (a0 + a1) + (a2 + a3);
#pragma unroll
            for (int q = 0; q < 8; ++q) lc[q] = ln[q]; }
        const int cg_ = 32 * hh + ql; const float bu = btS[cg_], bw = bu * fexp(gcS[cg_]);
#pragma unroll
        for (int i = 0; i < 32; ++i) { TuS[(32 * hh + i) * PT + cg_] = f2bf(Tc[i] * bu); TwS[(32 * hh + i) * PT + cg_] = f2bf(Tc[i] * bw); }
        if (hh == 0) {
#pragma unroll
            for (int i8 = 0; i8 < 4; ++i8) *(LAS u32x4*)(Tcm + ql * PB + 8 * i8) = (u32x4){cpk2(Tc[8 * i8], Tc[8 * i8 + 1]), cpk2(Tc[8 * i8 + 2], Tc[8 * i8 + 3]), cpk2(Tc[8 * i8 + 4], Tc[8 * i8 + 5]), cpk2(Tc[8 * i8 + 6], Tc[8 * i8 + 7])};
        } else {
#pragma unroll
            for (int i = 0; i < 32; ++i) T22r[i * PB + ql] = f2bf(Tc[i]);
        }
        LDS_WAIT();
        f32x16 x1;
#pragma unroll
        for (int r = 0; r < 16; ++r) x1[r] = 0.f;
#pragma unroll
        for (int s2 = 0; s2 < 2; ++s2) x1 = MFMA32(*(const LAS bf16x8*)(L21b + ql * PB + 16 * s2 + 8 * hh), *(const LAS bf16x8*)(Tcm + ql * PB + 16 * s2 + 8 * hh), x1);
        f32x16 yy;
#pragma unroll
        for (int r = 0; r < 16; ++r) yy[r] = 0.f;
#pragma unroll
        for (int s2 = 0; s2 < 2; ++s2) { const u32x2 lo = *(const LAS u32x2*)(T22r + ql * PB + 16 * s2 + 4 * hh), hi = *(const LAS u32x2*)(T22r + ql * PB + 16 * s2 + 8 + 4 * hh);
            const u32x4 af = {lo.x, lo.y, hi.x, hi.y};
            yy = MFMA32(__builtin_bit_cast(bf16x8, af), pack8(x1, s2), yy); }
        { const float bu0 = btS[ql], bw0 = bu0 * fexp(gcS[ql]);
#pragma unroll
            for (int r = 0; r < 16; ++r) { const int i2 = 32 + crow(r, hh); TuS[i2 * PT + ql] = f2bf(-yy[r] * bu0); TwS[i2 * PT + ql] = f2bf(-yy[r] * bw0); } }
    }
    __syncthreads();
    {
        const int isW = wave >> 2, ct = wave & 3, col = 32 * ct + ql;
        const LAS bf16_t* Ta = (isW ? TwS : TuS) + 8 * hh; const LAS bf16_t* Bs = (isW ? kT : vT) + col * PT + 8 * hh;
        bf16x8 bf[4];
#pragma unroll
        for (int ks = 0; ks < 4; ++ks) bf[ks] = *(const LAS bf16x8*)(Bs + 16 * ks);
        f32x16 xa[2];
#pragma unroll
        for (int jt = 0; jt < 2; ++jt) {
#pragma unroll
            for (int r = 0; r < 16; ++r) xa[jt][r] = 0.f;
#pragma unroll
            for (int ks = 0; ks < 4; ++ks) if (jt == 1 || ks < 2) xa[jt] = MFMA32(*(const LAS bf16x8*)(Ta + (32 * jt + ql) * PT + 16 * ks), bf[ks], xa[jt]); }
        bf16x8 xb[4] = {pack8(xa[0], 0), pack8(xa[0], 1), pack8(xa[1], 0), pack8(xa[1], 1)};
        f32x16 ra[2];
#pragma unroll
        for (int it = 0; it < 2; ++it) {
#pragma unroll
            for (int r = 0; r < 16; ++r) ra[it][r] = 0.f;
#pragma unroll
            for (int kk = 0; kk < 4; ++kk) if (it == 1 || kk < 2) { const LAS bf16_t* ap = AQ + (32 * it + ql) * PT + 16 * kk + 4 * hh;
                const u32x2 lo = *(const LAS u32x2*)ap, hi = *(const LAS u32x2*)(ap + 8); const u32x4 af = {lo.x, lo.y, hi.x, hi.y};
                ra[it] = MFMA32(__builtin_bit_cast(bf16x8, af), xb[kk], ra[it]); } }
        if (!isW) {
#pragma unroll
            for (int jt = 0; jt < 2; ++jt)
#pragma unroll
                for (int bq = 0; bq < 4; ++bq) { const int f = col * 64 + 32 * jt + 8 * bq + 4 * hh;
                    *(u32x2*)(U + slotU(t0, h, 0, f)) = (u32x2){cpk2(xa[jt][4 * bq], xa[jt][4 * bq + 1]), cpk2(xa[jt][4 * bq + 2], xa[jt][4 * bq + 3])};
                    *(u32x2*)(U + slotU(t0, h, 512, f)) = (u32x2){cpk2(ra[jt][4 * bq], ra[jt][4 * bq + 1]), cpk2(ra[jt][4 * bq + 2], ra[jt][4 * bq + 3])}; }
        } else {
            const int pc = permpos(col);
#pragma unroll
            for (int jt = 0; jt < 2; ++jt)
#pragma unroll
                for (int r = 0; r < 16; ++r) { const int tok = 32 * jt + crow(r, hh);
                    P[(t0 + tok) * NIN + C_QDN + h * 128 + pc] = f2bf(-xa[jt][r]);
                    P[(t0 + tok) * NIN + C_KDN + h * 128 + pc] = f2bf(bf2f(qS[tok * PQ + col]) * fexp(gcS[tok]) - ra[jt][r]); }
        }
    }
    __syncthreads();
  }
#undef CP_LOAD
}
constexpr int SC_PW = 136, SC_PK = 72, SC_NW = 0, SC_Q2 = 64 * SC_PW * 2, SC_KD = 2 * 64 * SC_PW * 2, SC_STAGE = 2 * 64 * SC_PW * 2 + 128 * SC_PK * 2, SC_OS = 2 * SC_STAGE,
              SC_US = SC_OS + 128 * SC_PK * 2, SC_OI = SC_US + 128 * SC_PK * 2, SC_END = SC_OI + 128 * SC_PK * 2;
static_assert(SC_END <= BST_OFF, "scan LDS");
__device__ __forceinline__ void gdn_scan_block(const Params& p, LAS unsigned char* lds, int bh, int tid, int wave, int lane) {
    asm volatile("" : "+v"(tid), "+v"(lane));
    bf16_t* P = (bf16_t*)(p.ws + WS_P); const bf16_t* U = (const bf16_t*)(p.ws + WS_U); const float* EGL = (const float*)(p.ws + WS_EGL);
    const int b = bh >> 2, h = bh & 3, ql = lane & 31, hh = lane >> 5;
    const size_t tb = (size_t)b * SEQ;
    LAS bf16_t* oS = (LAS bf16_t*)(lds + SC_OS);
    if (wave >= 4) {
        int lt = tid - 256, ftok = lt >> 2, fseg = lt & 3;
        u32x4 ra[20], rb[20];
#define SC_LOAD(r, n_) do { const size_t t0_ = tb + (size_t)(n_) * 64; _Pragma("unroll") for (int i = 0; i < 4; ++i) { const int c = lt + 256 * i, row = c >> 4, c8 = (c & 15) * 8; \
            const bf16_t* g_ = P + (t0_ + row) * NIN + h * 128 + c8; const bf16_t* u_ = U + (t0_ + row) * D + h * 128 + c8; \
            r[i] = *(const u32x4*)(g_ + C_QDN); r[4 + i] = *(const u32x4*)(g_ + C_KDN); r[8 + i] = *(const u32x4*)(g_ + C_VSB); r[12 + i] = *(const u32x4*)u_; r[16 + i] = *(const u32x4*)(u_ + 512); } } while (0)
#define SC_STORE(r, st_) do { LAS unsigned char* s_ = lds + (st_) * SC_STAGE; _Pragma("unroll") for (int i = 0; i < 4; ++i) { const int c = lt + 256 * i, row = c >> 4, c8 = (c & 15) * 8; \
            *(LAS u32x4*)(s_ + SC_NW + (row * SC_PW + c8) * 2) = r[i]; *(LAS u32x4*)(s_ + SC_Q2 + (row * SC_PW + c8) * 2) = r[4 + i]; \
            *(LAS u32x4*)(s_ + SC_KD + ((2 * row + (c8 >> 6)) * SC_PK + (c8 & 63)) * 2) = r[8 + i]; } } while (0)
#define SC_STOREU(r) do { _Pragma("unroll") for (int i = 0; i < 4; ++i) { const int c = lt + 256 * i, row = c >> 4, c8 = (c & 15) * 8; const int o_ = ((2 * row + (c8 >> 6)) * SC_PK + (c8 & 63)) * 2; \
            *(LAS u32x4*)(lds + SC_US + o_) = r[12 + i]; *(LAS u32x4*)(lds + SC_OI + o_) = r[16 + i]; } } while (0)
#define SC_FIN(m_) do { bf16_t* orow = P + (tb + (size_t)(m_) * 64 + ftok) * NIN + h * 128 + fseg * 32 + C_VDN; \
            _Pragma("unroll") for (int i = 0; i < 4; ++i) { unsigned w_[4]; \
                _Pragma("unroll") for (int j = 0; j < 4; ++j) { const int c_ = fseg * 32 + 8 * i + 2 * j; w_[j] = (unsigned)oS[c_ * SC_PK + ftok] | ((unsigned)oS[(c_ + 1) * SC_PK + ftok] << 16); } \
                *(u32x4*)(orow + 8 * i) = (u32x4){w_[0], w_[1], w_[2], w_[3]}; } } while (0)
        SC_LOAD(ra, 0); SC_STORE(ra, 0); SC_STOREU(ra); SC_LOAD(ra, 1);
        __syncthreads();
#pragma unroll 1
        for (int n = 0; n < 32; n += 2) {
            asm volatile("" : "+v"(lt), "+v"(ftok), "+v"(fseg));
            if (n + 2 < 32) SC_LOAD(rb, n + 2);
            SC_STORE(ra, 1);
            if (n > 0) SC_FIN(n - 1);
            __syncthreads();
            SC_STOREU(ra);
            __syncthreads();
            if (n + 3 < 32) SC_LOAD(ra, n + 3);
            if (n + 2 < 32) SC_STORE(rb, 0);
            SC_FIN(n);
            __syncthreads();
            if (n + 2 < 32) SC_STOREU(rb);
            __syncthreads();
        }
        SC_FIN(31);
#undef SC_LOAD
#undef SC_STORE
#undef SC_STOREU
#undef SC_FIN
    } else {
        const int col = 32 * wave + ql;
        f32x16 S[4];
#pragma unroll
        for (int rt = 0; rt < 4; ++rt)
#pragma unroll
            for (int r = 0; r < 16; ++r) S[rt][r] = 0.f;
        const float eglv = EGL[bh * 32 + ql];
        __syncthreads();
#pragma unroll 1
        for (int n = 0; n < 32; ++n) {
            const float egl = __builtin_bit_cast(float, __builtin_amdgcn_readlane(__builtin_bit_cast(int, eglv), n));
            const LAS unsigned char* st = lds + (n & 1) * SC_STAGE;
            f32x16 vn[2], oa[2];
            { const LAS unsigned char* up_ = lds + SC_US + (col * SC_PK + 4 * hh) * 2; const LAS unsigned char* op_ = lds + SC_OI + (col * SC_PK + 4 * hh) * 2;
#pragma unroll
              for (int jt = 0; jt < 2; ++jt)
#pragma unroll
                for (int bq = 0; bq < 4; ++bq) { const u32x2 uw = *(const LAS u32x2*)(up_ + (32 * jt + 8 * bq) * 2), ow = *(const LAS u32x2*)(op_ + (32 * jt + 8 * bq) * 2);
                    vn[jt][4 * bq] = bf_lo(uw.x); vn[jt][4 * bq + 1] = bf_hi(uw.x); vn[jt][4 * bq + 2] = bf_lo(uw.y); vn[jt][4 * bq + 3] = bf_hi(uw.y);
                    oa[jt][4 * bq] = bf_lo(ow.x); oa[jt][4 * bq + 1] = bf_hi(ow.x); oa[jt][4 * bq + 2] = bf_lo(ow.y); oa[jt][4 * bq + 3] = bf_hi(ow.y); } }
            const LAS unsigned char* w0_ = st + (ql * SC_PW + 8 * hh) * 2; const LAS unsigned char* w1_ = w0_ + 32 * SC_PW * 2;
            const LAS unsigned char* kd_ = st + SC_KD + (ql * SC_PK + 8 * hh) * 2;
            bf16x8 fa[4], fb[4];
#define SC_RD4(dst, ptr) do { _Pragma("unroll") for (int i_ = 0; i_ < 4; ++i_) dst[i_] = *(const LAS bf16x8*)((ptr) + 32 * i_); } while (0)
#define SC_MM4(acc, fr, bb) do { _Pragma("unroll") for (int i_ = 0; i_ < 4; ++i_) acc = MFMA32(fr[i_], bb[i_], acc); __builtin_amdgcn_sched_barrier(0); } while (0)
            SC_RD4(fa, w0_ + SC_NW); SC_RD4(fb, w1_ + SC_NW);
            { bf16x8 sb[4] = {pack8(S[0], 0), pack8(S[0], 1), pack8(S[1], 0), pack8(S[1], 1)};
              SC_MM4(vn[0], fa, sb); SC_RD4(fa, w0_ + SC_Q2);
              SC_MM4(vn[1], fb, sb); SC_RD4(fb, w1_ + SC_Q2);
              SC_MM4(oa[0], fa, sb); SC_RD4(fa, w0_ + SC_NW + 128);
              SC_MM4(oa[1], fb, sb); SC_RD4(fb, w1_ + SC_NW + 128); }
            { bf16x8 sb[4] = {pack8(S[2], 0), pack8(S[2], 1), pack8(S[3], 0), pack8(S[3], 1)};
              SC_MM4(vn[0], fa, sb); SC_RD4(fa, w0_ + SC_Q2 + 128);
              SC_MM4(vn[1], fb, sb); SC_RD4(fb, w1_ + SC_Q2 + 128);
              bf16x8 vb[4] = {pack8(vn[0], 0), pack8(vn[0], 1), pack8(vn[1], 0), pack8(vn[1], 1)};
              SC_MM4(oa[0], fa, sb); SC_RD4(fa, kd_);
              SC_MM4(oa[1], fb, sb); SC_RD4(fb, kd_ + 32 * SC_PK * 2);
#pragma unroll
              for (int rt = 0; rt < 4; ++rt)
#pragma unroll
                  for (int r = 0; r < 16; ++r) S[rt][r] *= egl;
              SC_MM4(S[0], fa, vb); SC_RD4(fa, kd_ + 64 * SC_PK * 2);
              SC_MM4(S[1], fb, vb); SC_RD4(fb, kd_ + 96 * SC_PK * 2);
              SC_MM4(S[2], fa, vb);
              SC_MM4(S[3], fb, vb); }
#undef SC_RD4
#undef SC_MM4
            __syncthreads();
#pragma unroll
            for (int jt = 0; jt < 2; ++jt)
#pragma unroll
                for (int bq = 0; bq < 4; ++bq) *(LAS u32x2*)(oS + col * SC_PK + 32 * jt + 8 * bq + 4 * hh) = (u32x2){cpk2(oa[jt][4 * bq], oa[jt][4 * bq + 1]), cpk2(oa[jt][4 * bq + 2], oa[jt][4 * bq + 3])};
            __syncthreads();
        }
    }
}
__device__ __forceinline__ void gdn_finalize_phase(const Params& p, int wave, int lane) {
    asm volatile("" : "+v"(lane));
    bf16_t* P = (bf16_t*)(p.ws + WS_P);
    const int c0 = (lane & 15) * 8;
    float gg[8];
#pragma unroll
    for (int e = 0; e < 8; ++e) gg[e] = p.in[I_GDNOUT][c0 + e];
    for (int row = blockIdx.x * 8 + wave; row < T; row += gridDim.x * 8) {
        bf16_t* op = P + (size_t)row * NIN + C_VDN + lane * 8; const bf16_t* zp = P + (size_t)row * NIN + C_ZDN + lane * 8;
        const u32x4 ow = *(const u32x4*)op, zw = *(const u32x4*)zp;
        const float o[8] = {bf_lo(ow.x), bf_hi(ow.x), bf_lo(ow.y), bf_hi(ow.y), bf_lo(ow.z), bf_hi(ow.z), bf_lo(ow.w), bf_hi(ow.w)};
        const float z[8] = {bf_lo(zw.x), bf_hi(zw.x), bf_lo(zw.y), bf_hi(zw.y), bf_lo(zw.z), bf_hi(zw.z), bf_lo(zw.w), bf_hi(zw.w)};
        float ss = 0.f;
#pragma unroll
        for (int e = 0; e < 8; ++e) ss += o[e] * o[e];
        ss += __shfl_xor(ss, 1); ss += __shfl_xor(ss, 2); ss += __shfl_xor(ss, 4); ss += __shfl_xor(ss, 8);
        const float rstd = 1.0f / sqrtf(ss * (1.f / 128.f) + EPS);
        float r[8];
#pragma unroll
        for (int e = 0; e < 8; ++e) r[e] = o[e] * rstd * gg[e] * fsilu(z[e]);
        u32x4 w; w.x = pk2(r[0], r[1]); w.y = pk2(r[2], r[3]); w.z = pk2(r[4], r[5]); w.w = pk2(r[6], r[7]);
        *(u32x4*)op = w;
    }
}

#define XB_TMO      128
#define XB_XCNT(j)  (256  + 64 * (j))
#define XB_XSUB(j)  (1280 + 64 * (j))
#define XB_XGEN(j)  (2304 + 64 * (j))
#define XB_TOP      3328
#define XB_TOPGEN   3392
#define XCD_BAR_WORDS 3456
#define XB_SPIN_CAP (1u << 18)
__device__ __forceinline__ unsigned xb_ld(unsigned* p)              { return __hip_atomic_load(p, __ATOMIC_RELAXED, __HIP_MEMORY_SCOPE_AGENT); }
__device__ __forceinline__ unsigned xb_add(unsigned* p, unsigned v) { return __hip_atomic_fetch_add(p, v, __ATOMIC_RELAXED, __HIP_MEMORY_SCOPE_AGENT); }
__device__ __forceinline__ unsigned xb_xcc_id() { return (unsigned)__builtin_amdgcn_s_getreg((3 << 11) | 20) & 0xFu; }
#define XB_SPIN(cond, bar) do { unsigned _sp = 0; while (cond) { __builtin_amdgcn_s_sleep(1); \
    if ((++_sp & 255u) == 0u) { if (xb_ld(&(bar)[XB_TMO])) break; if (_sp > XB_SPIN_CAP) { atomicAdd(&(bar)[XB_TMO], 1u); break; } } } } while (0)
struct XcdBarrier { unsigned* bar; unsigned x; volatile LAS unsigned* st; };
__device__ __forceinline__ XcdBarrier xcd_barrier_post(unsigned* bar, volatile LAS unsigned* st) {
    XcdBarrier b; b.bar = bar; b.x = xb_xcc_id(); b.st = st;
    if (threadIdx.x == 0) (void)xb_add(&bar[XB_XCNT(b.x)], 1u);
    return b;
}
__device__ __forceinline__ void xcd_barrier_complete(unsigned* bar, unsigned x, unsigned& nloc, unsigned& nx) {
    const unsigned G = gridDim.x * gridDim.y * gridDim.z;
    unsigned sum, cnt, mine, sp = 0u;
    for (;;) {
        sum = 0u; cnt = 0u; mine = 0u;
#pragma unroll
        for (unsigned j = 0; j < 16; ++j) { const unsigned c = xb_ld(&bar[XB_XCNT(j)]); sum += c; cnt += (c > 0u) ? 1u : 0u; mine = (j == x) ? c : mine; }
        if (sum == G) break;
        __builtin_amdgcn_s_sleep(1);
        if ((++sp & 255u) == 0u) { if (xb_ld(&bar[XB_TMO])) break; if (sp > XB_SPIN_CAP) { atomicAdd(&bar[XB_TMO], 1u); break; } }
    }
    nloc = mine > 0u ? mine : 1u; nx = cnt > 0u ? cnt : 1u;
}
__device__ __forceinline__ void xcd_barrier(const XcdBarrier& b) {
    asm volatile("s_waitcnt vmcnt(0)" ::: "memory");
    __syncthreads();
    if (threadIdx.x == 0) {
        unsigned* bar = b.bar;
        __builtin_amdgcn_s_waitcnt(0);
        unsigned nloc = b.st[0], nx = b.st[1];
        if (nloc == 0u) { xcd_barrier_complete(bar, b.x, nloc, nx); b.st[0] = nloc; b.st[1] = nx; }
        const unsigned old = xb_add(&bar[XB_XSUB(b.x)], 1u);
        const unsigned gen = old / nloc;
        if (old + 1u == (gen + 1u) * nloc) {
            __builtin_amdgcn_fence(__ATOMIC_RELEASE, "agent");
            asm volatile("s_waitcnt vmcnt(0)" ::: "memory");
            const unsigned og = xb_add(&bar[XB_TOP], 1u);
            const unsigned tg = og / nx;
            if (og + 1u == (tg + 1u) * nx) xb_add(&bar[XB_TOPGEN], 1u);
            else XB_SPIN(xb_ld(&bar[XB_TOPGEN]) == tg, bar);
            __builtin_amdgcn_fence(__ATOMIC_ACQUIRE, "agent");
            xb_add(&bar[XB_XGEN(b.x)], 1u);
            asm volatile("s_waitcnt vmcnt(0)" ::: "memory");
        } else {
            XB_SPIN(xb_ld(&bar[XB_XGEN(b.x)]) == gen, bar);
            __builtin_amdgcn_fence(__ATOMIC_ACQUIRE, "agent");
            asm volatile("s_waitcnt vmcnt(0)" ::: "memory");
        }
    }
    __syncthreads();
}

#ifndef PHMASK
#define PHMASK 0xFFFF
#endif
#define PH(n) ((PHMASK >> (n)) & 1)
#ifndef PROBE
#define PROBE 0
#endif
#define REP(g) for (int _rep = 0; _rep < ((PROBE == (g)) ? 2 : 1); ++_rep)
__global__ void __launch_bounds__(512, 2) fwd_megakernel(Params p) {
    extern __shared__ __attribute__((aligned(16))) unsigned char lds_raw[];
    LAS unsigned char* lds = (LAS unsigned char*)lds_raw;
    cg::grid_group grid = cg::this_grid();
    const int tid = threadIdx.x, lane = tid & 63, wave = __builtin_amdgcn_readfirstlane(tid >> 6);
    const int G = gridDim.x, gw = wave * G + blockIdx.x, ngw = G * 8;
    unsigned char* ws = p.ws;
    bf16_t* U = (bf16_t*)(ws + WS_U); bf16_t* P = (bf16_t*)(ws + WS_P);
    const float* mod = (const float*)(ws + WS_MOD);
    LAS float* scr = (LAS float*)(lds + wave * 16384);

    unsigned* barw = (unsigned*)(ws + WS_BAR);
    volatile LAS unsigned* bst = (volatile LAS unsigned*)(lds + BST_OFF);
    if (tid < 2) bst[tid] = 0u;
    __syncthreads();
    if (p.ws == nullptr) grid.sync();
    const XcdBarrier xbar = xcd_barrier_post(barw, bst);
    REP(1) { if (PH(0)) for (int it = blockIdx.x; it < NMOD / 64; it += G) mod_item(p, lds, it, tid, wave, lane);
    { const int nmod = NMOD / 64;
      if (PH(0)) { if (G >= nmod + 64) { if ((int)blockIdx.x >= nmod) ffn_weight_items(p.in[I_WFFN1IN], p.in[I_WFFN1OUT], (bf16_t*)(ws + W_FFIN), (bf16_t*)(ws + W_FFOUT), scr, wave * (G - nmod) + ((int)blockIdx.x - nmod), (G - nmod) * 8, lane); }
                   else ffn_weight_items(p.in[I_WFFN1IN], p.in[I_WFFN1OUT], (bf16_t*)(ws + W_FFIN), (bf16_t*)(ws + W_FFOUT), scr, gw, ngw, lane); } }
    __syncthreads(); }
    xcd_barrier(xbar);
    if (PROBE == 3) for (int i = 0; i < 16; ++i) xcd_barrier(xbar);
    REP(1) if (PH(1)) norm_mod_phase<false>(p, lds, p.in[I_X], p.in[I_GFFN1], 0, U, tid, wave, lane);
    xcd_barrier(xbar);
    REP(2) if (PH(2)) run_gemm(lds, U, D, (const bf16_t*)(ws + W_FFIN), 2 * FF, D, EpiSwiGLU{P, FF});
    { const int nfull = (64 * 22) % G, nidle = nfull ? G - nfull : G;
      const int ib = nfull ? (int)blockIdx.x - nfull : (int)blockIdx.x;
      if (PH(0) && ib >= 0) mixer_weight_items(p, scr, wave * nidle + ib, nidle * 8, lane); }
    xcd_barrier(xbar);
    const bool fusedn = (G == 256);
    unsigned* xslot = (unsigned*)(ws + WS_XSLOT); unsigned* xcnt = (unsigned*)(ws + WS_XCNT);
    if (fusedn) { if (PH(3)) run_gemm(lds, P, FF, (const bf16_t*)(ws + W_FFOUT), D, FF, EpiResidNorm{p.in[I_X], p.out, mod + 2 * D, p.in[I_GMIX], mod + 3 * D, U, xslot, xcnt, 0.5f, 0}); }
    else { REP(2) if (PH(3)) run_gemm(lds, P, FF, (const bf16_t*)(ws + W_FFOUT), D, FF, EpiResid{p.in[I_X], p.out, mod + 2 * D, 0.5f}); }
    xcd_barrier(xbar);
    if (!fusedn) { REP(1) if (PH(4)) norm_mod_phase<true>(p, lds, p.out, p.in[I_GMIX], 3, U, tid, wave, lane); xcd_barrier(xbar); }
    REP(2) if (PH(5)) run_gemm(lds, U, D, (const bf16_t*)(ws + W_IN), NIN, D, EpiBf16{P, NIN});
    { const int nfull = (64 * 22) % G, nidle = nfull ? G - nfull : G; const int ib = nfull ? (int)blockIdx.x - nfull : (int)blockIdx.x;
      if (PH(12) && ib >= 0) ffn_weight_items(p.in[I_WFFN2IN], p.in[I_WFFN2OUT], (bf16_t*)(ws + WS_F2IN), (bf16_t*)(ws + W_FFOUT), scr, wave * nidle + ib, nidle * 8, lane, 0, 2816); }
    xcd_barrier(xbar);
    if (PH(6)) prep_phase(p, lds, fusedn, tid, wave, lane);
    xcd_barrier(xbar);
    if (PH(7)) gdn_chunk_prep_phase(p, lds, tid, wave, lane);
    xcd_barrier(xbar);
    if (PH(15)) for (int it = blockIdx.x; it < 32; it += G) gdn_scan_block(p, lds, it, tid, wave, lane);
    if (PH(8)) {
        const unsigned x0 = xb_xcc_id() & 7u;
        for (unsigned dx = 0; dx < 8u; ++dx) { const unsigned x = (x0 + dx) & 7u; unsigned* ctr = (unsigned*)(ws + WS_CTR) + 64 * x;
            for (;;) { unsigned idx = 0; if (lane == 0) idx = atomicAdd(ctr, 1u); idx = __builtin_amdgcn_readfirstlane(idx);
                if (idx >= 512u) break;
                attn_item_mfma(P, (const bf16_t*)(ws + WS_VT), (int)(8u * x + (idx & 7u)), 63 - (int)(idx >> 3), lane); } } }
    xcd_barrier(xbar);
    if (PH(9)) gdn_finalize_phase(p, wave, lane);
    xcd_barrier(xbar);
    if (PH(10)) run_gemm(lds, P + C_QSB, NIN, (const bf16_t*)(ws + W_UPSB), D, 1024, EpiGateFused{P + C_RSB, P + C_RDN, U}, 8, (C_VDN - C_QSB) * 2 - 8 * 128);
    if (fusedn && PH(12)) ffn_weight_items(p.in[I_WFFN2IN], p.in[I_WFFN2OUT], (bf16_t*)(ws + WS_F2IN), (bf16_t*)(ws + W_FFOUT), scr, gw, ngw, lane, 2816, 2816 + 1408);
    xcd_barrier(xbar);
    if (fusedn) { if (PH(11)) run_gemm(lds, U, D, (const bf16_t*)(ws + W_OUT), D, D, EpiResidNorm{p.out, p.out, mod + 5 * D, p.in[I_GFFN2], mod + 6 * D, U, xslot + 64 * 256 * 4, xcnt + 64 * 64, 1.0f, 0}); }
    else { if (PH(11)) run_gemm(lds, U, D, (const bf16_t*)(ws + W_OUT), D, D, EpiResid{p.out, p.out, mod + 5 * D, 1.0f}); }
    xcd_barrier(xbar);
    if (!fusedn) { REP(1) if (PH(12)) norm_mod_phase<false>(p, lds, p.out, p.in[I_GFFN2], 6, U, tid, wave, lane);
        __syncthreads();
        if (PH(12)) ffn_weight_items(p.in[I_WFFN2IN], p.in[I_WFFN2OUT], (bf16_t*)(ws + WS_F2IN), (bf16_t*)(ws + W_FFOUT), scr, gw, ngw, lane, 2816, 2816 + 1408);
        xcd_barrier(xbar); }
    REP(2) if (PH(13)) run_gemm(lds, U, D, (const bf16_t*)(ws + WS_F2IN), 2 * FF, D, EpiSwiGLU{P, FF});
    xcd_barrier(xbar);
    if (PH(14)) run_gemm(lds, P, FF, (const bf16_t*)(ws + W_FFOUT), D, FF, EpiResid{p.out, p.out, mod + 8 * D, 0.5f});
}

extern "C" void kernel_launch(void* const* d_in, const int* in_sizes, int n_in, void* d_out, int out_size, void* d_ws, size_t ws_size, hipStream_t stream) {
    static int grid_blocks = 0;
    if (!grid_blocks) {
        int dev = 0, cus = 0, per_cu = 0;
        (void)hipGetDevice(&dev);
        (void)hipDeviceGetAttribute(&cus, hipDeviceAttributeMultiprocessorCount, dev);
        (void)hipFuncSetAttribute((const void*)fwd_megakernel, hipFuncAttributeMaxDynamicSharedMemorySize, LDS_BYTES);
        (void)hipOccupancyMaxActiveBlocksPerMultiprocessor(&per_cu, (const void*)fwd_megakernel, 512, LDS_BYTES);
        if (per_cu < 1) { fprintf(stderr, "occupancy query says %d blocks/CU\n", per_cu); per_cu = 1; }
        grid_blocks = cus;
    }
    Params p{};
    for (int i = 0; i < N_IN; ++i) p.in[i] = (const float*)d_in[i];
    p.out = (float*)d_out; p.ws = (unsigned char*)d_ws;
    static_assert(WS_BAR + XCD_BAR_WORDS * 4 <= WS_XCNT, "control words");
    (void)hipMemsetAsync((char*)d_ws + WS_CTR, 0, WS_ZEND - WS_CTR, stream);
    void* args[] = {&p};
    hipError_t e = hipLaunchCooperativeKernel((const void*)fwd_megakernel, dim3(grid_blocks), dim3(512), args, LDS_BYTES, stream);
    if (e != hipSuccess) fprintf(stderr, "cooperative launch failed: %s (grid %d)\n", hipGetErrorString(e), grid_blocks);
}
```

```cpp
#include <hip/hip_runtime.h>
#include <hip/hip_cooperative_groups.h>
#include <cstdio>
namespace cg = cooperative_groups;

#define LAS __attribute__((address_space(3)))
typedef unsigned short bf16_t;
typedef short bf16x8 __attribute__((ext_vector_type(8)));
typedef float f32x4 __attribute__((ext_vector_type(4)));
typedef unsigned u32x4 __attribute__((ext_vector_type(4)));
typedef unsigned u32x2 __attribute__((ext_vector_type(2)));
typedef float f32x16 __attribute__((ext_vector_type(16)));
typedef float f32x2 __attribute__((ext_vector_type(2)));
typedef __bf16 nbf16x2 __attribute__((ext_vector_type(2)));

constexpr int T = 16384, D = 1024, SEQ = 2048, NB = 8, FF = 2816, NIN = 5632, INW = 5640, NMOD = 9216;
constexpr int C_QSB = 0, C_KSB = 512, C_VSB = 1024, C_QDN = 1536, C_KDN = 2048, C_VDN = 2560, C_ZDN = 3072, C_RSB = 3584, C_RDN = 4608;
constexpr float EPS = 1e-6f;
constexpr int LDS_BYTES = 163840, BST_OFF = LDS_BYTES - 64;
constexpr size_t MiB = 1024 * 1024;
constexpr size_t WS_MOD = 0, WS_BG = 512 * 1024, WS_SS = 242 * MiB, WS_W = 2 * MiB;
constexpr size_t W_FFIN = WS_W, W_FFOUT = W_FFIN + (size_t)2 * FF * D * 2, W_IN = W_FFOUT + (size_t)D * FF * 2, W_UPSB = W_IN + (size_t)NIN * D * 2,
                 W_UPDN = W_UPSB + (size_t)D * 512 * 2, W_OUT = W_UPDN + (size_t)D * 512 * 2, W_END = W_OUT + (size_t)D * D * 2;
constexpr size_t WS_U = 34 * MiB, WS_P = 66 * MiB, WS_F2IN = 242 * MiB;
static_assert(W_END <= WS_U, "weights overflow");
constexpr size_t WS_EGL = 384 * 1024, WS_CTR = 400 * 1024, WS_BAR = 416 * 1024, WS_XCNT = 432 * 1024, WS_ZEND = 464 * 1024;
constexpr size_t WS_XSLOT = 1 * MiB;
constexpr size_t WS_VT = W_FFIN;
static_assert((size_t)T * 512 * 2 <= W_IN - W_FFIN, "Vt overflow");

enum { I_X = 0, I_C, I_WADA, I_BADA, I_GFFN1, I_WFFN1IN, I_WFFN1OUT, I_GMIX, I_WIN, I_GQSB, I_GKSB, I_WCONV, I_ALOG, I_DTBIAS, I_GDNOUT, I_WUPSB, I_WUPDN, I_WOUT, I_GFFN2, I_WFFN2IN, I_WFFN2OUT, N_IN };
struct Params { const float* in[N_IN]; float* out; unsigned char* ws; };

__device__ __forceinline__ float bf_lo(unsigned w) { return __uint_as_float(w << 16); }
__device__ __forceinline__ float bf_hi(unsigned w) { return __uint_as_float(w & 0xffff0000u); }
__device__ __forceinline__ float bf2f(bf16_t b) { return __uint_as_float(((unsigned)b) << 16); }
__device__ __forceinline__ unsigned pk2(float lo, float hi) { unsigned r; asm("v_cvt_pk_bf16_f32 %0, %1, %2" : "=v"(r) : "v"(lo), "v"(hi)); return r; }
__device__ __forceinline__ unsigned cpk2(float lo, float hi) { const f32x2 v = {lo, hi}; return __builtin_bit_cast(unsigned, __builtin_convertvector(v, nbf16x2)); }
__device__ __forceinline__ bf16_t f2bf(float f) { return (bf16_t)(pk2(f, 0.f) & 0xffffu); }
__device__ __forceinline__ float fexp(float x) { return __builtin_amdgcn_exp2f(x * 1.4426950408889634f); }
__device__ __forceinline__ float flog(float x) { return __builtin_amdgcn_logf(x) * 0.6931471805599453f; }
__device__ __forceinline__ float fsigmoid(float x) { return __builtin_amdgcn_rcpf(1.f + fexp(-x)); }
__device__ __forceinline__ float fsilu(float x) { return x * fsigmoid(x); }
__device__ __forceinline__ float fsoftplus(float x) { return fmaxf(x, 0.f) + flog(1.f + fexp(-fabsf(x))); }
__device__ __forceinline__ float wave_sum(float v) {
#pragma unroll
    for (int o = 1; o < 64; o <<= 1) v += __shfl_xor(v, o);
    return v;
}
#define LDS_WAIT() asm volatile("s_waitcnt lgkmcnt(0)" ::: "memory")
#define LDS_BARRIER() do { asm volatile("s_waitcnt lgkmcnt(0)" ::: "memory"); __builtin_amdgcn_s_barrier(); asm volatile("" ::: "memory"); } while (0)

namespace pg8 {
constexpr int BM = 256, BK = 64, HALF = 128, HTB = HALF * BK * 2, STAGE_BYTES = 8 * HTB, NXCD = 8, WGM = 8;
__host__ __device__ __forceinline__ int lds_byte(int r, int c) { const int st = (r >> 4) * 2 + (c >> 5), rr = r & 15, cc = c & 31, ob = rr * 64 + cc * 2; return st * 1024 + (ob ^ (((ob >> 9) & 1) << 5)); }
__host__ __device__ __forceinline__ void stage_rc(int b, int& R, int& C) { const int st = b / 1024, sb = b % 1024, swz = sb ^ (((sb >> 9) & 1) << 5); R = (st >> 1) * 16 + swz / 64; C = (st & 1) * 32 + (swz % 64) / 2; }
__host__ __device__ __forceinline__ int perm32(int rho) { const int n = rho >> 4, i = rho & 15; return 8 * (i >> 2) + 4 * n + (i & 3); }
struct Unit { int pm, pn; };
struct Gemm { const bf16_t* A; const bf16_t* Bt; int M, N, K, lda; int jt; int jbytes; };
struct StaticOrder {
    int nM, nN, nwg, G, c;
    __host__ __device__ void init(int M, int N, int G_, int c_) { nM = M / BM; nN = N / BM; nwg = nM * nN; G = G_; c = c_; }
    __host__ __device__ bool next(int i, Unit& u) const {
        const long L = (long)i * G + c; if (L >= nwg) return false;
        int wgid = (int)L; { const int q = nwg / NXCD, r = nwg % NXCD, xcd = wgid % NXCD, off = wgid / NXCD; wgid = (xcd < r ? xcd * (q + 1) : r * (q + 1) + (xcd - r) * q) + off; }
        const int nig = WGM * nN, gid = wgid / nig, fm = gid * WGM, gsz = (nM - fm) < WGM ? (nM - fm) : WGM;
        u.pm = fm + ((wgid % nig) % gsz); u.pn = (wgid % nig) / gsz; return true;
    }
};
template <class Epi>
__device__ __forceinline__ void gemm_phase(LAS unsigned char* lds, const Gemm g, const StaticOrder& S, const Epi E) {
    int tid = threadIdx.x; asm volatile("" : "+v"(tid));
    const int wid = __builtin_amdgcn_readfirstlane(tid >> 6), lane = tid & 63, wr = wid >> 2, wc = wid & 3, fr = lane & 15, fq = lane >> 4;
    const int K = g.K, nt = K / BK, lda = g.lda;
    unsigned voffA[2], voffB[2];
#pragma unroll
    for (int i = 0; i < 2; ++i) { int R, C; stage_rc(tid * 16 + i * 8192, R, C); const int Rb = Epi::PERM ? ((R & ~31) + perm32(R & 31)) : R;
        voffA[i] = (unsigned)(R * lda + C) * 2u; voffB[i] = (unsigned)(Rb * K + C) * 2u; }
    const size_t kstep = (size_t)(BK * 2);
    const size_t hstepA = (size_t)HALF * lda * 2, hstepB = (size_t)HALF * K * 2;
    const size_t tstepA = 2 * hstepA, tstepB = 2 * hstepB;
    const unsigned ldsw = (unsigned)wid * 1024u;
    const int aoff = lds_byte(wr * 64 + fr, fq * 8), boff = lds_byte(wc * 32 + fr, fq * 8);
#define PG8_SA(b, h) (((b) * 2 + (h)) * HTB)
#define PG8_SB(b, h) ((4 + (b) * 2 + (h)) * HTB)
#define PG8_STAGE(bufoff, gbase, voff) do { _Pragma("unroll") for (int _i = 0; _i < 2; ++_i) \
        __builtin_amdgcn_global_load_lds((const unsigned*)((const char*)(gbase) + (voff)[_i]), (LAS unsigned*)(lds + (bufoff) + ldsw + _i * 8192), 16, 0, 0); } while (0)
#define PG8_LDA(dst, b, h) do { _Pragma("unroll") for (int m = 0; m < 4; ++m) _Pragma("unroll") for (int k = 0; k < 2; ++k) dst[m][k] = *(const LAS bf16x8*)(lds + PG8_SA(b, h) + aoff + m * 2048 + k * 1024); } while (0)
#define PG8_LDB(dst, b, h) do { _Pragma("unroll") for (int n = 0; n < 2; ++n) _Pragma("unroll") for (int k = 0; k < 2; ++k) dst[n][k] = *(const LAS bf16x8*)(lds + PG8_SB(b, h) + boff + n * 2048 + k * 1024); } while (0)
#define PG8_MMA(ai, bj, At, Bt) do { __builtin_amdgcn_s_setprio(1); _Pragma("unroll") for (int m = 0; m < 4; ++m) _Pragma("unroll") for (int n = 0; n < 2; ++n) _Pragma("unroll") for (int k = 0; k < 2; ++k) \
        acc[ai][bj][m][n] = __builtin_amdgcn_mfma_f32_16x16x32_bf16(Bt[n][k], At[m][k], acc[ai][bj][m][n], 0, 0, 0); __builtin_amdgcn_s_setprio(0); } while (0)
#define PG8_WAIT_V(n) asm volatile("s_waitcnt vmcnt(" #n ")" ::: "memory")
#define PG8_WAIT_L(n) asm volatile("s_waitcnt lgkmcnt(" #n ")" ::: "memory")
#define PG8_BAR __builtin_amdgcn_s_barrier()
#define PG8_SCHED __builtin_amdgcn_sched_barrier(0)
    Unit cur, nxt; int ui = 0;
    if (!S.next(0, cur)) return;
    f32x4 acc[2][2][4][2];
#pragma unroll
    for (int a = 0; a < 2; ++a)
#pragma unroll
        for (int b = 0; b < 2; ++b)
#pragma unroll
            for (int m = 0; m < 4; ++m)
#pragma unroll
                for (int n = 0; n < 2; ++n) acc[a][b][m][n] = (f32x4){0.f, 0.f, 0.f, 0.f};
    bf16x8 At[4][2], B0[2][2], B1[2][2];
    const char* cA = (const char*)g.A + (size_t)cur.pm * tstepA; const char* cB = (const char*)g.Bt + (size_t)cur.pn * tstepB;
    PG8_STAGE(PG8_SB(0, 0), cB, voffB); PG8_STAGE(PG8_SA(0, 0), cA, voffA); PG8_STAGE(PG8_SB(0, 1), cB + hstepB, voffB); PG8_STAGE(PG8_SA(0, 1), cA + hstepA, voffA);
    if (wr == 1) PG8_BAR;
    PG8_WAIT_V(4); PG8_BAR;
    PG8_STAGE(PG8_SB(1, 0), cB + kstep, voffB); PG8_STAGE(PG8_SA(1, 0), cA + kstep, voffA); PG8_STAGE(PG8_SB(1, 1), cB + hstepB + kstep, voffB);
    PG8_WAIT_V(6); PG8_BAR;
    for (;;) {
        const bool has_next = S.next(ui + 1, nxt);
        const char* nA = has_next ? (const char*)g.A + (size_t)nxt.pm * tstepA : cA; const char* nB = has_next ? (const char*)g.Bt + (size_t)nxt.pn * tstepB : cB;
        for (int t = 0; t < nt; t += 2) {
            const bool last = (t == nt - 2);
            const char* a1 = cA + (size_t)(t + 1) * kstep + (t + 1 >= g.jt ? g.jbytes : 0);
            const char* a2 = last ? nA : cA + (size_t)(t + 2) * kstep + (t + 2 >= g.jt ? g.jbytes : 0); const char* b2 = last ? nB : cB + (size_t)(t + 2) * kstep;
            const char* a3 = a2 + kstep; const char* b3 = b2 + kstep;
            if constexpr (Epi::HAS_MID) { if (t == g.jt) E.mid(acc, cur, wr, wc, fr, fq); }
            PG8_LDB(B0, 0, 0); PG8_SCHED; PG8_LDA(At, 0, 0); PG8_STAGE(PG8_SA(1, 1), a1 + hstepA, voffA);
            PG8_WAIT_L(8); PG8_BAR; PG8_WAIT_L(0); PG8_MMA(0, 0, At, B0); PG8_BAR; PG8_SCHED;
            PG8_LDB(B1, 0, 1); PG8_STAGE(PG8_SB(0, 0), b2, voffB);
            PG8_BAR; PG8_WAIT_L(0); PG8_MMA(0, 1, At, B1); PG8_BAR;
            PG8_LDA(At, 0, 1); PG8_STAGE(PG8_SA(0, 0), a2, voffA);
            PG8_BAR; PG8_WAIT_L(0); PG8_MMA(1, 0, At, B0); PG8_BAR; PG8_SCHED;
            PG8_STAGE(PG8_SB(0, 1), b2 + hstepB, voffB);
            PG8_WAIT_V(6); PG8_BAR; PG8_MMA(1, 1, At, B1); PG8_BAR;
            PG8_LDB(B0, 1, 0); PG8_SCHED; PG8_LDA(At, 1, 0); PG8_STAGE(PG8_SA(0, 1), a2 + hstepA, voffA);
            PG8_WAIT_L(8); PG8_BAR; PG8_WAIT_L(0); PG8_MMA(0, 0, At, B0); PG8_BAR; PG8_SCHED;
            PG8_LDB(B1, 1, 1); PG8_STAGE(PG8_SB(1, 0), b3, voffB);
            PG8_BAR; PG8_WAIT_L(0); PG8_MMA(0, 1, At, B1); PG8_BAR;
            PG8_LDA(At, 1, 1); PG8_STAGE(PG8_SA(1, 0), a3, voffA);
            PG8_BAR; PG8_WAIT_L(0); PG8_MMA(1, 0, At, B0); PG8_BAR; PG8_SCHED;
            PG8_STAGE(PG8_SB(1, 1), b3 + hstepB, voffB);
            PG8_WAIT_V(6); PG8_BAR; PG8_MMA(1, 1, At, B1); PG8_BAR;
        }
        if constexpr (!Epi::AFTER) E(acc, cur, wr, wc, fr, fq);
        if (!has_next) break;
#pragma unroll
        for (int a = 0; a < 2; ++a)
#pragma unroll
            for (int b = 0; b < 2; ++b)
#pragma unroll
                for (int m = 0; m < 4; ++m)
#pragma unroll
                    for (int n = 0; n < 2; ++n) acc[a][b][m][n] = (f32x4){0.f, 0.f, 0.f, 0.f};
        cur = nxt; cA = nA; cB = nB; ++ui;
    }
    PG8_WAIT_V(0);
    if (wr == 0) PG8_BAR;
    PG8_BAR;
    if constexpr (Epi::AFTER) E.fused(acc, cur, wr, wc, fr, fq, lds, wid, lane);
#undef PG8_SA
#undef PG8_SB
#undef PG8_STAGE
#undef PG8_LDA
#undef PG8_LDB
#undef PG8_MMA
#undef PG8_WAIT_V
#undef PG8_WAIT_L
#undef PG8_BAR
#undef PG8_SCHED
}
}

typedef const f32x4 (&AccRef)[2][2][4][2];
struct EpiBf16 {
    static constexpr bool PERM = true, HAS_MID = false, AFTER = false;
    bf16_t* O; int ldc;
    __device__ __forceinline__ void operator()(AccRef acc, const pg8::Unit& u, int wr, int wc, int fr, int fq) const {
        const int row0 = u.pm * 256 + wr * 64 + fr, col0 = u.pn * 256 + wc * 32 + 8 * fq;
#pragma unroll
        for (int ai = 0; ai < 2; ++ai)
#pragma unroll
            for (int m = 0; m < 4; ++m) { bf16_t* rowp = O + (size_t)(row0 + ai * 128 + m * 16) * ldc + col0;
#pragma unroll
                for (int bj = 0; bj < 2; ++bj) { const f32x4 v0 = acc[ai][bj][m][0], v1 = acc[ai][bj][m][1];
                    u32x4 w; w.x = pk2(v0[0], v0[1]); w.y = pk2(v0[2], v0[3]); w.z = pk2(v1[0], v1[1]); w.w = pk2(v1[2], v1[3]);
                    *(u32x4*)(rowp + bj * 128) = w; } }
    }
};
struct EpiSwiGLU {
    static constexpr bool PERM = true, HAS_MID = false, AFTER = false;
    bf16_t* O; int ldc;
    __device__ __forceinline__ void operator()(AccRef acc, const pg8::Unit& u, int wr, int wc, int fr, int fq) const {
        const int row0 = u.pm * 256 + wr * 64 + fr, col0 = u.pn * 128 + wc * 32 + 8 * fq;
#pragma unroll
        for (int ai = 0; ai < 2; ++ai)
#pragma unroll
            for (int m = 0; m < 4; ++m) { bf16_t* rowp = O + (size_t)(row0 + ai * 128 + m * 16) * ldc + col0;
                float r[8];
#pragma unroll
                for (int n = 0; n < 2; ++n)
#pragma unroll
                    for (int j = 0; j < 4; ++j) { const float a = acc[ai][0][m][n][j], b = acc[ai][1][m][n][j]; r[n * 4 + j] = fsilu(a) * b; }
                u32x4 w; w.x = pk2(r[0], r[1]); w.y = pk2(r[2], r[3]); w.z = pk2(r[4], r[5]); w.w = pk2(r[6], r[7]);
                *(u32x4*)rowp = w; }
    }
};
struct EpiResid {
    static constexpr bool PERM = false, HAS_MID = false, AFTER = false;
    const float* base; float* out; const float* gate; float scale;
    __device__ __forceinline__ void operator()(AccRef acc, const pg8::Unit& u, int wr, int wc, int fr, int fq) const {
        const int row0 = u.pm * 256 + wr * 64 + fr, col0 = u.pn * 256 + wc * 32 + 4 * fq;
        const float* gp = gate + (size_t)(u.pm >> 3) * NMOD + col0;
        f32x4 gv[2][2];
#pragma unroll
        for (int bj = 0; bj < 2; ++bj)
#pragma unroll
            for (int n = 0; n < 2; ++n) gv[bj][n] = *(const f32x4*)(gp + bj * 128 + n * 16) * scale;
#pragma unroll
        for (int ai = 0; ai < 2; ++ai) {
            f32x4 bs[4][2][2];
#pragma unroll
            for (int m = 0; m < 4; ++m) { const size_t off = (size_t)(row0 + ai * 128 + m * 16) * D + col0;
#pragma unroll
                for (int bj = 0; bj < 2; ++bj)
#pragma unroll
                    for (int n = 0; n < 2; ++n) bs[m][bj][n] = *(const f32x4*)(base + off + bj * 128 + n * 16); }
#pragma unroll
            for (int m = 0; m < 4; ++m) { const size_t off = (size_t)(row0 + ai * 128 + m * 16) * D + col0;
#pragma unroll
                for (int bj = 0; bj < 2; ++bj)
#pragma unroll
                    for (int n = 0; n < 2; ++n) *(f32x4*)(out + off + bj * 128 + n * 16) = bs[m][bj][n] + gv[bj][n] * acc[ai][bj][m][n]; }
            asm volatile("" ::: "memory"); }
    }
};
struct EpiResidNorm {
    static constexpr bool PERM = false, HAS_MID = false, AFTER = true;
    const float* base; float* out; const float* gate;
    const float* gain; const float* modsh; bf16_t* un;
    unsigned* xslot; unsigned* cnt; float scale; int pad_;
    __device__ __forceinline__ void fused(f32x4 (&acc)[2][2][4][2], const pg8::Unit& u, int wr, int wc, int fr, int fq, LAS unsigned char* lds, int wid, int lane) const {
        const int row0 = u.pm * 256 + wr * 64 + fr, col0 = u.pn * 256 + wc * 32 + 4 * fq, tid = wid * 64 + lane;
        LAS float* Pt = (LAS float*)lds; LAS float* St = (LAS float*)(lds + 4096);
        const float* gp = gate + (size_t)(u.pm >> 3) * NMOD + col0;
        f32x4 gv[2][2];
#pragma unroll
        for (int bj = 0; bj < 2; ++bj)
#pragma unroll
            for (int n = 0; n < 2; ++n) gv[bj][n] = *(const f32x4*)(gp + bj * 128 + n * 16) * scale;
#pragma unroll
        for (int ai = 0; ai < 2; ++ai) {
            f32x4 bs[4][2][2];
#pragma unroll
            for (int m = 0; m < 4; ++m) { const size_t off = (size_t)(row0 + ai * 128 + m * 16) * D + col0;
#pragma unroll
                for (int bj = 0; bj < 2; ++bj)
#pragma unroll
                    for (int n = 0; n < 2; ++n) bs[m][bj][n] = *(const f32x4*)(base + off + bj * 128 + n * 16); }
#pragma unroll
            for (int m = 0; m < 4; ++m) { const size_t off = (size_t)(row0 + ai * 128 + m * 16) * D + col0; float sq = 0.f;
#pragma unroll
                for (int bj = 0; bj < 2; ++bj)
#pragma unroll
                    for (int n = 0; n < 2; ++n) { const f32x4 hv = bs[m][bj][n] + gv[bj][n] * acc[ai][bj][m][n]; acc[ai][bj][m][n] = hv; *(f32x4*)(out + off + bj * 128 + n * 16) = hv;
                        sq += (hv[0] * hv[0] + hv[1] * hv[1]) + (hv[2] * hv[2] + hv[3] * hv[3]); }
                sq += __shfl_xor(sq, 16); sq += __shfl_xor(sq, 32);
                if (fq == 0) Pt[(ai * 128 + wr * 64 + m * 16 + fr) * 4 + wc] = sq; }
            asm volatile("" ::: "memory"); }
        LDS_WAIT(); __syncthreads();
        if (tid < 256) { const f32x4 t4 = *(const LAS f32x4*)(Pt + tid * 4); const float sq = (t4[0] + t4[1]) + (t4[2] + t4[3]);
            __hip_atomic_store(xslot + ((size_t)(u.pm * 256 + tid) * 4 + u.pn), __float_as_uint(sq), __ATOMIC_RELAXED, __HIP_MEMORY_SCOPE_AGENT);
            asm volatile("s_waitcnt vmcnt(0)" ::: "memory");
            if (lane == 0) __hip_atomic_fetch_add(cnt + 64 * u.pm, 1u, __ATOMIC_RELAXED, __HIP_MEMORY_SCOPE_AGENT); }
        if (wid == 0) { unsigned spins = 0;
            while ((unsigned)__builtin_amdgcn_readfirstlane(__hip_atomic_load(cnt + 64 * u.pm, __ATOMIC_RELAXED, __HIP_MEMORY_SCOPE_AGENT)) < 16u) { __builtin_amdgcn_s_sleep(2); if (++spins > (1u << 22)) break; }
            __builtin_amdgcn_fence(__ATOMIC_ACQUIRE, "agent"); asm volatile("s_waitcnt vmcnt(0)" ::: "memory"); }
        __syncthreads();
        if (tid < 256) { const unsigned* sl = xslot + (size_t)(u.pm * 256 + tid) * 4; float sq = 0.f;
#pragma unroll
            for (int t = 0; t < 4; ++t) sq += __uint_as_float(__hip_atomic_load(sl + t, __ATOMIC_RELAXED, __HIP_MEMORY_SCOPE_AGENT));
            St[tid] = 1.0f / sqrtf(sq * (1.f / D) + EPS); }
        LDS_WAIT(); __syncthreads();
        const float* shp = modsh + (size_t)(u.pm >> 3) * NMOD + col0;
        f32x4 gs[2][2], sh[2][2];
#pragma unroll
        for (int bj = 0; bj < 2; ++bj)
#pragma unroll
            for (int n = 0; n < 2; ++n) { gs[bj][n] = *(const f32x4*)(gain + col0 + bj * 128 + n * 16) * (*(const f32x4*)(shp + D + bj * 128 + n * 16) + 1.0f); sh[bj][n] = *(const f32x4*)(shp + bj * 128 + n * 16); }
#pragma unroll
        for (int ai = 0; ai < 2; ++ai)
#pragma unroll
            for (int m = 0; m < 4; ++m) { const int r = ai * 128 + wr * 64 + m * 16 + fr; const float rstd = St[r]; bf16_t* up = un + (size_t)(u.pm * 256 + r) * D + col0;
#pragma unroll
                for (int bj = 0; bj < 2; ++bj)
#pragma unroll
                    for (int n = 0; n < 2; ++n) { const f32x4 uu = acc[ai][bj][m][n] * rstd * gs[bj][n] + sh[bj][n];
                        *(u32x2*)(up + bj * 128 + n * 16) = (u32x2){pk2(uu[0], uu[1]), pk2(uu[2], uu[3])}; } }
        __syncthreads();
    }
};
struct EpiGateFused {
    static constexpr bool PERM = true, HAS_MID = true, AFTER = false;
    const bf16_t* Rsb; const bf16_t* Rdn; bf16_t* O;
    __device__ __forceinline__ void mid(f32x4 (&acc)[2][2][4][2], const pg8::Unit& u, int wr, int wc, int fr, int fq) const {
        int row0 = u.pm * 256 + wr * 64 + fr, col0 = u.pn * 256 + wc * 32 + 8 * fq;
        asm volatile("" : "+v"(row0), "+v"(col0));
#pragma unroll
        for (int ai = 0; ai < 2; ++ai)
#pragma unroll
            for (int mp = 0; mp < 2; ++mp) {
                u32x4 av[2][2], dv[2][2];
#pragma unroll
                for (int mm = 0; mm < 2; ++mm)
#pragma unroll
                    for (int bj = 0; bj < 2; ++bj) { const size_t row = (size_t)(row0 + ai * 128 + (2 * mp + mm) * 16);
                        av[mm][bj] = *(const u32x4*)(Rsb + row * NIN + col0 + bj * 128); dv[mm][bj] = *(const u32x4*)(Rdn + row * NIN + col0 + bj * 128); }
#pragma unroll
                for (int mm = 0; mm < 2; ++mm)
#pragma unroll
                    for (int bj = 0; bj < 2; ++bj) { const int m = 2 * mp + mm; const u32x4 a = av[mm][bj], d = dv[mm][bj];
                        const float ra[8] = {bf_lo(a.x), bf_hi(a.x), bf_lo(a.y), bf_hi(a.y), bf_lo(a.z), bf_hi(a.z), bf_lo(a.w), bf_hi(a.w)};
                        const float rd[8] = {bf_lo(d.x), bf_hi(d.x), bf_lo(d.y), bf_hi(d.y), bf_lo(d.z), bf_hi(d.z), bf_lo(d.w), bf_hi(d.w)};
#pragma unroll
                        for (int e = 0; e < 8; ++e) { const float q = (1.0f + fexp(fminf(-rd[e], 30.0f))) * __builtin_amdgcn_rcpf(1.0f + fexp(-ra[e])); acc[ai][bj][m][e >> 2][e & 3] *= q; } }
                asm volatile("" ::: "memory"); }
    }
    __device__ __forceinline__ void operator()(AccRef acc, const pg8::Unit& u, int wr, int wc, int fr, int fq) const {
        const int row0 = u.pm * 256 + wr * 64 + fr, col0 = u.pn * 256 + wc * 32 + 8 * fq;
#pragma unroll
        for (int ai = 0; ai < 2; ++ai) {
            u32x4 dv[4][2];
#pragma unroll
            for (int m = 0; m < 4; ++m)
#pragma unroll
                for (int bj = 0; bj < 2; ++bj) dv[m][bj] = *(const u32x4*)(Rdn + (size_t)(row0 + ai * 128 + m * 16) * NIN + col0 + bj * 128);
#pragma unroll
            for (int m = 0; m < 4; ++m) { const size_t row = (size_t)(row0 + ai * 128 + m * 16);
#pragma unroll
                for (int bj = 0; bj < 2; ++bj) { const u32x4 d = dv[m][bj];
                    const f32x4 v0 = acc[ai][bj][m][0], v1 = acc[ai][bj][m][1];
#define SGC(x) __builtin_amdgcn_rcpf(1.0f + fexp(fminf(-(x), 30.0f)))
                    const float r[8] = {SGC(bf_lo(d.x)) * v0[0], SGC(bf_hi(d.x)) * v0[1], SGC(bf_lo(d.y)) * v0[2], SGC(bf_hi(d.y)) * v0[3],
                                        SGC(bf_lo(d.z)) * v1[0], SGC(bf_hi(d.z)) * v1[1], SGC(bf_lo(d.w)) * v1[2], SGC(bf_hi(d.w)) * v1[3]};
#undef SGC
                    u32x4 w; w.x = pk2(r[0], r[1]); w.y = pk2(r[2], r[3]); w.z = pk2(r[4], r[5]); w.w = pk2(r[6], r[7]);
                    *(u32x4*)(O + row * D + col0 + bj * 128) = w; } } }
    }
};
template <class Epi> __device__ __forceinline__ void run_gemm(LAS unsigned char* lds, const bf16_t* A, int lda, const bf16_t* Bt, int N, int K, const Epi E, int jt = 1 << 30, int jbytes = 0) {
    pg8::Gemm g{A, Bt, T, N, K, lda, jt, jbytes}; pg8::StaticOrder S; S.init(T, N, (int)gridDim.x, (int)blockIdx.x);
    pg8::gemm_phase<Epi>(lds, g, S, E);
}

__device__ __forceinline__ void transpose_item(const float* W, int ldw, int s0, int k0, bf16_t* WT, int ldk, int d0, LAS float* scr, int lane) {
    float tv[32];
#pragma unroll
    for (int i = 0; i < 32; ++i) tv[i] = W[(size_t)(k0 + 2 * i + (lane >> 5)) * ldw + s0 + (lane & 31)];
#pragma unroll
    for (int i = 0; i < 32; ++i) scr[(2 * i + (lane >> 5)) * 33 + (lane & 31)] = tv[i];
    LDS_WAIT();
    const int c = lane & 7;
#pragma unroll
    for (int j = 0; j < 4; ++j) { const int n = (lane >> 3) + 8 * j; const LAS float* s = scr + (8 * c) * 33 + n;
        u32x4 o; o.x = pk2(s[0 * 33], s[1 * 33]); o.y = pk2(s[2 * 33], s[3 * 33]); o.z = pk2(s[4 * 33], s[5 * 33]); o.w = pk2(s[6 * 33], s[7 * 33]);
        *(u32x4*)(WT + (size_t)(d0 + n) * ldk + k0 + 8 * c) = o; }
    LDS_WAIT();
}
struct TrD { const float* W; int ldw, s0, k0; bf16_t* WT; int ldk, d0; };
__device__ __forceinline__ TrD ffn_item_desc(const float* w_in, const float* w_out, bf16_t* wt_in, bf16_t* wt_out, int it) {
    if (it < 2816) { const int kb = it / 176, nb = it % 176, d0 = nb * 32, pn = d0 >> 8, bj = (d0 >> 7) & 1, c = d0 & 127, s0 = bj * FF + pn * 128 + c; return TrD{w_in, 2 * FF, s0, kb * 64, wt_in, D, d0}; }
    const int r = it - 2816, kb = r / 32, nb = r % 32; return TrD{w_out, D, nb * 32, kb * 64, wt_out, FF, nb * 32};
}
__device__ __forceinline__ void ffn_weight_items(const float* w_in, const float* w_out, bf16_t* wt_in, bf16_t* wt_out, LAS float* scr, int gw, int ngw, int lane, int lo = 0, int NIT = 2816 + 1408) {
    gw += lo;
    float tv[32];
#define TR_LOAD(d_) do { _Pragma("unroll") for (int i = 0; i < 32; ++i) tv[i] = (d_).W[(size_t)((d_).k0 + 2 * i + (lane >> 5)) * (d_).ldw + (d_).s0 + (lane & 31)]; } while (0)
    if (gw < NIT) { const TrD d0_ = ffn_item_desc(w_in, w_out, wt_in, wt_out, gw); TR_LOAD(d0_); }
    for (int it = gw; it < NIT; it += ngw) {
        const TrD d = ffn_item_desc(w_in, w_out, wt_in, wt_out, it);
#pragma unroll
        for (int i = 0; i < 32; ++i) scr[(2 * i + (lane >> 5)) * 33 + (lane & 31)] = tv[i];
        LDS_WAIT();
        if (it + ngw < NIT) { const TrD dn = ffn_item_desc(w_in, w_out, wt_in, wt_out, it + ngw); TR_LOAD(dn); }
        const int c = lane & 7;
#pragma unroll
        for (int j = 0; j < 4; ++j) { const int n = (lane >> 3) + 8 * j; const LAS float* s_ = scr + (8 * c) * 33 + n;
            u32x4 o; o.x = pk2(s_[0 * 33], s_[1 * 33]); o.y = pk2(s_[2 * 33], s_[3 * 33]); o.z = pk2(s_[4 * 33], s_[5 * 33]); o.w = pk2(s_[6 * 33], s_[7 * 33]);
            *(u32x4*)(d.WT + (size_t)(d.d0 + n) * d.ldk + d.k0 + 8 * c) = o; }
        LDS_WAIT();
    }
#undef TR_LOAD
}
__device__ __forceinline__ void mixer_weight_items(const Params& p, LAS float* scr, int gw, int ngw, int lane) {
    unsigned char* ws = p.ws;
    for (int it = gw; it < 2816 + 256 + 256 + 512; it += ngw) {
        int r = it;
        if (r < 2816) { const int kb = r / 176, nb = r % 176, d0 = nb * 32, s0 = d0 < C_RSB ? d0 : d0 + 8; transpose_item(p.in[I_WIN], INW, s0, kb * 64, (bf16_t*)(ws + W_IN), D, d0, scr, lane); continue; } r -= 2816;
        if (r < 256) { const int kb = r / 32, nb = r % 32; transpose_item(p.in[I_WUPSB], D, nb * 32, kb * 64, (bf16_t*)(ws + W_UPSB), D, nb * 32, scr, lane); continue; } r -= 256;
        if (r < 256) { const int kb = r / 32, nb = r % 32; transpose_item(p.in[I_WUPDN], D, nb * 32, kb * 64, (bf16_t*)(ws + W_UPSB) + 512, D, nb * 32, scr, lane); continue; } r -= 256;
        { const int kb = r / 32, nb = r % 32; transpose_item(p.in[I_WOUT], D, nb * 32, kb * 64, (bf16_t*)(ws + W_OUT), D, nb * 32, scr, lane); }
    }
}
__device__ __forceinline__ void mod_item(const Params& p, LAS unsigned char* lds, int cb, int tid, int wave, int lane) {
    asm volatile("" : "+v"(tid), "+v"(lane));
    LAS float* sc = (LAS float*)lds; LAS float* red = (LAS float*)(lds + 32768);
    for (int i = tid; i < NB * D; i += 512) sc[i] = fsilu(p.in[I_C][i]);
    __syncthreads();
    const float* wa = p.in[I_WADA] + cb * 64 + lane;
    float acc[NB];
#pragma unroll
    for (int b = 0; b < NB; ++b) acc[b] = 0.f;
    for (int k = wave * 128; k < wave * 128 + 128; k += 32) {
        float w[32];
#pragma unroll
        for (int e = 0; e < 32; ++e) w[e] = wa[(size_t)(k + e) * NMOD];
#pragma unroll
        for (int b = 0; b < NB; ++b)
#pragma unroll
            for (int e4 = 0; e4 < 8; ++e4) { const f32x4 s = *(const LAS f32x4*)(sc + b * D + k + 4 * e4); acc[b] += s[0] * w[4 * e4] + s[1] * w[4 * e4 + 1] + s[2] * w[4 * e4 + 2] + s[3] * w[4 * e4 + 3]; }
    }
#pragma unroll
    for (int b = 0; b < NB; ++b) red[(wave * NB + b) * 64 + lane] = acc[b];
    __syncthreads();
    { const int b = tid >> 6; float s = p.in[I_BADA][cb * 64 + lane];
#pragma unroll
        for (int w = 0; w < 8; ++w) s += red[(w * NB + b) * 64 + lane];
        ((float*)(p.ws + WS_MOD))[b * NMOD + cb * 64 + lane] = s; }
    __syncthreads();
}

template <bool DN>
__device__ __forceinline__ void norm_mod_phase(const Params& p, LAS unsigned char* lds, const float* src, const float* gain, int midx, bf16_t* dst, int tid, int wave, int lane) {
    asm volatile("" : "+v"(tid), "+v"(lane));
    const float* mod = (const float*)(p.ws + WS_MOD);
    LAS float* wl = (LAS float*)lds;
    if (DN) { for (int i = tid; i < D * 8; i += 512) { const int k = i >> 3, j = i & 7; wl[8 * k + 4 * (k >> 2) + j] = p.in[I_WIN][(size_t)k * INW + C_RSB + j]; } __syncthreads(); }
    f32x4 g4[4];
#pragma unroll
    for (int j = 0; j < 4; ++j) g4[j] = ((const f32x4*)gain)[lane + 64 * j];
    const int rstep = gridDim.x * 8;
    f32x4 nv[4];
    { const int r0 = blockIdx.x * 8 + wave; const f32x4* xr = (const f32x4*)(src + (size_t)(r0 < T ? r0 : 0) * D) + lane;
#pragma unroll
      for (int j = 0; j < 4; ++j) nv[j] = xr[64 * j]; }
    for (int row = blockIdx.x * 8 + wave; row < T; row += rstep) {
        const int b = row >> 11;
        const f32x4* shp = (const f32x4*)(mod + (size_t)b * NMOD + midx * D) + lane; const f32x4* scp = shp + D / 4;
        f32x4 v[4], shv[4], scv[4]; float ss = 0.f;
#pragma unroll
        for (int j = 0; j < 4; ++j) { v[j] = nv[j]; shv[j] = shp[64 * j]; scv[j] = scp[64 * j]; }
        { const int rn = row + rstep < T ? row + rstep : row; const f32x4* xr = (const f32x4*)(src + (size_t)rn * D) + lane;
#pragma unroll
          for (int j = 0; j < 4; ++j) nv[j] = xr[64 * j]; }
#pragma unroll
        for (int j = 0; j < 4; ++j) ss += (v[j][0] * v[j][0] + v[j][1] * v[j][1]) + (v[j][2] * v[j][2] + v[j][3] * v[j][3]);
        const float rstd = 1.0f / sqrtf(wave_sum(ss) * (1.f / D) + EPS);
        u32x2* o8 = (u32x2*)(dst + (size_t)row * D) + lane;
        float dot[8];
        if (DN) {
#pragma unroll
            for (int e = 0; e < 8; ++e) dot[e] = 0.f; }
#pragma unroll
        for (int j = 0; j < 4; ++j) { const f32x4 sh = shv[j], sc = scv[j];
            const f32x4 uu = v[j] * rstd * g4[j] * (sc + 1.0f) + sh;
            u32x2 w; w.x = pk2(uu[0], uu[1]); w.y = pk2(uu[2], uu[3]); o8[64 * j] = w;
            if (DN) {
#pragma unroll
                for (int e = 0; e < 4; ++e) { const int k = 4 * lane + 256 * j + e; const LAS f32x4* wp = (const LAS f32x4*)(wl + 8 * k + 4 * (k >> 2)); const f32x4 w0 = wp[0], w1 = wp[1];
                    dot[0] += uu[e] * w0[0]; dot[1] += uu[e] * w0[1]; dot[2] += uu[e] * w0[2]; dot[3] += uu[e] * w0[3];
                    dot[4] += uu[e] * w1[0]; dot[5] += uu[e] * w1[1]; dot[6] += uu[e] * w1[2]; dot[7] += uu[e] * w1[3]; } } }
        if (DN) {
#pragma unroll
            for (int e = 0; e < 8; ++e) dot[e] = wave_sum(dot[e]);
            float mine = dot[0];
#pragma unroll
            for (int e = 1; e < 8; ++e) mine = (lane == e) ? dot[e] : mine;
            if (lane < 8) { float r;
                if (lane < 4) r = 1.0f / (1.0f + expf(-mine));
                else { const int hh = lane - 4; const float a = mine + p.in[I_DTBIAS][hh]; const float sp = a > 20.f ? a : log1pf(expf(a)); r = -expf(p.in[I_ALOG][hh]) * sp; }
                ((float*)(p.ws + WS_BG))[(size_t)row * 8 + lane] = r; } }
    }
    if (DN) __syncthreads();
}

__device__ __forceinline__ void dn_gate_phase(const Params& p, LAS unsigned char* lds, const bf16_t* u2, int tid, int wave, int lane) {
    asm volatile("" : "+v"(tid), "+v"(lane));
    LAS float* wl = (LAS float*)lds;
    for (int i = tid; i < D * 8; i += 512) { const int k = i >> 3, j = i & 7; wl[8 * k + 4 * (k >> 2) + j] = p.in[I_WIN][(size_t)k * INW + C_RSB + j]; }
    __syncthreads();
    const int rstep = gridDim.x * 8;
    u32x4 na, nb;
    { const int r0 = blockIdx.x * 8 + wave; const bf16_t* up = u2 + (size_t)(r0 < T ? r0 : 0) * D + 16 * lane; na = ((const u32x4*)up)[0]; nb = ((const u32x4*)up)[1]; }
    for (int row = blockIdx.x * 8 + wave; row < T; row += rstep) {
        const u32x4 ca = na, cb = nb;
        { const int rn = row + rstep < T ? row + rstep : row; const bf16_t* up = u2 + (size_t)rn * D + 16 * lane; na = ((const u32x4*)up)[0]; nb = ((const u32x4*)up)[1]; }
        const unsigned w8[8] = {ca.x, ca.y, ca.z, ca.w, cb.x, cb.y, cb.z, cb.w};
        float dot[8];
#pragma unroll
        for (int e = 0; e < 8; ++e) dot[e] = 0.f;
#pragma unroll
        for (int e = 0; e < 16; ++e) { const int k = 16 * lane + e; const LAS f32x4* wp = (const LAS f32x4*)(wl + 8 * k + 4 * (k >> 2)); const f32x4 w0 = wp[0], w1 = wp[1];
            const float uv = (e & 1) ? bf_hi(w8[e >> 1]) : bf_lo(w8[e >> 1]);
            dot[0] += uv * w0[0]; dot[1] += uv * w0[1]; dot[2] += uv * w0[2]; dot[3] += uv * w0[3]; dot[4] += uv * w1[0]; dot[5] += uv * w1[1]; dot[6] += uv * w1[2]; dot[7] += uv * w1[3]; }
#pragma unroll
        for (int e = 0; e < 8; ++e) dot[e] = wave_sum(dot[e]);
        float mine = dot[0];
#pragma unroll
        for (int e = 1; e < 8; ++e) mine = (lane == e) ? dot[e] : mine;
        if (lane < 8) { float r;
            if (lane < 4) r = 1.0f / (1.0f + expf(-mine));
            else { const int hh = lane - 4; const float a = mine + p.in[I_DTBIAS][hh]; const float sp = a > 20.f ? a : log1pf(expf(a)); r = -expf(p.in[I_ALOG][hh]) * sp; }
            ((float*)(p.ws + WS_BG))[(size_t)row * 8 + lane] = r; }
    }
    __syncthreads();
}
__device__ __forceinline__ void unpack16(const bf16_t* p, float* f) {
    const u32x4 a = ((const u32x4*)p)[0], b = ((const u32x4*)p)[1];
    f[0] = bf_lo(a.x); f[1] = bf_hi(a.x); f[2] = bf_lo(a.y); f[3] = bf_hi(a.y); f[4] = bf_lo(a.z); f[5] = bf_hi(a.z); f[6] = bf_lo(a.w); f[7] = bf_hi(a.w);
    f[8] = bf_lo(b.x); f[9] = bf_hi(b.x); f[10] = bf_lo(b.y); f[11] = bf_hi(b.y); f[12] = bf_lo(b.z); f[13] = bf_hi(b.z); f[14] = bf_lo(b.w); f[15] = bf_hi(b.w);
}
__device__ __forceinline__ void pack16(bf16_t* p, const float* f) {
    u32x4 a, b; a.x = pk2(f[0], f[1]); a.y = pk2(f[2], f[3]); a.z = pk2(f[4], f[5]); a.w = pk2(f[6], f[7]); b.x = pk2(f[8], f[9]); b.y = pk2(f[10], f[11]); b.z = pk2(f[12], f[13]); b.w = pk2(f[14], f[15]);
    ((u32x4*)p)[0] = a; ((u32x4*)p)[1] = b;
}
__device__ __forceinline__ void prep_phase(const Params& p, LAS unsigned char* lds, bool dn, int tid, int wave, int lane) {
    asm volatile("" : "+v"(lane), "+v"(tid));
    bf16_t* P = (bf16_t*)(p.ws + WS_P); bf16_t* U = (bf16_t*)(p.ws + WS_U);
    LAS float* wl = (LAS float*)lds;
    if (dn) { for (int i = tid; i < D * 8; i += 512) { const int k = i >> 3, j = i & 7; wl[(k & 15) * 520 + (k >> 4) * 8 + j] = p.in[I_WIN][(size_t)k * INW + C_RSB + j]; } __syncthreads(); }
    const int ch = 16 * lane;
    float gsb[16], wcv[4][16];
    { const float* gp = (ch < 512 ? p.in[I_GQSB] : p.in[I_GKSB]) + (ch & 63); const float sc = ch < 512 ? 0.18033688011112042f : 1.0f;
#pragma unroll
        for (int e = 0; e < 16; ++e) gsb[e] = gp[e] * sc;
#pragma unroll
        for (int i = 0; i < 4; ++i)
#pragma unroll
            for (int e = 0; e < 16; ++e) wcv[i][e] = p.in[I_WCONV][i * 1536 + ch + e]; }
    for (int row = blockIdx.x * 8 + wave; row < T; row += gridDim.x * 8) {
        const int tl = row & (SEQ - 1);
        if (dn) {
            const u32x4 ca = *(const u32x4*)(U + (size_t)row * D + ch), cb = *(const u32x4*)(U + (size_t)row * D + ch + 8);
            const unsigned w8[8] = {ca.x, ca.y, ca.z, ca.w, cb.x, cb.y, cb.z, cb.w};
            float dot[8];
#pragma unroll
            for (int e = 0; e < 8; ++e) dot[e] = 0.f;
#pragma unroll
            for (int e = 0; e < 16; ++e) { const LAS f32x4* wp = (const LAS f32x4*)(wl + e * 520 + lane * 8); const f32x4 w0 = wp[0], w1 = wp[1];
                const float uv = (e & 1) ? bf_hi(w8[e >> 1]) : bf_lo(w8[e >> 1]);
                dot[0] += uv * w0[0]; dot[1] += uv * w0[1]; dot[2] += uv * w0[2]; dot[3] += uv * w0[3]; dot[4] += uv * w1[0]; dot[5] += uv * w1[1]; dot[6] += uv * w1[2]; dot[7] += uv * w1[3]; }
#pragma unroll
            for (int e = 0; e < 8; ++e) dot[e] = wave_sum(dot[e]);
            float mine = dot[0];
#pragma unroll
            for (int e = 1; e < 8; ++e) mine = (lane == e) ? dot[e] : mine;
            if (lane < 8) { float r;
                if (lane < 4) r = 1.0f / (1.0f + expf(-mine));
                else { const int hh = lane - 4; const float a = mine + p.in[I_DTBIAS][hh]; const float sp = a > 20.f ? a : log1pf(expf(a)); r = -expf(p.in[I_ALOG][hh]) * sp; }
                ((float*)(p.ws + WS_BG))[(size_t)row * 8 + lane] = r; } }
        { bf16_t* qp = P + (size_t)row * NIN + ch; float f[16]; unpack16(qp, f); float ss = 0.f;
#pragma unroll
            for (int e = 0; e < 16; ++e) ss += f[e] * f[e];
            ss += __shfl_xor(ss, 1); ss += __shfl_xor(ss, 2);
            const float rstd = 1.0f / sqrtf(ss * (1.f / 64.f) + EPS);
#pragma unroll
            for (int e = 0; e < 16; ++e) f[e] = f[e] * rstd * gsb[e];
            pack16(qp, f); }
        { float y[16];
#pragma unroll
            for (int e = 0; e < 16; ++e) y[e] = 0.f;
#pragma unroll
            for (int i = 0; i < 4; ++i) { if (tl - 3 + i >= 0) { float f[16]; unpack16(P + (size_t)(row - 3 + i) * NIN + C_QDN + ch, f);
#pragma unroll
                    for (int e = 0; e < 16; ++e) y[e] += wcv[i][e] * f[e]; } }
            float ss = 0.f;
#pragma unroll
            for (int e = 0; e < 16; ++e) { y[e] = fsilu(y[e]); ss += y[e] * y[e]; }
            ss += __shfl_xor(ss, 1); ss += __shfl_xor(ss, 2); ss += __shfl_xor(ss, 4);
            const float sc = (1.0f / sqrtf(ss + EPS)) * (ch < 512 ? 0.08838834764831845f : 1.0f);
#pragma unroll
            for (int e = 0; e < 16; ++e) y[e] *= sc;
            pack16(U + (size_t)row * D + ch, y); }
    }
    bf16_t* Vt = (bf16_t*)(p.ws + WS_VT);
    for (int it = blockIdx.x * 8 + wave; it < T / 16; it += gridDim.x * 8) {
        const int row0 = it * 16, b = row0 >> 11, tl0 = row0 & (SEQ - 1), c8 = lane * 8, hd = c8 >> 6, d0 = c8 & 63;
        u32x4 w[16];
#pragma unroll
        for (int r = 0; r < 16; ++r) w[r] = *(const u32x4*)(P + (size_t)(row0 + r) * NIN + C_VSB + c8);
#pragma unroll
        for (int e = 0; e < 8; ++e) {
            unsigned o[8];
#pragma unroll
            for (int i = 0; i < 8; ++i) {
                const int p0 = 2 * i, p1 = 2 * i + 1;
                const int k0 = 8 * ((p0 >> 2) & 1) + 4 * (p0 >> 3) + (p0 & 3), k1 = 8 * ((p1 >> 2) & 1) + 4 * (p1 >> 3) + (p1 & 3);
                const unsigned a0 = w[k0][e >> 1], a1 = w[k1][e >> 1];
                const unsigned lo = (e & 1) ? (a0 >> 16) : (a0 & 0xffffu), hi = (e & 1) ? (a1 & 0xffff0000u) : (a1 << 16);
                o[i] = lo | hi; }
            bf16_t* dst = Vt + ((size_t)(b * 8 + hd) * 64 + d0 + e) * SEQ + tl0;
            ((u32x4*)dst)[0] = (u32x4){o[0], o[1], o[2], o[3]}; ((u32x4*)dst)[1] = (u32x4){o[4], o[5], o[6], o[7]}; }
    }
}

__device__ __forceinline__ float xlane32(float x, int hh) {
    const unsigned xi = __builtin_bit_cast(unsigned, x);
    const u32x2 r = __builtin_amdgcn_permlane32_swap(xi, xi, false, false);
    return __builtin_bit_cast(float, hh ? r.x : r.y);
}
template <bool DIAG>
__device__ __forceinline__ void attn_tile(const f32x16& z, const bf16x8 (&vc)[4], f32x16& o0, f32x16& o1, float& R, int ql, int hh) {
    float sg[16], m[16];
#pragma unroll
    for (int i = 0; i < 16; ++i) { const float e = __builtin_amdgcn_exp2f(fminf(-z[i], 80.0f)); float sig = __builtin_amdgcn_rcpf(1.0f + e); float mm = e * sig;
        if (DIAG) { const bool act = ((i & 3) + 8 * (i >> 2) + 4 * hh) < ql; sig = act ? sig : 0.f; mm = act ? mm : 1.0f; }
        sg[i] = sig; m[i] = mm; }
    float g[4], gp[4];
#pragma unroll
    for (int bq = 0; bq < 4; ++bq) { g[bq] = (m[4 * bq] * m[4 * bq + 1]) * (m[4 * bq + 2] * m[4 * bq + 3]); gp[bq] = xlane32(g[bq], hh); }
    float outer[4]; float tb = R;
#pragma unroll
    for (int bq = 3; bq >= 0; --bq) { outer[bq] = hh == 0 ? tb * gp[bq] : tb; tb *= g[bq] * gp[bq]; }
    R = tb;
    float w[16];
#pragma unroll
    for (int bq = 0; bq < 4; ++bq) { const float s3 = outer[bq], s2 = s3 * m[4 * bq + 3], s1 = s2 * m[4 * bq + 2], s0 = s1 * m[4 * bq + 1];
        w[4 * bq + 3] = sg[4 * bq + 3] * s3; w[4 * bq + 2] = sg[4 * bq + 2] * s2; w[4 * bq + 1] = sg[4 * bq + 1] * s1; w[4 * bq] = sg[4 * bq] * s0; }
    bf16x8 wf[2];
#pragma unroll
    for (int s2 = 0; s2 < 2; ++s2) { const u32x4 pw = {cpk2(w[8 * s2], w[8 * s2 + 1]), cpk2(w[8 * s2 + 2], w[8 * s2 + 3]), cpk2(w[8 * s2 + 4], w[8 * s2 + 5]), cpk2(w[8 * s2 + 6], w[8 * s2 + 7])}; wf[s2] = __builtin_bit_cast(bf16x8, pw); }
    o0 = __builtin_amdgcn_mfma_f32_32x32x16_bf16(vc[0], wf[0], o0, 0, 0, 0); o0 = __builtin_amdgcn_mfma_f32_32x32x16_bf16(vc[1], wf[1], o0, 0, 0, 0);
    o1 = __builtin_amdgcn_mfma_f32_32x32x16_bf16(vc[2], wf[0], o1, 0, 0, 0); o1 = __builtin_amdgcn_mfma_f32_32x32x16_bf16(vc[3], wf[1], o1, 0, 0, 0);
}
__device__ __forceinline__ void attn_item_mfma(bf16_t* P, const bf16_t* Vt, int bh, int qt, int lane) {
    asm volatile("" : "+v"(lane));
    const int b = bh >> 3, h = bh & 7, ql = lane & 31, hh = lane >> 5, q0 = qt * 32;
    bf16_t* qrow = P + (size_t)(b * SEQ + q0 + ql) * NIN + C_QSB + h * 64;
    bf16x8 qf[4];
#pragma unroll
    for (int s = 0; s < 4; ++s) qf[s] = *(const bf16x8*)(qrow + 16 * s + 8 * hh);
    f32x16 o0, o1;
#pragma unroll
    for (int i = 0; i < 16; ++i) { o0[i] = 0.f; o1[i] = 0.f; }
    float R = 1.0f;
    const bf16_t* kb = P + (size_t)(b * SEQ + ql) * NIN + C_KSB + h * 64 + 8 * hh;
    const bf16_t* vb = Vt + ((size_t)bh * 64 + ql) * SEQ + 8 * hh;
    bf16x8 kf[4], vf[4], vn[4];
#define AT_LOADK(k0_) do { _Pragma("unroll") for (int s = 0; s < 4; ++s) kf[s] = *(const bf16x8*)(kb + (size_t)(k0_) * NIN + 16 * s); } while (0)
#define AT_LOADV(dst, k0_) do { _Pragma("unroll") for (int j = 0; j < 4; ++j) dst[j] = *(const bf16x8*)(vb + (size_t)(j >> 1) * 32 * SEQ + (k0_) + 16 * (j & 1)); } while (0)
#define AT_QK(zz) do { _Pragma("unroll") for (int i = 0; i < 16; ++i) zz[i] = 0.f; _Pragma("unroll") for (int s = 0; s < 4; ++s) zz = __builtin_amdgcn_mfma_f32_32x32x16_bf16(kf[s], qf[s], zz, 0, 0, 0); } while (0)
    f32x16 zc, zn;
    AT_LOADK(q0); AT_LOADV(vf, q0);
    AT_QK(zc);
    { const int k1 = (qt > 0 ? qt - 1 : 0) * 32; AT_LOADK(k1); AT_LOADV(vn, k1); }
    { AT_QK(zn);
      const int k2 = (qt > 1 ? qt - 2 : 0) * 32; AT_LOADK(k2);
      attn_tile<true>(zc, vf, o0, o1, R, ql, hh);
      zc = zn;
#pragma unroll
      for (int j = 0; j < 4; ++j) vf[j] = vn[j];
      const int k1 = (qt > 1 ? qt - 2 : 0) * 32; AT_LOADV(vn, k1); }
#pragma unroll 1
    for (int kt = qt - 1; kt >= 0; --kt) {
        AT_QK(zn);
        const int k2 = (kt > 1 ? kt - 2 : 0) * 32; AT_LOADK(k2);
        attn_tile<false>(zc, vf, o0, o1, R, ql, hh);
        if (__builtin_amdgcn_ballot_w64(R != 0.0f) == 0ull) break;
        zc = zn;
#pragma unroll
        for (int j = 0; j < 4; ++j) vf[j] = vn[j];
        AT_LOADV(vn, k2);
    }
#undef AT_LOADK
#undef AT_LOADV
#undef AT_QK
#pragma unroll
    for (int bq = 0; bq < 4; ++bq) {
        u32x2 w0 = {cpk2(o0[4 * bq], o0[4 * bq + 1]), cpk2(o0[4 * bq + 2], o0[4 * bq + 3])}, w1 = {cpk2(o1[4 * bq], o1[4 * bq + 1]), cpk2(o1[4 * bq + 2], o1[4 * bq + 3])};
        *(u32x2*)(qrow + 8 * bq + 4 * hh) = w0; *(u32x2*)(qrow + 32 + 8 * bq + 4 * hh) = w1; }
}
__device__ __forceinline__ size_t slotU(size_t t0, int h, int colbase, int f) { return (t0 + (size_t)(f >> 7)) * D + colbase + h * 128 + (f & 127); }
__device__ __forceinline__ size_t slotP(size_t t0, int h, int colbase, int f) { return (t0 + (size_t)(f >> 7)) * NIN + colbase + h * 128 + (f & 127); }
__device__ __forceinline__ int permpos(int x) { const int k = x & 15; return (x & ~15) + 8 * ((k >> 2) & 1) + 4 * (k >> 3) + (k & 3); }
__device__ __forceinline__ int crow(int r, int hh) { return (r & 3) + 8 * (r >> 2) + 4 * hh; }
__device__ __forceinline__ bf16x8 pack8(const f32x16& x, int s2) {
    const u32x4 pw = {cpk2(x[8 * s2], x[8 * s2 + 1]), cpk2(x[8 * s2 + 2], x[8 * s2 + 3]), cpk2(x[8 * s2 + 4], x[8 * s2 + 5]), cpk2(x[8 * s2 + 6], x[8 * s2 + 7])};
    return __builtin_bit_cast(bf16x8, pw);
}
#define MFMA32(a, b, c) __builtin_amdgcn_mfma_f32_32x32x16_bf16((a), (b), (c), 0, 0, 0)
constexpr int PT = 72, PQ = 136, PL = 68, PB = 40;
constexpr int CP_GC = 0, CP_BT = 256, CP_LS = 1024, CP_TU = CP_LS + 64 * PL * 4, CP_TW = CP_TU + 64 * PT * 2, CP_KT = CP_TW + 64 * PT * 2, CP_VT = CP_KT + 128 * PT * 2,
              CP_QS = CP_VT + 128 * PT * 2, CP_KS = CP_QS + 64 * PQ * 2, CP_AQ = CP_KS + 64 * PQ * 2, CP_L21 = CP_AQ + 64 * PT * 2, CP_TCM = CP_L21 + 32 * PB * 2, CP_T22 = CP_TCM + 32 * PB * 2, CP_END = CP_T22 + 32 * PB * 2;
static_assert(CP_END <= 131072, "chunk prep LDS");
__device__ __forceinline__ void gdn_chunk_prep_phase(const Params& p, LAS unsigned char* lds, int tid, int wave, int lane) {
    bf16_t* P = (bf16_t*)(p.ws + WS_P); bf16_t* U = (bf16_t*)(p.ws + WS_U); const float* BG = (const float*)(p.ws + WS_BG);
    u32x4 ka, kb, qa, qb, xv[4][2]; float gx = 0.f, gbt = 0.f;
#define CP_LOAD(item_) do { const int bh_ = (item_) >> 5, n_ = (item_) & 31, b_ = bh_ >> 2, h_ = bh_ & 3; const size_t t0_ = (size_t)b_ * SEQ + n_ * 64; const int tok_ = tid & 63, c16_ = (tid >> 6) * 16; \
        ka = *(const u32x4*)(U + (t0_ + tok_) * D + 512 + h_ * 128 + c16_); kb = *(const u32x4*)(U + (t0_ + tok_) * D + 512 + h_ * 128 + c16_ + 8); \
        qa = *(const u32x4*)(U + (t0_ + tok_) * D + h_ * 128 + c16_); qb = *(const u32x4*)(U + (t0_ + tok_) * D + h_ * 128 + c16_ + 8); \
        _Pragma("unroll") for (int i = 0; i < 4; ++i) { const bool ok = n_ * 64 + tok_ - 3 + i >= 0; const bf16_t* vp = P + (t0_ + tok_ - 3 + i) * NIN + C_VDN + h_ * 128 + c16_; \
            xv[i][0] = ok ? *(const u32x4*)vp : (u32x4){0u, 0u, 0u, 0u}; xv[i][1] = ok ? *(const u32x4*)(vp + 8) : (u32x4){0u, 0u, 0u, 0u}; } \
        if (tid < 64) { gx = BG[(t0_ + tid) * 8 + 4 + h_]; gbt = BG[(t0_ + tid) * 8 + h_]; } } while (0)
    if ((int)blockIdx.x < 1024) CP_LOAD((int)blockIdx.x);
  for (int item = blockIdx.x; item < 1024; item += gridDim.x) {
    asm volatile("" : "+v"(tid), "+v"(lane));
    const int bh = item >> 5, n = item & 31, b = bh >> 2, h = bh & 3, ql = lane & 31, hh = lane >> 5;
    const size_t t0 = (size_t)b * SEQ + n * 64;
    LAS float* gcS = (LAS float*)(lds + CP_GC); LAS float* btS = (LAS float*)(lds + CP_BT);
    LAS float* LS = (LAS float*)(lds + CP_LS);
    LAS bf16_t* TuS = (LAS bf16_t*)(lds + CP_TU); LAS bf16_t* TwS = (LAS bf16_t*)(lds + CP_TW);
    LAS bf16_t* kT = (LAS bf16_t*)(lds + CP_KT); LAS bf16_t* vT = (LAS bf16_t*)(lds + CP_VT); LAS bf16_t* qS = (LAS bf16_t*)(lds + CP_QS); LAS bf16_t* kS = (LAS bf16_t*)(lds + CP_KS);
    LAS bf16_t* AQ = (LAS bf16_t*)(lds + CP_AQ); LAS bf16_t* L21b = (LAS bf16_t*)(lds + CP_L21); LAS bf16_t* Tcm = (LAS bf16_t*)(lds + CP_TCM); LAS bf16_t* T22r = (LAS bf16_t*)(lds + CP_T22);
    if (tid < 64) { float x = gx;
#pragma unroll
        for (int o = 1; o < 64; o <<= 1) { const float y = __shfl_up(x, o); if (lane >= o) x += y; }
        gcS[tid] = x; btS[tid] = gbt; }
    { const int tok = tid & 63, c16 = (tid >> 6) * 16;
        *(LAS u32x4*)(kS + tok * PQ + c16) = ka; *(LAS u32x4*)(kS + tok * PQ + c16 + 8) = kb;
        *(LAS u32x4*)(qS + tok * PQ + c16) = qa; *(LAS u32x4*)(qS + tok * PQ + c16 + 8) = qb;
        const unsigned kw[8] = {ka.x, ka.y, ka.z, ka.w, kb.x, kb.y, kb.z, kb.w};
#pragma unroll
        for (int e = 0; e < 8; ++e) { kT[(c16 + 2 * e) * PT + tok] = (bf16_t)(kw[e] & 0xffffu); kT[(c16 + 2 * e + 1) * PT + tok] = (bf16_t)(kw[e] >> 16); }
        float y[16];
#pragma unroll
        for (int e = 0; e < 16; ++e) y[e] = 0.f;
#pragma unroll
        for (int i = 0; i < 4; ++i) { const float* wp = p.in[I_WCONV] + i * 1536 + 1024 + h * 128 + c16;
            const unsigned xw[8] = {xv[i][0].x, xv[i][0].y, xv[i][0].z, xv[i][0].w, xv[i][1].x, xv[i][1].y, xv[i][1].z, xv[i][1].w};
#pragma unroll
            for (int e = 0; e < 8; ++e) { y[2 * e] += wp[2 * e] * bf_lo(xw[e]); y[2 * e + 1] += wp[2 * e + 1] * bf_hi(xw[e]); } }
#pragma unroll
        for (int e = 0; e < 16; ++e) vT[(c16 + e) * PT + tok] = f2bf(fsilu(y[e])); }
    LDS_BARRIER();
    if (item + (int)gridDim.x < 1024) CP_LOAD(item + (int)gridDim.x);
    if (wave == 0 || wave == 4 || wave == 5) {
        const int it = wave == 0 ? 0 : 1, jt = wave == 4 ? 1 : 0;
        f32x16 acc;
#pragma unroll
        for (int r = 0; r < 16; ++r) acc[r] = 0.f;
#pragma unroll
        for (int ks = 0; ks < 8; ++ks) acc = MFMA32(*(const LAS bf16x8*)(kS + (32 * it + ql) * PQ + 16 * ks + 8 * hh), *(const LAS bf16x8*)(kS + (32 * jt + ql) * PQ + 16 * ks + 8 * hh), acc);
        const int j = 32 * jt + ql; const float gj = gcS[j];
#pragma unroll
        for (int r = 0; r < 16; ++r) { const int i = 32 * it + crow(r, hh); const float l = (j < i) ? btS[i] * acc[r] * fexp(gcS[i] - gj) : 0.f;
            if (it != jt) L21b[(i - 32) * PB + j] = f2bf(l); else LS[i * PL + j] = l; }
    } else if (wave < 4) {
        const int jt = wave == 3 ? 1 : 0, it = wave == 1 ? 0 : 1;
        f32x16 acc;
#pragma unroll
        for (int r = 0; r < 16; ++r) acc[r] = 0.f;
#pragma unroll
        for (int ks = 0; ks < 8; ++ks) acc = MFMA32(*(const LAS bf16x8*)(kS + (32 * jt + ql) * PQ + 16 * ks + 8 * hh), *(const LAS bf16x8*)(qS + (32 * it + ql) * PQ + 16 * ks + 8 * hh), acc);
        const int i = 32 * it + ql; const float gi = gcS[i];
#pragma unroll
        for (int r = 0; r < 16; ++r) { const int j = 32 * jt + crow(r, hh); acc[r] = (j <= i) ? acc[r] * fexp(gi - gcS[j]) : 0.f; }
#pragma unroll
        for (int bq = 0; bq < 4; ++bq) *(LAS u32x2*)(AQ + i * PT + 32 * jt + 8 * bq + 4 * hh) = (u32x2){cpk2(acc[4 * bq], acc[4 * bq + 1]), cpk2(acc[4 * bq + 2], acc[4 * bq + 3])};
    } else {
        const float gl = gcS[63];
#pragma unroll
        for (int uu = 0; uu < 4; ++uu) { const int unit = (tid - 384) + 128 * uu, dk = unit >> 2, blk = unit & 3;
            const u32x4 k0 = *(const LAS u32x4*)(kT + dk * PT + 16 * blk), k1 = *(const LAS u32x4*)(kT + dk * PT + 16 * blk + 8);
            float kv[16] = {bf_lo(k0.x), bf_hi(k0.x), bf_lo(k0.y), bf_hi(k0.y), bf_lo(k0.z), bf_hi(k0.z), bf_lo(k0.w), bf_hi(k0.w), bf_lo(k1.x), bf_hi(k1.x), bf_lo(k1.y), bf_hi(k1.y), bf_lo(k1.z), bf_hi(k1.z), bf_lo(k1.w), bf_hi(k1.w)};
#pragma unroll
            for (int e = 0; e < 16; ++e) kv[e] *= fexp(gl - gcS[16 * blk + e]);
            float pv[16];
#pragma unroll
            for (int e = 0; e < 16; ++e) pv[permpos(e)] = kv[e];
            pack16(P + slotP(t0, h, C_VSB, dk * 64 + 16 * blk), pv); }
        if (tid == 384) ((float*)(p.ws + WS_EGL))[bh * 32 + n] = fexp(gl);
    }
    LDS_BARRIER();
    if (wave == 0) {
        const LAS float* LB = LS + (32 * hh) * PL + 32 * hh;
        float Tc[32];
        f32x4 lc[8], ln[8];
        Tc[0] = (ql == 0) ? 1.0f : 0.f;
        lc[0] = *(const LAS f32x4*)(LB + 1 * PL);
#pragma unroll
        for (int i = 1; i < 32; ++i) {
            if (i + 1 < 32) {
#pragma unroll
                for (int j4 = 0; j4 < i + 1; j4 += 4) ln[j4 >> 2] = *(const LAS f32x4*)(LB + (i + 1) * PL + j4); }
            float a0 = (ql == i) ? 1.0f : 0.f, a1 = 0.f, a2 = 0.f, a3 = 0.f;
#pragma unroll
            for (int j4 = 0; j4 < i; j4 += 4) { const f32x4 l4 = lc[j4 >> 2];
                a0 -= l4[0] * Tc[j4]; if (j4 + 1 < i) a1 -= l4[1] * Tc[j4 + 1]; if (j4 + 2 < i) a2 -= l4[2] * Tc[j4 + 2]; if (j4 + 3 < i) a3 -= l4[3] * Tc[j4 + 3]; }
            Tc[i] = (a0 + a1) + (a2 + a3);
#pragma unroll
            for (int q = 0; q < 8; ++q) lc[q] = ln[q]; }
        const int cg_ = 32 * hh + ql; const float bu = btS[cg_], bw = bu * fexp(gcS[cg_]);
#pragma unroll
        for (int i = 0; i < 32; ++i) { TuS[(32 * hh + i) * PT + cg_] = f2bf(Tc[i] * bu); TwS[(32 * hh + i) * PT + cg_] = f2bf(Tc[i] * bw); }
        if (hh == 0) {
#pragma unroll
            for (int i8 = 0; i8 < 4; ++i8) *(LAS u32x4*)(Tcm + ql * PB + 8 * i8) = (u32x4){cpk2(Tc[8 * i8], Tc[8 * i8 + 1]), cpk2(Tc[8 * i8 + 2], Tc[8 * i8 + 3]), cpk2(Tc[8 * i8 + 4], Tc[8 * i8 + 5]), cpk2(Tc[8 * i8 + 6], Tc[8 * i8 + 7])};
        } else {
#pragma unroll
            for (int i = 0; i < 32; ++i) T22r[i * PB + ql] = f2bf(Tc[i]);
        }
        LDS_WAIT();
        f32x16 x1;
#pragma unroll
        for (int r = 0; r < 16; ++r) x1[r] = 0.f;
#pragma unroll
        for (int s2 = 0; s2 < 2; ++s2) x1 = MFMA32(*(const LAS bf16x8*)(L21b + ql * PB + 16 * s2 + 8 * hh), *(const LAS bf16x8*)(Tcm + ql * PB + 16 * s2 + 8 * hh), x1);
        f32x16 yy;
#pragma unroll
        for (int r = 0; r < 16; ++r) yy[r] = 0.f;
#pragma unroll
        for (int s2 = 0; s2 < 2; ++s2) { const u32x2 lo = *(const LAS u32x2*)(T22r + ql * PB + 16 * s2 + 4 * hh), hi = *(const LAS u32x2*)(T22r + ql * PB + 16 * s2 + 8 + 4 * hh);
            const u32x4 af = {lo.x, lo.y, hi.x, hi.y};
            yy = MFMA32(__builtin_bit_cast(bf16x8, af), pack8(x1, s2), yy); }
        { const float bu0 = btS[ql], bw0 = bu0 * fexp(gcS[ql]);
#pragma unroll
            for (int r = 0; r < 16; ++r) { const int i2 = 32 + crow(r, hh); TuS[i2 * PT + ql] = f2bf(-yy[r] * bu0); TwS[i2 * PT + ql] = f2bf(-yy[r] * bw0); } }
    }
    LDS_BARRIER();
    {
        const int isW = wave >> 2, ct = wave & 3, col = 32 * ct + ql;
        const LAS bf16_t* Ta = (isW ? TwS : TuS) + 8 * hh; const LAS bf16_t* Bs = (isW ? kT : vT) + col * PT + 8 * hh;
        bf16x8 bf[4];
#pragma unroll
        for (int ks = 0; ks < 4; ++ks) bf[ks] = *(const LAS bf16x8*)(Bs + 16 * ks);
        f32x16 xa[2];
#pragma unroll
        for (int jt = 0; jt < 2; ++jt) {
#pragma unroll
            for (int r = 0; r < 16; ++r) xa[jt][r] = 0.f;
#pragma unroll
            for (int ks = 0; ks < 4; ++ks) if (jt == 1 || ks < 2) xa[jt] = MFMA32(*(const LAS bf16x8*)(Ta + (32 * jt + ql) * PT + 16 * ks), bf[ks], xa[jt]); }
        bf16x8 xb[4] = {pack8(xa[0], 0), pack8(xa[0], 1), pack8(xa[1], 0), pack8(xa[1], 1)};
        f32x16 ra[2];
#pragma unroll
        for (int it = 0; it < 2; ++it) {
#pragma unroll
            for (int r = 0; r < 16; ++r) ra[it][r] = 0.f;
#pragma unroll
            for (int kk = 0; kk < 4; ++kk) if (it == 1 || kk < 2) { const LAS bf16_t* ap = AQ + (32 * it + ql) * PT + 16 * kk + 4 * hh;
                const u32x2 lo = *(const LAS u32x2*)ap, hi = *(const LAS u32x2*)(ap + 8); const u32x4 af = {lo.x, lo.y, hi.x, hi.y};
                ra[it] = MFMA32(__builtin_bit_cast(bf16x8, af), xb[kk], ra[it]); } }
        if (!isW) {
#pragma unroll
            for (int jt = 0; jt < 2; ++jt)
#pragma unroll
                for (int bq = 0; bq < 4; ++bq) { const int f = col * 64 + 32 * jt + 8 * bq + 4 * hh;
                    *(u32x2*)(U + slotU(t0, h, 0, f)) = (u32x2){cpk2(xa[jt][4 * bq], xa[jt][4 * bq + 1]), cpk2(xa[jt][4 * bq + 2], xa[jt][4 * bq + 3])};
                    *(u32x2*)(U + slotU(t0, h, 512, f)) = (u32x2){cpk2(ra[jt][4 * bq], ra[jt][4 * bq + 1]), cpk2(ra[jt][4 * bq + 2], ra[jt][4 * bq + 3])}; }
        } else {
            const int pc = permpos(col);
#pragma unroll
            for (int jt = 0; jt < 2; ++jt)
#pragma unroll
                for (int r = 0; r < 16; ++r) { const int tok = 32 * jt + crow(r, hh);
                    P[(t0 + tok) * NIN + C_QDN + h * 128 + pc] = f2bf(-xa[jt][r]);
                    P[(t0 + tok) * NIN + C_KDN + h * 128 + pc] = f2bf(bf2f(qS[tok * PQ + col]) * fexp(gcS[tok]) - ra[jt][r]); }
        }
    }
    LDS_BARRIER();
  }
#undef CP_LOAD
}
constexpr int SC_PW = 136, SC_PK = 72, SC_NW = 0, SC_Q2 = 64 * SC_PW * 2, SC_KD = 2 * 64 * SC_PW * 2, SC_STAGE = 2 * 64 * SC_PW * 2 + 128 * SC_PK * 2, SC_OS = 2 * SC_STAGE,
              SC_US = SC_OS + 128 * SC_PK * 2, SC_OI = SC_US + 128 * SC_PK * 2, SC_END = SC_OI + 128 * SC_PK * 2;
static_assert(SC_END <= BST_OFF, "scan LDS");
__device__ __forceinline__ void gdn_scan_block(const Params& p, LAS unsigned char* lds, int bh, int tid, int wave, int lane) {
    asm volatile("" : "+v"(tid), "+v"(lane));
    bf16_t* P = (bf16_t*)(p.ws + WS_P); const bf16_t* U = (const bf16_t*)(p.ws + WS_U); const float* EGL = (const float*)(p.ws + WS_EGL);
    const int b = bh >> 2, h = bh & 3, ql = lane & 31, hh = lane >> 5;
    const size_t tb = (size_t)b * SEQ;
    LAS bf16_t* oS = (LAS bf16_t*)(lds + SC_OS);
    if (wave >= 4) {
        int lt = tid - 256, ftok = lt >> 2, fseg = lt & 3;
        u32x4 ra[20], rb[20];
#define SC_LOAD(r, n_) do { const size_t t0_ = tb + (size_t)(n_) * 64; _Pragma("unroll") for (int i = 0; i < 4; ++i) { const int c = lt + 256 * i, row = c >> 4, c8 = (c & 15) * 8; \
            const bf16_t* g_ = P + (t0_ + row) * NIN + h * 128 + c8; const bf16_t* u_ = U + (t0_ + row) * D + h * 128 + c8; \
            r[i] = *(const u32x4*)(g_ + C_QDN); r[4 + i] = *(const u32x4*)(g_ + C_KDN); r[8 + i] = *(const u32x4*)(g_ + C_VSB); r[12 + i] = *(const u32x4*)u_; r[16 + i] = *(const u32x4*)(u_ + 512); } } while (0)
#define SC_STORE(r, st_) do { LAS unsigned char* s_ = lds + (st_) * SC_STAGE; _Pragma("unroll") for (int i = 0; i < 4; ++i) { const int c = lt + 256 * i, row = c >> 4, c8 = (c & 15) * 8; \
            *(LAS u32x4*)(s_ + SC_NW + (row * SC_PW + c8) * 2) = r[i]; *(LAS u32x4*)(s_ + SC_Q2 + (row * SC_PW + c8) * 2) = r[4 + i]; \
            *(LAS u32x4*)(s_ + SC_KD + ((2 * row + (c8 >> 6)) * SC_PK + (c8 & 63)) * 2) = r[8 + i]; } } while (0)
#define SC_STOREU(r) do { _Pragma("unroll") for (int i = 0; i < 4; ++i) { const int c = lt + 256 * i, row = c >> 4, c8 = (c & 15) * 8; const int o_ = ((2 * row + (c8 >> 6)) * SC_PK + (c8 & 63)) * 2; \
            *(LAS u32x4*)(lds + SC_US + o_) = r[12 + i]; *(LAS u32x4*)(lds + SC_OI + o_) = r[16 + i]; } } while (0)
#define SC_FIN(m_) do { bf16_t* orow = P + (tb + (size_t)(m_) * 64 + ftok) * NIN + h * 128 + fseg * 32 + C_VDN; \
            _Pragma("unroll") for (int i = 0; i < 4; ++i) { unsigned w_[4]; \
                _Pragma("unroll") for (int j = 0; j < 4; ++j) { const int c_ = fseg * 32 + 8 * i + 2 * j; w_[j] = (unsigned)oS[c_ * SC_PK + ftok] | ((unsigned)oS[(c_ + 1) * SC_PK + ftok] << 16); } \
                *(u32x4*)(orow + 8 * i) = (u32x4){w_[0], w_[1], w_[2], w_[3]}; } } while (0)
        SC_LOAD(ra, 0); SC_STORE(ra, 0); SC_STOREU(ra); SC_LOAD(ra, 1);
        LDS_BARRIER();
#pragma unroll 1
        for (int n = 0; n < 32; n += 2) {
            asm volatile("" : "+v"(lt), "+v"(ftok), "+v"(fseg));
            if (n + 2 < 32) SC_LOAD(rb, n + 2);
            SC_STORE(ra, 1);
            if (n > 0) SC_FIN(n - 1);
            LDS_BARRIER();
            SC_STOREU(ra);
            LDS_BARRIER();
            if (n + 3 < 32) SC_LOAD(ra, n + 3);
            if (n + 2 < 32) SC_STORE(rb, 0);
            SC_FIN(n);
            LDS_BARRIER();
            if (n + 2 < 32) SC_STOREU(rb);
            LDS_BARRIER();
        }
        SC_FIN(31);
#undef SC_LOAD
#undef SC_STORE
#undef SC_STOREU
#undef SC_FIN
    } else {
        const int col = 32 * wave + ql;
        f32x16 S[4];
#pragma unroll
        for (int rt = 0; rt < 4; ++rt)
#pragma unroll
            for (int r = 0; r < 16; ++r) S[rt][r] = 0.f;
        const float eglv = EGL[bh * 32 + ql];
        LDS_BARRIER();
#pragma unroll 1
        for (int n = 0; n < 32; ++n) {
            const float egl = __builtin_bit_cast(float, __builtin_amdgcn_readlane(__builtin_bit_cast(int, eglv), n));
            const LAS unsigned char* st = lds + (n & 1) * SC_STAGE;
            f32x16 vn[2], oa[2];
            { const LAS unsigned char* up_ = lds + SC_US + (col * SC_PK + 4 * hh) * 2; const LAS unsigned char* op_ = lds + SC_OI + (col * SC_PK + 4 * hh) * 2;
#pragma unroll
              for (int jt = 0; jt < 2; ++jt)
#pragma unroll
                for (int bq = 0; bq < 4; ++bq) { const u32x2 uw = *(const LAS u32x2*)(up_ + (32 * jt + 8 * bq) * 2), ow = *(const LAS u32x2*)(op_ + (32 * jt + 8 * bq) * 2);
                    vn[jt][4 * bq] = bf_lo(uw.x); vn[jt][4 * bq + 1] = bf_hi(uw.x); vn[jt][4 * bq + 2] = bf_lo(uw.y); vn[jt][4 * bq + 3] = bf_hi(uw.y);
                    oa[jt][4 * bq] = bf_lo(ow.x); oa[jt][4 * bq + 1] = bf_hi(ow.x); oa[jt][4 * bq + 2] = bf_lo(ow.y); oa[jt][4 * bq + 3] = bf_hi(ow.y); } }
            const LAS unsigned char* w0_ = st + (ql * SC_PW + 8 * hh) * 2; const LAS unsigned char* w1_ = w0_ + 32 * SC_PW * 2;
            const LAS unsigned char* kd_ = st + SC_KD + (ql * SC_PK + 8 * hh) * 2;
            bf16x8 fa[4], fb[4];
#define SC_RD4(dst, ptr) do { _Pragma("unroll") for (int i_ = 0; i_ < 4; ++i_) dst[i_] = *(const LAS bf16x8*)((ptr) + 32 * i_); } while (0)
#define SC_MM4(acc, fr, bb) do { _Pragma("unroll") for (int i_ = 0; i_ < 4; ++i_) acc = MFMA32(fr[i_], bb[i_], acc); __builtin_amdgcn_sched_barrier(0); } while (0)
            SC_RD4(fa, w0_ + SC_NW); SC_RD4(fb, w1_ + SC_NW);
            { bf16x8 sb[4] = {pack8(S[0], 0), pack8(S[0], 1), pack8(S[1], 0), pack8(S[1], 1)};
              SC_MM4(vn[0], fa, sb); SC_RD4(fa, w0_ + SC_Q2);
              SC_MM4(vn[1], fb, sb); SC_RD4(fb, w1_ + SC_Q2);
              SC_MM4(oa[0], fa, sb); SC_RD4(fa, w0_ + SC_NW + 128);
              SC_MM4(oa[1], fb, sb); SC_RD4(fb, w1_ + SC_NW + 128); }
            { bf16x8 sb[4] = {pack8(S[2], 0), pack8(S[2], 1), pack8(S[3], 0), pack8(S[3], 1)};
              SC_MM4(vn[0], fa, sb); SC_RD4(fa, w0_ + SC_Q2 + 128);
              SC_MM4(vn[1], fb, sb); SC_RD4(fb, w1_ + SC_Q2 + 128);
              bf16x8 vb[4] = {pack8(vn[0], 0), pack8(vn[0], 1), pack8(vn[1], 0), pack8(vn[1], 1)};
              SC_MM4(oa[0], fa, sb); SC_RD4(fa, kd_);
              SC_MM4(oa[1], fb, sb); SC_RD4(fb, kd_ + 32 * SC_PK * 2);
#pragma unroll
              for (int rt = 0; rt < 4; ++rt)
#pragma unroll
                  for (int r = 0; r < 16; ++r) S[rt][r] *= egl;
              SC_MM4(S[0], fa, vb); SC_RD4(fa, kd_ + 64 * SC_PK * 2);
              SC_MM4(S[1], fb, vb); SC_RD4(fb, kd_ + 96 * SC_PK * 2);
              SC_MM4(S[2], fa, vb);
              SC_MM4(S[3], fb, vb); }
#undef SC_RD4
#undef SC_MM4
            LDS_BARRIER();
#pragma unroll
            for (int jt = 0; jt < 2; ++jt)
#pragma unroll
                for (int bq = 0; bq < 4; ++bq) *(LAS u32x2*)(oS + col * SC_PK + 32 * jt + 8 * bq + 4 * hh) = (u32x2){cpk2(oa[jt][4 * bq], oa[jt][4 * bq + 1]), cpk2(oa[jt][4 * bq + 2], oa[jt][4 * bq + 3])};
            LDS_BARRIER();
        }
    }
}
__device__ __forceinline__ void gdn_finalize_phase(const Params& p, int wave, int lane) {
    asm volatile("" : "+v"(lane));
    bf16_t* P = (bf16_t*)(p.ws + WS_P);
    const int c0 = (lane & 15) * 8;
    float gg[8];
#pragma unroll
    for (int e = 0; e < 8; ++e) gg[e] = p.in[I_GDNOUT][c0 + e];
    for (int row = blockIdx.x * 8 + wave; row < T; row += gridDim.x * 8) {
        bf16_t* op = P + (size_t)row * NIN + C_VDN + lane * 8; const bf16_t* zp = P + (size_t)row * NIN + C_ZDN + lane * 8;
        const u32x4 ow = *(const u32x4*)op, zw = *(const u32x4*)zp;
        const float o[8] = {bf_lo(ow.x), bf_hi(ow.x), bf_lo(ow.y), bf_hi(ow.y), bf_lo(ow.z), bf_hi(ow.z), bf_lo(ow.w), bf_hi(ow.w)};
        const float z[8] = {bf_lo(zw.x), bf_hi(zw.x), bf_lo(zw.y), bf_hi(zw.y), bf_lo(zw.z), bf_hi(zw.z), bf_lo(zw.w), bf_hi(zw.w)};
        float ss = 0.f;
#pragma unroll
        for (int e = 0; e < 8; ++e) ss += o[e] * o[e];
        ss += __shfl_xor(ss, 1); ss += __shfl_xor(ss, 2); ss += __shfl_xor(ss, 4); ss += __shfl_xor(ss, 8);
        const float rstd = 1.0f / sqrtf(ss * (1.f / 128.f) + EPS);
        float r[8];
#pragma unroll
        for (int e = 0; e < 8; ++e) r[e] = o[e] * rstd * gg[e] * fsilu(z[e]);
        u32x4 w; w.x = pk2(r[0], r[1]); w.y = pk2(r[2], r[3]); w.z = pk2(r[4], r[5]); w.w = pk2(r[6], r[7]);
        *(u32x4*)op = w;
    }
}

#define XB_TMO      128
#define XB_XCNT(j)  (256  + 64 * (j))
#define XB_XSUB(j)  (1280 + 64 * (j))
#define XB_XGEN(j)  (2304 + 64 * (j))
#define XB_TOP      3328
#define XB_TOPGEN   3392
#define XCD_BAR_WORDS 3456
#define XB_SPIN_CAP (1u << 18)
__device__ __forceinline__ unsigned xb_ld(unsigned* p)              { return __hip_atomic_load(p, __ATOMIC_RELAXED, __HIP_MEMORY_SCOPE_AGENT); }
__device__ __forceinline__ unsigned xb_add(unsigned* p, unsigned v) { return __hip_atomic_fetch_add(p, v, __ATOMIC_RELAXED, __HIP_MEMORY_SCOPE_AGENT); }
__device__ __forceinline__ unsigned xb_xcc_id() { return (unsigned)__builtin_amdgcn_s_getreg((3 << 11) | 20) & 0xFu; }
#define XB_SPIN(cond, bar) do { unsigned _sp = 0; while (cond) { __builtin_amdgcn_s_sleep(1); \
    if ((++_sp & 255u) == 0u) { if (xb_ld(&(bar)[XB_TMO])) break; if (_sp > XB_SPIN_CAP) { atomicAdd(&(bar)[XB_TMO], 1u); break; } } } } while (0)
struct XcdBarrier { unsigned* bar; unsigned x; volatile LAS unsigned* st; };
__device__ __forceinline__ XcdBarrier xcd_barrier_post(unsigned* bar, volatile LAS unsigned* st) {
    XcdBarrier b; b.bar = bar; b.x = xb_xcc_id(); b.st = st;
    if (threadIdx.x == 0) (void)xb_add(&bar[XB_XCNT(b.x)], 1u);
    return b;
}
__device__ __forceinline__ void xcd_barrier_complete(unsigned* bar, unsigned x, unsigned& nloc, unsigned& nx) {
    const unsigned G = gridDim.x * gridDim.y * gridDim.z;
    unsigned sum, cnt, mine, sp = 0u;
    for (;;) {
        sum = 0u; cnt = 0u; mine = 0u;
#pragma unroll
        for (unsigned j = 0; j < 16; ++j) { const unsigned c = xb_ld(&bar[XB_XCNT(j)]); sum += c; cnt += (c > 0u) ? 1u : 0u; mine = (j == x) ? c : mine; }
        if (sum == G) break;
        __builtin_amdgcn_s_sleep(1);
        if ((++sp & 255u) == 0u) { if (xb_ld(&bar[XB_TMO])) break; if (sp > XB_SPIN_CAP) { atomicAdd(&bar[XB_TMO], 1u); break; } }
    }
    nloc = mine > 0u ? mine : 1u; nx = cnt > 0u ? cnt : 1u;
}
__device__ __forceinline__ void xcd_barrier(const XcdBarrier& b) {
    asm volatile("s_waitcnt vmcnt(0)" ::: "memory");
    __syncthreads();
    if (threadIdx.x == 0) {
        unsigned* bar = b.bar;
        __builtin_amdgcn_s_waitcnt(0);
        unsigned nloc = b.st[0], nx = b.st[1];
        if (nloc == 0u) { xcd_barrier_complete(bar, b.x, nloc, nx); b.st[0] = nloc; b.st[1] = nx; }
        const unsigned old = xb_add(&bar[XB_XSUB(b.x)], 1u);
        const unsigned gen = old / nloc;
        if (old + 1u == (gen + 1u) * nloc) {
            __builtin_amdgcn_fence(__ATOMIC_RELEASE, "agent");
            asm volatile("s_waitcnt vmcnt(0)" ::: "memory");
            const unsigned og = xb_add(&bar[XB_TOP], 1u);
            const unsigned tg = og / nx;
            if (og + 1u == (tg + 1u) * nx) xb_add(&bar[XB_TOPGEN], 1u);
            else XB_SPIN(xb_ld(&bar[XB_TOPGEN]) == tg, bar);
            __builtin_amdgcn_fence(__ATOMIC_ACQUIRE, "agent");
            xb_add(&bar[XB_XGEN(b.x)], 1u);
            asm volatile("s_waitcnt vmcnt(0)" ::: "memory");
        } else {
            XB_SPIN(xb_ld(&bar[XB_XGEN(b.x)]) == gen, bar);
            __builtin_amdgcn_fence(__ATOMIC_ACQUIRE, "agent");
            asm volatile("s_waitcnt vmcnt(0)" ::: "memory");
        }
    }
    __syncthreads();
}

#ifndef PHMASK
#define PHMASK 0xFFFF
#endif
#define PH(n) ((PHMASK >> (n)) & 1)
#ifndef PROBE
#define PROBE 0
#endif
#define REP(g) for (int _rep = 0; _rep < ((PROBE == (g)) ? 2 : 1); ++_rep)
__global__ void __launch_bounds__(512, 2) fwd_megakernel(Params p) {
    extern __shared__ __attribute__((aligned(16))) unsigned char lds_raw[];
    LAS unsigned char* lds = (LAS unsigned char*)lds_raw;
    cg::grid_group grid = cg::this_grid();
    const int tid = threadIdx.x, lane = tid & 63, wave = __builtin_amdgcn_readfirstlane(tid >> 6);
    const int G = gridDim.x, gw = wave * G + blockIdx.x, ngw = G * 8;
    unsigned char* ws = p.ws;
    bf16_t* U = (bf16_t*)(ws + WS_U); bf16_t* P = (bf16_t*)(ws + WS_P);
    const float* mod = (const float*)(ws + WS_MOD);
    LAS float* scr = (LAS float*)(lds + wave * 16384);

    unsigned* barw = (unsigned*)(ws + WS_BAR);
    volatile LAS unsigned* bst = (volatile LAS unsigned*)(lds + BST_OFF);
    if (tid < 2) bst[tid] = 0u;
    __syncthreads();
    if (p.ws == nullptr) grid.sync();
    const XcdBarrier xbar = xcd_barrier_post(barw, bst);
    REP(1) { if (PH(0)) for (int it = blockIdx.x; it < NMOD / 64; it += G) mod_item(p, lds, it, tid, wave, lane);
    { const int nmod = NMOD / 64;
      if (PH(0)) { if (G >= nmod + 64) { if ((int)blockIdx.x >= nmod) ffn_weight_items(p.in[I_WFFN1IN], p.in[I_WFFN1OUT], (bf16_t*)(ws + W_FFIN), (bf16_t*)(ws + W_FFOUT), scr, wave * (G - nmod) + ((int)blockIdx.x - nmod), (G - nmod) * 8, lane); }
                   else ffn_weight_items(p.in[I_WFFN1IN], p.in[I_WFFN1OUT], (bf16_t*)(ws + W_FFIN), (bf16_t*)(ws + W_FFOUT), scr, gw, ngw, lane); } }
    __syncthreads(); }
    xcd_barrier(xbar);
    if (PROBE == 3) for (int i = 0; i < 16; ++i) xcd_barrier(xbar);
    REP(1) if (PH(1)) norm_mod_phase<false>(p, lds, p.in[I_X], p.in[I_GFFN1], 0, U, tid, wave, lane);
    xcd_barrier(xbar);
    REP(2) if (PH(2)) run_gemm(lds, U, D, (const bf16_t*)(ws + W_FFIN), 2 * FF, D, EpiSwiGLU{P, FF});
    { const int nfull = (64 * 22) % G, nidle = nfull ? G - nfull : G;
      const int ib = nfull ? (int)blockIdx.x - nfull : (int)blockIdx.x;
      if (PH(0) && ib >= 0) mixer_weight_items(p, scr, wave * nidle + ib, nidle * 8, lane); }
    xcd_barrier(xbar);
    const bool fusedn = (G == 256);
    unsigned* xslot = (unsigned*)(ws + WS_XSLOT); unsigned* xcnt = (unsigned*)(ws + WS_XCNT);
    if (fusedn) { if (PH(3)) run_gemm(lds, P, FF, (const bf16_t*)(ws + W_FFOUT), D, FF, EpiResidNorm{p.in[I_X], p.out, mod + 2 * D, p.in[I_GMIX], mod + 3 * D, U, xslot, xcnt, 0.5f, 0}); }
    else { REP(2) if (PH(3)) run_gemm(lds, P, FF, (const bf16_t*)(ws + W_FFOUT), D, FF, EpiResid{p.in[I_X], p.out, mod + 2 * D, 0.5f}); }
    xcd_barrier(xbar);
    if (!fusedn) { REP(1) if (PH(4)) norm_mod_phase<true>(p, lds, p.out, p.in[I_GMIX], 3, U, tid, wave, lane); xcd_barrier(xbar); }
    REP(2) if (PH(5)) run_gemm(lds, U, D, (const bf16_t*)(ws + W_IN), NIN, D, EpiBf16{P, NIN});
    { const int nfull = (64 * 22) % G, nidle = nfull ? G - nfull : G; const int ib = nfull ? (int)blockIdx.x - nfull : (int)blockIdx.x;
      if (PH(12) && ib >= 0) ffn_weight_items(p.in[I_WFFN2IN], p.in[I_WFFN2OUT], (bf16_t*)(ws + WS_F2IN), (bf16_t*)(ws + W_FFOUT), scr, wave * nidle + ib, nidle * 8, lane, 0, 2816); }
    xcd_barrier(xbar);
    if (PH(6)) prep_phase(p, lds, fusedn, tid, wave, lane);
    xcd_barrier(xbar);
    if (PH(7)) gdn_chunk_prep_phase(p, lds, tid, wave, lane);
    xcd_barrier(xbar);
    if (PH(15)) for (int it = blockIdx.x; it < 32; it += G) gdn_scan_block(p, lds, it, tid, wave, lane);
    if (PH(8)) {
        const unsigned x0 = xb_xcc_id() & 7u;
        for (unsigned dx = 0; dx < 8u; ++dx) { const unsigned x = (x0 + dx) & 7u; unsigned* ctr = (unsigned*)(ws + WS_CTR) + 64 * x;
            for (;;) { unsigned idx = 0; if (lane == 0) idx = atomicAdd(ctr, 1u); idx = __builtin_amdgcn_readfirstlane(idx);
                if (idx >= 512u) break;
                attn_item_mfma(P, (const bf16_t*)(ws + WS_VT), (int)(8u * x + (idx & 7u)), 63 - (int)(idx >> 3), lane); } } }
    xcd_barrier(xbar);
    if (PH(9)) gdn_finalize_phase(p, wave, lane);
    xcd_barrier(xbar);
    if (PH(10)) run_gemm(lds, P + C_QSB, NIN, (const bf16_t*)(ws + W_UPSB), D, 1024, EpiGateFused{P + C_RSB, P + C_RDN, U}, 8, (C_VDN - C_QSB) * 2 - 8 * 128);
    if (fusedn && PH(12)) ffn_weight_items(p.in[I_WFFN2IN], p.in[I_WFFN2OUT], (bf16_t*)(ws + WS_F2IN), (bf16_t*)(ws + W_FFOUT), scr, gw, ngw, lane, 2816, 2816 + 1408);
    xcd_barrier(xbar);
    if (fusedn) { if (PH(11)) run_gemm(lds, U, D, (const bf16_t*)(ws + W_OUT), D, D, EpiResidNorm{p.out, p.out, mod + 5 * D, p.in[I_GFFN2], mod + 6 * D, U, xslot + 64 * 256 * 4, xcnt + 64 * 64, 1.0f, 0}); }
    else { if (PH(11)) run_gemm(lds, U, D, (const bf16_t*)(ws + W_OUT), D, D, EpiResid{p.out, p.out, mod + 5 * D, 1.0f}); }
    xcd_barrier(xbar);
    if (!fusedn) { REP(1) if (PH(12)) norm_mod_phase<false>(p, lds, p.out, p.in[I_GFFN2], 6, U, tid, wave, lane);
        __syncthreads();
        if (PH(12)) ffn_weight_items(p.in[I_WFFN2IN], p.in[I_WFFN2OUT], (bf16_t*)(ws + WS_F2IN), (bf16_t*)(ws + W_FFOUT), scr, gw, ngw, lane, 2816, 2816 + 1408);
        xcd_barrier(xbar); }
    REP(2) if (PH(13)) run_gemm(lds, U, D, (const bf16_t*)(ws + WS_F2IN), 2 * FF, D, EpiSwiGLU{P, FF});
    xcd_barrier(xbar);
    if (PH(14)) run_gemm(lds, P, FF, (const bf16_t*)(ws + W_FFOUT), D, FF, EpiResid{p.out, p.out, mod + 8 * D, 0.5f});
}

extern "C" void kernel_launch(void* const* d_in, const int* in_sizes, int n_in, void* d_out, int out_size, void* d_ws, size_t ws_size, hipStream_t stream) {
    static int grid_blocks = 0;
    if (!grid_blocks) {
        int dev = 0, cus = 0, per_cu = 0;
        (void)hipGetDevice(&dev);
        (void)hipDeviceGetAttribute(&cus, hipDeviceAttributeMultiprocessorCount, dev);
        (void)hipFuncSetAttribute((const void*)fwd_megakernel, hipFuncAttributeMaxDynamicSharedMemorySize, LDS_BYTES);
        (void)hipOccupancyMaxActiveBlocksPerMultiprocessor(&per_cu, (const void*)fwd_megakernel, 512, LDS_BYTES);
        if (per_cu < 1) { fprintf(stderr, "occupancy query says %d blocks/CU\n", per_cu); per_cu = 1; }
        grid_blocks = cus;
    }
    Params p{};
    for (int i = 0; i < N_IN; ++i) p.in[i] = (const float*)d_in[i];
    p.out = (float*)d_out; p.ws = (unsigned char*)d_ws;
    static_assert(WS_BAR + XCD_BAR_WORDS * 4 <= WS_XCNT, "control words");
    (void)hipMemsetAsync((char*)d_ws + WS_CTR, 0, WS_ZEND - WS_CTR, stream);
    void* args[] = {&p};
    hipError_t e = hipLaunchCooperativeKernel((const void*)fwd_megakernel, dim3(grid_blocks), dim3(512), args, LDS_BYTES, stream);
    if (e != hipSuccess) fprintf(stderr, "cooperative launch failed: %s (grid %d)\n", hipGetErrorString(e), grid_blocks);
}
```

```cpp
#include <hip/hip_runtime.h>
#include <hip/hip_cooperative_groups.h>
#include <cstdio>
namespace cg = cooperative_groups;

#define LAS __attribute__((address_space(3)))
typedef unsigned short bf16_t;
typedef short bf16x8 __attribute__((ext_vector_type(8)));
typedef float f32x4 __attribute__((ext_vector_type(4)));
typedef unsigned u32x4 __attribute__((ext_vector_type(4)));
typedef unsigned u32x2 __attribute__((ext_vector_type(2)));
typedef float f32x16 __attribute__((ext_vector_type(16)));
typedef float f32x2 __attribute__((ext_vector_type(2)));
typedef __bf16 nbf16x2 __attribute__((ext_vector_type(2)));

constexpr int T = 16384, D = 1024, SEQ = 2048, NB = 8, FF = 2816, NIN = 5632, INW = 5640, NMOD = 9216;
constexpr int C_QSB = 0, C_KSB = 512, C_VSB = 1024, C_QDN = 1536, C_KDN = 2048, C_VDN = 2560, C_ZDN = 3072, C_RSB = 3584, C_RDN = 4608;
constexpr float EPS = 1e-6f;
constexpr int LDS_BYTES = 163840, BST_OFF = LDS_BYTES - 64;
constexpr size_t MiB = 1024 * 1024;
constexpr size_t WS_MOD = 0, WS_BG = 512 * 1024, WS_SS = 242 * MiB, WS_W = 2 * MiB;
constexpr size_t W_FFIN = WS_W, W_FFOUT = W_FFIN + (size_t)2 * FF * D * 2, W_IN = W_FFOUT + (size_t)D * FF * 2, W_UPSB = W_IN + (size_t)NIN * D * 2,
                 W_UPDN = W_UPSB + (size_t)D * 512 * 2, W_OUT = W_UPDN + (size_t)D * 512 * 2, W_END = W_OUT + (size_t)D * D * 2;
constexpr size_t WS_U = 34 * MiB, WS_P = 66 * MiB, WS_F2IN = 242 * MiB;
static_assert(W_END <= WS_U, "weights overflow");
constexpr size_t WS_EGL = 384 * 1024, WS_CTR = 400 * 1024, WS_BAR = 416 * 1024, WS_XCNT = 432 * 1024, WS_ZEND = 464 * 1024;
constexpr size_t WS_XSLOT = 1 * MiB;
constexpr size_t WS_VT = W_FFIN;
static_assert((size_t)T * 512 * 2 <= W_IN - W_FFIN, "Vt overflow");

enum { I_X = 0, I_C, I_WADA, I_BADA, I_GFFN1, I_WFFN1IN, I_WFFN1OUT, I_GMIX, I_WIN, I_GQSB, I_GKSB, I_WCONV, I_ALOG, I_DTBIAS, I_GDNOUT, I_WUPSB, I_WUPDN, I_WOUT, I_GFFN2, I_WFFN2IN, I_WFFN2OUT, N_IN };
struct Params { const float* in[N_IN]; float* out; unsigned char* ws; };

__device__ __forceinline__ float bf_lo(unsigned w) { return __uint_as_float(w << 16); }
__device__ __forceinline__ float bf_hi(unsigned w) { return __uint_as_float(w & 0xffff0000u); }
__device__ __forceinline__ float bf2f(bf16_t b) { return __uint_as_float(((unsigned)b) << 16); }
__device__ __forceinline__ unsigned pk2(float lo, float hi) { unsigned r; asm("v_cvt_pk_bf16_f32 %0, %1, %2" : "=v"(r) : "v"(lo), "v"(hi)); return r; }
__device__ __forceinline__ unsigned cpk2(float lo, float hi) { const f32x2 v = {lo, hi}; return __builtin_bit_cast(unsigned, __builtin_convertvector(v, nbf16x2)); }
__device__ __forceinline__ bf16_t f2bf(float f) { return (bf16_t)(pk2(f, 0.f) & 0xffffu); }
__device__ __forceinline__ float fexp(float x) { return __builtin_amdgcn_exp2f(x * 1.4426950408889634f); }
__device__ __forceinline__ float flog(float x) { return __builtin_amdgcn_logf(x) * 0.6931471805599453f; }
__device__ __forceinline__ float fsigmoid(float x) { return __builtin_amdgcn_rcpf(1.f + fexp(-x)); }
__device__ __forceinline__ float fsilu(float x) { return x * fsigmoid(x); }
__device__ __forceinline__ float fsoftplus(float x) { return fmaxf(x, 0.f) + flog(1.f + fexp(-fabsf(x))); }
__device__ __forceinline__ float wave_sum(float v) {
#pragma unroll
    for (int o = 1; o < 64; o <<= 1) v += __shfl_xor(v, o);
    return v;
}
#define LDS_WAIT() asm volatile("s_waitcnt lgkmcnt(0)" ::: "memory")
#define LDS_BARRIER() do { asm volatile("s_waitcnt lgkmcnt(0)" ::: "memory"); __builtin_amdgcn_s_barrier(); asm volatile("" ::: "memory"); } while (0)

namespace pg8 {
constexpr int BM = 256, BK = 64, HALF = 128, HTB = HALF * BK * 2, STAGE_BYTES = 8 * HTB, NXCD = 8, WGM = 8;
__host__ __device__ __forceinline__ int lds_byte(int r, int c) { const int st = (r >> 4) * 2 + (c >> 5), rr = r & 15, cc = c & 31, ob = rr * 64 + cc * 2; return st * 1024 + (ob ^ (((ob >> 9) & 1) << 5)); }
__host__ __device__ __forceinline__ void stage_rc(int b, int& R, int& C) { const int st = b / 1024, sb = b % 1024, swz = sb ^ (((sb >> 9) & 1) << 5); R = (st >> 1) * 16 + swz / 64; C = (st & 1) * 32 + (swz % 64) / 2; }
__host__ __device__ __forceinline__ int perm32(int rho) { const int n = rho >> 4, i = rho & 15; return 8 * (i >> 2) + 4 * n + (i & 3); }
struct Unit { int pm, pn; };
struct Gemm { const bf16_t* A; const bf16_t* Bt; int M, N, K, lda; int jt; int jbytes; };
struct StaticOrder {
    int nM, nN, nwg, G, c;
    __host__ __device__ void init(int M, int N, int G_, int c_) { nM = M / BM; nN = N / BM; nwg = nM * nN; G = G_; c = c_; }
    __host__ __device__ bool next(int i, Unit& u) const {
        const long L = (long)i * G + c; if (L >= nwg) return false;
        int wgid = (int)L; { const int q = nwg / NXCD, r = nwg % NXCD, xcd = wgid % NXCD, off = wgid / NXCD; wgid = (xcd < r ? xcd * (q + 1) : r * (q + 1) + (xcd - r) * q) + off; }
        const int nig = WGM * nN, gid = wgid / nig, fm = gid * WGM, gsz = (nM - fm) < WGM ? (nM - fm) : WGM;
        u.pm = fm + ((wgid % nig) % gsz); u.pn = (wgid % nig) / gsz; return true;
    }
};
template <class Epi>
__device__ __forceinline__ void gemm_phase(LAS unsigned char* lds, const Gemm g, const StaticOrder& S, const Epi E) {
    int tid = threadIdx.x; asm volatile("" : "+v"(tid));
    const int wid = __builtin_amdgcn_readfirstlane(tid >> 6), lane = tid & 63, wr = wid >> 2, wc = wid & 3, fr = lane & 15, fq = lane >> 4;
    const int K = g.K, nt = K / BK, lda = g.lda;
    unsigned voffA[2], voffB[2];
#pragma unroll
    for (int i = 0; i < 2; ++i) { int R, C; stage_rc(tid * 16 + i * 8192, R, C); const int Rb = Epi::PERM ? ((R & ~31) + perm32(R & 31)) : R;
        voffA[i] = (unsigned)(R * lda + C) * 2u; voffB[i] = (unsigned)(Rb * K + C) * 2u; }
    const size_t kstep = (size_t)(BK * 2);
    const size_t hstepA = (size_t)HALF * lda * 2, hstepB = (size_t)HALF * K * 2;
    const size_t tstepA = 2 * hstepA, tstepB = 2 * hstepB;
    const unsigned ldsw = (unsigned)wid * 1024u;
    const int aoff = lds_byte(wr * 64 + fr, fq * 8), boff = lds_byte(wc * 32 + fr, fq * 8);
#define PG8_SA(b, h) (((b) * 2 + (h)) * HTB)
#define PG8_SB(b, h) ((4 + (b) * 2 + (h)) * HTB)
#define PG8_STAGE(bufoff, gbase, voff) do { _Pragma("unroll") for (int _i = 0; _i < 2; ++_i) \
        __builtin_amdgcn_global_load_lds((const unsigned*)((const char*)(gbase) + (voff)[_i]), (LAS unsigned*)(lds + (bufoff) + ldsw + _i * 8192), 16, 0, 0); } while (0)
#define PG8_LDA(dst, b, h) do { _Pragma("unroll") for (int m = 0; m < 4; ++m) _Pragma("unroll") for (int k = 0; k < 2; ++k) dst[m][k] = *(const LAS bf16x8*)(lds + PG8_SA(b, h) + aoff + m * 2048 + k * 1024); } while (0)
#define PG8_LDB(dst, b, h) do { _Pragma("unroll") for (int n = 0; n < 2; ++n) _Pragma("unroll") for (int k = 0; k < 2; ++k) dst[n][k] = *(const LAS bf16x8*)(lds + PG8_SB(b, h) + boff + n * 2048 + k * 1024); } while (0)
#define PG8_MMA(ai, bj, At, Bt) do { __builtin_amdgcn_s_setprio(1); _Pragma("unroll") for (int m = 0; m < 4; ++m) _Pragma("unroll") for (int n = 0; n < 2; ++n) _Pragma("unroll") for (int k = 0; k < 2; ++k) \
        acc[ai][bj][m][n] = __builtin_amdgcn_mfma_f32_16x16x32_bf16(Bt[n][k], At[m][k], acc[ai][bj][m][n], 0, 0, 0); __builtin_amdgcn_s_setprio(0); } while (0)
#define PG8_WAIT_V(n) asm volatile("s_waitcnt vmcnt(" #n ")" ::: "memory")
#define PG8_WAIT_L(n) asm volatile("s_waitcnt lgkmcnt(" #n ")" ::: "memory")
#define PG8_BAR __builtin_amdgcn_s_barrier()
#define PG8_SCHED __builtin_amdgcn_sched_barrier(0)
    Unit cur, nxt; int ui = 0;
    if (!S.next(0, cur)) return;
    f32x4 acc[2][2][4][2];
#pragma unroll
    for (int a = 0; a < 2; ++a)
#pragma unroll
        for (int b = 0; b < 2; ++b)
#pragma unroll
            for (int m = 0; m < 4; ++m)
#pragma unroll
                for (int n = 0; n < 2; ++n) acc[a][b][m][n] = (f32x4){0.f, 0.f, 0.f, 0.f};
    bf16x8 At[4][2], B0[2][2], B1[2][2];
    const char* cA = (const char*)g.A + (size_t)cur.pm * tstepA; const char* cB = (const char*)g.Bt + (size_t)cur.pn * tstepB;
    PG8_STAGE(PG8_SB(0, 0), cB, voffB); PG8_STAGE(PG8_SA(0, 0), cA, voffA); PG8_STAGE(PG8_SB(0, 1), cB + hstepB, voffB); PG8_STAGE(PG8_SA(0, 1), cA + hstepA, voffA);
    if (wr == 1) PG8_BAR;
    PG8_WAIT_V(4); PG8_BAR;
    PG8_STAGE(PG8_SB(1, 0), cB + kstep, voffB); PG8_STAGE(PG8_SA(1, 0), cA + kstep, voffA); PG8_STAGE(PG8_SB(1, 1), cB + hstepB + kstep, voffB);
    PG8_WAIT_V(6); PG8_BAR;
    for (;;) {
        const bool has_next = S.next(ui + 1, nxt);
        const char* nA = has_next ? (const char*)g.A + (size_t)nxt.pm * tstepA : cA; const char* nB = has_next ? (const char*)g.Bt + (size_t)nxt.pn * tstepB : cB;
        for (int t = 0; t < nt; t += 2) {
            const bool last = (t == nt - 2);
            const char* a1 = cA + (size_t)(t + 1) * kstep + (t + 1 >= g.jt ? g.jbytes : 0);
            const char* a2 = last ? nA : cA + (size_t)(t + 2) * kstep + (t + 2 >= g.jt ? g.jbytes : 0); const char* b2 = last ? nB : cB + (size_t)(t + 2) * kstep;
            const char* a3 = a2 + kstep; const char* b3 = b2 + kstep;
            if constexpr (Epi::HAS_MID) { if (t == g.jt) E.mid(acc, cur, wr, wc, fr, fq); }
            PG8_LDB(B0, 0, 0); PG8_SCHED; PG8_LDA(At, 0, 0); PG8_STAGE(PG8_SA(1, 1), a1 + hstepA, voffA);
            PG8_WAIT_L(8); PG8_BAR; PG8_WAIT_L(0); PG8_MMA(0, 0, At, B0); PG8_BAR; PG8_SCHED;
            PG8_LDB(B1, 0, 1); PG8_STAGE(PG8_SB(0, 0), b2, voffB);
            PG8_BAR; PG8_WAIT_L(0); PG8_MMA(0, 1, At, B1); PG8_BAR;
            PG8_LDA(At, 0, 1); PG8_STAGE(PG8_SA(0, 0), a2, voffA);
            PG8_BAR; PG8_WAIT_L(0); PG8_MMA(1, 0, At, B0); PG8_BAR; PG8_SCHED;
            PG8_STAGE(PG8_SB(0, 1), b2 + hstepB, voffB);
            PG8_WAIT_V(6); PG8_BAR; PG8_MMA(1, 1, At, B1); PG8_BAR;
            PG8_LDB(B0, 1, 0); PG8_SCHED; PG8_LDA(At, 1, 0); PG8_STAGE(PG8_SA(0, 1), a2 + hstepA, voffA);
            PG8_WAIT_L(8); PG8_BAR; PG8_WAIT_L(0); PG8_MMA(0, 0, At, B0); PG8_BAR; PG8_SCHED;
            PG8_LDB(B1, 1, 1); PG8_STAGE(PG8_SB(1, 0), b3, voffB);
            PG8_BAR; PG8_WAIT_L(0); PG8_MMA(0, 1, At, B1); PG8_BAR;
            PG8_LDA(At, 1, 1); PG8_STAGE(PG8_SA(1, 0), a3, voffA);
            PG8_BAR; PG8_WAIT_L(0); PG8_MMA(1, 0, At, B0); PG8_BAR; PG8_SCHED;
            PG8_STAGE(PG8_SB(1, 1), b3 + hstepB, voffB);
            PG8_WAIT_V(6); PG8_BAR; PG8_MMA(1, 1, At, B1); PG8_BAR;
        }
        if constexpr (!Epi::AFTER) E(acc, cur, wr, wc, fr, fq);
        if (!has_next) break;
#pragma unroll
        for (int a = 0; a < 2; ++a)
#pragma unroll
            for (int b = 0; b < 2; ++b)
#pragma unroll
                for (int m = 0; m < 4; ++m)
#pragma unroll
                    for (int n = 0; n < 2; ++n) acc[a][b][m][n] = (f32x4){0.f, 0.f, 0.f, 0.f};
        cur = nxt; cA = nA; cB = nB; ++ui;
    }
    PG8_WAIT_V(0);
    if (wr == 0) PG8_BAR;
    PG8_BAR;
    if constexpr (Epi::AFTER) E.fused(acc, cur, wr, wc, fr, fq, lds, wid, lane);
#undef PG8_SA
#undef PG8_SB
#undef PG8_STAGE
#undef PG8_LDA
#undef PG8_LDB
#undef PG8_MMA
#undef PG8_WAIT_V
#undef PG8_WAIT_L
#undef PG8_BAR
#undef PG8_SCHED
}
}

typedef const f32x4 (&AccRef)[2][2][4][2];
struct EpiBf16 {
    static constexpr bool PERM = true, HAS_MID = false, AFTER = false;
    bf16_t* O; int ldc;
    __device__ __forceinline__ void operator()(AccRef acc, const pg8::Unit& u, int wr, int wc, int fr, int fq) const {
        const int row0 = u.pm * 256 + wr * 64 + fr, col0 = u.pn * 256 + wc * 32 + 8 * fq;
#pragma unroll
        for (int ai = 0; ai < 2; ++ai)
#pragma unroll
            for (int m = 0; m < 4; ++m) { bf16_t* rowp = O + (size_t)(row0 + ai * 128 + m * 16) * ldc + col0;
#pragma unroll
                for (int bj = 0; bj < 2; ++bj) { const f32x4 v0 = acc[ai][bj][m][0], v1 = acc[ai][bj][m][1];
                    u32x4 w; w.x = pk2(v0[0], v0[1]); w.y = pk2(v0[2], v0[3]); w.z = pk2(v1[0], v1[1]); w.w = pk2(v1[2], v1[3]);
                    *(u32x4*)(rowp + bj * 128) = w; } }
    }
};
struct EpiSwiGLU {
    static constexpr bool PERM = true, HAS_MID = false, AFTER = false;
    bf16_t* O; int ldc;
    __device__ __forceinline__ void operator()(AccRef acc, const pg8::Unit& u, int wr, int wc, int fr, int fq) const {
        const int row0 = u.pm * 256 + wr * 64 + fr, col0 = u.pn * 128 + wc * 32 + 8 * fq;
#pragma unroll
        for (int ai = 0; ai < 2; ++ai)
#pragma unroll
            for (int m = 0; m < 4; ++m) { bf16_t* rowp = O + (size_t)(row0 + ai * 128 + m * 16) * ldc + col0;
                float r[8];
#pragma unroll
                for (int n = 0; n < 2; ++n)
#pragma unroll
                    for (int j = 0; j < 4; ++j) { const float a = acc[ai][0][m][n][j], b = acc[ai][1][m][n][j]; r[n * 4 + j] = fsilu(a) * b; }
                u32x4 w; w.x = pk2(r[0], r[1]); w.y = pk2(r[2], r[3]); w.z = pk2(r[4], r[5]); w.w = pk2(r[6], r[7]);
                *(u32x4*)rowp = w; }
    }
};
struct EpiResid {
    static constexpr bool PERM = false, HAS_MID = false, AFTER = false;
    const float* base; float* out; const float* gate; float scale;
    __device__ __forceinline__ void operator()(AccRef acc, const pg8::Unit& u, int wr, int wc, int fr, int fq) const {
        const int row0 = u.pm * 256 + wr * 64 + fr, col0 = u.pn * 256 + wc * 32 + 4 * fq;
        const float* gp = gate + (size_t)(u.pm >> 3) * NMOD + col0;
        f32x4 gv[2][2];
#pragma unroll
        for (int bj = 0; bj < 2; ++bj)
#pragma unroll
            for (int n = 0; n < 2; ++n) gv[bj][n] = *(const f32x4*)(gp + bj * 128 + n * 16) * scale;
#pragma unroll
        for (int ai = 0; ai < 2; ++ai) {
            f32x4 bs[4][2][2];
#pragma unroll
            for (int m = 0; m < 4; ++m) { const size_t off = (size_t)(row0 + ai * 128 + m * 16) * D + col0;
#pragma unroll
                for (int bj = 0; bj < 2; ++bj)
#pragma unroll
                    for (int n = 0; n < 2; ++n) bs[m][bj][n] = *(const f32x4*)(base + off + bj * 128 + n * 16); }
#pragma unroll
            for (int m = 0; m < 4; ++m) { const size_t off = (size_t)(row0 + ai * 128 + m * 16) * D + col0;
#pragma unroll
                for (int bj = 0; bj < 2; ++bj)
#pragma unroll
                    for (int n = 0; n < 2; ++n) *(f32x4*)(out + off + bj * 128 + n * 16) = bs[m][bj][n] + gv[bj][n] * acc[ai][bj][m][n]; }
            asm volatile("" ::: "memory"); }
    }
};
struct EpiResidNorm {
    static constexpr bool PERM = false, HAS_MID = false, AFTER = true;
    const float* base; float* out; const float* gate;
    const float* gain; const float* modsh; bf16_t* un;
    unsigned* xslot; unsigned* cnt; float scale; int pad_;
    __device__ __forceinline__ void fused(f32x4 (&acc)[2][2][4][2], const pg8::Unit& u, int wr, int wc, int fr, int fq, LAS unsigned char* lds, int wid, int lane) const {
        const int row0 = u.pm * 256 + wr * 64 + fr, col0 = u.pn * 256 + wc * 32 + 4 * fq, tid = wid * 64 + lane;
        LAS float* Pt = (LAS float*)lds; LAS float* St = (LAS float*)(lds + 4096);
        const float* gp = gate + (size_t)(u.pm >> 3) * NMOD + col0;
        f32x4 gv[2][2];
#pragma unroll
        for (int bj = 0; bj < 2; ++bj)
#pragma unroll
            for (int n = 0; n < 2; ++n) gv[bj][n] = *(const f32x4*)(gp + bj * 128 + n * 16) * scale;
#pragma unroll
        for (int ai = 0; ai < 2; ++ai) {
            f32x4 bs[4][2][2];
#pragma unroll
            for (int m = 0; m < 4; ++m) { const size_t off = (size_t)(row0 + ai * 128 + m * 16) * D + col0;
#pragma unroll
                for (int bj = 0; bj < 2; ++bj)
#pragma unroll
                    for (int n = 0; n < 2; ++n) bs[m][bj][n] = *(const f32x4*)(base + off + bj * 128 + n * 16); }
#pragma unroll
            for (int m = 0; m < 4; ++m) { const size_t off = (size_t)(row0 + ai * 128 + m * 16) * D + col0; float sq = 0.f;
#pragma unroll
                for (int bj = 0; bj < 2; ++bj)
#pragma unroll
                    for (int n = 0; n < 2; ++n) { const f32x4 hv = bs[m][bj][n] + gv[bj][n] * acc[ai][bj][m][n]; acc[ai][bj][m][n] = hv; *(f32x4*)(out + off + bj * 128 + n * 16) = hv;
                        sq += (hv[0] * hv[0] + hv[1] * hv[1]) + (hv[2] * hv[2] + hv[3] * hv[3]); }
                sq += __shfl_xor(sq, 16); sq += __shfl_xor(sq, 32);
                if (fq == 0) Pt[(ai * 128 + wr * 64 + m * 16 + fr) * 4 + wc] = sq; }
            asm volatile("" ::: "memory"); }
        LDS_WAIT(); __syncthreads();
        if (tid < 256) { const f32x4 t4 = *(const LAS f32x4*)(Pt + tid * 4); const float sq = (t4[0] + t4[1]) + (t4[2] + t4[3]);
            __hip_atomic_store(xslot + ((size_t)(u.pm * 256 + tid) * 4 + u.pn), __float_as_uint(sq), __ATOMIC_RELAXED, __HIP_MEMORY_SCOPE_AGENT);
            asm volatile("s_waitcnt vmcnt(0)" ::: "memory");
            if (lane == 0) __hip_atomic_fetch_add(cnt + 64 * u.pm, 1u, __ATOMIC_RELAXED, __HIP_MEMORY_SCOPE_AGENT); }
        if (wid == 0) { unsigned spins = 0;
            while ((unsigned)__builtin_amdgcn_readfirstlane(__hip_atomic_load(cnt + 64 * u.pm, __ATOMIC_RELAXED, __HIP_MEMORY_SCOPE_AGENT)) < 16u) { __builtin_amdgcn_s_sleep(2); if (++spins > (1u << 22)) break; }
            __builtin_amdgcn_fence(__ATOMIC_ACQUIRE, "agent"); asm volatile("s_waitcnt vmcnt(0)" ::: "memory"); }
        __syncthreads();
        if (tid < 256) { const unsigned* sl = xslot + (size_t)(u.pm * 256 + tid) * 4; float sq = 0.f;
#pragma unroll
            for (int t = 0; t < 4; ++t) sq += __uint_as_float(__hip_atomic_load(sl + t, __ATOMIC_RELAXED, __HIP_MEMORY_SCOPE_AGENT));
            St[tid] = 1.0f / sqrtf(sq * (1.f / D) + EPS); }
        LDS_WAIT(); __syncthreads();
        const float* shp = modsh + (size_t)(u.pm >> 3) * NMOD + col0;
        f32x4 gs[2][2], sh[2][2];
#pragma unroll
        for (int bj = 0; bj < 2; ++bj)
#pragma unroll
            for (int n = 0; n < 2; ++n) { gs[bj][n] = *(const f32x4*)(gain + col0 + bj * 128 + n * 16) * (*(const f32x4*)(shp + D + bj * 128 + n * 16) + 1.0f); sh[bj][n] = *(const f32x4*)(shp + bj * 128 + n * 16); }
#pragma unroll
        for (int ai = 0; ai < 2; ++ai)
#pragma unroll
            for (int m = 0; m < 4; ++m) { const int r = ai * 128 + wr * 64 + m * 16 + fr; const float rstd = St[r]; bf16_t* up = un + (size_t)(u.pm * 256 + r) * D + col0;
#pragma unroll
                for (int bj = 0; bj < 2; ++bj)
#pragma unroll
                    for (int n = 0; n < 2; ++n) { const f32x4 uu = acc[ai][bj][m][n] * rstd * gs[bj][n] + sh[bj][n];
                        *(u32x2*)(up + bj * 128 + n * 16) = (u32x2){pk2(uu[0], uu[1]), pk2(uu[2], uu[3])}; } }
        __syncthreads();
    }
};
struct EpiGateFused {
    static constexpr bool PERM = true, HAS_MID = true, AFTER = false;
    const bf16_t* Rsb; const bf16_t* Rdn; bf16_t* O;
    __device__ __forceinline__ void mid(f32x4 (&acc)[2][2][4][2], const pg8::Unit& u, int wr, int wc, int fr, int fq) const {
        int row0 = u.pm * 256 + wr * 64 + fr, col0 = u.pn * 256 + wc * 32 + 8 * fq;
        asm volatile("" : "+v"(row0), "+v"(col0));
#pragma unroll
        for (int ai = 0; ai < 2; ++ai)
#pragma unroll
            for (int mp = 0; mp < 2; ++mp) {
                u32x4 av[2][2], dv[2][2];
#pragma unroll
                for (int mm = 0; mm < 2; ++mm)
#pragma unroll
                    for (int bj = 0; bj < 2; ++bj) { const size_t row = (size_t)(row0 + ai * 128 + (2 * mp + mm) * 16);
                        av[mm][bj] = *(const u32x4*)(Rsb + row * NIN + col0 + bj * 128); dv[mm][bj] = *(const u32x4*)(Rdn + row * NIN + col0 + bj * 128); }
#pragma unroll
                for (int mm = 0; mm < 2; ++mm)
#pragma unroll
                    for (int bj = 0; bj < 2; ++bj) { const int m = 2 * mp + mm; const u32x4 a = av[mm][bj], d = dv[mm][bj];
                        const float ra[8] = {bf_lo(a.x), bf_hi(a.x), bf_lo(a.y), bf_hi(a.y), bf_lo(a.z), bf_hi(a.z), bf_lo(a.w), bf_hi(a.w)};
                        const float rd[8] = {bf_lo(d.x), bf_hi(d.x), bf_lo(d.y), bf_hi(d.y), bf_lo(d.z), bf_hi(d.z), bf_lo(d.w), bf_hi(d.w)};
#pragma unroll
                        for (int e = 0; e < 8; ++e) { const float q = (1.0f + fexp(fminf(-rd[e], 30.0f))) * __builtin_amdgcn_rcpf(1.0f + fexp(-ra[e])); acc[ai][bj][m][e >> 2][e & 3] *= q; } }
                asm volatile("" ::: "memory"); }
    }
    __device__ __forceinline__ void operator()(AccRef acc, const pg8::Unit& u, int wr, int wc, int fr, int fq) const {
        const int row0 = u.pm * 256 + wr * 64 + fr, col0 = u.pn * 256 + wc * 32 + 8 * fq;
#pragma unroll
        for (int ai = 0; ai < 2; ++ai) {
            u32x4 dv[4][2];
#pragma unroll
            for (int m = 0; m < 4; ++m)
#pragma unroll
                for (int bj = 0; bj < 2; ++bj) dv[m][bj] = *(const u32x4*)(Rdn + (size_t)(row0 + ai * 128 + m * 16) * NIN + col0 + bj * 128);
#pragma unroll
            for (int m = 0; m < 4; ++m) { const size_t row = (size_t)(row0 + ai * 128 + m * 16);
#pragma unroll
                for (int bj = 0; bj < 2; ++bj) { const u32x4 d = dv[m][bj];
                    const f32x4 v0 = acc[ai][bj][m][0], v1 = acc[ai][bj][m][1];
#define SGC(x) __builtin_amdgcn_rcpf(1.0f + fexp(fminf(-(x), 30.0f)))
                    const float r[8] = {SGC(bf_lo(d.x)) * v0[0], SGC(bf_hi(d.x)) * v0[1], SGC(bf_lo(d.y)) * v0[2], SGC(bf_hi(d.y)) * v0[3],
                                        SGC(bf_lo(d.z)) * v1[0], SGC(bf_hi(d.z)) * v1[1], SGC(bf_lo(d.w)) * v1[2], SGC(bf_hi(d.w)) * v1[3]};
#undef SGC
                    u32x4 w; w.x = pk2(r[0], r[1]); w.y = pk2(r[2], r[3]); w.z = pk2(r[4], r[5]); w.w = pk2(r[6], r[7]);
                    *(u32x4*)(O + row * D + col0 + bj * 128) = w; } } }
    }
};
template <class Epi> __device__ __forceinline__ void run_gemm(LAS unsigned char* lds, const bf16_t* A, int lda, const bf16_t* Bt, int N, int K, const Epi E, int jt = 1 << 30, int jbytes = 0) {
    pg8::Gemm g{A, Bt, T, N, K, lda, jt, jbytes}; pg8::StaticOrder S; S.init(T, N, (int)gridDim.x, (int)blockIdx.x);
    pg8::gemm_phase<Epi>(lds, g, S, E);
}

__device__ __forceinline__ void transpose_item(const float* W, int ldw, int s0, int k0, bf16_t* WT, int ldk, int d0, LAS float* scr, int lane) {
    float tv[32];
#pragma unroll
    for (int i = 0; i < 32; ++i) tv[i] = W[(size_t)(k0 + 2 * i + (lane >> 5)) * ldw + s0 + (lane & 31)];
#pragma unroll
    for (int i = 0; i < 32; ++i) scr[(2 * i + (lane >> 5)) * 33 + (lane & 31)] = tv[i];
    LDS_WAIT();
    const int c = lane & 7;
#pragma unroll
    for (int j = 0; j < 4; ++j) { const int n = (lane >> 3) + 8 * j; const LAS float* s = scr + (8 * c) * 33 + n;
        u32x4 o; o.x = pk2(s[0 * 33], s[1 * 33]); o.y = pk2(s[2 * 33], s[3 * 33]); o.z = pk2(s[4 * 33], s[5 * 33]); o.w = pk2(s[6 * 33], s[7 * 33]);
        *(u32x4*)(WT + (size_t)(d0 + n) * ldk + k0 + 8 * c) = o; }
    LDS_WAIT();
}
struct TrD { const float* W; int ldw, s0, k0; bf16_t* WT; int ldk, d0; };
__device__ __forceinline__ TrD ffn_item_desc(const float* w_in, const float* w_out, bf16_t* wt_in, bf16_t* wt_out, int it) {
    if (it < 2816) { const int kb = it / 176, nb = it % 176, d0 = nb * 32, pn = d0 >> 8, bj = (d0 >> 7) & 1, c = d0 & 127, s0 = bj * FF + pn * 128 + c; return TrD{w_in, 2 * FF, s0, kb * 64, wt_in, D, d0}; }
    const int r = it - 2816, kb = r / 32, nb = r % 32; return TrD{w_out, D, nb * 32, kb * 64, wt_out, FF, nb * 32};
}
__device__ __forceinline__ void ffn_weight_items(const float* w_in, const float* w_out, bf16_t* wt_in, bf16_t* wt_out, LAS float* scr, int gw, int ngw, int lane, int lo = 0, int NIT = 2816 + 1408) {
    gw += lo;
    float tv[32];
#define TR_LOAD(d_) do { _Pragma("unroll") for (int i = 0; i < 32; ++i) tv[i] = (d_).W[(size_t)((d_).k0 + 2 * i + (lane >> 5)) * (d_).ldw + (d_).s0 + (lane & 31)]; } while (0)
    if (gw < NIT) { const TrD d0_ = ffn_item_desc(w_in, w_out, wt_in, wt_out, gw); TR_LOAD(d0_); }
    for (int it = gw; it < NIT; it += ngw) {
        const TrD d = ffn_item_desc(w_in, w_out, wt_in, wt_out, it);
#pragma unroll
        for (int i = 0; i < 32; ++i) scr[(2 * i + (lane >> 5)) * 33 + (lane & 31)] = tv[i];
        LDS_WAIT();
        if (it + ngw < NIT) { const TrD dn = ffn_item_desc(w_in, w_out, wt_in, wt_out, it + ngw); TR_LOAD(dn); }
        const int c = lane & 7;
#pragma unroll
        for (int j = 0; j < 4; ++j) { const int n = (lane >> 3) + 8 * j; const LAS float* s_ = scr + (8 * c) * 33 + n;
            u32x4 o; o.x = pk2(s_[0 * 33], s_[1 * 33]); o.y = pk2(s_[2 * 33], s_[3 * 33]); o.z = pk2(s_[4 * 33], s_[5 * 33]); o.w = pk2(s_[6 * 33], s_[7 * 33]);
            *(u32x4*)(d.WT + (size_t)(d.d0 + n) * d.ldk + d.k0 + 8 * c) = o; }
        LDS_WAIT();
    }
#undef TR_LOAD
}
__device__ __forceinline__ void mixer_weight_items(const Params& p, LAS float* scr, int gw, int ngw, int lane) {
    unsigned char* ws = p.ws;
    for (int it = gw; it < 2816 + 256 + 256 + 512; it += ngw) {
        int r = it;
        if (r < 2816) { const int kb = r / 176, nb = r % 176, d0 = nb * 32, s0 = d0 < C_RSB ? d0 : d0 + 8; transpose_item(p.in[I_WIN], INW, s0, kb * 64, (bf16_t*)(ws + W_IN), D, d0, scr, lane); continue; } r -= 2816;
        if (r < 256) { const int kb = r / 32, nb = r % 32; transpose_item(p.in[I_WUPSB], D, nb * 32, kb * 64, (bf16_t*)(ws + W_UPSB), D, nb * 32, scr, lane); continue; } r -= 256;
        if (r < 256) { const int kb = r / 32, nb = r % 32; transpose_item(p.in[I_WUPDN], D, nb * 32, kb * 64, (bf16_t*)(ws + W_UPSB) + 512, D, nb * 32, scr, lane); continue; } r -= 256;
        { const int kb = r / 32, nb = r % 32; transpose_item(p.in[I_WOUT], D, nb * 32, kb * 64, (bf16_t*)(ws + W_OUT), D, nb * 32, scr, lane); }
    }
}
__device__ __forceinline__ void mod_item(const Params& p, LAS unsigned char* lds, int cb, int tid, int wave, int lane) {
    asm volatile("" : "+v"(tid), "+v"(lane));
    LAS float* sc = (LAS float*)lds; LAS float* red = (LAS float*)(lds + 32768);
    for (int i = tid; i < NB * D; i += 512) sc[i] = fsilu(p.in[I_C][i]);
    __syncthreads();
    const float* wa = p.in[I_WADA] + cb * 64 + lane;
    float acc[NB];
#pragma unroll
    for (int b = 0; b < NB; ++b) acc[b] = 0.f;
    for (int k = wave * 128; k < wave * 128 + 128; k += 32) {
        float w[32];
#pragma unroll
        for (int e = 0; e < 32; ++e) w[e] = wa[(size_t)(k + e) * NMOD];
#pragma unroll
        for (int b = 0; b < NB; ++b)
#pragma unroll
            for (int e4 = 0; e4 < 8; ++e4) { const f32x4 s = *(const LAS f32x4*)(sc + b * D + k + 4 * e4); acc[b] += s[0] * w[4 * e4] + s[1] * w[4 * e4 + 1] + s[2] * w[4 * e4 + 2] + s[3] * w[4 * e4 + 3]; }
    }
#pragma unroll
    for (int b = 0; b < NB; ++b) red[(wave * NB + b) * 64 + lane] = acc[b];
    __syncthreads();
    { const int b = tid >> 6; float s = p.in[I_BADA][cb * 64 + lane];
#pragma unroll
        for (int w = 0; w < 8; ++w) s += red[(w * NB + b) * 64 + lane];
        ((float*)(p.ws + WS_MOD))[b * NMOD + cb * 64 + lane] = s; }
    __syncthreads();
}

template <bool DN>
__device__ __forceinline__ void norm_mod_phase(const Params& p, LAS unsigned char* lds, const float* src, const float* gain, int midx, bf16_t* dst, int tid, int wave, int lane) {
    asm volatile("" : "+v"(tid), "+v"(lane));
    const float* mod = (const float*)(p.ws + WS_MOD);
    LAS float* wl = (LAS float*)lds;
    if (DN) { for (int i = tid; i < D * 8; i += 512) { const int k = i >> 3, j = i & 7; wl[8 * k + 4 * (k >> 2) + j] = p.in[I_WIN][(size_t)k * INW + C_RSB + j]; } __syncthreads(); }
    f32x4 g4[4];
#pragma unroll
    for (int j = 0; j < 4; ++j) g4[j] = ((const f32x4*)gain)[lane + 64 * j];
    const int rstep = gridDim.x * 8;
    f32x4 nv[4];
    { const int r0 = blockIdx.x * 8 + wave; const f32x4* xr = (const f32x4*)(src + (size_t)(r0 < T ? r0 : 0) * D) + lane;
#pragma unroll
      for (int j = 0; j < 4; ++j) nv[j] = xr[64 * j]; }
    for (int row = blockIdx.x * 8 + wave; row < T; row += rstep) {
        const int b = row >> 11;
        const f32x4* shp = (const f32x4*)(mod + (size_t)b * NMOD + midx * D) + lane; const f32x4* scp = shp + D / 4;
        f32x4 v[4], shv[4], scv[4]; float ss = 0.f;
#pragma unroll
        for (int j = 0; j < 4; ++j) { v[j] = nv[j]; shv[j] = shp[64 * j]; scv[j] = scp[64 * j]; }
        { const int rn = row + rstep < T ? row + rstep : row; const f32x4* xr = (const f32x4*)(src + (size_t)rn * D) + lane;
#pragma unroll
          for (int j = 0; j < 4; ++j) nv[j] = xr[64 * j]; }
#pragma unroll
        for (int j = 0; j < 4; ++j) ss += (v[j][0] * v[j][0] + v[j][1] * v[j][1]) + (v[j][2] * v[j][2] + v[j][3] * v[j][3]);
        const float rstd = 1.0f / sqrtf(wave_sum(ss) * (1.f / D) + EPS);
        u32x2* o8 = (u32x2*)(dst + (size_t)row * D) + lane;
        float dot[8];
        if (DN) {
#pragma unroll
            for (int e = 0; e < 8; ++e) dot[e] = 0.f; }
#pragma unroll
        for (int j = 0; j < 4; ++j) { const f32x4 sh = shv[j], sc = scv[j];
            const f32x4 uu = v[j] * rstd * g4[j] * (sc + 1.0f) + sh;
            u32x2 w; w.x = pk2(uu[0], uu[1]); w.y = pk2(uu[2], uu[3]); o8[64 * j] = w;
            if (DN) {
#pragma unroll
                for (int e = 0; e < 4; ++e) { const int k = 4 * lane + 256 * j + e; const LAS f32x4* wp = (const LAS f32x4*)(wl + 8 * k + 4 * (k >> 2)); const f32x4 w0 = wp[0], w1 = wp[1];
                    dot[0] += uu[e] * w0[0]; dot[1] += uu[e] * w0[1]; dot[2] += uu[e] * w0[2]; dot[3] += uu[e] * w0[3];
                    dot[4] += uu[e] * w1[0]; dot[5] += uu[e] * w1[1]; dot[6] += uu[e] * w1[2]; dot[7] += uu[e] * w1[3]; } } }
        if (DN) {
#pragma unroll
            for (int e = 0; e < 8; ++e) dot[e] = wave_sum(dot[e]);
            float mine = dot[0];
#pragma unroll
            for (int e = 1; e < 8; ++e) mine = (lane == e) ? dot[e] : mine;
            if (lane < 8) { float r;
                if (lane < 4) r = 1.0f / (1.0f + expf(-mine));
                else { const int hh = lane - 4; const float a = mine + p.in[I_DTBIAS][hh]; const float sp = a > 20.f ? a : log1pf(expf(a)); r = -expf(p.in[I_ALOG][hh]) * sp; }
                ((float*)(p.ws + WS_BG))[(size_t)row * 8 + lane] = r; } }
    }
    if (DN) __syncthreads();
}

__device__ __forceinline__ void dn_gate_phase(const Params& p, LAS unsigned char* lds, const bf16_t* u2, int tid, int wave, int lane) {
    asm volatile("" : "+v"(tid), "+v"(lane));
    LAS float* wl = (LAS float*)lds;
    for (int i = tid; i < D * 8; i += 512) { const int k = i >> 3, j = i & 7; wl[8 * k + 4 * (k >> 2) + j] = p.in[I_WIN][(size_t)k * INW + C_RSB + j]; }
    __syncthreads();
    const int rstep = gridDim.x * 8;
    u32x4 na, nb;
    { const int r0 = blockIdx.x * 8 + wave; const bf16_t* up = u2 + (size_t)(r0 < T ? r0 : 0) * D + 16 * lane; na = ((const u32x4*)up)[0]; nb = ((const u32x4*)up)[1]; }
    for (int row = blockIdx.x * 8 + wave; row < T; row += rstep) {
        const u32x4 ca = na, cb = nb;
        { const int rn = row + rstep < T ? row + rstep : row; const bf16_t* up = u2 + (size_t)rn * D + 16 * lane; na = ((const u32x4*)up)[0]; nb = ((const u32x4*)up)[1]; }
        const unsigned w8[8] = {ca.x, ca.y, ca.z, ca.w, cb.x, cb.y, cb.z, cb.w};
        float dot[8];
#pragma unroll
        for (int e = 0; e < 8; ++e) dot[e] = 0.f;
#pragma unroll
        for (int e = 0; e < 16; ++e) { const int k = 16 * lane + e; const LAS f32x4* wp = (const LAS f32x4*)(wl + 8 * k + 4 * (k >> 2)); const f32x4 w0 = wp[0], w1 = wp[1];
            const float uv = (e & 1) ? bf_hi(w8[e >> 1]) : bf_lo(w8[e >> 1]);
            dot[0] += uv * w0[0]; dot[1] += uv * w0[1]; dot[2] += uv * w0[2]; dot[3] += uv * w0[3]; dot[4] += uv * w1[0]; dot[5] += uv * w1[1]; dot[6] += uv * w1[2]; dot[7] += uv * w1[3]; }
#pragma unroll
        for (int e = 0; e < 8; ++e) dot[e] = wave_sum(dot[e]);
        float mine = dot[0];
#pragma unroll
        for (int e = 1; e < 8; ++e) mine = (lane == e) ? dot[e] : mine;
        if (lane < 8) { float r;
            if (lane < 4) r = 1.0f / (1.0f + expf(-mine));
            else { const int hh = lane - 4; const float a = mine + p.in[I_DTBIAS][hh]; const float sp = a > 20.f ? a : log1pf(expf(a)); r = -expf(p.in[I_ALOG][hh]) * sp; }
            ((float*)(p.ws + WS_BG))[(size_t)row * 8 + lane] = r; }
    }
    __syncthreads();
}
__device__ __forceinline__ void unpack16(const bf16_t* p, float* f) {
    const u32x4 a = ((const u32x4*)p)[0], b = ((const u32x4*)p)[1];
    f[0] = bf_lo(a.x); f[1] = bf_hi(a.x); f[2] = bf_lo(a.y); f[3] = bf_hi(a.y); f[4] = bf_lo(a.z); f[5] = bf_hi(a.z); f[6] = bf_lo(a.w); f[7] = bf_hi(a.w);
    f[8] = bf_lo(b.x); f[9] = bf_hi(b.x); f[10] = bf_lo(b.y); f[11] = bf_hi(b.y); f[12] = bf_lo(b.z); f[13] = bf_hi(b.z); f[14] = bf_lo(b.w); f[15] = bf_hi(b.w);
}
__device__ __forceinline__ void pack16(bf16_t* p, const float* f) {
    u32x4 a, b; a.x = pk2(f[0], f[1]); a.y = pk2(f[2], f[3]); a.z = pk2(f[4], f[5]); a.w = pk2(f[6], f[7]); b.x = pk2(f[8], f[9]); b.y = pk2(f[10], f[11]); b.z = pk2(f[12], f[13]); b.w = pk2(f[14], f[15]);
    ((u32x4*)p)[0] = a; ((u32x4*)p)[1] = b;
}
__device__ __forceinline__ void prep_phase(const Params& p, LAS unsigned char* lds, bool dn, int tid, int wave, int lane) {
    asm volatile("" : "+v"(lane), "+v"(tid));
    bf16_t* P = (bf16_t*)(p.ws + WS_P); bf16_t* U = (bf16_t*)(p.ws + WS_U);
    LAS float* wl = (LAS float*)lds;
    if (dn) { for (int i = tid; i < D * 8; i += 512) { const int k = i >> 3, j = i & 7; wl[(k & 15) * 520 + (k >> 4) * 8 + j] = p.in[I_WIN][(size_t)k * INW + C_RSB + j]; } __syncthreads(); }
    const int ch = 16 * lane;
    float gsb[16], wcv[4][16];
    { const float* gp = (ch < 512 ? p.in[I_GQSB] : p.in[I_GKSB]) + (ch & 63); const float sc = ch < 512 ? 0.18033688011112042f : 1.0f;
#pragma unroll
        for (int e = 0; e < 16; ++e) gsb[e] = gp[e] * sc;
#pragma unroll
        for (int i = 0; i < 4; ++i)
#pragma unroll
            for (int e = 0; e < 16; ++e) wcv[i][e] = p.in[I_WCONV][i * 1536 + ch + e]; }
    for (int row = blockIdx.x * 8 + wave; row < T; row += gridDim.x * 8) {
        const int tl = row & (SEQ - 1);
        if (dn) {
            const u32x4 ca = *(const u32x4*)(U + (size_t)row * D + ch), cb = *(const u32x4*)(U + (size_t)row * D + ch + 8);
            const unsigned w8[8] = {ca.x, ca.y, ca.z, ca.w, cb.x, cb.y, cb.z, cb.w};
            float dot[8];
#pragma unroll
            for (int e = 0; e < 8; ++e) dot[e] = 0.f;
#pragma unroll
            for (int e = 0; e < 16; ++e) { const LAS f32x4* wp = (const LAS f32x4*)(wl + e * 520 + lane * 8); const f32x4 w0 = wp[0], w1 = wp[1];
                const float uv = (e & 1) ? bf_hi(w8[e >> 1]) : bf_lo(w8[e >> 1]);
                dot[0] += uv * w0[0]; dot[1] += uv * w0[1]; dot[2] += uv * w0[2]; dot[3] += uv * w0[3]; dot[4] += uv * w1[0]; dot[5] += uv * w1[1]; dot[6] += uv * w1[2]; dot[7] += uv * w1[3]; }
#pragma unroll
            for (int e = 0; e < 8; ++e) dot[e] = wave_sum(dot[e]);
            float mine = dot[0];
#pragma unroll
            for (int e = 1; e < 8; ++e) mine = (lane == e) ? dot[e] : mine;
            if (lane < 8) { float r;
                if (lane < 4) r = 1.0f / (1.0f + expf(-mine));
                else { const int hh = lane - 4; const float a = mine + p.in[I_DTBIAS][hh]; const float sp = a > 20.f ? a : log1pf(expf(a)); r = -expf(p.in[I_ALOG][hh]) * sp; }
                ((float*)(p.ws + WS_BG))[(size_t)row * 8 + lane] = r; } }
        { bf16_t* qp = P + (size_t)row * NIN + ch; float f[16]; unpack16(qp, f); float ss = 0.f;
#pragma unroll
            for (int e = 0; e < 16; ++e) ss += f[e] * f[e];
            ss += __shfl_xor(ss, 1); ss += __shfl_xor(ss, 2);
            const float rstd = 1.0f / sqrtf(ss * (1.f / 64.f) + EPS);
#pragma unroll
            for (int e = 0; e < 16; ++e) f[e] = f[e] * rstd * gsb[e];
            pack16(qp, f); }
        { float y[16];
#pragma unroll
            for (int e = 0; e < 16; ++e) y[e] = 0.f;
#pragma unroll
            for (int i = 0; i < 4; ++i) { if (tl - 3 + i >= 0) { float f[16]; unpack16(P + (size_t)(row - 3 + i) * NIN + C_QDN + ch, f);
#pragma unroll
                    for (int e = 0; e < 16; ++e) y[e] += wcv[i][e] * f[e]; } }
            float ss = 0.f;
#pragma unroll
            for (int e = 0; e < 16; ++e) { y[e] = fsilu(y[e]); ss += y[e] * y[e]; }
            ss += __shfl_xor(ss, 1); ss += __shfl_xor(ss, 2); ss += __shfl_xor(ss, 4);
            const float sc = (1.0f / sqrtf(ss + EPS)) * (ch < 512 ? 0.08838834764831845f : 1.0f);
#pragma unroll
            for (int e = 0; e < 16; ++e) y[e] *= sc;
            pack16(U + (size_t)row * D + ch, y); }
    }
    bf16_t* Vt = (bf16_t*)(p.ws + WS_VT);
    for (int it = blockIdx.x * 8 + wave; it < T / 16; it += gridDim.x * 8) {
        const int row0 = it * 16, b = row0 >> 11, tl0 = row0 & (SEQ - 1), c8 = lane * 8, hd = c8 >> 6, d0 = c8 & 63;
        u32x4 w[16];
#pragma unroll
        for (int r = 0; r < 16; ++r) w[r] = *(const u32x4*)(P + (size_t)(row0 + r) * NIN + C_VSB + c8);
#pragma unroll
        for (int e = 0; e < 8; ++e) {
            unsigned o[8];
#pragma unroll
            for (int i = 0; i < 8; ++i) {
                const int p0 = 2 * i, p1 = 2 * i + 1;
                const int k0 = 8 * ((p0 >> 2) & 1) + 4 * (p0 >> 3) + (p0 & 3), k1 = 8 * ((p1 >> 2) & 1) + 4 * (p1 >> 3) + (p1 & 3);
                const unsigned a0 = w[k0][e >> 1], a1 = w[k1][e >> 1];
                const unsigned lo = (e & 1) ? (a0 >> 16) : (a0 & 0xffffu), hi = (e & 1) ? (a1 & 0xffff0000u) : (a1 << 16);
                o[i] = lo | hi; }
            bf16_t* dst = Vt + ((size_t)(b * 8 + hd) * 64 + d0 + e) * SEQ + tl0;
            ((u32x4*)dst)[0] = (u32x4){o[0], o[1], o[2], o[3]}; ((u32x4*)dst)[1] = (u32x4){o[4], o[5], o[6], o[7]}; }
    }
}

__device__ __forceinline__ float xlane32(float x, int hh) {
    const unsigned xi = __builtin_bit_cast(unsigned, x);
    const u32x2 r = __builtin_amdgcn_permlane32_swap(xi, xi, false, false);
    return __builtin_bit_cast(float, hh ? r.x : r.y);
}
template <bool DIAG>
__device__ __forceinline__ void attn_tile(const f32x16& z, const bf16x8 (&vc)[4], f32x16& o0, f32x16& o1, float& R, int ql, int hh) {
    float sg[16], m[16];
#pragma unroll
    for (int i = 0; i < 16; ++i) { const float e = __builtin_amdgcn_exp2f(fminf(-z[i], 80.0f)); float sig = __builtin_amdgcn_rcpf(1.0f + e); float mm = e * sig;
        if (DIAG) { const bool act = ((i & 3) + 8 * (i >> 2) + 4 * hh) < ql; sig = act ? sig : 0.f; mm = act ? mm : 1.0f; }
        sg[i] = sig; m[i] = mm; }
    float g[4], gp[4];
#pragma unroll
    for (int bq = 0; bq < 4; ++bq) { g[bq] = (m[4 * bq] * m[4 * bq + 1]) * (m[4 * bq + 2] * m[4 * bq + 3]); gp[bq] = xlane32(g[bq], hh); }
    float outer[4]; float tb = R;
#pragma unroll
    for (int bq = 3; bq >= 0; --bq) { outer[bq] = hh == 0 ? tb * gp[bq] : tb; tb *= g[bq] * gp[bq]; }
    R = tb;
    float w[16];
#pragma unroll
    for (int bq = 0; bq < 4; ++bq) { const float s3 = outer[bq], s2 = s3 * m[4 * bq + 3], s1 = s2 * m[4 * bq + 2], s0 = s1 * m[4 * bq + 1];
        w[4 * bq + 3] = sg[4 * bq + 3] * s3; w[4 * bq + 2] = sg[4 * bq + 2] * s2; w[4 * bq + 1] = sg[4 * bq + 1] * s1; w[4 * bq] = sg[4 * bq] * s0; }
    bf16x8 wf[2];
#pragma unroll
    for (int s2 = 0; s2 < 2; ++s2) { const u32x4 pw = {cpk2(w[8 * s2], w[8 * s2 + 1]), cpk2(w[8 * s2 + 2], w[8 * s2 + 3]), cpk2(w[8 * s2 + 4], w[8 * s2 + 5]), cpk2(w[8 * s2 + 6], w[8 * s2 + 7])}; wf[s2] = __builtin_bit_cast(bf16x8, pw); }
    o0 = __builtin_amdgcn_mfma_f32_32x32x16_bf16(vc[0], wf[0], o0, 0, 0, 0); o0 = __builtin_amdgcn_mfma_f32_32x32x16_bf16(vc[1], wf[1], o0, 0, 0, 0);
    o1 = __builtin_amdgcn_mfma_f32_32x32x16_bf16(vc[2], wf[0], o1, 0, 0, 0); o1 = __builtin_amdgcn_mfma_f32_32x32x16_bf16(vc[3], wf[1], o1, 0, 0, 0);
}
__device__ __forceinline__ void attn_item_mfma(bf16_t* P, const bf16_t* Vt, int bh, int qt, int lane) {
    asm volatile("" : "+v"(lane));
    const int b = bh >> 3, h = bh & 7, ql = lane & 31, hh = lane >> 5, q0 = qt * 32;
    bf16_t* qrow = P + (size_t)(b * SEQ + q0 + ql) * NIN + C_QSB + h * 64;
    bf16x8 qf[4];
#pragma unroll
    for (int s = 0; s < 4; ++s) qf[s] = *(const bf16x8*)(qrow + 16 * s + 8 * hh);
    f32x16 o0, o1;
#pragma unroll
    for (int i = 0; i < 16; ++i) { o0[i] = 0.f; o1[i] = 0.f; }
    float R = 1.0f;
    const bf16_t* kb = P + (size_t)(b * SEQ + ql) * NIN + C_KSB + h * 64 + 8 * hh;
    const bf16_t* vb = Vt + ((size_t)bh * 64 + ql) * SEQ + 8 * hh;
    bf16x8 kf[4], vf[4], vn[4];
#define AT_LOADK(k0_) do { _Pragma("unroll") for (int s = 0; s < 4; ++s) kf[s] = *(const bf16x8*)(kb + (size_t)(k0_) * NIN + 16 * s); } while (0)
#define AT_LOADV(dst, k0_) do { _Pragma("unroll") for (int j = 0; j < 4; ++j) dst[j] = *(const bf16x8*)(vb + (size_t)(j >> 1) * 32 * SEQ + (k0_) + 16 * (j & 1)); } while (0)
#define AT_QK(zz) do { _Pragma("unroll") for (int i = 0; i < 16; ++i) zz[i] = 0.f; _Pragma("unroll") for (int s = 0; s < 4; ++s) zz = __builtin_amdgcn_mfma_f32_32x32x16_bf16(kf[s], qf[s], zz, 0, 0, 0); } while (0)
    f32x16 zc, zn;
    AT_LOADK(q0); AT_LOADV(vf, q0);
    AT_QK(zc);
    { const int k1 = (qt > 0 ? qt - 1 : 0) * 32; AT_LOADK(k1); AT_LOADV(vn, k1); }
    { AT_QK(zn);
      const int k2 = (qt > 1 ? qt - 2 : 0) * 32; AT_LOADK(k2);
      attn_tile<true>(zc, vf, o0, o1, R, ql, hh);
      zc = zn;
#pragma unroll
      for (int j = 0; j < 4; ++j) vf[j] = vn[j];
      const int k1 = (qt > 1 ? qt - 2 : 0) * 32; AT_LOADV(vn, k1); }
#pragma unroll 1
    for (int kt = qt - 1; kt >= 0; --kt) {
        AT_QK(zn);
        const int k2 = (kt > 1 ? kt - 2 : 0) * 32; AT_LOADK(k2);
        attn_tile<false>(zc, vf, o0, o1, R, ql, hh);
        if (__builtin_amdgcn_ballot_w64(R != 0.0f) == 0ull) break;
        zc = zn;
#pragma unroll
        for (int j = 0; j < 4; ++j) vf[j] = vn[j];
        AT_LOADV(vn, k2);
    }
#undef AT_LOADK
#undef AT_LOADV
#undef AT_QK
#pragma unroll
    for (int bq = 0; bq < 4; ++bq) {
        u32x2 w0 = {cpk2(o0[4 * bq], o0[4 * bq + 1]), cpk2(o0[4 * bq + 2], o0[4 * bq + 3])}, w1 = {cpk2(o1[4 * bq], o1[4 * bq + 1]), cpk2(o1[4 * bq + 2], o1[4 * bq + 3])};
        *(u32x2*)(qrow + 8 * bq + 4 * hh) = w0; *(u32x2*)(qrow + 32 + 8 * bq + 4 * hh) = w1; }
}
__device__ __forceinline__ size_t slotU(size_t t0, int h, int colbase, int f) { return (t0 + (size_t)(f >> 7)) * D + colbase + h * 128 + (f & 127); }
__device__ __forceinline__ size_t slotP(size_t t0, int h, int colbase, int f) { return (t0 + (size_t)(f >> 7)) * NIN + colbase + h * 128 + (f & 127); }
__device__ __forceinline__ int permpos(int x) { const int k = x & 15; return (x & ~15) + 8 * ((k >> 2) & 1) + 4 * (k >> 3) + (k & 3); }
__device__ __forceinline__ int crow(int r, int hh) { return (r & 3) + 8 * (r >> 2) + 4 * hh; }
__device__ __forceinline__ bf16x8 pack8(const f32x16& x, int s2) {
    const u32x4 pw = {cpk2(x[8 * s2], x[8 * s2 + 1]), cpk2(x[8 * s2 + 2], x[8 * s2 + 3]), cpk2(x[8 * s2 + 4], x[8 * s2 + 5]), cpk2(x[8 * s2 + 6], x[8 * s2 + 7])};
    return __builtin_bit_cast(bf16x8, pw);
}
#define MFMA32(a, b, c) __builtin_amdgcn_mfma_f32_32x32x16_bf16((a), (b), (c), 0, 0, 0)
constexpr int PT = 72, PQ = 136, PL = 68, PB = 40;
constexpr int CP_GC = 0, CP_BT = 256, CP_LS = 1024, CP_TU = CP_LS + 64 * PL * 4, CP_TW = CP_TU + 64 * PT * 2, CP_KT = CP_TW + 64 * PT * 2, CP_VT = CP_KT + 128 * PT * 2,
              CP_QS = CP_VT + 128 * PT * 2, CP_KS = CP_QS + 64 * PQ * 2, CP_AQ = CP_KS + 64 * PQ * 2, CP_L21 = CP_AQ + 64 * PT * 2, CP_TCM = CP_L21 + 32 * PB * 2, CP_T22 = CP_TCM + 32 * PB * 2, CP_END = CP_T22 + 32 * PB * 2;
static_assert(CP_END <= 131072, "chunk prep LDS");
__device__ __forceinline__ void gdn_chunk_prep_phase(const Params& p, LAS unsigned char* lds, int tid, int wave, int lane) {
    bf16_t* P = (bf16_t*)(p.ws + WS_P); bf16_t* U = (bf16_t*)(p.ws + WS_U); const float* BG = (const float*)(p.ws + WS_BG);
    u32x4 ka, kb, qa, qb, xv[4][2]; float gx = 0.f, gbt = 0.f;
#define CP_LOAD(item_) do { const int bh_ = (item_) >> 5, n_ = (item_) & 31, b_ = bh_ >> 2, h_ = bh_ & 3; const size_t t0_ = (size_t)b_ * SEQ + n_ * 64; const int tok_ = tid & 63, c16_ = (tid >> 6) * 16; \
        ka = *(const u32x4*)(U + (t0_ + tok_) * D + 512 + h_ * 128 + c16_); kb = *(const u32x4*)(U + (t0_ + tok_) * D + 512 + h_ * 128 + c16_ + 8); \
        qa = *(const u32x4*)(U + (t0_ + tok_) * D + h_ * 128 + c16_); qb = *(const u32x4*)(U + (t0_ + tok_) * D + h_ * 128 + c16_ + 8); \
        _Pragma("unroll") for (int i = 0; i < 4; ++i) { const bool ok = n_ * 64 + tok_ - 3 + i >= 0; const bf16_t* vp = P + (t0_ + tok_ - 3 + i) * NIN + C_VDN + h_ * 128 + c16_; \
            xv[i][0] = ok ? *(const u32x4*)vp : (u32x4){0u, 0u, 0u, 0u}; xv[i][1] = ok ? *(const u32x4*)(vp + 8) : (u32x4){0u, 0u, 0u, 0u}; } \
        if (tid < 64) { gx = BG[(t0_ + tid) * 8 + 4 + h_]; gbt = BG[(t0_ + tid) * 8 + h_]; } } while (0)
    if ((int)blockIdx.x < 1024) CP_LOAD((int)blockIdx.x);
  for (int item = blockIdx.x; item < 1024; item += gridDim.x) {
    asm volatile("" : "+v"(tid), "+v"(lane));
    const int bh = item >> 5, n = item & 31, b = bh >> 2, h = bh & 3, ql = lane & 31, hh = lane >> 5;
    const size_t t0 = (size_t)b * SEQ + n * 64;
    LAS float* gcS = (LAS float*)(lds + CP_GC); LAS float* btS = (LAS float*)(lds + CP_BT);
    LAS float* LS = (LAS float*)(lds + CP_LS);
    LAS bf16_t* TuS = (LAS bf16_t*)(lds + CP_TU); LAS bf16_t* TwS = (LAS bf16_t*)(lds + CP_TW);
    LAS bf16_t* kT = (LAS bf16_t*)(lds + CP_KT); LAS bf16_t* vT = (LAS bf16_t*)(lds + CP_VT); LAS bf16_t* qS = (LAS bf16_t*)(lds + CP_QS); LAS bf16_t* kS = (LAS bf16_t*)(lds + CP_KS);
    LAS bf16_t* AQ = (LAS bf16_t*)(lds + CP_AQ); LAS bf16_t* L21b = (LAS bf16_t*)(lds + CP_L21); LAS bf16_t* Tcm = (LAS bf16_t*)(lds + CP_TCM); LAS bf16_t* T22r = (LAS bf16_t*)(lds + CP_T22);
    if (tid < 64) { float x = gx;
#pragma unroll
        for (int o = 1; o < 64; o <<= 1) { const float y = __shfl_up(x, o); if (lane >= o) x += y; }
        gcS[tid] = x; btS[tid] = gbt; }
    { const int tok = tid & 63, c16 = (tid >> 6) * 16;
        *(LAS u32x4*)(kS + tok * PQ + c16) = ka; *(LAS u32x4*)(kS + tok * PQ + c16 + 8) = kb;
        *(LAS u32x4*)(qS + tok * PQ + c16) = qa; *(LAS u32x4*)(qS + tok * PQ + c16 + 8) = qb;
        const unsigned kw[8] = {ka.x, ka.y, ka.z, ka.w, kb.x, kb.y, kb.z, kb.w};
#pragma unroll
        for (int e = 0; e < 8; ++e) { kT[(c16 + 2 * e) * PT + tok] = (bf16_t)(kw[e] & 0xffffu); kT[(c16 + 2 * e + 1) * PT + tok] = (bf16_t)(kw[e] >> 16); }
        float y[16];
#pragma unroll
        for (int e = 0; e < 16; ++e) y[e] = 0.f;
#pragma unroll
        for (int i = 0; i < 4; ++i) { const float* wp = p.in[I_WCONV] + i * 1536 + 1024 + h * 128 + c16;
            const unsigned xw[8] = {xv[i][0].x, xv[i][0].y, xv[i][0].z, xv[i][0].w, xv[i][1].x, xv[i][1].y, xv[i][1].z, xv[i][1].w};
#pragma unroll
            for (int e = 0; e < 8; ++e) { y[2 * e] += wp[2 * e] * bf_lo(xw[e]); y[2 * e + 1] += wp[2 * e + 1] * bf_hi(xw[e]); } }
#pragma unroll
        for (int e = 0; e < 16; ++e) vT[(c16 + e) * PT + tok] = f2bf(fsilu(y[e])); }
    LDS_BARRIER();
    if (item + (int)gridDim.x < 1024) CP_LOAD(item + (int)gridDim.x);
    if (wave == 0 || wave == 4 || wave == 5) {
        const int it = wave == 0 ? 0 : 1, jt = wave == 4 ? 1 : 0;
        f32x16 acc;
#pragma unroll
        for (int r = 0; r < 16; ++r) acc[r] = 0.f;
#pragma unroll
        for (int ks = 0; ks < 8; ++ks) acc = MFMA32(*(const LAS bf16x8*)(kS + (32 * it + ql) * PQ + 16 * ks + 8 * hh), *(const LAS bf16x8*)(kS + (32 * jt + ql) * PQ + 16 * ks + 8 * hh), acc);
        const int j = 32 * jt + ql; const float gj = gcS[j];
#pragma unroll
        for (int r = 0; r < 16; ++r) { const int i = 32 * it + crow(r, hh); const float l = (j < i) ? btS[i] * acc[r] * fexp(gcS[i] - gj) : 0.f;
            if (it != jt) L21b[(i - 32) * PB + j] = f2bf(l); else LS[i * PL + j] = l; }
    } else if (wave < 4) {
        const int jt = wave == 3 ? 1 : 0, it = wave == 1 ? 0 : 1;
        f32x16 acc;
#pragma unroll
        for (int r = 0; r < 16; ++r) acc[r] = 0.f;
#pragma unroll
        for (int ks = 0; ks < 8; ++ks) acc = MFMA32(*(const LAS bf16x8*)(kS + (32 * jt + ql) * PQ + 16 * ks + 8 * hh), *(const LAS bf16x8*)(qS + (32 * it + ql) * PQ + 16 * ks + 8 * hh), acc);
        const int i = 32 * it + ql; const float gi = gcS[i];
#pragma unroll
        for (int r = 0; r < 16; ++r) { const int j = 32 * jt + crow(r, hh); acc[r] = (j <= i) ? acc[r] * fexp(gi - gcS[j]) : 0.f; }
#pragma unroll
        for (int bq = 0; bq < 4; ++bq) *(LAS u32x2*)(AQ + i * PT + 32 * jt + 8 * bq + 4 * hh) = (u32x2){cpk2(acc[4 * bq], acc[4 * bq + 1]), cpk2(acc[4 * bq + 2], acc[4 * bq + 3])};
    } else {
        const float gl = gcS[63];
#pragma unroll
        for (int uu = 0; uu < 4; ++uu) { const int unit = (tid - 384) + 128 * uu, dk = unit >> 2, blk = unit & 3;
            const u32x4 k0 = *(const LAS u32x4*)(kT + dk * PT + 16 * blk), k1 = *(const LAS u32x4*)(kT + dk * PT + 16 * blk + 8);
            float kv[16] = {bf_lo(k0.x), bf_hi(k0.x), bf_lo(k0.y), bf_hi(k0.y), bf_lo(k0.z), bf_hi(k0.z), bf_lo(k0.w), bf_hi(k0.w), bf_lo(k1.x), bf_hi(k1.x), bf_lo(k1.y), bf_hi(k1.y), bf_lo(k1.z), bf_hi(k1.z), bf_lo(k1.w), bf_hi(k1.w)};
#pragma unroll
            for (int e = 0; e < 16; ++e) kv[e] *= fexp(gl - gcS[16 * blk + e]);
            float pv[16];
#pragma unroll
            for (int e = 0; e < 16; ++e) pv[permpos(e)] = kv[e];
            pack16(P + slotP(t0, h, C_VSB, dk * 64 + 16 * blk), pv); }
        if (tid == 384) ((float*)(p.ws + WS_EGL))[bh * 32 + n] = fexp(gl);
    }
    LDS_BARRIER();
    if (wave == 0) {
        const LAS float* LB = LS + (32 * hh) * PL + 32 * hh;
        float Tc[32];
        f32x4 lc[8], ln[8];
        Tc[0] = (ql == 0) ? 1.0f : 0.f;
        lc[0] = *(const LAS f32x4*)(LB + 1 * PL);
#pragma unroll
        for (int i = 1; i < 32; ++i) {
            if (i + 1 < 32) {
#pragma unroll
                for (int j4 = 0; j4 < i + 1; j4 += 4) ln[j4 >> 2] = *(const LAS f32x4*)(LB + (i + 1) * PL + j4); }
            float a0 = (ql == i) ? 1.0f : 0.f, a1 = 0.f, a2 = 0.f, a3 = 0.f;
#pragma unroll
            for (int j4 = 0; j4 < i; j4 += 4) { const f32x4 l4 = lc[j4 >> 2];
                a0 -= l4[0] * Tc[j4]; if (j4 + 1 < i) a1 -= l4[1] * Tc[j4 + 1]; if (j4 + 2 < i) a2 -= l4[2] * Tc[j4 + 2]; if (j4 + 3 < i) a3 -= l4[3] * Tc[j4 + 3]; }
            Tc[i] = (a0 + a1) + (a2 + a3);
#pragma unroll
            for (int q = 0; q < 8; ++q) lc[q] = ln[q]; }
        const int cg_ = 32 * hh + ql; const float bu = btS[cg_], bw = bu * fexp(gcS[cg_]);
#pragma unroll
        for (int i = 0; i < 32; ++i) { TuS[(32 * hh + i) * PT + cg_] = f2bf(Tc[i] * bu); TwS[(32 * hh + i) * PT + cg_] = f2bf(Tc[i] * bw); }
        if (hh == 0) {
#pragma unroll
            for (int i8 = 0; i8 < 4; ++i8) *(LAS u32x4*)(Tcm + ql * PB + 8 * i8) = (u32x4){cpk2(Tc[8 * i8], Tc[8 * i8 + 1]), cpk2(Tc[8 * i8 + 2], Tc[8 * i8 + 3]), cpk2(Tc[8 * i8 + 4], Tc[8 * i8 + 5]), cpk2(Tc[8 * i8 + 6], Tc[8 * i8 + 7])};
        } else {
#pragma unroll
            for (int i = 0; i < 32; ++i) T22r[i * PB + ql] = f2bf(Tc[i]);
        }
        LDS_WAIT();
        f32x16 x1;
#pragma unroll
        for (int r = 0; r < 16; ++r) x1[r] = 0.f;
#pragma unroll
        for (int s2 = 0; s2 < 2; ++s2) x1 = MFMA32(*(const LAS bf16x8*)(L21b + ql * PB + 16 * s2 + 8 * hh), *(const LAS bf16x8*)(Tcm + ql * PB + 16 * s2 + 8 * hh), x1);
        f32x16 yy;
#pragma unroll
        for (int r = 0; r < 16; ++r) yy[r] = 0.f;
#pragma unroll
        for (int s2 = 0; s2 < 2; ++s2) { const u32x2 lo = *(const LAS u32x2*)(T22r + ql * PB + 16 * s2 + 4 * hh), hi = *(const LAS u32x2*)(T22r + ql * PB + 16 * s2 + 8 + 4 * hh);
            const u32x4 af = {lo.x, lo.y, hi.x, hi.y};
            yy = MFMA32(__builtin_bit_cast(bf16x8, af), pack8(x1, s2), yy); }
        { const float bu0 = btS[ql], bw0 = bu0 * fexp(gcS[ql]);
#pragma unroll
            for (int r = 0; r < 16; ++r) { const int i2 = 32 + crow(r, hh); TuS[i2 * PT + ql] = f2bf(-yy[r] * bu0); TwS[i2 * PT + ql] = f2bf(-yy[r] * bw0); } }
    }
    LDS_BARRIER();
    {
        const int isW = wave >> 2, ct = wave & 3, col = 32 * ct + ql;
        const LAS bf16_t* Ta = (isW ? TwS : TuS) + 8 * hh; const LAS bf16_t* Bs = (isW ? kT : vT) + col * PT + 8 * hh;
        bf16x8 bf[4];
#pragma unroll
        for (int ks = 0; ks < 4; ++ks) bf[ks] = *(const LAS bf16x8*)(Bs + 16 * ks);
        f32x16 xa[2];
#pragma unroll
        for (int jt = 0; jt < 2; ++jt) {
#pragma unroll
            for (int r = 0; r < 16; ++r) xa[jt][r] = 0.f;
#pragma unroll
            for (int ks = 0; ks < 4; ++ks) if (jt == 1 || ks < 2) xa[jt] = MFMA32(*(const LAS bf16x8*)(Ta + (32 * jt + ql) * PT + 16 * ks), bf[ks], xa[jt]); }
        bf16x8 xb[4] = {pack8(xa[0], 0), pack8(xa[0], 1), pack8(xa[1], 0), pack8(xa[1], 1)};
        f32x16 ra[2];
#pragma unroll
        for (int it = 0; it < 2; ++it) {
#pragma unroll
            for (int r = 0; r < 16; ++r) ra[it][r] = 0.f;
#pragma unroll
            for (int kk = 0; kk < 4; ++kk) if (it == 1 || kk < 2) { const LAS bf16_t* ap = AQ + (32 * it + ql) * PT + 16 * kk + 4 * hh;
                const u32x2 lo = *(const LAS u32x2*)ap, hi = *(const LAS u32x2*)(ap + 8); const u32x4 af = {lo.x, lo.y, hi.x, hi.y};
                ra[it] = MFMA32(__builtin_bit_cast(bf16x8, af), xb[kk], ra[it]); } }
        if (!isW) {
#pragma unroll
            for (int jt = 0; jt < 2; ++jt)
#pragma unroll
                for (int bq = 0; bq < 4; ++bq) { const int f = col * 64 + 32 * jt + 8 * bq + 4 * hh;
                    *(u32x2*)(U + slotU(t0, h, 0, f)) = (u32x2){cpk2(xa[jt][4 * bq], xa[jt][4 * bq + 1]), cpk2(xa[jt][4 * bq + 2], xa[jt][4 * bq + 3])};
                    *(u32x2*)(U + slotU(t0, h, 512, f)) = (u32x2){cpk2(ra[jt][4 * bq], ra[jt][4 * bq + 1]), cpk2(ra[jt][4 * bq + 2], ra[jt][4 * bq + 3])}; }
        } else {
            const int pc = permpos(col);
#pragma unroll
            for (int jt = 0; jt < 2; ++jt)
#pragma unroll
                for (int r = 0; r < 16; ++r) { const int tok = 32 * jt + crow(r, hh);
                    P[(t0 + tok) * NIN + C_QDN + h * 128 + pc] = f2bf(-xa[jt][r]);
                    P[(t0 + tok) * NIN + C_KDN + h * 128 + pc] = f2bf(bf2f(qS[tok * PQ + col]) * fexp(gcS[tok]) - ra[jt][r]); }
        }
    }
    LDS_BARRIER();
  }
#undef CP_LOAD
}
constexpr int SC_PW = 136, SC_PK = 72, SC_NW = 0, SC_Q2 = 64 * SC_PW * 2, SC_KD = 2 * 64 * SC_PW * 2, SC_STAGE = 2 * 64 * SC_PW * 2 + 128 * SC_PK * 2, SC_OS = 2 * SC_STAGE,
              SC_US = SC_OS + 128 * SC_PK * 2, SC_OI = SC_US + 128 * SC_PK * 2, SC_END = SC_OI + 128 * SC_PK * 2;
static_assert(SC_END <= BST_OFF, "scan LDS");
__device__ __forceinline__ void gdn_scan_block(const Params& p, LAS unsigned char* lds, int bh, int tid, int wave, int lane) {
    asm volatile("" : "+v"(tid), "+v"(lane));
    bf16_t* P = (bf16_t*)(p.ws + WS_P); const bf16_t* U = (const bf16_t*)(p.ws + WS_U); const float* EGL = (const float*)(p.ws + WS_EGL);
    const int b = bh >> 2, h = bh & 3, ql = lane & 31, hh = lane >> 5;
    const size_t tb = (size_t)b * SEQ;
    LAS bf16_t* oS = (LAS bf16_t*)(lds + SC_OS);
    if (wave >= 4) {
        int lt = tid - 256, ftok = lt >> 2, fseg = lt & 3;
        u32x4 ra[20], rb[20];
#define SC_LOAD(r, n_) do { const size_t t0_ = tb + (size_t)(n_) * 64; _Pragma("unroll") for (int i = 0; i < 4; ++i) { const int c = lt + 256 * i, row = c >> 4, c8 = (c & 15) * 8; \
            const bf16_t* g_ = P + (t0_ + row) * NIN + h * 128 + c8; const bf16_t* u_ = U + (t0_ + row) * D + h * 128 + c8; \
            r[i] = *(const u32x4*)(g_ + C_QDN); r[4 + i] = *(const u32x4*)(g_ + C_KDN); r[8 + i] = *(const u32x4*)(g_ + C_VSB); r[12 + i] = *(const u32x4*)u_; r[16 + i] = *(const u32x4*)(u_ + 512); } } while (0)
#define SC_STORE(r, st_) do { LAS unsigned char* s_ = lds + (st_) * SC_STAGE; _Pragma("unroll") for (int i = 0; i < 4; ++i) { const int c = lt + 256 * i, row = c >> 4, c8 = (c & 15) * 8; \
            *(LAS u32x4*)(s_ + SC_NW + (row * SC_PW + c8) * 2) = r[i]; *(LAS u32x4*)(s_ + SC_Q2 + (row * SC_PW + c8) * 2) = r[4 + i]; \
            *(LAS u32x4*)(s_ + SC_KD + ((2 * row + (c8 >> 6)) * SC_PK + (c8 & 63)) * 2) = r[8 + i]; } } while (0)
#define SC_STOREU(r) do { _Pragma("unroll") for (int i = 0; i < 4; ++i) { const int c = lt + 256 * i, row = c >> 4, c8 = (c & 15) * 8; const int o_ = ((2 * row + (c8 >> 6)) * SC_PK + (c8 & 63)) * 2; \
            *(LAS u32x4*)(lds + SC_US + o_) = r[12 + i]; *(LAS u32x4*)(lds + SC_OI + o_) = r[16 + i]; } } while (0)
#define SC_FIN(m_) do { bf16_t* orow = P + (tb + (size_t)(m_) * 64 + ftok) * NIN + h * 128 + fseg * 32 + C_VDN; \
            _Pragma("unroll") for (int i = 0; i < 4; ++i) { unsigned w_[4]; \
                _Pragma("unroll") for (int j = 0; j < 4; ++j) { const int c_ = fseg * 32 + 8 * i + 2 * j; w_[j] = (unsigned)oS[c_ * SC_PK + ftok] | ((unsigned)oS[(c_ + 1) * SC_PK + ftok] << 16); } \
                *(u32x4*)(orow + 8 * i) = (u32x4){w_[0], w_[1], w_[2], w_[3]}; } } while (0)
        SC_LOAD(ra, 0); SC_STORE(ra, 0); SC_STOREU(ra); SC_LOAD(ra, 1);
        LDS_BARRIER();
#pragma unroll 1
        for (int n = 0; n < 32; n += 2) {
            asm volatile("" : "+v"(lt), "+v"(ftok), "+v"(fseg));
            if (n + 2 < 32) SC_LOAD(rb, n + 2);
            SC_STORE(ra, 1);
            if (n > 0) SC_FIN(n - 1);
            LDS_BARRIER();
            SC_STOREU(ra);
            LDS_BARRIER();
            if (n + 3 < 32) SC_LOAD(ra, n + 3);
            if (n + 2 < 32) SC_STORE(rb, 0);
            SC_FIN(n);
            LDS_BARRIER();
            if (n + 2 < 32) SC_STOREU(rb);
            LDS_BARRIER();
        }
        SC_FIN(31);
#undef SC_LOAD
#undef SC_STORE
#undef SC_STOREU
#undef SC_FIN
    } else {
        const int col = 32 * wave + ql;
        f32x16 S[4];
#pragma unroll
        for (int rt = 0; rt < 4; ++rt)
#pragma unroll
            for (int r = 0; r < 16; ++r) S[rt][r] = 0.f;
        const float eglv = EGL[bh * 32 + ql];
        LDS_BARRIER();
#pragma unroll 1
        for (int n = 0; n < 32; ++n) {
            const float egl = __builtin_bit_cast(float, __builtin_amdgcn_readlane(__builtin_bit_cast(int, eglv), n));
            const LAS unsigned char* st = lds + (n & 1) * SC_STAGE;
            f32x16 vn[2], oa[2];
            { const LAS unsigned char* up_ = lds + SC_US + (col * SC_PK + 4 * hh) * 2; const LAS unsigned char* op_ = lds + SC_OI + (col * SC_PK + 4 * hh) * 2;
#pragma unroll
              for (int jt = 0; jt < 2; ++jt)
#pragma unroll
                for (int bq = 0; bq < 4; ++bq) { const u32x2 uw = *(const LAS u32x2*)(up_ + (32 * jt + 8 * bq) * 2), ow = *(const LAS u32x2*)(op_ + (32 * jt + 8 * bq) * 2);
                    vn[jt][4 * bq] = bf_lo(uw.x); vn[jt][4 * bq + 1] = bf_hi(uw.x); vn[jt][4 * bq + 2] = bf_lo(uw.y); vn[jt][4 * bq + 3] = bf_hi(uw.y);
                    oa[jt][4 * bq] = bf_lo(ow.x); oa[jt][4 * bq + 1] = bf_hi(ow.x); oa[jt][4 * bq + 2] = bf_lo(ow.y); oa[jt][4 * bq + 3] = bf_hi(ow.y); } }
            const LAS unsigned char* w0_ = st + (ql * SC_PW + 8 * hh) * 2; const LAS unsigned char* w1_ = w0_ + 32 * SC_PW * 2;
            const LAS unsigned char* kd_ = st + SC_KD + (ql * SC_PK + 8 * hh) * 2;
            bf16x8 fa[4], fb[4];
#define SC_RD4(dst, ptr) do { _Pragma("unroll") for (int i_ = 0; i_ < 4; ++i_) dst[i_] = *(const LAS bf16x8*)((ptr) + 32 * i_); } while (0)
#define SC_MM4(acc, fr, bb) do { _Pragma("unroll") for (int i_ = 0; i_ < 4; ++i_) acc = MFMA32(fr[i_], bb[i_], acc); __builtin_amdgcn_sched_barrier(0); } while (0)
            SC_RD4(fa, w0_ + SC_NW); SC_RD4(fb, w1_ + SC_NW);
            { bf16x8 sb[4] = {pack8(S[0], 0), pack8(S[0], 1), pack8(S[1], 0), pack8(S[1], 1)};
              SC_MM4(vn[0], fa, sb); SC_RD4(fa, w0_ + SC_Q2);
              SC_MM4(vn[1], fb, sb); SC_RD4(fb, w1_ + SC_Q2);
              SC_MM4(oa[0], fa, sb); SC_RD4(fa, w0_ + SC_NW + 128);
              SC_MM4(oa[1], fb, sb); SC_RD4(fb, w1_ + SC_NW + 128); }
            { bf16x8 sb[4] = {pack8(S[2], 0), pack8(S[2], 1), pack8(S[3], 0), pack8(S[3], 1)};
              SC_MM4(vn[0], fa, sb); SC_RD4(fa, w0_ + SC_Q2 + 128);
              SC_MM4(vn[1], fb, sb); SC_RD4(fb, w1_ + SC_Q2 + 128);
              bf16x8 vb[4] = {pack8(vn[0], 0), pack8(vn[0], 1), pack8(vn[1], 0), pack8(vn[1], 1)};
              SC_MM4(oa[0], fa, sb); SC_RD4(fa, kd_);
              SC_MM4(oa[1], fb, sb); SC_RD4(fb, kd_ + 32 * SC_PK * 2);
#pragma unroll
              for (int rt = 0; rt < 4; ++rt)
#pragma unroll
                  for (int r = 0; r < 16; ++r) S[rt][r] *= egl;
              SC_MM4(S[0], fa, vb); SC_RD4(fa, kd_ + 64 * SC_PK * 2);
              SC_MM4(S[1], fb, vb); SC_RD4(fb, kd_ + 96 * SC_PK * 2);
              SC_MM4(S[2], fa, vb);
              SC_MM4(S[3], fb, vb); }
#undef SC_RD4
#undef SC_MM4
            LDS_BARRIER();
#pragma unroll
            for (int jt = 0; jt < 2; ++jt)
#pragma unroll
                for (int bq = 0; bq < 4; ++bq) *(LAS u32x2*)(oS + col * SC_PK + 32 * jt + 8 * bq + 4 * hh) = (u32x2){cpk2(oa[jt][4 * bq], oa[jt][4 * bq + 1]), cpk2(oa[jt][4 * bq + 2], oa[jt][4 * bq + 3])};
            LDS_BARRIER();
        }
    }
}
__device__ __forceinline__ void gdn_finalize_phase(const Params& p, int wave, int lane) {
    asm volatile("" : "+v"(lane));
    bf16_t* P = (bf16_t*)(p.ws + WS_P);
    const int c0 = (lane & 15) * 8;
    float gg[8];
#pragma unroll
    for (int e = 0; e < 8; ++e) gg[e] = p.in[I_GDNOUT][c0 + e];
    for (int row = blockIdx.x * 8 + wave; row < T; row += gridDim.x * 8) {
        bf16_t* op = P + (size_t)row * NIN + C_VDN + lane * 8; const bf16_t* zp = P + (size_t)row * NIN + C_ZDN + lane * 8;
        const u32x4 ow = *(const u32x4*)op, zw = *(const u32x4*)zp;
        const float o[8] = {bf_lo(ow.x), bf_hi(ow.x), bf_lo(ow.y), bf_hi(ow.y), bf_lo(ow.z), bf_hi(ow.z), bf_lo(ow.w), bf_hi(ow.w)};
        const float z[8] = {bf_lo(zw.x), bf_hi(zw.x), bf_lo(zw.y), bf_hi(zw.y), bf_lo(zw.z), bf_hi(zw.z), bf_lo(zw.w), bf_hi(zw.w)};
        float ss = 0.f;
#pragma unroll
        for (int e = 0; e < 8; ++e) ss += o[e] * o[e];
        ss += __shfl_xor(ss, 1); ss += __shfl_xor(ss, 2); ss += __shfl_xor(ss, 4); ss += __shfl_xor(ss, 8);
        const float rstd = 1.0f / sqrtf(ss * (1.f / 128.f) + EPS);
        float r[8];
#pragma unroll
        for (int e = 0; e < 8; ++e) r[e] = o[e] * rstd * gg[e] * fsilu(z[e]);
        u32x4 w; w.x = pk2(r[0], r[1]); w.y = pk2(r[2], r[3]); w.z = pk2(r[4], r[5]); w.w = pk2(r[6], r[7]);
        *(u32x4*)op = w;
    }
}

#define XB_TMO      128
#define XB_XCNT(j)  (256  + 64 * (j))
#define XB_XSUB(j)  (1280 + 64 * (j))
#define XB_XGEN(j)  (2304 + 64 * (j))
#define XB_TOP      3328
#define XB_TOPGEN   3392
#define XCD_BAR_WORDS 3456
#define XB_SPIN_CAP (1u << 18)
__device__ __forceinline__ unsigned xb_ld(unsigned* p)              { return __hip_atomic_load(p, __ATOMIC_RELAXED, __HIP_MEMORY_SCOPE_AGENT); }
__device__ __forceinline__ unsigned xb_add(unsigned* p, unsigned v) { return __hip_atomic_fetch_add(p, v, __ATOMIC_RELAXED, __HIP_MEMORY_SCOPE_AGENT); }
__device__ __forceinline__ unsigned xb_xcc_id() { return (unsigned)__builtin_amdgcn_s_getreg((3 << 11) | 20) & 0xFu; }
#define XB_SPIN(cond, bar) do { unsigned _sp = 0; while (cond) { __builtin_amdgcn_s_sleep(1); \
    if ((++_sp & 255u) == 0u) { if (xb_ld(&(bar)[XB_TMO])) break; if (_sp > XB_SPIN_CAP) { atomicAdd(&(bar)[XB_TMO], 1u); break; } } } } while (0)
struct XcdBarrier { unsigned* bar; unsigned x; volatile LAS unsigned* st; };
__device__ __forceinline__ XcdBarrier xcd_barrier_post(unsigned* bar, volatile LAS unsigned* st) {
    XcdBarrier b; b.bar = bar; b.x = xb_xcc_id(); b.st = st;
    if (threadIdx.x == 0) (void)xb_add(&bar[XB_XCNT(b.x)], 1u);
    return b;
}
__device__ __forceinline__ void xcd_barrier_complete(unsigned* bar, unsigned x, unsigned& nloc, unsigned& nx) {
    const unsigned G = gridDim.x * gridDim.y * gridDim.z;
    unsigned sum, cnt, mine, sp = 0u;
    for (;;) {
        sum = 0u; cnt = 0u; mine = 0u;
#pragma unroll
        for (unsigned j = 0; j < 16; ++j) { const unsigned c = xb_ld(&bar[XB_XCNT(j)]); sum += c; cnt += (c > 0u) ? 1u : 0u; mine = (j == x) ? c : mine; }
        if (sum == G) break;
        __builtin_amdgcn_s_sleep(1);
        if ((++sp & 255u) == 0u) { if (xb_ld(&bar[XB_TMO])) break; if (sp > XB_SPIN_CAP) { atomicAdd(&bar[XB_TMO], 1u); break; } }
    }
    nloc = mine > 0u ? mine : 1u; nx = cnt > 0u ? cnt : 1u;
}
__device__ __forceinline__ void xcd_barrier(const XcdBarrier& b) {
    asm volatile("s_waitcnt vmcnt(0)" ::: "memory");
    __syncthreads();
    if (threadIdx.x == 0) {
        unsigned* bar = b.bar;
        __builtin_amdgcn_s_waitcnt(0);
        unsigned nloc = b.st[0], nx = b.st[1];
        if (nloc == 0u) { xcd_barrier_complete(bar, b.x, nloc, nx); b.st[0] = nloc; b.st[1] = nx; }
        const unsigned old = xb_add(&bar[XB_XSUB(b.x)], 1u);
        const unsigned gen = old / nloc;
        if (old + 1u == (gen + 1u) * nloc) {
            __builtin_amdgcn_fence(__ATOMIC_RELEASE, "agent");
            asm volatile("s_waitcnt vmcnt(0)" ::: "memory");
            const unsigned og = xb_add(&bar[XB_TOP], 1u);
            const unsigned tg = og / nx;
            if (og + 1u == (tg + 1u) * nx) xb_add(&bar[XB_TOPGEN], 1u);
            else XB_SPIN(xb_ld(&bar[XB_TOPGEN]) == tg, bar);
            __builtin_amdgcn_fence(__ATOMIC_ACQUIRE, "agent");
            xb_add(&bar[XB_XGEN(b.x)], 1u);
            asm volatile("s_waitcnt vmcnt(0)" ::: "memory");
        } else {
            XB_SPIN(xb_ld(&bar[XB_TOPGEN]) == gen, bar);
            __builtin_amdgcn_fence(__ATOMIC_ACQUIRE, "agent");
            asm volatile("s_waitcnt vmcnt(0)" ::: "memory");
        }
    }
    __syncthreads();
}

#ifndef PHMASK
#define PHMASK 0xFFFF
#endif
#define PH(n) ((PHMASK >> (n)) & 1)
#ifndef PROBE
#define PROBE 0
#endif
#define REP(g) for (int _rep = 0; _rep < ((PROBE == (g)) ? 2 : 1); ++_rep)
__global__ void __launch_bounds__(512, 2) fwd_megakernel(Params p) {
    extern __shared__ __attribute__((aligned(16))) unsigned char lds_raw[];
    LAS unsigned char* lds = (LAS unsigned char*)lds_raw;
    cg::grid_group grid = cg::this_grid();
    const int tid = threadIdx.x, lane = tid & 63, wave = __builtin_amdgcn_readfirstlane(tid >> 6);
    const int G = gridDim.x, gw = wave * G + blockIdx.x, ngw = G * 8;
    unsigned char* ws = p.ws;
    bf16_t* U = (bf16_t*)(ws + WS_U); bf16_t* P = (bf16_t*)(ws + WS_P);
    const float* mod = (const float*)(ws + WS_MOD);
    LAS float* scr = (LAS float*)(lds + wave * 16384);

    unsigned* barw = (unsigned*)(ws + WS_BAR);
    volatile LAS unsigned* bst = (volatile LAS unsigned*)(lds + BST_OFF);
    if (tid < 2) bst[tid] = 0u;
    __syncthreads();
    if (p.ws == nullptr) grid.sync();
    const XcdBarrier xbar = xcd_barrier_post(barw, bst);
    REP(1) { if (PH(0)) for (int it = blockIdx.x; it < NMOD / 64; it += G) mod_item(p, lds, it, tid, wave, lane);
    { const int nmod = NMOD / 64;
      if (PH(0)) { if (G >= nmod + 64) { if ((int)blockIdx.x >= nmod) ffn_weight_items(p.in[I_WFFN1IN], p.in[I_WFFN1OUT], (bf16_t*)(ws + W_FFIN), (bf16_t*)(ws + W_FFOUT), scr, wave * (G - nmod) + ((int)blockIdx.x - nmod), (G - nmod) * 8, lane); }
                   else ffn_weight_items(p.in[I_WFFN1IN], p.in[I_WFFN1OUT], (bf16_t*)(ws + W_FFIN), (bf16_t*)(ws + W_FFOUT), scr, gw, ngw, lane); } }
    __syncthreads(); }
    xcd_barrier(xbar);
    if (PROBE == 3) for (int i = 0; i < 16; ++i) xcd_barrier(xbar);
    REP(1) if (PH(1)) norm_mod_phase<false>(p, lds, p.in[I_X], p.in[I_GFFN1], 0, U, tid, wave, lane);
    xcd_barrier(xbar);
    REP(2) if (PH(2)) run_gemm(lds, U, D, (const bf16_t*)(ws + W_FFIN), 2 * FF, D, EpiSwiGLU{P, FF});
    { const int nfull = (64 * 22) % G, nidle = nfull ? G - nfull : G;
      const int ib = nfull ? (int)blockIdx.x - nfull : (int)blockIdx.x;
      if (PH(0) && ib >= 0) mixer_weight_items(p, scr, wave * nidle + ib, nidle * 8, lane); }
    xcd_barrier(xbar);
    const bool fusedn = (G == 256);
    unsigned* xslot = (unsigned*)(ws + WS_XSLOT); unsigned* xcnt = (unsigned*)(ws + WS_XCNT);
    if (fusedn) { if (PH(3)) run_gemm(lds, P, FF, (const bf16_t*)(ws + W_FFOUT), D, FF, EpiResidNorm{p.in[I_X], p.out, mod + 2 * D, p.in[I_GMIX], mod + 3 * D, U, xslot, xcnt, 0.5f, 0}); }
    else { REP(2) if (PH(3)) run_gemm(lds, P, FF, (const bf16_t*)(ws + W_FFOUT), D, FF, EpiResid{p.in[I_X], p.out, mod + 2 * D, 0.5f}); }
    xcd_barrier(xbar);
    if (!fusedn) { REP(1) if (PH(4)) norm_mod_phase<true>(p, lds, p.out, p.in[I_GMIX], 3, U, tid, wave, lane); xcd_barrier(xbar); }
    REP(2) if (PH(5)) run_gemm(lds, U, D, (const bf16_t*)(ws + W_IN), NIN, D, EpiBf16{P, NIN});
    { const int nfull = (64 * 22) % G, nidle = nfull ? G - nfull : G; const int ib = nfull ? (int)blockIdx.x - nfull : (int)blockIdx.x;
      if (PH(12) && ib >= 0) ffn_weight_items(p.in[I_WFFN2IN], p.in[I_WFFN2OUT], (bf16_t*)(ws + WS_F2IN), (bf16_t*)(ws + W_FFOUT), scr, wave * nidle + ib, nidle * 8, lane, 0, 2816); }
    xcd_barrier(xbar);
    if (PH(6)) prep_phase(p, lds, fusedn, tid, wave, lane);
    xcd_barrier(xbar);
    if (PH(7)) gdn_chunk_prep_phase(p, lds, tid, wave, lane);
    xcd_barrier(xbar);
    if (PH(15)) for (int it = blockIdx.x; it < 32; it += G) gdn_scan_block(p, lds, it, tid, wave, lane);
    if (PH(8)) {
        const unsigned x0 = xb_xcc_id() & 7u;
        for (unsigned dx = 0; dx < 8u; ++dx) { const unsigned x = (x0 + dx) & 7u; unsigned* ctr = (unsigned*)(ws + WS_CTR) + 64 * x;
            for (;;) { unsigned idx = 0; if (lane == 0) idx = atomicAdd(ctr, 1u); idx = __builtin_amdgcn_readfirstlane(idx);
                if (idx >= 512u) break;
                attn_item_mfma(P, (const bf16_t*)(ws + WS_VT), (int)(8u * x + (idx & 7u)), 63 - (int)(idx >> 3), lane); } } }
    xcd_barrier(xbar);
    if (PH(9)) gdn_finalize_phase(p, wave, lane);
    xcd_barrier(xbar);
    if (PH(10)) run_gemm(lds, P + C_QSB, NIN, (const bf16_t*)(ws + W_UPSB), D, 1024, EpiGateFused{P + C_RSB, P + C_RDN, U}, 8, (C_VDN - C_QSB) * 2 - 8 * 128);
    if (fusedn && PH(12)) ffn_weight_items(p.in[I_WFFN2IN], p.in[I_WFFN2OUT], (bf16_t*)(ws + WS_F2IN), (bf16_t*)(ws + W_FFOUT), scr, gw, ngw, lane, 2816, 2816 + 1408);
    xcd_barrier(xbar);
    if (fusedn) { if (PH(11)) run_gemm(lds, U, D, (const bf16_t*)(ws + W_OUT), D, D, EpiResidNorm{p.out, p.out, mod + 5 * D, p.in[I_GFFN2], mod + 6 * D, U, xslot + 64 * 256 * 4, xcnt + 64 * 64, 1.0f, 0}); }
    else { if (PH(11)) run_gemm(lds, U, D, (const bf16_t*)(ws + W_OUT), D, D, EpiResid{p.out, p.out, mod + 5 * D, 1.0f}); }
    xcd_barrier(xbar);
    if (!fusedn) { REP(1) if (PH(12)) norm_mod_phase<false>(p, lds, p.out, p.in[I_GFFN2], 6, U, tid, wave, lane);
        __syncthreads();
        if (PH(12)) ffn_weight_items(p.in[I_WFFN2IN], p.in[I_WFFN2OUT], (bf16_t*)(ws + WS_F2IN), (bf16_t*)(ws + W_FFOUT), scr, gw, ngw, lane, 2816, 2816 + 1408);
        xcd_barrier(xbar); }
    REP(2) if (PH(13)) run_gemm(lds, U, D, (const bf16_t*)(ws + WS_F2IN), 2 * FF, D, EpiSwiGLU{P, FF});
    xcd_barrier(xbar);
    if (PH(14)) run_gemm(lds, P, FF, (const bf16_t*)(ws + W_FFOUT), D, FF, EpiResid{p.out, p.out, mod + 8 * D, 0.5f});
}

extern "C" void kernel_launch(void* const* d_in, const int* in_sizes, int n_in, void* d_out, int out_size, void* d_ws, size_t ws_size, hipStream_t stream) {
    static int grid_blocks = 0;
    if (!grid_blocks) {
        int dev = 0, cus = 0, per_cu = 0;
        (void)hipGetDevice(&dev);
        (void)hipDeviceGetAttribute(&cus, hipDeviceAttributeMultiprocessorCount, dev);
        (void)hipFuncSetAttribute((const void*)fwd_megakernel, hipFuncAttributeMaxDynamicSharedMemorySize, LDS_BYTES);
        (void)hipOccupancyMaxActiveBlocksPerMultiprocessor(&per_cu, (const void*)fwd_megakernel, 512, LDS_BYTES);
        if (per_cu < 1) { fprintf(stderr, "occupancy query says %d blocks/CU\n", per_cu); per_cu = 1; }
        grid_blocks = cus;
    }
    Params p{};
    for (int i = 0; i < N_IN; ++i) p.in[i] = (const float*)d_in[i];
    p.out = (float*)d_out; p.ws = (unsigned char*)d_ws;
    static_assert(WS_BAR + XCD_BAR_WORDS * 4 <= WS_XCNT, "control words");
    (void)hipMemsetAsync((char*)d_ws + WS_CTR, 0, WS_ZEND - WS_CTR, stream);
    void* args[] = {&p};
    hipError_t e = hipLaunchCooperativeKernel((const void*)fwd_megakernel, dim3(grid_blocks), dim3(512), args, LDS_BYTES, stream);
    if (e != hipSuccess) fprintf(stderr, "cooperative launch failed: %s (grid %d)\n", hipGetErrorString(e), grid_blocks);
}
```

```cpp
#include <hip/hip_runtime.h>
#include <hip/hip_cooperative_groups.h>
#include <cstdio>
namespace cg = cooperative_groups;

#define LAS __attribute__((address_space(3)))
typedef unsigned short bf16_t;
typedef short bf16x8 __attribute__((ext_vector_type(8)));
typedef float f32x4 __attribute__((ext_vector_type(4)));
typedef unsigned u32x4 __attribute__((ext_vector_type(4)));
typedef unsigned u32x2 __attribute__((ext_vector_type(2)));
typedef float f32x16 __attribute__((ext_vector_type(16)));
typedef float f32x2 __attribute__((ext_vector_type(2)));
typedef __bf16 nbf16x2 __attribute__((ext_vector_type(2)));

constexpr int T = 16384, D = 1024, SEQ = 2048, NB = 8, FF = 2816, NIN = 5632, INW = 5640, NMOD = 9216;
constexpr int C_QSB = 0, C_KSB = 512, C_VSB = 1024, C_QDN = 1536, C_KDN = 2048, C_VDN = 2560, C_ZDN = 3072, C_RSB = 3584, C_RDN = 4608;
constexpr float EPS = 1e-6f;
constexpr int LDS_BYTES = 163840, BST_OFF = LDS_BYTES - 64;
constexpr size_t MiB = 1024 * 1024;
constexpr size_t WS_MOD = 0, WS_BG = 512 * 1024, WS_SS = 242 * MiB, WS_W = 2 * MiB;
constexpr size_t W_FFIN = WS_W, W_FFOUT = W_FFIN + (size_t)2 * FF * D * 2, W_IN = W_FFOUT + (size_t)D * FF * 2, W_UPSB = W_IN + (size_t)NIN * D * 2,
                 W_UPDN = W_UPSB + (size_t)D * 512 * 2, W_OUT = W_UPDN + (size_t)D * 512 * 2, W_END = W_OUT + (size_t)D * D * 2;
constexpr size_t WS_U = 34 * MiB, WS_P = 66 * MiB, WS_F2IN = 242 * MiB;
static_assert(W_END <= WS_U, "weights overflow");
constexpr size_t WS_EGL = 384 * 1024, WS_CTR = 400 * 1024, WS_BAR = 416 * 1024, WS_XCNT = 432 * 1024, WS_ZEND = 464 * 1024;
constexpr size_t WS_XSLOT = 1 * MiB;
constexpr size_t WS_VT = W_FFIN;
static_assert((size_t)T * 512 * 2 <= W_IN - W_FFIN, "Vt overflow");

enum { I_X = 0, I_C, I_WADA, I_BADA, I_GFFN1, I_WFFN1IN, I_WFFN1OUT, I_GMIX, I_WIN, I_GQSB, I_GKSB, I_WCONV, I_ALOG, I_DTBIAS, I_GDNOUT, I_WUPSB, I_WUPDN, I_WOUT, I_GFFN2, I_WFFN2IN, I_WFFN2OUT, N_IN };
struct Params { const float* in[N_IN]; float* out; unsigned char* ws; };

__device__ __forceinline__ float bf_lo(unsigned w) { return __uint_as_float(w << 16); }
__device__ __forceinline__ float bf_hi(unsigned w) { return __uint_as_float(w & 0xffff0000u); }
__device__ __forceinline__ float bf2f(bf16_t b) { return __uint_as_float(((unsigned)b) << 16); }
__device__ __forceinline__ unsigned pk2(float lo, float hi) { unsigned r; asm("v_cvt_pk_bf16_f32 %0, %1, %2" : "=v"(r) : "v"(lo), "v"(hi)); return r; }
__device__ __forceinline__ unsigned cpk2(float lo, float hi) { const f32x2 v = {lo, hi}; return __builtin_bit_cast(unsigned, __builtin_convertvector(v, nbf16x2)); }
__device__ __forceinline__ bf16_t f2bf(float f) { return (bf16_t)(pk2(f, 0.f) & 0xffffu); }
__device__ __forceinline__ float fexp(float x) { return __builtin_amdgcn_exp2f(x * 1.4426950408889634f); }
__device__ __forceinline__ float flog(float x) { return __builtin_amdgcn_logf(x) * 0.6931471805599453f; }
__device__ __forceinline__ float fsigmoid(float x) { return __builtin_amdgcn_rcpf(1.f + fexp(-x)); }
__device__ __forceinline__ float fsilu(float x) { return x * fsigmoid(x); }
__device__ __forceinline__ float fsoftplus(float x) { return fmaxf(x, 0.f) + flog(1.f + fexp(-fabsf(x))); }
__device__ __forceinline__ float wave_sum(float v) {
#pragma unroll
    for (int o = 1; o < 64; o <<= 1) v += __shfl_xor(v, o);
    return v;
}
#define LDS_WAIT() asm volatile("s_waitcnt lgkmcnt(0)" ::: "memory")
#define LDS_BARRIER() do { asm volatile("s_waitcnt lgkmcnt(0)" ::: "memory"); __builtin_amdgcn_s_barrier(); asm volatile("" ::: "memory"); } while (0)

namespace pg8 {
constexpr int BM = 256, BK = 64, HALF = 128, HTB = HALF * BK * 2, STAGE_BYTES = 8 * HTB, NXCD = 8, WGM = 4;
__host__ __device__ __forceinline__ int lds_byte(int r, int c) { const int st = (r >> 4) * 2 + (c >> 5), rr = r & 15, cc = c & 31, ob = rr * 64 + cc * 2; return st * 1024 + (ob ^ (((ob >> 9) & 1) << 5)); }
__host__ __device__ __forceinline__ void stage_rc(int b, int& R, int& C) { const int st = b / 1024, sb = b % 1024, swz = sb ^ (((sb >> 9) & 1) << 5); R = (st >> 1) * 16 + swz / 64; C = (st & 1) * 32 + (swz % 64) / 2; }
__host__ __device__ __forceinline__ int perm32(int rho) { const int n = rho >> 4, i = rho & 15; return 8 * (i >> 2) + 4 * n + (i & 3); }
struct Unit { int pm, pn; };
struct Gemm { const bf16_t* A; const bf16_t* Bt; int M, N, K, lda; int jt; int jbytes; };
struct StaticOrder {
    int nM, nN, nwg, G, c;
    __host__ __device__ void init(int M, int N, int G_, int c_) { nM = M / BM; nN = N / BM; nwg = nM * nN; G = G_; c = c_; }
    __host__ __device__ bool next(int i, Unit& u) const {
        const long L = (long)i * G + c; if (L >= nwg) return false;
        int wgid = (int)L; { const int q = nwg / NXCD, r = nwg % NXCD, xcd = wgid % NXCD, off = wgid / NXCD; wgid = (xcd < r ? xcd * (q + 1) : r * (q + 1) + (xcd - r) * q) + off; }
        const int nig = WGM * nN, gid = wgid / nig, fm = gid * WGM, gsz = (nM - fm) < WGM ? (nM - fm) : WGM;
        u.pm = fm + ((wgid % nig) % gsz); u.pn = (wgid % nig) / gsz; return true;
    }
};
template <class Epi>
__device__ __forceinline__ void gemm_phase(LAS unsigned char* lds, const Gemm g, const StaticOrder& S, const Epi E) {
    int tid = threadIdx.x; asm volatile("" : "+v"(tid));
    const int wid = __builtin_amdgcn_readfirstlane(tid >> 6), lane = tid & 63, wr = wid >> 2, wc = wid & 3, fr = lane & 15, fq = lane >> 4;
    const int K = g.K, nt = K / BK, lda = g.lda;
    unsigned voffA[2], voffB[2];
#pragma unroll
    for (int i = 0; i < 2; ++i) { int R, C; stage_rc(tid * 16 + i * 8192, R, C); const int Rb = Epi::PERM ? ((R & ~31) + perm32(R & 31)) : R;
        voffA[i] = (unsigned)(R * lda + C) * 2u; voffB[i] = (unsigned)(Rb * K + C) * 2u; }
    const size_t kstep = (size_t)(BK * 2);
    const size_t hstepA = (size_t)HALF * lda * 2, hstepB = (size_t)HALF * K * 2;
    const size_t tstepA = 2 * hstepA, tstepB = 2 * hstepB;
    const unsigned ldsw = (unsigned)wid * 1024u;
    const int aoff = lds_byte(wr * 64 + fr, fq * 8), boff = lds_byte(wc * 32 + fr, fq * 8);
#define PG8_SA(b, h) (((b) * 2 + (h)) * HTB)
#define PG8_SB(b, h) ((4 + (b) * 2 + (h)) * HTB)
#define PG8_STAGE(bufoff, gbase, voff) do { _Pragma("unroll") for (int _i = 0; _i < 2; ++_i) \
        __builtin_amdgcn_global_load_lds((const unsigned*)((const char*)(gbase) + (voff)[_i]), (LAS unsigned*)(lds + (bufoff) + ldsw + _i * 8192), 16, 0, 0); } while (0)
#define PG8_LDA(dst, b, h) do { _Pragma("unroll") for (int m = 0; m < 4; ++m) _Pragma("unroll") for (int k = 0; k < 2; ++k) dst[m][k] = *(const LAS bf16x8*)(lds + PG8_SA(b, h) + aoff + m * 2048 + k * 1024); } while (0)
#define PG8_LDB(dst, b, h) do { _Pragma("unroll") for (int n = 0; n < 2; ++n) _Pragma("unroll") for (int k = 0; k < 2; ++k) dst[n][k] = *(const LAS bf16x8*)(lds + PG8_SB(b, h) + boff + n * 2048 + k * 1024); } while (0)
#define PG8_MMA(ai, bj, At, Bt) do { __builtin_amdgcn_s_setprio(1); _Pragma("unroll") for (int m = 0; m < 4; ++m) _Pragma("unroll") for (int n = 0; n < 2; ++n) _Pragma("unroll") for (int k = 0; k < 2; ++k) \
        acc[ai][bj][m][n] = __builtin_amdgcn_mfma_f32_16x16x32_bf16(Bt[n][k], At[m][k], acc[ai][bj][m][n], 0, 0, 0); __builtin_amdgcn_s_setprio(0); } while (0)
#define PG8_WAIT_V(n) asm volatile("s_waitcnt vmcnt(" #n ")" ::: "memory")
#define PG8_WAIT_L(n) asm volatile("s_waitcnt lgkmcnt(" #n ")" ::: "memory")
#define PG8_BAR __builtin_amdgcn_s_barrier()
#define PG8_SCHED __builtin_amdgcn_sched_barrier(0)
    Unit cur, nxt; int ui = 0;
    if (!S.next(0, cur)) return;
    f32x4 acc[2][2][4][2];
#pragma unroll
    for (int a = 0; a < 2; ++a)
#pragma unroll
        for (int b = 0; b < 2; ++b)
#pragma unroll
            for (int m = 0; m < 4; ++m)
#pragma unroll
                for (int n = 0; n < 2; ++n) acc[a][b][m][n] = (f32x4){0.f, 0.f, 0.f, 0.f};
    bf16x8 At[4][2], B0[2][2], B1[2][2];
    const char* cA = (const char*)g.A + (size_t)cur.pm * tstepA; const char* cB = (const char*)g.Bt + (size_t)cur.pn * tstepB;
    PG8_STAGE(PG8_SB(0, 0), cB, voffB); PG8_STAGE(PG8_SA(0, 0), cA, voffA); PG8_STAGE(PG8_SB(0, 1), cB + hstepB, voffB); PG8_STAGE(PG8_SA(0, 1), cA + hstepA, voffA);
    if (wr == 1) PG8_BAR;
    PG8_WAIT_V(4); PG8_BAR;
    PG8_STAGE(PG8_SB(1, 0), cB + kstep, voffB); PG8_STAGE(PG8_SA(1, 0), cA + kstep, voffA); PG8_STAGE(PG8_SB(1, 1), cB + hstepB + kstep, voffB);
    PG8_WAIT_V(6); PG8_BAR;
    for (;;) {
        const bool has_next = S.next(ui + 1, nxt);
        const char* nA = has_next ? (const char*)g.A + (size_t)nxt.pm * tstepA : cA; const char* nB = has_next ? (const char*)g.Bt + (size_t)nxt.pn * tstepB : cB;
        for (int t = 0; t < nt; t += 2) {
            const bool last = (t == nt - 2);
            const char* a1 = cA + (size_t)(t + 1) * kstep + (t + 1 >= g.jt ? g.jbytes : 0);
            const char* a2 = last ? nA : cA + (size_t)(t + 2) * kstep + (t + 2 >= g.jt ? g.jbytes : 0); const char* b2 = last ? nB : cB + (size_t)(t + 2) * kstep;
            const char* a3 = a2 + kstep; const char* b3 = b2 + kstep;
            if constexpr (Epi::HAS_MID) { if (t == g.jt) E.mid(acc, cur, wr, wc, fr, fq); }
            PG8_LDB(B0, 0, 0); PG8_SCHED; PG8_LDA(At, 0, 0); PG8_STAGE(PG8_SA(1, 1), a1 + hstepA, voffA);
            PG8_WAIT_L(8); PG8_BAR; PG8_WAIT_L(0); PG8_MMA(0, 0, At, B0); PG8_BAR; PG8_SCHED;
            PG8_LDB(B1, 0, 1); PG8_STAGE(PG8_SB(0, 0), b2, voffB);
            PG8_BAR; PG8_WAIT_L(0); PG8_MMA(0, 1, At, B1); PG8_BAR;
            PG8_LDA(At, 0, 1); PG8_STAGE(PG8_SA(0, 0), a2, voffA);
            PG8_BAR; PG8_WAIT_L(0); PG8_MMA(1, 0, At, B0); PG8_BAR; PG8_SCHED;
            PG8_STAGE(PG8_SB(0, 1), b2 + hstepB, voffB);
            PG8_WAIT_V(6); PG8_BAR; PG8_MMA(1, 1, At, B1); PG8_BAR;
            PG8_LDB(B0, 1, 0); PG8_SCHED; PG8_LDA(At, 1, 0); PG8_STAGE(PG8_SA(0, 1), a2 + hstepA, voffA);
            PG8_WAIT_L(8); PG8_BAR; PG8_WAIT_L(0); PG8_MMA(0, 0, At, B0); PG8_BAR; PG8_SCHED;
            PG8_LDB(B1, 1, 1); PG8_STAGE(PG8_SB(1, 0), b3, voffB);
            PG8_BAR; PG8_WAIT_L(0); PG8_MMA(0, 1, At, B1); PG8_BAR;
            PG8_LDA(At, 1, 1); PG8_STAGE(PG8_SA(1, 0), a3, voffA);
            PG8_BAR; PG8_WAIT_L(0); PG8_MMA(1, 0, At, B0); PG8_BAR; PG8_SCHED;
            PG8_STAGE(PG8_SB(1, 1), b3 + hstepB, voffB);
            PG8_WAIT_V(6); PG8_BAR; PG8_MMA(1, 1, At, B1); PG8_BAR;
        }
        if constexpr (!Epi::AFTER) E(acc, cur, wr, wc, fr, fq);
        if (!has_next) break;
#pragma unroll
        for (int a = 0; a < 2; ++a)
#pragma unroll
            for (int b = 0; b < 2; ++b)
#pragma unroll
                for (int m = 0; m < 4; ++m)
#pragma unroll
                    for (int n = 0; n < 2; ++n) acc[a][b][m][n] = (f32x4){0.f, 0.f, 0.f, 0.f};
        cur = nxt; cA = nA; cB = nB; ++ui;
    }
    PG8_WAIT_V(0);
    if (wr == 0) PG8_BAR;
    PG8_BAR;
    if constexpr (Epi::AFTER) E.fused(acc, cur, wr, wc, fr, fq, lds, wid, lane);
#undef PG8_SA
#undef PG8_SB
#undef PG8_STAGE
#undef PG8_LDA
#undef PG8_LDB
#undef PG8_MMA
#undef PG8_WAIT_V
#undef PG8_WAIT_L
#undef PG8_BAR
#undef PG8_SCHED
}
}

typedef const f32x4 (&AccRef)[2][2][4][2];
struct EpiBf16 {
    static constexpr bool PERM = true, HAS_MID = false, AFTER = false;
    bf16_t* O; int ldc;
    __device__ __forceinline__ void operator()(AccRef acc, const pg8::Unit& u, int wr, int wc, int fr, int fq) const {
        const int row0 = u.pm * 256 + wr * 64 + fr, col0 = u.pn * 256 + wc * 32 + 8 * fq;
#pragma unroll
        for (int ai = 0; ai < 2; ++ai)
#pragma unroll
            for (int m = 0; m < 4; ++m) { bf16_t* rowp = O + (size_t)(row0 + ai * 128 + m * 16) * ldc + col0;
#pragma unroll
                for (int bj = 0; bj < 2; ++bj) { const f32x4 v0 = acc[ai][bj][m][0], v1 = acc[ai][bj][m][1];
                    u32x4 w; w.x = pk2(v0[0], v0[1]); w.y = pk2(v0[2], v0[3]); w.z = pk2(v1[0], v1[1]); w.w = pk2(v1[2], v1[3]);
                    *(u32x4*)(rowp + bj * 128) = w; } }
    }
};
struct EpiSwiGLU {
    static constexpr bool PERM = true, HAS_MID = false, AFTER = false;
    bf16_t* O; int ldc;
    __device__ __forceinline__ void operator()(AccRef acc, const pg8::Unit& u, int wr, int wc, int fr, int fq) const {
        const int row0 = u.pm * 256 + wr * 64 + fr, col0 = u.pn * 128 + wc * 32 + 8 * fq;
#pragma unroll
        for (int ai = 0; ai < 2; ++ai)
#pragma unroll
            for (int m = 0; m < 4; ++m) { bf16_t* rowp = O + (size_t)(row0 + ai * 128 + m * 16) * ldc + col0;
                float r[8];
#pragma unroll
                for (int n = 0; n < 2; ++n)
#pragma unroll
                    for (int j = 0; j < 4; ++j) { const float a = acc[ai][0][m][n][j], b = acc[ai][1][m][n][j]; r[n * 4 + j] = fsilu(a) * b; }
                u32x4 w; w.x = pk2(r[0], r[1]); w.y = pk2(r[2], r[3]); w.z = pk2(r[4], r[5]); w.w = pk2(r[6], r[7]);
                *(u32x4*)rowp = w; }
    }
};
struct EpiResid {
    static constexpr bool PERM = false, HAS_MID = false, AFTER = false;
    const float* base; float* out; const float* gate; float scale;
    __device__ __forceinline__ void operator()(AccRef acc, const pg8::Unit& u, int wr, int wc, int fr, int fq) const {
        const int row0 = u.pm * 256 + wr * 64 + fr, col0 = u.pn * 256 + wc * 32 + 4 * fq;
        const float* gp = gate + (size_t)(u.pm >> 3) * NMOD + col0;
        f32x4 gv[2][2];
#pragma unroll
        for (int bj = 0; bj < 2; ++bj)
#pragma unroll
            for (int n = 0; n < 2; ++n) gv[bj][n] = *(const f32x4*)(gp + bj * 128 + n * 16) * scale;
#pragma unroll
        for (int ai = 0; ai < 2; ++ai) {
            f32x4 bs[4][2][2];
#pragma unroll
            for (int m = 0; m < 4; ++m) { const size_t off = (size_t)(row0 + ai * 128 + m * 16) * D + col0;
#pragma unroll
                for (int bj = 0; bj < 2; ++bj)
#pragma unroll
                    for (int n = 0; n < 2; ++n) bs[m][bj][n] = *(const f32x4*)(base + off + bj * 128 + n * 16); }
#pragma unroll
            for (int m = 0; m < 4; ++m) { const size_t off = (size_t)(row0 + ai * 128 + m * 16) * D + col0;
#pragma unroll
                for (int bj = 0; bj < 2; ++bj)
#pragma unroll
                    for (int n = 0; n < 2; ++n) *(f32x4*)(out + off + bj * 128 + n * 16) = bs[m][bj][n] + gv[bj][n] * acc[ai][bj][m][n]; }
            asm volatile("" ::: "memory"); }
    }
};
struct EpiResidNorm {
    static constexpr bool PERM = false, HAS_MID = false, AFTER = true;
    const float* base; float* out; const float* gate;
    const float* gain; const float* modsh; bf16_t* un;
    unsigned* xslot; unsigned* cnt; float scale; int pad_;
    __device__ __forceinline__ void fused(f32x4 (&acc)[2][2][4][2], const pg8::Unit& u, int wr, int wc, int fr, int fq, LAS unsigned char* lds, int wid, int lane) const {
        const int row0 = u.pm * 256 + wr * 64 + fr, col0 = u.pn * 256 + wc * 32 + 4 * fq, tid = wid * 64 + lane;
        LAS float* Pt = (LAS float*)lds; LAS float* St = (LAS float*)(lds + 4096);
        const float* gp = gate + (size_t)(u.pm >> 3) * NMOD + col0;
        f32x4 gv[2][2];
#pragma unroll
        for (int bj = 0; bj < 2; ++bj)
#pragma unroll
            for (int n = 0; n < 2; ++n) gv[bj][n] = *(const f32x4*)(gp + bj * 128 + n * 16) * scale;
#pragma unroll
        for (int ai = 0; ai < 2; ++ai) {
            f32x4 bs[4][2][2];
#pragma unroll
            for (int m = 0; m < 4; ++m) { const size_t off = (size_t)(row0 + ai * 128 + m * 16) * D + col0;
#pragma unroll
                for (int bj = 0; bj < 2; ++bj)
#pragma unroll
                    for (int n = 0; n < 2; ++n) bs[m][bj][n] = *(const f32x4*)(base + off + bj * 128 + n * 16); }
#pragma unroll
            for (int m = 0; m < 4; ++m) { const size_t off = (size_t)(row0 + ai * 128 + m * 16) * D + col0; float sq = 0.f;
#pragma unroll
                for (int bj = 0; bj < 2; ++bj)
#pragma unroll
                    for (int n = 0; n < 2; ++n) { const f32x4 hv = bs[m][bj][n] + gv[bj][n] * acc[ai][bj][m][n]; acc[ai][bj][m][n] = hv; *(f32x4*)(out + off + bj * 128 + n * 16) = hv;
                        sq += (hv[0] * hv[0] + hv[1] * hv[1]) + (hv[2] * hv[2] + hv[3] * hv[3]); }
                sq += __shfl_xor(sq, 16); sq += __shfl_xor(sq, 32);
                if (fq == 0) Pt[(ai * 128 + wr * 64 + m * 16 + fr) * 4 + wc] = sq; }
            asm volatile("" ::: "memory"); }
        LDS_WAIT(); __syncthreads();
        if (tid < 256) { const f32x4 t4 = *(const LAS f32x4*)(Pt + tid * 4); const float sq = (t4[0] + t4[1]) + (t4[2] + t4[3]);
            __hip_atomic_store(xslot + ((size_t)(u.pm * 256 + tid) * 4 + u.pn), __float_as_uint(sq), __ATOMIC_RELAXED, __HIP_MEMORY_SCOPE_AGENT);
            asm volatile("s_waitcnt vmcnt(0)" ::: "memory");
            if (lane == 0) __hip_atomic_fetch_add(cnt + 64 * u.pm, 1u, __ATOMIC_RELAXED, __HIP_MEMORY_SCOPE_AGENT); }
        if (wid == 0) { unsigned spins = 0;
            while ((unsigned)__builtin_amdgcn_readfirstlane(__hip_atomic_load(cnt + 64 * u.pm, __ATOMIC_RELAXED, __HIP_MEMORY_SCOPE_AGENT)) < 16u) { __builtin_amdgcn_s_sleep(2); if (++spins > (1u << 22)) break; }
            __builtin_amdgcn_fence(__ATOMIC_ACQUIRE, "agent"); asm volatile("s_waitcnt vmcnt(0)" ::: "memory"); }
        __syncthreads();
        if (tid < 256) { const unsigned* sl = xslot + (size_t)(u.pm * 256 + tid) * 4; float sq = 0.f;
#pragma unroll
            for (int t = 0; t < 4; ++t) sq += __uint_as_float(__hip_atomic_load(sl + t, __ATOMIC_RELAXED, __HIP_MEMORY_SCOPE_AGENT));
            St[tid] = 1.0f / sqrtf(sq * (1.f / D) + EPS); }
        LDS_WAIT(); __syncthreads();
        const float* shp = modsh + (size_t)(u.pm >> 3) * NMOD + col0;
        f32x4 gs[2][2], sh[2][2];
#pragma unroll
        for (int bj = 0; bj < 2; ++bj)
#pragma unroll
            for (int n = 0; n < 2; ++n) { gs[bj][n] = *(const f32x4*)(gain + col0 + bj * 128 + n * 16) * (*(const f32x4*)(shp + D + bj * 128 + n * 16) + 1.0f); sh[bj][n] = *(const f32x4*)(shp + bj * 128 + n * 16); }
#pragma unroll
        for (int ai = 0; ai < 2; ++ai)
#pragma unroll
            for (int m = 0; m < 4; ++m) { const int r = ai * 128 + wr * 64 + m * 16 + fr; const float rstd = St[r]; bf16_t* up = un + (size_t)(u.pm * 256 + r) * D + col0;
#pragma unroll
                for (int bj = 0; bj < 2; ++bj)
#pragma unroll
                    for (int n = 0; n < 2; ++n) { const f32x4 uu = acc[ai][bj][m][n] * rstd * gs[bj][n] + sh[bj][n];
                        *(u32x2*)(up + bj * 128 + n * 16) = (u32x2){pk2(uu[0], uu[1]), pk2(uu[2], uu[3])}; } }
        __syncthreads();
    }
};
struct EpiGateFused {
    static constexpr bool PERM = true, HAS_MID = true, AFTER = false;
    const bf16_t* Rsb; const bf16_t* Rdn; bf16_t* O;
    __device__ __forceinline__ void mid(f32x4 (&acc)[2][2][4][2], const pg8::Unit& u, int wr, int wc, int fr, int fq) const {
        int row0 = u.pm * 256 + wr * 64 + fr, col0 = u.pn * 256 + wc * 32 + 8 * fq;
        asm volatile("" : "+v"(row0), "+v"(col0));
#pragma unroll
        for (int ai = 0; ai < 2; ++ai)
#pragma unroll
            for (int mp = 0; mp < 2; ++mp) {
                u32x4 av[2][2], dv[2][2];
#pragma unroll
                for (int mm = 0; mm < 2; ++mm)
#pragma unroll
                    for (int bj = 0; bj < 2; ++bj) { const size_t row = (size_t)(row0 + ai * 128 + (2 * mp + mm) * 16);
                        av[mm][bj] = *(const u32x4*)(Rsb + row * NIN + col0 + bj * 128); dv[mm][bj] = *(const u32x4*)(Rdn + row * NIN + col0 + bj * 128); }
#pragma unroll
                for (int mm = 0; mm < 2; ++mm)
#pragma unroll
                    for (int bj = 0; bj < 2; ++bj) { const int m = 2 * mp + mm; const u32x4 a = av[mm][bj], d = dv[mm][bj];
                        const float ra[8] = {bf_lo(a.x), bf_hi(a.x), bf_lo(a.y), bf_hi(a.y), bf_lo(a.z), bf_hi(a.z), bf_lo(a.w), bf_hi(a.w)};
                        const float rd[8] = {bf_lo(d.x), bf_hi(d.x), bf_lo(d.y), bf_hi(d.y), bf_lo(d.z), bf_hi(d.z), bf_lo(d.w), bf_hi(d.w)};
#pragma unroll
                        for (int e = 0; e < 8; ++e) { const float q = (1.0f + fexp(fminf(-rd[e], 30.0f))) * __builtin_amdgcn_rcpf(1.0f + fexp(-ra[e])); acc[ai][bj][m][e >> 2][e & 3] *= q; } }
                asm volatile("" ::: "memory"); }
    }
    __device__ __forceinline__ void operator()(AccRef acc, const pg8::Unit& u, int wr, int wc, int fr, int fq) const {
        const int row0 = u.pm * 256 + wr * 64 + fr, col0 = u.pn * 256 + wc * 32 + 8 * fq;
#pragma unroll
        for (int ai = 0; ai < 2; ++ai) {
            u32x4 dv[4][2];
#pragma unroll
            for (int m = 0; m < 4; ++m)
#pragma unroll
                for (int bj = 0; bj < 2; ++bj) dv[m][bj] = *(const u32x4*)(Rdn + (size_t)(row0 + ai * 128 + m * 16) * NIN + col0 + bj * 128);
#pragma unroll
            for (int m = 0; m < 4; ++m) { const size_t row = (size_t)(row0 + ai * 128 + m * 16);
#pragma unroll
                for (int bj = 0; bj < 2; ++bj) { const u32x4 d = dv[m][bj];
                    const f32x4 v0 = acc[ai][bj][m][0], v1 = acc[ai][bj][m][1];
#define SGC(x) __builtin_amdgcn_rcpf(1.0f + fexp(fminf(-(x), 30.0f)))
                    const float r[8] = {SGC(bf_lo(d.x)) * v0[0], SGC(bf_hi(d.x)) * v0[1], SGC(bf_lo(d.y)) * v0[2], SGC(bf_hi(d.y)) * v0[3],
                                        SGC(bf_lo(d.z)) * v1[0], SGC(bf_hi(d.z)) * v1[1], SGC(bf_lo(d.w)) * v1[2], SGC(bf_hi(d.w)) * v1[3]};
#undef SGC
                    u32x4 w; w.x = pk2(r[0], r[1]); w.y = pk2(r[2], r[3]); w.z = pk2(r[4], r[5]); w.w = pk2(r[6], r[7]);
                    *(u32x4*)(O + row * D + col0 + bj * 128) = w; } } }
    }
};
template <class Epi> __device__ __forceinline__ void run_gemm(LAS unsigned char* lds, const bf16_t* A, int lda, const bf16_t* Bt, int N, int K, const Epi E, int jt = 1 << 30, int jbytes = 0) {
    pg8::Gemm g{A, Bt, T, N, K, lda, jt, jbytes}; pg8::StaticOrder S; S.init(T, N, (int)gridDim.x, (int)blockIdx.x);
    pg8::gemm_phase<Epi>(lds, g, S, E);
}

__device__ __forceinline__ void transpose_item(const float* W, int ldw, int s0, int k0, bf16_t* WT, int ldk, int d0, LAS float* scr, int lane) {
    float tv[32];
#pragma unroll
    for (int i = 0; i < 32; ++i) tv[i] = W[(size_t)(k0 + 2 * i + (lane >> 5)) * ldw + s0 + (lane & 31)];
#pragma unroll
    for (int i = 0; i < 32; ++i) scr[(2 * i + (lane >> 5)) * 33 + (lane & 31)] = tv[i];
    LDS_WAIT();
    const int c = lane & 7;
#pragma unroll
    for (int j = 0; j < 4; ++j) { const int n = (lane >> 3) + 8 * j; const LAS float* s = scr + (8 * c) * 33 + n;
        u32x4 o; o.x = pk2(s[0 * 33], s[1 * 33]); o.y = pk2(s[2 * 33], s[3 * 33]); o.z = pk2(s[4 * 33], s[5 * 33]); o.w = pk2(s[6 * 33], s[7 * 33]);
        *(u32x4*)(WT + (size_t)(d0 + n) * ldk + k0 + 8 * c) = o; }
    LDS_WAIT();
}
struct TrD { const float* W; int ldw, s0, k0; bf16_t* WT; int ldk, d0; };
__device__ __forceinline__ TrD ffn_item_desc(const float* w_in, const float* w_out, bf16_t* wt_in, bf16_t* wt_out, int it) {
    if (it < 2816) { const int kb = it / 176, nb = it % 176, d0 = nb * 32, pn = d0 >> 8, bj = (d0 >> 7) & 1, c = d0 & 127, s0 = bj * FF + pn * 128 + c; return TrD{w_in, 2 * FF, s0, kb * 64, wt_in, D, d0}; }
    const int r = it - 2816, kb = r / 32, nb = r % 32; return TrD{w_out, D, nb * 32, kb * 64, wt_out, FF, nb * 32};
}
__device__ __forceinline__ void ffn_weight_items(const float* w_in, const float* w_out, bf16_t* wt_in, bf16_t* wt_out, LAS float* scr, int gw, int ngw, int lane, int lo = 0, int NIT = 2816 + 1408) {
    gw += lo;
    float tv[32];
#define TR_LOAD(d_) do { _Pragma("unroll") for (int i = 0; i < 32; ++i) tv[i] = (d_).W[(size_t)((d_).k0 + 2 * i + (lane >> 5)) * (d_).ldw + (d_).s0 + (lane & 31)]; } while (0)
    if (gw < NIT) { const TrD d0_ = ffn_item_desc(w_in, w_out, wt_in, wt_out, gw); TR_LOAD(d0_); }
    for (int it = gw; it < NIT; it += ngw) {
        const TrD d = ffn_item_desc(w_in, w_out, wt_in, wt_out, it);
#pragma unroll
        for (int i = 0; i < 32; ++i) scr[(2 * i + (lane >> 5)) * 33 + (lane & 31)] = tv[i];
        LDS_WAIT();
        if (it + ngw < NIT) { const TrD dn = ffn_item_desc(w_in, w_out, wt_in, wt_out, it + ngw); TR_LOAD(dn); }
        const int c = lane & 7;
#pragma unroll
        for (int j = 0; j < 4; ++j) { const int n = (lane >> 3) + 8 * j; const LAS float* s_ = scr + (8 * c) * 33 + n;
            u32x4 o; o.x = pk2(s_[0 * 33], s_[1 * 33]); o.y = pk2(s_[2 * 33], s_[3 * 33]); o.z = pk2(s_[4 * 33], s_[5 * 33]); o.w = pk2(s_[6 * 33], s_[7 * 33]);
            *(u32x4*)(d.WT + (size_t)(d.d0 + n) * d.ldk + d.k0 + 8 * c) = o; }
        LDS_WAIT();
    }
#undef TR_LOAD
}
__device__ __forceinline__ void mixer_weight_items(const Params& p, LAS float* scr, int gw, int ngw, int lane) {
    unsigned char* ws = p.ws;
    for (int it = gw; it < 2816 + 256 + 256 + 512; it += ngw) {
        int r = it;
        if (r < 2816) { const int kb = r / 176, nb = r % 176, d0 = nb * 32, s0 = d0 < C_RSB ? d0 : d0 + 8; transpose_item(p.in[I_WIN], INW, s0, kb * 64, (bf16_t*)(ws + W_IN), D, d0, scr, lane); continue; } r -= 2816;
        if (r < 256) { const int kb = r / 32, nb = r % 32; transpose_item(p.in[I_WUPSB], D, nb * 32, kb * 64, (bf16_t*)(ws + W_UPSB), D, nb * 32, scr, lane); continue; } r -= 256;
        if (r < 256) { const int kb = r / 32, nb = r % 32; transpose_item(p.in[I_WUPDN], D, nb * 32, kb * 64, (bf16_t*)(ws + W_UPSB) + 512, D, nb * 32, scr, lane); continue; } r -= 256;
        { const int kb = r / 32, nb = r % 32; transpose_item(p.in[I_WOUT], D, nb * 32, kb * 64, (bf16_t*)(ws + W_OUT), D, nb * 32, scr, lane); }
    }
}
__device__ __forceinline__ void mod_item(const Params& p, LAS unsigned char* lds, int cb, int tid, int wave, int lane) {
    asm volatile("" : "+v"(tid), "+v"(lane));
    LAS float* sc = (LAS float*)lds; LAS float* red = (LAS float*)(lds + 32768);
    for (int i = tid; i < NB * D; i += 512) sc[i] = fsilu(p.in[I_C][i]);
    __syncthreads();
    const float* wa = p.in[I_WADA] + cb * 64 + lane;
    float acc[NB];
#pragma unroll
    for (int b = 0; b < NB; ++b) acc[b] = 0.f;
    for (int k = wave * 128; k < wave * 128 + 128; k += 32) {
        float w[32];
#pragma unroll
        for (int e = 0; e < 32; ++e) w[e] = wa[(size_t)(k + e) * NMOD];
#pragma unroll
        for (int b = 0; b < NB; ++b)
#pragma unroll
            for (int e4 = 0; e4 < 8; ++e4) { const f32x4 s = *(const LAS f32x4*)(sc + b * D + k + 4 * e4); acc[b] += s[0] * w[4 * e4] + s[1] * w[4 * e4 + 1] + s[2] * w[4 * e4 + 2] + s[3] * w[4 * e4 + 3]; }
    }
#pragma unroll
    for (int b = 0; b < NB; ++b) red[(wave * NB + b) * 64 + lane] = acc[b];
    __syncthreads();
    { const int b = tid >> 6; float s = p.in[I_BADA][cb * 64 + lane];
#pragma unroll
        for (int w = 0; w < 8; ++w) s += red[(w * NB + b) * 64 + lane];
        ((float*)(p.ws + WS_MOD))[b * NMOD + cb * 64 + lane] = s; }
    __syncthreads();
}

template <bool DN>
__device__ __forceinline__ void norm_mod_phase(const Params& p, LAS unsigned char* lds, const float* src, const float* gain, int midx, bf16_t* dst, int tid, int wave, int lane) {
    asm volatile("" : "+v"(tid), "+v"(lane));
    const float* mod = (const float*)(p.ws + WS_MOD);
    LAS float* wl = (LAS float*)lds;
    if (DN) { for (int i = tid; i < D * 8; i += 512) { const int k = i >> 3, j = i & 7; wl[8 * k + 4 * (k >> 2) + j] = p.in[I_WIN][(size_t)k * INW + C_RSB + j]; } __syncthreads(); }
    f32x4 g4[4];
#pragma unroll
    for (int j = 0; j < 4; ++j) g4[j] = ((const f32x4*)gain)[lane + 64 * j];
    const int rstep = gridDim.x * 8;
    f32x4 nv[4];
    { const int r0 = blockIdx.x * 8 + wave; const f32x4* xr = (const f32x4*)(src + (size_t)(r0 < T ? r0 : 0) * D) + lane;
#pragma unroll
      for (int j = 0; j < 4; ++j) nv[j] = xr[64 * j]; }
    for (int row = blockIdx.x * 8 + wave; row < T; row += rstep) {
        const int b = row >> 11;
        const f32x4* shp = (const f32x4*)(mod + (size_t)b * NMOD + midx * D) + lane; const f32x4* scp = shp + D / 4;
        f32x4 v[4], shv[4], scv[4]; float ss = 0.f;
#pragma unroll
        for (int j = 0; j < 4; ++j) { v[j] = nv[j]; shv[j] = shp[64 * j]; scv[j] = scp[64 * j]; }
        { const int rn = row + rstep < T ? row + rstep : row; const f32x4* xr = (const f32x4*)(src + (size_t)rn * D) + lane;
#pragma unroll
          for (int j = 0; j < 4; ++j) nv[j] = xr[64 * j]; }
#pragma unroll
        for (int j = 0; j < 4; ++j) ss += (v[j][0] * v[j][0] + v[j][1] * v[j][1]) + (v[j][2] * v[j][2] + v[j][3] * v[j][3]);
        const float rstd = 1.0f / sqrtf(wave_sum(ss) * (1.f / D) + EPS);
        u32x2* o8 = (u32x2*)(dst + (size_t)row * D) + lane;
        float dot[8];
        if (DN) {
#pragma unroll
            for (int e = 0; e < 8; ++e) dot[e] = 0.f; }
#pragma unroll
        for (int j = 0; j < 4; ++j) { const f32x4 sh = shv[j], sc = scv[j];
            const f32x4 uu = v[j] * rstd * g4[j] * (sc + 1.0f) + sh;
            u32x2 w; w.x = pk2(uu[0], uu[1]); w.y = pk2(uu[2], uu[3]); o8[64 * j] = w;
            if (DN) {
#pragma unroll
                for (int e = 0; e < 4; ++e) { const int k = 4 * lane + 256 * j + e; const LAS f32x4* wp = (const LAS f32x4*)(wl + 8 * k + 4 * (k >> 2)); const f32x4 w0 = wp[0], w1 = wp[1];
                    dot[0] += uu[e] * w0[0]; dot[1] += uu[e] * w0[1]; dot[2] += uu[e] * w0[2]; dot[3] += uu[e] * w0[3];
                    dot[4] += uu[e] * w1[0]; dot[5] += uu[e] * w1[1]; dot[6] += uu[e] * w1[2]; dot[7] += uu[e] * w1[3]; } } }
        if (DN) {
#pragma unroll
            for (int e = 0; e < 8; ++e) dot[e] = wave_sum(dot[e]);
            float mine = dot[0];
#pragma unroll
            for (int e = 1; e < 8; ++e) mine = (lane == e) ? dot[e] : mine;
            if (lane < 8) { float r;
                if (lane < 4) r = 1.0f / (1.0f + expf(-mine));
                else { const int hh = lane - 4; const float a = mine + p.in[I_DTBIAS][hh]; const float sp = a > 20.f ? a : log1pf(expf(a)); r = -expf(p.in[I_ALOG][hh]) * sp; }
                ((float*)(p.ws + WS_BG))[(size_t)row * 8 + lane] = r; } }
    }
    if (DN) __syncthreads();
}

__device__ __forceinline__ void dn_gate_phase(const Params& p, LAS unsigned char* lds, const bf16_t* u2, int tid, int wave, int lane) {
    asm volatile("" : "+v"(tid), "+v"(lane));
    LAS float* wl = (LAS float*)lds;
    for (int i = tid; i < D * 8; i += 512) { const int k = i >> 3, j = i & 7; wl[8 * k + 4 * (k >> 2) + j] = p.in[I_WIN][(size_t)k * INW + C_RSB + j]; }
    __syncthreads();
    const int rstep = gridDim.x * 8;
    u32x4 na, nb;
    { const int r0 = blockIdx.x * 8 + wave; const bf16_t* up = u2 + (size_t)(r0 < T ? r0 : 0) * D + 16 * lane; na = ((const u32x4*)up)[0]; nb = ((const u32x4*)up)[1]; }
    for (int row = blockIdx.x * 8 + wave; row < T; row += rstep) {
        const u32x4 ca = na, cb = nb;
        { const int rn = row + rstep < T ? row + rstep : row; const bf16_t* up = u2 + (size_t)rn * D + 16 * lane; na = ((const u32x4*)up)[0]; nb = ((const u32x4*)up)[1]; }
        const unsigned w8[8] = {ca.x, ca.y, ca.z, ca.w, cb.x, cb.y, cb.z, cb.w};
        float dot[8];
#pragma unroll
        for (int e = 0; e < 8; ++e) dot[e] = 0.f;
#pragma unroll
        for (int e = 0; e < 16; ++e) { const int k = 16 * lane + e; const LAS f32x4* wp = (const LAS f32x4*)(wl + 8 * k + 4 * (k >> 2)); const f32x4 w0 = wp[0], w1 = wp[1];
            const float uv = (e & 1) ? bf_hi(w8[e >> 1]) : bf_lo(w8[e >> 1]);
            dot[0] += uv * w0[0]; dot[1] += uv * w0[1]; dot[2] += uv * w0[2]; dot[3] += uv * w0[3]; dot[4] += uv * w1[0]; dot[5] += uv * w1[1]; dot[6] += uv * w1[2]; dot[7] += uv * w1[3]; }
#pragma unroll
        for (int e = 0; e < 8; ++e) dot[e] = wave_sum(dot[e]);
        float mine = dot[0];
#pragma unroll
        for (int e = 1; e < 8; ++e) mine = (lane == e) ? dot[e] : mine;
        if (lane < 8) { float r;
            if (lane < 4) r = 1.0f / (1.0f + expf(-mine));
            else { const int hh = lane - 4; const float a = mine + p.in[I_DTBIAS][hh]; const float sp = a > 20.f ? a : log1pf(expf(a)); r = -expf(p.in[I_ALOG][hh]) * sp; }
            ((float*)(p.ws + WS_BG))[(size_t)row * 8 + lane] = r; }
    }
    __syncthreads();
}
__device__ __forceinline__ void unpack16(const bf16_t* p, float* f) {
    const u32x4 a = ((const u32x4*)p)[0], b = ((const u32x4*)p)[1];
    f[0] = bf_lo(a.x); f[1] = bf_hi(a.x); f[2] = bf_lo(a.y); f[3] = bf_hi(a.y); f[4] = bf_lo(a.z); f[5] = bf_hi(a.z); f[6] = bf_lo(a.w); f[7] = bf_hi(a.w);
    f[8] = bf_lo(b.x); f[9] = bf_hi(b.x); f[10] = bf_lo(b.y); f[11] = bf_hi(b.y); f[12] = bf_lo(b.z); f[13] = bf_hi(b.z); f[14] = bf_lo(b.w); f[15] = bf_hi(b.w);
}
__device__ __forceinline__ void pack16(bf16_t* p, const float* f) {
    u32x4 a, b; a.x = pk2(f[0], f[1]); a.y = pk2(f[2], f[3]); a.z = pk2(f[4], f[5]); a.w = pk2(f[6], f[7]); b.x = pk2(f[8], f[9]); b.y = pk2(f[10], f[11]); b.z = pk2(f[12], f[13]); b.w = pk2(f[14], f[15]);
    ((u32x4*)p)[0] = a; ((u32x4*)p)[1] = b;
}
__device__ __forceinline__ void prep_phase(const Params& p, LAS unsigned char* lds, bool dn, int tid, int wave, int lane) {
    asm volatile("" : "+v"(lane), "+v"(tid));
    bf16_t* P = (bf16_t*)(p.ws + WS_P); bf16_t* U = (bf16_t*)(p.ws + WS_U);
    LAS float* wl = (LAS float*)lds;
    if (dn) { for (int i = tid; i < D * 8; i += 512) { const int k = i >> 3, j = i & 7; wl[(k & 15) * 520 + (k >> 4) * 8 + j] = p.in[I_WIN][(size_t)k * INW + C_RSB + j]; } __syncthreads(); }
    const int ch = 16 * lane;
    float gsb[16], wcv[4][16];
    { const float* gp = (ch < 512 ? p.in[I_GQSB] : p.in[I_GKSB]) + (ch & 63); const float sc = ch < 512 ? 0.18033688011112042f : 1.0f;
#pragma unroll
        for (int e = 0; e < 16; ++e) gsb[e] = gp[e] * sc;
#pragma unroll
        for (int i = 0; i < 4; ++i)
#pragma unroll
            for (int e = 0; e < 16; ++e) wcv[i][e] = p.in[I_WCONV][i * 1536 + ch + e]; }
    for (int row = blockIdx.x * 8 + wave; row < T; row += gridDim.x * 8) {
        const int tl = row & (SEQ - 1);
        if (dn) {
            const u32x4 ca = *(const u32x4*)(U + (size_t)row * D + ch), cb = *(const u32x4*)(U + (size_t)row * D + ch + 8);
            const unsigned w8[8] = {ca.x, ca.y, ca.z, ca.w, cb.x, cb.y, cb.z, cb.w};
            float dot[8];
#pragma unroll
            for (int e = 0; e < 8; ++e) dot[e] = 0.f;
#pragma unroll
            for (int e = 0; e < 16; ++e) { const LAS f32x4* wp = (const LAS f32x4*)(wl + e * 520 + lane * 8); const f32x4 w0 = wp[0], w1 = wp[1];
                const float uv = (e & 1) ? bf_hi(w8[e >> 1]) : bf_lo(w8[e >> 1]);
                dot[0] += uv * w0[0]; dot[1] += uv * w0[1]; dot[2] += uv * w0[2]; dot[3] += uv * w0[3]; dot[4] += uv * w1[0]; dot[5] += uv * w1[1]; dot[6] += uv * w1[2]; dot[7] += uv * w1[3]; }
#pragma unroll
            for (int e = 0; e < 8; ++e) dot[e] = wave_sum(dot[e]);
            float mine = dot[0];
#pragma unroll
            for (int e = 1; e < 8; ++e) mine = (lane == e) ? dot[e] : mine;
            if (lane < 8) { float r;
                if (lane < 4) r = 1.0f / (1.0f + expf(-mine));
                else { const int hh = lane - 4; const float a = mine + p.in[I_DTBIAS][hh]; const float sp = a > 20.f ? a : log1pf(expf(a)); r = -expf(p.in[I_ALOG][hh]) * sp; }
                ((float*)(p.ws + WS_BG))[(size_t)row * 8 + lane] = r; } }
        { bf16_t* qp = P + (size_t)row * NIN + ch; float f[16]; unpack16(qp, f); float ss = 0.f;
#pragma unroll
            for (int e = 0; e < 16; ++e) ss += f[e] * f[e];
            ss += __shfl_xor(ss, 1); ss += __shfl_xor(ss, 2);
            const float rstd = 1.0f / sqrtf(ss * (1.f / 64.f) + EPS);
#pragma unroll
            for (int e = 0; e < 16; ++e) f[e] = f[e] * rstd * gsb[e];
            pack16(qp, f); }
        { float y[16];
#pragma unroll
            for (int e = 0; e < 16; ++e) y[e] = 0.f;
#pragma unroll
            for (int i = 0; i < 4; ++i) { if (tl - 3 + i >= 0) { float f[16]; unpack16(P + (size_t)(row - 3 + i) * NIN + C_QDN + ch, f);
#pragma unroll
                    for (int e = 0; e < 16; ++e) y[e] += wcv[i][e] * f[e]; } }
            float ss = 0.f;
#pragma unroll
            for (int e = 0; e < 16; ++e) { y[e] = fsilu(y[e]); ss += y[e] * y[e]; }
            ss += __shfl_xor(ss, 1); ss += __shfl_xor(ss, 2); ss += __shfl_xor(ss, 4);
            const float sc = (1.0f / sqrtf(ss + EPS)) * (ch < 512 ? 0.08838834764831845f : 1.0f);
#pragma unroll
            for (int e = 0; e < 16; ++e) y[e] *= sc;
            pack16(U + (size_t)row * D + ch, y); }
    }
    bf16_t* Vt = (bf16_t*)(p.ws + WS_VT);
    for (int it = blockIdx.x * 8 + wave; it < T / 16; it += gridDim.x * 8) {
        const int row0 = it * 16, b = row0 >> 11, tl0 = row0 & (SEQ - 1), c8 = lane * 8, hd = c8 >> 6, d0 = c8 & 63;
        u32x4 w[16];
#pragma unroll
        for (int r = 0; r < 16; ++r) w[r] = *(const u32x4*)(P + (size_t)(row0 + r) * NIN + C_VSB + c8);
#pragma unroll
        for (int e = 0; e < 8; ++e) {
            unsigned o[8];
#pragma unroll
            for (int i = 0; i < 8; ++i) {
                const int p0 = 2 * i, p1 = 2 * i + 1;
                const int k0 = 8 * ((p0 >> 2) & 1) + 4 * (p0 >> 3) + (p0 & 3), k1 = 8 * ((p1 >> 2) & 1) + 4 * (p1 >> 3) + (p1 & 3);
                const unsigned a0 = w[k0][e >> 1], a1 = w[k1][e >> 1];
                const unsigned lo = (e & 1) ? (a0 >> 16) : (a0 & 0xffffu), hi = (e & 1) ? (a1 & 0xffff0000u) : (a1 << 16);
                o[i] = lo | hi; }
            bf16_t* dst = Vt + ((size_t)(b * 8 + hd) * 64 + d0 + e) * SEQ + tl0;
            ((u32x4*)dst)[0] = (u32x4){o[0], o[1], o[2], o[3]}; ((u32x4*)dst)[1] = (u32x4){o[4], o[5], o[6], o[7]}; }
    }
}

__device__ __forceinline__ float xlane32(float x, int hh) {
    const unsigned xi = __builtin_bit_cast(unsigned, x);
    const u32x2 r = __builtin_amdgcn_permlane32_swap(xi, xi, false, false);
    return __builtin_bit_cast(float, hh ? r.x : r.y);
}
template <bool DIAG>
__device__ __forceinline__ void attn_tile(const f32x16& z, const bf16x8 (&vc)[4], f32x16& o0, f32x16& o1, float& R, int ql, int hh) {
    float sg[16], m[16];
#pragma unroll
    for (int i = 0; i < 16; ++i) { const float e = __builtin_amdgcn_exp2f(fminf(-z[i], 80.0f)); float sig = __builtin_amdgcn_rcpf(1.0f + e); float mm = e * sig;
        if (DIAG) { const bool act = ((i & 3) + 8 * (i >> 2) + 4 * hh) < ql; sig = act ? sig : 0.f; mm = act ? mm : 1.0f; }
        sg[i] = sig; m[i] = mm; }
    float g[4], gp[4];
#pragma unroll
    for (int bq = 0; bq < 4; ++bq) { g[bq] = (m[4 * bq] * m[4 * bq + 1]) * (m[4 * bq + 2] * m[4 * bq + 3]); gp[bq] = xlane32(g[bq], hh); }
    float outer[4]; float tb = R;
#pragma unroll
    for (int bq = 3; bq >= 0; --bq) { outer[bq] = hh == 0 ? tb * gp[bq] : tb; tb *= g[bq] * gp[bq]; }
    R = tb;
    float w[16];
#pragma unroll
    for (int bq = 0; bq < 4; ++bq) { const float s3 = outer[bq], s2 = s3 * m[4 * bq + 3], s1 = s2 * m[4 * bq + 2], s0 = s1 * m[4 * bq + 1];
        w[4 * bq + 3] = sg[4 * bq + 3] * s3; w[4 * bq + 2] = sg[4 * bq + 2] * s2; w[4 * bq + 1] = sg[4 * bq + 1] * s1; w[4 * bq] = sg[4 * bq] * s0; }
    bf16x8 wf[2];
#pragma unroll
    for (int s2 = 0; s2 < 2; ++s2) { const u32x4 pw = {cpk2(w[8 * s2], w[8 * s2 + 1]), cpk2(w[8 * s2 + 2], w[8 * s2 + 3]), cpk2(w[8 * s2 + 4], w[8 * s2 + 5]), cpk2(w[8 * s2 + 6], w[8 * s2 + 7])}; wf[s2] = __builtin_bit_cast(bf16x8, pw); }
    o0 = __builtin_amdgcn_mfma_f32_32x32x16_bf16(vc[0], wf[0], o0, 0, 0, 0); o0 = __builtin_amdgcn_mfma_f32_32x32x16_bf16(vc[1], wf[1], o0, 0, 0, 0);
    o1 = __builtin_amdgcn_mfma_f32_32x32x16_bf16(vc[2], wf[0], o1, 0, 0, 0); o1 = __builtin_amdgcn_mfma_f32_32x32x16_bf16(vc[3], wf[1], o1, 0, 0, 0);
}
__device__ __forceinline__ void attn_item_mfma(bf16_t* P, const bf16_t* Vt, int bh, int qt, int lane) {
    asm volatile("" : "+v"(lane));
    const int b = bh >> 3, h = bh & 7, ql = lane & 31, hh = lane >> 5, q0 = qt * 32;
    bf16_t* qrow = P + (size_t)(b * SEQ + q0 + ql) * NIN + C_QSB + h * 64;
    bf16x8 qf[4];
#pragma unroll
    for (int s = 0; s < 4; ++s) qf[s] = *(const bf16x8*)(qrow + 16 * s + 8 * hh);
    f32x16 o0, o1;
#pragma unroll
    for (int i = 0; i < 16; ++i) { o0[i] = 0.f; o1[i] = 0.f; }
    float R = 1.0f;
    const bf16_t* kb = P + (size_t)(b * SEQ + ql) * NIN + C_KSB + h * 64 + 8 * hh;
    const bf16_t* vb = Vt + ((size_t)bh * 64 + ql) * SEQ + 8 * hh;
    bf16x8 kf[4], vf[4], vn[4];
#define AT_LOADK(k0_) do { _Pragma("unroll") for (int s = 0; s < 4; ++s) kf[s] = *(const bf16x8*)(kb + (size_t)(k0_) * NIN + 16 * s); } while (0)
#define AT_LOADV(dst, k0_) do { _Pragma("unroll") for (int j = 0; j < 4; ++j) dst[j] = *(const bf16x8*)(vb + (size_t)(j >> 1) * 32 * SEQ + (k0_) + 16 * (j & 1)); } while (0)
#define AT_QK(zz) do { _Pragma("unroll") for (int i = 0; i < 16; ++i) zz[i] = 0.f; _Pragma("unroll") for (int s = 0; s < 4; ++s) zz = __builtin_amdgcn_mfma_f32_32x32x16_bf16(kf[s], qf[s], zz, 0, 0, 0); } while (0)
    f32x16 zc, zn;
    AT_LOADK(q0); AT_LOADV(vf, q0);
    AT_QK(zc);
    { const int k1 = (qt > 0 ? qt - 1 : 0) * 32; AT_LOADK(k1); AT_LOADV(vn, k1); }
    { AT_QK(zn);
      const int k2 = (qt > 1 ? qt - 2 : 0) * 32; AT_LOADK(k2);
      attn_tile<true>(zc, vf, o0, o1, R, ql, hh);
      zc = zn;
#pragma unroll
      for (int j = 0; j < 4; ++j) vf[j] = vn[j];
      const int k1 = (qt > 1 ? qt - 2 : 0) * 32; AT_LOADV(vn, k1); }
#pragma unroll 1
    for (int kt = qt - 1; kt >= 0; --kt) {
        AT_QK(zn);
        const int k2 = (kt > 1 ? kt - 2 : 0) * 32; AT_LOADK(k2);
        attn_tile<false>(zc, vf, o0, o1, R, ql, hh);
        if (__builtin_amdgcn_ballot_w64(R != 0.0f) == 0ull) break;
        zc = zn;
#pragma unroll
        for (int j = 0; j < 4; ++j) vf[j] = vn[j];
        AT_LOADV(vn, k2);
    }
#undef AT_LOADK
#undef AT_LOADV
#undef AT_QK
#pragma unroll
    for (int bq = 0; bq < 4; ++bq) {
        u32x2 w0 = {cpk2(o0[4 * bq], o0[4 * bq + 1]), cpk2(o0[4 * bq + 2], o0[4 * bq + 3])}, w1 = {cpk2(o1[4 * bq], o1[4 * bq + 1]), cpk2(o1[4 * bq + 2], o1[4 * bq + 3])};
        *(u32x2*)(qrow + 8 * bq + 4 * hh) = w0; *(u32x2*)(qrow + 32 + 8 * bq + 4 * hh) = w1; }
}
__device__ __forceinline__ size_t slotU(size_t t0, int h, int colbase, int f) { return (t0 + (size_t)(f >> 7)) * D + colbase + h * 128 + (f & 127); }
__device__ __forceinline__ size_t slotP(size_t t0, int h, int colbase, int f) { return (t0 + (size_t)(f >> 7)) * NIN + colbase + h * 128 + (f & 127); }
__device__ __forceinline__ int permpos(int x) { const int k = x & 15; return (x & ~15) + 8 * ((k >> 2) & 1) + 4 * (k >> 3) + (k & 3); }
__device__ __forceinline__ int crow(int r, int hh) { return (r & 3) + 8 * (r >> 2) + 4 * hh; }
__device__ __forceinline__ bf16x8 pack8(const f32x16& x, int s2) {
    const u32x4 pw = {cpk2(x[8 * s2], x[8 * s2 + 1]), cpk2(x[8 * s2 + 2], x[8 * s2 + 3]), cpk2(x[8 * s2 + 4], x[8 * s2 + 5]), cpk2(x[8 * s2 + 6], x[8 * s2 + 7])};
    return __builtin_bit_cast(bf16x8, pw);
}
#define MFMA32(a, b, c) __builtin_amdgcn_mfma_f32_32x32x16_bf16((a), (b), (c), 0, 0, 0)
constexpr int PT = 72, PQ = 136, PL = 68, PB = 40;
constexpr int CP_GC = 0, CP_BT = 256, CP_LS = 1024, CP_TU = CP_LS + 64 * PL * 4, CP_TW = CP_TU + 64 * PT * 2, CP_KT = CP_TW + 64 * PT * 2, CP_VT = CP_KT + 128 * PT * 2,
              CP_QS = CP_VT + 128 * PT * 2, CP_KS = CP_QS + 64 * PQ * 2, CP_AQ = CP_KS + 64 * PQ * 2, CP_L21 = CP_AQ + 64 * PT * 2, CP_TCM = CP_L21 + 32 * PB * 2, CP_T22 = CP_TCM + 32 * PB * 2, CP_END = CP_T22 + 32 * PB * 2;
static_assert(CP_END <= 131072, "chunk prep LDS");
__device__ __forceinline__ void gdn_chunk_prep_phase(const Params& p, LAS unsigned char* lds, int tid, int wave, int lane) {
    bf16_t* P = (bf16_t*)(p.ws + WS_P); bf16_t* U = (bf16_t*)(p.ws + WS_U); const float* BG = (const float*)(p.ws + WS_BG);
    u32x4 ka, kb, qa, qb, xv[4][2]; float gx = 0.f, gbt = 0.f;
#define CP_LOAD(item_) do { const int bh_ = (item_) >> 5, n_ = (item_) & 31, b_ = bh_ >> 2, h_ = bh_ & 3; const size_t t0_ = (size_t)b_ * SEQ + n_ * 64; const int tok_ = tid & 63, c16_ = (tid >> 6) * 16; \
        ka = *(const u32x4*)(U + (t0_ + tok_) * D + 512 + h_ * 128 + c16_); kb = *(const u32x4*)(U + (t0_ + tok_) * D + 512 + h_ * 128 + c16_ + 8); \
        qa = *(const u32x4*)(U + (t0_ + tok_) * D + h_ * 128 + c16_); qb = *(const u32x4*)(U + (t0_ + tok_) * D + h_ * 128 + c16_ + 8); \
        _Pragma("unroll") for (int i = 0; i < 4; ++i) { const bool ok = n_ * 64 + tok_ - 3 + i >= 0; const bf16_t* vp = P + (t0_ + tok_ - 3 + i) * NIN + C_VDN + h_ * 128 + c16_; \
            xv[i][0] = ok ? *(const u32x4*)vp : (u32x4){0u, 0u, 0u, 0u}; xv[i][1] = ok ? *(const u32x4*)(vp + 8) : (u32x4){0u, 0u, 0u, 0u}; } \
        if (tid < 64) { gx = BG[(t0_ + tid) * 8 + 4 + h_]; gbt = BG[(t0_ + tid) * 8 + h_]; } } while (0)
    if ((int)blockIdx.x < 1024) CP_LOAD((int)blockIdx.x);
  for (int item = blockIdx.x; item < 1024; item += gridDim.x) {
    asm volatile("" : "+v"(tid), "+v"(lane));
    const int bh = item >> 5, n = item & 31, b = bh >> 2, h = bh & 3, ql = lane & 31, hh = lane >> 5;
    const size_t t0 = (size_t)b * SEQ + n * 64;
    LAS float* gcS = (LAS float*)(lds + CP_GC); LAS float* btS = (LAS float*)(lds + CP_BT);
    LAS float* LS = (LAS float*)(lds + CP_LS);
    LAS bf16_t* TuS = (LAS bf16_t*)(lds + CP_TU); LAS bf16_t* TwS = (LAS bf16_t*)(lds + CP_TW);
    LAS bf16_t* kT = (LAS bf16_t*)(lds + CP_KT); LAS bf16_t* vT = (LAS bf16_t*)(lds + CP_VT); LAS bf16_t* qS = (LAS bf16_t*)(lds + CP_QS); LAS bf16_t* kS = (LAS bf16_t*)(lds + CP_KS);
    LAS bf16_t* AQ = (LAS bf16_t*)(lds + CP_AQ); LAS bf16_t* L21b = (LAS bf16_t*)(lds + CP_L21); LAS bf16_t* Tcm = (LAS bf16_t*)(lds + CP_TCM); LAS bf16_t* T22r = (LAS bf16_t*)(lds + CP_T22);
    if (tid < 64) { float x = gx;
#pragma unroll
        for (int o = 1; o < 64; o <<= 1) { const float y = __shfl_up(x, o); if (lane >= o) x += y; }
        gcS[tid] = x; btS[tid] = gbt; }
    { const int tok = tid & 63, c16 = (tid >> 6) * 16;
        *(LAS u32x4*)(kS + tok * PQ + c16) = ka; *(LAS u32x4*)(kS + tok * PQ + c16 + 8) = kb;
        *(LAS u32x4*)(qS + tok * PQ + c16) = qa; *(LAS u32x4*)(qS + tok * PQ + c16 + 8) = qb;
        const unsigned kw[8] = {ka.x, ka.y, ka.z, ka.w, kb.x, kb.y, kb.z, kb.w};
#pragma unroll
        for (int e = 0; e < 8; ++e) { kT[(c16 + 2 * e) * PT + tok] = (bf16_t)(kw[e] & 0xffffu); kT[(c16 + 2 * e + 1) * PT + tok] = (bf16_t)(kw[e] >> 16); }
        float y[16];
#pragma unroll
        for (int e = 0; e < 16; ++e) y[e] = 0.f;
#pragma unroll
        for (int i = 0; i < 4; ++i) { const float* wp = p.in[I_WCONV] + i * 1536 + 1024 + h * 128 + c16;
            const unsigned xw[8] = {xv[i][0].x, xv[i][0].y, xv[i][0].z, xv[i][0].w, xv[i][1].x, xv[i][1].y, xv[i][1].z, xv[i][1].w};
#pragma unroll
            for (int e = 0; e < 8; ++e) { y[2 * e] += wp[2 * e] * bf_lo(xw[e]); y[2 * e + 1] += wp[2 * e + 1] * bf_hi(xw[e]); } }
#pragma unroll
        for (int e = 0; e < 16; ++e) vT[(c16 + e) * PT + tok] = f2bf(fsilu(y[e])); }
    LDS_BARRIER();
    if (item + (int)gridDim.x < 1024) CP_LOAD(item + (int)gridDim.x);
    if (wave == 0 || wave == 4 || wave == 5) {
        const int it = wave == 0 ? 0 : 1, jt = wave == 4 ? 1 : 0;
        f32x16 acc;
#pragma unroll
        for (int r = 0; r < 16; ++r) acc[r] = 0.f;
#pragma unroll
        for (int ks = 0; ks < 8; ++ks) acc = MFMA32(*(const LAS bf16x8*)(kS + (32 * it + ql) * PQ + 16 * ks + 8 * hh), *(const LAS bf16x8*)(kS + (32 * jt + ql) * PQ + 16 * ks + 8 * hh), acc);
        const int j = 32 * jt + ql; const float gj = gcS[j];
#pragma unroll
        for (int r = 0; r < 16; ++r) { const int i = 32 * it + crow(r, hh); const float l = (j < i) ? btS[i] * acc[r] * fexp(gcS[i] - gj) : 0.f;
            if (it != jt) L21b[(i - 32) * PB + j] = f2bf(l); else LS[i * PL + j] = l; }
    } else if (wave < 4) {
        const int jt = wave == 3 ? 1 : 0, it = wave == 1 ? 0 : 1;
        f32x16 acc;
#pragma unroll
        for (int r = 0; r < 16; ++r) acc[r] = 0.f;
#pragma unroll
        for (int ks = 0; ks < 8; ++ks) acc = MFMA32(*(const LAS bf16x8*)(kS + (32 * jt + ql) * PQ + 16 * ks + 8 * hh), *(const LAS bf16x8*)(qS + (32 * it + ql) * PQ + 16 * ks + 8 * hh), acc);
        const int i = 32 * it + ql; const float gi = gcS[i];
#pragma unroll
        for (int r = 0; r < 16; ++r) { const int j = 32 * jt + crow(r, hh); acc[r] = (j <= i) ? acc[r] * fexp(gi - gcS[j]) : 0.f; }
#pragma unroll
        for (int bq = 0; bq < 4; ++bq) *(LAS u32x2*)(AQ + i * PT + 32 * jt + 8 * bq + 4 * hh) = (u32x2){cpk2(acc[4 * bq], acc[4 * bq + 1]), cpk2(acc[4 * bq + 2], acc[4 * bq + 3])};
    } else {
        const float gl = gcS[63];
#pragma unroll
        for (int uu = 0; uu < 4; ++uu) { const int unit = (tid - 384) + 128 * uu, dk = unit >> 2, blk = unit & 3;
            const u32x4 k0 = *(const LAS u32x4*)(kT + dk * PT + 16 * blk), k1 = *(const LAS u32x4*)(kT + dk * PT + 16 * blk + 8);
            float kv[16] = {bf_lo(k0.x), bf_hi(k0.x), bf_lo(k0.y), bf_hi(k0.y), bf_lo(k0.z), bf_hi(k0.z), bf_lo(k0.w), bf_hi(k0.w), bf_lo(k1.x), bf_hi(k1.x), bf_lo(k1.y), bf_hi(k1.y), bf_lo(k1.z), bf_hi(k1.z), bf_lo(k1.w), bf_hi(k1.w)};
#pragma unroll
            for (int e = 0; e < 16; ++e) kv[e] *= fexp(gl - gcS[16 * blk + e]);
            float pv[16];
#pragma unroll
            for (int e = 0; e < 16; ++e) pv[permpos(e)] = kv[e];
            pack16(P + slotP(t0, h, C_VSB, dk * 64 + 16 * blk), pv); }
        if (tid == 384) ((float*)(p.ws + WS_EGL))[bh * 32 + n] = fexp(gl);
    }
    LDS_BARRIER();
    if (wave == 0) {
        const LAS float* LB = LS + (32 * hh) * PL + 32 * hh;
        float Tc[32];
        f32x4 lc[8], ln[8];
        Tc[0] = (ql == 0) ? 1.0f : 0.f;
        lc[0] = *(const LAS f32x4*)(LB + 1 * PL);
#pragma unroll
        for (int i = 1; i < 32; ++i) {
            if (i + 1 < 32) {
#pragma unroll
                for (int j4 = 0; j4 < i + 1; j4 += 4) ln[j4 >> 2] = *(const LAS f32x4*)(LB + (i + 1) * PL + j4); }
            float a0 = (ql == i) ? 1.0f : 0.f, a1 = 0.f, a2 = 0.f, a3 = 0.f;
#pragma unroll
            for (int j4 = 0; j4 < i; j4 += 4) { const f32x4 l4 = lc[j4 >> 2];
                a0 -= l4[0] * Tc[j4]; if (j4 + 1 < i) a1 -= l4[1] * Tc[j4 + 1]; if (j4 + 2 < i) a2 -= l4[2] * Tc[j4 + 2]; if (j4 + 3 < i) a3 -= l4[3] * Tc[j4 + 3]; }
            Tc[i] = (a0 + a1) + (a2 + a3);
#pragma unroll
            for (int q = 0; q < 8; ++q) lc[q] = ln[q]; }
        const int cg_ = 32 * hh + ql; const float bu = btS[cg_], bw = bu * fexp(gcS[cg_]);
#pragma unroll
        for (int i = 0; i < 32; ++i) { TuS[(32 * hh + i) * PT + cg_] = f2bf(Tc[i] * bu); TwS[(32 * hh + i) * PT + cg_] = f2bf(Tc[i] * bw); }
        if (hh == 0) {
#pragma unroll
            for (int i8 = 0; i8 < 4; ++i8) *(LAS u32x4*)(Tcm + ql * PB + 8 * i8) = (u32x4){cpk2(Tc[8 * i8], Tc[8 * i8 + 1]), cpk2(Tc[8 * i8 + 2], Tc[8 * i8 + 3]), cpk2(Tc[8 * i8 + 4], Tc[8 * i8 + 5]), cpk2(Tc[8 * i8 + 6], Tc[8 * i8 + 7])};
        } else {
#pragma unroll
            for (int i = 0; i < 32; ++i) T22r[i * PB + ql] = f2bf(Tc[i]);
        }
        LDS_WAIT();
        f32x16 x1;
#pragma unroll
        for (int r = 0; r < 16; ++r) x1[r] = 0.f;
#pragma unroll
        for (int s2 = 0; s2 < 2; ++s2) x1 = MFMA32(*(const LAS bf16x8*)(L21b + ql * PB + 16 * s2 + 8 * hh), *(const LAS bf16x8*)(Tcm + ql * PB + 16 * s2 + 8 * hh), x1);
        f32x16 yy;
#pragma unroll
        for (int r = 0; r < 16; ++r) yy[r] = 0.f;
#pragma unroll
        for (int s2 = 0; s2 < 2; ++s2) { const u32x2 lo = *(const LAS u32x2*)(T22r + ql * PB + 16 * s2 + 4 * hh), hi = *(const LAS u32x2*)(T22r + ql * PB + 16 * s2 + 8 + 4 * hh);
            const u32x4 af = {lo.x, lo.y, hi.x, hi.y};
            yy = MFMA32(__builtin_bit_cast(bf16x8, af), pack8(x1, s2), yy); }
        { const float bu0 = btS[ql], bw0 = bu0 * fexp(gcS[ql]);
#pragma unroll
            for (int r = 0; r < 16; ++r) { const int i2 = 32 + crow(r, hh); TuS[i2 * PT + ql] = f2bf(-yy[r] * bu0); TwS[i2 * PT + ql] = f2bf(-yy[r] * bw0); } }
    }
    LDS_BARRIER();
    {
        const int isW = wave >> 2, ct = wave & 3, col = 32 * ct + ql;
        const LAS bf16_t* Ta = (isW ? TwS : TuS) + 8 * hh; const LAS bf16_t* Bs = (isW ? kT : vT) + col * PT + 8 * hh;
        bf16x8 bf[4];
#pragma unroll
        for (int ks = 0; ks < 4; ++ks) bf[ks] = *(const LAS bf16x8*)(Bs + 16 * ks);
        f32x16 xa[2];
#pragma unroll
        for (int jt = 0; jt < 2; ++jt) {
#pragma unroll
            for (int r = 0; r < 16; ++r) xa[jt][r] = 0.f;
#pragma unroll
            for (int ks = 0; ks < 4; ++ks) if (jt == 1 || ks < 2) xa[jt] = MFMA32(*(const LAS bf16x8*)(Ta + (32 * jt + ql) * PT + 16 * ks), bf[ks], xa[jt]); }
        bf16x8 xb[4] = {pack8(xa[0], 0), pack8(xa[0], 1), pack8(xa[1], 0), pack8(xa[1], 1)};
        f32x16 ra[2];
#pragma unroll
        for (int it = 0; it < 2; ++it) {
#pragma unroll
            for (int r = 0; r < 16; ++r) ra[it][r] = 0.f;
#pragma unroll
            for (int kk = 0; kk < 4; ++kk) if (it == 1 || kk < 2) { const LAS bf16_t* ap = AQ + (32 * it + ql) * PT + 16 * kk + 4 * hh;
                const u32x2 lo = *(const LAS u32x2*)ap, hi = *(const LAS u32x2*)(ap + 8); const u32x4 af = {lo.x, lo.y, hi.x, hi.y};
                ra[it] = MFMA32(__builtin_bit_cast(bf16x8, af), xb[kk], ra[it]); } }
        if (!isW) {
#pragma unroll
            for (int jt = 0; jt < 2; ++jt)
#pragma unroll
                for (int bq = 0; bq < 4; ++bq) { const int f = col * 64 + 32 * jt + 8 * bq + 4 * hh;
                    *(u32x2*)(U + slotU(t0, h, 0, f)) = (u32x2){cpk2(xa[jt][4 * bq], xa[jt][4 * bq + 1]), cpk2(xa[jt][4 * bq + 2], xa[jt][4 * bq + 3])};
                    *(u32x2*)(U + slotU(t0, h, 512, f)) = (u32x2){cpk2(ra[jt][4 * bq], ra[jt][4 * bq + 1]), cpk2(ra[jt][4 * bq + 2], ra[jt][4 * bq + 3])}; }
        } else {
            const int pc = permpos(col);
#pragma unroll
            for (int jt = 0; jt < 2; ++jt)
#pragma unroll
                for (int r = 0; r < 16; ++r) { const int tok = 32 * jt + crow(r, hh);
                    P[(t0 + tok) * NIN + C_QDN + h * 128 + pc] = f2bf(-xa[jt][r]);
                    P[(t0 + tok) * NIN + C_KDN + h * 128 + pc] = f2bf(bf2f(qS[tok * PQ + col]) * fexp(gcS[tok]) - ra[jt][r]); }
        }
    }
    LDS_BARRIER();
  }
#undef CP_LOAD
}
constexpr int SC_PW = 136, SC_PK = 72, SC_NW = 0, SC_Q2 = 64 * SC_PW * 2, SC_KD = 2 * 64 * SC_PW * 2, SC_STAGE = 2 * 64 * SC_PW * 2 + 128 * SC_PK * 2, SC_OS = 2 * SC_STAGE,
              SC_US = SC_OS + 128 * SC_PK * 2, SC_OI = SC_US + 128 * SC_PK * 2, SC_END = SC_OI + 128 * SC_PK * 2;
static_assert(SC_END <= BST_OFF, "scan LDS");
__device__ __forceinline__ void gdn_scan_block(const Params& p, LAS unsigned char* lds, int bh, int tid, int wave, int lane) {
    asm volatile("" : "+v"(tid), "+v"(lane));
    bf16_t* P = (bf16_t*)(p.ws + WS_P); const bf16_t* U = (const bf16_t*)(p.ws + WS_U); const float* EGL = (const float*)(p.ws + WS_EGL);
    const int b = bh >> 2, h = bh & 3, ql = lane & 31, hh = lane >> 5;
    const size_t tb = (size_t)b * SEQ;
    LAS bf16_t* oS = (LAS bf16_t*)(lds + SC_OS);
    if (wave >= 4) {
        int lt = tid - 256, ftok = lt >> 2, fseg = lt & 3;
        u32x4 ra[20], rb[20];
#define SC_LOAD(r, n_) do { const size_t t0_ = tb + (size_t)(n_) * 64; _Pragma("unroll") for (int i = 0; i < 4; ++i) { const int c = lt + 256 * i, row = c >> 4, c8 = (c & 15) * 8; \
            const bf16_t* g_ = P + (t0_ + row) * NIN + h * 128 + c8; const bf16_t* u_ = U + (t0_ + row) * D + h * 128 + c8; \
            r[i] = *(const u32x4*)(g_ + C_QDN); r[4 + i] = *(const u32x4*)(g_ + C_KDN); r[8 + i] = *(const u32x4*)(g_ + C_VSB); r[12 + i] = *(const u32x4*)u_; r[16 + i] = *(const u32x4*)(u_ + 512); } } while (0)
#define SC_STORE(r, st_) do { LAS unsigned char* s_ = lds + (st_) * SC_STAGE; _Pragma("unroll") for (int i = 0; i < 4; ++i) { const int c = lt + 256 * i, row = c >> 4, c8 = (c & 15) * 8; \
            *(LAS u32x4*)(s_ + SC_NW + (row * SC_PW + c8) * 2) = r[i]; *(LAS u32x4*)(s_ + SC_Q2 + (row * SC_PW + c8) * 2) = r[4 + i]; \
            *(LAS u32x4*)(s_ + SC_KD + ((2 * row + (c8 >> 6)) * SC_PK + (c8 & 63)) * 2) = r[8 + i]; } } while (0)
#define SC_STOREU(r) do { _Pragma("unroll") for (int i = 0; i < 4; ++i) { const int c = lt + 256 * i, row = c >> 4, c8 = (c & 15) * 8; const int o_ = ((2 * row + (c8 >> 6)) * SC_PK + (c8 & 63)) * 2; \
            *(LAS u32x4*)(lds + SC_US + o_) = r[12 + i]; *(LAS u32x4*)(lds + SC_OI + o_) = r[16 + i]; } } while (0)
#define SC_FIN(m_) do { bf16_t* orow = P + (tb + (size_t)(m_) * 64 + ftok) * NIN + h * 128 + fseg * 32 + C_VDN; \
            _Pragma("unroll") for (int i = 0; i < 4; ++i) { unsigned w_[4]; \
                _Pragma("unroll") for (int j = 0; j < 4; ++j) { const int c_ = fseg * 32 + 8 * i + 2 * j; w_[j] = (unsigned)oS[c_ * SC_PK + ftok] | ((unsigned)oS[(c_ + 1) * SC_PK + ftok] << 16); } \
                *(u32x4*)(orow + 8 * i) = (u32x4){w_[0], w_[1], w_[2], w_[3]}; } } while (0)
        SC_LOAD(ra, 0); SC_STORE(ra, 0); SC_STOREU(ra); SC_LOAD(ra, 1);
        LDS_BARRIER();
#pragma unroll 1
        for (int n = 0; n < 32; n += 2) {
            asm volatile("" : "+v"(lt), "+v"(ftok), "+v"(fseg));
            if (n + 2 < 32) SC_LOAD(rb, n + 2);
            SC_STORE(ra, 1);
            if (n > 0) SC_FIN(n - 1);
            LDS_BARRIER();
            SC_STOREU(ra);
            LDS_BARRIER();
            if (n + 3 < 32) SC_LOAD(ra, n + 3);
            if (n + 2 < 32) SC_STORE(rb, 0);
            SC_FIN(n);
            LDS_BARRIER();
            if (n + 2 < 32) SC_STOREU(rb);
            LDS_BARRIER();
        }
        SC_FIN(31);
#undef SC_LOAD
#undef SC_STORE
#undef SC_STOREU
#undef SC_FIN
    } else {
        const int col = 32 * wave + ql;
        f32x16 S[4];
#pragma unroll
        for (int rt = 0; rt < 4; ++rt)
#pragma unroll
            for (int r = 0; r < 16; ++r) S[rt][r] = 0.f;
        const float eglv = EGL[bh * 32 + ql];
        LDS_BARRIER();
#pragma unroll 1
        for (int n = 0; n < 32; ++n) {
            const float egl = __builtin_bit_cast(float, __builtin_amdgcn_readlane(__builtin_bit_cast(int, eglv), n));
            const LAS unsigned char* st = lds + (n & 1) * SC_STAGE;
            f32x16 vn[2], oa[2];
            { const LAS unsigned char* up_ = lds + SC_US + (col * SC_PK + 4 * hh) * 2; const LAS unsigned char* op_ = lds + SC_OI + (col * SC_PK + 4 * hh) * 2;
#pragma unroll
              for (int jt = 0; jt < 2; ++jt)
#pragma unroll
                for (int bq = 0; bq < 4; ++bq) { const u32x2 uw = *(const LAS u32x2*)(up_ + (32 * jt + 8 * bq) * 2), ow = *(const LAS u32x2*)(op_ + (32 * jt + 8 * bq) * 2);
                    vn[jt][4 * bq] = bf_lo(uw.x); vn[jt][4 * bq + 1] = bf_hi(uw.x); vn[jt][4 * bq + 2] = bf_lo(uw.y); vn[jt][4 * bq + 3] = bf_hi(uw.y);
                    oa[jt][4 * bq] = bf_lo(ow.x); oa[jt][4 * bq + 1] = bf_hi(ow.x); oa[jt][4 * bq + 2] = bf_lo(ow.y); oa[jt][4 * bq + 3] = bf_hi(ow.y); } }
            const LAS unsigned char* w0_ = st + (ql * SC_PW + 8 * hh) * 2; const LAS unsigned char* w1_ = w0_ + 32 * SC_PW * 2;
            const LAS unsigned char* kd_ = st + SC_KD + (ql * SC_PK + 8 * hh) * 2;
            bf16x8 fa[4], fb[4];
#define SC_RD4(dst, ptr) do { _Pragma("unroll") for (int i_ = 0; i_ < 4; ++i_) dst[i_] = *(const LAS bf16x8*)((ptr) + 32 * i_); } while (0)
#define SC_MM4(acc, fr, bb) do { _Pragma("unroll") for (int i_ = 0; i_ < 4; ++i_) acc = MFMA32(fr[i_], bb[i_], acc); __builtin_amdgcn_sched_barrier(0); } while (0)
            SC_RD4(fa, w0_ + SC_NW); SC_RD4(fb, w1_ + SC_NW);
            { bf16x8 sb[4] = {pack8(S[0], 0), pack8(S[0], 1), pack8(S[1], 0), pack8(S[1], 1)};
              SC_MM4(vn[0], fa, sb); SC_RD4(fa, w0_ + SC_Q2);
              SC_MM4(vn[1], fb, sb); SC_RD4(fb, w1_ + SC_Q2);
              SC_MM4(oa[0], fa, sb); SC_RD4(fa, w0_ + SC_NW + 128);
              SC_MM4(oa[1], fb, sb); SC_RD4(fb, w1_ + SC_NW + 128); }
            { bf16x8 sb[4] = {pack8(S[2], 0), pack8(S[2], 1), pack8(S[3], 0), pack8(S[3], 1)};
              SC_MM4(vn[0], fa, sb); SC_RD4(fa, w0_ + SC_Q2 + 128);
              SC_MM4(vn[1], fb, sb); SC_RD4(fb, w1_ + SC_Q2 + 128);
              bf16x8 vb[4] = {pack8(vn[0], 0), pack8(vn[0], 1), pack8(vn[1], 0), pack8(vn[1], 1)};
              SC_MM4(oa[0], fa, sb); SC_RD4(fa, kd_);
              SC_MM4(oa[1], fb, sb); SC_RD4(fb, kd_ + 32 * SC_PK * 2);
#pragma unroll
              for (int rt = 0; rt < 4; ++rt)
#pragma unroll
                  for (int r = 0; r < 16; ++r) S[rt][r] *= egl;
              SC_MM4(S[0], fa, vb); SC_RD4(fa, kd_ + 64 * SC_PK * 2);
              SC_MM4(S[1], fb, vb); SC_RD4(fb, kd_ + 96 * SC_PK * 2);
              SC_MM4(S[2], fa, vb);
              SC_MM4(S[3], fb, vb); }
#undef SC_RD4
#undef SC_MM4
            LDS_BARRIER();
#pragma unroll
            for (int jt = 0; jt < 2; ++jt)
#pragma unroll
                for (int bq = 0; bq < 4; ++bq) *(LAS u32x2*)(oS + col * SC_PK + 32 * jt + 8 * bq + 4 * hh) = (u32x2){cpk2(oa[jt][4 * bq], oa[jt][4 * bq + 1]), cpk2(oa[jt][4 * bq + 2], oa[jt][4 * bq + 3])};
            LDS_BARRIER();
        }
    }
}
__device__ __forceinline__ void gdn_finalize_phase(const Params& p, int wave, int lane) {
    asm volatile("" : "+v"(lane));
    bf16_t* P = (bf16_t*)(p.ws + WS_P);
    const int c0 = (lane & 15) * 8;
    float gg[8];
#pragma unroll
    for (int e = 0; e < 8; ++e) gg[e] = p.in[I_GDNOUT][c0 + e];
    for (int row = blockIdx.x * 8 + wave; row < T; row += gridDim.x * 8) {
        bf16_t* op = P + (size_t)row * NIN + C_VDN + lane * 8; const bf16_t* zp = P + (size_t)row * NIN + C_ZDN + lane * 8;
        const u32x4 ow = *(const u32x4*)op, zw = *(const u32x4*)zp;
        const float o[8] = {bf_lo(ow.x), bf_hi(ow.x), bf_lo(ow.y), bf_hi(ow.y), bf_lo(ow.z), bf_hi(ow.z), bf_lo(ow.w), bf_hi(ow.w)};
        const float z[8] = {bf_lo(zw.x), bf_hi(zw.x), bf_lo(zw.y), bf_hi(zw.y), bf_lo(zw.z), bf_hi(zw.z), bf_lo(zw.w), bf_hi(zw.w)};
        float ss = 0.f;
#pragma unroll
        for (int e = 0; e < 8; ++e) ss += o[e] * o[e];
        ss += __shfl_xor(ss, 1); ss += __shfl_xor(ss, 2); ss += __shfl_xor(ss, 4); ss += __shfl_xor(ss, 8);
        const float rstd = 1.0f / sqrtf(ss * (1.f / 128.f) + EPS);
        float r[8];
#pragma unroll
        for (int e = 0; e < 8; ++e) r[e] = o[e] * rstd * gg[e] * fsilu(z[e]);
        u32x4 w; w.x = pk2(r[0], r[1]); w.y = pk2(r[2], r[3]); w.z = pk2(r[4], r[5]); w.w = pk2(r[6], r[7]);
        *(u32x4*)op = w;
    }
}

#define XB_TMO      128
#define XB_XCNT(j)  (256  + 64 * (j))
#define XB_XSUB(j)  (1280 + 64 * (j))
#define XB_XGEN(j)  (2304 + 64 * (j))
#define XB_TOP      3328
#define XB_TOPGEN   3392
#define XCD_BAR_WORDS 3456
#define XB_SPIN_CAP (1u << 18)
__device__ __forceinline__ unsigned xb_ld(unsigned* p)              { return __hip_atomic_load(p, __ATOMIC_RELAXED, __HIP_MEMORY_SCOPE_AGENT); }
__device__ __forceinline__ unsigned xb_add(unsigned* p, unsigned v) { return __hip_atomic_fetch_add(p, v, __ATOMIC_RELAXED, __HIP_MEMORY_SCOPE_AGENT); }
__device__ __forceinline__ unsigned xb_xcc_id() { return (unsigned)__builtin_amdgcn_s_getreg((3 << 11) | 20) & 0xFu; }
#define XB_SPIN(cond, bar) do { unsigned _sp = 0; while (cond) { __builtin_amdgcn_s_sleep(1); \
    if ((++_sp & 255u) == 0u) { if (xb_ld(&(bar)[XB_TMO])) break; if (_sp > XB_SPIN_CAP) { atomicAdd(&(bar)[XB_TMO], 1u); break; } } } } while (0)
struct XcdBarrier { unsigned* bar; unsigned x; volatile LAS unsigned* st; };
__device__ __forceinline__ XcdBarrier xcd_barrier_post(unsigned* bar, volatile LAS unsigned* st) {
    XcdBarrier b; b.bar = bar; b.x = xb_xcc_id(); b.st = st;
    if (threadIdx.x == 0) (void)xb_add(&bar[XB_XCNT(b.x)], 1u);
    return b;
}
__device__ __forceinline__ void xcd_barrier_complete(unsigned* bar, unsigned x, unsigned& nloc, unsigned& nx) {
    const unsigned G = gridDim.x * gridDim.y * gridDim.z;
    unsigned sum, cnt, mine, sp = 0u;
    for (;;) {
        sum = 0u; cnt = 0u; mine = 0u;
#pragma unroll
        for (unsigned j = 0; j < 16; ++j) { const unsigned c = xb_ld(&bar[XB_XCNT(j)]); sum += c; cnt += (c > 0u) ? 1u : 0u; mine = (j == x) ? c : mine; }
        if (sum == G) break;
        __builtin_amdgcn_s_sleep(1);
        if ((++sp & 255u) == 0u) { if (xb_ld(&bar[XB_TMO])) break; if (sp > XB_SPIN_CAP) { atomicAdd(&bar[XB_TMO], 1u); break; } }
    }
    nloc = mine > 0u ? mine : 1u; nx = cnt > 0u ? cnt : 1u;
}
__device__ __forceinline__ void xcd_barrier(const XcdBarrier& b) {
    asm volatile("s_waitcnt vmcnt(0)" ::: "memory");
    __syncthreads();
    if (threadIdx.x == 0) {
        unsigned* bar = b.bar;
        __builtin_amdgcn_s_waitcnt(0);
        unsigned nloc = b.st[0], nx = b.st[1];
        if (nloc == 0u) { xcd_barrier_complete(bar, b.x, nloc, nx); b.st[0] = nloc; b.st[1] = nx; }
        const unsigned old = xb_add(&bar[XB_XSUB(b.x)], 1u);
        const unsigned gen = old / nloc;
        if (old + 1u == (gen + 1u) * nloc) {
            __builtin_amdgcn_fence(__ATOMIC_RELEASE, "agent");
            asm volatile("s_waitcnt vmcnt(0)" ::: "memory");
            const unsigned og = xb_add(&bar[XB_TOP], 1u);
            const unsigned tg = og / nx;
            if (og + 1u == (tg + 1u) * nx) xb_add(&bar[XB_TOPGEN], 1u);
            else XB_SPIN(xb_ld(&bar[XB_TOPGEN]) == tg, bar);
            __builtin_amdgcn_fence(__ATOMIC_ACQUIRE, "agent");
            xb_add(&bar[XB_XGEN(b.x)], 1u);
            asm volatile("s_waitcnt vmcnt(0)" ::: "memory");
        } else {
            XB_SPIN(xb_ld(&bar[XB_TOPGEN]) == gen, bar);
            __builtin_amdgcn_fence(__ATOMIC_ACQUIRE, "agent");
            asm volatile("s_waitcnt vmcnt(0)" ::: "memory");
        }
    }
    __syncthreads();
}

#ifndef PHMASK
#define PHMASK 0xFFFF
#endif
#define PH(n) ((PHMASK >> (n)) & 1)
#ifndef PROBE
#define PROBE 0
#endif
#define REP(g) for (int _rep = 0; _rep < ((PROBE == (g)) ? 2 : 1); ++_rep)
__global__ void __launch_bounds__(512, 2) fwd_megakernel(Params p) {
    extern __shared__ __attribute__((aligned(16))) unsigned char lds_raw[];
    LAS unsigned char* lds = (LAS unsigned char*)lds_raw;
    cg::grid_group grid = cg::this_grid();
    const int tid = threadIdx.x, lane = tid & 63, wave = __builtin_amdgcn_readfirstlane(tid >> 6);
    const int G = gridDim.x, gw = wave * G + blockIdx.x, ngw = G * 8;
    unsigned char* ws = p.ws;
    bf16_t* U = (bf16_t*)(ws + WS_U); bf16_t* P = (bf16_t*)(ws + WS_P);
    const float* mod = (const float*)(ws + WS_MOD);
    LAS float* scr = (LAS float*)(lds + wave * 16384);

    unsigned* barw = (unsigned*)(ws + WS_BAR);
    volatile LAS unsigned* bst = (volatile LAS unsigned*)(lds + BST_OFF);
    if (tid < 2) bst[tid] = 0u;
    __syncthreads();
    if (p.ws == nullptr) grid.sync();
    const XcdBarrier xbar = xcd_barrier_post(barw, bst);
    REP(1) { if (PH(0)) for (int it = blockIdx.x; it < NMOD / 64; it += G) mod_item(p, lds, it, tid, wave, lane);
    { const int nmod = NMOD / 64;
      if (PH(0)) { if (G >= nmod + 64) { if ((int)blockIdx.x >= nmod) ffn_weight_items(p.in[I_WFFN1IN], p.in[I_WFFN1OUT], (bf16_t*)(ws + W_FFIN), (bf16_t*)(ws + W_FFOUT), scr, wave * (G - nmod) + ((int)blockIdx.x - nmod), (G - nmod) * 8, lane); }
                   else ffn_weight_items(p.in[I_WFFN1IN], p.in[I_WFFN1OUT], (bf16_t*)(ws + W_FFIN), (bf16_t*)(ws + W_FFOUT), scr, gw, ngw, lane); } }
    __syncthreads(); }
    xcd_barrier(xbar);
    if (PROBE == 3) for (int i = 0; i < 16; ++i) xcd_barrier(xbar);
    REP(1) if (PH(1)) norm_mod_phase<false>(p, lds, p.in[I_X], p.in[I_GFFN1], 0, U, tid, wave, lane);
    xcd_barrier(xbar);
    REP(2) if (PH(2)) run_gemm(lds, U, D, (const bf16_t*)(ws + W_FFIN), 2 * FF, D, EpiSwiGLU{P, FF});
    { const int nfull = (64 * 22) % G, nidle = nfull ? G - nfull : G;
      const int ib = nfull ? (int)blockIdx.x - nfull : (int)blockIdx.x;
      if (PH(0) && ib >= 0) mixer_weight_items(p, scr, wave * nidle + ib, nidle * 8, lane); }
    xcd_barrier(xbar);
    const bool fusedn = (G == 256);
    unsigned* xslot = (unsigned*)(ws + WS_XSLOT); unsigned* xcnt = (unsigned*)(ws + WS_XCNT);
    if (fusedn) { if (PH(3)) run_gemm(lds, P, FF, (const bf16_t*)(ws + W_FFOUT), D, FF, EpiResidNorm{p.in[I_X], p.out, mod + 2 * D, p.in[I_GMIX], mod + 3 * D, U, xslot, xcnt, 0.5f, 0}); }
    else { REP(2) if (PH(3)) run_gemm(lds, P, FF, (const bf16_t*)(ws + W_FFOUT), D, FF, EpiResid{p.in[I_X], p.out, mod + 2 * D, 0.5f}); }
    xcd_barrier(xbar);
    if (!fusedn) { REP(1) if (PH(4)) norm_mod_phase<true>(p, lds, p.out, p.in[I_GMIX], 3, U, tid, wave, lane); xcd_barrier(xbar); }
    REP(2) if (PH(5)) run_gemm(lds, U, D, (const bf16_t*)(ws + W_IN), NIN, D, EpiBf16{P, NIN});
    { const int nfull = (64 * 22) % G, nidle = nfull ? G - nfull : G; const int ib = nfull ? (int)blockIdx.x - nfull : (int)blockIdx.x;
      if (PH(12) && ib >= 0) ffn_weight_items(p.in[I_WFFN2IN], p.in[I_WFFN2OUT], (bf16_t*)(ws + WS_F2IN), (bf16_t*)(ws + W_FFOUT), scr, wave * nidle + ib, nidle * 8, lane, 0, 2816); }
    xcd_barrier(xbar);
    if (PH(6)) prep_phase(p, lds, fusedn, tid, wave, lane);
    xcd_barrier(xbar);
    if (PH(7)) gdn_chunk_prep_phase(p, lds, tid, wave, lane);
    xcd_barrier(xbar);
    if (PH(15)) for (int it = blockIdx.x; it < 32; it += G) gdn_scan_block(p, lds, it, tid, wave, lane);
    if (PH(8)) {
        const unsigned x0 = xb_xcc_id() & 7u;
        for (unsigned dx = 0; dx < 8u; ++dx) { const unsigned x = (x0 + dx) & 7u; unsigned* ctr = (unsigned*)(ws + WS_CTR) + 64 * x;
            for (;;) { unsigned idx = 0; if (lane == 0) idx = atomicAdd(ctr, 1u); idx = __builtin_amdgcn_readfirstlane(idx);
                if (idx >= 512u) break;
                attn_item_mfma(P, (const bf16_t*)(ws + WS_VT), (int)(8u * x + (idx & 7u)), 63 - (int)(idx >> 3), lane); } } }
    xcd_barrier(xbar);
    if (PH(9)) gdn_finalize_phase(p, wave, lane);
    xcd_barrier(xbar);
    if (PH(10)) run_gemm(lds, P + C_QSB, NIN, (const bf16_t*)(ws + W_UPSB), D, 1024, EpiGateFused{P + C_RSB, P + C_RDN, U}, 8, (C_VDN - C_QSB) * 2 - 8 * 128);
    if (fusedn && PH(12)) ffn_weight_items(p.in[I_WFFN2IN], p.in[I_WFFN2OUT], (bf16_t*)(ws + WS_F2IN), (bf16_t*)(ws + W_FFOUT), scr, gw, ngw, lane, 2816, 2816 + 1408);
    xcd_barrier(xbar);
    if (fusedn) { if (PH(11)) run_gemm(lds, U, D, (const bf16_t*)(ws + W_OUT), D, D, EpiResidNorm{p.out, p.out, mod + 5 * D, p.in[I_GFFN2], mod + 6 * D, U, xslot + 64 * 256 * 4, xcnt + 64 * 64, 1.0f, 0}); }
    else { if (PH(11)) run_gemm(lds, U, D, (const bf16_t*)(ws + W_OUT), D, D, EpiResid{p.out, p.out, mod + 5 * D, 1.0f}); }
    xcd_barrier(xbar);
    if (!fusedn) { REP(1) if (PH(12)) norm_mod_phase<false>(p, lds, p.out, p.in[I_GFFN2], 6, U, tid, wave, lane);
        __syncthreads();
        if (PH(12)) ffn_weight_items(p.in[I_WFFN2IN], p.in[I_WFFN2OUT], (bf16_t*)(ws + WS_F2IN), (bf16_t*)(ws + W_FFOUT), scr, gw, ngw, lane, 2816, 2816 + 1408);
        xcd_barrier(xbar); }
    REP(2) if (PH(13)) run_gemm(lds, U, D, (const bf16_t*)(ws + WS_F2IN), 2 * FF, D, EpiSwiGLU{P, FF});
    xcd_barrier(xbar);
    if (PH(14)) run_gemm(lds, P, FF, (const bf16_t*)(ws + W_FFOUT), D, FF, EpiResid{p.out, p.out, mod + 8 * D, 0.5f});
}

extern "C" void kernel_launch(void* const* d_in, const int* in_sizes, int n_in, void* d_out, int out_size, void* d_ws, size_t ws_size, hipStream_t stream) {
    static int grid_blocks = 0;
    if (!grid_blocks) {
        int dev = 0, cus = 0, per_cu = 0;
        (void)hipGetDevice(&dev);
        (void)hipDeviceGetAttribute(&cus, hipDeviceAttributeMultiprocessorCount, dev);
        (void)hipFuncSetAttribute((const void*)fwd_megakernel, hipFuncAttributeMaxDynamicSharedMemorySize, LDS_BYTES);
        (void)hipOccupancyMaxActiveBlocksPerMultiprocessor(&per_cu, (const void*)fwd_megakernel, 512, LDS_BYTES);
        if (per_cu < 1) { fprintf(stderr, "occupancy query says %d blocks/CU\n", per_cu); per_cu = 1; }
        grid_blocks = cus;
    }
    Params p{};
    for (int i = 0; i < N_IN; ++i) p.in[i] = (const float*)d_in[i];
    p.out = (float*)d_out; p.ws = (unsigned char*)d_ws;
    static_assert(WS_BAR + XCD_BAR_WORDS * 4 <= WS_XCNT, "control words");
    (void)hipMemsetAsync((char*)d_ws + WS_CTR, 0, WS_ZEND - WS_CTR, stream);
    void* args[] = {&p};
    hipError_t e = hipLaunchCooperativeKernel((const void*)fwd_megakernel, dim3(grid_blocks), dim3(512), args, LDS_BYTES, stream);
    if (e != hipSuccess) fprintf(stderr, "cooperative launch failed: %s (grid %d)\n", hipGetErrorString(e), grid_blocks);
}
```

```cpp
#include <hip/hip_runtime.h>
#include <hip/hip_cooperative_groups.h>
#include <cstdio>
namespace cg = cooperative_groups;

#define LAS __attribute__((address_space(3)))
typedef unsigned short bf16_t;
typedef short bf16x8 __attribute__((ext_vector_type(8)));
typedef float f32x4 __attribute__((ext_vector_type(4)));
typedef unsigned u32x4 __attribute__((ext_vector_type(4)));
typedef unsigned u32x2 __attribute__((ext_vector_type(2)));
typedef float f32x16 __attribute__((ext_vector_type(16)));
typedef float f32x2 __attribute__((ext_vector_type(2)));
typedef __bf16 nbf16x2 __attribute__((ext_vector_type(2)));

constexpr int T = 16384, D = 1024, SEQ = 2048, NB = 8, FF = 2816, NIN = 5632, INW = 5640, NMOD = 9216;
constexpr int C_QSB = 0, C_KSB = 512, C_VSB = 1024, C_QDN = 1536, C_KDN = 2048, C_VDN = 2560, C_ZDN = 3072, C_RSB = 3584, C_RDN = 4608;
constexpr float EPS = 1e-6f;
constexpr int LDS_BYTES = 163840, BST_OFF = LDS_BYTES - 64;
constexpr size_t MiB = 1024 * 1024;
constexpr size_t WS_MOD = 0, WS_BG = 512 * 1024, WS_SS = 242 * MiB, WS_W = 2 * MiB;
constexpr size_t W_FFIN = WS_W, W_FFOUT = W_FFIN + (size_t)2 * FF * D * 2, W_IN = W_FFOUT + (size_t)D * FF * 2, W_UPSB = W_IN + (size_t)NIN * D * 2,
                 W_UPDN = W_UPSB + (size_t)D * 512 * 2, W_OUT = W_UPDN + (size_t)D * 512 * 2, W_END = W_OUT + (size_t)D * D * 2;
constexpr size_t WS_U = 34 * MiB, WS_P = 66 * MiB, WS_F2IN = 242 * MiB;
static_assert(W_END <= WS_U, "weights overflow");
constexpr size_t WS_EGL = 384 * 1024, WS_CTR = 400 * 1024, WS_BAR = 416 * 1024, WS_XCNT = 432 * 1024, WS_ZEND = 464 * 1024;
constexpr size_t WS_XSLOT = 1 * MiB;
constexpr size_t WS_VT = W_FFIN;
static_assert((size_t)T * 512 * 2 <= W_IN - W_FFIN, "Vt overflow");

enum { I_X = 0, I_C, I_WADA, I_BADA, I_GFFN1, I_WFFN1IN, I_WFFN1OUT, I_GMIX, I_WIN, I_GQSB, I_GKSB, I_WCONV, I_ALOG, I_DTBIAS, I_GDNOUT, I_WUPSB, I_WUPDN, I_WOUT, I_GFFN2, I_WFFN2IN, I_WFFN2OUT, N_IN };
struct Params { const float* in[N_IN]; float* out; unsigned char* ws; };

__device__ __forceinline__ float bf_lo(unsigned w) { return __uint_as_float(w << 16); }
__device__ __forceinline__ float bf_hi(unsigned w) { return __uint_as_float(w & 0xffff0000u); }
__device__ __forceinline__ float bf2f(bf16_t b) { return __uint_as_float(((unsigned)b) << 16); }
__device__ __forceinline__ unsigned pk2(float lo, float hi) { unsigned r; asm("v_cvt_pk_bf16_f32 %0, %1, %2" : "=v"(r) : "v"(lo), "v"(hi)); return r; }
__device__ __forceinline__ unsigned cpk2(float lo, float hi) { const f32x2 v = {lo, hi}; return __builtin_bit_cast(unsigned, __builtin_convertvector(v, nbf16x2)); }
__device__ __forceinline__ bf16_t f2bf(float f) { return (bf16_t)(pk2(f, 0.f) & 0xffffu); }
__device__ __forceinline__ float fexp(float x) { return __builtin_amdgcn_exp2f(x * 1.4426950408889634f); }
__device__ __forceinline__ float flog(float x) { return __builtin_amdgcn_logf(x) * 0.6931471805599453f; }
__device__ __forceinline__ float fsigmoid(float x) { return __builtin_amdgcn_rcpf(1.f + fexp(-x)); }
__device__ __forceinline__ float fsilu(float x) { return x * fsigmoid(x); }
__device__ __forceinline__ float fsoftplus(float x) { return fmaxf(x, 0.f) + flog(1.f + fexp(-fabsf(x))); }
__device__ __forceinline__ float wave_sum(float v) {
#pragma unroll
    for (int o = 1; o < 64; o <<= 1) v += __shfl_xor(v, o);
    return v;
}
#define LDS_WAIT() asm volatile("s_waitcnt lgkmcnt(0)" ::: "memory")
#define LDS_BARRIER() do { asm volatile("s_waitcnt lgkmcnt(0)" ::: "memory"); __builtin_amdgcn_s_barrier(); asm volatile("" ::: "memory"); } while (0)

namespace pg8 {
constexpr int BM = 256, BK = 64, HALF = 128, HTB = HALF * BK * 2, STAGE_BYTES = 8 * HTB, NXCD = 8, WGM = 2;
__host__ __device__ __forceinline__ int lds_byte(int r, int c) { const int st = (r >> 4) * 2 + (c >> 5), rr = r & 15, cc = c & 31, ob = rr * 64 + cc * 2; return st * 1024 + (ob ^ (((ob >> 9) & 1) << 5)); }
__host__ __device__ __forceinline__ void stage_rc(int b, int& R, int& C) { const int st = b / 1024, sb = b % 1024, swz = sb ^ (((sb >> 9) & 1) << 5); R = (st >> 1) * 16 + swz / 64; C = (st & 1) * 32 + (swz % 64) / 2; }
__host__ __device__ __forceinline__ int perm32(int rho) { const int n = rho >> 4, i = rho & 15; return 8 * (i >> 2) + 4 * n + (i & 3); }
struct Unit { int pm, pn; };
struct Gemm { const bf16_t* A; const bf16_t* Bt; int M, N, K, lda; int jt; int jbytes; };
struct StaticOrder {
    int nM, nN, nwg, G, c;
    __host__ __device__ void init(int M, int N, int G_, int c_) { nM = M / BM; nN = N / BM; nwg = nM * nN; G = G_; c = c_; }
    __host__ __device__ bool next(int i, Unit& u) const {
        const long L = (long)i * G + c; if (L >= nwg) return false;
        int wgid = (int)L; { const int q = nwg / NXCD, r = nwg % NXCD, xcd = wgid % NXCD, off = wgid / NXCD; wgid = (xcd < r ? xcd * (q + 1) : r * (q + 1) + (xcd - r) * q) + off; }
        const int nig = WGM * nN, gid = wgid / nig, fm = gid * WGM, gsz = (nM - fm) < WGM ? (nM - fm) : WGM;
        u.pm = fm + ((wgid % nig) % gsz); u.pn = (wgid % nig) / gsz; return true;
    }
};
template <class Epi>
__device__ __forceinline__ void gemm_phase(LAS unsigned char* lds, const Gemm g, const StaticOrder& S, const Epi E) {
    int tid = threadIdx.x; asm volatile("" : "+v"(tid));
    const int wid = __builtin_amdgcn_readfirstlane(tid >> 6), lane = tid & 63, wr = wid >> 2, wc = wid & 3, fr = lane & 15, fq = lane >> 4;
    const int K = g.K, nt = K / BK, lda = g.lda;
    unsigned voffA[2], voffB[2];
#pragma unroll
    for (int i = 0; i < 2; ++i) { int R, C; stage_rc(tid * 16 + i * 8192, R, C); const int Rb = Epi::PERM ? ((R & ~31) + perm32(R & 31)) : R;
        voffA[i] = (unsigned)(R * lda + C) * 2u; voffB[i] = (unsigned)(Rb * K + C) * 2u; }
    const size_t kstep = (size_t)(BK * 2);
    const size_t hstepA = (size_t)HALF * lda * 2, hstepB = (size_t)HALF * K * 2;
    const size_t tstepA = 2 * hstepA, tstepB = 2 * hstepB;
    const unsigned ldsw = (unsigned)wid * 1024u;
    const int aoff = lds_byte(wr * 64 + fr, fq * 8), boff = lds_byte(wc * 32 + fr, fq * 8);
#define PG8_SA(b, h) (((b) * 2 + (h)) * HTB)
#define PG8_SB(b, h) ((4 + (b) * 2 + (h)) * HTB)
#define PG8_STAGE(bufoff, gbase, voff) do { _Pragma("unroll") for (int _i = 0; _i < 2; ++_i) \
        __builtin_amdgcn_global_load_lds((const unsigned*)((const char*)(gbase) + (voff)[_i]), (LAS unsigned*)(lds + (bufoff) + ldsw + _i * 8192), 16, 0, 0); } while (0)
#define PG8_LDA(dst, b, h) do { _Pragma("unroll") for (int m = 0; m < 4; ++m) _Pragma("unroll") for (int k = 0; k < 2; ++k) dst[m][k] = *(const LAS bf16x8*)(lds + PG8_SA(b, h) + aoff + m * 2048 + k * 1024); } while (0)
#define PG8_LDB(dst, b, h) do { _Pragma("unroll") for (int n = 0; n < 2; ++n) _Pragma("unroll") for (int k = 0; k < 2; ++k) dst[n][k] = *(const LAS bf16x8*)(lds + PG8_SB(b, h) + boff + n * 2048 + k * 1024); } while (0)
#define PG8_MMA(ai, bj, At, Bt) do { __builtin_amdgcn_s_setprio(1); _Pragma("unroll") for (int m = 0; m < 4; ++m) _Pragma("unroll") for (int n = 0; n < 2; ++n) _Pragma("unroll") for (int k = 0; k < 2; ++k) \
        acc[ai][bj][m][n] = __builtin_amdgcn_mfma_f32_16x16x32_bf16(Bt[n][k], At[m][k], acc[ai][bj][m][n], 0, 0, 0); __builtin_amdgcn_s_setprio(0); } while (0)
#define PG8_WAIT_V(n) asm volatile("s_waitcnt vmcnt(" #n ")" ::: "memory")
#define PG8_WAIT_L(n) asm volatile("s_waitcnt lgkmcnt(" #n ")" ::: "memory")
#define PG8_BAR __builtin_amdgcn_s_barrier()
#define PG8_SCHED __builtin_amdgcn_sched_barrier(0)
    Unit cur, nxt; int ui = 0;
    if (!S.next(0, cur)) return;
    f32x4 acc[2][2][4][2];
#pragma unroll
    for (int a = 0; a < 2; ++a)
#pragma unroll
        for (int b = 0; b < 2; ++b)
#pragma unroll
            for (int m = 0; m < 4; ++m)
#pragma unroll
                for (int n = 0; n < 2; ++n) acc[a][b][m][n] = (f32x4){0.f, 0.f, 0.f, 0.f};
    bf16x8 At[4][2], B0[2][2], B1[2][2];
    const char* cA = (const char*)g.A + (size_t)cur.pm * tstepA; const char* cB = (const char*)g.Bt + (size_t)cur.pn * tstepB;
    PG8_STAGE(PG8_SB(0, 0), cB, voffB); PG8_STAGE(PG8_SA(0, 0), cA, voffA); PG8_STAGE(PG8_SB(0, 1), cB + hstepB, voffB); PG8_STAGE(PG8_SA(0, 1), cA + hstepA, voffA);
    if (wr == 1) PG8_BAR;
    PG8_WAIT_V(4); PG8_BAR;
    PG8_STAGE(PG8_SB(1, 0), cB + kstep, voffB); PG8_STAGE(PG8_SA(1, 0), cA + kstep, voffA); PG8_STAGE(PG8_SB(1, 1), cB + hstepB + kstep, voffB);
    PG8_WAIT_V(6); PG8_BAR;
    for (;;) {
        const bool has_next = S.next(ui + 1, nxt);
        const char* nA = has_next ? (const char*)g.A + (size_t)nxt.pm * tstepA : cA; const char* nB = has_next ? (const char*)g.Bt + (size_t)nxt.pn * tstepB : cB;
        for (int t = 0; t < nt; t += 2) {
            const bool last = (t == nt - 2);
            const char* a1 = cA + (size_t)(t + 1) * kstep + (t + 1 >= g.jt ? g.jbytes : 0);
            const char* a2 = last ? nA : cA + (size_t)(t + 2) * kstep + (t + 2 >= g.jt ? g.jbytes : 0); const char* b2 = last ? nB : cB + (size_t)(t + 2) * kstep;
            const char* a3 = a2 + kstep; const char* b3 = b2 + kstep;
            if constexpr (Epi::HAS_MID) { if (t == g.jt) E.mid(acc, cur, wr, wc, fr, fq); }
            PG8_LDB(B0, 0, 0); PG8_SCHED; PG8_LDA(At, 0, 0); PG8_STAGE(PG8_SA(1, 1), a1 + hstepA, voffA);
            PG8_WAIT_L(8); PG8_BAR; PG8_WAIT_L(0); PG8_MMA(0, 0, At, B0); PG8_BAR; PG8_SCHED;
            PG8_LDB(B1, 0, 1); PG8_STAGE(PG8_SB(0, 0), b2, voffB);
            PG8_BAR; PG8_WAIT_L(0); PG8_MMA(0, 1, At, B1); PG8_BAR;
            PG8_LDA(At, 0, 1); PG8_STAGE(PG8_SA(0, 0), a2, voffA);
            PG8_BAR; PG8_WAIT_L(0); PG8_MMA(1, 0, At, B0); PG8_BAR; PG8_SCHED;
            PG8_STAGE(PG8_SB(0, 1), b2 + hstepB, voffB);
            PG8_WAIT_V(6); PG8_BAR; PG8_MMA(1, 1, At, B1); PG8_BAR;
            PG8_LDB(B0, 1, 0); PG8_SCHED; PG8_LDA(At, 1, 0); PG8_STAGE(PG8_SA(0, 1), a2 + hstepA, voffA);
            PG8_WAIT_L(8); PG8_BAR; PG8_WAIT_L(0); PG8_MMA(0, 0, At, B0); PG8_BAR; PG8_SCHED;
            PG8_LDB(B1, 1, 1); PG8_STAGE(PG8_SB(1, 0), b3, voffB);
            PG8_BAR; PG8_WAIT_L(0); PG8_MMA(0, 1, At, B1); PG8_BAR;
            PG8_LDA(At, 1, 1); PG8_STAGE(PG8_SA(1, 0), a3, voffA);
            PG8_BAR; PG8_WAIT_L(0); PG8_MMA(1, 0, At, B0); PG8_BAR; PG8_SCHED;
            PG8_STAGE(PG8_SB(1, 1), b3 + hstepB, voffB);
            PG8_WAIT_V(6); PG8_BAR; PG8_MMA(1, 1, At, B1); PG8_BAR;
        }
        if constexpr (!Epi::AFTER) E(acc, cur, wr, wc, fr, fq);
        if (!has_next) break;
#pragma unroll
        for (int a = 0; a < 2; ++a)
#pragma unroll
            for (int b = 0; b < 2; ++b)
#pragma unroll
                for (int m = 0; m < 4; ++m)
#pragma unroll
                    for (int n = 0; n < 2; ++n) acc[a][b][m][n] = (f32x4){0.f, 0.f, 0.f, 0.f};
        cur = nxt; cA = nA; cB = nB; ++ui;
    }
    PG8_WAIT_V(0);
    if (wr == 0) PG8_BAR;
    PG8_BAR;
    if constexpr (Epi::AFTER) E.fused(acc, cur, wr, wc, fr, fq, lds, wid, lane);
#undef PG8_SA
#undef PG8_SB
#undef PG8_STAGE
#undef PG8_LDA
#undef PG8_LDB
#undef PG8_MMA
#undef PG8_WAIT_V
#undef PG8_WAIT_L
#undef PG8_BAR
#undef PG8_SCHED
}
}

typedef const f32x4 (&AccRef)[2][2][4][2];
struct EpiBf16 {
    static constexpr bool PERM = true, HAS_MID = false, AFTER = false;
    bf16_t* O; int ldc;
    __device__ __forceinline__ void operator()(AccRef acc, const pg8::Unit& u, int wr, int wc, int fr, int fq) const {
        const int row0 = u.pm * 256 + wr * 64 + fr, col0 = u.pn * 256 + wc * 32 + 8 * fq;
#pragma unroll
        for (int ai = 0; ai < 2; ++ai)
#pragma unroll
            for (int m = 0; m < 4; ++m) { bf16_t* rowp = O + (size_t)(row0 + ai * 128 + m * 16) * ldc + col0;
#pragma unroll
                for (int bj = 0; bj < 2; ++bj) { const f32x4 v0 = acc[ai][bj][m][0], v1 = acc[ai][bj][m][1];
                    u32x4 w; w.x = pk2(v0[0], v0[1]); w.y = pk2(v0[2], v0[3]); w.z = pk2(v1[0], v1[1]); w.w = pk2(v1[2], v1[3]);
                    *(u32x4*)(rowp + bj * 128) = w; } }
    }
};
struct EpiSwiGLU {
    static constexpr bool PERM = true, HAS_MID = false, AFTER = false;
    bf16_t* O; int ldc;
    __device__ __forceinline__ void operator()(AccRef acc, const pg8::Unit& u, int wr, int wc, int fr, int fq) const {
        const int row0 = u.pm * 256 + wr * 64 + fr, col0 = u.pn * 128 + wc * 32 + 8 * fq;
#pragma unroll
        for (int ai = 0; ai < 2; ++ai)
#pragma unroll
            for (int m = 0; m < 4; ++m) { bf16_t* rowp = O + (size_t)(row0 + ai * 128 + m * 16) * ldc + col0;
                float r[8];
#pragma unroll
                for (int n = 0; n < 2; ++n)
#pragma unroll
                    for (int j = 0; j < 4; ++j) { const float a = acc[ai][0][m][n][j], b = acc[ai][1][m][n][j]; r[n * 4 + j] = fsilu(a) * b; }
                u32x4 w; w.x = pk2(r[0], r[1]); w.y = pk2(r[2], r[3]); w.z = pk2(r[4], r[5]); w.w = pk2(r[6], r[7]);
                *(u32x4*)rowp = w; }
    }
};
struct EpiResid {
    static constexpr bool PERM = false, HAS_MID = false, AFTER = false;
    const float* base; float* out; const float* gate; float scale;
    __device__ __forceinline__ void operator()(AccRef acc, const pg8::Unit& u, int wr, int wc, int fr, int fq) const {
        const int row0 = u.pm * 256 + wr * 64 + fr, col0 = u.pn * 256 + wc * 32 + 4 * fq;
        const float* gp = gate + (size_t)(u.pm >> 3) * NMOD + col0;
        f32x4 gv[2][2];
#pragma unroll
        for (int bj = 0; bj < 2; ++bj)
#pragma unroll
            for (int n = 0; n < 2; ++n) gv[bj][n] = *(const f32x4*)(gp + bj * 128 + n * 16) * scale;
#pragma unroll
        for (int ai = 0; ai < 2; ++ai) {
            f32x4 bs[4][2][2];
#pragma unroll
            for (int m = 0; m < 4; ++m) { const size_t off = (size_t)(row0 + ai * 128 + m * 16) * D + col0;
#pragma unroll
                for (int bj = 0; bj < 2; ++bj)
#pragma unroll
                    for (int n = 0; n < 2; ++n) bs[m][bj][n] = *(const f32x4*)(base + off + bj * 128 + n * 16); }
#pragma unroll
            for (int m = 0; m < 4; ++m) { const size_t off = (size_t)(row0 + ai * 128 + m * 16) * D + col0;
#pragma unroll
                for (int bj = 0; bj < 2; ++bj)
#pragma unroll
                    for (int n = 0; n < 2; ++n) *(f32x4*)(out + off + bj * 128 + n * 16) = bs[m][bj][n] + gv[bj][n] * acc[ai][bj][m][n]; }
            asm volatile("" ::: "memory"); }
    }
};
struct EpiResidNorm {
    static constexpr bool PERM = false, HAS_MID = false, AFTER = true;
    const float* base; float* out; const float* gate;
    const float* gain; const float* modsh; bf16_t* un;
    unsigned* xslot; unsigned* cnt; float scale; int pad_;
    __device__ __forceinline__ void fused(f32x4 (&acc)[2][2][4][2], const pg8::Unit& u, int wr, int wc, int fr, int fq, LAS unsigned char* lds, int wid, int lane) const {
        const int row0 = u.pm * 256 + wr * 64 + fr, col0 = u.pn * 256 + wc * 32 + 4 * fq, tid = wid * 64 + lane;
        LAS float* Pt = (LAS float*)lds; LAS float* St = (LAS float*)(lds + 4096);
        const float* gp = gate + (size_t)(u.pm >> 3) * NMOD + col0;
        f32x4 gv[2][2];
#pragma unroll
        for (int bj = 0; bj < 2; ++bj)
#pragma unroll
            for (int n = 0; n < 2; ++n) gv[bj][n] = *(const f32x4*)(gp + bj * 128 + n * 16) * scale;
#pragma unroll
        for (int ai = 0; ai < 2; ++ai) {
            f32x4 bs[4][2][2];
#pragma unroll
            for (int m = 0; m < 4; ++m) { const size_t off = (size_t)(row0 + ai * 128 + m * 16) * D + col0;
#pragma unroll
                for (int bj = 0; bj < 2; ++bj)
#pragma unroll
                    for (int n = 0; n < 2; ++n) bs[m][bj][n] = *(const f32x4*)(base + off + bj * 128 + n * 16); }
#pragma unroll
            for (int m = 0; m < 4; ++m) { const size_t off = (size_t)(row0 + ai * 128 + m * 16) * D + col0; float sq = 0.f;
#pragma unroll
                for (int bj = 0; bj < 2; ++bj)
#pragma unroll
                    for (int n = 0; n < 2; ++n) { const f32x4 hv = bs[m][bj][n] + gv[bj][n] * acc[ai][bj][m][n]; acc[ai][bj][m][n] = hv; *(f32x4*)(out + off + bj * 128 + n * 16) = hv;
                        sq += (hv[0] * hv[0] + hv[1] * hv[1]) + (hv[2] * hv[2] + hv[3] * hv[3]); }
                sq += __shfl_xor(sq, 16); sq += __shfl_xor(sq, 32);
                if (fq == 0) Pt[(ai * 128 + wr * 64 + m * 16 + fr) * 4 + wc] = sq; }
            asm volatile("" ::: "memory"); }
        LDS_WAIT(); __syncthreads();
        if (tid < 256) { const f32x4 t4 = *(const LAS f32x4*)(Pt + tid * 4); const float sq = (t4[0] + t4[1]) + (t4[2] + t4[3]);
            __hip_atomic_store(xslot + ((size_t)(u.pm * 256 + tid) * 4 + u.pn), __float_as_uint(sq), __ATOMIC_RELAXED, __HIP_MEMORY_SCOPE_AGENT);
            asm volatile("s_waitcnt vmcnt(0)" ::: "memory");
            if (lane == 0) __hip_atomic_fetch_add(cnt + 64 * u.pm, 1u, __ATOMIC_RELAXED, __HIP_MEMORY_SCOPE_AGENT); }
        if (wid == 0) { unsigned spins = 0;
            while ((unsigned)__builtin_amdgcn_readfirstlane(__hip_atomic_load(cnt + 64 * u.pm, __ATOMIC_RELAXED, __HIP_MEMORY_SCOPE_AGENT)) < 16u) { __builtin_amdgcn_s_sleep(2); if (++spins > (1u << 22)) break; }
            __builtin_amdgcn_fence(__ATOMIC_ACQUIRE, "agent"); asm volatile("s_waitcnt vmcnt(0)" ::: "memory"); }
        __syncthreads();
        if (tid < 256) { const unsigned* sl = xslot + (size_t)(u.pm * 256 + tid) * 4; float sq = 0.f;
#pragma unroll
            for (int t = 0; t < 4; ++t) sq += __uint_as_float(__hip_atomic_load(sl + t, __ATOMIC_RELAXED, __HIP_MEMORY_SCOPE_AGENT));
            St[tid] = 1.0f / sqrtf(sq * (1.f / D) + EPS); }
        LDS_WAIT(); __syncthreads();
        const float* shp = modsh + (size_t)(u.pm >> 3) * NMOD + col0;
        f32x4 gs[2][2], sh[2][2];
#pragma unroll
        for (int bj = 0; bj < 2; ++bj)
#pragma unroll
            for (int n = 0; n < 2; ++n) { gs[bj][n] = *(const f32x4*)(gain + col0 + bj * 128 + n * 16) * (*(const f32x4*)(shp + D + bj * 128 + n * 16) + 1.0f); sh[bj][n] = *(const f32x4*)(shp + bj * 128 + n * 16); }
#pragma unroll
        for (int ai = 0; ai < 2; ++ai)
#pragma unroll
            for (int m = 0; m < 4; ++m) { const int r = ai * 128 + wr * 64 + m * 16 + fr; const float rstd = St[r]; bf16_t* up = un + (size_t)(u.pm * 256 + r) * D + col0;
#pragma unroll
                for (int bj = 0; bj < 2; ++bj)
#pragma unroll
                    for (int n = 0; n < 2; ++n) { const f32x4 uu = acc[ai][bj][m][n] * rstd * gs[bj][n] + sh[bj][n];
                        *(u32x2*)(up + bj * 128 + n * 16) = (u32x2){pk2(uu[0], uu[1]), pk2(uu[2], uu[3])}; } }
        __syncthreads();
    }
};
struct EpiGateFused {
    static constexpr bool PERM = true, HAS_MID = true, AFTER = false;
    const bf16_t* Rsb; const bf16_t* Rdn; bf16_t* O;
    __device__ __forceinline__ void mid(f32x4 (&acc)[2][2][4][2], const pg8::Unit& u, int wr, int wc, int fr, int fq) const {
        int row0 = u.pm * 256 + wr * 64 + fr, col0 = u.pn * 256 + wc * 32 + 8 * fq;
        asm volatile("" : "+v"(row0), "+v"(col0));
#pragma unroll
        for (int ai = 0; ai < 2; ++ai)
#pragma unroll
            for (int mp = 0; mp < 2; ++mp) {
                u32x4 av[2][2], dv[2][2];
#pragma unroll
                for (int mm = 0; mm < 2; ++mm)
#pragma unroll
                    for (int bj = 0; bj < 2; ++bj) { const size_t row = (size_t)(row0 + ai * 128 + (2 * mp + mm) * 16);
                        av[mm][bj] = *(const u32x4*)(Rsb + row * NIN + col0 + bj * 128); dv[mm][bj] = *(const u32x4*)(Rdn + row * NIN + col0 + bj * 128); }
#pragma unroll
                for (int mm = 0; mm < 2; ++mm)
#pragma unroll
                    for (int bj = 0; bj < 2; ++bj) { const int m = 2 * mp + mm; const u32x4 a = av[mm][bj], d = dv[mm][bj];
                        const float ra[8] = {bf_lo(a.x), bf_hi(a.x), bf_lo(a.y), bf_hi(a.y), bf_lo(a.z), bf_hi(a.z), bf_lo(a.w), bf_hi(a.w)};
                        const float rd[8] = {bf_lo(d.x), bf_hi(d.x), bf_lo(d.y), bf_hi(d.y), bf_lo(d.z), bf_hi(d.z), bf_lo(d.w), bf_hi(d.w)};
#pragma unroll
                        for (int e = 0; e < 8; ++e) { const float q = (1.0f + fexp(fminf(-rd[e], 30.0f))) * __builtin_amdgcn_rcpf(1.0f + fexp(-ra[e])); acc[ai][bj][m][e >> 2][e & 3] *= q; } }
                asm volatile("" ::: "memory"); }
    }
    __device__ __forceinline__ void operator()(AccRef acc, const pg8::Unit& u, int wr, int wc, int fr, int fq) const {
        const int row0 = u.pm * 256 + wr * 64 + fr, col0 = u.pn * 256 + wc * 32 + 8 * fq;
#pragma unroll
        for (int ai = 0; ai < 2; ++ai) {
            u32x4 dv[4][2];
#pragma unroll
            for (int m = 0; m < 4; ++m)
#pragma unroll
                for (int bj = 0; bj < 2; ++bj) dv[m][bj] = *(const u32x4*)(Rdn + (size_t)(row0 + ai * 128 + m * 16) * NIN + col0 + bj * 128);
#pragma unroll
            for (int m = 0; m < 4; ++m) { const size_t row = (size_t)(row0 + ai * 128 + m * 16);
#pragma unroll
                for (int bj = 0; bj < 2; ++bj) { const u32x4 d = dv[m][bj];
                    const f32x4 v0 = acc[ai][bj][m][0], v1 = acc[ai][bj][m][1];
#define SGC(x) __builtin_amdgcn_rcpf(1.0f + fexp(fminf(-(x), 30.0f)))
                    const float r[8] = {SGC(bf_lo(d.x)) * v0[0], SGC(bf_hi(d.x)) * v0[1], SGC(bf_lo(d.y)) * v0[2], SGC(bf_hi(d.y)) * v0[3],
                                        SGC(bf_lo(d.z)) * v1[0], SGC(bf_hi(d.z)) * v1[1], SGC(bf_lo(d.w)) * v1[2], SGC(bf_hi(d.w)) * v1[3]};
#undef SGC
                    u32x4 w; w.x = pk2(r[0], r[1]); w.y = pk2(r[2], r[3]); w.z = pk2(r[4], r[5]); w.w = pk2(r[6], r[7]);
                    *(u32x4*)(O + row * D + col0 + bj * 128) = w; } } }
    }
};
template <class Epi> __device__ __forceinline__ void run_gemm(LAS unsigned char* lds, const bf16_t* A, int lda, const bf16_t* Bt, int N, int K, const Epi E, int jt = 1 << 30, int jbytes = 0) {
    pg8::Gemm g{A, Bt, T, N, K, lda, jt, jbytes}; pg8::StaticOrder S; S.init(T, N, (int)gridDim.x, (int)blockIdx.x);
    pg8::gemm_phase<Epi>(lds, g, S, E);
}

__device__ __forceinline__ void transpose_item(const float* W, int ldw, int s0, int k0, bf16_t* WT, int ldk, int d0, LAS float* scr, int lane) {
    float tv[32];
#pragma unroll
    for (int i = 0; i < 32; ++i) tv[i] = W[(size_t)(k0 + 2 * i + (lane >> 5)) * ldw + s0 + (lane & 31)];
#pragma unroll
    for (int i = 0; i < 32; ++i) scr[(2 * i + (lane >> 5)) * 33 + (lane & 31)] = tv[i];
    LDS_WAIT();
    const int c = lane & 7;
#pragma unroll
    for (int j = 0; j < 4; ++j) { const int n = (lane >> 3) + 8 * j; const LAS float* s = scr + (8 * c) * 33 + n;
        u32x4 o; o.x = pk2(s[0 * 33], s[1 * 33]); o.y = pk2(s[2 * 33], s[3 * 33]); o.z = pk2(s[4 * 33], s[5 * 33]); o.w = pk2(s[6 * 33], s[7 * 33]);
        *(u32x4*)(WT + (size_t)(d0 + n) * ldk + k0 + 8 * c) = o; }
    LDS_WAIT();
}
struct TrD { const float* W; int ldw, s0, k0; bf16_t* WT; int ldk, d0; };
__device__ __forceinline__ TrD ffn_item_desc(const float* w_in, const float* w_out, bf16_t* wt_in, bf16_t* wt_out, int it) {
    if (it < 2816) { const int kb = it / 176, nb = it % 176, d0 = nb * 32, pn = d0 >> 8, bj = (d0 >> 7) & 1, c = d0 & 127, s0 = bj * FF + pn * 128 + c; return TrD{w_in, 2 * FF, s0, kb * 64, wt_in, D, d0}; }
    const int r = it - 2816, kb = r / 32, nb = r % 32; return TrD{w_out, D, nb * 32, kb * 64, wt_out, FF, nb * 32};
}
__device__ __forceinline__ void ffn_weight_items(const float* w_in, const float* w_out, bf16_t* wt_in, bf16_t* wt_out, LAS float* scr, int gw, int ngw, int lane, int lo = 0, int NIT = 2816 + 1408) {
    gw += lo;
    float tv[32];
#define TR_LOAD(d_) do { _Pragma("unroll") for (int i = 0; i < 32; ++i) tv[i] = (d_).W[(size_t)((d_).k0 + 2 * i + (lane >> 5)) * (d_).ldw + (d_).s0 + (lane & 31)]; } while (0)
    if (gw < NIT) { const TrD d0_ = ffn_item_desc(w_in, w_out, wt_in, wt_out, gw); TR_LOAD(d0_); }
    for (int it = gw; it < NIT; it += ngw) {
        const TrD d = ffn_item_desc(w_in, w_out, wt_in, wt_out, it);
#pragma unroll
        for (int i = 0; i < 32; ++i) scr[(2 * i + (lane >> 5)) * 33 + (lane & 31)] = tv[i];
        LDS_WAIT();
        if (it + ngw < NIT) { const TrD dn = ffn_item_desc(w_in, w_out, wt_in, wt_out, it + ngw); TR_LOAD(dn); }
        const int c = lane & 7;
#pragma unroll
        for (int j = 0; j < 4; ++j) { const int n = (lane >> 3) + 8 * j; const LAS float* s_ = scr + (8 * c) * 33 + n;
            u32x4 o; o.x = pk2(s_[0 * 33], s_[1 * 33]); o.y = pk2(s_[2 * 33], s_[3 * 33]); o.z = pk2(s_[4 * 33], s_[5 * 33]); o.w = pk2(s_[6 * 33], s_[7 * 33]);
            *(u32x4*)(d.WT + (size_t)(d.d0 + n) * d.ldk + d.k0 + 8 * c) = o; }
        LDS_WAIT();
    }
#undef TR_LOAD
}
__device__ __forceinline__ void mixer_weight_items(const Params& p, LAS float* scr, int gw, int ngw, int lane) {
    unsigned char* ws = p.ws;
    for (int it = gw; it < 2816 + 256 + 256 + 512; it += ngw) {
        int r = it;
        if (r < 2816) { const int kb = r / 176, nb = r % 176, d0 = nb * 32, s0 = d0 < C_RSB ? d0 : d0 + 8; transpose_item(p.in[I_WIN], INW, s0, kb * 64, (bf16_t*)(ws + W_IN), D, d0, scr, lane); continue; } r -= 2816;
        if (r < 256) { const int kb = r / 32, nb = r % 32; transpose_item(p.in[I_WUPSB], D, nb * 32, kb * 64, (bf16_t*)(ws + W_UPSB), D, nb * 32, scr, lane); continue; } r -= 256;
        if (r < 256) { const int kb = r / 32, nb = r % 32; transpose_item(p.in[I_WUPDN], D, nb * 32, kb * 64, (bf16_t*)(ws + W_UPSB) + 512, D, nb * 32, scr, lane); continue; } r -= 256;
        { const int kb = r / 32, nb = r % 32; transpose_item(p.in[I_WOUT], D, nb * 32, kb * 64, (bf16_t*)(ws + W_OUT), D, nb * 32, scr, lane); }
    }
}
__device__ __forceinline__ void mod_item(const Params& p, LAS unsigned char* lds, int cb, int tid, int wave, int lane) {
    asm volatile("" : "+v"(tid), "+v"(lane));
    LAS float* sc = (LAS float*)lds; LAS float* red = (LAS float*)(lds + 32768);
    for (int i = tid; i < NB * D; i += 512) sc[i] = fsilu(p.in[I_C][i]);
    __syncthreads();
    const float* wa = p.in[I_WADA] + cb * 64 + lane;
    float acc[NB];
#pragma unroll
    for (int b = 0; b < NB; ++b) acc[b] = 0.f;
    for (int k = wave * 128; k < wave * 128 + 128; k += 32) {
        float w[32];
#pragma unroll
        for (int e = 0; e < 32; ++e) w[e] = wa[(size_t)(k + e) * NMOD];
#pragma unroll
        for (int b = 0; b < NB; ++b)
#pragma unroll
            for (int e4 = 0; e4 < 8; ++e4) { const f32x4 s = *(const LAS f32x4*)(sc + b * D + k + 4 * e4); acc[b] += s[0] * w[4 * e4] + s[1] * w[4 * e4 + 1] + s[2] * w[4 * e4 + 2] + s[3] * w[4 * e4 + 3]; }
    }
#pragma unroll
    for (int b = 0; b < NB; ++b) red[(wave * NB + b) * 64 + lane] = acc[b];
    __syncthreads();
    { const int b = tid >> 6; float s = p.in[I_BADA][cb * 64 + lane];
#pragma unroll
        for (int w = 0; w < 8; ++w) s += red[(w * NB + b) * 64 + lane];
        ((float*)(p.ws + WS_MOD))[b * NMOD + cb * 64 + lane] = s; }
    __syncthreads();
}

template <bool DN>
__device__ __forceinline__ void norm_mod_phase(const Params& p, LAS unsigned char* lds, const float* src, const float* gain, int midx, bf16_t* dst, int tid, int wave, int lane) {
    asm volatile("" : "+v"(tid), "+v"(lane));
    const float* mod = (const float*)(p.ws + WS_MOD);
    LAS float* wl = (LAS float*)lds;
    if (DN) { for (int i = tid; i < D * 8; i += 512) { const int k = i >> 3, j = i & 7; wl[8 * k + 4 * (k >> 2) + j] = p.in[I_WIN][(size_t)k * INW + C_RSB + j]; } __syncthreads(); }
    f32x4 g4[4];
#pragma unroll
    for (int j = 0; j < 4; ++j) g4[j] = ((const f32x4*)gain)[lane + 64 * j];
    const int rstep = gridDim.x * 8;
    f32x4 nv[4];
    { const int r0 = blockIdx.x * 8 + wave; const f32x4* xr = (const f32x4*)(src + (size_t)(r0 < T ? r0 : 0) * D) + lane;
#pragma unroll
      for (int j = 0; j < 4; ++j) nv[j] = xr[64 * j]; }
    for (int row = blockIdx.x * 8 + wave; row < T; row += rstep) {
        const int b = row >> 11;
        const f32x4* shp = (const f32x4*)(mod + (size_t)b * NMOD + midx * D) + lane; const f32x4* scp = shp + D / 4;
        f32x4 v[4], shv[4], scv[4]; float ss = 0.f;
#pragma unroll
        for (int j = 0; j < 4; ++j) { v[j] = nv[j]; shv[j] = shp[64 * j]; scv[j] = scp[64 * j]; }
        { const int rn = row + rstep < T ? row + rstep : row; const f32x4* xr = (const f32x4*)(src + (size_t)rn * D) + lane;
#pragma unroll
          for (int j = 0; j < 4; ++j) nv[j] = xr[64 * j]; }
#pragma unroll
        for (int j = 0; j < 4; ++j) ss += (v[j][0] * v[j][0] + v[j][1] * v[j][1]) + (v[j][2] * v[j][2] + v[j][3] * v[j][3]);
        const float rstd = 1.0f / sqrtf(wave_sum(ss) * (1.f / D) + EPS);
        u32x2* o8 = (u32x2*)(dst + (size_t)row * D) + lane;
        float dot[8];
        if (DN) {
#pragma unroll
            for (int e = 0; e < 8; ++e) dot[e] = 0.f; }
#pragma unroll
        for (int j = 0; j < 4; ++j) { const f32x4 sh = shv[j], sc = scv[j];
            const f32x4 uu = v[j] * rstd * g4[j] * (sc + 1.0f) + sh;
            u32x2 w; w.x = pk2(uu[0], uu[1]); w.y = pk2(uu[2], uu[3]); o8[64 * j] = w;
            if (DN) {
#pragma unroll
                for (int e = 0; e < 4; ++e) { const int k = 4 * lane + 256 * j + e; const LAS f32x4* wp = (const LAS f32x4*)(wl + 8 * k + 4 * (k >> 2)); const f32x4 w0 = wp[0], w1 = wp[1];
                    dot[0] += uu[e] * w0[0]; dot[1] += uu[e] * w0[1]; dot[2] += uu[e] * w0[2]; dot[3] += uu[e] * w0[3];
                    dot[4] += uu[e] * w1[0]; dot[5] += uu[e] * w1[1]; dot[6] += uu[e] * w1[2]; dot[7] += uu[e] * w1[3]; } } }
        if (DN) {
#pragma unroll
            for (int e = 0; e < 8; ++e) dot[e] = wave_sum(dot[e]);
            float mine = dot[0];
#pragma unroll
            for (int e = 1; e < 8; ++e) mine = (lane == e) ? dot[e] : mine;
            if (lane < 8) { float r;
                if (lane < 4) r = 1.0f / (1.0f + expf(-mine));
                else { const int hh = lane - 4; const float a = mine + p.in[I_DTBIAS][hh]; const float sp = a > 20.f ? a : log1pf(expf(a)); r = -expf(p.in[I_ALOG][hh]) * sp; }
                ((float*)(p.ws + WS_BG))[(size_t)row * 8 + lane] = r; } }
    }
    if (DN) __syncthreads();
}

__device__ __forceinline__ void dn_gate_phase(const Params& p, LAS unsigned char* lds, const bf16_t* u2, int tid, int wave, int lane) {
    asm volatile("" : "+v"(tid), "+v"(lane));
    LAS float* wl = (LAS float*)lds;
    for (int i = tid; i < D * 8; i += 512) { const int k = i >> 3, j = i & 7; wl[8 * k + 4 * (k >> 2) + j] = p.in[I_WIN][(size_t)k * INW + C_RSB + j]; }
    __syncthreads();
    const int rstep = gridDim.x * 8;
    u32x4 na, nb;
    { const int r0 = blockIdx.x * 8 + wave; const bf16_t* up = u2 + (size_t)(r0 < T ? r0 : 0) * D + 16 * lane; na = ((const u32x4*)up)[0]; nb = ((const u32x4*)up)[1]; }
    for (int row = blockIdx.x * 8 + wave; row < T; row += rstep) {
        const u32x4 ca = na, cb = nb;
        { const int rn = row + rstep < T ? row + rstep : row; const bf16_t* up = u2 + (size_t)rn * D + 16 * lane; na = ((const u32x4*)up)[0]; nb = ((const u32x4*)up)[1]; }
        const unsigned w8[8] = {ca.x, ca.y, ca.z, ca.w, cb.x, cb.y, cb.z, cb.w};
        float dot[8];
#pragma unroll
        for (int e = 0; e < 8; ++e) dot[e] = 0.f;
#pragma unroll
        for (int e = 0; e < 16; ++e) { const int k = 16 * lane + e; const LAS f32x4* wp = (const LAS f32x4*)(wl + 8 * k + 4 * (k >> 2)); const f32x4 w0 = wp[0], w1 = wp[1];
            const float uv = (e & 1) ? bf_hi(w8[e >> 1]) : bf_lo(w8[e >> 1]);
            dot[0] += uv * w0[0]; dot[1] += uv * w0[1]; dot[2] += uv * w0[2]; dot[3] += uv * w0[3]; dot[4] += uv * w1[0]; dot[5] += uv * w1[1]; dot[6] += uv * w1[2]; dot[7] += uv * w1[3]; }
#pragma unroll
        for (int e = 0; e < 8; ++e) dot[e] = wave_sum(dot[e]);
        float mine = dot[0];
#pragma unroll
        for (int e = 1; e < 8; ++e) mine = (lane == e) ? dot[e] : mine;
        if (lane < 8) { float r;
            if (lane < 4) r = 1.0f / (1.0f + expf(-mine));
            else { const int hh = lane - 4; const float a = mine + p.in[I_DTBIAS][hh]; const float sp = a > 20.f ? a : log1pf(expf(a)); r = -expf(p.in[I_ALOG][hh]) * sp; }
            ((float*)(p.ws + WS_BG))[(size_t)row * 8 + lane] = r; }
    }
    __syncthreads();
}
__device__ __forceinline__ void unpack16(const bf16_t* p, float* f) {
    const u32x4 a = ((const u32x4*)p)[0], b = ((const u32x4*)p)[1];
    f[0] = bf_lo(a.x); f[1] = bf_hi(a.x); f[2] = bf_lo(a.y); f[3] = bf_hi(a.y); f[4] = bf_lo(a.z); f[5] = bf_hi(a.z); f[6] = bf_lo(a.w); f[7] = bf_hi(a.w);
    f[8] = bf_lo(b.x); f[9] = bf_hi(b.x); f[10] = bf_lo(b.y); f[11] = bf_hi(b.y); f[12] = bf_lo(b.z); f[13] = bf_hi(b.z); f[14] = bf_lo(b.w); f[15] = bf_hi(b.w);
}
__device__ __forceinline__ void pack16(bf16_t* p, const float* f) {
    u32x4 a, b; a.x = pk2(f[0], f[1]); a.y = pk2(f[2], f[3]); a.z = pk2(f[4], f[5]); a.w = pk2(f[6], f[7]); b.x = pk2(f[8], f[9]); b.y = pk2(f[10], f[11]); b.z = pk2(f[12], f[13]); b.w = pk2(f[14], f[15]);
    ((u32x4*)p)[0] = a; ((u32x4*)p)[1] = b;
}
__device__ __forceinline__ void prep_phase(const Params& p, LAS unsigned char* lds, bool dn, int tid, int wave, int lane) {
    asm volatile("" : "+v"(lane), "+v"(tid));
    bf16_t* P = (bf16_t*)(p.ws + WS_P); bf16_t* U = (bf16_t*)(p.ws + WS_U);
    LAS float* wl = (LAS float*)lds;
    if (dn) { for (int i = tid; i < D * 8; i += 512) { const int k = i >> 3, j = i & 7; wl[(k & 15) * 520 + (k >> 4) * 8 + j] = p.in[I_WIN][(size_t)k * INW + C_RSB + j]; } __syncthreads(); }
    const int ch = 16 * lane;
    float gsb[16], wcv[4][16];
    { const float* gp = (ch < 512 ? p.in[I_GQSB] : p.in[I_GKSB]) + (ch & 63); const float sc = ch < 512 ? 0.18033688011112042f : 1.0f;
#pragma unroll
        for (int e = 0; e < 16; ++e) gsb[e] = gp[e] * sc;
#pragma unroll
        for (int i = 0; i < 4; ++i)
#pragma unroll
            for (int e = 0; e < 16; ++e) wcv[i][e] = p.in[I_WCONV][i * 1536 + ch + e]; }
    for (int row = blockIdx.x * 8 + wave; row < T; row += gridDim.x * 8) {
        const int tl = row & (SEQ - 1);
        if (dn) {
            const u32x4 ca = *(const u32x4*)(U + (size_t)row * D + ch), cb = *(const u32x4*)(U + (size_t)row * D + ch + 8);
            const unsigned w8[8] = {ca.x, ca.y, ca.z, ca.w, cb.x, cb.y, cb.z, cb.w};
            float dot[8];
#pragma unroll
            for (int e = 0; e < 8; ++e) dot[e] = 0.f;
#pragma unroll
            for (int e = 0; e < 16; ++e) { const LAS f32x4* wp = (const LAS f32x4*)(wl + e * 520 + lane * 8); const f32x4 w0 = wp[0], w1 = wp[1];
                const float uv = (e & 1) ? bf_hi(w8[e >> 1]) : bf_lo(w8[e >> 1]);
                dot[0] += uv * w0[0]; dot[1] += uv * w0[1]; dot[2] += uv * w0[2]; dot[3] += uv * w0[3]; dot[4] += uv * w1[0]; dot[5] += uv * w1[1]; dot[6] += uv * w1[2]; dot[7] += uv * w1[3]; }
#pragma unroll
            for (int e = 0; e < 8; ++e) dot[e] = wave_sum(dot[e]);
            float mine = dot[0];
#pragma unroll
            for (int e = 1; e < 8; ++e) mine = (lane == e) ? dot[e] : mine;
            if (lane < 8) { float r;
                if (lane < 4) r = 1.0f / (1.0f + expf(-mine));
                else { const int hh = lane - 4; const float a = mine + p.in[I_DTBIAS][hh]; const float sp = a > 20.f ? a : log1pf(expf(a)); r = -expf(p.in[I_ALOG][hh]) * sp; }
                ((float*)(p.ws + WS_BG))[(size_t)row * 8 + lane] = r; } }
        { bf16_t* qp = P + (size_t)row * NIN + ch; float f[16]; unpack16(qp, f); float ss = 0.f;
#pragma unroll
            for (int e = 0; e < 16; ++e) ss += f[e] * f[e];
            ss += __shfl_xor(ss, 1); ss += __shfl_xor(ss, 2);
            const float rstd = 1.0f / sqrtf(ss * (1.f / 64.f) + EPS);
#pragma unroll
            for (int e = 0; e < 16; ++e) f[e] = f[e] * rstd * gsb[e];
            pack16(qp, f); }
        { float y[16];
#pragma unroll
            for (int e = 0; e < 16; ++e) y[e] = 0.f;
#pragma unroll
            for (int i = 0; i < 4; ++i) { if (tl - 3 + i >= 0) { float f[16]; unpack16(P + (size_t)(row - 3 + i) * NIN + C_QDN + ch, f);
#pragma unroll
                    for (int e = 0; e < 16; ++e) y[e] += wcv[i][e] * f[e]; } }
            float ss = 0.f;
#pragma unroll
            for (int e = 0; e < 16; ++e) { y[e] = fsilu(y[e]); ss += y[e] * y[e]; }
            ss += __shfl_xor(ss, 1); ss += __shfl_xor(ss, 2); ss += __shfl_xor(ss, 4);
            const float sc = (1.0f / sqrtf(ss + EPS)) * (ch < 512 ? 0.08838834764831845f : 1.0f);
#pragma unroll
            for (int e = 0; e < 16; ++e) y[e] *= sc;
            pack16(U + (size_t)row * D + ch, y); }
    }
    bf16_t* Vt = (bf16_t*)(p.ws + WS_VT);
    for (int it = blockIdx.x * 8 + wave; it < T / 16; it += gridDim.x * 8) {
        const int row0 = it * 16, b = row0 >> 11, tl0 = row0 & (SEQ - 1), c8 = lane * 8, hd = c8 >> 6, d0 = c8 & 63;
        u32x4 w[16];
#pragma unroll
        for (int r = 0; r < 16; ++r) w[r] = *(const u32x4*)(P + (size_t)(row0 + r) * NIN + C_VSB + c8);
#pragma unroll
        for (int e = 0; e < 8; ++e) {
            unsigned o[8];
#pragma unroll
            for (int i = 0; i < 8; ++i) {
                const int p0 = 2 * i, p1 = 2 * i + 1;
                const int k0 = 8 * ((p0 >> 2) & 1) + 4 * (p0 >> 3) + (p0 & 3), k1 = 8 * ((p1 >> 2) & 1) + 4 * (p1 >> 3) + (p1 & 3);
                const unsigned a0 = w[k0][e >> 1], a1 = w[k1][e >> 1];
                const unsigned lo = (e & 1) ? (a0 >> 16) : (a0 & 0xffffu), hi = (e & 1) ? (a1 & 0xffff0000u) : (a1 << 16);
                o[i] = lo | hi; }
            bf16_t* dst = Vt + ((size_t)(b * 8 + hd) * 64 + d0 + e) * SEQ + tl0;
            ((u32x4*)dst)[0] = (u32x4){o[0], o[1], o[2], o[3]}; ((u32x4*)dst)[1] = (u32x4){o[4], o[5], o[6], o[7]}; }
    }
}

__device__ __forceinline__ float xlane32(float x, int hh) {
    const unsigned xi = __builtin_bit_cast(unsigned, x);
    const u32x2 r = __builtin_amdgcn_permlane32_swap(xi, xi, false, false);
    return __builtin_bit_cast(float, hh ? r.x : r.y);
}
template <bool DIAG>
__device__ __forceinline__ void attn_tile(const f32x16& z, const bf16x8 (&vc)[4], f32x16& o0, f32x16& o1, float& R, int ql, int hh) {
    float sg[16], m[16];
#pragma unroll
    for (int i = 0; i < 16; ++i) { const float e = __builtin_amdgcn_exp2f(fminf(-z[i], 80.0f)); float sig = __builtin_amdgcn_rcpf(1.0f + e); float mm = e * sig;
        if (DIAG) { const bool act = ((i & 3) + 8 * (i >> 2) + 4 * hh) < ql; sig = act ? sig : 0.f; mm = act ? mm : 1.0f; }
        sg[i] = sig; m[i] = mm; }
    float g[4], gp[4];
#pragma unroll
    for (int bq = 0; bq < 4; ++bq) { g[bq] = (m[4 * bq] * m[4 * bq + 1]) * (m[4 * bq + 2] * m[4 * bq + 3]); gp[bq] = xlane32(g[bq], hh); }
    float outer[4]; float tb = R;
#pragma unroll
    for (int bq = 3; bq >= 0; --bq) { outer[bq] = hh == 0 ? tb * gp[bq] : tb; tb *= g[bq] * gp[bq]; }
    R = tb;
    float w[16];
#pragma unroll
    for (int bq = 0; bq < 4; ++bq) { const float s3 = outer[bq], s2 = s3 * m[4 * bq + 3], s1 = s2 * m[4 * bq + 2], s0 = s1 * m[4 * bq + 1];
        w[4 * bq + 3] = sg[4 * bq + 3] * s3; w[4 * bq + 2] = sg[4 * bq + 2] * s2; w[4 * bq + 1] = sg[4 * bq + 1] * s1; w[4 * bq] = sg[4 * bq] * s0; }
    bf16x8 wf[2];
#pragma unroll
    for (int s2 = 0; s2 < 2; ++s2) { const u32x4 pw = {cpk2(w[8 * s2], w[8 * s2 + 1]), cpk2(w[8 * s2 + 2], w[8 * s2 + 3]), cpk2(w[8 * s2 + 4], w[8 * s2 + 5]), cpk2(w[8 * s2 + 6], w[8 * s2 + 7])}; wf[s2] = __builtin_bit_cast(bf16x8, pw); }
    o0 = __builtin_amdgcn_mfma_f32_32x32x16_bf16(vc[0], wf[0], o0, 0, 0, 0); o0 = __builtin_amdgcn_mfma_f32_32x32x16_bf16(vc[1], wf[1], o0, 0, 0, 0);
    o1 = __builtin_amdgcn_mfma_f32_32x32x16_bf16(vc[2], wf[0], o1, 0, 0, 0); o1 = __builtin_amdgcn_mfma_f32_32x32x16_bf16(vc[3], wf[1], o1, 0, 0, 0);
}
__device__ __forceinline__ void attn_item_mfma(bf16_t* P, const bf16_t* Vt, int bh, int qt, int lane) {
    asm volatile("" : "+v"(lane));
    const int b = bh >> 3, h = bh & 7, ql = lane & 31, hh = lane >> 5, q0 = qt * 32;
    bf16_t* qrow = P + (size_t)(b * SEQ + q0 + ql) * NIN + C_QSB + h * 64;
    bf16x8 qf[4];
#pragma unroll
    for (int s = 0; s < 4; ++s) qf[s] = *(const bf16x8*)(qrow + 16 * s + 8 * hh);
    f32x16 o0, o1;
#pragma unroll
    for (int i = 0; i < 16; ++i) { o0[i] = 0.f; o1[i] = 0.f; }
    float R = 1.0f;
    const bf16_t* kb = P + (size_t)(b * SEQ + ql) * NIN + C_KSB + h * 64 + 8 * hh;
    const bf16_t* vb = Vt + ((size_t)bh * 64 + ql) * SEQ + 8 * hh;
    bf16x8 kf[4], vf[4], vn[4];
#define AT_LOADK(k0_) do { _Pragma("unroll") for (int s = 0; s < 4; ++s) kf[s] = *(const bf16x8*)(kb + (size_t)(k0_) * NIN + 16 * s); } while (0)
#define AT_LOADV(dst, k0_) do { _Pragma("unroll") for (int j = 0; j < 4; ++j) dst[j] = *(const bf16x8*)(vb + (size_t)(j >> 1) * 32 * SEQ + (k0_) + 16 * (j & 1)); } while (0)
#define AT_QK(zz) do { _Pragma("unroll") for (int i = 0; i < 16; ++i) zz[i] = 0.f; _Pragma("unroll") for (int s = 0; s < 4; ++s) zz = __builtin_amdgcn_mfma_f32_32x32x16_bf16(kf[s], qf[s], zz, 0, 0, 0); } while (0)
    f32x16 zc, zn;
    AT_LOADK(q0); AT_LOADV(vf, q0);
    AT_QK(zc);
    { const int k1 = (qt > 0 ? qt - 1 : 0) * 32; AT_LOADK(k1); AT_LOADV(vn, k1); }
    { AT_QK(zn);
      const int k2 = (qt > 1 ? qt - 2 : 0) * 32; AT_LOADK(k2);
      attn_tile<true>(zc, vf, o0, o1, R, ql, hh);
      zc = zn;
#pragma unroll
      for (int j = 0; j < 4; ++j) vf[j] = vn[j];
      const int k1 = (qt > 1 ? qt - 2 : 0) * 32; AT_LOADV(vn, k1); }
#pragma unroll 1
    for (int kt = qt - 1; kt >= 0; --kt) {
        AT_QK(zn);
        const int k2 = (kt > 1 ? kt - 2 : 0) * 32; AT_LOADK(k2);
        attn_tile<false>(zc, vf, o0, o1, R, ql, hh);
        if (__builtin_amdgcn_ballot_w64(R != 0.0f) == 0ull) break;
        zc = zn;
#pragma unroll
        for (int j = 0; j < 4; ++j) vf[j] = vn[j];
        AT_LOADV(vn, k2);
    }
#undef AT_LOADK
#undef AT_LOADV
#undef AT_QK
#pragma unroll
    for (int bq = 0; bq < 4; ++bq) {
        u32x2 w0 = {cpk2(o0[4 * bq], o0[4 * bq + 1]), cpk2(o0[4 * bq + 2], o0[4 * bq + 3])}, w1 = {cpk2(o1[4 * bq], o1[4 * bq + 1]), cpk2(o1[4 * bq + 2], o1[4 * bq + 3])};
        *(u32x2*)(qrow + 8 * bq + 4 * hh) = w0; *(u32x2*)(qrow + 32 + 8 * bq + 4 * hh) = w1; }
}
__device__ __forceinline__ size_t slotU(size_t t0, int h, int colbase, int f) { return (t0 + (size_t)(f >> 7)) * D + colbase + h * 128 + (f & 127); }
__device__ __forceinline__ size_t slotP(size_t t0, int h, int colbase, int f) { return (t0 + (size_t)(f >> 7)) * NIN + colbase + h * 128 + (f & 127); }
__device__ __forceinline__ int permpos(int x) { const int k = x & 15; return (x & ~15) + 8 * ((k >> 2) & 1) + 4 * (k >> 3) + (k & 3); }
__device__ __forceinline__ int crow(int r, int hh) { return (r & 3) + 8 * (r >> 2) + 4 * hh; }
__device__ __forceinline__ bf16x8 pack8(const f32x16& x, int s2) {
    const u32x4 pw = {cpk2(x[8 * s2], x[8 * s2 + 1]), cpk2(x[8 * s2 + 2], x[8 * s2 + 3]), cpk2(x[8 * s2 + 4], x[8 * s2 + 5]), cpk2(x[8 * s2 + 6], x[8 * s2 + 7])};
    return __builtin_bit_cast(bf16x8, pw);
}
#define MFMA32(a, b, c) __builtin_amdgcn_mfma_f32_32x32x16_bf16((a), (b), (c), 0, 0, 0)
constexpr int PT = 72, PQ = 136, PL = 68, PB = 40;
constexpr int CP_GC = 0, CP_BT = 256, CP_LS = 1024, CP_TU = CP_LS + 64 * PL * 4, CP_TW = CP_TU + 64 * PT * 2, CP_KT = CP_TW + 64 * PT * 2, CP_VT = CP_KT + 128 * PT * 2,
              CP_QS = CP_VT + 128 * PT * 2, CP_KS = CP_QS + 64 * PQ * 2, CP_AQ = CP_KS + 64 * PQ * 2, CP_L21 = CP_AQ + 64 * PT * 2, CP_TCM = CP_L21 + 32 * PB * 2, CP_T22 = CP_TCM + 32 * PB * 2, CP_END = CP_T22 + 32 * PB * 2;
static_assert(CP_END <= 131072, "chunk prep LDS");
__device__ __forceinline__ void gdn_chunk_prep_phase(const Params& p, LAS unsigned char* lds, int tid, int wave, int lane) {
    bf16_t* P = (bf16_t*)(p.ws + WS_P); bf16_t* U = (bf16_t*)(p.ws + WS_U); const float* BG = (const float*)(p.ws + WS_BG);
    u32x4 ka, kb, qa, qb, xv[4][2]; float gx = 0.f, gbt = 0.f;
#define CP_LOAD(item_) do { const int bh_ = (item_) >> 5, n_ = (item_) & 31, b_ = bh_ >> 2, h_ = bh_ & 3; const size_t t0_ = (size_t)b_ * SEQ + n_ * 64; const int tok_ = tid & 63, c16_ = (tid >> 6) * 16; \
        ka = *(const u32x4*)(U + (t0_ + tok_) * D + 512 + h_ * 128 + c16_); kb = *(const u32x4*)(U + (t0_ + tok_) * D + 512 + h_ * 128 + c16_ + 8); \
        qa = *(const u32x4*)(U + (t0_ + tok_) * D + h_ * 128 + c16_); qb = *(const u32x4*)(U + (t0_ + tok_) * D + h_ * 128 + c16_ + 8); \
        _Pragma("unroll") for (int i = 0; i < 4; ++i) { const bool ok = n_ * 64 + tok_ - 3 + i >= 0; const bf16_t* vp = P + (t0_ + tok_ - 3 + i) * NIN + C_VDN + h_ * 128 + c16_; \
            xv[i][0] = ok ? *(const u32x4*)vp : (u32x4){0u, 0u, 0u, 0u}; xv[i][1] = ok ? *(const u32x4*)(vp + 8) : (u32x4){0u, 0u, 0u, 0u}; } \
        if (tid < 64) { gx = BG[(t0_ + tid) * 8 + 4 + h_]; gbt = BG[(t0_ + tid) * 8 + h_]; } } while (0)
    if ((int)blockIdx.x < 1024) CP_LOAD((int)blockIdx.x);
  for (int item = blockIdx.x; item < 1024; item += gridDim.x) {
    asm volatile("" : "+v"(tid), "+v"(lane));
    const int bh = item >> 5, n = item & 31, b = bh >> 2, h = bh & 3, ql = lane & 31, hh = lane >> 5;
    const size_t t0 = (size_t)b * SEQ + n * 64;
    LAS float* gcS = (LAS float*)(lds + CP_GC); LAS float* btS = (LAS float*)(lds + CP_BT);
    LAS float* LS = (LAS float*)(lds + CP_LS);
    LAS bf16_t* TuS = (LAS bf16_t*)(lds + CP_TU); LAS bf16_t* TwS = (LAS bf16_t*)(lds + CP_TW);
    LAS bf16_t* kT = (LAS bf16_t*)(lds + CP_KT); LAS bf16_t* vT = (LAS bf16_t*)(lds + CP_VT); LAS bf16_t* qS = (LAS bf16_t*)(lds + CP_QS); LAS bf16_t* kS = (LAS bf16_t*)(lds + CP_KS);
    LAS bf16_t* AQ = (LAS bf16_t*)(lds + CP_AQ); LAS bf16_t* L21b = (LAS bf16_t*)(lds + CP_L21); LAS bf16_t* Tcm = (LAS bf16_t*)(lds + CP_TCM); LAS bf16_t* T22r = (LAS bf16_t*)(lds + CP_T22);
    if (tid < 64) { float x = gx;
#pragma unroll
        for (int o = 1; o < 64; o <<= 1) { const float y = __shfl_up(x, o); if (lane >= o) x += y; }
        gcS[tid] = x; btS[tid] = gbt; }
    { const int tok = tid & 63, c16 = (tid >> 6) * 16;
        *(LAS u32x4*)(kS + tok * PQ + c16) = ka; *(LAS u32x4*)(kS + tok * PQ + c16 + 8) = kb;
        *(LAS u32x4*)(qS + tok * PQ + c16) = qa; *(LAS u32x4*)(qS + tok * PQ + c16 + 8) = qb;
        const unsigned kw[8] = {ka.x, ka.y, ka.z, ka.w, kb.x, kb.y, kb.z, kb.w};
#pragma unroll
        for (int e = 0; e < 8; ++e) { kT[(c16 + 2 * e) * PT + tok] = (bf16_t)(kw[e] & 0xffffu); kT[(c16 + 2 * e + 1) * PT + tok] = (bf16_t)(kw[e] >> 16); }
        float y[16];
#pragma unroll
        for (int e = 0; e < 16; ++e) y[e] = 0.f;
#pragma unroll
        for (int i = 0; i < 4; ++i) { const float* wp = p.in[I_WCONV] + i * 1536 + 1024 + h * 128 + c16;
            const unsigned xw[8] = {xv[i][0].x, xv[i][0].y, xv[i][0].z, xv[i][0].w, xv[i][1].x, xv[i][1].y, xv[i][1].z, xv[i][1].w};
#pragma unroll
            for (int e = 0; e < 8; ++e) { y[2 * e] += wp[2 * e] * bf_lo(xw[e]); y[2 * e + 1] += wp[2 * e + 1] * bf_hi(xw[e]); } }
#pragma unroll
        for (int e = 0; e < 16; ++e) vT[(c16 + e) * PT + tok] = f2bf(fsilu(y[e])); }
    LDS_BARRIER();
    if (item + (int)gridDim.x < 1024) CP_LOAD(item + (int)gridDim.x);
    if (wave == 0 || wave == 4 || wave == 5) {
        const int it = wave == 0 ? 0 : 1, jt = wave == 4 ? 1 : 0;
        f32x16 acc;
#pragma unroll
        for (int r = 0; r < 16; ++r) acc[r] = 0.f;
#pragma unroll
        for (int ks = 0; ks < 8; ++ks) acc = MFMA32(*(const LAS bf16x8*)(kS + (32 * it + ql) * PQ + 16 * ks + 8 * hh), *(const LAS bf16x8*)(kS + (32 * jt + ql) * PQ + 16 * ks + 8 * hh), acc);
        const int j = 32 * jt + ql; const float gj = gcS[j];
#pragma unroll
        for (int r = 0; r < 16; ++r) { const int i = 32 * it + crow(r, hh); const float l = (j < i) ? btS[i] * acc[r] * fexp(gcS[i] - gj) : 0.f;
            if (it != jt) L21b[(i - 32) * PB + j] = f2bf(l); else LS[i * PL + j] = l; }
    } else if (wave < 4) {
        const int jt = wave == 3 ? 1 : 0, it = wave == 1 ? 0 : 1;
        f32x16 acc;
#pragma unroll
        for (int r = 0; r < 16; ++r) acc[r] = 0.f;
#pragma unroll
        for (int ks = 0; ks < 8; ++ks) acc = MFMA32(*(const LAS bf16x8*)(kS + (32 * jt + ql) * PQ + 16 * ks + 8 * hh), *(const LAS bf16x8*)(qS + (32 * it + ql) * PQ + 16 * ks + 8 * hh), acc);
        const int i = 32 * it + ql; const float gi = gcS[i];
#pragma unroll
        for (int r = 0; r < 16; ++r) { const int j = 32 * jt + crow(r, hh); acc[r] = (j <= i) ? acc[r] * fexp(gi - gcS[j]) : 0.f; }
#pragma unroll
        for (int bq = 0; bq < 4; ++bq) *(LAS u32x2*)(AQ + i * PT + 32 * jt + 8 * bq + 4 * hh) = (u32x2){cpk2(acc[4 * bq], acc[4 * bq + 1]), cpk2(acc[4 * bq + 2], acc[4 * bq + 3])};
    } else {
        const float gl = gcS[63];
#pragma unroll
        for (int uu = 0; uu < 4; ++uu) { const int unit = (tid - 384) + 128 * uu, dk = unit >> 2, blk = unit & 3;
            const u32x4 k0 = *(const LAS u32x4*)(kT + dk * PT + 16 * blk), k1 = *(const LAS u32x4*)(kT + dk * PT + 16 * blk + 8);
            float kv[16] = {bf_lo(k0.x), bf_hi(k0.x), bf_lo(k0.y), bf_hi(k0.y), bf_lo(k0.z), bf_hi(k0.z), bf_lo(k0.w), bf_hi(k0.w), bf_lo(k1.x), bf_hi(k1.x), bf_lo(k1.y), bf_hi(k1.y), bf_lo(k1.z), bf_hi(k1.z), bf_lo(k1.w), bf_hi(k1.w)};
#pragma unroll
            for (int e = 0; e < 16; ++e) kv[e] *= fexp(gl - gcS[16 * blk + e]);
            float pv[16];
#pragma unroll
            for (int e = 0; e < 16; ++e) pv[permpos(e)] = kv[e];
            pack16(P + slotP(t0, h, C_VSB, dk * 64 + 16 * blk), pv); }
        if (tid == 384) ((float*)(p.ws + WS_EGL))[bh * 32 + n] = fexp(gl);
    }
    LDS_BARRIER();
    if (wave == 0) {
        const LAS float* LB = LS + (32 * hh) * PL + 32 * hh;
        float Tc[32];
        f32x4 lc[8], ln[8];
        Tc[0] = (ql == 0) ? 1.0f : 0.f;
        lc[0] = *(const LAS f32x4*)(LB + 1 * PL);
#pragma unroll
        for (int i = 1; i < 32; ++i) {
            if (i + 1 < 32) {
#pragma unroll
                for (int j4 = 0; j4 < i + 1; j4 += 4) ln[j4 >> 2] = *(const LAS f32x4*)(LB + (i + 1) * PL + j4); }
            float a0 = (ql == i) ? 1.0f : 0.f, a1 = 0.f, a2 = 0.f, a3 = 0.f;
#pragma unroll
            for (int j4 = 0; j4 < i; j4 += 4) { const f32x4 l4 = lc[j4 >> 2];
                a0 -= l4[0] * Tc[j4]; if (j4 + 1 < i) a1 -= l4[1] * Tc[j4 + 1]; if (j4 + 2 < i) a2 -= l4[2] * Tc[j4 + 2]; if (j4 + 3 < i) a3 -= l4[3] * Tc[j4 + 3]; }
            Tc[i] = (a0 + a1) + (a2 + a3);
#pragma unroll
            for (int q = 0; q < 8; ++q) lc[q] = ln[q]; }
        const int cg_ = 32 * hh + ql; const float bu = btS[cg_], bw = bu * fexp(gcS[cg_]);
#pragma unroll
        for (int i = 0; i < 32; ++i) { TuS[(32 * hh + i) * PT + cg_] = f2bf(Tc[i] * bu); TwS[(32 * hh + i) * PT + cg_] = f2bf(Tc[i] * bw); }
        if (hh == 0) {
#pragma unroll
            for (int i8 = 0; i8 < 4; ++i8) *(LAS u32x4*)(Tcm + ql * PB + 8 * i8) = (u32x4){cpk2(Tc[8 * i8], Tc[8 * i8 + 1]), cpk2(Tc[8 * i8 + 2], Tc[8 * i8 + 3]), cpk2(Tc[8 * i8 + 4], Tc[8 * i8 + 5]), cpk2(Tc[8 * i8 + 6], Tc[8 * i8 + 7])};
        } else {
#pragma unroll
            for (int i = 0; i < 32; ++i) T22r[i * PB + ql] = f2bf(Tc[i]);
        }
        LDS_WAIT();
        f32x16 x1;
#pragma unroll
        for (int r = 0; r < 16; ++r) x1[r] = 0.f;
#pragma unroll
        for (int s2 = 0; s2 < 2; ++s2) x1 = MFMA32(*(const LAS bf16x8*)(L21b + ql * PB + 16 * s2 + 8 * hh), *(const LAS bf16x8*)(Tcm + ql * PB + 16 * s2 + 8 * hh), x1);
        f32x16 yy;
#pragma unroll
        for (int r = 0; r < 16; ++r) yy[r] = 0.f;
#pragma unroll
        for (int s2 = 0; s2 < 2; ++s2) { const u32x2 lo = *(const LAS u32x2*)(T22r + ql * PB + 16 * s2 + 4 * hh), hi = *(const LAS u32x2*)(T22r + ql * PB + 16 * s2 + 8 + 4 * hh);
            const u32x4 af = {lo.x, lo.y, hi.x, hi.y};
            yy = MFMA32(__builtin_bit_cast(bf16x8, af), pack8(x1, s2), yy); }
        { const float bu0 = btS[ql], bw0 = bu0 * fexp(gcS[ql]);
#pragma unroll
            for (int r = 0; r < 16; ++r) { const int i2 = 32 + crow(r, hh); TuS[i2 * PT + ql] = f2bf(-yy[r] * bu0); TwS[i2 * PT + ql] = f2bf(-yy[r] * bw0); } }
    }
    LDS_BARRIER();
    {
        const int isW = wave >> 2, ct = wave & 3, col = 32 * ct + ql;
        const LAS bf16_t* Ta = (isW ? TwS : TuS) + 8 * hh; const LAS bf16_t* Bs = (isW ? kT : vT) + col * PT + 8 * hh;
        bf16x8 bf[4];
#pragma unroll
        for (int ks = 0; ks < 4; ++ks) bf[ks] = *(const LAS bf16x8*)(Bs + 16 * ks);
        f32x16 xa[2];
#pragma unroll
        for (int jt = 0; jt < 2; ++jt) {
#pragma unroll
            for (int r = 0; r < 16; ++r) xa[jt][r] = 0.f;
#pragma unroll
            for (int ks = 0; ks < 4; ++ks) if (jt == 1 || ks < 2) xa[jt] = MFMA32(*(const LAS bf16x8*)(Ta + (32 * jt + ql) * PT + 16 * ks), bf[ks], xa[jt]); }
        bf16x8 xb[4] = {pack8(xa[0], 0), pack8(xa[0], 1), pack8(xa[1], 0), pack8(xa[1], 1)};
        f32x16 ra[2];
#pragma unroll
        for (int it = 0; it < 2; ++it) {
#pragma unroll
            for (int r = 0; r < 16; ++r) ra[it][r] = 0.f;
#pragma unroll
            for (int kk = 0; kk < 4; ++kk) if (it == 1 || kk < 2) { const LAS bf16_t* ap = AQ + (32 * it + ql) * PT + 16 * kk + 4 * hh;
                const u32x2 lo = *(const LAS u32x2*)ap, hi = *(const LAS u32x2*)(ap + 8); const u32x4 af = {lo.x, lo.y, hi.x, hi.y};
                ra[it] = MFMA32(__builtin_bit_cast(bf16x8, af), xb[kk], ra[it]); } }
        if (!isW) {
#pragma unroll
            for (int jt = 0; jt < 2; ++jt)
#pragma unroll
                for (int bq = 0; bq < 4; ++bq) { const int f = col * 64 + 32 * jt + 8 * bq + 4 * hh;
                    *(u32x2*)(U + slotU(t0, h, 0, f)) = (u32x2){cpk2(xa[jt][4 * bq], xa[jt][4 * bq + 1]), cpk2(xa[jt][4 * bq + 2], xa[jt][4 * bq + 3])};
                    *(u32x2*)(U + slotU(t0, h, 512, f)) = (u32x2){cpk2(ra[jt][4 * bq], ra[jt][4 * bq + 1]), cpk2(ra[jt][4 * bq + 2], ra[jt][4 * bq + 3])}; }
        } else {
            const int pc = permpos(col);
#pragma unroll
            for (int jt = 0; jt < 2; ++jt)
#pragma unroll
                for (int r = 0; r < 16; ++r) { const int tok = 32 * jt + crow(r, hh);
                    P[(t0 + tok) * NIN + C_QDN + h * 128 + pc] = f2bf(-xa[jt][r]);
                    P[(t0 + tok) * NIN + C_KDN + h * 128 + pc] = f2bf(bf2f(qS[tok * PQ + col]) * fexp(gcS[tok]) - ra[jt][r]); }
        }
    }
    LDS_BARRIER();
  }
#undef CP_LOAD
}
constexpr int SC_PW = 136, SC_PK = 72, SC_NW = 0, SC_Q2 = 64 * SC_PW * 2, SC_KD = 2 * 64 * SC_PW * 2, SC_STAGE = 2 * 64 * SC_PW * 2 + 128 * SC_PK * 2, SC_OS = 2 * SC_STAGE,
              SC_US = SC_OS + 128 * SC_PK * 2, SC_OI = SC_US + 128 * SC_PK * 2, SC_END = SC_OI + 128 * SC_PK * 2;
static_assert(SC_END <= BST_OFF, "scan LDS");
__device__ __forceinline__ void gdn_scan_block(const Params& p, LAS unsigned char* lds, int bh, int tid, int wave, int lane) {
    asm volatile("" : "+v"(tid), "+v"(lane));
    bf16_t* P = (bf16_t*)(p.ws + WS_P); const bf16_t* U = (const bf16_t*)(p.ws + WS_U); const float* EGL = (const float*)(p.ws + WS_EGL);
    const int b = bh >> 2, h = bh & 3, ql = lane & 31, hh = lane >> 5;
    const size_t tb = (size_t)b * SEQ;
    LAS bf16_t* oS = (LAS bf16_t*)(lds + SC_OS);
    if (wave >= 4) {
        int lt = tid - 256, ftok = lt >> 2, fseg = lt & 3;
        u32x4 ra[20], rb[20];
#define SC_LOAD(r, n_) do { const size_t t0_ = tb + (size_t)(n_) * 64; _Pragma("unroll") for (int i = 0; i < 4; ++i) { const int c = lt + 256 * i, row = c >> 4, c8 = (c & 15) * 8; \
            const bf16_t* g_ = P + (t0_ + row) * NIN + h * 128 + c8; const bf16_t* u_ = U + (t0_ + row) * D + h * 128 + c8; \
            r[i] = *(const u32x4*)(g_ + C_QDN); r[4 + i] = *(const u32x4*)(g_ + C_KDN); r[8 + i] = *(const u32x4*)(g_ + C_VSB); r[12 + i] = *(const u32x4*)u_; r[16 + i] = *(const u32x4*)(u_ + 512); } } while (0)
#define SC_STORE(r, st_) do { LAS unsigned char* s_ = lds + (st_) * SC_STAGE; _Pragma("unroll") for (int i = 0; i < 4; ++i) { const int c = lt + 256 * i, row = c >> 4, c8 = (c & 15) * 8; \
            *(LAS u32x4*)(s_ + SC_NW + (row * SC_PW + c8) * 2) = r[i]; *(LAS u32x4*)(s_ + SC_Q2 + (row * SC_PW + c8) * 2) = r[4 + i]; \
            *(LAS u32x4*)(s_ + SC_KD + ((2 * row + (c8 >> 6)) * SC_PK + (c8 & 63)) * 2) = r[8 + i]; } } while (0)
#define SC_STOREU(r) do { _Pragma("unroll") for (int i = 0; i < 4; ++i) { const int c = lt + 256 * i, row = c >> 4, c8 = (c & 15) * 8; const int o_ = ((2 * row + (c8 >> 6)) * SC_PK + (c8 & 63)) * 2; \
            *(LAS u32x4*)(lds + SC_US + o_) = r[12 + i]; *(LAS u32x4*)(lds + SC_OI + o_) = r[16 + i]; } } while (0)
#define SC_FIN(m_) do { bf16_t* orow = P + (tb + (size_t)(m_) * 64 + ftok) * NIN + h * 128 + fseg * 32 + C_VDN; \
            _Pragma("unroll") for (int i = 0; i < 4; ++i) { unsigned w_[4]; \
                _Pragma("unroll") for (int j = 0; j < 4; ++j) { const int c_ = fseg * 32 + 8 * i + 2 * j; w_[j] = (unsigned)oS[c_ * SC_PK + ftok] | ((unsigned)oS[(c_ + 1) * SC_PK + ftok] << 16); } \
                *(u32x4*)(orow + 8 * i) = (u32x4){w_[0], w_[1], w_[2], w_[3]}; } } while (0)
        SC_LOAD(ra, 0); SC_STORE(ra, 0); SC_STOREU(ra); SC_LOAD(ra, 1);
        LDS_BARRIER();
#pragma unroll 1
        for (int n = 0; n < 32; n += 2) {
            asm volatile("" : "+v"(lt), "+v"(ftok), "+v"(fseg));
            if (n + 2 < 32) SC_LOAD(rb, n + 2);
            SC_STORE(ra, 1);
            if (n > 0) SC_FIN(n - 1);
            LDS_BARRIER();
            SC_STOREU(ra);
            LDS_BARRIER();
            if (n + 3 < 32) SC_LOAD(ra, n + 3);
            if (n + 2 < 32) SC_STORE(rb, 0);
            SC_FIN(n);
            LDS_BARRIER();
            if (n + 2 < 32) SC_STOREU(rb);
            LDS_BARRIER();
        }
        SC_FIN(31);
#undef SC_LOAD
#undef SC_STORE
#undef SC_STOREU
#undef SC_FIN
    } else {
        const int col = 32 * wave + ql;
        f32x16 S[4];
#pragma unroll
        for (int rt = 0; rt < 4; ++rt)
#pragma unroll
            for (int r = 0; r < 16; ++r) S[rt][r] = 0.f;
        const float eglv = EGL[bh * 32 + ql];
        LDS_BARRIER();
#pragma unroll 1
        for (int n = 0; n < 32; ++n) {
            const float egl = __builtin_bit_cast(float, __builtin_amdgcn_readlane(__builtin_bit_cast(int, eglv), n));
            const LAS unsigned char* st = lds + (n & 1) * SC_STAGE;
            f32x16 vn[2], oa[2];
            { const LAS unsigned char* up_ = lds + SC_US + (col * SC_PK + 4 * hh) * 2; const LAS unsigned char* op_ = lds + SC_OI + (col * SC_PK + 4 * hh) * 2;
#pragma unroll
              for (int jt = 0; jt < 2; ++jt)
#pragma unroll
                for (int bq = 0; bq < 4; ++bq) { const u32x2 uw = *(const LAS u32x2*)(up_ + (32 * jt + 8 * bq) * 2), ow = *(const LAS u32x2*)(op_ + (32 * jt + 8 * bq) * 2);
                    vn[jt][4 * bq] = bf_lo(uw.x); vn[jt][4 * bq + 1] = bf_hi(uw.x); vn[jt][4 * bq + 2] = bf_lo(uw.y); vn[jt][4 * bq + 3] = bf_hi(uw.y);
                    oa[jt][4 * bq] = bf_lo(ow.x); oa[jt][4 * bq + 1] = bf_hi(ow.x); oa[jt][4 * bq + 2] = bf_lo(ow.y); oa[jt][4 * bq + 3] = bf_hi(ow.y); } }
            const LAS unsigned char* w0_ = st + (ql * SC_PW + 8 * hh) * 2; const LAS unsigned char* w1_ = w0_ + 32 * SC_PW * 2;
            const LAS unsigned char* kd_ = st + SC_KD + (ql * SC_PK + 8 * hh) * 2;
            bf16x8 fa[4], fb[4];
#define SC_RD4(dst, ptr) do { _Pragma("unroll") for (int i_ = 0; i_ < 4; ++i_) dst[i_] = *(const LAS bf16x8*)((ptr) + 32 * i_); } while (0)
#define SC_MM4(acc, fr, bb) do { _Pragma("unroll") for (int i_ = 0; i_ < 4; ++i_) acc = MFMA32(fr[i_], bb[i_], acc); __builtin_amdgcn_sched_barrier(0); } while (0)
            SC_RD4(fa, w0_ + SC_NW); SC_RD4(fb, w1_ + SC_NW);
            { bf16x8 sb[4] = {pack8(S[0], 0), pack8(S[0], 1), pack8(S[1], 0), pack8(S[1], 1)};
              SC_MM4(vn[0], fa, sb); SC_RD4(fa, w0_ + SC_Q2);
              SC_MM4(vn[1], fb, sb); SC_RD4(fb, w1_ + SC_Q2);
              SC_MM4(oa[0], fa, sb); SC_RD4(fa, w0_ + SC_NW + 128);
              SC_MM4(oa[1], fb, sb); SC_RD4(fb, w1_ + SC_NW + 128); }
            { bf16x8 sb[4] = {pack8(S[2], 0), pack8(S[2], 1), pack8(S[3], 0), pack8(S[3], 1)};
              SC_MM4(vn[0], fa, sb); SC_RD4(fa, w0_ + SC_Q2 + 128);
              SC_MM4(vn[1], fb, sb); SC_RD4(fb, w1_ + SC_Q2 + 128);
              bf16x8 vb[4] = {pack8(vn[0], 0), pack8(vn[0], 1), pack8(vn[1], 0), pack8(vn[1], 1)};
              SC_MM4(oa[0], fa, sb); SC_RD4(fa, kd_);
              SC_MM4(oa[1], fb, sb); SC_RD4(fb, kd_ + 32 * SC_PK * 2);
#pragma unroll
              for (int rt = 0; rt < 4; ++rt)
#pragma unroll
                  for (int r = 0; r < 16; ++r) S[rt][r] *= egl;
              SC_MM4(S[0], fa, vb); SC_RD4(fa, kd_ + 64 * SC_PK * 2);
              SC_MM4(S[1], fb, vb); SC_RD4(fb, kd_ + 96 * SC_PK * 2);
              SC_MM4(S[2], fa, vb);
              SC_MM4(S[3], fb, vb); }
#undef SC_RD4
#undef SC_MM4
            LDS_BARRIER();
#pragma unroll
            for (int jt = 0; jt < 2; ++jt)
#pragma unroll
                for (int bq = 0; bq < 4; ++bq) *(LAS u32x2*)(oS + col * SC_PK + 32 * jt + 8 * bq + 4 * hh) = (u32x2){cpk2(oa[jt][4 * bq], oa[jt][4 * bq + 1]), cpk2(oa[jt][4 * bq + 2], oa[jt][4 * bq + 3])};
            LDS_BARRIER();
        }
    }
}
__device__ __forceinline__ void gdn_finalize_phase(const Params& p, int wave, int lane) {
    asm volatile("" : "+v"(lane));
    bf16_t* P = (bf16_t*)(p.ws + WS_P);
    const int c0 = (lane & 15) * 8;
    float gg[8];
#pragma unroll
    for (int e = 0; e < 8; ++e) gg[e] = p.in[I_GDNOUT][c0 + e];
    for (int row = blockIdx.x * 8 + wave; row < T; row += gridDim.x * 8) {
        bf16_t* op = P + (size_t)row * NIN + C_VDN + lane * 8; const bf16_t* zp = P + (size_t)row * NIN + C_ZDN + lane * 8;
        const u32x4 ow = *(const u32x4*)op, zw = *(const u32x4*)zp;
        const float o[8] = {bf_lo(ow.x), bf_hi(ow.x), bf_lo(ow.y), bf_hi(ow.y), bf_lo(ow.z), bf_hi(ow.z), bf_lo(ow.w), bf_hi(ow.w)};
        const float z[8] = {bf_lo(zw.x), bf_hi(zw.x), bf_lo(zw.y), bf_hi(zw.y), bf_lo(zw.z), bf_hi(zw.z), bf_lo(zw.w), bf_hi(zw.w)};
        float ss = 0.f;
#pragma unroll
        for (int e = 0; e < 8; ++e) ss += o[e] * o[e];
        ss += __shfl_xor(ss, 1); ss += __shfl_xor(ss, 2); ss += __shfl_xor(ss, 4); ss += __shfl_xor(ss, 8);
        const float rstd = 1.0f / sqrtf(ss * (1.f / 128.f) + EPS);
        float r[8];
#pragma unroll
        for (int e = 0; e < 8; ++e) r[e] = o[e] * rstd * gg[e] * fsilu(z[e]);
        u32x4 w; w.x = pk2(r[0], r[1]); w.y = pk2(r[2], r[3]); w.z = pk2(r[4], r[5]); w.w = pk2(r[6], r[7]);
        *(u32x4*)op = w;
    }
}

#define XB_TMO      128
#define XB_XCNT(j)  (256  + 64 * (j))
#define XB_XSUB(j)  (1280 + 64 * (j))
#define XB_XGEN(j)  (2304 + 64 * (j))
#define XB_TOP      3328
#define XB_TOPGEN   3392
#define XCD_BAR_WORDS 3456
#define XB_SPIN_CAP (1u << 18)
__device__ __forceinline__ unsigned xb_ld(unsigned* p)              { return __hip_atomic_load(p, __ATOMIC_RELAXED, __HIP_MEMORY_SCOPE_AGENT); }
__device__ __forceinline__ unsigned xb_add(unsigned* p, unsigned v) { return __hip_atomic_fetch_add(p, v, __ATOMIC_RELAXED, __HIP_MEMORY_SCOPE_AGENT); }
__device__ __forceinline__ unsigned xb_xcc_id() { return (unsigned)__builtin_amdgcn_s_getreg((3 << 11) | 20) & 0xFu; }
#define XB_SPIN(cond, bar) do { unsigned _sp = 0; while (cond) { __builtin_amdgcn_s_sleep(1); \
    if ((++_sp & 255u) == 0u) { if (xb_ld(&(bar)[XB_TMO])) break; if (_sp > XB_SPIN_CAP) { atomicAdd(&(bar)[XB_TMO], 1u); break; } } } } while (0)
struct XcdBarrier { unsigned* bar; unsigned x; volatile LAS unsigned* st; };
__device__ __forceinline__ XcdBarrier xcd_barrier_post(unsigned* bar, volatile LAS unsigned* st) {
    XcdBarrier b; b.bar = bar; b.x = xb_xcc_id(); b.st = st;
    if (threadIdx.x == 0) (void)xb_add(&bar[XB_XCNT(b.x)], 1u);
    return b;
}
__device__ __forceinline__ void xcd_barrier_complete(unsigned* bar, unsigned x, unsigned& nloc, unsigned& nx) {
    const unsigned G = gridDim.x * gridDim.y * gridDim.z;
    unsigned sum, cnt, mine, sp = 0u;
    for (;;) {
        sum = 0u; cnt = 0u; mine = 0u;
#pragma unroll
        for (unsigned j = 0; j < 16; ++j) { const unsigned c = xb_ld(&bar[XB_XCNT(j)]); sum += c; cnt += (c > 0u) ? 1u : 0u; mine = (j == x) ? c : mine; }
        if (sum == G) break;
        __builtin_amdgcn_s_sleep(1);
        if ((++sp & 255u) == 0u) { if (xb_ld(&bar[XB_TMO])) break; if (sp > XB_SPIN_CAP) { atomicAdd(&bar[XB_TMO], 1u); break; } }
    }
    nloc = mine > 0u ? mine : 1u; nx = cnt > 0u ? cnt : 1u;
}
__device__ __forceinline__ void xcd_barrier(const XcdBarrier& b) {
    asm volatile("s_waitcnt vmcnt(0)" ::: "memory");
    __syncthreads();
    if (threadIdx.x == 0) {
        unsigned* bar = b.bar;
        __builtin_amdgcn_s_waitcnt(0);
        unsigned nloc = b.st[0], nx = b.st[1];
        if (nloc == 0u) { xcd_barrier_complete(bar, b.x, nloc, nx); b.st[0] = nloc; b.st[1] = nx; }
        const unsigned old = xb_add(&bar[XB_XSUB(b.x)], 1u);
        const unsigned gen = old / nloc;
        if (old + 1u == (gen + 1u) * nloc) {
            __builtin_amdgcn_fence(__ATOMIC_RELEASE, "agent");
            asm volatile("s_waitcnt vmcnt(0)" ::: "memory");
            const unsigned og = xb_add(&bar[XB_TOP], 1u);
            const unsigned tg = og / nx;
            if (og + 1u == (tg + 1u) * nx) xb_add(&bar[XB_TOPGEN], 1u);
            else XB_SPIN(xb_ld(&bar[XB_TOPGEN]) == tg, bar);
            __builtin_amdgcn_fence(__ATOMIC_ACQUIRE, "agent");
            xb_add(&bar[XB_XGEN(b.x)], 1u);
            asm volatile("s_waitcnt vmcnt(0)" ::: "memory");
        } else {
            XB_SPIN(xb_ld(&bar[XB_TOPGEN]) == gen, bar);
            __builtin_amdgcn_fence(__ATOMIC_ACQUIRE, "agent");
            asm volatile("s_waitcnt vmcnt(0)" ::: "memory");
        }
    }
    __syncthreads();
}

#ifndef PHMASK
#define PHMASK 0xFFFF
#endif
#define PH(n) ((PHMASK >> (n)) & 1)
#ifndef PROBE
#define PROBE 0
#endif
#define REP(g) for (int _rep = 0; _rep < ((PROBE == (g)) ? 2 : 1); ++_rep)
__global__ void __launch_bounds__(512, 2) fwd_megakernel(Params p) {
    extern __shared__ __attribute__((aligned(16))) unsigned char lds_raw[];
    LAS unsigned char* lds = (LAS unsigned char*)lds_raw;
    cg::grid_group grid = cg::this_grid();
    const int tid = threadIdx.x, lane = tid & 63, wave = __builtin_amdgcn_readfirstlane(tid >> 6);
    const int G = gridDim.x, gw = wave * G + blockIdx.x, ngw = G * 8;
    unsigned char* ws = p.ws;
    bf16_t* U = (bf16_t*)(ws + WS_U); bf16_t* P = (bf16_t*)(ws + WS_P);
    const float* mod = (const float*)(ws + WS_MOD);
    LAS float* scr = (LAS float*)(lds + wave * 16384);

    unsigned* barw = (unsigned*)(ws + WS_BAR);
    volatile LAS unsigned* bst = (volatile LAS unsigned*)(lds + BST_OFF);
    if (tid < 2) bst[tid] = 0u;
    __syncthreads();
    if (p.ws == nullptr) grid.sync();
    const XcdBarrier xbar = xcd_barrier_post(barw, bst);
    REP(1) { if (PH(0)) for (int it = blockIdx.x; it < NMOD / 64; it += G) mod_item(p, lds, it, tid, wave, lane);
    { const int nmod = NMOD / 64;
      if (PH(0)) { if (G >= nmod + 64) { if ((int)blockIdx.x >= nmod) ffn_weight_items(p.in[I_WFFN1IN], p.in[I_WFFN1OUT], (bf16_t*)(ws + W_FFIN), (bf16_t*)(ws + W_FFOUT), scr, wave * (G - nmod) + ((int)blockIdx.x - nmod), (G - nmod) * 8, lane); }
                   else ffn_weight_items(p.in[I_WFFN1IN], p.in[I_WFFN1OUT], (bf16_t*)(ws + W_FFIN), (bf16_t*)(ws + W_FFOUT), scr, gw, ngw, lane); } }
    __syncthreads(); }
    xcd_barrier(xbar);
    if (PROBE == 3) for (int i = 0; i < 16; ++i) xcd_barrier(xbar);
    REP(1) if (PH(1)) norm_mod_phase<false>(p, lds, p.in[I_X], p.in[I_GFFN1], 0, U, tid, wave, lane);
    xcd_barrier(xbar);
    REP(2) if (PH(2)) run_gemm(lds, U, D, (const bf16_t*)(ws + W_FFIN), 2 * FF, D, EpiSwiGLU{P, FF});
    { const int nfull = (64 * 22) % G, nidle = nfull ? G - nfull : G;
      const int ib = nfull ? (int)blockIdx.x - nfull : (int)blockIdx.x;
      if (PH(0) && ib >= 0) mixer_weight_items(p, scr, wave * nidle + ib, nidle * 8, lane); }
    xcd_barrier(xbar);
    const bool fusedn = (G == 256);
    unsigned* xslot = (unsigned*)(ws + WS_XSLOT); unsigned* xcnt = (unsigned*)(ws + WS_XCNT);
    if (fusedn) { if (PH(3)) run_gemm(lds, P, FF, (const bf16_t*)(ws + W_FFOUT), D, FF, EpiResidNorm{p.in[I_X], p.out, mod + 2 * D, p.in[I_GMIX], mod + 3 * D, U, xslot, xcnt, 0.5f, 0}); }
    else { REP(2) if (PH(3)) run_gemm(lds, P, FF, (const bf16_t*)(ws + W_FFOUT), D, FF, EpiResid{p.in[I_X], p.out, mod + 2 * D, 0.5f}); }
    xcd_barrier(xbar);
    if (!fusedn) { REP(1) if (PH(4)) norm_mod_phase<true>(p, lds, p.out, p.in[I_GMIX], 3, U, tid, wave, lane); xcd_barrier(xbar); }
    REP(2) if (PH(5)) run_gemm(lds, U, D, (const bf16_t*)(ws + W_IN), NIN, D, EpiBf16{P, NIN});
    { const int nfull = (64 * 22) % G, nidle = nfull ? G - nfull : G; const int ib = nfull ? (int)blockIdx.x - nfull : (int)blockIdx.x;
      if (PH(12) && ib >= 0) ffn_weight_items(p.in[I_WFFN2IN], p.in[I_WFFN2OUT], (bf16_t*)(ws + WS_F2IN), (bf16_t*)(ws + W_FFOUT), scr, wave * nidle + ib, nidle * 8, lane, 0, 2816); }
    xcd_barrier(xbar);
    if (PH(6)) prep_phase(p, lds, fusedn, tid, wave, lane);
    xcd_barrier(xbar);
    if (PH(7)) gdn_chunk_prep_phase(p, lds, tid, wave, lane);
    xcd_barrier(xbar);
    if (PH(15)) for (int it = blockIdx.x; it < 32; it += G) gdn_scan_block(p, lds, it, tid, wave, lane);
    if (PH(8)) {
        const unsigned x0 = xb_xcc_id() & 7u;
        for (unsigned dx = 0; dx < 8u; ++dx) { const unsigned x = (x0 + dx) & 7u; unsigned* ctr = (unsigned*)(ws + WS_CTR) + 64 * x;
            for (;;) { unsigned idx = 0; if (lane == 0) idx = atomicAdd(ctr, 1u); idx = __builtin_amdgcn_readfirstlane(idx);
                if (idx >= 512u) break;
                attn_item_mfma(P, (const bf16_t*)(ws + WS_VT), (int)(8u * x + (idx & 7u)), 63 - (int)(idx >> 3), lane); } } }
    xcd_barrier(xbar);
    if (PH(9)) gdn_finalize_phase(p, wave, lane);
    xcd_barrier(xbar);
    if (PH(10)) run_gemm(lds, P + C_QSB, NIN, (const bf16_t*)(ws + W_UPSB), D, 1024, EpiGateFused{P + C_RSB, P + C_RDN, U}, 8, (C_VDN - C_QSB) * 2 - 8 * 128);
    if (fusedn && PH(12)) ffn_weight_items(p.in[I_WFFN2IN], p.in[I_WFFN2OUT], (bf16_t*)(ws + WS_F2IN), (bf16_t*)(ws + W_FFOUT), scr, gw, ngw, lane, 2816, 2816 + 1408);
    xcd_barrier(xbar);
    if (fusedn) { if (PH(11)) run_gemm(lds, U, D, (const bf16_t*)(ws + W_OUT), D, D, EpiResidNorm{p.out, p.out, mod + 5 * D, p.in[I_GFFN2], mod + 6 * D, U, xslot + 64 * 256 * 4, xcnt + 64 * 64, 1.0f, 0}); }
    else { if (PH(11)) run_gemm(lds, U, D, (const bf16_t*)(ws + W_OUT), D, D, EpiResid{p.out, p.out, mod + 5 * D, 1.0f}); }
    xcd_barrier(xbar);
    if (!fusedn) { REP(1) if (PH(12)) norm_mod_phase<false>(p, lds, p.out, p.in[I_GFFN2], 6, U, tid, wave, lane);
        __syncthreads();
        if (PH(12)) ffn_weight_items(p.in[I_WFFN2IN], p.in[I_WFFN2OUT], (bf16_t*)(ws + WS_F2IN), (bf16_t*)(ws + W_FFOUT), scr, gw, ngw, lane, 2816, 2816 + 1408);
        xcd_barrier(xbar); }
    REP(2) if (PH(13)) run_gemm(lds, U, D, (const bf16_t*)(ws + WS_F2IN), 2 * FF, D, EpiSwiGLU{P, FF});
    xcd_barrier(xbar);
    if (PH(14)) run_gemm(lds, P, FF, (const bf16_t*)(ws + W_FFOUT), D, FF, EpiResid{p.out, p.out, mod + 8 * D, 0.5f});
}

extern "C" void kernel_launch(void* const* d_in, const int* in_sizes, int n_in, void* d_out, int out_size, void* d_ws, size_t ws_size, hipStream_t stream) {
    static int grid_blocks = 0;
    if (!grid_blocks) {
        int dev = 0, cus = 0, per_cu = 0;
        (void)hipGetDevice(&dev);
        (void)hipDeviceGetAttribute(&cus, hipDeviceAttributeMultiprocessorCount, dev);
        (void)hipFuncSetAttribute((const void*)fwd_megakernel, hipFuncAttributeMaxDynamicSharedMemorySize, LDS_BYTES);
        (void)hipOccupancyMaxActiveBlocksPerMultiprocessor(&per_cu, (const void*)fwd_megakernel, 512, LDS_BYTES);
        if (per_cu < 1) { fprintf(stderr, "occupancy query says %d blocks/CU\n", per_cu); per_cu = 1; }
        grid_blocks = cus;
    }
    Params p{};
    for (int i = 0; i < N_IN; ++i) p.in[i] = (const float*)d_in[i];
    p.out = (float*)d_out; p.ws = (unsigned char*)d_ws;
    static_assert(WS_BAR + XCD_BAR_WORDS * 4 <= WS_XCNT, "control words");
    (void)hipMemsetAsync((char*)d_ws + WS_CTR, 0, WS_ZEND - WS_CTR, stream);
    void* args[] = {&p};
    hipError_t e = hipLaunchCooperativeKernel((const void*)fwd_megakernel, dim3(grid_blocks), dim3(512), args, LDS_BYTES, stream);
    if (e != hipSuccess) fprintf(stderr, "cooperative launch failed: %s (grid %d)\n", hipGetErrorString(e), grid_blocks);
}
```
